# Optimizing an MI355X kernel written in HIP

```python
import math
import jax, jax.numpy as jnp
from jax import lax
import numpy as np

D_MODEL = 1024
BATCH = 8
SEQ = 2048
DEPTH = 1

GRID_W = 64
N_DIFF_HEADS = 4
DIFF_HEAD_DIM = 64
DIFF_V_DIM = 2 * DIFF_HEAD_DIM
ROPE_THETA = 500000.0
ROPE_DIM = DIFF_HEAD_DIM // 4
Q_BLOCK = 128
N_NA_HEADS = 8
NA_HEAD_DIM = 64
NA_KR_MAX = 8
NA_KC = 16
A_QK_W = N_DIFF_HEADS * 2 * DIFF_HEAD_DIM
A_V_W = N_DIFF_HEADS * DIFF_V_DIM
B_W = N_NA_HEADS * NA_HEAD_DIM
IN_W = 2 * A_QK_W + A_V_W + 3 * B_W + 2 * D_MODEL
PEER_HEADS = 8
PEER_N_KEYS = 128
PEER_N_EXPERTS = PEER_N_KEYS * PEER_N_KEYS
PEER_QUERY_DIM = 256
PEER_TOPK = 16
PEER_TOKEN_BLOCK = 128
EPS = 1e-6

kernel_name = "hybrid_diffattn_natten_peer_block"


def rmsnorm(x, g):
    xf = x.astype(jnp.float32)
    y = xf * lax.rsqrt(jnp.mean(xf * xf, axis=-1, keepdims=True) + EPS)
    return (y * g.astype(jnp.float32)).astype(x.dtype)


def rope_tables(seq_len):
    inv_freq = ROPE_THETA ** (-jnp.arange(0, ROPE_DIM, 2, dtype=jnp.float32) / ROPE_DIM)
    ang = jnp.arange(seq_len, dtype=jnp.float32)[:, None] * inv_freq[None, :]
    return jnp.cos(ang), jnp.sin(ang)


def apply_partial_rope(x, cos, sin):
    xr, xp = x[..., :ROPE_DIM], x[..., ROPE_DIM:]
    half = ROPE_DIM // 2
    x1, x2 = xr[..., :half], xr[..., half:]
    c, s = cos.astype(x.dtype), sin.astype(x.dtype)
    rot = jnp.concatenate([x1 * c - x2 * s, x2 * c + x1 * s], axis=-1)
    return jnp.concatenate([rot, xp], axis=-1)


def differential_attention(q, k, v, lam, lam_init, subln_g):
    B, S, _ = v.shape
    H, d = N_DIFF_HEADS, DIFF_HEAD_DIM
    q = q.reshape(B, S, H, 2, d).transpose(0, 2, 3, 1, 4)
    k = k.reshape(B, S, H, 2, d).transpose(0, 2, 3, 1, 4)
    v = v.reshape(B, S, H, DIFF_V_DIM).transpose(0, 2, 1, 3)
    cos, sin = rope_tables(S)
    q = apply_partial_rope(q, cos, sin) * (d ** -0.5)
    k = apply_partial_rope(k, cos, sin)
    n_blocks = S // Q_BLOCK
    qb = q.reshape(B, H, 2, n_blocks, Q_BLOCK, d).transpose(3, 0, 1, 2, 4, 5)
    lam_v = lam.astype(v.dtype)

    def block(q_blk):
        s = jnp.einsum('bhmqd,bhmkd->bhmqk', q_blk, k).astype(jnp.float32)
        p = jax.nn.softmax(s, axis=-1).astype(v.dtype)
        a = p[:, :, 0] - lam_v * p[:, :, 1]
        return jnp.einsum('bhqk,bhkv->bhqv', a, v)

    o = lax.map(block, qb)
    o = o.transpose(1, 0, 3, 2, 4).reshape(B, S, H, DIFF_V_DIM)
    o = rmsnorm(o, subln_g) * (1.0 - lam_init)
    return o.reshape(B, S, H * DIFF_V_DIM)


def neighbourhood_attention(q, k, v, rpb):
    B, S, _ = q.shape
    H, d = N_NA_HEADS, NA_HEAD_DIM
    rows = S // GRID_W
    kr = min(NA_KR_MAX, rows)

    def to_grid(t):
        return t.reshape(B, rows, GRID_W, H, d).transpose(0, 3, 1, 2, 4)

    qg = to_grid(q) * (d ** -0.5)
    kg, vg = to_grid(k), to_grid(v)
    cols = jnp.arange(GRID_W)
    col_start = jnp.clip(cols - NA_KC // 2, 0, GRID_W - NA_KC)
    col_idx = col_start[:, None] + jnp.arange(NA_KC)[None, :]
    col_bias_idx = col_idx - cols[:, None] + (NA_KC - 1)

    def row_block(r):
        rs = jnp.clip(r - kr // 2, 0, rows - kr)
        k_rows = lax.dynamic_slice_in_dim(kg, rs, kr, axis=2)
        v_rows = lax.dynamic_slice_in_dim(vg, rs, kr, axis=2)
        k_nb = k_rows[:, :, :, col_idx, :]
        v_nb = v_rows[:, :, :, col_idx, :]
        q_r = lax.dynamic_index_in_dim(qg, r, axis=2, keepdims=False)
        row_bias_idx = rs + jnp.arange(kr) - r + (NA_KR_MAX - 1)
        bias = rpb[:, row_bias_idx[:, None, None], col_bias_idx[None, :, :]]
        bias = bias.transpose(0, 2, 1, 3)
        s = jnp.einsum('bhcd,bhicjd->bhcij', q_r, k_nb) + bias[None]
        s = s.astype(jnp.float32).reshape(B, H, GRID_W, kr * NA_KC)
        p = jax.nn.softmax(s, axis=-1).astype(v.dtype).reshape(B, H, GRID_W, kr, NA_KC)
        return jnp.einsum('bhcij,bhicjd->bhcd', p, v_nb)

    o = lax.map(row_block, jnp.arange(rows))
    return o.transpose(1, 0, 3, 2, 4).reshape(B, S, H * d)


def peer_ffn(x, w_query, sub_keys, expert_u, expert_v):
    B, S, D = x.shape
    TB, PH, K = PEER_TOKEN_BLOCK, PEER_HEADS, PEER_TOPK
    xt = x.reshape(B * S // TB, TB, D)

    def block(xb):
        q = (xb @ w_query).reshape(TB, PH, 2, PEER_QUERY_DIM // 2)
        s = jnp.einsum('thpd,hpkd->thpk', q, sub_keys).astype(jnp.float32)
        v_half, i_half = lax.top_k(s, K)
        cand = v_half[:, :, 0, :, None] + v_half[:, :, 1, None, :]
        cidx = i_half[:, :, 0, :, None] * PEER_N_KEYS + i_half[:, :, 1, None, :]
        top_s, pos = lax.top_k(cand.reshape(TB, PH, K * K), K)
        idx = jnp.take_along_axis(cidx.reshape(TB, PH, K * K), pos, axis=-1)
        g = jax.nn.softmax(top_s, axis=-1).astype(xb.dtype)
        u = expert_u[idx]
        a = jax.nn.gelu(jnp.einsum('td,thkd->thk', xb, u), approximate=False)
        return jnp.einsum('thk,thkd->td', g * a, expert_v[idx])

    return lax.map(block, xt).reshape(B, S, D)


def setup_inputs(seed: int = 0) -> dict:
    key = jax.random.key(seed)
    ks = jax.random.split(key, 20)
    f32 = jnp.float32
    nrm = lambda k, shape, scale: jax.random.normal(k, shape, f32) * scale
    return {
        "x": nrm(ks[0], (BATCH, SEQ, D_MODEL), 1.0),
        "w_in": nrm(ks[1], (DEPTH, D_MODEL, IN_W), D_MODEL ** -0.5),
        "w_proj_a": nrm(ks[2], (DEPTH, A_V_W, D_MODEL), A_V_W ** -0.5),
        "w_proj_b": nrm(ks[3], (DEPTH, B_W, D_MODEL), B_W ** -0.5),
        "w_out": nrm(ks[4], (DEPTH, D_MODEL, D_MODEL), D_MODEL ** -0.5),
        "norm_mix": 1.0 + nrm(ks[5], (DEPTH, D_MODEL), 0.02),
        "norm_ffn": 1.0 + nrm(ks[6], (DEPTH, D_MODEL), 0.02),
        "norm_final": 1.0 + nrm(ks[7], (D_MODEL,), 0.02),
        "lambda_q1": nrm(ks[8], (DEPTH, DIFF_HEAD_DIM), 0.1),
        "lambda_k1": nrm(ks[9], (DEPTH, DIFF_HEAD_DIM), 0.1),
        "lambda_q2": nrm(ks[10], (DEPTH, DIFF_HEAD_DIM), 0.1),
        "lambda_k2": nrm(ks[11], (DEPTH, DIFF_HEAD_DIM), 0.1),
        "diff_subln": 1.0 + nrm(ks[12], (DEPTH, DIFF_V_DIM), 0.02),
        "na_rpb": nrm(ks[13], (DEPTH, N_NA_HEADS, 2 * NA_KR_MAX - 1, 2 * NA_KC - 1), 0.1),
        "peer_w_query": nrm(ks[14], (DEPTH, D_MODEL, PEER_HEADS * PEER_QUERY_DIM), D_MODEL ** -0.5),
        "peer_sub_keys": nrm(ks[15], (DEPTH, PEER_HEADS, 2, PEER_N_KEYS, PEER_QUERY_DIM // 2), (PEER_QUERY_DIM // 2) ** -0.5),
        "peer_u": nrm(ks[16], (DEPTH, PEER_N_EXPERTS, D_MODEL), D_MODEL ** -0.5),
        "peer_v": nrm(ks[17], (DEPTH, PEER_N_EXPERTS, D_MODEL), 0.5),
    }


def reference(x, w_in, w_proj_a, w_proj_b, w_out, norm_mix, norm_ffn, norm_final,
              lambda_q1, lambda_k1, lambda_q2, lambda_k2, diff_subln, na_rpb,
              peer_w_query, peer_sub_keys, peer_u, peer_v):
    split_points = list(np.cumsum([A_QK_W, A_QK_W, A_V_W, B_W, B_W, B_W, D_MODEL])[:])
    h = x
    for l in range(DEPTH):
        lam_init = 0.8 - 0.6 * math.exp(-0.3 * l)
        lam = (jnp.exp(jnp.sum(lambda_q1[l].astype(jnp.float32) * lambda_k1[l].astype(jnp.float32)))
               - jnp.exp(jnp.sum(lambda_q2[l].astype(jnp.float32) * lambda_k2[l].astype(jnp.float32)))
               + lam_init)
        n = rmsnorm(h, norm_mix[l])
        proj = n @ w_in[l]
        qa, ka, va, qb, kb, vb, ga, gb = jnp.split(proj, split_points, axis=-1)
        y_a = differential_attention(qa, ka, va, lam, lam_init, diff_subln[l])
        y_b = neighbourhood_attention(qb, kb, vb, na_rpb[l])
        merged = (jax.nn.sigmoid(ga) * (y_a @ w_proj_a[l])
                  + jax.nn.sigmoid(gb) * (y_b @ w_proj_b[l]))
        h = h + merged @ w_out[l]
        h = h + peer_ffn(rmsnorm(h, norm_ffn[l]), peer_w_query[l], peer_sub_keys[l],
                         peer_u[l], peer_v[l])
    return rmsnorm(h, norm_final)
```

```cpp
#include <hip/hip_runtime.h>
#include <cstdio>
#include <cstdint>

typedef unsigned short bf16_t;
typedef unsigned u32x4 __attribute__((ext_vector_type(4)));
typedef unsigned u32x2 __attribute__((ext_vector_type(2)));
typedef float f32x4 __attribute__((ext_vector_type(4)));
typedef __bf16 bf16x2_t __attribute__((ext_vector_type(2)));

constexpr int D = 1024, BATCH = 8, SEQ = 2048, M = BATCH * SEQ, INW = 5120;
constexpr int C_QA = 0, C_KA = 512, C_VA = 1024, C_QB = 1536, C_KB = 2048, C_VB = 2560, C_GA = 3072, C_GB = 4096;
constexpr int NEXP = 16384, PQ = 2048;
constexpr float EPS = 1e-6f;
constexpr float LOG2E = 1.4426950408889634f;
constexpr float QSCALE = 0.125f * LOG2E;

constexpr size_t MiB = 1u << 20;
constexpr size_t WS_PROJ = 0;
constexpr size_t WS_HB = 0;
constexpr size_t WS_Q = 32 * MiB;
constexpr size_t WS_U = 96 * MiB;
constexpr size_t WS_V = 128 * MiB;
constexpr size_t WS_XN = 160 * MiB;
constexpr size_t WS_YA = 160 * MiB;
constexpr size_t WS_YB = 176 * MiB;
constexpr size_t WS_IDX = 160 * MiB;
constexpr size_t WS_G = 168 * MiB;
constexpr size_t WS_MERGED = 192 * MiB;
constexpr size_t WS_TOPV = 192 * MiB;
constexpr size_t WS_TOPI = 208 * MiB;
constexpr size_t WS_WIN = 224 * MiB;
constexpr size_t WS_WQ = 234 * MiB;
constexpr size_t WS_WOUT = 238 * MiB;
constexpr size_t WS_WPA = 240 * MiB;
constexpr size_t WS_WPB = 241 * MiB;
constexpr size_t WS_SK = 242 * MiB;
constexpr size_t WS_ROPE = 242 * MiB + 512 * 1024;
constexpr size_t WS_SSQ = 243 * MiB;
constexpr size_t WS_CTL = 244 * MiB;
constexpr size_t WS_END = 256 * MiB;

__device__ __forceinline__ float bf2f(unsigned v) { return __uint_as_float(v << 16); }
__device__ __forceinline__ float bflo(unsigned w) { return __uint_as_float(w << 16); }
__device__ __forceinline__ float bfhi(unsigned w) { return __uint_as_float(w & 0xffff0000u); }
__device__ __forceinline__ unsigned f2bf(float f) { unsigned u = __float_as_uint(f); return (u + 0x7fffu + ((u >> 16) & 1u)) >> 16; }
__device__ __forceinline__ unsigned pk2(float lo, float hi) { return f2bf(lo) | (f2bf(hi) << 16); }
__device__ __forceinline__ float wave_sum(float v) {
#pragma unroll
    for (int o = 1; o < 64; o <<= 1) v += __shfl_xor(v, o);
    return v;
}
__device__ __forceinline__ float sigmoidf_(float x) { return 1.f / (1.f + __expf(-x)); }
__device__ __forceinline__ float gelu_exact(float x) { return 0.5f * x * (1.f + erff(x * 0.70710678118654752f)); }

struct Ptrs {
    const float *x, *w_in, *w_pa, *w_pb, *w_out, *norm_mix, *norm_ffn, *norm_final, *lq1, *lk1, *lq2, *lk2, *subln, *rpb, *w_query, *sub_keys, *peer_u, *peer_v;
    float* out; unsigned char* ws;
};

__device__ __forceinline__ void transpose_item(const float* W, int K, int N, const float* gain, bf16_t* WT, float* scr, int item, int lane) {
    const int nblk = N / 32, kb = item / nblk, nb = item % nblk, k0 = 64 * kb, n0 = 32 * nb;
#pragma unroll 8
    for (int i = 0; i < 32; ++i) { const int kk = 2 * i + (lane >> 5); float w = W[(size_t)(k0 + kk) * N + n0 + (lane & 31)]; if (gain) w *= gain[k0 + kk]; scr[kk * 33 + (lane & 31)] = w; }
    asm volatile("s_waitcnt lgkmcnt(0)" ::: "memory");
    const int c = lane & 7;
#pragma unroll
    for (int j = 0; j < 4; ++j) { const int n = (lane >> 3) + 8 * j; const float* s = scr + (8 * c) * 33 + n;
        u32x4 o; o.x = pk2(s[0 * 33], s[1 * 33]); o.y = pk2(s[2 * 33], s[3 * 33]); o.z = pk2(s[4 * 33], s[5 * 33]); o.w = pk2(s[6 * 33], s[7 * 33]);
        *(u32x4*)(WT + (size_t)(n0 + n) * K + k0 + 8 * c) = o; }
    asm volatile("s_waitcnt lgkmcnt(0)" ::: "memory");
}
__device__ __forceinline__ void cvt8(const float* src, bf16_t* dst, size_t i8) {
    const f32x4 a = *(const f32x4*)(src + i8 * 8), b = *(const f32x4*)(src + i8 * 8 + 4);
    u32x4 o; o.x = pk2(a.x, a.y); o.y = pk2(a.z, a.w); o.z = pk2(b.x, b.y); o.w = pk2(b.z, b.w);
    *(u32x4*)(dst + i8 * 8) = o;
}
__device__ __forceinline__ void rms_row_to_bf16(const float* xrow, bf16_t* orow, int lane) {
    const f32x4* xr = (const f32x4*)xrow + lane;
    f32x4 v[4]; float s = 0.f;
#pragma unroll
    for (int j = 0; j < 4; ++j) { v[j] = xr[64 * j]; s += (v[j].x * v[j].x + v[j].y * v[j].y) + (v[j].z * v[j].z + v[j].w * v[j].w); }
    const float rstd = 1.f / sqrtf(wave_sum(s) * (1.f / D) + EPS);
    u32x2* o8 = (u32x2*)orow + lane;
#pragma unroll
    for (int j = 0; j < 4; ++j) { u32x2 w; w.x = pk2(v[j].x * rstd, v[j].y * rstd); w.y = pk2(v[j].z * rstd, v[j].w * rstd); o8[64 * j] = w; }
}

__global__ void __launch_bounds__(256) k_prep(Ptrs P) {
    __shared__ float scr_all[4][64 * 33];
    const int lane = threadIdx.x & 63, wave = threadIdx.x >> 6;
    const int gw = blockIdx.x * 4 + wave, NGW = gridDim.x * 4;
    float* scr = scr_all[wave];
    unsigned char* ws = P.ws;
    constexpr int I_IN = (D / 64) * (INW / 32), I_Q = (D / 64) * (PQ / 32), I_OUT = (D / 64) * (D / 32), I_PA = (512 / 64) * (D / 32);
    constexpr int NIT = I_IN + I_Q + I_OUT + 2 * I_PA;
    for (int it = gw; it < NIT; it += NGW) {
        int r = it;
        if (r < I_IN) { transpose_item(P.w_in, D, INW, P.norm_mix, (bf16_t*)(ws + WS_WIN), scr, r, lane); continue; } r -= I_IN;
        if (r < I_Q) { transpose_item(P.w_query, D, PQ, P.norm_ffn, (bf16_t*)(ws + WS_WQ), scr, r, lane); continue; } r -= I_Q;
        if (r < I_OUT) { transpose_item(P.w_out, D, D, nullptr, (bf16_t*)(ws + WS_WOUT), scr, r, lane); continue; } r -= I_OUT;
        if (r < I_PA) { transpose_item(P.w_pa, 512, D, nullptr, (bf16_t*)(ws + WS_WPA), scr, r, lane); continue; } r -= I_PA;
        transpose_item(P.w_pb, 512, D, nullptr, (bf16_t*)(ws + WS_WPB), scr, r, lane);
    }
    for (int m = gw; m < M; m += NGW) rms_row_to_bf16(P.x + (size_t)m * D, (bf16_t*)(ws + WS_XN) + (size_t)m * D, lane);
    const size_t gt = (size_t)blockIdx.x * 256 + threadIdx.x, NT = (size_t)gridDim.x * 256;
    for (size_t i = gt; i < (size_t)16 * 128 * 128 / 8; i += NT) cvt8(P.sub_keys, (bf16_t*)(ws + WS_SK), i);
    for (size_t i = gt; i < (size_t)SEQ * 8; i += NT) {
        const int pos = (int)(i >> 3), k = (int)(i & 7);
        const float inv = (float)pow(500000.0, -(double)k / 8.0);
        const float ang = (float)pos * inv;
        float* t = (float*)(ws + WS_ROPE) + (size_t)pos * 16;
        t[k] = (float)cos((double)ang); t[8 + k] = (float)sin((double)ang);
    }
}
__global__ void __launch_bounds__(256) k_cvt_experts(Ptrs P) {
    const size_t gt = (size_t)blockIdx.x * 256 + threadIdx.x, NT = (size_t)gridDim.x * 256;
    for (size_t i = gt; i < (size_t)NEXP * D / 8; i += NT) { cvt8(P.peer_u, (bf16_t*)(P.ws + WS_U), i); cvt8(P.peer_v, (bf16_t*)(P.ws + WS_V), i); }
}

enum { EPI_PROJ = 0, EPI_GATE_A = 1, EPI_GATE_B = 2, EPI_HOUT = 3, EPI_Q = 4 };
template <int EPI> __global__ void __launch_bounds__(256) k_gemm_naive(const bf16_t* A, const bf16_t* Bt, int N, int K, Ptrs P) {
    const int col = blockIdx.x * 64 + (threadIdx.x & 63), row = blockIdx.y * 4 + (threadIdx.x >> 6);
    const bf16_t* a = A + (size_t)row * K; const bf16_t* b = Bt + (size_t)col * K;
    float acc = 0.f;
    for (int k = 0; k < K; k += 8) {
        const u32x4 av = *(const u32x4*)(a + k), bv = *(const u32x4*)(b + k);
        acc += bflo(av.x) * bflo(bv.x); acc += bfhi(av.x) * bfhi(bv.x); acc += bflo(av.y) * bflo(bv.y); acc += bfhi(av.y) * bfhi(bv.y);
        acc += bflo(av.z) * bflo(bv.z); acc += bfhi(av.z) * bfhi(bv.z); acc += bflo(av.w) * bflo(bv.w); acc += bfhi(av.w) * bfhi(bv.w);
    }
    unsigned char* ws = P.ws;
    if (EPI == EPI_PROJ) { ((bf16_t*)(ws + WS_PROJ))[(size_t)row * INW + col] = (bf16_t)f2bf(acc); }
    if (EPI == EPI_GATE_A) { const float g = bf2f(((const bf16_t*)(ws + WS_PROJ))[(size_t)row * INW + C_GA + col]); P.out[(size_t)row * D + col] = sigmoidf_(g) * acc; }
    if (EPI == EPI_GATE_B) { const float g = bf2f(((const bf16_t*)(ws + WS_PROJ))[(size_t)row * INW + C_GB + col]);
        ((bf16_t*)(ws + WS_MERGED))[(size_t)row * D + col] = (bf16_t)f2bf(P.out[(size_t)row * D + col] + sigmoidf_(g) * acc); }
    if (EPI == EPI_HOUT) { const float h = P.x[(size_t)row * D + col] + acc; P.out[(size_t)row * D + col] = h; ((bf16_t*)(ws + WS_HB))[(size_t)row * D + col] = (bf16_t)f2bf(h); }
    if (EPI == EPI_Q) { const float* s = (const float*)(ws + WS_SSQ) + (size_t)row * 4; const float rstd = 1.f / sqrtf(((s[0] + s[1]) + (s[2] + s[3])) * (1.f / D) + EPS);
        ((bf16_t*)(ws + WS_Q))[(size_t)row * PQ + col] = (bf16_t)f2bf(acc * rstd); }
}
__global__ void __launch_bounds__(256) k_rope_naive(Ptrs P) {
    bf16_t* proj = (bf16_t*)(P.ws + WS_PROJ); const float* rope = (const float*)(P.ws + WS_ROPE);
    const size_t gt = (size_t)blockIdx.x * 256 + threadIdx.x;
    if (gt >= (size_t)M * 16 * 8) return;
    const int i = (int)(gt & 7), slot = (int)((gt >> 3) & 15), row = (int)(gt >> 7);
    const int base = (slot < 8 ? C_QA : C_KA) + (slot & 7) * 64, pos = row % SEQ;
    bf16_t* p = proj + (size_t)row * INW + base;
    const float x1 = bf2f(p[i]), x2 = bf2f(p[i + 8]), c = rope[pos * 16 + i], s = rope[pos * 16 + 8 + i];
    p[i] = (bf16_t)f2bf(x1 * c - x2 * s); p[i + 8] = (bf16_t)f2bf(x2 * c + x1 * s);
}
__global__ void __launch_bounds__(256) k_scale_naive(Ptrs P) {
    bf16_t* proj = (bf16_t*)(P.ws + WS_PROJ);
    const size_t gt = (size_t)blockIdx.x * 256 + threadIdx.x;
    if (gt >= (size_t)M * 1024) return;
    const int c = (int)(gt & 1023), row = (int)(gt >> 10);
    bf16_t* p = proj + (size_t)row * INW + (c < 512 ? C_QA + c : C_QB + (c - 512));
    *p = (bf16_t)f2bf(bf2f(*p) * QSCALE);
}
__device__ __forceinline__ float lambda_full(const Ptrs& P) {
    float a = 0.f, b = 0.f;
    for (int i = 0; i < 64; ++i) { a += P.lq1[i] * P.lk1[i]; b += P.lq2[i] * P.lk2[i]; }
    return __expf(a) - __expf(b) + 0.2f;
}
__global__ void __launch_bounds__(256) k_attn_a_naive(Ptrs P) {
    const bf16_t* proj = (const bf16_t*)(P.ws + WS_PROJ);
    const int gt = blockIdx.x * 256 + threadIdx.x;
    const int ch = gt & 3, q = (gt >> 2) & 2047, h = (gt >> 13) & 3, b = gt >> 15;
    const float lam = lambda_full(P);
    const size_t qrow = (size_t)b * SEQ + q;
    float y[32];
#pragma unroll
    for (int j = 0; j < 32; ++j) y[j] = 0.f;
    for (int m = 0; m < 2; ++m) {
        float qv[64];
        const bf16_t* qp = proj + qrow * INW + C_QA + h * 128 + m * 64;
#pragma unroll
        for (int d = 0; d < 64; ++d) qv[d] = bf2f(qp[d]);
        float mx = -1e30f, l = 0.f, acc[32];
#pragma unroll
        for (int j = 0; j < 32; ++j) acc[j] = 0.f;
        for (int k = 0; k < SEQ; ++k) {
            const size_t krow = (size_t)b * SEQ + k;
            const bf16_t* kp = proj + krow * INW + C_KA + h * 128 + m * 64;
            float s = 0.f;
#pragma unroll
            for (int d8 = 0; d8 < 8; ++d8) { const u32x4 kv = *(const u32x4*)(kp + d8 * 8);
                s += qv[d8 * 8 + 0] * bflo(kv.x); s += qv[d8 * 8 + 1] * bfhi(kv.x); s += qv[d8 * 8 + 2] * bflo(kv.y); s += qv[d8 * 8 + 3] * bfhi(kv.y);
                s += qv[d8 * 8 + 4] * bflo(kv.z); s += qv[d8 * 8 + 5] * bfhi(kv.z); s += qv[d8 * 8 + 6] * bflo(kv.w); s += qv[d8 * 8 + 7] * bfhi(kv.w); }
            if (s > mx) { const float f = exp2f(mx - s); l *= f;
#pragma unroll
                for (int j = 0; j < 32; ++j) acc[j] *= f;
                mx = s; }
            const float p = exp2f(s - mx); l += p;
            const bf16_t* vp = proj + krow * INW + C_VA + h * 128 + ch * 32;
#pragma unroll
            for (int d8 = 0; d8 < 4; ++d8) { const u32x4 vv = *(const u32x4*)(vp + d8 * 8);
                acc[d8 * 8 + 0] += p * bflo(vv.x); acc[d8 * 8 + 1] += p * bfhi(vv.x); acc[d8 * 8 + 2] += p * bflo(vv.y); acc[d8 * 8 + 3] += p * bfhi(vv.y);
                acc[d8 * 8 + 4] += p * bflo(vv.z); acc[d8 * 8 + 5] += p * bfhi(vv.z); acc[d8 * 8 + 6] += p * bflo(vv.w); acc[d8 * 8 + 7] += p * bfhi(vv.w); }
        }
        const float il = 1.f / l, sg = (m == 0) ? 1.f : -lam;
#pragma unroll
        for (int j = 0; j < 32; ++j) y[j] += sg * acc[j] * il;
    }
    float ss = 0.f;
#pragma unroll
    for (int j = 0; j < 32; ++j) ss += y[j] * y[j];
    ss += __shfl_xor(ss, 1); ss += __shfl_xor(ss, 2);
    const float rstd = 1.f / sqrtf(ss * (1.f / 128.f) + EPS) * 0.8f;
    bf16_t* yo = (bf16_t*)(P.ws + WS_YA) + qrow * 512 + h * 128 + ch * 32;
#pragma unroll
    for (int j = 0; j < 32; ++j) yo[j] = (bf16_t)f2bf(y[j] * rstd * P.subln[ch * 32 + j]);
}
__global__ void __launch_bounds__(256) k_attn_b_naive(Ptrs P) {
    const bf16_t* proj = (const bf16_t*)(P.ws + WS_PROJ);
    const int gt = blockIdx.x * 256 + threadIdx.x;
    const int c = gt & 63, r = (gt >> 6) & 31, h = (gt >> 11) & 7, b = gt >> 14;
    const size_t qrow = (size_t)b * SEQ + r * 64 + c;
    float qv[64];
    const bf16_t* qp = proj + qrow * INW + C_QB + h * 64;
#pragma unroll
    for (int d = 0; d < 64; ++d) qv[d] = bf2f(qp[d]);
    int rs = r - 4; rs = rs < 0 ? 0 : (rs > 24 ? 24 : rs);
    int cs = c - 8; cs = cs < 0 ? 0 : (cs > 48 ? 48 : cs);
    float mx = -1e30f, l = 0.f, acc[64];
#pragma unroll
    for (int j = 0; j < 64; ++j) acc[j] = 0.f;
    for (int i = 0; i < 8; ++i)
        for (int j = 0; j < 16; ++j) {
            const size_t krow = (size_t)b * SEQ + (rs + i) * 64 + (cs + j);
            const bf16_t* kp = proj + krow * INW + C_KB + h * 64;
            float s = 0.f;
#pragma unroll
            for (int d8 = 0; d8 < 8; ++d8) { const u32x4 kv = *(const u32x4*)(kp + d8 * 8);
                s += qv[d8 * 8 + 0] * bflo(kv.x); s += qv[d8 * 8 + 1] * bfhi(kv.x); s += qv[d8 * 8 + 2] * bflo(kv.y); s += qv[d8 * 8 + 3] * bfhi(kv.y);
                s += qv[d8 * 8 + 4] * bflo(kv.z); s += qv[d8 * 8 + 5] * bfhi(kv.z); s += qv[d8 * 8 + 6] * bflo(kv.w); s += qv[d8 * 8 + 7] * bfhi(kv.w); }
            s += LOG2E * P.rpb[(h * 15 + (rs + i - r + 7)) * 31 + (cs + j - c + 15)];
            if (s > mx) { const float f = exp2f(mx - s); l *= f;
#pragma unroll
                for (int jj = 0; jj < 64; ++jj) acc[jj] *= f;
                mx = s; }
            const float p = exp2f(s - mx); l += p;
            const bf16_t* vp = proj + krow * INW + C_VB + h * 64;
#pragma unroll
            for (int d8 = 0; d8 < 8; ++d8) { const u32x4 vv = *(const u32x4*)(vp + d8 * 8);
                acc[d8 * 8 + 0] += p * bflo(vv.x); acc[d8 * 8 + 1] += p * bfhi(vv.x); acc[d8 * 8 + 2] += p * bflo(vv.y); acc[d8 * 8 + 3] += p * bfhi(vv.y);
                acc[d8 * 8 + 4] += p * bflo(vv.z); acc[d8 * 8 + 5] += p * bfhi(vv.z); acc[d8 * 8 + 6] += p * bflo(vv.w); acc[d8 * 8 + 7] += p * bfhi(vv.w); }
        }
    const float il = 1.f / l;
    bf16_t* yo = (bf16_t*)(P.ws + WS_YB) + qrow * 512 + h * 64;
#pragma unroll
    for (int j = 0; j < 64; ++j) yo[j] = (bf16_t)f2bf(acc[j] * il);
}
__global__ void __launch_bounds__(256) k_ssq_naive(Ptrs P) {
    const int gt = blockIdx.x * 256 + threadIdx.x;
    const int t = gt & 3, row = gt >> 2;
    const float* h = P.out + (size_t)row * D + t * 256; float s = 0.f;
    for (int i = 0; i < 256; ++i) s += h[i] * h[i];
    ((float*)(P.ws + WS_SSQ))[gt] = s;
}
__global__ void __launch_bounds__(64) k_topk1_naive(Ptrs P) {
    __shared__ float sc[128][64];
    const int tid = threadIdx.x, gt = blockIdx.x * 64 + tid;
    const int t = gt & (M - 1), hp = gt >> 14;
    const bf16_t* qp = (const bf16_t*)(P.ws + WS_Q) + (size_t)t * PQ + hp * 128;
    const bf16_t* sk = (const bf16_t*)(P.ws + WS_SK) + (size_t)hp * 128 * 128;
    float qv[128];
#pragma unroll
    for (int d = 0; d < 128; ++d) qv[d] = bf2f(qp[d]);
    for (int k = 0; k < 128; ++k) {
        float s = 0.f;
#pragma unroll
        for (int d8 = 0; d8 < 16; ++d8) { const u32x4 kv = *(const u32x4*)(sk + k * 128 + d8 * 8);
            s += qv[d8 * 8 + 0] * bflo(kv.x); s += qv[d8 * 8 + 1] * bfhi(kv.x); s += qv[d8 * 8 + 2] * bflo(kv.y); s += qv[d8 * 8 + 3] * bfhi(kv.y);
            s += qv[d8 * 8 + 4] * bflo(kv.z); s += qv[d8 * 8 + 5] * bfhi(kv.z); s += qv[d8 * 8 + 6] * bflo(kv.w); s += qv[d8 * 8 + 7] * bfhi(kv.w); }
        sc[k][tid] = s;
    }
    float pv = 3e38f; int pk = -1;
    float* tv = (float*)(P.ws + WS_TOPV) + ((size_t)t * 16 + hp) * 16; int* ti = (int*)(P.ws + WS_TOPI) + ((size_t)t * 16 + hp) * 16;
    for (int j = 0; j < 16; ++j) {
        float bv = -3e38f; int bk = -1;
        for (int k = 0; k < 128; ++k) { const float v = sc[k][tid]; const bool below = (v < pv) || (v == pv && k > pk); if (below && v > bv) { bv = v; bk = k; } }
        tv[j] = bv; ti[j] = bk; pv = bv; pk = bk;
    }
}
__global__ void __launch_bounds__(256) k_topk2_naive(Ptrs P) {
    const int gt = blockIdx.x * 256 + threadIdx.x;
    const float* tv = (const float*)(P.ws + WS_TOPV) + (size_t)gt * 32; const int* ti = (const int*)(P.ws + WS_TOPI) + (size_t)gt * 32;
    float v0[16], v1[16]; int i0[16], i1[16];
#pragma unroll
    for (int j = 0; j < 16; ++j) { v0[j] = tv[j]; v1[j] = tv[16 + j]; i0[j] = ti[j]; i1[j] = ti[16 + j]; }
    float* go = (float*)(P.ws + WS_G) + (size_t)gt * 16; int* io = (int*)(P.ws + WS_IDX) + (size_t)gt * 16;
    float pv = 3e38f; int pk = -1; float s0 = 0.f, esum = 0.f;
    for (int j = 0; j < 16; ++j) {
        float bv = -3e38f; int bk = -1, bidx = 0;
        int iz; asm volatile("v_mov_b32 %0, 0" : "=v"(iz));
#pragma unroll
        for (int a = 0; a < 16; ++a)
#pragma unroll
            for (int b = 0; b < 16; ++b) { const float v = v0[a] + __int_as_float(__float_as_int(v1[b]) | iz); const int k = a * 16 + b; const bool below = (v < pv) || (v == pv && k > pk);
                if (below && v > bv) { bv = v; bk = k; bidx = (i0[a] | iz) * 128 + i1[b]; } }
        if (j == 0) s0 = bv;
        const float e = __expf(bv - s0); esum += e;
        go[j] = e; io[j] = bidx; pv = bv; pk = bk;
    }
    const float inv = 1.f / esum;
#pragma unroll
    for (int j = 0; j < 16; ++j) go[j] *= inv;
}
__global__ void __launch_bounds__(256) k_peer_apply(Ptrs P) {
    const int lane = threadIdx.x & 63, sub = lane & 15, g = lane >> 4;
    const int t = blockIdx.x * 4 + (threadIdx.x >> 6);
    const float* hrow = P.out + (size_t)t * D;
    const float* ssq = (const float*)(P.ws + WS_SSQ) + (size_t)t * 4;
    const float rstd = 1.f / sqrtf(((ssq[0] + ssq[1]) + (ssq[2] + ssq[3])) * (1.f / D) + EPS);
    unsigned xh[8][4]; float hv[8][8];
#pragma unroll
    for (int i = 0; i < 8; ++i) { const int e0 = (sub + 16 * i) * 8;
        const f32x4 a = *(const f32x4*)(hrow + e0), b = *(const f32x4*)(hrow + e0 + 4);
        const f32x4 ga = *(const f32x4*)(P.norm_ffn + e0), gb = *(const f32x4*)(P.norm_ffn + e0 + 4);
        hv[i][0] = a.x; hv[i][1] = a.y; hv[i][2] = a.z; hv[i][3] = a.w; hv[i][4] = b.x; hv[i][5] = b.y; hv[i][6] = b.z; hv[i][7] = b.w;
        xh[i][0] = pk2(a.x * rstd * ga.x, a.y * rstd * ga.y); xh[i][1] = pk2(a.z * rstd * ga.z, a.w * rstd * ga.w);
        xh[i][2] = pk2(b.x * rstd * gb.x, b.y * rstd * gb.y); xh[i][3] = pk2(b.z * rstd * gb.z, b.w * rstd * gb.w); }
    const int* idxp = (const int*)(P.ws + WS_IDX) + (size_t)t * 128; const float* gp = (const float*)(P.ws + WS_G) + (size_t)t * 128;
    const int id0 = idxp[lane], id1 = idxp[64 + lane]; const float g0 = gp[lane], g1 = gp[64 + lane];
    const bf16_t* U = (const bf16_t*)(P.ws + WS_U); const bf16_t* V = (const bf16_t*)(P.ws + WS_V);
    float acc[8][8];
#pragma unroll
    for (int i = 0; i < 8; ++i)
#pragma unroll
        for (int e = 0; e < 8; ++e) acc[i][e] = 0.f;
    for (int j = 0; j < 32; ++j) {
        const int src = (4 * j + g) & 63;
        const int e = (j < 16) ? __shfl(id0, src) : __shfl(id1, src);
        const float gate = (j < 16) ? __shfl(g0, src) : __shfl(g1, src);
        const bf16_t* ur = U + (size_t)e * D; const bf16_t* vr = V + (size_t)e * D;
        u32x4 uu[8], vv[8];
#pragma unroll
        for (int i = 0; i < 8; ++i) { uu[i] = *(const u32x4*)(ur + (sub + 16 * i) * 8); vv[i] = *(const u32x4*)(vr + (sub + 16 * i) * 8); }
        float d = 0.f;
#pragma unroll
        for (int i = 0; i < 8; ++i) {
            d += bflo(uu[i].x) * bflo(xh[i][0]) + bfhi(uu[i].x) * bfhi(xh[i][0]); d += bflo(uu[i].y) * bflo(xh[i][1]) + bfhi(uu[i].y) * bfhi(xh[i][1]);
            d += bflo(uu[i].z) * bflo(xh[i][2]) + bfhi(uu[i].z) * bfhi(xh[i][2]); d += bflo(uu[i].w) * bflo(xh[i][3]) + bfhi(uu[i].w) * bfhi(xh[i][3]); }
        d += __shfl_xor(d, 1); d += __shfl_xor(d, 2); d += __shfl_xor(d, 4); d += __shfl_xor(d, 8);
        const float c = gate * gelu_exact(d);
#pragma unroll
        for (int i = 0; i < 8; ++i) {
            acc[i][0] += c * bflo(vv[i].x); acc[i][1] += c * bfhi(vv[i].x); acc[i][2] += c * bflo(vv[i].y); acc[i][3] += c * bfhi(vv[i].y);
            acc[i][4] += c * bflo(vv[i].z); acc[i][5] += c * bfhi(vv[i].z); acc[i][6] += c * bflo(vv[i].w); acc[i][7] += c * bfhi(vv[i].w); }
    }
    float ss = 0.f;
#pragma unroll
    for (int i = 0; i < 8; ++i)
#pragma unroll
        for (int e = 0; e < 8; ++e) { float a = acc[i][e]; a += __shfl_xor(a, 16); a += __shfl_xor(a, 32); a += hv[i][e]; acc[i][e] = a; ss += a * a; }
    ss += __shfl_xor(ss, 1); ss += __shfl_xor(ss, 2); ss += __shfl_xor(ss, 4); ss += __shfl_xor(ss, 8);
    const float r2 = 1.f / sqrtf(ss * (1.f / D) + EPS);
    float* orow = P.out + (size_t)t * D;
#pragma unroll
    for (int i = 0; i < 8; ++i) if ((i & 3) == g) { const int e0 = (sub + 16 * i) * 8;
        const f32x4 ga = *(const f32x4*)(P.norm_final + e0), gb = *(const f32x4*)(P.norm_final + e0 + 4);
        f32x4 o0, o1; o0.x = acc[i][0] * r2 * ga.x; o0.y = acc[i][1] * r2 * ga.y; o0.z = acc[i][2] * r2 * ga.z; o0.w = acc[i][3] * r2 * ga.w;
        o1.x = acc[i][4] * r2 * gb.x; o1.y = acc[i][5] * r2 * gb.y; o1.z = acc[i][6] * r2 * gb.z; o1.w = acc[i][7] * r2 * gb.w;
        *(f32x4*)(orow + e0) = o0; *(f32x4*)(orow + e0 + 4) = o1; }
}

extern "C" void kernel_launch(void* const* d_in, const int* in_sizes, int n_in, void* d_out, int out_size, void* d_ws, size_t ws_size, hipStream_t stream) {
    if (n_in != 18 || ws_size < WS_END) { fprintf(stderr, "kernel_launch: unexpected n_in %d / ws_size %zu\n", n_in, ws_size); return; }
    Ptrs P{};
    P.x = (const float*)d_in[0]; P.w_in = (const float*)d_in[1]; P.w_pa = (const float*)d_in[2]; P.w_pb = (const float*)d_in[3]; P.w_out = (const float*)d_in[4];
    P.norm_mix = (const float*)d_in[5]; P.norm_ffn = (const float*)d_in[6]; P.norm_final = (const float*)d_in[7];
    P.lq1 = (const float*)d_in[8]; P.lk1 = (const float*)d_in[9]; P.lq2 = (const float*)d_in[10]; P.lk2 = (const float*)d_in[11];
    P.subln = (const float*)d_in[12]; P.rpb = (const float*)d_in[13]; P.w_query = (const float*)d_in[14]; P.sub_keys = (const float*)d_in[15];
    P.peer_u = (const float*)d_in[16]; P.peer_v = (const float*)d_in[17];
    P.out = (float*)d_out; P.ws = (unsigned char*)d_ws;
    unsigned char* ws = P.ws;
    k_prep<<<1024, 256, 0, stream>>>(P);
    k_gemm_naive<EPI_PROJ><<<dim3(INW / 64, M / 4), 256, 0, stream>>>((const bf16_t*)(ws + WS_XN), (const bf16_t*)(ws + WS_WIN), INW, D, P);
    k_rope_naive<<<M * 16 * 8 / 256, 256, 0, stream>>>(P);
    k_scale_naive<<<M * 1024 / 256, 256, 0, stream>>>(P);
    k_attn_a_naive<<<BATCH * 4 * SEQ * 4 / 256, 256, 0, stream>>>(P);
    k_attn_b_naive<<<BATCH * 8 * SEQ / 256, 256, 0, stream>>>(P);
    k_gemm_naive<EPI_GATE_A><<<dim3(D / 64, M / 4), 256, 0, stream>>>((const bf16_t*)(ws + WS_YA), (const bf16_t*)(ws + WS_WPA), D, 512, P);
    k_gemm_naive<EPI_GATE_B><<<dim3(D / 64, M / 4), 256, 0, stream>>>((const bf16_t*)(ws + WS_YB), (const bf16_t*)(ws + WS_WPB), D, 512, P);
    k_gemm_naive<EPI_HOUT><<<dim3(D / 64, M / 4), 256, 0, stream>>>((const bf16_t*)(ws + WS_MERGED), (const bf16_t*)(ws + WS_WOUT), D, D, P);
    k_ssq_naive<<<M * 4 / 256, 256, 0, stream>>>(P);
    k_gemm_naive<EPI_Q><<<dim3(PQ / 64, M / 4), 256, 0, stream>>>((const bf16_t*)(ws + WS_HB), (const bf16_t*)(ws + WS_WQ), PQ, D, P);
    k_cvt_experts<<<2048, 256, 0, stream>>>(P);
    k_topk1_naive<<<M * 16 / 64, 64, 0, stream>>>(P);
    k_topk2_naive<<<M * 8 / 256, 256, 0, stream>>>(P);
    k_peer_apply<<<M / 4, 256, 0, stream>>>(P);
}
```

```cpp
#include <hip/hip_runtime.h>
#include <cstdio>
#include <cstdint>

typedef unsigned short bf16_t;
typedef unsigned u32x4 __attribute__((ext_vector_type(4)));
typedef unsigned u32x2 __attribute__((ext_vector_type(2)));
typedef float f32x4 __attribute__((ext_vector_type(4)));
typedef __bf16 bf16x2_t __attribute__((ext_vector_type(2)));

constexpr int D = 1024, BATCH = 8, SEQ = 2048, M = BATCH * SEQ, INW = 5120;
constexpr int C_QA = 0, C_KA = 512, C_VA = 1024, C_QB = 1536, C_KB = 2048, C_VB = 2560, C_GA = 3072, C_GB = 4096;
constexpr int NEXP = 16384, PQ = 2048;
constexpr float EPS = 1e-6f;
constexpr float LOG2E = 1.4426950408889634f;
constexpr float QSCALE = 0.125f * LOG2E;

constexpr size_t MiB = 1u << 20;
constexpr size_t WS_PROJ = 0;
constexpr size_t WS_HB = 0;
constexpr size_t WS_Q = 32 * MiB;
constexpr size_t WS_U = 96 * MiB;
constexpr size_t WS_V = 128 * MiB;
constexpr size_t WS_XN = 160 * MiB;
constexpr size_t WS_YA = 160 * MiB;
constexpr size_t WS_YB = 176 * MiB;
constexpr size_t WS_IDX = 160 * MiB;
constexpr size_t WS_G = 168 * MiB;
constexpr size_t WS_MERGED = 192 * MiB;
constexpr size_t WS_TOPV = 192 * MiB;
constexpr size_t WS_TOPI = 208 * MiB;
constexpr size_t WS_WIN = 224 * MiB;
constexpr size_t WS_WQ = 234 * MiB;
constexpr size_t WS_WOUT = 238 * MiB;
constexpr size_t WS_WPA = 240 * MiB;
constexpr size_t WS_WPB = 241 * MiB;
constexpr size_t WS_SK = 242 * MiB;
constexpr size_t WS_ROPE = 242 * MiB + 512 * 1024;
constexpr size_t WS_SSQ = 243 * MiB;
constexpr size_t WS_CTL = 244 * MiB;
constexpr size_t WS_END = 256 * MiB;

__device__ __forceinline__ float bf2f(unsigned v) { return __uint_as_float(v << 16); }
__device__ __forceinline__ float bflo(unsigned w) { return __uint_as_float(w << 16); }
__device__ __forceinline__ float bfhi(unsigned w) { return __uint_as_float(w & 0xffff0000u); }
__device__ __forceinline__ unsigned f2bf(float f) { unsigned u = __float_as_uint(f); return (u + 0x7fffu + ((u >> 16) & 1u)) >> 16; }
__device__ __forceinline__ unsigned pk2(float lo, float hi) { return f2bf(lo) | (f2bf(hi) << 16); }
__device__ __forceinline__ float wave_sum(float v) {
#pragma unroll
    for (int o = 1; o < 64; o <<= 1) v += __shfl_xor(v, o);
    return v;
}
__device__ __forceinline__ float sigmoidf_(float x) { return 1.f / (1.f + __expf(-x)); }
__device__ __forceinline__ float gelu_exact(float x) { return 0.5f * x * (1.f + erff(x * 0.70710678118654752f)); }

struct Ptrs {
    const float *x, *w_in, *w_pa, *w_pb, *w_out, *norm_mix, *norm_ffn, *norm_final, *lq1, *lk1, *lq2, *lk2, *subln, *rpb, *w_query, *sub_keys, *peer_u, *peer_v;
    float* out; unsigned char* ws;
};

__device__ __forceinline__ void transpose_item(const float* W, int K, int N, const float* gain, bf16_t* WT, float* scr, int item, int lane) {
    const int nblk = N / 32, kb = item / nblk, nb = item % nblk, k0 = 64 * kb, n0 = 32 * nb;
#pragma unroll 8
    for (int i = 0; i < 32; ++i) { const int kk = 2 * i + (lane >> 5); float w = W[(size_t)(k0 + kk) * N + n0 + (lane & 31)]; if (gain) w *= gain[k0 + kk]; scr[kk * 33 + (lane & 31)] = w; }
    asm volatile("s_waitcnt lgkmcnt(0)" ::: "memory");
    const int c = lane & 7;
#pragma unroll
    for (int j = 0; j < 4; ++j) { const int n = (lane >> 3) + 8 * j; const float* s = scr + (8 * c) * 33 + n;
        u32x4 o; o.x = pk2(s[0 * 33], s[1 * 33]); o.y = pk2(s[2 * 33], s[3 * 33]); o.z = pk2(s[4 * 33], s[5 * 33]); o.w = pk2(s[6 * 33], s[7 * 33]);
        *(u32x4*)(WT + (size_t)(n0 + n) * K + k0 + 8 * c) = o; }
    asm volatile("s_waitcnt lgkmcnt(0)" ::: "memory");
}
__device__ __forceinline__ void cvt8(const float* src, bf16_t* dst, size_t i8) {
    const f32x4 a = *(const f32x4*)(src + i8 * 8), b = *(const f32x4*)(src + i8 * 8 + 4);
    u32x4 o; o.x = pk2(a.x, a.y); o.y = pk2(a.z, a.w); o.z = pk2(b.x, b.y); o.w = pk2(b.z, b.w);
    *(u32x4*)(dst + i8 * 8) = o;
}
__device__ __forceinline__ void rms_row_to_bf16(const float* xrow, bf16_t* orow, int lane) {
    const f32x4* xr = (const f32x4*)xrow + lane;
    f32x4 v[4]; float s = 0.f;
#pragma unroll
    for (int j = 0; j < 4; ++j) { v[j] = xr[64 * j]; s += (v[j].x * v[j].x + v[j].y * v[j].y) + (v[j].z * v[j].z + v[j].w * v[j].w); }
    const float rstd = 1.f / sqrtf(wave_sum(s) * (1.f / D) + EPS);
    u32x2* o8 = (u32x2*)orow + lane;
#pragma unroll
    for (int j = 0; j < 4; ++j) { u32x2 w; w.x = pk2(v[j].x * rstd, v[j].y * rstd); w.y = pk2(v[j].z * rstd, v[j].w * rstd); o8[64 * j] = w; }
}

__global__ void __launch_bounds__(256) k_prep(Ptrs P) {
    __shared__ float scr_all[4][64 * 33];
    const int lane = threadIdx.x & 63, wave = threadIdx.x >> 6;
    const int gw = blockIdx.x * 4 + wave, NGW = gridDim.x * 4;
    float* scr = scr_all[wave];
    unsigned char* ws = P.ws;
    constexpr int I_IN = (D / 64) * (INW / 32), I_Q = (D / 64) * (PQ / 32), I_OUT = (D / 64) * (D / 32), I_PA = (512 / 64) * (D / 32);
    constexpr int NIT = I_IN + I_Q + I_OUT + 2 * I_PA;
    for (int it = gw; it < NIT; it += NGW) {
        int r = it;
        if (r < I_IN) { transpose_item(P.w_in, D, INW, P.norm_mix, (bf16_t*)(ws + WS_WIN), scr, r, lane); continue; } r -= I_IN;
        if (r < I_Q) { transpose_item(P.w_query, D, PQ, P.norm_ffn, (bf16_t*)(ws + WS_WQ), scr, r, lane); continue; } r -= I_Q;
        if (r < I_OUT) { transpose_item(P.w_out, D, D, nullptr, (bf16_t*)(ws + WS_WOUT), scr, r, lane); continue; } r -= I_OUT;
        if (r < I_PA) { transpose_item(P.w_pa, 512, D, nullptr, (bf16_t*)(ws + WS_WPA), scr, r, lane); continue; } r -= I_PA;
        transpose_item(P.w_pb, 512, D, nullptr, (bf16_t*)(ws + WS_WPB), scr, r, lane);
    }
    for (int m = gw; m < M; m += NGW) rms_row_to_bf16(P.x + (size_t)m * D, (bf16_t*)(ws + WS_XN) + (size_t)m * D, lane);
    const size_t gt = (size_t)blockIdx.x * 256 + threadIdx.x, NT = (size_t)gridDim.x * 256;
    for (size_t i = gt; i < (size_t)16 * 128 * 128 / 8; i += NT) cvt8(P.sub_keys, (bf16_t*)(ws + WS_SK), i);
    for (size_t i = gt; i < (size_t)SEQ * 8; i += NT) {
        const int pos = (int)(i >> 3), k = (int)(i & 7);
        const float inv = (float)pow(500000.0, -(double)k / 8.0);
        const float ang = (float)pos * inv;
        float* t = (float*)(ws + WS_ROPE) + (size_t)pos * 16;
        t[k] = (float)cos((double)ang); t[8 + k] = (float)sin((double)ang);
    }
}
__global__ void __launch_bounds__(256) k_cvt_experts(Ptrs P) {
    const size_t gt = (size_t)blockIdx.x * 256 + threadIdx.x, NT = (size_t)gridDim.x * 256;
    for (size_t i = gt; i < (size_t)NEXP * D / 8; i += NT) { cvt8(P.peer_u, (bf16_t*)(P.ws + WS_U), i); cvt8(P.peer_v, (bf16_t*)(P.ws + WS_V), i); }
}

namespace pg8 {
#define PG8_LAS __attribute__((address_space(3)))
typedef unsigned short bf16_t;
typedef short bf16x8 __attribute__((ext_vector_type(8)));
typedef float f32x4 __attribute__((ext_vector_type(4)));
typedef unsigned u32x4 __attribute__((ext_vector_type(4)));
constexpr int BM = 256, BK = 64, HALF = 128, HTB = HALF * BK * 2  , STAGE_BYTES = 8 * HTB, NXCD = 8, WGM = 8;

__host__ __device__ __forceinline__ int lds_byte(int r, int c) { const int st = (r >> 4) * 2 + (c >> 5), rr = r & 15, cc = c & 31, ob = rr * 64 + cc * 2; return st * 1024 + (ob ^ (((ob >> 9) & 1) << 5)); }
__host__ __device__ __forceinline__ void stage_rc(int b, int& R, int& C) { const int st = b / 1024, sb = b % 1024, swz = sb ^ (((sb >> 9) & 1) << 5); R = (st >> 1) * 16 + swz / 64; C = (st & 1) * 32 + (swz % 64) / 2; }
__host__ __device__ __forceinline__ int perm32(int rho) { const int n = rho >> 4, i = rho & 15; return 8 * (i >> 2) + 4 * n + (i & 3); }

struct Unit { int pm, pn; };
struct Gemm { const bf16_t* A; const bf16_t* Bt; int M, N, K, pad; };

struct StaticOrder {
    int nM, nN, nwg, G, c;
    __host__ __device__ void init(int M, int N, int G_, int c_) { nM = M / BM; nN = N / BM; nwg = nM * nN; G = G_; c = c_; }
    __host__ __device__ bool next(int i, Unit& u) const {
        const long L = (long)i * G + c; if (L >= nwg) return false;
        int wgid = (int)L; { const int q = nwg / NXCD, r = nwg % NXCD, xcd = wgid % NXCD, off = wgid / NXCD; wgid = (xcd < r ? xcd * (q + 1) : r * (q + 1) + (xcd - r) * q) + off; }
        const int nig = WGM * nN, gid = wgid / nig, fm = gid * WGM, gsz = (nM - fm) < WGM ? (nM - fm) : WGM;
        u.pm = fm + ((wgid % nig) % gsz); u.pn = (wgid % nig) / gsz; return true;
    }
    __device__ __forceinline__ void a_ready(const Unit&) const {}
    __device__ __forceinline__ void done(const Unit&) const {}
};
__device__ __forceinline__ unsigned cvt_pk_bf16(float lo, float hi) { unsigned r; asm volatile("v_cvt_pk_bf16_f32 %0, %1, %2" : "=v"(r) : "v"(lo), "v"(hi)); return r; }
typedef float f32x2 __attribute__((ext_vector_type(2)));

__device__ __forceinline__ float sigm(float x) { return __builtin_amdgcn_rcpf(1.f + __builtin_amdgcn_exp2f(-1.4426950408889634f * x)); }
struct EpiProj {
    static constexpr bool PERM = true, AFTER_DRAIN = false;
    bf16_t* O; const float* rope;
    __device__ __forceinline__ void operator()(const f32x4 (&acc)[2][2][4][2], const Unit& u, int wr, int wc, int fr, int fq) const {
        const int row0 = u.pm * BM + wr * 64 + fr, col0 = u.pn * BM + wc * 32 + 8 * fq;
        const float sc = (u.pn < 2 || u.pn == 6 || u.pn == 7) ? QSCALE : 1.f;
        const bool dorope = (u.pn < 4) && ((wc & 1) == 0);
#pragma unroll
        for (int ai = 0; ai < 2; ++ai)
#pragma unroll
            for (int m = 0; m < 4; ++m) { const int row = row0 + ai * HALF + m * 16; bf16_t* rowp = O + (size_t)row * INW + col0;
                f32x4 c4[2] = {{1.f, 1.f, 1.f, 1.f}, {1.f, 1.f, 1.f, 1.f}}, s4[2] = {{0.f, 0.f, 0.f, 0.f}, {0.f, 0.f, 0.f, 0.f}};
                if (dorope) { const float* rp = rope + (size_t)(row & (SEQ - 1)) * 16; c4[0] = *(const f32x4*)(rp); c4[1] = *(const f32x4*)(rp + 4); s4[0] = *(const f32x4*)(rp + 8); s4[1] = *(const f32x4*)(rp + 12); }
#pragma unroll
                for (int bj = 0; bj < 2; ++bj) { f32x4 v0 = acc[ai][bj][m][0], v1 = acc[ai][bj][m][1];
                    if (dorope) { f32x4 o0, o1;
#pragma unroll
                        for (int j = 0; j < 4; ++j) { o0[j] = __shfl_xor(v0[j], 16); o1[j] = __shfl_xor(v1[j], 16); }
                        if (fq == 0) { v0 = v0 * c4[0] - o0 * s4[0]; v1 = v1 * c4[1] - o1 * s4[1]; }
                        else if (fq == 1) { v0 = v0 * c4[0] + o0 * s4[0]; v1 = v1 * c4[1] + o1 * s4[1]; } }
                    v0 = v0 * sc; v1 = v1 * sc; u32x4 w; w.x = cvt_pk_bf16(v0[0], v0[1]); w.y = cvt_pk_bf16(v0[2], v0[3]); w.z = cvt_pk_bf16(v1[0], v1[1]); w.w = cvt_pk_bf16(v1[2], v1[3]);
                    *(u32x4*)(rowp + bj * HALF) = w; } }
    }
};
struct EpiGateA {
    static constexpr bool PERM = true, AFTER_DRAIN = false;
    const bf16_t* proj; float* T;
    __device__ __forceinline__ void operator()(const f32x4 (&acc)[2][2][4][2], const Unit& u, int wr, int wc, int fr, int fq) const {
        const int row0 = u.pm * BM + wr * 64 + fr, col0 = u.pn * BM + wc * 32 + 8 * fq;
#pragma unroll
        for (int ai = 0; ai < 2; ++ai)
#pragma unroll
            for (int m = 0; m < 4; ++m) { const int row = row0 + ai * HALF + m * 16;
#pragma unroll
                for (int bj = 0; bj < 2; ++bj) { const int col = col0 + bj * HALF; const u32x4 g = *(const u32x4*)(proj + (size_t)row * INW + C_GA + col);
                    f32x4 v0 = acc[ai][bj][m][0], v1 = acc[ai][bj][m][1];
                    v0[0] *= sigm(bflo(g.x)); v0[1] *= sigm(bfhi(g.x)); v0[2] *= sigm(bflo(g.y)); v0[3] *= sigm(bfhi(g.y));
                    v1[0] *= sigm(bflo(g.z)); v1[1] *= sigm(bfhi(g.z)); v1[2] *= sigm(bflo(g.w)); v1[3] *= sigm(bfhi(g.w));
                    float* tp = T + (size_t)row * D + col; *(f32x4*)tp = v0; *(f32x4*)(tp + 4) = v1; } }
    }
};
struct EpiGateB {
    static constexpr bool PERM = true, AFTER_DRAIN = false;
    const bf16_t* proj; const float* T; bf16_t* O;
    __device__ __forceinline__ void operator()(const f32x4 (&acc)[2][2][4][2], const Unit& u, int wr, int wc, int fr, int fq) const {
        const int row0 = u.pm * BM + wr * 64 + fr, col0 = u.pn * BM + wc * 32 + 8 * fq;
#pragma unroll
        for (int ai = 0; ai < 2; ++ai)
#pragma unroll
            for (int m = 0; m < 4; ++m) { const int row = row0 + ai * HALF + m * 16;
#pragma unroll
                for (int bj = 0; bj < 2; ++bj) { const int col = col0 + bj * HALF; const u32x4 g = *(const u32x4*)(proj + (size_t)row * INW + C_GB + col);
                    const float* tp = T + (size_t)row * D + col; const f32x4 t0 = *(const f32x4*)tp, t1 = *(const f32x4*)(tp + 4);
                    f32x4 v0 = acc[ai][bj][m][0], v1 = acc[ai][bj][m][1];
                    v0[0] = t0[0] + v0[0] * sigm(bflo(g.x)); v0[1] = t0[1] + v0[1] * sigm(bfhi(g.x)); v0[2] = t0[2] + v0[2] * sigm(bflo(g.y)); v0[3] = t0[3] + v0[3] * sigm(bfhi(g.y));
                    v1[0] = t1[0] + v1[0] * sigm(bflo(g.z)); v1[1] = t1[1] + v1[1] * sigm(bfhi(g.z)); v1[2] = t1[2] + v1[2] * sigm(bflo(g.w)); v1[3] = t1[3] + v1[3] * sigm(bfhi(g.w));
                    u32x4 w; w.x = cvt_pk_bf16(v0[0], v0[1]); w.y = cvt_pk_bf16(v0[2], v0[3]); w.z = cvt_pk_bf16(v1[0], v1[1]); w.w = cvt_pk_bf16(v1[2], v1[3]);
                    *(u32x4*)(O + (size_t)row * D + col) = w; } }
    }
};
struct EpiHout {
    static constexpr bool PERM = true, AFTER_DRAIN = false;
    const float* x; float* H; bf16_t* HB; float* ssq16;
    __device__ __forceinline__ void operator()(const f32x4 (&acc)[2][2][4][2], const Unit& u, int wr, int wc, int fr, int fq) const {
        const int row0 = u.pm * BM + wr * 64 + fr, col0 = u.pn * BM + wc * 32 + 8 * fq;
#pragma unroll
        for (int ai = 0; ai < 2; ++ai)
#pragma unroll
            for (int m = 0; m < 4; ++m) { const int row = row0 + ai * HALF + m * 16; float ss = 0.f;
#pragma unroll
                for (int bj = 0; bj < 2; ++bj) { const int col = col0 + bj * HALF; const float* xp = x + (size_t)row * D + col;
                    const f32x4 v0 = acc[ai][bj][m][0] + *(const f32x4*)xp, v1 = acc[ai][bj][m][1] + *(const f32x4*)(xp + 4);
                    float* hp = H + (size_t)row * D + col; *(f32x4*)hp = v0; *(f32x4*)(hp + 4) = v1;
                    u32x4 w; w.x = cvt_pk_bf16(v0[0], v0[1]); w.y = cvt_pk_bf16(v0[2], v0[3]); w.z = cvt_pk_bf16(v1[0], v1[1]); w.w = cvt_pk_bf16(v1[2], v1[3]);
                    *(u32x4*)(HB + (size_t)row * D + col) = w;
                    ss += (v0[0] * v0[0] + v0[1] * v0[1]) + (v0[2] * v0[2] + v0[3] * v0[3]) + (v1[0] * v1[0] + v1[1] * v1[1]) + (v1[2] * v1[2] + v1[3] * v1[3]); }
                ss += __shfl_xor(ss, 16); ss += __shfl_xor(ss, 32);
                if (fq == 0) ssq16[(size_t)row * 16 + u.pn * 4 + wc] = ss; }
    }
};
struct EpiQ {
    static constexpr bool PERM = true, AFTER_DRAIN = false;
    const float* ssq16; bf16_t* O;
    __device__ __forceinline__ void operator()(const f32x4 (&acc)[2][2][4][2], const Unit& u, int wr, int wc, int fr, int fq) const {
        const int row0 = u.pm * BM + wr * 64 + fr, col0 = u.pn * BM + wc * 32 + 8 * fq;
#pragma unroll
        for (int ai = 0; ai < 2; ++ai)
#pragma unroll
            for (int m = 0; m < 4; ++m) { const int row = row0 + ai * HALF + m * 16; const f32x4* sp = (const f32x4*)(ssq16 + (size_t)row * 16);
                const f32x4 a = sp[0], b = sp[1], c = sp[2], d = sp[3];
                const float tot = ((a[0] + a[1]) + (a[2] + a[3])) + ((b[0] + b[1]) + (b[2] + b[3])) + ((c[0] + c[1]) + (c[2] + c[3])) + ((d[0] + d[1]) + (d[2] + d[3]));
                const float rstd = 1.f / sqrtf(tot * (1.f / D) + EPS);
#pragma unroll
                for (int bj = 0; bj < 2; ++bj) { const f32x4 v0 = acc[ai][bj][m][0] * rstd, v1 = acc[ai][bj][m][1] * rstd;
                    u32x4 w; w.x = cvt_pk_bf16(v0[0], v0[1]); w.y = cvt_pk_bf16(v0[2], v0[3]); w.z = cvt_pk_bf16(v1[0], v1[1]); w.w = cvt_pk_bf16(v1[2], v1[3]);
                    *(u32x4*)(O + (size_t)row * PQ + col0 + bj * HALF) = w; } }
    }
};
template <class Epi, class Sched, bool ALIGN_EPI = false, bool SP2 = false>
__device__ __forceinline__ void gemm_phase(PG8_LAS unsigned char* lds, const Gemm g, const Sched& S, const Epi& E) {
    const int tid = threadIdx.x, wid = __builtin_amdgcn_readfirstlane(tid >> 6), lane = tid & 63, wr = wid >> 2, wc = wid & 3, fr = lane & 15, fq = lane >> 4;
    const int K = g.K, nt = K / BK;
    unsigned voffA[2], voffB[2];
#pragma unroll
    for (int i = 0; i < 2; ++i) { int R, C; stage_rc(tid * 16 + i * 8192, R, C); const int Rb = Epi::PERM ? ((R & ~31) + perm32(R & 31)) : R;
        voffA[i] = (unsigned)(R * K + C) * 2u; voffB[i] = (unsigned)(Rb * K + C) * 2u; }
    const size_t kstep = (size_t)(BK * 2);
    const size_t hstep = (size_t)HALF * K * 2;
    const size_t tstep = 2 * hstep;
    const unsigned ldsw = (unsigned)wid * 1024u;
    const int aoff = lds_byte(wr * 64 + fr, fq * 8), boff = lds_byte(wc * 32 + fr, fq * 8);
#define PG8_SA(b, h) (((b) * 2 + (h)) * HTB)
#define PG8_SB(b, h) ((4 + (b) * 2 + (h)) * HTB)
#define PG8_STAGE(bufoff, gbase, voff) do { _Pragma("unroll") for (int _i = 0; _i < 2; ++_i) \
        __builtin_amdgcn_global_load_lds((const unsigned*)((const char*)(gbase) + (voff)[_i]), (PG8_LAS unsigned*)(lds + (bufoff) + ldsw + _i * 8192), 16, 0, 0); } while (0)
#define PG8_LDA(dst, b, h) do { _Pragma("unroll") for (int m = 0; m < 4; ++m) _Pragma("unroll") for (int k = 0; k < 2; ++k) dst[m][k] = *(const PG8_LAS bf16x8*)(lds + PG8_SA(b, h) + aoff + m * 2048 + k * 1024); } while (0)
#define PG8_LDB(dst, b, h) do { _Pragma("unroll") for (int n = 0; n < 2; ++n) _Pragma("unroll") for (int k = 0; k < 2; ++k) dst[n][k] = *(const PG8_LAS bf16x8*)(lds + PG8_SB(b, h) + boff + n * 2048 + k * 1024); } while (0)
#define PG8_MMA(ai, bj, At, Bt) do { __builtin_amdgcn_s_setprio(1); _Pragma("unroll") for (int m = 0; m < 4; ++m) _Pragma("unroll") for (int n = 0; n < 2; ++n) _Pragma("unroll") for (int k = 0; k < 2; ++k) \
        acc[ai][bj][m][n] = __builtin_amdgcn_mfma_f32_16x16x32_bf16(Bt[n][k], At[m][k], acc[ai][bj][m][n], 0, 0, 0); __builtin_amdgcn_s_setprio(0); } while (0)
#define PG8_WAIT_V(n) asm volatile("s_waitcnt vmcnt(" #n ")" ::: "memory")
#define PG8_WAIT_L(n) asm volatile("s_waitcnt lgkmcnt(" #n ")" ::: "memory")
#define PG8_BAR __builtin_amdgcn_s_barrier()
#define PG8_SCHED __builtin_amdgcn_sched_barrier(0)
    Unit cur, nxt; int ui = 0;
    if (!S.next(0, cur)) return;
    f32x4 acc[2][2][4][2];
#pragma unroll
    for (int a = 0; a < 2; ++a)
#pragma unroll
        for (int b = 0; b < 2; ++b)
#pragma unroll
            for (int m = 0; m < 4; ++m)
#pragma unroll
                for (int n = 0; n < 2; ++n) acc[a][b][m][n] = (f32x4){0.f, 0.f, 0.f, 0.f};
    bf16x8 At[4][2], B0[2][2], B1[2][2];
    const char* cA = (const char*)g.A + (size_t)cur.pm * tstep; const char* cB = (const char*)g.Bt + (size_t)cur.pn * tstep;
    S.a_ready(cur);
    if constexpr (SP2) {
        PG8_STAGE(PG8_SB(0, 0), cB, voffB); PG8_STAGE(PG8_SB(0, 1), cB + hstep, voffB); PG8_STAGE(PG8_SA(0, 0), cA, voffA); PG8_STAGE(PG8_SA(0, 1), cA + hstep, voffA);
        if (wr == 1) PG8_BAR;
        PG8_WAIT_V(2); PG8_BAR;
        PG8_STAGE(PG8_SB(1, 0), cB + kstep, voffB); PG8_STAGE(PG8_SA(1, 0), cA + kstep, voffA); PG8_STAGE(PG8_SB(1, 1), cB + hstep + kstep, voffB);
        PG8_WAIT_V(6); PG8_BAR;
    } else {
        PG8_STAGE(PG8_SB(0, 0), cB, voffB); PG8_STAGE(PG8_SA(0, 0), cA, voffA); PG8_STAGE(PG8_SB(0, 1), cB + hstep, voffB); PG8_STAGE(PG8_SA(0, 1), cA + hstep, voffA);
        if (wr == 1) PG8_BAR;
        PG8_WAIT_V(4); PG8_BAR;
        PG8_STAGE(PG8_SB(1, 0), cB + kstep, voffB); PG8_STAGE(PG8_SA(1, 0), cA + kstep, voffA); PG8_STAGE(PG8_SB(1, 1), cB + hstep + kstep, voffB);
        PG8_WAIT_V(6); PG8_BAR;
    }
    for (;;) {
        const bool has_next = S.next(ui + 1, nxt);
        const char* nA = has_next ? (const char*)g.A + (size_t)nxt.pm * tstep : cA; const char* nB = has_next ? (const char*)g.Bt + (size_t)nxt.pn * tstep : cB;
        for (int t = 0; t < nt; t += 2) {
            const bool last = (t == nt - 2);
            const char* a1 = cA + (size_t)(t + 1) * kstep;
            const char* a2 = last ? nA : cA + (size_t)(t + 2) * kstep; const char* b2 = last ? nB : cB + (size_t)(t + 2) * kstep;
            const char* a3 = a2 + kstep; const char* b3 = b2 + kstep;
            if (last && has_next) S.a_ready(nxt);
            if constexpr (SP2) {
            PG8_LDB(B0, 0, 0); PG8_LDB(B1, 0, 1); PG8_SCHED; PG8_LDA(At, 0, 0); PG8_STAGE(PG8_SA(1, 1), a1 + hstep, voffA);
            PG8_WAIT_V(8); PG8_WAIT_L(0); PG8_BAR; PG8_MMA(0, 0, At, B0); PG8_MMA(0, 1, At, B1); PG8_BAR; PG8_SCHED;
            PG8_LDA(At, 0, 1); PG8_STAGE(PG8_SB(0, 0), b2, voffB); PG8_STAGE(PG8_SB(0, 1), b2 + hstep, voffB); PG8_STAGE(PG8_SA(0, 0), a2, voffA);
            PG8_WAIT_V(8); PG8_WAIT_L(0); PG8_BAR; PG8_MMA(1, 0, At, B0); PG8_MMA(1, 1, At, B1); PG8_BAR; PG8_SCHED;
            PG8_LDB(B0, 1, 0); PG8_LDB(B1, 1, 1); PG8_SCHED; PG8_LDA(At, 1, 0); PG8_STAGE(PG8_SA(0, 1), a2 + hstep, voffA);
            PG8_WAIT_V(8); PG8_WAIT_L(0); PG8_BAR; PG8_MMA(0, 0, At, B0); PG8_MMA(0, 1, At, B1); PG8_BAR; PG8_SCHED;
            PG8_LDA(At, 1, 1); PG8_STAGE(PG8_SB(1, 0), b3, voffB); PG8_STAGE(PG8_SB(1, 1), b3 + hstep, voffB); PG8_STAGE(PG8_SA(1, 0), a3, voffA);
            PG8_WAIT_V(8); PG8_WAIT_L(0); PG8_BAR; PG8_MMA(1, 0, At, B0); PG8_MMA(1, 1, At, B1); PG8_BAR; PG8_SCHED;
            } else {
            PG8_LDB(B0, 0, 0); PG8_SCHED; PG8_LDA(At, 0, 0); PG8_STAGE(PG8_SA(1, 1), a1 + hstep, voffA);
            PG8_WAIT_L(8); PG8_BAR; PG8_WAIT_L(0); PG8_MMA(0, 0, At, B0); PG8_BAR; PG8_SCHED;
            PG8_LDB(B1, 0, 1); PG8_STAGE(PG8_SB(0, 0), b2, voffB);
            PG8_BAR; PG8_WAIT_L(0); PG8_MMA(0, 1, At, B1); PG8_BAR;
            PG8_LDA(At, 0, 1); PG8_STAGE(PG8_SA(0, 0), a2, voffA);
            PG8_BAR; PG8_WAIT_L(0); PG8_MMA(1, 0, At, B0); PG8_BAR; PG8_SCHED;
            PG8_STAGE(PG8_SB(0, 1), b2 + hstep, voffB);
            PG8_WAIT_V(6); PG8_BAR; PG8_MMA(1, 1, At, B1); PG8_BAR;
            PG8_LDB(B0, 1, 0); PG8_SCHED; PG8_LDA(At, 1, 0); PG8_STAGE(PG8_SA(0, 1), a2 + hstep, voffA);
            PG8_WAIT_L(8); PG8_BAR; PG8_WAIT_L(0); PG8_MMA(0, 0, At, B0); PG8_BAR; PG8_SCHED;
            PG8_LDB(B1, 1, 1); PG8_STAGE(PG8_SB(1, 0), b3, voffB);
            PG8_BAR; PG8_WAIT_L(0); PG8_MMA(0, 1, At, B1); PG8_BAR;
            PG8_LDA(At, 1, 1); PG8_STAGE(PG8_SA(1, 0), a3, voffA);
            PG8_BAR; PG8_WAIT_L(0); PG8_MMA(1, 0, At, B0); PG8_BAR; PG8_SCHED;
            PG8_STAGE(PG8_SB(1, 1), b3 + hstep, voffB);
            PG8_WAIT_V(6); PG8_BAR; PG8_MMA(1, 1, At, B1); PG8_BAR;
            }
        }
        if constexpr (ALIGN_EPI) { if (wr == 0) PG8_BAR; }
        if constexpr (!Epi::AFTER_DRAIN) { E(acc, cur, wr, wc, fr, fq); S.done(cur); }
        if (!has_next) break;
#pragma unroll
        for (int a = 0; a < 2; ++a)
#pragma unroll
            for (int b = 0; b < 2; ++b)
#pragma unroll
                for (int m = 0; m < 4; ++m)
#pragma unroll
                    for (int n = 0; n < 2; ++n) acc[a][b][m][n] = (f32x4){0.f, 0.f, 0.f, 0.f};
        cur = nxt; cA = nA; cB = nB; ++ui;
        if constexpr (ALIGN_EPI) { if (wr == 1) PG8_BAR; }
    }
    PG8_WAIT_V(0);
    if constexpr (!ALIGN_EPI) { if (wr == 0) PG8_BAR; }
    PG8_BAR;
    if constexpr (Epi::AFTER_DRAIN) { E.fused(acc, cur, wr, wc, fr, fq, lds, wid, lane); S.done(cur); }
#undef PG8_SA
#undef PG8_SB
#undef PG8_STAGE
#undef PG8_LDA
#undef PG8_LDB
#undef PG8_MMA
#undef PG8_WAIT_V
#undef PG8_WAIT_L
#undef PG8_BAR
#undef PG8_SCHED
}
}

template <class Epi> __global__ void __launch_bounds__(512, 2) k_gemm(pg8::Gemm g, Epi E) {
    extern __shared__ __attribute__((aligned(16))) unsigned char lds_dyn[];
    pg8::StaticOrder S; S.init(g.M, g.N, (int)gridDim.x, (int)blockIdx.x);
    pg8::gemm_phase<Epi, pg8::StaticOrder, true, true>((PG8_LAS unsigned char*)lds_dyn, g, S, E);
}

__device__ __forceinline__ float lambda_full(const Ptrs& P) {
    float a = 0.f, b = 0.f;
    for (int i = 0; i < 64; ++i) { a += P.lq1[i] * P.lk1[i]; b += P.lq2[i] * P.lk2[i]; }
    return __expf(a) - __expf(b) + 0.2f;
}

namespace att {
typedef short bf16x8 __attribute__((ext_vector_type(8)));
typedef short s16x4 __attribute__((ext_vector_type(4)));
typedef float f32x16 __attribute__((ext_vector_type(16)));
typedef float f32x2_t __attribute__((ext_vector_type(2)));
typedef __attribute__((address_space(3))) const char* lds_cptr;
typedef __attribute__((address_space(3))) char* lds_ptr;
__device__ __forceinline__ int crow(int r, int hi) { return (r & 3) + 8 * (r >> 2) + 4 * hi; }
__device__ __forceinline__ void glds16(const void* gsrc, unsigned lds_dst) { unsigned keep;
    asm volatile("s_mov_b32 %0, m0\n\ts_mov_b32 m0, %2\n\ts_nop 0\n\tglobal_load_lds_dwordx4 %1, off\n\ts_mov_b32 m0, %0" : "=&s"(keep) : "v"(gsrc), "s"(lds_dst) : "memory"); }
__device__ __forceinline__ unsigned cvtpk(float lo, float hi) { f32x2_t v = {lo, hi}; bf16x2_t b = __builtin_convertvector(v, bf16x2_t); return __builtin_bit_cast(unsigned, b); }
#define ATT_WAIT_BAR(N) asm volatile("s_waitcnt vmcnt(" #N ") lgkmcnt(0)\n\ts_barrier" ::: "memory")
#define ATT_LDSWAIT() asm volatile("s_waitcnt lgkmcnt(0)" ::: "memory")
#define ATT_SBAR() __builtin_amdgcn_sched_barrier(0)
__device__ __forceinline__ void qkt(f32x16& p0, f32x16& p1, lds_cptr Kslot, const bf16x8* qr, int r32, int hi) {
    lds_cptr kb = Kslot + hi * 1024 + r32 * 16;
    p0 = f32x16{}; p1 = f32x16{};
#pragma unroll
    for (int d0 = 0; d0 < 4; ++d0) {
        const bf16x8 b0 = *(const __attribute__((address_space(3))) bf16x8*)(kb + d0 * 2048);
        const bf16x8 b1 = *(const __attribute__((address_space(3))) bf16x8*)(kb + d0 * 2048 + 512);
        p0 = __builtin_amdgcn_mfma_f32_32x32x16_bf16(b0, qr[d0], p0, 0, 0, 0); p1 = __builtin_amdgcn_mfma_f32_32x32x16_bf16(b1, qr[d0], p1, 0, 0, 0); }
}
__device__ __forceinline__ float rowmax32(const f32x16& p0, const f32x16& p1) {
    float a = fmaxf(p0[0], p1[0]);
#pragma unroll
    for (int r = 1; r < 16; ++r) a = fmaxf(a, fmaxf(p0[r], p1[r]));
    auto rr = __builtin_amdgcn_permlane32_swap(__float_as_uint(a), __float_as_uint(a), false, false);
    return fmaxf(__uint_as_float(rr[0]), __uint_as_float(rr[1]));
}
__device__ __forceinline__ float halfsum(float a) { auto rr = __builtin_amdgcn_permlane32_swap(__float_as_uint(a), __float_as_uint(a), false, false); return __uint_as_float(rr[0]) + __uint_as_float(rr[1]); }
template <int ND0> __device__ __forceinline__ void pv(f32x16* o, int vb, bf16x8 pa0, bf16x8 pa1, bf16x8 pa2, bf16x8 pa3) {
#pragma unroll
    for (int d0 = 0; d0 < ND0; ++d0) { s16x4 lo[4], hi[4];
#pragma unroll
        for (int ks = 0; ks < 4; ++ks) {
            asm volatile("ds_read_b64_tr_b16 %0,%1 offset:%c2" : "=&v"(lo[ks]) : "v"(vb), "i"(d0 * 4096 + ks * 1024) : "memory");
            asm volatile("ds_read_b64_tr_b16 %0,%1 offset:%c2" : "=&v"(hi[ks]) : "v"(vb), "i"(d0 * 4096 + ks * 1024 + 512) : "memory"); }
        asm volatile("s_waitcnt lgkmcnt(0)" ::: "memory"); ATT_SBAR();
#define ATT_PK(k) (bf16x8){lo[k][0], lo[k][1], lo[k][2], lo[k][3], hi[k][0], hi[k][1], hi[k][2], hi[k][3]}
        o[d0] = __builtin_amdgcn_mfma_f32_32x32x16_bf16(pa0, ATT_PK(0), o[d0], 0, 0, 0);
        o[d0] = __builtin_amdgcn_mfma_f32_32x32x16_bf16(pa1, ATT_PK(1), o[d0], 0, 0, 0);
        o[d0] = __builtin_amdgcn_mfma_f32_32x32x16_bf16(pa2, ATT_PK(2), o[d0], 0, 0, 0);
        o[d0] = __builtin_amdgcn_mfma_f32_32x32x16_bf16(pa3, ATT_PK(3), o[d0], 0, 0, 0);
#undef ATT_PK
    }
}
template <int ND0, int THR> __device__ __forceinline__ void softmax_tile(f32x16& p0, f32x16& p1, float& mrun, float& lsum, f32x16* o, __attribute__((address_space(3))) float* wsf, int r32, int hi,
                                                                   u32x4& pw0, u32x4& pw1, u32x4& pw2, u32x4& pw3) {
    const float rm = rowmax32(p0, p1);
    if (__any(rm > mrun + (float)THR)) {
        const float mn = fmaxf(mrun, rm), alpha = __builtin_amdgcn_exp2f(mrun - mn); lsum *= alpha; mrun = mn;
        if (hi == 0) wsf[r32] = alpha;
        ATT_LDSWAIT();
#pragma unroll
        for (int g = 0; g < 4; ++g) { const f32x4 a4 = *(const __attribute__((address_space(3))) f32x4*)(wsf + 8 * g + 4 * hi);
#pragma unroll
            for (int d0 = 0; d0 < ND0; ++d0) { o[d0][4 * g + 0] *= a4[0]; o[d0][4 * g + 1] *= a4[1]; o[d0][4 * g + 2] *= a4[2]; o[d0][4 * g + 3] *= a4[3]; } }
        ATT_LDSWAIT();
    }
    float s = 0.f;
#pragma unroll
    for (int r = 0; r < 16; ++r) { p0[r] = __builtin_amdgcn_exp2f(p0[r] - mrun); p1[r] = __builtin_amdgcn_exp2f(p1[r] - mrun); s += p0[r] + p1[r]; }
    lsum += s;
    pw0 = (u32x4){cvtpk(p0[0], p0[1]), cvtpk(p0[2], p0[3]), cvtpk(p0[4], p0[5]), cvtpk(p0[6], p0[7])};
    pw1 = (u32x4){cvtpk(p0[8], p0[9]), cvtpk(p0[10], p0[11]), cvtpk(p0[12], p0[13]), cvtpk(p0[14], p0[15])};
    pw2 = (u32x4){cvtpk(p1[0], p1[1]), cvtpk(p1[2], p1[3]), cvtpk(p1[4], p1[5]), cvtpk(p1[6], p1[7])};
    pw3 = (u32x4){cvtpk(p1[8], p1[9]), cvtpk(p1[10], p1[11]), cvtpk(p1[12], p1[13]), cvtpk(p1[14], p1[15])};
}

constexpr int A_SLOTK = 8192, A_SLOTV = 16384, A_NS = 3;
constexpr int A_LDS_K = 0, A_LDS_V = A_NS * A_SLOTK, A_LDS_WS = A_LDS_V + A_NS * A_SLOTV, A_LDS_ST = A_LDS_WS + 8 * 256, A_LDS_BYTES = A_LDS_ST + 8 * 8192;
__device__ __forceinline__ void attn_a_unit(int b, int h, int qb, const bf16_t* proj, bf16_t* ya, const float* subln, float lam, unsigned char* shm) {
    const int tid = threadIdx.x, lane = tid & 63, r32 = lane & 31, hi = lane >> 5; const int wid = __builtin_amdgcn_readfirstlane(tid >> 6);
    const size_t rowbase = (size_t)b * SEQ; const int q0 = qb * 256;
    constexpr int NT = SEQ / 64;
    const unsigned lds0 = (unsigned)(uintptr_t)shm;
    const lds_cptr shm3 = (lds_cptr)shm;
    __attribute__((address_space(3))) float* wsf = (__attribute__((address_space(3))) float*)((lds_ptr)shm + A_LDS_WS) + wid * 64;
    const int vb0 = (int)(lds0 + A_LDS_V) + ((lane >> 4) & 1) * 32 + (lane & 3) * 8 + (4 * hi + ((lane & 15) >> 2)) * 64;
    __attribute__((address_space(3))) bf16_t* stg = (__attribute__((address_space(3))) bf16_t*)((lds_ptr)shm + A_LDS_ST) + wid * 4096;
    for (int mp = 0; mp < 2; ++mp) {
        const bf16_t* Kh = proj + rowbase * INW + C_KA + h * 128 + mp * 64;
        const bf16_t* Vh = proj + rowbase * INW + C_VA + h * 128;
        const bf16_t* Qw = proj + (rowbase + q0 + wid * 32) * INW + C_QA + h * 128 + mp * 64;
        const int pA = 2 * wid, pB = 2 * wid + 1;
        const unsigned kdst = lds0 + A_LDS_K + wid * 1024, vdstA = lds0 + A_LDS_V + pA * 1024, vdstB = lds0 + A_LDS_V + pB * 1024;
#define A_DMA(t, slot) do { int ln_ = lane; asm volatile("" : "+v"(ln_)); \
        const bf16_t* ksrc_ = Kh + (size_t)((t) * 64 + ln_) * INW + wid * 8; \
        const bf16_t* vsrcA_ = Vh + (size_t)((t) * 64 + 16 * (pA & 3) + (ln_ >> 2)) * INW + (pA >> 2) * 32 + (ln_ & 3) * 8; \
        const bf16_t* vsrcB_ = Vh + (size_t)((t) * 64 + 16 * (pB & 3) + (ln_ >> 2)) * INW + (pB >> 2) * 32 + (ln_ & 3) * 8; \
        glds16(ksrc_, (unsigned)__builtin_amdgcn_readfirstlane(kdst + (slot) * A_SLOTK)); \
        glds16(vsrcA_, (unsigned)__builtin_amdgcn_readfirstlane(vdstA + (slot) * A_SLOTV)); \
        glds16(vsrcB_, (unsigned)__builtin_amdgcn_readfirstlane(vdstB + (slot) * A_SLOTV)); } while (0)
        A_DMA(0, 0); A_DMA(1, 1);
        bf16x8 qr[4];
#pragma unroll
        for (int d0 = 0; d0 < 4; ++d0) qr[d0] = *(const bf16x8*)(Qw + (size_t)r32 * INW + d0 * 16 + hi * 8);
        f32x16 o[4]; o[0] = f32x16{}; o[1] = f32x16{}; o[2] = f32x16{}; o[3] = f32x16{};
        float mrun = -1e30f, lsum = 0.f;
        int slot = 0, slot2 = 2;
        for (int t = 0; t < NT; ++t) {
            if (t + 1 < NT) { ATT_WAIT_BAR(3); } else { ATT_WAIT_BAR(0); }
            if (t + 2 < NT) A_DMA(t + 2, slot2);
            f32x16 p0, p1; u32x4 pw0, pw1, pw2, pw3;
            qkt(p0, p1, shm3 + A_LDS_K + slot * A_SLOTK, qr, r32, hi);
            softmax_tile<4, 8>(p0, p1, mrun, lsum, o, wsf, r32, hi, pw0, pw1, pw2, pw3);
            pv<4>(o, vb0 + slot * A_SLOTV, __builtin_bit_cast(bf16x8, pw0), __builtin_bit_cast(bf16x8, pw1), __builtin_bit_cast(bf16x8, pw2), __builtin_bit_cast(bf16x8, pw3));
            slot = (slot == 2) ? 0 : slot + 1; slot2 = (slot2 == 2) ? 0 : slot2 + 1;
        }
#undef A_DMA
        const float lt = halfsum(lsum);
        if (hi == 0) wsf[32 + r32] = lt;
        ATT_LDSWAIT();
        float rli[16];
#pragma unroll
        for (int g = 0; g < 4; ++g) { const f32x4 l4 = *(const __attribute__((address_space(3))) f32x4*)(wsf + 32 + 8 * g + 4 * hi);
            rli[4 * g + 0] = __builtin_amdgcn_rcpf(l4[0]); rli[4 * g + 1] = __builtin_amdgcn_rcpf(l4[1]); rli[4 * g + 2] = __builtin_amdgcn_rcpf(l4[2]); rli[4 * g + 3] = __builtin_amdgcn_rcpf(l4[3]); }
        ATT_LDSWAIT();
        if (mp == 0) {
#pragma unroll
            for (int d0 = 0; d0 < 4; ++d0)
#pragma unroll
                for (int r = 0; r < 16; ++r) stg[crow(r, hi) * 128 + d0 * 32 + r32] = (bf16_t)f2bf(o[d0][r] * rli[r]);
            asm volatile("s_waitcnt lgkmcnt(0)\n\ts_barrier" ::: "memory");
        } else {
            float ss[16];
#pragma unroll
            for (int r = 0; r < 16; ++r) ss[r] = 0.f;
#pragma unroll
            for (int d0 = 0; d0 < 4; ++d0)
#pragma unroll
                for (int r = 0; r < 16; ++r) { const float a = bf2f(stg[crow(r, hi) * 128 + d0 * 32 + r32]); const float y = a - lam * o[d0][r] * rli[r]; o[d0][r] = y; ss[r] += y * y; }
#pragma unroll
            for (int r = 0; r < 16; ++r) { float v = ss[r]; v += __shfl_xor(v, 1); v += __shfl_xor(v, 2); v += __shfl_xor(v, 4); v += __shfl_xor(v, 8); v += __shfl_xor(v, 16);
                ss[r] = 0.8f / sqrtf(v * (1.f / 128.f) + EPS); }
            ATT_LDSWAIT();
#pragma unroll
            for (int d0 = 0; d0 < 4; ++d0) { const float gsub = subln[d0 * 32 + r32];
#pragma unroll
                for (int r = 0; r < 16; ++r) stg[crow(r, hi) * 128 + d0 * 32 + r32] = (bf16_t)f2bf(o[d0][r] * ss[r] * gsub); }
            ATT_LDSWAIT();
            bf16_t* Yw = ya + (rowbase + q0 + wid * 32) * 512 + h * 128;
#pragma unroll
            for (int i = 0; i < 8; ++i) { const int row = i * 4 + (lane >> 4), ch = lane & 15; const u32x4 v = *(const __attribute__((address_space(3))) u32x4*)(stg + row * 128 + ch * 8); *(u32x4*)(Yw + (size_t)row * 512 + ch * 8) = v; }
            asm volatile("s_waitcnt lgkmcnt(0)\n\ts_barrier" ::: "memory");
        }
    }
}
}

__global__ void __launch_bounds__(512, 2) k_attn_a(Ptrs P) {
    extern __shared__ __attribute__((aligned(16))) unsigned char lds_dyn[];
    const float lam = lambda_full(P);
    const int G = gridDim.x, bx = blockIdx.x, vcu = (G % 8 == 0) ? (bx % 8) * (G / 8) + bx / 8 : bx;
    for (int u = vcu; u < BATCH * 4 * 8; u += G)
        att::attn_a_unit(u >> 5, (u >> 3) & 3, u & 7, (const bf16_t*)(P.ws + WS_PROJ), (bf16_t*)(P.ws + WS_YA), P.subln, lam, lds_dyn);
}

__global__ void __launch_bounds__(256) k_attn_a_naive(Ptrs P) {
    const bf16_t* proj = (const bf16_t*)(P.ws + WS_PROJ);
    const int gt = blockIdx.x * 256 + threadIdx.x;
    const int ch = gt & 3, q = (gt >> 2) & 2047, h = (gt >> 13) & 3, b = gt >> 15;
    const float lam = lambda_full(P);
    const size_t qrow = (size_t)b * SEQ + q;
    float y[32];
#pragma unroll
    for (int j = 0; j < 32; ++j) y[j] = 0.f;
    for (int m = 0; m < 2; ++m) {
        float qv[64];
        const bf16_t* qp = proj + qrow * INW + C_QA + h * 128 + m * 64;
#pragma unroll
        for (int d = 0; d < 64; ++d) qv[d] = bf2f(qp[d]);
        float mx = -1e30f, l = 0.f, acc[32];
#pragma unroll
        for (int j = 0; j < 32; ++j) acc[j] = 0.f;
        for (int k = 0; k < SEQ; ++k) {
            const size_t krow = (size_t)b * SEQ + k;
            const bf16_t* kp = proj + krow * INW + C_KA + h * 128 + m * 64;
            float s = 0.f;
#pragma unroll
            for (int d8 = 0; d8 < 8; ++d8) { const u32x4 kv = *(const u32x4*)(kp + d8 * 8);
                s += qv[d8 * 8 + 0] * bflo(kv.x); s += qv[d8 * 8 + 1] * bfhi(kv.x); s += qv[d8 * 8 + 2] * bflo(kv.y); s += qv[d8 * 8 + 3] * bfhi(kv.y);
                s += qv[d8 * 8 + 4] * bflo(kv.z); s += qv[d8 * 8 + 5] * bfhi(kv.z); s += qv[d8 * 8 + 6] * bflo(kv.w); s += qv[d8 * 8 + 7] * bfhi(kv.w); }
            if (s > mx) { const float f = exp2f(mx - s); l *= f;
#pragma unroll
                for (int j = 0; j < 32; ++j) acc[j] *= f;
                mx = s; }
            const float p = exp2f(s - mx); l += p;
            const bf16_t* vp = proj + krow * INW + C_VA + h * 128 + ch * 32;
#pragma unroll
            for (int d8 = 0; d8 < 4; ++d8) { const u32x4 vv = *(const u32x4*)(vp + d8 * 8);
                acc[d8 * 8 + 0] += p * bflo(vv.x); acc[d8 * 8 + 1] += p * bfhi(vv.x); acc[d8 * 8 + 2] += p * bflo(vv.y); acc[d8 * 8 + 3] += p * bfhi(vv.y);
                acc[d8 * 8 + 4] += p * bflo(vv.z); acc[d8 * 8 + 5] += p * bfhi(vv.z); acc[d8 * 8 + 6] += p * bflo(vv.w); acc[d8 * 8 + 7] += p * bfhi(vv.w); }
        }
        const float il = 1.f / l, sg = (m == 0) ? 1.f : -lam;
#pragma unroll
        for (int j = 0; j < 32; ++j) y[j] += sg * acc[j] * il;
    }
    float ss = 0.f;
#pragma unroll
    for (int j = 0; j < 32; ++j) ss += y[j] * y[j];
    ss += __shfl_xor(ss, 1); ss += __shfl_xor(ss, 2);
    const float rstd = 1.f / sqrtf(ss * (1.f / 128.f) + EPS) * 0.8f;
    bf16_t* yo = (bf16_t*)(P.ws + WS_YA) + qrow * 512 + h * 128 + ch * 32;
#pragma unroll
    for (int j = 0; j < 32; ++j) yo[j] = (bf16_t)f2bf(y[j] * rstd * P.subln[ch * 32 + j]);
}
__global__ void __launch_bounds__(256) k_attn_b_naive(Ptrs P) {
    const bf16_t* proj = (const bf16_t*)(P.ws + WS_PROJ);
    const int gt = blockIdx.x * 256 + threadIdx.x;
    const int c = gt & 63, r = (gt >> 6) & 31, h = (gt >> 11) & 7, b = gt >> 14;
    const size_t qrow = (size_t)b * SEQ + r * 64 + c;
    float qv[64];
    const bf16_t* qp = proj + qrow * INW + C_QB + h * 64;
#pragma unroll
    for (int d = 0; d < 64; ++d) qv[d] = bf2f(qp[d]);
    int rs = r - 4; rs = rs < 0 ? 0 : (rs > 24 ? 24 : rs);
    int cs = c - 8; cs = cs < 0 ? 0 : (cs > 48 ? 48 : cs);
    float mx = -1e30f, l = 0.f, acc[64];
#pragma unroll
    for (int j = 0; j < 64; ++j) acc[j] = 0.f;
    for (int i = 0; i < 8; ++i)
        for (int j = 0; j < 16; ++j) {
            const size_t krow = (size_t)b * SEQ + (rs + i) * 64 + (cs + j);
            const bf16_t* kp = proj + krow * INW + C_KB + h * 64;
            float s = 0.f;
#pragma unroll
            for (int d8 = 0; d8 < 8; ++d8) { const u32x4 kv = *(const u32x4*)(kp + d8 * 8);
                s += qv[d8 * 8 + 0] * bflo(kv.x); s += qv[d8 * 8 + 1] * bfhi(kv.x); s += qv[d8 * 8 + 2] * bflo(kv.y); s += qv[d8 * 8 + 3] * bfhi(kv.y);
                s += qv[d8 * 8 + 4] * bflo(kv.z); s += qv[d8 * 8 + 5] * bfhi(kv.z); s += qv[d8 * 8 + 6] * bflo(kv.w); s += qv[d8 * 8 + 7] * bfhi(kv.w); }
            s += LOG2E * P.rpb[(h * 15 + (rs + i - r + 7)) * 31 + (cs + j - c + 15)];
            if (s > mx) { const float f = exp2f(mx - s); l *= f;
#pragma unroll
                for (int jj = 0; jj < 64; ++jj) acc[jj] *= f;
                mx = s; }
            const float p = exp2f(s - mx); l += p;
            const bf16_t* vp = proj + krow * INW + C_VB + h * 64;
#pragma unroll
            for (int d8 = 0; d8 < 8; ++d8) { const u32x4 vv = *(const u32x4*)(vp + d8 * 8);
                acc[d8 * 8 + 0] += p * bflo(vv.x); acc[d8 * 8 + 1] += p * bfhi(vv.x); acc[d8 * 8 + 2] += p * bflo(vv.y); acc[d8 * 8 + 3] += p * bfhi(vv.y);
                acc[d8 * 8 + 4] += p * bflo(vv.z); acc[d8 * 8 + 5] += p * bfhi(vv.z); acc[d8 * 8 + 6] += p * bflo(vv.w); acc[d8 * 8 + 7] += p * bfhi(vv.w); }
        }
    const float il = 1.f / l;
    bf16_t* yo = (bf16_t*)(P.ws + WS_YB) + qrow * 512 + h * 64;
#pragma unroll
    for (int j = 0; j < 64; ++j) yo[j] = (bf16_t)f2bf(acc[j] * il);
}
__global__ void __launch_bounds__(64) k_topk1_naive(Ptrs P) {
    __shared__ float sc[128][64];
    const int tid = threadIdx.x, gt = blockIdx.x * 64 + tid;
    const int t = gt & (M - 1), hp = gt >> 14;
    const bf16_t* qp = (const bf16_t*)(P.ws + WS_Q) + (size_t)t * PQ + hp * 128;
    const bf16_t* sk = (const bf16_t*)(P.ws + WS_SK) + (size_t)hp * 128 * 128;
    float qv[128];
#pragma unroll
    for (int d = 0; d < 128; ++d) qv[d] = bf2f(qp[d]);
    for (int k = 0; k < 128; ++k) {
        float s = 0.f;
#pragma unroll
        for (int d8 = 0; d8 < 16; ++d8) { const u32x4 kv = *(const u32x4*)(sk + k * 128 + d8 * 8);
            s += qv[d8 * 8 + 0] * bflo(kv.x); s += qv[d8 * 8 + 1] * bfhi(kv.x); s += qv[d8 * 8 + 2] * bflo(kv.y); s += qv[d8 * 8 + 3] * bfhi(kv.y);
            s += qv[d8 * 8 + 4] * bflo(kv.z); s += qv[d8 * 8 + 5] * bfhi(kv.z); s += qv[d8 * 8 + 6] * bflo(kv.w); s += qv[d8 * 8 + 7] * bfhi(kv.w); }
        sc[k][tid] = s;
    }
    float pv = 3e38f; int pk = -1;
    float* tv = (float*)(P.ws + WS_TOPV) + ((size_t)t * 16 + hp) * 16; int* ti = (int*)(P.ws + WS_TOPI) + ((size_t)t * 16 + hp) * 16;
    for (int j = 0; j < 16; ++j) {
        float bv = -3e38f; int bk = -1;
        for (int k = 0; k < 128; ++k) { const float v = sc[k][tid]; const bool below = (v < pv) || (v == pv && k > pk); if (below && v > bv) { bv = v; bk = k; } }
        tv[j] = bv; ti[j] = bk; pv = bv; pk = bk;
    }
}
__global__ void __launch_bounds__(256) k_topk2_naive(Ptrs P) {
    const int gt = blockIdx.x * 256 + threadIdx.x;
    const float* tv = (const float*)(P.ws + WS_TOPV) + (size_t)gt * 32; const int* ti = (const int*)(P.ws + WS_TOPI) + (size_t)gt * 32;
    float v0[16], v1[16]; int i0[16], i1[16];
#pragma unroll
    for (int j = 0; j < 16; ++j) { v0[j] = tv[j]; v1[j] = tv[16 + j]; i0[j] = ti[j]; i1[j] = ti[16 + j]; }
    float* go = (float*)(P.ws + WS_G) + (size_t)gt * 16; int* io = (int*)(P.ws + WS_IDX) + (size_t)gt * 16;
    float pv = 3e38f; int pk = -1; float s0 = 0.f, esum = 0.f;
    for (int j = 0; j < 16; ++j) {
        float bv = -3e38f; int bk = -1, bidx = 0;
        int iz; asm volatile("v_mov_b32 %0, 0" : "=v"(iz));
#pragma unroll
        for (int a = 0; a < 16; ++a)
#pragma unroll
            for (int b = 0; b < 16; ++b) { const float v = v0[a] + __int_as_float(__float_as_int(v1[b]) | iz); const int k = a * 16 + b; const bool below = (v < pv) || (v == pv && k > pk);
                if (below && v > bv) { bv = v; bk = k; bidx = (i0[a] | iz) * 128 + i1[b]; } }
        if (j == 0) s0 = bv;
        const float e = __expf(bv - s0); esum += e;
        go[j] = e; io[j] = bidx; pv = bv; pk = bk;
    }
    const float inv = 1.f / esum;
#pragma unroll
    for (int j = 0; j < 16; ++j) go[j] *= inv;
}
__global__ void __launch_bounds__(256) k_peer_apply(Ptrs P) {
    const int lane = threadIdx.x & 63, sub = lane & 15, g = lane >> 4;
    const int t = blockIdx.x * 4 + (threadIdx.x >> 6);
    const float* hrow = P.out + (size_t)t * D;
    const float* ssq = (const float*)(P.ws + WS_SSQ) + (size_t)t * 16;
    float tot = 0.f;
#pragma unroll
    for (int i = 0; i < 16; ++i) tot += ssq[i];
    const float rstd = 1.f / sqrtf(tot * (1.f / D) + EPS);
    unsigned xh[8][4]; float hv[8][8];
#pragma unroll
    for (int i = 0; i < 8; ++i) { const int e0 = (sub + 16 * i) * 8;
        const f32x4 a = *(const f32x4*)(hrow + e0), b = *(const f32x4*)(hrow + e0 + 4);
        const f32x4 ga = *(const f32x4*)(P.norm_ffn + e0), gb = *(const f32x4*)(P.norm_ffn + e0 + 4);
        hv[i][0] = a.x; hv[i][1] = a.y; hv[i][2] = a.z; hv[i][3] = a.w; hv[i][4] = b.x; hv[i][5] = b.y; hv[i][6] = b.z; hv[i][7] = b.w;
        xh[i][0] = pk2(a.x * rstd * ga.x, a.y * rstd * ga.y); xh[i][1] = pk2(a.z * rstd * ga.z, a.w * rstd * ga.w);
        xh[i][2] = pk2(b.x * rstd * gb.x, b.y * rstd * gb.y); xh[i][3] = pk2(b.z * rstd * gb.z, b.w * rstd * gb.w); }
    const int* idxp = (const int*)(P.ws + WS_IDX) + (size_t)t * 128; const float* gp = (const float*)(P.ws + WS_G) + (size_t)t * 128;
    const int id0 = idxp[lane], id1 = idxp[64 + lane]; const float g0 = gp[lane], g1 = gp[64 + lane];
    const bf16_t* U = (const bf16_t*)(P.ws + WS_U); const bf16_t* V = (const bf16_t*)(P.ws + WS_V);
    float acc[8][8];
#pragma unroll
    for (int i = 0; i < 8; ++i)
#pragma unroll
        for (int e = 0; e < 8; ++e) acc[i][e] = 0.f;
    for (int j = 0; j < 32; ++j) {
        const int src = (4 * j + g) & 63;
        const int e = (j < 16) ? __shfl(id0, src) : __shfl(id1, src);
        const float gate = (j < 16) ? __shfl(g0, src) : __shfl(g1, src);
        const bf16_t* ur = U + (size_t)e * D; const bf16_t* vr = V + (size_t)e * D;
        u32x4 uu[8], vv[8];
#pragma unroll
        for (int i = 0; i < 8; ++i) { uu[i] = *(const u32x4*)(ur + (sub + 16 * i) * 8); vv[i] = *(const u32x4*)(vr + (sub + 16 * i) * 8); }
        float d = 0.f;
#pragma unroll
        for (int i = 0; i < 8; ++i) {
            d += bflo(uu[i].x) * bflo(xh[i][0]) + bfhi(uu[i].x) * bfhi(xh[i][0]); d += bflo(uu[i].y) * bflo(xh[i][1]) + bfhi(uu[i].y) * bfhi(xh[i][1]);
            d += bflo(uu[i].z) * bflo(xh[i][2]) + bfhi(uu[i].z) * bfhi(xh[i][2]); d += bflo(uu[i].w) * bflo(xh[i][3]) + bfhi(uu[i].w) * bfhi(xh[i][3]); }
        d += __shfl_xor(d, 1); d += __shfl_xor(d, 2); d += __shfl_xor(d, 4); d += __shfl_xor(d, 8);
        const float c = gate * gelu_exact(d);
#pragma unroll
        for (int i = 0; i < 8; ++i) {
            acc[i][0] += c * bflo(vv[i].x); acc[i][1] += c * bfhi(vv[i].x); acc[i][2] += c * bflo(vv[i].y); acc[i][3] += c * bfhi(vv[i].y);
            acc[i][4] += c * bflo(vv[i].z); acc[i][5] += c * bfhi(vv[i].z); acc[i][6] += c * bflo(vv[i].w); acc[i][7] += c * bfhi(vv[i].w); }
    }
    float ss = 0.f;
#pragma unroll
    for (int i = 0; i < 8; ++i)
#pragma unroll
        for (int e = 0; e < 8; ++e) { float a = acc[i][e]; a += __shfl_xor(a, 16); a += __shfl_xor(a, 32); a += hv[i][e]; acc[i][e] = a; ss += a * a; }
    ss += __shfl_xor(ss, 1); ss += __shfl_xor(ss, 2); ss += __shfl_xor(ss, 4); ss += __shfl_xor(ss, 8);
    const float r2 = 1.f / sqrtf(ss * (1.f / D) + EPS);
    float* orow = P.out + (size_t)t * D;
#pragma unroll
    for (int i = 0; i < 8; ++i) if ((i & 3) == g) { const int e0 = (sub + 16 * i) * 8;
        const f32x4 ga = *(const f32x4*)(P.norm_final + e0), gb = *(const f32x4*)(P.norm_final + e0 + 4);
        f32x4 o0, o1; o0.x = acc[i][0] * r2 * ga.x; o0.y = acc[i][1] * r2 * ga.y; o0.z = acc[i][2] * r2 * ga.z; o0.w = acc[i][3] * r2 * ga.w;
        o1.x = acc[i][4] * r2 * gb.x; o1.y = acc[i][5] * r2 * gb.y; o1.z = acc[i][6] * r2 * gb.z; o1.w = acc[i][7] * r2 * gb.w;
        *(f32x4*)(orow + e0) = o0; *(f32x4*)(orow + e0 + 4) = o1; }
}

extern "C" void kernel_launch(void* const* d_in, const int* in_sizes, int n_in, void* d_out, int out_size, void* d_ws, size_t ws_size, hipStream_t stream) {
    if (n_in != 18 || ws_size < WS_END) { fprintf(stderr, "kernel_launch: unexpected n_in %d / ws_size %zu\n", n_in, ws_size); return; }
    Ptrs P{};
    P.x = (const float*)d_in[0]; P.w_in = (const float*)d_in[1]; P.w_pa = (const float*)d_in[2]; P.w_pb = (const float*)d_in[3]; P.w_out = (const float*)d_in[4];
    P.norm_mix = (const float*)d_in[5]; P.norm_ffn = (const float*)d_in[6]; P.norm_final = (const float*)d_in[7];
    P.lq1 = (const float*)d_in[8]; P.lk1 = (const float*)d_in[9]; P.lq2 = (const float*)d_in[10]; P.lk2 = (const float*)d_in[11];
    P.subln = (const float*)d_in[12]; P.rpb = (const float*)d_in[13]; P.w_query = (const float*)d_in[14]; P.sub_keys = (const float*)d_in[15];
    P.peer_u = (const float*)d_in[16]; P.peer_v = (const float*)d_in[17];
    P.out = (float*)d_out; P.ws = (unsigned char*)d_ws;
    unsigned char* ws = P.ws;
    k_prep<<<1024, 256, 0, stream>>>(P);
    constexpr int GEMM_LDS = pg8::STAGE_BYTES;
    const int G = 256;
    static bool attr_done = false;
    if (!attr_done) { attr_done = true;
    hipFuncSetAttribute((const void*)k_gemm<pg8::EpiProj>, hipFuncAttributeMaxDynamicSharedMemorySize, GEMM_LDS);
    hipFuncSetAttribute((const void*)k_gemm<pg8::EpiGateA>, hipFuncAttributeMaxDynamicSharedMemorySize, GEMM_LDS);
    hipFuncSetAttribute((const void*)k_gemm<pg8::EpiGateB>, hipFuncAttributeMaxDynamicSharedMemorySize, GEMM_LDS);
    hipFuncSetAttribute((const void*)k_gemm<pg8::EpiHout>, hipFuncAttributeMaxDynamicSharedMemorySize, GEMM_LDS);
    hipFuncSetAttribute((const void*)k_gemm<pg8::EpiQ>, hipFuncAttributeMaxDynamicSharedMemorySize, GEMM_LDS);
    hipFuncSetAttribute((const void*)k_attn_a, hipFuncAttributeMaxDynamicSharedMemorySize, att::A_LDS_BYTES); }
    k_gemm<pg8::EpiProj><<<G, 512, GEMM_LDS, stream>>>(pg8::Gemm{(const bf16_t*)(ws + WS_XN), (const bf16_t*)(ws + WS_WIN), M, INW, D, 0}, pg8::EpiProj{(bf16_t*)(ws + WS_PROJ), (const float*)(ws + WS_ROPE)});
    k_attn_a<<<G, 512, att::A_LDS_BYTES, stream>>>(P);
    k_attn_b_naive<<<BATCH * 8 * SEQ / 256, 256, 0, stream>>>(P);
    k_gemm<pg8::EpiGateA><<<G, 512, GEMM_LDS, stream>>>(pg8::Gemm{(const bf16_t*)(ws + WS_YA), (const bf16_t*)(ws + WS_WPA), M, D, 512, 0}, pg8::EpiGateA{(const bf16_t*)(ws + WS_PROJ), P.out});
    k_gemm<pg8::EpiGateB><<<G, 512, GEMM_LDS, stream>>>(pg8::Gemm{(const bf16_t*)(ws + WS_YB), (const bf16_t*)(ws + WS_WPB), M, D, 512, 0}, pg8::EpiGateB{(const bf16_t*)(ws + WS_PROJ), P.out, (bf16_t*)(ws + WS_MERGED)});
    k_gemm<pg8::EpiHout><<<G, 512, GEMM_LDS, stream>>>(pg8::Gemm{(const bf16_t*)(ws + WS_MERGED), (const bf16_t*)(ws + WS_WOUT), M, D, D, 0}, pg8::EpiHout{P.x, P.out, (bf16_t*)(ws + WS_HB), (float*)(ws + WS_SSQ)});
    k_gemm<pg8::EpiQ><<<G, 512, GEMM_LDS, stream>>>(pg8::Gemm{(const bf16_t*)(ws + WS_HB), (const bf16_t*)(ws + WS_WQ), M, PQ, D, 0}, pg8::EpiQ{(const float*)(ws + WS_SSQ), (bf16_t*)(ws + WS_Q)});
    k_cvt_experts<<<2048, 256, 0, stream>>>(P);
    k_topk1_naive<<<M * 16 / 64, 64, 0, stream>>>(P);
    k_topk2_naive<<<M * 8 / 256, 256, 0, stream>>>(P);
    k_peer_apply<<<M / 4, 256, 0, stream>>>(P);
}
```

```cpp
#include <hip/hip_runtime.h>
#include <cstdio>
#include <cstdint>

typedef unsigned short bf16_t;
typedef unsigned u32x4 __attribute__((ext_vector_type(4)));
typedef unsigned u32x2 __attribute__((ext_vector_type(2)));
typedef float f32x4 __attribute__((ext_vector_type(4)));
typedef __bf16 bf16x2_t __attribute__((ext_vector_type(2)));

constexpr int D = 1024, BATCH = 8, SEQ = 2048, M = BATCH * SEQ, INW = 5120;
constexpr int C_QA = 0, C_KA = 512, C_VA = 1024, C_QB = 1536, C_KB = 2048, C_VB = 2560, C_GA = 3072, C_GB = 4096;
constexpr int NEXP = 16384, PQ = 2048;
constexpr float EPS = 1e-6f;
constexpr float LOG2E = 1.4426950408889634f;
constexpr float QSCALE = 0.125f * LOG2E;

constexpr size_t MiB = 1u << 20;
constexpr size_t WS_PROJ = 0;
constexpr size_t WS_HB = 0;
constexpr size_t WS_Q = 32 * MiB;
constexpr size_t WS_U = 96 * MiB;
constexpr size_t WS_V = 128 * MiB;
constexpr size_t WS_XN = 160 * MiB;
constexpr size_t WS_YA = 160 * MiB;
constexpr size_t WS_YB = 176 * MiB;
constexpr size_t WS_IDX = 160 * MiB;
constexpr size_t WS_G = 168 * MiB;
constexpr size_t WS_MERGED = 192 * MiB;
constexpr size_t WS_TOPV = 192 * MiB;
constexpr size_t WS_TOPI = 208 * MiB;
constexpr size_t WS_WIN = 224 * MiB;
constexpr size_t WS_WQ = 234 * MiB;
constexpr size_t WS_WOUT = 238 * MiB;
constexpr size_t WS_WPA = 240 * MiB;
constexpr size_t WS_WPB = 241 * MiB;
constexpr size_t WS_SK = 242 * MiB;
constexpr size_t WS_ROPE = 242 * MiB + 512 * 1024;
constexpr size_t WS_SSQ = 243 * MiB;
constexpr size_t WS_CTL = 244 * MiB;
constexpr size_t WS_END = 256 * MiB;

__device__ __forceinline__ float bf2f(unsigned v) { return __uint_as_float(v << 16); }
__device__ __forceinline__ float bflo(unsigned w) { return __uint_as_float(w << 16); }
__device__ __forceinline__ float bfhi(unsigned w) { return __uint_as_float(w & 0xffff0000u); }
__device__ __forceinline__ unsigned f2bf(float f) { unsigned u = __float_as_uint(f); return (u + 0x7fffu + ((u >> 16) & 1u)) >> 16; }
__device__ __forceinline__ unsigned pk2(float lo, float hi) { return f2bf(lo) | (f2bf(hi) << 16); }
__device__ __forceinline__ float wave_sum(float v) {
#pragma unroll
    for (int o = 1; o < 64; o <<= 1) v += __shfl_xor(v, o);
    return v;
}
__device__ __forceinline__ float sigmoidf_(float x) { return 1.f / (1.f + __expf(-x)); }
__device__ __forceinline__ float gelu_exact(float x) { return 0.5f * x * (1.f + erff(x * 0.70710678118654752f)); }

struct Ptrs {
    const float *x, *w_in, *w_pa, *w_pb, *w_out, *norm_mix, *norm_ffn, *norm_final, *lq1, *lk1, *lq2, *lk2, *subln, *rpb, *w_query, *sub_keys, *peer_u, *peer_v;
    float* out; unsigned char* ws;
};

__device__ __forceinline__ void transpose_item(const float* W, int K, int N, const float* gain, bf16_t* WT, float* scr, int item, int lane) {
    const int nblk = N / 32, kb = item / nblk, nb = item % nblk, k0 = 64 * kb, n0 = 32 * nb;
#pragma unroll 8
    for (int i = 0; i < 32; ++i) { const int kk = 2 * i + (lane >> 5); float w = W[(size_t)(k0 + kk) * N + n0 + (lane & 31)]; if (gain) w *= gain[k0 + kk]; scr[kk * 33 + (lane & 31)] = w; }
    asm volatile("s_waitcnt lgkmcnt(0)" ::: "memory");
    const int c = lane & 7;
#pragma unroll
    for (int j = 0; j < 4; ++j) { const int n = (lane >> 3) + 8 * j; const float* s = scr + (8 * c) * 33 + n;
        u32x4 o; o.x = pk2(s[0 * 33], s[1 * 33]); o.y = pk2(s[2 * 33], s[3 * 33]); o.z = pk2(s[4 * 33], s[5 * 33]); o.w = pk2(s[6 * 33], s[7 * 33]);
        *(u32x4*)(WT + (size_t)(n0 + n) * K + k0 + 8 * c) = o; }
    asm volatile("s_waitcnt lgkmcnt(0)" ::: "memory");
}
__device__ __forceinline__ void cvt8(const float* src, bf16_t* dst, size_t i8) {
    const f32x4 a = *(const f32x4*)(src + i8 * 8), b = *(const f32x4*)(src + i8 * 8 + 4);
    u32x4 o; o.x = pk2(a.x, a.y); o.y = pk2(a.z, a.w); o.z = pk2(b.x, b.y); o.w = pk2(b.z, b.w);
    *(u32x4*)(dst + i8 * 8) = o;
}
__device__ __forceinline__ void rms_row_to_bf16(const float* xrow, bf16_t* orow, int lane) {
    const f32x4* xr = (const f32x4*)xrow + lane;
    f32x4 v[4]; float s = 0.f;
#pragma unroll
    for (int j = 0; j < 4; ++j) { v[j] = xr[64 * j]; s += (v[j].x * v[j].x + v[j].y * v[j].y) + (v[j].z * v[j].z + v[j].w * v[j].w); }
    const float rstd = 1.f / sqrtf(wave_sum(s) * (1.f / D) + EPS);
    u32x2* o8 = (u32x2*)orow + lane;
#pragma unroll
    for (int j = 0; j < 4; ++j) { u32x2 w; w.x = pk2(v[j].x * rstd, v[j].y * rstd); w.y = pk2(v[j].z * rstd, v[j].w * rstd); o8[64 * j] = w; }
}

__global__ void __launch_bounds__(256) k_prep(Ptrs P) {
    __shared__ float scr_all[4][64 * 33];
    const int lane = threadIdx.x & 63, wave = threadIdx.x >> 6;
    const int gw = blockIdx.x * 4 + wave, NGW = gridDim.x * 4;
    float* scr = scr_all[wave];
    unsigned char* ws = P.ws;
    constexpr int I_IN = (D / 64) * (INW / 32), I_Q = (D / 64) * (PQ / 32), I_OUT = (D / 64) * (D / 32), I_PA = (512 / 64) * (D / 32);
    constexpr int NIT = I_IN + I_Q + I_OUT + 2 * I_PA;
    for (int it = gw; it < NIT; it += NGW) {
        int r = it;
        if (r < I_IN) { transpose_item(P.w_in, D, INW, P.norm_mix, (bf16_t*)(ws + WS_WIN), scr, r, lane); continue; } r -= I_IN;
        if (r < I_Q) { transpose_item(P.w_query, D, PQ, P.norm_ffn, (bf16_t*)(ws + WS_WQ), scr, r, lane); continue; } r -= I_Q;
        if (r < I_OUT) { transpose_item(P.w_out, D, D, nullptr, (bf16_t*)(ws + WS_WOUT), scr, r, lane); continue; } r -= I_OUT;
        if (r < I_PA) { transpose_item(P.w_pa, 512, D, nullptr, (bf16_t*)(ws + WS_WPA), scr, r, lane); continue; } r -= I_PA;
        transpose_item(P.w_pb, 512, D, nullptr, (bf16_t*)(ws + WS_WPB), scr, r, lane);
    }
    for (int m = gw; m < M; m += NGW) rms_row_to_bf16(P.x + (size_t)m * D, (bf16_t*)(ws + WS_XN) + (size_t)m * D, lane);
    const size_t gt = (size_t)blockIdx.x * 256 + threadIdx.x, NT = (size_t)gridDim.x * 256;
    for (size_t i = gt; i < (size_t)16 * 128 * 128 / 8; i += NT) cvt8(P.sub_keys, (bf16_t*)(ws + WS_SK), i);
    for (size_t i = gt; i < (size_t)SEQ * 8; i += NT) {
        const int pos = (int)(i >> 3), k = (int)(i & 7);
        const float inv = (float)pow(500000.0, -(double)k / 8.0);
        const float ang = (float)pos * inv;
        float* t = (float*)(ws + WS_ROPE) + (size_t)pos * 16;
        t[k] = (float)cos((double)ang); t[8 + k] = (float)sin((double)ang);
    }
}
__global__ void __launch_bounds__(256) k_cvt_experts(Ptrs P) {
    const size_t gt = (size_t)blockIdx.x * 256 + threadIdx.x, NT = (size_t)gridDim.x * 256;
    for (size_t i = gt; i < (size_t)NEXP * D / 8; i += NT) { cvt8(P.peer_u, (bf16_t*)(P.ws + WS_U), i); cvt8(P.peer_v, (bf16_t*)(P.ws + WS_V), i); }
}

namespace pg8 {
#define PG8_LAS __attribute__((address_space(3)))
typedef unsigned short bf16_t;
typedef short bf16x8 __attribute__((ext_vector_type(8)));
typedef float f32x4 __attribute__((ext_vector_type(4)));
typedef unsigned u32x4 __attribute__((ext_vector_type(4)));
constexpr int BM = 256, BK = 64, HALF = 128, HTB = HALF * BK * 2  , STAGE_BYTES = 8 * HTB, NXCD = 8, WGM = 8;

__host__ __device__ __forceinline__ int lds_byte(int r, int c) { const int st = (r >> 4) * 2 + (c >> 5), rr = r & 15, cc = c & 31, ob = rr * 64 + cc * 2; return st * 1024 + (ob ^ (((ob >> 9) & 1) << 5)); }
__host__ __device__ __forceinline__ void stage_rc(int b, int& R, int& C) { const int st = b / 1024, sb = b % 1024, swz = sb ^ (((sb >> 9) & 1) << 5); R = (st >> 1) * 16 + swz / 64; C = (st & 1) * 32 + (swz % 64) / 2; }
__host__ __device__ __forceinline__ int perm32(int rho) { const int n = rho >> 4, i = rho & 15; return 8 * (i >> 2) + 4 * n + (i & 3); }

struct Unit { int pm, pn; };
struct Gemm { const bf16_t* A; const bf16_t* Bt; int M, N, K, pad; };

struct StaticOrder {
    int nM, nN, nwg, G, c;
    __host__ __device__ void init(int M, int N, int G_, int c_) { nM = M / BM; nN = N / BM; nwg = nM * nN; G = G_; c = c_; }
    __host__ __device__ bool next(int i, Unit& u) const {
        const long L = (long)i * G + c; if (L >= nwg) return false;
        int wgid = (int)L; { const int q = nwg / NXCD, r = nwg % NXCD, xcd = wgid % NXCD, off = wgid / NXCD; wgid = (xcd < r ? xcd * (q + 1) : r * (q + 1) + (xcd - r) * q) + off; }
        const int nig = WGM * nN, gid = wgid / nig, fm = gid * WGM, gsz = (nM - fm) < WGM ? (nM - fm) : WGM;
        u.pm = fm + ((wgid % nig) % gsz); u.pn = (wgid % nig) / gsz; return true;
    }
    __device__ __forceinline__ void a_ready(const Unit&) const {}
    __device__ __forceinline__ void done(const Unit&) const {}
};
__device__ __forceinline__ unsigned cvt_pk_bf16(float lo, float hi) { unsigned r; asm volatile("v_cvt_pk_bf16_f32 %0, %1, %2" : "=v"(r) : "v"(lo), "v"(hi)); return r; }
typedef float f32x2 __attribute__((ext_vector_type(2)));

__device__ __forceinline__ float sigm(float x) { return __builtin_amdgcn_rcpf(1.f + __builtin_amdgcn_exp2f(-1.4426950408889634f * x)); }
struct EpiProj {
    static constexpr bool PERM = true, AFTER_DRAIN = false;
    bf16_t* O; const float* rope;
    __device__ __forceinline__ void operator()(const f32x4 (&acc)[2][2][4][2], const Unit& u, int wr, int wc, int fr, int fq) const {
        const int row0 = u.pm * BM + wr * 64 + fr, col0 = u.pn * BM + wc * 32 + 8 * fq;
        const float sc = (u.pn < 2 || u.pn == 6 || u.pn == 7) ? QSCALE : 1.f;
        const bool dorope = (u.pn < 4) && ((wc & 1) == 0);
#pragma unroll
        for (int ai = 0; ai < 2; ++ai)
#pragma unroll
            for (int m = 0; m < 4; ++m) { const int row = row0 + ai * HALF + m * 16; bf16_t* rowp = O + (size_t)row * INW + col0;
                f32x4 c4[2] = {{1.f, 1.f, 1.f, 1.f}, {1.f, 1.f, 1.f, 1.f}}, s4[2] = {{0.f, 0.f, 0.f, 0.f}, {0.f, 0.f, 0.f, 0.f}};
                if (dorope) { const float* rp = rope + (size_t)(row & (SEQ - 1)) * 16; c4[0] = *(const f32x4*)(rp); c4[1] = *(const f32x4*)(rp + 4); s4[0] = *(const f32x4*)(rp + 8); s4[1] = *(const f32x4*)(rp + 12); }
#pragma unroll
                for (int bj = 0; bj < 2; ++bj) { f32x4 v0 = acc[ai][bj][m][0], v1 = acc[ai][bj][m][1];
                    if (dorope) { f32x4 o0, o1;
#pragma unroll
                        for (int j = 0; j < 4; ++j) { o0[j] = __shfl_xor(v0[j], 16); o1[j] = __shfl_xor(v1[j], 16); }
                        if (fq == 0) { v0 = v0 * c4[0] - o0 * s4[0]; v1 = v1 * c4[1] - o1 * s4[1]; }
                        else if (fq == 1) { v0 = v0 * c4[0] + o0 * s4[0]; v1 = v1 * c4[1] + o1 * s4[1]; } }
                    v0 = v0 * sc; v1 = v1 * sc; u32x4 w; w.x = cvt_pk_bf16(v0[0], v0[1]); w.y = cvt_pk_bf16(v0[2], v0[3]); w.z = cvt_pk_bf16(v1[0], v1[1]); w.w = cvt_pk_bf16(v1[2], v1[3]);
                    *(u32x4*)(rowp + bj * HALF) = w; } }
    }
};
struct EpiGateA {
    static constexpr bool PERM = true, AFTER_DRAIN = false;
    const bf16_t* proj; float* T;
    __device__ __forceinline__ void operator()(const f32x4 (&acc)[2][2][4][2], const Unit& u, int wr, int wc, int fr, int fq) const {
        const int row0 = u.pm * BM + wr * 64 + fr, col0 = u.pn * BM + wc * 32 + 8 * fq;
#pragma unroll
        for (int ai = 0; ai < 2; ++ai)
#pragma unroll
            for (int m = 0; m < 4; ++m) { const int row = row0 + ai * HALF + m * 16;
#pragma unroll
                for (int bj = 0; bj < 2; ++bj) { const int col = col0 + bj * HALF; const u32x4 g = *(const u32x4*)(proj + (size_t)row * INW + C_GA + col);
                    f32x4 v0 = acc[ai][bj][m][0], v1 = acc[ai][bj][m][1];
                    v0[0] *= sigm(bflo(g.x)); v0[1] *= sigm(bfhi(g.x)); v0[2] *= sigm(bflo(g.y)); v0[3] *= sigm(bfhi(g.y));
                    v1[0] *= sigm(bflo(g.z)); v1[1] *= sigm(bfhi(g.z)); v1[2] *= sigm(bflo(g.w)); v1[3] *= sigm(bfhi(g.w));
                    float* tp = T + (size_t)row * D + col; *(f32x4*)tp = v0; *(f32x4*)(tp + 4) = v1; } }
    }
};
struct EpiGateB {
    static constexpr bool PERM = true, AFTER_DRAIN = false;
    const bf16_t* proj; const float* T; bf16_t* O;
    __device__ __forceinline__ void operator()(const f32x4 (&acc)[2][2][4][2], const Unit& u, int wr, int wc, int fr, int fq) const {
        const int row0 = u.pm * BM + wr * 64 + fr, col0 = u.pn * BM + wc * 32 + 8 * fq;
#pragma unroll
        for (int ai = 0; ai < 2; ++ai)
#pragma unroll
            for (int m = 0; m < 4; ++m) { const int row = row0 + ai * HALF + m * 16;
#pragma unroll
                for (int bj = 0; bj < 2; ++bj) { const int col = col0 + bj * HALF; const u32x4 g = *(const u32x4*)(proj + (size_t)row * INW + C_GB + col);
                    const float* tp = T + (size_t)row * D + col; const f32x4 t0 = *(const f32x4*)tp, t1 = *(const f32x4*)(tp + 4);
                    f32x4 v0 = acc[ai][bj][m][0], v1 = acc[ai][bj][m][1];
                    v0[0] = t0[0] + v0[0] * sigm(bflo(g.x)); v0[1] = t0[1] + v0[1] * sigm(bfhi(g.x)); v0[2] = t0[2] + v0[2] * sigm(bflo(g.y)); v0[3] = t0[3] + v0[3] * sigm(bfhi(g.y));
                    v1[0] = t1[0] + v1[0] * sigm(bflo(g.z)); v1[1] = t1[1] + v1[1] * sigm(bfhi(g.z)); v1[2] = t1[2] + v1[2] * sigm(bflo(g.w)); v1[3] = t1[3] + v1[3] * sigm(bfhi(g.w));
                    u32x4 w; w.x = cvt_pk_bf16(v0[0], v0[1]); w.y = cvt_pk_bf16(v0[2], v0[3]); w.z = cvt_pk_bf16(v1[0], v1[1]); w.w = cvt_pk_bf16(v1[2], v1[3]);
                    *(u32x4*)(O + (size_t)row * D + col) = w; } }
    }
};
struct EpiHout {
    static constexpr bool PERM = true, AFTER_DRAIN = false;
    const float* x; float* H; bf16_t* HB; float* ssq16;
    __device__ __forceinline__ void operator()(const f32x4 (&acc)[2][2][4][2], const Unit& u, int wr, int wc, int fr, int fq) const {
        const int row0 = u.pm * BM + wr * 64 + fr, col0 = u.pn * BM + wc * 32 + 8 * fq;
#pragma unroll
        for (int ai = 0; ai < 2; ++ai)
#pragma unroll
            for (int m = 0; m < 4; ++m) { const int row = row0 + ai * HALF + m * 16; float ss = 0.f;
#pragma unroll
                for (int bj = 0; bj < 2; ++bj) { const int col = col0 + bj * HALF; const float* xp = x + (size_t)row * D + col;
                    const f32x4 v0 = acc[ai][bj][m][0] + *(const f32x4*)xp, v1 = acc[ai][bj][m][1] + *(const f32x4*)(xp + 4);
                    float* hp = H + (size_t)row * D + col; *(f32x4*)hp = v0; *(f32x4*)(hp + 4) = v1;
                    u32x4 w; w.x = cvt_pk_bf16(v0[0], v0[1]); w.y = cvt_pk_bf16(v0[2], v0[3]); w.z = cvt_pk_bf16(v1[0], v1[1]); w.w = cvt_pk_bf16(v1[2], v1[3]);
                    *(u32x4*)(HB + (size_t)row * D + col) = w;
                    ss += (v0[0] * v0[0] + v0[1] * v0[1]) + (v0[2] * v0[2] + v0[3] * v0[3]) + (v1[0] * v1[0] + v1[1] * v1[1]) + (v1[2] * v1[2] + v1[3] * v1[3]); }
                ss += __shfl_xor(ss, 16); ss += __shfl_xor(ss, 32);
                if (fq == 0) ssq16[(size_t)row * 16 + u.pn * 4 + wc] = ss; }
    }
};
struct EpiQ {
    static constexpr bool PERM = true, AFTER_DRAIN = false;
    const float* ssq16; bf16_t* O;
    __device__ __forceinline__ void operator()(const f32x4 (&acc)[2][2][4][2], const Unit& u, int wr, int wc, int fr, int fq) const {
        const int row0 = u.pm * BM + wr * 64 + fr, col0 = u.pn * BM + wc * 32 + 8 * fq;
#pragma unroll
        for (int ai = 0; ai < 2; ++ai)
#pragma unroll
            for (int m = 0; m < 4; ++m) { const int row = row0 + ai * HALF + m * 16; const f32x4* sp = (const f32x4*)(ssq16 + (size_t)row * 16);
                const f32x4 a = sp[0], b = sp[1], c = sp[2], d = sp[3];
                const float tot = ((a[0] + a[1]) + (a[2] + a[3])) + ((b[0] + b[1]) + (b[2] + b[3])) + ((c[0] + c[1]) + (c[2] + c[3])) + ((d[0] + d[1]) + (d[2] + d[3]));
                const float rstd = 1.f / sqrtf(tot * (1.f / D) + EPS);
#pragma unroll
                for (int bj = 0; bj < 2; ++bj) { const f32x4 v0 = acc[ai][bj][m][0] * rstd, v1 = acc[ai][bj][m][1] * rstd;
                    u32x4 w; w.x = cvt_pk_bf16(v0[0], v0[1]); w.y = cvt_pk_bf16(v0[2], v0[3]); w.z = cvt_pk_bf16(v1[0], v1[1]); w.w = cvt_pk_bf16(v1[2], v1[3]);
                    *(u32x4*)(O + (size_t)row * PQ + col0 + bj * HALF) = w; } }
    }
};
template <class Epi, class Sched, bool ALIGN_EPI = false, bool SP2 = false>
__device__ __forceinline__ void gemm_phase(PG8_LAS unsigned char* lds, const Gemm g, const Sched& S, const Epi& E) {
    const int tid = threadIdx.x, wid = __builtin_amdgcn_readfirstlane(tid >> 6), lane = tid & 63, wr = wid >> 2, wc = wid & 3, fr = lane & 15, fq = lane >> 4;
    const int K = g.K, nt = K / BK;
    unsigned voffA[2], voffB[2];
#pragma unroll
    for (int i = 0; i < 2; ++i) { int R, C; stage_rc(tid * 16 + i * 8192, R, C); const int Rb = Epi::PERM ? ((R & ~31) + perm32(R & 31)) : R;
        voffA[i] = (unsigned)(R * K + C) * 2u; voffB[i] = (unsigned)(Rb * K + C) * 2u; }
    const size_t kstep = (size_t)(BK * 2);
    const size_t hstep = (size_t)HALF * K * 2;
    const size_t tstep = 2 * hstep;
    const unsigned ldsw = (unsigned)wid * 1024u;
    const int aoff = lds_byte(wr * 64 + fr, fq * 8), boff = lds_byte(wc * 32 + fr, fq * 8);
#define PG8_SA(b, h) (((b) * 2 + (h)) * HTB)
#define PG8_SB(b, h) ((4 + (b) * 2 + (h)) * HTB)
#define PG8_STAGE(bufoff, gbase, voff) do { _Pragma("unroll") for (int _i = 0; _i < 2; ++_i) \
        __builtin_amdgcn_global_load_lds((const unsigned*)((const char*)(gbase) + (voff)[_i]), (PG8_LAS unsigned*)(lds + (bufoff) + ldsw + _i * 8192), 16, 0, 0); } while (0)
#define PG8_LDA(dst, b, h) do { _Pragma("unroll") for (int m = 0; m < 4; ++m) _Pragma("unroll") for (int k = 0; k < 2; ++k) dst[m][k] = *(const PG8_LAS bf16x8*)(lds + PG8_SA(b, h) + aoff + m * 2048 + k * 1024); } while (0)
#define PG8_LDB(dst, b, h) do { _Pragma("unroll") for (int n = 0; n < 2; ++n) _Pragma("unroll") for (int k = 0; k < 2; ++k) dst[n][k] = *(const PG8_LAS bf16x8*)(lds + PG8_SB(b, h) + boff + n * 2048 + k * 1024); } while (0)
#define PG8_MMA(ai, bj, At, Bt) do { __builtin_amdgcn_s_setprio(1); _Pragma("unroll") for (int m = 0; m < 4; ++m) _Pragma("unroll") for (int n = 0; n < 2; ++n) _Pragma("unroll") for (int k = 0; k < 2; ++k) \
        acc[ai][bj][m][n] = __builtin_amdgcn_mfma_f32_16x16x32_bf16(Bt[n][k], At[m][k], acc[ai][bj][m][n], 0, 0, 0); __builtin_amdgcn_s_setprio(0); } while (0)
#define PG8_WAIT_V(n) asm volatile("s_waitcnt vmcnt(" #n ")" ::: "memory")
#define PG8_WAIT_L(n) asm volatile("s_waitcnt lgkmcnt(" #n ")" ::: "memory")
#define PG8_BAR __builtin_amdgcn_s_barrier()
#define PG8_SCHED __builtin_amdgcn_sched_barrier(0)
    Unit cur, nxt; int ui = 0;
    if (!S.next(0, cur)) return;
    f32x4 acc[2][2][4][2];
#pragma unroll
    for (int a = 0; a < 2; ++a)
#pragma unroll
        for (int b = 0; b < 2; ++b)
#pragma unroll
            for (int m = 0; m < 4; ++m)
#pragma unroll
                for (int n = 0; n < 2; ++n) acc[a][b][m][n] = (f32x4){0.f, 0.f, 0.f, 0.f};
    bf16x8 At[4][2], B0[2][2], B1[2][2];
    const char* cA = (const char*)g.A + (size_t)cur.pm * tstep; const char* cB = (const char*)g.Bt + (size_t)cur.pn * tstep;
    S.a_ready(cur);
    if constexpr (SP2) {
        PG8_STAGE(PG8_SB(0, 0), cB, voffB); PG8_STAGE(PG8_SB(0, 1), cB + hstep, voffB); PG8_STAGE(PG8_SA(0, 0), cA, voffA); PG8_STAGE(PG8_SA(0, 1), cA + hstep, voffA);
        if (wr == 1) PG8_BAR;
        PG8_WAIT_V(2); PG8_BAR;
        PG8_STAGE(PG8_SB(1, 0), cB + kstep, voffB); PG8_STAGE(PG8_SA(1, 0), cA + kstep, voffA); PG8_STAGE(PG8_SB(1, 1), cB + hstep + kstep, voffB);
        PG8_WAIT_V(6); PG8_BAR;
    } else {
        PG8_STAGE(PG8_SB(0, 0), cB, voffB); PG8_STAGE(PG8_SA(0, 0), cA, voffA); PG8_STAGE(PG8_SB(0, 1), cB + hstep, voffB); PG8_STAGE(PG8_SA(0, 1), cA + hstep, voffA);
        if (wr == 1) PG8_BAR;
        PG8_WAIT_V(4); PG8_BAR;
        PG8_STAGE(PG8_SB(1, 0), cB + kstep, voffB); PG8_STAGE(PG8_SA(1, 0), cA + kstep, voffA); PG8_STAGE(PG8_SB(1, 1), cB + hstep + kstep, voffB);
        PG8_WAIT_V(6); PG8_BAR;
    }
    for (;;) {
        const bool has_next = S.next(ui + 1, nxt);
        const char* nA = has_next ? (const char*)g.A + (size_t)nxt.pm * tstep : cA; const char* nB = has_next ? (const char*)g.Bt + (size_t)nxt.pn * tstep : cB;
        for (int t = 0; t < nt; t += 2) {
            const bool last = (t == nt - 2);
            const char* a1 = cA + (size_t)(t + 1) * kstep;
            const char* a2 = last ? nA : cA + (size_t)(t + 2) * kstep; const char* b2 = last ? nB : cB + (size_t)(t + 2) * kstep;
            const char* a3 = a2 + kstep; const char* b3 = b2 + kstep;
            if (last && has_next) S.a_ready(nxt);
            if constexpr (SP2) {
            PG8_LDB(B0, 0, 0); PG8_LDB(B1, 0, 1); PG8_SCHED; PG8_LDA(At, 0, 0); PG8_STAGE(PG8_SA(1, 1), a1 + hstep, voffA);
            PG8_WAIT_V(8); PG8_WAIT_L(0); PG8_BAR; PG8_MMA(0, 0, At, B0); PG8_MMA(0, 1, At, B1); PG8_BAR; PG8_SCHED;
            PG8_LDA(At, 0, 1); PG8_STAGE(PG8_SB(0, 0), b2, voffB); PG8_STAGE(PG8_SB(0, 1), b2 + hstep, voffB); PG8_STAGE(PG8_SA(0, 0), a2, voffA);
            PG8_WAIT_V(8); PG8_WAIT_L(0); PG8_BAR; PG8_MMA(1, 0, At, B0); PG8_MMA(1, 1, At, B1); PG8_BAR; PG8_SCHED;
            PG8_LDB(B0, 1, 0); PG8_LDB(B1, 1, 1); PG8_SCHED; PG8_LDA(At, 1, 0); PG8_STAGE(PG8_SA(0, 1), a2 + hstep, voffA);
            PG8_WAIT_V(8); PG8_WAIT_L(0); PG8_BAR; PG8_MMA(0, 0, At, B0); PG8_MMA(0, 1, At, B1); PG8_BAR; PG8_SCHED;
            PG8_LDA(At, 1, 1); PG8_STAGE(PG8_SB(1, 0), b3, voffB); PG8_STAGE(PG8_SB(1, 1), b3 + hstep, voffB); PG8_STAGE(PG8_SA(1, 0), a3, voffA);
            PG8_WAIT_V(8); PG8_WAIT_L(0); PG8_BAR; PG8_MMA(1, 0, At, B0); PG8_MMA(1, 1, At, B1); PG8_BAR; PG8_SCHED;
            } else {
            PG8_LDB(B0, 0, 0); PG8_SCHED; PG8_LDA(At, 0, 0); PG8_STAGE(PG8_SA(1, 1), a1 + hstep, voffA);
            PG8_WAIT_L(8); PG8_BAR; PG8_WAIT_L(0); PG8_MMA(0, 0, At, B0); PG8_BAR; PG8_SCHED;
            PG8_LDB(B1, 0, 1); PG8_STAGE(PG8_SB(0, 0), b2, voffB);
            PG8_BAR; PG8_WAIT_L(0); PG8_MMA(0, 1, At, B1); PG8_BAR;
            PG8_LDA(At, 0, 1); PG8_STAGE(PG8_SA(0, 0), a2, voffA);
            PG8_BAR; PG8_WAIT_L(0); PG8_MMA(1, 0, At, B0); PG8_BAR; PG8_SCHED;
            PG8_STAGE(PG8_SB(0, 1), b2 + hstep, voffB);
            PG8_WAIT_V(6); PG8_BAR; PG8_MMA(1, 1, At, B1); PG8_BAR;
            PG8_LDB(B0, 1, 0); PG8_SCHED; PG8_LDA(At, 1, 0); PG8_STAGE(PG8_SA(0, 1), a2 + hstep, voffA);
            PG8_WAIT_L(8); PG8_BAR; PG8_WAIT_L(0); PG8_MMA(0, 0, At, B0); PG8_BAR; PG8_SCHED;
            PG8_LDB(B1, 1, 1); PG8_STAGE(PG8_SB(1, 0), b3, voffB);
            PG8_BAR; PG8_WAIT_L(0); PG8_MMA(0, 1, At, B1); PG8_BAR;
            PG8_LDA(At, 1, 1); PG8_STAGE(PG8_SA(1, 0), a3, voffA);
            PG8_BAR; PG8_WAIT_L(0); PG8_MMA(1, 0, At, B0); PG8_BAR; PG8_SCHED;
            PG8_STAGE(PG8_SB(1, 1), b3 + hstep, voffB);
            PG8_WAIT_V(6); PG8_BAR; PG8_MMA(1, 1, At, B1); PG8_BAR;
            }
        }
        if constexpr (ALIGN_EPI) { if (wr == 0) PG8_BAR; }
        if constexpr (!Epi::AFTER_DRAIN) { E(acc, cur, wr, wc, fr, fq); S.done(cur); }
        if (!has_next) break;
#pragma unroll
        for (int a = 0; a < 2; ++a)
#pragma unroll
            for (int b = 0; b < 2; ++b)
#pragma unroll
                for (int m = 0; m < 4; ++m)
#pragma unroll
                    for (int n = 0; n < 2; ++n) acc[a][b][m][n] = (f32x4){0.f, 0.f, 0.f, 0.f};
        cur = nxt; cA = nA; cB = nB; ++ui;
        if constexpr (ALIGN_EPI) { if (wr == 1) PG8_BAR; }
    }
    PG8_WAIT_V(0);
    if constexpr (!ALIGN_EPI) { if (wr == 0) PG8_BAR; }
    PG8_BAR;
    if constexpr (Epi::AFTER_DRAIN) { E.fused(acc, cur, wr, wc, fr, fq, lds, wid, lane); S.done(cur); }
#undef PG8_SA
#undef PG8_SB
#undef PG8_STAGE
#undef PG8_LDA
#undef PG8_LDB
#undef PG8_MMA
#undef PG8_WAIT_V
#undef PG8_WAIT_L
#undef PG8_BAR
#undef PG8_SCHED
}
}

template <class Epi> __global__ void __launch_bounds__(512, 2) k_gemm(pg8::Gemm g, Epi E) {
    extern __shared__ __attribute__((aligned(16))) unsigned char lds_dyn[];
    pg8::StaticOrder S; S.init(g.M, g.N, (int)gridDim.x, (int)blockIdx.x);
    pg8::gemm_phase<Epi, pg8::StaticOrder, true, true>((PG8_LAS unsigned char*)lds_dyn, g, S, E);
}

__device__ __forceinline__ float lambda_full(const Ptrs& P) {
    float a = 0.f, b = 0.f;
    for (int i = 0; i < 64; ++i) { a += P.lq1[i] * P.lk1[i]; b += P.lq2[i] * P.lk2[i]; }
    return __expf(a) - __expf(b) + 0.2f;
}

namespace att {
typedef short bf16x8 __attribute__((ext_vector_type(8)));
typedef short s16x4 __attribute__((ext_vector_type(4)));
typedef float f32x16 __attribute__((ext_vector_type(16)));
typedef float f32x2_t __attribute__((ext_vector_type(2)));
typedef __attribute__((address_space(3))) const char* lds_cptr;
typedef __attribute__((address_space(3))) char* lds_ptr;
__device__ __forceinline__ int crow(int r, int hi) { return (r & 3) + 8 * (r >> 2) + 4 * hi; }
__device__ __forceinline__ void glds16(const void* gsrc, unsigned lds_dst) { unsigned keep;
    asm volatile("s_mov_b32 %0, m0\n\ts_mov_b32 m0, %2\n\ts_nop 0\n\tglobal_load_lds_dwordx4 %1, off\n\ts_mov_b32 m0, %0" : "=&s"(keep) : "v"(gsrc), "s"(lds_dst) : "memory"); }
__device__ __forceinline__ unsigned cvtpk(float lo, float hi) { f32x2_t v = {lo, hi}; bf16x2_t b = __builtin_convertvector(v, bf16x2_t); return __builtin_bit_cast(unsigned, b); }
#define ATT_WAIT_BAR(N) asm volatile("s_waitcnt vmcnt(" #N ") lgkmcnt(0)\n\ts_barrier" ::: "memory")
#define ATT_LDSWAIT() asm volatile("s_waitcnt lgkmcnt(0)" ::: "memory")
#define ATT_SBAR() __builtin_amdgcn_sched_barrier(0)
__device__ __forceinline__ void qkt(f32x16& p0, f32x16& p1, lds_cptr Kslot, const bf16x8* qr, int r32, int hi) {
    lds_cptr kb = Kslot + hi * 1024 + r32 * 16;
    p0 = f32x16{}; p1 = f32x16{};
#pragma unroll
    for (int d0 = 0; d0 < 4; ++d0) {
        const bf16x8 b0 = *(const __attribute__((address_space(3))) bf16x8*)(kb + d0 * 2048);
        const bf16x8 b1 = *(const __attribute__((address_space(3))) bf16x8*)(kb + d0 * 2048 + 512);
        p0 = __builtin_amdgcn_mfma_f32_32x32x16_bf16(b0, qr[d0], p0, 0, 0, 0); p1 = __builtin_amdgcn_mfma_f32_32x32x16_bf16(b1, qr[d0], p1, 0, 0, 0); }
}
__device__ __forceinline__ float rowmax32(const f32x16& p0, const f32x16& p1) {
    float a = fmaxf(p0[0], p1[0]);
#pragma unroll
    for (int r = 1; r < 16; ++r) a = fmaxf(a, fmaxf(p0[r], p1[r]));
    auto rr = __builtin_amdgcn_permlane32_swap(__float_as_uint(a), __float_as_uint(a), false, false);
    return fmaxf(__uint_as_float(rr[0]), __uint_as_float(rr[1]));
}
__device__ __forceinline__ float halfsum(float a) { auto rr = __builtin_amdgcn_permlane32_swap(__float_as_uint(a), __float_as_uint(a), false, false); return __uint_as_float(rr[0]) + __uint_as_float(rr[1]); }
template <int ND0> __device__ __forceinline__ void pv(f32x16* o, int vb, bf16x8 pa0, bf16x8 pa1, bf16x8 pa2, bf16x8 pa3) {
#pragma unroll
    for (int d0 = 0; d0 < ND0; ++d0) { s16x4 lo[4], hi[4];
#pragma unroll
        for (int ks = 0; ks < 4; ++ks) {
            asm volatile("ds_read_b64_tr_b16 %0,%1 offset:%c2" : "=&v"(lo[ks]) : "v"(vb), "i"(d0 * 4096 + ks * 1024) : "memory");
            asm volatile("ds_read_b64_tr_b16 %0,%1 offset:%c2" : "=&v"(hi[ks]) : "v"(vb), "i"(d0 * 4096 + ks * 1024 + 512) : "memory"); }
        asm volatile("s_waitcnt lgkmcnt(0)" ::: "memory"); ATT_SBAR();
#define ATT_PK(k) (bf16x8){lo[k][0], lo[k][1], lo[k][2], lo[k][3], hi[k][0], hi[k][1], hi[k][2], hi[k][3]}
        o[d0] = __builtin_amdgcn_mfma_f32_32x32x16_bf16(pa0, ATT_PK(0), o[d0], 0, 0, 0);
        o[d0] = __builtin_amdgcn_mfma_f32_32x32x16_bf16(pa1, ATT_PK(1), o[d0], 0, 0, 0);
        o[d0] = __builtin_amdgcn_mfma_f32_32x32x16_bf16(pa2, ATT_PK(2), o[d0], 0, 0, 0);
        o[d0] = __builtin_amdgcn_mfma_f32_32x32x16_bf16(pa3, ATT_PK(3), o[d0], 0, 0, 0);
#undef ATT_PK
    }
}
template <int ND0, int THR> __device__ __forceinline__ void softmax_tile(f32x16& p0, f32x16& p1, float& mrun, float& lsum, f32x16* o, __attribute__((address_space(3))) float* wsf, int r32, int hi,
                                                                   u32x4& pw0, u32x4& pw1, u32x4& pw2, u32x4& pw3) {
    const float rm = rowmax32(p0, p1);
    if (__any(rm > mrun + (float)THR)) {
        const float mn = fmaxf(mrun, rm), alpha = __builtin_amdgcn_exp2f(mrun - mn); lsum *= alpha; mrun = mn;
        if (hi == 0) wsf[r32] = alpha;
        ATT_LDSWAIT();
#pragma unroll
        for (int g = 0; g < 4; ++g) { const f32x4 a4 = *(const __attribute__((address_space(3))) f32x4*)(wsf + 8 * g + 4 * hi);
#pragma unroll
            for (int d0 = 0; d0 < ND0; ++d0) { o[d0][4 * g + 0] *= a4[0]; o[d0][4 * g + 1] *= a4[1]; o[d0][4 * g + 2] *= a4[2]; o[d0][4 * g + 3] *= a4[3]; } }
        ATT_LDSWAIT();
    }
    float s = 0.f;
#pragma unroll
    for (int r = 0; r < 16; ++r) { p0[r] = __builtin_amdgcn_exp2f(p0[r] - mrun); p1[r] = __builtin_amdgcn_exp2f(p1[r] - mrun); s += p0[r] + p1[r]; }
    lsum += s;
    pw0 = (u32x4){cvtpk(p0[0], p0[1]), cvtpk(p0[2], p0[3]), cvtpk(p0[4], p0[5]), cvtpk(p0[6], p0[7])};
    pw1 = (u32x4){cvtpk(p0[8], p0[9]), cvtpk(p0[10], p0[11]), cvtpk(p0[12], p0[13]), cvtpk(p0[14], p0[15])};
    pw2 = (u32x4){cvtpk(p1[0], p1[1]), cvtpk(p1[2], p1[3]), cvtpk(p1[4], p1[5]), cvtpk(p1[6], p1[7])};
    pw3 = (u32x4){cvtpk(p1[8], p1[9]), cvtpk(p1[10], p1[11]), cvtpk(p1[12], p1[13]), cvtpk(p1[14], p1[15])};
}

constexpr int A_SLOTK = 8192, A_SLOTV = 16384, A_NS = 3;
constexpr int A_LDS_K = 0, A_LDS_V = A_NS * A_SLOTK, A_LDS_WS = A_LDS_V + A_NS * A_SLOTV, A_LDS_ST = A_LDS_WS + 8 * 256, A_LDS_BYTES = A_LDS_ST + 8 * 8192;
__device__ __forceinline__ void attn_a_unit(int b, int h, int qb, const bf16_t* proj, bf16_t* ya, const float* subln, float lam, unsigned char* shm) {
    const int tid = threadIdx.x, lane = tid & 63, r32 = lane & 31, hi = lane >> 5; const int wid = __builtin_amdgcn_readfirstlane(tid >> 6);
    const size_t rowbase = (size_t)b * SEQ; const int q0 = qb * 256;
    constexpr int NT = SEQ / 64;
    const unsigned lds0 = (unsigned)(uintptr_t)shm;
    const lds_cptr shm3 = (lds_cptr)shm;
    __attribute__((address_space(3))) float* wsf = (__attribute__((address_space(3))) float*)((lds_ptr)shm + A_LDS_WS) + wid * 64;
    const int vb0 = (int)(lds0 + A_LDS_V) + ((lane >> 4) & 1) * 32 + (lane & 3) * 8 + (4 * hi + ((lane & 15) >> 2)) * 64;
    __attribute__((address_space(3))) bf16_t* stg = (__attribute__((address_space(3))) bf16_t*)((lds_ptr)shm + A_LDS_ST) + wid * 4096;
    for (int mp = 0; mp < 2; ++mp) {
        const bf16_t* Kh = proj + rowbase * INW + C_KA + h * 128 + mp * 64;
        const bf16_t* Vh = proj + rowbase * INW + C_VA + h * 128;
        const bf16_t* Qw = proj + (rowbase + q0 + wid * 32) * INW + C_QA + h * 128 + mp * 64;
        const int pA = 2 * wid, pB = 2 * wid + 1;
        const unsigned kdst = lds0 + A_LDS_K + wid * 1024, vdstA = lds0 + A_LDS_V + pA * 1024, vdstB = lds0 + A_LDS_V + pB * 1024;
#define A_DMA(t, slot) do { int ln_ = lane; asm volatile("" : "+v"(ln_)); \
        const bf16_t* ksrc_ = Kh + (size_t)((t) * 64 + ln_) * INW + wid * 8; \
        const bf16_t* vsrcA_ = Vh + (size_t)((t) * 64 + 16 * (pA & 3) + (ln_ >> 2)) * INW + (pA >> 2) * 32 + (ln_ & 3) * 8; \
        const bf16_t* vsrcB_ = Vh + (size_t)((t) * 64 + 16 * (pB & 3) + (ln_ >> 2)) * INW + (pB >> 2) * 32 + (ln_ & 3) * 8; \
        glds16(ksrc_, (unsigned)__builtin_amdgcn_readfirstlane(kdst + (slot) * A_SLOTK)); \
        glds16(vsrcA_, (unsigned)__builtin_amdgcn_readfirstlane(vdstA + (slot) * A_SLOTV)); \
        glds16(vsrcB_, (unsigned)__builtin_amdgcn_readfirstlane(vdstB + (slot) * A_SLOTV)); } while (0)
        A_DMA(0, 0); A_DMA(1, 1);
        bf16x8 qr[4];
#pragma unroll
        for (int d0 = 0; d0 < 4; ++d0) qr[d0] = *(const bf16x8*)(Qw + (size_t)r32 * INW + d0 * 16 + hi * 8);
        f32x16 o[4]; o[0] = f32x16{}; o[1] = f32x16{}; o[2] = f32x16{}; o[3] = f32x16{};
        float mrun = -1e30f, lsum = 0.f;
        int slot = 0, slot2 = 2;
        for (int t = 0; t < NT; ++t) {
            if (t + 1 < NT) { ATT_WAIT_BAR(3); } else { ATT_WAIT_BAR(0); }
            if (t + 2 < NT) A_DMA(t + 2, slot2);
            f32x16 p0, p1; u32x4 pw0, pw1, pw2, pw3;
            qkt(p0, p1, shm3 + A_LDS_K + slot * A_SLOTK, qr, r32, hi);
            softmax_tile<4, 8>(p0, p1, mrun, lsum, o, wsf, r32, hi, pw0, pw1, pw2, pw3);
            pv<4>(o, vb0 + slot * A_SLOTV, __builtin_bit_cast(bf16x8, pw0), __builtin_bit_cast(bf16x8, pw1), __builtin_bit_cast(bf16x8, pw2), __builtin_bit_cast(bf16x8, pw3));
            slot = (slot == 2) ? 0 : slot + 1; slot2 = (slot2 == 2) ? 0 : slot2 + 1;
        }
#undef A_DMA
        const float lt = halfsum(lsum);
        if (hi == 0) wsf[32 + r32] = lt;
        ATT_LDSWAIT();
        float rli[16];
#pragma unroll
        for (int g = 0; g < 4; ++g) { const f32x4 l4 = *(const __attribute__((address_space(3))) f32x4*)(wsf + 32 + 8 * g + 4 * hi);
            rli[4 * g + 0] = __builtin_amdgcn_rcpf(l4[0]); rli[4 * g + 1] = __builtin_amdgcn_rcpf(l4[1]); rli[4 * g + 2] = __builtin_amdgcn_rcpf(l4[2]); rli[4 * g + 3] = __builtin_amdgcn_rcpf(l4[3]); }
        ATT_LDSWAIT();
        if (mp == 0) {
#pragma unroll
            for (int d0 = 0; d0 < 4; ++d0)
#pragma unroll
                for (int r = 0; r < 16; ++r) stg[crow(r, hi) * 128 + d0 * 32 + r32] = (bf16_t)f2bf(o[d0][r] * rli[r]);
            asm volatile("s_waitcnt lgkmcnt(0)\n\ts_barrier" ::: "memory");
        } else {
            float ss[16];
#pragma unroll
            for (int r = 0; r < 16; ++r) ss[r] = 0.f;
#pragma unroll
            for (int d0 = 0; d0 < 4; ++d0)
#pragma unroll
                for (int r = 0; r < 16; ++r) { const float a = bf2f(stg[crow(r, hi) * 128 + d0 * 32 + r32]); const float y = a - lam * o[d0][r] * rli[r]; o[d0][r] = y; ss[r] += y * y; }
#pragma unroll
            for (int r = 0; r < 16; ++r) { float v = ss[r]; v += __shfl_xor(v, 1); v += __shfl_xor(v, 2); v += __shfl_xor(v, 4); v += __shfl_xor(v, 8); v += __shfl_xor(v, 16);
                ss[r] = 0.8f / sqrtf(v * (1.f / 128.f) + EPS); }
            ATT_LDSWAIT();
#pragma unroll
            for (int d0 = 0; d0 < 4; ++d0) { const float gsub = subln[d0 * 32 + r32];
#pragma unroll
                for (int r = 0; r < 16; ++r) stg[crow(r, hi) * 128 + d0 * 32 + r32] = (bf16_t)f2bf(o[d0][r] * ss[r] * gsub); }
            ATT_LDSWAIT();
            bf16_t* Yw = ya + (rowbase + q0 + wid * 32) * 512 + h * 128;
#pragma unroll
            for (int i = 0; i < 8; ++i) { const int row = i * 4 + (lane >> 4), ch = lane & 15; const u32x4 v = *(const __attribute__((address_space(3))) u32x4*)(stg + row * 128 + ch * 8); *(u32x4*)(Yw + (size_t)row * 512 + ch * 8) = v; }
            asm volatile("s_waitcnt lgkmcnt(0)\n\ts_barrier" ::: "memory");
        }
    }
}

constexpr int B_SLOT = 8192, B_NS = 3;
constexpr int B_LDS_K = 0, B_LDS_V = B_NS * B_SLOT, B_LDS_WS = 2 * B_NS * B_SLOT, B_LDS_BIAS = B_LDS_WS + 8 * 256, B_LDS_ST = B_LDS_BIAS + 2048, B_LDS_BYTES = B_LDS_ST + 8 * 4096;
__device__ __forceinline__ void attn_b_unit(int b, int h, int rg, const bf16_t* proj, bf16_t* yb, const float* rpb, unsigned char* shm) {
    const int tid = threadIdx.x, lane = tid & 63, r32 = lane & 31, hi = lane >> 5; const int wid = __builtin_amdgcn_readfirstlane(tid >> 6);
    const size_t rowbase = (size_t)b * SEQ;
    const int r = 4 * rg + (wid >> 1), c0 = 32 * (wid & 1);
    int rs = r - 4; rs = rs < 0 ? 0 : (rs > 24 ? 24 : rs);
    int rmin = 4 * rg - 4; rmin = rmin < 0 ? 0 : (rmin > 24 ? 24 : rmin);
    int rmaxs = 4 * rg + 3 - 4; rmaxs = rmaxs < 0 ? 0 : (rmaxs > 24 ? 24 : rmaxs);
    const int ntile = rmaxs + 8 - rmin;
    const unsigned lds0 = (unsigned)(uintptr_t)shm;
    const lds_cptr shm3 = (lds_cptr)shm;
    __attribute__((address_space(3))) float* wsf = (__attribute__((address_space(3))) float*)((lds_ptr)shm + B_LDS_WS) + wid * 64;
    __attribute__((address_space(3))) float* bias = (__attribute__((address_space(3))) float*)((lds_ptr)shm + B_LDS_BIAS);
    __attribute__((address_space(3))) bf16_t* stg = (__attribute__((address_space(3))) bf16_t*)((lds_ptr)shm + B_LDS_ST) + wid * 2048;
    const int vb0 = (int)(lds0 + B_LDS_V) + ((lane >> 4) & 1) * 32 + (lane & 3) * 8 + (4 * hi + ((lane & 15) >> 2)) * 64;
    if (tid < 480) { const int ri = tid >> 5, cj = tid & 31; bias[tid] = (cj < 31) ? rpb[(h * 15 + ri) * 31 + cj] * LOG2E : 0.f; }
    const bf16_t* Kh = proj + rowbase * INW + C_KB + h * 64;
    const bf16_t* Vh = proj + rowbase * INW + C_VB + h * 64;
    const bf16_t* Qw = proj + (rowbase + r * 64 + c0) * INW + C_QB + h * 64;
    const unsigned kdst = lds0 + B_LDS_K + wid * 1024, vdst = lds0 + B_LDS_V + wid * 1024;
#define B_DMA(t, slot) do { int ln_ = lane; asm volatile("" : "+v"(ln_)); \
    const bf16_t* ksrc_ = Kh + (size_t)((rmin + (t)) * 64 + ln_) * INW + wid * 8; \
    const bf16_t* vsrc_ = Vh + (size_t)((rmin + (t)) * 64 + 16 * (wid & 3) + (ln_ >> 2)) * INW + (wid >> 2) * 32 + (ln_ & 3) * 8; \
    glds16(ksrc_, (unsigned)__builtin_amdgcn_readfirstlane(kdst + (slot) * B_SLOT)); \
    glds16(vsrc_, (unsigned)__builtin_amdgcn_readfirstlane(vdst + (slot) * B_SLOT)); } while (0)
    B_DMA(0, 0); B_DMA(1, 1);
    bf16x8 qr[4];
#pragma unroll
    for (int d0 = 0; d0 < 4; ++d0) qr[d0] = *(const bf16x8*)(Qw + (size_t)r32 * INW + d0 * 16 + hi * 8);
    f32x16 o[2]; o[0] = f32x16{}; o[1] = f32x16{};
    float mrun = -1e30f, lsum = 0.f;
    const int c = c0 + r32; int cs = c - 8; cs = cs < 0 ? 0 : (cs > 48 ? 48 : cs);
    int slot = 0, slot2 = 2;
    for (int t = 0; t < ntile; ++t) {
        if (t + 1 < ntile) { ATT_WAIT_BAR(2); } else { ATT_WAIT_BAR(0); }
        if (t + 2 < ntile) B_DMA(t + 2, slot2);
        const int kr = rmin + t;
        if (kr >= rs && kr < rs + 8) {
            f32x16 p0, p1; u32x4 pw0, pw1, pw2, pw3;
            qkt(p0, p1, shm3 + B_LDS_K + slot * B_SLOT, qr, r32, hi);
            const int bbase = (kr - r + 7) * 32 + 15 - c;
#pragma unroll
            for (int rr = 0; rr < 16; ++rr) { const int j0 = crow(rr, hi), j1 = j0 + 32;
                const bool v0 = (unsigned)(j0 - cs) < 16u, v1 = (unsigned)(j1 - cs) < 16u;
                const float b0 = bias[v0 ? bbase + j0 : 0], b1 = bias[v1 ? bbase + j1 : 0];
                p0[rr] = v0 ? p0[rr] + b0 : -1e30f; p1[rr] = v1 ? p1[rr] + b1 : -1e30f; }
            softmax_tile<2, 8>(p0, p1, mrun, lsum, o, wsf, r32, hi, pw0, pw1, pw2, pw3);
            pv<2>(o, vb0 + slot * B_SLOT, __builtin_bit_cast(bf16x8, pw0), __builtin_bit_cast(bf16x8, pw1), __builtin_bit_cast(bf16x8, pw2), __builtin_bit_cast(bf16x8, pw3));
        }
        slot = (slot == 2) ? 0 : slot + 1; slot2 = (slot2 == 2) ? 0 : slot2 + 1;
    }
#undef B_DMA
    const float lt = halfsum(lsum);
    if (hi == 0) wsf[32 + r32] = lt;
    ATT_LDSWAIT();
    float rli[16];
#pragma unroll
    for (int g = 0; g < 4; ++g) { const f32x4 l4 = *(const __attribute__((address_space(3))) f32x4*)(wsf + 32 + 8 * g + 4 * hi);
        rli[4 * g + 0] = __builtin_amdgcn_rcpf(l4[0]); rli[4 * g + 1] = __builtin_amdgcn_rcpf(l4[1]); rli[4 * g + 2] = __builtin_amdgcn_rcpf(l4[2]); rli[4 * g + 3] = __builtin_amdgcn_rcpf(l4[3]); }
#pragma unroll
    for (int d0 = 0; d0 < 2; ++d0)
#pragma unroll
        for (int rr = 0; rr < 16; ++rr) stg[crow(rr, hi) * 64 + d0 * 32 + r32] = (bf16_t)f2bf(o[d0][rr] * rli[rr]);
    ATT_LDSWAIT();
    bf16_t* Yw = yb + (rowbase + r * 64 + c0) * 512 + h * 64;
#pragma unroll
    for (int i = 0; i < 4; ++i) { const int row = i * 8 + (lane >> 3), ch = lane & 7; const u32x4 v = *(const __attribute__((address_space(3))) u32x4*)(stg + row * 64 + ch * 8); *(u32x4*)(Yw + (size_t)row * 512 + ch * 8) = v; }
    asm volatile("s_waitcnt lgkmcnt(0)\n\ts_barrier" ::: "memory");
}
}

__global__ void __launch_bounds__(512, 2) k_attn_a(Ptrs P) {
    extern __shared__ __attribute__((aligned(16))) unsigned char lds_dyn[];
    const float lam = lambda_full(P);
    const int G = gridDim.x, bx = blockIdx.x, vcu = (G % 8 == 0) ? (bx % 8) * (G / 8) + bx / 8 : bx;
    for (int u = vcu; u < BATCH * 4 * 8; u += G)
        att::attn_a_unit(u >> 5, (u >> 3) & 3, u & 7, (const bf16_t*)(P.ws + WS_PROJ), (bf16_t*)(P.ws + WS_YA), P.subln, lam, lds_dyn);
}


__global__ void __launch_bounds__(512, 2) k_attn_b(Ptrs P) {
    extern __shared__ __attribute__((aligned(16))) unsigned char lds_dyn[];
    const int G = gridDim.x, bx = blockIdx.x, vcu = (G % 8 == 0) ? (bx % 8) * (G / 8) + bx / 8 : bx;
    for (int u = vcu; u < BATCH * 8 * 8; u += G)
        att::attn_b_unit(u >> 6, (u >> 3) & 7, u & 7, (const bf16_t*)(P.ws + WS_PROJ), (bf16_t*)(P.ws + WS_YB), P.rpb, lds_dyn);
}

__global__ void __launch_bounds__(256) k_attn_a_naive(Ptrs P) {
    const bf16_t* proj = (const bf16_t*)(P.ws + WS_PROJ);
    const int gt = blockIdx.x * 256 + threadIdx.x;
    const int ch = gt & 3, q = (gt >> 2) & 2047, h = (gt >> 13) & 3, b = gt >> 15;
    const float lam = lambda_full(P);
    const size_t qrow = (size_t)b * SEQ + q;
    float y[32];
#pragma unroll
    for (int j = 0; j < 32; ++j) y[j] = 0.f;
    for (int m = 0; m < 2; ++m) {
        float qv[64];
        const bf16_t* qp = proj + qrow * INW + C_QA + h * 128 + m * 64;
#pragma unroll
        for (int d = 0; d < 64; ++d) qv[d] = bf2f(qp[d]);
        float mx = -1e30f, l = 0.f, acc[32];
#pragma unroll
        for (int j = 0; j < 32; ++j) acc[j] = 0.f;
        for (int k = 0; k < SEQ; ++k) {
            const size_t krow = (size_t)b * SEQ + k;
            const bf16_t* kp = proj + krow * INW + C_KA + h * 128 + m * 64;
            float s = 0.f;
#pragma unroll
            for (int d8 = 0; d8 < 8; ++d8) { const u32x4 kv = *(const u32x4*)(kp + d8 * 8);
                s += qv[d8 * 8 + 0] * bflo(kv.x); s += qv[d8 * 8 + 1] * bfhi(kv.x); s += qv[d8 * 8 + 2] * bflo(kv.y); s += qv[d8 * 8 + 3] * bfhi(kv.y);
                s += qv[d8 * 8 + 4] * bflo(kv.z); s += qv[d8 * 8 + 5] * bfhi(kv.z); s += qv[d8 * 8 + 6] * bflo(kv.w); s += qv[d8 * 8 + 7] * bfhi(kv.w); }
            if (s > mx) { const float f = exp2f(mx - s); l *= f;
#pragma unroll
                for (int j = 0; j < 32; ++j) acc[j] *= f;
                mx = s; }
            const float p = exp2f(s - mx); l += p;
            const bf16_t* vp = proj + krow * INW + C_VA + h * 128 + ch * 32;
#pragma unroll
            for (int d8 = 0; d8 < 4; ++d8) { const u32x4 vv = *(const u32x4*)(vp + d8 * 8);
                acc[d8 * 8 + 0] += p * bflo(vv.x); acc[d8 * 8 + 1] += p * bfhi(vv.x); acc[d8 * 8 + 2] += p * bflo(vv.y); acc[d8 * 8 + 3] += p * bfhi(vv.y);
                acc[d8 * 8 + 4] += p * bflo(vv.z); acc[d8 * 8 + 5] += p * bfhi(vv.z); acc[d8 * 8 + 6] += p * bflo(vv.w); acc[d8 * 8 + 7] += p * bfhi(vv.w); }
        }
        const float il = 1.f / l, sg = (m == 0) ? 1.f : -lam;
#pragma unroll
        for (int j = 0; j < 32; ++j) y[j] += sg * acc[j] * il;
    }
    float ss = 0.f;
#pragma unroll
    for (int j = 0; j < 32; ++j) ss += y[j] * y[j];
    ss += __shfl_xor(ss, 1); ss += __shfl_xor(ss, 2);
    const float rstd = 1.f / sqrtf(ss * (1.f / 128.f) + EPS) * 0.8f;
    bf16_t* yo = (bf16_t*)(P.ws + WS_YA) + qrow * 512 + h * 128 + ch * 32;
#pragma unroll
    for (int j = 0; j < 32; ++j) yo[j] = (bf16_t)f2bf(y[j] * rstd * P.subln[ch * 32 + j]);
}
__global__ void __launch_bounds__(256) k_attn_b_naive(Ptrs P) {
    const bf16_t* proj = (const bf16_t*)(P.ws + WS_PROJ);
    const int gt = blockIdx.x * 256 + threadIdx.x;
    const int c = gt & 63, r = (gt >> 6) & 31, h = (gt >> 11) & 7, b = gt >> 14;
    const size_t qrow = (size_t)b * SEQ + r * 64 + c;
    float qv[64];
    const bf16_t* qp = proj + qrow * INW + C_QB + h * 64;
#pragma unroll
    for (int d = 0; d < 64; ++d) qv[d] = bf2f(qp[d]);
    int rs = r - 4; rs = rs < 0 ? 0 : (rs > 24 ? 24 : rs);
    int cs = c - 8; cs = cs < 0 ? 0 : (cs > 48 ? 48 : cs);
    float mx = -1e30f, l = 0.f, acc[64];
#pragma unroll
    for (int j = 0; j < 64; ++j) acc[j] = 0.f;
    for (int i = 0; i < 8; ++i)
        for (int j = 0; j < 16; ++j) {
            const size_t krow = (size_t)b * SEQ + (rs + i) * 64 + (cs + j);
            const bf16_t* kp = proj + krow * INW + C_KB + h * 64;
            float s = 0.f;
#pragma unroll
            for (int d8 = 0; d8 < 8; ++d8) { const u32x4 kv = *(const u32x4*)(kp + d8 * 8);
                s += qv[d8 * 8 + 0] * bflo(kv.x); s += qv[d8 * 8 + 1] * bfhi(kv.x); s += qv[d8 * 8 + 2] * bflo(kv.y); s += qv[d8 * 8 + 3] * bfhi(kv.y);
                s += qv[d8 * 8 + 4] * bflo(kv.z); s += qv[d8 * 8 + 5] * bfhi(kv.z); s += qv[d8 * 8 + 6] * bflo(kv.w); s += qv[d8 * 8 + 7] * bfhi(kv.w); }
            s += LOG2E * P.rpb[(h * 15 + (rs + i - r + 7)) * 31 + (cs + j - c + 15)];
            if (s > mx) { const float f = exp2f(mx - s); l *= f;
#pragma unroll
                for (int jj = 0; jj < 64; ++jj) acc[jj] *= f;
                mx = s; }
            const float p = exp2f(s - mx); l += p;
            const bf16_t* vp = proj + krow * INW + C_VB + h * 64;
#pragma unroll
            for (int d8 = 0; d8 < 8; ++d8) { const u32x4 vv = *(const u32x4*)(vp + d8 * 8);
                acc[d8 * 8 + 0] += p * bflo(vv.x); acc[d8 * 8 + 1] += p * bfhi(vv.x); acc[d8 * 8 + 2] += p * bflo(vv.y); acc[d8 * 8 + 3] += p * bfhi(vv.y);
                acc[d8 * 8 + 4] += p * bflo(vv.z); acc[d8 * 8 + 5] += p * bfhi(vv.z); acc[d8 * 8 + 6] += p * bflo(vv.w); acc[d8 * 8 + 7] += p * bfhi(vv.w); }
        }
    const float il = 1.f / l;
    bf16_t* yo = (bf16_t*)(P.ws + WS_YB) + qrow * 512 + h * 64;
#pragma unroll
    for (int j = 0; j < 64; ++j) yo[j] = (bf16_t)f2bf(acc[j] * il);
}
__global__ void __launch_bounds__(64) k_topk1_naive(Ptrs P) {
    __shared__ float sc[128][64];
    const int tid = threadIdx.x, gt = blockIdx.x * 64 + tid;
    const int t = gt & (M - 1), hp = gt >> 14;
    const bf16_t* qp = (const bf16_t*)(P.ws + WS_Q) + (size_t)t * PQ + hp * 128;
    const bf16_t* sk = (const bf16_t*)(P.ws + WS_SK) + (size_t)hp * 128 * 128;
    float qv[128];
#pragma unroll
    for (int d = 0; d < 128; ++d) qv[d] = bf2f(qp[d]);
    for (int k = 0; k < 128; ++k) {
        float s = 0.f;
#pragma unroll
        for (int d8 = 0; d8 < 16; ++d8) { const u32x4 kv = *(const u32x4*)(sk + k * 128 + d8 * 8);
            s += qv[d8 * 8 + 0] * bflo(kv.x); s += qv[d8 * 8 + 1] * bfhi(kv.x); s += qv[d8 * 8 + 2] * bflo(kv.y); s += qv[d8 * 8 + 3] * bfhi(kv.y);
            s += qv[d8 * 8 + 4] * bflo(kv.z); s += qv[d8 * 8 + 5] * bfhi(kv.z); s += qv[d8 * 8 + 6] * bflo(kv.w); s += qv[d8 * 8 + 7] * bfhi(kv.w); }
        sc[k][tid] = s;
    }
    float pv = 3e38f; int pk = -1;
    float* tv = (float*)(P.ws + WS_TOPV) + ((size_t)t * 16 + hp) * 16; int* ti = (int*)(P.ws + WS_TOPI) + ((size_t)t * 16 + hp) * 16;
    for (int j = 0; j < 16; ++j) {
        float bv = -3e38f; int bk = -1;
        for (int k = 0; k < 128; ++k) { const float v = sc[k][tid]; const bool below = (v < pv) || (v == pv && k > pk); if (below && v > bv) { bv = v; bk = k; } }
        tv[j] = bv; ti[j] = bk; pv = bv; pk = bk;
    }
}
__global__ void __launch_bounds__(256) k_topk2_naive(Ptrs P) {
    const int gt = blockIdx.x * 256 + threadIdx.x;
    const float* tv = (const float*)(P.ws + WS_TOPV) + (size_t)gt * 32; const int* ti = (const int*)(P.ws + WS_TOPI) + (size_t)gt * 32;
    float v0[16], v1[16]; int i0[16], i1[16];
#pragma unroll
    for (int j = 0; j < 16; ++j) { v0[j] = tv[j]; v1[j] = tv[16 + j]; i0[j] = ti[j]; i1[j] = ti[16 + j]; }
    float* go = (float*)(P.ws + WS_G) + (size_t)gt * 16; int* io = (int*)(P.ws + WS_IDX) + (size_t)gt * 16;
    float pv = 3e38f; int pk = -1; float s0 = 0.f, esum = 0.f;
    for (int j = 0; j < 16; ++j) {
        float bv = -3e38f; int bk = -1, bidx = 0;
        int iz; asm volatile("v_mov_b32 %0, 0" : "=v"(iz));
#pragma unroll
        for (int a = 0; a < 16; ++a)
#pragma unroll
            for (int b = 0; b < 16; ++b) { const float v = v0[a] + __int_as_float(__float_as_int(v1[b]) | iz); const int k = a * 16 + b; const bool below = (v < pv) || (v == pv && k > pk);
                if (below && v > bv) { bv = v; bk = k; bidx = (i0[a] | iz) * 128 + i1[b]; } }
        if (j == 0) s0 = bv;
        const float e = __expf(bv - s0); esum += e;
        go[j] = e; io[j] = bidx; pv = bv; pk = bk;
    }
    const float inv = 1.f / esum;
#pragma unroll
    for (int j = 0; j < 16; ++j) go[j] *= inv;
}
__global__ void __launch_bounds__(256) k_peer_apply(Ptrs P) {
    const int lane = threadIdx.x & 63, sub = lane & 15, g = lane >> 4;
    const int t = blockIdx.x * 4 + (threadIdx.x >> 6);
    const float* hrow = P.out + (size_t)t * D;
    const float* ssq = (const float*)(P.ws + WS_SSQ) + (size_t)t * 16;
    float tot = 0.f;
#pragma unroll
    for (int i = 0; i < 16; ++i) tot += ssq[i];
    const float rstd = 1.f / sqrtf(tot * (1.f / D) + EPS);
    unsigned xh[8][4]; float hv[8][8];
#pragma unroll
    for (int i = 0; i < 8; ++i) { const int e0 = (sub + 16 * i) * 8;
        const f32x4 a = *(const f32x4*)(hrow + e0), b = *(const f32x4*)(hrow + e0 + 4);
        const f32x4 ga = *(const f32x4*)(P.norm_ffn + e0), gb = *(const f32x4*)(P.norm_ffn + e0 + 4);
        hv[i][0] = a.x; hv[i][1] = a.y; hv[i][2] = a.z; hv[i][3] = a.w; hv[i][4] = b.x; hv[i][5] = b.y; hv[i][6] = b.z; hv[i][7] = b.w;
        xh[i][0] = pk2(a.x * rstd * ga.x, a.y * rstd * ga.y); xh[i][1] = pk2(a.z * rstd * ga.z, a.w * rstd * ga.w);
        xh[i][2] = pk2(b.x * rstd * gb.x, b.y * rstd * gb.y); xh[i][3] = pk2(b.z * rstd * gb.z, b.w * rstd * gb.w); }
    const int* idxp = (const int*)(P.ws + WS_IDX) + (size_t)t * 128; const float* gp = (const float*)(P.ws + WS_G) + (size_t)t * 128;
    const int id0 = idxp[lane], id1 = idxp[64 + lane]; const float g0 = gp[lane], g1 = gp[64 + lane];
    const bf16_t* U = (const bf16_t*)(P.ws + WS_U); const bf16_t* V = (const bf16_t*)(P.ws + WS_V);
    float acc[8][8];
#pragma unroll
    for (int i = 0; i < 8; ++i)
#pragma unroll
        for (int e = 0; e < 8; ++e) acc[i][e] = 0.f;
    for (int j = 0; j < 32; ++j) {
        const int src = (4 * j + g) & 63;
        const int e = (j < 16) ? __shfl(id0, src) : __shfl(id1, src);
        const float gate = (j < 16) ? __shfl(g0, src) : __shfl(g1, src);
        const bf16_t* ur = U + (size_t)e * D; const bf16_t* vr = V + (size_t)e * D;
        u32x4 uu[8], vv[8];
#pragma unroll
        for (int i = 0; i < 8; ++i) { uu[i] = *(const u32x4*)(ur + (sub + 16 * i) * 8); vv[i] = *(const u32x4*)(vr + (sub + 16 * i) * 8); }
        float d = 0.f;
#pragma unroll
        for (int i = 0; i < 8; ++i) {
            d += bflo(uu[i].x) * bflo(xh[i][0]) + bfhi(uu[i].x) * bfhi(xh[i][0]); d += bflo(uu[i].y) * bflo(xh[i][1]) + bfhi(uu[i].y) * bfhi(xh[i][1]);
            d += bflo(uu[i].z) * bflo(xh[i][2]) + bfhi(uu[i].z) * bfhi(xh[i][2]); d += bflo(uu[i].w) * bflo(xh[i][3]) + bfhi(uu[i].w) * bfhi(xh[i][3]); }
        d += __shfl_xor(d, 1); d += __shfl_xor(d, 2); d += __shfl_xor(d, 4); d += __shfl_xor(d, 8);
        const float c = gate * gelu_exact(d);
#pragma unroll
        for (int i = 0; i < 8; ++i) {
            acc[i][0] += c * bflo(vv[i].x); acc[i][1] += c * bfhi(vv[i].x); acc[i][2] += c * bflo(vv[i].y); acc[i][3] += c * bfhi(vv[i].y);
            acc[i][4] += c * bflo(vv[i].z); acc[i][5] += c * bfhi(vv[i].z); acc[i][6] += c * bflo(vv[i].w); acc[i][7] += c * bfhi(vv[i].w); }
    }
    float ss = 0.f;
#pragma unroll
    for (int i = 0; i < 8; ++i)
#pragma unroll
        for (int e = 0; e < 8; ++e) { float a = acc[i][e]; a += __shfl_xor(a, 16); a += __shfl_xor(a, 32); a += hv[i][e]; acc[i][e] = a; ss += a * a; }
    ss += __shfl_xor(ss, 1); ss += __shfl_xor(ss, 2); ss += __shfl_xor(ss, 4); ss += __shfl_xor(ss, 8);
    const float r2 = 1.f / sqrtf(ss * (1.f / D) + EPS);
    float* orow = P.out + (size_t)t * D;
#pragma unroll
    for (int i = 0; i < 8; ++i) if ((i & 3) == g) { const int e0 = (sub + 16 * i) * 8;
        const f32x4 ga = *(const f32x4*)(P.norm_final + e0), gb = *(const f32x4*)(P.norm_final + e0 + 4);
        f32x4 o0, o1; o0.x = acc[i][0] * r2 * ga.x; o0.y = acc[i][1] * r2 * ga.y; o0.z = acc[i][2] * r2 * ga.z; o0.w = acc[i][3] * r2 * ga.w;
        o1.x = acc[i][4] * r2 * gb.x; o1.y = acc[i][5] * r2 * gb.y; o1.z = acc[i][6] * r2 * gb.z; o1.w = acc[i][7] * r2 * gb.w;
        *(f32x4*)(orow + e0) = o0; *(f32x4*)(orow + e0 + 4) = o1; }
}

extern "C" void kernel_launch(void* const* d_in, const int* in_sizes, int n_in, void* d_out, int out_size, void* d_ws, size_t ws_size, hipStream_t stream) {
    if (n_in != 18 || ws_size < WS_END) { fprintf(stderr, "kernel_launch: unexpected n_in %d / ws_size %zu\n", n_in, ws_size); return; }
    Ptrs P{};
    P.x = (const float*)d_in[0]; P.w_in = (const float*)d_in[1]; P.w_pa = (const float*)d_in[2]; P.w_pb = (const float*)d_in[3]; P.w_out = (const float*)d_in[4];
    P.norm_mix = (const float*)d_in[5]; P.norm_ffn = (const float*)d_in[6]; P.norm_final = (const float*)d_in[7];
    P.lq1 = (const float*)d_in[8]; P.lk1 = (const float*)d_in[9]; P.lq2 = (const float*)d_in[10]; P.lk2 = (const float*)d_in[11];
    P.subln = (const float*)d_in[12]; P.rpb = (const float*)d_in[13]; P.w_query = (const float*)d_in[14]; P.sub_keys = (const float*)d_in[15];
    P.peer_u = (const float*)d_in[16]; P.peer_v = (const float*)d_in[17];
    P.out = (float*)d_out; P.ws = (unsigned char*)d_ws;
    unsigned char* ws = P.ws;
    k_prep<<<1024, 256, 0, stream>>>(P);
    constexpr int GEMM_LDS = pg8::STAGE_BYTES;
    const int G = 256;
    static bool attr_done = false;
    if (!attr_done) { attr_done = true;
    hipFuncSetAttribute((const void*)k_gemm<pg8::EpiProj>, hipFuncAttributeMaxDynamicSharedMemorySize, GEMM_LDS);
    hipFuncSetAttribute((const void*)k_gemm<pg8::EpiGateA>, hipFuncAttributeMaxDynamicSharedMemorySize, GEMM_LDS);
    hipFuncSetAttribute((const void*)k_gemm<pg8::EpiGateB>, hipFuncAttributeMaxDynamicSharedMemorySize, GEMM_LDS);
    hipFuncSetAttribute((const void*)k_gemm<pg8::EpiHout>, hipFuncAttributeMaxDynamicSharedMemorySize, GEMM_LDS);
    hipFuncSetAttribute((const void*)k_gemm<pg8::EpiQ>, hipFuncAttributeMaxDynamicSharedMemorySize, GEMM_LDS);
    hipFuncSetAttribute((const void*)k_attn_a, hipFuncAttributeMaxDynamicSharedMemorySize, att::A_LDS_BYTES);
    hipFuncSetAttribute((const void*)k_attn_b, hipFuncAttributeMaxDynamicSharedMemorySize, att::B_LDS_BYTES); }
    k_gemm<pg8::EpiProj><<<G, 512, GEMM_LDS, stream>>>(pg8::Gemm{(const bf16_t*)(ws + WS_XN), (const bf16_t*)(ws + WS_WIN), M, INW, D, 0}, pg8::EpiProj{(bf16_t*)(ws + WS_PROJ), (const float*)(ws + WS_ROPE)});
    k_attn_a<<<G, 512, att::A_LDS_BYTES, stream>>>(P);
    k_attn_b<<<G, 512, att::B_LDS_BYTES, stream>>>(P);
    k_gemm<pg8::EpiGateA><<<G, 512, GEMM_LDS, stream>>>(pg8::Gemm{(const bf16_t*)(ws + WS_YA), (const bf16_t*)(ws + WS_WPA), M, D, 512, 0}, pg8::EpiGateA{(const bf16_t*)(ws + WS_PROJ), P.out});
    k_gemm<pg8::EpiGateB><<<G, 512, GEMM_LDS, stream>>>(pg8::Gemm{(const bf16_t*)(ws + WS_YB), (const bf16_t*)(ws + WS_WPB), M, D, 512, 0}, pg8::EpiGateB{(const bf16_t*)(ws + WS_PROJ), P.out, (bf16_t*)(ws + WS_MERGED)});
    k_gemm<pg8::EpiHout><<<G, 512, GEMM_LDS, stream>>>(pg8::Gemm{(const bf16_t*)(ws + WS_MERGED), (const bf16_t*)(ws + WS_WOUT), M, D, D, 0}, pg8::EpiHout{P.x, P.out, (bf16_t*)(ws + WS_HB), (float*)(ws + WS_SSQ)});
    k_gemm<pg8::EpiQ><<<G, 512, GEMM_LDS, stream>>>(pg8::Gemm{(const bf16_t*)(ws + WS_HB), (const bf16_t*)(ws + WS_WQ), M, PQ, D, 0}, pg8::EpiQ{(const float*)(ws + WS_SSQ), (bf16_t*)(ws + WS_Q)});
    k_cvt_experts<<<2048, 256, 0, stream>>>(P);
    k_topk1_naive<<<M * 16 / 64, 64, 0, stream>>>(P);
    k_topk2_naive<<<M * 8 / 256, 256, 0, stream>>>(P);
    k_peer_apply<<<M / 4, 256, 0, stream>>>(P);
}
```

```cpp
#include <hip/hip_runtime.h>
#include <cstdio>
#include <cstdint>

typedef unsigned short bf16_t;
typedef unsigned u32x4 __attribute__((ext_vector_type(4)));
typedef unsigned u32x2 __attribute__((ext_vector_type(2)));
typedef float f32x4 __attribute__((ext_vector_type(4)));
typedef __bf16 bf16x2_t __attribute__((ext_vector_type(2)));

constexpr int D = 1024, BATCH = 8, SEQ = 2048, M = BATCH * SEQ, INW = 5120;
constexpr int C_QA = 0, C_KA = 512, C_VA = 1024, C_QB = 1536, C_KB = 2048, C_VB = 2560, C_GA = 3072, C_GB = 4096;
constexpr int NEXP = 16384, PQ = 2048;
constexpr float EPS = 1e-6f;
constexpr float LOG2E = 1.4426950408889634f;
constexpr float QSCALE = 0.125f * LOG2E;

constexpr size_t MiB = 1u << 20;
constexpr size_t WS_PROJ = 0;
constexpr size_t WS_HB = 0;
constexpr size_t WS_Q = 32 * MiB;
constexpr size_t WS_U = 96 * MiB;
constexpr size_t WS_V = 128 * MiB;
constexpr size_t WS_XN = 160 * MiB;
constexpr size_t WS_YA = 160 * MiB;
constexpr size_t WS_YB = 176 * MiB;
constexpr size_t WS_IDX = 160 * MiB;
constexpr size_t WS_G = 168 * MiB;
constexpr size_t WS_MERGED = 192 * MiB;
constexpr size_t WS_TOPV = 192 * MiB;
constexpr size_t WS_TOPI = 208 * MiB;
constexpr size_t WS_WIN = 224 * MiB;
constexpr size_t WS_WQ = 234 * MiB;
constexpr size_t WS_WOUT = 238 * MiB;
constexpr size_t WS_WPA = 240 * MiB;
constexpr size_t WS_WPB = 241 * MiB;
constexpr size_t WS_SK = 242 * MiB;
constexpr size_t WS_ROPE = 242 * MiB + 512 * 1024;
constexpr size_t WS_SSQ = 243 * MiB;
constexpr size_t WS_CTL = 244 * MiB;
constexpr size_t WS_END = 256 * MiB;

__device__ __forceinline__ float bf2f(unsigned v) { return __uint_as_float(v << 16); }
__device__ __forceinline__ float bflo(unsigned w) { return __uint_as_float(w << 16); }
__device__ __forceinline__ float bfhi(unsigned w) { return __uint_as_float(w & 0xffff0000u); }
__device__ __forceinline__ unsigned f2bf(float f) { unsigned u = __float_as_uint(f); return (u + 0x7fffu + ((u >> 16) & 1u)) >> 16; }
__device__ __forceinline__ unsigned pk2(float lo, float hi) { return f2bf(lo) | (f2bf(hi) << 16); }
__device__ __forceinline__ float wave_sum(float v) {
#pragma unroll
    for (int o = 1; o < 64; o <<= 1) v += __shfl_xor(v, o);
    return v;
}
__device__ __forceinline__ float sigmoidf_(float x) { return 1.f / (1.f + __expf(-x)); }
__device__ __forceinline__ float gelu_exact(float x) { return 0.5f * x * (1.f + erff(x * 0.70710678118654752f)); }

struct Ptrs {
    const float *x, *w_in, *w_pa, *w_pb, *w_out, *norm_mix, *norm_ffn, *norm_final, *lq1, *lk1, *lq2, *lk2, *subln, *rpb, *w_query, *sub_keys, *peer_u, *peer_v;
    float* out; unsigned char* ws;
};

__device__ __forceinline__ void transpose_item(const float* W, int K, int N, const float* gain, bf16_t* WT, float* scr, int item, int lane) {
    const int nblk = N / 32, kb = item / nblk, nb = item % nblk, k0 = 64 * kb, n0 = 32 * nb;
#pragma unroll 8
    for (int i = 0; i < 32; ++i) { const int kk = 2 * i + (lane >> 5); float w = W[(size_t)(k0 + kk) * N + n0 + (lane & 31)]; if (gain) w *= gain[k0 + kk]; scr[kk * 33 + (lane & 31)] = w; }
    asm volatile("s_waitcnt lgkmcnt(0)" ::: "memory");
    const int c = lane & 7;
#pragma unroll
    for (int j = 0; j < 4; ++j) { const int n = (lane >> 3) + 8 * j; const float* s = scr + (8 * c) * 33 + n;
        u32x4 o; o.x = pk2(s[0 * 33], s[1 * 33]); o.y = pk2(s[2 * 33], s[3 * 33]); o.z = pk2(s[4 * 33], s[5 * 33]); o.w = pk2(s[6 * 33], s[7 * 33]);
        *(u32x4*)(WT + (size_t)(n0 + n) * K + k0 + 8 * c) = o; }
    asm volatile("s_waitcnt lgkmcnt(0)" ::: "memory");
}
__device__ __forceinline__ void cvt8(const float* src, bf16_t* dst, size_t i8) {
    const f32x4 a = *(const f32x4*)(src + i8 * 8), b = *(const f32x4*)(src + i8 * 8 + 4);
    u32x4 o; o.x = pk2(a.x, a.y); o.y = pk2(a.z, a.w); o.z = pk2(b.x, b.y); o.w = pk2(b.z, b.w);
    *(u32x4*)(dst + i8 * 8) = o;
}
__device__ __forceinline__ void rms_row_to_bf16(const float* xrow, bf16_t* orow, int lane) {
    const f32x4* xr = (const f32x4*)xrow + lane;
    f32x4 v[4]; float s = 0.f;
#pragma unroll
    for (int j = 0; j < 4; ++j) { v[j] = xr[64 * j]; s += (v[j].x * v[j].x + v[j].y * v[j].y) + (v[j].z * v[j].z + v[j].w * v[j].w); }
    const float rstd = 1.f / sqrtf(wave_sum(s) * (1.f / D) + EPS);
    u32x2* o8 = (u32x2*)orow + lane;
#pragma unroll
    for (int j = 0; j < 4; ++j) { u32x2 w; w.x = pk2(v[j].x * rstd, v[j].y * rstd); w.y = pk2(v[j].z * rstd, v[j].w * rstd); o8[64 * j] = w; }
}

__global__ void __launch_bounds__(256) k_prep(Ptrs P) {
    __shared__ float scr_all[4][64 * 33];
    const int lane = threadIdx.x & 63, wave = threadIdx.x >> 6;
    const int gw = blockIdx.x * 4 + wave, NGW = gridDim.x * 4;
    float* scr = scr_all[wave];
    unsigned char* ws = P.ws;
    constexpr int I_IN = (D / 64) * (INW / 32), I_Q = (D / 64) * (PQ / 32), I_OUT = (D / 64) * (D / 32), I_PA = (512 / 64) * (D / 32);
    constexpr int NIT = I_IN + I_Q + I_OUT + 2 * I_PA;
    for (int it = gw; it < NIT; it += NGW) {
        int r = it;
        if (r < I_IN) { transpose_item(P.w_in, D, INW, P.norm_mix, (bf16_t*)(ws + WS_WIN), scr, r, lane); continue; } r -= I_IN;
        if (r < I_Q) { transpose_item(P.w_query, D, PQ, P.norm_ffn, (bf16_t*)(ws + WS_WQ), scr, r, lane); continue; } r -= I_Q;
        if (r < I_OUT) { transpose_item(P.w_out, D, D, nullptr, (bf16_t*)(ws + WS_WOUT), scr, r, lane); continue; } r -= I_OUT;
        if (r < I_PA) { transpose_item(P.w_pa, 512, D, nullptr, (bf16_t*)(ws + WS_WPA), scr, r, lane); continue; } r -= I_PA;
        transpose_item(P.w_pb, 512, D, nullptr, (bf16_t*)(ws + WS_WPB), scr, r, lane);
    }
    for (int m = gw; m < M; m += NGW) rms_row_to_bf16(P.x + (size_t)m * D, (bf16_t*)(ws + WS_XN) + (size_t)m * D, lane);
    const size_t gt = (size_t)blockIdx.x * 256 + threadIdx.x, NT = (size_t)gridDim.x * 256;
    for (size_t i = gt; i < (size_t)16 * 128 * 128 / 8; i += NT) cvt8(P.sub_keys, (bf16_t*)(ws + WS_SK), i);
    for (size_t i = gt; i < (size_t)SEQ * 8; i += NT) {
        const int pos = (int)(i >> 3), k = (int)(i & 7);
        const float inv = (float)pow(500000.0, -(double)k / 8.0);
        const float ang = (float)pos * inv;
        float* t = (float*)(ws + WS_ROPE) + (size_t)pos * 16;
        t[k] = (float)cos((double)ang); t[8 + k] = (float)sin((double)ang);
    }
}
__global__ void __launch_bounds__(256) k_cvt_experts(Ptrs P) {
    const size_t gt = (size_t)blockIdx.x * 256 + threadIdx.x, NT = (size_t)gridDim.x * 256;
    for (size_t i = gt; i < (size_t)NEXP * D / 8; i += NT) { cvt8(P.peer_u, (bf16_t*)(P.ws + WS_U), i); cvt8(P.peer_v, (bf16_t*)(P.ws + WS_V), i); }
}

namespace pg8 {
#define PG8_LAS __attribute__((address_space(3)))
typedef unsigned short bf16_t;
typedef short bf16x8 __attribute__((ext_vector_type(8)));
typedef float f32x4 __attribute__((ext_vector_type(4)));
typedef unsigned u32x4 __attribute__((ext_vector_type(4)));
constexpr int BM = 256, BK = 64, HALF = 128, HTB = HALF * BK * 2  , STAGE_BYTES = 8 * HTB, NXCD = 8, WGM = 8;

__host__ __device__ __forceinline__ int lds_byte(int r, int c) { const int st = (r >> 4) * 2 + (c >> 5), rr = r & 15, cc = c & 31, ob = rr * 64 + cc * 2; return st * 1024 + (ob ^ (((ob >> 9) & 1) << 5)); }
__host__ __device__ __forceinline__ void stage_rc(int b, int& R, int& C) { const int st = b / 1024, sb = b % 1024, swz = sb ^ (((sb >> 9) & 1) << 5); R = (st >> 1) * 16 + swz / 64; C = (st & 1) * 32 + (swz % 64) / 2; }
__host__ __device__ __forceinline__ int perm32(int rho) { const int n = rho >> 4, i = rho & 15; return 8 * (i >> 2) + 4 * n + (i & 3); }

struct Unit { int pm, pn; };
struct Gemm { const bf16_t* A; const bf16_t* Bt; int M, N, K, pad; };

struct StaticOrder {
    int nM, nN, nwg, G, c;
    __host__ __device__ void init(int M, int N, int G_, int c_) { nM = M / BM; nN = N / BM; nwg = nM * nN; G = G_; c = c_; }
    __host__ __device__ bool next(int i, Unit& u) const {
        const long L = (long)i * G + c; if (L >= nwg) return false;
        int wgid = (int)L; { const int q = nwg / NXCD, r = nwg % NXCD, xcd = wgid % NXCD, off = wgid / NXCD; wgid = (xcd < r ? xcd * (q + 1) : r * (q + 1) + (xcd - r) * q) + off; }
        const int nig = WGM * nN, gid = wgid / nig, fm = gid * WGM, gsz = (nM - fm) < WGM ? (nM - fm) : WGM;
        u.pm = fm + ((wgid % nig) % gsz); u.pn = (wgid % nig) / gsz; return true;
    }
    __device__ __forceinline__ void a_ready(const Unit&) const {}
    __device__ __forceinline__ void done(const Unit&) const {}
};
__device__ __forceinline__ unsigned cvt_pk_bf16(float lo, float hi) { unsigned r; asm volatile("v_cvt_pk_bf16_f32 %0, %1, %2" : "=v"(r) : "v"(lo), "v"(hi)); return r; }
typedef float f32x2 __attribute__((ext_vector_type(2)));

__device__ __forceinline__ float sigm(float x) { return __builtin_amdgcn_rcpf(1.f + __builtin_amdgcn_exp2f(-1.4426950408889634f * x)); }
struct EpiProj {
    static constexpr bool PERM = true, AFTER_DRAIN = false;
    bf16_t* O; const float* rope;
    __device__ __forceinline__ void operator()(const f32x4 (&acc)[2][2][4][2], const Unit& u, int wr, int wc, int fr, int fq) const {
        const int row0 = u.pm * BM + wr * 64 + fr, col0 = u.pn * BM + wc * 32 + 8 * fq;
        const float sc = (u.pn < 2 || u.pn == 6 || u.pn == 7) ? QSCALE : 1.f;
        const bool dorope = (u.pn < 4) && ((wc & 1) == 0);
#pragma unroll
        for (int ai = 0; ai < 2; ++ai)
#pragma unroll
            for (int m = 0; m < 4; ++m) { const int row = row0 + ai * HALF + m * 16; bf16_t* rowp = O + (size_t)row * INW + col0;
                f32x4 c4[2] = {{1.f, 1.f, 1.f, 1.f}, {1.f, 1.f, 1.f, 1.f}}, s4[2] = {{0.f, 0.f, 0.f, 0.f}, {0.f, 0.f, 0.f, 0.f}};
                if (dorope) { const float* rp = rope + (size_t)(row & (SEQ - 1)) * 16; c4[0] = *(const f32x4*)(rp); c4[1] = *(const f32x4*)(rp + 4); s4[0] = *(const f32x4*)(rp + 8); s4[1] = *(const f32x4*)(rp + 12); }
#pragma unroll
                for (int bj = 0; bj < 2; ++bj) { f32x4 v0 = acc[ai][bj][m][0], v1 = acc[ai][bj][m][1];
                    if (dorope) { f32x4 o0, o1;
#pragma unroll
                        for (int j = 0; j < 4; ++j) { o0[j] = __shfl_xor(v0[j], 16); o1[j] = __shfl_xor(v1[j], 16); }
                        if (fq == 0) { v0 = v0 * c4[0] - o0 * s4[0]; v1 = v1 * c4[1] - o1 * s4[1]; }
                        else if (fq == 1) { v0 = v0 * c4[0] + o0 * s4[0]; v1 = v1 * c4[1] + o1 * s4[1]; } }
                    v0 = v0 * sc; v1 = v1 * sc; u32x4 w; w.x = cvt_pk_bf16(v0[0], v0[1]); w.y = cvt_pk_bf16(v0[2], v0[3]); w.z = cvt_pk_bf16(v1[0], v1[1]); w.w = cvt_pk_bf16(v1[2], v1[3]);
                    *(u32x4*)(rowp + bj * HALF) = w; } }
    }
};
struct EpiGateA {
    static constexpr bool PERM = true, AFTER_DRAIN = false;
    const bf16_t* proj; float* T;
    __device__ __forceinline__ void operator()(const f32x4 (&acc)[2][2][4][2], const Unit& u, int wr, int wc, int fr, int fq) const {
        const int row0 = u.pm * BM + wr * 64 + fr, col0 = u.pn * BM + wc * 32 + 8 * fq;
#pragma unroll
        for (int ai = 0; ai < 2; ++ai)
#pragma unroll
            for (int m = 0; m < 4; ++m) { const int row = row0 + ai * HALF + m * 16;
#pragma unroll
                for (int bj = 0; bj < 2; ++bj) { const int col = col0 + bj * HALF; const u32x4 g = *(const u32x4*)(proj + (size_t)row * INW + C_GA + col);
                    f32x4 v0 = acc[ai][bj][m][0], v1 = acc[ai][bj][m][1];
                    v0[0] *= sigm(bflo(g.x)); v0[1] *= sigm(bfhi(g.x)); v0[2] *= sigm(bflo(g.y)); v0[3] *= sigm(bfhi(g.y));
                    v1[0] *= sigm(bflo(g.z)); v1[1] *= sigm(bfhi(g.z)); v1[2] *= sigm(bflo(g.w)); v1[3] *= sigm(bfhi(g.w));
                    float* tp = T + (size_t)row * D + col; *(f32x4*)tp = v0; *(f32x4*)(tp + 4) = v1; } }
    }
};
struct EpiGateB {
    static constexpr bool PERM = true, AFTER_DRAIN = false;
    const bf16_t* proj; const float* T; bf16_t* O;
    __device__ __forceinline__ void operator()(const f32x4 (&acc)[2][2][4][2], const Unit& u, int wr, int wc, int fr, int fq) const {
        const int row0 = u.pm * BM + wr * 64 + fr, col0 = u.pn * BM + wc * 32 + 8 * fq;
#pragma unroll
        for (int ai = 0; ai < 2; ++ai)
#pragma unroll
            for (int m = 0; m < 4; ++m) { const int row = row0 + ai * HALF + m * 16;
#pragma unroll
                for (int bj = 0; bj < 2; ++bj) { const int col = col0 + bj * HALF; const u32x4 g = *(const u32x4*)(proj + (size_t)row * INW + C_GB + col);
                    const float* tp = T + (size_t)row * D + col; const f32x4 t0 = *(const f32x4*)tp, t1 = *(const f32x4*)(tp + 4);
                    f32x4 v0 = acc[ai][bj][m][0], v1 = acc[ai][bj][m][1];
                    v0[0] = t0[0] + v0[0] * sigm(bflo(g.x)); v0[1] = t0[1] + v0[1] * sigm(bfhi(g.x)); v0[2] = t0[2] + v0[2] * sigm(bflo(g.y)); v0[3] = t0[3] + v0[3] * sigm(bfhi(g.y));
                    v1[0] = t1[0] + v1[0] * sigm(bflo(g.z)); v1[1] = t1[1] + v1[1] * sigm(bfhi(g.z)); v1[2] = t1[2] + v1[2] * sigm(bflo(g.w)); v1[3] = t1[3] + v1[3] * sigm(bfhi(g.w));
                    u32x4 w; w.x = cvt_pk_bf16(v0[0], v0[1]); w.y = cvt_pk_bf16(v0[2], v0[3]); w.z = cvt_pk_bf16(v1[0], v1[1]); w.w = cvt_pk_bf16(v1[2], v1[3]);
                    *(u32x4*)(O + (size_t)row * D + col) = w; } }
    }
};
struct EpiHout {
    static constexpr bool PERM = true, AFTER_DRAIN = false;
    const float* x; float* H; bf16_t* HB; float* ssq16;
    __device__ __forceinline__ void operator()(const f32x4 (&acc)[2][2][4][2], const Unit& u, int wr, int wc, int fr, int fq) const {
        const int row0 = u.pm * BM + wr * 64 + fr, col0 = u.pn * BM + wc * 32 + 8 * fq;
#pragma unroll
        for (int ai = 0; ai < 2; ++ai)
#pragma unroll
            for (int m = 0; m < 4; ++m) { const int row = row0 + ai * HALF + m * 16; float ss = 0.f;
#pragma unroll
                for (int bj = 0; bj < 2; ++bj) { const int col = col0 + bj * HALF; const float* xp = x + (size_t)row * D + col;
                    const f32x4 v0 = acc[ai][bj][m][0] + *(const f32x4*)xp, v1 = acc[ai][bj][m][1] + *(const f32x4*)(xp + 4);
                    float* hp = H + (size_t)row * D + col; *(f32x4*)hp = v0; *(f32x4*)(hp + 4) = v1;
                    u32x4 w; w.x = cvt_pk_bf16(v0[0], v0[1]); w.y = cvt_pk_bf16(v0[2], v0[3]); w.z = cvt_pk_bf16(v1[0], v1[1]); w.w = cvt_pk_bf16(v1[2], v1[3]);
                    *(u32x4*)(HB + (size_t)row * D + col) = w;
                    ss += (v0[0] * v0[0] + v0[1] * v0[1]) + (v0[2] * v0[2] + v0[3] * v0[3]) + (v1[0] * v1[0] + v1[1] * v1[1]) + (v1[2] * v1[2] + v1[3] * v1[3]); }
                ss += __shfl_xor(ss, 16); ss += __shfl_xor(ss, 32);
                if (fq == 0) ssq16[(size_t)row * 16 + u.pn * 4 + wc] = ss; }
    }
};
struct EpiQ {
    static constexpr bool PERM = true, AFTER_DRAIN = false;
    const float* ssq16; bf16_t* O;
    __device__ __forceinline__ void operator()(const f32x4 (&acc)[2][2][4][2], const Unit& u, int wr, int wc, int fr, int fq) const {
        const int row0 = u.pm * BM + wr * 64 + fr, col0 = u.pn * BM + wc * 32 + 8 * fq;
#pragma unroll
        for (int ai = 0; ai < 2; ++ai)
#pragma unroll
            for (int m = 0; m < 4; ++m) { const int row = row0 + ai * HALF + m * 16; const f32x4* sp = (const f32x4*)(ssq16 + (size_t)row * 16);
                const f32x4 a = sp[0], b = sp[1], c = sp[2], d = sp[3];
                const float tot = ((a[0] + a[1]) + (a[2] + a[3])) + ((b[0] + b[1]) + (b[2] + b[3])) + ((c[0] + c[1]) + (c[2] + c[3])) + ((d[0] + d[1]) + (d[2] + d[3]));
                const float rstd = 1.f / sqrtf(tot * (1.f / D) + EPS);
#pragma unroll
                for (int bj = 0; bj < 2; ++bj) { const f32x4 v0 = acc[ai][bj][m][0] * rstd, v1 = acc[ai][bj][m][1] * rstd;
                    u32x4 w; w.x = cvt_pk_bf16(v0[0], v0[1]); w.y = cvt_pk_bf16(v0[2], v0[3]); w.z = cvt_pk_bf16(v1[0], v1[1]); w.w = cvt_pk_bf16(v1[2], v1[3]);
                    *(u32x4*)(O + (size_t)row * PQ + col0 + bj * HALF) = w; } }
    }
};
template <class Epi, class Sched, bool ALIGN_EPI = false, bool SP2 = false>
__device__ __forceinline__ void gemm_phase(PG8_LAS unsigned char* lds, const Gemm g, const Sched& S, const Epi& E) {
    const int tid = threadIdx.x, wid = __builtin_amdgcn_readfirstlane(tid >> 6), lane = tid & 63, wr = wid >> 2, wc = wid & 3, fr = lane & 15, fq = lane >> 4;
    const int K = g.K, nt = K / BK;
    unsigned voffA[2], voffB[2];
#pragma unroll
    for (int i = 0; i < 2; ++i) { int R, C; stage_rc(tid * 16 + i * 8192, R, C); const int Rb = Epi::PERM ? ((R & ~31) + perm32(R & 31)) : R;
        voffA[i] = (unsigned)(R * K + C) * 2u; voffB[i] = (unsigned)(Rb * K + C) * 2u; }
    const size_t kstep = (size_t)(BK * 2);
    const size_t hstep = (size_t)HALF * K * 2;
    const size_t tstep = 2 * hstep;
    const unsigned ldsw = (unsigned)wid * 1024u;
    const int aoff = lds_byte(wr * 64 + fr, fq * 8), boff = lds_byte(wc * 32 + fr, fq * 8);
#define PG8_SA(b, h) (((b) * 2 + (h)) * HTB)
#define PG8_SB(b, h) ((4 + (b) * 2 + (h)) * HTB)
#define PG8_STAGE(bufoff, gbase, voff) do { _Pragma("unroll") for (int _i = 0; _i < 2; ++_i) \
        __builtin_amdgcn_global_load_lds((const unsigned*)((const char*)(gbase) + (voff)[_i]), (PG8_LAS unsigned*)(lds + (bufoff) + ldsw + _i * 8192), 16, 0, 0); } while (0)
#define PG8_LDA(dst, b, h) do { _Pragma("unroll") for (int m = 0; m < 4; ++m) _Pragma("unroll") for (int k = 0; k < 2; ++k) dst[m][k] = *(const PG8_LAS bf16x8*)(lds + PG8_SA(b, h) + aoff + m * 2048 + k * 1024); } while (0)
#define PG8_LDB(dst, b, h) do { _Pragma("unroll") for (int n = 0; n < 2; ++n) _Pragma("unroll") for (int k = 0; k < 2; ++k) dst[n][k] = *(const PG8_LAS bf16x8*)(lds + PG8_SB(b, h) + boff + n * 2048 + k * 1024); } while (0)
#define PG8_MMA(ai, bj, At, Bt) do { __builtin_amdgcn_s_setprio(1); _Pragma("unroll") for (int m = 0; m < 4; ++m) _Pragma("unroll") for (int n = 0; n < 2; ++n) _Pragma("unroll") for (int k = 0; k < 2; ++k) \
        acc[ai][bj][m][n] = __builtin_amdgcn_mfma_f32_16x16x32_bf16(Bt[n][k], At[m][k], acc[ai][bj][m][n], 0, 0, 0); __builtin_amdgcn_s_setprio(0); } while (0)
#define PG8_WAIT_V(n) asm volatile("s_waitcnt vmcnt(" #n ")" ::: "memory")
#define PG8_WAIT_L(n) asm volatile("s_waitcnt lgkmcnt(" #n ")" ::: "memory")
#define PG8_BAR __builtin_amdgcn_s_barrier()
#define PG8_SCHED __builtin_amdgcn_sched_barrier(0)
    Unit cur, nxt; int ui = 0;
    if (!S.next(0, cur)) return;
    f32x4 acc[2][2][4][2];
#pragma unroll
    for (int a = 0; a < 2; ++a)
#pragma unroll
        for (int b = 0; b < 2; ++b)
#pragma unroll
            for (int m = 0; m < 4; ++m)
#pragma unroll
                for (int n = 0; n < 2; ++n) acc[a][b][m][n] = (f32x4){0.f, 0.f, 0.f, 0.f};
    bf16x8 At[4][2], B0[2][2], B1[2][2];
    const char* cA = (const char*)g.A + (size_t)cur.pm * tstep; const char* cB = (const char*)g.Bt + (size_t)cur.pn * tstep;
    S.a_ready(cur);
    if constexpr (SP2) {
        PG8_STAGE(PG8_SB(0, 0), cB, voffB); PG8_STAGE(PG8_SB(0, 1), cB + hstep, voffB); PG8_STAGE(PG8_SA(0, 0), cA, voffA); PG8_STAGE(PG8_SA(0, 1), cA + hstep, voffA);
        if (wr == 1) PG8_BAR;
        PG8_WAIT_V(2); PG8_BAR;
        PG8_STAGE(PG8_SB(1, 0), cB + kstep, voffB); PG8_STAGE(PG8_SA(1, 0), cA + kstep, voffA); PG8_STAGE(PG8_SB(1, 1), cB + hstep + kstep, voffB);
        PG8_WAIT_V(6); PG8_BAR;
    } else {
        PG8_STAGE(PG8_SB(0, 0), cB, voffB); PG8_STAGE(PG8_SA(0, 0), cA, voffA); PG8_STAGE(PG8_SB(0, 1), cB + hstep, voffB); PG8_STAGE(PG8_SA(0, 1), cA + hstep, voffA);
        if (wr == 1) PG8_BAR;
        PG8_WAIT_V(4); PG8_BAR;
        PG8_STAGE(PG8_SB(1, 0), cB + kstep, voffB); PG8_STAGE(PG8_SA(1, 0), cA + kstep, voffA); PG8_STAGE(PG8_SB(1, 1), cB + hstep + kstep, voffB);
        PG8_WAIT_V(6); PG8_BAR;
    }
    for (;;) {
        const bool has_next = S.next(ui + 1, nxt);
        const char* nA = has_next ? (const char*)g.A + (size_t)nxt.pm * tstep : cA; const char* nB = has_next ? (const char*)g.Bt + (size_t)nxt.pn * tstep : cB;
        for (int t = 0; t < nt; t += 2) {
            const bool last = (t == nt - 2);
            const char* a1 = cA + (size_t)(t + 1) * kstep;
            const char* a2 = last ? nA : cA + (size_t)(t + 2) * kstep; const char* b2 = last ? nB : cB + (size_t)(t + 2) * kstep;
            const char* a3 = a2 + kstep; const char* b3 = b2 + kstep;
            if (last && has_next) S.a_ready(nxt);
            if constexpr (SP2) {
            PG8_LDB(B0, 0, 0); PG8_LDB(B1, 0, 1); PG8_SCHED; PG8_LDA(At, 0, 0); PG8_STAGE(PG8_SA(1, 1), a1 + hstep, voffA);
            PG8_WAIT_V(8); PG8_WAIT_L(0); PG8_BAR; PG8_MMA(0, 0, At, B0); PG8_MMA(0, 1, At, B1); PG8_BAR; PG8_SCHED;
            PG8_LDA(At, 0, 1); PG8_STAGE(PG8_SB(0, 0), b2, voffB); PG8_STAGE(PG8_SB(0, 1), b2 + hstep, voffB); PG8_STAGE(PG8_SA(0, 0), a2, voffA);
            PG8_WAIT_V(8); PG8_WAIT_L(0); PG8_BAR; PG8_MMA(1, 0, At, B0); PG8_MMA(1, 1, At, B1); PG8_BAR; PG8_SCHED;
            PG8_LDB(B0, 1, 0); PG8_LDB(B1, 1, 1); PG8_SCHED; PG8_LDA(At, 1, 0); PG8_STAGE(PG8_SA(0, 1), a2 + hstep, voffA);
            PG8_WAIT_V(8); PG8_WAIT_L(0); PG8_BAR; PG8_MMA(0, 0, At, B0); PG8_MMA(0, 1, At, B1); PG8_BAR; PG8_SCHED;
            PG8_LDA(At, 1, 1); PG8_STAGE(PG8_SB(1, 0), b3, voffB); PG8_STAGE(PG8_SB(1, 1), b3 + hstep, voffB); PG8_STAGE(PG8_SA(1, 0), a3, voffA);
            PG8_WAIT_V(8); PG8_WAIT_L(0); PG8_BAR; PG8_MMA(1, 0, At, B0); PG8_MMA(1, 1, At, B1); PG8_BAR; PG8_SCHED;
            } else {
            PG8_LDB(B0, 0, 0); PG8_SCHED; PG8_LDA(At, 0, 0); PG8_STAGE(PG8_SA(1, 1), a1 + hstep, voffA);
            PG8_WAIT_L(8); PG8_BAR; PG8_WAIT_L(0); PG8_MMA(0, 0, At, B0); PG8_BAR; PG8_SCHED;
            PG8_LDB(B1, 0, 1); PG8_STAGE(PG8_SB(0, 0), b2, voffB);
            PG8_BAR; PG8_WAIT_L(0); PG8_MMA(0, 1, At, B1); PG8_BAR;
            PG8_LDA(At, 0, 1); PG8_STAGE(PG8_SA(0, 0), a2, voffA);
            PG8_BAR; PG8_WAIT_L(0); PG8_MMA(1, 0, At, B0); PG8_BAR; PG8_SCHED;
            PG8_STAGE(PG8_SB(0, 1), b2 + hstep, voffB);
            PG8_WAIT_V(6); PG8_BAR; PG8_MMA(1, 1, At, B1); PG8_BAR;
            PG8_LDB(B0, 1, 0); PG8_SCHED; PG8_LDA(At, 1, 0); PG8_STAGE(PG8_SA(0, 1), a2 + hstep, voffA);
            PG8_WAIT_L(8); PG8_BAR; PG8_WAIT_L(0); PG8_MMA(0, 0, At, B0); PG8_BAR; PG8_SCHED;
            PG8_LDB(B1, 1, 1); PG8_STAGE(PG8_SB(1, 0), b3, voffB);
            PG8_BAR; PG8_WAIT_L(0); PG8_MMA(0, 1, At, B1); PG8_BAR;
            PG8_LDA(At, 1, 1); PG8_STAGE(PG8_SA(1, 0), a3, voffA);
            PG8_BAR; PG8_WAIT_L(0); PG8_MMA(1, 0, At, B0); PG8_BAR; PG8_SCHED;
            PG8_STAGE(PG8_SB(1, 1), b3 + hstep, voffB);
            PG8_WAIT_V(6); PG8_BAR; PG8_MMA(1, 1, At, B1); PG8_BAR;
            }
        }
        if constexpr (ALIGN_EPI) { if (wr == 0) PG8_BAR; }
        if constexpr (!Epi::AFTER_DRAIN) { E(acc, cur, wr, wc, fr, fq); S.done(cur); }
        if (!has_next) break;
#pragma unroll
        for (int a = 0; a < 2; ++a)
#pragma unroll
            for (int b = 0; b < 2; ++b)
#pragma unroll
                for (int m = 0; m < 4; ++m)
#pragma unroll
                    for (int n = 0; n < 2; ++n) acc[a][b][m][n] = (f32x4){0.f, 0.f, 0.f, 0.f};
        cur = nxt; cA = nA; cB = nB; ++ui;
        if constexpr (ALIGN_EPI) { if (wr == 1) PG8_BAR; }
    }
    PG8_WAIT_V(0);
    if constexpr (!ALIGN_EPI) { if (wr == 0) PG8_BAR; }
    PG8_BAR;
    if constexpr (Epi::AFTER_DRAIN) { E.fused(acc, cur, wr, wc, fr, fq, lds, wid, lane); S.done(cur); }
#undef PG8_SA
#undef PG8_SB
#undef PG8_STAGE
#undef PG8_LDA
#undef PG8_LDB
#undef PG8_MMA
#undef PG8_WAIT_V
#undef PG8_WAIT_L
#undef PG8_BAR
#undef PG8_SCHED
}
}

template <class Epi> __global__ void __launch_bounds__(512, 2) k_gemm(pg8::Gemm g, Epi E) {
    extern __shared__ __attribute__((aligned(16))) unsigned char lds_dyn[];
    pg8::StaticOrder S; S.init(g.M, g.N, (int)gridDim.x, (int)blockIdx.x);
    pg8::gemm_phase<Epi, pg8::StaticOrder, true, true>((PG8_LAS unsigned char*)lds_dyn, g, S, E);
}

__device__ __forceinline__ float lambda_full(const Ptrs& P) {
    float a = 0.f, b = 0.f;
    for (int i = 0; i < 64; ++i) { a += P.lq1[i] * P.lk1[i]; b += P.lq2[i] * P.lk2[i]; }
    return __expf(a) - __expf(b) + 0.2f;
}

namespace att {
typedef short bf16x8 __attribute__((ext_vector_type(8)));
typedef short s16x4 __attribute__((ext_vector_type(4)));
typedef float f32x16 __attribute__((ext_vector_type(16)));
typedef float f32x2_t __attribute__((ext_vector_type(2)));
typedef __attribute__((address_space(3))) const char* lds_cptr;
typedef __attribute__((address_space(3))) char* lds_ptr;
__device__ __forceinline__ int crow(int r, int hi) { return (r & 3) + 8 * (r >> 2) + 4 * hi; }
__device__ __forceinline__ void glds16(const void* gsrc, unsigned lds_dst) { unsigned keep;
    asm volatile("s_mov_b32 %0, m0\n\ts_mov_b32 m0, %2\n\ts_nop 0\n\tglobal_load_lds_dwordx4 %1, off\n\ts_mov_b32 m0, %0" : "=&s"(keep) : "v"(gsrc), "s"(lds_dst) : "memory"); }
__device__ __forceinline__ unsigned cvtpk(float lo, float hi) { f32x2_t v = {lo, hi}; bf16x2_t b = __builtin_convertvector(v, bf16x2_t); return __builtin_bit_cast(unsigned, b); }
#define ATT_WAIT_BAR(N) asm volatile("s_waitcnt vmcnt(" #N ") lgkmcnt(0)\n\ts_barrier" ::: "memory")
#define ATT_LDSWAIT() asm volatile("s_waitcnt lgkmcnt(0)" ::: "memory")
#define ATT_SBAR() __builtin_amdgcn_sched_barrier(0)
__device__ __forceinline__ void qkt(f32x16& p0, f32x16& p1, lds_cptr Kslot, const bf16x8* qr, int r32, int hi) {
    lds_cptr kb = Kslot + hi * 1024 + r32 * 16;
    p0 = f32x16{}; p1 = f32x16{};
#pragma unroll
    for (int d0 = 0; d0 < 4; ++d0) {
        const bf16x8 b0 = *(const __attribute__((address_space(3))) bf16x8*)(kb + d0 * 2048);
        const bf16x8 b1 = *(const __attribute__((address_space(3))) bf16x8*)(kb + d0 * 2048 + 512);
        p0 = __builtin_amdgcn_mfma_f32_32x32x16_bf16(b0, qr[d0], p0, 0, 0, 0); p1 = __builtin_amdgcn_mfma_f32_32x32x16_bf16(b1, qr[d0], p1, 0, 0, 0); }
}
__device__ __forceinline__ float rowmax32(const f32x16& p0, const f32x16& p1) {
    float a = fmaxf(p0[0], p1[0]);
#pragma unroll
    for (int r = 1; r < 16; ++r) a = fmaxf(a, fmaxf(p0[r], p1[r]));
    auto rr = __builtin_amdgcn_permlane32_swap(__float_as_uint(a), __float_as_uint(a), false, false);
    return fmaxf(__uint_as_float(rr[0]), __uint_as_float(rr[1]));
}
__device__ __forceinline__ float halfsum(float a) { auto rr = __builtin_amdgcn_permlane32_swap(__float_as_uint(a), __float_as_uint(a), false, false); return __uint_as_float(rr[0]) + __uint_as_float(rr[1]); }
template <int ND0> __device__ __forceinline__ void pv(f32x16* o, int vb, bf16x8 pa0, bf16x8 pa1, bf16x8 pa2, bf16x8 pa3) {
#pragma unroll
    for (int d0 = 0; d0 < ND0; ++d0) { s16x4 lo[4], hi[4];
#pragma unroll
        for (int ks = 0; ks < 4; ++ks) {
            asm volatile("ds_read_b64_tr_b16 %0,%1 offset:%c2" : "=&v"(lo[ks]) : "v"(vb), "i"(d0 * 4096 + ks * 1024) : "memory");
            asm volatile("ds_read_b64_tr_b16 %0,%1 offset:%c2" : "=&v"(hi[ks]) : "v"(vb), "i"(d0 * 4096 + ks * 1024 + 512) : "memory"); }
        asm volatile("s_waitcnt lgkmcnt(0)" ::: "memory"); ATT_SBAR();
#define ATT_PK(k) (bf16x8){lo[k][0], lo[k][1], lo[k][2], lo[k][3], hi[k][0], hi[k][1], hi[k][2], hi[k][3]}
        o[d0] = __builtin_amdgcn_mfma_f32_32x32x16_bf16(pa0, ATT_PK(0), o[d0], 0, 0, 0);
        o[d0] = __builtin_amdgcn_mfma_f32_32x32x16_bf16(pa1, ATT_PK(1), o[d0], 0, 0, 0);
        o[d0] = __builtin_amdgcn_mfma_f32_32x32x16_bf16(pa2, ATT_PK(2), o[d0], 0, 0, 0);
        o[d0] = __builtin_amdgcn_mfma_f32_32x32x16_bf16(pa3, ATT_PK(3), o[d0], 0, 0, 0);
#undef ATT_PK
    }
}
template <int ND0, int THR> __device__ __forceinline__ void softmax_tile(f32x16& p0, f32x16& p1, float& mrun, float& lsum, f32x16* o, __attribute__((address_space(3))) float* wsf, int r32, int hi,
                                                                   u32x4& pw0, u32x4& pw1, u32x4& pw2, u32x4& pw3) {
    const float rm = rowmax32(p0, p1);
    if (__any(rm > mrun + (float)THR)) {
        const float mn = fmaxf(mrun, rm), alpha = __builtin_amdgcn_exp2f(mrun - mn); lsum *= alpha; mrun = mn;
        if (hi == 0) wsf[r32] = alpha;
        ATT_LDSWAIT();
#pragma unroll
        for (int g = 0; g < 4; ++g) { const f32x4 a4 = *(const __attribute__((address_space(3))) f32x4*)(wsf + 8 * g + 4 * hi);
#pragma unroll
            for (int d0 = 0; d0 < ND0; ++d0) { o[d0][4 * g + 0] *= a4[0]; o[d0][4 * g + 1] *= a4[1]; o[d0][4 * g + 2] *= a4[2]; o[d0][4 * g + 3] *= a4[3]; } }
        ATT_LDSWAIT();
    }
    float s = 0.f;
#pragma unroll
    for (int r = 0; r < 16; ++r) { p0[r] = __builtin_amdgcn_exp2f(p0[r] - mrun); p1[r] = __builtin_amdgcn_exp2f(p1[r] - mrun); s += p0[r] + p1[r]; }
    lsum += s;
    pw0 = (u32x4){cvtpk(p0[0], p0[1]), cvtpk(p0[2], p0[3]), cvtpk(p0[4], p0[5]), cvtpk(p0[6], p0[7])};
    pw1 = (u32x4){cvtpk(p0[8], p0[9]), cvtpk(p0[10], p0[11]), cvtpk(p0[12], p0[13]), cvtpk(p0[14], p0[15])};
    pw2 = (u32x4){cvtpk(p1[0], p1[1]), cvtpk(p1[2], p1[3]), cvtpk(p1[4], p1[5]), cvtpk(p1[6], p1[7])};
    pw3 = (u32x4){cvtpk(p1[8], p1[9]), cvtpk(p1[10], p1[11]), cvtpk(p1[12], p1[13]), cvtpk(p1[14], p1[15])};
}

constexpr int A_SLOTK = 8192, A_SLOTV = 16384, A_NS = 3;
constexpr int A_LDS_K = 0, A_LDS_V = A_NS * A_SLOTK, A_LDS_WS = A_LDS_V + A_NS * A_SLOTV, A_LDS_ST = A_LDS_WS + 8 * 256, A_LDS_BYTES = A_LDS_ST + 8 * 8192;
__device__ __forceinline__ void attn_a_unit(int b, int h, int qb, const bf16_t* proj, bf16_t* ya, const float* subln, float lam, unsigned char* shm) {
    const int tid = threadIdx.x, lane = tid & 63, r32 = lane & 31, hi = lane >> 5; const int wid = __builtin_amdgcn_readfirstlane(tid >> 6);
    const size_t rowbase = (size_t)b * SEQ; const int q0 = qb * 256;
    constexpr int NT = SEQ / 64;
    const unsigned lds0 = (unsigned)(uintptr_t)shm;
    const lds_cptr shm3 = (lds_cptr)shm;
    __attribute__((address_space(3))) float* wsf = (__attribute__((address_space(3))) float*)((lds_ptr)shm + A_LDS_WS) + wid * 64;
    const int vb0 = (int)(lds0 + A_LDS_V) + ((lane >> 4) & 1) * 32 + (lane & 3) * 8 + (4 * hi + ((lane & 15) >> 2)) * 64;
    __attribute__((address_space(3))) bf16_t* stg = (__attribute__((address_space(3))) bf16_t*)((lds_ptr)shm + A_LDS_ST) + wid * 4096;
    for (int mp = 0; mp < 2; ++mp) {
        const bf16_t* Kh = proj + rowbase * INW + C_KA + h * 128 + mp * 64;
        const bf16_t* Vh = proj + rowbase * INW + C_VA + h * 128;
        const bf16_t* Qw = proj + (rowbase + q0 + wid * 32) * INW + C_QA + h * 128 + mp * 64;
        const int pA = 2 * wid, pB = 2 * wid + 1;
        const unsigned kdst = lds0 + A_LDS_K + wid * 1024, vdstA = lds0 + A_LDS_V + pA * 1024, vdstB = lds0 + A_LDS_V + pB * 1024;
#define A_DMA(t, slot) do { int ln_ = lane; asm volatile("" : "+v"(ln_)); \
        const bf16_t* ksrc_ = Kh + (size_t)((t) * 64 + ln_) * INW + wid * 8; \
        const bf16_t* vsrcA_ = Vh + (size_t)((t) * 64 + 16 * (pA & 3) + (ln_ >> 2)) * INW + (pA >> 2) * 32 + (ln_ & 3) * 8; \
        const bf16_t* vsrcB_ = Vh + (size_t)((t) * 64 + 16 * (pB & 3) + (ln_ >> 2)) * INW + (pB >> 2) * 32 + (ln_ & 3) * 8; \
        glds16(ksrc_, (unsigned)__builtin_amdgcn_readfirstlane(kdst + (slot) * A_SLOTK)); \
        glds16(vsrcA_, (unsigned)__builtin_amdgcn_readfirstlane(vdstA + (slot) * A_SLOTV)); \
        glds16(vsrcB_, (unsigned)__builtin_amdgcn_readfirstlane(vdstB + (slot) * A_SLOTV)); } while (0)
        A_DMA(0, 0); A_DMA(1, 1);
        bf16x8 qr[4];
#pragma unroll
        for (int d0 = 0; d0 < 4; ++d0) qr[d0] = *(const bf16x8*)(Qw + (size_t)r32 * INW + d0 * 16 + hi * 8);
        f32x16 o[4]; o[0] = f32x16{}; o[1] = f32x16{}; o[2] = f32x16{}; o[3] = f32x16{};
        float mrun = -1e30f, lsum = 0.f;
        int slot = 0, slot2 = 2;
        for (int t = 0; t < NT; ++t) {
            if (t + 1 < NT) { ATT_WAIT_BAR(3); } else { ATT_WAIT_BAR(0); }
            if (t + 2 < NT) A_DMA(t + 2, slot2);
            f32x16 p0, p1; u32x4 pw0, pw1, pw2, pw3;
            qkt(p0, p1, shm3 + A_LDS_K + slot * A_SLOTK, qr, r32, hi);
            softmax_tile<4, 8>(p0, p1, mrun, lsum, o, wsf, r32, hi, pw0, pw1, pw2, pw3);
            pv<4>(o, vb0 + slot * A_SLOTV, __builtin_bit_cast(bf16x8, pw0), __builtin_bit_cast(bf16x8, pw1), __builtin_bit_cast(bf16x8, pw2), __builtin_bit_cast(bf16x8, pw3));
            slot = (slot == 2) ? 0 : slot + 1; slot2 = (slot2 == 2) ? 0 : slot2 + 1;
        }
#undef A_DMA
        const float lt = halfsum(lsum);
        if (hi == 0) wsf[32 + r32] = lt;
        ATT_LDSWAIT();
        float rli[16];
#pragma unroll
        for (int g = 0; g < 4; ++g) { const f32x4 l4 = *(const __attribute__((address_space(3))) f32x4*)(wsf + 32 + 8 * g + 4 * hi);
            rli[4 * g + 0] = __builtin_amdgcn_rcpf(l4[0]); rli[4 * g + 1] = __builtin_amdgcn_rcpf(l4[1]); rli[4 * g + 2] = __builtin_amdgcn_rcpf(l4[2]); rli[4 * g + 3] = __builtin_amdgcn_rcpf(l4[3]); }
        ATT_LDSWAIT();
        if (mp == 0) {
#pragma unroll
            for (int d0 = 0; d0 < 4; ++d0)
#pragma unroll
                for (int r = 0; r < 16; ++r) stg[crow(r, hi) * 128 + d0 * 32 + r32] = (bf16_t)f2bf(o[d0][r] * rli[r]);
            asm volatile("s_waitcnt lgkmcnt(0)\n\ts_barrier" ::: "memory");
        } else {
            float ss[16];
#pragma unroll
            for (int r = 0; r < 16; ++r) ss[r] = 0.f;
#pragma unroll
            for (int d0 = 0; d0 < 4; ++d0)
#pragma unroll
                for (int r = 0; r < 16; ++r) { const float a = bf2f(stg[crow(r, hi) * 128 + d0 * 32 + r32]); const float y = a - lam * o[d0][r] * rli[r]; o[d0][r] = y; ss[r] += y * y; }
#pragma unroll
            for (int r = 0; r < 16; ++r) { float v = ss[r]; v += __shfl_xor(v, 1); v += __shfl_xor(v, 2); v += __shfl_xor(v, 4); v += __shfl_xor(v, 8); v += __shfl_xor(v, 16);
                ss[r] = 0.8f / sqrtf(v * (1.f / 128.f) + EPS); }
            ATT_LDSWAIT();
#pragma unroll
            for (int d0 = 0; d0 < 4; ++d0) { const float gsub = subln[d0 * 32 + r32];
#pragma unroll
                for (int r = 0; r < 16; ++r) stg[crow(r, hi) * 128 + d0 * 32 + r32] = (bf16_t)f2bf(o[d0][r] * ss[r] * gsub); }
            ATT_LDSWAIT();
            bf16_t* Yw = ya + (rowbase + q0 + wid * 32) * 512 + h * 128;
#pragma unroll
            for (int i = 0; i < 8; ++i) { const int row = i * 4 + (lane >> 4), ch = lane & 15; const u32x4 v = *(const __attribute__((address_space(3))) u32x4*)(stg + row * 128 + ch * 8); *(u32x4*)(Yw + (size_t)row * 512 + ch * 8) = v; }
            asm volatile("s_waitcnt lgkmcnt(0)\n\ts_barrier" ::: "memory");
        }
    }
}

constexpr int B_SLOT = 8192, B_NS = 3;
constexpr int B_LDS_K = 0, B_LDS_V = B_NS * B_SLOT, B_LDS_WS = 2 * B_NS * B_SLOT, B_LDS_BIAS = B_LDS_WS + 8 * 256, B_LDS_ST = B_LDS_BIAS + 2048, B_LDS_BYTES = B_LDS_ST + 8 * 4096;
__device__ __forceinline__ void attn_b_unit(int b, int h, int rg, const bf16_t* proj, bf16_t* yb, const float* rpb, unsigned char* shm) {
    const int tid = threadIdx.x, lane = tid & 63, r32 = lane & 31, hi = lane >> 5; const int wid = __builtin_amdgcn_readfirstlane(tid >> 6);
    const size_t rowbase = (size_t)b * SEQ;
    const int r = 4 * rg + (wid >> 1), c0 = 32 * (wid & 1);
    int rs = r - 4; rs = rs < 0 ? 0 : (rs > 24 ? 24 : rs);
    int rmin = 4 * rg - 4; rmin = rmin < 0 ? 0 : (rmin > 24 ? 24 : rmin);
    int rmaxs = 4 * rg + 3 - 4; rmaxs = rmaxs < 0 ? 0 : (rmaxs > 24 ? 24 : rmaxs);
    const int ntile = rmaxs + 8 - rmin;
    const unsigned lds0 = (unsigned)(uintptr_t)shm;
    const lds_cptr shm3 = (lds_cptr)shm;
    __attribute__((address_space(3))) float* wsf = (__attribute__((address_space(3))) float*)((lds_ptr)shm + B_LDS_WS) + wid * 64;
    __attribute__((address_space(3))) float* bias = (__attribute__((address_space(3))) float*)((lds_ptr)shm + B_LDS_BIAS);
    __attribute__((address_space(3))) bf16_t* stg = (__attribute__((address_space(3))) bf16_t*)((lds_ptr)shm + B_LDS_ST) + wid * 2048;
    const int vb0 = (int)(lds0 + B_LDS_V) + ((lane >> 4) & 1) * 32 + (lane & 3) * 8 + (4 * hi + ((lane & 15) >> 2)) * 64;
    if (tid < 480) { const int ri = tid >> 5, cj = tid & 31; bias[tid] = (cj < 31) ? rpb[(h * 15 + ri) * 31 + cj] * LOG2E : 0.f; }
    const bf16_t* Kh = proj + rowbase * INW + C_KB + h * 64;
    const bf16_t* Vh = proj + rowbase * INW + C_VB + h * 64;
    const bf16_t* Qw = proj + (rowbase + r * 64 + c0) * INW + C_QB + h * 64;
    const unsigned kdst = lds0 + B_LDS_K + wid * 1024, vdst = lds0 + B_LDS_V + wid * 1024;
#define B_DMA(t, slot) do { int ln_ = lane; asm volatile("" : "+v"(ln_)); \
    const bf16_t* ksrc_ = Kh + (size_t)((rmin + (t)) * 64 + ln_) * INW + wid * 8; \
    const bf16_t* vsrc_ = Vh + (size_t)((rmin + (t)) * 64 + 16 * (wid & 3) + (ln_ >> 2)) * INW + (wid >> 2) * 32 + (ln_ & 3) * 8; \
    glds16(ksrc_, (unsigned)__builtin_amdgcn_readfirstlane(kdst + (slot) * B_SLOT)); \
    glds16(vsrc_, (unsigned)__builtin_amdgcn_readfirstlane(vdst + (slot) * B_SLOT)); } while (0)
    B_DMA(0, 0); B_DMA(1, 1);
    bf16x8 qr[4];
#pragma unroll
    for (int d0 = 0; d0 < 4; ++d0) qr[d0] = *(const bf16x8*)(Qw + (size_t)r32 * INW + d0 * 16 + hi * 8);
    f32x16 o[2]; o[0] = f32x16{}; o[1] = f32x16{};
    float mrun = -1e30f, lsum = 0.f;
    const int c = c0 + r32; int cs = c - 8; cs = cs < 0 ? 0 : (cs > 48 ? 48 : cs);
    int slot = 0, slot2 = 2;
    for (int t = 0; t < ntile; ++t) {
        if (t + 1 < ntile) { ATT_WAIT_BAR(2); } else { ATT_WAIT_BAR(0); }
        if (t + 2 < ntile) B_DMA(t + 2, slot2);
        const int kr = rmin + t;
        if (kr >= rs && kr < rs + 8) {
            f32x16 p0, p1; u32x4 pw0, pw1, pw2, pw3;
            qkt(p0, p1, shm3 + B_LDS_K + slot * B_SLOT, qr, r32, hi);
            const int bbase = (kr - r + 7) * 32 + 15 - c;
#pragma unroll
            for (int rr = 0; rr < 16; ++rr) { const int j0 = crow(rr, hi), j1 = j0 + 32;
                const bool v0 = (unsigned)(j0 - cs) < 16u, v1 = (unsigned)(j1 - cs) < 16u;
                const float b0 = bias[v0 ? bbase + j0 : 0], b1 = bias[v1 ? bbase + j1 : 0];
                p0[rr] = v0 ? p0[rr] + b0 : -1e30f; p1[rr] = v1 ? p1[rr] + b1 : -1e30f; }
            softmax_tile<2, 8>(p0, p1, mrun, lsum, o, wsf, r32, hi, pw0, pw1, pw2, pw3);
            pv<2>(o, vb0 + slot * B_SLOT, __builtin_bit_cast(bf16x8, pw0), __builtin_bit_cast(bf16x8, pw1), __builtin_bit_cast(bf16x8, pw2), __builtin_bit_cast(bf16x8, pw3));
        }
        slot = (slot == 2) ? 0 : slot + 1; slot2 = (slot2 == 2) ? 0 : slot2 + 1;
    }
#undef B_DMA
    const float lt = halfsum(lsum);
    if (hi == 0) wsf[32 + r32] = lt;
    ATT_LDSWAIT();
    float rli[16];
#pragma unroll
    for (int g = 0; g < 4; ++g) { const f32x4 l4 = *(const __attribute__((address_space(3))) f32x4*)(wsf + 32 + 8 * g + 4 * hi);
        rli[4 * g + 0] = __builtin_amdgcn_rcpf(l4[0]); rli[4 * g + 1] = __builtin_amdgcn_rcpf(l4[1]); rli[4 * g + 2] = __builtin_amdgcn_rcpf(l4[2]); rli[4 * g + 3] = __builtin_amdgcn_rcpf(l4[3]); }
#pragma unroll
    for (int d0 = 0; d0 < 2; ++d0)
#pragma unroll
        for (int rr = 0; rr < 16; ++rr) stg[crow(rr, hi) * 64 + d0 * 32 + r32] = (bf16_t)f2bf(o[d0][rr] * rli[rr]);
    ATT_LDSWAIT();
    bf16_t* Yw = yb + (rowbase + r * 64 + c0) * 512 + h * 64;
#pragma unroll
    for (int i = 0; i < 4; ++i) { const int row = i * 8 + (lane >> 3), ch = lane & 7; const u32x4 v = *(const __attribute__((address_space(3))) u32x4*)(stg + row * 64 + ch * 8); *(u32x4*)(Yw + (size_t)row * 512 + ch * 8) = v; }
    asm volatile("s_waitcnt lgkmcnt(0)\n\ts_barrier" ::: "memory");
}
}

__global__ void __launch_bounds__(512, 2) k_attn_a(Ptrs P) {
    extern __shared__ __attribute__((aligned(16))) unsigned char lds_dyn[];
    const float lam = lambda_full(P);
    const int G = gridDim.x, bx = blockIdx.x, vcu = (G % 8 == 0) ? (bx % 8) * (G / 8) + bx / 8 : bx;
    for (int u = vcu; u < BATCH * 4 * 8; u += G)
        att::attn_a_unit(u >> 5, (u >> 3) & 3, u & 7, (const bf16_t*)(P.ws + WS_PROJ), (bf16_t*)(P.ws + WS_YA), P.subln, lam, lds_dyn);
}


__global__ void __launch_bounds__(512, 2) k_attn_b(Ptrs P) {
    extern __shared__ __attribute__((aligned(16))) unsigned char lds_dyn[];
    const int G = gridDim.x, bx = blockIdx.x, vcu = (G % 8 == 0) ? (bx % 8) * (G / 8) + bx / 8 : bx;
    for (int u = vcu; u < BATCH * 8 * 8; u += G)
        att::attn_b_unit(u >> 6, (u >> 3) & 7, u & 7, (const bf16_t*)(P.ws + WS_PROJ), (bf16_t*)(P.ws + WS_YB), P.rpb, lds_dyn);
}


namespace peer {
typedef short bf16x8 __attribute__((ext_vector_type(8)));
typedef float f32x16 __attribute__((ext_vector_type(16)));
typedef __attribute__((address_space(3))) const char* lds_cptr;
constexpr int T_LDS_SK = 0, T_LDS_BYTES = 65536;
__device__ __forceinline__ int imax(int a, int b) { return a > b ? a : b; }
__device__ __forceinline__ int imin(int a, int b) { return a < b ? a : b; }
__device__ __forceinline__ int f2key(float s, int idx) { int b = __float_as_int(s); b = (b & ~127) | idx; return b ^ ((b >> 31) & 0x7fffffff); }
__device__ __forceinline__ int key2bits(int k) { return k ^ ((k >> 31) & 0x7fffffff); }
template <int N, int OFF, int TOT> __device__ __forceinline__ void bsort_desc(int (&a)[TOT]) {
#pragma unroll
    for (int k = 2; k <= N; k <<= 1)
#pragma unroll
        for (int j = k >> 1; j > 0; j >>= 1)
#pragma unroll
            for (int i = 0; i < N; ++i) { const int l = i ^ j; if (l > i) { const bool desc = (i & k) == 0; const int hi_ = imax(a[OFF + i], a[OFF + l]), lo_ = imin(a[OFF + i], a[OFF + l]); a[OFF + i] = desc ? hi_ : lo_; a[OFF + l] = desc ? lo_ : hi_; } }
}
template <int N, int OFF, int TOT> __device__ __forceinline__ void bmerge_desc(int (&a)[TOT]) {
#pragma unroll
    for (int j = N >> 1; j > 0; j >>= 1)
#pragma unroll
        for (int i = 0; i < N; ++i) { const int l = i ^ j; if (l > i) { const int hi_ = imax(a[OFF + i], a[OFF + l]), lo_ = imin(a[OFF + i], a[OFF + l]); a[OFF + i] = hi_; a[OFF + l] = lo_; } }
}
template <int A, int B, int TOT> __device__ __forceinline__ void merge_top16(int (&a)[TOT]) {
#pragma unroll
    for (int i = 0; i < 16; ++i) a[A + i] = imax(a[A + i], a[B + 15 - i]);
    bmerge_desc<16, A, TOT>(a);
}
__device__ __forceinline__ void cross_top16(int (&t)[16]) {
    int lo[16], hi[16];
#pragma unroll
    for (int i = 0; i < 16; ++i) { auto rr = __builtin_amdgcn_permlane32_swap((unsigned)t[i], (unsigned)t[i], false, false); lo[i] = (int)rr[0]; hi[i] = (int)rr[1]; }
#pragma unroll
    for (int i = 0; i < 16; ++i) t[i] = imax(lo[i], hi[15 - i]);
    bmerge_desc<16, 0, 16>(t);
}
__device__ __forceinline__ void half_top16(int (&top)[16], const bf16_t* qrow  , lds_cptr skp  , int hi) {
    f32x16 sc[4]; sc[0] = f32x16{}; sc[1] = f32x16{}; sc[2] = f32x16{}; sc[3] = f32x16{};
    bf16x8 qf[8];
#pragma unroll
    for (int ks = 0; ks < 8; ++ks) qf[ks] = *(const bf16x8*)(qrow + ks * 16);
#pragma unroll
    for (int ks = 0; ks < 8; ++ks)
#pragma unroll
        for (int kt = 0; kt < 4; ++kt) { const bf16x8 af = *(const __attribute__((address_space(3))) bf16x8*)(skp + ks * 4096 + kt * 512);
            sc[kt] = __builtin_amdgcn_mfma_f32_32x32x16_bf16(af, qf[ks], sc[kt], 0, 0, 0); }
    int k[64];
#pragma unroll
    for (int kt = 0; kt < 4; ++kt)
#pragma unroll
        for (int r = 0; r < 16; ++r) k[kt * 16 + r] = f2key(sc[kt][r], (32 * kt + (r & 3) + 8 * (r >> 2)) | (4 * hi));
    bsort_desc<16, 0, 64>(k); bsort_desc<16, 16, 64>(k); bsort_desc<16, 32, 64>(k); bsort_desc<16, 48, 64>(k);
    merge_top16<0, 16, 64>(k); merge_top16<32, 48, 64>(k); merge_top16<0, 32, 64>(k);
#pragma unroll
    for (int i = 0; i < 16; ++i) top[i] = k[i];
    cross_top16(top);
}
__device__ __forceinline__ void topk_wave(int tok0, int h, const bf16_t* Q, int* IDX, float* Gt, lds_cptr sk, int lane) {
    const int r32 = lane & 31, hi = lane >> 5, tok = tok0 + r32;
    const bf16_t* qrow = Q + (size_t)tok * PQ + h * 256 + 8 * hi;
    lds_cptr skl = sk + hi * 2048 + r32 * 16;
    int A0[16], A1[16];
    half_top16(A0, qrow, skl, hi);
    half_top16(A1, qrow + 128, skl + 32768, hi);
    float x[16], y[16]; int xw[16], yw[16];
#pragma unroll
    for (int a = 0; a < 16; ++a) { const int b0 = key2bits(A0[a]), b1 = key2bits(A1[a]);
        const float v0 = __int_as_float(b0 & ~127), v1 = __int_as_float(b1 & ~127); const int i0 = (b0 & 127) << 7, i1 = b1 & 127;
        x[a] = hi ? v1 : v0; y[a] = hi ? v0 : v1; xw[a] = hi ? i1 : i0; yw[a] = hi ? i0 : i1; }
    int w[32]; int n = 0;
#define PEER_CAND(a, b) do { const int bits = __float_as_int(x[a] + y[b]); const int key = bits ^ ((bits >> 31) & 0x7fffffff); int ww = (key & ~0x3FFF) | (xw[a] + yw[b]); \
        if ((a) == (b) && hi) ww = (int)0x80000000; w[n] = ww; ++n; } while (0)
#pragma unroll
    for (int b = 0; b < 16; ++b) PEER_CAND(0, b);
#pragma unroll
    for (int b = 1; b < 8; ++b) PEER_CAND(1, b);
#pragma unroll
    for (int b = 2; b < 5; ++b) PEER_CAND(2, b);
    PEER_CAND(3, 3);
#undef PEER_CAND
#pragma unroll
    for (int i = 27; i < 32; ++i) w[i] = (int)0x80000000;
    bsort_desc<32, 0, 32>(w);
    int T[16];
#pragma unroll
    for (int i = 0; i < 16; ++i) T[i] = w[i];
    cross_top16(T);
    float sv[16]; int ev[16];
#pragma unroll
    for (int j = 0; j < 16; ++j) { ev[j] = T[j] & 0x3FFF; const int kb = T[j] & ~0x3FFF; sv[j] = __int_as_float(kb ^ ((kb >> 31) & 0x7fffffff)); }
    const float s0 = sv[0]; float esum = 0.f;
#pragma unroll
    for (int j = 0; j < 16; ++j) { sv[j] = __expf(sv[j] - s0); esum += sv[j]; }
    const float inv = 1.f / esum;
    if (hi == 0) { u32x4* io = (u32x4*)(IDX + ((size_t)tok * 8 + h) * 16);
#pragma unroll
        for (int j = 0; j < 4; ++j) io[j] = (u32x4){(unsigned)ev[4 * j], (unsigned)ev[4 * j + 1], (unsigned)ev[4 * j + 2], (unsigned)ev[4 * j + 3]}; }
    else { f32x4* go = (f32x4*)(Gt + ((size_t)tok * 8 + h) * 16);
#pragma unroll
        for (int j = 0; j < 4; ++j) go[j] = (f32x4){sv[4 * j] * inv, sv[4 * j + 1] * inv, sv[4 * j + 2] * inv, sv[4 * j + 3] * inv}; }
}
__device__ __forceinline__ void topk_phase(const Ptrs& P, unsigned char* shm, int G, int bx) {
    const int tid = threadIdx.x, lane = tid & 63; const int wid = __builtin_amdgcn_readfirstlane(tid >> 6);
    const unsigned lds0 = (unsigned)(uintptr_t)shm;
    const bf16_t* SKg = (const bf16_t*)(P.ws + WS_SK);
    const int per = (512 + G - 1) / G; int hprev = -1;
    for (int i = 0; i < per; ++i) { const int T = bx * per + i; if (T >= 512) break;
        const int h = T >> 6, tg = T & 63;
        if (h != hprev) { hprev = h;
            asm volatile("s_waitcnt lgkmcnt(0)\n\ts_barrier" ::: "memory");
#pragma unroll
            for (int j = 0; j < 8; ++j) { const int piece = wid * 8 + j, p = piece >> 5, c = (piece >> 1) & 15, kh = piece & 1;
                att::glds16(SKg + ((size_t)((h * 2 + p) * 128 + kh * 64 + lane) * 128 + c * 8), (unsigned)__builtin_amdgcn_readfirstlane(lds0 + p * 32768 + c * 2048 + kh * 1024)); }
            asm volatile("s_waitcnt vmcnt(0)\n\ts_barrier" ::: "memory");
        }
        topk_wave(tg * 256 + wid * 32, h, (const bf16_t*)(P.ws + WS_Q), (int*)(P.ws + WS_IDX), (float*)(P.ws + WS_G), (lds_cptr)shm, lane);
    }
}
}

__global__ void __launch_bounds__(512, 2) k_topk(Ptrs P) {
    extern __shared__ __attribute__((aligned(16))) unsigned char lds_dyn[];
    peer::topk_phase(P, lds_dyn, (int)gridDim.x, (int)blockIdx.x);
}

__global__ void __launch_bounds__(256) k_attn_a_naive(Ptrs P) {
    const bf16_t* proj = (const bf16_t*)(P.ws + WS_PROJ);
    const int gt = blockIdx.x * 256 + threadIdx.x;
    const int ch = gt & 3, q = (gt >> 2) & 2047, h = (gt >> 13) & 3, b = gt >> 15;
    const float lam = lambda_full(P);
    const size_t qrow = (size_t)b * SEQ + q;
    float y[32];
#pragma unroll
    for (int j = 0; j < 32; ++j) y[j] = 0.f;
    for (int m = 0; m < 2; ++m) {
        float qv[64];
        const bf16_t* qp = proj + qrow * INW + C_QA + h * 128 + m * 64;
#pragma unroll
        for (int d = 0; d < 64; ++d) qv[d] = bf2f(qp[d]);
        float mx = -1e30f, l = 0.f, acc[32];
#pragma unroll
        for (int j = 0; j < 32; ++j) acc[j] = 0.f;
        for (int k = 0; k < SEQ; ++k) {
            const size_t krow = (size_t)b * SEQ + k;
            const bf16_t* kp = proj + krow * INW + C_KA + h * 128 + m * 64;
            float s = 0.f;
#pragma unroll
            for (int d8 = 0; d8 < 8; ++d8) { const u32x4 kv = *(const u32x4*)(kp + d8 * 8);
                s += qv[d8 * 8 + 0] * bflo(kv.x); s += qv[d8 * 8 + 1] * bfhi(kv.x); s += qv[d8 * 8 + 2] * bflo(kv.y); s += qv[d8 * 8 + 3] * bfhi(kv.y);
                s += qv[d8 * 8 + 4] * bflo(kv.z); s += qv[d8 * 8 + 5] * bfhi(kv.z); s += qv[d8 * 8 + 6] * bflo(kv.w); s += qv[d8 * 8 + 7] * bfhi(kv.w); }
            if (s > mx) { const float f = exp2f(mx - s); l *= f;
#pragma unroll
                for (int j = 0; j < 32; ++j) acc[j] *= f;
                mx = s; }
            const float p = exp2f(s - mx); l += p;
            const bf16_t* vp = proj + krow * INW + C_VA + h * 128 + ch * 32;
#pragma unroll
            for (int d8 = 0; d8 < 4; ++d8) { const u32x4 vv = *(const u32x4*)(vp + d8 * 8);
                acc[d8 * 8 + 0] += p * bflo(vv.x); acc[d8 * 8 + 1] += p * bfhi(vv.x); acc[d8 * 8 + 2] += p * bflo(vv.y); acc[d8 * 8 + 3] += p * bfhi(vv.y);
                acc[d8 * 8 + 4] += p * bflo(vv.z); acc[d8 * 8 + 5] += p * bfhi(vv.z); acc[d8 * 8 + 6] += p * bflo(vv.w); acc[d8 * 8 + 7] += p * bfhi(vv.w); }
        }
        const float il = 1.f / l, sg = (m == 0) ? 1.f : -lam;
#pragma unroll
        for (int j = 0; j < 32; ++j) y[j] += sg * acc[j] * il;
    }
    float ss = 0.f;
#pragma unroll
    for (int j = 0; j < 32; ++j) ss += y[j] * y[j];
    ss += __shfl_xor(ss, 1); ss += __shfl_xor(ss, 2);
    const float rstd = 1.f / sqrtf(ss * (1.f / 128.f) + EPS) * 0.8f;
    bf16_t* yo = (bf16_t*)(P.ws + WS_YA) + qrow * 512 + h * 128 + ch * 32;
#pragma unroll
    for (int j = 0; j < 32; ++j) yo[j] = (bf16_t)f2bf(y[j] * rstd * P.subln[ch * 32 + j]);
}
__global__ void __launch_bounds__(256) k_attn_b_naive(Ptrs P) {
    const bf16_t* proj = (const bf16_t*)(P.ws + WS_PROJ);
    const int gt = blockIdx.x * 256 + threadIdx.x;
    const int c = gt & 63, r = (gt >> 6) & 31, h = (gt >> 11) & 7, b = gt >> 14;
    const size_t qrow = (size_t)b * SEQ + r * 64 + c;
    float qv[64];
    const bf16_t* qp = proj + qrow * INW + C_QB + h * 64;
#pragma unroll
    for (int d = 0; d < 64; ++d) qv[d] = bf2f(qp[d]);
    int rs = r - 4; rs = rs < 0 ? 0 : (rs > 24 ? 24 : rs);
    int cs = c - 8; cs = cs < 0 ? 0 : (cs > 48 ? 48 : cs);
    float mx = -1e30f, l = 0.f, acc[64];
#pragma unroll
    for (int j = 0; j < 64; ++j) acc[j] = 0.f;
    for (int i = 0; i < 8; ++i)
        for (int j = 0; j < 16; ++j) {
            const size_t krow = (size_t)b * SEQ + (rs + i) * 64 + (cs + j);
            const bf16_t* kp = proj + krow * INW + C_KB + h * 64;
            float s = 0.f;
#pragma unroll
            for (int d8 = 0; d8 < 8; ++d8) { const u32x4 kv = *(const u32x4*)(kp + d8 * 8);
                s += qv[d8 * 8 + 0] * bflo(kv.x); s += qv[d8 * 8 + 1] * bfhi(kv.x); s += qv[d8 * 8 + 2] * bflo(kv.y); s += qv[d8 * 8 + 3] * bfhi(kv.y);
                s += qv[d8 * 8 + 4] * bflo(kv.z); s += qv[d8 * 8 + 5] * bfhi(kv.z); s += qv[d8 * 8 + 6] * bflo(kv.w); s += qv[d8 * 8 + 7] * bfhi(kv.w); }
            s += LOG2E * P.rpb[(h * 15 + (rs + i - r + 7)) * 31 + (cs + j - c + 15)];
            if (s > mx) { const float f = exp2f(mx - s); l *= f;
#pragma unroll
                for (int jj = 0; jj < 64; ++jj) acc[jj] *= f;
                mx = s; }
            const float p = exp2f(s - mx); l += p;
            const bf16_t* vp = proj + krow * INW + C_VB + h * 64;
#pragma unroll
            for (int d8 = 0; d8 < 8; ++d8) { const u32x4 vv = *(const u32x4*)(vp + d8 * 8);
                acc[d8 * 8 + 0] += p * bflo(vv.x); acc[d8 * 8 + 1] += p * bfhi(vv.x); acc[d8 * 8 + 2] += p * bflo(vv.y); acc[d8 * 8 + 3] += p * bfhi(vv.y);
                acc[d8 * 8 + 4] += p * bflo(vv.z); acc[d8 * 8 + 5] += p * bfhi(vv.z); acc[d8 * 8 + 6] += p * bflo(vv.w); acc[d8 * 8 + 7] += p * bfhi(vv.w); }
        }
    const float il = 1.f / l;
    bf16_t* yo = (bf16_t*)(P.ws + WS_YB) + qrow * 512 + h * 64;
#pragma unroll
    for (int j = 0; j < 64; ++j) yo[j] = (bf16_t)f2bf(acc[j] * il);
}
__global__ void __launch_bounds__(64) k_topk1_naive(Ptrs P) {
    __shared__ float sc[128][64];
    const int tid = threadIdx.x, gt = blockIdx.x * 64 + tid;
    const int t = gt & (M - 1), hp = gt >> 14;
    const bf16_t* qp = (const bf16_t*)(P.ws + WS_Q) + (size_t)t * PQ + hp * 128;
    const bf16_t* sk = (const bf16_t*)(P.ws + WS_SK) + (size_t)hp * 128 * 128;
    float qv[128];
#pragma unroll
    for (int d = 0; d < 128; ++d) qv[d] = bf2f(qp[d]);
    for (int k = 0; k < 128; ++k) {
        float s = 0.f;
#pragma unroll
        for (int d8 = 0; d8 < 16; ++d8) { const u32x4 kv = *(const u32x4*)(sk + k * 128 + d8 * 8);
            s += qv[d8 * 8 + 0] * bflo(kv.x); s += qv[d8 * 8 + 1] * bfhi(kv.x); s += qv[d8 * 8 + 2] * bflo(kv.y); s += qv[d8 * 8 + 3] * bfhi(kv.y);
            s += qv[d8 * 8 + 4] * bflo(kv.z); s += qv[d8 * 8 + 5] * bfhi(kv.z); s += qv[d8 * 8 + 6] * bflo(kv.w); s += qv[d8 * 8 + 7] * bfhi(kv.w); }
        sc[k][tid] = s;
    }
    float pv = 3e38f; int pk = -1;
    float* tv = (float*)(P.ws + WS_TOPV) + ((size_t)t * 16 + hp) * 16; int* ti = (int*)(P.ws + WS_TOPI) + ((size_t)t * 16 + hp) * 16;
    for (int j = 0; j < 16; ++j) {
        float bv = -3e38f; int bk = -1;
        for (int k = 0; k < 128; ++k) { const float v = sc[k][tid]; const bool below = (v < pv) || (v == pv && k > pk); if (below && v > bv) { bv = v; bk = k; } }
        tv[j] = bv; ti[j] = bk; pv = bv; pk = bk;
    }
}
__global__ void __launch_bounds__(256) k_topk2_naive(Ptrs P) {
    const int gt = blockIdx.x * 256 + threadIdx.x;
    const float* tv = (const float*)(P.ws + WS_TOPV) + (size_t)gt * 32; const int* ti = (const int*)(P.ws + WS_TOPI) + (size_t)gt * 32;
    float v0[16], v1[16]; int i0[16], i1[16];
#pragma unroll
    for (int j = 0; j < 16; ++j) { v0[j] = tv[j]; v1[j] = tv[16 + j]; i0[j] = ti[j]; i1[j] = ti[16 + j]; }
    float* go = (float*)(P.ws + WS_G) + (size_t)gt * 16; int* io = (int*)(P.ws + WS_IDX) + (size_t)gt * 16;
    float pv = 3e38f; int pk = -1; float s0 = 0.f, esum = 0.f;
    for (int j = 0; j < 16; ++j) {
        float bv = -3e38f; int bk = -1, bidx = 0;
        int iz; asm volatile("v_mov_b32 %0, 0" : "=v"(iz));
#pragma unroll
        for (int a = 0; a < 16; ++a)
#pragma unroll
            for (int b = 0; b < 16; ++b) { const float v = v0[a] + __int_as_float(__float_as_int(v1[b]) | iz); const int k = a * 16 + b; const bool below = (v < pv) || (v == pv && k > pk);
                if (below && v > bv) { bv = v; bk = k; bidx = (i0[a] | iz) * 128 + i1[b]; } }
        if (j == 0) s0 = bv;
        const float e = __expf(bv - s0); esum += e;
        go[j] = e; io[j] = bidx; pv = bv; pk = bk;
    }
    const float inv = 1.f / esum;
#pragma unroll
    for (int j = 0; j < 16; ++j) go[j] *= inv;
}
__global__ void __launch_bounds__(256) k_peer_apply(Ptrs P) {
    const int lane = threadIdx.x & 63, sub = lane & 15, g = lane >> 4;
    const int t = blockIdx.x * 4 + (threadIdx.x >> 6);
    const float* hrow = P.out + (size_t)t * D;
    const float* ssq = (const float*)(P.ws + WS_SSQ) + (size_t)t * 16;
    float tot = 0.f;
#pragma unroll
    for (int i = 0; i < 16; ++i) tot += ssq[i];
    const float rstd = 1.f / sqrtf(tot * (1.f / D) + EPS);
    unsigned xh[8][4]; float hv[8][8];
#pragma unroll
    for (int i = 0; i < 8; ++i) { const int e0 = (sub + 16 * i) * 8;
        const f32x4 a = *(const f32x4*)(hrow + e0), b = *(const f32x4*)(hrow + e0 + 4);
        const f32x4 ga = *(const f32x4*)(P.norm_ffn + e0), gb = *(const f32x4*)(P.norm_ffn + e0 + 4);
        hv[i][0] = a.x; hv[i][1] = a.y; hv[i][2] = a.z; hv[i][3] = a.w; hv[i][4] = b.x; hv[i][5] = b.y; hv[i][6] = b.z; hv[i][7] = b.w;
        xh[i][0] = pk2(a.x * rstd * ga.x, a.y * rstd * ga.y); xh[i][1] = pk2(a.z * rstd * ga.z, a.w * rstd * ga.w);
        xh[i][2] = pk2(b.x * rstd * gb.x, b.y * rstd * gb.y); xh[i][3] = pk2(b.z * rstd * gb.z, b.w * rstd * gb.w); }
    const int* idxp = (const int*)(P.ws + WS_IDX) + (size_t)t * 128; const float* gp = (const float*)(P.ws + WS_G) + (size_t)t * 128;
    const int id0 = idxp[lane], id1 = idxp[64 + lane]; const float g0 = gp[lane], g1 = gp[64 + lane];
    const bf16_t* U = (const bf16_t*)(P.ws + WS_U); const bf16_t* V = (const bf16_t*)(P.ws + WS_V);
    float acc[8][8];
#pragma unroll
    for (int i = 0; i < 8; ++i)
#pragma unroll
        for (int e = 0; e < 8; ++e) acc[i][e] = 0.f;
    for (int j = 0; j < 32; ++j) {
        const int src = (4 * j + g) & 63;
        const int e = (j < 16) ? __shfl(id0, src) : __shfl(id1, src);
        const float gate = (j < 16) ? __shfl(g0, src) : __shfl(g1, src);
        const bf16_t* ur = U + (size_t)e * D; const bf16_t* vr = V + (size_t)e * D;
        u32x4 uu[8], vv[8];
#pragma unroll
        for (int i = 0; i < 8; ++i) { uu[i] = *(const u32x4*)(ur + (sub + 16 * i) * 8); vv[i] = *(const u32x4*)(vr + (sub + 16 * i) * 8); }
        float d = 0.f;
#pragma unroll
        for (int i = 0; i < 8; ++i) {
            d += bflo(uu[i].x) * bflo(xh[i][0]) + bfhi(uu[i].x) * bfhi(xh[i][0]); d += bflo(uu[i].y) * bflo(xh[i][1]) + bfhi(uu[i].y) * bfhi(xh[i][1]);
            d += bflo(uu[i].z) * bflo(xh[i][2]) + bfhi(uu[i].z) * bfhi(xh[i][2]); d += bflo(uu[i].w) * bflo(xh[i][3]) + bfhi(uu[i].w) * bfhi(xh[i][3]); }
        d += __shfl_xor(d, 1); d += __shfl_xor(d, 2); d += __shfl_xor(d, 4); d += __shfl_xor(d, 8);
        const float c = gate * gelu_exact(d);
#pragma unroll
        for (int i = 0; i < 8; ++i) {
            acc[i][0] += c * bflo(vv[i].x); acc[i][1] += c * bfhi(vv[i].x); acc[i][2] += c * bflo(vv[i].y); acc[i][3] += c * bfhi(vv[i].y);
            acc[i][4] += c * bflo(vv[i].z); acc[i][5] += c * bfhi(vv[i].z); acc[i][6] += c * bflo(vv[i].w); acc[i][7] += c * bfhi(vv[i].w); }
    }
    float ss = 0.f;
#pragma unroll
    for (int i = 0; i < 8; ++i)
#pragma unroll
        for (int e = 0; e < 8; ++e) { float a = acc[i][e]; a += __shfl_xor(a, 16); a += __shfl_xor(a, 32); a += hv[i][e]; acc[i][e] = a; ss += a * a; }
    ss += __shfl_xor(ss, 1); ss += __shfl_xor(ss, 2); ss += __shfl_xor(ss, 4); ss += __shfl_xor(ss, 8);
    const float r2 = 1.f / sqrtf(ss * (1.f / D) + EPS);
    float* orow = P.out + (size_t)t * D;
#pragma unroll
    for (int i = 0; i < 8; ++i) if ((i & 3) == g) { const int e0 = (sub + 16 * i) * 8;
        const f32x4 ga = *(const f32x4*)(P.norm_final + e0), gb = *(const f32x4*)(P.norm_final + e0 + 4);
        f32x4 o0, o1; o0.x = acc[i][0] * r2 * ga.x; o0.y = acc[i][1] * r2 * ga.y; o0.z = acc[i][2] * r2 * ga.z; o0.w = acc[i][3] * r2 * ga.w;
        o1.x = acc[i][4] * r2 * gb.x; o1.y = acc[i][5] * r2 * gb.y; o1.z = acc[i][6] * r2 * gb.z; o1.w = acc[i][7] * r2 * gb.w;
        *(f32x4*)(orow + e0) = o0; *(f32x4*)(orow + e0 + 4) = o1; }
}

extern "C" void kernel_launch(void* const* d_in, const int* in_sizes, int n_in, void* d_out, int out_size, void* d_ws, size_t ws_size, hipStream_t stream) {
    if (n_in != 18 || ws_size < WS_END) { fprintf(stderr, "kernel_launch: unexpected n_in %d / ws_size %zu\n", n_in, ws_size); return; }
    Ptrs P{};
    P.x = (const float*)d_in[0]; P.w_in = (const float*)d_in[1]; P.w_pa = (const float*)d_in[2]; P.w_pb = (const float*)d_in[3]; P.w_out = (const float*)d_in[4];
    P.norm_mix = (const float*)d_in[5]; P.norm_ffn = (const float*)d_in[6]; P.norm_final = (const float*)d_in[7];
    P.lq1 = (const float*)d_in[8]; P.lk1 = (const float*)d_in[9]; P.lq2 = (const float*)d_in[10]; P.lk2 = (const float*)d_in[11];
    P.subln = (const float*)d_in[12]; P.rpb = (const float*)d_in[13]; P.w_query = (const float*)d_in[14]; P.sub_keys = (const float*)d_in[15];
    P.peer_u = (const float*)d_in[16]; P.peer_v = (const float*)d_in[17];
    P.out = (float*)d_out; P.ws = (unsigned char*)d_ws;
    unsigned char* ws = P.ws;
    k_prep<<<1024, 256, 0, stream>>>(P);
    constexpr int GEMM_LDS = pg8::STAGE_BYTES;
    const int G = 256;
    static bool attr_done = false;
    if (!attr_done) { attr_done = true;
    hipFuncSetAttribute((const void*)k_gemm<pg8::EpiProj>, hipFuncAttributeMaxDynamicSharedMemorySize, GEMM_LDS);
    hipFuncSetAttribute((const void*)k_gemm<pg8::EpiGateA>, hipFuncAttributeMaxDynamicSharedMemorySize, GEMM_LDS);
    hipFuncSetAttribute((const void*)k_gemm<pg8::EpiGateB>, hipFuncAttributeMaxDynamicSharedMemorySize, GEMM_LDS);
    hipFuncSetAttribute((const void*)k_gemm<pg8::EpiHout>, hipFuncAttributeMaxDynamicSharedMemorySize, GEMM_LDS);
    hipFuncSetAttribute((const void*)k_gemm<pg8::EpiQ>, hipFuncAttributeMaxDynamicSharedMemorySize, GEMM_LDS);
    hipFuncSetAttribute((const void*)k_attn_a, hipFuncAttributeMaxDynamicSharedMemorySize, att::A_LDS_BYTES);
    hipFuncSetAttribute((const void*)k_attn_b, hipFuncAttributeMaxDynamicSharedMemorySize, att::B_LDS_BYTES);
    hipFuncSetAttribute((const void*)k_topk, hipFuncAttributeMaxDynamicSharedMemorySize, peer::T_LDS_BYTES); }
    k_gemm<pg8::EpiProj><<<G, 512, GEMM_LDS, stream>>>(pg8::Gemm{(const bf16_t*)(ws + WS_XN), (const bf16_t*)(ws + WS_WIN), M, INW, D, 0}, pg8::EpiProj{(bf16_t*)(ws + WS_PROJ), (const float*)(ws + WS_ROPE)});
    k_attn_a<<<G, 512, att::A_LDS_BYTES, stream>>>(P);
    k_attn_b<<<G, 512, att::B_LDS_BYTES, stream>>>(P);
    k_gemm<pg8::EpiGateA><<<G, 512, GEMM_LDS, stream>>>(pg8::Gemm{(const bf16_t*)(ws + WS_YA), (const bf16_t*)(ws + WS_WPA), M, D, 512, 0}, pg8::EpiGateA{(const bf16_t*)(ws + WS_PROJ), P.out});
    k_gemm<pg8::EpiGateB><<<G, 512, GEMM_LDS, stream>>>(pg8::Gemm{(const bf16_t*)(ws + WS_YB), (const bf16_t*)(ws + WS_WPB), M, D, 512, 0}, pg8::EpiGateB{(const bf16_t*)(ws + WS_PROJ), P.out, (bf16_t*)(ws + WS_MERGED)});
    k_gemm<pg8::EpiHout><<<G, 512, GEMM_LDS, stream>>>(pg8::Gemm{(const bf16_t*)(ws + WS_MERGED), (const bf16_t*)(ws + WS_WOUT), M, D, D, 0}, pg8::EpiHout{P.x, P.out, (bf16_t*)(ws + WS_HB), (float*)(ws + WS_SSQ)});
    k_gemm<pg8::EpiQ><<<G, 512, GEMM_LDS, stream>>>(pg8::Gemm{(const bf16_t*)(ws + WS_HB), (const bf16_t*)(ws + WS_WQ), M, PQ, D, 0}, pg8::EpiQ{(const float*)(ws + WS_SSQ), (bf16_t*)(ws + WS_Q)});
    k_cvt_experts<<<2048, 256, 0, stream>>>(P);
    k_topk<<<G, 512, peer::T_LDS_BYTES, stream>>>(P);
    k_peer_apply<<<M / 4, 256, 0, stream>>>(P);
}
```

```cpp
#include <hip/hip_runtime.h>
#include <hip/hip_cooperative_groups.h>
#include <cstdio>
#include <cstdint>

typedef unsigned short bf16_t;
typedef unsigned u32x4 __attribute__((ext_vector_type(4)));
typedef unsigned u32x2 __attribute__((ext_vector_type(2)));
typedef float f32x4 __attribute__((ext_vector_type(4)));
typedef __bf16 bf16x2_t __attribute__((ext_vector_type(2)));

constexpr int D = 1024, BATCH = 8, SEQ = 2048, M = BATCH * SEQ, INW = 5120;
constexpr int C_QA = 0, C_KA = 512, C_VA = 1024, C_QB = 1536, C_KB = 2048, C_VB = 2560, C_GA = 3072, C_GB = 4096;
constexpr int NEXP = 16384, PQ = 2048;
constexpr float EPS = 1e-6f;
constexpr float LOG2E = 1.4426950408889634f;
constexpr float WIN_SCALE = 32.f;
constexpr float QSCALE = 0.125f * LOG2E;

constexpr size_t MiB = 1u << 20;
constexpr size_t WS_PROJ = 0;
constexpr size_t WS_HB = 0;
constexpr size_t WS_Q = 32 * MiB;
constexpr size_t WS_U = 96 * MiB;
constexpr size_t WS_V = 112 * MiB;
constexpr size_t WS_SU = 128 * MiB;
constexpr size_t WS_SV = 128 * MiB + 65536;
constexpr size_t WS_XN = 160 * MiB;
constexpr size_t WS_YA = 160 * MiB;
constexpr size_t WS_YB = 176 * MiB;
constexpr size_t WS_IDX = 160 * MiB;
constexpr size_t WS_G = 168 * MiB;
constexpr size_t WS_MERGED = 192 * MiB;
constexpr size_t WS_TOPV = 192 * MiB;
constexpr size_t WS_TOPI = 208 * MiB;
constexpr size_t WS_WIN = 224 * MiB;
constexpr size_t WS_WIN8 = 226 * MiB;
constexpr size_t WS_XN8 = 192 * MiB;
constexpr size_t WS_WQ = 234 * MiB;
constexpr size_t WS_WOUT = 238 * MiB;
constexpr size_t WS_WPA = 240 * MiB;
constexpr size_t WS_WPB = 241 * MiB;
constexpr size_t WS_SK = 242 * MiB;
constexpr size_t WS_ROPE = 242 * MiB + 512 * 1024;
constexpr size_t WS_SSQ = 243 * MiB;
constexpr size_t WS_CTL = 244 * MiB;
constexpr size_t WS_END = 256 * MiB;

__device__ __forceinline__ float bf2f(unsigned v) { return __uint_as_float(v << 16); }
__device__ __forceinline__ float bflo(unsigned w) { return __uint_as_float(w << 16); }
__device__ __forceinline__ float bfhi(unsigned w) { return __uint_as_float(w & 0xffff0000u); }
__device__ __forceinline__ unsigned f2bf(float f) { unsigned u = __float_as_uint(f); return (u + 0x7fffu + ((u >> 16) & 1u)) >> 16; }
__device__ __forceinline__ unsigned pk2(float lo, float hi) { return f2bf(lo) | (f2bf(hi) << 16); }
__device__ __forceinline__ float wave_sum(float v) {
#pragma unroll
    for (int o = 1; o < 64; o <<= 1) v += __shfl_xor(v, o);
    return v;
}
__device__ __forceinline__ float sigmoidf_(float x) { return 1.f / (1.f + __expf(-x)); }
__device__ __forceinline__ float gelu_exact(float x) { return 0.5f * x * (1.f + erff(x * 0.70710678118654752f)); }

struct Ptrs {
    const float *x, *w_in, *w_pa, *w_pb, *w_out, *norm_mix, *norm_ffn, *norm_final, *lq1, *lk1, *lq2, *lk2, *subln, *rpb, *w_query, *sub_keys, *peer_u, *peer_v;
    float* out; unsigned char* ws;
};

__device__ __forceinline__ void transpose_item(const float* W, int K, int N, const float* gain, bf16_t* WT, float* scr, int item, int lane, int ldo = 0, int koff = 0, int ldw = 0) {
    if (ldo == 0) ldo = K;
    if (ldw == 0) ldw = N;
    const int nblk = N / 32, kb = item / nblk, nb = item % nblk, k0 = 64 * kb, n0 = 32 * nb;
    float wv[32];
#pragma unroll
    for (int i = 0; i < 32; ++i) { const int kk = 2 * i + (lane >> 5); wv[i] = W[(size_t)(k0 + kk) * ldw + n0 + (lane & 31)]; }
#pragma unroll
    for (int i = 0; i < 32; ++i) { const int kk = 2 * i + (lane >> 5); float w = wv[i]; if (gain) w *= gain[k0 + kk]; scr[kk * 33 + (lane & 31)] = w; }
    asm volatile("s_waitcnt lgkmcnt(0)" ::: "memory");
    const int c = lane & 7;
#pragma unroll
    for (int j = 0; j < 4; ++j) { const int n = (lane >> 3) + 8 * j; const float* s = scr + (8 * c) * 33 + n;
        u32x4 o; o.x = pk2(s[0 * 33], s[1 * 33]); o.y = pk2(s[2 * 33], s[3 * 33]); o.z = pk2(s[4 * 33], s[5 * 33]); o.w = pk2(s[6 * 33], s[7 * 33]);
        *(u32x4*)(WT + (size_t)(n0 + n) * ldo + koff + k0 + 8 * c) = o; }
    asm volatile("s_waitcnt lgkmcnt(0)" ::: "memory");
}
__device__ __forceinline__ void cvt8(const float* src, bf16_t* dst, size_t i8) {
    const f32x4 a = *(const f32x4*)(src + i8 * 8), b = *(const f32x4*)(src + i8 * 8 + 4);
    u32x4 o; o.x = pk2(a.x, a.y); o.y = pk2(a.z, a.w); o.z = pk2(b.x, b.y); o.w = pk2(b.z, b.w);
    *(u32x4*)(dst + i8 * 8) = o;
}
__device__ __forceinline__ void transpose_item8(const float* W, int K, int N, int ldw, const float* gain, float wscale, unsigned char* WT, float* scr, int item, int lane) {
    const int nblk = N / 32, kb = item / nblk, nb = item % nblk, k0 = 64 * kb, n0 = 32 * nb;
    float wv[32];
#pragma unroll
    for (int i = 0; i < 32; ++i) { const int kk = 2 * i + (lane >> 5); wv[i] = W[(size_t)(k0 + kk) * ldw + n0 + (lane & 31)]; }
#pragma unroll
    for (int i = 0; i < 32; ++i) { const int kk = 2 * i + (lane >> 5); float w = wv[i] * wscale; if (gain) w *= gain[k0 + kk]; scr[kk * 33 + (lane & 31)] = w; }
    asm volatile("s_waitcnt lgkmcnt(0)" ::: "memory");
    const int c = lane & 7;
#pragma unroll
    for (int j = 0; j < 4; ++j) { const int n = (lane >> 3) + 8 * j; const float* s = scr + (8 * c) * 33 + n;
        u32x2 o; o.x = __builtin_amdgcn_cvt_pk_fp8_f32(s[0 * 33], s[1 * 33], 0u, false); o.x = __builtin_amdgcn_cvt_pk_fp8_f32(s[2 * 33], s[3 * 33], o.x, true);
        o.y = __builtin_amdgcn_cvt_pk_fp8_f32(s[4 * 33], s[5 * 33], 0u, false); o.y = __builtin_amdgcn_cvt_pk_fp8_f32(s[6 * 33], s[7 * 33], o.y, true);
        *(u32x2*)(WT + (size_t)(n0 + n) * K + k0 + 8 * c) = o; }
    asm volatile("s_waitcnt lgkmcnt(0)" ::: "memory");
}
__device__ __forceinline__ void rms_rows_emit(const f32x4 (&v)[4], bf16_t* orow16, unsigned char* orow, int lane) {
    float s = 0.f;
#pragma unroll
    for (int j = 0; j < 4; ++j) s += (v[j].x * v[j].x + v[j].y * v[j].y) + (v[j].z * v[j].z + v[j].w * v[j].w);
    const float rstd = 1.f / sqrtf(wave_sum(s) * (1.f / D) + EPS);
    unsigned* o4 = (unsigned*)orow + lane; u32x2* o8 = (u32x2*)orow16 + lane;
#pragma unroll
    for (int j = 0; j < 4; ++j) { unsigned w = __builtin_amdgcn_cvt_pk_fp8_f32(v[j].x * rstd, v[j].y * rstd, 0u, false); w = __builtin_amdgcn_cvt_pk_fp8_f32(v[j].z * rstd, v[j].w * rstd, w, true); o4[64 * j] = w;
        u32x2 w2; w2.x = pk2(v[j].x * rstd, v[j].y * rstd); w2.y = pk2(v[j].z * rstd, v[j].w * rstd); o8[64 * j] = w2; }
}
__device__ __forceinline__ void rms_rows(const float* x, bf16_t* xn16, unsigned char* xn8, int m0, int step, int lane) {
    if (m0 >= M) return;
    f32x4 cur[4], nxt[4];
#pragma unroll
    for (int j = 0; j < 4; ++j) cur[j] = ((const f32x4*)(x + (size_t)m0 * D) + lane)[64 * j];
    for (int m = m0; m < M; m += step) {
        const int mn = (m + step < M) ? m + step : m;
#pragma unroll
        for (int j = 0; j < 4; ++j) nxt[j] = ((const f32x4*)(x + (size_t)mn * D) + lane)[64 * j];
        rms_rows_emit(cur, xn16 + (size_t)m * D, xn8 + (size_t)m * D, lane);
#pragma unroll
        for (int j = 0; j < 4; ++j) cur[j] = nxt[j];
    }
}
__device__ __forceinline__ void rms_row_to_bf16(const float* xrow, bf16_t* orow, int lane) {
    const f32x4* xr = (const f32x4*)xrow + lane;
    f32x4 v[4]; float s = 0.f;
#pragma unroll
    for (int j = 0; j < 4; ++j) { v[j] = xr[64 * j]; s += (v[j].x * v[j].x + v[j].y * v[j].y) + (v[j].z * v[j].z + v[j].w * v[j].w); }
    const float rstd = 1.f / sqrtf(wave_sum(s) * (1.f / D) + EPS);
    u32x2* o8 = (u32x2*)orow + lane;
#pragma unroll
    for (int j = 0; j < 4; ++j) { u32x2 w; w.x = pk2(v[j].x * rstd, v[j].y * rstd); w.y = pk2(v[j].z * rstd, v[j].w * rstd); o8[64 * j] = w; }
}

__device__ __forceinline__ void prep_phase(const Ptrs& P, unsigned char* shm, int G, int bx) {
    int tid_l = threadIdx.x; asm volatile("" : "+v"(tid_l));
    const int lane = tid_l & 63; const int wave = __builtin_amdgcn_readfirstlane(tid_l >> 6);
    const int gw = bx * 8 + wave, NGW = G * 8;
    float* scr = (float*)(shm + wave * (64 * 33 * 4));
    unsigned char* ws = P.ws;
    constexpr int N_BF = 1024;
    constexpr int I_INB = (D / 64) * (N_BF / 32), I_IN8 = (D / 64) * ((INW - N_BF) / 32), I_IN = I_INB + I_IN8, I_Q = (D / 64) * (PQ / 32), I_OUT = (D / 64) * (D / 32), I_PA = (512 / 64) * (D / 32);
    constexpr int NIT = I_IN + I_Q + I_OUT + 2 * I_PA;
    for (int it = gw; it < NIT; it += NGW) {
        int r = it;
        if (r < I_INB) { transpose_item(P.w_in, D, N_BF, P.norm_mix, (bf16_t*)(ws + WS_WIN), scr, r, lane, 0, 0, INW); continue; } r -= I_INB;
        if (r < I_IN8) { transpose_item8(P.w_in + N_BF, D, INW - N_BF, INW, P.norm_mix, WIN_SCALE, ws + WS_WIN8, scr, r, lane); continue; } r -= I_IN8;
        if (r < I_Q) { transpose_item(P.w_query, D, PQ, P.norm_ffn, (bf16_t*)(ws + WS_WQ), scr, r, lane); continue; } r -= I_Q;
        if (r < I_OUT) { transpose_item(P.w_out, D, D, nullptr, (bf16_t*)(ws + WS_WOUT), scr, r, lane); continue; } r -= I_OUT;
        if (r < I_PA) { transpose_item(P.w_pa, 512, D, nullptr, (bf16_t*)(ws + WS_WPA), scr, r, lane, 1024, 0); continue; } r -= I_PA;
        transpose_item(P.w_pb, 512, D, nullptr, (bf16_t*)(ws + WS_WPA), scr, r, lane, 1024, 512);
    }
    rms_rows(P.x, (bf16_t*)(ws + WS_XN), ws + WS_XN8, gw, NGW, lane);
    const size_t gt = (size_t)bx * 512 + threadIdx.x, NT = (size_t)G * 512;
    for (size_t i = gt; i < (size_t)16 * 128 * 128 / 8; i += NT) cvt8(P.sub_keys, (bf16_t*)(ws + WS_SK), i);
    for (size_t i = gt; i < (size_t)SEQ * 8; i += NT) {
        const int pos = (int)(i >> 3), k = (int)(i & 7);
        const float inv = k == 0 ? 1.0f : k == 1 ? 0.19392274f : k == 2 ? 0.03760603f : k == 3 ? 0.0072926646f : k == 4 ? 0.0014142136f : k == 5 ? 0.0002742482f : k == 6 ? 5.3182957e-05f : 1.0313385e-05f;
        const float ang = (float)pos * inv;
        float sn, cs; sincosf(ang, &sn, &cs);
        float* t = (float*)(ws + WS_ROPE) + (size_t)pos * 16;
        t[k] = cs; t[8 + k] = sn;
    }
}
__device__ __forceinline__ void cvt_row_fp8(const f32x4 (&rv)[4], unsigned char* dst, float* inv_scale, int lane) {
    const f32x4 a = rv[0], b = rv[1], c = rv[2], d = rv[3];
    float m = fmaxf(fmaxf(fmaxf(fabsf(a.x), fabsf(a.y)), fmaxf(fabsf(a.z), fabsf(a.w))), fmaxf(fmaxf(fabsf(b.x), fabsf(b.y)), fmaxf(fabsf(b.z), fabsf(b.w))));
    m = fmaxf(m, fmaxf(fmaxf(fmaxf(fabsf(c.x), fabsf(c.y)), fmaxf(fabsf(c.z), fabsf(c.w))), fmaxf(fmaxf(fabsf(d.x), fabsf(d.y)), fmaxf(fabsf(d.z), fabsf(d.w)))));
#pragma unroll
    for (int o = 1; o < 64; o <<= 1) m = fmaxf(m, __shfl_xor(m, o));
    m = fmaxf(m, 1e-30f);
    const float sc = 256.f / m;
    u32x4 w;
    w.x = __builtin_amdgcn_cvt_pk_fp8_f32(a.x * sc, a.y * sc, 0u, false); w.x = __builtin_amdgcn_cvt_pk_fp8_f32(a.z * sc, a.w * sc, w.x, true);
    w.y = __builtin_amdgcn_cvt_pk_fp8_f32(b.x * sc, b.y * sc, 0u, false); w.y = __builtin_amdgcn_cvt_pk_fp8_f32(b.z * sc, b.w * sc, w.y, true);
    w.z = __builtin_amdgcn_cvt_pk_fp8_f32(c.x * sc, c.y * sc, 0u, false); w.z = __builtin_amdgcn_cvt_pk_fp8_f32(c.z * sc, c.w * sc, w.z, true);
    w.w = __builtin_amdgcn_cvt_pk_fp8_f32(d.x * sc, d.y * sc, 0u, false); w.w = __builtin_amdgcn_cvt_pk_fp8_f32(d.z * sc, d.w * sc, w.w, true);
    *(u32x4*)(dst + (size_t)(lane >> 5) * (NEXP * 512) + (lane & 31) * 16) = w;
    if (lane == 0) *inv_scale = m * (1.f / 256.f);
}
__device__ __forceinline__ unsigned pack_i8x4(float a, float b, float c, float d) {
    const int q0 = (int)rintf(a), q1 = (int)rintf(b), q2 = (int)rintf(c), q3 = (int)rintf(d);
    return (unsigned)(q0 & 0xff) | ((unsigned)(q1 & 0xff) << 8) | ((unsigned)(q2 & 0xff) << 16) | ((unsigned)q3 << 24);
}
__device__ __forceinline__ void cvt_row_i8(const f32x4 (&rv)[4], unsigned char* dst, float* inv_scale, int lane) {
    const f32x4 a = rv[0], b = rv[1], c = rv[2], d = rv[3];
    float m = fmaxf(fmaxf(fmaxf(fabsf(a.x), fabsf(a.y)), fmaxf(fabsf(a.z), fabsf(a.w))), fmaxf(fmaxf(fabsf(b.x), fabsf(b.y)), fmaxf(fabsf(b.z), fabsf(b.w))));
    m = fmaxf(m, fmaxf(fmaxf(fmaxf(fabsf(c.x), fabsf(c.y)), fmaxf(fabsf(c.z), fabsf(c.w))), fmaxf(fmaxf(fabsf(d.x), fabsf(d.y)), fmaxf(fabsf(d.z), fabsf(d.w)))));
#pragma unroll
    for (int o = 1; o < 64; o <<= 1) m = fmaxf(m, __shfl_xor(m, o));
    m = fmaxf(m, 1e-30f);
    const float sc = 127.f / m;
    u32x4 w;
    w.x = pack_i8x4(a.x * sc, a.y * sc, a.z * sc, a.w * sc); w.y = pack_i8x4(b.x * sc, b.y * sc, b.z * sc, b.w * sc);
    w.z = pack_i8x4(c.x * sc, c.y * sc, c.z * sc, c.w * sc); w.w = pack_i8x4(d.x * sc, d.y * sc, d.z * sc, d.w * sc);
    *(u32x4*)(dst + (size_t)(lane >> 5) * (NEXP * 512) + (lane & 31) * 16) = w;
    if (lane == 0) *inv_scale = m * (1.f / 127.f);
}
__device__ __forceinline__ void cvt_experts_phase(const Ptrs& P, int G, int bx) {
    int tid_l = threadIdx.x; asm volatile("" : "+v"(tid_l));
    const int lane = tid_l & 63; const int wave = __builtin_amdgcn_readfirstlane(tid_l >> 6);
    const int step = G * 8; int r = bx * 8 + wave;
    if (r >= 2 * NEXP) return;
    f32x4 cur[4], nxt[4];
    { const float* src = (r < NEXP ? P.peer_u + (size_t)r * D : P.peer_v + (size_t)(r - NEXP) * D);
#pragma unroll
      for (int j = 0; j < 4; ++j) cur[j] = ((const f32x4*)src + lane * 4)[j]; }
    for (; r < 2 * NEXP; r += step) {
        const int rn = (r + step < 2 * NEXP) ? r + step : r;
        const float* srcn = (rn < NEXP ? P.peer_u + (size_t)rn * D : P.peer_v + (size_t)(rn - NEXP) * D);
#pragma unroll
        for (int j = 0; j < 4; ++j) nxt[j] = ((const f32x4*)srcn + lane * 4)[j];
        if (r < NEXP) cvt_row_i8(cur, P.ws + WS_U + (size_t)r * 512, (float*)(P.ws + WS_SU) + r, lane);
        else { const int e = r - NEXP; cvt_row_fp8(cur, P.ws + WS_V + (size_t)e * 512, (float*)(P.ws + WS_SV) + e, lane); }
#pragma unroll
        for (int j = 0; j < 4; ++j) cur[j] = nxt[j];
    }
}

namespace pg8 {
#define PG8_LAS __attribute__((address_space(3)))
typedef unsigned short bf16_t;
typedef short bf16x8 __attribute__((ext_vector_type(8)));
typedef float f32x4 __attribute__((ext_vector_type(4)));
typedef unsigned u32x4 __attribute__((ext_vector_type(4)));
typedef int v8i_t __attribute__((ext_vector_type(8)));
constexpr int BM = 256, BK = 64, HALF = 128, HTB = HALF * BK * 2  , STAGE_BYTES = 8 * HTB, NXCD = 8, WGM = 8;

__host__ __device__ __forceinline__ int lds_byte(int r, int c) { const int st = (r >> 4) * 2 + (c >> 5), rr = r & 15, cc = c & 31, ob = rr * 64 + cc * 2; return st * 1024 + (ob ^ (((ob >> 9) & 1) << 5)); }
__host__ __device__ __forceinline__ void stage_rc(int b, int& R, int& C) { const int st = b / 1024, sb = b % 1024, swz = sb ^ (((sb >> 9) & 1) << 5); R = (st >> 1) * 16 + swz / 64; C = (st & 1) * 32 + (swz % 64) / 2; }
__host__ __device__ __forceinline__ int perm32(int rho) { const int n = rho >> 4, i = rho & 15; return 8 * (i >> 2) + 4 * n + (i & 3); }

struct Unit { int pm, pn; };
struct Gemm { const bf16_t* A; const bf16_t* Bt; int M, N, K, pad; };

struct StaticOrder {
    int nM, nN, nwg, G, c;
    __host__ __device__ void init(int M, int N, int G_, int c_) { nM = M / BM; nN = N / BM; nwg = nM * nN; G = G_; c = c_; }
    __host__ __device__ bool next(int i, Unit& u) const {
        const long L = (long)i * G + c; if (L >= nwg) return false;
        int wgid = (int)L; { const int q = nwg / NXCD, r = nwg % NXCD, xcd = wgid % NXCD, off = wgid / NXCD; wgid = (xcd < r ? xcd * (q + 1) : r * (q + 1) + (xcd - r) * q) + off; }
        const int nig = WGM * nN, gid = wgid / nig, fm = gid * WGM, gsz = (nM - fm) < WGM ? (nM - fm) : WGM;
        u.pm = fm + ((wgid % nig) % gsz); u.pn = (wgid % nig) / gsz; return true;
    }
    __device__ __forceinline__ void a_ready(const Unit&) const {}
    __device__ __forceinline__ void done(const Unit&) const {}
};
__device__ __forceinline__ unsigned cvt_pk_bf16(float lo, float hi) { unsigned r; asm volatile("v_cvt_pk_bf16_f32 %0, %1, %2" : "=v"(r) : "v"(lo), "v"(hi)); return r; }
typedef float f32x2 __attribute__((ext_vector_type(2)));

__device__ __forceinline__ float sigm(float x) { return __builtin_amdgcn_rcpf(1.f + __builtin_amdgcn_exp2f(-1.4426950408889634f * x)); }
struct EpiProj {
    static constexpr bool PERM = true, AFTER_DRAIN = false, MID = false;
    bf16_t* O; const float* rope; float osc; int pn0;
    __device__ __forceinline__ void operator()(const f32x4 (&acc)[2][2][4][2], const Unit& u, int wr, int wc, int fr_, int fq_) const {
        int fr = fr_, fq = fq_; asm volatile("" : "+v"(fr), "+v"(fq));
        const int pn = u.pn + pn0;
        const int row0 = u.pm * BM + wr * 64 + fr, col0 = pn * BM + wc * 32 + 8 * fq;
        const float sc = ((pn < 2 || pn == 6 || pn == 7) ? QSCALE : 1.f) * osc;
        const bool dorope = (pn < 4) && ((wc & 1) == 0);
#pragma unroll
        for (int ai = 0; ai < 2; ++ai)
#pragma unroll
            for (int m = 0; m < 4; ++m) { const int row = row0 + ai * HALF + m * 16; bf16_t* rowp = O + (size_t)row * INW + col0;
                f32x4 c4[2] = {{1.f, 1.f, 1.f, 1.f}, {1.f, 1.f, 1.f, 1.f}}, s4[2] = {{0.f, 0.f, 0.f, 0.f}, {0.f, 0.f, 0.f, 0.f}};
                if (dorope) { const float* rp = rope + (size_t)(row & (SEQ - 1)) * 16; c4[0] = *(const f32x4*)(rp); c4[1] = *(const f32x4*)(rp + 4); s4[0] = *(const f32x4*)(rp + 8); s4[1] = *(const f32x4*)(rp + 12); }
#pragma unroll
                for (int bj = 0; bj < 2; ++bj) { f32x4 v0 = acc[ai][bj][m][0], v1 = acc[ai][bj][m][1];
                    if (dorope) { f32x4 o0, o1;
#pragma unroll
                        for (int j = 0; j < 4; ++j) { o0[j] = __shfl_xor(v0[j], 16); o1[j] = __shfl_xor(v1[j], 16); }
                        if (fq == 0) { v0 = v0 * c4[0] - o0 * s4[0]; v1 = v1 * c4[1] - o1 * s4[1]; }
                        else if (fq == 1) { v0 = v0 * c4[0] + o0 * s4[0]; v1 = v1 * c4[1] + o1 * s4[1]; } }
                    v0 = v0 * sc; v1 = v1 * sc; u32x4 w; w.x = cvt_pk_bf16(v0[0], v0[1]); w.y = cvt_pk_bf16(v0[2], v0[3]); w.z = cvt_pk_bf16(v1[0], v1[1]); w.w = cvt_pk_bf16(v1[2], v1[3]);
                    *(u32x4*)(rowp + bj * HALF) = w; } }
    }
};
struct EpiGate2 {
    static constexpr bool PERM = true, AFTER_DRAIN = false, MID = true;
    const bf16_t* proj; bf16_t* O;
    __device__ __forceinline__ void mid(f32x4 (&acc)[2][2][4][2], const Unit& u, int wr, int wc, int fr, int fq) const {
        int row0 = u.pm * BM + wr * 64 + fr, col0 = u.pn * BM + wc * 32 + 8 * fq;
        asm volatile("" : "+v"(row0), "+v"(col0));
#pragma unroll
        for (int ai = 0; ai < 2; ++ai)
#pragma unroll
            for (int m = 0; m < 4; ++m) { const int row = row0 + ai * HALF + m * 16;
#pragma unroll
                for (int bj = 0; bj < 2; ++bj) { const int col = col0 + bj * HALF;
                    const u32x4 ga = *(const u32x4*)(proj + (size_t)row * INW + C_GA + col), gb = *(const u32x4*)(proj + (size_t)row * INW + C_GB + col);
                    const unsigned a_[4] = {ga.x, ga.y, ga.z, ga.w}, b_[4] = {gb.x, gb.y, gb.z, gb.w};
#pragma unroll
                    for (int q = 0; q < 4; ++q) {
                        const float r0 = (1.f + __builtin_amdgcn_exp2f(-1.4426950408889634f * bflo(b_[q]))) * __builtin_amdgcn_rcpf(1.f + __builtin_amdgcn_exp2f(-1.4426950408889634f * bflo(a_[q])));
                        const float r1 = (1.f + __builtin_amdgcn_exp2f(-1.4426950408889634f * bfhi(b_[q]))) * __builtin_amdgcn_rcpf(1.f + __builtin_amdgcn_exp2f(-1.4426950408889634f * bfhi(a_[q])));
                        acc[ai][bj][m][q >> 1][(q & 1) * 2] *= r0; acc[ai][bj][m][q >> 1][(q & 1) * 2 + 1] *= r1; } }
                asm volatile("" ::: "memory"); }
    }
    __device__ __forceinline__ void operator()(const f32x4 (&acc)[2][2][4][2], const Unit& u, int wr, int wc, int fr, int fq) const {
        const int row0 = u.pm * BM + wr * 64 + fr, col0 = u.pn * BM + wc * 32 + 8 * fq;
#pragma unroll
        for (int ai = 0; ai < 2; ++ai)
#pragma unroll
            for (int m = 0; m < 4; ++m) { const int row = row0 + ai * HALF + m * 16;
#pragma unroll
                for (int bj = 0; bj < 2; ++bj) { const int col = col0 + bj * HALF; const u32x4 g = *(const u32x4*)(proj + (size_t)row * INW + C_GB + col);
                    f32x4 v0 = acc[ai][bj][m][0], v1 = acc[ai][bj][m][1];
                    v0[0] *= sigm(bflo(g.x)); v0[1] *= sigm(bfhi(g.x)); v0[2] *= sigm(bflo(g.y)); v0[3] *= sigm(bfhi(g.y));
                    v1[0] *= sigm(bflo(g.z)); v1[1] *= sigm(bfhi(g.z)); v1[2] *= sigm(bflo(g.w)); v1[3] *= sigm(bfhi(g.w));
                    u32x4 w; w.x = cvt_pk_bf16(v0[0], v0[1]); w.y = cvt_pk_bf16(v0[2], v0[3]); w.z = cvt_pk_bf16(v1[0], v1[1]); w.w = cvt_pk_bf16(v1[2], v1[3]);
                    *(u32x4*)(O + (size_t)row * D + col) = w; } }
    }
};
struct EpiHout {
    static constexpr bool PERM = true, AFTER_DRAIN = false, MID = false;
    const float* x; float* H; bf16_t* HB; float* ssq16;
    __device__ __forceinline__ void operator()(const f32x4 (&acc)[2][2][4][2], const Unit& u, int wr, int wc, int fr, int fq) const {
        const int row0 = u.pm * BM + wr * 64 + fr, col0 = u.pn * BM + wc * 32 + 8 * fq;
#pragma unroll
        for (int ai = 0; ai < 2; ++ai)
#pragma unroll
            for (int m = 0; m < 4; ++m) { const int row = row0 + ai * HALF + m * 16; float ss = 0.f;
#pragma unroll
                for (int bj = 0; bj < 2; ++bj) { const int col = col0 + bj * HALF; const float* xp = x + (size_t)row * D + col;
                    const f32x4 v0 = acc[ai][bj][m][0] + *(const f32x4*)xp, v1 = acc[ai][bj][m][1] + *(const f32x4*)(xp + 4);
                    u32x4 w; w.x = cvt_pk_bf16(v0[0], v0[1]); w.y = cvt_pk_bf16(v0[2], v0[3]); w.z = cvt_pk_bf16(v1[0], v1[1]); w.w = cvt_pk_bf16(v1[2], v1[3]);
                    *(u32x4*)(HB + (size_t)row * D + col) = w;
                    ss += (v0[0] * v0[0] + v0[1] * v0[1]) + (v0[2] * v0[2] + v0[3] * v0[3]) + (v1[0] * v1[0] + v1[1] * v1[1]) + (v1[2] * v1[2] + v1[3] * v1[3]); }
                ss += __shfl_xor(ss, 16); ss += __shfl_xor(ss, 32);
                if (fq == 0) ssq16[(size_t)row * 16 + u.pn * 4 + wc] = ss; }
    }
};
struct EpiQ {
    static constexpr bool PERM = true, AFTER_DRAIN = false, MID = false;
    const float* ssq16; bf16_t* O;
    __device__ __forceinline__ void operator()(const f32x4 (&acc)[2][2][4][2], const Unit& u, int wr, int wc, int fr, int fq) const {
        const int row0 = u.pm * BM + wr * 64 + fr, col0 = u.pn * BM + wc * 32 + 8 * fq;
#pragma unroll
        for (int ai = 0; ai < 2; ++ai)
#pragma unroll
            for (int m = 0; m < 4; ++m) { const int row = row0 + ai * HALF + m * 16; const f32x4* sp = (const f32x4*)(ssq16 + (size_t)row * 16);
                const f32x4 a = sp[0], b = sp[1], c = sp[2], d = sp[3];
                const float tot = ((a[0] + a[1]) + (a[2] + a[3])) + ((b[0] + b[1]) + (b[2] + b[3])) + ((c[0] + c[1]) + (c[2] + c[3])) + ((d[0] + d[1]) + (d[2] + d[3]));
                const float rstd = 1.f / sqrtf(tot * (1.f / D) + EPS);
#pragma unroll
                for (int bj = 0; bj < 2; ++bj) { const f32x4 v0 = acc[ai][bj][m][0] * rstd, v1 = acc[ai][bj][m][1] * rstd;
                    u32x4 w; w.x = cvt_pk_bf16(v0[0], v0[1]); w.y = cvt_pk_bf16(v0[2], v0[3]); w.z = cvt_pk_bf16(v1[0], v1[1]); w.w = cvt_pk_bf16(v1[2], v1[3]);
                    *(u32x4*)(O + (size_t)row * PQ + col0 + bj * HALF) = w; } }
    }
};
template <class Epi, class Sched, bool ALIGN_EPI = false, bool SP2 = false, bool FP8 = false>
__device__ __forceinline__ void gemm_phase(PG8_LAS unsigned char* lds, const Gemm g, const Sched& S, const Epi& E) {
    int tid_l = threadIdx.x; asm volatile("" : "+v"(tid_l));
    const int tid = tid_l, wid = __builtin_amdgcn_readfirstlane(tid >> 6), lane = tid & 63, wr = wid >> 2, wc = wid & 3, fr = lane & 15, fq = lane >> 4;
    const int K = g.K, nt = K / BK;
    unsigned voffA[2], voffB[2];
#pragma unroll
    for (int i = 0; i < 2; ++i) { int R, C; stage_rc(tid * 16 + i * 8192, R, C); const int Rb = Epi::PERM ? ((R & ~31) + perm32(R & 31)) : R;
        voffA[i] = (unsigned)(R * K + C) * 2u; voffB[i] = (unsigned)(Rb * K + C) * 2u; }
    const size_t kstep = (size_t)(BK * 2);
    const size_t hstep = (size_t)HALF * K * 2;
    const size_t tstep = 2 * hstep;
    const unsigned ldsw = (unsigned)wid * 1024u;
    const int aoff = lds_byte(wr * 64 + fr, fq * 8), boff = lds_byte(wc * 32 + fr, fq * 8);
    const int aoffF0 = FP8 ? lds_byte(wr * 64 + fr, fq * 16) : 0, boffF0 = FP8 ? lds_byte(wc * 32 + fr, fq * 16) : 0;
#define PG8_SA(b, h) (((b) * 2 + (h)) * HTB)
#define PG8_SB(b, h) ((4 + (b) * 2 + (h)) * HTB)
#define PG8_STAGE(bufoff, gbase, voff) do { _Pragma("unroll") for (int _i = 0; _i < 2; ++_i) \
        __builtin_amdgcn_global_load_lds((const unsigned*)((const char*)(gbase) + (voff)[_i]), (PG8_LAS unsigned*)(lds + (bufoff) + ldsw + _i * 8192), 16, 0, 0); } while (0)
#define PG8_LDA(dst, b, h) do { if constexpr (FP8) { _Pragma("unroll") for (int m = 0; m < 4; ++m) { const u32x4 l_ = *(const PG8_LAS u32x4*)(lds + PG8_SA(b, h) + aoffF0 + m * 2048), h_ = *(const PG8_LAS u32x4*)(lds + PG8_SA(b, h) + aoffF0 + m * 2048 + 16); \
            dst##8[m] = (v8i_t){(int)l_.x, (int)l_.y, (int)l_.z, (int)l_.w, (int)h_.x, (int)h_.y, (int)h_.z, (int)h_.w}; } } \
        else { _Pragma("unroll") for (int m = 0; m < 4; ++m) _Pragma("unroll") for (int k = 0; k < 2; ++k) dst[m][k] = *(const PG8_LAS bf16x8*)(lds + PG8_SA(b, h) + aoff + m * 2048 + k * 1024); } } while (0)
#define PG8_LDB(dst, b, h) do { if constexpr (FP8) { _Pragma("unroll") for (int n = 0; n < 2; ++n) { const u32x4 l_ = *(const PG8_LAS u32x4*)(lds + PG8_SB(b, h) + boffF0 + n * 2048), h_ = *(const PG8_LAS u32x4*)(lds + PG8_SB(b, h) + boffF0 + n * 2048 + 16); \
            dst##8[n] = (v8i_t){(int)l_.x, (int)l_.y, (int)l_.z, (int)l_.w, (int)h_.x, (int)h_.y, (int)h_.z, (int)h_.w}; } } \
        else { _Pragma("unroll") for (int n = 0; n < 2; ++n) _Pragma("unroll") for (int k = 0; k < 2; ++k) dst[n][k] = *(const PG8_LAS bf16x8*)(lds + PG8_SB(b, h) + boff + n * 2048 + k * 1024); } } while (0)
#define PG8_MMA(ai, bj, At, Bt) do { __builtin_amdgcn_s_setprio(1); \
        if constexpr (FP8) { _Pragma("unroll") for (int m = 0; m < 4; ++m) _Pragma("unroll") for (int n = 0; n < 2; ++n) \
            asm volatile("v_mfma_scale_f32_16x16x128_f8f6f4 %0, %1, %2, %0, %3, %3 op_sel_hi:[0,0,0]" : "+v"(acc[ai][bj][m][n]) : "v"(Bt##8[n]), "v"(At##8[m]), "v"(mxone)); } \
        else { _Pragma("unroll") for (int m = 0; m < 4; ++m) _Pragma("unroll") for (int n = 0; n < 2; ++n) _Pragma("unroll") for (int k = 0; k < 2; ++k) \
            acc[ai][bj][m][n] = __builtin_amdgcn_mfma_f32_16x16x32_bf16(Bt[n][k], At[m][k], acc[ai][bj][m][n], 0, 0, 0); } \
        __builtin_amdgcn_s_setprio(0); } while (0)
#define PG8_WAIT_V(n) asm volatile("s_waitcnt vmcnt(" #n ")" ::: "memory")
#define PG8_WAIT_L(n) asm volatile("s_waitcnt lgkmcnt(" #n ")" ::: "memory")
#define PG8_BAR __builtin_amdgcn_s_barrier()
#define PG8_SCHED __builtin_amdgcn_sched_barrier(0)
    Unit cur, nxt; int ui = 0;
    if (!S.next(0, cur)) return;
    f32x4 acc[2][2][4][2];
#pragma unroll
    for (int a = 0; a < 2; ++a)
#pragma unroll
        for (int b = 0; b < 2; ++b)
#pragma unroll
            for (int m = 0; m < 4; ++m)
#pragma unroll
                for (int n = 0; n < 2; ++n) acc[a][b][m][n] = (f32x4){0.f, 0.f, 0.f, 0.f};
    bf16x8 At[4][2], B0[2][2], B1[2][2]; v8i_t At8[4], B08[2], B18[2];
    int mxone = 0x7F7F7F7F; asm volatile("" : "+v"(mxone));
    const char* cA = (const char*)g.A + (size_t)cur.pm * tstep; const char* cB = (const char*)g.Bt + (size_t)cur.pn * tstep;
    S.a_ready(cur);
    if constexpr (SP2) {
        PG8_STAGE(PG8_SB(0, 0), cB, voffB); PG8_STAGE(PG8_SB(0, 1), cB + hstep, voffB); PG8_STAGE(PG8_SA(0, 0), cA, voffA); PG8_STAGE(PG8_SA(0, 1), cA + hstep, voffA);
        if (wr == 1) PG8_BAR;
        PG8_WAIT_V(2); PG8_BAR;
        PG8_STAGE(PG8_SB(1, 0), cB + kstep, voffB); PG8_STAGE(PG8_SA(1, 0), cA + kstep, voffA); PG8_STAGE(PG8_SB(1, 1), cB + hstep + kstep, voffB);
        PG8_WAIT_V(6); PG8_BAR;
    } else {
        PG8_STAGE(PG8_SB(0, 0), cB, voffB); PG8_STAGE(PG8_SA(0, 0), cA, voffA); PG8_STAGE(PG8_SB(0, 1), cB + hstep, voffB); PG8_STAGE(PG8_SA(0, 1), cA + hstep, voffA);
        if (wr == 1) PG8_BAR;
        PG8_WAIT_V(4); PG8_BAR;
        PG8_STAGE(PG8_SB(1, 0), cB + kstep, voffB); PG8_STAGE(PG8_SA(1, 0), cA + kstep, voffA); PG8_STAGE(PG8_SB(1, 1), cB + hstep + kstep, voffB);
        PG8_WAIT_V(6); PG8_BAR;
    }
    for (;;) {
        const bool has_next = S.next(ui + 1, nxt);
        const char* nA = has_next ? (const char*)g.A + (size_t)nxt.pm * tstep : cA; const char* nB = has_next ? (const char*)g.Bt + (size_t)nxt.pn * tstep : cB;
#pragma unroll 1
        for (int t = 0; t < nt; t += 2) {
            if constexpr (Epi::MID) { if (t == nt / 2) E.mid(acc, cur, wr, wc, fr, fq); }
            const bool last = (t == nt - 2);
            const char* a1 = cA + (size_t)(t + 1) * kstep;
            const char* a2 = last ? nA : cA + (size_t)(t + 2) * kstep; const char* b2 = last ? nB : cB + (size_t)(t + 2) * kstep;
            const char* a3 = a2 + kstep; const char* b3 = b2 + kstep;
            if (last && has_next) S.a_ready(nxt);
            if constexpr (SP2) {
            PG8_LDB(B0, 0, 0); PG8_LDB(B1, 0, 1); PG8_SCHED; PG8_LDA(At, 0, 0); PG8_STAGE(PG8_SA(1, 1), a1 + hstep, voffA);
            PG8_WAIT_V(8); PG8_WAIT_L(0); PG8_BAR; PG8_MMA(0, 0, At, B0); PG8_MMA(0, 1, At, B1); PG8_BAR; PG8_SCHED;
            PG8_LDA(At, 0, 1); PG8_STAGE(PG8_SB(0, 0), b2, voffB); PG8_STAGE(PG8_SB(0, 1), b2 + hstep, voffB); PG8_STAGE(PG8_SA(0, 0), a2, voffA);
            PG8_WAIT_V(8); PG8_WAIT_L(0); PG8_BAR; PG8_MMA(1, 0, At, B0); PG8_MMA(1, 1, At, B1); PG8_BAR; PG8_SCHED;
            PG8_LDB(B0, 1, 0); PG8_LDB(B1, 1, 1); PG8_SCHED; PG8_LDA(At, 1, 0); PG8_STAGE(PG8_SA(0, 1), a2 + hstep, voffA);
            PG8_WAIT_V(8); PG8_WAIT_L(0); PG8_BAR; PG8_MMA(0, 0, At, B0); PG8_MMA(0, 1, At, B1); PG8_BAR; PG8_SCHED;
            PG8_LDA(At, 1, 1); PG8_STAGE(PG8_SB(1, 0), b3, voffB); PG8_STAGE(PG8_SB(1, 1), b3 + hstep, voffB); PG8_STAGE(PG8_SA(1, 0), a3, voffA);
            PG8_WAIT_V(8); PG8_WAIT_L(0); PG8_BAR; PG8_MMA(1, 0, At, B0); PG8_MMA(1, 1, At, B1); PG8_BAR; PG8_SCHED;
            } else {
            PG8_LDB(B0, 0, 0); PG8_SCHED; PG8_LDA(At, 0, 0); PG8_STAGE(PG8_SA(1, 1), a1 + hstep, voffA);
            PG8_WAIT_L(8); PG8_BAR; PG8_WAIT_L(0); PG8_MMA(0, 0, At, B0); PG8_BAR; PG8_SCHED;
            PG8_LDB(B1, 0, 1); PG8_STAGE(PG8_SB(0, 0), b2, voffB);
            PG8_BAR; PG8_WAIT_L(0); PG8_MMA(0, 1, At, B1); PG8_BAR;
            PG8_LDA(At, 0, 1); PG8_STAGE(PG8_SA(0, 0), a2, voffA);
            PG8_BAR; PG8_WAIT_L(0); PG8_MMA(1, 0, At, B0); PG8_BAR; PG8_SCHED;
            PG8_STAGE(PG8_SB(0, 1), b2 + hstep, voffB);
            PG8_WAIT_V(6); PG8_BAR; PG8_MMA(1, 1, At, B1); PG8_BAR;
            PG8_LDB(B0, 1, 0); PG8_SCHED; PG8_LDA(At, 1, 0); PG8_STAGE(PG8_SA(0, 1), a2 + hstep, voffA);
            PG8_WAIT_L(8); PG8_BAR; PG8_WAIT_L(0); PG8_MMA(0, 0, At, B0); PG8_BAR; PG8_SCHED;
            PG8_LDB(B1, 1, 1); PG8_STAGE(PG8_SB(1, 0), b3, voffB);
            PG8_BAR; PG8_WAIT_L(0); PG8_MMA(0, 1, At, B1); PG8_BAR;
            PG8_LDA(At, 1, 1); PG8_STAGE(PG8_SA(1, 0), a3, voffA);
            PG8_BAR; PG8_WAIT_L(0); PG8_MMA(1, 0, At, B0); PG8_BAR; PG8_SCHED;
            PG8_STAGE(PG8_SB(1, 1), b3 + hstep, voffB);
            PG8_WAIT_V(6); PG8_BAR; PG8_MMA(1, 1, At, B1); PG8_BAR;
            }
        }
        if constexpr (ALIGN_EPI) { if (wr == 0) PG8_BAR; }
        if constexpr (FP8) { asm volatile("s_nop 15\n\ts_nop 7" ::: "memory"); PG8_SCHED; }
        if constexpr (!Epi::AFTER_DRAIN) { E(acc, cur, wr, wc, fr, fq); S.done(cur); }
        if (!has_next) break;
#pragma unroll
        for (int a = 0; a < 2; ++a)
#pragma unroll
            for (int b = 0; b < 2; ++b)
#pragma unroll
                for (int m = 0; m < 4; ++m)
#pragma unroll
                    for (int n = 0; n < 2; ++n) acc[a][b][m][n] = (f32x4){0.f, 0.f, 0.f, 0.f};
        cur = nxt; cA = nA; cB = nB; ++ui;
        if constexpr (ALIGN_EPI) { if (wr == 1) PG8_BAR; }
    }
    PG8_WAIT_V(0);
    if constexpr (!ALIGN_EPI) { if (wr == 0) PG8_BAR; }
    PG8_BAR;
    if constexpr (Epi::AFTER_DRAIN) { E.fused(acc, cur, wr, wc, fr, fq, lds, wid, lane); S.done(cur); }
#undef PG8_SA
#undef PG8_SB
#undef PG8_STAGE
#undef PG8_LDA
#undef PG8_LDB
#undef PG8_MMA
#undef PG8_WAIT_V
#undef PG8_WAIT_L
#undef PG8_BAR
#undef PG8_SCHED
}
}

__device__ __forceinline__ float lambda_full(const Ptrs& P) {
    float a = 0.f, b = 0.f;
    for (int i = 0; i < 64; ++i) { a += P.lq1[i] * P.lk1[i]; b += P.lq2[i] * P.lk2[i]; }
    return __expf(a) - __expf(b) + 0.2f;
}

namespace att {
typedef short bf16x8 __attribute__((ext_vector_type(8)));
typedef short s16x4 __attribute__((ext_vector_type(4)));
typedef float f32x16 __attribute__((ext_vector_type(16)));
typedef float f32x2_t __attribute__((ext_vector_type(2)));
typedef __attribute__((address_space(3))) const char* lds_cptr;
typedef __attribute__((address_space(3))) char* lds_ptr;
__device__ __forceinline__ int crow(int r, int hi) { return (r & 3) + 8 * (r >> 2) + 4 * hi; }
__device__ __forceinline__ void glds16(const void* gsrc, unsigned lds_dst) { unsigned keep;
    asm volatile("s_mov_b32 %0, m0\n\ts_mov_b32 m0, %2\n\ts_nop 0\n\tglobal_load_lds_dwordx4 %1, off\n\ts_mov_b32 m0, %0" : "=&s"(keep) : "v"(gsrc), "s"(lds_dst) : "memory"); }
__device__ __forceinline__ unsigned cvtpk(float lo, float hi) { f32x2_t v = {lo, hi}; bf16x2_t b = __builtin_convertvector(v, bf16x2_t); return __builtin_bit_cast(unsigned, b); }
#define ATT_WAIT_BAR(N) asm volatile("s_waitcnt vmcnt(" #N ") lgkmcnt(0)\n\ts_barrier" ::: "memory")
#define ATT_LDSWAIT() asm volatile("s_waitcnt lgkmcnt(0)" ::: "memory")
#define ATT_SBAR() __builtin_amdgcn_sched_barrier(0)
template <bool REL> __device__ __forceinline__ void qkt(f32x16& p0, f32x16& p1, lds_cptr Kslot, const bf16x8* qr, const f32x16& negm, int r32, int hi) {
    lds_cptr kb = Kslot + hi * 1024 + r32 * 16;
#pragma unroll
    for (int d0 = 0; d0 < 4; ++d0) {
        const bf16x8 b0 = *(const __attribute__((address_space(3))) bf16x8*)(kb + d0 * 2048);
        const bf16x8 b1 = *(const __attribute__((address_space(3))) bf16x8*)(kb + d0 * 2048 + 512);
        if (d0 == 0) { if (REL) { p0 = __builtin_amdgcn_mfma_f32_32x32x16_bf16(b0, qr[0], negm, 0, 0, 0); p1 = __builtin_amdgcn_mfma_f32_32x32x16_bf16(b1, qr[0], negm, 0, 0, 0); }
                       else { p0 = __builtin_amdgcn_mfma_f32_32x32x16_bf16(b0, qr[0], f32x16{}, 0, 0, 0); p1 = __builtin_amdgcn_mfma_f32_32x32x16_bf16(b1, qr[0], f32x16{}, 0, 0, 0); } }
        else { p0 = __builtin_amdgcn_mfma_f32_32x32x16_bf16(b0, qr[d0], p0, 0, 0, 0); p1 = __builtin_amdgcn_mfma_f32_32x32x16_bf16(b1, qr[d0], p1, 0, 0, 0); } }
}
__device__ __forceinline__ float rowmax32(const f32x16& p0, const f32x16& p1) {
    float a = fmaxf(p0[0], p1[0]);
#pragma unroll
    for (int r = 1; r < 16; ++r) a = fmaxf(a, fmaxf(p0[r], p1[r]));
    auto rr = __builtin_amdgcn_permlane32_swap(__float_as_uint(a), __float_as_uint(a), false, false);
    return fmaxf(__uint_as_float(rr[0]), __uint_as_float(rr[1]));
}
__device__ __forceinline__ float halfsum(float a) { auto rr = __builtin_amdgcn_permlane32_swap(__float_as_uint(a), __float_as_uint(a), false, false); return __uint_as_float(rr[0]) + __uint_as_float(rr[1]); }
template <int ND0> __device__ __forceinline__ void pv(f32x16* o, int vb, bf16x8 pa0, bf16x8 pa1, bf16x8 pa2, bf16x8 pa3) {
#pragma unroll
    for (int d0 = 0; d0 < ND0; ++d0) { s16x4 lo[4], hi[4];
#pragma unroll
        for (int ks = 0; ks < 4; ++ks) {
            asm volatile("ds_read_b64_tr_b16 %0,%1 offset:%c2" : "=&v"(lo[ks]) : "v"(vb), "i"(d0 * 4096 + ks * 1024) : "memory");
            asm volatile("ds_read_b64_tr_b16 %0,%1 offset:%c2" : "=&v"(hi[ks]) : "v"(vb), "i"(d0 * 4096 + ks * 1024 + 512) : "memory"); }
        asm volatile("s_waitcnt lgkmcnt(0)" ::: "memory"); ATT_SBAR();
#define ATT_PK(k) (bf16x8){lo[k][0], lo[k][1], lo[k][2], lo[k][3], hi[k][0], hi[k][1], hi[k][2], hi[k][3]}
        o[d0] = __builtin_amdgcn_mfma_f32_32x32x16_bf16(pa0, ATT_PK(0), o[d0], 0, 0, 0);
        o[d0] = __builtin_amdgcn_mfma_f32_32x32x16_bf16(pa1, ATT_PK(1), o[d0], 0, 0, 0);
        o[d0] = __builtin_amdgcn_mfma_f32_32x32x16_bf16(pa2, ATT_PK(2), o[d0], 0, 0, 0);
        o[d0] = __builtin_amdgcn_mfma_f32_32x32x16_bf16(pa3, ATT_PK(3), o[d0], 0, 0, 0);
#undef ATT_PK
    }
}
template <int ND0, int THR, bool REL> __device__ __forceinline__ void softmax_tile(f32x16& p0, f32x16& p1, float& mrun, float& lsum, f32x16& negm, bool first, f32x16* o, __attribute__((address_space(3))) float* wsf, int r32, int hi,
                                                                   u32x4& pw0, u32x4& pw1, u32x4& pw2, u32x4& pw3) {
    float rm = rowmax32(p0, p1);
    if (!REL) rm -= mrun;
    if (first) {
        mrun = REL ? rm : mrun + rm;
        if (REL) {
#pragma unroll
            for (int r = 0; r < 16; ++r) { p0[r] -= rm; p1[r] -= rm; negm[r] = -mrun; } }
    } else if (__any(rm > (float)THR)) {
        const float dl = fmaxf(rm, 0.f), alpha = __builtin_amdgcn_exp2f(-dl); lsum *= alpha; mrun += dl;
        if (REL) {
#pragma unroll
            for (int r = 0; r < 16; ++r) { p0[r] -= dl; p1[r] -= dl; negm[r] = -mrun; } }
        if (hi == 0) wsf[r32] = alpha;
        ATT_LDSWAIT();
#pragma unroll
        for (int g = 0; g < 4; ++g) { const f32x4 a4 = *(const __attribute__((address_space(3))) f32x4*)(wsf + 8 * g + 4 * hi);
#pragma unroll
            for (int d0 = 0; d0 < ND0; ++d0) { o[d0][4 * g + 0] *= a4[0]; o[d0][4 * g + 1] *= a4[1]; o[d0][4 * g + 2] *= a4[2]; o[d0][4 * g + 3] *= a4[3]; } }
        ATT_LDSWAIT();
    }
    float s = 0.f;
#pragma unroll
    for (int r = 0; r < 16; ++r) { p0[r] = __builtin_amdgcn_exp2f(REL ? p0[r] : p0[r] - mrun); p1[r] = __builtin_amdgcn_exp2f(REL ? p1[r] : p1[r] - mrun); s += p0[r] + p1[r]; }
    lsum += s;
    pw0 = (u32x4){cvtpk(p0[0], p0[1]), cvtpk(p0[2], p0[3]), cvtpk(p0[4], p0[5]), cvtpk(p0[6], p0[7])};
    pw1 = (u32x4){cvtpk(p0[8], p0[9]), cvtpk(p0[10], p0[11]), cvtpk(p0[12], p0[13]), cvtpk(p0[14], p0[15])};
    pw2 = (u32x4){cvtpk(p1[0], p1[1]), cvtpk(p1[2], p1[3]), cvtpk(p1[4], p1[5]), cvtpk(p1[6], p1[7])};
    pw3 = (u32x4){cvtpk(p1[8], p1[9]), cvtpk(p1[10], p1[11]), cvtpk(p1[12], p1[13]), cvtpk(p1[14], p1[15])};
}

constexpr int A_SLOTK = 8192, A_SLOTV = 16384, A_NS = 3, A_NSV = 4;
constexpr int A_LDS_K = 0, A_LDS_V = A_NS * A_SLOTK, A_LDS_WS = A_LDS_V + A_NSV * A_SLOTV, A_LDS_ST = A_LDS_WS + 8 * 256, A_LDS_BYTES = A_LDS_ST + 8 * 8192;
__device__ __forceinline__ void attn_a_unit(int b, int h, int qb, const bf16_t* proj, bf16_t* ya, const float* subln, float lam, unsigned char* shm) {
    int tid_l = threadIdx.x; asm volatile("" : "+v"(tid_l));
    const int tid = tid_l, lane = tid & 63, r32 = lane & 31, hi = lane >> 5; const int wid = __builtin_amdgcn_readfirstlane(tid >> 6);
    const size_t rowbase = (size_t)b * SEQ; const int q0 = qb * 256;
    constexpr int NT = SEQ / 64;
    const unsigned lds0 = (unsigned)(uintptr_t)shm;
    const lds_cptr shm3 = (lds_cptr)shm;
    __attribute__((address_space(3))) float* wsf = (__attribute__((address_space(3))) float*)((lds_ptr)shm + A_LDS_WS) + wid * 64;
    const int vb0 = (int)(lds0 + A_LDS_V) + ((lane >> 4) & 1) * 32 + (lane & 3) * 8 + (4 * hi + ((lane & 15) >> 2)) * 64;
    __attribute__((address_space(3))) bf16_t* stg = (__attribute__((address_space(3))) bf16_t*)((lds_ptr)shm + A_LDS_ST) + wid * 4096;
    for (int mp = 0; mp < 2; ++mp) {
        const bf16_t* Kh = proj + rowbase * INW + C_KA + h * 128 + mp * 64;
        const bf16_t* Vh = proj + rowbase * INW + C_VA + h * 128;
        const bf16_t* Qw = proj + (rowbase + q0 + wid * 32) * INW + C_QA + h * 128 + mp * 64;
        const int pA = 2 * wid, pB = 2 * wid + 1;
        const unsigned kdst = lds0 + A_LDS_K + wid * 1024, vdstA = lds0 + A_LDS_V + pA * 1024, vdstB = lds0 + A_LDS_V + pB * 1024;
#define A_DMA(t, slot, vsl) do { int ln_ = lane; asm volatile("" : "+v"(ln_)); \
        const bf16_t* ksrc_ = Kh + (size_t)((t) * 64 + ln_) * INW + wid * 8; \
        const bf16_t* vsrcA_ = Vh + (size_t)((t) * 64 + 16 * (pA & 3) + (ln_ >> 2)) * INW + (pA >> 2) * 32 + (ln_ & 3) * 8; \
        const bf16_t* vsrcB_ = Vh + (size_t)((t) * 64 + 16 * (pB & 3) + (ln_ >> 2)) * INW + (pB >> 2) * 32 + (ln_ & 3) * 8; \
        glds16(ksrc_, (unsigned)__builtin_amdgcn_readfirstlane(kdst + (slot) * A_SLOTK)); \
        glds16(vsrcA_, (unsigned)__builtin_amdgcn_readfirstlane(vdstA + (vsl) * A_SLOTV)); \
        glds16(vsrcB_, (unsigned)__builtin_amdgcn_readfirstlane(vdstB + (vsl) * A_SLOTV)); } while (0)
        A_DMA(0, 0, 0); A_DMA(1, 1, 1);
        bf16x8 qr[4];
#pragma unroll
        for (int d0 = 0; d0 < 4; ++d0) qr[d0] = *(const bf16x8*)(Qw + (size_t)r32 * INW + d0 * 16 + hi * 8);
        f32x16 o[4]; o[0] = f32x16{}; o[1] = f32x16{}; o[2] = f32x16{}; o[3] = f32x16{};
        float mrun = 0.f, lsum = 0.f; f32x16 negm = f32x16{};
        int slot = 0, slot2 = 2, vslot = 0, vslot2 = 2, vprev = 3;
        const bool late = wid >= 4;
        u32x4 pw0 = {}, pw1 = {}, pw2 = {}, pw3 = {};
        for (int t = 0; t < NT; ++t) {
            if (t + 1 < NT) { ATT_WAIT_BAR(3); } else { ATT_WAIT_BAR(0); }
            if (t + 2 < NT) A_DMA(t + 2, slot2, vslot2);
            if (late && t > 0) pv<4>(o, vb0 + vprev * A_SLOTV, __builtin_bit_cast(bf16x8, pw0), __builtin_bit_cast(bf16x8, pw1), __builtin_bit_cast(bf16x8, pw2), __builtin_bit_cast(bf16x8, pw3));
            f32x16 p0, p1;
            qkt<false>(p0, p1, shm3 + A_LDS_K + slot * A_SLOTK, qr, negm, r32, hi);
            softmax_tile<4, 8, false>(p0, p1, mrun, lsum, negm, t == 0, o, wsf, r32, hi, pw0, pw1, pw2, pw3);
            if (!late) pv<4>(o, vb0 + vslot * A_SLOTV, __builtin_bit_cast(bf16x8, pw0), __builtin_bit_cast(bf16x8, pw1), __builtin_bit_cast(bf16x8, pw2), __builtin_bit_cast(bf16x8, pw3));
            slot = (slot == 2) ? 0 : slot + 1; slot2 = (slot2 == 2) ? 0 : slot2 + 1;
            vprev = vslot; vslot = (vslot + 1) & 3; vslot2 = (vslot2 + 1) & 3;
        }
        if (late) pv<4>(o, vb0 + vprev * A_SLOTV, __builtin_bit_cast(bf16x8, pw0), __builtin_bit_cast(bf16x8, pw1), __builtin_bit_cast(bf16x8, pw2), __builtin_bit_cast(bf16x8, pw3));
#undef A_DMA
        const float lt = halfsum(lsum);
        if (hi == 0) wsf[32 + r32] = lt;
        ATT_LDSWAIT();
        float rli[16];
#pragma unroll
        for (int g = 0; g < 4; ++g) { const f32x4 l4 = *(const __attribute__((address_space(3))) f32x4*)(wsf + 32 + 8 * g + 4 * hi);
            rli[4 * g + 0] = __builtin_amdgcn_rcpf(l4[0]); rli[4 * g + 1] = __builtin_amdgcn_rcpf(l4[1]); rli[4 * g + 2] = __builtin_amdgcn_rcpf(l4[2]); rli[4 * g + 3] = __builtin_amdgcn_rcpf(l4[3]); }
        ATT_LDSWAIT();
        if (mp == 0) {
#pragma unroll
            for (int d0 = 0; d0 < 4; ++d0)
#pragma unroll
                for (int r = 0; r < 16; ++r) stg[crow(r, hi) * 128 + d0 * 32 + r32] = (bf16_t)f2bf(o[d0][r] * rli[r]);
            asm volatile("s_waitcnt lgkmcnt(0)\n\ts_barrier" ::: "memory");
        } else {
            float ss[16];
#pragma unroll
            for (int r = 0; r < 16; ++r) ss[r] = 0.f;
#pragma unroll
            for (int d0 = 0; d0 < 4; ++d0)
#pragma unroll
                for (int r = 0; r < 16; ++r) { const float a = bf2f(stg[crow(r, hi) * 128 + d0 * 32 + r32]); const float y = a - lam * o[d0][r] * rli[r]; o[d0][r] = y; ss[r] += y * y; }
#pragma unroll
            for (int r = 0; r < 16; ++r) { float v = ss[r]; v += __shfl_xor(v, 1); v += __shfl_xor(v, 2); v += __shfl_xor(v, 4); v += __shfl_xor(v, 8); v += __shfl_xor(v, 16);
                ss[r] = 0.8f / sqrtf(v * (1.f / 128.f) + EPS); }
            ATT_LDSWAIT();
#pragma unroll
            for (int d0 = 0; d0 < 4; ++d0) { const float gsub = subln[d0 * 32 + r32];
#pragma unroll
                for (int r = 0; r < 16; ++r) stg[crow(r, hi) * 128 + d0 * 32 + r32] = (bf16_t)f2bf(o[d0][r] * ss[r] * gsub); }
            ATT_LDSWAIT();
            bf16_t* Yw = ya + (rowbase + q0 + wid * 32) * 1024 + h * 128;
#pragma unroll
            for (int i = 0; i < 8; ++i) { const int row = i * 4 + (lane >> 4), ch = lane & 15; const u32x4 v = *(const __attribute__((address_space(3))) u32x4*)(stg + row * 128 + ch * 8); *(u32x4*)(Yw + (size_t)row * 1024 + ch * 8) = v; }
            asm volatile("s_waitcnt lgkmcnt(0)\n\ts_barrier" ::: "memory");
        }
    }
}

constexpr int B_SLOT = 8192, B_NS = 6, B_PF = 5;
constexpr int B_LDS_K = 0, B_LDS_V = B_NS * B_SLOT, B_LDS_WS = 2 * B_NS * B_SLOT, B_LDS_BIAS = B_LDS_WS + 8 * 256, B_LDS_ST = B_LDS_BIAS + 2048, B_LDS_BYTES = B_LDS_ST + 8 * 4096;
__device__ __forceinline__ void attn_b_unit(int b, int h, int rg, const bf16_t* proj, bf16_t* yb, const float* rpb, unsigned char* shm) {
    int tid_l = threadIdx.x; asm volatile("" : "+v"(tid_l));
    const int tid = tid_l, lane = tid & 63, r32 = lane & 31, hi = lane >> 5; const int wid = __builtin_amdgcn_readfirstlane(tid >> 6);
    const size_t rowbase = (size_t)b * SEQ;
    const int r = 4 * rg + (wid >> 1), c0 = 32 * (wid & 1);
    int rs = r - 4; rs = rs < 0 ? 0 : (rs > 24 ? 24 : rs);
    int rmin = 4 * rg - 4; rmin = rmin < 0 ? 0 : (rmin > 24 ? 24 : rmin);
    int rmaxs = 4 * rg + 3 - 4; rmaxs = rmaxs < 0 ? 0 : (rmaxs > 24 ? 24 : rmaxs);
    const int ntile = rmaxs + 8 - rmin;
    const unsigned lds0 = (unsigned)(uintptr_t)shm;
    const lds_cptr shm3 = (lds_cptr)shm;
    __attribute__((address_space(3))) float* wsf = (__attribute__((address_space(3))) float*)((lds_ptr)shm + B_LDS_WS) + wid * 64;
    __attribute__((address_space(3))) float* bias = (__attribute__((address_space(3))) float*)((lds_ptr)shm + B_LDS_BIAS);
    __attribute__((address_space(3))) bf16_t* stg = (__attribute__((address_space(3))) bf16_t*)((lds_ptr)shm + B_LDS_ST) + wid * 2048;
    const int vb0 = (int)(lds0 + B_LDS_V) + ((lane >> 4) & 1) * 32 + (lane & 3) * 8 + (4 * hi + ((lane & 15) >> 2)) * 64;
    if (tid < 480) { const int ri = tid >> 5, cj = tid & 31; bias[tid] = (cj < 31) ? rpb[(h * 15 + ri) * 31 + cj] * LOG2E : 0.f; }
    const bf16_t* Kh = proj + rowbase * INW + C_KB + h * 64;
    const bf16_t* Vh = proj + rowbase * INW + C_VB + h * 64;
    const bf16_t* Qw = proj + (rowbase + r * 64 + c0) * INW + C_QB + h * 64;
    const unsigned kdst = lds0 + B_LDS_K + wid * 1024, vdst = lds0 + B_LDS_V + wid * 1024;
#define B_DMA(t, slot) do { int ln_ = lane; asm volatile("" : "+v"(ln_)); \
    const bf16_t* ksrc_ = Kh + (size_t)((rmin + (t)) * 64 + ln_) * INW + wid * 8; \
    const bf16_t* vsrc_ = Vh + (size_t)((rmin + (t)) * 64 + 16 * (wid & 3) + (ln_ >> 2)) * INW + (wid >> 2) * 32 + (ln_ & 3) * 8; \
    glds16(ksrc_, (unsigned)__builtin_amdgcn_readfirstlane(kdst + (slot) * B_SLOT)); \
    glds16(vsrc_, (unsigned)__builtin_amdgcn_readfirstlane(vdst + (slot) * B_SLOT)); } while (0)
#pragma unroll
    for (int t = 0; t < B_PF; ++t) B_DMA(t, t);
    bf16x8 qr[4];
#pragma unroll
    for (int d0 = 0; d0 < 4; ++d0) qr[d0] = *(const bf16x8*)(Qw + (size_t)r32 * INW + d0 * 16 + hi * 8);
    f32x16 o[2]; o[0] = f32x16{}; o[1] = f32x16{};
    float mrun = 0.f, lsum = 0.f; f32x16 negm = f32x16{}; bool first = true;
    const int c = c0 + r32; int cs = c - 8; cs = cs < 0 ? 0 : (cs > 48 ? 48 : cs);
    int slot = 0, slotn = B_PF;
    for (int t = 0; t < ntile; ++t) {
        { const int rem = ntile - 1 - t;
          if (rem >= 4) { ATT_WAIT_BAR(8); } else if (rem == 3) { ATT_WAIT_BAR(6); } else if (rem == 2) { ATT_WAIT_BAR(4); } else if (rem == 1) { ATT_WAIT_BAR(2); } else { ATT_WAIT_BAR(0); } }
        if (t + B_PF < ntile) B_DMA(t + B_PF, slotn);
        const int kr = rmin + t;
        if (kr >= rs && kr < rs + 8) {
            f32x16 p0, p1; u32x4 pw0, pw1, pw2, pw3;
            qkt<true>(p0, p1, shm3 + B_LDS_K + slot * B_SLOT, qr, negm, r32, hi);
            const int bbase = (kr - r + 7) * 32 + 15 - c;
#pragma unroll
            for (int rr = 0; rr < 16; ++rr) { const int j0 = crow(rr, hi), j1 = j0 + 32;
                const bool v0 = (unsigned)(j0 - cs) < 16u, v1 = (unsigned)(j1 - cs) < 16u;
                const float b0 = bias[v0 ? bbase + j0 : 0], b1 = bias[v1 ? bbase + j1 : 0];
                p0[rr] = v0 ? p0[rr] + b0 : -1e30f; p1[rr] = v1 ? p1[rr] + b1 : -1e30f; }
            softmax_tile<2, 8, true>(p0, p1, mrun, lsum, negm, first, o, wsf, r32, hi, pw0, pw1, pw2, pw3); first = false;
            pv<2>(o, vb0 + slot * B_SLOT, __builtin_bit_cast(bf16x8, pw0), __builtin_bit_cast(bf16x8, pw1), __builtin_bit_cast(bf16x8, pw2), __builtin_bit_cast(bf16x8, pw3));
        }
        slot = (slot == B_NS - 1) ? 0 : slot + 1; slotn = (slotn == B_NS - 1) ? 0 : slotn + 1;
    }
#undef B_DMA
    const float lt = halfsum(lsum);
    if (hi == 0) wsf[32 + r32] = lt;
    ATT_LDSWAIT();
    float rli[16];
#pragma unroll
    for (int g = 0; g < 4; ++g) { const f32x4 l4 = *(const __attribute__((address_space(3))) f32x4*)(wsf + 32 + 8 * g + 4 * hi);
        rli[4 * g + 0] = __builtin_amdgcn_rcpf(l4[0]); rli[4 * g + 1] = __builtin_amdgcn_rcpf(l4[1]); rli[4 * g + 2] = __builtin_amdgcn_rcpf(l4[2]); rli[4 * g + 3] = __builtin_amdgcn_rcpf(l4[3]); }
#pragma unroll
    for (int d0 = 0; d0 < 2; ++d0)
#pragma unroll
        for (int rr = 0; rr < 16; ++rr) stg[crow(rr, hi) * 64 + d0 * 32 + r32] = (bf16_t)f2bf(o[d0][rr] * rli[rr]);
    ATT_LDSWAIT();
    bf16_t* Yw = yb + (rowbase + r * 64 + c0) * 1024 + 512 + h * 64;
#pragma unroll
    for (int i = 0; i < 4; ++i) { const int row = i * 8 + (lane >> 3), ch = lane & 7; const u32x4 v = *(const __attribute__((address_space(3))) u32x4*)(stg + row * 64 + ch * 8); *(u32x4*)(Yw + (size_t)row * 1024 + ch * 8) = v; }
    asm volatile("s_waitcnt lgkmcnt(0)\n\ts_barrier" ::: "memory");
}
}

namespace peer {
typedef short bf16x8 __attribute__((ext_vector_type(8)));
typedef float f32x16 __attribute__((ext_vector_type(16)));
typedef __attribute__((address_space(3))) const char* lds_cptr;
constexpr int T_LDS_SK = 0, T_LDS_BYTES = 65536;
__device__ __forceinline__ int imax(int a, int b) { int r; asm("v_max_f32 %0, %1, %2" : "=v"(r) : "v"(a), "v"(b)); return r; }
__device__ __forceinline__ int imin(int a, int b) { int r; asm("v_min_f32 %0, %1, %2" : "=v"(r) : "v"(a), "v"(b)); return r; }
__device__ __forceinline__ int f2key(float s, int idx) { return (__float_as_int(s) & ~127) | idx; }
__device__ __forceinline__ int key2bits(int k) { return k; }
template <int N, int OFF, int TOT> __device__ __forceinline__ void bsort_desc(int (&a)[TOT]) {
#pragma unroll
    for (int k = 2; k <= N; k <<= 1)
#pragma unroll
        for (int j = k >> 1; j > 0; j >>= 1)
#pragma unroll
            for (int i = 0; i < N; ++i) { const int l = i ^ j; if (l > i) { const bool desc = (i & k) == 0; const int hi_ = imax(a[OFF + i], a[OFF + l]), lo_ = imin(a[OFF + i], a[OFF + l]); a[OFF + i] = desc ? hi_ : lo_; a[OFF + l] = desc ? lo_ : hi_; } }
}
template <int N, int OFF, int TOT> __device__ __forceinline__ void bmerge_desc(int (&a)[TOT]) {
#pragma unroll
    for (int j = N >> 1; j > 0; j >>= 1)
#pragma unroll
        for (int i = 0; i < N; ++i) { const int l = i ^ j; if (l > i) { const int hi_ = imax(a[OFF + i], a[OFF + l]), lo_ = imin(a[OFF + i], a[OFF + l]); a[OFF + i] = hi_; a[OFF + l] = lo_; } }
}
template <int A, int B, int TOT> __device__ __forceinline__ void merge_top16(int (&a)[TOT]) {
#pragma unroll
    for (int i = 0; i < 16; ++i) a[A + i] = imax(a[A + i], a[B + 15 - i]);
    bmerge_desc<16, A, TOT>(a);
}
__device__ __forceinline__ void cross_top16(int (&t)[16]) {
    int lo[16], hi[16];
#pragma unroll
    for (int i = 0; i < 16; ++i) { auto rr = __builtin_amdgcn_permlane32_swap((unsigned)t[i], (unsigned)t[i], false, false); lo[i] = (int)rr[0]; hi[i] = (int)rr[1]; }
#pragma unroll
    for (int i = 0; i < 16; ++i) t[i] = imax(lo[i], hi[15 - i]);
    bmerge_desc<16, 0, 16>(t);
}
__device__ __forceinline__ void half_top16(int (&top)[16], const bf16_t* qrow  , lds_cptr skp  , int hi) {
    f32x16 sc[4]; sc[0] = f32x16{}; sc[1] = f32x16{}; sc[2] = f32x16{}; sc[3] = f32x16{};
    bf16x8 qf[8];
#pragma unroll
    for (int ks = 0; ks < 8; ++ks) qf[ks] = *(const bf16x8*)(qrow + ks * 16);
#pragma unroll
    for (int ks = 0; ks < 8; ++ks)
#pragma unroll
        for (int kt = 0; kt < 4; ++kt) { const bf16x8 af = *(const __attribute__((address_space(3))) bf16x8*)(skp + ks * 4096 + kt * 512);
            sc[kt] = __builtin_amdgcn_mfma_f32_32x32x16_bf16(af, qf[ks], sc[kt], 0, 0, 0); }
    int k[64];
#pragma unroll
    for (int kt = 0; kt < 4; ++kt)
#pragma unroll
        for (int r = 0; r < 16; ++r) k[kt * 16 + r] = f2key(sc[kt][r], (32 * kt + (r & 3) + 8 * (r >> 2)) | (4 * hi));
    bsort_desc<16, 0, 64>(k); bsort_desc<16, 16, 64>(k); bsort_desc<16, 32, 64>(k); bsort_desc<16, 48, 64>(k);
    merge_top16<0, 16, 64>(k); merge_top16<32, 48, 64>(k); merge_top16<0, 32, 64>(k);
#pragma unroll
    for (int i = 0; i < 16; ++i) top[i] = k[i];
    cross_top16(top);
}
__device__ __forceinline__ void topk_wave(int tok0, int h, const bf16_t* Q, int* IDX, float* Gt, lds_cptr sk, int lane) {
    const int r32 = lane & 31, hi = lane >> 5, tok = tok0 + r32;
    const bf16_t* qrow = Q + (size_t)tok * PQ + h * 256 + 8 * hi;
    lds_cptr skl = sk + hi * 2048 + r32 * 16;
    int A0[16], A1[16];
    half_top16(A0, qrow, skl, hi);
    half_top16(A1, qrow + 128, skl + 32768, hi);
    float x[16], y[16]; int xw[16], yw[16];
#pragma unroll
    for (int a = 0; a < 16; ++a) { const int b0 = key2bits(A0[a]), b1 = key2bits(A1[a]);
        const float v0 = __int_as_float(b0 & ~127), v1 = __int_as_float(b1 & ~127); const int i0 = (b0 & 127) << 7, i1 = b1 & 127;
        x[a] = hi ? v1 : v0; y[a] = hi ? v0 : v1; xw[a] = hi ? i1 : i0; yw[a] = hi ? i0 : i1; }
    int w[32]; int n = 0;
#define PEER_CAND(a, b) do { const int bits = __float_as_int(x[a] + y[b]); int ww = (bits & ~0x3FFF) | (xw[a] + yw[b]); \
        if ((a) == (b) && hi) ww = (int)0xFF800000; w[n] = ww; ++n; } while (0)
#pragma unroll
    for (int b = 0; b < 16; ++b) PEER_CAND(0, b);
#pragma unroll
    for (int b = 1; b < 8; ++b) PEER_CAND(1, b);
#pragma unroll
    for (int b = 2; b < 5; ++b) PEER_CAND(2, b);
    PEER_CAND(3, 3);
#undef PEER_CAND
#pragma unroll
    for (int i = 27; i < 32; ++i) w[i] = (int)0xFF800000;
    bsort_desc<32, 0, 32>(w);
    int T[16];
#pragma unroll
    for (int i = 0; i < 16; ++i) T[i] = w[i];
    cross_top16(T);
    float sv[16]; int ev[16];
#pragma unroll
    for (int j = 0; j < 16; ++j) { ev[j] = T[j] & 0x3FFF; sv[j] = __int_as_float(T[j] & ~0x3FFF); }
    const float s0 = sv[0]; float esum = 0.f;
#pragma unroll
    for (int j = 0; j < 16; ++j) { sv[j] = __expf(sv[j] - s0); esum += sv[j]; }
    const float inv = 1.f / esum;
    if (hi == 0) { u32x4* io = (u32x4*)(IDX + ((size_t)tok * 8 + h) * 16);
#pragma unroll
        for (int j = 0; j < 4; ++j) io[j] = (u32x4){(unsigned)ev[4 * j], (unsigned)ev[4 * j + 1], (unsigned)ev[4 * j + 2], (unsigned)ev[4 * j + 3]}; }
    else { f32x4* go = (f32x4*)(Gt + ((size_t)tok * 8 + h) * 16);
#pragma unroll
        for (int j = 0; j < 4; ++j) go[j] = (f32x4){sv[4 * j] * inv, sv[4 * j + 1] * inv, sv[4 * j + 2] * inv, sv[4 * j + 3] * inv}; }
}
template <class Sched> __device__ __forceinline__ void topk_own_units(const Ptrs& P, unsigned char* shm, const Sched& S) {
    int tid_l = threadIdx.x; asm volatile("" : "+v"(tid_l));
    const int tid = tid_l, lane = tid & 63; const int wid = __builtin_amdgcn_readfirstlane(tid >> 6);
    const unsigned lds0 = (unsigned)(uintptr_t)shm;
    const bf16_t* SKg = (const bf16_t*)(P.ws + WS_SK);
    int hprev = -1; pg8::Unit u;
    for (int i = 0; S.next(i, u); ++i) {
        const int h = u.pn, tg = u.pm;
        if (h != hprev) { hprev = h;
            asm volatile("s_waitcnt lgkmcnt(0)\n\ts_barrier" ::: "memory");
#pragma unroll
            for (int j = 0; j < 8; ++j) { const int piece = wid * 8 + j, p = piece >> 5, c = (piece >> 1) & 15, kh = piece & 1;
                att::glds16(SKg + ((size_t)((h * 2 + p) * 128 + kh * 64 + lane) * 128 + c * 8), (unsigned)__builtin_amdgcn_readfirstlane(lds0 + p * 32768 + c * 2048 + kh * 1024)); }
            asm volatile("s_waitcnt vmcnt(0)\n\ts_barrier" ::: "memory");
        }
        topk_wave(tg * 256 + wid * 32, h, (const bf16_t*)(P.ws + WS_Q), (int*)(P.ws + WS_IDX), (float*)(P.ws + WS_G), (lds_cptr)shm, lane);
    }
}
}

namespace apply {
typedef float f32x2 __attribute__((ext_vector_type(2)));
typedef __attribute__((address_space(3))) unsigned* lds_u32p;
constexpr int AP_WAVE_BYTES = 4 * (512 + 2048), AP_LDS_BYTES = 8 * AP_WAVE_BYTES;
__device__ __forceinline__ float gelu_fast(float v) {
    const float av = fabsf(v), t = __builtin_amdgcn_rcpf(av * 0.2316418882f + 1.0f);
    float q = t * 0.5307027145f + (-0.7265760135f); q = q * t + 0.7107068705f; q = q * t + (-0.142248368f); q = q * t + 0.127414796f; q = q * t;
    const float e = __builtin_amdgcn_exp2f((v * v) * (-0.72134752044f));
    const float m = v * (q * e);
    return v < 0.f ? m : v - m;
}
#define AP_DPP(v, ctrl) __builtin_bit_cast(float, __builtin_amdgcn_update_dpp(0, __builtin_bit_cast(int, (v)), (ctrl), 0xF, 0xF, true))
__device__ __forceinline__ float row16_sum(float v) { v += AP_DPP(v, 0xB1); v += AP_DPP(v, 0x4E); v += AP_DPP(v, 0x141); v += AP_DPP(v, 0x140); return v; }
__device__ __forceinline__ void load_half(u32x4 (&r)[2], const unsigned char* img, unsigned e, int sub) {
    const unsigned off = e * 512u + (unsigned)(sub * 16);
    r[0] = *(const u32x4*)(img + off); r[1] = *(const u32x4*)(img + off + 256u);
}
constexpr int AP_PROBE_RING = 16;
constexpr int AP_RING = 8;
typedef __attribute__((address_space(3))) u32x4* lds_v4p;
template <int HF, int MODE, int RING> __device__ __forceinline__ void pass_u(const Ptrs& P, const bf16_t* hrow, float rstd, lds_v4p grp, u32x4 (&R)[RING][2], const unsigned char* img, const unsigned char* img_next, int sub) {
    unsigned xq[8]; float sx;
    {
        float xf[2][16]; float mx = 0.f;
#pragma unroll
        for (int i = 0; i < 2; ++i) { const int e0 = (sub + 16 * (2 * HF + i)) * 16;
#pragma unroll
            for (int q = 0; q < 4; ++q) { const u32x2 hb = *(const u32x2*)(hrow + e0 + 4 * q); const f32x4 gv = *(const f32x4*)(P.norm_ffn + e0 + 4 * q);
                xf[i][4 * q] = bflo(hb.x) * rstd * gv.x; xf[i][4 * q + 1] = bfhi(hb.x) * rstd * gv.y; xf[i][4 * q + 2] = bflo(hb.y) * rstd * gv.z; xf[i][4 * q + 3] = bfhi(hb.y) * rstd * gv.w;
                mx = fmaxf(fmaxf(mx, fmaxf(fabsf(xf[i][4 * q]), fabsf(xf[i][4 * q + 1]))), fmaxf(fabsf(xf[i][4 * q + 2]), fabsf(xf[i][4 * q + 3]))); } }
        mx = fmaxf(mx, AP_DPP(mx, 0xB1)); mx = fmaxf(mx, AP_DPP(mx, 0x4E)); mx = fmaxf(mx, AP_DPP(mx, 0x141)); mx = fmaxf(mx, AP_DPP(mx, 0x140));
        mx = fmaxf(mx, 1e-30f); sx = mx * (1.f / 127.f); const float qs = 127.f / mx;
#pragma unroll
        for (int i = 0; i < 2; ++i)
#pragma unroll
            for (int q = 0; q < 4; ++q) xq[4 * i + q] = pack_i8x4(xf[i][4 * q] * qs, xf[i][4 * q + 1] * qs, xf[i][4 * q + 2] * qs, xf[i][4 * q + 3] * qs);
    }
#pragma unroll 1
    for (int j = 0; j < 128; j += RING) {
        const int jn = (j + RING) & 127;
        __builtin_amdgcn_s_barrier();
        const unsigned char* tb = (j + RING < 128) ? img : img_next;
        unsigned nid[RING], part[RING], suv[RING], gsv[RING];
#pragma unroll
        for (int b4 = 0; b4 < RING / 4; ++b4) { const u32x4 na = grp[jn / 4 + b4];
            nid[4 * b4] = na.x; nid[4 * b4 + 1] = na.y; nid[4 * b4 + 2] = na.z; nid[4 * b4 + 3] = na.w;
            u32x4 pa = {}, sa = {}, ga = {};
            if (HF == 1) { pa = grp[96 + j / 4 + b4]; sa = grp[32 + j / 4 + b4]; ga = grp[64 + j / 4 + b4]; }
            part[4 * b4] = pa.x; part[4 * b4 + 1] = pa.y; part[4 * b4 + 2] = pa.z; part[4 * b4 + 3] = pa.w;
            suv[4 * b4] = sa.x; suv[4 * b4 + 1] = sa.y; suv[4 * b4 + 2] = sa.z; suv[4 * b4 + 3] = sa.w;
            gsv[4 * b4] = ga.x; gsv[4 * b4 + 1] = ga.y; gsv[4 * b4 + 2] = ga.z; gsv[4 * b4 + 3] = ga.w; }
        float outv[RING];
#pragma unroll
        for (int bq = 0; bq < RING; ++bq) {
            int d0_ = 0, d1_ = 0;
            if (MODE == 1) { asm volatile("" :: "v"(R[bq][0]), "v"(R[bq][1])); d0_ = (int)xq[0]; }
            else {
                d0_ = __builtin_amdgcn_sdot4((int)R[bq][0].x, (int)xq[0], d0_, false); d1_ = __builtin_amdgcn_sdot4((int)R[bq][0].y, (int)xq[1], d1_, false);
                d0_ = __builtin_amdgcn_sdot4((int)R[bq][0].z, (int)xq[2], d0_, false); d1_ = __builtin_amdgcn_sdot4((int)R[bq][0].w, (int)xq[3], d1_, false);
                d0_ = __builtin_amdgcn_sdot4((int)R[bq][1].x, (int)xq[4], d0_, false); d1_ = __builtin_amdgcn_sdot4((int)R[bq][1].y, (int)xq[5], d1_, false);
                d0_ = __builtin_amdgcn_sdot4((int)R[bq][1].z, (int)xq[6], d0_, false); d1_ = __builtin_amdgcn_sdot4((int)R[bq][1].w, (int)xq[7], d1_, false);
            }
            asm volatile("" ::: "memory");
            load_half(R[bq], tb, MODE == 2 ? (nid[bq] & 15u) : nid[bq], sub);
            asm volatile("" ::: "memory");
            float a_ = row16_sum((float)(d0_ + d1_)) * sx;
            if (HF == 1) { a_ = (a_ + __uint_as_float(part[bq])) * __uint_as_float(suv[bq]); a_ = __uint_as_float(gsv[bq]) * gelu_fast(a_); }
            outv[bq] = a_;
        }
        if (sub == 0) {
#pragma unroll
            for (int b4 = 0; b4 < RING / 4; ++b4) grp[96 + j / 4 + b4] = (u32x4){__float_as_uint(outv[4 * b4]), __float_as_uint(outv[4 * b4 + 1]), __float_as_uint(outv[4 * b4 + 2]), __float_as_uint(outv[4 * b4 + 3])}; }
    }
    asm volatile("s_waitcnt lgkmcnt(0)" ::: "memory");
}
template <int HF, int MODE, int RING> __device__ __forceinline__ void pass_v(float (&acc)[4][16], lds_v4p grp, u32x4 (&R)[RING][2], const unsigned char* img, const unsigned char* img_next, int sub) {
#pragma unroll 1
    for (int j = 0; j < 128; j += RING) {
        const int jn = (j + RING) & 127;
        __builtin_amdgcn_s_barrier();
        const unsigned char* tb = (j + RING < 128) ? img : img_next;
        unsigned nid[RING], cvv[RING];
#pragma unroll
        for (int b4 = 0; b4 < RING / 4; ++b4) { const u32x4 na = grp[jn / 4 + b4], ca = grp[96 + j / 4 + b4];
            nid[4 * b4] = na.x; nid[4 * b4 + 1] = na.y; nid[4 * b4 + 2] = na.z; nid[4 * b4 + 3] = na.w; cvv[4 * b4] = ca.x; cvv[4 * b4 + 1] = ca.y; cvv[4 * b4 + 2] = ca.z; cvv[4 * b4 + 3] = ca.w; }
#pragma unroll
        for (int bq = 0; bq < RING; ++bq) {
            const float c_ = __uint_as_float(cvv[bq]); const f32x2 c2 = {c_, c_};
            if (MODE == 1) { asm volatile("" :: "v"(R[bq][0]), "v"(R[bq][1])); acc[2 * HF][0] += c_; }
            else {
#pragma unroll
            for (int i = 0; i < 2; ++i) { const unsigned w_[4] = {R[bq][i].x, R[bq][i].y, R[bq][i].z, R[bq][i].w};
#pragma unroll
                for (int q = 0; q < 4; ++q) { const f32x2 lo_ = __builtin_amdgcn_cvt_pk_f32_fp8(w_[q], false), hi_ = __builtin_amdgcn_cvt_pk_f32_fp8(w_[q], true);
                    f32x2 a0 = {acc[2 * HF + i][4 * q], acc[2 * HF + i][4 * q + 1]}, a1 = {acc[2 * HF + i][4 * q + 2], acc[2 * HF + i][4 * q + 3]}; a0 += c2 * lo_; a1 += c2 * hi_;
                    acc[2 * HF + i][4 * q] = a0.x; acc[2 * HF + i][4 * q + 1] = a0.y; acc[2 * HF + i][4 * q + 2] = a1.x; acc[2 * HF + i][4 * q + 3] = a1.y; } }
            }
            asm volatile("" ::: "memory");
            load_half(R[bq], tb, MODE == 2 ? (nid[bq] & 15u) : nid[bq], sub);
            asm volatile("" ::: "memory");
        }
    }
}
template <int MODE> __device__ __forceinline__ void apply_round(const Ptrs& P, float* outbase, int tbase, unsigned char* shm_wave, int lane_in) {
    int lane = lane_in; asm volatile("" : "+v"(lane));
    const int sub = lane & 15, g = lane >> 4, t = tbase + g;
    __attribute__((address_space(3))) unsigned* cnt = (lds_u32p)(__attribute__((address_space(3))) unsigned char*)shm_wave + g * 128;
    lds_v4p grp = (lds_v4p)((__attribute__((address_space(3))) unsigned char*)shm_wave + 2048 + g * 2048);
    __attribute__((address_space(3))) unsigned* grp1 = (__attribute__((address_space(3))) unsigned*)grp;
    const unsigned char* U8 = P.ws + WS_U; const unsigned char* V8 = P.ws + WS_V;
    {
        const int* idxp = (const int*)(P.ws + WS_IDX) + (size_t)t * 128 + sub * 8; const float* gp = (const float*)(P.ws + WS_G) + (size_t)t * 128 + sub * 8;
        const u32x4 ia = *(const u32x4*)idxp, ib = *(const u32x4*)(idxp + 4); const f32x4 ga = *(const f32x4*)gp, gb = *(const f32x4*)(gp + 4);
        const int e[8] = {(int)ia.x, (int)ia.y, (int)ia.z, (int)ia.w, (int)ib.x, (int)ib.y, (int)ib.z, (int)ib.w};
        const float gt[8] = {ga.x, ga.y, ga.z, ga.w, gb.x, gb.y, gb.z, gb.w};
        float su[8], sv[8];
#pragma unroll
        for (int i = 0; i < 8; ++i) { su[i] = ((const float*)(P.ws + WS_SU))[e[i]]; sv[i] = ((const float*)(P.ws + WS_SV))[e[i]]; }
#pragma unroll
        for (int i = 0; i < 8; ++i) cnt[sub * 8 + i] = 0u;
        asm volatile("s_waitcnt lgkmcnt(0)" ::: "memory");
        unsigned pos[8];
#pragma unroll
        for (int i = 0; i < 8; ++i) pos[i] = __hip_atomic_fetch_add(cnt + (e[i] >> 7), 1u, __ATOMIC_RELAXED, __HIP_MEMORY_SCOPE_WAVEFRONT);
        asm volatile("s_waitcnt lgkmcnt(0)" ::: "memory");
        unsigned c[8]; unsigned tot = 0;
#pragma unroll
        for (int i = 0; i < 8; ++i) { c[i] = cnt[sub * 8 + i]; }
#pragma unroll
        for (int i = 0; i < 8; ++i) { const unsigned x = c[i]; c[i] = tot; tot += x; }
        unsigned inc = tot;
#pragma unroll
        for (int d = 1; d < 16; d <<= 1) { const unsigned y = __shfl_up(inc, d, 16); if (sub >= d) inc += y; }
        const unsigned base = inc - tot;
        asm volatile("s_waitcnt lgkmcnt(0)" ::: "memory");
#pragma unroll
        for (int i = 0; i < 8; ++i) cnt[sub * 8 + i] = base + c[i];
        asm volatile("s_waitcnt lgkmcnt(0)" ::: "memory");
#pragma unroll
        for (int i = 0; i < 8; ++i) { const unsigned p = cnt[e[i] >> 7] + pos[i];
            grp1[p] = (unsigned)e[i]; grp1[128 + p] = __float_as_uint(su[i]); grp1[256 + p] = __float_as_uint(gt[i] * sv[i]); }
        asm volatile("s_waitcnt lgkmcnt(0)" ::: "memory");
    }
    const bf16_t* hrow = (const bf16_t*)(P.ws + WS_HB) + (size_t)t * D;
    float rstd;
    { const float* ssq = (const float*)(P.ws + WS_SSQ) + (size_t)t * 16;
      const f32x4 s0 = *(const f32x4*)ssq, s1 = *(const f32x4*)(ssq + 4), s2 = *(const f32x4*)(ssq + 8), s3 = *(const f32x4*)(ssq + 12);
      const float tot = ((s0.x + s0.y) + (s0.z + s0.w)) + ((s1.x + s1.y) + (s1.z + s1.w)) + ((s2.x + s2.y) + (s2.z + s2.w)) + ((s3.x + s3.y) + (s3.z + s3.w));
      rstd = 1.f / sqrtf(tot * (1.f / D) + EPS); }
    constexpr int RG = (MODE == 1) ? AP_PROBE_RING : AP_RING;
    const unsigned char* U0 = U8; const unsigned char* U1 = U8 + (size_t)NEXP * 512; const unsigned char* V0 = V8; const unsigned char* V1 = V8 + (size_t)NEXP * 512;
    u32x4 R[RG][2];
    {
#pragma unroll
      for (int b4 = 0; b4 < RG / 4; ++b4) { const u32x4 ia = grp[b4]; load_half(R[4 * b4], U0, ia.x, sub); load_half(R[4 * b4 + 1], U0, ia.y, sub); load_half(R[4 * b4 + 2], U0, ia.z, sub); load_half(R[4 * b4 + 3], U0, ia.w, sub); } }
    pass_u<0, MODE, RG>(P, hrow, rstd, grp, R, U0, U1, sub);
    pass_u<1, MODE, RG>(P, hrow, rstd, grp, R, U1, V0, sub);
    float acc[4][16];
#pragma unroll
    for (int i = 0; i < 4; ++i)
#pragma unroll
        for (int q = 0; q < 16; ++q) acc[i][q] = 0.f;
    pass_v<0, MODE, RG>(acc, grp, R, V0, V1, sub);
    pass_v<1, MODE, RG>(acc, grp, R, V1, V1, sub);
    float ss = 0.f;
#pragma unroll
    for (int i = 0; i < 4; ++i) { const int e0 = (sub + 16 * i) * 16;
#pragma unroll
        for (int q = 0; q < 4; ++q) { const u32x2 hb = *(const u32x2*)(hrow + e0 + 4 * q);
            acc[i][4 * q] += bflo(hb.x); acc[i][4 * q + 1] += bfhi(hb.x); acc[i][4 * q + 2] += bflo(hb.y); acc[i][4 * q + 3] += bfhi(hb.y);
            ss += (acc[i][4 * q] * acc[i][4 * q] + acc[i][4 * q + 1] * acc[i][4 * q + 1]) + (acc[i][4 * q + 2] * acc[i][4 * q + 2] + acc[i][4 * q + 3] * acc[i][4 * q + 3]); }
        asm volatile("" ::: "memory"); }
    ss = row16_sum(ss);
    const float r2 = 1.f / sqrtf(ss * (1.f / D) + EPS);
    float* orow = outbase + (size_t)t * D;
#pragma unroll
    for (int i = 0; i < 4; ++i) { const int e0 = (sub + 16 * i) * 16;
#pragma unroll
        for (int q = 0; q < 4; ++q) { const f32x4 gv = *(const f32x4*)(P.norm_final + e0 + 4 * q);
            *(f32x4*)(orow + e0 + 4 * q) = (f32x4){acc[i][4 * q] * r2 * gv.x, acc[i][4 * q + 1] * r2 * gv.y, acc[i][4 * q + 2] * r2 * gv.z, acc[i][4 * q + 3] * r2 * gv.w}; }
        asm volatile("" ::: "memory"); }
}
template <int MODE> __device__ __forceinline__ void apply_phase(const Ptrs& P, float* outbase, unsigned char* shm, int G, int vcu) {
    int tid_l = threadIdx.x; asm volatile("" : "+v"(tid_l));
    const int lane = tid_l & 63; const int wave = __builtin_amdgcn_readfirstlane(tid_l >> 6);
    const int per = M / (G * 8);
#pragma unroll 1
    for (int r = 0; r < per; r += 4) apply_round<MODE>(P, outbase, (vcu * 8 + wave) * per + r, shm + wave * AP_WAVE_BYTES, lane);
}
}

#define LAS __attribute__((address_space(3)))
#define XB_TMO      128
#define XB_XCNT(j)  (256  + 64 * (j))
#define XB_XSUB(j)  (1280 + 64 * (j))
#define XB_XGEN(j)  (2304 + 64 * (j))
#define XB_TOP      3328
#define XB_TOPGEN   3392
#define XCD_BAR_WORDS 3456
#define XB_SPIN_CAP (1u << 18)

__device__ __forceinline__ unsigned xb_ld(unsigned* p)              { return __hip_atomic_load(p, __ATOMIC_RELAXED, __HIP_MEMORY_SCOPE_AGENT); }
__device__ __forceinline__ unsigned xb_add(unsigned* p, unsigned v) { return __hip_atomic_fetch_add(p, v, __ATOMIC_RELAXED, __HIP_MEMORY_SCOPE_AGENT); }
__device__ __forceinline__ unsigned xb_xcc_id() { return (unsigned)__builtin_amdgcn_s_getreg((3 << 11) | 20) & 0xFu; }
#define XB_SPIN(cond, bar) do { unsigned _sp = 0; while (cond) { __builtin_amdgcn_s_sleep(1); \
    if ((++_sp & 255u) == 0u) { if (xb_ld(&(bar)[XB_TMO])) break; if (_sp > XB_SPIN_CAP) { atomicAdd(&(bar)[XB_TMO], 1u); break; } } } } while (0)

struct XcdBarrier {
    unsigned* bar; unsigned x;
    volatile LAS unsigned* st;
};

__device__ __forceinline__ XcdBarrier xcd_barrier_post(unsigned* bar, volatile LAS unsigned* st) {
    XcdBarrier b; b.bar = bar; b.x = xb_xcc_id(); b.st = st;
    if (threadIdx.x == 0) (void)xb_add(&bar[XB_XCNT(b.x)], 1u);
    return b;
}
__device__ __forceinline__ void xcd_barrier_complete(unsigned* bar, unsigned x, unsigned& nloc, unsigned& nx) {
    const unsigned G = gridDim.x * gridDim.y * gridDim.z;
    unsigned sum, cnt, mine, sp = 0u;
    for (;;) {
        sum = 0u; cnt = 0u; mine = 0u;
#pragma unroll
        for (unsigned j = 0; j < 16; ++j) { const unsigned c = xb_ld(&bar[XB_XCNT(j)]); sum += c; cnt += (c > 0u) ? 1u : 0u; mine = (j == x) ? c : mine; }
        if (sum == G) break;
        __builtin_amdgcn_s_sleep(1);
        if ((++sp & 255u) == 0u) { if (xb_ld(&bar[XB_TMO])) break; if (sp > XB_SPIN_CAP) { atomicAdd(&bar[XB_TMO], 1u); break; } }
    }
    nloc = mine > 0u ? mine : 1u; nx = cnt > 0u ? cnt : 1u;
}

__device__ __forceinline__ void xcd_barrier(const XcdBarrier& b) {
    asm volatile("s_waitcnt vmcnt(0)" ::: "memory");
    __syncthreads();
    if (threadIdx.x == 0) {
        unsigned* bar = b.bar;
        __builtin_amdgcn_s_waitcnt(0);
        unsigned nloc = b.st[0], nx = b.st[1];
        if (nloc == 0u) { xcd_barrier_complete(bar, b.x, nloc, nx); b.st[0] = nloc; b.st[1] = nx; }
        const unsigned old = xb_add(&bar[XB_XSUB(b.x)], 1u);
        const unsigned gen = old / nloc;
        if (old + 1u == (gen + 1u) * nloc) {
            __builtin_amdgcn_fence(__ATOMIC_RELEASE, "agent");
            asm volatile("s_waitcnt vmcnt(0)" ::: "memory");
            const unsigned og = xb_add(&bar[XB_TOP], 1u);
            const unsigned tg = og / nx;
            if (og + 1u == (tg + 1u) * nx) xb_add(&bar[XB_TOPGEN], 1u);
            else XB_SPIN(xb_ld(&bar[XB_TOPGEN]) == tg, bar);
            __builtin_amdgcn_fence(__ATOMIC_ACQUIRE, "agent");
            xb_add(&bar[XB_XGEN(b.x)], 1u);
            asm volatile("s_waitcnt vmcnt(0)" ::: "memory");
        } else {
            XB_SPIN(xb_ld(&bar[XB_XGEN(b.x)]) == gen, bar);
            __builtin_amdgcn_fence(__ATOMIC_ACQUIRE, "agent");
            asm volatile("s_waitcnt vmcnt(0)" ::: "memory");
        }
    }
    __syncthreads();
}


namespace cg = cooperative_groups;
#ifndef REP_MASK
#define REP_MASK 0
#endif
#define REPS(k) (((REP_MASK) >> (k)) & 1 ? 2 : 1)
constexpr int PHASE_LDS = att::A_LDS_BYTES;
constexpr int MEGA_LDS = PHASE_LDS + 64;
static_assert(PHASE_LDS >= pg8::STAGE_BYTES && PHASE_LDS >= att::B_LDS_BYTES && PHASE_LDS >= peer::T_LDS_BYTES && PHASE_LDS >= 8 * 64 * 33 * 4 && PHASE_LDS >= apply::AP_LDS_BYTES, "LDS budget");
__global__ void __launch_bounds__(512, 2) mega_fwd(Ptrs P) {
    extern __shared__ __attribute__((aligned(16))) unsigned char lds_dyn[];
    volatile LAS unsigned* bst = (volatile LAS unsigned*)((LAS unsigned char*)lds_dyn + PHASE_LDS);
    if (threadIdx.x < 2) bst[threadIdx.x] = 0u;
    __syncthreads();
    const XcdBarrier bar = xcd_barrier_post((unsigned*)(P.ws + WS_CTL), bst);
    const int G = (int)gridDim.x, bx = (int)blockIdx.x, vcu = (G % 8 == 0) ? (bx % 8) * (G / 8) + bx / 8 : bx;
    unsigned char* ws = P.ws;
    PG8_LAS unsigned char* lds3 = (PG8_LAS unsigned char*)lds_dyn;
    for (int rep = 0; rep < REPS(0); ++rep) prep_phase(P, lds_dyn, G, bx);
    xcd_barrier(bar); if (REPS(9) == 2) xcd_barrier(bar);
    for (int rep = 0; rep < REPS(1); ++rep) {
      { pg8::Gemm g{(const bf16_t*)(ws + WS_XN), (const bf16_t*)(ws + WS_WIN), M, 1024, D, 0}; pg8::StaticOrder S; S.init(M, 1024, G, bx);
        pg8::gemm_phase<pg8::EpiProj, pg8::StaticOrder, true, true, false>(lds3, g, S, pg8::EpiProj{(bf16_t*)(ws + WS_PROJ), (const float*)(ws + WS_ROPE), 1.f, 0}); }
      { pg8::Gemm g{(const bf16_t*)(ws + WS_XN8), (const bf16_t*)(ws + WS_WIN8), M, INW - 1024, D / 2, 0}; pg8::StaticOrder S; S.init(M, INW - 1024, G, bx);
        pg8::gemm_phase<pg8::EpiProj, pg8::StaticOrder, true, true, true>(lds3, g, S, pg8::EpiProj{(bf16_t*)(ws + WS_PROJ), (const float*)(ws + WS_ROPE), 1.f / WIN_SCALE, 4}); } }
    xcd_barrier(bar); if (REPS(9) == 2) xcd_barrier(bar);
    { const float lam = lambda_full(P);
      for (int rep = 0; rep < REPS(2); ++rep) for (int u = vcu; u < BATCH * 4 * 8; u += G) att::attn_a_unit(u >> 5, (u >> 3) & 3, u & 7, (const bf16_t*)(ws + WS_PROJ), (bf16_t*)(ws + WS_YA), P.subln, lam, lds_dyn);
      for (int rep = 0; rep < REPS(3); ++rep) for (int u = vcu; u < BATCH * 8 * 8; u += G) att::attn_b_unit(u >> 6, (u >> 3) & 7, u & 7, (const bf16_t*)(ws + WS_PROJ), (bf16_t*)(ws + WS_YA), P.rpb, lds_dyn); }
    xcd_barrier(bar); if (REPS(9) == 2) xcd_barrier(bar);
    for (int rep = 0; rep < REPS(4); ++rep) { pg8::StaticOrder S; S.init(M, D, G, bx);
      pg8::gemm_phase<pg8::EpiGate2, pg8::StaticOrder, true, true>(lds3, pg8::Gemm{(const bf16_t*)(ws + WS_YA), (const bf16_t*)(ws + WS_WPA), M, D, D, 0}, S, pg8::EpiGate2{(const bf16_t*)(ws + WS_PROJ), (bf16_t*)(ws + WS_MERGED)}); }
    xcd_barrier(bar); if (REPS(9) == 2) xcd_barrier(bar);
    for (int rep = 0; rep < REPS(5); ++rep) { pg8::StaticOrder S; S.init(M, D, G, bx);
      pg8::gemm_phase<pg8::EpiHout, pg8::StaticOrder, true, true>(lds3, pg8::Gemm{(const bf16_t*)(ws + WS_MERGED), (const bf16_t*)(ws + WS_WOUT), M, D, D, 0}, S, pg8::EpiHout{P.x, P.out, (bf16_t*)(ws + WS_HB), (float*)(ws + WS_SSQ)});
      cvt_experts_phase(P, G, bx); }
    xcd_barrier(bar); if (REPS(9) == 2) xcd_barrier(bar);
    { pg8::StaticOrder S; S.init(M, PQ, G, bx);
      for (int rep = 0; rep < REPS(8); ++rep)
        pg8::gemm_phase<pg8::EpiQ, pg8::StaticOrder, true, true>(lds3, pg8::Gemm{(const bf16_t*)(ws + WS_HB), (const bf16_t*)(ws + WS_WQ), M, PQ, D, 0}, S, pg8::EpiQ{(const float*)(ws + WS_SSQ), (bf16_t*)(ws + WS_Q)});
      asm volatile("s_waitcnt vmcnt(0)" ::: "memory");
      __syncthreads();
      if (threadIdx.x == 0) { __builtin_amdgcn_fence(__ATOMIC_ACQUIRE, "agent"); asm volatile("s_waitcnt vmcnt(0)" ::: "memory"); }
      __syncthreads();
      for (int rep = 0; rep < REPS(6); ++rep) peer::topk_own_units(P, lds_dyn, S); }
    xcd_barrier(bar); if (REPS(9) == 2) xcd_barrier(bar);
#ifndef PROBE_MODE
#define PROBE_MODE 0
#endif
    if (REPS(7) == 2) apply::apply_phase<PROBE_MODE>(P, (float*)(ws + WS_Q), lds_dyn, G, vcu);
    apply::apply_phase<0>(P, P.out, lds_dyn, G, vcu);
}

extern "C" void kernel_launch(void* const* d_in, const int* in_sizes, int n_in, void* d_out, int out_size, void* d_ws, size_t ws_size, hipStream_t stream) {
    if (n_in != 18 || ws_size < WS_END) { fprintf(stderr, "kernel_launch: unexpected n_in %d / ws_size %zu\n", n_in, ws_size); return; }
    Ptrs P{};
    P.x = (const float*)d_in[0]; P.w_in = (const float*)d_in[1]; P.w_pa = (const float*)d_in[2]; P.w_pb = (const float*)d_in[3]; P.w_out = (const float*)d_in[4];
    P.norm_mix = (const float*)d_in[5]; P.norm_ffn = (const float*)d_in[6]; P.norm_final = (const float*)d_in[7];
    P.lq1 = (const float*)d_in[8]; P.lk1 = (const float*)d_in[9]; P.lq2 = (const float*)d_in[10]; P.lk2 = (const float*)d_in[11];
    P.subln = (const float*)d_in[12]; P.rpb = (const float*)d_in[13]; P.w_query = (const float*)d_in[14]; P.sub_keys = (const float*)d_in[15];
    P.peer_u = (const float*)d_in[16]; P.peer_v = (const float*)d_in[17];
    P.out = (float*)d_out; P.ws = (unsigned char*)d_ws;
    static int grid_blocks = 0;
    if (!grid_blocks) {
        int dev = 0, cus = 0, per_cu = 0;
        hipGetDevice(&dev);
        hipDeviceGetAttribute(&cus, hipDeviceAttributeMultiprocessorCount, dev);
        hipFuncSetAttribute((const void*)mega_fwd, hipFuncAttributeMaxDynamicSharedMemorySize, MEGA_LDS);
        hipOccupancyMaxActiveBlocksPerMultiprocessor(&per_cu, (const void*)mega_fwd, 512, MEGA_LDS);
        if (per_cu < 1) { fprintf(stderr, "kernel_launch: occupancy query says %d blocks per CU\n", per_cu); per_cu = 1; }
        grid_blocks = cus * per_cu;
    }
    hipMemsetAsync((unsigned char*)d_ws + WS_CTL, 0, 16384, stream);
    void* args[] = {&P};
    hipError_t e = hipLaunchCooperativeKernel((const void*)mega_fwd, dim3(grid_blocks), dim3(512), args, MEGA_LDS, stream);
    if (e != hipSuccess) fprintf(stderr, "cooperative launch failed: %s (grid %d)\n", hipGetErrorString(e), grid_blocks);
}
```

```cpp
#include <hip/hip_runtime.h>
#include <hip/hip_cooperative_groups.h>
#include <cstdio>
#include <cstdint>

typedef unsigned short bf16_t;
typedef unsigned u32x4 __attribute__((ext_vector_type(4)));
typedef unsigned u32x2 __attribute__((ext_vector_type(2)));
typedef float f32x4 __attribute__((ext_vector_type(4)));
typedef __bf16 bf16x2_t __attribute__((ext_vector_type(2)));

constexpr int D = 1024, BATCH = 8, SEQ = 2048, M = BATCH * SEQ, INW = 5120;
constexpr int C_QA = 0, C_KA = 512, C_VA = 1024, C_QB = 1536, C_KB = 2048, C_VB = 2560, C_GA = 3072, C_GB = 4096;
constexpr int NEXP = 16384, PQ = 2048;
constexpr float EPS = 1e-6f;
constexpr float LOG2E = 1.4426950408889634f;
constexpr float WIN_SCALE = 32.f;
constexpr float QSCALE = 0.125f * LOG2E;

constexpr size_t MiB = 1u << 20;
constexpr size_t WS_PROJ = 0;
constexpr size_t WS_HB = 0;
constexpr size_t WS_Q = 32 * MiB;
constexpr size_t WS_U = 96 * MiB;
constexpr size_t WS_V = 112 * MiB;
constexpr size_t WS_SU = 128 * MiB;
constexpr size_t WS_SV = 128 * MiB + 65536;
constexpr size_t WS_XN = 160 * MiB;
constexpr size_t WS_YA = 160 * MiB;
constexpr size_t WS_YB = 176 * MiB;
constexpr size_t WS_IDX = 160 * MiB;
constexpr size_t WS_G = 168 * MiB;
constexpr size_t WS_MERGED = 192 * MiB;
constexpr size_t WS_TOPV = 192 * MiB;
constexpr size_t WS_TOPI = 208 * MiB;
constexpr size_t WS_WIN = 224 * MiB;
constexpr size_t WS_WIN8 = 226 * MiB;
constexpr size_t WS_XN8 = 192 * MiB;
constexpr size_t WS_WQ = 234 * MiB;
constexpr size_t WS_WOUT = 238 * MiB;
constexpr size_t WS_WPA = 240 * MiB;
constexpr size_t WS_WPB = 241 * MiB;
constexpr size_t WS_SK = 242 * MiB;
constexpr size_t WS_ROPE = 242 * MiB + 512 * 1024;
constexpr size_t WS_SSQ = 243 * MiB;
constexpr size_t WS_CTL = 244 * MiB;
constexpr size_t WS_END = 256 * MiB;

__device__ __forceinline__ float bf2f(unsigned v) { return __uint_as_float(v << 16); }
__device__ __forceinline__ float bflo(unsigned w) { return __uint_as_float(w << 16); }
__device__ __forceinline__ float bfhi(unsigned w) { return __uint_as_float(w & 0xffff0000u); }
__device__ __forceinline__ unsigned f2bf(float f) { unsigned u = __float_as_uint(f); return (u + 0x7fffu + ((u >> 16) & 1u)) >> 16; }
__device__ __forceinline__ unsigned pk2(float lo, float hi) { return f2bf(lo) | (f2bf(hi) << 16); }
__device__ __forceinline__ float wave_sum(float v) {
#pragma unroll
    for (int o = 1; o < 64; o <<= 1) v += __shfl_xor(v, o);
    return v;
}
__device__ __forceinline__ float sigmoidf_(float x) { return 1.f / (1.f + __expf(-x)); }
__device__ __forceinline__ float gelu_exact(float x) { return 0.5f * x * (1.f + erff(x * 0.70710678118654752f)); }

struct Ptrs {
    const float *x, *w_in, *w_pa, *w_pb, *w_out, *norm_mix, *norm_ffn, *norm_final, *lq1, *lk1, *lq2, *lk2, *subln, *rpb, *w_query, *sub_keys, *peer_u, *peer_v;
    float* out; unsigned char* ws;
};

__device__ __forceinline__ void transpose_item(const float* W, int K, int N, const float* gain, bf16_t* WT, float* scr, int item, int lane, int ldo = 0, int koff = 0, int ldw = 0) {
    if (ldo == 0) ldo = K;
    if (ldw == 0) ldw = N;
    const int nblk = N / 32, kb = item / nblk, nb = item % nblk, k0 = 64 * kb, n0 = 32 * nb;
    float wv[32];
#pragma unroll
    for (int i = 0; i < 32; ++i) { const int kk = 2 * i + (lane >> 5); wv[i] = W[(size_t)(k0 + kk) * ldw + n0 + (lane & 31)]; }
#pragma unroll
    for (int i = 0; i < 32; ++i) { const int kk = 2 * i + (lane >> 5); float w = wv[i]; if (gain) w *= gain[k0 + kk]; scr[kk * 33 + (lane & 31)] = w; }
    asm volatile("s_waitcnt lgkmcnt(0)" ::: "memory");
    const int c = lane & 7;
#pragma unroll
    for (int j = 0; j < 4; ++j) { const int n = (lane >> 3) + 8 * j; const float* s = scr + (8 * c) * 33 + n;
        u32x4 o; o.x = pk2(s[0 * 33], s[1 * 33]); o.y = pk2(s[2 * 33], s[3 * 33]); o.z = pk2(s[4 * 33], s[5 * 33]); o.w = pk2(s[6 * 33], s[7 * 33]);
        *(u32x4*)(WT + (size_t)(n0 + n) * ldo + koff + k0 + 8 * c) = o; }
    asm volatile("s_waitcnt lgkmcnt(0)" ::: "memory");
}
__device__ __forceinline__ void cvt8(const float* src, bf16_t* dst, size_t i8) {
    const f32x4 a = *(const f32x4*)(src + i8 * 8), b = *(const f32x4*)(src + i8 * 8 + 4);
    u32x4 o; o.x = pk2(a.x, a.y); o.y = pk2(a.z, a.w); o.z = pk2(b.x, b.y); o.w = pk2(b.z, b.w);
    *(u32x4*)(dst + i8 * 8) = o;
}
__device__ __forceinline__ void transpose_item8(const float* W, int K, int N, int ldw, const float* gain, float wscale, unsigned char* WT, float* scr, int item, int lane) {
    const int nblk = N / 32, kb = item / nblk, nb = item % nblk, k0 = 64 * kb, n0 = 32 * nb;
    float wv[32];
#pragma unroll
    for (int i = 0; i < 32; ++i) { const int kk = 2 * i + (lane >> 5); wv[i] = W[(size_t)(k0 + kk) * ldw + n0 + (lane & 31)]; }
#pragma unroll
    for (int i = 0; i < 32; ++i) { const int kk = 2 * i + (lane >> 5); float w = wv[i] * wscale; if (gain) w *= gain[k0 + kk]; scr[kk * 33 + (lane & 31)] = w; }
    asm volatile("s_waitcnt lgkmcnt(0)" ::: "memory");
    const int c = lane & 7;
#pragma unroll
    for (int j = 0; j < 4; ++j) { const int n = (lane >> 3) + 8 * j; const float* s = scr + (8 * c) * 33 + n;
        u32x2 o; o.x = __builtin_amdgcn_cvt_pk_fp8_f32(s[0 * 33], s[1 * 33], 0u, false); o.x = __builtin_amdgcn_cvt_pk_fp8_f32(s[2 * 33], s[3 * 33], o.x, true);
        o.y = __builtin_amdgcn_cvt_pk_fp8_f32(s[4 * 33], s[5 * 33], 0u, false); o.y = __builtin_amdgcn_cvt_pk_fp8_f32(s[6 * 33], s[7 * 33], o.y, true);
        *(u32x2*)(WT + (size_t)(n0 + n) * K + k0 + 8 * c) = o; }
    asm volatile("s_waitcnt lgkmcnt(0)" ::: "memory");
}
__device__ __forceinline__ void rms_rows_emit(const f32x4 (&v)[4], bf16_t* orow16, unsigned char* orow, int lane) {
    float s = 0.f;
#pragma unroll
    for (int j = 0; j < 4; ++j) s += (v[j].x * v[j].x + v[j].y * v[j].y) + (v[j].z * v[j].z + v[j].w * v[j].w);
    const float rstd = 1.f / sqrtf(wave_sum(s) * (1.f / D) + EPS);
    unsigned* o4 = (unsigned*)orow + lane; u32x2* o8 = (u32x2*)orow16 + lane;
#pragma unroll
    for (int j = 0; j < 4; ++j) { unsigned w = __builtin_amdgcn_cvt_pk_fp8_f32(v[j].x * rstd, v[j].y * rstd, 0u, false); w = __builtin_amdgcn_cvt_pk_fp8_f32(v[j].z * rstd, v[j].w * rstd, w, true); o4[64 * j] = w;
        u32x2 w2; w2.x = pk2(v[j].x * rstd, v[j].y * rstd); w2.y = pk2(v[j].z * rstd, v[j].w * rstd); o8[64 * j] = w2; }
}
__device__ __forceinline__ void rms_rows(const float* x, bf16_t* xn16, unsigned char* xn8, int m0, int step, int lane) {
    if (m0 >= M) return;
    f32x4 cur[4], nxt[4];
#pragma unroll
    for (int j = 0; j < 4; ++j) cur[j] = ((const f32x4*)(x + (size_t)m0 * D) + lane)[64 * j];
    for (int m = m0; m < M; m += step) {
        const int mn = (m + step < M) ? m + step : m;
#pragma unroll
        for (int j = 0; j < 4; ++j) nxt[j] = ((const f32x4*)(x + (size_t)mn * D) + lane)[64 * j];
        rms_rows_emit(cur, xn16 + (size_t)m * D, xn8 + (size_t)m * D, lane);
#pragma unroll
        for (int j = 0; j < 4; ++j) cur[j] = nxt[j];
    }
}
__device__ __forceinline__ void rms_row_to_bf16(const float* xrow, bf16_t* orow, int lane) {
    const f32x4* xr = (const f32x4*)xrow + lane;
    f32x4 v[4]; float s = 0.f;
#pragma unroll
    for (int j = 0; j < 4; ++j) { v[j] = xr[64 * j]; s += (v[j].x * v[j].x + v[j].y * v[j].y) + (v[j].z * v[j].z + v[j].w * v[j].w); }
    const float rstd = 1.f / sqrtf(wave_sum(s) * (1.f / D) + EPS);
    u32x2* o8 = (u32x2*)orow + lane;
#pragma unroll
    for (int j = 0; j < 4; ++j) { u32x2 w; w.x = pk2(v[j].x * rstd, v[j].y * rstd); w.y = pk2(v[j].z * rstd, v[j].w * rstd); o8[64 * j] = w; }
}

__device__ __forceinline__ void prep_phase(const Ptrs& P, unsigned char* shm, int G, int bx) {
    int tid_l = threadIdx.x; asm volatile("" : "+v"(tid_l));
    const int lane = tid_l & 63; const int wave = __builtin_amdgcn_readfirstlane(tid_l >> 6);
    const int gw = bx * 8 + wave, NGW = G * 8;
    float* scr = (float*)(shm + wave * (64 * 33 * 4));
    unsigned char* ws = P.ws;
    constexpr int N_BF = 1024;
    constexpr int I_INB = (D / 64) * (N_BF / 32), I_IN8 = (D / 64) * ((INW - N_BF) / 32), I_IN = I_INB + I_IN8, I_Q = (D / 64) * (PQ / 32), I_OUT = (D / 64) * (D / 32), I_PA = (512 / 64) * (D / 32);
    constexpr int NIT = I_IN + I_Q + I_OUT + 2 * I_PA;
    for (int it = gw; it < NIT; it += NGW) {
        int r = it;
        if (r < I_INB) { transpose_item(P.w_in, D, N_BF, P.norm_mix, (bf16_t*)(ws + WS_WIN), scr, r, lane, 0, 0, INW); continue; } r -= I_INB;
        if (r < I_IN8) { transpose_item8(P.w_in + N_BF, D, INW - N_BF, INW, P.norm_mix, WIN_SCALE, ws + WS_WIN8, scr, r, lane); continue; } r -= I_IN8;
        if (r < I_Q) { transpose_item(P.w_query, D, PQ, P.norm_ffn, (bf16_t*)(ws + WS_WQ), scr, r, lane); continue; } r -= I_Q;
        if (r < I_OUT) { transpose_item(P.w_out, D, D, nullptr, (bf16_t*)(ws + WS_WOUT), scr, r, lane); continue; } r -= I_OUT;
        if (r < I_PA) { transpose_item(P.w_pa, 512, D, nullptr, (bf16_t*)(ws + WS_WPA), scr, r, lane, 1024, 0); continue; } r -= I_PA;
        transpose_item(P.w_pb, 512, D, nullptr, (bf16_t*)(ws + WS_WPA), scr, r, lane, 1024, 512);
    }
    rms_rows(P.x, (bf16_t*)(ws + WS_XN), ws + WS_XN8, gw, NGW, lane);
    const size_t gt = (size_t)bx * 512 + threadIdx.x, NT = (size_t)G * 512;
    for (size_t i = gt; i < (size_t)16 * 128 * 128 / 8; i += NT) cvt8(P.sub_keys, (bf16_t*)(ws + WS_SK), i);
    for (size_t i = gt; i < (size_t)SEQ * 8; i += NT) {
        const int pos = (int)(i >> 3), k = (int)(i & 7);
        const float inv = k == 0 ? 1.0f : k == 1 ? 0.19392274f : k == 2 ? 0.03760603f : k == 3 ? 0.0072926646f : k == 4 ? 0.0014142136f : k == 5 ? 0.0002742482f : k == 6 ? 5.3182957e-05f : 1.0313385e-05f;
        const float ang = (float)pos * inv;
        float sn, cs; sincosf(ang, &sn, &cs);
        float* t = (float*)(ws + WS_ROPE) + (size_t)pos * 16;
        t[k] = cs; t[8 + k] = sn;
    }
}
__device__ __forceinline__ void cvt_row_fp8(const f32x4 (&rv)[4], unsigned char* dst, float* inv_scale, int lane) {
    const f32x4 a = rv[0], b = rv[1], c = rv[2], d = rv[3];
    float m = fmaxf(fmaxf(fmaxf(fabsf(a.x), fabsf(a.y)), fmaxf(fabsf(a.z), fabsf(a.w))), fmaxf(fmaxf(fabsf(b.x), fabsf(b.y)), fmaxf(fabsf(b.z), fabsf(b.w))));
    m = fmaxf(m, fmaxf(fmaxf(fmaxf(fabsf(c.x), fabsf(c.y)), fmaxf(fabsf(c.z), fabsf(c.w))), fmaxf(fmaxf(fabsf(d.x), fabsf(d.y)), fmaxf(fabsf(d.z), fabsf(d.w)))));
#pragma unroll
    for (int o = 1; o < 64; o <<= 1) m = fmaxf(m, __shfl_xor(m, o));
    m = fmaxf(m, 1e-30f);
    const float sc = 256.f / m;
    u32x4 w;
    w.x = __builtin_amdgcn_cvt_pk_fp8_f32(a.x * sc, a.y * sc, 0u, false); w.x = __builtin_amdgcn_cvt_pk_fp8_f32(a.z * sc, a.w * sc, w.x, true);
    w.y = __builtin_amdgcn_cvt_pk_fp8_f32(b.x * sc, b.y * sc, 0u, false); w.y = __builtin_amdgcn_cvt_pk_fp8_f32(b.z * sc, b.w * sc, w.y, true);
    w.z = __builtin_amdgcn_cvt_pk_fp8_f32(c.x * sc, c.y * sc, 0u, false); w.z = __builtin_amdgcn_cvt_pk_fp8_f32(c.z * sc, c.w * sc, w.z, true);
    w.w = __builtin_amdgcn_cvt_pk_fp8_f32(d.x * sc, d.y * sc, 0u, false); w.w = __builtin_amdgcn_cvt_pk_fp8_f32(d.z * sc, d.w * sc, w.w, true);
    *(u32x4*)(dst + (size_t)(lane >> 5) * (NEXP * 512) + (lane & 31) * 16) = w;
    if (lane == 0) *inv_scale = m * (1.f / 256.f);
}
__device__ __forceinline__ unsigned pack_i8x4(float a, float b, float c, float d) {
    const int q0 = (int)rintf(a), q1 = (int)rintf(b), q2 = (int)rintf(c), q3 = (int)rintf(d);
    return (unsigned)(q0 & 0xff) | ((unsigned)(q1 & 0xff) << 8) | ((unsigned)(q2 & 0xff) << 16) | ((unsigned)q3 << 24);
}
__device__ __forceinline__ void cvt_row_i8(const f32x4 (&rv)[4], unsigned char* dst, float* inv_scale, int lane) {
    const f32x4 a = rv[0], b = rv[1], c = rv[2], d = rv[3];
    float m = fmaxf(fmaxf(fmaxf(fabsf(a.x), fabsf(a.y)), fmaxf(fabsf(a.z), fabsf(a.w))), fmaxf(fmaxf(fabsf(b.x), fabsf(b.y)), fmaxf(fabsf(b.z), fabsf(b.w))));
    m = fmaxf(m, fmaxf(fmaxf(fmaxf(fabsf(c.x), fabsf(c.y)), fmaxf(fabsf(c.z), fabsf(c.w))), fmaxf(fmaxf(fabsf(d.x), fabsf(d.y)), fmaxf(fabsf(d.z), fabsf(d.w)))));
#pragma unroll
    for (int o = 1; o < 64; o <<= 1) m = fmaxf(m, __shfl_xor(m, o));
    m = fmaxf(m, 1e-30f);
    const float sc = 127.f / m;
    u32x4 w;
    w.x = pack_i8x4(a.x * sc, a.y * sc, a.z * sc, a.w * sc); w.y = pack_i8x4(b.x * sc, b.y * sc, b.z * sc, b.w * sc);
    w.z = pack_i8x4(c.x * sc, c.y * sc, c.z * sc, c.w * sc); w.w = pack_i8x4(d.x * sc, d.y * sc, d.z * sc, d.w * sc);
    *(u32x4*)(dst + (size_t)(lane >> 5) * (NEXP * 512) + (lane & 31) * 16) = w;
    if (lane == 0) *inv_scale = m * (1.f / 127.f);
}
__device__ __forceinline__ void cvt_experts_phase(const Ptrs& P, int G, int bx) {
    int tid_l = threadIdx.x; asm volatile("" : "+v"(tid_l));
    const int lane = tid_l & 63; const int wave = __builtin_amdgcn_readfirstlane(tid_l >> 6);
    const int step = G * 8; int r = bx * 8 + wave;
    if (r >= 2 * NEXP) return;
    f32x4 cur[4], nxt[4];
    { const float* src = (r < NEXP ? P.peer_u + (size_t)r * D : P.peer_v + (size_t)(r - NEXP) * D);
#pragma unroll
      for (int j = 0; j < 4; ++j) cur[j] = ((const f32x4*)src + lane * 4)[j]; }
    for (; r < 2 * NEXP; r += step) {
        const int rn = (r + step < 2 * NEXP) ? r + step : r;
        const float* srcn = (rn < NEXP ? P.peer_u + (size_t)rn * D : P.peer_v + (size_t)(rn - NEXP) * D);
#pragma unroll
        for (int j = 0; j < 4; ++j) nxt[j] = ((const f32x4*)srcn + lane * 4)[j];
        if (r < NEXP) cvt_row_i8(cur, P.ws + WS_U + (size_t)r * 512, (float*)(P.ws + WS_SU) + r, lane);
        else { const int e = r - NEXP; cvt_row_fp8(cur, P.ws + WS_V + (size_t)e * 512, (float*)(P.ws + WS_SV) + e, lane); }
#pragma unroll
        for (int j = 0; j < 4; ++j) cur[j] = nxt[j];
    }
}

namespace pg8 {
#define PG8_LAS __attribute__((address_space(3)))
typedef unsigned short bf16_t;
typedef short bf16x8 __attribute__((ext_vector_type(8)));
typedef float f32x4 __attribute__((ext_vector_type(4)));
typedef unsigned u32x4 __attribute__((ext_vector_type(4)));
typedef int v8i_t __attribute__((ext_vector_type(8)));
constexpr int BM = 256, BK = 64, HALF = 128, HTB = HALF * BK * 2  , STAGE_BYTES = 8 * HTB, NXCD = 8, WGM = 8;

__host__ __device__ __forceinline__ int lds_byte(int r, int c) { const int st = (r >> 4) * 2 + (c >> 5), rr = r & 15, cc = c & 31, ob = rr * 64 + cc * 2; return st * 1024 + (ob ^ (((ob >> 9) & 1) << 5)); }
__host__ __device__ __forceinline__ void stage_rc(int b, int& R, int& C) { const int st = b / 1024, sb = b % 1024, swz = sb ^ (((sb >> 9) & 1) << 5); R = (st >> 1) * 16 + swz / 64; C = (st & 1) * 32 + (swz % 64) / 2; }
__host__ __device__ __forceinline__ int perm32(int rho) { const int n = rho >> 4, i = rho & 15; return 8 * (i >> 2) + 4 * n + (i & 3); }

struct Unit { int pm, pn; };
struct Gemm { const bf16_t* A; const bf16_t* Bt; int M, N, K, pad; };

struct StaticOrder {
    int nM, nN, nwg, G, c;
    __host__ __device__ void init(int M, int N, int G_, int c_) { nM = M / BM; nN = N / BM; nwg = nM * nN; G = G_; c = c_; }
    __host__ __device__ bool next(int i, Unit& u) const {
        const long L = (long)i * G + c; if (L >= nwg) return false;
        int wgid = (int)L; { const int q = nwg / NXCD, r = nwg % NXCD, xcd = wgid % NXCD, off = wgid / NXCD; wgid = (xcd < r ? xcd * (q + 1) : r * (q + 1) + (xcd - r) * q) + off; }
        const int nig = WGM * nN, gid = wgid / nig, fm = gid * WGM, gsz = (nM - fm) < WGM ? (nM - fm) : WGM;
        u.pm = fm + ((wgid % nig) % gsz); u.pn = (wgid % nig) / gsz; return true;
    }
    __device__ __forceinline__ void a_ready(const Unit&) const {}
    __device__ __forceinline__ void done(const Unit&) const {}
};
__device__ __forceinline__ unsigned cvt_pk_bf16(float lo, float hi) { unsigned r; asm volatile("v_cvt_pk_bf16_f32 %0, %1, %2" : "=v"(r) : "v"(lo), "v"(hi)); return r; }
typedef float f32x2 __attribute__((ext_vector_type(2)));

__device__ __forceinline__ float sigm(float x) { return __builtin_amdgcn_rcpf(1.f + __builtin_amdgcn_exp2f(-1.4426950408889634f * x)); }
struct EpiProj {
    static constexpr bool PERM = true, AFTER_DRAIN = false, MID = false;
    bf16_t* O; const float* rope; float osc; int pn0;
    __device__ __forceinline__ void operator()(const f32x4 (&acc)[2][2][4][2], const Unit& u, int wr, int wc, int fr_, int fq_) const {
        int fr = fr_, fq = fq_; asm volatile("" : "+v"(fr), "+v"(fq));
        const int pn = u.pn + pn0;
        const int row0 = u.pm * BM + wr * 64 + fr, col0 = pn * BM + wc * 32 + 8 * fq;
        const float sc = ((pn < 2 || pn == 6 || pn == 7) ? QSCALE : 1.f) * osc;
        const bool dorope = (pn < 4) && ((wc & 1) == 0);
#pragma unroll
        for (int ai = 0; ai < 2; ++ai)
#pragma unroll
            for (int m = 0; m < 4; ++m) { const int row = row0 + ai * HALF + m * 16; bf16_t* rowp = O + (size_t)row * INW + col0;
                f32x4 c4[2] = {{1.f, 1.f, 1.f, 1.f}, {1.f, 1.f, 1.f, 1.f}}, s4[2] = {{0.f, 0.f, 0.f, 0.f}, {0.f, 0.f, 0.f, 0.f}};
                if (dorope) { const float* rp = rope + (size_t)(row & (SEQ - 1)) * 16; c4[0] = *(const f32x4*)(rp); c4[1] = *(const f32x4*)(rp + 4); s4[0] = *(const f32x4*)(rp + 8); s4[1] = *(const f32x4*)(rp + 12); }
#pragma unroll
                for (int bj = 0; bj < 2; ++bj) { f32x4 v0 = acc[ai][bj][m][0], v1 = acc[ai][bj][m][1];
                    if (dorope) { f32x4 o0, o1;
#pragma unroll
                        for (int j = 0; j < 4; ++j) { o0[j] = __shfl_xor(v0[j], 16); o1[j] = __shfl_xor(v1[j], 16); }
                        if (fq == 0) { v0 = v0 * c4[0] - o0 * s4[0]; v1 = v1 * c4[1] - o1 * s4[1]; }
                        else if (fq == 1) { v0 = v0 * c4[0] + o0 * s4[0]; v1 = v1 * c4[1] + o1 * s4[1]; } }
                    v0 = v0 * sc; v1 = v1 * sc; u32x4 w; w.x = cvt_pk_bf16(v0[0], v0[1]); w.y = cvt_pk_bf16(v0[2], v0[3]); w.z = cvt_pk_bf16(v1[0], v1[1]); w.w = cvt_pk_bf16(v1[2], v1[3]);
                    *(u32x4*)(rowp + bj * HALF) = w; } }
    }
};
struct EpiGate2 {
    static constexpr bool PERM = true, AFTER_DRAIN = false, MID = true;
    const bf16_t* proj; bf16_t* O;
    __device__ __forceinline__ void mid(f32x4 (&acc)[2][2][4][2], const Unit& u, int wr, int wc, int fr, int fq) const {
        int row0 = u.pm * BM + wr * 64 + fr, col0 = u.pn * BM + wc * 32 + 8 * fq;
        asm volatile("" : "+v"(row0), "+v"(col0));
#pragma unroll
        for (int ai = 0; ai < 2; ++ai)
#pragma unroll
            for (int m = 0; m < 4; ++m) { const int row = row0 + ai * HALF + m * 16;
#pragma unroll
                for (int bj = 0; bj < 2; ++bj) { const int col = col0 + bj * HALF;
                    const u32x4 ga = *(const u32x4*)(proj + (size_t)row * INW + C_GA + col), gb = *(const u32x4*)(proj + (size_t)row * INW + C_GB + col);
                    const unsigned a_[4] = {ga.x, ga.y, ga.z, ga.w}, b_[4] = {gb.x, gb.y, gb.z, gb.w};
#pragma unroll
                    for (int q = 0; q < 4; ++q) {
                        const float r0 = (1.f + __builtin_amdgcn_exp2f(-1.4426950408889634f * bflo(b_[q]))) * __builtin_amdgcn_rcpf(1.f + __builtin_amdgcn_exp2f(-1.4426950408889634f * bflo(a_[q])));
                        const float r1 = (1.f + __builtin_amdgcn_exp2f(-1.4426950408889634f * bfhi(b_[q]))) * __builtin_amdgcn_rcpf(1.f + __builtin_amdgcn_exp2f(-1.4426950408889634f * bfhi(a_[q])));
                        acc[ai][bj][m][q >> 1][(q & 1) * 2] *= r0; acc[ai][bj][m][q >> 1][(q & 1) * 2 + 1] *= r1; } }
                asm volatile("" ::: "memory"); }
    }
    __device__ __forceinline__ void operator()(const f32x4 (&acc)[2][2][4][2], const Unit& u, int wr, int wc, int fr, int fq) const {
        const int row0 = u.pm * BM + wr * 64 + fr, col0 = u.pn * BM + wc * 32 + 8 * fq;
#pragma unroll
        for (int ai = 0; ai < 2; ++ai)
#pragma unroll
            for (int m = 0; m < 4; ++m) { const int row = row0 + ai * HALF + m * 16;
#pragma unroll
                for (int bj = 0; bj < 2; ++bj) { const int col = col0 + bj * HALF; const u32x4 g = *(const u32x4*)(proj + (size_t)row * INW + C_GB + col);
                    f32x4 v0 = acc[ai][bj][m][0], v1 = acc[ai][bj][m][1];
                    v0[0] *= sigm(bflo(g.x)); v0[1] *= sigm(bfhi(g.x)); v0[2] *= sigm(bflo(g.y)); v0[3] *= sigm(bfhi(g.y));
                    v1[0] *= sigm(bflo(g.z)); v1[1] *= sigm(bfhi(g.z)); v1[2] *= sigm(bflo(g.w)); v1[3] *= sigm(bfhi(g.w));
                    u32x4 w; w.x = cvt_pk_bf16(v0[0], v0[1]); w.y = cvt_pk_bf16(v0[2], v0[3]); w.z = cvt_pk_bf16(v1[0], v1[1]); w.w = cvt_pk_bf16(v1[2], v1[3]);
                    *(u32x4*)(O + (size_t)row * D + col) = w; } }
    }
};
struct EpiHout {
    static constexpr bool PERM = true, AFTER_DRAIN = false, MID = false;
    const float* x; float* H; bf16_t* HB; float* ssq16;
    __device__ __forceinline__ void operator()(const f32x4 (&acc)[2][2][4][2], const Unit& u, int wr, int wc, int fr, int fq) const {
        const int row0 = u.pm * BM + wr * 64 + fr, col0 = u.pn * BM + wc * 32 + 8 * fq;
#pragma unroll
        for (int ai = 0; ai < 2; ++ai)
#pragma unroll
            for (int m = 0; m < 4; ++m) { const int row = row0 + ai * HALF + m * 16; float ss = 0.f;
#pragma unroll
                for (int bj = 0; bj < 2; ++bj) { const int col = col0 + bj * HALF; const float* xp = x + (size_t)row * D + col;
                    const f32x4 v0 = acc[ai][bj][m][0] + *(const f32x4*)xp, v1 = acc[ai][bj][m][1] + *(const f32x4*)(xp + 4);
                    u32x4 w; w.x = cvt_pk_bf16(v0[0], v0[1]); w.y = cvt_pk_bf16(v0[2], v0[3]); w.z = cvt_pk_bf16(v1[0], v1[1]); w.w = cvt_pk_bf16(v1[2], v1[3]);
                    *(u32x4*)(HB + (size_t)row * D + col) = w;
                    ss += (v0[0] * v0[0] + v0[1] * v0[1]) + (v0[2] * v0[2] + v0[3] * v0[3]) + (v1[0] * v1[0] + v1[1] * v1[1]) + (v1[2] * v1[2] + v1[3] * v1[3]); }
                ss += __shfl_xor(ss, 16); ss += __shfl_xor(ss, 32);
                if (fq == 0) ssq16[(size_t)row * 16 + u.pn * 4 + wc] = ss; }
    }
};
struct EpiQ {
    static constexpr bool PERM = true, AFTER_DRAIN = false, MID = false;
    const float* ssq16; bf16_t* O;
    __device__ __forceinline__ void operator()(const f32x4 (&acc)[2][2][4][2], const Unit& u, int wr, int wc, int fr, int fq) const {
        const int row0 = u.pm * BM + wr * 64 + fr, col0 = u.pn * BM + wc * 32 + 8 * fq;
#pragma unroll
        for (int ai = 0; ai < 2; ++ai)
#pragma unroll
            for (int m = 0; m < 4; ++m) { const int row = row0 + ai * HALF + m * 16; const f32x4* sp = (const f32x4*)(ssq16 + (size_t)row * 16);
                const f32x4 a = sp[0], b = sp[1], c = sp[2], d = sp[3];
                const float tot = ((a[0] + a[1]) + (a[2] + a[3])) + ((b[0] + b[1]) + (b[2] + b[3])) + ((c[0] + c[1]) + (c[2] + c[3])) + ((d[0] + d[1]) + (d[2] + d[3]));
                const float rstd = 1.f / sqrtf(tot * (1.f / D) + EPS);
#pragma unroll
                for (int bj = 0; bj < 2; ++bj) { const f32x4 v0 = acc[ai][bj][m][0] * rstd, v1 = acc[ai][bj][m][1] * rstd;
                    u32x4 w; w.x = cvt_pk_bf16(v0[0], v0[1]); w.y = cvt_pk_bf16(v0[2], v0[3]); w.z = cvt_pk_bf16(v1[0], v1[1]); w.w = cvt_pk_bf16(v1[2], v1[3]);
                    *(u32x4*)(O + (size_t)row * PQ + col0 + bj * HALF) = w; } }
    }
};
template <class Epi, class Sched, bool ALIGN_EPI = false, bool SP2 = false, bool FP8 = false>
__device__ __forceinline__ void gemm_phase(PG8_LAS unsigned char* lds, const Gemm g, const Sched& S, const Epi& E) {
    int tid_l = threadIdx.x; asm volatile("" : "+v"(tid_l));
    const int tid = tid_l, wid = __builtin_amdgcn_readfirstlane(tid >> 6), lane = tid & 63, wr = wid >> 2, wc = wid & 3, fr = lane & 15, fq = lane >> 4;
    const int K = g.K, nt = K / BK;
    unsigned voffA[2], voffB[2];
#pragma unroll
    for (int i = 0; i < 2; ++i) { int R, C; stage_rc(tid * 16 + i * 8192, R, C); const int Rb = Epi::PERM ? ((R & ~31) + perm32(R & 31)) : R;
        voffA[i] = (unsigned)(R * K + C) * 2u; voffB[i] = (unsigned)(Rb * K + C) * 2u; }
    const size_t kstep = (size_t)(BK * 2);
    const size_t hstep = (size_t)HALF * K * 2;
    const size_t tstep = 2 * hstep;
    const unsigned ldsw = (unsigned)wid * 1024u;
    const int aoff = lds_byte(wr * 64 + fr, fq * 8), boff = lds_byte(wc * 32 + fr, fq * 8);
    const int aoffF0 = FP8 ? lds_byte(wr * 64 + fr, fq * 16) : 0, boffF0 = FP8 ? lds_byte(wc * 32 + fr, fq * 16) : 0;
#define PG8_SA(b, h) (((b) * 2 + (h)) * HTB)
#define PG8_SB(b, h) ((4 + (b) * 2 + (h)) * HTB)
#define PG8_STAGE(bufoff, gbase, voff) do { _Pragma("unroll") for (int _i = 0; _i < 2; ++_i) \
        __builtin_amdgcn_global_load_lds((const unsigned*)((const char*)(gbase) + (voff)[_i]), (PG8_LAS unsigned*)(lds + (bufoff) + ldsw + _i * 8192), 16, 0, 0); } while (0)
#define PG8_LDA(dst, b, h) do { if constexpr (FP8) { _Pragma("unroll") for (int m = 0; m < 4; ++m) { const u32x4 l_ = *(const PG8_LAS u32x4*)(lds + PG8_SA(b, h) + aoffF0 + m * 2048), h_ = *(const PG8_LAS u32x4*)(lds + PG8_SA(b, h) + aoffF0 + m * 2048 + 16); \
            dst##8[m] = (v8i_t){(int)l_.x, (int)l_.y, (int)l_.z, (int)l_.w, (int)h_.x, (int)h_.y, (int)h_.z, (int)h_.w}; } } \
        else { _Pragma("unroll") for (int m = 0; m < 4; ++m) _Pragma("unroll") for (int k = 0; k < 2; ++k) dst[m][k] = *(const PG8_LAS bf16x8*)(lds + PG8_SA(b, h) + aoff + m * 2048 + k * 1024); } } while (0)
#define PG8_LDB(dst, b, h) do { if constexpr (FP8) { _Pragma("unroll") for (int n = 0; n < 2; ++n) { const u32x4 l_ = *(const PG8_LAS u32x4*)(lds + PG8_SB(b, h) + boffF0 + n * 2048), h_ = *(const PG8_LAS u32x4*)(lds + PG8_SB(b, h) + boffF0 + n * 2048 + 16); \
            dst##8[n] = (v8i_t){(int)l_.x, (int)l_.y, (int)l_.z, (int)l_.w, (int)h_.x, (int)h_.y, (int)h_.z, (int)h_.w}; } } \
        else { _Pragma("unroll") for (int n = 0; n < 2; ++n) _Pragma("unroll") for (int k = 0; k < 2; ++k) dst[n][k] = *(const PG8_LAS bf16x8*)(lds + PG8_SB(b, h) + boff + n * 2048 + k * 1024); } } while (0)
#define PG8_MMA(ai, bj, At, Bt) do { __builtin_amdgcn_s_setprio(1); \
        if constexpr (FP8) { _Pragma("unroll") for (int m = 0; m < 4; ++m) _Pragma("unroll") for (int n = 0; n < 2; ++n) \
            asm volatile("v_mfma_scale_f32_16x16x128_f8f6f4 %0, %1, %2, %0, %3, %3 op_sel_hi:[0,0,0]" : "+v"(acc[ai][bj][m][n]) : "v"(Bt##8[n]), "v"(At##8[m]), "v"(mxone)); } \
        else { _Pragma("unroll") for (int m = 0; m < 4; ++m) _Pragma("unroll") for (int n = 0; n < 2; ++n) _Pragma("unroll") for (int k = 0; k < 2; ++k) \
            acc[ai][bj][m][n] = __builtin_amdgcn_mfma_f32_16x16x32_bf16(Bt[n][k], At[m][k], acc[ai][bj][m][n], 0, 0, 0); } \
        __builtin_amdgcn_s_setprio(0); } while (0)
#define PG8_WAIT_V(n) asm volatile("s_waitcnt vmcnt(" #n ")" ::: "memory")
#define PG8_WAIT_L(n) asm volatile("s_waitcnt lgkmcnt(" #n ")" ::: "memory")
#define PG8_BAR __builtin_amdgcn_s_barrier()
#define PG8_SCHED __builtin_amdgcn_sched_barrier(0)
    Unit cur, nxt; int ui = 0;
    if (!S.next(0, cur)) return;
    f32x4 acc[2][2][4][2];
#pragma unroll
    for (int a = 0; a < 2; ++a)
#pragma unroll
        for (int b = 0; b < 2; ++b)
#pragma unroll
            for (int m = 0; m < 4; ++m)
#pragma unroll
                for (int n = 0; n < 2; ++n) acc[a][b][m][n] = (f32x4){0.f, 0.f, 0.f, 0.f};
    bf16x8 At[4][2], B0[2][2], B1[2][2]; v8i_t At8[4], B08[2], B18[2];
    int mxone = 0x7F7F7F7F; asm volatile("" : "+v"(mxone));
    const char* cA = (const char*)g.A + (size_t)cur.pm * tstep; const char* cB = (const char*)g.Bt + (size_t)cur.pn * tstep;
    S.a_ready(cur);
    if constexpr (SP2) {
        PG8_STAGE(PG8_SB(0, 0), cB, voffB); PG8_STAGE(PG8_SB(0, 1), cB + hstep, voffB); PG8_STAGE(PG8_SA(0, 0), cA, voffA); PG8_STAGE(PG8_SA(0, 1), cA + hstep, voffA);
        if (wr == 1) PG8_BAR;
        PG8_WAIT_V(2); PG8_BAR;
        PG8_STAGE(PG8_SB(1, 0), cB + kstep, voffB); PG8_STAGE(PG8_SA(1, 0), cA + kstep, voffA); PG8_STAGE(PG8_SB(1, 1), cB + hstep + kstep, voffB);
        PG8_WAIT_V(6); PG8_BAR;
    } else {
        PG8_STAGE(PG8_SB(0, 0), cB, voffB); PG8_STAGE(PG8_SA(0, 0), cA, voffA); PG8_STAGE(PG8_SB(0, 1), cB + hstep, voffB); PG8_STAGE(PG8_SA(0, 1), cA + hstep, voffA);
        if (wr == 1) PG8_BAR;
        PG8_WAIT_V(4); PG8_BAR;
        PG8_STAGE(PG8_SB(1, 0), cB + kstep, voffB); PG8_STAGE(PG8_SA(1, 0), cA + kstep, voffA); PG8_STAGE(PG8_SB(1, 1), cB + hstep + kstep, voffB);
        PG8_WAIT_V(6); PG8_BAR;
    }
    for (;;) {
        const bool has_next = S.next(ui + 1, nxt);
        const char* nA = has_next ? (const char*)g.A + (size_t)nxt.pm * tstep : cA; const char* nB = has_next ? (const char*)g.Bt + (size_t)nxt.pn * tstep : cB;
#pragma unroll 1
        for (int t = 0; t < nt; t += 2) {
            if constexpr (Epi::MID) { if (t == nt / 2) E.mid(acc, cur, wr, wc, fr, fq); }
            const bool last = (t == nt - 2);
            const char* a1 = cA + (size_t)(t + 1) * kstep;
            const char* a2 = last ? nA : cA + (size_t)(t + 2) * kstep; const char* b2 = last ? nB : cB + (size_t)(t + 2) * kstep;
            const char* a3 = a2 + kstep; const char* b3 = b2 + kstep;
            if (last && has_next) S.a_ready(nxt);
            if constexpr (SP2) {
            PG8_LDB(B0, 0, 0); PG8_LDB(B1, 0, 1); PG8_SCHED; PG8_LDA(At, 0, 0); PG8_STAGE(PG8_SA(1, 1), a1 + hstep, voffA);
            PG8_WAIT_V(8); PG8_WAIT_L(0); PG8_BAR; PG8_MMA(0, 0, At, B0); PG8_MMA(0, 1, At, B1); PG8_BAR; PG8_SCHED;
            PG8_LDA(At, 0, 1); PG8_STAGE(PG8_SB(0, 0), b2, voffB); PG8_STAGE(PG8_SB(0, 1), b2 + hstep, voffB); PG8_STAGE(PG8_SA(0, 0), a2, voffA);
            PG8_WAIT_V(8); PG8_WAIT_L(0); PG8_BAR; PG8_MMA(1, 0, At, B0); PG8_MMA(1, 1, At, B1); PG8_BAR; PG8_SCHED;
            PG8_LDB(B0, 1, 0); PG8_LDB(B1, 1, 1); PG8_SCHED; PG8_LDA(At, 1, 0); PG8_STAGE(PG8_SA(0, 1), a2 + hstep, voffA);
            PG8_WAIT_V(8); PG8_WAIT_L(0); PG8_BAR; PG8_MMA(0, 0, At, B0); PG8_MMA(0, 1, At, B1); PG8_BAR; PG8_SCHED;
            PG8_LDA(At, 1, 1); PG8_STAGE(PG8_SB(1, 0), b3, voffB); PG8_STAGE(PG8_SB(1, 1), b3 + hstep, voffB); PG8_STAGE(PG8_SA(1, 0), a3, voffA);
            PG8_WAIT_V(8); PG8_WAIT_L(0); PG8_BAR; PG8_MMA(1, 0, At, B0); PG8_MMA(1, 1, At, B1); PG8_BAR; PG8_SCHED;
            } else {
            PG8_LDB(B0, 0, 0); PG8_SCHED; PG8_LDA(At, 0, 0); PG8_STAGE(PG8_SA(1, 1), a1 + hstep, voffA);
            PG8_WAIT_L(8); PG8_BAR; PG8_WAIT_L(0); PG8_MMA(0, 0, At, B0); PG8_BAR; PG8_SCHED;
            PG8_LDB(B1, 0, 1); PG8_STAGE(PG8_SB(0, 0), b2, voffB);
            PG8_BAR; PG8_WAIT_L(0); PG8_MMA(0, 1, At, B1); PG8_BAR;
            PG8_LDA(At, 0, 1); PG8_STAGE(PG8_SA(0, 0), a2, voffA);
            PG8_BAR; PG8_WAIT_L(0); PG8_MMA(1, 0, At, B0); PG8_BAR; PG8_SCHED;
            PG8_STAGE(PG8_SB(0, 1), b2 + hstep, voffB);
            PG8_WAIT_V(6); PG8_BAR; PG8_MMA(1, 1, At, B1); PG8_BAR;
            PG8_LDB(B0, 1, 0); PG8_SCHED; PG8_LDA(At, 1, 0); PG8_STAGE(PG8_SA(0, 1), a2 + hstep, voffA);
            PG8_WAIT_L(8); PG8_BAR; PG8_WAIT_L(0); PG8_MMA(0, 0, At, B0); PG8_BAR; PG8_SCHED;
            PG8_LDB(B1, 1, 1); PG8_STAGE(PG8_SB(1, 0), b3, voffB);
            PG8_BAR; PG8_WAIT_L(0); PG8_MMA(0, 1, At, B1); PG8_BAR;
            PG8_LDA(At, 1, 1); PG8_STAGE(PG8_SA(1, 0), a3, voffA);
            PG8_BAR; PG8_WAIT_L(0); PG8_MMA(1, 0, At, B0); PG8_BAR; PG8_SCHED;
            PG8_STAGE(PG8_SB(1, 1), b3 + hstep, voffB);
            PG8_WAIT_V(6); PG8_BAR; PG8_MMA(1, 1, At, B1); PG8_BAR;
            }
        }
        if constexpr (ALIGN_EPI) { if (wr == 0) PG8_BAR; }
        if constexpr (FP8) { asm volatile("s_nop 15\n\ts_nop 7" ::: "memory"); PG8_SCHED; }
        if constexpr (!Epi::AFTER_DRAIN) { E(acc, cur, wr, wc, fr, fq); S.done(cur); }
        if (!has_next) break;
#pragma unroll
        for (int a = 0; a < 2; ++a)
#pragma unroll
            for (int b = 0; b < 2; ++b)
#pragma unroll
                for (int m = 0; m < 4; ++m)
#pragma unroll
                    for (int n = 0; n < 2; ++n) acc[a][b][m][n] = (f32x4){0.f, 0.f, 0.f, 0.f};
        cur = nxt; cA = nA; cB = nB; ++ui;
        if constexpr (ALIGN_EPI) { if (wr == 1) PG8_BAR; }
    }
    PG8_WAIT_V(0);
    if constexpr (!ALIGN_EPI) { if (wr == 0) PG8_BAR; }
    PG8_BAR;
    if constexpr (Epi::AFTER_DRAIN) { E.fused(acc, cur, wr, wc, fr, fq, lds, wid, lane); S.done(cur); }
#undef PG8_SA
#undef PG8_SB
#undef PG8_STAGE
#undef PG8_LDA
#undef PG8_LDB
#undef PG8_MMA
#undef PG8_WAIT_V
#undef PG8_WAIT_L
#undef PG8_BAR
#undef PG8_SCHED
}
}

__device__ __forceinline__ float lambda_full(const Ptrs& P) {
    float a = 0.f, b = 0.f;
    for (int i = 0; i < 64; ++i) { a += P.lq1[i] * P.lk1[i]; b += P.lq2[i] * P.lk2[i]; }
    return __expf(a) - __expf(b) + 0.2f;
}

namespace att {
typedef short bf16x8 __attribute__((ext_vector_type(8)));
typedef short s16x4 __attribute__((ext_vector_type(4)));
typedef float f32x16 __attribute__((ext_vector_type(16)));
typedef float f32x2_t __attribute__((ext_vector_type(2)));
typedef __attribute__((address_space(3))) const char* lds_cptr;
typedef __attribute__((address_space(3))) char* lds_ptr;
__device__ __forceinline__ int crow(int r, int hi) { return (r & 3) + 8 * (r >> 2) + 4 * hi; }
__device__ __forceinline__ void glds16(const void* gsrc, unsigned lds_dst) { unsigned keep;
    asm volatile("s_mov_b32 %0, m0\n\ts_mov_b32 m0, %2\n\ts_nop 0\n\tglobal_load_lds_dwordx4 %1, off\n\ts_mov_b32 m0, %0" : "=&s"(keep) : "v"(gsrc), "s"(lds_dst) : "memory"); }
__device__ __forceinline__ unsigned cvtpk(float lo, float hi) { f32x2_t v = {lo, hi}; bf16x2_t b = __builtin_convertvector(v, bf16x2_t); return __builtin_bit_cast(unsigned, b); }
#define ATT_WAIT_BAR(N) asm volatile("s_waitcnt vmcnt(" #N ") lgkmcnt(0)\n\ts_barrier" ::: "memory")
#define ATT_LDSWAIT() asm volatile("s_waitcnt lgkmcnt(0)" ::: "memory")
#define ATT_SBAR() __builtin_amdgcn_sched_barrier(0)
template <bool REL> __device__ __forceinline__ void qkt(f32x16& p0, f32x16& p1, lds_cptr Kslot, const bf16x8* qr, const f32x16& negm, int r32, int hi) {
    lds_cptr kb = Kslot + hi * 1024 + r32 * 16;
#pragma unroll
    for (int d0 = 0; d0 < 4; ++d0) {
        const bf16x8 b0 = *(const __attribute__((address_space(3))) bf16x8*)(kb + d0 * 2048);
        const bf16x8 b1 = *(const __attribute__((address_space(3))) bf16x8*)(kb + d0 * 2048 + 512);
        if (d0 == 0) { if (REL) { p0 = __builtin_amdgcn_mfma_f32_32x32x16_bf16(b0, qr[0], negm, 0, 0, 0); p1 = __builtin_amdgcn_mfma_f32_32x32x16_bf16(b1, qr[0], negm, 0, 0, 0); }
                       else { p0 = __builtin_amdgcn_mfma_f32_32x32x16_bf16(b0, qr[0], f32x16{}, 0, 0, 0); p1 = __builtin_amdgcn_mfma_f32_32x32x16_bf16(b1, qr[0], f32x16{}, 0, 0, 0); } }
        else { p0 = __builtin_amdgcn_mfma_f32_32x32x16_bf16(b0, qr[d0], p0, 0, 0, 0); p1 = __builtin_amdgcn_mfma_f32_32x32x16_bf16(b1, qr[d0], p1, 0, 0, 0); } }
}
__device__ __forceinline__ float rowmax32(const f32x16& p0, const f32x16& p1) {
    float a = fmaxf(p0[0], p1[0]);
#pragma unroll
    for (int r = 1; r < 16; ++r) a = fmaxf(a, fmaxf(p0[r], p1[r]));
    auto rr = __builtin_amdgcn_permlane32_swap(__float_as_uint(a), __float_as_uint(a), false, false);
    return fmaxf(__uint_as_float(rr[0]), __uint_as_float(rr[1]));
}
__device__ __forceinline__ float halfsum(float a) { auto rr = __builtin_amdgcn_permlane32_swap(__float_as_uint(a), __float_as_uint(a), false, false); return __uint_as_float(rr[0]) + __uint_as_float(rr[1]); }
template <int ND0> __device__ __forceinline__ void pv(f32x16* o, int vb, bf16x8 pa0, bf16x8 pa1, bf16x8 pa2, bf16x8 pa3) {
#pragma unroll
    for (int d0 = 0; d0 < ND0; ++d0) { s16x4 lo[4], hi[4];
#pragma unroll
        for (int ks = 0; ks < 4; ++ks) {
            asm volatile("ds_read_b64_tr_b16 %0,%1 offset:%c2" : "=&v"(lo[ks]) : "v"(vb), "i"(d0 * 4096 + ks * 1024) : "memory");
            asm volatile("ds_read_b64_tr_b16 %0,%1 offset:%c2" : "=&v"(hi[ks]) : "v"(vb), "i"(d0 * 4096 + ks * 1024 + 512) : "memory"); }
        asm volatile("s_waitcnt lgkmcnt(0)" ::: "memory"); ATT_SBAR();
#define ATT_PK(k) (bf16x8){lo[k][0], lo[k][1], lo[k][2], lo[k][3], hi[k][0], hi[k][1], hi[k][2], hi[k][3]}
        o[d0] = __builtin_amdgcn_mfma_f32_32x32x16_bf16(pa0, ATT_PK(0), o[d0], 0, 0, 0);
        o[d0] = __builtin_amdgcn_mfma_f32_32x32x16_bf16(pa1, ATT_PK(1), o[d0], 0, 0, 0);
        o[d0] = __builtin_amdgcn_mfma_f32_32x32x16_bf16(pa2, ATT_PK(2), o[d0], 0, 0, 0);
        o[d0] = __builtin_amdgcn_mfma_f32_32x32x16_bf16(pa3, ATT_PK(3), o[d0], 0, 0, 0);
#undef ATT_PK
    }
}
template <int ND0, int THR, bool REL> __device__ __forceinline__ void softmax_tile(f32x16& p0, f32x16& p1, float& mrun, float& lsum, f32x16& negm, bool first, f32x16* o, __attribute__((address_space(3))) float* wsf, int r32, int hi,
                                                                   u32x4& pw0, u32x4& pw1, u32x4& pw2, u32x4& pw3) {
    float rm = rowmax32(p0, p1);
    if (!REL) rm -= mrun;
    if (first) {
        mrun = REL ? rm : mrun + rm;
        if (REL) {
#pragma unroll
            for (int r = 0; r < 16; ++r) { p0[r] -= rm; p1[r] -= rm; negm[r] = -mrun; } }
    } else if (__any(rm > (float)THR)) {
        const float dl = fmaxf(rm, 0.f), alpha = __builtin_amdgcn_exp2f(-dl); lsum *= alpha; mrun += dl;
        if (REL) {
#pragma unroll
            for (int r = 0; r < 16; ++r) { p0[r] -= dl; p1[r] -= dl; negm[r] = -mrun; } }
        if (hi == 0) wsf[r32] = alpha;
        ATT_LDSWAIT();
#pragma unroll
        for (int g = 0; g < 4; ++g) { const f32x4 a4 = *(const __attribute__((address_space(3))) f32x4*)(wsf + 8 * g + 4 * hi);
#pragma unroll
            for (int d0 = 0; d0 < ND0; ++d0) { o[d0][4 * g + 0] *= a4[0]; o[d0][4 * g + 1] *= a4[1]; o[d0][4 * g + 2] *= a4[2]; o[d0][4 * g + 3] *= a4[3]; } }
        ATT_LDSWAIT();
    }
    float s = 0.f;
#pragma unroll
    for (int r = 0; r < 16; ++r) { p0[r] = __builtin_amdgcn_exp2f(REL ? p0[r] : p0[r] - mrun); p1[r] = __builtin_amdgcn_exp2f(REL ? p1[r] : p1[r] - mrun); s += p0[r] + p1[r]; }
    lsum += s;
    pw0 = (u32x4){cvtpk(p0[0], p0[1]), cvtpk(p0[2], p0[3]), cvtpk(p0[4], p0[5]), cvtpk(p0[6], p0[7])};
    pw1 = (u32x4){cvtpk(p0[8], p0[9]), cvtpk(p0[10], p0[11]), cvtpk(p0[12], p0[13]), cvtpk(p0[14], p0[15])};
    pw2 = (u32x4){cvtpk(p1[0], p1[1]), cvtpk(p1[2], p1[3]), cvtpk(p1[4], p1[5]), cvtpk(p1[6], p1[7])};
    pw3 = (u32x4){cvtpk(p1[8], p1[9]), cvtpk(p1[10], p1[11]), cvtpk(p1[12], p1[13]), cvtpk(p1[14], p1[15])};
}

constexpr int A_SLOTK = 8192, A_SLOTV = 16384, A_NS = 3, A_NSV = 4;
constexpr int A_LDS_K = 0, A_LDS_V = A_NS * A_SLOTK, A_LDS_WS = A_LDS_V + A_NSV * A_SLOTV, A_LDS_ST = A_LDS_WS + 8 * 256, A_LDS_BYTES = A_LDS_ST + 8 * 8192;
__device__ __forceinline__ void attn_a_unit(int b, int h, int qb, const bf16_t* proj, bf16_t* ya, const float* subln, float lam, unsigned char* shm) {
    int tid_l = threadIdx.x; asm volatile("" : "+v"(tid_l));
    const int tid = tid_l, lane = tid & 63, r32 = lane & 31, hi = lane >> 5; const int wid = __builtin_amdgcn_readfirstlane(tid >> 6);
    const size_t rowbase = (size_t)b * SEQ; const int q0 = qb * 256;
    constexpr int NT = SEQ / 64;
    const unsigned lds0 = (unsigned)(uintptr_t)shm;
    const lds_cptr shm3 = (lds_cptr)shm;
    __attribute__((address_space(3))) float* wsf = (__attribute__((address_space(3))) float*)((lds_ptr)shm + A_LDS_WS) + wid * 64;
    const int vb0 = (int)(lds0 + A_LDS_V) + ((lane >> 4) & 1) * 32 + (lane & 3) * 8 + (4 * hi + ((lane & 15) >> 2)) * 64;
    __attribute__((address_space(3))) bf16_t* stg = (__attribute__((address_space(3))) bf16_t*)((lds_ptr)shm + A_LDS_ST) + wid * 4096;
    for (int mp = 0; mp < 2; ++mp) {
        const bf16_t* Kh = proj + rowbase * INW + C_KA + h * 128 + mp * 64;
        const bf16_t* Vh = proj + rowbase * INW + C_VA + h * 128;
        const bf16_t* Qw = proj + (rowbase + q0 + wid * 32) * INW + C_QA + h * 128 + mp * 64;
        const int pA = 2 * wid, pB = 2 * wid + 1;
        const unsigned kdst = lds0 + A_LDS_K + wid * 1024, vdstA = lds0 + A_LDS_V + pA * 1024, vdstB = lds0 + A_LDS_V + pB * 1024;
#define A_DMA(t, slot, vsl) do { int ln_ = lane; asm volatile("" : "+v"(ln_)); \
        const bf16_t* ksrc_ = Kh + (size_t)((t) * 64 + ln_) * INW + wid * 8; \
        const bf16_t* vsrcA_ = Vh + (size_t)((t) * 64 + 16 * (pA & 3) + (ln_ >> 2)) * INW + (pA >> 2) * 32 + (ln_ & 3) * 8; \
        const bf16_t* vsrcB_ = Vh + (size_t)((t) * 64 + 16 * (pB & 3) + (ln_ >> 2)) * INW + (pB >> 2) * 32 + (ln_ & 3) * 8; \
        glds16(ksrc_, (unsigned)__builtin_amdgcn_readfirstlane(kdst + (slot) * A_SLOTK)); \
        glds16(vsrcA_, (unsigned)__builtin_amdgcn_readfirstlane(vdstA + (vsl) * A_SLOTV)); \
        glds16(vsrcB_, (unsigned)__builtin_amdgcn_readfirstlane(vdstB + (vsl) * A_SLOTV)); } while (0)
        A_DMA(0, 0, 0); A_DMA(1, 1, 1);
        bf16x8 qr[4];
#pragma unroll
        for (int d0 = 0; d0 < 4; ++d0) qr[d0] = *(const bf16x8*)(Qw + (size_t)r32 * INW + d0 * 16 + hi * 8);
        f32x16 o[4]; o[0] = f32x16{}; o[1] = f32x16{}; o[2] = f32x16{}; o[3] = f32x16{};
        float mrun = 0.f, lsum = 0.f; f32x16 negm = f32x16{};
        int slot = 0, slot2 = 2, vslot = 0, vslot2 = 2, vprev = 3;
        const bool late = wid >= 4;
        u32x4 pw0 = {}, pw1 = {}, pw2 = {}, pw3 = {};
        for (int t = 0; t < NT; ++t) {
            if (t + 1 < NT) { ATT_WAIT_BAR(3); } else { ATT_WAIT_BAR(0); }
            if (t + 2 < NT) A_DMA(t + 2, slot2, vslot2);
            if (late && t > 0) pv<4>(o, vb0 + vprev * A_SLOTV, __builtin_bit_cast(bf16x8, pw0), __builtin_bit_cast(bf16x8, pw1), __builtin_bit_cast(bf16x8, pw2), __builtin_bit_cast(bf16x8, pw3));
            f32x16 p0, p1;
            qkt<false>(p0, p1, shm3 + A_LDS_K + slot * A_SLOTK, qr, negm, r32, hi);
            softmax_tile<4, 8, false>(p0, p1, mrun, lsum, negm, t == 0, o, wsf, r32, hi, pw0, pw1, pw2, pw3);
            if (!late) pv<4>(o, vb0 + vslot * A_SLOTV, __builtin_bit_cast(bf16x8, pw0), __builtin_bit_cast(bf16x8, pw1), __builtin_bit_cast(bf16x8, pw2), __builtin_bit_cast(bf16x8, pw3));
            slot = (slot == 2) ? 0 : slot + 1; slot2 = (slot2 == 2) ? 0 : slot2 + 1;
            vprev = vslot; vslot = (vslot + 1) & 3; vslot2 = (vslot2 + 1) & 3;
        }
        if (late) pv<4>(o, vb0 + vprev * A_SLOTV, __builtin_bit_cast(bf16x8, pw0), __builtin_bit_cast(bf16x8, pw1), __builtin_bit_cast(bf16x8, pw2), __builtin_bit_cast(bf16x8, pw3));
#undef A_DMA
        const float lt = halfsum(lsum);
        if (hi == 0) wsf[32 + r32] = lt;
        ATT_LDSWAIT();
        float rli[16];
#pragma unroll
        for (int g = 0; g < 4; ++g) { const f32x4 l4 = *(const __attribute__((address_space(3))) f32x4*)(wsf + 32 + 8 * g + 4 * hi);
            rli[4 * g + 0] = __builtin_amdgcn_rcpf(l4[0]); rli[4 * g + 1] = __builtin_amdgcn_rcpf(l4[1]); rli[4 * g + 2] = __builtin_amdgcn_rcpf(l4[2]); rli[4 * g + 3] = __builtin_amdgcn_rcpf(l4[3]); }
        ATT_LDSWAIT();
        if (mp == 0) {
#pragma unroll
            for (int d0 = 0; d0 < 4; ++d0)
#pragma unroll
                for (int r = 0; r < 16; ++r) stg[crow(r, hi) * 128 + d0 * 32 + r32] = (bf16_t)f2bf(o[d0][r] * rli[r]);
            asm volatile("s_waitcnt lgkmcnt(0)\n\ts_barrier" ::: "memory");
        } else {
            float ss[16];
#pragma unroll
            for (int r = 0; r < 16; ++r) ss[r] = 0.f;
#pragma unroll
            for (int d0 = 0; d0 < 4; ++d0)
#pragma unroll
                for (int r = 0; r < 16; ++r) { const float a = bf2f(stg[crow(r, hi) * 128 + d0 * 32 + r32]); const float y = a - lam * o[d0][r] * rli[r]; o[d0][r] = y; ss[r] += y * y; }
#pragma unroll
            for (int r = 0; r < 16; ++r) { float v = ss[r]; v += __shfl_xor(v, 1); v += __shfl_xor(v, 2); v += __shfl_xor(v, 4); v += __shfl_xor(v, 8); v += __shfl_xor(v, 16);
                ss[r] = 0.8f / sqrtf(v * (1.f / 128.f) + EPS); }
            ATT_LDSWAIT();
#pragma unroll
            for (int d0 = 0; d0 < 4; ++d0) { const float gsub = subln[d0 * 32 + r32];
#pragma unroll
                for (int r = 0; r < 16; ++r) stg[crow(r, hi) * 128 + d0 * 32 + r32] = (bf16_t)f2bf(o[d0][r] * ss[r] * gsub); }
            ATT_LDSWAIT();
            bf16_t* Yw = ya + (rowbase + q0 + wid * 32) * 1024 + h * 128;
#pragma unroll
            for (int i = 0; i < 8; ++i) { const int row = i * 4 + (lane >> 4), ch = lane & 15; const u32x4 v = *(const __attribute__((address_space(3))) u32x4*)(stg + row * 128 + ch * 8); *(u32x4*)(Yw + (size_t)row * 1024 + ch * 8) = v; }
            asm volatile("s_waitcnt lgkmcnt(0)\n\ts_barrier" ::: "memory");
        }
    }
}

constexpr int B_SLOT = 8192, B_NS = 6, B_PF = 5;
constexpr int B_LDS_K = 0, B_LDS_V = B_NS * B_SLOT, B_LDS_WS = 2 * B_NS * B_SLOT, B_LDS_BIAS = B_LDS_WS + 8 * 256, B_LDS_ST = B_LDS_BIAS + 2560, B_LDS_BYTES = B_LDS_ST + 8 * 4096;
__device__ __forceinline__ void attn_b_unit(int b, int h, int rg, const bf16_t* proj, bf16_t* yb, const float* rpb, unsigned char* shm) {
    int tid_l = threadIdx.x; asm volatile("" : "+v"(tid_l));
    const int tid = tid_l, lane = tid & 63, r32 = lane & 31, hi = lane >> 5; const int wid = __builtin_amdgcn_readfirstlane(tid >> 6);
    const size_t rowbase = (size_t)b * SEQ;
    const int r = 4 * rg + (wid >> 1), c0 = 32 * (wid & 1);
    int rs = r - 4; rs = rs < 0 ? 0 : (rs > 24 ? 24 : rs);
    int rmin = 4 * rg - 4; rmin = rmin < 0 ? 0 : (rmin > 24 ? 24 : rmin);
    int rmaxs = 4 * rg + 3 - 4; rmaxs = rmaxs < 0 ? 0 : (rmaxs > 24 ? 24 : rmaxs);
    const int ntile = rmaxs + 8 - rmin;
    const unsigned lds0 = (unsigned)(uintptr_t)shm;
    const lds_cptr shm3 = (lds_cptr)shm;
    __attribute__((address_space(3))) float* wsf = (__attribute__((address_space(3))) float*)((lds_ptr)shm + B_LDS_WS) + wid * 64;
    __attribute__((address_space(3))) float* bias = (__attribute__((address_space(3))) float*)((lds_ptr)shm + B_LDS_BIAS) + 64;
    __attribute__((address_space(3))) bf16_t* stg = (__attribute__((address_space(3))) bf16_t*)((lds_ptr)shm + B_LDS_ST) + wid * 2048;
    const int vb0 = (int)(lds0 + B_LDS_V) + ((lane >> 4) & 1) * 32 + (lane & 3) * 8 + (4 * hi + ((lane & 15) >> 2)) * 64;
    for (int i = tid; i < 640; i += 512) { const int e = i - 64, ri = e >> 5, cj = e & 31; bias[e] = (e >= 0 && e < 480 && cj < 31) ? rpb[(h * 15 + ri) * 31 + cj] * LOG2E : 0.f; }
    const bf16_t* Kh = proj + rowbase * INW + C_KB + h * 64;
    const bf16_t* Vh = proj + rowbase * INW + C_VB + h * 64;
    const bf16_t* Qw = proj + (rowbase + r * 64 + c0) * INW + C_QB + h * 64;
    const unsigned kdst = lds0 + B_LDS_K + wid * 1024, vdst = lds0 + B_LDS_V + wid * 1024;
#define B_DMA(t, slot) do { int ln_ = lane; asm volatile("" : "+v"(ln_)); \
    const bf16_t* ksrc_ = Kh + (size_t)((rmin + (t)) * 64 + ln_) * INW + wid * 8; \
    const bf16_t* vsrc_ = Vh + (size_t)((rmin + (t)) * 64 + 16 * (wid & 3) + (ln_ >> 2)) * INW + (wid >> 2) * 32 + (ln_ & 3) * 8; \
    glds16(ksrc_, (unsigned)__builtin_amdgcn_readfirstlane(kdst + (slot) * B_SLOT)); \
    glds16(vsrc_, (unsigned)__builtin_amdgcn_readfirstlane(vdst + (slot) * B_SLOT)); } while (0)
#pragma unroll
    for (int t = 0; t < B_PF; ++t) B_DMA(t, t);
    bf16x8 qr[4];
#pragma unroll
    for (int d0 = 0; d0 < 4; ++d0) qr[d0] = *(const bf16x8*)(Qw + (size_t)r32 * INW + d0 * 16 + hi * 8);
    f32x16 o[2]; o[0] = f32x16{}; o[1] = f32x16{};
    float mrun = 0.f, lsum = 0.f; f32x16 negm = f32x16{}; bool first = true;
    const int c = c0 + r32; int cs = c - 8; cs = cs < 0 ? 0 : (cs > 48 ? 48 : cs);
    float fm0[16], fm1[16];
#pragma unroll
    for (int rr = 0; rr < 16; ++rr) { const int j0 = crow(rr, hi); fm0[rr] = ((unsigned)(j0 - cs) < 16u) ? 0.f : -1e30f; fm1[rr] = ((unsigned)(j0 + 32 - cs) < 16u) ? 0.f : -1e30f; }
    int slot = 0, slotn = B_PF;
    for (int t = 0; t < ntile; ++t) {
        { const int rem = ntile - 1 - t;
          if (rem >= 4) { ATT_WAIT_BAR(8); } else if (rem == 3) { ATT_WAIT_BAR(6); } else if (rem == 2) { ATT_WAIT_BAR(4); } else if (rem == 1) { ATT_WAIT_BAR(2); } else { ATT_WAIT_BAR(0); } }
        if (t + B_PF < ntile) B_DMA(t + B_PF, slotn);
        const int kr = rmin + t;
        if (kr >= rs && kr < rs + 8) {
            f32x16 p0, p1; u32x4 pw0, pw1, pw2, pw3;
            qkt<true>(p0, p1, shm3 + B_LDS_K + slot * B_SLOT, qr, negm, r32, hi);
            const __attribute__((address_space(3))) float* bp = bias + ((kr - r + 7) * 32 + 15 - c + 4 * hi);
#pragma unroll
            for (int rr = 0; rr < 16; ++rr) { const int jj = (rr & 3) + 8 * (rr >> 2);
                p0[rr] += bp[jj] + fm0[rr]; p1[rr] += bp[jj + 32] + fm1[rr]; }
            softmax_tile<2, 8, true>(p0, p1, mrun, lsum, negm, first, o, wsf, r32, hi, pw0, pw1, pw2, pw3); first = false;
            pv<2>(o, vb0 + slot * B_SLOT, __builtin_bit_cast(bf16x8, pw0), __builtin_bit_cast(bf16x8, pw1), __builtin_bit_cast(bf16x8, pw2), __builtin_bit_cast(bf16x8, pw3));
        }
        slot = (slot == B_NS - 1) ? 0 : slot + 1; slotn = (slotn == B_NS - 1) ? 0 : slotn + 1;
    }
#undef B_DMA
    const float lt = halfsum(lsum);
    if (hi == 0) wsf[32 + r32] = lt;
    ATT_LDSWAIT();
    float rli[16];
#pragma unroll
    for (int g = 0; g < 4; ++g) { const f32x4 l4 = *(const __attribute__((address_space(3))) f32x4*)(wsf + 32 + 8 * g + 4 * hi);
        rli[4 * g + 0] = __builtin_amdgcn_rcpf(l4[0]); rli[4 * g + 1] = __builtin_amdgcn_rcpf(l4[1]); rli[4 * g + 2] = __builtin_amdgcn_rcpf(l4[2]); rli[4 * g + 3] = __builtin_amdgcn_rcpf(l4[3]); }
#pragma unroll
    for (int d0 = 0; d0 < 2; ++d0)
#pragma unroll
        for (int rr = 0; rr < 16; ++rr) stg[crow(rr, hi) * 64 + d0 * 32 + r32] = (bf16_t)f2bf(o[d0][rr] * rli[rr]);
    ATT_LDSWAIT();
    bf16_t* Yw = yb + (rowbase + r * 64 + c0) * 1024 + 512 + h * 64;
#pragma unroll
    for (int i = 0; i < 4; ++i) { const int row = i * 8 + (lane >> 3), ch = lane & 7; const u32x4 v = *(const __attribute__((address_space(3))) u32x4*)(stg + row * 64 + ch * 8); *(u32x4*)(Yw + (size_t)row * 1024 + ch * 8) = v; }
    asm volatile("s_waitcnt lgkmcnt(0)\n\ts_barrier" ::: "memory");
}
}

namespace peer {
typedef short bf16x8 __attribute__((ext_vector_type(8)));
typedef float f32x16 __attribute__((ext_vector_type(16)));
typedef __attribute__((address_space(3))) const char* lds_cptr;
constexpr int T_LDS_SK = 0, T_LDS_BYTES = 65536;
__device__ __forceinline__ int imax(int a, int b) { int r; asm("v_max_f32 %0, %1, %2" : "=v"(r) : "v"(a), "v"(b)); return r; }
__device__ __forceinline__ int imin(int a, int b) { int r; asm("v_min_f32 %0, %1, %2" : "=v"(r) : "v"(a), "v"(b)); return r; }
__device__ __forceinline__ int f2key(float s, int idx) { return (__float_as_int(s) & ~127) | idx; }
__device__ __forceinline__ int key2bits(int k) { return k; }
template <int N, int OFF, int TOT> __device__ __forceinline__ void bsort_desc(int (&a)[TOT]) {
#pragma unroll
    for (int k = 2; k <= N; k <<= 1)
#pragma unroll
        for (int j = k >> 1; j > 0; j >>= 1)
#pragma unroll
            for (int i = 0; i < N; ++i) { const int l = i ^ j; if (l > i) { const bool desc = (i & k) == 0; const int hi_ = imax(a[OFF + i], a[OFF + l]), lo_ = imin(a[OFF + i], a[OFF + l]); a[OFF + i] = desc ? hi_ : lo_; a[OFF + l] = desc ? lo_ : hi_; } }
}
template <int N, int OFF, int TOT> __device__ __forceinline__ void bmerge_desc(int (&a)[TOT]) {
#pragma unroll
    for (int j = N >> 1; j > 0; j >>= 1)
#pragma unroll
        for (int i = 0; i < N; ++i) { const int l = i ^ j; if (l > i) { const int hi_ = imax(a[OFF + i], a[OFF + l]), lo_ = imin(a[OFF + i], a[OFF + l]); a[OFF + i] = hi_; a[OFF + l] = lo_; } }
}
template <int A, int B, int TOT> __device__ __forceinline__ void merge_top16(int (&a)[TOT]) {
#pragma unroll
    for (int i = 0; i < 16; ++i) a[A + i] = imax(a[A + i], a[B + 15 - i]);
    bmerge_desc<16, A, TOT>(a);
}
__device__ __forceinline__ void cross_top16(int (&t)[16]) {
    int lo[16], hi[16];
#pragma unroll
    for (int i = 0; i < 16; ++i) { auto rr = __builtin_amdgcn_permlane32_swap((unsigned)t[i], (unsigned)t[i], false, false); lo[i] = (int)rr[0]; hi[i] = (int)rr[1]; }
#pragma unroll
    for (int i = 0; i < 16; ++i) t[i] = imax(lo[i], hi[15 - i]);
    bmerge_desc<16, 0, 16>(t);
}
__device__ __forceinline__ void half_top16(int (&top)[16], const bf16_t* qrow  , lds_cptr skp  , int hi) {
    f32x16 sc[4]; sc[0] = f32x16{}; sc[1] = f32x16{}; sc[2] = f32x16{}; sc[3] = f32x16{};
    bf16x8 qf[8];
#pragma unroll
    for (int ks = 0; ks < 8; ++ks) qf[ks] = *(const bf16x8*)(qrow + ks * 16);
#pragma unroll
    for (int ks = 0; ks < 8; ++ks)
#pragma unroll
        for (int kt = 0; kt < 4; ++kt) { const bf16x8 af = *(const __attribute__((address_space(3))) bf16x8*)(skp + ks * 4096 + kt * 512);
            sc[kt] = __builtin_amdgcn_mfma_f32_32x32x16_bf16(af, qf[ks], sc[kt], 0, 0, 0); }
    int k[64];
#pragma unroll
    for (int kt = 0; kt < 4; ++kt)
#pragma unroll
        for (int r = 0; r < 16; ++r) k[kt * 16 + r] = f2key(sc[kt][r], (32 * kt + (r & 3) + 8 * (r >> 2)) | (4 * hi));
    bsort_desc<16, 0, 64>(k); bsort_desc<16, 16, 64>(k); bsort_desc<16, 32, 64>(k); bsort_desc<16, 48, 64>(k);
    merge_top16<0, 16, 64>(k); merge_top16<32, 48, 64>(k); merge_top16<0, 32, 64>(k);
#pragma unroll
    for (int i = 0; i < 16; ++i) top[i] = k[i];
    cross_top16(top);
}
__device__ __forceinline__ void topk_wave(int tok0, int h, const bf16_t* Q, int* IDX, float* Gt, lds_cptr sk, int lane) {
    const int r32 = lane & 31, hi = lane >> 5, tok = tok0 + r32;
    const bf16_t* qrow = Q + (size_t)tok * PQ + h * 256 + 8 * hi;
    lds_cptr skl = sk + hi * 2048 + r32 * 16;
    int A0[16], A1[16];
    half_top16(A0, qrow, skl, hi);
    half_top16(A1, qrow + 128, skl + 32768, hi);
    float x[16], y[16]; int xw[16], yw[16];
#pragma unroll
    for (int a = 0; a < 16; ++a) { const int b0 = key2bits(A0[a]), b1 = key2bits(A1[a]);
        const float v0 = __int_as_float(b0 & ~127), v1 = __int_as_float(b1 & ~127); const int i0 = (b0 & 127) << 7, i1 = b1 & 127;
        x[a] = hi ? v1 : v0; y[a] = hi ? v0 : v1; xw[a] = hi ? i1 : i0; yw[a] = hi ? i0 : i1; }
    int w[32]; int n = 0;
#define PEER_CAND(a, b) do { const int bits = __float_as_int(x[a] + y[b]); int ww = (bits & ~0x3FFF) | (xw[a] + yw[b]); \
        if ((a) == (b) && hi) ww = (int)0xFF800000; w[n] = ww; ++n; } while (0)
#pragma unroll
    for (int b = 0; b < 16; ++b) PEER_CAND(0, b);
#pragma unroll
    for (int b = 1; b < 8; ++b) PEER_CAND(1, b);
#pragma unroll
    for (int b = 2; b < 5; ++b) PEER_CAND(2, b);
    PEER_CAND(3, 3);
#undef PEER_CAND
#pragma unroll
    for (int i = 27; i < 32; ++i) w[i] = (int)0xFF800000;
    bsort_desc<32, 0, 32>(w);
    int T[16];
#pragma unroll
    for (int i = 0; i < 16; ++i) T[i] = w[i];
    cross_top16(T);
    float sv[16]; int ev[16];
#pragma unroll
    for (int j = 0; j < 16; ++j) { ev[j] = T[j] & 0x3FFF; sv[j] = __int_as_float(T[j] & ~0x3FFF); }
    const float s0 = sv[0]; float esum = 0.f;
#pragma unroll
    for (int j = 0; j < 16; ++j) { sv[j] = __expf(sv[j] - s0); esum += sv[j]; }
    const float inv = 1.f / esum;
    if (hi == 0) { u32x4* io = (u32x4*)(IDX + ((size_t)tok * 8 + h) * 16);
#pragma unroll
        for (int j = 0; j < 4; ++j) io[j] = (u32x4){(unsigned)ev[4 * j], (unsigned)ev[4 * j + 1], (unsigned)ev[4 * j + 2], (unsigned)ev[4 * j + 3]}; }
    else { f32x4* go = (f32x4*)(Gt + ((size_t)tok * 8 + h) * 16);
#pragma unroll
        for (int j = 0; j < 4; ++j) go[j] = (f32x4){sv[4 * j] * inv, sv[4 * j + 1] * inv, sv[4 * j + 2] * inv, sv[4 * j + 3] * inv}; }
}
template <class Sched> __device__ __forceinline__ void topk_own_units(const Ptrs& P, unsigned char* shm, const Sched& S) {
    int tid_l = threadIdx.x; asm volatile("" : "+v"(tid_l));
    const int tid = tid_l, lane = tid & 63; const int wid = __builtin_amdgcn_readfirstlane(tid >> 6);
    const unsigned lds0 = (unsigned)(uintptr_t)shm;
    const bf16_t* SKg = (const bf16_t*)(P.ws + WS_SK);
    int hprev = -1; pg8::Unit u;
    for (int i = 0; S.next(i, u); ++i) {
        const int h = u.pn, tg = u.pm;
        if (h != hprev) { hprev = h;
            asm volatile("s_waitcnt lgkmcnt(0)\n\ts_barrier" ::: "memory");
#pragma unroll
            for (int j = 0; j < 8; ++j) { const int piece = wid * 8 + j, p = piece >> 5, c = (piece >> 1) & 15, kh = piece & 1;
                att::glds16(SKg + ((size_t)((h * 2 + p) * 128 + kh * 64 + lane) * 128 + c * 8), (unsigned)__builtin_amdgcn_readfirstlane(lds0 + p * 32768 + c * 2048 + kh * 1024)); }
            asm volatile("s_waitcnt vmcnt(0)\n\ts_barrier" ::: "memory");
        }
        topk_wave(tg * 256 + wid * 32, h, (const bf16_t*)(P.ws + WS_Q), (int*)(P.ws + WS_IDX), (float*)(P.ws + WS_G), (lds_cptr)shm, lane);
    }
}
}

namespace apply {
typedef float f32x2 __attribute__((ext_vector_type(2)));
typedef __attribute__((address_space(3))) unsigned* lds_u32p;
constexpr int AP_WAVE_BYTES = 4 * (512 + 2048), AP_LDS_BYTES = 8 * AP_WAVE_BYTES;
__device__ __forceinline__ float gelu_fast(float v) {
    const float av = fabsf(v), t = __builtin_amdgcn_rcpf(av * 0.2316418882f + 1.0f);
    float q = t * 0.5307027145f + (-0.7265760135f); q = q * t + 0.7107068705f; q = q * t + (-0.142248368f); q = q * t + 0.127414796f; q = q * t;
    const float e = __builtin_amdgcn_exp2f((v * v) * (-0.72134752044f));
    const float m = v * (q * e);
    return v < 0.f ? m : v - m;
}
#define AP_DPP(v, ctrl) __builtin_bit_cast(float, __builtin_amdgcn_update_dpp(0, __builtin_bit_cast(int, (v)), (ctrl), 0xF, 0xF, true))
__device__ __forceinline__ float row16_sum(float v) { v += AP_DPP(v, 0xB1); v += AP_DPP(v, 0x4E); v += AP_DPP(v, 0x141); v += AP_DPP(v, 0x140); return v; }
__device__ __forceinline__ void load_half(u32x4 (&r)[2], const unsigned char* img, unsigned e, int sub) {
    const unsigned off = e * 512u + (unsigned)(sub * 16);
    r[0] = *(const u32x4*)(img + off); r[1] = *(const u32x4*)(img + off + 256u);
}
constexpr int AP_PROBE_RING = 16;
constexpr int AP_RING = 8;
typedef __attribute__((address_space(3))) u32x4* lds_v4p;
template <int HF, int MODE, int RING> __device__ __forceinline__ void pass_u(const Ptrs& P, const bf16_t* hrow, float rstd, lds_v4p grp, u32x4 (&R)[RING][2], const unsigned char* img, const unsigned char* img_next, int sub) {
    unsigned xq[8]; float sx;
    {
        float xf[2][16]; float mx = 0.f;
#pragma unroll
        for (int i = 0; i < 2; ++i) { const int e0 = (sub + 16 * (2 * HF + i)) * 16;
#pragma unroll
            for (int q = 0; q < 4; ++q) { const u32x2 hb = *(const u32x2*)(hrow + e0 + 4 * q); const f32x4 gv = *(const f32x4*)(P.norm_ffn + e0 + 4 * q);
                xf[i][4 * q] = bflo(hb.x) * rstd * gv.x; xf[i][4 * q + 1] = bfhi(hb.x) * rstd * gv.y; xf[i][4 * q + 2] = bflo(hb.y) * rstd * gv.z; xf[i][4 * q + 3] = bfhi(hb.y) * rstd * gv.w;
                mx = fmaxf(fmaxf(mx, fmaxf(fabsf(xf[i][4 * q]), fabsf(xf[i][4 * q + 1]))), fmaxf(fabsf(xf[i][4 * q + 2]), fabsf(xf[i][4 * q + 3]))); } }
        mx = fmaxf(mx, AP_DPP(mx, 0xB1)); mx = fmaxf(mx, AP_DPP(mx, 0x4E)); mx = fmaxf(mx, AP_DPP(mx, 0x141)); mx = fmaxf(mx, AP_DPP(mx, 0x140));
        mx = fmaxf(mx, 1e-30f); sx = mx * (1.f / 127.f); const float qs = 127.f / mx;
#pragma unroll
        for (int i = 0; i < 2; ++i)
#pragma unroll
            for (int q = 0; q < 4; ++q) xq[4 * i + q] = pack_i8x4(xf[i][4 * q] * qs, xf[i][4 * q + 1] * qs, xf[i][4 * q + 2] * qs, xf[i][4 * q + 3] * qs);
    }
#pragma unroll 1
    for (int j = 0; j < 128; j += RING) {
        const int jn = (j + RING) & 127;
        __builtin_amdgcn_s_barrier();
        const unsigned char* tb = (j + RING < 128) ? img : img_next;
        unsigned nid[RING], part[RING], suv[RING], gsv[RING];
#pragma unroll
        for (int b4 = 0; b4 < RING / 4; ++b4) { const u32x4 na = grp[jn / 4 + b4];
            nid[4 * b4] = na.x; nid[4 * b4 + 1] = na.y; nid[4 * b4 + 2] = na.z; nid[4 * b4 + 3] = na.w;
            u32x4 pa = {}, sa = {}, ga = {};
            if (HF == 1) { pa = grp[96 + j / 4 + b4]; sa = grp[32 + j / 4 + b4]; ga = grp[64 + j / 4 + b4]; }
            part[4 * b4] = pa.x; part[4 * b4 + 1] = pa.y; part[4 * b4 + 2] = pa.z; part[4 * b4 + 3] = pa.w;
            suv[4 * b4] = sa.x; suv[4 * b4 + 1] = sa.y; suv[4 * b4 + 2] = sa.z; suv[4 * b4 + 3] = sa.w;
            gsv[4 * b4] = ga.x; gsv[4 * b4 + 1] = ga.y; gsv[4 * b4 + 2] = ga.z; gsv[4 * b4 + 3] = ga.w; }
        float outv[RING];
#pragma unroll
        for (int bq = 0; bq < RING; ++bq) {
            int d0_ = 0, d1_ = 0;
            if (MODE == 1) { asm volatile("" :: "v"(R[bq][0]), "v"(R[bq][1])); d0_ = (int)xq[0]; }
            else {
                d0_ = __builtin_amdgcn_sdot4((int)R[bq][0].x, (int)xq[0], d0_, false); d1_ = __builtin_amdgcn_sdot4((int)R[bq][0].y, (int)xq[1], d1_, false);
                d0_ = __builtin_amdgcn_sdot4((int)R[bq][0].z, (int)xq[2], d0_, false); d1_ = __builtin_amdgcn_sdot4((int)R[bq][0].w, (int)xq[3], d1_, false);
                d0_ = __builtin_amdgcn_sdot4((int)R[bq][1].x, (int)xq[4], d0_, false); d1_ = __builtin_amdgcn_sdot4((int)R[bq][1].y, (int)xq[5], d1_, false);
                d0_ = __builtin_amdgcn_sdot4((int)R[bq][1].z, (int)xq[6], d0_, false); d1_ = __builtin_amdgcn_sdot4((int)R[bq][1].w, (int)xq[7], d1_, false);
            }
            asm volatile("" ::: "memory");
            load_half(R[bq], tb, MODE == 2 ? (nid[bq] & 15u) : nid[bq], sub);
            asm volatile("" ::: "memory");
            float a_ = row16_sum((float)(d0_ + d1_)) * sx;
            if (HF == 1) { a_ = (a_ + __uint_as_float(part[bq])) * __uint_as_float(suv[bq]); a_ = __uint_as_float(gsv[bq]) * gelu_fast(a_); }
            outv[bq] = a_;
        }
        if (sub == 0) {
#pragma unroll
            for (int b4 = 0; b4 < RING / 4; ++b4) grp[96 + j / 4 + b4] = (u32x4){__float_as_uint(outv[4 * b4]), __float_as_uint(outv[4 * b4 + 1]), __float_as_uint(outv[4 * b4 + 2]), __float_as_uint(outv[4 * b4 + 3])}; }
    }
    asm volatile("s_waitcnt lgkmcnt(0)" ::: "memory");
}
template <int HF, int MODE, int RING> __device__ __forceinline__ void pass_v(float (&acc)[4][16], lds_v4p grp, u32x4 (&R)[RING][2], const unsigned char* img, const unsigned char* img_next, int sub) {
#pragma unroll 1
    for (int j = 0; j < 128; j += RING) {
        const int jn = (j + RING) & 127;
        __builtin_amdgcn_s_barrier();
        const unsigned char* tb = (j + RING < 128) ? img : img_next;
        unsigned nid[RING], cvv[RING];
#pragma unroll
        for (int b4 = 0; b4 < RING / 4; ++b4) { const u32x4 na = grp[jn / 4 + b4], ca = grp[96 + j / 4 + b4];
            nid[4 * b4] = na.x; nid[4 * b4 + 1] = na.y; nid[4 * b4 + 2] = na.z; nid[4 * b4 + 3] = na.w; cvv[4 * b4] = ca.x; cvv[4 * b4 + 1] = ca.y; cvv[4 * b4 + 2] = ca.z; cvv[4 * b4 + 3] = ca.w; }
#pragma unroll
        for (int bq = 0; bq < RING; ++bq) {
            const float c_ = __uint_as_float(cvv[bq]); const f32x2 c2 = {c_, c_};
            if (MODE == 1) { asm volatile("" :: "v"(R[bq][0]), "v"(R[bq][1])); acc[2 * HF][0] += c_; }
            else {
#pragma unroll
            for (int i = 0; i < 2; ++i) { const unsigned w_[4] = {R[bq][i].x, R[bq][i].y, R[bq][i].z, R[bq][i].w};
#pragma unroll
                for (int q = 0; q < 4; ++q) { const f32x2 lo_ = __builtin_amdgcn_cvt_pk_f32_fp8(w_[q], false), hi_ = __builtin_amdgcn_cvt_pk_f32_fp8(w_[q], true);
                    f32x2 a0 = {acc[2 * HF + i][4 * q], acc[2 * HF + i][4 * q + 1]}, a1 = {acc[2 * HF + i][4 * q + 2], acc[2 * HF + i][4 * q + 3]}; a0 += c2 * lo_; a1 += c2 * hi_;
                    acc[2 * HF + i][4 * q] = a0.x; acc[2 * HF + i][4 * q + 1] = a0.y; acc[2 * HF + i][4 * q + 2] = a1.x; acc[2 * HF + i][4 * q + 3] = a1.y; } }
            }
            asm volatile("" ::: "memory");
            load_half(R[bq], tb, MODE == 2 ? (nid[bq] & 15u) : nid[bq], sub);
            asm volatile("" ::: "memory");
        }
    }
}
template <int MODE> __device__ __forceinline__ void apply_round(const Ptrs& P, float* outbase, int tbase, unsigned char* shm_wave, int lane_in) {
    int lane = lane_in; asm volatile("" : "+v"(lane));
    const int sub = lane & 15, g = lane >> 4, t = tbase + g;
    __attribute__((address_space(3))) unsigned* cnt = (lds_u32p)(__attribute__((address_space(3))) unsigned char*)shm_wave + g * 128;
    lds_v4p grp = (lds_v4p)((__attribute__((address_space(3))) unsigned char*)shm_wave + 2048 + g * 2048);
    __attribute__((address_space(3))) unsigned* grp1 = (__attribute__((address_space(3))) unsigned*)grp;
    const unsigned char* U8 = P.ws + WS_U; const unsigned char* V8 = P.ws + WS_V;
    {
        const int* idxp = (const int*)(P.ws + WS_IDX) + (size_t)t * 128 + sub * 8; const float* gp = (const float*)(P.ws + WS_G) + (size_t)t * 128 + sub * 8;
        const u32x4 ia = *(const u32x4*)idxp, ib = *(const u32x4*)(idxp + 4); const f32x4 ga = *(const f32x4*)gp, gb = *(const f32x4*)(gp + 4);
        const int e[8] = {(int)ia.x, (int)ia.y, (int)ia.z, (int)ia.w, (int)ib.x, (int)ib.y, (int)ib.z, (int)ib.w};
        const float gt[8] = {ga.x, ga.y, ga.z, ga.w, gb.x, gb.y, gb.z, gb.w};
        float su[8], sv[8];
#pragma unroll
        for (int i = 0; i < 8; ++i) { su[i] = ((const float*)(P.ws + WS_SU))[e[i]]; sv[i] = ((const float*)(P.ws + WS_SV))[e[i]]; }
#pragma unroll
        for (int i = 0; i < 8; ++i) cnt[sub * 8 + i] = 0u;
        asm volatile("s_waitcnt lgkmcnt(0)" ::: "memory");
        unsigned pos[8];
#pragma unroll
        for (int i = 0; i < 8; ++i) pos[i] = __hip_atomic_fetch_add(cnt + (e[i] >> 7), 1u, __ATOMIC_RELAXED, __HIP_MEMORY_SCOPE_WAVEFRONT);
        asm volatile("s_waitcnt lgkmcnt(0)" ::: "memory");
        unsigned c[8]; unsigned tot = 0;
#pragma unroll
        for (int i = 0; i < 8; ++i) { c[i] = cnt[sub * 8 + i]; }
#pragma unroll
        for (int i = 0; i < 8; ++i) { const unsigned x = c[i]; c[i] = tot; tot += x; }
        unsigned inc = tot;
#pragma unroll
        for (int d = 1; d < 16; d <<= 1) { const unsigned y = __shfl_up(inc, d, 16); if (sub >= d) inc += y; }
        const unsigned base = inc - tot;
        asm volatile("s_waitcnt lgkmcnt(0)" ::: "memory");
#pragma unroll
        for (int i = 0; i < 8; ++i) cnt[sub * 8 + i] = base + c[i];
        asm volatile("s_waitcnt lgkmcnt(0)" ::: "memory");
#pragma unroll
        for (int i = 0; i < 8; ++i) { const unsigned p = cnt[e[i] >> 7] + pos[i];
            grp1[p] = (unsigned)e[i]; grp1[128 + p] = __float_as_uint(su[i]); grp1[256 + p] = __float_as_uint(gt[i] * sv[i]); }
        asm volatile("s_waitcnt lgkmcnt(0)" ::: "memory");
    }
    const bf16_t* hrow = (const bf16_t*)(P.ws + WS_HB) + (size_t)t * D;
    float rstd;
    { const float* ssq = (const float*)(P.ws + WS_SSQ) + (size_t)t * 16;
      const f32x4 s0 = *(const f32x4*)ssq, s1 = *(const f32x4*)(ssq + 4), s2 = *(const f32x4*)(ssq + 8), s3 = *(const f32x4*)(ssq + 12);
      const float tot = ((s0.x + s0.y) + (s0.z + s0.w)) + ((s1.x + s1.y) + (s1.z + s1.w)) + ((s2.x + s2.y) + (s2.z + s2.w)) + ((s3.x + s3.y) + (s3.z + s3.w));
      rstd = 1.f / sqrtf(tot * (1.f / D) + EPS); }
    constexpr int RG = (MODE == 1) ? AP_PROBE_RING : AP_RING;
    const unsigned char* U0 = U8; const unsigned char* U1 = U8 + (size_t)NEXP * 512; const unsigned char* V0 = V8; const unsigned char* V1 = V8 + (size_t)NEXP * 512;
    u32x4 R[RG][2];
    {
#pragma unroll
      for (int b4 = 0; b4 < RG / 4; ++b4) { const u32x4 ia = grp[b4]; load_half(R[4 * b4], U0, ia.x, sub); load_half(R[4 * b4 + 1], U0, ia.y, sub); load_half(R[4 * b4 + 2], U0, ia.z, sub); load_half(R[4 * b4 + 3], U0, ia.w, sub); } }
    pass_u<0, MODE, RG>(P, hrow, rstd, grp, R, U0, U1, sub);
    pass_u<1, MODE, RG>(P, hrow, rstd, grp, R, U1, V0, sub);
    float acc[4][16];
#pragma unroll
    for (int i = 0; i < 4; ++i)
#pragma unroll
        for (int q = 0; q < 16; ++q) acc[i][q] = 0.f;
    pass_v<0, MODE, RG>(acc, grp, R, V0, V1, sub);
    pass_v<1, MODE, RG>(acc, grp, R, V1, V1, sub);
    float ss = 0.f;
#pragma unroll
    for (int i = 0; i < 4; ++i) { const int e0 = (sub + 16 * i) * 16;
#pragma unroll
        for (int q = 0; q < 4; ++q) { const u32x2 hb = *(const u32x2*)(hrow + e0 + 4 * q);
            acc[i][4 * q] += bflo(hb.x); acc[i][4 * q + 1] += bfhi(hb.x); acc[i][4 * q + 2] += bflo(hb.y); acc[i][4 * q + 3] += bfhi(hb.y);
            ss += (acc[i][4 * q] * acc[i][4 * q] + acc[i][4 * q + 1] * acc[i][4 * q + 1]) + (acc[i][4 * q + 2] * acc[i][4 * q + 2] + acc[i][4 * q + 3] * acc[i][4 * q + 3]); }
        asm volatile("" ::: "memory"); }
    ss = row16_sum(ss);
    const float r2 = 1.f / sqrtf(ss * (1.f / D) + EPS);
    float* orow = outbase + (size_t)t * D;
#pragma unroll
    for (int i = 0; i < 4; ++i) { const int e0 = (sub + 16 * i) * 16;
#pragma unroll
        for (int q = 0; q < 4; ++q) { const f32x4 gv = *(const f32x4*)(P.norm_final + e0 + 4 * q);
            *(f32x4*)(orow + e0 + 4 * q) = (f32x4){acc[i][4 * q] * r2 * gv.x, acc[i][4 * q + 1] * r2 * gv.y, acc[i][4 * q + 2] * r2 * gv.z, acc[i][4 * q + 3] * r2 * gv.w}; }
        asm volatile("" ::: "memory"); }
}
template <int MODE> __device__ __forceinline__ void apply_phase(const Ptrs& P, float* outbase, unsigned char* shm, int G, int vcu) {
    int tid_l = threadIdx.x; asm volatile("" : "+v"(tid_l));
    const int lane = tid_l & 63; const int wave = __builtin_amdgcn_readfirstlane(tid_l >> 6);
    const int per = M / (G * 8);
#pragma unroll 1
    for (int r = 0; r < per; r += 4) apply_round<MODE>(P, outbase, (vcu * 8 + wave) * per + r, shm + wave * AP_WAVE_BYTES, lane);
}
}

#define LAS __attribute__((address_space(3)))
#define XB_TMO      128
#define XB_XCNT(j)  (256  + 64 * (j))
#define XB_XSUB(j)  (1280 + 64 * (j))
#define XB_XGEN(j)  (2304 + 64 * (j))
#define XB_TOP      3328
#define XB_TOPGEN   3392
#define XCD_BAR_WORDS 3456
#define XB_SPIN_CAP (1u << 18)

__device__ __forceinline__ unsigned xb_ld(unsigned* p)              { return __hip_atomic_load(p, __ATOMIC_RELAXED, __HIP_MEMORY_SCOPE_AGENT); }
__device__ __forceinline__ unsigned xb_add(unsigned* p, unsigned v) { return __hip_atomic_fetch_add(p, v, __ATOMIC_RELAXED, __HIP_MEMORY_SCOPE_AGENT); }
__device__ __forceinline__ unsigned xb_xcc_id() { return (unsigned)__builtin_amdgcn_s_getreg((3 << 11) | 20) & 0xFu; }
#define XB_SPIN(cond, bar) do { unsigned _sp = 0; while (cond) { __builtin_amdgcn_s_sleep(1); \
    if ((++_sp & 255u) == 0u) { if (xb_ld(&(bar)[XB_TMO])) break; if (_sp > XB_SPIN_CAP) { atomicAdd(&(bar)[XB_TMO], 1u); break; } } } } while (0)

struct XcdBarrier {
    unsigned* bar; unsigned x;
    volatile LAS unsigned* st;
};

__device__ __forceinline__ XcdBarrier xcd_barrier_post(unsigned* bar, volatile LAS unsigned* st) {
    XcdBarrier b; b.bar = bar; b.x = xb_xcc_id(); b.st = st;
    if (threadIdx.x == 0) (void)xb_add(&bar[XB_XCNT(b.x)], 1u);
    return b;
}
__device__ __forceinline__ void xcd_barrier_complete(unsigned* bar, unsigned x, unsigned& nloc, unsigned& nx) {
    const unsigned G = gridDim.x * gridDim.y * gridDim.z;
    unsigned sum, cnt, mine, sp = 0u;
    for (;;) {
        sum = 0u; cnt = 0u; mine = 0u;
#pragma unroll
        for (unsigned j = 0; j < 16; ++j) { const unsigned c = xb_ld(&bar[XB_XCNT(j)]); sum += c; cnt += (c > 0u) ? 1u : 0u; mine = (j == x) ? c : mine; }
        if (sum == G) break;
        __builtin_amdgcn_s_sleep(1);
        if ((++sp & 255u) == 0u) { if (xb_ld(&bar[XB_TMO])) break; if (sp > XB_SPIN_CAP) { atomicAdd(&bar[XB_TMO], 1u); break; } }
    }
    nloc = mine > 0u ? mine : 1u; nx = cnt > 0u ? cnt : 1u;
}

__device__ __forceinline__ void xcd_barrier(const XcdBarrier& b) {
    asm volatile("s_waitcnt vmcnt(0)" ::: "memory");
    __syncthreads();
    if (threadIdx.x == 0) {
        unsigned* bar = b.bar;
        __builtin_amdgcn_s_waitcnt(0);
        unsigned nloc = b.st[0], nx = b.st[1];
        if (nloc == 0u) { xcd_barrier_complete(bar, b.x, nloc, nx); b.st[0] = nloc; b.st[1] = nx; }
        const unsigned old = xb_add(&bar[XB_XSUB(b.x)], 1u);
        const unsigned gen = old / nloc;
        if (old + 1u == (gen + 1u) * nloc) {
            __builtin_amdgcn_fence(__ATOMIC_RELEASE, "agent");
            asm volatile("s_waitcnt vmcnt(0)" ::: "memory");
            const unsigned og = xb_add(&bar[XB_TOP], 1u);
            const unsigned tg = og / nx;
            if (og + 1u == (tg + 1u) * nx) xb_add(&bar[XB_TOPGEN], 1u);
            else XB_SPIN(xb_ld(&bar[XB_TOPGEN]) == tg, bar);
            __builtin_amdgcn_fence(__ATOMIC_ACQUIRE, "agent");
            xb_add(&bar[XB_XGEN(b.x)], 1u);
            asm volatile("s_waitcnt vmcnt(0)" ::: "memory");
        } else {
            XB_SPIN(xb_ld(&bar[XB_XGEN(b.x)]) == gen, bar);
            __builtin_amdgcn_fence(__ATOMIC_ACQUIRE, "agent");
            asm volatile("s_waitcnt vmcnt(0)" ::: "memory");
        }
    }
    __syncthreads();
}


namespace cg = cooperative_groups;
#ifndef REP_MASK
#define REP_MASK 0
#endif
#define REPS(k) (((REP_MASK) >> (k)) & 1 ? 2 : 1)
constexpr int PHASE_LDS = att::A_LDS_BYTES;
constexpr int MEGA_LDS = PHASE_LDS + 64;
static_assert(PHASE_LDS >= pg8::STAGE_BYTES && PHASE_LDS >= att::B_LDS_BYTES && PHASE_LDS >= peer::T_LDS_BYTES && PHASE_LDS >= 8 * 64 * 33 * 4 && PHASE_LDS >= apply::AP_LDS_BYTES, "LDS budget");
__global__ void __launch_bounds__(512, 2) mega_fwd(Ptrs P) {
    extern __shared__ __attribute__((aligned(16))) unsigned char lds_dyn[];
    volatile LAS unsigned* bst = (volatile LAS unsigned*)((LAS unsigned char*)lds_dyn + PHASE_LDS);
    if (threadIdx.x < 2) bst[threadIdx.x] = 0u;
    __syncthreads();
    const XcdBarrier bar = xcd_barrier_post((unsigned*)(P.ws + WS_CTL), bst);
    const int G = (int)gridDim.x, bx = (int)blockIdx.x, vcu = (G % 8 == 0) ? (bx % 8) * (G / 8) + bx / 8 : bx;
    unsigned char* ws = P.ws;
    PG8_LAS unsigned char* lds3 = (PG8_LAS unsigned char*)lds_dyn;
    for (int rep = 0; rep < REPS(0); ++rep) prep_phase(P, lds_dyn, G, bx);
    xcd_barrier(bar); if (REPS(9) == 2) xcd_barrier(bar);
    for (int rep = 0; rep < REPS(1); ++rep) {
      { pg8::Gemm g{(const bf16_t*)(ws + WS_XN), (const bf16_t*)(ws + WS_WIN), M, 1024, D, 0}; pg8::StaticOrder S; S.init(M, 1024, G, bx);
        pg8::gemm_phase<pg8::EpiProj, pg8::StaticOrder, true, true, false>(lds3, g, S, pg8::EpiProj{(bf16_t*)(ws + WS_PROJ), (const float*)(ws + WS_ROPE), 1.f, 0}); }
      { pg8::Gemm g{(const bf16_t*)(ws + WS_XN8), (const bf16_t*)(ws + WS_WIN8), M, INW - 1024, D / 2, 0}; pg8::StaticOrder S; S.init(M, INW - 1024, G, bx);
        pg8::gemm_phase<pg8::EpiProj, pg8::StaticOrder, true, true, true>(lds3, g, S, pg8::EpiProj{(bf16_t*)(ws + WS_PROJ), (const float*)(ws + WS_ROPE), 1.f / WIN_SCALE, 4}); } }
    xcd_barrier(bar); if (REPS(9) == 2) xcd_barrier(bar);
    { const float lam = lambda_full(P);
      for (int rep = 0; rep < REPS(2); ++rep) for (int u = vcu; u < BATCH * 4 * 8; u += G) att::attn_a_unit(u >> 5, (u >> 3) & 3, u & 7, (const bf16_t*)(ws + WS_PROJ), (bf16_t*)(ws + WS_YA), P.subln, lam, lds_dyn);
      for (int rep = 0; rep < REPS(3); ++rep) for (int u = vcu; u < BATCH * 8 * 8; u += G) att::attn_b_unit(u >> 6, (u >> 3) & 7, u & 7, (const bf16_t*)(ws + WS_PROJ), (bf16_t*)(ws + WS_YA), P.rpb, lds_dyn); }
    xcd_barrier(bar); if (REPS(9) == 2) xcd_barrier(bar);
    for (int rep = 0; rep < REPS(4); ++rep) { pg8::StaticOrder S; S.init(M, D, G, bx);
      pg8::gemm_phase<pg8::EpiGate2, pg8::StaticOrder, true, true>(lds3, pg8::Gemm{(const bf16_t*)(ws + WS_YA), (const bf16_t*)(ws + WS_WPA), M, D, D, 0}, S, pg8::EpiGate2{(const bf16_t*)(ws + WS_PROJ), (bf16_t*)(ws + WS_MERGED)}); }
    xcd_barrier(bar); if (REPS(9) == 2) xcd_barrier(bar);
    for (int rep = 0; rep < REPS(5); ++rep) { pg8::StaticOrder S; S.init(M, D, G, bx);
      pg8::gemm_phase<pg8::EpiHout, pg8::StaticOrder, true, true>(lds3, pg8::Gemm{(const bf16_t*)(ws + WS_MERGED), (const bf16_t*)(ws + WS_WOUT), M, D, D, 0}, S, pg8::EpiHout{P.x, P.out, (bf16_t*)(ws + WS_HB), (float*)(ws + WS_SSQ)});
      cvt_experts_phase(P, G, bx); }
    xcd_barrier(bar); if (REPS(9) == 2) xcd_barrier(bar);
    { pg8::StaticOrder S; S.init(M, PQ, G, bx);
      for (int rep = 0; rep < REPS(8); ++rep)
        pg8::gemm_phase<pg8::EpiQ, pg8::StaticOrder, true, true>(lds3, pg8::Gemm{(const bf16_t*)(ws + WS_HB), (const bf16_t*)(ws + WS_WQ), M, PQ, D, 0}, S, pg8::EpiQ{(const float*)(ws + WS_SSQ), (bf16_t*)(ws + WS_Q)});
      asm volatile("s_waitcnt vmcnt(0)" ::: "memory");
      __syncthreads();
      if (threadIdx.x == 0) { __builtin_amdgcn_fence(__ATOMIC_ACQUIRE, "agent"); asm volatile("s_waitcnt vmcnt(0)" ::: "memory"); }
      __syncthreads();
      for (int rep = 0; rep < REPS(6); ++rep) peer::topk_own_units(P, lds_dyn, S); }
    xcd_barrier(bar); if (REPS(9) == 2) xcd_barrier(bar);
#ifndef PROBE_MODE
#define PROBE_MODE 0
#endif
    if (REPS(7) == 2) apply::apply_phase<PROBE_MODE>(P, (float*)(ws + WS_Q), lds_dyn, G, vcu);
    apply::apply_phase<0>(P, P.out, lds_dyn, G, vcu);
}

extern "C" void kernel_launch(void* const* d_in, const int* in_sizes, int n_in, void* d_out, int out_size, void* d_ws, size_t ws_size, hipStream_t stream) {
    if (n_in != 18 || ws_size < WS_END) { fprintf(stderr, "kernel_launch: unexpected n_in %d / ws_size %zu\n", n_in, ws_size); return; }
    Ptrs P{};
    P.x = (const float*)d_in[0]; P.w_in = (const float*)d_in[1]; P.w_pa = (const float*)d_in[2]; P.w_pb = (const float*)d_in[3]; P.w_out = (const float*)d_in[4];
    P.norm_mix = (const float*)d_in[5]; P.norm_ffn = (const float*)d_in[6]; P.norm_final = (const float*)d_in[7];
    P.lq1 = (const float*)d_in[8]; P.lk1 = (const float*)d_in[9]; P.lq2 = (const float*)d_in[10]; P.lk2 = (const float*)d_in[11];
    P.subln = (const float*)d_in[12]; P.rpb = (const float*)d_in[13]; P.w_query = (const float*)d_in[14]; P.sub_keys = (const float*)d_in[15];
    P.peer_u = (const float*)d_in[16]; P.peer_v = (const float*)d_in[17];
    P.out = (float*)d_out; P.ws = (unsigned char*)d_ws;
    static int grid_blocks = 0;
    if (!grid_blocks) {
        int dev = 0, cus = 0, per_cu = 0;
        hipGetDevice(&dev);
        hipDeviceGetAttribute(&cus, hipDeviceAttributeMultiprocessorCount, dev);
        hipFuncSetAttribute((const void*)mega_fwd, hipFuncAttributeMaxDynamicSharedMemorySize, MEGA_LDS);
        hipOccupancyMaxActiveBlocksPerMultiprocessor(&per_cu, (const void*)mega_fwd, 512, MEGA_LDS);
        if (per_cu < 1) { fprintf(stderr, "kernel_launch: occupancy query says %d blocks per CU\n", per_cu); per_cu = 1; }
        grid_blocks = cus * per_cu;
    }
    hipMemsetAsync((unsigned char*)d_ws + WS_CTL, 0, 16384, stream);
    void* args[] = {&P};
    hipError_t e = hipLaunchCooperativeKernel((const void*)mega_fwd, dim3(grid_blocks), dim3(512), args, MEGA_LDS, stream);
    if (e != hipSuccess) fprintf(stderr, "cooperative launch failed: %s (grid %d)\n", hipGetErrorString(e), grid_blocks);
}
```

```cpp
#include <hip/hip_runtime.h>
#include <hip/hip_cooperative_groups.h>
#include <cstdio>
#include <cstdint>

typedef unsigned short bf16_t;
typedef unsigned u32x4 __attribute__((ext_vector_type(4)));
typedef unsigned u32x2 __attribute__((ext_vector_type(2)));
typedef float f32x4 __attribute__((ext_vector_type(4)));
typedef __bf16 bf16x2_t __attribute__((ext_vector_type(2)));

constexpr int D = 1024, BATCH = 8, SEQ = 2048, M = BATCH * SEQ, INW = 5120;
constexpr int C_QA = 0, C_KA = 512, C_VA = 1024, C_QB = 1536, C_KB = 2048, C_VB = 2560, C_GA = 3072, C_GB = 4096;
constexpr int NEXP = 16384, PQ = 2048;
constexpr float EPS = 1e-6f;
constexpr float LOG2E = 1.4426950408889634f;
constexpr float WIN_SCALE = 32.f;
constexpr float QSCALE = 0.125f * LOG2E;

constexpr size_t MiB = 1u << 20;
constexpr size_t WS_PROJ = 0;
constexpr size_t WS_HB = 0;
constexpr size_t WS_Q = 32 * MiB;
constexpr size_t WS_U = 96 * MiB;
constexpr size_t WS_V = 112 * MiB;
constexpr size_t WS_SU = 128 * MiB;
constexpr size_t WS_SV = 128 * MiB + 65536;
constexpr size_t WS_XN = 160 * MiB;
constexpr size_t WS_YA = 160 * MiB;
constexpr size_t WS_YB = 176 * MiB;
constexpr size_t WS_IDX = 160 * MiB;
constexpr size_t WS_G = 168 * MiB;
constexpr size_t WS_MERGED = 192 * MiB;
constexpr size_t WS_TOPV = 192 * MiB;
constexpr size_t WS_TOPI = 208 * MiB;
constexpr size_t WS_WIN = 224 * MiB;
constexpr size_t WS_WIN8 = 226 * MiB;
constexpr size_t WS_XN8 = 192 * MiB;
constexpr size_t WS_WQ = 234 * MiB;
constexpr size_t WS_WOUT = 238 * MiB;
constexpr size_t WS_WPA = 240 * MiB;
constexpr size_t WS_WPB = 241 * MiB;
constexpr size_t WS_SK = 242 * MiB;
constexpr size_t WS_ROPE = 242 * MiB + 512 * 1024;
constexpr size_t WS_SSQ = 243 * MiB;
constexpr size_t WS_CTL = 244 * MiB;
constexpr size_t WS_END = 256 * MiB;

__device__ __forceinline__ float bf2f(unsigned v) { return __uint_as_float(v << 16); }
__device__ __forceinline__ float bflo(unsigned w) { return __uint_as_float(w << 16); }
__device__ __forceinline__ float bfhi(unsigned w) { return __uint_as_float(w & 0xffff0000u); }
__device__ __forceinline__ unsigned f2bf(float f) { unsigned u = __float_as_uint(f); return (u + 0x7fffu + ((u >> 16) & 1u)) >> 16; }
__device__ __forceinline__ unsigned pk2(float lo, float hi) { return f2bf(lo) | (f2bf(hi) << 16); }
__device__ __forceinline__ float wave_sum(float v) {
#pragma unroll
    for (int o = 1; o < 64; o <<= 1) v += __shfl_xor(v, o);
    return v;
}
__device__ __forceinline__ float sigmoidf_(float x) { return 1.f / (1.f + __expf(-x)); }
__device__ __forceinline__ float gelu_exact(float x) { return 0.5f * x * (1.f + erff(x * 0.70710678118654752f)); }

struct Ptrs {
    const float *x, *w_in, *w_pa, *w_pb, *w_out, *norm_mix, *norm_ffn, *norm_final, *lq1, *lk1, *lq2, *lk2, *subln, *rpb, *w_query, *sub_keys, *peer_u, *peer_v;
    float* out; unsigned char* ws;
};

__device__ __forceinline__ void transpose_item(const float* W, int K, int N, const float* gain, bf16_t* WT, float* scr, int item, int lane, int ldo = 0, int koff = 0, int ldw = 0) {
    if (ldo == 0) ldo = K;
    if (ldw == 0) ldw = N;
    const int nblk = N / 32, kb = item / nblk, nb = item % nblk, k0 = 64 * kb, n0 = 32 * nb;
    float wv[32];
#pragma unroll
    for (int i = 0; i < 32; ++i) { const int kk = 2 * i + (lane >> 5); wv[i] = W[(size_t)(k0 + kk) * ldw + n0 + (lane & 31)]; }
#pragma unroll
    for (int i = 0; i < 32; ++i) { const int kk = 2 * i + (lane >> 5); float w = wv[i]; if (gain) w *= gain[k0 + kk]; scr[kk * 33 + (lane & 31)] = w; }
    asm volatile("s_waitcnt lgkmcnt(0)" ::: "memory");
    const int c = lane & 7;
#pragma unroll
    for (int j = 0; j < 4; ++j) { const int n = (lane >> 3) + 8 * j; const float* s = scr + (8 * c) * 33 + n;
        u32x4 o; o.x = pk2(s[0 * 33], s[1 * 33]); o.y = pk2(s[2 * 33], s[3 * 33]); o.z = pk2(s[4 * 33], s[5 * 33]); o.w = pk2(s[6 * 33], s[7 * 33]);
        *(u32x4*)(WT + (size_t)(n0 + n) * ldo + koff + k0 + 8 * c) = o; }
    asm volatile("s_waitcnt lgkmcnt(0)" ::: "memory");
}
__device__ __forceinline__ void cvt8(const float* src, bf16_t* dst, size_t i8) {
    const f32x4 a = *(const f32x4*)(src + i8 * 8), b = *(const f32x4*)(src + i8 * 8 + 4);
    u32x4 o; o.x = pk2(a.x, a.y); o.y = pk2(a.z, a.w); o.z = pk2(b.x, b.y); o.w = pk2(b.z, b.w);
    *(u32x4*)(dst + i8 * 8) = o;
}
__device__ __forceinline__ void transpose_item8(const float* W, int K, int N, int ldw, const float* gain, float wscale, unsigned char* WT, float* scr, int item, int lane) {
    const int nblk = N / 32, kb = item / nblk, nb = item % nblk, k0 = 64 * kb, n0 = 32 * nb;
    float wv[32];
#pragma unroll
    for (int i = 0; i < 32; ++i) { const int kk = 2 * i + (lane >> 5); wv[i] = W[(size_t)(k0 + kk) * ldw + n0 + (lane & 31)]; }
#pragma unroll
    for (int i = 0; i < 32; ++i) { const int kk = 2 * i + (lane >> 5); float w = wv[i] * wscale; if (gain) w *= gain[k0 + kk]; scr[kk * 33 + (lane & 31)] = w; }
    asm volatile("s_waitcnt lgkmcnt(0)" ::: "memory");
    const int c = lane & 7;
#pragma unroll
    for (int j = 0; j < 4; ++j) { const int n = (lane >> 3) + 8 * j; const float* s = scr + (8 * c) * 33 + n;
        u32x2 o; o.x = __builtin_amdgcn_cvt_pk_fp8_f32(s[0 * 33], s[1 * 33], 0u, false); o.x = __builtin_amdgcn_cvt_pk_fp8_f32(s[2 * 33], s[3 * 33], o.x, true);
        o.y = __builtin_amdgcn_cvt_pk_fp8_f32(s[4 * 33], s[5 * 33], 0u, false); o.y = __builtin_amdgcn_cvt_pk_fp8_f32(s[6 * 33], s[7 * 33], o.y, true);
        *(u32x2*)(WT + (size_t)(n0 + n) * K + k0 + 8 * c) = o; }
    asm volatile("s_waitcnt lgkmcnt(0)" ::: "memory");
}
__device__ __forceinline__ void rms_rows_emit(const f32x4 (&v)[4], bf16_t* orow16, unsigned char* orow, int lane) {
    float s = 0.f;
#pragma unroll
    for (int j = 0; j < 4; ++j) s += (v[j].x * v[j].x + v[j].y * v[j].y) + (v[j].z * v[j].z + v[j].w * v[j].w);
    const float rstd = 1.f / sqrtf(wave_sum(s) * (1.f / D) + EPS);
    unsigned* o4 = (unsigned*)orow + lane; u32x2* o8 = (u32x2*)orow16 + lane;
#pragma unroll
    for (int j = 0; j < 4; ++j) { unsigned w = __builtin_amdgcn_cvt_pk_fp8_f32(v[j].x * rstd, v[j].y * rstd, 0u, false); w = __builtin_amdgcn_cvt_pk_fp8_f32(v[j].z * rstd, v[j].w * rstd, w, true); o4[64 * j] = w;
        u32x2 w2; w2.x = pk2(v[j].x * rstd, v[j].y * rstd); w2.y = pk2(v[j].z * rstd, v[j].w * rstd); o8[64 * j] = w2; }
}
__device__ __forceinline__ void rms_rows(const float* x, bf16_t* xn16, unsigned char* xn8, int m0, int step, int lane) {
    if (m0 >= M) return;
    f32x4 cur[4], nxt[4];
#pragma unroll
    for (int j = 0; j < 4; ++j) cur[j] = ((const f32x4*)(x + (size_t)m0 * D) + lane)[64 * j];
    for (int m = m0; m < M; m += step) {
        const int mn = (m + step < M) ? m + step : m;
#pragma unroll
        for (int j = 0; j < 4; ++j) nxt[j] = ((const f32x4*)(x + (size_t)mn * D) + lane)[64 * j];
        rms_rows_emit(cur, xn16 + (size_t)m * D, xn8 + (size_t)m * D, lane);
#pragma unroll
        for (int j = 0; j < 4; ++j) cur[j] = nxt[j];
    }
}
__device__ __forceinline__ void rms_row_to_bf16(const float* xrow, bf16_t* orow, int lane) {
    const f32x4* xr = (const f32x4*)xrow + lane;
    f32x4 v[4]; float s = 0.f;
#pragma unroll
    for (int j = 0; j < 4; ++j) { v[j] = xr[64 * j]; s += (v[j].x * v[j].x + v[j].y * v[j].y) + (v[j].z * v[j].z + v[j].w * v[j].w); }
    const float rstd = 1.f / sqrtf(wave_sum(s) * (1.f / D) + EPS);
    u32x2* o8 = (u32x2*)orow + lane;
#pragma unroll
    for (int j = 0; j < 4; ++j) { u32x2 w; w.x = pk2(v[j].x * rstd, v[j].y * rstd); w.y = pk2(v[j].z * rstd, v[j].w * rstd); o8[64 * j] = w; }
}

__device__ __forceinline__ void prep_phase(const Ptrs& P, unsigned char* shm, int G, int bx) {
    int tid_l = threadIdx.x; asm volatile("" : "+v"(tid_l));
    const int lane = tid_l & 63; const int wave = __builtin_amdgcn_readfirstlane(tid_l >> 6);
    const int gw = bx * 8 + wave, NGW = G * 8;
    float* scr = (float*)(shm + wave * (64 * 33 * 4));
    unsigned char* ws = P.ws;
    constexpr int N_BF = 1024;
    constexpr int I_INB = (D / 64) * (N_BF / 32), I_IN8 = (D / 64) * ((INW - N_BF) / 32), I_IN = I_INB + I_IN8, I_Q = (D / 64) * (PQ / 32), I_OUT = (D / 64) * (D / 32), I_PA = (512 / 64) * (D / 32);
    constexpr int NIT = I_IN + I_Q + I_OUT + 2 * I_PA;
    for (int it = gw; it < NIT; it += NGW) {
        int r = it;
        if (r < I_INB) { transpose_item(P.w_in, D, N_BF, P.norm_mix, (bf16_t*)(ws + WS_WIN), scr, r, lane, 0, 0, INW); continue; } r -= I_INB;
        if (r < I_IN8) { transpose_item8(P.w_in + N_BF, D, INW - N_BF, INW, P.norm_mix, WIN_SCALE, ws + WS_WIN8, scr, r, lane); continue; } r -= I_IN8;
        if (r < I_Q) { transpose_item(P.w_query, D, PQ, P.norm_ffn, (bf16_t*)(ws + WS_WQ), scr, r, lane); continue; } r -= I_Q;
        if (r < I_OUT) { transpose_item(P.w_out, D, D, nullptr, (bf16_t*)(ws + WS_WOUT), scr, r, lane); continue; } r -= I_OUT;
        if (r < I_PA) { transpose_item(P.w_pa, 512, D, nullptr, (bf16_t*)(ws + WS_WPA), scr, r, lane, 1024, 0); continue; } r -= I_PA;
        transpose_item(P.w_pb, 512, D, nullptr, (bf16_t*)(ws + WS_WPA), scr, r, lane, 1024, 512);
    }
    rms_rows(P.x, (bf16_t*)(ws + WS_XN), ws + WS_XN8, gw, NGW, lane);
    const size_t gt = (size_t)bx * 512 + threadIdx.x, NT = (size_t)G * 512;
    for (size_t i = gt; i < (size_t)16 * 128 * 128 / 8; i += NT) cvt8(P.sub_keys, (bf16_t*)(ws + WS_SK), i);
    for (size_t i = gt; i < (size_t)SEQ * 8; i += NT) {
        const int pos = (int)(i >> 3), k = (int)(i & 7);
        const float inv = k == 0 ? 1.0f : k == 1 ? 0.19392274f : k == 2 ? 0.03760603f : k == 3 ? 0.0072926646f : k == 4 ? 0.0014142136f : k == 5 ? 0.0002742482f : k == 6 ? 5.3182957e-05f : 1.0313385e-05f;
        const float ang = (float)pos * inv;
        float sn, cs; sincosf(ang, &sn, &cs);
        float* t = (float*)(ws + WS_ROPE) + (size_t)pos * 16;
        t[k] = cs; t[8 + k] = sn;
    }
}
__device__ __forceinline__ void cvt_row_fp8(const f32x4 (&rv)[4], unsigned char* dst, float* inv_scale, int lane) {
    const f32x4 a = rv[0], b = rv[1], c = rv[2], d = rv[3];
    float m = fmaxf(fmaxf(fmaxf(fabsf(a.x), fabsf(a.y)), fmaxf(fabsf(a.z), fabsf(a.w))), fmaxf(fmaxf(fabsf(b.x), fabsf(b.y)), fmaxf(fabsf(b.z), fabsf(b.w))));
    m = fmaxf(m, fmaxf(fmaxf(fmaxf(fabsf(c.x), fabsf(c.y)), fmaxf(fabsf(c.z), fabsf(c.w))), fmaxf(fmaxf(fabsf(d.x), fabsf(d.y)), fmaxf(fabsf(d.z), fabsf(d.w)))));
#pragma unroll
    for (int o = 1; o < 64; o <<= 1) m = fmaxf(m, __shfl_xor(m, o));
    m = fmaxf(m, 1e-30f);
    const float sc = 256.f / m;
    u32x4 w;
    w.x = __builtin_amdgcn_cvt_pk_fp8_f32(a.x * sc, a.y * sc, 0u, false); w.x = __builtin_amdgcn_cvt_pk_fp8_f32(a.z * sc, a.w * sc, w.x, true);
    w.y = __builtin_amdgcn_cvt_pk_fp8_f32(b.x * sc, b.y * sc, 0u, false); w.y = __builtin_amdgcn_cvt_pk_fp8_f32(b.z * sc, b.w * sc, w.y, true);
    w.z = __builtin_amdgcn_cvt_pk_fp8_f32(c.x * sc, c.y * sc, 0u, false); w.z = __builtin_amdgcn_cvt_pk_fp8_f32(c.z * sc, c.w * sc, w.z, true);
    w.w = __builtin_amdgcn_cvt_pk_fp8_f32(d.x * sc, d.y * sc, 0u, false); w.w = __builtin_amdgcn_cvt_pk_fp8_f32(d.z * sc, d.w * sc, w.w, true);
    *(u32x4*)(dst + (size_t)(lane >> 5) * (NEXP * 512) + (lane & 31) * 16) = w;
    if (lane == 0) *inv_scale = m * (1.f / 256.f);
}
__device__ __forceinline__ unsigned pack_i8x4(float a, float b, float c, float d) {
    const int q0 = (int)rintf(a), q1 = (int)rintf(b), q2 = (int)rintf(c), q3 = (int)rintf(d);
    return (unsigned)(q0 & 0xff) | ((unsigned)(q1 & 0xff) << 8) | ((unsigned)(q2 & 0xff) << 16) | ((unsigned)q3 << 24);
}
__device__ __forceinline__ void cvt_row_i8(const f32x4 (&rv)[4], unsigned char* dst, float* inv_scale, int lane) {
    const f32x4 a = rv[0], b = rv[1], c = rv[2], d = rv[3];
    float m = fmaxf(fmaxf(fmaxf(fabsf(a.x), fabsf(a.y)), fmaxf(fabsf(a.z), fabsf(a.w))), fmaxf(fmaxf(fabsf(b.x), fabsf(b.y)), fmaxf(fabsf(b.z), fabsf(b.w))));
    m = fmaxf(m, fmaxf(fmaxf(fmaxf(fabsf(c.x), fabsf(c.y)), fmaxf(fabsf(c.z), fabsf(c.w))), fmaxf(fmaxf(fabsf(d.x), fabsf(d.y)), fmaxf(fabsf(d.z), fabsf(d.w)))));
#pragma unroll
    for (int o = 1; o < 64; o <<= 1) m = fmaxf(m, __shfl_xor(m, o));
    m = fmaxf(m, 1e-30f);
    const float sc = 127.f / m;
    u32x4 w;
    w.x = pack_i8x4(a.x * sc, a.y * sc, a.z * sc, a.w * sc); w.y = pack_i8x4(b.x * sc, b.y * sc, b.z * sc, b.w * sc);
    w.z = pack_i8x4(c.x * sc, c.y * sc, c.z * sc, c.w * sc); w.w = pack_i8x4(d.x * sc, d.y * sc, d.z * sc, d.w * sc);
    *(u32x4*)(dst + (size_t)(lane >> 5) * (NEXP * 512) + (lane & 31) * 16) = w;
    if (lane == 0) *inv_scale = m * (1.f / 127.f);
}
__device__ __forceinline__ void cvt_experts_phase(const Ptrs& P, int G, int bx) {
    int tid_l = threadIdx.x; asm volatile("" : "+v"(tid_l));
    const int lane = tid_l & 63; const int wave = __builtin_amdgcn_readfirstlane(tid_l >> 6);
    const int step = G * 8; int r = bx * 8 + wave;
    if (r >= 2 * NEXP) return;
    f32x4 cur[4], nxt[4];
    { const float* src = (r < NEXP ? P.peer_u + (size_t)r * D : P.peer_v + (size_t)(r - NEXP) * D);
#pragma unroll
      for (int j = 0; j < 4; ++j) cur[j] = ((const f32x4*)src + lane * 4)[j]; }
    for (; r < 2 * NEXP; r += step) {
        const int rn = (r + step < 2 * NEXP) ? r + step : r;
        const float* srcn = (rn < NEXP ? P.peer_u + (size_t)rn * D : P.peer_v + (size_t)(rn - NEXP) * D);
#pragma unroll
        for (int j = 0; j < 4; ++j) nxt[j] = ((const f32x4*)srcn + lane * 4)[j];
        if (r < NEXP) cvt_row_i8(cur, P.ws + WS_U + (size_t)r * 512, (float*)(P.ws + WS_SU) + r, lane);
        else { const int e = r - NEXP; cvt_row_fp8(cur, P.ws + WS_V + (size_t)e * 512, (float*)(P.ws + WS_SV) + e, lane); }
#pragma unroll
        for (int j = 0; j < 4; ++j) cur[j] = nxt[j];
    }
}

namespace pg8 {
#define PG8_LAS __attribute__((address_space(3)))
typedef unsigned short bf16_t;
typedef short bf16x8 __attribute__((ext_vector_type(8)));
typedef float f32x4 __attribute__((ext_vector_type(4)));
typedef unsigned u32x4 __attribute__((ext_vector_type(4)));
typedef int v8i_t __attribute__((ext_vector_type(8)));
constexpr int BM = 256, BK = 64, HALF = 128, HTB = HALF * BK * 2  , STAGE_BYTES = 8 * HTB, NXCD = 8, WGM = 8;

__host__ __device__ __forceinline__ int lds_byte(int r, int c) { const int st = (r >> 4) * 2 + (c >> 5), rr = r & 15, cc = c & 31, ob = rr * 64 + cc * 2; return st * 1024 + (ob ^ (((ob >> 9) & 1) << 5)); }
__host__ __device__ __forceinline__ void stage_rc(int b, int& R, int& C) { const int st = b / 1024, sb = b % 1024, swz = sb ^ (((sb >> 9) & 1) << 5); R = (st >> 1) * 16 + swz / 64; C = (st & 1) * 32 + (swz % 64) / 2; }
__host__ __device__ __forceinline__ int perm32(int rho) { const int n = rho >> 4, i = rho & 15; return 8 * (i >> 2) + 4 * n + (i & 3); }

struct Unit { int pm, pn; };
struct Gemm { const bf16_t* A; const bf16_t* Bt; int M, N, K, pad; };

struct StaticOrder {
    int nM, nN, nwg, G, c;
    __host__ __device__ void init(int M, int N, int G_, int c_) { nM = M / BM; nN = N / BM; nwg = nM * nN; G = G_; c = c_; }
    __host__ __device__ bool next(int i, Unit& u) const {
        const long L = (long)i * G + c; if (L >= nwg) return false;
        int wgid = (int)L; { const int q = nwg / NXCD, r = nwg % NXCD, xcd = wgid % NXCD, off = wgid / NXCD; wgid = (xcd < r ? xcd * (q + 1) : r * (q + 1) + (xcd - r) * q) + off; }
        const int nig = WGM * nN, gid = wgid / nig, fm = gid * WGM, gsz = (nM - fm) < WGM ? (nM - fm) : WGM;
        u.pm = fm + ((wgid % nig) % gsz); u.pn = (wgid % nig) / gsz; return true;
    }
    __device__ __forceinline__ void a_ready(const Unit&) const {}
    __device__ __forceinline__ void done(const Unit&) const {}
};
__device__ __forceinline__ unsigned cvt_pk_bf16(float lo, float hi) { unsigned r; asm volatile("v_cvt_pk_bf16_f32 %0, %1, %2" : "=v"(r) : "v"(lo), "v"(hi)); return r; }
typedef float f32x2 __attribute__((ext_vector_type(2)));

__device__ __forceinline__ float sigm(float x) { return __builtin_amdgcn_rcpf(1.f + __builtin_amdgcn_exp2f(-1.4426950408889634f * x)); }
struct EpiProj {
    static constexpr bool PERM = true, AFTER_DRAIN = false, MID = false;
    bf16_t* O; const float* rope; float osc; int pn0;
    __device__ __forceinline__ void operator()(const f32x4 (&acc)[2][2][4][2], const Unit& u, int wr, int wc, int fr_, int fq_) const {
        int fr = fr_, fq = fq_; asm volatile("" : "+v"(fr), "+v"(fq));
        const int pn = u.pn + pn0;
        const int row0 = u.pm * BM + wr * 64 + fr, col0 = pn * BM + wc * 32 + 8 * fq;
        const float sc = ((pn < 2 || pn == 6 || pn == 7) ? QSCALE : 1.f) * osc;
        const bool dorope = (pn < 4) && ((wc & 1) == 0);
#pragma unroll
        for (int ai = 0; ai < 2; ++ai)
#pragma unroll
            for (int m = 0; m < 4; ++m) { const int row = row0 + ai * HALF + m * 16; bf16_t* rowp = O + (size_t)row * INW + col0;
                f32x4 c4[2] = {{1.f, 1.f, 1.f, 1.f}, {1.f, 1.f, 1.f, 1.f}}, s4[2] = {{0.f, 0.f, 0.f, 0.f}, {0.f, 0.f, 0.f, 0.f}};
                if (dorope) { const float* rp = rope + (size_t)(row & (SEQ - 1)) * 16; c4[0] = *(const f32x4*)(rp); c4[1] = *(const f32x4*)(rp + 4); s4[0] = *(const f32x4*)(rp + 8); s4[1] = *(const f32x4*)(rp + 12); }
#pragma unroll
                for (int bj = 0; bj < 2; ++bj) { f32x4 v0 = acc[ai][bj][m][0], v1 = acc[ai][bj][m][1];
                    if (dorope) { f32x4 o0, o1;
#pragma unroll
                        for (int j = 0; j < 4; ++j) { o0[j] = __shfl_xor(v0[j], 16); o1[j] = __shfl_xor(v1[j], 16); }
                        if (fq == 0) { v0 = v0 * c4[0] - o0 * s4[0]; v1 = v1 * c4[1] - o1 * s4[1]; }
                        else if (fq == 1) { v0 = v0 * c4[0] + o0 * s4[0]; v1 = v1 * c4[1] + o1 * s4[1]; } }
                    v0 = v0 * sc; v1 = v1 * sc; u32x4 w; w.x = cvt_pk_bf16(v0[0], v0[1]); w.y = cvt_pk_bf16(v0[2], v0[3]); w.z = cvt_pk_bf16(v1[0], v1[1]); w.w = cvt_pk_bf16(v1[2], v1[3]);
                    *(u32x4*)(rowp + bj * HALF) = w; } }
    }
};
struct EpiGate2 {
    static constexpr bool PERM = true, AFTER_DRAIN = false, MID = true;
    const bf16_t* proj; bf16_t* O;
    __device__ __forceinline__ void mid(f32x4 (&acc)[2][2][4][2], const Unit& u, int wr, int wc, int fr, int fq) const {
        int row0 = u.pm * BM + wr * 64 + fr, col0 = u.pn * BM + wc * 32 + 8 * fq;
        asm volatile("" : "+v"(row0), "+v"(col0));
#pragma unroll
        for (int ai = 0; ai < 2; ++ai) {
            u32x4 gav[4][2], gbv[4][2];
#pragma unroll
            for (int m = 0; m < 4; ++m)
#pragma unroll
                for (int bj = 0; bj < 2; ++bj) { const bf16_t* gp = proj + (size_t)(row0 + ai * HALF + m * 16) * INW + col0 + bj * HALF; gav[m][bj] = *(const u32x4*)(gp + C_GA); gbv[m][bj] = *(const u32x4*)(gp + C_GB); }
#pragma unroll
            for (int m = 0; m < 4; ++m) {
#pragma unroll
                for (int bj = 0; bj < 2; ++bj) { const u32x4 ga = gav[m][bj], gb = gbv[m][bj];
                    const unsigned a_[4] = {ga.x, ga.y, ga.z, ga.w}, b_[4] = {gb.x, gb.y, gb.z, gb.w};
#pragma unroll
                    for (int q = 0; q < 4; ++q) {
                        const float r0 = (1.f + __builtin_amdgcn_exp2f(-1.4426950408889634f * bflo(b_[q]))) * __builtin_amdgcn_rcpf(1.f + __builtin_amdgcn_exp2f(-1.4426950408889634f * bflo(a_[q])));
                        const float r1 = (1.f + __builtin_amdgcn_exp2f(-1.4426950408889634f * bfhi(b_[q]))) * __builtin_amdgcn_rcpf(1.f + __builtin_amdgcn_exp2f(-1.4426950408889634f * bfhi(a_[q])));
                        acc[ai][bj][m][q >> 1][(q & 1) * 2] *= r0; acc[ai][bj][m][q >> 1][(q & 1) * 2 + 1] *= r1; } } }
            asm volatile("" ::: "memory"); }
    }
    __device__ __forceinline__ void operator()(const f32x4 (&acc)[2][2][4][2], const Unit& u, int wr, int wc, int fr_, int fq_) const {
        int fr = fr_, fq = fq_; asm volatile("" : "+v"(fr), "+v"(fq));
        const int row0 = u.pm * BM + wr * 64 + fr, col0 = u.pn * BM + wc * 32 + 8 * fq;
#pragma unroll
        for (int ai = 0; ai < 2; ++ai) {
            u32x4 gv[4][2];
#pragma unroll
            for (int m = 0; m < 4; ++m)
#pragma unroll
                for (int bj = 0; bj < 2; ++bj) gv[m][bj] = *(const u32x4*)(proj + (size_t)(row0 + ai * HALF + m * 16) * INW + C_GB + col0 + bj * HALF);
#pragma unroll
            for (int m = 0; m < 4; ++m) { const int row = row0 + ai * HALF + m * 16;
#pragma unroll
                for (int bj = 0; bj < 2; ++bj) { const int col = col0 + bj * HALF; const u32x4 g = gv[m][bj];
                    f32x4 v0 = acc[ai][bj][m][0], v1 = acc[ai][bj][m][1];
                    v0[0] *= sigm(bflo(g.x)); v0[1] *= sigm(bfhi(g.x)); v0[2] *= sigm(bflo(g.y)); v0[3] *= sigm(bfhi(g.y));
                    v1[0] *= sigm(bflo(g.z)); v1[1] *= sigm(bfhi(g.z)); v1[2] *= sigm(bflo(g.w)); v1[3] *= sigm(bfhi(g.w));
                    u32x4 w; w.x = cvt_pk_bf16(v0[0], v0[1]); w.y = cvt_pk_bf16(v0[2], v0[3]); w.z = cvt_pk_bf16(v1[0], v1[1]); w.w = cvt_pk_bf16(v1[2], v1[3]);
                    *(u32x4*)(O + (size_t)row * D + col) = w; } }
            asm volatile("" ::: "memory"); }
    }
};
struct EpiHout {
    static constexpr bool PERM = true, AFTER_DRAIN = false, MID = false;
    const float* x; float* H; bf16_t* HB; float* ssq16;
    __device__ __forceinline__ void operator()(const f32x4 (&acc)[2][2][4][2], const Unit& u, int wr, int wc, int fr_, int fq_) const {
        int fr = fr_, fq = fq_; asm volatile("" : "+v"(fr), "+v"(fq));
        const int row0 = u.pm * BM + wr * 64 + fr, col0 = u.pn * BM + wc * 32 + 8 * fq;
#pragma unroll
        for (int ai = 0; ai < 2; ++ai) {
            f32x4 xv[4][2][2];
#pragma unroll
            for (int m = 0; m < 4; ++m)
#pragma unroll
                for (int bj = 0; bj < 2; ++bj) { const float* xp = x + (size_t)(row0 + ai * HALF + m * 16) * D + col0 + bj * HALF; xv[m][bj][0] = *(const f32x4*)xp; xv[m][bj][1] = *(const f32x4*)(xp + 4); }
#pragma unroll
            for (int m = 0; m < 4; ++m) { const int row = row0 + ai * HALF + m * 16; float ss = 0.f;
#pragma unroll
                for (int bj = 0; bj < 2; ++bj) { const int col = col0 + bj * HALF;
                    const f32x4 v0 = acc[ai][bj][m][0] + xv[m][bj][0], v1 = acc[ai][bj][m][1] + xv[m][bj][1];
                    u32x4 w; w.x = cvt_pk_bf16(v0[0], v0[1]); w.y = cvt_pk_bf16(v0[2], v0[3]); w.z = cvt_pk_bf16(v1[0], v1[1]); w.w = cvt_pk_bf16(v1[2], v1[3]);
                    *(u32x4*)(HB + (size_t)row * D + col) = w;
                    ss += (v0[0] * v0[0] + v0[1] * v0[1]) + (v0[2] * v0[2] + v0[3] * v0[3]) + (v1[0] * v1[0] + v1[1] * v1[1]) + (v1[2] * v1[2] + v1[3] * v1[3]); }
                ss += __shfl_xor(ss, 16); ss += __shfl_xor(ss, 32);
                if (fq == 0) ssq16[(size_t)row * 16 + u.pn * 4 + wc] = ss; }
            asm volatile("" ::: "memory"); }
    }
};
struct EpiQ {
    static constexpr bool PERM = true, AFTER_DRAIN = false, MID = false;
    const float* ssq16; bf16_t* O;
    __device__ __forceinline__ void operator()(const f32x4 (&acc)[2][2][4][2], const Unit& u, int wr, int wc, int fr, int fq) const {
        const int row0 = u.pm * BM + wr * 64 + fr, col0 = u.pn * BM + wc * 32 + 8 * fq;
#pragma unroll
        for (int ai = 0; ai < 2; ++ai)
#pragma unroll
            for (int m = 0; m < 4; ++m) { const int row = row0 + ai * HALF + m * 16; const f32x4* sp = (const f32x4*)(ssq16 + (size_t)row * 16);
                const f32x4 a = sp[0], b = sp[1], c = sp[2], d = sp[3];
                const float tot = ((a[0] + a[1]) + (a[2] + a[3])) + ((b[0] + b[1]) + (b[2] + b[3])) + ((c[0] + c[1]) + (c[2] + c[3])) + ((d[0] + d[1]) + (d[2] + d[3]));
                const float rstd = 1.f / sqrtf(tot * (1.f / D) + EPS);
#pragma unroll
                for (int bj = 0; bj < 2; ++bj) { const f32x4 v0 = acc[ai][bj][m][0] * rstd, v1 = acc[ai][bj][m][1] * rstd;
                    u32x4 w; w.x = cvt_pk_bf16(v0[0], v0[1]); w.y = cvt_pk_bf16(v0[2], v0[3]); w.z = cvt_pk_bf16(v1[0], v1[1]); w.w = cvt_pk_bf16(v1[2], v1[3]);
                    *(u32x4*)(O + (size_t)row * PQ + col0 + bj * HALF) = w; } }
    }
};
template <class Epi, class Sched, bool ALIGN_EPI = false, bool SP2 = false, bool FP8 = false>
__device__ __forceinline__ void gemm_phase(PG8_LAS unsigned char* lds, const Gemm g, const Sched& S, const Epi& E) {
    int tid_l = threadIdx.x; asm volatile("" : "+v"(tid_l));
    const int tid = tid_l, wid = __builtin_amdgcn_readfirstlane(tid >> 6), lane = tid & 63, wr = wid >> 2, wc = wid & 3, fr = lane & 15, fq = lane >> 4;
    const int K = g.K, nt = K / BK;
    unsigned voffA[2], voffB[2];
#pragma unroll
    for (int i = 0; i < 2; ++i) { int R, C; stage_rc(tid * 16 + i * 8192, R, C); const int Rb = Epi::PERM ? ((R & ~31) + perm32(R & 31)) : R;
        voffA[i] = (unsigned)(R * K + C) * 2u; voffB[i] = (unsigned)(Rb * K + C) * 2u; }
    const size_t kstep = (size_t)(BK * 2);
    const size_t hstep = (size_t)HALF * K * 2;
    const size_t tstep = 2 * hstep;
    const unsigned ldsw = (unsigned)wid * 1024u;
    const int aoff = lds_byte(wr * 64 + fr, fq * 8), boff = lds_byte(wc * 32 + fr, fq * 8);
    const int aoffF0 = FP8 ? lds_byte(wr * 64 + fr, fq * 16) : 0, boffF0 = FP8 ? lds_byte(wc * 32 + fr, fq * 16) : 0;
#define PG8_SA(b, h) (((b) * 2 + (h)) * HTB)
#define PG8_SB(b, h) ((4 + (b) * 2 + (h)) * HTB)
#define PG8_STAGE(bufoff, gbase, voff) do { _Pragma("unroll") for (int _i = 0; _i < 2; ++_i) \
        __builtin_amdgcn_global_load_lds((const unsigned*)((const char*)(gbase) + (voff)[_i]), (PG8_LAS unsigned*)(lds + (bufoff) + ldsw + _i * 8192), 16, 0, 0); } while (0)
#define PG8_LDA(dst, b, h) do { if constexpr (FP8) { _Pragma("unroll") for (int m = 0; m < 4; ++m) { const u32x4 l_ = *(const PG8_LAS u32x4*)(lds + PG8_SA(b, h) + aoffF0 + m * 2048), h_ = *(const PG8_LAS u32x4*)(lds + PG8_SA(b, h) + aoffF0 + m * 2048 + 16); \
            dst##8[m] = (v8i_t){(int)l_.x, (int)l_.y, (int)l_.z, (int)l_.w, (int)h_.x, (int)h_.y, (int)h_.z, (int)h_.w}; } } \
        else { _Pragma("unroll") for (int m = 0; m < 4; ++m) _Pragma("unroll") for (int k = 0; k < 2; ++k) dst[m][k] = *(const PG8_LAS bf16x8*)(lds + PG8_SA(b, h) + aoff + m * 2048 + k * 1024); } } while (0)
#define PG8_LDB(dst, b, h) do { if constexpr (FP8) { _Pragma("unroll") for (int n = 0; n < 2; ++n) { const u32x4 l_ = *(const PG8_LAS u32x4*)(lds + PG8_SB(b, h) + boffF0 + n * 2048), h_ = *(const PG8_LAS u32x4*)(lds + PG8_SB(b, h) + boffF0 + n * 2048 + 16); \
            dst##8[n] = (v8i_t){(int)l_.x, (int)l_.y, (int)l_.z, (int)l_.w, (int)h_.x, (int)h_.y, (int)h_.z, (int)h_.w}; } } \
        else { _Pragma("unroll") for (int n = 0; n < 2; ++n) _Pragma("unroll") for (int k = 0; k < 2; ++k) dst[n][k] = *(const PG8_LAS bf16x8*)(lds + PG8_SB(b, h) + boff + n * 2048 + k * 1024); } } while (0)
#define PG8_MMA(ai, bj, At, Bt) do { __builtin_amdgcn_s_setprio(1); \
        if constexpr (FP8) { _Pragma("unroll") for (int m = 0; m < 4; ++m) _Pragma("unroll") for (int n = 0; n < 2; ++n) \
            asm volatile("v_mfma_scale_f32_16x16x128_f8f6f4 %0, %1, %2, %0, %3, %3 op_sel_hi:[0,0,0]" : "+v"(acc[ai][bj][m][n]) : "v"(Bt##8[n]), "v"(At##8[m]), "v"(mxone)); } \
        else { _Pragma("unroll") for (int m = 0; m < 4; ++m) _Pragma("unroll") for (int n = 0; n < 2; ++n) _Pragma("unroll") for (int k = 0; k < 2; ++k) \
            acc[ai][bj][m][n] = __builtin_amdgcn_mfma_f32_16x16x32_bf16(Bt[n][k], At[m][k], acc[ai][bj][m][n], 0, 0, 0); } \
        __builtin_amdgcn_s_setprio(0); } while (0)
#define PG8_WAIT_V(n) asm volatile("s_waitcnt vmcnt(" #n ")" ::: "memory")
#define PG8_WAIT_L(n) asm volatile("s_waitcnt lgkmcnt(" #n ")" ::: "memory")
#define PG8_BAR __builtin_amdgcn_s_barrier()
#define PG8_SCHED __builtin_amdgcn_sched_barrier(0)
    Unit cur, nxt; int ui = 0;
    if (!S.next(0, cur)) return;
    f32x4 acc[2][2][4][2];
#pragma unroll
    for (int a = 0; a < 2; ++a)
#pragma unroll
        for (int b = 0; b < 2; ++b)
#pragma unroll
            for (int m = 0; m < 4; ++m)
#pragma unroll
                for (int n = 0; n < 2; ++n) acc[a][b][m][n] = (f32x4){0.f, 0.f, 0.f, 0.f};
    bf16x8 At[4][2], B0[2][2], B1[2][2]; v8i_t At8[4], B08[2], B18[2];
    int mxone = 0x7F7F7F7F; asm volatile("" : "+v"(mxone));
    const char* cA = (const char*)g.A + (size_t)cur.pm * tstep; const char* cB = (const char*)g.Bt + (size_t)cur.pn * tstep;
    S.a_ready(cur);
    if constexpr (SP2) {
        PG8_STAGE(PG8_SB(0, 0), cB, voffB); PG8_STAGE(PG8_SB(0, 1), cB + hstep, voffB); PG8_STAGE(PG8_SA(0, 0), cA, voffA); PG8_STAGE(PG8_SA(0, 1), cA + hstep, voffA);
        if (wr == 1) PG8_BAR;
        PG8_WAIT_V(2); PG8_BAR;
        PG8_STAGE(PG8_SB(1, 0), cB + kstep, voffB); PG8_STAGE(PG8_SA(1, 0), cA + kstep, voffA); PG8_STAGE(PG8_SB(1, 1), cB + hstep + kstep, voffB);
        PG8_WAIT_V(6); PG8_BAR;
    } else {
        PG8_STAGE(PG8_SB(0, 0), cB, voffB); PG8_STAGE(PG8_SA(0, 0), cA, voffA); PG8_STAGE(PG8_SB(0, 1), cB + hstep, voffB); PG8_STAGE(PG8_SA(0, 1), cA + hstep, voffA);
        if (wr == 1) PG8_BAR;
        PG8_WAIT_V(4); PG8_BAR;
        PG8_STAGE(PG8_SB(1, 0), cB + kstep, voffB); PG8_STAGE(PG8_SA(1, 0), cA + kstep, voffA); PG8_STAGE(PG8_SB(1, 1), cB + hstep + kstep, voffB);
        PG8_WAIT_V(6); PG8_BAR;
    }
    for (;;) {
        const bool has_next = S.next(ui + 1, nxt);
        const char* nA = has_next ? (const char*)g.A + (size_t)nxt.pm * tstep : cA; const char* nB = has_next ? (const char*)g.Bt + (size_t)nxt.pn * tstep : cB;
#pragma unroll 1
        for (int t = 0; t < nt; t += 2) {
            if constexpr (Epi::MID) { if (t == nt / 2) E.mid(acc, cur, wr, wc, fr, fq); }
            const bool last = (t == nt - 2);
            const char* a1 = cA + (size_t)(t + 1) * kstep;
            const char* a2 = last ? nA : cA + (size_t)(t + 2) * kstep; const char* b2 = last ? nB : cB + (size_t)(t + 2) * kstep;
            const char* a3 = a2 + kstep; const char* b3 = b2 + kstep;
            if (last && has_next) S.a_ready(nxt);
            if constexpr (SP2) {
            PG8_LDB(B0, 0, 0); PG8_LDB(B1, 0, 1); PG8_SCHED; PG8_LDA(At, 0, 0); PG8_STAGE(PG8_SA(1, 1), a1 + hstep, voffA);
            PG8_WAIT_V(8); PG8_WAIT_L(0); PG8_BAR; PG8_MMA(0, 0, At, B0); PG8_MMA(0, 1, At, B1); PG8_BAR; PG8_SCHED;
            PG8_LDA(At, 0, 1); PG8_STAGE(PG8_SB(0, 0), b2, voffB); PG8_STAGE(PG8_SB(0, 1), b2 + hstep, voffB); PG8_STAGE(PG8_SA(0, 0), a2, voffA);
            PG8_WAIT_V(8); PG8_WAIT_L(0); PG8_BAR; PG8_MMA(1, 0, At, B0); PG8_MMA(1, 1, At, B1); PG8_BAR; PG8_SCHED;
            PG8_LDB(B0, 1, 0); PG8_LDB(B1, 1, 1); PG8_SCHED; PG8_LDA(At, 1, 0); PG8_STAGE(PG8_SA(0, 1), a2 + hstep, voffA);
            PG8_WAIT_V(8); PG8_WAIT_L(0); PG8_BAR; PG8_MMA(0, 0, At, B0); PG8_MMA(0, 1, At, B1); PG8_BAR; PG8_SCHED;
            PG8_LDA(At, 1, 1); PG8_STAGE(PG8_SB(1, 0), b3, voffB); PG8_STAGE(PG8_SB(1, 1), b3 + hstep, voffB); PG8_STAGE(PG8_SA(1, 0), a3, voffA);
            PG8_WAIT_V(8); PG8_WAIT_L(0); PG8_BAR; PG8_MMA(1, 0, At, B0); PG8_MMA(1, 1, At, B1); PG8_BAR; PG8_SCHED;
            } else {
            PG8_LDB(B0, 0, 0); PG8_SCHED; PG8_LDA(At, 0, 0); PG8_STAGE(PG8_SA(1, 1), a1 + hstep, voffA);
            PG8_WAIT_L(8); PG8_BAR; PG8_WAIT_L(0); PG8_MMA(0, 0, At, B0); PG8_BAR; PG8_SCHED;
            PG8_LDB(B1, 0, 1); PG8_STAGE(PG8_SB(0, 0), b2, voffB);
            PG8_BAR; PG8_WAIT_L(0); PG8_MMA(0, 1, At, B1); PG8_BAR;
            PG8_LDA(At, 0, 1); PG8_STAGE(PG8_SA(0, 0), a2, voffA);
            PG8_BAR; PG8_WAIT_L(0); PG8_MMA(1, 0, At, B0); PG8_BAR; PG8_SCHED;
            PG8_STAGE(PG8_SB(0, 1), b2 + hstep, voffB);
            PG8_WAIT_V(6); PG8_BAR; PG8_MMA(1, 1, At, B1); PG8_BAR;
            PG8_LDB(B0, 1, 0); PG8_SCHED; PG8_LDA(At, 1, 0); PG8_STAGE(PG8_SA(0, 1), a2 + hstep, voffA);
            PG8_WAIT_L(8); PG8_BAR; PG8_WAIT_L(0); PG8_MMA(0, 0, At, B0); PG8_BAR; PG8_SCHED;
            PG8_LDB(B1, 1, 1); PG8_STAGE(PG8_SB(1, 0), b3, voffB);
            PG8_BAR; PG8_WAIT_L(0); PG8_MMA(0, 1, At, B1); PG8_BAR;
            PG8_LDA(At, 1, 1); PG8_STAGE(PG8_SA(1, 0), a3, voffA);
            PG8_BAR; PG8_WAIT_L(0); PG8_MMA(1, 0, At, B0); PG8_BAR; PG8_SCHED;
            PG8_STAGE(PG8_SB(1, 1), b3 + hstep, voffB);
            PG8_WAIT_V(6); PG8_BAR; PG8_MMA(1, 1, At, B1); PG8_BAR;
            }
        }
        if constexpr (ALIGN_EPI) { if (wr == 0) PG8_BAR; }
        if constexpr (FP8) { asm volatile("s_nop 15\n\ts_nop 7" ::: "memory"); PG8_SCHED; }
        if constexpr (!Epi::AFTER_DRAIN) { E(acc, cur, wr, wc, fr, fq); S.done(cur); }
        if (!has_next) break;
#pragma unroll
        for (int a = 0; a < 2; ++a)
#pragma unroll
            for (int b = 0; b < 2; ++b)
#pragma unroll
                for (int m = 0; m < 4; ++m)
#pragma unroll
                    for (int n = 0; n < 2; ++n) acc[a][b][m][n] = (f32x4){0.f, 0.f, 0.f, 0.f};
        cur = nxt; cA = nA; cB = nB; ++ui;
        if constexpr (ALIGN_EPI) { if (wr == 1) PG8_BAR; }
    }
    PG8_WAIT_V(0);
    if constexpr (!ALIGN_EPI) { if (wr == 0) PG8_BAR; }
    PG8_BAR;
    if constexpr (Epi::AFTER_DRAIN) { E.fused(acc, cur, wr, wc, fr, fq, lds, wid, lane); S.done(cur); }
#undef PG8_SA
#undef PG8_SB
#undef PG8_STAGE
#undef PG8_LDA
#undef PG8_LDB
#undef PG8_MMA
#undef PG8_WAIT_V
#undef PG8_WAIT_L
#undef PG8_BAR
#undef PG8_SCHED
}
}

__device__ __forceinline__ float lambda_full(const Ptrs& P) {
    float a = 0.f, b = 0.f;
    for (int i = 0; i < 64; ++i) { a += P.lq1[i] * P.lk1[i]; b += P.lq2[i] * P.lk2[i]; }
    return __expf(a) - __expf(b) + 0.2f;
}

namespace att {
typedef short bf16x8 __attribute__((ext_vector_type(8)));
typedef short s16x4 __attribute__((ext_vector_type(4)));
typedef float f32x16 __attribute__((ext_vector_type(16)));
typedef float f32x2_t __attribute__((ext_vector_type(2)));
typedef __attribute__((address_space(3))) const char* lds_cptr;
typedef __attribute__((address_space(3))) char* lds_ptr;
__device__ __forceinline__ int crow(int r, int hi) { return (r & 3) + 8 * (r >> 2) + 4 * hi; }
__device__ __forceinline__ void glds16(const void* gsrc, unsigned lds_dst) { unsigned keep;
    asm volatile("s_mov_b32 %0, m0\n\ts_mov_b32 m0, %2\n\ts_nop 0\n\tglobal_load_lds_dwordx4 %1, off\n\ts_mov_b32 m0, %0" : "=&s"(keep) : "v"(gsrc), "s"(lds_dst) : "memory"); }
__device__ __forceinline__ unsigned cvtpk(float lo, float hi) { f32x2_t v = {lo, hi}; bf16x2_t b = __builtin_convertvector(v, bf16x2_t); return __builtin_bit_cast(unsigned, b); }
#define ATT_WAIT_BAR(N) asm volatile("s_waitcnt vmcnt(" #N ") lgkmcnt(0)\n\ts_barrier" ::: "memory")
#define ATT_LDSWAIT() asm volatile("s_waitcnt lgkmcnt(0)" ::: "memory")
#define ATT_SBAR() __builtin_amdgcn_sched_barrier(0)
template <bool REL> __device__ __forceinline__ void qkt(f32x16& p0, f32x16& p1, lds_cptr Kslot, const bf16x8* qr, const f32x16& negm, int r32, int hi) {
    lds_cptr kb = Kslot + hi * 1024 + r32 * 16;
#pragma unroll
    for (int d0 = 0; d0 < 4; ++d0) {
        const bf16x8 b0 = *(const __attribute__((address_space(3))) bf16x8*)(kb + d0 * 2048);
        const bf16x8 b1 = *(const __attribute__((address_space(3))) bf16x8*)(kb + d0 * 2048 + 512);
        if (d0 == 0) { if (REL) { p0 = __builtin_amdgcn_mfma_f32_32x32x16_bf16(b0, qr[0], negm, 0, 0, 0); p1 = __builtin_amdgcn_mfma_f32_32x32x16_bf16(b1, qr[0], negm, 0, 0, 0); }
                       else { p0 = __builtin_amdgcn_mfma_f32_32x32x16_bf16(b0, qr[0], f32x16{}, 0, 0, 0); p1 = __builtin_amdgcn_mfma_f32_32x32x16_bf16(b1, qr[0], f32x16{}, 0, 0, 0); } }
        else { p0 = __builtin_amdgcn_mfma_f32_32x32x16_bf16(b0, qr[d0], p0, 0, 0, 0); p1 = __builtin_amdgcn_mfma_f32_32x32x16_bf16(b1, qr[d0], p1, 0, 0, 0); } }
}
__device__ __forceinline__ float rowmax32(const f32x16& p0, const f32x16& p1) {
    float a = fmaxf(p0[0], p1[0]);
#pragma unroll
    for (int r = 1; r < 16; ++r) a = fmaxf(a, fmaxf(p0[r], p1[r]));
    auto rr = __builtin_amdgcn_permlane32_swap(__float_as_uint(a), __float_as_uint(a), false, false);
    return fmaxf(__uint_as_float(rr[0]), __uint_as_float(rr[1]));
}
__device__ __forceinline__ float halfsum(float a) { auto rr = __builtin_amdgcn_permlane32_swap(__float_as_uint(a), __float_as_uint(a), false, false); return __uint_as_float(rr[0]) + __uint_as_float(rr[1]); }
template <int ND0> __device__ __forceinline__ void pv(f32x16* o, int vb, bf16x8 pa0, bf16x8 pa1, bf16x8 pa2, bf16x8 pa3) {
#pragma unroll
    for (int d0 = 0; d0 < ND0; ++d0) { s16x4 lo[4], hi[4];
#pragma unroll
        for (int ks = 0; ks < 4; ++ks) {
            asm volatile("ds_read_b64_tr_b16 %0,%1 offset:%c2" : "=&v"(lo[ks]) : "v"(vb), "i"(d0 * 4096 + ks * 1024) : "memory");
            asm volatile("ds_read_b64_tr_b16 %0,%1 offset:%c2" : "=&v"(hi[ks]) : "v"(vb), "i"(d0 * 4096 + ks * 1024 + 512) : "memory"); }
        asm volatile("s_waitcnt lgkmcnt(0)" ::: "memory"); ATT_SBAR();
#define ATT_PK(k) (bf16x8){lo[k][0], lo[k][1], lo[k][2], lo[k][3], hi[k][0], hi[k][1], hi[k][2], hi[k][3]}
        o[d0] = __builtin_amdgcn_mfma_f32_32x32x16_bf16(pa0, ATT_PK(0), o[d0], 0, 0, 0);
        o[d0] = __builtin_amdgcn_mfma_f32_32x32x16_bf16(pa1, ATT_PK(1), o[d0], 0, 0, 0);
        o[d0] = __builtin_amdgcn_mfma_f32_32x32x16_bf16(pa2, ATT_PK(2), o[d0], 0, 0, 0);
        o[d0] = __builtin_amdgcn_mfma_f32_32x32x16_bf16(pa3, ATT_PK(3), o[d0], 0, 0, 0);
#undef ATT_PK
    }
}
template <int ND0, int THR, bool REL> __device__ __forceinline__ void softmax_tile(f32x16& p0, f32x16& p1, float& mrun, float& lsum, f32x16& negm, bool first, f32x16* o, __attribute__((address_space(3))) float* wsf, int r32, int hi,
                                                                   u32x4& pw0, u32x4& pw1, u32x4& pw2, u32x4& pw3) {
    float rm = rowmax32(p0, p1);
    if (!REL) rm -= mrun;
    if (first) {
        mrun = REL ? rm : mrun + rm;
        if (REL) {
#pragma unroll
            for (int r = 0; r < 16; ++r) { p0[r] -= rm; p1[r] -= rm; negm[r] = -mrun; } }
    } else if (__any(rm > (float)THR)) {
        const float dl = fmaxf(rm, 0.f), alpha = __builtin_amdgcn_exp2f(-dl); lsum *= alpha; mrun += dl;
        if (REL) {
#pragma unroll
            for (int r = 0; r < 16; ++r) { p0[r] -= dl; p1[r] -= dl; negm[r] = -mrun; } }
        if (hi == 0) wsf[r32] = alpha;
        ATT_LDSWAIT();
#pragma unroll
        for (int g = 0; g < 4; ++g) { const f32x4 a4 = *(const __attribute__((address_space(3))) f32x4*)(wsf + 8 * g + 4 * hi);
#pragma unroll
            for (int d0 = 0; d0 < ND0; ++d0) { o[d0][4 * g + 0] *= a4[0]; o[d0][4 * g + 1] *= a4[1]; o[d0][4 * g + 2] *= a4[2]; o[d0][4 * g + 3] *= a4[3]; } }
        ATT_LDSWAIT();
    }
    float s = 0.f;
#pragma unroll
    for (int r = 0; r < 16; ++r) { p0[r] = __builtin_amdgcn_exp2f(REL ? p0[r] : p0[r] - mrun); p1[r] = __builtin_amdgcn_exp2f(REL ? p1[r] : p1[r] - mrun); s += p0[r] + p1[r]; }
    lsum += s;
    pw0 = (u32x4){cvtpk(p0[0], p0[1]), cvtpk(p0[2], p0[3]), cvtpk(p0[4], p0[5]), cvtpk(p0[6], p0[7])};
    pw1 = (u32x4){cvtpk(p0[8], p0[9]), cvtpk(p0[10], p0[11]), cvtpk(p0[12], p0[13]), cvtpk(p0[14], p0[15])};
    pw2 = (u32x4){cvtpk(p1[0], p1[1]), cvtpk(p1[2], p1[3]), cvtpk(p1[4], p1[5]), cvtpk(p1[6], p1[7])};
    pw3 = (u32x4){cvtpk(p1[8], p1[9]), cvtpk(p1[10], p1[11]), cvtpk(p1[12], p1[13]), cvtpk(p1[14], p1[15])};
}

constexpr int A_SLOTK = 8192, A_SLOTV = 16384, A_NS = 3, A_NSV = 4;
constexpr int A_LDS_K = 0, A_LDS_V = A_NS * A_SLOTK, A_LDS_WS = A_LDS_V + A_NSV * A_SLOTV, A_LDS_ST = A_LDS_WS + 8 * 256, A_LDS_BYTES = A_LDS_ST + 8 * 8192;
__device__ __forceinline__ void attn_a_unit(int b, int h, int qb, const bf16_t* proj, bf16_t* ya, const float* subln, float lam, unsigned char* shm) {
    int tid_l = threadIdx.x; asm volatile("" : "+v"(tid_l));
    const int tid = tid_l, lane = tid & 63, r32 = lane & 31, hi = lane >> 5; const int wid = __builtin_amdgcn_readfirstlane(tid >> 6);
    const size_t rowbase = (size_t)b * SEQ; const int q0 = qb * 256;
    constexpr int NT = SEQ / 64;
    const unsigned lds0 = (unsigned)(uintptr_t)shm;
    const lds_cptr shm3 = (lds_cptr)shm;
    __attribute__((address_space(3))) float* wsf = (__attribute__((address_space(3))) float*)((lds_ptr)shm + A_LDS_WS) + wid * 64;
    const int vb0 = (int)(lds0 + A_LDS_V) + ((lane >> 4) & 1) * 32 + (lane & 3) * 8 + (4 * hi + ((lane & 15) >> 2)) * 64;
    __attribute__((address_space(3))) bf16_t* stg = (__attribute__((address_space(3))) bf16_t*)((lds_ptr)shm + A_LDS_ST) + wid * 4096;
    for (int mp = 0; mp < 2; ++mp) {
        const bf16_t* Kh = proj + rowbase * INW + C_KA + h * 128 + mp * 64;
        const bf16_t* Vh = proj + rowbase * INW + C_VA + h * 128;
        const bf16_t* Qw = proj + (rowbase + q0 + wid * 32) * INW + C_QA + h * 128 + mp * 64;
        const int pA = 2 * wid, pB = 2 * wid + 1;
        const unsigned kdst = lds0 + A_LDS_K + wid * 1024, vdstA = lds0 + A_LDS_V + pA * 1024, vdstB = lds0 + A_LDS_V + pB * 1024;
#define A_DMA(t, slot, vsl) do { int ln_ = lane; asm volatile("" : "+v"(ln_)); \
        const bf16_t* ksrc_ = Kh + (size_t)((t) * 64 + ln_) * INW + wid * 8; \
        const bf16_t* vsrcA_ = Vh + (size_t)((t) * 64 + 16 * (pA & 3) + (ln_ >> 2)) * INW + (pA >> 2) * 32 + (ln_ & 3) * 8; \
        const bf16_t* vsrcB_ = Vh + (size_t)((t) * 64 + 16 * (pB & 3) + (ln_ >> 2)) * INW + (pB >> 2) * 32 + (ln_ & 3) * 8; \
        glds16(ksrc_, (unsigned)__builtin_amdgcn_readfirstlane(kdst + (slot) * A_SLOTK)); \
        glds16(vsrcA_, (unsigned)__builtin_amdgcn_readfirstlane(vdstA + (vsl) * A_SLOTV)); \
        glds16(vsrcB_, (unsigned)__builtin_amdgcn_readfirstlane(vdstB + (vsl) * A_SLOTV)); } while (0)
        A_DMA(0, 0, 0); A_DMA(1, 1, 1);
        bf16x8 qr[4];
#pragma unroll
        for (int d0 = 0; d0 < 4; ++d0) qr[d0] = *(const bf16x8*)(Qw + (size_t)r32 * INW + d0 * 16 + hi * 8);
        f32x16 o[4]; o[0] = f32x16{}; o[1] = f32x16{}; o[2] = f32x16{}; o[3] = f32x16{};
        float mrun = 0.f, lsum = 0.f; f32x16 negm = f32x16{};
        int slot = 0, slot2 = 2, vslot = 0, vslot2 = 2, vprev = 3;
        const bool late = wid >= 4;
        u32x4 pw0 = {}, pw1 = {}, pw2 = {}, pw3 = {};
        for (int t = 0; t < NT; ++t) {
            if (t + 1 < NT) { ATT_WAIT_BAR(3); } else { ATT_WAIT_BAR(0); }
            if (t + 2 < NT) A_DMA(t + 2, slot2, vslot2);
            if (late && t > 0) pv<4>(o, vb0 + vprev * A_SLOTV, __builtin_bit_cast(bf16x8, pw0), __builtin_bit_cast(bf16x8, pw1), __builtin_bit_cast(bf16x8, pw2), __builtin_bit_cast(bf16x8, pw3));
            f32x16 p0, p1;
            qkt<false>(p0, p1, shm3 + A_LDS_K + slot * A_SLOTK, qr, negm, r32, hi);
            softmax_tile<4, 8, false>(p0, p1, mrun, lsum, negm, t == 0, o, wsf, r32, hi, pw0, pw1, pw2, pw3);
            if (!late) pv<4>(o, vb0 + vslot * A_SLOTV, __builtin_bit_cast(bf16x8, pw0), __builtin_bit_cast(bf16x8, pw1), __builtin_bit_cast(bf16x8, pw2), __builtin_bit_cast(bf16x8, pw3));
            slot = (slot == 2) ? 0 : slot + 1; slot2 = (slot2 == 2) ? 0 : slot2 + 1;
            vprev = vslot; vslot = (vslot + 1) & 3; vslot2 = (vslot2 + 1) & 3;
        }
        if (late) pv<4>(o, vb0 + vprev * A_SLOTV, __builtin_bit_cast(bf16x8, pw0), __builtin_bit_cast(bf16x8, pw1), __builtin_bit_cast(bf16x8, pw2), __builtin_bit_cast(bf16x8, pw3));
#undef A_DMA
        const float lt = halfsum(lsum);
        if (hi == 0) wsf[32 + r32] = lt;
        ATT_LDSWAIT();
        float rli[16];
#pragma unroll
        for (int g = 0; g < 4; ++g) { const f32x4 l4 = *(const __attribute__((address_space(3))) f32x4*)(wsf + 32 + 8 * g + 4 * hi);
            rli[4 * g + 0] = __builtin_amdgcn_rcpf(l4[0]); rli[4 * g + 1] = __builtin_amdgcn_rcpf(l4[1]); rli[4 * g + 2] = __builtin_amdgcn_rcpf(l4[2]); rli[4 * g + 3] = __builtin_amdgcn_rcpf(l4[3]); }
        ATT_LDSWAIT();
        if (mp == 0) {
#pragma unroll
            for (int d0 = 0; d0 < 4; ++d0)
#pragma unroll
                for (int r = 0; r < 16; ++r) stg[crow(r, hi) * 128 + d0 * 32 + r32] = (bf16_t)f2bf(o[d0][r] * rli[r]);
            asm volatile("s_waitcnt lgkmcnt(0)\n\ts_barrier" ::: "memory");
        } else {
            float ss[16];
#pragma unroll
            for (int r = 0; r < 16; ++r) ss[r] = 0.f;
#pragma unroll
            for (int d0 = 0; d0 < 4; ++d0)
#pragma unroll
                for (int r = 0; r < 16; ++r) { const float a = bf2f(stg[crow(r, hi) * 128 + d0 * 32 + r32]); const float y = a - lam * o[d0][r] * rli[r]; o[d0][r] = y; ss[r] += y * y; }
#pragma unroll
            for (int r = 0; r < 16; ++r) { float v = ss[r]; v += __shfl_xor(v, 1); v += __shfl_xor(v, 2); v += __shfl_xor(v, 4); v += __shfl_xor(v, 8); v += __shfl_xor(v, 16);
                ss[r] = 0.8f / sqrtf(v * (1.f / 128.f) + EPS); }
            ATT_LDSWAIT();
#pragma unroll
            for (int d0 = 0; d0 < 4; ++d0) { const float gsub = subln[d0 * 32 + r32];
#pragma unroll
                for (int r = 0; r < 16; ++r) stg[crow(r, hi) * 128 + d0 * 32 + r32] = (bf16_t)f2bf(o[d0][r] * ss[r] * gsub); }
            ATT_LDSWAIT();
            bf16_t* Yw = ya + (rowbase + q0 + wid * 32) * 1024 + h * 128;
#pragma unroll
            for (int i = 0; i < 8; ++i) { const int row = i * 4 + (lane >> 4), ch = lane & 15; const u32x4 v = *(const __attribute__((address_space(3))) u32x4*)(stg + row * 128 + ch * 8); *(u32x4*)(Yw + (size_t)row * 1024 + ch * 8) = v; }
            asm volatile("s_waitcnt lgkmcnt(0)\n\ts_barrier" ::: "memory");
        }
    }
}

constexpr int B_SLOT = 8192, B_NS = 6, B_PF = 5;
constexpr int B_LDS_K = 0, B_LDS_V = B_NS * B_SLOT, B_LDS_WS = 2 * B_NS * B_SLOT, B_LDS_BIAS = B_LDS_WS + 8 * 256, B_LDS_ST = B_LDS_BIAS + 2560, B_LDS_BYTES = B_LDS_ST + 8 * 4096;
__device__ __forceinline__ void attn_b_unit(int b, int h, int rg, const bf16_t* proj, bf16_t* yb, const float* rpb, unsigned char* shm) {
    int tid_l = threadIdx.x; asm volatile("" : "+v"(tid_l));
    const int tid = tid_l, lane = tid & 63, r32 = lane & 31, hi = lane >> 5; const int wid = __builtin_amdgcn_readfirstlane(tid >> 6);
    const size_t rowbase = (size_t)b * SEQ;
    const int r = 4 * rg + (wid >> 1), c0 = 32 * (wid & 1);
    int rs = r - 4; rs = rs < 0 ? 0 : (rs > 24 ? 24 : rs);
    int rmin = 4 * rg - 4; rmin = rmin < 0 ? 0 : (rmin > 24 ? 24 : rmin);
    int rmaxs = 4 * rg + 3 - 4; rmaxs = rmaxs < 0 ? 0 : (rmaxs > 24 ? 24 : rmaxs);
    const int ntile = rmaxs + 8 - rmin;
    const unsigned lds0 = (unsigned)(uintptr_t)shm;
    const lds_cptr shm3 = (lds_cptr)shm;
    __attribute__((address_space(3))) float* wsf = (__attribute__((address_space(3))) float*)((lds_ptr)shm + B_LDS_WS) + wid * 64;
    __attribute__((address_space(3))) float* bias = (__attribute__((address_space(3))) float*)((lds_ptr)shm + B_LDS_BIAS) + 64;
    __attribute__((address_space(3))) bf16_t* stg = (__attribute__((address_space(3))) bf16_t*)((lds_ptr)shm + B_LDS_ST) + wid * 2048;
    const int vb0 = (int)(lds0 + B_LDS_V) + ((lane >> 4) & 1) * 32 + (lane & 3) * 8 + (4 * hi + ((lane & 15) >> 2)) * 64;
    for (int i = tid; i < 640; i += 512) { const int e = i - 64, ri = e >> 5, cj = e & 31; bias[e] = (e >= 0 && e < 480 && cj < 31) ? rpb[(h * 15 + ri) * 31 + cj] * LOG2E : 0.f; }
    const bf16_t* Kh = proj + rowbase * INW + C_KB + h * 64;
    const bf16_t* Vh = proj + rowbase * INW + C_VB + h * 64;
    const bf16_t* Qw = proj + (rowbase + r * 64 + c0) * INW + C_QB + h * 64;
    const unsigned kdst = lds0 + B_LDS_K + wid * 1024, vdst = lds0 + B_LDS_V + wid * 1024;
#define B_DMA(t, slot) do { int ln_ = lane; asm volatile("" : "+v"(ln_)); \
    const bf16_t* ksrc_ = Kh + (size_t)((rmin + (t)) * 64 + ln_) * INW + wid * 8; \
    const bf16_t* vsrc_ = Vh + (size_t)((rmin + (t)) * 64 + 16 * (wid & 3) + (ln_ >> 2)) * INW + (wid >> 2) * 32 + (ln_ & 3) * 8; \
    glds16(ksrc_, (unsigned)__builtin_amdgcn_readfirstlane(kdst + (slot) * B_SLOT)); \
    glds16(vsrc_, (unsigned)__builtin_amdgcn_readfirstlane(vdst + (slot) * B_SLOT)); } while (0)
#pragma unroll
    for (int t = 0; t < B_PF; ++t) B_DMA(t, t);
    bf16x8 qr[4];
#pragma unroll
    for (int d0 = 0; d0 < 4; ++d0) qr[d0] = *(const bf16x8*)(Qw + (size_t)r32 * INW + d0 * 16 + hi * 8);
    f32x16 o[2]; o[0] = f32x16{}; o[1] = f32x16{};
    float mrun = 0.f, lsum = 0.f; f32x16 negm = f32x16{}; bool first = true;
    const int c = c0 + r32; int cs = c - 8; cs = cs < 0 ? 0 : (cs > 48 ? 48 : cs);
    float fm0[16], fm1[16];
#pragma unroll
    for (int rr = 0; rr < 16; ++rr) { const int j0 = crow(rr, hi); fm0[rr] = ((unsigned)(j0 - cs) < 16u) ? 0.f : -1e30f; fm1[rr] = ((unsigned)(j0 + 32 - cs) < 16u) ? 0.f : -1e30f; }
    int slot = 0, slotn = B_PF;
    for (int t = 0; t < ntile; ++t) {
        { const int rem = ntile - 1 - t;
          if (rem >= 4) { ATT_WAIT_BAR(8); } else if (rem == 3) { ATT_WAIT_BAR(6); } else if (rem == 2) { ATT_WAIT_BAR(4); } else if (rem == 1) { ATT_WAIT_BAR(2); } else { ATT_WAIT_BAR(0); } }
        if (t + B_PF < ntile) B_DMA(t + B_PF, slotn);
        const int kr = rmin + t;
        if (kr >= rs && kr < rs + 8) {
            f32x16 p0, p1; u32x4 pw0, pw1, pw2, pw3;
            qkt<true>(p0, p1, shm3 + B_LDS_K + slot * B_SLOT, qr, negm, r32, hi);
            const __attribute__((address_space(3))) float* bp = bias + ((kr - r + 7) * 32 + 15 - c + 4 * hi);
#pragma unroll
            for (int rr = 0; rr < 16; ++rr) { const int jj = (rr & 3) + 8 * (rr >> 2);
                p0[rr] += bp[jj] + fm0[rr]; p1[rr] += bp[jj + 32] + fm1[rr]; }
            softmax_tile<2, 8, true>(p0, p1, mrun, lsum, negm, first, o, wsf, r32, hi, pw0, pw1, pw2, pw3); first = false;
            pv<2>(o, vb0 + slot * B_SLOT, __builtin_bit_cast(bf16x8, pw0), __builtin_bit_cast(bf16x8, pw1), __builtin_bit_cast(bf16x8, pw2), __builtin_bit_cast(bf16x8, pw3));
        }
        slot = (slot == B_NS - 1) ? 0 : slot + 1; slotn = (slotn == B_NS - 1) ? 0 : slotn + 1;
    }
#undef B_DMA
    const float lt = halfsum(lsum);
    if (hi == 0) wsf[32 + r32] = lt;
    ATT_LDSWAIT();
    float rli[16];
#pragma unroll
    for (int g = 0; g < 4; ++g) { const f32x4 l4 = *(const __attribute__((address_space(3))) f32x4*)(wsf + 32 + 8 * g + 4 * hi);
        rli[4 * g + 0] = __builtin_amdgcn_rcpf(l4[0]); rli[4 * g + 1] = __builtin_amdgcn_rcpf(l4[1]); rli[4 * g + 2] = __builtin_amdgcn_rcpf(l4[2]); rli[4 * g + 3] = __builtin_amdgcn_rcpf(l4[3]); }
#pragma unroll
    for (int d0 = 0; d0 < 2; ++d0)
#pragma unroll
        for (int rr = 0; rr < 16; ++rr) stg[crow(rr, hi) * 64 + d0 * 32 + r32] = (bf16_t)f2bf(o[d0][rr] * rli[rr]);
    ATT_LDSWAIT();
    bf16_t* Yw = yb + (rowbase + r * 64 + c0) * 1024 + 512 + h * 64;
#pragma unroll
    for (int i = 0; i < 4; ++i) { const int row = i * 8 + (lane >> 3), ch = lane & 7; const u32x4 v = *(const __attribute__((address_space(3))) u32x4*)(stg + row * 64 + ch * 8); *(u32x4*)(Yw + (size_t)row * 1024 + ch * 8) = v; }
    asm volatile("s_waitcnt lgkmcnt(0)\n\ts_barrier" ::: "memory");
}
}

namespace peer {
typedef short bf16x8 __attribute__((ext_vector_type(8)));
typedef float f32x16 __attribute__((ext_vector_type(16)));
typedef __attribute__((address_space(3))) const char* lds_cptr;
constexpr int T_LDS_SK = 0, T_LDS_BYTES = 65536;
__device__ __forceinline__ int imax(int a, int b) { int r; asm("v_max_f32 %0, %1, %2" : "=v"(r) : "v"(a), "v"(b)); return r; }
__device__ __forceinline__ int imin(int a, int b) { int r; asm("v_min_f32 %0, %1, %2" : "=v"(r) : "v"(a), "v"(b)); return r; }
__device__ __forceinline__ int f2key(float s, int idx) { return (__float_as_int(s) & ~127) | idx; }
__device__ __forceinline__ int key2bits(int k) { return k; }
template <int N, int OFF, int TOT> __device__ __forceinline__ void bsort_desc(int (&a)[TOT]) {
#pragma unroll
    for (int k = 2; k <= N; k <<= 1)
#pragma unroll
        for (int j = k >> 1; j > 0; j >>= 1)
#pragma unroll
            for (int i = 0; i < N; ++i) { const int l = i ^ j; if (l > i) { const bool desc = (i & k) == 0; const int hi_ = imax(a[OFF + i], a[OFF + l]), lo_ = imin(a[OFF + i], a[OFF + l]); a[OFF + i] = desc ? hi_ : lo_; a[OFF + l] = desc ? lo_ : hi_; } }
}
template <int N, int OFF, int TOT> __device__ __forceinline__ void bmerge_desc(int (&a)[TOT]) {
#pragma unroll
    for (int j = N >> 1; j > 0; j >>= 1)
#pragma unroll
        for (int i = 0; i < N; ++i) { const int l = i ^ j; if (l > i) { const int hi_ = imax(a[OFF + i], a[OFF + l]), lo_ = imin(a[OFF + i], a[OFF + l]); a[OFF + i] = hi_; a[OFF + l] = lo_; } }
}
template <int A, int B, int TOT> __device__ __forceinline__ void merge_top16(int (&a)[TOT]) {
#pragma unroll
    for (int i = 0; i < 16; ++i) a[A + i] = imax(a[A + i], a[B + 15 - i]);
    bmerge_desc<16, A, TOT>(a);
}
__device__ __forceinline__ void cross_top16(int (&t)[16]) {
    int lo[16], hi[16];
#pragma unroll
    for (int i = 0; i < 16; ++i) { auto rr = __builtin_amdgcn_permlane32_swap((unsigned)t[i], (unsigned)t[i], false, false); lo[i] = (int)rr[0]; hi[i] = (int)rr[1]; }
#pragma unroll
    for (int i = 0; i < 16; ++i) t[i] = imax(lo[i], hi[15 - i]);
    bmerge_desc<16, 0, 16>(t);
}
__device__ __forceinline__ void half_top16(int (&top)[16], const bf16_t* qrow  , lds_cptr skp  , int hi) {
    f32x16 sc[4]; sc[0] = f32x16{}; sc[1] = f32x16{}; sc[2] = f32x16{}; sc[3] = f32x16{};
    bf16x8 qf[8];
#pragma unroll
    for (int ks = 0; ks < 8; ++ks) qf[ks] = *(const bf16x8*)(qrow + ks * 16);
#pragma unroll
    for (int ks = 0; ks < 8; ++ks)
#pragma unroll
        for (int kt = 0; kt < 4; ++kt) { const bf16x8 af = *(const __attribute__((address_space(3))) bf16x8*)(skp + ks * 4096 + kt * 512);
            sc[kt] = __builtin_amdgcn_mfma_f32_32x32x16_bf16(af, qf[ks], sc[kt], 0, 0, 0); }
    int k[64];
#pragma unroll
    for (int kt = 0; kt < 4; ++kt)
#pragma unroll
        for (int r = 0; r < 16; ++r) k[kt * 16 + r] = f2key(sc[kt][r], (32 * kt + (r & 3) + 8 * (r >> 2)) | (4 * hi));
    bsort_desc<16, 0, 64>(k); bsort_desc<16, 16, 64>(k); bsort_desc<16, 32, 64>(k); bsort_desc<16, 48, 64>(k);
    merge_top16<0, 16, 64>(k); merge_top16<32, 48, 64>(k); merge_top16<0, 32, 64>(k);
#pragma unroll
    for (int i = 0; i < 16; ++i) top[i] = k[i];
    cross_top16(top);
}
__device__ __forceinline__ void topk_wave(int tok0, int h, const bf16_t* Q, int* IDX, float* Gt, lds_cptr sk, int lane) {
    const int r32 = lane & 31, hi = lane >> 5, tok = tok0 + r32;
    const bf16_t* qrow = Q + (size_t)tok * PQ + h * 256 + 8 * hi;
    lds_cptr skl = sk + hi * 2048 + r32 * 16;
    int A0[16], A1[16];
    half_top16(A0, qrow, skl, hi);
    half_top16(A1, qrow + 128, skl + 32768, hi);
    float x[16], y[16]; int xw[16], yw[16];
#pragma unroll
    for (int a = 0; a < 16; ++a) { const int b0 = key2bits(A0[a]), b1 = key2bits(A1[a]);
        const float v0 = __int_as_float(b0 & ~127), v1 = __int_as_float(b1 & ~127); const int i0 = (b0 & 127) << 7, i1 = b1 & 127;
        x[a] = hi ? v1 : v0; y[a] = hi ? v0 : v1; xw[a] = hi ? i1 : i0; yw[a] = hi ? i0 : i1; }
    int w[32]; int n = 0;
#define PEER_CAND(a, b) do { const int bits = __float_as_int(x[a] + y[b]); int ww = (bits & ~0x3FFF) | (xw[a] + yw[b]); \
        if ((a) == (b) && hi) ww = (int)0xFF800000; w[n] = ww; ++n; } while (0)
#pragma unroll
    for (int b = 0; b < 16; ++b) PEER_CAND(0, b);
#pragma unroll
    for (int b = 1; b < 8; ++b) PEER_CAND(1, b);
#pragma unroll
    for (int b = 2; b < 5; ++b) PEER_CAND(2, b);
    PEER_CAND(3, 3);
#undef PEER_CAND
#pragma unroll
    for (int i = 27; i < 32; ++i) w[i] = (int)0xFF800000;
    bsort_desc<32, 0, 32>(w);
    int T[16];
#pragma unroll
    for (int i = 0; i < 16; ++i) T[i] = w[i];
    cross_top16(T);
    float sv[16]; int ev[16];
#pragma unroll
    for (int j = 0; j < 16; ++j) { ev[j] = T[j] & 0x3FFF; sv[j] = __int_as_float(T[j] & ~0x3FFF); }
    const float s0 = sv[0]; float esum = 0.f;
#pragma unroll
    for (int j = 0; j < 16; ++j) { sv[j] = __expf(sv[j] - s0); esum += sv[j]; }
    const float inv = 1.f / esum;
    if (hi == 0) { u32x4* io = (u32x4*)(IDX + ((size_t)tok * 8 + h) * 16);
#pragma unroll
        for (int j = 0; j < 4; ++j) io[j] = (u32x4){(unsigned)ev[4 * j], (unsigned)ev[4 * j + 1], (unsigned)ev[4 * j + 2], (unsigned)ev[4 * j + 3]}; }
    else { f32x4* go = (f32x4*)(Gt + ((size_t)tok * 8 + h) * 16);
#pragma unroll
        for (int j = 0; j < 4; ++j) go[j] = (f32x4){sv[4 * j] * inv, sv[4 * j + 1] * inv, sv[4 * j + 2] * inv, sv[4 * j + 3] * inv}; }
}
template <class Sched> __device__ __forceinline__ void topk_own_units(const Ptrs& P, unsigned char* shm, const Sched& S) {
    int tid_l = threadIdx.x; asm volatile("" : "+v"(tid_l));
    const int tid = tid_l, lane = tid & 63; const int wid = __builtin_amdgcn_readfirstlane(tid >> 6);
    const unsigned lds0 = (unsigned)(uintptr_t)shm;
    const bf16_t* SKg = (const bf16_t*)(P.ws + WS_SK);
    int hprev = -1; pg8::Unit u;
    for (int i = 0; S.next(i, u); ++i) {
        const int h = u.pn, tg = u.pm;
        if (h != hprev) { hprev = h;
            asm volatile("s_waitcnt lgkmcnt(0)\n\ts_barrier" ::: "memory");
#pragma unroll
            for (int j = 0; j < 8; ++j) { const int piece = wid * 8 + j, p = piece >> 5, c = (piece >> 1) & 15, kh = piece & 1;
                att::glds16(SKg + ((size_t)((h * 2 + p) * 128 + kh * 64 + lane) * 128 + c * 8), (unsigned)__builtin_amdgcn_readfirstlane(lds0 + p * 32768 + c * 2048 + kh * 1024)); }
            asm volatile("s_waitcnt vmcnt(0)\n\ts_barrier" ::: "memory");
        }
        topk_wave(tg * 256 + wid * 32, h, (const bf16_t*)(P.ws + WS_Q), (int*)(P.ws + WS_IDX), (float*)(P.ws + WS_G), (lds_cptr)shm, lane);
    }
}
}

namespace apply {
typedef float f32x2 __attribute__((ext_vector_type(2)));
typedef __attribute__((address_space(3))) unsigned* lds_u32p;
constexpr int AP_WAVE_BYTES = 4 * (512 + 2048), AP_LDS_BYTES = 8 * AP_WAVE_BYTES;
__device__ __forceinline__ float gelu_fast(float v) {
    const float av = fabsf(v), t = __builtin_amdgcn_rcpf(av * 0.2316418882f + 1.0f);
    float q = t * 0.5307027145f + (-0.7265760135f); q = q * t + 0.7107068705f; q = q * t + (-0.142248368f); q = q * t + 0.127414796f; q = q * t;
    const float e = __builtin_amdgcn_exp2f((v * v) * (-0.72134752044f));
    const float m = v * (q * e);
    return v < 0.f ? m : v - m;
}
#define AP_DPP(v, ctrl) __builtin_bit_cast(float, __builtin_amdgcn_update_dpp(0, __builtin_bit_cast(int, (v)), (ctrl), 0xF, 0xF, true))
__device__ __forceinline__ float row16_sum(float v) { v += AP_DPP(v, 0xB1); v += AP_DPP(v, 0x4E); v += AP_DPP(v, 0x141); v += AP_DPP(v, 0x140); return v; }
__device__ __forceinline__ void load_half(u32x4 (&r)[2], const unsigned char* img, unsigned e, int sub) {
    const unsigned off = e * 512u + (unsigned)(sub * 16);
    r[0] = *(const u32x4*)(img + off); r[1] = *(const u32x4*)(img + off + 256u);
}
constexpr int AP_PROBE_RING = 16;
constexpr int AP_RING = 8;
typedef __attribute__((address_space(3))) u32x4* lds_v4p;
template <int HF, int MODE, int RING> __device__ __forceinline__ void pass_u(const Ptrs& P, const bf16_t* hrow, float rstd, lds_v4p grp, u32x4 (&R)[RING][2], const unsigned char* img, const unsigned char* img_next, int sub) {
    unsigned xq[8]; float sx;
    {
        float xf[2][16]; float mx = 0.f;
#pragma unroll
        for (int i = 0; i < 2; ++i) { const int e0 = (sub + 16 * (2 * HF + i)) * 16;
#pragma unroll
            for (int q = 0; q < 4; ++q) { const u32x2 hb = *(const u32x2*)(hrow + e0 + 4 * q); const f32x4 gv = *(const f32x4*)(P.norm_ffn + e0 + 4 * q);
                xf[i][4 * q] = bflo(hb.x) * rstd * gv.x; xf[i][4 * q + 1] = bfhi(hb.x) * rstd * gv.y; xf[i][4 * q + 2] = bflo(hb.y) * rstd * gv.z; xf[i][4 * q + 3] = bfhi(hb.y) * rstd * gv.w;
                mx = fmaxf(fmaxf(mx, fmaxf(fabsf(xf[i][4 * q]), fabsf(xf[i][4 * q + 1]))), fmaxf(fabsf(xf[i][4 * q + 2]), fabsf(xf[i][4 * q + 3]))); } }
        mx = fmaxf(mx, AP_DPP(mx, 0xB1)); mx = fmaxf(mx, AP_DPP(mx, 0x4E)); mx = fmaxf(mx, AP_DPP(mx, 0x141)); mx = fmaxf(mx, AP_DPP(mx, 0x140));
        mx = fmaxf(mx, 1e-30f); sx = mx * (1.f / 127.f); const float qs = 127.f / mx;
#pragma unroll
        for (int i = 0; i < 2; ++i)
#pragma unroll
            for (int q = 0; q < 4; ++q) xq[4 * i + q] = pack_i8x4(xf[i][4 * q] * qs, xf[i][4 * q + 1] * qs, xf[i][4 * q + 2] * qs, xf[i][4 * q + 3] * qs);
    }
#pragma unroll 1
    for (int j = 0; j < 128; j += RING) {
        const int jn = (j + RING) & 127;
        __builtin_amdgcn_s_barrier();
        const unsigned char* tb = (j + RING < 128) ? img : img_next;
        unsigned nid[RING], part[RING], suv[RING], gsv[RING];
#pragma unroll
        for (int b4 = 0; b4 < RING / 4; ++b4) { const u32x4 na = grp[jn / 4 + b4];
            nid[4 * b4] = na.x; nid[4 * b4 + 1] = na.y; nid[4 * b4 + 2] = na.z; nid[4 * b4 + 3] = na.w;
            u32x4 pa = {}, sa = {}, ga = {};
            if (HF == 1) { pa = grp[96 + j / 4 + b4]; sa = grp[32 + j / 4 + b4]; ga = grp[64 + j / 4 + b4]; }
            part[4 * b4] = pa.x; part[4 * b4 + 1] = pa.y; part[4 * b4 + 2] = pa.z; part[4 * b4 + 3] = pa.w;
            suv[4 * b4] = sa.x; suv[4 * b4 + 1] = sa.y; suv[4 * b4 + 2] = sa.z; suv[4 * b4 + 3] = sa.w;
            gsv[4 * b4] = ga.x; gsv[4 * b4 + 1] = ga.y; gsv[4 * b4 + 2] = ga.z; gsv[4 * b4 + 3] = ga.w; }
        float outv[RING];
#pragma unroll
        for (int bq = 0; bq < RING; ++bq) {
            int d0_ = 0, d1_ = 0;
            if (MODE == 1) { asm volatile("" :: "v"(R[bq][0]), "v"(R[bq][1])); d0_ = (int)xq[0]; }
            else {
                d0_ = __builtin_amdgcn_sdot4((int)R[bq][0].x, (int)xq[0], d0_, false); d1_ = __builtin_amdgcn_sdot4((int)R[bq][0].y, (int)xq[1], d1_, false);
                d0_ = __builtin_amdgcn_sdot4((int)R[bq][0].z, (int)xq[2], d0_, false); d1_ = __builtin_amdgcn_sdot4((int)R[bq][0].w, (int)xq[3], d1_, false);
                d0_ = __builtin_amdgcn_sdot4((int)R[bq][1].x, (int)xq[4], d0_, false); d1_ = __builtin_amdgcn_sdot4((int)R[bq][1].y, (int)xq[5], d1_, false);
                d0_ = __builtin_amdgcn_sdot4((int)R[bq][1].z, (int)xq[6], d0_, false); d1_ = __builtin_amdgcn_sdot4((int)R[bq][1].w, (int)xq[7], d1_, false);
            }
            asm volatile("" ::: "memory");
            load_half(R[bq], tb, MODE == 2 ? (nid[bq] & 15u) : nid[bq], sub);
            asm volatile("" ::: "memory");
            float a_ = row16_sum((float)(d0_ + d1_)) * sx;
            if (HF == 1) { a_ = (a_ + __uint_as_float(part[bq])) * __uint_as_float(suv[bq]); a_ = __uint_as_float(gsv[bq]) * gelu_fast(a_); }
            outv[bq] = a_;
        }
        if (sub == 0) {
#pragma unroll
            for (int b4 = 0; b4 < RING / 4; ++b4) grp[96 + j / 4 + b4] = (u32x4){__float_as_uint(outv[4 * b4]), __float_as_uint(outv[4 * b4 + 1]), __float_as_uint(outv[4 * b4 + 2]), __float_as_uint(outv[4 * b4 + 3])}; }
    }
    asm volatile("s_waitcnt lgkmcnt(0)" ::: "memory");
}
template <int HF, int MODE, int RING> __device__ __forceinline__ void pass_v(float (&acc)[4][16], lds_v4p grp, u32x4 (&R)[RING][2], const unsigned char* img, const unsigned char* img_next, int sub) {
#pragma unroll 1
    for (int j = 0; j < 128; j += RING) {
        const int jn = (j + RING) & 127;
        __builtin_amdgcn_s_barrier();
        const unsigned char* tb = (j + RING < 128) ? img : img_next;
        unsigned nid[RING], cvv[RING];
#pragma unroll
        for (int b4 = 0; b4 < RING / 4; ++b4) { const u32x4 na = grp[jn / 4 + b4], ca = grp[96 + j / 4 + b4];
            nid[4 * b4] = na.x; nid[4 * b4 + 1] = na.y; nid[4 * b4 + 2] = na.z; nid[4 * b4 + 3] = na.w; cvv[4 * b4] = ca.x; cvv[4 * b4 + 1] = ca.y; cvv[4 * b4 + 2] = ca.z; cvv[4 * b4 + 3] = ca.w; }
#pragma unroll
        for (int bq = 0; bq < RING; ++bq) {
            const float c_ = __uint_as_float(cvv[bq]); const f32x2 c2 = {c_, c_};
            if (MODE == 1) { asm volatile("" :: "v"(R[bq][0]), "v"(R[bq][1])); acc[2 * HF][0] += c_; }
            else {
#pragma unroll
            for (int i = 0; i < 2; ++i) { const unsigned w_[4] = {R[bq][i].x, R[bq][i].y, R[bq][i].z, R[bq][i].w};
#pragma unroll
                for (int q = 0; q < 4; ++q) { const f32x2 lo_ = __builtin_amdgcn_cvt_pk_f32_fp8(w_[q], false), hi_ = __builtin_amdgcn_cvt_pk_f32_fp8(w_[q], true);
                    f32x2 a0 = {acc[2 * HF + i][4 * q], acc[2 * HF + i][4 * q + 1]}, a1 = {acc[2 * HF + i][4 * q + 2], acc[2 * HF + i][4 * q + 3]}; a0 += c2 * lo_; a1 += c2 * hi_;
                    acc[2 * HF + i][4 * q] = a0.x; acc[2 * HF + i][4 * q + 1] = a0.y; acc[2 * HF + i][4 * q + 2] = a1.x; acc[2 * HF + i][4 * q + 3] = a1.y; } }
            }
            asm volatile("" ::: "memory");
            load_half(R[bq], tb, MODE == 2 ? (nid[bq] & 15u) : nid[bq], sub);
            asm volatile("" ::: "memory");
        }
    }
}
template <int MODE> __device__ __forceinline__ void apply_round(const Ptrs& P, float* outbase, int tbase, unsigned char* shm_wave, int lane_in) {
    int lane = lane_in; asm volatile("" : "+v"(lane));
    const int sub = lane & 15, g = lane >> 4, t = tbase + g;
    __attribute__((address_space(3))) unsigned* cnt = (lds_u32p)(__attribute__((address_space(3))) unsigned char*)shm_wave + g * 128;
    lds_v4p grp = (lds_v4p)((__attribute__((address_space(3))) unsigned char*)shm_wave + 2048 + g * 2048);
    __attribute__((address_space(3))) unsigned* grp1 = (__attribute__((address_space(3))) unsigned*)grp;
    const unsigned char* U8 = P.ws + WS_U; const unsigned char* V8 = P.ws + WS_V;
    {
        const int* idxp = (const int*)(P.ws + WS_IDX) + (size_t)t * 128 + sub * 8; const float* gp = (const float*)(P.ws + WS_G) + (size_t)t * 128 + sub * 8;
        const u32x4 ia = *(const u32x4*)idxp, ib = *(const u32x4*)(idxp + 4); const f32x4 ga = *(const f32x4*)gp, gb = *(const f32x4*)(gp + 4);
        const int e[8] = {(int)ia.x, (int)ia.y, (int)ia.z, (int)ia.w, (int)ib.x, (int)ib.y, (int)ib.z, (int)ib.w};
        const float gt[8] = {ga.x, ga.y, ga.z, ga.w, gb.x, gb.y, gb.z, gb.w};
        float su[8], sv[8];
#pragma unroll
        for (int i = 0; i < 8; ++i) { su[i] = ((const float*)(P.ws + WS_SU))[e[i]]; sv[i] = ((const float*)(P.ws + WS_SV))[e[i]]; }
#pragma unroll
        for (int i = 0; i < 8; ++i) cnt[sub * 8 + i] = 0u;
        asm volatile("s_waitcnt lgkmcnt(0)" ::: "memory");
        unsigned pos[8];
#pragma unroll
        for (int i = 0; i < 8; ++i) pos[i] = __hip_atomic_fetch_add(cnt + (e[i] >> 7), 1u, __ATOMIC_RELAXED, __HIP_MEMORY_SCOPE_WAVEFRONT);
        asm volatile("s_waitcnt lgkmcnt(0)" ::: "memory");
        unsigned c[8]; unsigned tot = 0;
#pragma unroll
        for (int i = 0; i < 8; ++i) { c[i] = cnt[sub * 8 + i]; }
#pragma unroll
        for (int i = 0; i < 8; ++i) { const unsigned x = c[i]; c[i] = tot; tot += x; }
        unsigned inc = tot;
#pragma unroll
        for (int d = 1; d < 16; d <<= 1) { const unsigned y = __shfl_up(inc, d, 16); if (sub >= d) inc += y; }
        const unsigned base = inc - tot;
        asm volatile("s_waitcnt lgkmcnt(0)" ::: "memory");
#pragma unroll
        for (int i = 0; i < 8; ++i) cnt[sub * 8 + i] = base + c[i];
        asm volatile("s_waitcnt lgkmcnt(0)" ::: "memory");
#pragma unroll
        for (int i = 0; i < 8; ++i) { const unsigned p = cnt[e[i] >> 7] + pos[i];
            grp1[p] = (unsigned)e[i]; grp1[128 + p] = __float_as_uint(su[i]); grp1[256 + p] = __float_as_uint(gt[i] * sv[i]); }
        asm volatile("s_waitcnt lgkmcnt(0)" ::: "memory");
    }
    const bf16_t* hrow = (const bf16_t*)(P.ws + WS_HB) + (size_t)t * D;
    float rstd;
    { const float* ssq = (const float*)(P.ws + WS_SSQ) + (size_t)t * 16;
      const f32x4 s0 = *(const f32x4*)ssq, s1 = *(const f32x4*)(ssq + 4), s2 = *(const f32x4*)(ssq + 8), s3 = *(const f32x4*)(ssq + 12);
      const float tot = ((s0.x + s0.y) + (s0.z + s0.w)) + ((s1.x + s1.y) + (s1.z + s1.w)) + ((s2.x + s2.y) + (s2.z + s2.w)) + ((s3.x + s3.y) + (s3.z + s3.w));
      rstd = 1.f / sqrtf(tot * (1.f / D) + EPS); }
    constexpr int RG = (MODE == 1) ? AP_PROBE_RING : AP_RING;
    const unsigned char* U0 = U8; const unsigned char* U1 = U8 + (size_t)NEXP * 512; const unsigned char* V0 = V8; const unsigned char* V1 = V8 + (size_t)NEXP * 512;
    u32x4 R[RG][2];
    {
#pragma unroll
      for (int b4 = 0; b4 < RG / 4; ++b4) { const u32x4 ia = grp[b4]; load_half(R[4 * b4], U0, ia.x, sub); load_half(R[4 * b4 + 1], U0, ia.y, sub); load_half(R[4 * b4 + 2], U0, ia.z, sub); load_half(R[4 * b4 + 3], U0, ia.w, sub); } }
    pass_u<0, MODE, RG>(P, hrow, rstd, grp, R, U0, U1, sub);
    pass_u<1, MODE, RG>(P, hrow, rstd, grp, R, U1, V0, sub);
    float acc[4][16];
#pragma unroll
    for (int i = 0; i < 4; ++i)
#pragma unroll
        for (int q = 0; q < 16; ++q) acc[i][q] = 0.f;
    pass_v<0, MODE, RG>(acc, grp, R, V0, V1, sub);
    pass_v<1, MODE, RG>(acc, grp, R, V1, V1, sub);
    float ss = 0.f;
#pragma unroll
    for (int i = 0; i < 4; ++i) { const int e0 = (sub + 16 * i) * 16;
#pragma unroll
        for (int q = 0; q < 4; ++q) { const u32x2 hb = *(const u32x2*)(hrow + e0 + 4 * q);
            acc[i][4 * q] += bflo(hb.x); acc[i][4 * q + 1] += bfhi(hb.x); acc[i][4 * q + 2] += bflo(hb.y); acc[i][4 * q + 3] += bfhi(hb.y);
            ss += (acc[i][4 * q] * acc[i][4 * q] + acc[i][4 * q + 1] * acc[i][4 * q + 1]) + (acc[i][4 * q + 2] * acc[i][4 * q + 2] + acc[i][4 * q + 3] * acc[i][4 * q + 3]); }
        asm volatile("" ::: "memory"); }
    ss = row16_sum(ss);
    const float r2 = 1.f / sqrtf(ss * (1.f / D) + EPS);
    float* orow = outbase + (size_t)t * D;
#pragma unroll
    for (int i = 0; i < 4; ++i) { const int e0 = (sub + 16 * i) * 16;
#pragma unroll
        for (int q = 0; q < 4; ++q) { const f32x4 gv = *(const f32x4*)(P.norm_final + e0 + 4 * q);
            *(f32x4*)(orow + e0 + 4 * q) = (f32x4){acc[i][4 * q] * r2 * gv.x, acc[i][4 * q + 1] * r2 * gv.y, acc[i][4 * q + 2] * r2 * gv.z, acc[i][4 * q + 3] * r2 * gv.w}; }
        asm volatile("" ::: "memory"); }
}
template <int MODE> __device__ __forceinline__ void apply_phase(const Ptrs& P, float* outbase, unsigned char* shm, int G, int vcu) {
    int tid_l = threadIdx.x; asm volatile("" : "+v"(tid_l));
    const int lane = tid_l & 63; const int wave = __builtin_amdgcn_readfirstlane(tid_l >> 6);
    const int per = M / (G * 8);
#pragma unroll 1
    for (int r = 0; r < per; r += 4) apply_round<MODE>(P, outbase, (vcu * 8 + wave) * per + r, shm + wave * AP_WAVE_BYTES, lane);
}
}

#define LAS __attribute__((address_space(3)))
#define XB_TMO      128
#define XB_XCNT(j)  (256  + 64 * (j))
#define XB_XSUB(j)  (1280 + 64 * (j))
#define XB_XGEN(j)  (2304 + 64 * (j))
#define XB_TOP      3328
#define XB_TOPGEN   3392
#define XCD_BAR_WORDS 3456
#define XB_SPIN_CAP (1u << 18)

__device__ __forceinline__ unsigned xb_ld(unsigned* p)              { return __hip_atomic_load(p, __ATOMIC_RELAXED, __HIP_MEMORY_SCOPE_AGENT); }
__device__ __forceinline__ unsigned xb_add(unsigned* p, unsigned v) { return __hip_atomic_fetch_add(p, v, __ATOMIC_RELAXED, __HIP_MEMORY_SCOPE_AGENT); }
__device__ __forceinline__ unsigned xb_xcc_id() { return (unsigned)__builtin_amdgcn_s_getreg((3 << 11) | 20) & 0xFu; }
#define XB_SPIN(cond, bar) do { unsigned _sp = 0; while (cond) { __builtin_amdgcn_s_sleep(1); \
    if ((++_sp & 255u) == 0u) { if (xb_ld(&(bar)[XB_TMO])) break; if (_sp > XB_SPIN_CAP) { atomicAdd(&(bar)[XB_TMO], 1u); break; } } } } while (0)

struct XcdBarrier {
    unsigned* bar; unsigned x;
    volatile LAS unsigned* st;
};

__device__ __forceinline__ XcdBarrier xcd_barrier_post(unsigned* bar, volatile LAS unsigned* st) {
    XcdBarrier b; b.bar = bar; b.x = xb_xcc_id(); b.st = st;
    if (threadIdx.x == 0) (void)xb_add(&bar[XB_XCNT(b.x)], 1u);
    return b;
}
__device__ __forceinline__ void xcd_barrier_complete(unsigned* bar, unsigned x, unsigned& nloc, unsigned& nx) {
    const unsigned G = gridDim.x * gridDim.y * gridDim.z;
    unsigned sum, cnt, mine, sp = 0u;
    for (;;) {
        sum = 0u; cnt = 0u; mine = 0u;
#pragma unroll
        for (unsigned j = 0; j < 16; ++j) { const unsigned c = xb_ld(&bar[XB_XCNT(j)]); sum += c; cnt += (c > 0u) ? 1u : 0u; mine = (j == x) ? c : mine; }
        if (sum == G) break;
        __builtin_amdgcn_s_sleep(1);
        if ((++sp & 255u) == 0u) { if (xb_ld(&bar[XB_TMO])) break; if (sp > XB_SPIN_CAP) { atomicAdd(&bar[XB_TMO], 1u); break; } }
    }
    nloc = mine > 0u ? mine : 1u; nx = cnt > 0u ? cnt : 1u;
}

__device__ __forceinline__ void xcd_barrier(const XcdBarrier& b) {
    asm volatile("s_waitcnt vmcnt(0)" ::: "memory");
    __syncthreads();
    if (threadIdx.x == 0) {
        unsigned* bar = b.bar;
        __builtin_amdgcn_s_waitcnt(0);
        unsigned nloc = b.st[0], nx = b.st[1];
        if (nloc == 0u) { xcd_barrier_complete(bar, b.x, nloc, nx); b.st[0] = nloc; b.st[1] = nx; }
        const unsigned old = xb_add(&bar[XB_XSUB(b.x)], 1u);
        const unsigned gen = old / nloc;
        if (old + 1u == (gen + 1u) * nloc) {
            __builtin_amdgcn_fence(__ATOMIC_RELEASE, "agent");
            asm volatile("s_waitcnt vmcnt(0)" ::: "memory");
            const unsigned og = xb_add(&bar[XB_TOP], 1u);
            const unsigned tg = og / nx;
            if (og + 1u == (tg + 1u) * nx) xb_add(&bar[XB_TOPGEN], 1u);
            else XB_SPIN(xb_ld(&bar[XB_TOPGEN]) == tg, bar);
            __builtin_amdgcn_fence(__ATOMIC_ACQUIRE, "agent");
            xb_add(&bar[XB_XGEN(b.x)], 1u);
            asm volatile("s_waitcnt vmcnt(0)" ::: "memory");
        } else {
            XB_SPIN(xb_ld(&bar[XB_XGEN(b.x)]) == gen, bar);
            __builtin_amdgcn_fence(__ATOMIC_ACQUIRE, "agent");
            asm volatile("s_waitcnt vmcnt(0)" ::: "memory");
        }
    }
    __syncthreads();
}


namespace cg = cooperative_groups;
#ifndef REP_MASK
#define REP_MASK 0
#endif
#define REPS(k) (((REP_MASK) >> (k)) & 1 ? 2 : 1)
constexpr int PHASE_LDS = att::A_LDS_BYTES;
constexpr int MEGA_LDS = PHASE_LDS + 64;
static_assert(PHASE_LDS >= pg8::STAGE_BYTES && PHASE_LDS >= att::B_LDS_BYTES && PHASE_LDS >= peer::T_LDS_BYTES && PHASE_LDS >= 8 * 64 * 33 * 4 && PHASE_LDS >= apply::AP_LDS_BYTES, "LDS budget");
__global__ void __launch_bounds__(512, 2) mega_fwd(Ptrs P) {
    extern __shared__ __attribute__((aligned(16))) unsigned char lds_dyn[];
    volatile LAS unsigned* bst = (volatile LAS unsigned*)((LAS unsigned char*)lds_dyn + PHASE_LDS);
    if (threadIdx.x < 2) bst[threadIdx.x] = 0u;
    __syncthreads();
    const XcdBarrier bar = xcd_barrier_post((unsigned*)(P.ws + WS_CTL), bst);
    const int G = (int)gridDim.x, bx = (int)blockIdx.x, vcu = (G % 8 == 0) ? (bx % 8) * (G / 8) + bx / 8 : bx;
    unsigned char* ws = P.ws;
    PG8_LAS unsigned char* lds3 = (PG8_LAS unsigned char*)lds_dyn;
    for (int rep = 0; rep < REPS(0); ++rep) prep_phase(P, lds_dyn, G, bx);
    xcd_barrier(bar); if (REPS(9) == 2) xcd_barrier(bar);
    for (int rep = 0; rep < REPS(1); ++rep) {
      { pg8::Gemm g{(const bf16_t*)(ws + WS_XN), (const bf16_t*)(ws + WS_WIN), M, 1024, D, 0}; pg8::StaticOrder S; S.init(M, 1024, G, bx);
        pg8::gemm_phase<pg8::EpiProj, pg8::StaticOrder, true, true, false>(lds3, g, S, pg8::EpiProj{(bf16_t*)(ws + WS_PROJ), (const float*)(ws + WS_ROPE), 1.f, 0}); }
      { pg8::Gemm g{(const bf16_t*)(ws + WS_XN8), (const bf16_t*)(ws + WS_WIN8), M, INW - 1024, D / 2, 0}; pg8::StaticOrder S; S.init(M, INW - 1024, G, bx);
        pg8::gemm_phase<pg8::EpiProj, pg8::StaticOrder, true, true, true>(lds3, g, S, pg8::EpiProj{(bf16_t*)(ws + WS_PROJ), (const float*)(ws + WS_ROPE), 1.f / WIN_SCALE, 4}); } }
    xcd_barrier(bar); if (REPS(9) == 2) xcd_barrier(bar);
    { const float lam = lambda_full(P);
      for (int rep = 0; rep < REPS(2); ++rep) for (int u = vcu; u < BATCH * 4 * 8; u += G) att::attn_a_unit(u >> 5, (u >> 3) & 3, u & 7, (const bf16_t*)(ws + WS_PROJ), (bf16_t*)(ws + WS_YA), P.subln, lam, lds_dyn);
      for (int rep = 0; rep < REPS(3); ++rep) for (int u = vcu; u < BATCH * 8 * 8; u += G) att::attn_b_unit(u >> 6, (u >> 3) & 7, u & 7, (const bf16_t*)(ws + WS_PROJ), (bf16_t*)(ws + WS_YA), P.rpb, lds_dyn); }
    xcd_barrier(bar); if (REPS(9) == 2) xcd_barrier(bar);
    for (int rep = 0; rep < REPS(4); ++rep) { pg8::StaticOrder S; S.init(M, D, G, bx);
      pg8::gemm_phase<pg8::EpiGate2, pg8::StaticOrder, true, true>(lds3, pg8::Gemm{(const bf16_t*)(ws + WS_YA), (const bf16_t*)(ws + WS_WPA), M, D, D, 0}, S, pg8::EpiGate2{(const bf16_t*)(ws + WS_PROJ), (bf16_t*)(ws + WS_MERGED)}); }
    xcd_barrier(bar); if (REPS(9) == 2) xcd_barrier(bar);
    for (int rep = 0; rep < REPS(5); ++rep) { pg8::StaticOrder S; S.init(M, D, G, bx);
      pg8::gemm_phase<pg8::EpiHout, pg8::StaticOrder, true, true>(lds3, pg8::Gemm{(const bf16_t*)(ws + WS_MERGED), (const bf16_t*)(ws + WS_WOUT), M, D, D, 0}, S, pg8::EpiHout{P.x, P.out, (bf16_t*)(ws + WS_HB), (float*)(ws + WS_SSQ)});
      cvt_experts_phase(P, G, bx); }
    xcd_barrier(bar); if (REPS(9) == 2) xcd_barrier(bar);
    { pg8::StaticOrder S; S.init(M, PQ, G, bx);
      for (int rep = 0; rep < REPS(8); ++rep)
        pg8::gemm_phase<pg8::EpiQ, pg8::StaticOrder, true, true>(lds3, pg8::Gemm{(const bf16_t*)(ws + WS_HB), (const bf16_t*)(ws + WS_WQ), M, PQ, D, 0}, S, pg8::EpiQ{(const float*)(ws + WS_SSQ), (bf16_t*)(ws + WS_Q)});
      asm volatile("s_waitcnt vmcnt(0)" ::: "memory");
      __syncthreads();
      if (threadIdx.x == 0) { __builtin_amdgcn_fence(__ATOMIC_ACQUIRE, "agent"); asm volatile("s_waitcnt vmcnt(0)" ::: "memory"); }
      __syncthreads();
      for (int rep = 0; rep < REPS(6); ++rep) peer::topk_own_units(P, lds_dyn, S); }
    xcd_barrier(bar); if (REPS(9) == 2) xcd_barrier(bar);
#ifndef PROBE_MODE
#define PROBE_MODE 0
#endif
    if (REPS(7) == 2) apply::apply_phase<PROBE_MODE>(P, (float*)(ws + WS_Q), lds_dyn, G, vcu);
    apply::apply_phase<0>(P, P.out, lds_dyn, G, vcu);
}

extern "C" void kernel_launch(void* const* d_in, const int* in_sizes, int n_in, void* d_out, int out_size, void* d_ws, size_t ws_size, hipStream_t stream) {
    if (n_in != 18 || ws_size < WS_END) { fprintf(stderr, "kernel_launch: unexpected n_in %d / ws_size %zu\n", n_in, ws_size); return; }
    Ptrs P{};
    P.x = (const float*)d_in[0]; P.w_in = (const float*)d_in[1]; P.w_pa = (const float*)d_in[2]; P.w_pb = (const float*)d_in[3]; P.w_out = (const float*)d_in[4];
    P.norm_mix = (const float*)d_in[5]; P.norm_ffn = (const float*)d_in[6]; P.norm_final = (const float*)d_in[7];
    P.lq1 = (const float*)d_in[8]; P.lk1 = (const float*)d_in[9]; P.lq2 = (const float*)d_in[10]; P.lk2 = (const float*)d_in[11];
    P.subln = (const float*)d_in[12]; P.rpb = (const float*)d_in[13]; P.w_query = (const float*)d_in[14]; P.sub_keys = (const float*)d_in[15];
    P.peer_u = (const float*)d_in[16]; P.peer_v = (const float*)d_in[17];
    P.out = (float*)d_out; P.ws = (unsigned char*)d_ws;
    static int grid_blocks = 0;
    if (!grid_blocks) {
        int dev = 0, cus = 0, per_cu = 0;
        hipGetDevice(&dev);
        hipDeviceGetAttribute(&cus, hipDeviceAttributeMultiprocessorCount, dev);
        hipFuncSetAttribute((const void*)mega_fwd, hipFuncAttributeMaxDynamicSharedMemorySize, MEGA_LDS);
        hipOccupancyMaxActiveBlocksPerMultiprocessor(&per_cu, (const void*)mega_fwd, 512, MEGA_LDS);
        if (per_cu < 1) { fprintf(stderr, "kernel_launch: occupancy query says %d blocks per CU\n", per_cu); per_cu = 1; }
        grid_blocks = cus * per_cu;
    }
    hipMemsetAsync((unsigned char*)d_ws + WS_CTL, 0, 16384, stream);
    void* args[] = {&P};
    hipError_t e = hipLaunchCooperativeKernel((const void*)mega_fwd, dim3(grid_blocks), dim3(512), args, MEGA_LDS, stream);
    if (e != hipSuccess) fprintf(stderr, "cooperative launch failed: %s (grid %d)\n", hipGetErrorString(e), grid_blocks);
}
```

```cpp
#include <hip/hip_runtime.h>
#include <hip/hip_cooperative_groups.h>
#include <cstdio>
#include <cstdint>

typedef unsigned short bf16_t;
typedef unsigned u32x4 __attribute__((ext_vector_type(4)));
typedef unsigned u32x2 __attribute__((ext_vector_type(2)));
typedef float f32x4 __attribute__((ext_vector_type(4)));
typedef __bf16 bf16x2_t __attribute__((ext_vector_type(2)));

constexpr int D = 1024, BATCH = 8, SEQ = 2048, M = BATCH * SEQ, INW = 5120;
constexpr int C_QA = 0, C_KA = 512, C_VA = 1024, C_QB = 1536, C_KB = 2048, C_VB = 2560, C_GA = 3072, C_GB = 4096;
constexpr int NEXP = 16384, PQ = 2048;
constexpr float EPS = 1e-6f;
constexpr float LOG2E = 1.4426950408889634f;
constexpr float WIN_SCALE = 32.f;
constexpr float QSCALE = 0.125f * LOG2E;

constexpr size_t MiB = 1u << 20;
constexpr size_t WS_PROJ = 0;
constexpr size_t WS_HB = 0;
constexpr size_t WS_Q = 32 * MiB;
constexpr size_t WS_U = 96 * MiB;
constexpr size_t WS_V = 112 * MiB;
constexpr size_t WS_SU = 128 * MiB;
constexpr size_t WS_SV = 128 * MiB + 65536;
constexpr size_t WS_XN = 160 * MiB;
constexpr size_t WS_YA = 160 * MiB;
constexpr size_t WS_YB = 176 * MiB;
constexpr size_t WS_IDX = 160 * MiB;
constexpr size_t WS_G = 168 * MiB;
constexpr size_t WS_MERGED = 192 * MiB;
constexpr size_t WS_TOPV = 192 * MiB;
constexpr size_t WS_TOPI = 208 * MiB;
constexpr size_t WS_WIN = 224 * MiB;
constexpr size_t WS_WIN8 = 226 * MiB;
constexpr size_t WS_XN8 = 192 * MiB;
constexpr size_t WS_WQ = 234 * MiB;
constexpr size_t WS_WOUT = 238 * MiB;
constexpr size_t WS_WPA = 240 * MiB;
constexpr size_t WS_WPB = 241 * MiB;
constexpr size_t WS_SK = 242 * MiB;
constexpr size_t WS_ROPE = 242 * MiB + 512 * 1024;
constexpr size_t WS_SSQ = 243 * MiB;
constexpr size_t WS_CTL = 244 * MiB;
constexpr size_t WS_END = 256 * MiB;

__device__ __forceinline__ float bf2f(unsigned v) { return __uint_as_float(v << 16); }
__device__ __forceinline__ float bflo(unsigned w) { return __uint_as_float(w << 16); }
__device__ __forceinline__ float bfhi(unsigned w) { return __uint_as_float(w & 0xffff0000u); }
__device__ __forceinline__ unsigned f2bf(float f) { unsigned u = __float_as_uint(f); return (u + 0x7fffu + ((u >> 16) & 1u)) >> 16; }
__device__ __forceinline__ unsigned pk2(float lo, float hi) { return f2bf(lo) | (f2bf(hi) << 16); }
__device__ __forceinline__ float wave_sum(float v) {
#pragma unroll
    for (int o = 1; o < 64; o <<= 1) v += __shfl_xor(v, o);
    return v;
}
__device__ __forceinline__ float sigmoidf_(float x) { return 1.f / (1.f + __expf(-x)); }
__device__ __forceinline__ float gelu_exact(float x) { return 0.5f * x * (1.f + erff(x * 0.70710678118654752f)); }

struct Ptrs {
    const float *x, *w_in, *w_pa, *w_pb, *w_out, *norm_mix, *norm_ffn, *norm_final, *lq1, *lk1, *lq2, *lk2, *subln, *rpb, *w_query, *sub_keys, *peer_u, *peer_v;
    float* out; unsigned char* ws;
};

__device__ __forceinline__ void transpose_item(const float* W, int K, int N, const float* gain, bf16_t* WT, float* scr, int item, int lane, int ldo = 0, int koff = 0, int ldw = 0) {
    if (ldo == 0) ldo = K;
    if (ldw == 0) ldw = N;
    const int nblk = N / 32, kb = item / nblk, nb = item % nblk, k0 = 64 * kb, n0 = 32 * nb;
    float wv[32];
#pragma unroll
    for (int i = 0; i < 32; ++i) { const int kk = 2 * i + (lane >> 5); wv[i] = W[(size_t)(k0 + kk) * ldw + n0 + (lane & 31)]; }
#pragma unroll
    for (int i = 0; i < 32; ++i) { const int kk = 2 * i + (lane >> 5); float w = wv[i]; if (gain) w *= gain[k0 + kk]; scr[kk * 33 + (lane & 31)] = w; }
    asm volatile("s_waitcnt lgkmcnt(0)" ::: "memory");
    const int c = lane & 7;
#pragma unroll
    for (int j = 0; j < 4; ++j) { const int n = (lane >> 3) + 8 * j; const float* s = scr + (8 * c) * 33 + n;
        u32x4 o; o.x = pk2(s[0 * 33], s[1 * 33]); o.y = pk2(s[2 * 33], s[3 * 33]); o.z = pk2(s[4 * 33], s[5 * 33]); o.w = pk2(s[6 * 33], s[7 * 33]);
        *(u32x4*)(WT + (size_t)(n0 + n) * ldo + koff + k0 + 8 * c) = o; }
    asm volatile("s_waitcnt lgkmcnt(0)" ::: "memory");
}
__device__ __forceinline__ void cvt8(const float* src, bf16_t* dst, size_t i8) {
    const f32x4 a = *(const f32x4*)(src + i8 * 8), b = *(const f32x4*)(src + i8 * 8 + 4);
    u32x4 o; o.x = pk2(a.x, a.y); o.y = pk2(a.z, a.w); o.z = pk2(b.x, b.y); o.w = pk2(b.z, b.w);
    *(u32x4*)(dst + i8 * 8) = o;
}
__device__ __forceinline__ void transpose_item8(const float* W, int K, int N, int ldw, const float* gain, float wscale, unsigned char* WT, float* scr, int item, int lane) {
    const int nblk = N / 32, kb = item / nblk, nb = item % nblk, k0 = 64 * kb, n0 = 32 * nb;
    float wv[32];
#pragma unroll
    for (int i = 0; i < 32; ++i) { const int kk = 2 * i + (lane >> 5); wv[i] = W[(size_t)(k0 + kk) * ldw + n0 + (lane & 31)]; }
#pragma unroll
    for (int i = 0; i < 32; ++i) { const int kk = 2 * i + (lane >> 5); float w = wv[i] * wscale; if (gain) w *= gain[k0 + kk]; scr[kk * 33 + (lane & 31)] = w; }
    asm volatile("s_waitcnt lgkmcnt(0)" ::: "memory");
    const int c = lane & 7;
#pragma unroll
    for (int j = 0; j < 4; ++j) { const int n = (lane >> 3) + 8 * j; const float* s = scr + (8 * c) * 33 + n;
        u32x2 o; o.x = __builtin_amdgcn_cvt_pk_fp8_f32(s[0 * 33], s[1 * 33], 0u, false); o.x = __builtin_amdgcn_cvt_pk_fp8_f32(s[2 * 33], s[3 * 33], o.x, true);
        o.y = __builtin_amdgcn_cvt_pk_fp8_f32(s[4 * 33], s[5 * 33], 0u, false); o.y = __builtin_amdgcn_cvt_pk_fp8_f32(s[6 * 33], s[7 * 33], o.y, true);
        *(u32x2*)(WT + (size_t)(n0 + n) * K + k0 + 8 * c) = o; }
    asm volatile("s_waitcnt lgkmcnt(0)" ::: "memory");
}
__device__ __forceinline__ void rms_rows_emit(const f32x4 (&v)[4], bf16_t* orow16, unsigned char* orow, int lane) {
    float s = 0.f;
#pragma unroll
    for (int j = 0; j < 4; ++j) s += (v[j].x * v[j].x + v[j].y * v[j].y) + (v[j].z * v[j].z + v[j].w * v[j].w);
    const float rstd = 1.f / sqrtf(wave_sum(s) * (1.f / D) + EPS);
    unsigned* o4 = (unsigned*)orow + lane; u32x2* o8 = (u32x2*)orow16 + lane;
#pragma unroll
    for (int j = 0; j < 4; ++j) { unsigned w = __builtin_amdgcn_cvt_pk_fp8_f32(v[j].x * rstd, v[j].y * rstd, 0u, false); w = __builtin_amdgcn_cvt_pk_fp8_f32(v[j].z * rstd, v[j].w * rstd, w, true); o4[64 * j] = w;
        u32x2 w2; w2.x = pk2(v[j].x * rstd, v[j].y * rstd); w2.y = pk2(v[j].z * rstd, v[j].w * rstd); o8[64 * j] = w2; }
}
__device__ __forceinline__ void rms_rows(const float* x, bf16_t* xn16, unsigned char* xn8, int m0, int step, int lane) {
    if (m0 >= M) return;
    f32x4 cur[4], nxt[4];
#pragma unroll
    for (int j = 0; j < 4; ++j) cur[j] = ((const f32x4*)(x + (size_t)m0 * D) + lane)[64 * j];
    for (int m = m0; m < M; m += step) {
        const int mn = (m + step < M) ? m + step : m;
#pragma unroll
        for (int j = 0; j < 4; ++j) nxt[j] = ((const f32x4*)(x + (size_t)mn * D) + lane)[64 * j];
        rms_rows_emit(cur, xn16 + (size_t)m * D, xn8 + (size_t)m * D, lane);
#pragma unroll
        for (int j = 0; j < 4; ++j) cur[j] = nxt[j];
    }
}
__device__ __forceinline__ void rms_row_to_bf16(const float* xrow, bf16_t* orow, int lane) {
    const f32x4* xr = (const f32x4*)xrow + lane;
    f32x4 v[4]; float s = 0.f;
#pragma unroll
    for (int j = 0; j < 4; ++j) { v[j] = xr[64 * j]; s += (v[j].x * v[j].x + v[j].y * v[j].y) + (v[j].z * v[j].z + v[j].w * v[j].w); }
    const float rstd = 1.f / sqrtf(wave_sum(s) * (1.f / D) + EPS);
    u32x2* o8 = (u32x2*)orow + lane;
#pragma unroll
    for (int j = 0; j < 4; ++j) { u32x2 w; w.x = pk2(v[j].x * rstd, v[j].y * rstd); w.y = pk2(v[j].z * rstd, v[j].w * rstd); o8[64 * j] = w; }
}

__device__ __forceinline__ void prep_phase(const Ptrs& P, unsigned char* shm, int G, int bx) {
    int tid_l = threadIdx.x; asm volatile("" : "+v"(tid_l));
    const int lane = tid_l & 63; const int wave = __builtin_amdgcn_readfirstlane(tid_l >> 6);
    const int gw = bx * 8 + wave, NGW = G * 8;
    float* scr = (float*)(shm + wave * (64 * 33 * 4));
    unsigned char* ws = P.ws;
    constexpr int N_BF = 1024;
    constexpr int I_INB = (D / 64) * (N_BF / 32), I_IN8 = (D / 64) * ((INW - N_BF) / 32), I_IN = I_INB + I_IN8, I_Q = (D / 64) * (PQ / 32), I_OUT = (D / 64) * (D / 32), I_PA = (512 / 64) * (D / 32);
    constexpr int NIT = I_IN + I_Q + I_OUT + 2 * I_PA;
    for (int it = gw; it < NIT; it += NGW) {
        int r = it;
        if (r < I_INB) { transpose_item(P.w_in, D, N_BF, P.norm_mix, (bf16_t*)(ws + WS_WIN), scr, r, lane, 0, 0, INW); continue; } r -= I_INB;
        if (r < I_IN8) { transpose_item8(P.w_in + N_BF, D, INW - N_BF, INW, P.norm_mix, WIN_SCALE, ws + WS_WIN8, scr, r, lane); continue; } r -= I_IN8;
        if (r < I_Q) { transpose_item(P.w_query, D, PQ, P.norm_ffn, (bf16_t*)(ws + WS_WQ), scr, r, lane); continue; } r -= I_Q;
        if (r < I_OUT) { transpose_item(P.w_out, D, D, nullptr, (bf16_t*)(ws + WS_WOUT), scr, r, lane); continue; } r -= I_OUT;
        if (r < I_PA) { transpose_item(P.w_pa, 512, D, nullptr, (bf16_t*)(ws + WS_WPA), scr, r, lane, 1024, 0); continue; } r -= I_PA;
        transpose_item(P.w_pb, 512, D, nullptr, (bf16_t*)(ws + WS_WPA), scr, r, lane, 1024, 512);
    }
    rms_rows(P.x, (bf16_t*)(ws + WS_XN), ws + WS_XN8, gw, NGW, lane);
    const size_t gt = (size_t)bx * 512 + threadIdx.x, NT = (size_t)G * 512;
    for (size_t i = gt; i < (size_t)16 * 128 * 128 / 8; i += NT) cvt8(P.sub_keys, (bf16_t*)(ws + WS_SK), i);
    for (size_t i = gt; i < (size_t)SEQ * 8; i += NT) {
        const int pos = (int)(i >> 3), k = (int)(i & 7);
        const float inv = k == 0 ? 1.0f : k == 1 ? 0.19392274f : k == 2 ? 0.03760603f : k == 3 ? 0.0072926646f : k == 4 ? 0.0014142136f : k == 5 ? 0.0002742482f : k == 6 ? 5.3182957e-05f : 1.0313385e-05f;
        const float ang = (float)pos * inv;
        float sn, cs; sincosf(ang, &sn, &cs);
        float* t = (float*)(ws + WS_ROPE) + (size_t)pos * 16;
        t[k] = cs; t[8 + k] = sn;
    }
}
__device__ __forceinline__ void cvt_row_fp8(const f32x4 (&rv)[4], unsigned char* dst, float* inv_scale, int lane) {
    const f32x4 a = rv[0], b = rv[1], c = rv[2], d = rv[3];
    float m = fmaxf(fmaxf(fmaxf(fabsf(a.x), fabsf(a.y)), fmaxf(fabsf(a.z), fabsf(a.w))), fmaxf(fmaxf(fabsf(b.x), fabsf(b.y)), fmaxf(fabsf(b.z), fabsf(b.w))));
    m = fmaxf(m, fmaxf(fmaxf(fmaxf(fabsf(c.x), fabsf(c.y)), fmaxf(fabsf(c.z), fabsf(c.w))), fmaxf(fmaxf(fabsf(d.x), fabsf(d.y)), fmaxf(fabsf(d.z), fabsf(d.w)))));
#pragma unroll
    for (int o = 1; o < 64; o <<= 1) m = fmaxf(m, __shfl_xor(m, o));
    m = fmaxf(m, 1e-30f);
    const float sc = 256.f / m;
    u32x4 w;
    w.x = __builtin_amdgcn_cvt_pk_fp8_f32(a.x * sc, a.y * sc, 0u, false); w.x = __builtin_amdgcn_cvt_pk_fp8_f32(a.z * sc, a.w * sc, w.x, true);
    w.y = __builtin_amdgcn_cvt_pk_fp8_f32(b.x * sc, b.y * sc, 0u, false); w.y = __builtin_amdgcn_cvt_pk_fp8_f32(b.z * sc, b.w * sc, w.y, true);
    w.z = __builtin_amdgcn_cvt_pk_fp8_f32(c.x * sc, c.y * sc, 0u, false); w.z = __builtin_amdgcn_cvt_pk_fp8_f32(c.z * sc, c.w * sc, w.z, true);
    w.w = __builtin_amdgcn_cvt_pk_fp8_f32(d.x * sc, d.y * sc, 0u, false); w.w = __builtin_amdgcn_cvt_pk_fp8_f32(d.z * sc, d.w * sc, w.w, true);
    *(u32x4*)(dst + (size_t)(lane >> 5) * (NEXP * 512) + (lane & 31) * 16) = w;
    if (lane == 0) *inv_scale = m * (1.f / 256.f);
}
__device__ __forceinline__ unsigned pack_i8x4(float a, float b, float c, float d) {
    const int q0 = (int)rintf(a), q1 = (int)rintf(b), q2 = (int)rintf(c), q3 = (int)rintf(d);
    return (unsigned)(q0 & 0xff) | ((unsigned)(q1 & 0xff) << 8) | ((unsigned)(q2 & 0xff) << 16) | ((unsigned)q3 << 24);
}
__device__ __forceinline__ void cvt_row_i8(const f32x4 (&rv)[4], unsigned char* dst, float* inv_scale, int lane) {
    const f32x4 a = rv[0], b = rv[1], c = rv[2], d = rv[3];
    float m = fmaxf(fmaxf(fmaxf(fabsf(a.x), fabsf(a.y)), fmaxf(fabsf(a.z), fabsf(a.w))), fmaxf(fmaxf(fabsf(b.x), fabsf(b.y)), fmaxf(fabsf(b.z), fabsf(b.w))));
    m = fmaxf(m, fmaxf(fmaxf(fmaxf(fabsf(c.x), fabsf(c.y)), fmaxf(fabsf(c.z), fabsf(c.w))), fmaxf(fmaxf(fabsf(d.x), fabsf(d.y)), fmaxf(fabsf(d.z), fabsf(d.w)))));
#pragma unroll
    for (int o = 1; o < 64; o <<= 1) m = fmaxf(m, __shfl_xor(m, o));
    m = fmaxf(m, 1e-30f);
    const float sc = 127.f / m;
    u32x4 w;
    w.x = pack_i8x4(a.x * sc, a.y * sc, a.z * sc, a.w * sc); w.y = pack_i8x4(b.x * sc, b.y * sc, b.z * sc, b.w * sc);
    w.z = pack_i8x4(c.x * sc, c.y * sc, c.z * sc, c.w * sc); w.w = pack_i8x4(d.x * sc, d.y * sc, d.z * sc, d.w * sc);
    *(u32x4*)(dst + (size_t)(lane >> 5) * (NEXP * 512) + (lane & 31) * 16) = w;
    if (lane == 0) *inv_scale = m * (1.f / 127.f);
}
__device__ __forceinline__ void cvt_experts_phase(const Ptrs& P, int G, int bx) {
    int tid_l = threadIdx.x; asm volatile("" : "+v"(tid_l));
    const int lane = tid_l & 63; const int wave = __builtin_amdgcn_readfirstlane(tid_l >> 6);
    const int step = G * 8; int r = bx * 8 + wave;
    if (r >= 2 * NEXP) return;
    f32x4 cur[4], nxt[4];
    { const float* src = (r < NEXP ? P.peer_u + (size_t)r * D : P.peer_v + (size_t)(r - NEXP) * D);
#pragma unroll
      for (int j = 0; j < 4; ++j) cur[j] = ((const f32x4*)src + lane * 4)[j]; }
    for (; r < 2 * NEXP; r += step) {
        const int rn = (r + step < 2 * NEXP) ? r + step : r;
        const float* srcn = (rn < NEXP ? P.peer_u + (size_t)rn * D : P.peer_v + (size_t)(rn - NEXP) * D);
#pragma unroll
        for (int j = 0; j < 4; ++j) nxt[j] = ((const f32x4*)srcn + lane * 4)[j];
        if (r < NEXP) cvt_row_i8(cur, P.ws + WS_U + (size_t)r * 512, (float*)(P.ws + WS_SU) + r, lane);
        else { const int e = r - NEXP; cvt_row_fp8(cur, P.ws + WS_V + (size_t)e * 512, (float*)(P.ws + WS_SV) + e, lane); }
#pragma unroll
        for (int j = 0; j < 4; ++j) cur[j] = nxt[j];
    }
}

namespace pg8 {
#define PG8_LAS __attribute__((address_space(3)))
typedef unsigned short bf16_t;
typedef short bf16x8 __attribute__((ext_vector_type(8)));
typedef float f32x4 __attribute__((ext_vector_type(4)));
typedef unsigned u32x4 __attribute__((ext_vector_type(4)));
typedef int v8i_t __attribute__((ext_vector_type(8)));
constexpr int BM = 256, BK = 64, HALF = 128, HTB = HALF * BK * 2  , STAGE_BYTES = 8 * HTB, NXCD = 8, WGM = 8;

__host__ __device__ __forceinline__ int lds_byte(int r, int c) { const int st = (r >> 4) * 2 + (c >> 5), rr = r & 15, cc = c & 31, ob = rr * 64 + cc * 2; return st * 1024 + (ob ^ (((ob >> 9) & 1) << 5)); }
__host__ __device__ __forceinline__ void stage_rc(int b, int& R, int& C) { const int st = b / 1024, sb = b % 1024, swz = sb ^ (((sb >> 9) & 1) << 5); R = (st >> 1) * 16 + swz / 64; C = (st & 1) * 32 + (swz % 64) / 2; }
__host__ __device__ __forceinline__ int perm32(int rho) { const int n = rho >> 4, i = rho & 15; return 8 * (i >> 2) + 4 * n + (i & 3); }

struct Unit { int pm, pn; };
struct Gemm { const bf16_t* A; const bf16_t* Bt; int M, N, K, pad; };

struct StaticOrder {
    int nM, nN, nwg, G, c;
    __host__ __device__ void init(int M, int N, int G_, int c_) { nM = M / BM; nN = N / BM; nwg = nM * nN; G = G_; c = c_; }
    __host__ __device__ bool next(int i, Unit& u) const {
        const long L = (long)i * G + c; if (L >= nwg) return false;
        int wgid = (int)L; { const int q = nwg / NXCD, r = nwg % NXCD, xcd = wgid % NXCD, off = wgid / NXCD; wgid = (xcd < r ? xcd * (q + 1) : r * (q + 1) + (xcd - r) * q) + off; }
        const int nig = WGM * nN, gid = wgid / nig, fm = gid * WGM, gsz = (nM - fm) < WGM ? (nM - fm) : WGM;
        u.pm = fm + ((wgid % nig) % gsz); u.pn = (wgid % nig) / gsz; return true;
    }
    __device__ __forceinline__ void a_ready(const Unit&) const {}
    __device__ __forceinline__ void done(const Unit&) const {}
};
__device__ __forceinline__ unsigned cvt_pk_bf16(float lo, float hi) { unsigned r; asm volatile("v_cvt_pk_bf16_f32 %0, %1, %2" : "=v"(r) : "v"(lo), "v"(hi)); return r; }
typedef float f32x2 __attribute__((ext_vector_type(2)));

__device__ __forceinline__ float sigm(float x) { return __builtin_amdgcn_rcpf(1.f + __builtin_amdgcn_exp2f(-1.4426950408889634f * x)); }
struct EpiProj {
    static constexpr bool PERM = true, AFTER_DRAIN = false, MID = false;
    bf16_t* O; const float* rope; float osc; int pn0;
    __device__ __forceinline__ void operator()(const f32x4 (&acc)[2][2][4][2], const Unit& u, int wr, int wc, int fr_, int fq_) const {
        int fr = fr_, fq = fq_; asm volatile("" : "+v"(fr), "+v"(fq));
        const int pn = u.pn + pn0;
        const int row0 = u.pm * BM + wr * 64 + fr, col0 = pn * BM + wc * 32 + 8 * fq;
        const float sc = ((pn < 2 || pn == 6 || pn == 7) ? QSCALE : 1.f) * osc;
        const bool dorope = (pn < 4) && ((wc & 1) == 0);
#pragma unroll
        for (int ai = 0; ai < 2; ++ai)
#pragma unroll
            for (int m = 0; m < 4; ++m) { const int row = row0 + ai * HALF + m * 16; bf16_t* rowp = O + (size_t)row * INW + col0;
                f32x4 c4[2] = {{1.f, 1.f, 1.f, 1.f}, {1.f, 1.f, 1.f, 1.f}}, s4[2] = {{0.f, 0.f, 0.f, 0.f}, {0.f, 0.f, 0.f, 0.f}};
                if (dorope) { const float* rp = rope + (size_t)(row & (SEQ - 1)) * 16; c4[0] = *(const f32x4*)(rp); c4[1] = *(const f32x4*)(rp + 4); s4[0] = *(const f32x4*)(rp + 8); s4[1] = *(const f32x4*)(rp + 12); }
#pragma unroll
                for (int bj = 0; bj < 2; ++bj) { f32x4 v0 = acc[ai][bj][m][0], v1 = acc[ai][bj][m][1];
                    if (dorope) { f32x4 o0, o1;
#pragma unroll
                        for (int j = 0; j < 4; ++j) { o0[j] = __shfl_xor(v0[j], 16); o1[j] = __shfl_xor(v1[j], 16); }
                        if (fq == 0) { v0 = v0 * c4[0] - o0 * s4[0]; v1 = v1 * c4[1] - o1 * s4[1]; }
                        else if (fq == 1) { v0 = v0 * c4[0] + o0 * s4[0]; v1 = v1 * c4[1] + o1 * s4[1]; } }
                    v0 = v0 * sc; v1 = v1 * sc; u32x4 w; w.x = cvt_pk_bf16(v0[0], v0[1]); w.y = cvt_pk_bf16(v0[2], v0[3]); w.z = cvt_pk_bf16(v1[0], v1[1]); w.w = cvt_pk_bf16(v1[2], v1[3]);
                    *(u32x4*)(rowp + bj * HALF) = w; } }
    }
};
struct EpiGate2 {
    static constexpr bool PERM = true, AFTER_DRAIN = false, MID = true;
    const bf16_t* proj; bf16_t* O;
    __device__ __forceinline__ void mid(f32x4 (&acc)[2][2][4][2], const Unit& u, int wr, int wc, int fr, int fq) const {
        int row0 = u.pm * BM + wr * 64 + fr, col0 = u.pn * BM + wc * 32 + 8 * fq;
        asm volatile("" : "+v"(row0), "+v"(col0));
#pragma unroll
        for (int ai = 0; ai < 2; ++ai) {
            u32x4 gav[4][2], gbv[4][2];
#pragma unroll
            for (int m = 0; m < 4; ++m)
#pragma unroll
                for (int bj = 0; bj < 2; ++bj) { const bf16_t* gp = proj + (size_t)(row0 + ai * HALF + m * 16) * INW + col0 + bj * HALF; gav[m][bj] = *(const u32x4*)(gp + C_GA); gbv[m][bj] = *(const u32x4*)(gp + C_GB); }
#pragma unroll
            for (int m = 0; m < 4; ++m) {
#pragma unroll
                for (int bj = 0; bj < 2; ++bj) { const u32x4 ga = gav[m][bj], gb = gbv[m][bj];
                    const unsigned a_[4] = {ga.x, ga.y, ga.z, ga.w}, b_[4] = {gb.x, gb.y, gb.z, gb.w};
#pragma unroll
                    for (int q = 0; q < 4; ++q) {
                        const float r0 = (1.f + __builtin_amdgcn_exp2f(-1.4426950408889634f * bflo(b_[q]))) * __builtin_amdgcn_rcpf(1.f + __builtin_amdgcn_exp2f(-1.4426950408889634f * bflo(a_[q])));
                        const float r1 = (1.f + __builtin_amdgcn_exp2f(-1.4426950408889634f * bfhi(b_[q]))) * __builtin_amdgcn_rcpf(1.f + __builtin_amdgcn_exp2f(-1.4426950408889634f * bfhi(a_[q])));
                        acc[ai][bj][m][q >> 1][(q & 1) * 2] *= r0; acc[ai][bj][m][q >> 1][(q & 1) * 2 + 1] *= r1; } } }
            asm volatile("" ::: "memory"); }
    }
    __device__ __forceinline__ void operator()(const f32x4 (&acc)[2][2][4][2], const Unit& u, int wr, int wc, int fr_, int fq_) const {
        int fr = fr_, fq = fq_; asm volatile("" : "+v"(fr), "+v"(fq));
        const int row0 = u.pm * BM + wr * 64 + fr, col0 = u.pn * BM + wc * 32 + 8 * fq;
#pragma unroll
        for (int ai = 0; ai < 2; ++ai) {
            u32x4 gv[4][2];
#pragma unroll
            for (int m = 0; m < 4; ++m)
#pragma unroll
                for (int bj = 0; bj < 2; ++bj) gv[m][bj] = *(const u32x4*)(proj + (size_t)(row0 + ai * HALF + m * 16) * INW + C_GB + col0 + bj * HALF);
#pragma unroll
            for (int m = 0; m < 4; ++m) { const int row = row0 + ai * HALF + m * 16;
#pragma unroll
                for (int bj = 0; bj < 2; ++bj) { const int col = col0 + bj * HALF; const u32x4 g = gv[m][bj];
                    f32x4 v0 = acc[ai][bj][m][0], v1 = acc[ai][bj][m][1];
                    v0[0] *= sigm(bflo(g.x)); v0[1] *= sigm(bfhi(g.x)); v0[2] *= sigm(bflo(g.y)); v0[3] *= sigm(bfhi(g.y));
                    v1[0] *= sigm(bflo(g.z)); v1[1] *= sigm(bfhi(g.z)); v1[2] *= sigm(bflo(g.w)); v1[3] *= sigm(bfhi(g.w));
                    u32x4 w; w.x = cvt_pk_bf16(v0[0], v0[1]); w.y = cvt_pk_bf16(v0[2], v0[3]); w.z = cvt_pk_bf16(v1[0], v1[1]); w.w = cvt_pk_bf16(v1[2], v1[3]);
                    *(u32x4*)(O + (size_t)row * D + col) = w; } }
            asm volatile("" ::: "memory"); }
    }
};
struct EpiHout {
    static constexpr bool PERM = true, AFTER_DRAIN = false, MID = false;
    const float* x; float* H; bf16_t* HB; float* ssq16;
    __device__ __forceinline__ void operator()(const f32x4 (&acc)[2][2][4][2], const Unit& u, int wr, int wc, int fr_, int fq_) const {
        int fr = fr_, fq = fq_; asm volatile("" : "+v"(fr), "+v"(fq));
        const int row0 = u.pm * BM + wr * 64 + fr, col0 = u.pn * BM + wc * 32 + 8 * fq;
#pragma unroll
        for (int ai = 0; ai < 2; ++ai) {
            f32x4 xv[4][2][2];
#pragma unroll
            for (int m = 0; m < 4; ++m)
#pragma unroll
                for (int bj = 0; bj < 2; ++bj) { const float* xp = x + (size_t)(row0 + ai * HALF + m * 16) * D + col0 + bj * HALF; xv[m][bj][0] = *(const f32x4*)xp; xv[m][bj][1] = *(const f32x4*)(xp + 4); }
#pragma unroll
            for (int m = 0; m < 4; ++m) { const int row = row0 + ai * HALF + m * 16; float ss = 0.f;
#pragma unroll
                for (int bj = 0; bj < 2; ++bj) { const int col = col0 + bj * HALF;
                    const f32x4 v0 = acc[ai][bj][m][0] + xv[m][bj][0], v1 = acc[ai][bj][m][1] + xv[m][bj][1];
                    u32x4 w; w.x = cvt_pk_bf16(v0[0], v0[1]); w.y = cvt_pk_bf16(v0[2], v0[3]); w.z = cvt_pk_bf16(v1[0], v1[1]); w.w = cvt_pk_bf16(v1[2], v1[3]);
                    *(u32x4*)(HB + (size_t)row * D + col) = w;
                    ss += (v0[0] * v0[0] + v0[1] * v0[1]) + (v0[2] * v0[2] + v0[3] * v0[3]) + (v1[0] * v1[0] + v1[1] * v1[1]) + (v1[2] * v1[2] + v1[3] * v1[3]); }
                ss += __shfl_xor(ss, 16); ss += __shfl_xor(ss, 32);
                if (fq == 0) ssq16[(size_t)row * 16 + u.pn * 4 + wc] = ss; }
            asm volatile("" ::: "memory"); }
    }
};
struct EpiQ {
    static constexpr bool PERM = true, AFTER_DRAIN = false, MID = false;
    const float* ssq16; bf16_t* O;
    __device__ __forceinline__ void operator()(const f32x4 (&acc)[2][2][4][2], const Unit& u, int wr, int wc, int fr, int fq) const {
        const int row0 = u.pm * BM + wr * 64 + fr, col0 = u.pn * BM + wc * 32 + 8 * fq;
#pragma unroll
        for (int ai = 0; ai < 2; ++ai)
#pragma unroll
            for (int m = 0; m < 4; ++m) { const int row = row0 + ai * HALF + m * 16; const f32x4* sp = (const f32x4*)(ssq16 + (size_t)row * 16);
                const f32x4 a = sp[0], b = sp[1], c = sp[2], d = sp[3];
                const float tot = ((a[0] + a[1]) + (a[2] + a[3])) + ((b[0] + b[1]) + (b[2] + b[3])) + ((c[0] + c[1]) + (c[2] + c[3])) + ((d[0] + d[1]) + (d[2] + d[3]));
                const float rstd = 1.f / sqrtf(tot * (1.f / D) + EPS);
#pragma unroll
                for (int bj = 0; bj < 2; ++bj) { const f32x4 v0 = acc[ai][bj][m][0] * rstd, v1 = acc[ai][bj][m][1] * rstd;
                    u32x4 w; w.x = cvt_pk_bf16(v0[0], v0[1]); w.y = cvt_pk_bf16(v0[2], v0[3]); w.z = cvt_pk_bf16(v1[0], v1[1]); w.w = cvt_pk_bf16(v1[2], v1[3]);
                    *(u32x4*)(O + (size_t)row * PQ + col0 + bj * HALF) = w; } }
    }
};
template <class Epi, class Sched, bool ALIGN_EPI = false, bool SP2 = false, bool FP8 = false>
__device__ __forceinline__ void gemm_phase(PG8_LAS unsigned char* lds, const Gemm g, const Sched& S, const Epi& E) {
    int tid_l = threadIdx.x; asm volatile("" : "+v"(tid_l));
    const int tid = tid_l, wid = __builtin_amdgcn_readfirstlane(tid >> 6), lane = tid & 63, wr = wid >> 2, wc = wid & 3, fr = lane & 15, fq = lane >> 4;
    const int K = g.K, nt = K / BK;
    unsigned voffA[2], voffB[2];
#pragma unroll
    for (int i = 0; i < 2; ++i) { int R, C; stage_rc(tid * 16 + i * 8192, R, C); const int Rb = Epi::PERM ? ((R & ~31) + perm32(R & 31)) : R;
        voffA[i] = (unsigned)(R * K + C) * 2u; voffB[i] = (unsigned)(Rb * K + C) * 2u; }
    const size_t kstep = (size_t)(BK * 2);
    const size_t hstep = (size_t)HALF * K * 2;
    const size_t tstep = 2 * hstep;
    const unsigned ldsw = (unsigned)wid * 1024u;
    const int aoff = lds_byte(wr * 64 + fr, fq * 8), boff = lds_byte(wc * 32 + fr, fq * 8);
    const int aoffF0 = FP8 ? lds_byte(wr * 64 + fr, fq * 16) : 0, boffF0 = FP8 ? lds_byte(wc * 32 + fr, fq * 16) : 0;
#define PG8_SA(b, h) (((b) * 2 + (h)) * HTB)
#define PG8_SB(b, h) ((4 + (b) * 2 + (h)) * HTB)
#define PG8_STAGE(bufoff, gbase, voff) do { _Pragma("unroll") for (int _i = 0; _i < 2; ++_i) \
        __builtin_amdgcn_global_load_lds((const unsigned*)((const char*)(gbase) + (voff)[_i]), (PG8_LAS unsigned*)(lds + (bufoff) + ldsw + _i * 8192), 16, 0, 0); } while (0)
#define PG8_LDA(dst, b, h) do { if constexpr (FP8) { _Pragma("unroll") for (int m = 0; m < 4; ++m) { const u32x4 l_ = *(const PG8_LAS u32x4*)(lds + PG8_SA(b, h) + aoffF0 + m * 2048), h_ = *(const PG8_LAS u32x4*)(lds + PG8_SA(b, h) + aoffF0 + m * 2048 + 16); \
            dst##8[m] = (v8i_t){(int)l_.x, (int)l_.y, (int)l_.z, (int)l_.w, (int)h_.x, (int)h_.y, (int)h_.z, (int)h_.w}; } } \
        else { _Pragma("unroll") for (int m = 0; m < 4; ++m) _Pragma("unroll") for (int k = 0; k < 2; ++k) dst[m][k] = *(const PG8_LAS bf16x8*)(lds + PG8_SA(b, h) + aoff + m * 2048 + k * 1024); } } while (0)
#define PG8_LDB(dst, b, h) do { if constexpr (FP8) { _Pragma("unroll") for (int n = 0; n < 2; ++n) { const u32x4 l_ = *(const PG8_LAS u32x4*)(lds + PG8_SB(b, h) + boffF0 + n * 2048), h_ = *(const PG8_LAS u32x4*)(lds + PG8_SB(b, h) + boffF0 + n * 2048 + 16); \
            dst##8[n] = (v8i_t){(int)l_.x, (int)l_.y, (int)l_.z, (int)l_.w, (int)h_.x, (int)h_.y, (int)h_.z, (int)h_.w}; } } \
        else { _Pragma("unroll") for (int n = 0; n < 2; ++n) _Pragma("unroll") for (int k = 0; k < 2; ++k) dst[n][k] = *(const PG8_LAS bf16x8*)(lds + PG8_SB(b, h) + boff + n * 2048 + k * 1024); } } while (0)
#define PG8_MMA(ai, bj, At, Bt) do { __builtin_amdgcn_s_setprio(1); \
        if constexpr (FP8) { _Pragma("unroll") for (int m = 0; m < 4; ++m) _Pragma("unroll") for (int n = 0; n < 2; ++n) \
            asm volatile("v_mfma_scale_f32_16x16x128_f8f6f4 %0, %1, %2, %0, %3, %3 op_sel_hi:[0,0,0]" : "+v"(acc[ai][bj][m][n]) : "v"(Bt##8[n]), "v"(At##8[m]), "v"(mxone)); } \
        else { _Pragma("unroll") for (int m = 0; m < 4; ++m) _Pragma("unroll") for (int n = 0; n < 2; ++n) _Pragma("unroll") for (int k = 0; k < 2; ++k) \
            acc[ai][bj][m][n] = __builtin_amdgcn_mfma_f32_16x16x32_bf16(Bt[n][k], At[m][k], acc[ai][bj][m][n], 0, 0, 0); } \
        __builtin_amdgcn_s_setprio(0); } while (0)
#define PG8_WAIT_V(n) asm volatile("s_waitcnt vmcnt(" #n ")" ::: "memory")
#define PG8_WAIT_L(n) asm volatile("s_waitcnt lgkmcnt(" #n ")" ::: "memory")
#define PG8_BAR __builtin_amdgcn_s_barrier()
#define PG8_SCHED __builtin_amdgcn_sched_barrier(0)
    Unit cur, nxt; int ui = 0;
    if (!S.next(0, cur)) return;
    f32x4 acc[2][2][4][2];
#pragma unroll
    for (int a = 0; a < 2; ++a)
#pragma unroll
        for (int b = 0; b < 2; ++b)
#pragma unroll
            for (int m = 0; m < 4; ++m)
#pragma unroll
                for (int n = 0; n < 2; ++n) acc[a][b][m][n] = (f32x4){0.f, 0.f, 0.f, 0.f};
    bf16x8 At[4][2], B0[2][2], B1[2][2]; v8i_t At8[4], B08[2], B18[2];
    int mxone = 0x7F7F7F7F; asm volatile("" : "+v"(mxone));
    const char* cA = (const char*)g.A + (size_t)cur.pm * tstep; const char* cB = (const char*)g.Bt + (size_t)cur.pn * tstep;
    S.a_ready(cur);
    if constexpr (SP2) {
        PG8_STAGE(PG8_SB(0, 0), cB, voffB); PG8_STAGE(PG8_SB(0, 1), cB + hstep, voffB); PG8_STAGE(PG8_SA(0, 0), cA, voffA); PG8_STAGE(PG8_SA(0, 1), cA + hstep, voffA);
        if (wr == 1) PG8_BAR;
        PG8_WAIT_V(2); PG8_BAR;
        PG8_STAGE(PG8_SB(1, 0), cB + kstep, voffB); PG8_STAGE(PG8_SA(1, 0), cA + kstep, voffA); PG8_STAGE(PG8_SB(1, 1), cB + hstep + kstep, voffB);
        PG8_WAIT_V(6); PG8_BAR;
    } else {
        PG8_STAGE(PG8_SB(0, 0), cB, voffB); PG8_STAGE(PG8_SA(0, 0), cA, voffA); PG8_STAGE(PG8_SB(0, 1), cB + hstep, voffB); PG8_STAGE(PG8_SA(0, 1), cA + hstep, voffA);
        if (wr == 1) PG8_BAR;
        PG8_WAIT_V(4); PG8_BAR;
        PG8_STAGE(PG8_SB(1, 0), cB + kstep, voffB); PG8_STAGE(PG8_SA(1, 0), cA + kstep, voffA); PG8_STAGE(PG8_SB(1, 1), cB + hstep + kstep, voffB);
        PG8_WAIT_V(6); PG8_BAR;
    }
    for (;;) {
        const bool has_next = S.next(ui + 1, nxt);
        const char* nA = has_next ? (const char*)g.A + (size_t)nxt.pm * tstep : cA; const char* nB = has_next ? (const char*)g.Bt + (size_t)nxt.pn * tstep : cB;
#pragma unroll 1
        for (int t = 0; t < nt; t += 2) {
            if constexpr (Epi::MID) { if (t == nt / 2) E.mid(acc, cur, wr, wc, fr, fq); }
            const bool last = (t == nt - 2);
            const char* a1 = cA + (size_t)(t + 1) * kstep;
            const char* a2 = last ? nA : cA + (size_t)(t + 2) * kstep; const char* b2 = last ? nB : cB + (size_t)(t + 2) * kstep;
            const char* a3 = a2 + kstep; const char* b3 = b2 + kstep;
            if (last && has_next) S.a_ready(nxt);
            if constexpr (SP2) {
            PG8_LDB(B0, 0, 0); PG8_LDB(B1, 0, 1); PG8_SCHED; PG8_LDA(At, 0, 0); PG8_STAGE(PG8_SA(1, 1), a1 + hstep, voffA);
            PG8_WAIT_V(8); PG8_WAIT_L(0); PG8_BAR; PG8_MMA(0, 0, At, B0); PG8_MMA(0, 1, At, B1); PG8_BAR; PG8_SCHED;
            PG8_LDA(At, 0, 1); PG8_STAGE(PG8_SB(0, 0), b2, voffB); PG8_STAGE(PG8_SB(0, 1), b2 + hstep, voffB); PG8_STAGE(PG8_SA(0, 0), a2, voffA);
            PG8_WAIT_V(8); PG8_WAIT_L(0); PG8_BAR; PG8_MMA(1, 0, At, B0); PG8_MMA(1, 1, At, B1); PG8_BAR; PG8_SCHED;
            PG8_LDB(B0, 1, 0); PG8_LDB(B1, 1, 1); PG8_SCHED; PG8_LDA(At, 1, 0); PG8_STAGE(PG8_SA(0, 1), a2 + hstep, voffA);
            PG8_WAIT_V(8); PG8_WAIT_L(0); PG8_BAR; PG8_MMA(0, 0, At, B0); PG8_MMA(0, 1, At, B1); PG8_BAR; PG8_SCHED;
            PG8_LDA(At, 1, 1); PG8_STAGE(PG8_SB(1, 0), b3, voffB); PG8_STAGE(PG8_SB(1, 1), b3 + hstep, voffB); PG8_STAGE(PG8_SA(1, 0), a3, voffA);
            PG8_WAIT_V(8); PG8_WAIT_L(0); PG8_BAR; PG8_MMA(1, 0, At, B0); PG8_MMA(1, 1, At, B1); PG8_BAR; PG8_SCHED;
            } else {
            PG8_LDB(B0, 0, 0); PG8_SCHED; PG8_LDA(At, 0, 0); PG8_STAGE(PG8_SA(1, 1), a1 + hstep, voffA);
            PG8_WAIT_L(8); PG8_BAR; PG8_WAIT_L(0); PG8_MMA(0, 0, At, B0); PG8_BAR; PG8_SCHED;
            PG8_LDB(B1, 0, 1); PG8_STAGE(PG8_SB(0, 0), b2, voffB);
            PG8_BAR; PG8_WAIT_L(0); PG8_MMA(0, 1, At, B1); PG8_BAR;
            PG8_LDA(At, 0, 1); PG8_STAGE(PG8_SA(0, 0), a2, voffA);
            PG8_BAR; PG8_WAIT_L(0); PG8_MMA(1, 0, At, B0); PG8_BAR; PG8_SCHED;
            PG8_STAGE(PG8_SB(0, 1), b2 + hstep, voffB);
            PG8_WAIT_V(6); PG8_BAR; PG8_MMA(1, 1, At, B1); PG8_BAR;
            PG8_LDB(B0, 1, 0); PG8_SCHED; PG8_LDA(At, 1, 0); PG8_STAGE(PG8_SA(0, 1), a2 + hstep, voffA);
            PG8_WAIT_L(8); PG8_BAR; PG8_WAIT_L(0); PG8_MMA(0, 0, At, B0); PG8_BAR; PG8_SCHED;
            PG8_LDB(B1, 1, 1); PG8_STAGE(PG8_SB(1, 0), b3, voffB);
            PG8_BAR; PG8_WAIT_L(0); PG8_MMA(0, 1, At, B1); PG8_BAR;
            PG8_LDA(At, 1, 1); PG8_STAGE(PG8_SA(1, 0), a3, voffA);
            PG8_BAR; PG8_WAIT_L(0); PG8_MMA(1, 0, At, B0); PG8_BAR; PG8_SCHED;
            PG8_STAGE(PG8_SB(1, 1), b3 + hstep, voffB);
            PG8_WAIT_V(6); PG8_BAR; PG8_MMA(1, 1, At, B1); PG8_BAR;
            }
        }
        if constexpr (ALIGN_EPI) { if (wr == 0) PG8_BAR; }
        if constexpr (FP8) { asm volatile("s_nop 15\n\ts_nop 7" ::: "memory"); PG8_SCHED; }
        if constexpr (!Epi::AFTER_DRAIN) { E(acc, cur, wr, wc, fr, fq); S.done(cur); }
        if (!has_next) break;
#pragma unroll
        for (int a = 0; a < 2; ++a)
#pragma unroll
            for (int b = 0; b < 2; ++b)
#pragma unroll
                for (int m = 0; m < 4; ++m)
#pragma unroll
                    for (int n = 0; n < 2; ++n) acc[a][b][m][n] = (f32x4){0.f, 0.f, 0.f, 0.f};
        cur = nxt; cA = nA; cB = nB; ++ui;
        if constexpr (ALIGN_EPI) { if (wr == 1) PG8_BAR; }
    }
    PG8_WAIT_V(0);
    if constexpr (!ALIGN_EPI) { if (wr == 0) PG8_BAR; }
    PG8_BAR;
    if constexpr (Epi::AFTER_DRAIN) { E.fused(acc, cur, wr, wc, fr, fq, lds, wid, lane); S.done(cur); }
#undef PG8_SA
#undef PG8_SB
#undef PG8_STAGE
#undef PG8_LDA
#undef PG8_LDB
#undef PG8_MMA
#undef PG8_WAIT_V
#undef PG8_WAIT_L
#undef PG8_BAR
#undef PG8_SCHED
}
}

__device__ __forceinline__ float lambda_full(const Ptrs& P) {
    float a = 0.f, b = 0.f;
    for (int i = 0; i < 64; ++i) { a += P.lq1[i] * P.lk1[i]; b += P.lq2[i] * P.lk2[i]; }
    return __expf(a) - __expf(b) + 0.2f;
}

namespace att {
typedef short bf16x8 __attribute__((ext_vector_type(8)));
typedef short s16x4 __attribute__((ext_vector_type(4)));
typedef float f32x16 __attribute__((ext_vector_type(16)));
typedef float f32x2_t __attribute__((ext_vector_type(2)));
typedef __attribute__((address_space(3))) const char* lds_cptr;
typedef __attribute__((address_space(3))) char* lds_ptr;
__device__ __forceinline__ int crow(int r, int hi) { return (r & 3) + 8 * (r >> 2) + 4 * hi; }
__device__ __forceinline__ void glds16(const void* gsrc, unsigned lds_dst) { unsigned keep;
    asm volatile("s_mov_b32 %0, m0\n\ts_mov_b32 m0, %2\n\ts_nop 0\n\tglobal_load_lds_dwordx4 %1, off\n\ts_mov_b32 m0, %0" : "=&s"(keep) : "v"(gsrc), "s"(lds_dst) : "memory"); }
__device__ __forceinline__ unsigned cvtpk(float lo, float hi) { f32x2_t v = {lo, hi}; bf16x2_t b = __builtin_convertvector(v, bf16x2_t); return __builtin_bit_cast(unsigned, b); }
#define ATT_WAIT_BAR(N) asm volatile("s_waitcnt vmcnt(" #N ") lgkmcnt(0)\n\ts_barrier" ::: "memory")
#define ATT_LDSWAIT() asm volatile("s_waitcnt lgkmcnt(0)" ::: "memory")
#define ATT_SBAR() __builtin_amdgcn_sched_barrier(0)
template <bool REL> __device__ __forceinline__ void qkt(f32x16& p0, f32x16& p1, lds_cptr Kslot, const bf16x8* qr, const f32x16& negm, int r32, int hi) {
    lds_cptr kb = Kslot + hi * 1024 + r32 * 16;
#pragma unroll
    for (int d0 = 0; d0 < 4; ++d0) {
        const bf16x8 b0 = *(const __attribute__((address_space(3))) bf16x8*)(kb + d0 * 2048);
        const bf16x8 b1 = *(const __attribute__((address_space(3))) bf16x8*)(kb + d0 * 2048 + 512);
        if (d0 == 0) { if (REL) { p0 = __builtin_amdgcn_mfma_f32_32x32x16_bf16(b0, qr[0], negm, 0, 0, 0); p1 = __builtin_amdgcn_mfma_f32_32x32x16_bf16(b1, qr[0], negm, 0, 0, 0); }
                       else { p0 = __builtin_amdgcn_mfma_f32_32x32x16_bf16(b0, qr[0], f32x16{}, 0, 0, 0); p1 = __builtin_amdgcn_mfma_f32_32x32x16_bf16(b1, qr[0], f32x16{}, 0, 0, 0); } }
        else { p0 = __builtin_amdgcn_mfma_f32_32x32x16_bf16(b0, qr[d0], p0, 0, 0, 0); p1 = __builtin_amdgcn_mfma_f32_32x32x16_bf16(b1, qr[d0], p1, 0, 0, 0); } }
}
__device__ __forceinline__ float rowmax32(const f32x16& p0, const f32x16& p1) {
    float a = fmaxf(p0[0], p1[0]);
#pragma unroll
    for (int r = 1; r < 16; ++r) a = fmaxf(a, fmaxf(p0[r], p1[r]));
    auto rr = __builtin_amdgcn_permlane32_swap(__float_as_uint(a), __float_as_uint(a), false, false);
    return fmaxf(__uint_as_float(rr[0]), __uint_as_float(rr[1]));
}
__device__ __forceinline__ float halfsum(float a) { auto rr = __builtin_amdgcn_permlane32_swap(__float_as_uint(a), __float_as_uint(a), false, false); return __uint_as_float(rr[0]) + __uint_as_float(rr[1]); }
#define ATT_VREAD(lo, hi, d0) do { _Pragma("unroll") for (int ks = 0; ks < 4; ++ks) { \
        asm volatile("ds_read_b64_tr_b16 %0,%1 offset:%c2" : "=&v"(lo[ks]) : "v"(vb), "i"((d0) * 4096 + ks * 1024) : "memory"); \
        asm volatile("ds_read_b64_tr_b16 %0,%1 offset:%c2" : "=&v"(hi[ks]) : "v"(vb), "i"((d0) * 4096 + ks * 1024 + 512) : "memory"); } } while (0)
#define ATT_PK(lo, hi, k) (bf16x8){lo[k][0], lo[k][1], lo[k][2], lo[k][3], hi[k][0], hi[k][1], hi[k][2], hi[k][3]}
#define ATT_PVMMA(lo, hi, d0) do { \
        o[d0] = __builtin_amdgcn_mfma_f32_32x32x16_bf16(pa0, ATT_PK(lo, hi, 0), o[d0], 0, 0, 0); o[d0] = __builtin_amdgcn_mfma_f32_32x32x16_bf16(pa1, ATT_PK(lo, hi, 1), o[d0], 0, 0, 0); \
        o[d0] = __builtin_amdgcn_mfma_f32_32x32x16_bf16(pa2, ATT_PK(lo, hi, 2), o[d0], 0, 0, 0); o[d0] = __builtin_amdgcn_mfma_f32_32x32x16_bf16(pa3, ATT_PK(lo, hi, 3), o[d0], 0, 0, 0); } while (0)
template <int ND0> __device__ __forceinline__ void pv(f32x16* o, int vb, bf16x8 pa0, bf16x8 pa1, bf16x8 pa2, bf16x8 pa3) {
    s16x4 loA[4], hiA[4], loB[4], hiB[4];
    ATT_VREAD(loA, hiA, 0);
#pragma unroll
    for (int d0 = 0; d0 < ND0; d0 += 2) {
        if (d0 + 1 < ND0) { ATT_VREAD(loB, hiB, d0 + 1); asm volatile("s_waitcnt lgkmcnt(8)" ::: "memory"); } else { asm volatile("s_waitcnt lgkmcnt(0)" ::: "memory"); }
        ATT_SBAR();
        ATT_PVMMA(loA, hiA, d0);
        if (d0 + 1 < ND0) {
            if (d0 + 2 < ND0) { ATT_VREAD(loA, hiA, d0 + 2); asm volatile("s_waitcnt lgkmcnt(8)" ::: "memory"); } else { asm volatile("s_waitcnt lgkmcnt(0)" ::: "memory"); }
            ATT_SBAR();
            ATT_PVMMA(loB, hiB, d0 + 1);
        }
    }
}
#undef ATT_VREAD
#undef ATT_PVMMA
#undef ATT_PK
template <int ND0, int THR, bool REL> __device__ __forceinline__ void softmax_tile(f32x16& p0, f32x16& p1, float& mrun, float& lsum, f32x16& negm, bool first, f32x16* o, __attribute__((address_space(3))) float* wsf, int r32, int hi,
                                                                   u32x4& pw0, u32x4& pw1, u32x4& pw2, u32x4& pw3) {
    float rm = rowmax32(p0, p1);
    if (!REL) rm -= mrun;
    if (first) {
        mrun = REL ? rm : mrun + rm;
        if (REL) {
#pragma unroll
            for (int r = 0; r < 16; ++r) { p0[r] -= rm; p1[r] -= rm; negm[r] = -mrun; } }
    } else if (__any(rm > (float)THR)) {
        const float dl = fmaxf(rm, 0.f), alpha = __builtin_amdgcn_exp2f(-dl); lsum *= alpha; mrun += dl;
        if (REL) {
#pragma unroll
            for (int r = 0; r < 16; ++r) { p0[r] -= dl; p1[r] -= dl; negm[r] = -mrun; } }
        if (hi == 0) wsf[r32] = alpha;
        ATT_LDSWAIT();
#pragma unroll
        for (int g = 0; g < 4; ++g) { const f32x4 a4 = *(const __attribute__((address_space(3))) f32x4*)(wsf + 8 * g + 4 * hi);
#pragma unroll
            for (int d0 = 0; d0 < ND0; ++d0) { o[d0][4 * g + 0] *= a4[0]; o[d0][4 * g + 1] *= a4[1]; o[d0][4 * g + 2] *= a4[2]; o[d0][4 * g + 3] *= a4[3]; } }
        ATT_LDSWAIT();
    }
    float s = 0.f;
#pragma unroll
    for (int r = 0; r < 16; ++r) { p0[r] = __builtin_amdgcn_exp2f(REL ? p0[r] : p0[r] - mrun); p1[r] = __builtin_amdgcn_exp2f(REL ? p1[r] : p1[r] - mrun); s += p0[r] + p1[r]; }
    lsum += s;
    pw0 = (u32x4){cvtpk(p0[0], p0[1]), cvtpk(p0[2], p0[3]), cvtpk(p0[4], p0[5]), cvtpk(p0[6], p0[7])};
    pw1 = (u32x4){cvtpk(p0[8], p0[9]), cvtpk(p0[10], p0[11]), cvtpk(p0[12], p0[13]), cvtpk(p0[14], p0[15])};
    pw2 = (u32x4){cvtpk(p1[0], p1[1]), cvtpk(p1[2], p1[3]), cvtpk(p1[4], p1[5]), cvtpk(p1[6], p1[7])};
    pw3 = (u32x4){cvtpk(p1[8], p1[9]), cvtpk(p1[10], p1[11]), cvtpk(p1[12], p1[13]), cvtpk(p1[14], p1[15])};
}

constexpr int A_SLOTK = 8192, A_SLOTV = 16384, A_NS = 3, A_NSV = 4;
constexpr int A_LDS_K = 0, A_LDS_V = A_NS * A_SLOTK, A_LDS_WS = A_LDS_V + A_NSV * A_SLOTV, A_LDS_ST = A_LDS_WS + 8 * 256, A_LDS_BYTES = A_LDS_ST + 8 * 8192;
__device__ __forceinline__ void attn_a_unit(int b, int h, int qb, const bf16_t* proj, bf16_t* ya, const float* subln, float lam, unsigned char* shm) {
    int tid_l = threadIdx.x; asm volatile("" : "+v"(tid_l));
    const int tid = tid_l, lane = tid & 63, r32 = lane & 31, hi = lane >> 5; const int wid = __builtin_amdgcn_readfirstlane(tid >> 6);
    const size_t rowbase = (size_t)b * SEQ; const int q0 = qb * 256;
    constexpr int NT = SEQ / 64;
    const unsigned lds0 = (unsigned)(uintptr_t)shm;
    const lds_cptr shm3 = (lds_cptr)shm;
    __attribute__((address_space(3))) float* wsf = (__attribute__((address_space(3))) float*)((lds_ptr)shm + A_LDS_WS) + wid * 64;
    const int vb0 = (int)(lds0 + A_LDS_V) + ((lane >> 4) & 1) * 32 + (lane & 3) * 8 + (4 * hi + ((lane & 15) >> 2)) * 64;
    __attribute__((address_space(3))) bf16_t* stg = (__attribute__((address_space(3))) bf16_t*)((lds_ptr)shm + A_LDS_ST) + wid * 4096;
    for (int mp = 0; mp < 2; ++mp) {
        const bf16_t* Kh = proj + rowbase * INW + C_KA + h * 128 + mp * 64;
        const bf16_t* Vh = proj + rowbase * INW + C_VA + h * 128;
        const bf16_t* Qw = proj + (rowbase + q0 + wid * 32) * INW + C_QA + h * 128 + mp * 64;
        const int pA = 2 * wid, pB = 2 * wid + 1;
        const unsigned kdst = lds0 + A_LDS_K + wid * 1024, vdstA = lds0 + A_LDS_V + pA * 1024, vdstB = lds0 + A_LDS_V + pB * 1024;
#define A_DMA(t, slot, vsl) do { int ln_ = lane; asm volatile("" : "+v"(ln_)); \
        const bf16_t* ksrc_ = Kh + (size_t)((t) * 64 + ln_) * INW + wid * 8; \
        const bf16_t* vsrcA_ = Vh + (size_t)((t) * 64 + 16 * (pA & 3) + (ln_ >> 2)) * INW + (pA >> 2) * 32 + (ln_ & 3) * 8; \
        const bf16_t* vsrcB_ = Vh + (size_t)((t) * 64 + 16 * (pB & 3) + (ln_ >> 2)) * INW + (pB >> 2) * 32 + (ln_ & 3) * 8; \
        glds16(ksrc_, (unsigned)__builtin_amdgcn_readfirstlane(kdst + (slot) * A_SLOTK)); \
        glds16(vsrcA_, (unsigned)__builtin_amdgcn_readfirstlane(vdstA + (vsl) * A_SLOTV)); \
        glds16(vsrcB_, (unsigned)__builtin_amdgcn_readfirstlane(vdstB + (vsl) * A_SLOTV)); } while (0)
        A_DMA(0, 0, 0); A_DMA(1, 1, 1);
        bf16x8 qr[4];
#pragma unroll
        for (int d0 = 0; d0 < 4; ++d0) qr[d0] = *(const bf16x8*)(Qw + (size_t)r32 * INW + d0 * 16 + hi * 8);
        f32x16 o[4]; o[0] = f32x16{}; o[1] = f32x16{}; o[2] = f32x16{}; o[3] = f32x16{};
        float mrun = 0.f, lsum = 0.f; f32x16 negm = f32x16{};
        int slot = 0, slot2 = 2, vslot = 0, vslot2 = 2, vprev = 3;
        const bool late = wid >= 4;
        u32x4 pw0 = {}, pw1 = {}, pw2 = {}, pw3 = {};
        for (int t = 0; t < NT; ++t) {
            if (t + 1 < NT) { ATT_WAIT_BAR(3); } else { ATT_WAIT_BAR(0); }
            if (t + 2 < NT) A_DMA(t + 2, slot2, vslot2);
            if (late && t > 0) pv<4>(o, vb0 + vprev * A_SLOTV, __builtin_bit_cast(bf16x8, pw0), __builtin_bit_cast(bf16x8, pw1), __builtin_bit_cast(bf16x8, pw2), __builtin_bit_cast(bf16x8, pw3));
            f32x16 p0, p1;
            qkt<false>(p0, p1, shm3 + A_LDS_K + slot * A_SLOTK, qr, negm, r32, hi);
            softmax_tile<4, 8, false>(p0, p1, mrun, lsum, negm, t == 0, o, wsf, r32, hi, pw0, pw1, pw2, pw3);
            if (!late) pv<4>(o, vb0 + vslot * A_SLOTV, __builtin_bit_cast(bf16x8, pw0), __builtin_bit_cast(bf16x8, pw1), __builtin_bit_cast(bf16x8, pw2), __builtin_bit_cast(bf16x8, pw3));
            slot = (slot == 2) ? 0 : slot + 1; slot2 = (slot2 == 2) ? 0 : slot2 + 1;
            vprev = vslot; vslot = (vslot + 1) & 3; vslot2 = (vslot2 + 1) & 3;
        }
        if (late) pv<4>(o, vb0 + vprev * A_SLOTV, __builtin_bit_cast(bf16x8, pw0), __builtin_bit_cast(bf16x8, pw1), __builtin_bit_cast(bf16x8, pw2), __builtin_bit_cast(bf16x8, pw3));
#undef A_DMA
        const float lt = halfsum(lsum);
        if (hi == 0) wsf[32 + r32] = lt;
        ATT_LDSWAIT();
        float rli[16];
#pragma unroll
        for (int g = 0; g < 4; ++g) { const f32x4 l4 = *(const __attribute__((address_space(3))) f32x4*)(wsf + 32 + 8 * g + 4 * hi);
            rli[4 * g + 0] = __builtin_amdgcn_rcpf(l4[0]); rli[4 * g + 1] = __builtin_amdgcn_rcpf(l4[1]); rli[4 * g + 2] = __builtin_amdgcn_rcpf(l4[2]); rli[4 * g + 3] = __builtin_amdgcn_rcpf(l4[3]); }
        ATT_LDSWAIT();
        if (mp == 0) {
#pragma unroll
            for (int d0 = 0; d0 < 4; ++d0)
#pragma unroll
                for (int r = 0; r < 16; ++r) stg[crow(r, hi) * 128 + d0 * 32 + r32] = (bf16_t)f2bf(o[d0][r] * rli[r]);
            asm volatile("s_waitcnt lgkmcnt(0)\n\ts_barrier" ::: "memory");
        } else {
            float ss[16];
#pragma unroll
            for (int r = 0; r < 16; ++r) ss[r] = 0.f;
#pragma unroll
            for (int d0 = 0; d0 < 4; ++d0)
#pragma unroll
                for (int r = 0; r < 16; ++r) { const float a = bf2f(stg[crow(r, hi) * 128 + d0 * 32 + r32]); const float y = a - lam * o[d0][r] * rli[r]; o[d0][r] = y; ss[r] += y * y; }
#pragma unroll
            for (int r = 0; r < 16; ++r) { float v = ss[r]; v += __shfl_xor(v, 1); v += __shfl_xor(v, 2); v += __shfl_xor(v, 4); v += __shfl_xor(v, 8); v += __shfl_xor(v, 16);
                ss[r] = 0.8f / sqrtf(v * (1.f / 128.f) + EPS); }
            ATT_LDSWAIT();
#pragma unroll
            for (int d0 = 0; d0 < 4; ++d0) { const float gsub = subln[d0 * 32 + r32];
#pragma unroll
                for (int r = 0; r < 16; ++r) stg[crow(r, hi) * 128 + d0 * 32 + r32] = (bf16_t)f2bf(o[d0][r] * ss[r] * gsub); }
            ATT_LDSWAIT();
            bf16_t* Yw = ya + (rowbase + q0 + wid * 32) * 1024 + h * 128;
#pragma unroll
            for (int i = 0; i < 8; ++i) { const int row = i * 4 + (lane >> 4), ch = lane & 15; const u32x4 v = *(const __attribute__((address_space(3))) u32x4*)(stg + row * 128 + ch * 8); *(u32x4*)(Yw + (size_t)row * 1024 + ch * 8) = v; }
            asm volatile("s_waitcnt lgkmcnt(0)\n\ts_barrier" ::: "memory");
        }
    }
}

constexpr int B_SLOT = 8192, B_NS = 6, B_PF = 5;
constexpr int B_LDS_K = 0, B_LDS_V = B_NS * B_SLOT, B_LDS_WS = 2 * B_NS * B_SLOT, B_LDS_BIAS = B_LDS_WS + 8 * 256, B_LDS_ST = B_LDS_BIAS + 2560, B_LDS_BYTES = B_LDS_ST + 8 * 4096;
__device__ __forceinline__ void attn_b_unit(int b, int h, int rg, const bf16_t* proj, bf16_t* yb, const float* rpb, unsigned char* shm) {
    int tid_l = threadIdx.x; asm volatile("" : "+v"(tid_l));
    const int tid = tid_l, lane = tid & 63, r32 = lane & 31, hi = lane >> 5; const int wid = __builtin_amdgcn_readfirstlane(tid >> 6);
    const size_t rowbase = (size_t)b * SEQ;
    const int r = 4 * rg + (wid >> 1), c0 = 32 * (wid & 1);
    int rs = r - 4; rs = rs < 0 ? 0 : (rs > 24 ? 24 : rs);
    int rmin = 4 * rg - 4; rmin = rmin < 0 ? 0 : (rmin > 24 ? 24 : rmin);
    int rmaxs = 4 * rg + 3 - 4; rmaxs = rmaxs < 0 ? 0 : (rmaxs > 24 ? 24 : rmaxs);
    const int ntile = rmaxs + 8 - rmin;
    const unsigned lds0 = (unsigned)(uintptr_t)shm;
    const lds_cptr shm3 = (lds_cptr)shm;
    __attribute__((address_space(3))) float* wsf = (__attribute__((address_space(3))) float*)((lds_ptr)shm + B_LDS_WS) + wid * 64;
    __attribute__((address_space(3))) float* bias = (__attribute__((address_space(3))) float*)((lds_ptr)shm + B_LDS_BIAS) + 64;
    __attribute__((address_space(3))) bf16_t* stg = (__attribute__((address_space(3))) bf16_t*)((lds_ptr)shm + B_LDS_ST) + wid * 2048;
    const int vb0 = (int)(lds0 + B_LDS_V) + ((lane >> 4) & 1) * 32 + (lane & 3) * 8 + (4 * hi + ((lane & 15) >> 2)) * 64;
    for (int i = tid; i < 640; i += 512) { const int e = i - 64, ri = e >> 5, cj = e & 31; bias[e] = (e >= 0 && e < 480 && cj < 31) ? rpb[(h * 15 + ri) * 31 + cj] * LOG2E : 0.f; }
    const bf16_t* Kh = proj + rowbase * INW + C_KB + h * 64;
    const bf16_t* Vh = proj + rowbase * INW + C_VB + h * 64;
    const bf16_t* Qw = proj + (rowbase + r * 64 + c0) * INW + C_QB + h * 64;
    const unsigned kdst = lds0 + B_LDS_K + wid * 1024, vdst = lds0 + B_LDS_V + wid * 1024;
#define B_DMA(t, slot) do { int ln_ = lane; asm volatile("" : "+v"(ln_)); \
    const bf16_t* ksrc_ = Kh + (size_t)((rmin + (t)) * 64 + ln_) * INW + wid * 8; \
    const bf16_t* vsrc_ = Vh + (size_t)((rmin + (t)) * 64 + 16 * (wid & 3) + (ln_ >> 2)) * INW + (wid >> 2) * 32 + (ln_ & 3) * 8; \
    glds16(ksrc_, (unsigned)__builtin_amdgcn_readfirstlane(kdst + (slot) * B_SLOT)); \
    glds16(vsrc_, (unsigned)__builtin_amdgcn_readfirstlane(vdst + (slot) * B_SLOT)); } while (0)
#pragma unroll
    for (int t = 0; t < B_PF; ++t) B_DMA(t, t);
    bf16x8 qr[4];
#pragma unroll
    for (int d0 = 0; d0 < 4; ++d0) qr[d0] = *(const bf16x8*)(Qw + (size_t)r32 * INW + d0 * 16 + hi * 8);
    f32x16 o[2]; o[0] = f32x16{}; o[1] = f32x16{};
    float mrun = 0.f, lsum = 0.f; f32x16 negm = f32x16{}; bool first = true;
    const int c = c0 + r32; int cs = c - 8; cs = cs < 0 ? 0 : (cs > 48 ? 48 : cs);
    float fm0[16], fm1[16];
#pragma unroll
    for (int rr = 0; rr < 16; ++rr) { const int j0 = crow(rr, hi); fm0[rr] = ((unsigned)(j0 - cs) < 16u) ? 0.f : -1e30f; fm1[rr] = ((unsigned)(j0 + 32 - cs) < 16u) ? 0.f : -1e30f; }
    int slot = 0, slotn = B_PF;
    for (int t = 0; t < ntile; ++t) {
        { const int rem = ntile - 1 - t;
          if (rem >= 4) { ATT_WAIT_BAR(8); } else if (rem == 3) { ATT_WAIT_BAR(6); } else if (rem == 2) { ATT_WAIT_BAR(4); } else if (rem == 1) { ATT_WAIT_BAR(2); } else { ATT_WAIT_BAR(0); } }
        if (t + B_PF < ntile) B_DMA(t + B_PF, slotn);
        const int kr = rmin + t;
        if (kr >= rs && kr < rs + 8) {
            f32x16 p0, p1; u32x4 pw0, pw1, pw2, pw3;
            qkt<true>(p0, p1, shm3 + B_LDS_K + slot * B_SLOT, qr, negm, r32, hi);
            const __attribute__((address_space(3))) float* bp = bias + ((kr - r + 7) * 32 + 15 - c + 4 * hi);
#pragma unroll
            for (int rr = 0; rr < 16; ++rr) { const int jj = (rr & 3) + 8 * (rr >> 2);
                p0[rr] += bp[jj] + fm0[rr]; p1[rr] += bp[jj + 32] + fm1[rr]; }
            softmax_tile<2, 8, true>(p0, p1, mrun, lsum, negm, first, o, wsf, r32, hi, pw0, pw1, pw2, pw3); first = false;
            pv<2>(o, vb0 + slot * B_SLOT, __builtin_bit_cast(bf16x8, pw0), __builtin_bit_cast(bf16x8, pw1), __builtin_bit_cast(bf16x8, pw2), __builtin_bit_cast(bf16x8, pw3));
        }
        slot = (slot == B_NS - 1) ? 0 : slot + 1; slotn = (slotn == B_NS - 1) ? 0 : slotn + 1;
    }
#undef B_DMA
    const float lt = halfsum(lsum);
    if (hi == 0) wsf[32 + r32] = lt;
    ATT_LDSWAIT();
    float rli[16];
#pragma unroll
    for (int g = 0; g < 4; ++g) { const f32x4 l4 = *(const __attribute__((address_space(3))) f32x4*)(wsf + 32 + 8 * g + 4 * hi);
        rli[4 * g + 0] = __builtin_amdgcn_rcpf(l4[0]); rli[4 * g + 1] = __builtin_amdgcn_rcpf(l4[1]); rli[4 * g + 2] = __builtin_amdgcn_rcpf(l4[2]); rli[4 * g + 3] = __builtin_amdgcn_rcpf(l4[3]); }
#pragma unroll
    for (int d0 = 0; d0 < 2; ++d0)
#pragma unroll
        for (int rr = 0; rr < 16; ++rr) stg[crow(rr, hi) * 64 + d0 * 32 + r32] = (bf16_t)f2bf(o[d0][rr] * rli[rr]);
    ATT_LDSWAIT();
    bf16_t* Yw = yb + (rowbase + r * 64 + c0) * 1024 + 512 + h * 64;
#pragma unroll
    for (int i = 0; i < 4; ++i) { const int row = i * 8 + (lane >> 3), ch = lane & 7; const u32x4 v = *(const __attribute__((address_space(3))) u32x4*)(stg + row * 64 + ch * 8); *(u32x4*)(Yw + (size_t)row * 1024 + ch * 8) = v; }
    asm volatile("s_waitcnt lgkmcnt(0)\n\ts_barrier" ::: "memory");
}
}

namespace peer {
typedef short bf16x8 __attribute__((ext_vector_type(8)));
typedef float f32x16 __attribute__((ext_vector_type(16)));
typedef __attribute__((address_space(3))) const char* lds_cptr;
constexpr int T_LDS_SK = 0, T_LDS_BYTES = 65536;
__device__ __forceinline__ int imax(int a, int b) { int r; asm("v_max_f32 %0, %1, %2" : "=v"(r) : "v"(a), "v"(b)); return r; }
__device__ __forceinline__ int imin(int a, int b) { int r; asm("v_min_f32 %0, %1, %2" : "=v"(r) : "v"(a), "v"(b)); return r; }
__device__ __forceinline__ int f2key(float s, int idx) { return (__float_as_int(s) & ~127) | idx; }
__device__ __forceinline__ int key2bits(int k) { return k; }
template <int N, int OFF, int TOT> __device__ __forceinline__ void bsort_desc(int (&a)[TOT]) {
#pragma unroll
    for (int k = 2; k <= N; k <<= 1)
#pragma unroll
        for (int j = k >> 1; j > 0; j >>= 1)
#pragma unroll
            for (int i = 0; i < N; ++i) { const int l = i ^ j; if (l > i) { const bool desc = (i & k) == 0; const int hi_ = imax(a[OFF + i], a[OFF + l]), lo_ = imin(a[OFF + i], a[OFF + l]); a[OFF + i] = desc ? hi_ : lo_; a[OFF + l] = desc ? lo_ : hi_; } }
}
template <int N, int OFF, int TOT> __device__ __forceinline__ void bmerge_desc(int (&a)[TOT]) {
#pragma unroll
    for (int j = N >> 1; j > 0; j >>= 1)
#pragma unroll
        for (int i = 0; i < N; ++i) { const int l = i ^ j; if (l > i) { const int hi_ = imax(a[OFF + i], a[OFF + l]), lo_ = imin(a[OFF + i], a[OFF + l]); a[OFF + i] = hi_; a[OFF + l] = lo_; } }
}
template <int A, int B, int TOT> __device__ __forceinline__ void merge_top16(int (&a)[TOT]) {
#pragma unroll
    for (int i = 0; i < 16; ++i) a[A + i] = imax(a[A + i], a[B + 15 - i]);
    bmerge_desc<16, A, TOT>(a);
}
__device__ __forceinline__ void cross_top16(int (&t)[16]) {
    int lo[16], hi[16];
#pragma unroll
    for (int i = 0; i < 16; ++i) { auto rr = __builtin_amdgcn_permlane32_swap((unsigned)t[i], (unsigned)t[i], false, false); lo[i] = (int)rr[0]; hi[i] = (int)rr[1]; }
#pragma unroll
    for (int i = 0; i < 16; ++i) t[i] = imax(lo[i], hi[15 - i]);
    bmerge_desc<16, 0, 16>(t);
}
__device__ __forceinline__ void half_top16(int (&top)[16], const bf16_t* qrow  , lds_cptr skp  , int hi) {
    f32x16 sc[4]; sc[0] = f32x16{}; sc[1] = f32x16{}; sc[2] = f32x16{}; sc[3] = f32x16{};
    bf16x8 qf[8];
#pragma unroll
    for (int ks = 0; ks < 8; ++ks) qf[ks] = *(const bf16x8*)(qrow + ks * 16);
#pragma unroll
    for (int ks = 0; ks < 8; ++ks)
#pragma unroll
        for (int kt = 0; kt < 4; ++kt) { const bf16x8 af = *(const __attribute__((address_space(3))) bf16x8*)(skp + ks * 4096 + kt * 512);
            sc[kt] = __builtin_amdgcn_mfma_f32_32x32x16_bf16(af, qf[ks], sc[kt], 0, 0, 0); }
    int k[64];
#pragma unroll
    for (int kt = 0; kt < 4; ++kt)
#pragma unroll
        for (int r = 0; r < 16; ++r) k[kt * 16 + r] = f2key(sc[kt][r], (32 * kt + (r & 3) + 8 * (r >> 2)) | (4 * hi));
    bsort_desc<16, 0, 64>(k); bsort_desc<16, 16, 64>(k); bsort_desc<16, 32, 64>(k); bsort_desc<16, 48, 64>(k);
    merge_top16<0, 16, 64>(k); merge_top16<32, 48, 64>(k); merge_top16<0, 32, 64>(k);
#pragma unroll
    for (int i = 0; i < 16; ++i) top[i] = k[i];
    cross_top16(top);
}
__device__ __forceinline__ void topk_wave(int tok0, int h, const bf16_t* Q, int* IDX, float* Gt, lds_cptr sk, int lane) {
    const int r32 = lane & 31, hi = lane >> 5, tok = tok0 + r32;
    const bf16_t* qrow = Q + (size_t)tok * PQ + h * 256 + 8 * hi;
    lds_cptr skl = sk + hi * 2048 + r32 * 16;
    int A0[16], A1[16];
    half_top16(A0, qrow, skl, hi);
    half_top16(A1, qrow + 128, skl + 32768, hi);
    float x[16], y[16]; int xw[16], yw[16];
#pragma unroll
    for (int a = 0; a < 16; ++a) { const int b0 = key2bits(A0[a]), b1 = key2bits(A1[a]);
        const float v0 = __int_as_float(b0 & ~127), v1 = __int_as_float(b1 & ~127); const int i0 = (b0 & 127) << 7, i1 = b1 & 127;
        x[a] = hi ? v1 : v0; y[a] = hi ? v0 : v1; xw[a] = hi ? i1 : i0; yw[a] = hi ? i0 : i1; }
    int w[32]; int n = 0;
#define PEER_CAND(a, b) do { const int bits = __float_as_int(x[a] + y[b]); int ww = (bits & ~0x3FFF) | (xw[a] + yw[b]); \
        if ((a) == (b) && hi) ww = (int)0xFF800000; w[n] = ww; ++n; } while (0)
#pragma unroll
    for (int b = 0; b < 16; ++b) PEER_CAND(0, b);
#pragma unroll
    for (int b = 1; b < 8; ++b) PEER_CAND(1, b);
#pragma unroll
    for (int b = 2; b < 5; ++b) PEER_CAND(2, b);
    PEER_CAND(3, 3);
#undef PEER_CAND
#pragma unroll
    for (int i = 27; i < 32; ++i) w[i] = (int)0xFF800000;
    bsort_desc<32, 0, 32>(w);
    int T[16];
#pragma unroll
    for (int i = 0; i < 16; ++i) T[i] = w[i];
    cross_top16(T);
    float sv[16]; int ev[16];
#pragma unroll
    for (int j = 0; j < 16; ++j) { ev[j] = T[j] & 0x3FFF; sv[j] = __int_as_float(T[j] & ~0x3FFF); }
    const float s0 = sv[0]; float esum = 0.f;
#pragma unroll
    for (int j = 0; j < 16; ++j) { sv[j] = __expf(sv[j] - s0); esum += sv[j]; }
    const float inv = 1.f / esum;
    if (hi == 0) { u32x4* io = (u32x4*)(IDX + ((size_t)tok * 8 + h) * 16);
#pragma unroll
        for (int j = 0; j < 4; ++j) io[j] = (u32x4){(unsigned)ev[4 * j], (unsigned)ev[4 * j + 1], (unsigned)ev[4 * j + 2], (unsigned)ev[4 * j + 3]}; }
    else { f32x4* go = (f32x4*)(Gt + ((size_t)tok * 8 + h) * 16);
#pragma unroll
        for (int j = 0; j < 4; ++j) go[j] = (f32x4){sv[4 * j] * inv, sv[4 * j + 1] * inv, sv[4 * j + 2] * inv, sv[4 * j + 3] * inv}; }
}
template <class Sched> __device__ __forceinline__ void topk_own_units(const Ptrs& P, unsigned char* shm, const Sched& S) {
    int tid_l = threadIdx.x; asm volatile("" : "+v"(tid_l));
    const int tid = tid_l, lane = tid & 63; const int wid = __builtin_amdgcn_readfirstlane(tid >> 6);
    const unsigned lds0 = (unsigned)(uintptr_t)shm;
    const bf16_t* SKg = (const bf16_t*)(P.ws + WS_SK);
    int hprev = -1; pg8::Unit u;
    for (int i = 0; S.next(i, u); ++i) {
        const int h = u.pn, tg = u.pm;
        if (h != hprev) { hprev = h;
            asm volatile("s_waitcnt lgkmcnt(0)\n\ts_barrier" ::: "memory");
#pragma unroll
            for (int j = 0; j < 8; ++j) { const int piece = wid * 8 + j, p = piece >> 5, c = (piece >> 1) & 15, kh = piece & 1;
                att::glds16(SKg + ((size_t)((h * 2 + p) * 128 + kh * 64 + lane) * 128 + c * 8), (unsigned)__builtin_amdgcn_readfirstlane(lds0 + p * 32768 + c * 2048 + kh * 1024)); }
            asm volatile("s_waitcnt vmcnt(0)\n\ts_barrier" ::: "memory");
        }
        topk_wave(tg * 256 + wid * 32, h, (const bf16_t*)(P.ws + WS_Q), (int*)(P.ws + WS_IDX), (float*)(P.ws + WS_G), (lds_cptr)shm, lane);
    }
}
}

namespace apply {
typedef float f32x2 __attribute__((ext_vector_type(2)));
typedef __attribute__((address_space(3))) unsigned* lds_u32p;
constexpr int AP_WAVE_BYTES = 4 * (512 + 2048), AP_LDS_BYTES = 8 * AP_WAVE_BYTES;
__device__ __forceinline__ float gelu_fast(float v) {
    const float av = fabsf(v), t = __builtin_amdgcn_rcpf(av * 0.2316418882f + 1.0f);
    float q = t * 0.5307027145f + (-0.7265760135f); q = q * t + 0.7107068705f; q = q * t + (-0.142248368f); q = q * t + 0.127414796f; q = q * t;
    const float e = __builtin_amdgcn_exp2f((v * v) * (-0.72134752044f));
    const float m = v * (q * e);
    return v < 0.f ? m : v - m;
}
#define AP_DPP(v, ctrl) __builtin_bit_cast(float, __builtin_amdgcn_update_dpp(0, __builtin_bit_cast(int, (v)), (ctrl), 0xF, 0xF, true))
__device__ __forceinline__ float row16_sum(float v) { v += AP_DPP(v, 0xB1); v += AP_DPP(v, 0x4E); v += AP_DPP(v, 0x141); v += AP_DPP(v, 0x140); return v; }
__device__ __forceinline__ void load_half(u32x4 (&r)[2], const unsigned char* img, unsigned e, int sub) {
    const unsigned off = e * 512u + (unsigned)(sub * 16);
    r[0] = *(const u32x4*)(img + off); r[1] = *(const u32x4*)(img + off + 256u);
}
constexpr int AP_PROBE_RING = 16;
constexpr int AP_RING = 8;
typedef __attribute__((address_space(3))) u32x4* lds_v4p;
template <int HF, int MODE, int RING> __device__ __forceinline__ void pass_u(const Ptrs& P, const bf16_t* hrow, float rstd, lds_v4p grp, u32x4 (&R)[RING][2], const unsigned char* img, const unsigned char* img_next, int sub) {
    unsigned xq[8]; float sx;
    {
        float xf[2][16]; float mx = 0.f;
#pragma unroll
        for (int i = 0; i < 2; ++i) { const int e0 = (sub + 16 * (2 * HF + i)) * 16;
#pragma unroll
            for (int q = 0; q < 4; ++q) { const u32x2 hb = *(const u32x2*)(hrow + e0 + 4 * q); const f32x4 gv = *(const f32x4*)(P.norm_ffn + e0 + 4 * q);
                xf[i][4 * q] = bflo(hb.x) * rstd * gv.x; xf[i][4 * q + 1] = bfhi(hb.x) * rstd * gv.y; xf[i][4 * q + 2] = bflo(hb.y) * rstd * gv.z; xf[i][4 * q + 3] = bfhi(hb.y) * rstd * gv.w;
                mx = fmaxf(fmaxf(mx, fmaxf(fabsf(xf[i][4 * q]), fabsf(xf[i][4 * q + 1]))), fmaxf(fabsf(xf[i][4 * q + 2]), fabsf(xf[i][4 * q + 3]))); } }
        mx = fmaxf(mx, AP_DPP(mx, 0xB1)); mx = fmaxf(mx, AP_DPP(mx, 0x4E)); mx = fmaxf(mx, AP_DPP(mx, 0x141)); mx = fmaxf(mx, AP_DPP(mx, 0x140));
        mx = fmaxf(mx, 1e-30f); sx = mx * (1.f / 127.f); const float qs = 127.f / mx;
#pragma unroll
        for (int i = 0; i < 2; ++i)
#pragma unroll
            for (int q = 0; q < 4; ++q) xq[4 * i + q] = pack_i8x4(xf[i][4 * q] * qs, xf[i][4 * q + 1] * qs, xf[i][4 * q + 2] * qs, xf[i][4 * q + 3] * qs);
    }
#pragma unroll 1
    for (int j = 0; j < 128; j += RING) {
        const int jn = (j + RING) & 127;
        __builtin_amdgcn_s_barrier();
        const unsigned char* tb = (j + RING < 128) ? img : img_next;
        unsigned nid[RING], part[RING], suv[RING], gsv[RING];
#pragma unroll
        for (int b4 = 0; b4 < RING / 4; ++b4) { const u32x4 na = grp[jn / 4 + b4];
            nid[4 * b4] = na.x; nid[4 * b4 + 1] = na.y; nid[4 * b4 + 2] = na.z; nid[4 * b4 + 3] = na.w;
            u32x4 pa = {}, sa = {}, ga = {};
            if (HF == 1) { pa = grp[96 + j / 4 + b4]; sa = grp[32 + j / 4 + b4]; ga = grp[64 + j / 4 + b4]; }
            part[4 * b4] = pa.x; part[4 * b4 + 1] = pa.y; part[4 * b4 + 2] = pa.z; part[4 * b4 + 3] = pa.w;
            suv[4 * b4] = sa.x; suv[4 * b4 + 1] = sa.y; suv[4 * b4 + 2] = sa.z; suv[4 * b4 + 3] = sa.w;
            gsv[4 * b4] = ga.x; gsv[4 * b4 + 1] = ga.y; gsv[4 * b4 + 2] = ga.z; gsv[4 * b4 + 3] = ga.w; }
        float outv[RING];
#pragma unroll
        for (int bq = 0; bq < RING; ++bq) {
            int d0_ = 0, d1_ = 0;
            if (MODE == 1) { asm volatile("" :: "v"(R[bq][0]), "v"(R[bq][1])); d0_ = (int)xq[0]; }
            else {
                d0_ = __builtin_amdgcn_sdot4((int)R[bq][0].x, (int)xq[0], d0_, false); d1_ = __builtin_amdgcn_sdot4((int)R[bq][0].y, (int)xq[1], d1_, false);
                d0_ = __builtin_amdgcn_sdot4((int)R[bq][0].z, (int)xq[2], d0_, false); d1_ = __builtin_amdgcn_sdot4((int)R[bq][0].w, (int)xq[3], d1_, false);
                d0_ = __builtin_amdgcn_sdot4((int)R[bq][1].x, (int)xq[4], d0_, false); d1_ = __builtin_amdgcn_sdot4((int)R[bq][1].y, (int)xq[5], d1_, false);
                d0_ = __builtin_amdgcn_sdot4((int)R[bq][1].z, (int)xq[6], d0_, false); d1_ = __builtin_amdgcn_sdot4((int)R[bq][1].w, (int)xq[7], d1_, false);
            }
            asm volatile("" ::: "memory");
            load_half(R[bq], tb, MODE == 2 ? (nid[bq] & 15u) : nid[bq], sub);
            asm volatile("" ::: "memory");
            float a_ = row16_sum((float)(d0_ + d1_)) * sx;
            if (HF == 1) { a_ = (a_ + __uint_as_float(part[bq])) * __uint_as_float(suv[bq]); a_ = __uint_as_float(gsv[bq]) * gelu_fast(a_); }
            outv[bq] = a_;
        }
        if (sub == 0) {
#pragma unroll
            for (int b4 = 0; b4 < RING / 4; ++b4) grp[96 + j / 4 + b4] = (u32x4){__float_as_uint(outv[4 * b4]), __float_as_uint(outv[4 * b4 + 1]), __float_as_uint(outv[4 * b4 + 2]), __float_as_uint(outv[4 * b4 + 3])}; }
    }
    asm volatile("s_waitcnt lgkmcnt(0)" ::: "memory");
}
template <int HF, int MODE, int RING> __device__ __forceinline__ void pass_v(float (&acc)[4][16], lds_v4p grp, u32x4 (&R)[RING][2], const unsigned char* img, const unsigned char* img_next, int sub) {
#pragma unroll 1
    for (int j = 0; j < 128; j += RING) {
        const int jn = (j + RING) & 127;
        __builtin_amdgcn_s_barrier();
        const unsigned char* tb = (j + RING < 128) ? img : img_next;
        unsigned nid[RING], cvv[RING];
#pragma unroll
        for (int b4 = 0; b4 < RING / 4; ++b4) { const u32x4 na = grp[jn / 4 + b4], ca = grp[96 + j / 4 + b4];
            nid[4 * b4] = na.x; nid[4 * b4 + 1] = na.y; nid[4 * b4 + 2] = na.z; nid[4 * b4 + 3] = na.w; cvv[4 * b4] = ca.x; cvv[4 * b4 + 1] = ca.y; cvv[4 * b4 + 2] = ca.z; cvv[4 * b4 + 3] = ca.w; }
#pragma unroll
        for (int bq = 0; bq < RING; ++bq) {
            const float c_ = __uint_as_float(cvv[bq]); const f32x2 c2 = {c_, c_};
            if (MODE == 1) { asm volatile("" :: "v"(R[bq][0]), "v"(R[bq][1])); acc[2 * HF][0] += c_; }
            else {
#pragma unroll
            for (int i = 0; i < 2; ++i) { const unsigned w_[4] = {R[bq][i].x, R[bq][i].y, R[bq][i].z, R[bq][i].w};
#pragma unroll
                for (int q = 0; q < 4; ++q) { const f32x2 lo_ = __builtin_amdgcn_cvt_pk_f32_fp8(w_[q], false), hi_ = __builtin_amdgcn_cvt_pk_f32_fp8(w_[q], true);
                    f32x2 a0 = {acc[2 * HF + i][4 * q], acc[2 * HF + i][4 * q + 1]}, a1 = {acc[2 * HF + i][4 * q + 2], acc[2 * HF + i][4 * q + 3]}; a0 += c2 * lo_; a1 += c2 * hi_;
                    acc[2 * HF + i][4 * q] = a0.x; acc[2 * HF + i][4 * q + 1] = a0.y; acc[2 * HF + i][4 * q + 2] = a1.x; acc[2 * HF + i][4 * q + 3] = a1.y; } }
            }
            asm volatile("" ::: "memory");
            load_half(R[bq], tb, MODE == 2 ? (nid[bq] & 15u) : nid[bq], sub);
            asm volatile("" ::: "memory");
        }
    }
}
template <int MODE> __device__ __forceinline__ void apply_round(const Ptrs& P, float* outbase, int tbase, unsigned char* shm_wave, int lane_in) {
    int lane = lane_in; asm volatile("" : "+v"(lane));
    const int sub = lane & 15, g = lane >> 4, t = tbase + g;
    __attribute__((address_space(3))) unsigned* cnt = (lds_u32p)(__attribute__((address_space(3))) unsigned char*)shm_wave + g * 128;
    lds_v4p grp = (lds_v4p)((__attribute__((address_space(3))) unsigned char*)shm_wave + 2048 + g * 2048);
    __attribute__((address_space(3))) unsigned* grp1 = (__attribute__((address_space(3))) unsigned*)grp;
    const unsigned char* U8 = P.ws + WS_U; const unsigned char* V8 = P.ws + WS_V;
    {
        const int* idxp = (const int*)(P.ws + WS_IDX) + (size_t)t * 128 + sub * 8; const float* gp = (const float*)(P.ws + WS_G) + (size_t)t * 128 + sub * 8;
        const u32x4 ia = *(const u32x4*)idxp, ib = *(const u32x4*)(idxp + 4); const f32x4 ga = *(const f32x4*)gp, gb = *(const f32x4*)(gp + 4);
        const int e[8] = {(int)ia.x, (int)ia.y, (int)ia.z, (int)ia.w, (int)ib.x, (int)ib.y, (int)ib.z, (int)ib.w};
        const float gt[8] = {ga.x, ga.y, ga.z, ga.w, gb.x, gb.y, gb.z, gb.w};
        float su[8], sv[8];
#pragma unroll
        for (int i = 0; i < 8; ++i) { su[i] = ((const float*)(P.ws + WS_SU))[e[i]]; sv[i] = ((const float*)(P.ws + WS_SV))[e[i]]; }
#pragma unroll
        for (int i = 0; i < 8; ++i) cnt[sub * 8 + i] = 0u;
        asm volatile("s_waitcnt lgkmcnt(0)" ::: "memory");
        unsigned pos[8];
#pragma unroll
        for (int i = 0; i < 8; ++i) pos[i] = __hip_atomic_fetch_add(cnt + (e[i] >> 7), 1u, __ATOMIC_RELAXED, __HIP_MEMORY_SCOPE_WAVEFRONT);
        asm volatile("s_waitcnt lgkmcnt(0)" ::: "memory");
        unsigned c[8]; unsigned tot = 0;
#pragma unroll
        for (int i = 0; i < 8; ++i) { c[i] = cnt[sub * 8 + i]; }
#pragma unroll
        for (int i = 0; i < 8; ++i) { const unsigned x = c[i]; c[i] = tot; tot += x; }
        unsigned inc = tot;
#pragma unroll
        for (int d = 1; d < 16; d <<= 1) { const unsigned y = __shfl_up(inc, d, 16); if (sub >= d) inc += y; }
        const unsigned base = inc - tot;
        asm volatile("s_waitcnt lgkmcnt(0)" ::: "memory");
#pragma unroll
        for (int i = 0; i < 8; ++i) cnt[sub * 8 + i] = base + c[i];
        asm volatile("s_waitcnt lgkmcnt(0)" ::: "memory");
#pragma unroll
        for (int i = 0; i < 8; ++i) { const unsigned p = cnt[e[i] >> 7] + pos[i];
            grp1[p] = (unsigned)e[i]; grp1[128 + p] = __float_as_uint(su[i]); grp1[256 + p] = __float_as_uint(gt[i] * sv[i]); }
        asm volatile("s_waitcnt lgkmcnt(0)" ::: "memory");
    }
    const bf16_t* hrow = (const bf16_t*)(P.ws + WS_HB) + (size_t)t * D;
    float rstd;
    { const float* ssq = (const float*)(P.ws + WS_SSQ) + (size_t)t * 16;
      const f32x4 s0 = *(const f32x4*)ssq, s1 = *(const f32x4*)(ssq + 4), s2 = *(const f32x4*)(ssq + 8), s3 = *(const f32x4*)(ssq + 12);
      const float tot = ((s0.x + s0.y) + (s0.z + s0.w)) + ((s1.x + s1.y) + (s1.z + s1.w)) + ((s2.x + s2.y) + (s2.z + s2.w)) + ((s3.x + s3.y) + (s3.z + s3.w));
      rstd = 1.f / sqrtf(tot * (1.f / D) + EPS); }
    constexpr int RG = (MODE == 1) ? AP_PROBE_RING : AP_RING;
    const unsigned char* U0 = U8; const unsigned char* U1 = U8 + (size_t)NEXP * 512; const unsigned char* V0 = V8; const unsigned char* V1 = V8 + (size_t)NEXP * 512;
    u32x4 R[RG][2];
    {
#pragma unroll
      for (int b4 = 0; b4 < RG / 4; ++b4) { const u32x4 ia = grp[b4]; load_half(R[4 * b4], U0, ia.x, sub); load_half(R[4 * b4 + 1], U0, ia.y, sub); load_half(R[4 * b4 + 2], U0, ia.z, sub); load_half(R[4 * b4 + 3], U0, ia.w, sub); } }
    pass_u<0, MODE, RG>(P, hrow, rstd, grp, R, U0, U1, sub);
    pass_u<1, MODE, RG>(P, hrow, rstd, grp, R, U1, V0, sub);
    float acc[4][16];
#pragma unroll
    for (int i = 0; i < 4; ++i)
#pragma unroll
        for (int q = 0; q < 16; ++q) acc[i][q] = 0.f;
    pass_v<0, MODE, RG>(acc, grp, R, V0, V1, sub);
    pass_v<1, MODE, RG>(acc, grp, R, V1, V1, sub);
    float ss = 0.f;
#pragma unroll
    for (int i = 0; i < 4; ++i) { const int e0 = (sub + 16 * i) * 16;
#pragma unroll
        for (int q = 0; q < 4; ++q) { const u32x2 hb = *(const u32x2*)(hrow + e0 + 4 * q);
            acc[i][4 * q] += bflo(hb.x); acc[i][4 * q + 1] += bfhi(hb.x); acc[i][4 * q + 2] += bflo(hb.y); acc[i][4 * q + 3] += bfhi(hb.y);
            ss += (acc[i][4 * q] * acc[i][4 * q] + acc[i][4 * q + 1] * acc[i][4 * q + 1]) + (acc[i][4 * q + 2] * acc[i][4 * q + 2] + acc[i][4 * q + 3] * acc[i][4 * q + 3]); }
        asm volatile("" ::: "memory"); }
    ss = row16_sum(ss);
    const float r2 = 1.f / sqrtf(ss * (1.f / D) + EPS);
    float* orow = outbase + (size_t)t * D;
#pragma unroll
    for (int i = 0; i < 4; ++i) { const int e0 = (sub + 16 * i) * 16;
#pragma unroll
        for (int q = 0; q < 4; ++q) { const f32x4 gv = *(const f32x4*)(P.norm_final + e0 + 4 * q);
            *(f32x4*)(orow + e0 + 4 * q) = (f32x4){acc[i][4 * q] * r2 * gv.x, acc[i][4 * q + 1] * r2 * gv.y, acc[i][4 * q + 2] * r2 * gv.z, acc[i][4 * q + 3] * r2 * gv.w}; }
        asm volatile("" ::: "memory"); }
}
template <int MODE> __device__ __forceinline__ void apply_phase(const Ptrs& P, float* outbase, unsigned char* shm, int G, int vcu) {
    int tid_l = threadIdx.x; asm volatile("" : "+v"(tid_l));
    const int lane = tid_l & 63; const int wave = __builtin_amdgcn_readfirstlane(tid_l >> 6);
    const int per = M / (G * 8);
#pragma unroll 1
    for (int r = 0; r < per; r += 4) apply_round<MODE>(P, outbase, (vcu * 8 + wave) * per + r, shm + wave * AP_WAVE_BYTES, lane);
}
}

#define LAS __attribute__((address_space(3)))
#define XB_TMO      128
#define XB_XCNT(j)  (256  + 64 * (j))
#define XB_XSUB(j)  (1280 + 64 * (j))
#define XB_XGEN(j)  (2304 + 64 * (j))
#define XB_TOP      3328
#define XB_TOPGEN   3392
#define XCD_BAR_WORDS 3456
#define XB_SPIN_CAP (1u << 18)

__device__ __forceinline__ unsigned xb_ld(unsigned* p)              { return __hip_atomic_load(p, __ATOMIC_RELAXED, __HIP_MEMORY_SCOPE_AGENT); }
__device__ __forceinline__ unsigned xb_add(unsigned* p, unsigned v) { return __hip_atomic_fetch_add(p, v, __ATOMIC_RELAXED, __HIP_MEMORY_SCOPE_AGENT); }
__device__ __forceinline__ unsigned xb_xcc_id() { return (unsigned)__builtin_amdgcn_s_getreg((3 << 11) | 20) & 0xFu; }
#define XB_SPIN(cond, bar) do { unsigned _sp = 0; while (cond) { __builtin_amdgcn_s_sleep(1); \
    if ((++_sp & 255u) == 0u) { if (xb_ld(&(bar)[XB_TMO])) break; if (_sp > XB_SPIN_CAP) { atomicAdd(&(bar)[XB_TMO], 1u); break; } } } } while (0)

struct XcdBarrier {
    unsigned* bar; unsigned x;
    volatile LAS unsigned* st;
};

__device__ __forceinline__ XcdBarrier xcd_barrier_post(unsigned* bar, volatile LAS unsigned* st) {
    XcdBarrier b; b.bar = bar; b.x = xb_xcc_id(); b.st = st;
    if (threadIdx.x == 0) (void)xb_add(&bar[XB_XCNT(b.x)], 1u);
    return b;
}
__device__ __forceinline__ void xcd_barrier_complete(unsigned* bar, unsigned x, unsigned& nloc, unsigned& nx) {
    const unsigned G = gridDim.x * gridDim.y * gridDim.z;
    unsigned sum, cnt, mine, sp = 0u;
    for (;;) {
        sum = 0u; cnt = 0u; mine = 0u;
#pragma unroll
        for (unsigned j = 0; j < 16; ++j) { const unsigned c = xb_ld(&bar[XB_XCNT(j)]); sum += c; cnt += (c > 0u) ? 1u : 0u; mine = (j == x) ? c : mine; }
        if (sum == G) break;
        __builtin_amdgcn_s_sleep(1);
        if ((++sp & 255u) == 0u) { if (xb_ld(&bar[XB_TMO])) break; if (sp > XB_SPIN_CAP) { atomicAdd(&bar[XB_TMO], 1u); break; } }
    }
    nloc = mine > 0u ? mine : 1u; nx = cnt > 0u ? cnt : 1u;
}

__device__ __forceinline__ void xcd_barrier(const XcdBarrier& b) {
    asm volatile("s_waitcnt vmcnt(0)" ::: "memory");
    __syncthreads();
    if (threadIdx.x == 0) {
        unsigned* bar = b.bar;
        __builtin_amdgcn_s_waitcnt(0);
        unsigned nloc = b.st[0], nx = b.st[1];
        if (nloc == 0u) { xcd_barrier_complete(bar, b.x, nloc, nx); b.st[0] = nloc; b.st[1] = nx; }
        const unsigned old = xb_add(&bar[XB_XSUB(b.x)], 1u);
        const unsigned gen = old / nloc;
        if (old + 1u == (gen + 1u) * nloc) {
            __builtin_amdgcn_fence(__ATOMIC_RELEASE, "agent");
            asm volatile("s_waitcnt vmcnt(0)" ::: "memory");
            const unsigned og = xb_add(&bar[XB_TOP], 1u);
            const unsigned tg = og / nx;
            if (og + 1u == (tg + 1u) * nx) xb_add(&bar[XB_TOPGEN], 1u);
            else XB_SPIN(xb_ld(&bar[XB_TOPGEN]) == tg, bar);
            __builtin_amdgcn_fence(__ATOMIC_ACQUIRE, "agent");
            xb_add(&bar[XB_XGEN(b.x)], 1u);
            asm volatile("s_waitcnt vmcnt(0)" ::: "memory");
        } else {
            XB_SPIN(xb_ld(&bar[XB_XGEN(b.x)]) == gen, bar);
            __builtin_amdgcn_fence(__ATOMIC_ACQUIRE, "agent");
            asm volatile("s_waitcnt vmcnt(0)" ::: "memory");
        }
    }
    __syncthreads();
}


namespace cg = cooperative_groups;
#ifndef REP_MASK
#define REP_MASK 0
#endif
#define REPS(k) (((REP_MASK) >> (k)) & 1 ? 2 : 1)
constexpr int PHASE_LDS = att::A_LDS_BYTES;
constexpr int MEGA_LDS = PHASE_LDS + 64;
static_assert(PHASE_LDS >= pg8::STAGE_BYTES && PHASE_LDS >= att::B_LDS_BYTES && PHASE_LDS >= peer::T_LDS_BYTES && PHASE_LDS >= 8 * 64 * 33 * 4 && PHASE_LDS >= apply::AP_LDS_BYTES, "LDS budget");
__global__ void __launch_bounds__(512, 2) mega_fwd(Ptrs P) {
    extern __shared__ __attribute__((aligned(16))) unsigned char lds_dyn[];
    volatile LAS unsigned* bst = (volatile LAS unsigned*)((LAS unsigned char*)lds_dyn + PHASE_LDS);
    if (threadIdx.x < 2) bst[threadIdx.x] = 0u;
    __syncthreads();
    const XcdBarrier bar = xcd_barrier_post((unsigned*)(P.ws + WS_CTL), bst);
    const int G = (int)gridDim.x, bx = (int)blockIdx.x, vcu = (G % 8 == 0) ? (bx % 8) * (G / 8) + bx / 8 : bx;
    unsigned char* ws = P.ws;
    PG8_LAS unsigned char* lds3 = (PG8_LAS unsigned char*)lds_dyn;
    for (int rep = 0; rep < REPS(0); ++rep) prep_phase(P, lds_dyn, G, bx);
    xcd_barrier(bar); if (REPS(9) == 2) xcd_barrier(bar);
    for (int rep = 0; rep < REPS(1); ++rep) {
      { pg8::Gemm g{(const bf16_t*)(ws + WS_XN), (const bf16_t*)(ws + WS_WIN), M, 1024, D, 0}; pg8::StaticOrder S; S.init(M, 1024, G, bx);
        pg8::gemm_phase<pg8::EpiProj, pg8::StaticOrder, true, true, false>(lds3, g, S, pg8::EpiProj{(bf16_t*)(ws + WS_PROJ), (const float*)(ws + WS_ROPE), 1.f, 0}); }
      { pg8::Gemm g{(const bf16_t*)(ws + WS_XN8), (const bf16_t*)(ws + WS_WIN8), M, INW - 1024, D / 2, 0}; pg8::StaticOrder S; S.init(M, INW - 1024, G, bx);
        pg8::gemm_phase<pg8::EpiProj, pg8::StaticOrder, true, true, true>(lds3, g, S, pg8::EpiProj{(bf16_t*)(ws + WS_PROJ), (const float*)(ws + WS_ROPE), 1.f / WIN_SCALE, 4}); } }
    xcd_barrier(bar); if (REPS(9) == 2) xcd_barrier(bar);
    { const float lam = lambda_full(P);
      for (int rep = 0; rep < REPS(2); ++rep) for (int u = vcu; u < BATCH * 4 * 8; u += G) att::attn_a_unit(u >> 5, (u >> 3) & 3, u & 7, (const bf16_t*)(ws + WS_PROJ), (bf16_t*)(ws + WS_YA), P.subln, lam, lds_dyn);
      for (int rep = 0; rep < REPS(3); ++rep) for (int u = vcu; u < BATCH * 8 * 8; u += G) att::attn_b_unit(u >> 6, (u >> 3) & 7, u & 7, (const bf16_t*)(ws + WS_PROJ), (bf16_t*)(ws + WS_YA), P.rpb, lds_dyn); }
    xcd_barrier(bar); if (REPS(9) == 2) xcd_barrier(bar);
    for (int rep = 0; rep < REPS(4); ++rep) { pg8::StaticOrder S; S.init(M, D, G, bx);
      pg8::gemm_phase<pg8::EpiGate2, pg8::StaticOrder, true, true>(lds3, pg8::Gemm{(const bf16_t*)(ws + WS_YA), (const bf16_t*)(ws + WS_WPA), M, D, D, 0}, S, pg8::EpiGate2{(const bf16_t*)(ws + WS_PROJ), (bf16_t*)(ws + WS_MERGED)}); }
    xcd_barrier(bar); if (REPS(9) == 2) xcd_barrier(bar);
    for (int rep = 0; rep < REPS(5); ++rep) { pg8::StaticOrder S; S.init(M, D, G, bx);
      pg8::gemm_phase<pg8::EpiHout, pg8::StaticOrder, true, true>(lds3, pg8::Gemm{(const bf16_t*)(ws + WS_MERGED), (const bf16_t*)(ws + WS_WOUT), M, D, D, 0}, S, pg8::EpiHout{P.x, P.out, (bf16_t*)(ws + WS_HB), (float*)(ws + WS_SSQ)});
      cvt_experts_phase(P, G, bx); }
    xcd_barrier(bar); if (REPS(9) == 2) xcd_barrier(bar);
    { pg8::StaticOrder S; S.init(M, PQ, G, bx);
      for (int rep = 0; rep < REPS(8); ++rep)
        pg8::gemm_phase<pg8::EpiQ, pg8::StaticOrder, true, true>(lds3, pg8::Gemm{(const bf16_t*)(ws + WS_HB), (const bf16_t*)(ws + WS_WQ), M, PQ, D, 0}, S, pg8::EpiQ{(const float*)(ws + WS_SSQ), (bf16_t*)(ws + WS_Q)});
      asm volatile("s_waitcnt vmcnt(0)" ::: "memory");
      __syncthreads();
      if (threadIdx.x == 0) { __builtin_amdgcn_fence(__ATOMIC_ACQUIRE, "agent"); asm volatile("s_waitcnt vmcnt(0)" ::: "memory"); }
      __syncthreads();
      for (int rep = 0; rep < REPS(6); ++rep) peer::topk_own_units(P, lds_dyn, S); }
    xcd_barrier(bar); if (REPS(9) == 2) xcd_barrier(bar);
#ifndef PROBE_MODE
#define PROBE_MODE 0
#endif
    if (REPS(7) == 2) apply::apply_phase<PROBE_MODE>(P, (float*)(ws + WS_Q), lds_dyn, G, vcu);
    apply::apply_phase<0>(P, P.out, lds_dyn, G, vcu);
}

extern "C" void kernel_launch(void* const* d_in, const int* in_sizes, int n_in, void* d_out, int out_size, void* d_ws, size_t ws_size, hipStream_t stream) {
    if (n_in != 18 || ws_size < WS_END) { fprintf(stderr, "kernel_launch: unexpected n_in %d / ws_size %zu\n", n_in, ws_size); return; }
    Ptrs P{};
    P.x = (const float*)d_in[0]; P.w_in = (const float*)d_in[1]; P.w_pa = (const float*)d_in[2]; P.w_pb = (const float*)d_in[3]; P.w_out = (const float*)d_in[4];
    P.norm_mix = (const float*)d_in[5]; P.norm_ffn = (const float*)d_in[6]; P.norm_final = (const float*)d_in[7];
    P.lq1 = (const float*)d_in[8]; P.lk1 = (const float*)d_in[9]; P.lq2 = (const float*)d_in[10]; P.lk2 = (const float*)d_in[11];
    P.subln = (const float*)d_in[12]; P.rpb = (const float*)d_in[13]; P.w_query = (const float*)d_in[14]; P.sub_keys = (const float*)d_in[15];
    P.peer_u = (const float*)d_in[16]; P.peer_v = (const float*)d_in[17];
    P.out = (float*)d_out; P.ws = (unsigned char*)d_ws;
    static int grid_blocks = 0;
    if (!grid_blocks) {
        int dev = 0, cus = 0, per_cu = 0;
        hipGetDevice(&dev);
        hipDeviceGetAttribute(&cus, hipDeviceAttributeMultiprocessorCount, dev);
        hipFuncSetAttribute((const void*)mega_fwd, hipFuncAttributeMaxDynamicSharedMemorySize, MEGA_LDS);
        hipOccupancyMaxActiveBlocksPerMultiprocessor(&per_cu, (const void*)mega_fwd, 512, MEGA_LDS);
        if (per_cu < 1) { fprintf(stderr, "kernel_launch: occupancy query says %d blocks per CU\n", per_cu); per_cu = 1; }
        grid_blocks = cus * per_cu;
    }
    hipMemsetAsync((unsigned char*)d_ws + WS_CTL, 0, 16384, stream);
    void* args[] = {&P};
    hipError_t e = hipLaunchCooperativeKernel((const void*)mega_fwd, dim3(grid_blocks), dim3(512), args, MEGA_LDS, stream);
    if (e != hipSuccess) fprintf(stderr, "cooperative launch failed: %s (grid %d)\n", hipGetErrorString(e), grid_blocks);
}
```

```cpp
#include <hip/hip_runtime.h>
#include <hip/hip_cooperative_groups.h>
#include <cstdio>
#include <cstdint>

typedef unsigned short bf16_t;
typedef unsigned u32x4 __attribute__((ext_vector_type(4)));
typedef unsigned u32x2 __attribute__((ext_vector_type(2)));
typedef float f32x4 __attribute__((ext_vector_type(4)));
typedef __bf16 bf16x2_t __attribute__((ext_vector_type(2)));

constexpr int D = 1024, BATCH = 8, SEQ = 2048, M = BATCH * SEQ, INW = 5120;
constexpr int C_QA = 0, C_KA = 512, C_VA = 1024, C_QB = 1536, C_KB = 2048, C_VB = 2560, C_GA = 3072, C_GB = 4096;
constexpr int NEXP = 16384, PQ = 2048;
constexpr float EPS = 1e-6f;
constexpr float LOG2E = 1.4426950408889634f;
constexpr float WIN_SCALE = 32.f;
constexpr float QSCALE = 0.125f * LOG2E;

constexpr size_t MiB = 1u << 20;
constexpr size_t WS_PROJ = 0;
constexpr size_t WS_HB = 0;
constexpr size_t WS_Q = 32 * MiB;
constexpr size_t WS_U = 96 * MiB;
constexpr size_t WS_V = 112 * MiB;
constexpr size_t WS_SU = 128 * MiB;
constexpr size_t WS_SV = 128 * MiB + 65536;
constexpr size_t WS_XN = 160 * MiB;
constexpr size_t WS_YA = 160 * MiB;
constexpr size_t WS_YB = 176 * MiB;
constexpr size_t WS_IDX = 160 * MiB;
constexpr size_t WS_G = 168 * MiB;
constexpr size_t WS_MERGED = 192 * MiB;
constexpr size_t WS_TOPV = 192 * MiB;
constexpr size_t WS_TOPI = 208 * MiB;
constexpr size_t WS_WIN = 224 * MiB;
constexpr size_t WS_WIN8 = 226 * MiB;
constexpr size_t WS_XN8 = 192 * MiB;
constexpr size_t WS_WQ = 234 * MiB;
constexpr size_t WS_WOUT = 238 * MiB;
constexpr size_t WS_WPA = 240 * MiB;
constexpr size_t WS_WPB = 241 * MiB;
constexpr size_t WS_SK = 242 * MiB;
constexpr size_t WS_ROPE = 242 * MiB + 512 * 1024;
constexpr size_t WS_SSQ = 243 * MiB;
constexpr size_t WS_CTL = 244 * MiB;
constexpr size_t WS_END = 256 * MiB;

__device__ __forceinline__ float bf2f(unsigned v) { return __uint_as_float(v << 16); }
__device__ __forceinline__ float bflo(unsigned w) { return __uint_as_float(w << 16); }
__device__ __forceinline__ float bfhi(unsigned w) { return __uint_as_float(w & 0xffff0000u); }
__device__ __forceinline__ unsigned f2bf(float f) { unsigned u = __float_as_uint(f); return (u + 0x7fffu + ((u >> 16) & 1u)) >> 16; }
__device__ __forceinline__ unsigned pk2(float lo, float hi) { return f2bf(lo) | (f2bf(hi) << 16); }
__device__ __forceinline__ float wave_sum(float v) {
#pragma unroll
    for (int o = 1; o < 64; o <<= 1) v += __shfl_xor(v, o);
    return v;
}
__device__ __forceinline__ float sigmoidf_(float x) { return 1.f / (1.f + __expf(-x)); }
__device__ __forceinline__ float gelu_exact(float x) { return 0.5f * x * (1.f + erff(x * 0.70710678118654752f)); }

struct Ptrs {
    const float *x, *w_in, *w_pa, *w_pb, *w_out, *norm_mix, *norm_ffn, *norm_final, *lq1, *lk1, *lq2, *lk2, *subln, *rpb, *w_query, *sub_keys, *peer_u, *peer_v;
    float* out; unsigned char* ws;
};

__device__ __forceinline__ void transpose_item(const float* W, int K, int N, const float* gain, bf16_t* WT, float* scr, int item, int lane, int ldo = 0, int koff = 0, int ldw = 0) {
    if (ldo == 0) ldo = K;
    if (ldw == 0) ldw = N;
    const int nblk = N / 32, kb = item / nblk, nb = item % nblk, k0 = 64 * kb, n0 = 32 * nb;
    float wv[32];
#pragma unroll
    for (int i = 0; i < 32; ++i) { const int kk = 2 * i + (lane >> 5); wv[i] = W[(size_t)(k0 + kk) * ldw + n0 + (lane & 31)]; }
#pragma unroll
    for (int i = 0; i < 32; ++i) { const int kk = 2 * i + (lane >> 5); float w = wv[i]; if (gain) w *= gain[k0 + kk]; scr[kk * 33 + (lane & 31)] = w; }
    asm volatile("s_waitcnt lgkmcnt(0)" ::: "memory");
    const int c = lane & 7;
#pragma unroll
    for (int j = 0; j < 4; ++j) { const int n = (lane >> 3) + 8 * j; const float* s = scr + (8 * c) * 33 + n;
        u32x4 o; o.x = pk2(s[0 * 33], s[1 * 33]); o.y = pk2(s[2 * 33], s[3 * 33]); o.z = pk2(s[4 * 33], s[5 * 33]); o.w = pk2(s[6 * 33], s[7 * 33]);
        *(u32x4*)(WT + (size_t)(n0 + n) * ldo + koff + k0 + 8 * c) = o; }
    asm volatile("s_waitcnt lgkmcnt(0)" ::: "memory");
}
__device__ __forceinline__ void cvt8(const float* src, bf16_t* dst, size_t i8) {
    const f32x4 a = *(const f32x4*)(src + i8 * 8), b = *(const f32x4*)(src + i8 * 8 + 4);
    u32x4 o; o.x = pk2(a.x, a.y); o.y = pk2(a.z, a.w); o.z = pk2(b.x, b.y); o.w = pk2(b.z, b.w);
    *(u32x4*)(dst + i8 * 8) = o;
}
__device__ __forceinline__ void transpose_item8(const float* W, int K, int N, int ldw, const float* gain, float wscale, unsigned char* WT, float* scr, int item, int lane) {
    const int nblk = N / 32, kb = item / nblk, nb = item % nblk, k0 = 64 * kb, n0 = 32 * nb;
    float wv[32];
#pragma unroll
    for (int i = 0; i < 32; ++i) { const int kk = 2 * i + (lane >> 5); wv[i] = W[(size_t)(k0 + kk) * ldw + n0 + (lane & 31)]; }
#pragma unroll
    for (int i = 0; i < 32; ++i) { const int kk = 2 * i + (lane >> 5); float w = wv[i] * wscale; if (gain) w *= gain[k0 + kk]; scr[kk * 33 + (lane & 31)] = w; }
    asm volatile("s_waitcnt lgkmcnt(0)" ::: "memory");
    const int c = lane & 7;
#pragma unroll
    for (int j = 0; j < 4; ++j) { const int n = (lane >> 3) + 8 * j; const float* s = scr + (8 * c) * 33 + n;
        u32x2 o; o.x = __builtin_amdgcn_cvt_pk_fp8_f32(s[0 * 33], s[1 * 33], 0u, false); o.x = __builtin_amdgcn_cvt_pk_fp8_f32(s[2 * 33], s[3 * 33], o.x, true);
        o.y = __builtin_amdgcn_cvt_pk_fp8_f32(s[4 * 33], s[5 * 33], 0u, false); o.y = __builtin_amdgcn_cvt_pk_fp8_f32(s[6 * 33], s[7 * 33], o.y, true);
        *(u32x2*)(WT + (size_t)(n0 + n) * K + k0 + 8 * c) = o; }
    asm volatile("s_waitcnt lgkmcnt(0)" ::: "memory");
}
__device__ __forceinline__ void rms_rows_emit(const f32x4 (&v)[4], bf16_t* orow16, unsigned char* orow, int lane) {
    float s = 0.f;
#pragma unroll
    for (int j = 0; j < 4; ++j) s += (v[j].x * v[j].x + v[j].y * v[j].y) + (v[j].z * v[j].z + v[j].w * v[j].w);
    const float rstd = 1.f / sqrtf(wave_sum(s) * (1.f / D) + EPS);
    unsigned* o4 = (unsigned*)orow + lane; u32x2* o8 = (u32x2*)orow16 + lane;
#pragma unroll
    for (int j = 0; j < 4; ++j) { unsigned w = __builtin_amdgcn_cvt_pk_fp8_f32(v[j].x * rstd, v[j].y * rstd, 0u, false); w = __builtin_amdgcn_cvt_pk_fp8_f32(v[j].z * rstd, v[j].w * rstd, w, true); o4[64 * j] = w;
        u32x2 w2; w2.x = pk2(v[j].x * rstd, v[j].y * rstd); w2.y = pk2(v[j].z * rstd, v[j].w * rstd); o8[64 * j] = w2; }
}
__device__ __forceinline__ void rms_rows(const float* x, bf16_t* xn16, unsigned char* xn8, int m0, int step, int lane) {
    if (m0 >= M) return;
    f32x4 cur[4], nxt[4];
#pragma unroll
    for (int j = 0; j < 4; ++j) cur[j] = ((const f32x4*)(x + (size_t)m0 * D) + lane)[64 * j];
    for (int m = m0; m < M; m += step) {
        const int mn = (m + step < M) ? m + step : m;
#pragma unroll
        for (int j = 0; j < 4; ++j) nxt[j] = ((const f32x4*)(x + (size_t)mn * D) + lane)[64 * j];
        rms_rows_emit(cur, xn16 + (size_t)m * D, xn8 + (size_t)m * D, lane);
#pragma unroll
        for (int j = 0; j < 4; ++j) cur[j] = nxt[j];
    }
}
__device__ __forceinline__ void rms_row_to_bf16(const float* xrow, bf16_t* orow, int lane) {
    const f32x4* xr = (const f32x4*)xrow + lane;
    f32x4 v[4]; float s = 0.f;
#pragma unroll
    for (int j = 0; j < 4; ++j) { v[j] = xr[64 * j]; s += (v[j].x * v[j].x + v[j].y * v[j].y) + (v[j].z * v[j].z + v[j].w * v[j].w); }
    const float rstd = 1.f / sqrtf(wave_sum(s) * (1.f / D) + EPS);
    u32x2* o8 = (u32x2*)orow + lane;
#pragma unroll
    for (int j = 0; j < 4; ++j) { u32x2 w; w.x = pk2(v[j].x * rstd, v[j].y * rstd); w.y = pk2(v[j].z * rstd, v[j].w * rstd); o8[64 * j] = w; }
}

__device__ __forceinline__ void prep_phase(const Ptrs& P, unsigned char* shm, int G, int bx) {
    int tid_l = threadIdx.x; asm volatile("" : "+v"(tid_l));
    const int lane = tid_l & 63; const int wave = __builtin_amdgcn_readfirstlane(tid_l >> 6);
    const int gw = bx * 8 + wave, NGW = G * 8;
    float* scr = (float*)(shm + wave * (64 * 33 * 4));
    unsigned char* ws = P.ws;
    constexpr int N_BF = 1024;
    constexpr int I_INB = (D / 64) * (N_BF / 32), I_IN8 = (D / 64) * ((INW - N_BF) / 32), I_IN = I_INB + I_IN8, I_Q = (D / 64) * (PQ / 32), I_OUT = (D / 64) * (D / 32), I_PA = (512 / 64) * (D / 32);
    constexpr int NIT = I_IN + I_Q + I_OUT + 2 * I_PA;
    for (int it = gw; it < NIT; it += NGW) {
        int r = it;
        if (r < I_INB) { transpose_item(P.w_in, D, N_BF, P.norm_mix, (bf16_t*)(ws + WS_WIN), scr, r, lane, 0, 0, INW); continue; } r -= I_INB;
        if (r < I_IN8) { transpose_item8(P.w_in + N_BF, D, INW - N_BF, INW, P.norm_mix, WIN_SCALE, ws + WS_WIN8, scr, r, lane); continue; } r -= I_IN8;
        if (r < I_Q) { transpose_item(P.w_query, D, PQ, P.norm_ffn, (bf16_t*)(ws + WS_WQ), scr, r, lane); continue; } r -= I_Q;
        if (r < I_OUT) { transpose_item(P.w_out, D, D, nullptr, (bf16_t*)(ws + WS_WOUT), scr, r, lane); continue; } r -= I_OUT;
        if (r < I_PA) { transpose_item(P.w_pa, 512, D, nullptr, (bf16_t*)(ws + WS_WPA), scr, r, lane, 1024, 0); continue; } r -= I_PA;
        transpose_item(P.w_pb, 512, D, nullptr, (bf16_t*)(ws + WS_WPA), scr, r, lane, 1024, 512);
    }
    rms_rows(P.x, (bf16_t*)(ws + WS_XN), ws + WS_XN8, gw, NGW, lane);
    const size_t gt = (size_t)bx * 512 + threadIdx.x, NT = (size_t)G * 512;
    for (size_t i = gt; i < (size_t)16 * 128 * 128 / 8; i += NT) cvt8(P.sub_keys, (bf16_t*)(ws + WS_SK), i);
    for (size_t i = gt; i < (size_t)SEQ * 8; i += NT) {
        const int pos = (int)(i >> 3), k = (int)(i & 7);
        const float inv = k == 0 ? 1.0f : k == 1 ? 0.19392274f : k == 2 ? 0.03760603f : k == 3 ? 0.0072926646f : k == 4 ? 0.0014142136f : k == 5 ? 0.0002742482f : k == 6 ? 5.3182957e-05f : 1.0313385e-05f;
        const float ang = (float)pos * inv;
        float sn, cs; sincosf(ang, &sn, &cs);
        float* t = (float*)(ws + WS_ROPE) + (size_t)pos * 16;
        t[k] = cs; t[8 + k] = sn;
    }
}
__device__ __forceinline__ void cvt_row_fp8(const f32x4 (&rv)[4], unsigned char* dst, float* inv_scale, int lane) {
    const f32x4 a = rv[0], b = rv[1], c = rv[2], d = rv[3];
    float m = fmaxf(fmaxf(fmaxf(fabsf(a.x), fabsf(a.y)), fmaxf(fabsf(a.z), fabsf(a.w))), fmaxf(fmaxf(fabsf(b.x), fabsf(b.y)), fmaxf(fabsf(b.z), fabsf(b.w))));
    m = fmaxf(m, fmaxf(fmaxf(fmaxf(fabsf(c.x), fabsf(c.y)), fmaxf(fabsf(c.z), fabsf(c.w))), fmaxf(fmaxf(fabsf(d.x), fabsf(d.y)), fmaxf(fabsf(d.z), fabsf(d.w)))));
#pragma unroll
    for (int o = 1; o < 64; o <<= 1) m = fmaxf(m, __shfl_xor(m, o));
    m = fmaxf(m, 1e-30f);
    const float sc = 256.f / m;
    u32x4 w;
    w.x = __builtin_amdgcn_cvt_pk_fp8_f32(a.x * sc, a.y * sc, 0u, false); w.x = __builtin_amdgcn_cvt_pk_fp8_f32(a.z * sc, a.w * sc, w.x, true);
    w.y = __builtin_amdgcn_cvt_pk_fp8_f32(b.x * sc, b.y * sc, 0u, false); w.y = __builtin_amdgcn_cvt_pk_fp8_f32(b.z * sc, b.w * sc, w.y, true);
    w.z = __builtin_amdgcn_cvt_pk_fp8_f32(c.x * sc, c.y * sc, 0u, false); w.z = __builtin_amdgcn_cvt_pk_fp8_f32(c.z * sc, c.w * sc, w.z, true);
    w.w = __builtin_amdgcn_cvt_pk_fp8_f32(d.x * sc, d.y * sc, 0u, false); w.w = __builtin_amdgcn_cvt_pk_fp8_f32(d.z * sc, d.w * sc, w.w, true);
    *(u32x4*)(dst + (size_t)(lane >> 5) * (NEXP * 512) + (lane & 31) * 16) = w;
    if (lane == 0) *inv_scale = m * (1.f / 256.f);
}
__device__ __forceinline__ unsigned pack_i8x4(float a, float b, float c, float d) {
    const int q0 = (int)rintf(a), q1 = (int)rintf(b), q2 = (int)rintf(c), q3 = (int)rintf(d);
    return (unsigned)(q0 & 0xff) | ((unsigned)(q1 & 0xff) << 8) | ((unsigned)(q2 & 0xff) << 16) | ((unsigned)q3 << 24);
}
__device__ __forceinline__ void cvt_row_i8(const f32x4 (&rv)[4], unsigned char* dst, float* inv_scale, int lane) {
    const f32x4 a = rv[0], b = rv[1], c = rv[2], d = rv[3];
    float m = fmaxf(fmaxf(fmaxf(fabsf(a.x), fabsf(a.y)), fmaxf(fabsf(a.z), fabsf(a.w))), fmaxf(fmaxf(fabsf(b.x), fabsf(b.y)), fmaxf(fabsf(b.z), fabsf(b.w))));
    m = fmaxf(m, fmaxf(fmaxf(fmaxf(fabsf(c.x), fabsf(c.y)), fmaxf(fabsf(c.z), fabsf(c.w))), fmaxf(fmaxf(fabsf(d.x), fabsf(d.y)), fmaxf(fabsf(d.z), fabsf(d.w)))));
#pragma unroll
    for (int o = 1; o < 64; o <<= 1) m = fmaxf(m, __shfl_xor(m, o));
    m = fmaxf(m, 1e-30f);
    const float sc = 127.f / m;
    u32x4 w;
    w.x = pack_i8x4(a.x * sc, a.y * sc, a.z * sc, a.w * sc); w.y = pack_i8x4(b.x * sc, b.y * sc, b.z * sc, b.w * sc);
    w.z = pack_i8x4(c.x * sc, c.y * sc, c.z * sc, c.w * sc); w.w = pack_i8x4(d.x * sc, d.y * sc, d.z * sc, d.w * sc);
    *(u32x4*)(dst + (size_t)(lane >> 5) * (NEXP * 512) + (lane & 31) * 16) = w;
    if (lane == 0) *inv_scale = m * (1.f / 127.f);
}
__device__ __forceinline__ void cvt_experts_phase(const Ptrs& P, int G, int bx) {
    int tid_l = threadIdx.x; asm volatile("" : "+v"(tid_l));
    const int lane = tid_l & 63; const int wave = __builtin_amdgcn_readfirstlane(tid_l >> 6);
    const int step = G * 8; int r = bx * 8 + wave;
    if (r >= 2 * NEXP) return;
    f32x4 cur[4], nxt[4];
    { const float* src = (r < NEXP ? P.peer_u + (size_t)r * D : P.peer_v + (size_t)(r - NEXP) * D);
#pragma unroll
      for (int j = 0; j < 4; ++j) cur[j] = ((const f32x4*)src + lane * 4)[j]; }
    for (; r < 2 * NEXP; r += step) {
        const int rn = (r + step < 2 * NEXP) ? r + step : r;
        const float* srcn = (rn < NEXP ? P.peer_u + (size_t)rn * D : P.peer_v + (size_t)(rn - NEXP) * D);
#pragma unroll
        for (int j = 0; j < 4; ++j) nxt[j] = ((const f32x4*)srcn + lane * 4)[j];
        if (r < NEXP) cvt_row_i8(cur, P.ws + WS_U + (size_t)r * 512, (float*)(P.ws + WS_SU) + r, lane);
        else { const int e = r - NEXP; cvt_row_fp8(cur, P.ws + WS_V + (size_t)e * 512, (float*)(P.ws + WS_SV) + e, lane); }
#pragma unroll
        for (int j = 0; j < 4; ++j) cur[j] = nxt[j];
    }
}

namespace pg8 {
#define PG8_LAS __attribute__((address_space(3)))
typedef unsigned short bf16_t;
typedef short bf16x8 __attribute__((ext_vector_type(8)));
typedef float f32x4 __attribute__((ext_vector_type(4)));
typedef unsigned u32x4 __attribute__((ext_vector_type(4)));
typedef int v8i_t __attribute__((ext_vector_type(8)));
constexpr int BM = 256, BK = 64, HALF = 128, HTB = HALF * BK * 2  , STAGE_BYTES = 8 * HTB, NXCD = 8, WGM = 8;

__host__ __device__ __forceinline__ int lds_byte(int r, int c) { const int st = (r >> 4) * 2 + (c >> 5), rr = r & 15, cc = c & 31, ob = rr * 64 + cc * 2; return st * 1024 + (ob ^ (((ob >> 9) & 1) << 5)); }
__host__ __device__ __forceinline__ void stage_rc(int b, int& R, int& C) { const int st = b / 1024, sb = b % 1024, swz = sb ^ (((sb >> 9) & 1) << 5); R = (st >> 1) * 16 + swz / 64; C = (st & 1) * 32 + (swz % 64) / 2; }
__host__ __device__ __forceinline__ int perm32(int rho) { const int n = rho >> 4, i = rho & 15; return 8 * (i >> 2) + 4 * n + (i & 3); }

struct Unit { int pm, pn; };
struct Gemm { const bf16_t* A; const bf16_t* Bt; int M, N, K, pad; };

struct StaticOrder {
    int nM, nN, nwg, G, c;
    __host__ __device__ void init(int M, int N, int G_, int c_) { nM = M / BM; nN = N / BM; nwg = nM * nN; G = G_; c = c_; }
    __host__ __device__ bool next(int i, Unit& u) const {
        const long L = (long)i * G + c; if (L >= nwg) return false;
        int wgid = (int)L; { const int q = nwg / NXCD, r = nwg % NXCD, xcd = wgid % NXCD, off = wgid / NXCD; wgid = (xcd < r ? xcd * (q + 1) : r * (q + 1) + (xcd - r) * q) + off; }
        const int nig = WGM * nN, gid = wgid / nig, fm = gid * WGM, gsz = (nM - fm) < WGM ? (nM - fm) : WGM;
        u.pm = fm + ((wgid % nig) % gsz); u.pn = (wgid % nig) / gsz; return true;
    }
    __device__ __forceinline__ void a_ready(const Unit&) const {}
    __device__ __forceinline__ void done(const Unit&) const {}
};
__device__ __forceinline__ unsigned cvt_pk_bf16(float lo, float hi) { unsigned r; asm volatile("v_cvt_pk_bf16_f32 %0, %1, %2" : "=v"(r) : "v"(lo), "v"(hi)); return r; }
typedef float f32x2 __attribute__((ext_vector_type(2)));

__device__ __forceinline__ float sigm(float x) { return __builtin_amdgcn_rcpf(1.f + __builtin_amdgcn_exp2f(-1.4426950408889634f * x)); }
struct EpiProj {
    static constexpr bool PERM = true, AFTER_DRAIN = false, MID = false;
    bf16_t* O; const float* rope; float osc; int pn0;
    __device__ __forceinline__ void operator()(const f32x4 (&acc)[2][2][4][2], const Unit& u, int wr, int wc, int fr_, int fq_) const {
        int fr = fr_, fq = fq_; asm volatile("" : "+v"(fr), "+v"(fq));
        const int pn = u.pn + pn0;
        const int row0 = u.pm * BM + wr * 64 + fr, col0 = pn * BM + wc * 32 + 8 * fq;
        const float sc = ((pn < 2 || pn == 6 || pn == 7) ? QSCALE : 1.f) * osc;
        const bool dorope = (pn < 4) && ((wc & 1) == 0);
#pragma unroll
        for (int ai = 0; ai < 2; ++ai)
#pragma unroll
            for (int m = 0; m < 4; ++m) { const int row = row0 + ai * HALF + m * 16; bf16_t* rowp = O + (size_t)row * INW + col0;
                f32x4 c4[2] = {{1.f, 1.f, 1.f, 1.f}, {1.f, 1.f, 1.f, 1.f}}, s4[2] = {{0.f, 0.f, 0.f, 0.f}, {0.f, 0.f, 0.f, 0.f}};
                if (dorope) { const float* rp = rope + (size_t)(row & (SEQ - 1)) * 16; c4[0] = *(const f32x4*)(rp); c4[1] = *(const f32x4*)(rp + 4); s4[0] = *(const f32x4*)(rp + 8); s4[1] = *(const f32x4*)(rp + 12); }
#pragma unroll
                for (int bj = 0; bj < 2; ++bj) { f32x4 v0 = acc[ai][bj][m][0], v1 = acc[ai][bj][m][1];
                    if (dorope) { f32x4 o0, o1;
#pragma unroll
                        for (int j = 0; j < 4; ++j) { o0[j] = __shfl_xor(v0[j], 16); o1[j] = __shfl_xor(v1[j], 16); }
                        if (fq == 0) { v0 = v0 * c4[0] - o0 * s4[0]; v1 = v1 * c4[1] - o1 * s4[1]; }
                        else if (fq == 1) { v0 = v0 * c4[0] + o0 * s4[0]; v1 = v1 * c4[1] + o1 * s4[1]; } }
                    v0 = v0 * sc; v1 = v1 * sc; u32x4 w; w.x = cvt_pk_bf16(v0[0], v0[1]); w.y = cvt_pk_bf16(v0[2], v0[3]); w.z = cvt_pk_bf16(v1[0], v1[1]); w.w = cvt_pk_bf16(v1[2], v1[3]);
                    *(u32x4*)(rowp + bj * HALF) = w; } }
    }
};
struct EpiGate2 {
    static constexpr bool PERM = true, AFTER_DRAIN = false, MID = true;
    const bf16_t* proj; bf16_t* O;
    __device__ __forceinline__ void mid(f32x4 (&acc)[2][2][4][2], const Unit& u, int wr, int wc, int fr, int fq) const {
        int row0 = u.pm * BM + wr * 64 + fr, col0 = u.pn * BM + wc * 32 + 8 * fq;
        asm volatile("" : "+v"(row0), "+v"(col0));
#pragma unroll
        for (int ai = 0; ai < 2; ++ai) {
            u32x4 gav[4][2], gbv[4][2];
#pragma unroll
            for (int m = 0; m < 4; ++m)
#pragma unroll
                for (int bj = 0; bj < 2; ++bj) { const bf16_t* gp = proj + (size_t)(row0 + ai * HALF + m * 16) * INW + col0 + bj * HALF; gav[m][bj] = *(const u32x4*)(gp + C_GA); gbv[m][bj] = *(const u32x4*)(gp + C_GB); }
#pragma unroll
            for (int m = 0; m < 4; ++m) {
#pragma unroll
                for (int bj = 0; bj < 2; ++bj) { const u32x4 ga = gav[m][bj], gb = gbv[m][bj];
                    const unsigned a_[4] = {ga.x, ga.y, ga.z, ga.w}, b_[4] = {gb.x, gb.y, gb.z, gb.w};
#pragma unroll
                    for (int q = 0; q < 4; ++q) {
                        const float r0 = (1.f + __builtin_amdgcn_exp2f(-1.4426950408889634f * bflo(b_[q]))) * __builtin_amdgcn_rcpf(1.f + __builtin_amdgcn_exp2f(-1.4426950408889634f * bflo(a_[q])));
                        const float r1 = (1.f + __builtin_amdgcn_exp2f(-1.4426950408889634f * bfhi(b_[q]))) * __builtin_amdgcn_rcpf(1.f + __builtin_amdgcn_exp2f(-1.4426950408889634f * bfhi(a_[q])));
                        acc[ai][bj][m][q >> 1][(q & 1) * 2] *= r0; acc[ai][bj][m][q >> 1][(q & 1) * 2 + 1] *= r1; } } }
            asm volatile("" ::: "memory"); }
    }
    __device__ __forceinline__ void operator()(const f32x4 (&acc)[2][2][4][2], const Unit& u, int wr, int wc, int fr_, int fq_) const {
        int fr = fr_, fq = fq_; asm volatile("" : "+v"(fr), "+v"(fq));
        const int row0 = u.pm * BM + wr * 64 + fr, col0 = u.pn * BM + wc * 32 + 8 * fq;
#pragma unroll
        for (int ai = 0; ai < 2; ++ai) {
            u32x4 gv[4][2];
#pragma unroll
            for (int m = 0; m < 4; ++m)
#pragma unroll
                for (int bj = 0; bj < 2; ++bj) gv[m][bj] = *(const u32x4*)(proj + (size_t)(row0 + ai * HALF + m * 16) * INW + C_GB + col0 + bj * HALF);
#pragma unroll
            for (int m = 0; m < 4; ++m) { const int row = row0 + ai * HALF + m * 16;
#pragma unroll
                for (int bj = 0; bj < 2; ++bj) { const int col = col0 + bj * HALF; const u32x4 g = gv[m][bj];
                    f32x4 v0 = acc[ai][bj][m][0], v1 = acc[ai][bj][m][1];
                    v0[0] *= sigm(bflo(g.x)); v0[1] *= sigm(bfhi(g.x)); v0[2] *= sigm(bflo(g.y)); v0[3] *= sigm(bfhi(g.y));
                    v1[0] *= sigm(bflo(g.z)); v1[1] *= sigm(bfhi(g.z)); v1[2] *= sigm(bflo(g.w)); v1[3] *= sigm(bfhi(g.w));
                    u32x4 w; w.x = cvt_pk_bf16(v0[0], v0[1]); w.y = cvt_pk_bf16(v0[2], v0[3]); w.z = cvt_pk_bf16(v1[0], v1[1]); w.w = cvt_pk_bf16(v1[2], v1[3]);
                    *(u32x4*)(O + (size_t)row * D + col) = w; } }
            asm volatile("" ::: "memory"); }
    }
};
struct EpiHout {
    static constexpr bool PERM = true, AFTER_DRAIN = false, MID = false;
    const float* x; float* H; bf16_t* HB; float* ssq16;
    __device__ __forceinline__ void operator()(const f32x4 (&acc)[2][2][4][2], const Unit& u, int wr, int wc, int fr_, int fq_) const {
        int fr = fr_, fq = fq_; asm volatile("" : "+v"(fr), "+v"(fq));
        const int row0 = u.pm * BM + wr * 64 + fr, col0 = u.pn * BM + wc * 32 + 8 * fq;
#pragma unroll
        for (int ai = 0; ai < 2; ++ai) {
            f32x4 xv[4][2][2];
#pragma unroll
            for (int m = 0; m < 4; ++m)
#pragma unroll
                for (int bj = 0; bj < 2; ++bj) { const float* xp = x + (size_t)(row0 + ai * HALF + m * 16) * D + col0 + bj * HALF; xv[m][bj][0] = *(const f32x4*)xp; xv[m][bj][1] = *(const f32x4*)(xp + 4); }
#pragma unroll
            for (int m = 0; m < 4; ++m) { const int row = row0 + ai * HALF + m * 16; float ss = 0.f;
#pragma unroll
                for (int bj = 0; bj < 2; ++bj) { const int col = col0 + bj * HALF;
                    const f32x4 v0 = acc[ai][bj][m][0] + xv[m][bj][0], v1 = acc[ai][bj][m][1] + xv[m][bj][1];
                    u32x4 w; w.x = cvt_pk_bf16(v0[0], v0[1]); w.y = cvt_pk_bf16(v0[2], v0[3]); w.z = cvt_pk_bf16(v1[0], v1[1]); w.w = cvt_pk_bf16(v1[2], v1[3]);
                    *(u32x4*)(HB + (size_t)row * D + col) = w;
                    ss += (v0[0] * v0[0] + v0[1] * v0[1]) + (v0[2] * v0[2] + v0[3] * v0[3]) + (v1[0] * v1[0] + v1[1] * v1[1]) + (v1[2] * v1[2] + v1[3] * v1[3]); }
                ss += __shfl_xor(ss, 16); ss += __shfl_xor(ss, 32);
                if (fq == 0) ssq16[(size_t)row * 16 + u.pn * 4 + wc] = ss; }
            asm volatile("" ::: "memory"); }
    }
};
struct EpiQ {
    static constexpr bool PERM = true, AFTER_DRAIN = false, MID = false;
    const float* ssq16; bf16_t* O;
    __device__ __forceinline__ void operator()(const f32x4 (&acc)[2][2][4][2], const Unit& u, int wr, int wc, int fr, int fq) const {
        const int row0 = u.pm * BM + wr * 64 + fr, col0 = u.pn * BM + wc * 32 + 8 * fq;
#pragma unroll
        for (int ai = 0; ai < 2; ++ai)
#pragma unroll
            for (int m = 0; m < 4; ++m) { const int row = row0 + ai * HALF + m * 16; const f32x4* sp = (const f32x4*)(ssq16 + (size_t)row * 16);
                const f32x4 a = sp[0], b = sp[1], c = sp[2], d = sp[3];
                const float tot = ((a[0] + a[1]) + (a[2] + a[3])) + ((b[0] + b[1]) + (b[2] + b[3])) + ((c[0] + c[1]) + (c[2] + c[3])) + ((d[0] + d[1]) + (d[2] + d[3]));
                const float rstd = 1.f / sqrtf(tot * (1.f / D) + EPS);
#pragma unroll
                for (int bj = 0; bj < 2; ++bj) { const f32x4 v0 = acc[ai][bj][m][0] * rstd, v1 = acc[ai][bj][m][1] * rstd;
                    u32x4 w; w.x = cvt_pk_bf16(v0[0], v0[1]); w.y = cvt_pk_bf16(v0[2], v0[3]); w.z = cvt_pk_bf16(v1[0], v1[1]); w.w = cvt_pk_bf16(v1[2], v1[3]);
                    *(u32x4*)(O + (size_t)row * PQ + col0 + bj * HALF) = w; } }
    }
};
template <class Epi, class Sched, bool ALIGN_EPI = false, bool SP2 = false, bool FP8 = false>
__device__ __forceinline__ void gemm_phase(PG8_LAS unsigned char* lds, const Gemm g, const Sched& S, const Epi& E) {
    int tid_l = threadIdx.x; asm volatile("" : "+v"(tid_l));
    const int tid = tid_l, wid = __builtin_amdgcn_readfirstlane(tid >> 6), lane = tid & 63, wr = wid >> 2, wc = wid & 3, fr = lane & 15, fq = lane >> 4;
    const int K = g.K, nt = K / BK;
    unsigned voffA[2], voffB[2];
#pragma unroll
    for (int i = 0; i < 2; ++i) { int R, C; stage_rc(tid * 16 + i * 8192, R, C); const int Rb = Epi::PERM ? ((R & ~31) + perm32(R & 31)) : R;
        voffA[i] = (unsigned)(R * K + C) * 2u; voffB[i] = (unsigned)(Rb * K + C) * 2u; }
    const size_t kstep = (size_t)(BK * 2);
    const size_t hstep = (size_t)HALF * K * 2;
    const size_t tstep = 2 * hstep;
    const unsigned ldsw = (unsigned)wid * 1024u;
    const int aoff = lds_byte(wr * 64 + fr, fq * 8), boff = lds_byte(wc * 32 + fr, fq * 8);
    const int aoffF0 = FP8 ? lds_byte(wr * 64 + fr, fq * 16) : 0, boffF0 = FP8 ? lds_byte(wc * 32 + fr, fq * 16) : 0;
#define PG8_SA(b, h) (((b) * 2 + (h)) * HTB)
#define PG8_SB(b, h) ((4 + (b) * 2 + (h)) * HTB)
#define PG8_STAGE(bufoff, gbase, voff) do { _Pragma("unroll") for (int _i = 0; _i < 2; ++_i) \
        __builtin_amdgcn_global_load_lds((const unsigned*)((const char*)(gbase) + (voff)[_i]), (PG8_LAS unsigned*)(lds + (bufoff) + ldsw + _i * 8192), 16, 0, 0); } while (0)
#define PG8_LDA(dst, b, h) do { if constexpr (FP8) { _Pragma("unroll") for (int m = 0; m < 4; ++m) { const u32x4 l_ = *(const PG8_LAS u32x4*)(lds + PG8_SA(b, h) + aoffF0 + m * 2048), h_ = *(const PG8_LAS u32x4*)(lds + PG8_SA(b, h) + aoffF0 + m * 2048 + 16); \
            dst##8[m] = (v8i_t){(int)l_.x, (int)l_.y, (int)l_.z, (int)l_.w, (int)h_.x, (int)h_.y, (int)h_.z, (int)h_.w}; } } \
        else { _Pragma("unroll") for (int m = 0; m < 4; ++m) _Pragma("unroll") for (int k = 0; k < 2; ++k) dst[m][k] = *(const PG8_LAS bf16x8*)(lds + PG8_SA(b, h) + aoff + m * 2048 + k * 1024); } } while (0)
#define PG8_LDB(dst, b, h) do { if constexpr (FP8) { _Pragma("unroll") for (int n = 0; n < 2; ++n) { const u32x4 l_ = *(const PG8_LAS u32x4*)(lds + PG8_SB(b, h) + boffF0 + n * 2048), h_ = *(const PG8_LAS u32x4*)(lds + PG8_SB(b, h) + boffF0 + n * 2048 + 16); \
            dst##8[n] = (v8i_t){(int)l_.x, (int)l_.y, (int)l_.z, (int)l_.w, (int)h_.x, (int)h_.y, (int)h_.z, (int)h_.w}; } } \
        else { _Pragma("unroll") for (int n = 0; n < 2; ++n) _Pragma("unroll") for (int k = 0; k < 2; ++k) dst[n][k] = *(const PG8_LAS bf16x8*)(lds + PG8_SB(b, h) + boff + n * 2048 + k * 1024); } } while (0)
#define PG8_MMA(ai, bj, At, Bt) do { __builtin_amdgcn_s_setprio(1); \
        if constexpr (FP8) { _Pragma("unroll") for (int m = 0; m < 4; ++m) _Pragma("unroll") for (int n = 0; n < 2; ++n) \
            asm volatile("v_mfma_scale_f32_16x16x128_f8f6f4 %0, %1, %2, %0, %3, %3 op_sel_hi:[0,0,0]" : "+v"(acc[ai][bj][m][n]) : "v"(Bt##8[n]), "v"(At##8[m]), "v"(mxone)); } \
        else { _Pragma("unroll") for (int m = 0; m < 4; ++m) _Pragma("unroll") for (int n = 0; n < 2; ++n) _Pragma("unroll") for (int k = 0; k < 2; ++k) \
            acc[ai][bj][m][n] = __builtin_amdgcn_mfma_f32_16x16x32_bf16(Bt[n][k], At[m][k], acc[ai][bj][m][n], 0, 0, 0); } \
        __builtin_amdgcn_s_setprio(0); } while (0)
#define PG8_WAIT_V(n) asm volatile("s_waitcnt vmcnt(" #n ")" ::: "memory")
#define PG8_WAIT_L(n) asm volatile("s_waitcnt lgkmcnt(" #n ")" ::: "memory")
#define PG8_BAR __builtin_amdgcn_s_barrier()
#define PG8_SCHED __builtin_amdgcn_sched_barrier(0)
    Unit cur, nxt; int ui = 0;
    if (!S.next(0, cur)) return;
    f32x4 acc[2][2][4][2];
#pragma unroll
    for (int a = 0; a < 2; ++a)
#pragma unroll
        for (int b = 0; b < 2; ++b)
#pragma unroll
            for (int m = 0; m < 4; ++m)
#pragma unroll
                for (int n = 0; n < 2; ++n) acc[a][b][m][n] = (f32x4){0.f, 0.f, 0.f, 0.f};
    bf16x8 At[4][2], B0[2][2], B1[2][2]; v8i_t At8[4], B08[2], B18[2];
    int mxone = 0x7F7F7F7F; asm volatile("" : "+v"(mxone));
    const char* cA = (const char*)g.A + (size_t)cur.pm * tstep; const char* cB = (const char*)g.Bt + (size_t)cur.pn * tstep;
    S.a_ready(cur);
    if constexpr (SP2) {
        PG8_STAGE(PG8_SB(0, 0), cB, voffB); PG8_STAGE(PG8_SB(0, 1), cB + hstep, voffB); PG8_STAGE(PG8_SA(0, 0), cA, voffA); PG8_STAGE(PG8_SA(0, 1), cA + hstep, voffA);
        if (wr == 1) PG8_BAR;
        PG8_WAIT_V(2); PG8_BAR;
        PG8_STAGE(PG8_SB(1, 0), cB + kstep, voffB); PG8_STAGE(PG8_SA(1, 0), cA + kstep, voffA); PG8_STAGE(PG8_SB(1, 1), cB + hstep + kstep, voffB);
        PG8_WAIT_V(6); PG8_BAR;
    } else {
        PG8_STAGE(PG8_SB(0, 0), cB, voffB); PG8_STAGE(PG8_SA(0, 0), cA, voffA); PG8_STAGE(PG8_SB(0, 1), cB + hstep, voffB); PG8_STAGE(PG8_SA(0, 1), cA + hstep, voffA);
        if (wr == 1) PG8_BAR;
        PG8_WAIT_V(4); PG8_BAR;
        PG8_STAGE(PG8_SB(1, 0), cB + kstep, voffB); PG8_STAGE(PG8_SA(1, 0), cA + kstep, voffA); PG8_STAGE(PG8_SB(1, 1), cB + hstep + kstep, voffB);
        PG8_WAIT_V(6); PG8_BAR;
    }
    for (;;) {
        const bool has_next = S.next(ui + 1, nxt);
        const char* nA = has_next ? (const char*)g.A + (size_t)nxt.pm * tstep : cA; const char* nB = has_next ? (const char*)g.Bt + (size_t)nxt.pn * tstep : cB;
#pragma unroll 1
        for (int t = 0; t < nt; t += 2) {
            if constexpr (Epi::MID) { if (t == nt / 2) E.mid(acc, cur, wr, wc, fr, fq); }
            const bool last = (t == nt - 2);
            const char* a1 = cA + (size_t)(t + 1) * kstep;
            const char* a2 = last ? nA : cA + (size_t)(t + 2) * kstep; const char* b2 = last ? nB : cB + (size_t)(t + 2) * kstep;
            const char* a3 = a2 + kstep; const char* b3 = b2 + kstep;
            if (last && has_next) S.a_ready(nxt);
            if constexpr (SP2) {
            PG8_LDB(B0, 0, 0); PG8_LDB(B1, 0, 1); PG8_SCHED; PG8_LDA(At, 0, 0); PG8_STAGE(PG8_SA(1, 1), a1 + hstep, voffA);
            PG8_WAIT_V(8); PG8_WAIT_L(0); PG8_BAR; PG8_MMA(0, 0, At, B0); PG8_MMA(0, 1, At, B1); PG8_BAR; PG8_SCHED;
            PG8_LDA(At, 0, 1); PG8_STAGE(PG8_SB(0, 0), b2, voffB); PG8_STAGE(PG8_SB(0, 1), b2 + hstep, voffB); PG8_STAGE(PG8_SA(0, 0), a2, voffA);
            PG8_WAIT_V(8); PG8_WAIT_L(0); PG8_BAR; PG8_MMA(1, 0, At, B0); PG8_MMA(1, 1, At, B1); PG8_BAR; PG8_SCHED;
            PG8_LDB(B0, 1, 0); PG8_LDB(B1, 1, 1); PG8_SCHED; PG8_LDA(At, 1, 0); PG8_STAGE(PG8_SA(0, 1), a2 + hstep, voffA);
            PG8_WAIT_V(8); PG8_WAIT_L(0); PG8_BAR; PG8_MMA(0, 0, At, B0); PG8_MMA(0, 1, At, B1); PG8_BAR; PG8_SCHED;
            PG8_LDA(At, 1, 1); PG8_STAGE(PG8_SB(1, 0), b3, voffB); PG8_STAGE(PG8_SB(1, 1), b3 + hstep, voffB); PG8_STAGE(PG8_SA(1, 0), a3, voffA);
            PG8_WAIT_V(8); PG8_WAIT_L(0); PG8_BAR; PG8_MMA(1, 0, At, B0); PG8_MMA(1, 1, At, B1); PG8_BAR; PG8_SCHED;
            } else {
            PG8_LDB(B0, 0, 0); PG8_SCHED; PG8_LDA(At, 0, 0); PG8_STAGE(PG8_SA(1, 1), a1 + hstep, voffA);
            PG8_WAIT_L(8); PG8_BAR; PG8_WAIT_L(0); PG8_MMA(0, 0, At, B0); PG8_BAR; PG8_SCHED;
            PG8_LDB(B1, 0, 1); PG8_STAGE(PG8_SB(0, 0), b2, voffB);
            PG8_BAR; PG8_WAIT_L(0); PG8_MMA(0, 1, At, B1); PG8_BAR;
            PG8_LDA(At, 0, 1); PG8_STAGE(PG8_SA(0, 0), a2, voffA);
            PG8_BAR; PG8_WAIT_L(0); PG8_MMA(1, 0, At, B0); PG8_BAR; PG8_SCHED;
            PG8_STAGE(PG8_SB(0, 1), b2 + hstep, voffB);
            PG8_WAIT_V(6); PG8_BAR; PG8_MMA(1, 1, At, B1); PG8_BAR;
            PG8_LDB(B0, 1, 0); PG8_SCHED; PG8_LDA(At, 1, 0); PG8_STAGE(PG8_SA(0, 1), a2 + hstep, voffA);
            PG8_WAIT_L(8); PG8_BAR; PG8_WAIT_L(0); PG8_MMA(0, 0, At, B0); PG8_BAR; PG8_SCHED;
            PG8_LDB(B1, 1, 1); PG8_STAGE(PG8_SB(1, 0), b3, voffB);
            PG8_BAR; PG8_WAIT_L(0); PG8_MMA(0, 1, At, B1); PG8_BAR;
            PG8_LDA(At, 1, 1); PG8_STAGE(PG8_SA(1, 0), a3, voffA);
            PG8_BAR; PG8_WAIT_L(0); PG8_MMA(1, 0, At, B0); PG8_BAR; PG8_SCHED;
            PG8_STAGE(PG8_SB(1, 1), b3 + hstep, voffB);
            PG8_WAIT_V(6); PG8_BAR; PG8_MMA(1, 1, At, B1); PG8_BAR;
            }
        }
        if constexpr (ALIGN_EPI) { if (wr == 0) PG8_BAR; }
        if constexpr (FP8) { asm volatile("s_nop 15\n\ts_nop 7" ::: "memory"); PG8_SCHED; }
        if constexpr (!Epi::AFTER_DRAIN) { E(acc, cur, wr, wc, fr, fq); S.done(cur); }
        if (!has_next) break;
#pragma unroll
        for (int a = 0; a < 2; ++a)
#pragma unroll
            for (int b = 0; b < 2; ++b)
#pragma unroll
                for (int m = 0; m < 4; ++m)
#pragma unroll
                    for (int n = 0; n < 2; ++n) acc[a][b][m][n] = (f32x4){0.f, 0.f, 0.f, 0.f};
        cur = nxt; cA = nA; cB = nB; ++ui;
        if constexpr (ALIGN_EPI) { if (wr == 1) PG8_BAR; }
    }
    PG8_WAIT_V(0);
    if constexpr (!ALIGN_EPI) { if (wr == 0) PG8_BAR; }
    PG8_BAR;
    if constexpr (Epi::AFTER_DRAIN) { E.fused(acc, cur, wr, wc, fr, fq, lds, wid, lane); S.done(cur); }
#undef PG8_SA
#undef PG8_SB
#undef PG8_STAGE
#undef PG8_LDA
#undef PG8_LDB
#undef PG8_MMA
#undef PG8_WAIT_V
#undef PG8_WAIT_L
#undef PG8_BAR
#undef PG8_SCHED
}
}

__device__ __forceinline__ float lambda_full(const Ptrs& P) {
    float a = 0.f, b = 0.f;
    for (int i = 0; i < 64; ++i) { a += P.lq1[i] * P.lk1[i]; b += P.lq2[i] * P.lk2[i]; }
    return __expf(a) - __expf(b) + 0.2f;
}

namespace att {
typedef short bf16x8 __attribute__((ext_vector_type(8)));
typedef short s16x4 __attribute__((ext_vector_type(4)));
typedef float f32x16 __attribute__((ext_vector_type(16)));
typedef float f32x2_t __attribute__((ext_vector_type(2)));
typedef __attribute__((address_space(3))) const char* lds_cptr;
typedef __attribute__((address_space(3))) char* lds_ptr;
__device__ __forceinline__ int crow(int r, int hi) { return (r & 3) + 8 * (r >> 2) + 4 * hi; }
__device__ __forceinline__ void glds16(const void* gsrc, unsigned lds_dst) { unsigned keep;
    asm volatile("s_mov_b32 %0, m0\n\ts_mov_b32 m0, %2\n\ts_nop 0\n\tglobal_load_lds_dwordx4 %1, off\n\ts_mov_b32 m0, %0" : "=&s"(keep) : "v"(gsrc), "s"(lds_dst) : "memory"); }
__device__ __forceinline__ unsigned cvtpk(float lo, float hi) { f32x2_t v = {lo, hi}; bf16x2_t b = __builtin_convertvector(v, bf16x2_t); return __builtin_bit_cast(unsigned, b); }
#define ATT_WAIT_BAR(N) asm volatile("s_waitcnt vmcnt(" #N ") lgkmcnt(0)\n\ts_barrier" ::: "memory")
#define ATT_LDSWAIT() asm volatile("s_waitcnt lgkmcnt(0)" ::: "memory")
#define ATT_SBAR() __builtin_amdgcn_sched_barrier(0)
template <bool REL> __device__ __forceinline__ void qkt(f32x16& p0, f32x16& p1, lds_cptr Kslot, const bf16x8* qr, const f32x16& negm, int r32, int hi) {
    lds_cptr kb = Kslot + hi * 1024 + r32 * 16;
#pragma unroll
    for (int d0 = 0; d0 < 4; ++d0) {
        const bf16x8 b0 = *(const __attribute__((address_space(3))) bf16x8*)(kb + d0 * 2048);
        const bf16x8 b1 = *(const __attribute__((address_space(3))) bf16x8*)(kb + d0 * 2048 + 512);
        if (d0 == 0) { if (REL) { p0 = __builtin_amdgcn_mfma_f32_32x32x16_bf16(b0, qr[0], negm, 0, 0, 0); p1 = __builtin_amdgcn_mfma_f32_32x32x16_bf16(b1, qr[0], negm, 0, 0, 0); }
                       else { p0 = __builtin_amdgcn_mfma_f32_32x32x16_bf16(b0, qr[0], f32x16{}, 0, 0, 0); p1 = __builtin_amdgcn_mfma_f32_32x32x16_bf16(b1, qr[0], f32x16{}, 0, 0, 0); } }
        else { p0 = __builtin_amdgcn_mfma_f32_32x32x16_bf16(b0, qr[d0], p0, 0, 0, 0); p1 = __builtin_amdgcn_mfma_f32_32x32x16_bf16(b1, qr[d0], p1, 0, 0, 0); } }
}
__device__ __forceinline__ float rowmax32(const f32x16& p0, const f32x16& p1) {
    float a = fmaxf(p0[0], p1[0]);
#pragma unroll
    for (int r = 1; r < 16; ++r) a = fmaxf(a, fmaxf(p0[r], p1[r]));
    auto rr = __builtin_amdgcn_permlane32_swap(__float_as_uint(a), __float_as_uint(a), false, false);
    return fmaxf(__uint_as_float(rr[0]), __uint_as_float(rr[1]));
}
__device__ __forceinline__ float halfsum(float a) { auto rr = __builtin_amdgcn_permlane32_swap(__float_as_uint(a), __float_as_uint(a), false, false); return __uint_as_float(rr[0]) + __uint_as_float(rr[1]); }
#define ATT_VREAD(lo, hi, d0) do { _Pragma("unroll") for (int ks = 0; ks < 4; ++ks) { \
        asm volatile("ds_read_b64_tr_b16 %0,%1 offset:%c2" : "=&v"(lo[ks]) : "v"(vb), "i"((d0) * 4096 + ks * 1024) : "memory"); \
        asm volatile("ds_read_b64_tr_b16 %0,%1 offset:%c2" : "=&v"(hi[ks]) : "v"(vb), "i"((d0) * 4096 + ks * 1024 + 512) : "memory"); } } while (0)
#define ATT_PK(lo, hi, k) (bf16x8){lo[k][0], lo[k][1], lo[k][2], lo[k][3], hi[k][0], hi[k][1], hi[k][2], hi[k][3]}
#define ATT_PVMMA(lo, hi, d0) do { \
        o[d0] = __builtin_amdgcn_mfma_f32_32x32x16_bf16(pa0, ATT_PK(lo, hi, 0), o[d0], 0, 0, 0); o[d0] = __builtin_amdgcn_mfma_f32_32x32x16_bf16(pa1, ATT_PK(lo, hi, 1), o[d0], 0, 0, 0); \
        o[d0] = __builtin_amdgcn_mfma_f32_32x32x16_bf16(pa2, ATT_PK(lo, hi, 2), o[d0], 0, 0, 0); o[d0] = __builtin_amdgcn_mfma_f32_32x32x16_bf16(pa3, ATT_PK(lo, hi, 3), o[d0], 0, 0, 0); } while (0)
template <int ND0> __device__ __forceinline__ void pv(f32x16* o, int vb, bf16x8 pa0, bf16x8 pa1, bf16x8 pa2, bf16x8 pa3) {
    s16x4 loA[4], hiA[4], loB[4], hiB[4];
    ATT_VREAD(loA, hiA, 0);
#pragma unroll
    for (int d0 = 0; d0 < ND0; d0 += 2) {
        if (d0 + 1 < ND0) { ATT_VREAD(loB, hiB, d0 + 1); asm volatile("s_waitcnt lgkmcnt(8)" ::: "memory"); } else { asm volatile("s_waitcnt lgkmcnt(0)" ::: "memory"); }
        ATT_SBAR();
        ATT_PVMMA(loA, hiA, d0);
        if (d0 + 1 < ND0) {
            if (d0 + 2 < ND0) { ATT_VREAD(loA, hiA, d0 + 2); asm volatile("s_waitcnt lgkmcnt(8)" ::: "memory"); } else { asm volatile("s_waitcnt lgkmcnt(0)" ::: "memory"); }
            ATT_SBAR();
            ATT_PVMMA(loB, hiB, d0 + 1);
        }
    }
}
#undef ATT_VREAD
#undef ATT_PVMMA
#undef ATT_PK
template <int ND0, int THR, bool REL> __device__ __forceinline__ void softmax_tile(f32x16& p0, f32x16& p1, float& mrun, float& lsum, f32x16& negm, bool first, f32x16* o, __attribute__((address_space(3))) float* wsf, int r32, int hi,
                                                                   u32x4& pw0, u32x4& pw1, u32x4& pw2, u32x4& pw3) {
    float rm = rowmax32(p0, p1);
    if (!REL) rm -= mrun;
    if (first) {
        mrun = REL ? rm : mrun + rm;
        if (REL) {
#pragma unroll
            for (int r = 0; r < 16; ++r) { p0[r] -= rm; p1[r] -= rm; negm[r] = -mrun; } }
    } else if (__any(rm > (float)THR)) {
        const float dl = fmaxf(rm, 0.f), alpha = __builtin_amdgcn_exp2f(-dl); lsum *= alpha; mrun += dl;
        if (REL) {
#pragma unroll
            for (int r = 0; r < 16; ++r) { p0[r] -= dl; p1[r] -= dl; negm[r] = -mrun; } }
        if (hi == 0) wsf[r32] = alpha;
        ATT_LDSWAIT();
#pragma unroll
        for (int g = 0; g < 4; ++g) { const f32x4 a4 = *(const __attribute__((address_space(3))) f32x4*)(wsf + 8 * g + 4 * hi);
#pragma unroll
            for (int d0 = 0; d0 < ND0; ++d0) { o[d0][4 * g + 0] *= a4[0]; o[d0][4 * g + 1] *= a4[1]; o[d0][4 * g + 2] *= a4[2]; o[d0][4 * g + 3] *= a4[3]; } }
        ATT_LDSWAIT();
    }
    float s = 0.f;
#pragma unroll
    for (int r = 0; r < 16; ++r) { p0[r] = __builtin_amdgcn_exp2f(REL ? p0[r] : p0[r] - mrun); p1[r] = __builtin_amdgcn_exp2f(REL ? p1[r] : p1[r] - mrun); s += p0[r] + p1[r]; }
    lsum += s;
    pw0 = (u32x4){cvtpk(p0[0], p0[1]), cvtpk(p0[2], p0[3]), cvtpk(p0[4], p0[5]), cvtpk(p0[6], p0[7])};
    pw1 = (u32x4){cvtpk(p0[8], p0[9]), cvtpk(p0[10], p0[11]), cvtpk(p0[12], p0[13]), cvtpk(p0[14], p0[15])};
    pw2 = (u32x4){cvtpk(p1[0], p1[1]), cvtpk(p1[2], p1[3]), cvtpk(p1[4], p1[5]), cvtpk(p1[6], p1[7])};
    pw3 = (u32x4){cvtpk(p1[8], p1[9]), cvtpk(p1[10], p1[11]), cvtpk(p1[12], p1[13]), cvtpk(p1[14], p1[15])};
}

constexpr int A_SLOTK = 8192, A_SLOTV = 16384, A_NS = 3, A_NSV = 4;
constexpr int A_LDS_K = 0, A_LDS_V = A_NS * A_SLOTK, A_LDS_WS = A_LDS_V + A_NSV * A_SLOTV, A_LDS_ST = A_LDS_WS + 8 * 256, A_LDS_BYTES = A_LDS_ST + 8 * 8192;
__device__ __forceinline__ void attn_a_unit(int b, int h, int qb, const bf16_t* proj, bf16_t* ya, const float* subln, float lam, unsigned char* shm) {
    int tid_l = threadIdx.x; asm volatile("" : "+v"(tid_l));
    const int tid = tid_l, lane = tid & 63, r32 = lane & 31, hi = lane >> 5; const int wid = __builtin_amdgcn_readfirstlane(tid >> 6);
    const size_t rowbase = (size_t)b * SEQ; const int q0 = qb * 256;
    constexpr int NT = SEQ / 64;
    const unsigned lds0 = (unsigned)(uintptr_t)shm;
    const lds_cptr shm3 = (lds_cptr)shm;
    __attribute__((address_space(3))) float* wsf = (__attribute__((address_space(3))) float*)((lds_ptr)shm + A_LDS_WS) + wid * 64;
    const int vb0 = (int)(lds0 + A_LDS_V) + ((lane >> 4) & 1) * 32 + (lane & 3) * 8 + (4 * hi + ((lane & 15) >> 2)) * 64;
    __attribute__((address_space(3))) bf16_t* stg = (__attribute__((address_space(3))) bf16_t*)((lds_ptr)shm + A_LDS_ST) + wid * 4096;
    for (int mp = 0; mp < 2; ++mp) {
        const bf16_t* Kh = proj + rowbase * INW + C_KA + h * 128 + mp * 64;
        const bf16_t* Vh = proj + rowbase * INW + C_VA + h * 128;
        const bf16_t* Qw = proj + (rowbase + q0 + wid * 32) * INW + C_QA + h * 128 + mp * 64;
        const int pA = 2 * wid, pB = 2 * wid + 1;
        const unsigned kdst = lds0 + A_LDS_K + wid * 1024, vdstA = lds0 + A_LDS_V + pA * 1024, vdstB = lds0 + A_LDS_V + pB * 1024;
#define A_DMA(t, slot, vsl) do { int ln_ = lane; asm volatile("" : "+v"(ln_)); \
        const bf16_t* ksrc_ = Kh + (size_t)((t) * 64 + ln_) * INW + wid * 8; \
        const bf16_t* vsrcA_ = Vh + (size_t)((t) * 64 + 16 * (pA & 3) + (ln_ >> 2)) * INW + (pA >> 2) * 32 + (ln_ & 3) * 8; \
        const bf16_t* vsrcB_ = Vh + (size_t)((t) * 64 + 16 * (pB & 3) + (ln_ >> 2)) * INW + (pB >> 2) * 32 + (ln_ & 3) * 8; \
        glds16(ksrc_, (unsigned)__builtin_amdgcn_readfirstlane(kdst + (slot) * A_SLOTK)); \
        glds16(vsrcA_, (unsigned)__builtin_amdgcn_readfirstlane(vdstA + (vsl) * A_SLOTV)); \
        glds16(vsrcB_, (unsigned)__builtin_amdgcn_readfirstlane(vdstB + (vsl) * A_SLOTV)); } while (0)
        A_DMA(0, 0, 0); A_DMA(1, 1, 1);
        bf16x8 qr[4];
#pragma unroll
        for (int d0 = 0; d0 < 4; ++d0) qr[d0] = *(const bf16x8*)(Qw + (size_t)r32 * INW + d0 * 16 + hi * 8);
        f32x16 o[4]; o[0] = f32x16{}; o[1] = f32x16{}; o[2] = f32x16{}; o[3] = f32x16{};
        float mrun = 0.f, lsum = 0.f; f32x16 negm = f32x16{};
        int slot = 0, slot2 = 2, vslot = 0, vslot2 = 2, vprev = 3;
        const bool late = wid >= 4;
        u32x4 pw0 = {}, pw1 = {}, pw2 = {}, pw3 = {};
        for (int t = 0; t < NT; ++t) {
            if (t + 1 < NT) { ATT_WAIT_BAR(3); } else { ATT_WAIT_BAR(0); }
            if (t + 2 < NT) A_DMA(t + 2, slot2, vslot2);
            if (late && t > 0) pv<4>(o, vb0 + vprev * A_SLOTV, __builtin_bit_cast(bf16x8, pw0), __builtin_bit_cast(bf16x8, pw1), __builtin_bit_cast(bf16x8, pw2), __builtin_bit_cast(bf16x8, pw3));
            f32x16 p0, p1;
            qkt<false>(p0, p1, shm3 + A_LDS_K + slot * A_SLOTK, qr, negm, r32, hi);
            softmax_tile<4, 8, false>(p0, p1, mrun, lsum, negm, t == 0, o, wsf, r32, hi, pw0, pw1, pw2, pw3);
            if (!late) pv<4>(o, vb0 + vslot * A_SLOTV, __builtin_bit_cast(bf16x8, pw0), __builtin_bit_cast(bf16x8, pw1), __builtin_bit_cast(bf16x8, pw2), __builtin_bit_cast(bf16x8, pw3));
            slot = (slot == 2) ? 0 : slot + 1; slot2 = (slot2 == 2) ? 0 : slot2 + 1;
            vprev = vslot; vslot = (vslot + 1) & 3; vslot2 = (vslot2 + 1) & 3;
        }
        if (late) pv<4>(o, vb0 + vprev * A_SLOTV, __builtin_bit_cast(bf16x8, pw0), __builtin_bit_cast(bf16x8, pw1), __builtin_bit_cast(bf16x8, pw2), __builtin_bit_cast(bf16x8, pw3));
#undef A_DMA
        const float lt = halfsum(lsum);
        if (hi == 0) wsf[32 + r32] = lt;
        ATT_LDSWAIT();
        float rli[16];
#pragma unroll
        for (int g = 0; g < 4; ++g) { const f32x4 l4 = *(const __attribute__((address_space(3))) f32x4*)(wsf + 32 + 8 * g + 4 * hi);
            rli[4 * g + 0] = __builtin_amdgcn_rcpf(l4[0]); rli[4 * g + 1] = __builtin_amdgcn_rcpf(l4[1]); rli[4 * g + 2] = __builtin_amdgcn_rcpf(l4[2]); rli[4 * g + 3] = __builtin_amdgcn_rcpf(l4[3]); }
        ATT_LDSWAIT();
        if (mp == 0) {
#pragma unroll
            for (int d0 = 0; d0 < 4; ++d0)
#pragma unroll
                for (int r = 0; r < 16; ++r) stg[crow(r, hi) * 128 + d0 * 32 + r32] = (bf16_t)f2bf(o[d0][r] * rli[r]);
            asm volatile("s_waitcnt lgkmcnt(0)\n\ts_barrier" ::: "memory");
        } else {
            float ss[16];
#pragma unroll
            for (int r = 0; r < 16; ++r) ss[r] = 0.f;
#pragma unroll
            for (int d0 = 0; d0 < 4; ++d0)
#pragma unroll
                for (int r = 0; r < 16; ++r) { const float a = bf2f(stg[crow(r, hi) * 128 + d0 * 32 + r32]); const float y = a - lam * o[d0][r] * rli[r]; o[d0][r] = y; ss[r] += y * y; }
#pragma unroll
            for (int r = 0; r < 16; ++r) { float v = ss[r]; v += __shfl_xor(v, 1); v += __shfl_xor(v, 2); v += __shfl_xor(v, 4); v += __shfl_xor(v, 8); v += __shfl_xor(v, 16);
                ss[r] = 0.8f / sqrtf(v * (1.f / 128.f) + EPS); }
            ATT_LDSWAIT();
#pragma unroll
            for (int d0 = 0; d0 < 4; ++d0) { const float gsub = subln[d0 * 32 + r32];
#pragma unroll
                for (int r = 0; r < 16; ++r) stg[crow(r, hi) * 128 + d0 * 32 + r32] = (bf16_t)f2bf(o[d0][r] * ss[r] * gsub); }
            ATT_LDSWAIT();
            bf16_t* Yw = ya + (rowbase + q0 + wid * 32) * 1024 + h * 128;
#pragma unroll
            for (int i = 0; i < 8; ++i) { const int row = i * 4 + (lane >> 4), ch = lane & 15; const u32x4 v = *(const __attribute__((address_space(3))) u32x4*)(stg + row * 128 + ch * 8); *(u32x4*)(Yw + (size_t)row * 1024 + ch * 8) = v; }
            asm volatile("s_waitcnt lgkmcnt(0)\n\ts_barrier" ::: "memory");
        }
    }
}

constexpr int B_SLOT = 8192, B_NS = 6, B_PF = 5;
constexpr int B_LDS_K = 0, B_LDS_V = B_NS * B_SLOT, B_LDS_WS = 2 * B_NS * B_SLOT, B_LDS_BIAS = B_LDS_WS + 8 * 256, B_LDS_ST = B_LDS_BIAS + 2560, B_LDS_BYTES = B_LDS_ST + 8 * 4096;
__device__ __forceinline__ void attn_b_unit(int b, int h, int rg, const bf16_t* proj, bf16_t* yb, const float* rpb, unsigned char* shm) {
    int tid_l = threadIdx.x; asm volatile("" : "+v"(tid_l));
    const int tid = tid_l, lane = tid & 63, r32 = lane & 31, hi = lane >> 5; const int wid = __builtin_amdgcn_readfirstlane(tid >> 6);
    const size_t rowbase = (size_t)b * SEQ;
    const int r = 4 * rg + (wid >> 1), c0 = 32 * (wid & 1);
    int rs = r - 4; rs = rs < 0 ? 0 : (rs > 24 ? 24 : rs);
    int rmin = 4 * rg - 4; rmin = rmin < 0 ? 0 : (rmin > 24 ? 24 : rmin);
    int rmaxs = 4 * rg + 3 - 4; rmaxs = rmaxs < 0 ? 0 : (rmaxs > 24 ? 24 : rmaxs);
    const int ntile = rmaxs + 8 - rmin;
    const unsigned lds0 = (unsigned)(uintptr_t)shm;
    const lds_cptr shm3 = (lds_cptr)shm;
    __attribute__((address_space(3))) float* wsf = (__attribute__((address_space(3))) float*)((lds_ptr)shm + B_LDS_WS) + wid * 64;
    __attribute__((address_space(3))) float* bias = (__attribute__((address_space(3))) float*)((lds_ptr)shm + B_LDS_BIAS) + 64;
    __attribute__((address_space(3))) bf16_t* stg = (__attribute__((address_space(3))) bf16_t*)((lds_ptr)shm + B_LDS_ST) + wid * 2048;
    const int vb0 = (int)(lds0 + B_LDS_V) + ((lane >> 4) & 1) * 32 + (lane & 3) * 8 + (4 * hi + ((lane & 15) >> 2)) * 64;
    for (int i = tid; i < 640; i += 512) { const int e = i - 64, ri = e >> 5, cj = e & 31; bias[e] = (e >= 0 && e < 480 && cj < 31) ? rpb[(h * 15 + ri) * 31 + cj] * LOG2E : 0.f; }
    const bf16_t* Kh = proj + rowbase * INW + C_KB + h * 64;
    const bf16_t* Vh = proj + rowbase * INW + C_VB + h * 64;
    const bf16_t* Qw = proj + (rowbase + r * 64 + c0) * INW + C_QB + h * 64;
    const unsigned kdst = lds0 + B_LDS_K + wid * 1024, vdst = lds0 + B_LDS_V + wid * 1024;
#define B_DMA(t, slot) do { int ln_ = lane; asm volatile("" : "+v"(ln_)); \
    const bf16_t* ksrc_ = Kh + (size_t)((rmin + (t)) * 64 + ln_) * INW + wid * 8; \
    const bf16_t* vsrc_ = Vh + (size_t)((rmin + (t)) * 64 + 16 * (wid & 3) + (ln_ >> 2)) * INW + (wid >> 2) * 32 + (ln_ & 3) * 8; \
    glds16(ksrc_, (unsigned)__builtin_amdgcn_readfirstlane(kdst + (slot) * B_SLOT)); \
    glds16(vsrc_, (unsigned)__builtin_amdgcn_readfirstlane(vdst + (slot) * B_SLOT)); } while (0)
#pragma unroll
    for (int t = 0; t < B_PF; ++t) B_DMA(t, t);
    bf16x8 qr[4];
#pragma unroll
    for (int d0 = 0; d0 < 4; ++d0) qr[d0] = *(const bf16x8*)(Qw + (size_t)r32 * INW + d0 * 16 + hi * 8);
    f32x16 o[2]; o[0] = f32x16{}; o[1] = f32x16{};
    float mrun = 0.f, lsum = 0.f; f32x16 negm = f32x16{}; bool first = true;
    const int c = c0 + r32; int cs = c - 8; cs = cs < 0 ? 0 : (cs > 48 ? 48 : cs);
    float fm0[16], fm1[16];
#pragma unroll
    for (int rr = 0; rr < 16; ++rr) { const int j0 = crow(rr, hi); fm0[rr] = ((unsigned)(j0 - cs) < 16u) ? 0.f : -1e30f; fm1[rr] = ((unsigned)(j0 + 32 - cs) < 16u) ? 0.f : -1e30f; }
    int slot = 0, slotn = B_PF;
    for (int t = 0; t < ntile; ++t) {
        { const int rem = ntile - 1 - t;
          if (rem >= 4) { ATT_WAIT_BAR(8); } else if (rem == 3) { ATT_WAIT_BAR(6); } else if (rem == 2) { ATT_WAIT_BAR(4); } else if (rem == 1) { ATT_WAIT_BAR(2); } else { ATT_WAIT_BAR(0); } }
        if (t + B_PF < ntile) B_DMA(t + B_PF, slotn);
        const int kr = rmin + t;
        if (kr >= rs && kr < rs + 8) {
            f32x16 p0, p1; u32x4 pw0, pw1, pw2, pw3;
            qkt<true>(p0, p1, shm3 + B_LDS_K + slot * B_SLOT, qr, negm, r32, hi);
            const __attribute__((address_space(3))) float* bp = bias + ((kr - r + 7) * 32 + 15 - c + 4 * hi);
#pragma unroll
            for (int rr = 0; rr < 16; ++rr) { const int jj = (rr & 3) + 8 * (rr >> 2);
                p0[rr] += bp[jj] + fm0[rr]; p1[rr] += bp[jj + 32] + fm1[rr]; }
            softmax_tile<2, 8, true>(p0, p1, mrun, lsum, negm, first, o, wsf, r32, hi, pw0, pw1, pw2, pw3); first = false;
            pv<2>(o, vb0 + slot * B_SLOT, __builtin_bit_cast(bf16x8, pw0), __builtin_bit_cast(bf16x8, pw1), __builtin_bit_cast(bf16x8, pw2), __builtin_bit_cast(bf16x8, pw3));
        }
        slot = (slot == B_NS - 1) ? 0 : slot + 1; slotn = (slotn == B_NS - 1) ? 0 : slotn + 1;
    }
#undef B_DMA
    const float lt = halfsum(lsum);
    if (hi == 0) wsf[32 + r32] = lt;
    ATT_LDSWAIT();
    float rli[16];
#pragma unroll
    for (int g = 0; g < 4; ++g) { const f32x4 l4 = *(const __attribute__((address_space(3))) f32x4*)(wsf + 32 + 8 * g + 4 * hi);
        rli[4 * g + 0] = __builtin_amdgcn_rcpf(l4[0]); rli[4 * g + 1] = __builtin_amdgcn_rcpf(l4[1]); rli[4 * g + 2] = __builtin_amdgcn_rcpf(l4[2]); rli[4 * g + 3] = __builtin_amdgcn_rcpf(l4[3]); }
#pragma unroll
    for (int d0 = 0; d0 < 2; ++d0)
#pragma unroll
        for (int rr = 0; rr < 16; ++rr) stg[crow(rr, hi) * 64 + d0 * 32 + r32] = (bf16_t)f2bf(o[d0][rr] * rli[rr]);
    ATT_LDSWAIT();
    bf16_t* Yw = yb + (rowbase + r * 64 + c0) * 1024 + 512 + h * 64;
#pragma unroll
    for (int i = 0; i < 4; ++i) { const int row = i * 8 + (lane >> 3), ch = lane & 7; const u32x4 v = *(const __attribute__((address_space(3))) u32x4*)(stg + row * 64 + ch * 8); *(u32x4*)(Yw + (size_t)row * 1024 + ch * 8) = v; }
    asm volatile("s_waitcnt lgkmcnt(0)\n\ts_barrier" ::: "memory");
}
}

namespace peer {
typedef short bf16x8 __attribute__((ext_vector_type(8)));
typedef float f32x16 __attribute__((ext_vector_type(16)));
typedef __attribute__((address_space(3))) const char* lds_cptr;
constexpr int T_LDS_SK = 0, T_LDS_BYTES = 65536;
__device__ __forceinline__ int imax(int a, int b) { int r; asm("v_max_f32 %0, %1, %2" : "=v"(r) : "v"(a), "v"(b)); return r; }
__device__ __forceinline__ int imin(int a, int b) { int r; asm("v_min_f32 %0, %1, %2" : "=v"(r) : "v"(a), "v"(b)); return r; }
__device__ __forceinline__ int f2key(float s, int idx) { return (__float_as_int(s) & ~127) | idx; }
__device__ __forceinline__ int key2bits(int k) { return k; }
template <int N, int OFF, int TOT> __device__ __forceinline__ void bsort_desc(int (&a)[TOT]) {
#pragma unroll
    for (int k = 2; k <= N; k <<= 1)
#pragma unroll
        for (int j = k >> 1; j > 0; j >>= 1)
#pragma unroll
            for (int i = 0; i < N; ++i) { const int l = i ^ j; if (l > i) { const bool desc = (i & k) == 0; const int hi_ = imax(a[OFF + i], a[OFF + l]), lo_ = imin(a[OFF + i], a[OFF + l]); a[OFF + i] = desc ? hi_ : lo_; a[OFF + l] = desc ? lo_ : hi_; } }
}
__device__ constexpr unsigned char NET16[126] = {0,1,2,3,0,2,1,3,1,2,4,5,6,7,4,6,5,7,5,6,0,4,2,6,2,4,1,5,3,7,3,5,1,2,3,4,5,6,8,9,10,11,8,10,9,11,9,10,12,13,14,15,12,14,13,15,13,14,8,12,10,14,10,12,9,13,11,15,11,13,9,10,11,12,13,14,0,8,4,12,4,8,2,10,6,14,6,10,2,4,6,8,10,12,1,9,5,13,5,9,3,11,7,15,7,11,3,5,7,9,11,13,1,2,3,4,5,6,7,8,9,10,11,12,13,14};
__device__ constexpr unsigned char NET32[382] = {0,1,2,3,0,2,1,3,1,2,4,5,6,7,4,6,5,7,5,6,0,4,2,6,2,4,1,5,3,7,3,5,1,2,3,4,5,6,8,9,10,11,8,10,9,11,9,10,12,13,14,15,12,14,13,15,13,14,8,12,10,14,10,12,9,13,11,15,11,13,9,10,11,12,13,14,0,8,4,12,4,8,2,10,6,14,6,10,2,4,6,8,10,12,1,9,5,13,5,9,3,11,7,15,7,11,3,5,7,9,11,13,1,2,3,4,5,6,7,8,9,10,11,12,13,14,16,17,18,19,16,18,17,19,17,18,20,21,22,23,20,22,21,23,21,22,16,20,18,22,18,20,17,21,19,23,19,21,17,18,19,20,21,22,24,25,26,27,24,26,25,27,25,26,28,29,30,31,28,30,29,31,29,30,24,28,26,30,26,28,25,29,27,31,27,29,25,26,27,28,29,30,16,24,20,28,20,24,18,26,22,30,22,26,18,20,22,24,26,28,17,25,21,29,21,25,19,27,23,31,23,27,19,21,23,25,27,29,17,18,19,20,21,22,23,24,25,26,27,28,29,30,0,16,8,24,8,16,4,20,12,28,12,20,4,8,12,16,20,24,2,18,10,26,10,18,6,22,14,30,14,22,6,10,14,18,22,26,2,4,6,8,10,12,14,16,18,20,22,24,26,28,1,17,9,25,9,17,5,21,13,29,13,21,5,9,13,17,21,25,3,19,11,27,11,19,7,23,15,31,15,23,7,11,15,19,23,27,3,5,7,9,11,13,15,17,19,21,23,25,27,29,1,2,3,4,5,6,7,8,9,10,11,12,13,14,15,16,17,18,19,20,21,22,23,24,25,26,27,28,29,30};
template <int OFF, int TOT> __device__ __forceinline__ void sort16_desc(int (&a)[TOT]) {
#pragma unroll
    for (int c = 0; c < 63; ++c) { const int i = OFF + NET16[2 * c], j = OFF + NET16[2 * c + 1]; const int hi_ = imax(a[i], a[j]), lo_ = imin(a[i], a[j]); a[i] = hi_; a[j] = lo_; }
}
template <int TOT> __device__ __forceinline__ void sort32_desc(int (&a)[TOT]) {
#pragma unroll
    for (int c = 0; c < 191; ++c) { const int i = NET32[2 * c], j = NET32[2 * c + 1]; const int hi_ = imax(a[i], a[j]), lo_ = imin(a[i], a[j]); a[i] = hi_; a[j] = lo_; }
}
template <int N, int OFF, int TOT> __device__ __forceinline__ void bmerge_desc(int (&a)[TOT]) {
#pragma unroll
    for (int j = N >> 1; j > 0; j >>= 1)
#pragma unroll
        for (int i = 0; i < N; ++i) { const int l = i ^ j; if (l > i) { const int hi_ = imax(a[OFF + i], a[OFF + l]), lo_ = imin(a[OFF + i], a[OFF + l]); a[OFF + i] = hi_; a[OFF + l] = lo_; } }
}
template <int A, int B, int TOT> __device__ __forceinline__ void merge_top16(int (&a)[TOT]) {
#pragma unroll
    for (int i = 0; i < 16; ++i) a[A + i] = imax(a[A + i], a[B + 15 - i]);
    bmerge_desc<16, A, TOT>(a);
}
__device__ __forceinline__ void cross_top16(int (&t)[16]) {
    int lo[16], hi[16];
#pragma unroll
    for (int i = 0; i < 16; ++i) { auto rr = __builtin_amdgcn_permlane32_swap((unsigned)t[i], (unsigned)t[i], false, false); lo[i] = (int)rr[0]; hi[i] = (int)rr[1]; }
#pragma unroll
    for (int i = 0; i < 16; ++i) t[i] = imax(lo[i], hi[15 - i]);
    bmerge_desc<16, 0, 16>(t);
}
__device__ __forceinline__ void half_top16(int (&top)[16], const bf16_t* qrow  , lds_cptr skp  , int hi) {
    f32x16 sc[4]; sc[0] = f32x16{}; sc[1] = f32x16{}; sc[2] = f32x16{}; sc[3] = f32x16{};
    bf16x8 qf[8];
#pragma unroll
    for (int ks = 0; ks < 8; ++ks) qf[ks] = *(const bf16x8*)(qrow + ks * 16);
#pragma unroll
    for (int ks = 0; ks < 8; ++ks)
#pragma unroll
        for (int kt = 0; kt < 4; ++kt) { const bf16x8 af = *(const __attribute__((address_space(3))) bf16x8*)(skp + ks * 4096 + kt * 512);
            sc[kt] = __builtin_amdgcn_mfma_f32_32x32x16_bf16(af, qf[ks], sc[kt], 0, 0, 0); }
    int k[64];
#pragma unroll
    for (int kt = 0; kt < 4; ++kt)
#pragma unroll
        for (int r = 0; r < 16; ++r) k[kt * 16 + r] = f2key(sc[kt][r], (32 * kt + (r & 3) + 8 * (r >> 2)) | (4 * hi));
    sort16_desc<0, 64>(k); sort16_desc<16, 64>(k); sort16_desc<32, 64>(k); sort16_desc<48, 64>(k);
    merge_top16<0, 16, 64>(k); merge_top16<32, 48, 64>(k); merge_top16<0, 32, 64>(k);
#pragma unroll
    for (int i = 0; i < 16; ++i) top[i] = k[i];
    cross_top16(top);
}
__device__ __forceinline__ void topk_wave(int tok0, int h, const bf16_t* Q, int* IDX, float* Gt, lds_cptr sk, int lane) {
    const int r32 = lane & 31, hi = lane >> 5, tok = tok0 + r32;
    const bf16_t* qrow = Q + (size_t)tok * PQ + h * 256 + 8 * hi;
    lds_cptr skl = sk + hi * 2048 + r32 * 16;
    int A0[16], A1[16];
    half_top16(A0, qrow, skl, hi);
    half_top16(A1, qrow + 128, skl + 32768, hi);
    float x[16], y[16]; int xw[16], yw[16];
#pragma unroll
    for (int a = 0; a < 16; ++a) { const int b0 = key2bits(A0[a]), b1 = key2bits(A1[a]);
        const float v0 = __int_as_float(b0 & ~127), v1 = __int_as_float(b1 & ~127); const int i0 = (b0 & 127) << 7, i1 = b1 & 127;
        x[a] = hi ? v1 : v0; y[a] = hi ? v0 : v1; xw[a] = hi ? i1 : i0; yw[a] = hi ? i0 : i1; }
    int w[32]; int n = 0;
#define PEER_CAND(a, b) do { const int bits = __float_as_int(x[a] + y[b]); int ww = (bits & ~0x3FFF) | (xw[a] + yw[b]); \
        if ((a) == (b) && hi) ww = (int)0xFF800000; w[n] = ww; ++n; } while (0)
#pragma unroll
    for (int b = 0; b < 16; ++b) PEER_CAND(0, b);
#pragma unroll
    for (int b = 1; b < 8; ++b) PEER_CAND(1, b);
#pragma unroll
    for (int b = 2; b < 5; ++b) PEER_CAND(2, b);
    PEER_CAND(3, 3);
#undef PEER_CAND
#pragma unroll
    for (int i = 27; i < 32; ++i) w[i] = (int)0xFF800000;
    sort32_desc<32>(w);
    int T[16];
#pragma unroll
    for (int i = 0; i < 16; ++i) T[i] = w[i];
    cross_top16(T);
    float sv[16]; int ev[16];
#pragma unroll
    for (int j = 0; j < 16; ++j) { ev[j] = T[j] & 0x3FFF; sv[j] = __int_as_float(T[j] & ~0x3FFF); }
    const float s0 = sv[0]; float esum = 0.f;
#pragma unroll
    for (int j = 0; j < 16; ++j) { sv[j] = __expf(sv[j] - s0); esum += sv[j]; }
    const float inv = 1.f / esum;
    if (hi == 0) { u32x4* io = (u32x4*)(IDX + ((size_t)tok * 8 + h) * 16);
#pragma unroll
        for (int j = 0; j < 4; ++j) io[j] = (u32x4){(unsigned)ev[4 * j], (unsigned)ev[4 * j + 1], (unsigned)ev[4 * j + 2], (unsigned)ev[4 * j + 3]}; }
    else { f32x4* go = (f32x4*)(Gt + ((size_t)tok * 8 + h) * 16);
#pragma unroll
        for (int j = 0; j < 4; ++j) go[j] = (f32x4){sv[4 * j] * inv, sv[4 * j + 1] * inv, sv[4 * j + 2] * inv, sv[4 * j + 3] * inv}; }
}
template <class Sched> __device__ __forceinline__ void topk_own_units(const Ptrs& P, unsigned char* shm, const Sched& S) {
    int tid_l = threadIdx.x; asm volatile("" : "+v"(tid_l));
    const int tid = tid_l, lane = tid & 63; const int wid = __builtin_amdgcn_readfirstlane(tid >> 6);
    const unsigned lds0 = (unsigned)(uintptr_t)shm;
    const bf16_t* SKg = (const bf16_t*)(P.ws + WS_SK);
    int hprev = -1; pg8::Unit u;
    for (int i = 0; S.next(i, u); ++i) {
        const int h = u.pn, tg = u.pm;
        if (h != hprev) { hprev = h;
            asm volatile("s_waitcnt lgkmcnt(0)\n\ts_barrier" ::: "memory");
#pragma unroll
            for (int j = 0; j < 8; ++j) { const int piece = wid * 8 + j, p = piece >> 5, c = (piece >> 1) & 15, kh = piece & 1;
                att::glds16(SKg + ((size_t)((h * 2 + p) * 128 + kh * 64 + lane) * 128 + c * 8), (unsigned)__builtin_amdgcn_readfirstlane(lds0 + p * 32768 + c * 2048 + kh * 1024)); }
            asm volatile("s_waitcnt vmcnt(0)\n\ts_barrier" ::: "memory");
        }
        topk_wave(tg * 256 + wid * 32, h, (const bf16_t*)(P.ws + WS_Q), (int*)(P.ws + WS_IDX), (float*)(P.ws + WS_G), (lds_cptr)shm, lane);
    }
}
}

namespace apply {
typedef float f32x2 __attribute__((ext_vector_type(2)));
typedef __attribute__((address_space(3))) unsigned* lds_u32p;
constexpr int AP_WAVE_BYTES = 4 * (512 + 2048), AP_LDS_BYTES = 8 * AP_WAVE_BYTES;
__device__ __forceinline__ float gelu_fast(float v) {
    const float av = fabsf(v), t = __builtin_amdgcn_rcpf(av * 0.2316418882f + 1.0f);
    float q = t * 0.5307027145f + (-0.7265760135f); q = q * t + 0.7107068705f; q = q * t + (-0.142248368f); q = q * t + 0.127414796f; q = q * t;
    const float e = __builtin_amdgcn_exp2f((v * v) * (-0.72134752044f));
    const float m = v * (q * e);
    return v < 0.f ? m : v - m;
}
#define AP_DPP(v, ctrl) __builtin_bit_cast(float, __builtin_amdgcn_update_dpp(0, __builtin_bit_cast(int, (v)), (ctrl), 0xF, 0xF, true))
__device__ __forceinline__ float row16_sum(float v) { v += AP_DPP(v, 0xB1); v += AP_DPP(v, 0x4E); v += AP_DPP(v, 0x141); v += AP_DPP(v, 0x140); return v; }
__device__ __forceinline__ void load_half(u32x4 (&r)[2], const unsigned char* img, unsigned e, int sub) {
    const unsigned off = e * 512u + (unsigned)(sub * 16);
    r[0] = *(const u32x4*)(img + off); r[1] = *(const u32x4*)(img + off + 256u);
}
constexpr int AP_PROBE_RING = 16;
constexpr int AP_RING = 8;
typedef __attribute__((address_space(3))) u32x4* lds_v4p;
template <int HF, int MODE, int RING> __device__ __forceinline__ void pass_u(const Ptrs& P, const bf16_t* hrow, float rstd, lds_v4p grp, u32x4 (&R)[RING][2], const unsigned char* img, const unsigned char* img_next, int sub) {
    unsigned xq[8]; float sx;
    {
        float xf[2][16]; float mx = 0.f;
#pragma unroll
        for (int i = 0; i < 2; ++i) { const int e0 = (sub + 16 * (2 * HF + i)) * 16;
#pragma unroll
            for (int q = 0; q < 4; ++q) { const u32x2 hb = *(const u32x2*)(hrow + e0 + 4 * q); const f32x4 gv = *(const f32x4*)(P.norm_ffn + e0 + 4 * q);
                xf[i][4 * q] = bflo(hb.x) * rstd * gv.x; xf[i][4 * q + 1] = bfhi(hb.x) * rstd * gv.y; xf[i][4 * q + 2] = bflo(hb.y) * rstd * gv.z; xf[i][4 * q + 3] = bfhi(hb.y) * rstd * gv.w;
                mx = fmaxf(fmaxf(mx, fmaxf(fabsf(xf[i][4 * q]), fabsf(xf[i][4 * q + 1]))), fmaxf(fabsf(xf[i][4 * q + 2]), fabsf(xf[i][4 * q + 3]))); } }
        mx = fmaxf(mx, AP_DPP(mx, 0xB1)); mx = fmaxf(mx, AP_DPP(mx, 0x4E)); mx = fmaxf(mx, AP_DPP(mx, 0x141)); mx = fmaxf(mx, AP_DPP(mx, 0x140));
        mx = fmaxf(mx, 1e-30f); sx = mx * (1.f / 127.f); const float qs = 127.f / mx;
#pragma unroll
        for (int i = 0; i < 2; ++i)
#pragma unroll
            for (int q = 0; q < 4; ++q) xq[4 * i + q] = pack_i8x4(xf[i][4 * q] * qs, xf[i][4 * q + 1] * qs, xf[i][4 * q + 2] * qs, xf[i][4 * q + 3] * qs);
    }
#pragma unroll 1
    for (int j = 0; j < 128; j += RING) {
        const int jn = (j + RING) & 127;
        __builtin_amdgcn_s_barrier();
        const unsigned char* tb = (j + RING < 128) ? img : img_next;
        unsigned nid[RING], part[RING], suv[RING], gsv[RING];
#pragma unroll
        for (int b4 = 0; b4 < RING / 4; ++b4) { const u32x4 na = grp[jn / 4 + b4];
            nid[4 * b4] = na.x; nid[4 * b4 + 1] = na.y; nid[4 * b4 + 2] = na.z; nid[4 * b4 + 3] = na.w;
            u32x4 pa = {}, sa = {}, ga = {};
            if (HF == 1) { pa = grp[96 + j / 4 + b4]; sa = grp[32 + j / 4 + b4]; ga = grp[64 + j / 4 + b4]; }
            part[4 * b4] = pa.x; part[4 * b4 + 1] = pa.y; part[4 * b4 + 2] = pa.z; part[4 * b4 + 3] = pa.w;
            suv[4 * b4] = sa.x; suv[4 * b4 + 1] = sa.y; suv[4 * b4 + 2] = sa.z; suv[4 * b4 + 3] = sa.w;
            gsv[4 * b4] = ga.x; gsv[4 * b4 + 1] = ga.y; gsv[4 * b4 + 2] = ga.z; gsv[4 * b4 + 3] = ga.w; }
        float outv[RING];
#pragma unroll
        for (int bq = 0; bq < RING; ++bq) {
            int d0_ = 0, d1_ = 0;
            if (MODE == 1) { asm volatile("" :: "v"(R[bq][0]), "v"(R[bq][1])); d0_ = (int)xq[0]; }
            else {
                d0_ = __builtin_amdgcn_sdot4((int)R[bq][0].x, (int)xq[0], d0_, false); d1_ = __builtin_amdgcn_sdot4((int)R[bq][0].y, (int)xq[1], d1_, false);
                d0_ = __builtin_amdgcn_sdot4((int)R[bq][0].z, (int)xq[2], d0_, false); d1_ = __builtin_amdgcn_sdot4((int)R[bq][0].w, (int)xq[3], d1_, false);
                d0_ = __builtin_amdgcn_sdot4((int)R[bq][1].x, (int)xq[4], d0_, false); d1_ = __builtin_amdgcn_sdot4((int)R[bq][1].y, (int)xq[5], d1_, false);
                d0_ = __builtin_amdgcn_sdot4((int)R[bq][1].z, (int)xq[6], d0_, false); d1_ = __builtin_amdgcn_sdot4((int)R[bq][1].w, (int)xq[7], d1_, false);
            }
            asm volatile("" ::: "memory");
            load_half(R[bq], tb, MODE == 2 ? (nid[bq] & 15u) : nid[bq], sub);
            asm volatile("" ::: "memory");
            float a_ = row16_sum((float)(d0_ + d1_)) * sx;
            if (HF == 1) { a_ = (a_ + __uint_as_float(part[bq])) * __uint_as_float(suv[bq]); a_ = __uint_as_float(gsv[bq]) * gelu_fast(a_); }
            outv[bq] = a_;
        }
        if (sub == 0) {
#pragma unroll
            for (int b4 = 0; b4 < RING / 4; ++b4) grp[96 + j / 4 + b4] = (u32x4){__float_as_uint(outv[4 * b4]), __float_as_uint(outv[4 * b4 + 1]), __float_as_uint(outv[4 * b4 + 2]), __float_as_uint(outv[4 * b4 + 3])}; }
    }
    asm volatile("s_waitcnt lgkmcnt(0)" ::: "memory");
}
template <int HF, int MODE, int RING> __device__ __forceinline__ void pass_v(float (&acc)[4][16], lds_v4p grp, u32x4 (&R)[RING][2], const unsigned char* img, const unsigned char* img_next, int sub) {
#pragma unroll 1
    for (int j = 0; j < 128; j += RING) {
        const int jn = (j + RING) & 127;
        __builtin_amdgcn_s_barrier();
        const unsigned char* tb = (j + RING < 128) ? img : img_next;
        unsigned nid[RING], cvv[RING];
#pragma unroll
        for (int b4 = 0; b4 < RING / 4; ++b4) { const u32x4 na = grp[jn / 4 + b4], ca = grp[96 + j / 4 + b4];
            nid[4 * b4] = na.x; nid[4 * b4 + 1] = na.y; nid[4 * b4 + 2] = na.z; nid[4 * b4 + 3] = na.w; cvv[4 * b4] = ca.x; cvv[4 * b4 + 1] = ca.y; cvv[4 * b4 + 2] = ca.z; cvv[4 * b4 + 3] = ca.w; }
#pragma unroll
        for (int bq = 0; bq < RING; ++bq) {
            const float c_ = __uint_as_float(cvv[bq]); const f32x2 c2 = {c_, c_};
            if (MODE == 1) { asm volatile("" :: "v"(R[bq][0]), "v"(R[bq][1])); acc[2 * HF][0] += c_; }
            else {
#pragma unroll
            for (int i = 0; i < 2; ++i) { const unsigned w_[4] = {R[bq][i].x, R[bq][i].y, R[bq][i].z, R[bq][i].w};
#pragma unroll
                for (int q = 0; q < 4; ++q) { const f32x2 lo_ = __builtin_amdgcn_cvt_pk_f32_fp8(w_[q], false), hi_ = __builtin_amdgcn_cvt_pk_f32_fp8(w_[q], true);
                    f32x2 a0 = {acc[2 * HF + i][4 * q], acc[2 * HF + i][4 * q + 1]}, a1 = {acc[2 * HF + i][4 * q + 2], acc[2 * HF + i][4 * q + 3]}; a0 += c2 * lo_; a1 += c2 * hi_;
                    acc[2 * HF + i][4 * q] = a0.x; acc[2 * HF + i][4 * q + 1] = a0.y; acc[2 * HF + i][4 * q + 2] = a1.x; acc[2 * HF + i][4 * q + 3] = a1.y; } }
            }
            asm volatile("" ::: "memory");
            load_half(R[bq], tb, MODE == 2 ? (nid[bq] & 15u) : nid[bq], sub);
            asm volatile("" ::: "memory");
        }
    }
}
template <int MODE> __device__ __forceinline__ void apply_round(const Ptrs& P, float* outbase, int tbase, unsigned char* shm_wave, int lane_in) {
    int lane = lane_in; asm volatile("" : "+v"(lane));
    const int sub = lane & 15, g = lane >> 4, t = tbase + g;
    __attribute__((address_space(3))) unsigned* cnt = (lds_u32p)(__attribute__((address_space(3))) unsigned char*)shm_wave + g * 128;
    lds_v4p grp = (lds_v4p)((__attribute__((address_space(3))) unsigned char*)shm_wave + 2048 + g * 2048);
    __attribute__((address_space(3))) unsigned* grp1 = (__attribute__((address_space(3))) unsigned*)grp;
    const unsigned char* U8 = P.ws + WS_U; const unsigned char* V8 = P.ws + WS_V;
    {
        const int* idxp = (const int*)(P.ws + WS_IDX) + (size_t)t * 128 + sub * 8; const float* gp = (const float*)(P.ws + WS_G) + (size_t)t * 128 + sub * 8;
        const u32x4 ia = *(const u32x4*)idxp, ib = *(const u32x4*)(idxp + 4); const f32x4 ga = *(const f32x4*)gp, gb = *(const f32x4*)(gp + 4);
        const int e[8] = {(int)ia.x, (int)ia.y, (int)ia.z, (int)ia.w, (int)ib.x, (int)ib.y, (int)ib.z, (int)ib.w};
        const float gt[8] = {ga.x, ga.y, ga.z, ga.w, gb.x, gb.y, gb.z, gb.w};
        float su[8], sv[8];
#pragma unroll
        for (int i = 0; i < 8; ++i) { su[i] = ((const float*)(P.ws + WS_SU))[e[i]]; sv[i] = ((const float*)(P.ws + WS_SV))[e[i]]; }
#pragma unroll
        for (int i = 0; i < 8; ++i) cnt[sub * 8 + i] = 0u;
        asm volatile("s_waitcnt lgkmcnt(0)" ::: "memory");
        unsigned pos[8];
#pragma unroll
        for (int i = 0; i < 8; ++i) pos[i] = __hip_atomic_fetch_add(cnt + (e[i] >> 7), 1u, __ATOMIC_RELAXED, __HIP_MEMORY_SCOPE_WAVEFRONT);
        asm volatile("s_waitcnt lgkmcnt(0)" ::: "memory");
        unsigned c[8]; unsigned tot = 0;
#pragma unroll
        for (int i = 0; i < 8; ++i) { c[i] = cnt[sub * 8 + i]; }
#pragma unroll
        for (int i = 0; i < 8; ++i) { const unsigned x = c[i]; c[i] = tot; tot += x; }
        unsigned inc = tot;
#pragma unroll
        for (int d = 1; d < 16; d <<= 1) { const unsigned y = __shfl_up(inc, d, 16); if (sub >= d) inc += y; }
        const unsigned base = inc - tot;
        asm volatile("s_waitcnt lgkmcnt(0)" ::: "memory");
#pragma unroll
        for (int i = 0; i < 8; ++i) cnt[sub * 8 + i] = base + c[i];
        asm volatile("s_waitcnt lgkmcnt(0)" ::: "memory");
#pragma unroll
        for (int i = 0; i < 8; ++i) { const unsigned p = cnt[e[i] >> 7] + pos[i];
            grp1[p] = (unsigned)e[i]; grp1[128 + p] = __float_as_uint(su[i]); grp1[256 + p] = __float_as_uint(gt[i] * sv[i]); }
        asm volatile("s_waitcnt lgkmcnt(0)" ::: "memory");
    }
    const bf16_t* hrow = (const bf16_t*)(P.ws + WS_HB) + (size_t)t * D;
    float rstd;
    { const float* ssq = (const float*)(P.ws + WS_SSQ) + (size_t)t * 16;
      const f32x4 s0 = *(const f32x4*)ssq, s1 = *(const f32x4*)(ssq + 4), s2 = *(const f32x4*)(ssq + 8), s3 = *(const f32x4*)(ssq + 12);
      const float tot = ((s0.x + s0.y) + (s0.z + s0.w)) + ((s1.x + s1.y) + (s1.z + s1.w)) + ((s2.x + s2.y) + (s2.z + s2.w)) + ((s3.x + s3.y) + (s3.z + s3.w));
      rstd = 1.f / sqrtf(tot * (1.f / D) + EPS); }
    constexpr int RG = (MODE == 1) ? AP_PROBE_RING : AP_RING;
    const unsigned char* U0 = U8; const unsigned char* U1 = U8 + (size_t)NEXP * 512; const unsigned char* V0 = V8; const unsigned char* V1 = V8 + (size_t)NEXP * 512;
    u32x4 R[RG][2];
    {
#pragma unroll
      for (int b4 = 0; b4 < RG / 4; ++b4) { const u32x4 ia = grp[b4]; load_half(R[4 * b4], U0, ia.x, sub); load_half(R[4 * b4 + 1], U0, ia.y, sub); load_half(R[4 * b4 + 2], U0, ia.z, sub); load_half(R[4 * b4 + 3], U0, ia.w, sub); } }
    pass_u<0, MODE, RG>(P, hrow, rstd, grp, R, U0, U1, sub);
    pass_u<1, MODE, RG>(P, hrow, rstd, grp, R, U1, V0, sub);
    float acc[4][16];
#pragma unroll
    for (int i = 0; i < 4; ++i)
#pragma unroll
        for (int q = 0; q < 16; ++q) acc[i][q] = 0.f;
    pass_v<0, MODE, RG>(acc, grp, R, V0, V1, sub);
    pass_v<1, MODE, RG>(acc, grp, R, V1, V1, sub);
    float ss = 0.f;
#pragma unroll
    for (int i = 0; i < 4; ++i) { const int e0 = (sub + 16 * i) * 16;
#pragma unroll
        for (int q = 0; q < 4; ++q) { const u32x2 hb = *(const u32x2*)(hrow + e0 + 4 * q);
            acc[i][4 * q] += bflo(hb.x); acc[i][4 * q + 1] += bfhi(hb.x); acc[i][4 * q + 2] += bflo(hb.y); acc[i][4 * q + 3] += bfhi(hb.y);
            ss += (acc[i][4 * q] * acc[i][4 * q] + acc[i][4 * q + 1] * acc[i][4 * q + 1]) + (acc[i][4 * q + 2] * acc[i][4 * q + 2] + acc[i][4 * q + 3] * acc[i][4 * q + 3]); }
        asm volatile("" ::: "memory"); }
    ss = row16_sum(ss);
    const float r2 = 1.f / sqrtf(ss * (1.f / D) + EPS);
    float* orow = outbase + (size_t)t * D;
#pragma unroll
    for (int i = 0; i < 4; ++i) { const int e0 = (sub + 16 * i) * 16;
#pragma unroll
        for (int q = 0; q < 4; ++q) { const f32x4 gv = *(const f32x4*)(P.norm_final + e0 + 4 * q);
            *(f32x4*)(orow + e0 + 4 * q) = (f32x4){acc[i][4 * q] * r2 * gv.x, acc[i][4 * q + 1] * r2 * gv.y, acc[i][4 * q + 2] * r2 * gv.z, acc[i][4 * q + 3] * r2 * gv.w}; }
        asm volatile("" ::: "memory"); }
}
template <int MODE> __device__ __forceinline__ void apply_phase(const Ptrs& P, float* outbase, unsigned char* shm, int G, int vcu) {
    int tid_l = threadIdx.x; asm volatile("" : "+v"(tid_l));
    const int lane = tid_l & 63; const int wave = __builtin_amdgcn_readfirstlane(tid_l >> 6);
    const int per = M / (G * 8);
#pragma unroll 1
    for (int r = 0; r < per; r += 4) apply_round<MODE>(P, outbase, (vcu * 8 + wave) * per + r, shm + wave * AP_WAVE_BYTES, lane);
}
}

#define LAS __attribute__((address_space(3)))
#define XB_TMO      128
#define XB_XCNT(j)  (256  + 64 * (j))
#define XB_XSUB(j)  (1280 + 64 * (j))
#define XB_XGEN(j)  (2304 + 64 * (j))
#define XB_TOP      3328
#define XB_TOPGEN   3392
#define XCD_BAR_WORDS 3456
#define XB_SPIN_CAP (1u << 18)

__device__ __forceinline__ unsigned xb_ld(unsigned* p)              { return __hip_atomic_load(p, __ATOMIC_RELAXED, __HIP_MEMORY_SCOPE_AGENT); }
__device__ __forceinline__ unsigned xb_add(unsigned* p, unsigned v) { return __hip_atomic_fetch_add(p, v, __ATOMIC_RELAXED, __HIP_MEMORY_SCOPE_AGENT); }
__device__ __forceinline__ unsigned xb_xcc_id() { return (unsigned)__builtin_amdgcn_s_getreg((3 << 11) | 20) & 0xFu; }
#define XB_SPIN(cond, bar) do { unsigned _sp = 0; while (cond) { __builtin_amdgcn_s_sleep(1); \
    if ((++_sp & 255u) == 0u) { if (xb_ld(&(bar)[XB_TMO])) break; if (_sp > XB_SPIN_CAP) { atomicAdd(&(bar)[XB_TMO], 1u); break; } } } } while (0)

struct XcdBarrier {
    unsigned* bar; unsigned x;
    volatile LAS unsigned* st;
};

__device__ __forceinline__ XcdBarrier xcd_barrier_post(unsigned* bar, volatile LAS unsigned* st) {
    XcdBarrier b; b.bar = bar; b.x = xb_xcc_id(); b.st = st;
    if (threadIdx.x == 0) (void)xb_add(&bar[XB_XCNT(b.x)], 1u);
    return b;
}
__device__ __forceinline__ void xcd_barrier_complete(unsigned* bar, unsigned x, unsigned& nloc, unsigned& nx) {
    const unsigned G = gridDim.x * gridDim.y * gridDim.z;
    unsigned sum, cnt, mine, sp = 0u;
    for (;;) {
        sum = 0u; cnt = 0u; mine = 0u;
#pragma unroll
        for (unsigned j = 0; j < 16; ++j) { const unsigned c = xb_ld(&bar[XB_XCNT(j)]); sum += c; cnt += (c > 0u) ? 1u : 0u; mine = (j == x) ? c : mine; }
        if (sum == G) break;
        __builtin_amdgcn_s_sleep(1);
        if ((++sp & 255u) == 0u) { if (xb_ld(&bar[XB_TMO])) break; if (sp > XB_SPIN_CAP) { atomicAdd(&bar[XB_TMO], 1u); break; } }
    }
    nloc = mine > 0u ? mine : 1u; nx = cnt > 0u ? cnt : 1u;
}

__device__ __forceinline__ void xcd_barrier(const XcdBarrier& b) {
    asm volatile("s_waitcnt vmcnt(0)" ::: "memory");
    __syncthreads();
    if (threadIdx.x == 0) {
        unsigned* bar = b.bar;
        __builtin_amdgcn_s_waitcnt(0);
        unsigned nloc = b.st[0], nx = b.st[1];
        if (nloc == 0u) { xcd_barrier_complete(bar, b.x, nloc, nx); b.st[0] = nloc; b.st[1] = nx; }
        const unsigned old = xb_add(&bar[XB_XSUB(b.x)], 1u);
        const unsigned gen = old / nloc;
        if (old + 1u == (gen + 1u) * nloc) {
            __builtin_amdgcn_fence(__ATOMIC_RELEASE, "agent");
            asm volatile("s_waitcnt vmcnt(0)" ::: "memory");
            const unsigned og = xb_add(&bar[XB_TOP], 1u);
            const unsigned tg = og / nx;
            if (og + 1u == (tg + 1u) * nx) xb_add(&bar[XB_TOPGEN], 1u);
            else XB_SPIN(xb_ld(&bar[XB_TOPGEN]) == tg, bar);
            __builtin_amdgcn_fence(__ATOMIC_ACQUIRE, "agent");
            xb_add(&bar[XB_XGEN(b.x)], 1u);
            asm volatile("s_waitcnt vmcnt(0)" ::: "memory");
        } else {
            XB_SPIN(xb_ld(&bar[XB_XGEN(b.x)]) == gen, bar);
            __builtin_amdgcn_fence(__ATOMIC_ACQUIRE, "agent");
            asm volatile("s_waitcnt vmcnt(0)" ::: "memory");
        }
    }
    __syncthreads();
}


namespace cg = cooperative_groups;
#ifndef REP_MASK
#define REP_MASK 0
#endif
#define REPS(k) (((REP_MASK) >> (k)) & 1 ? 2 : 1)
constexpr int PHASE_LDS = att::A_LDS_BYTES;
constexpr int MEGA_LDS = PHASE_LDS + 64;
static_assert(PHASE_LDS >= pg8::STAGE_BYTES && PHASE_LDS >= att::B_LDS_BYTES && PHASE_LDS >= peer::T_LDS_BYTES && PHASE_LDS >= 8 * 64 * 33 * 4 && PHASE_LDS >= apply::AP_LDS_BYTES, "LDS budget");
__global__ void __launch_bounds__(512, 2) mega_fwd(Ptrs P) {
    extern __shared__ __attribute__((aligned(16))) unsigned char lds_dyn[];
    volatile LAS unsigned* bst = (volatile LAS unsigned*)((LAS unsigned char*)lds_dyn + PHASE_LDS);
    if (threadIdx.x < 2) bst[threadIdx.x] = 0u;
    __syncthreads();
    const XcdBarrier bar = xcd_barrier_post((unsigned*)(P.ws + WS_CTL), bst);
    const int G = (int)gridDim.x, bx = (int)blockIdx.x, vcu = (G % 8 == 0) ? (bx % 8) * (G / 8) + bx / 8 : bx;
    unsigned char* ws = P.ws;
    PG8_LAS unsigned char* lds3 = (PG8_LAS unsigned char*)lds_dyn;
    for (int rep = 0; rep < REPS(0); ++rep) prep_phase(P, lds_dyn, G, bx);
    xcd_barrier(bar); if (REPS(9) == 2) xcd_barrier(bar);
    for (int rep = 0; rep < REPS(1); ++rep) {
      { pg8::Gemm g{(const bf16_t*)(ws + WS_XN), (const bf16_t*)(ws + WS_WIN), M, 1024, D, 0}; pg8::StaticOrder S; S.init(M, 1024, G, bx);
        pg8::gemm_phase<pg8::EpiProj, pg8::StaticOrder, true, true, false>(lds3, g, S, pg8::EpiProj{(bf16_t*)(ws + WS_PROJ), (const float*)(ws + WS_ROPE), 1.f, 0}); }
      { pg8::Gemm g{(const bf16_t*)(ws + WS_XN8), (const bf16_t*)(ws + WS_WIN8), M, INW - 1024, D / 2, 0}; pg8::StaticOrder S; S.init(M, INW - 1024, G, bx);
        pg8::gemm_phase<pg8::EpiProj, pg8::StaticOrder, true, true, true>(lds3, g, S, pg8::EpiProj{(bf16_t*)(ws + WS_PROJ), (const float*)(ws + WS_ROPE), 1.f / WIN_SCALE, 4}); } }
    xcd_barrier(bar); if (REPS(9) == 2) xcd_barrier(bar);
    { const float lam = lambda_full(P);
      for (int rep = 0; rep < REPS(2); ++rep) for (int u = vcu; u < BATCH * 4 * 8; u += G) att::attn_a_unit(u >> 5, (u >> 3) & 3, u & 7, (const bf16_t*)(ws + WS_PROJ), (bf16_t*)(ws + WS_YA), P.subln, lam, lds_dyn);
      for (int rep = 0; rep < REPS(3); ++rep) for (int u = vcu; u < BATCH * 8 * 8; u += G) att::attn_b_unit(u >> 6, (u >> 3) & 7, u & 7, (const bf16_t*)(ws + WS_PROJ), (bf16_t*)(ws + WS_YA), P.rpb, lds_dyn); }
    xcd_barrier(bar); if (REPS(9) == 2) xcd_barrier(bar);
    for (int rep = 0; rep < REPS(4); ++rep) { pg8::StaticOrder S; S.init(M, D, G, bx);
      pg8::gemm_phase<pg8::EpiGate2, pg8::StaticOrder, true, true>(lds3, pg8::Gemm{(const bf16_t*)(ws + WS_YA), (const bf16_t*)(ws + WS_WPA), M, D, D, 0}, S, pg8::EpiGate2{(const bf16_t*)(ws + WS_PROJ), (bf16_t*)(ws + WS_MERGED)}); }
    xcd_barrier(bar); if (REPS(9) == 2) xcd_barrier(bar);
    for (int rep = 0; rep < REPS(5); ++rep) { pg8::StaticOrder S; S.init(M, D, G, bx);
      pg8::gemm_phase<pg8::EpiHout, pg8::StaticOrder, true, true>(lds3, pg8::Gemm{(const bf16_t*)(ws + WS_MERGED), (const bf16_t*)(ws + WS_WOUT), M, D, D, 0}, S, pg8::EpiHout{P.x, P.out, (bf16_t*)(ws + WS_HB), (float*)(ws + WS_SSQ)});
      cvt_experts_phase(P, G, bx); }
    xcd_barrier(bar); if (REPS(9) == 2) xcd_barrier(bar);
    { pg8::StaticOrder S; S.init(M, PQ, G, bx);
      for (int rep = 0; rep < REPS(8); ++rep)
        pg8::gemm_phase<pg8::EpiQ, pg8::StaticOrder, true, true>(lds3, pg8::Gemm{(const bf16_t*)(ws + WS_HB), (const bf16_t*)(ws + WS_WQ), M, PQ, D, 0}, S, pg8::EpiQ{(const float*)(ws + WS_SSQ), (bf16_t*)(ws + WS_Q)});
      asm volatile("s_waitcnt vmcnt(0)" ::: "memory");
      __syncthreads();
      if (threadIdx.x == 0) { __builtin_amdgcn_fence(__ATOMIC_ACQUIRE, "agent"); asm volatile("s_waitcnt vmcnt(0)" ::: "memory"); }
      __syncthreads();
      for (int rep = 0; rep < REPS(6); ++rep) peer::topk_own_units(P, lds_dyn, S); }
    xcd_barrier(bar); if (REPS(9) == 2) xcd_barrier(bar);
#ifndef PROBE_MODE
#define PROBE_MODE 0
#endif
    if (REPS(7) == 2) apply::apply_phase<PROBE_MODE>(P, (float*)(ws + WS_Q), lds_dyn, G, vcu);
    apply::apply_phase<0>(P, P.out, lds_dyn, G, vcu);
}

extern "C" void kernel_launch(void* const* d_in, const int* in_sizes, int n_in, void* d_out, int out_size, void* d_ws, size_t ws_size, hipStream_t stream) {
    if (n_in != 18 || ws_size < WS_END) { fprintf(stderr, "kernel_launch: unexpected n_in %d / ws_size %zu\n", n_in, ws_size); return; }
    Ptrs P{};
    P.x = (const float*)d_in[0]; P.w_in = (const float*)d_in[1]; P.w_pa = (const float*)d_in[2]; P.w_pb = (const float*)d_in[3]; P.w_out = (const float*)d_in[4];
    P.norm_mix = (const float*)d_in[5]; P.norm_ffn = (const float*)d_in[6]; P.norm_final = (const float*)d_in[7];
    P.lq1 = (const float*)d_in[8]; P.lk1 = (const float*)d_in[9]; P.lq2 = (const float*)d_in[10]; P.lk2 = (const float*)d_in[11];
    P.subln = (const float*)d_in[12]; P.rpb = (const float*)d_in[13]; P.w_query = (const float*)d_in[14]; P.sub_keys = (const float*)d_in[15];
    P.peer_u = (const float*)d_in[16]; P.peer_v = (const float*)d_in[17];
    P.out = (float*)d_out; P.ws = (unsigned char*)d_ws;
    static int grid_blocks = 0;
    if (!grid_blocks) {
        int dev = 0, cus = 0, per_cu = 0;
        hipGetDevice(&dev);
        hipDeviceGetAttribute(&cus, hipDeviceAttributeMultiprocessorCount, dev);
        hipFuncSetAttribute((const void*)mega_fwd, hipFuncAttributeMaxDynamicSharedMemorySize, MEGA_LDS);
        hipOccupancyMaxActiveBlocksPerMultiprocessor(&per_cu, (const void*)mega_fwd, 512, MEGA_LDS);
        if (per_cu < 1) { fprintf(stderr, "kernel_launch: occupancy query says %d blocks per CU\n", per_cu); per_cu = 1; }
        grid_blocks = cus * per_cu;
    }
    hipMemsetAsync((unsigned char*)d_ws + WS_CTL, 0, 16384, stream);
    void* args[] = {&P};
    hipError_t e = hipLaunchCooperativeKernel((const void*)mega_fwd, dim3(grid_blocks), dim3(512), args, MEGA_LDS, stream);
    if (e != hipSuccess) fprintf(stderr, "cooperative launch failed: %s (grid %d)\n", hipGetErrorString(e), grid_blocks);
}
```

```cpp
#include <hip/hip_runtime.h>
#include <hip/hip_cooperative_groups.h>
#include <cstdio>
#include <cstdint>

typedef unsigned short bf16_t;
typedef unsigned u32x4 __attribute__((ext_vector_type(4)));
typedef unsigned u32x2 __attribute__((ext_vector_type(2)));
typedef float f32x4 __attribute__((ext_vector_type(4)));
typedef __bf16 bf16x2_t __attribute__((ext_vector_type(2)));

constexpr int D = 1024, BATCH = 8, SEQ = 2048, M = BATCH * SEQ, INW = 5120;
constexpr int C_QA = 0, C_KA = 512, C_VA = 1024, C_QB = 1536, C_KB = 2048, C_VB = 2560, C_GA = 3072, C_GB = 4096;
constexpr int NEXP = 16384, PQ = 2048;
constexpr float EPS = 1e-6f;
constexpr float LOG2E = 1.4426950408889634f;
constexpr float WIN_SCALE = 32.f;
constexpr float QSCALE = 0.125f * LOG2E;

constexpr size_t MiB = 1u << 20;
constexpr size_t WS_PROJ = 0;
constexpr size_t WS_HB = 0;
constexpr size_t WS_Q = 32 * MiB;
constexpr size_t WS_U = 96 * MiB;
constexpr size_t WS_V = 112 * MiB;
constexpr size_t WS_SU = 128 * MiB;
constexpr size_t WS_SV = 128 * MiB + 65536;
constexpr size_t WS_XN = 160 * MiB;
constexpr size_t WS_YA = 160 * MiB;
constexpr size_t WS_YB = 176 * MiB;
constexpr size_t WS_IDX = 160 * MiB;
constexpr size_t WS_G = 168 * MiB;
constexpr size_t WS_MERGED = 192 * MiB;
constexpr size_t WS_TOPV = 192 * MiB;
constexpr size_t WS_TOPI = 208 * MiB;
constexpr size_t WS_WIN = 224 * MiB;
constexpr size_t WS_WIN8 = 226 * MiB;
constexpr size_t WS_XN8 = 192 * MiB;
constexpr size_t WS_WQ = 234 * MiB;
constexpr size_t WS_WOUT = 238 * MiB;
constexpr size_t WS_WPA = 240 * MiB;
constexpr size_t WS_WPB = 241 * MiB;
constexpr size_t WS_SK = 242 * MiB;
constexpr size_t WS_ROPE = 242 * MiB + 512 * 1024;
constexpr size_t WS_SSQ = 243 * MiB;
constexpr size_t WS_CTL = 244 * MiB;
constexpr size_t WS_END = 256 * MiB;

__device__ __forceinline__ float bf2f(unsigned v) { return __uint_as_float(v << 16); }
__device__ __forceinline__ float bflo(unsigned w) { return __uint_as_float(w << 16); }
__device__ __forceinline__ float bfhi(unsigned w) { return __uint_as_float(w & 0xffff0000u); }
__device__ __forceinline__ unsigned f2bf(float f) { unsigned u = __float_as_uint(f); return (u + 0x7fffu + ((u >> 16) & 1u)) >> 16; }
__device__ __forceinline__ unsigned pk2(float lo, float hi) { return f2bf(lo) | (f2bf(hi) << 16); }
__device__ __forceinline__ float wave_sum(float v) {
#pragma unroll
    for (int o = 1; o < 64; o <<= 1) v += __shfl_xor(v, o);
    return v;
}
__device__ __forceinline__ float sigmoidf_(float x) { return 1.f / (1.f + __expf(-x)); }
__device__ __forceinline__ float gelu_exact(float x) { return 0.5f * x * (1.f + erff(x * 0.70710678118654752f)); }

struct Ptrs {
    const float *x, *w_in, *w_pa, *w_pb, *w_out, *norm_mix, *norm_ffn, *norm_final, *lq1, *lk1, *lq2, *lk2, *subln, *rpb, *w_query, *sub_keys, *peer_u, *peer_v;
    float* out; unsigned char* ws;
};

__device__ __forceinline__ void transpose_item(const float* W, int K, int N, const float* gain, bf16_t* WT, float* scr, int item, int lane, int ldo = 0, int koff = 0, int ldw = 0) {
    if (ldo == 0) ldo = K;
    if (ldw == 0) ldw = N;
    const int nblk = N / 32, kb = item / nblk, nb = item % nblk, k0 = 64 * kb, n0 = 32 * nb;
    float wv[32];
#pragma unroll
    for (int i = 0; i < 32; ++i) { const int kk = 2 * i + (lane >> 5); wv[i] = W[(size_t)(k0 + kk) * ldw + n0 + (lane & 31)]; }
#pragma unroll
    for (int i = 0; i < 32; ++i) { const int kk = 2 * i + (lane >> 5); float w = wv[i]; if (gain) w *= gain[k0 + kk]; scr[kk * 33 + (lane & 31)] = w; }
    asm volatile("s_waitcnt lgkmcnt(0)" ::: "memory");
    const int c = lane & 7;
#pragma unroll
    for (int j = 0; j < 4; ++j) { const int n = (lane >> 3) + 8 * j; const float* s = scr + (8 * c) * 33 + n;
        u32x4 o; o.x = pk2(s[0 * 33], s[1 * 33]); o.y = pk2(s[2 * 33], s[3 * 33]); o.z = pk2(s[4 * 33], s[5 * 33]); o.w = pk2(s[6 * 33], s[7 * 33]);
        *(u32x4*)(WT + (size_t)(n0 + n) * ldo + koff + k0 + 8 * c) = o; }
    asm volatile("s_waitcnt lgkmcnt(0)" ::: "memory");
}
__device__ __forceinline__ void cvt8(const float* src, bf16_t* dst, size_t i8) {
    const f32x4 a = *(const f32x4*)(src + i8 * 8), b = *(const f32x4*)(src + i8 * 8 + 4);
    u32x4 o; o.x = pk2(a.x, a.y); o.y = pk2(a.z, a.w); o.z = pk2(b.x, b.y); o.w = pk2(b.z, b.w);
    *(u32x4*)(dst + i8 * 8) = o;
}
__device__ __forceinline__ void transpose_item8(const float* W, int K, int N, int ldw, const float* gain, float wscale, unsigned char* WT, float* scr, int item, int lane) {
    const int nblk = N / 32, kb = item / nblk, nb = item % nblk, k0 = 64 * kb, n0 = 32 * nb;
    float wv[32];
#pragma unroll
    for (int i = 0; i < 32; ++i) { const int kk = 2 * i + (lane >> 5); wv[i] = W[(size_t)(k0 + kk) * ldw + n0 + (lane & 31)]; }
#pragma unroll
    for (int i = 0; i < 32; ++i) { const int kk = 2 * i + (lane >> 5); float w = wv[i] * wscale; if (gain) w *= gain[k0 + kk]; scr[kk * 33 + (lane & 31)] = w; }
    asm volatile("s_waitcnt lgkmcnt(0)" ::: "memory");
    const int c = lane & 7;
#pragma unroll
    for (int j = 0; j < 4; ++j) { const int n = (lane >> 3) + 8 * j; const float* s = scr + (8 * c) * 33 + n;
        u32x2 o; o.x = __builtin_amdgcn_cvt_pk_fp8_f32(s[0 * 33], s[1 * 33], 0u, false); o.x = __builtin_amdgcn_cvt_pk_fp8_f32(s[2 * 33], s[3 * 33], o.x, true);
        o.y = __builtin_amdgcn_cvt_pk_fp8_f32(s[4 * 33], s[5 * 33], 0u, false); o.y = __builtin_amdgcn_cvt_pk_fp8_f32(s[6 * 33], s[7 * 33], o.y, true);
        *(u32x2*)(WT + (size_t)(n0 + n) * K + k0 + 8 * c) = o; }
    asm volatile("s_waitcnt lgkmcnt(0)" ::: "memory");
}
__device__ __forceinline__ void rms_rows_emit(const f32x4 (&v)[4], bf16_t* orow16, unsigned char* orow, int lane) {
    float s = 0.f;
#pragma unroll
    for (int j = 0; j < 4; ++j) s += (v[j].x * v[j].x + v[j].y * v[j].y) + (v[j].z * v[j].z + v[j].w * v[j].w);
    const float rstd = 1.f / sqrtf(wave_sum(s) * (1.f / D) + EPS);
    unsigned* o4 = (unsigned*)orow + lane; u32x2* o8 = (u32x2*)orow16 + lane;
#pragma unroll
    for (int j = 0; j < 4; ++j) { unsigned w = __builtin_amdgcn_cvt_pk_fp8_f32(v[j].x * rstd, v[j].y * rstd, 0u, false); w = __builtin_amdgcn_cvt_pk_fp8_f32(v[j].z * rstd, v[j].w * rstd, w, true); o4[64 * j] = w;
        u32x2 w2; w2.x = pk2(v[j].x * rstd, v[j].y * rstd); w2.y = pk2(v[j].z * rstd, v[j].w * rstd); o8[64 * j] = w2; }
}
__device__ __forceinline__ void rms_rows(const float* x, bf16_t* xn16, unsigned char* xn8, int m0, int step, int lane) {
    if (m0 >= M) return;
    f32x4 cur[4], nxt[4];
#pragma unroll
    for (int j = 0; j < 4; ++j) cur[j] = ((const f32x4*)(x + (size_t)m0 * D) + lane)[64 * j];
    for (int m = m0; m < M; m += step) {
        const int mn = (m + step < M) ? m + step : m;
#pragma unroll
        for (int j = 0; j < 4; ++j) nxt[j] = ((const f32x4*)(x + (size_t)mn * D) + lane)[64 * j];
        rms_rows_emit(cur, xn16 + (size_t)m * D, xn8 + (size_t)m * D, lane);
#pragma unroll
        for (int j = 0; j < 4; ++j) cur[j] = nxt[j];
    }
}
__device__ __forceinline__ void rms_row_to_bf16(const float* xrow, bf16_t* orow, int lane) {
    const f32x4* xr = (const f32x4*)xrow + lane;
    f32x4 v[4]; float s = 0.f;
#pragma unroll
    for (int j = 0; j < 4; ++j) { v[j] = xr[64 * j]; s += (v[j].x * v[j].x + v[j].y * v[j].y) + (v[j].z * v[j].z + v[j].w * v[j].w); }
    const float rstd = 1.f / sqrtf(wave_sum(s) * (1.f / D) + EPS);
    u32x2* o8 = (u32x2*)orow + lane;
#pragma unroll
    for (int j = 0; j < 4; ++j) { u32x2 w; w.x = pk2(v[j].x * rstd, v[j].y * rstd); w.y = pk2(v[j].z * rstd, v[j].w * rstd); o8[64 * j] = w; }
}

__device__ __forceinline__ void prep_phase(const Ptrs& P, unsigned char* shm, int G, int bx) {
    int tid_l = threadIdx.x; asm volatile("" : "+v"(tid_l));
    const int lane = tid_l & 63; const int wave = __builtin_amdgcn_readfirstlane(tid_l >> 6);
    const int gw = bx * 8 + wave, NGW = G * 8;
    float* scr = (float*)(shm + wave * (64 * 33 * 4));
    unsigned char* ws = P.ws;
    constexpr int N_BF = 1024;
    constexpr int I_INB = (D / 64) * (N_BF / 32), I_IN8 = (D / 64) * ((INW - N_BF) / 32), I_IN = I_INB + I_IN8, I_Q = (D / 64) * (PQ / 32), I_OUT = (D / 64) * (D / 32), I_PA = (512 / 64) * (D / 32);
    constexpr int NIT = I_IN + I_Q + I_OUT + 2 * I_PA;
    for (int it = gw; it < NIT; it += NGW) {
        int r = it;
        if (r < I_INB) { transpose_item(P.w_in, D, N_BF, P.norm_mix, (bf16_t*)(ws + WS_WIN), scr, r, lane, 0, 0, INW); continue; } r -= I_INB;
        if (r < I_IN8) { transpose_item8(P.w_in + N_BF, D, INW - N_BF, INW, P.norm_mix, WIN_SCALE, ws + WS_WIN8, scr, r, lane); continue; } r -= I_IN8;
        if (r < I_Q) { transpose_item(P.w_query, D, PQ, P.norm_ffn, (bf16_t*)(ws + WS_WQ), scr, r, lane); continue; } r -= I_Q;
        if (r < I_OUT) { transpose_item(P.w_out, D, D, nullptr, (bf16_t*)(ws + WS_WOUT), scr, r, lane); continue; } r -= I_OUT;
        if (r < I_PA) { transpose_item(P.w_pa, 512, D, nullptr, (bf16_t*)(ws + WS_WPA), scr, r, lane, 1024, 0); continue; } r -= I_PA;
        transpose_item(P.w_pb, 512, D, nullptr, (bf16_t*)(ws + WS_WPA), scr, r, lane, 1024, 512);
    }
    rms_rows(P.x, (bf16_t*)(ws + WS_XN), ws + WS_XN8, gw, NGW, lane);
    const size_t gt = (size_t)bx * 512 + threadIdx.x, NT = (size_t)G * 512;
    for (size_t i = gt; i < (size_t)16 * 128 * 128 / 8; i += NT) cvt8(P.sub_keys, (bf16_t*)(ws + WS_SK), i);
    for (size_t i = gt; i < (size_t)SEQ * 8; i += NT) {
        const int pos = (int)(i >> 3), k = (int)(i & 7);
        const float inv = k == 0 ? 1.0f : k == 1 ? 0.19392274f : k == 2 ? 0.03760603f : k == 3 ? 0.0072926646f : k == 4 ? 0.0014142136f : k == 5 ? 0.0002742482f : k == 6 ? 5.3182957e-05f : 1.0313385e-05f;
        const float ang = (float)pos * inv;
        float sn, cs; sincosf(ang, &sn, &cs);
        float* t = (float*)(ws + WS_ROPE) + (size_t)pos * 16;
        t[k] = cs; t[8 + k] = sn;
    }
}
__device__ __forceinline__ void cvt_row_fp8(const f32x4 (&rv)[4], unsigned char* dst, float* inv_scale, int lane) {
    const f32x4 a = rv[0], b = rv[1], c = rv[2], d = rv[3];
    float m = fmaxf(fmaxf(fmaxf(fabsf(a.x), fabsf(a.y)), fmaxf(fabsf(a.z), fabsf(a.w))), fmaxf(fmaxf(fabsf(b.x), fabsf(b.y)), fmaxf(fabsf(b.z), fabsf(b.w))));
    m = fmaxf(m, fmaxf(fmaxf(fmaxf(fabsf(c.x), fabsf(c.y)), fmaxf(fabsf(c.z), fabsf(c.w))), fmaxf(fmaxf(fabsf(d.x), fabsf(d.y)), fmaxf(fabsf(d.z), fabsf(d.w)))));
#pragma unroll
    for (int o = 1; o < 64; o <<= 1) m = fmaxf(m, __shfl_xor(m, o));
    m = fmaxf(m, 1e-30f);
    const float sc = 256.f / m;
    u32x4 w;
    w.x = __builtin_amdgcn_cvt_pk_fp8_f32(a.x * sc, a.y * sc, 0u, false); w.x = __builtin_amdgcn_cvt_pk_fp8_f32(a.z * sc, a.w * sc, w.x, true);
    w.y = __builtin_amdgcn_cvt_pk_fp8_f32(b.x * sc, b.y * sc, 0u, false); w.y = __builtin_amdgcn_cvt_pk_fp8_f32(b.z * sc, b.w * sc, w.y, true);
    w.z = __builtin_amdgcn_cvt_pk_fp8_f32(c.x * sc, c.y * sc, 0u, false); w.z = __builtin_amdgcn_cvt_pk_fp8_f32(c.z * sc, c.w * sc, w.z, true);
    w.w = __builtin_amdgcn_cvt_pk_fp8_f32(d.x * sc, d.y * sc, 0u, false); w.w = __builtin_amdgcn_cvt_pk_fp8_f32(d.z * sc, d.w * sc, w.w, true);
    *(u32x4*)(dst + (size_t)(lane >> 5) * (NEXP * 512) + (lane & 31) * 16) = w;
    if (lane == 0) *inv_scale = m * (1.f / 256.f);
}
__device__ __forceinline__ unsigned pack_i8x4(float a, float b, float c, float d) {
    const int q0 = (int)rintf(a), q1 = (int)rintf(b), q2 = (int)rintf(c), q3 = (int)rintf(d);
    return (unsigned)(q0 & 0xff) | ((unsigned)(q1 & 0xff) << 8) | ((unsigned)(q2 & 0xff) << 16) | ((unsigned)q3 << 24);
}
__device__ __forceinline__ void cvt_row_i8(const f32x4 (&rv)[4], unsigned char* dst, float* inv_scale, int lane) {
    const f32x4 a = rv[0], b = rv[1], c = rv[2], d = rv[3];
    float m = fmaxf(fmaxf(fmaxf(fabsf(a.x), fabsf(a.y)), fmaxf(fabsf(a.z), fabsf(a.w))), fmaxf(fmaxf(fabsf(b.x), fabsf(b.y)), fmaxf(fabsf(b.z), fabsf(b.w))));
    m = fmaxf(m, fmaxf(fmaxf(fmaxf(fabsf(c.x), fabsf(c.y)), fmaxf(fabsf(c.z), fabsf(c.w))), fmaxf(fmaxf(fabsf(d.x), fabsf(d.y)), fmaxf(fabsf(d.z), fabsf(d.w)))));
#pragma unroll
    for (int o = 1; o < 64; o <<= 1) m = fmaxf(m, __shfl_xor(m, o));
    m = fmaxf(m, 1e-30f);
    const float sc = 127.f / m;
    u32x4 w;
    w.x = pack_i8x4(a.x * sc, a.y * sc, a.z * sc, a.w * sc); w.y = pack_i8x4(b.x * sc, b.y * sc, b.z * sc, b.w * sc);
    w.z = pack_i8x4(c.x * sc, c.y * sc, c.z * sc, c.w * sc); w.w = pack_i8x4(d.x * sc, d.y * sc, d.z * sc, d.w * sc);
    *(u32x4*)(dst + (size_t)(lane >> 5) * (NEXP * 512) + (lane & 31) * 16) = w;
    if (lane == 0) *inv_scale = m * (1.f / 127.f);
}
__device__ __forceinline__ void cvt_experts_phase(const Ptrs& P, int G, int bx) {
    int tid_l = threadIdx.x; asm volatile("" : "+v"(tid_l));
    const int lane = tid_l & 63; const int wave = __builtin_amdgcn_readfirstlane(tid_l >> 6);
    const int step = G * 8; int r = bx * 8 + wave;
    if (r >= 2 * NEXP) return;
    f32x4 cur[4], nxt[4];
    { const float* src = (r < NEXP ? P.peer_u + (size_t)r * D : P.peer_v + (size_t)(r - NEXP) * D);
#pragma unroll
      for (int j = 0; j < 4; ++j) cur[j] = ((const f32x4*)src + lane * 4)[j]; }
    for (; r < 2 * NEXP; r += step) {
        const int rn = (r + step < 2 * NEXP) ? r + step : r;
        const float* srcn = (rn < NEXP ? P.peer_u + (size_t)rn * D : P.peer_v + (size_t)(rn - NEXP) * D);
#pragma unroll
        for (int j = 0; j < 4; ++j) nxt[j] = ((const f32x4*)srcn + lane * 4)[j];
        if (r < NEXP) cvt_row_i8(cur, P.ws + WS_U + (size_t)r * 512, (float*)(P.ws + WS_SU) + r, lane);
        else { const int e = r - NEXP; cvt_row_fp8(cur, P.ws + WS_V + (size_t)e * 512, (float*)(P.ws + WS_SV) + e, lane); }
#pragma unroll
        for (int j = 0; j < 4; ++j) cur[j] = nxt[j];
    }
}

namespace pg8 {
#define PG8_LAS __attribute__((address_space(3)))
typedef unsigned short bf16_t;
typedef short bf16x8 __attribute__((ext_vector_type(8)));
typedef float f32x4 __attribute__((ext_vector_type(4)));
typedef unsigned u32x4 __attribute__((ext_vector_type(4)));
typedef int v8i_t __attribute__((ext_vector_type(8)));
constexpr int BM = 256, BK = 64, HALF = 128, HTB = HALF * BK * 2  , STAGE_BYTES = 8 * HTB, NXCD = 8, WGM = 8;

__host__ __device__ __forceinline__ int lds_byte(int r, int c) { const int st = (r >> 4) * 2 + (c >> 5), rr = r & 15, cc = c & 31, ob = rr * 64 + cc * 2; return st * 1024 + (ob ^ (((ob >> 9) & 1) << 5)); }
__host__ __device__ __forceinline__ void stage_rc(int b, int& R, int& C) { const int st = b / 1024, sb = b % 1024, swz = sb ^ (((sb >> 9) & 1) << 5); R = (st >> 1) * 16 + swz / 64; C = (st & 1) * 32 + (swz % 64) / 2; }
__host__ __device__ __forceinline__ int perm32(int rho) { const int n = rho >> 4, i = rho & 15; return 8 * (i >> 2) + 4 * n + (i & 3); }

struct Unit { int pm, pn; };
struct Gemm { const bf16_t* A; const bf16_t* Bt; int M, N, K, pad; };

struct StaticOrder {
    int nM, nN, nwg, G, c;
    __host__ __device__ void init(int M, int N, int G_, int c_) { nM = M / BM; nN = N / BM; nwg = nM * nN; G = G_; c = c_; }
    __host__ __device__ bool next(int i, Unit& u) const {
        const long L = (long)i * G + c; if (L >= nwg) return false;
        int wgid = (int)L; { const int q = nwg / NXCD, r = nwg % NXCD, xcd = wgid % NXCD, off = wgid / NXCD; wgid = (xcd < r ? xcd * (q + 1) : r * (q + 1) + (xcd - r) * q) + off; }
        const int nig = WGM * nN, gid = wgid / nig, fm = gid * WGM, gsz = (nM - fm) < WGM ? (nM - fm) : WGM;
        u.pm = fm + ((wgid % nig) % gsz); u.pn = (wgid % nig) / gsz; return true;
    }
    __device__ __forceinline__ void a_ready(const Unit&) const {}
    __device__ __forceinline__ void done(const Unit&) const {}
};
__device__ __forceinline__ unsigned cvt_pk_bf16(float lo, float hi) { unsigned r; asm volatile("v_cvt_pk_bf16_f32 %0, %1, %2" : "=v"(r) : "v"(lo), "v"(hi)); return r; }
typedef float f32x2 __attribute__((ext_vector_type(2)));

__device__ __forceinline__ float sigm(float x) { return __builtin_amdgcn_rcpf(1.f + __builtin_amdgcn_exp2f(-1.4426950408889634f * x)); }
struct EpiProj {
    static constexpr bool PERM = true, AFTER_DRAIN = false, MID = false;
    bf16_t* O; const float* rope; float osc; int pn0;
    __device__ __forceinline__ void operator()(const f32x4 (&acc)[2][2][4][2], const Unit& u, int wr, int wc, int fr_, int fq_) const {
        int fr = fr_, fq = fq_; asm volatile("" : "+v"(fr), "+v"(fq));
        const int pn = u.pn + pn0;
        const int row0 = u.pm * BM + wr * 64 + fr, col0 = pn * BM + wc * 32 + 8 * fq;
        const float sc = ((pn < 2 || pn == 6 || pn == 7) ? QSCALE : 1.f) * osc;
        const bool dorope = (pn < 4) && ((wc & 1) == 0);
#pragma unroll
        for (int ai = 0; ai < 2; ++ai)
#pragma unroll
            for (int m = 0; m < 4; ++m) { const int row = row0 + ai * HALF + m * 16; bf16_t* rowp = O + (size_t)row * INW + col0;
                f32x4 c4[2] = {{1.f, 1.f, 1.f, 1.f}, {1.f, 1.f, 1.f, 1.f}}, s4[2] = {{0.f, 0.f, 0.f, 0.f}, {0.f, 0.f, 0.f, 0.f}};
                if (dorope) { const float* rp = rope + (size_t)(row & (SEQ - 1)) * 16; c4[0] = *(const f32x4*)(rp); c4[1] = *(const f32x4*)(rp + 4); s4[0] = *(const f32x4*)(rp + 8); s4[1] = *(const f32x4*)(rp + 12); }
#pragma unroll
                for (int bj = 0; bj < 2; ++bj) { f32x4 v0 = acc[ai][bj][m][0], v1 = acc[ai][bj][m][1];
                    if (dorope) { f32x4 o0, o1;
#pragma unroll
                        for (int j = 0; j < 4; ++j) { o0[j] = __shfl_xor(v0[j], 16); o1[j] = __shfl_xor(v1[j], 16); }
                        if (fq == 0) { v0 = v0 * c4[0] - o0 * s4[0]; v1 = v1 * c4[1] - o1 * s4[1]; }
                        else if (fq == 1) { v0 = v0 * c4[0] + o0 * s4[0]; v1 = v1 * c4[1] + o1 * s4[1]; } }
                    v0 = v0 * sc; v1 = v1 * sc; u32x4 w; w.x = cvt_pk_bf16(v0[0], v0[1]); w.y = cvt_pk_bf16(v0[2], v0[3]); w.z = cvt_pk_bf16(v1[0], v1[1]); w.w = cvt_pk_bf16(v1[2], v1[3]);
                    *(u32x4*)(rowp + bj * HALF) = w; } }
    }
};
struct EpiGate2 {
    static constexpr bool PERM = true, AFTER_DRAIN = false, MID = true;
    const bf16_t* proj; bf16_t* O;
    __device__ __forceinline__ void mid(f32x4 (&acc)[2][2][4][2], const Unit& u, int wr, int wc, int fr, int fq) const {
        int row0 = u.pm * BM + wr * 64 + fr, col0 = u.pn * BM + wc * 32 + 8 * fq;
        asm volatile("" : "+v"(row0), "+v"(col0));
#pragma unroll
        for (int ai = 0; ai < 2; ++ai) {
            u32x4 gav[4][2], gbv[4][2];
#pragma unroll
            for (int m = 0; m < 4; ++m)
#pragma unroll
                for (int bj = 0; bj < 2; ++bj) { const bf16_t* gp = proj + (size_t)(row0 + ai * HALF + m * 16) * INW + col0 + bj * HALF; gav[m][bj] = *(const u32x4*)(gp + C_GA); gbv[m][bj] = *(const u32x4*)(gp + C_GB); }
#pragma unroll
            for (int m = 0; m < 4; ++m) {
#pragma unroll
                for (int bj = 0; bj < 2; ++bj) { const u32x4 ga = gav[m][bj], gb = gbv[m][bj];
                    const unsigned a_[4] = {ga.x, ga.y, ga.z, ga.w}, b_[4] = {gb.x, gb.y, gb.z, gb.w};
#pragma unroll
                    for (int q = 0; q < 4; ++q) {
                        const float r0 = (1.f + __builtin_amdgcn_exp2f(-1.4426950408889634f * bflo(b_[q]))) * __builtin_amdgcn_rcpf(1.f + __builtin_amdgcn_exp2f(-1.4426950408889634f * bflo(a_[q])));
                        const float r1 = (1.f + __builtin_amdgcn_exp2f(-1.4426950408889634f * bfhi(b_[q]))) * __builtin_amdgcn_rcpf(1.f + __builtin_amdgcn_exp2f(-1.4426950408889634f * bfhi(a_[q])));
                        acc[ai][bj][m][q >> 1][(q & 1) * 2] *= r0; acc[ai][bj][m][q >> 1][(q & 1) * 2 + 1] *= r1; } } }
            asm volatile("" ::: "memory"); }
    }
    __device__ __forceinline__ void operator()(const f32x4 (&acc)[2][2][4][2], const Unit& u, int wr, int wc, int fr_, int fq_) const {
        int fr = fr_, fq = fq_; asm volatile("" : "+v"(fr), "+v"(fq));
        const int row0 = u.pm * BM + wr * 64 + fr, col0 = u.pn * BM + wc * 32 + 8 * fq;
#pragma unroll
        for (int ai = 0; ai < 2; ++ai) {
            u32x4 gv[4][2];
#pragma unroll
            for (int m = 0; m < 4; ++m)
#pragma unroll
                for (int bj = 0; bj < 2; ++bj) gv[m][bj] = *(const u32x4*)(proj + (size_t)(row0 + ai * HALF + m * 16) * INW + C_GB + col0 + bj * HALF);
#pragma unroll
            for (int m = 0; m < 4; ++m) { const int row = row0 + ai * HALF + m * 16;
#pragma unroll
                for (int bj = 0; bj < 2; ++bj) { const int col = col0 + bj * HALF; const u32x4 g = gv[m][bj];
                    f32x4 v0 = acc[ai][bj][m][0], v1 = acc[ai][bj][m][1];
                    v0[0] *= sigm(bflo(g.x)); v0[1] *= sigm(bfhi(g.x)); v0[2] *= sigm(bflo(g.y)); v0[3] *= sigm(bfhi(g.y));
                    v1[0] *= sigm(bflo(g.z)); v1[1] *= sigm(bfhi(g.z)); v1[2] *= sigm(bflo(g.w)); v1[3] *= sigm(bfhi(g.w));
                    u32x4 w; w.x = cvt_pk_bf16(v0[0], v0[1]); w.y = cvt_pk_bf16(v0[2], v0[3]); w.z = cvt_pk_bf16(v1[0], v1[1]); w.w = cvt_pk_bf16(v1[2], v1[3]);
                    *(u32x4*)(O + (size_t)row * D + col) = w; } }
            asm volatile("" ::: "memory"); }
    }
};
struct EpiHout {
    static constexpr bool PERM = true, AFTER_DRAIN = false, MID = false;
    const float* x; float* H; bf16_t* HB; float* ssq16;
    __device__ __forceinline__ void operator()(const f32x4 (&acc)[2][2][4][2], const Unit& u, int wr, int wc, int fr_, int fq_) const {
        int fr = fr_, fq = fq_; asm volatile("" : "+v"(fr), "+v"(fq));
        const int row0 = u.pm * BM + wr * 64 + fr, col0 = u.pn * BM + wc * 32 + 8 * fq;
#pragma unroll
        for (int ai = 0; ai < 2; ++ai) {
            f32x4 xv[4][2][2];
#pragma unroll
            for (int m = 0; m < 4; ++m)
#pragma unroll
                for (int bj = 0; bj < 2; ++bj) { const float* xp = x + (size_t)(row0 + ai * HALF + m * 16) * D + col0 + bj * HALF; xv[m][bj][0] = *(const f32x4*)xp; xv[m][bj][1] = *(const f32x4*)(xp + 4); }
#pragma unroll
            for (int m = 0; m < 4; ++m) { const int row = row0 + ai * HALF + m * 16; float ss = 0.f;
#pragma unroll
                for (int bj = 0; bj < 2; ++bj) { const int col = col0 + bj * HALF;
                    const f32x4 v0 = acc[ai][bj][m][0] + xv[m][bj][0], v1 = acc[ai][bj][m][1] + xv[m][bj][1];
                    u32x4 w; w.x = cvt_pk_bf16(v0[0], v0[1]); w.y = cvt_pk_bf16(v0[2], v0[3]); w.z = cvt_pk_bf16(v1[0], v1[1]); w.w = cvt_pk_bf16(v1[2], v1[3]);
                    *(u32x4*)(HB + (size_t)row * D + col) = w;
                    ss += (v0[0] * v0[0] + v0[1] * v0[1]) + (v0[2] * v0[2] + v0[3] * v0[3]) + (v1[0] * v1[0] + v1[1] * v1[1]) + (v1[2] * v1[2] + v1[3] * v1[3]); }
                ss += __shfl_xor(ss, 16); ss += __shfl_xor(ss, 32);
                if (fq == 0) ssq16[(size_t)row * 16 + u.pn * 4 + wc] = ss; }
            asm volatile("" ::: "memory"); }
    }
};
struct EpiQ {
    static constexpr bool PERM = true, AFTER_DRAIN = false, MID = false;
    const float* ssq16; bf16_t* O;
    __device__ __forceinline__ void operator()(const f32x4 (&acc)[2][2][4][2], const Unit& u, int wr, int wc, int fr, int fq) const {
        const int row0 = u.pm * BM + wr * 64 + fr, col0 = u.pn * BM + wc * 32 + 8 * fq;
#pragma unroll
        for (int ai = 0; ai < 2; ++ai)
#pragma unroll
            for (int m = 0; m < 4; ++m) { const int row = row0 + ai * HALF + m * 16; const f32x4* sp = (const f32x4*)(ssq16 + (size_t)row * 16);
                const f32x4 a = sp[0], b = sp[1], c = sp[2], d = sp[3];
                const float tot = ((a[0] + a[1]) + (a[2] + a[3])) + ((b[0] + b[1]) + (b[2] + b[3])) + ((c[0] + c[1]) + (c[2] + c[3])) + ((d[0] + d[1]) + (d[2] + d[3]));
                const float rstd = 1.f / sqrtf(tot * (1.f / D) + EPS);
#pragma unroll
                for (int bj = 0; bj < 2; ++bj) { const f32x4 v0 = acc[ai][bj][m][0] * rstd, v1 = acc[ai][bj][m][1] * rstd;
                    u32x4 w; w.x = cvt_pk_bf16(v0[0], v0[1]); w.y = cvt_pk_bf16(v0[2], v0[3]); w.z = cvt_pk_bf16(v1[0], v1[1]); w.w = cvt_pk_bf16(v1[2], v1[3]);
                    *(u32x4*)(O + (size_t)row * PQ + col0 + bj * HALF) = w; } }
    }
};
template <class Epi, class Sched, bool ALIGN_EPI = false, bool SP2 = false, bool FP8 = false>
__device__ __forceinline__ void gemm_phase(PG8_LAS unsigned char* lds, const Gemm g, const Sched& S, const Epi& E) {
    int tid_l = threadIdx.x; asm volatile("" : "+v"(tid_l));
    const int tid = tid_l, wid = __builtin_amdgcn_readfirstlane(tid >> 6), lane = tid & 63, wr = wid >> 2, wc = wid & 3, fr = lane & 15, fq = lane >> 4;
    const int K = g.K, nt = K / BK;
    unsigned voffA[2], voffB[2];
#pragma unroll
    for (int i = 0; i < 2; ++i) { int R, C; stage_rc(tid * 16 + i * 8192, R, C); const int Rb = Epi::PERM ? ((R & ~31) + perm32(R & 31)) : R;
        voffA[i] = (unsigned)(R * K + C) * 2u; voffB[i] = (unsigned)(Rb * K + C) * 2u; }
    const size_t kstep = (size_t)(BK * 2);
    const size_t hstep = (size_t)HALF * K * 2;
    const size_t tstep = 2 * hstep;
    const unsigned ldsw = (unsigned)wid * 1024u;
    const int aoff = lds_byte(wr * 64 + fr, fq * 8), boff = lds_byte(wc * 32 + fr, fq * 8);
    const int aoffF0 = FP8 ? lds_byte(wr * 64 + fr, fq * 16) : 0, boffF0 = FP8 ? lds_byte(wc * 32 + fr, fq * 16) : 0;
#define PG8_SA(b, h) (((b) * 2 + (h)) * HTB)
#define PG8_SB(b, h) ((4 + (b) * 2 + (h)) * HTB)
#define PG8_STAGE(bufoff, gbase, voff) do { _Pragma("unroll") for (int _i = 0; _i < 2; ++_i) \
        __builtin_amdgcn_global_load_lds((const unsigned*)((const char*)(gbase) + (voff)[_i]), (PG8_LAS unsigned*)(lds + (bufoff) + ldsw + _i * 8192), 16, 0, 0); } while (0)
#define PG8_LDA(dst, b, h) do { if constexpr (FP8) { _Pragma("unroll") for (int m = 0; m < 4; ++m) { const u32x4 l_ = *(const PG8_LAS u32x4*)(lds + PG8_SA(b, h) + aoffF0 + m * 2048), h_ = *(const PG8_LAS u32x4*)(lds + PG8_SA(b, h) + aoffF0 + m * 2048 + 16); \
            dst##8[m] = (v8i_t){(int)l_.x, (int)l_.y, (int)l_.z, (int)l_.w, (int)h_.x, (int)h_.y, (int)h_.z, (int)h_.w}; } } \
        else { _Pragma("unroll") for (int m = 0; m < 4; ++m) _Pragma("unroll") for (int k = 0; k < 2; ++k) dst[m][k] = *(const PG8_LAS bf16x8*)(lds + PG8_SA(b, h) + aoff + m * 2048 + k * 1024); } } while (0)
#define PG8_LDB(dst, b, h) do { if constexpr (FP8) { _Pragma("unroll") for (int n = 0; n < 2; ++n) { const u32x4 l_ = *(const PG8_LAS u32x4*)(lds + PG8_SB(b, h) + boffF0 + n * 2048), h_ = *(const PG8_LAS u32x4*)(lds + PG8_SB(b, h) + boffF0 + n * 2048 + 16); \
            dst##8[n] = (v8i_t){(int)l_.x, (int)l_.y, (int)l_.z, (int)l_.w, (int)h_.x, (int)h_.y, (int)h_.z, (int)h_.w}; } } \
        else { _Pragma("unroll") for (int n = 0; n < 2; ++n) _Pragma("unroll") for (int k = 0; k < 2; ++k) dst[n][k] = *(const PG8_LAS bf16x8*)(lds + PG8_SB(b, h) + boff + n * 2048 + k * 1024); } } while (0)
#define PG8_MMA(ai, bj, At, Bt) do { __builtin_amdgcn_s_setprio(1); \
        if constexpr (FP8) { _Pragma("unroll") for (int m = 0; m < 4; ++m) _Pragma("unroll") for (int n = 0; n < 2; ++n) \
            asm volatile("v_mfma_scale_f32_16x16x128_f8f6f4 %0, %1, %2, %0, %3, %3 op_sel_hi:[0,0,0]" : "+v"(acc[ai][bj][m][n]) : "v"(Bt##8[n]), "v"(At##8[m]), "v"(mxone)); } \
        else { _Pragma("unroll") for (int m = 0; m < 4; ++m) _Pragma("unroll") for (int n = 0; n < 2; ++n) _Pragma("unroll") for (int k = 0; k < 2; ++k) \
            acc[ai][bj][m][n] = __builtin_amdgcn_mfma_f32_16x16x32_bf16(Bt[n][k], At[m][k], acc[ai][bj][m][n], 0, 0, 0); } \
        __builtin_amdgcn_s_setprio(0); } while (0)
#define PG8_WAIT_V(n) asm volatile("s_waitcnt vmcnt(" #n ")" ::: "memory")
#define PG8_WAIT_L(n) asm volatile("s_waitcnt lgkmcnt(" #n ")" ::: "memory")
#define PG8_BAR __builtin_amdgcn_s_barrier()
#define PG8_SCHED __builtin_amdgcn_sched_barrier(0)
    Unit cur, nxt; int ui = 0;
    if (!S.next(0, cur)) return;
    f32x4 acc[2][2][4][2];
#pragma unroll
    for (int a = 0; a < 2; ++a)
#pragma unroll
        for (int b = 0; b < 2; ++b)
#pragma unroll
            for (int m = 0; m < 4; ++m)
#pragma unroll
                for (int n = 0; n < 2; ++n) acc[a][b][m][n] = (f32x4){0.f, 0.f, 0.f, 0.f};
    bf16x8 At[4][2], B0[2][2], B1[2][2]; v8i_t At8[4], B08[2], B18[2];
    int mxone = 0x7F7F7F7F; asm volatile("" : "+v"(mxone));
    const char* cA = (const char*)g.A + (size_t)cur.pm * tstep; const char* cB = (const char*)g.Bt + (size_t)cur.pn * tstep;
    S.a_ready(cur);
    if constexpr (SP2) {
        PG8_STAGE(PG8_SB(0, 0), cB, voffB); PG8_STAGE(PG8_SB(0, 1), cB + hstep, voffB); PG8_STAGE(PG8_SA(0, 0), cA, voffA); PG8_STAGE(PG8_SA(0, 1), cA + hstep, voffA);
        if (wr == 1) PG8_BAR;
        PG8_WAIT_V(2); PG8_BAR;
        PG8_STAGE(PG8_SB(1, 0), cB + kstep, voffB); PG8_STAGE(PG8_SA(1, 0), cA + kstep, voffA); PG8_STAGE(PG8_SB(1, 1), cB + hstep + kstep, voffB);
        PG8_WAIT_V(6); PG8_BAR;
    } else {
        PG8_STAGE(PG8_SB(0, 0), cB, voffB); PG8_STAGE(PG8_SA(0, 0), cA, voffA); PG8_STAGE(PG8_SB(0, 1), cB + hstep, voffB); PG8_STAGE(PG8_SA(0, 1), cA + hstep, voffA);
        if (wr == 1) PG8_BAR;
        PG8_WAIT_V(4); PG8_BAR;
        PG8_STAGE(PG8_SB(1, 0), cB + kstep, voffB); PG8_STAGE(PG8_SA(1, 0), cA + kstep, voffA); PG8_STAGE(PG8_SB(1, 1), cB + hstep + kstep, voffB);
        PG8_WAIT_V(6); PG8_BAR;
    }
    for (;;) {
        const bool has_next = S.next(ui + 1, nxt);
        const char* nA = has_next ? (const char*)g.A + (size_t)nxt.pm * tstep : cA; const char* nB = has_next ? (const char*)g.Bt + (size_t)nxt.pn * tstep : cB;
#pragma unroll 1
        for (int t = 0; t < nt; t += 2) {
            if constexpr (Epi::MID) { if (t == nt / 2) E.mid(acc, cur, wr, wc, fr, fq); }
            const bool last = (t == nt - 2);
            const char* a1 = cA + (size_t)(t + 1) * kstep;
            const char* a2 = last ? nA : cA + (size_t)(t + 2) * kstep; const char* b2 = last ? nB : cB + (size_t)(t + 2) * kstep;
            const char* a3 = a2 + kstep; const char* b3 = b2 + kstep;
            if (last && has_next) S.a_ready(nxt);
            if constexpr (SP2) {
            PG8_LDB(B0, 0, 0); PG8_LDB(B1, 0, 1); PG8_SCHED; PG8_LDA(At, 0, 0); PG8_STAGE(PG8_SA(1, 1), a1 + hstep, voffA);
            PG8_WAIT_V(8); PG8_WAIT_L(0); PG8_BAR; PG8_MMA(0, 0, At, B0); PG8_MMA(0, 1, At, B1); PG8_BAR; PG8_SCHED;
            PG8_LDA(At, 0, 1); PG8_STAGE(PG8_SB(0, 0), b2, voffB); PG8_STAGE(PG8_SB(0, 1), b2 + hstep, voffB); PG8_STAGE(PG8_SA(0, 0), a2, voffA);
            PG8_WAIT_V(8); PG8_WAIT_L(0); PG8_BAR; PG8_MMA(1, 0, At, B0); PG8_MMA(1, 1, At, B1); PG8_BAR; PG8_SCHED;
            PG8_LDB(B0, 1, 0); PG8_LDB(B1, 1, 1); PG8_SCHED; PG8_LDA(At, 1, 0); PG8_STAGE(PG8_SA(0, 1), a2 + hstep, voffA);
            PG8_WAIT_V(8); PG8_WAIT_L(0); PG8_BAR; PG8_MMA(0, 0, At, B0); PG8_MMA(0, 1, At, B1); PG8_BAR; PG8_SCHED;
            PG8_LDA(At, 1, 1); PG8_STAGE(PG8_SB(1, 0), b3, voffB); PG8_STAGE(PG8_SB(1, 1), b3 + hstep, voffB); PG8_STAGE(PG8_SA(1, 0), a3, voffA);
            PG8_WAIT_V(8); PG8_WAIT_L(0); PG8_BAR; PG8_MMA(1, 0, At, B0); PG8_MMA(1, 1, At, B1); PG8_BAR; PG8_SCHED;
            } else {
            PG8_LDB(B0, 0, 0); PG8_SCHED; PG8_LDA(At, 0, 0); PG8_STAGE(PG8_SA(1, 1), a1 + hstep, voffA);
            PG8_WAIT_L(8); PG8_BAR; PG8_WAIT_L(0); PG8_MMA(0, 0, At, B0); PG8_BAR; PG8_SCHED;
            PG8_LDB(B1, 0, 1); PG8_STAGE(PG8_SB(0, 0), b2, voffB);
            PG8_BAR; PG8_WAIT_L(0); PG8_MMA(0, 1, At, B1); PG8_BAR;
            PG8_LDA(At, 0, 1); PG8_STAGE(PG8_SA(0, 0), a2, voffA);
            PG8_BAR; PG8_WAIT_L(0); PG8_MMA(1, 0, At, B0); PG8_BAR; PG8_SCHED;
            PG8_STAGE(PG8_SB(0, 1), b2 + hstep, voffB);
            PG8_WAIT_V(6); PG8_BAR; PG8_MMA(1, 1, At, B1); PG8_BAR;
            PG8_LDB(B0, 1, 0); PG8_SCHED; PG8_LDA(At, 1, 0); PG8_STAGE(PG8_SA(0, 1), a2 + hstep, voffA);
            PG8_WAIT_L(8); PG8_BAR; PG8_WAIT_L(0); PG8_MMA(0, 0, At, B0); PG8_BAR; PG8_SCHED;
            PG8_LDB(B1, 1, 1); PG8_STAGE(PG8_SB(1, 0), b3, voffB);
            PG8_BAR; PG8_WAIT_L(0); PG8_MMA(0, 1, At, B1); PG8_BAR;
            PG8_LDA(At, 1, 1); PG8_STAGE(PG8_SA(1, 0), a3, voffA);
            PG8_BAR; PG8_WAIT_L(0); PG8_MMA(1, 0, At, B0); PG8_BAR; PG8_SCHED;
            PG8_STAGE(PG8_SB(1, 1), b3 + hstep, voffB);
            PG8_WAIT_V(6); PG8_BAR; PG8_MMA(1, 1, At, B1); PG8_BAR;
            }
        }
        if constexpr (ALIGN_EPI) { if (wr == 0) PG8_BAR; }
        if constexpr (FP8) { asm volatile("s_nop 15\n\ts_nop 7" ::: "memory"); PG8_SCHED; }
        if constexpr (!Epi::AFTER_DRAIN) { E(acc, cur, wr, wc, fr, fq); S.done(cur); }
        if (!has_next) break;
#pragma unroll
        for (int a = 0; a < 2; ++a)
#pragma unroll
            for (int b = 0; b < 2; ++b)
#pragma unroll
                for (int m = 0; m < 4; ++m)
#pragma unroll
                    for (int n = 0; n < 2; ++n) acc[a][b][m][n] = (f32x4){0.f, 0.f, 0.f, 0.f};
        cur = nxt; cA = nA; cB = nB; ++ui;
        if constexpr (ALIGN_EPI) { if (wr == 1) PG8_BAR; }
    }
    PG8_WAIT_V(0);
    if constexpr (!ALIGN_EPI) { if (wr == 0) PG8_BAR; }
    PG8_BAR;
    if constexpr (Epi::AFTER_DRAIN) { E.fused(acc, cur, wr, wc, fr, fq, lds, wid, lane); S.done(cur); }
#undef PG8_SA
#undef PG8_SB
#undef PG8_STAGE
#undef PG8_LDA
#undef PG8_LDB
#undef PG8_MMA
#undef PG8_WAIT_V
#undef PG8_WAIT_L
#undef PG8_BAR
#undef PG8_SCHED
}
}

__device__ __forceinline__ float lambda_full(const Ptrs& P) {
    float a = 0.f, b = 0.f;
    for (int i = 0; i < 64; ++i) { a += P.lq1[i] * P.lk1[i]; b += P.lq2[i] * P.lk2[i]; }
    return __expf(a) - __expf(b) + 0.2f;
}

namespace att {
typedef short bf16x8 __attribute__((ext_vector_type(8)));
typedef short s16x4 __attribute__((ext_vector_type(4)));
typedef float f32x16 __attribute__((ext_vector_type(16)));
typedef float f32x2_t __attribute__((ext_vector_type(2)));
typedef __attribute__((address_space(3))) const char* lds_cptr;
typedef __attribute__((address_space(3))) char* lds_ptr;
__device__ __forceinline__ int crow(int r, int hi) { return (r & 3) + 8 * (r >> 2) + 4 * hi; }
__device__ __forceinline__ void glds16(const void* gsrc, unsigned lds_dst) { unsigned keep;
    asm volatile("s_mov_b32 %0, m0\n\ts_mov_b32 m0, %2\n\ts_nop 0\n\tglobal_load_lds_dwordx4 %1, off\n\ts_mov_b32 m0, %0" : "=&s"(keep) : "v"(gsrc), "s"(lds_dst) : "memory"); }
__device__ __forceinline__ unsigned cvtpk(float lo, float hi) { f32x2_t v = {lo, hi}; bf16x2_t b = __builtin_convertvector(v, bf16x2_t); return __builtin_bit_cast(unsigned, b); }
#define ATT_WAIT_BAR(N) asm volatile("s_waitcnt vmcnt(" #N ") lgkmcnt(0)\n\ts_barrier" ::: "memory")
#define ATT_LDSWAIT() asm volatile("s_waitcnt lgkmcnt(0)" ::: "memory")
#define ATT_SBAR() __builtin_amdgcn_sched_barrier(0)
template <bool REL> __device__ __forceinline__ void qkt(f32x16& p0, f32x16& p1, lds_cptr Kslot, const bf16x8* qr, const f32x16& negm, int r32, int hi) {
    lds_cptr kb = Kslot + hi * 1024 + r32 * 16;
#pragma unroll
    for (int d0 = 0; d0 < 4; ++d0) {
        const bf16x8 b0 = *(const __attribute__((address_space(3))) bf16x8*)(kb + d0 * 2048);
        const bf16x8 b1 = *(const __attribute__((address_space(3))) bf16x8*)(kb + d0 * 2048 + 512);
        if (d0 == 0) { if (REL) { p0 = __builtin_amdgcn_mfma_f32_32x32x16_bf16(b0, qr[0], negm, 0, 0, 0); p1 = __builtin_amdgcn_mfma_f32_32x32x16_bf16(b1, qr[0], negm, 0, 0, 0); }
                       else { p0 = __builtin_amdgcn_mfma_f32_32x32x16_bf16(b0, qr[0], f32x16{}, 0, 0, 0); p1 = __builtin_amdgcn_mfma_f32_32x32x16_bf16(b1, qr[0], f32x16{}, 0, 0, 0); } }
        else { p0 = __builtin_amdgcn_mfma_f32_32x32x16_bf16(b0, qr[d0], p0, 0, 0, 0); p1 = __builtin_amdgcn_mfma_f32_32x32x16_bf16(b1, qr[d0], p1, 0, 0, 0); } }
}
__device__ __forceinline__ float rowmax32(const f32x16& p0, const f32x16& p1) {
    float a = fmaxf(p0[0], p1[0]);
#pragma unroll
    for (int r = 1; r < 16; ++r) a = fmaxf(a, fmaxf(p0[r], p1[r]));
    auto rr = __builtin_amdgcn_permlane32_swap(__float_as_uint(a), __float_as_uint(a), false, false);
    return fmaxf(__uint_as_float(rr[0]), __uint_as_float(rr[1]));
}
__device__ __forceinline__ float halfsum(float a) { auto rr = __builtin_amdgcn_permlane32_swap(__float_as_uint(a), __float_as_uint(a), false, false); return __uint_as_float(rr[0]) + __uint_as_float(rr[1]); }
#define ATT_VREAD(lo, hi, d0) do { _Pragma("unroll") for (int ks = 0; ks < 4; ++ks) { \
        asm volatile("ds_read_b64_tr_b16 %0,%1 offset:%c2" : "=&v"(lo[ks]) : "v"(vb), "i"((d0) * 4096 + ks * 1024) : "memory"); \
        asm volatile("ds_read_b64_tr_b16 %0,%1 offset:%c2" : "=&v"(hi[ks]) : "v"(vb), "i"((d0) * 4096 + ks * 1024 + 512) : "memory"); } } while (0)
#define ATT_PK(lo, hi, k) (bf16x8){lo[k][0], lo[k][1], lo[k][2], lo[k][3], hi[k][0], hi[k][1], hi[k][2], hi[k][3]}
#define ATT_PVMMA(lo, hi, d0) do { \
        o[d0] = __builtin_amdgcn_mfma_f32_32x32x16_bf16(pa0, ATT_PK(lo, hi, 0), o[d0], 0, 0, 0); o[d0] = __builtin_amdgcn_mfma_f32_32x32x16_bf16(pa1, ATT_PK(lo, hi, 1), o[d0], 0, 0, 0); \
        o[d0] = __builtin_amdgcn_mfma_f32_32x32x16_bf16(pa2, ATT_PK(lo, hi, 2), o[d0], 0, 0, 0); o[d0] = __builtin_amdgcn_mfma_f32_32x32x16_bf16(pa3, ATT_PK(lo, hi, 3), o[d0], 0, 0, 0); } while (0)
template <int ND0> __device__ __forceinline__ void pv(f32x16* o, int vb, bf16x8 pa0, bf16x8 pa1, bf16x8 pa2, bf16x8 pa3) {
    s16x4 loA[4], hiA[4], loB[4], hiB[4];
    ATT_VREAD(loA, hiA, 0);
#pragma unroll
    for (int d0 = 0; d0 < ND0; d0 += 2) {
        if (d0 + 1 < ND0) { ATT_VREAD(loB, hiB, d0 + 1); asm volatile("s_waitcnt lgkmcnt(8)" ::: "memory"); } else { asm volatile("s_waitcnt lgkmcnt(0)" ::: "memory"); }
        ATT_SBAR();
        ATT_PVMMA(loA, hiA, d0);
        if (d0 + 1 < ND0) {
            if (d0 + 2 < ND0) { ATT_VREAD(loA, hiA, d0 + 2); asm volatile("s_waitcnt lgkmcnt(8)" ::: "memory"); } else { asm volatile("s_waitcnt lgkmcnt(0)" ::: "memory"); }
            ATT_SBAR();
            ATT_PVMMA(loB, hiB, d0 + 1);
        }
    }
}
#undef ATT_VREAD
#undef ATT_PVMMA
#undef ATT_PK
template <int DEAD> __device__ __forceinline__ constexpr bool live0(int r) { return DEAD != 2 || r >= 12; }
template <int DEAD> __device__ __forceinline__ constexpr bool live1(int r) { return DEAD != 1 || r < 4; }
template <int ND0, int THR, bool REL, int DEAD = 0> __device__ __forceinline__ void softmax_tile(f32x16& p0, f32x16& p1, float& mrun, float& lsum, f32x16& negm, bool first, f32x16* o, __attribute__((address_space(3))) float* wsf, int r32, int hi,
                                                                   u32x4& pw0, u32x4& pw1, u32x4& pw2, u32x4& pw3) {
    float rm;
    if (DEAD == 0) rm = rowmax32(p0, p1);
    else { float a = -3e38f;
#pragma unroll
        for (int r = 0; r < 16; ++r) { if (live0<DEAD>(r)) a = fmaxf(a, p0[r]); if (live1<DEAD>(r)) a = fmaxf(a, p1[r]); }
        auto rr = __builtin_amdgcn_permlane32_swap(__float_as_uint(a), __float_as_uint(a), false, false); rm = fmaxf(__uint_as_float(rr[0]), __uint_as_float(rr[1])); }
    if (!REL) rm -= mrun;
    if (first) {
        mrun = REL ? rm : mrun + rm;
        if (REL) {
#pragma unroll
            for (int r = 0; r < 16; ++r) { if (live0<DEAD>(r)) p0[r] -= rm; if (live1<DEAD>(r)) p1[r] -= rm; negm[r] = -mrun; } }
    } else if (__any(rm > (float)THR)) {
        const float dl = fmaxf(rm, 0.f), alpha = __builtin_amdgcn_exp2f(-dl); lsum *= alpha; mrun += dl;
        if (REL) {
#pragma unroll
            for (int r = 0; r < 16; ++r) { if (live0<DEAD>(r)) p0[r] -= dl; if (live1<DEAD>(r)) p1[r] -= dl; negm[r] = -mrun; } }
        if (hi == 0) wsf[r32] = alpha;
        ATT_LDSWAIT();
#pragma unroll
        for (int g = 0; g < 4; ++g) { const f32x4 a4 = *(const __attribute__((address_space(3))) f32x4*)(wsf + 8 * g + 4 * hi);
#pragma unroll
            for (int d0 = 0; d0 < ND0; ++d0) { o[d0][4 * g + 0] *= a4[0]; o[d0][4 * g + 1] *= a4[1]; o[d0][4 * g + 2] *= a4[2]; o[d0][4 * g + 3] *= a4[3]; } }
        ATT_LDSWAIT();
    }
    float s = 0.f;
#pragma unroll
    for (int r = 0; r < 16; ++r) {
        if (live0<DEAD>(r)) { p0[r] = __builtin_amdgcn_exp2f(REL ? p0[r] : p0[r] - mrun); s += p0[r]; } else p0[r] = 0.f;
        if (live1<DEAD>(r)) { p1[r] = __builtin_amdgcn_exp2f(REL ? p1[r] : p1[r] - mrun); s += p1[r]; } else p1[r] = 0.f; }
    lsum += s;
    pw0 = (u32x4){cvtpk(p0[0], p0[1]), cvtpk(p0[2], p0[3]), cvtpk(p0[4], p0[5]), cvtpk(p0[6], p0[7])};
    pw1 = (u32x4){cvtpk(p0[8], p0[9]), cvtpk(p0[10], p0[11]), cvtpk(p0[12], p0[13]), cvtpk(p0[14], p0[15])};
    pw2 = (u32x4){cvtpk(p1[0], p1[1]), cvtpk(p1[2], p1[3]), cvtpk(p1[4], p1[5]), cvtpk(p1[6], p1[7])};
    pw3 = (u32x4){cvtpk(p1[8], p1[9]), cvtpk(p1[10], p1[11]), cvtpk(p1[12], p1[13]), cvtpk(p1[14], p1[15])};
}

constexpr int A_SLOTK = 8192, A_SLOTV = 16384, A_NS = 3, A_NSV = 4;
constexpr int A_LDS_K = 0, A_LDS_V = A_NS * A_SLOTK, A_LDS_WS = A_LDS_V + A_NSV * A_SLOTV, A_LDS_ST = A_LDS_WS + 8 * 256, A_LDS_BYTES = A_LDS_ST + 8 * 8192;
__device__ __forceinline__ void attn_a_unit(int b, int h, int qb, const bf16_t* proj, bf16_t* ya, const float* subln, float lam, unsigned char* shm) {
    int tid_l = threadIdx.x; asm volatile("" : "+v"(tid_l));
    const int tid = tid_l, lane = tid & 63, r32 = lane & 31, hi = lane >> 5; const int wid = __builtin_amdgcn_readfirstlane(tid >> 6);
    const size_t rowbase = (size_t)b * SEQ; const int q0 = qb * 256;
    constexpr int NT = SEQ / 64;
    const unsigned lds0 = (unsigned)(uintptr_t)shm;
    const lds_cptr shm3 = (lds_cptr)shm;
    __attribute__((address_space(3))) float* wsf = (__attribute__((address_space(3))) float*)((lds_ptr)shm + A_LDS_WS) + wid * 64;
    const int vb0 = (int)(lds0 + A_LDS_V) + ((lane >> 4) & 1) * 32 + (lane & 3) * 8 + (4 * hi + ((lane & 15) >> 2)) * 64;
    __attribute__((address_space(3))) bf16_t* stg = (__attribute__((address_space(3))) bf16_t*)((lds_ptr)shm + A_LDS_ST) + wid * 4096;
    for (int mp = 0; mp < 2; ++mp) {
        const bf16_t* Kh = proj + rowbase * INW + C_KA + h * 128 + mp * 64;
        const bf16_t* Vh = proj + rowbase * INW + C_VA + h * 128;
        const bf16_t* Qw = proj + (rowbase + q0 + wid * 32) * INW + C_QA + h * 128 + mp * 64;
        const int pA = 2 * wid, pB = 2 * wid + 1;
        const unsigned kdst = lds0 + A_LDS_K + wid * 1024, vdstA = lds0 + A_LDS_V + pA * 1024, vdstB = lds0 + A_LDS_V + pB * 1024;
#define A_DMA(t, slot, vsl) do { int ln_ = lane; asm volatile("" : "+v"(ln_)); \
        const bf16_t* ksrc_ = Kh + (size_t)((t) * 64 + ln_) * INW + wid * 8; \
        const bf16_t* vsrcA_ = Vh + (size_t)((t) * 64 + 16 * (pA & 3) + (ln_ >> 2)) * INW + (pA >> 2) * 32 + (ln_ & 3) * 8; \
        const bf16_t* vsrcB_ = Vh + (size_t)((t) * 64 + 16 * (pB & 3) + (ln_ >> 2)) * INW + (pB >> 2) * 32 + (ln_ & 3) * 8; \
        glds16(ksrc_, (unsigned)__builtin_amdgcn_readfirstlane(kdst + (slot) * A_SLOTK)); \
        glds16(vsrcA_, (unsigned)__builtin_amdgcn_readfirstlane(vdstA + (vsl) * A_SLOTV)); \
        glds16(vsrcB_, (unsigned)__builtin_amdgcn_readfirstlane(vdstB + (vsl) * A_SLOTV)); } while (0)
        A_DMA(0, 0, 0); A_DMA(1, 1, 1);
        bf16x8 qr[4];
#pragma unroll
        for (int d0 = 0; d0 < 4; ++d0) qr[d0] = *(const bf16x8*)(Qw + (size_t)r32 * INW + d0 * 16 + hi * 8);
        f32x16 o[4]; o[0] = f32x16{}; o[1] = f32x16{}; o[2] = f32x16{}; o[3] = f32x16{};
        float mrun = 0.f, lsum = 0.f; f32x16 negm = f32x16{};
        int slot = 0, slot2 = 2, vslot = 0, vslot2 = 2, vprev = 3;
        const bool late = wid >= 4;
        u32x4 pw0 = {}, pw1 = {}, pw2 = {}, pw3 = {};
        for (int t = 0; t < NT; ++t) {
            if (t + 1 < NT) { ATT_WAIT_BAR(3); } else { ATT_WAIT_BAR(0); }
            if (t + 2 < NT) A_DMA(t + 2, slot2, vslot2);
            if (late && t > 0) pv<4>(o, vb0 + vprev * A_SLOTV, __builtin_bit_cast(bf16x8, pw0), __builtin_bit_cast(bf16x8, pw1), __builtin_bit_cast(bf16x8, pw2), __builtin_bit_cast(bf16x8, pw3));
            f32x16 p0, p1;
            qkt<false>(p0, p1, shm3 + A_LDS_K + slot * A_SLOTK, qr, negm, r32, hi);
            softmax_tile<4, 8, false>(p0, p1, mrun, lsum, negm, t == 0, o, wsf, r32, hi, pw0, pw1, pw2, pw3);
            if (!late) pv<4>(o, vb0 + vslot * A_SLOTV, __builtin_bit_cast(bf16x8, pw0), __builtin_bit_cast(bf16x8, pw1), __builtin_bit_cast(bf16x8, pw2), __builtin_bit_cast(bf16x8, pw3));
            slot = (slot == 2) ? 0 : slot + 1; slot2 = (slot2 == 2) ? 0 : slot2 + 1;
            vprev = vslot; vslot = (vslot + 1) & 3; vslot2 = (vslot2 + 1) & 3;
        }
        if (late) pv<4>(o, vb0 + vprev * A_SLOTV, __builtin_bit_cast(bf16x8, pw0), __builtin_bit_cast(bf16x8, pw1), __builtin_bit_cast(bf16x8, pw2), __builtin_bit_cast(bf16x8, pw3));
#undef A_DMA
        const float lt = halfsum(lsum);
        if (hi == 0) wsf[32 + r32] = lt;
        ATT_LDSWAIT();
        float rli[16];
#pragma unroll
        for (int g = 0; g < 4; ++g) { const f32x4 l4 = *(const __attribute__((address_space(3))) f32x4*)(wsf + 32 + 8 * g + 4 * hi);
            rli[4 * g + 0] = __builtin_amdgcn_rcpf(l4[0]); rli[4 * g + 1] = __builtin_amdgcn_rcpf(l4[1]); rli[4 * g + 2] = __builtin_amdgcn_rcpf(l4[2]); rli[4 * g + 3] = __builtin_amdgcn_rcpf(l4[3]); }
        ATT_LDSWAIT();
        if (mp == 0) {
#pragma unroll
            for (int d0 = 0; d0 < 4; ++d0)
#pragma unroll
                for (int r = 0; r < 16; ++r) stg[crow(r, hi) * 128 + d0 * 32 + r32] = (bf16_t)f2bf(o[d0][r] * rli[r]);
            asm volatile("s_waitcnt lgkmcnt(0)\n\ts_barrier" ::: "memory");
        } else {
            float ss[16];
#pragma unroll
            for (int r = 0; r < 16; ++r) ss[r] = 0.f;
#pragma unroll
            for (int d0 = 0; d0 < 4; ++d0)
#pragma unroll
                for (int r = 0; r < 16; ++r) { const float a = bf2f(stg[crow(r, hi) * 128 + d0 * 32 + r32]); const float y = a - lam * o[d0][r] * rli[r]; o[d0][r] = y; ss[r] += y * y; }
#pragma unroll
            for (int r = 0; r < 16; ++r) { float v = ss[r]; v += __shfl_xor(v, 1); v += __shfl_xor(v, 2); v += __shfl_xor(v, 4); v += __shfl_xor(v, 8); v += __shfl_xor(v, 16);
                ss[r] = 0.8f / sqrtf(v * (1.f / 128.f) + EPS); }
            ATT_LDSWAIT();
#pragma unroll
            for (int d0 = 0; d0 < 4; ++d0) { const float gsub = subln[d0 * 32 + r32];
#pragma unroll
                for (int r = 0; r < 16; ++r) stg[crow(r, hi) * 128 + d0 * 32 + r32] = (bf16_t)f2bf(o[d0][r] * ss[r] * gsub); }
            ATT_LDSWAIT();
            bf16_t* Yw = ya + (rowbase + q0 + wid * 32) * 1024 + h * 128;
#pragma unroll
            for (int i = 0; i < 8; ++i) { const int row = i * 4 + (lane >> 4), ch = lane & 15; const u32x4 v = *(const __attribute__((address_space(3))) u32x4*)(stg + row * 128 + ch * 8); *(u32x4*)(Yw + (size_t)row * 1024 + ch * 8) = v; }
            asm volatile("s_waitcnt lgkmcnt(0)\n\ts_barrier" ::: "memory");
        }
    }
}

template <int DEAD> __device__ __forceinline__ void na_tile(lds_cptr Kslot, int vb, const bf16x8* qr, const __attribute__((address_space(3))) float* bp, const float (&fm0)[16], const float (&fm1)[16],
                                                        float& mrun, float& lsum, f32x16& negm, bool first, f32x16* o, __attribute__((address_space(3))) float* wsf, int r32, int hi) {
    f32x16 p0, p1; u32x4 pw0, pw1, pw2, pw3;
    qkt<true>(p0, p1, Kslot, qr, negm, r32, hi);
#pragma unroll
    for (int rr = 0; rr < 16; ++rr) { const int jj = (rr & 3) + 8 * (rr >> 2);
        if (live0<DEAD>(rr)) p0[rr] += bp[jj] + fm0[rr];
        if (live1<DEAD>(rr)) p1[rr] += bp[jj + 32] + fm1[rr]; }
    softmax_tile<2, 8, true, DEAD>(p0, p1, mrun, lsum, negm, first, o, wsf, r32, hi, pw0, pw1, pw2, pw3);
    pv<2>(o, vb, __builtin_bit_cast(bf16x8, pw0), __builtin_bit_cast(bf16x8, pw1), __builtin_bit_cast(bf16x8, pw2), __builtin_bit_cast(bf16x8, pw3));
}
constexpr int B_SLOT = 8192, B_NS = 6, B_PF = 5;
constexpr int B_LDS_K = 0, B_LDS_V = B_NS * B_SLOT, B_LDS_WS = 2 * B_NS * B_SLOT, B_LDS_BIAS = B_LDS_WS + 8 * 256, B_LDS_ST = B_LDS_BIAS + 2560, B_LDS_BYTES = B_LDS_ST + 8 * 4096;
__device__ __forceinline__ void attn_b_unit(int b, int h, int rg, const bf16_t* proj, bf16_t* yb, const float* rpb, unsigned char* shm) {
    int tid_l = threadIdx.x; asm volatile("" : "+v"(tid_l));
    const int tid = tid_l, lane = tid & 63, r32 = lane & 31, hi = lane >> 5; const int wid = __builtin_amdgcn_readfirstlane(tid >> 6);
    const size_t rowbase = (size_t)b * SEQ;
    const int r = 4 * rg + (wid >> 1), c0 = 32 * (wid & 1);
    int rs = r - 4; rs = rs < 0 ? 0 : (rs > 24 ? 24 : rs);
    int rmin = 4 * rg - 4; rmin = rmin < 0 ? 0 : (rmin > 24 ? 24 : rmin);
    int rmaxs = 4 * rg + 3 - 4; rmaxs = rmaxs < 0 ? 0 : (rmaxs > 24 ? 24 : rmaxs);
    const int ntile = rmaxs + 8 - rmin;
    const unsigned lds0 = (unsigned)(uintptr_t)shm;
    const lds_cptr shm3 = (lds_cptr)shm;
    __attribute__((address_space(3))) float* wsf = (__attribute__((address_space(3))) float*)((lds_ptr)shm + B_LDS_WS) + wid * 64;
    __attribute__((address_space(3))) float* bias = (__attribute__((address_space(3))) float*)((lds_ptr)shm + B_LDS_BIAS) + 64;
    __attribute__((address_space(3))) bf16_t* stg = (__attribute__((address_space(3))) bf16_t*)((lds_ptr)shm + B_LDS_ST) + wid * 2048;
    const int vb0 = (int)(lds0 + B_LDS_V) + ((lane >> 4) & 1) * 32 + (lane & 3) * 8 + (4 * hi + ((lane & 15) >> 2)) * 64;
    for (int i = tid; i < 640; i += 512) { const int e = i - 64, ri = e >> 5, cj = e & 31; bias[e] = (e >= 0 && e < 480 && cj < 31) ? rpb[(h * 15 + ri) * 31 + cj] * LOG2E : 0.f; }
    const bf16_t* Kh = proj + rowbase * INW + C_KB + h * 64;
    const bf16_t* Vh = proj + rowbase * INW + C_VB + h * 64;
    const bf16_t* Qw = proj + (rowbase + r * 64 + c0) * INW + C_QB + h * 64;
    const unsigned kdst = lds0 + B_LDS_K + wid * 1024, vdst = lds0 + B_LDS_V + wid * 1024;
#define B_DMA(t, slot) do { int ln_ = lane; asm volatile("" : "+v"(ln_)); \
    const bf16_t* ksrc_ = Kh + (size_t)((rmin + (t)) * 64 + ln_) * INW + wid * 8; \
    const bf16_t* vsrc_ = Vh + (size_t)((rmin + (t)) * 64 + 16 * (wid & 3) + (ln_ >> 2)) * INW + (wid >> 2) * 32 + (ln_ & 3) * 8; \
    glds16(ksrc_, (unsigned)__builtin_amdgcn_readfirstlane(kdst + (slot) * B_SLOT)); \
    glds16(vsrc_, (unsigned)__builtin_amdgcn_readfirstlane(vdst + (slot) * B_SLOT)); } while (0)
#pragma unroll
    for (int t = 0; t < B_PF; ++t) B_DMA(t, t);
    bf16x8 qr[4];
#pragma unroll
    for (int d0 = 0; d0 < 4; ++d0) qr[d0] = *(const bf16x8*)(Qw + (size_t)r32 * INW + d0 * 16 + hi * 8);
    f32x16 o[2]; o[0] = f32x16{}; o[1] = f32x16{};
    float mrun = 0.f, lsum = 0.f; f32x16 negm = f32x16{}; bool first = true;
    const int c = c0 + r32; int cs = c - 8; cs = cs < 0 ? 0 : (cs > 48 ? 48 : cs);
    float fm0[16], fm1[16];
#pragma unroll
    for (int rr = 0; rr < 16; ++rr) { const int j0 = crow(rr, hi); fm0[rr] = ((unsigned)(j0 - cs) < 16u) ? 0.f : -1e30f; fm1[rr] = ((unsigned)(j0 + 32 - cs) < 16u) ? 0.f : -1e30f; }
    int slot = 0, slotn = B_PF;
    for (int t = 0; t < ntile; ++t) {
        { const int rem = ntile - 1 - t;
          if (rem >= 4) { ATT_WAIT_BAR(8); } else if (rem == 3) { ATT_WAIT_BAR(6); } else if (rem == 2) { ATT_WAIT_BAR(4); } else if (rem == 1) { ATT_WAIT_BAR(2); } else { ATT_WAIT_BAR(0); } }
        if (t + B_PF < ntile) B_DMA(t + B_PF, slotn);
        const int kr = rmin + t;
        if (kr >= rs && kr < rs + 8) {
            const __attribute__((address_space(3))) float* bp = bias + ((kr - r + 7) * 32 + 15 - c + 4 * hi);
            if (wid & 1) na_tile<2>(shm3 + B_LDS_K + slot * B_SLOT, vb0 + slot * B_SLOT, qr, bp, fm0, fm1, mrun, lsum, negm, first, o, wsf, r32, hi);
            else         na_tile<1>(shm3 + B_LDS_K + slot * B_SLOT, vb0 + slot * B_SLOT, qr, bp, fm0, fm1, mrun, lsum, negm, first, o, wsf, r32, hi);
            first = false;
        }
        slot = (slot == B_NS - 1) ? 0 : slot + 1; slotn = (slotn == B_NS - 1) ? 0 : slotn + 1;
    }
#undef B_DMA
    const float lt = halfsum(lsum);
    if (hi == 0) wsf[32 + r32] = lt;
    ATT_LDSWAIT();
    float rli[16];
#pragma unroll
    for (int g = 0; g < 4; ++g) { const f32x4 l4 = *(const __attribute__((address_space(3))) f32x4*)(wsf + 32 + 8 * g + 4 * hi);
        rli[4 * g + 0] = __builtin_amdgcn_rcpf(l4[0]); rli[4 * g + 1] = __builtin_amdgcn_rcpf(l4[1]); rli[4 * g + 2] = __builtin_amdgcn_rcpf(l4[2]); rli[4 * g + 3] = __builtin_amdgcn_rcpf(l4[3]); }
#pragma unroll
    for (int d0 = 0; d0 < 2; ++d0)
#pragma unroll
        for (int rr = 0; rr < 16; ++rr) stg[crow(rr, hi) * 64 + d0 * 32 + r32] = (bf16_t)f2bf(o[d0][rr] * rli[rr]);
    ATT_LDSWAIT();
    bf16_t* Yw = yb + (rowbase + r * 64 + c0) * 1024 + 512 + h * 64;
#pragma unroll
    for (int i = 0; i < 4; ++i) { const int row = i * 8 + (lane >> 3), ch = lane & 7; const u32x4 v = *(const __attribute__((address_space(3))) u32x4*)(stg + row * 64 + ch * 8); *(u32x4*)(Yw + (size_t)row * 1024 + ch * 8) = v; }
    asm volatile("s_waitcnt lgkmcnt(0)\n\ts_barrier" ::: "memory");
}
}

namespace peer {
typedef short bf16x8 __attribute__((ext_vector_type(8)));
typedef float f32x16 __attribute__((ext_vector_type(16)));
typedef __attribute__((address_space(3))) const char* lds_cptr;
constexpr int T_LDS_SK = 0, T_LDS_BYTES = 65536;
__device__ __forceinline__ int imax(int a, int b) { int r; asm("v_max_f32 %0, %1, %2" : "=v"(r) : "v"(a), "v"(b)); return r; }
__device__ __forceinline__ int imin(int a, int b) { int r; asm("v_min_f32 %0, %1, %2" : "=v"(r) : "v"(a), "v"(b)); return r; }
__device__ __forceinline__ int f2key(float s, int idx) { return (__float_as_int(s) & ~127) | idx; }
__device__ __forceinline__ int key2bits(int k) { return k; }
template <int N, int OFF, int TOT> __device__ __forceinline__ void bsort_desc(int (&a)[TOT]) {
#pragma unroll
    for (int k = 2; k <= N; k <<= 1)
#pragma unroll
        for (int j = k >> 1; j > 0; j >>= 1)
#pragma unroll
            for (int i = 0; i < N; ++i) { const int l = i ^ j; if (l > i) { const bool desc = (i & k) == 0; const int hi_ = imax(a[OFF + i], a[OFF + l]), lo_ = imin(a[OFF + i], a[OFF + l]); a[OFF + i] = desc ? hi_ : lo_; a[OFF + l] = desc ? lo_ : hi_; } }
}
__device__ constexpr unsigned char NET16[126] = {0,1,2,3,0,2,1,3,1,2,4,5,6,7,4,6,5,7,5,6,0,4,2,6,2,4,1,5,3,7,3,5,1,2,3,4,5,6,8,9,10,11,8,10,9,11,9,10,12,13,14,15,12,14,13,15,13,14,8,12,10,14,10,12,9,13,11,15,11,13,9,10,11,12,13,14,0,8,4,12,4,8,2,10,6,14,6,10,2,4,6,8,10,12,1,9,5,13,5,9,3,11,7,15,7,11,3,5,7,9,11,13,1,2,3,4,5,6,7,8,9,10,11,12,13,14};
__device__ constexpr unsigned char NET32[382] = {0,1,2,3,0,2,1,3,1,2,4,5,6,7,4,6,5,7,5,6,0,4,2,6,2,4,1,5,3,7,3,5,1,2,3,4,5,6,8,9,10,11,8,10,9,11,9,10,12,13,14,15,12,14,13,15,13,14,8,12,10,14,10,12,9,13,11,15,11,13,9,10,11,12,13,14,0,8,4,12,4,8,2,10,6,14,6,10,2,4,6,8,10,12,1,9,5,13,5,9,3,11,7,15,7,11,3,5,7,9,11,13,1,2,3,4,5,6,7,8,9,10,11,12,13,14,16,17,18,19,16,18,17,19,17,18,20,21,22,23,20,22,21,23,21,22,16,20,18,22,18,20,17,21,19,23,19,21,17,18,19,20,21,22,24,25,26,27,24,26,25,27,25,26,28,29,30,31,28,30,29,31,29,30,24,28,26,30,26,28,25,29,27,31,27,29,25,26,27,28,29,30,16,24,20,28,20,24,18,26,22,30,22,26,18,20,22,24,26,28,17,25,21,29,21,25,19,27,23,31,23,27,19,21,23,25,27,29,17,18,19,20,21,22,23,24,25,26,27,28,29,30,0,16,8,24,8,16,4,20,12,28,12,20,4,8,12,16,20,24,2,18,10,26,10,18,6,22,14,30,14,22,6,10,14,18,22,26,2,4,6,8,10,12,14,16,18,20,22,24,26,28,1,17,9,25,9,17,5,21,13,29,13,21,5,9,13,17,21,25,3,19,11,27,11,19,7,23,15,31,15,23,7,11,15,19,23,27,3,5,7,9,11,13,15,17,19,21,23,25,27,29,1,2,3,4,5,6,7,8,9,10,11,12,13,14,15,16,17,18,19,20,21,22,23,24,25,26,27,28,29,30};
template <int OFF, int TOT> __device__ __forceinline__ void sort16_desc(int (&a)[TOT]) {
#pragma unroll
    for (int c = 0; c < 63; ++c) { const int i = OFF + NET16[2 * c], j = OFF + NET16[2 * c + 1]; const int hi_ = imax(a[i], a[j]), lo_ = imin(a[i], a[j]); a[i] = hi_; a[j] = lo_; }
}
template <int TOT> __device__ __forceinline__ void sort32_desc(int (&a)[TOT]) {
#pragma unroll
    for (int c = 0; c < 191; ++c) { const int i = NET32[2 * c], j = NET32[2 * c + 1]; const int hi_ = imax(a[i], a[j]), lo_ = imin(a[i], a[j]); a[i] = hi_; a[j] = lo_; }
}
template <int N, int OFF, int TOT> __device__ __forceinline__ void bmerge_desc(int (&a)[TOT]) {
#pragma unroll
    for (int j = N >> 1; j > 0; j >>= 1)
#pragma unroll
        for (int i = 0; i < N; ++i) { const int l = i ^ j; if (l > i) { const int hi_ = imax(a[OFF + i], a[OFF + l]), lo_ = imin(a[OFF + i], a[OFF + l]); a[OFF + i] = hi_; a[OFF + l] = lo_; } }
}
template <int A, int B, int TOT> __device__ __forceinline__ void merge_top16(int (&a)[TOT]) {
#pragma unroll
    for (int i = 0; i < 16; ++i) a[A + i] = imax(a[A + i], a[B + 15 - i]);
    bmerge_desc<16, A, TOT>(a);
}
__device__ __forceinline__ void cross_top16(int (&t)[16]) {
    int lo[16], hi[16];
#pragma unroll
    for (int i = 0; i < 16; ++i) { auto rr = __builtin_amdgcn_permlane32_swap((unsigned)t[i], (unsigned)t[i], false, false); lo[i] = (int)rr[0]; hi[i] = (int)rr[1]; }
#pragma unroll
    for (int i = 0; i < 16; ++i) t[i] = imax(lo[i], hi[15 - i]);
    bmerge_desc<16, 0, 16>(t);
}
__device__ __forceinline__ void half_top16(int (&top)[16], const bf16_t* qrow  , lds_cptr skp  , int hi) {
    f32x16 sc[4]; sc[0] = f32x16{}; sc[1] = f32x16{}; sc[2] = f32x16{}; sc[3] = f32x16{};
    bf16x8 qf[8];
#pragma unroll
    for (int ks = 0; ks < 8; ++ks) qf[ks] = *(const bf16x8*)(qrow + ks * 16);
#pragma unroll
    for (int ks = 0; ks < 8; ++ks)
#pragma unroll
        for (int kt = 0; kt < 4; ++kt) { const bf16x8 af = *(const __attribute__((address_space(3))) bf16x8*)(skp + ks * 4096 + kt * 512);
            sc[kt] = __builtin_amdgcn_mfma_f32_32x32x16_bf16(af, qf[ks], sc[kt], 0, 0, 0); }
    int k[64];
#pragma unroll
    for (int kt = 0; kt < 4; ++kt)
#pragma unroll
        for (int r = 0; r < 16; ++r) k[kt * 16 + r] = f2key(sc[kt][r], (32 * kt + (r & 3) + 8 * (r >> 2)) | (4 * hi));
    sort16_desc<0, 64>(k); sort16_desc<16, 64>(k); sort16_desc<32, 64>(k); sort16_desc<48, 64>(k);
    merge_top16<0, 16, 64>(k); merge_top16<32, 48, 64>(k); merge_top16<0, 32, 64>(k);
#pragma unroll
    for (int i = 0; i < 16; ++i) top[i] = k[i];
    cross_top16(top);
}
__device__ __forceinline__ void topk_wave(int tok0, int h, const bf16_t* Q, int* IDX, float* Gt, lds_cptr sk, int lane) {
    const int r32 = lane & 31, hi = lane >> 5, tok = tok0 + r32;
    const bf16_t* qrow = Q + (size_t)tok * PQ + h * 256 + 8 * hi;
    lds_cptr skl = sk + hi * 2048 + r32 * 16;
    int A0[16], A1[16];
    half_top16(A0, qrow, skl, hi);
    half_top16(A1, qrow + 128, skl + 32768, hi);
    float x[16], y[16]; int xw[16], yw[16];
#pragma unroll
    for (int a = 0; a < 16; ++a) { const int b0 = key2bits(A0[a]), b1 = key2bits(A1[a]);
        const float v0 = __int_as_float(b0 & ~127), v1 = __int_as_float(b1 & ~127); const int i0 = (b0 & 127) << 7, i1 = b1 & 127;
        x[a] = hi ? v1 : v0; y[a] = hi ? v0 : v1; xw[a] = hi ? i1 : i0; yw[a] = hi ? i0 : i1; }
    int w[32]; int n = 0;
#define PEER_CAND(a, b) do { const int bits = __float_as_int(x[a] + y[b]); int ww = (bits & ~0x3FFF) | (xw[a] + yw[b]); \
        if ((a) == (b) && hi) ww = (int)0xFF800000; w[n] = ww; ++n; } while (0)
#pragma unroll
    for (int b = 0; b < 16; ++b) PEER_CAND(0, b);
#pragma unroll
    for (int b = 1; b < 8; ++b) PEER_CAND(1, b);
#pragma unroll
    for (int b = 2; b < 5; ++b) PEER_CAND(2, b);
    PEER_CAND(3, 3);
#undef PEER_CAND
#pragma unroll
    for (int i = 27; i < 32; ++i) w[i] = (int)0xFF800000;
    sort32_desc<32>(w);
    int T[16];
#pragma unroll
    for (int i = 0; i < 16; ++i) T[i] = w[i];
    cross_top16(T);
    float sv[16]; int ev[16];
#pragma unroll
    for (int j = 0; j < 16; ++j) { ev[j] = T[j] & 0x3FFF; sv[j] = __int_as_float(T[j] & ~0x3FFF); }
    const float s0 = sv[0]; float esum = 0.f;
#pragma unroll
    for (int j = 0; j < 16; ++j) { sv[j] = __expf(sv[j] - s0); esum += sv[j]; }
    const float inv = 1.f / esum;
    if (hi == 0) { u32x4* io = (u32x4*)(IDX + ((size_t)tok * 8 + h) * 16);
#pragma unroll
        for (int j = 0; j < 4; ++j) io[j] = (u32x4){(unsigned)ev[4 * j], (unsigned)ev[4 * j + 1], (unsigned)ev[4 * j + 2], (unsigned)ev[4 * j + 3]}; }
    else { f32x4* go = (f32x4*)(Gt + ((size_t)tok * 8 + h) * 16);
#pragma unroll
        for (int j = 0; j < 4; ++j) go[j] = (f32x4){sv[4 * j] * inv, sv[4 * j + 1] * inv, sv[4 * j + 2] * inv, sv[4 * j + 3] * inv}; }
}
template <class Sched> __device__ __forceinline__ void topk_own_units(const Ptrs& P, unsigned char* shm, const Sched& S) {
    int tid_l = threadIdx.x; asm volatile("" : "+v"(tid_l));
    const int tid = tid_l, lane = tid & 63; const int wid = __builtin_amdgcn_readfirstlane(tid >> 6);
    const unsigned lds0 = (unsigned)(uintptr_t)shm;
    const bf16_t* SKg = (const bf16_t*)(P.ws + WS_SK);
    int hprev = -1; pg8::Unit u;
    for (int i = 0; S.next(i, u); ++i) {
        const int h = u.pn, tg = u.pm;
        if (h != hprev) { hprev = h;
            asm volatile("s_waitcnt lgkmcnt(0)\n\ts_barrier" ::: "memory");
#pragma unroll
            for (int j = 0; j < 8; ++j) { const int piece = wid * 8 + j, p = piece >> 5, c = (piece >> 1) & 15, kh = piece & 1;
                att::glds16(SKg + ((size_t)((h * 2 + p) * 128 + kh * 64 + lane) * 128 + c * 8), (unsigned)__builtin_amdgcn_readfirstlane(lds0 + p * 32768 + c * 2048 + kh * 1024)); }
            asm volatile("s_waitcnt vmcnt(0)\n\ts_barrier" ::: "memory");
        }
        topk_wave(tg * 256 + wid * 32, h, (const bf16_t*)(P.ws + WS_Q), (int*)(P.ws + WS_IDX), (float*)(P.ws + WS_G), (lds_cptr)shm, lane);
    }
}
}

namespace apply {
typedef float f32x2 __attribute__((ext_vector_type(2)));
typedef __attribute__((address_space(3))) unsigned* lds_u32p;
constexpr int AP_WAVE_BYTES = 4 * (512 + 2048), AP_LDS_BYTES = 8 * AP_WAVE_BYTES;
__device__ __forceinline__ float gelu_fast(float v) {
    const float av = fabsf(v), t = __builtin_amdgcn_rcpf(av * 0.2316418882f + 1.0f);
    float q = t * 0.5307027145f + (-0.7265760135f); q = q * t + 0.7107068705f; q = q * t + (-0.142248368f); q = q * t + 0.127414796f; q = q * t;
    const float e = __builtin_amdgcn_exp2f((v * v) * (-0.72134752044f));
    const float m = v * (q * e);
    return v < 0.f ? m : v - m;
}
#define AP_DPP(v, ctrl) __builtin_bit_cast(float, __builtin_amdgcn_update_dpp(0, __builtin_bit_cast(int, (v)), (ctrl), 0xF, 0xF, true))
__device__ __forceinline__ float row16_sum(float v) { v += AP_DPP(v, 0xB1); v += AP_DPP(v, 0x4E); v += AP_DPP(v, 0x141); v += AP_DPP(v, 0x140); return v; }
__device__ __forceinline__ void load_half(u32x4 (&r)[2], const unsigned char* img, unsigned e, int sub) {
    const unsigned off = e * 512u + (unsigned)(sub * 16);
    r[0] = *(const u32x4*)(img + off); r[1] = *(const u32x4*)(img + off + 256u);
}
constexpr int AP_PROBE_RING = 16;
constexpr int AP_RING = 8;
typedef __attribute__((address_space(3))) u32x4* lds_v4p;
template <int HF, int MODE, int RING> __device__ __forceinline__ void pass_u(const Ptrs& P, const bf16_t* hrow, float rstd, lds_v4p grp, u32x4 (&R)[RING][2], const unsigned char* img, const unsigned char* img_next, int sub) {
    unsigned xq[8]; float sx;
    {
        float xf[2][16]; float mx = 0.f;
#pragma unroll
        for (int i = 0; i < 2; ++i) { const int e0 = (sub + 16 * (2 * HF + i)) * 16;
#pragma unroll
            for (int q = 0; q < 4; ++q) { const u32x2 hb = *(const u32x2*)(hrow + e0 + 4 * q); const f32x4 gv = *(const f32x4*)(P.norm_ffn + e0 + 4 * q);
                xf[i][4 * q] = bflo(hb.x) * rstd * gv.x; xf[i][4 * q + 1] = bfhi(hb.x) * rstd * gv.y; xf[i][4 * q + 2] = bflo(hb.y) * rstd * gv.z; xf[i][4 * q + 3] = bfhi(hb.y) * rstd * gv.w;
                mx = fmaxf(fmaxf(mx, fmaxf(fabsf(xf[i][4 * q]), fabsf(xf[i][4 * q + 1]))), fmaxf(fabsf(xf[i][4 * q + 2]), fabsf(xf[i][4 * q + 3]))); } }
        mx = fmaxf(mx, AP_DPP(mx, 0xB1)); mx = fmaxf(mx, AP_DPP(mx, 0x4E)); mx = fmaxf(mx, AP_DPP(mx, 0x141)); mx = fmaxf(mx, AP_DPP(mx, 0x140));
        mx = fmaxf(mx, 1e-30f); sx = mx * (1.f / 127.f); const float qs = 127.f / mx;
#pragma unroll
        for (int i = 0; i < 2; ++i)
#pragma unroll
            for (int q = 0; q < 4; ++q) xq[4 * i + q] = pack_i8x4(xf[i][4 * q] * qs, xf[i][4 * q + 1] * qs, xf[i][4 * q + 2] * qs, xf[i][4 * q + 3] * qs);
    }
#pragma unroll 1
    for (int j = 0; j < 128; j += RING) {
        const int jn = (j + RING) & 127;
        __builtin_amdgcn_s_barrier();
        const unsigned char* tb = (j + RING < 128) ? img : img_next;
        unsigned nid[RING], part[RING], suv[RING], gsv[RING];
#pragma unroll
        for (int b4 = 0; b4 < RING / 4; ++b4) { const u32x4 na = grp[jn / 4 + b4];
            nid[4 * b4] = na.x; nid[4 * b4 + 1] = na.y; nid[4 * b4 + 2] = na.z; nid[4 * b4 + 3] = na.w;
            u32x4 pa = {}, sa = {}, ga = {};
            if (HF == 1) { pa = grp[96 + j / 4 + b4]; sa = grp[32 + j / 4 + b4]; ga = grp[64 + j / 4 + b4]; }
            part[4 * b4] = pa.x; part[4 * b4 + 1] = pa.y; part[4 * b4 + 2] = pa.z; part[4 * b4 + 3] = pa.w;
            suv[4 * b4] = sa.x; suv[4 * b4 + 1] = sa.y; suv[4 * b4 + 2] = sa.z; suv[4 * b4 + 3] = sa.w;
            gsv[4 * b4] = ga.x; gsv[4 * b4 + 1] = ga.y; gsv[4 * b4 + 2] = ga.z; gsv[4 * b4 + 3] = ga.w; }
        float outv[RING];
#pragma unroll
        for (int bq = 0; bq < RING; ++bq) {
            int d0_ = 0, d1_ = 0;
            if (MODE == 1) { asm volatile("" :: "v"(R[bq][0]), "v"(R[bq][1])); d0_ = (int)xq[0]; }
            else {
                d0_ = __builtin_amdgcn_sdot4((int)R[bq][0].x, (int)xq[0], d0_, false); d1_ = __builtin_amdgcn_sdot4((int)R[bq][0].y, (int)xq[1], d1_, false);
                d0_ = __builtin_amdgcn_sdot4((int)R[bq][0].z, (int)xq[2], d0_, false); d1_ = __builtin_amdgcn_sdot4((int)R[bq][0].w, (int)xq[3], d1_, false);
                d0_ = __builtin_amdgcn_sdot4((int)R[bq][1].x, (int)xq[4], d0_, false); d1_ = __builtin_amdgcn_sdot4((int)R[bq][1].y, (int)xq[5], d1_, false);
                d0_ = __builtin_amdgcn_sdot4((int)R[bq][1].z, (int)xq[6], d0_, false); d1_ = __builtin_amdgcn_sdot4((int)R[bq][1].w, (int)xq[7], d1_, false);
            }
            asm volatile("" ::: "memory");
            load_half(R[bq], tb, MODE == 2 ? (nid[bq] & 15u) : nid[bq], sub);
            asm volatile("" ::: "memory");
            float a_ = row16_sum((float)(d0_ + d1_)) * sx;
            if (HF == 1) { a_ = (a_ + __uint_as_float(part[bq])) * __uint_as_float(suv[bq]); a_ = __uint_as_float(gsv[bq]) * gelu_fast(a_); }
            outv[bq] = a_;
        }
        if (sub == 0) {
#pragma unroll
            for (int b4 = 0; b4 < RING / 4; ++b4) grp[96 + j / 4 + b4] = (u32x4){__float_as_uint(outv[4 * b4]), __float_as_uint(outv[4 * b4 + 1]), __float_as_uint(outv[4 * b4 + 2]), __float_as_uint(outv[4 * b4 + 3])}; }
    }
    asm volatile("s_waitcnt lgkmcnt(0)" ::: "memory");
}
template <int HF, int MODE, int RING> __device__ __forceinline__ void pass_v(float (&acc)[4][16], lds_v4p grp, u32x4 (&R)[RING][2], const unsigned char* img, const unsigned char* img_next, int sub) {
#pragma unroll 1
    for (int j = 0; j < 128; j += RING) {
        const int jn = (j + RING) & 127;
        __builtin_amdgcn_s_barrier();
        const unsigned char* tb = (j + RING < 128) ? img : img_next;
        unsigned nid[RING], cvv[RING];
#pragma unroll
        for (int b4 = 0; b4 < RING / 4; ++b4) { const u32x4 na = grp[jn / 4 + b4], ca = grp[96 + j / 4 + b4];
            nid[4 * b4] = na.x; nid[4 * b4 + 1] = na.y; nid[4 * b4 + 2] = na.z; nid[4 * b4 + 3] = na.w; cvv[4 * b4] = ca.x; cvv[4 * b4 + 1] = ca.y; cvv[4 * b4 + 2] = ca.z; cvv[4 * b4 + 3] = ca.w; }
#pragma unroll
        for (int bq = 0; bq < RING; ++bq) {
            const float c_ = __uint_as_float(cvv[bq]); const f32x2 c2 = {c_, c_};
            if (MODE == 1) { asm volatile("" :: "v"(R[bq][0]), "v"(R[bq][1])); acc[2 * HF][0] += c_; }
            else {
#pragma unroll
            for (int i = 0; i < 2; ++i) { const unsigned w_[4] = {R[bq][i].x, R[bq][i].y, R[bq][i].z, R[bq][i].w};
#pragma unroll
                for (int q = 0; q < 4; ++q) { const f32x2 lo_ = __builtin_amdgcn_cvt_pk_f32_fp8(w_[q], false), hi_ = __builtin_amdgcn_cvt_pk_f32_fp8(w_[q], true);
                    f32x2 a0 = {acc[2 * HF + i][4 * q], acc[2 * HF + i][4 * q + 1]}, a1 = {acc[2 * HF + i][4 * q + 2], acc[2 * HF + i][4 * q + 3]}; a0 += c2 * lo_; a1 += c2 * hi_;
                    acc[2 * HF + i][4 * q] = a0.x; acc[2 * HF + i][4 * q + 1] = a0.y; acc[2 * HF + i][4 * q + 2] = a1.x; acc[2 * HF + i][4 * q + 3] = a1.y; } }
            }
            asm volatile("" ::: "memory");
            load_half(R[bq], tb, MODE == 2 ? (nid[bq] & 15u) : nid[bq], sub);
            asm volatile("" ::: "memory");
        }
    }
}
template <int MODE> __device__ __forceinline__ void apply_round(const Ptrs& P, float* outbase, int tbase, unsigned char* shm_wave, int lane_in) {
    int lane = lane_in; asm volatile("" : "+v"(lane));
    const int sub = lane & 15, g = lane >> 4, t = tbase + g;
    __attribute__((address_space(3))) unsigned* cnt = (lds_u32p)(__attribute__((address_space(3))) unsigned char*)shm_wave + g * 128;
    lds_v4p grp = (lds_v4p)((__attribute__((address_space(3))) unsigned char*)shm_wave + 2048 + g * 2048);
    __attribute__((address_space(3))) unsigned* grp1 = (__attribute__((address_space(3))) unsigned*)grp;
    const unsigned char* U8 = P.ws + WS_U; const unsigned char* V8 = P.ws + WS_V;
    {
        const int* idxp = (const int*)(P.ws + WS_IDX) + (size_t)t * 128 + sub * 8; const float* gp = (const float*)(P.ws + WS_G) + (size_t)t * 128 + sub * 8;
        const u32x4 ia = *(const u32x4*)idxp, ib = *(const u32x4*)(idxp + 4); const f32x4 ga = *(const f32x4*)gp, gb = *(const f32x4*)(gp + 4);
        const int e[8] = {(int)ia.x, (int)ia.y, (int)ia.z, (int)ia.w, (int)ib.x, (int)ib.y, (int)ib.z, (int)ib.w};
        const float gt[8] = {ga.x, ga.y, ga.z, ga.w, gb.x, gb.y, gb.z, gb.w};
        float su[8], sv[8];
#pragma unroll
        for (int i = 0; i < 8; ++i) { su[i] = ((const float*)(P.ws + WS_SU))[e[i]]; sv[i] = ((const float*)(P.ws + WS_SV))[e[i]]; }
#pragma unroll
        for (int i = 0; i < 8; ++i) cnt[sub * 8 + i] = 0u;
        asm volatile("s_waitcnt lgkmcnt(0)" ::: "memory");
        unsigned pos[8];
#pragma unroll
        for (int i = 0; i < 8; ++i) pos[i] = __hip_atomic_fetch_add(cnt + (e[i] >> 7), 1u, __ATOMIC_RELAXED, __HIP_MEMORY_SCOPE_WAVEFRONT);
        asm volatile("s_waitcnt lgkmcnt(0)" ::: "memory");
        unsigned c[8]; unsigned tot = 0;
#pragma unroll
        for (int i = 0; i < 8; ++i) { c[i] = cnt[sub * 8 + i]; }
#pragma unroll
        for (int i = 0; i < 8; ++i) { const unsigned x = c[i]; c[i] = tot; tot += x; }
        unsigned inc = tot;
#pragma unroll
        for (int d = 1; d < 16; d <<= 1) { const unsigned y = __shfl_up(inc, d, 16); if (sub >= d) inc += y; }
        const unsigned base = inc - tot;
        asm volatile("s_waitcnt lgkmcnt(0)" ::: "memory");
#pragma unroll
        for (int i = 0; i < 8; ++i) cnt[sub * 8 + i] = base + c[i];
        asm volatile("s_waitcnt lgkmcnt(0)" ::: "memory");
#pragma unroll
        for (int i = 0; i < 8; ++i) { const unsigned p = cnt[e[i] >> 7] + pos[i];
            grp1[p] = (unsigned)e[i]; grp1[128 + p] = __float_as_uint(su[i]); grp1[256 + p] = __float_as_uint(gt[i] * sv[i]); }
        asm volatile("s_waitcnt lgkmcnt(0)" ::: "memory");
    }
    const bf16_t* hrow = (const bf16_t*)(P.ws + WS_HB) + (size_t)t * D;
    float rstd;
    { const float* ssq = (const float*)(P.ws + WS_SSQ) + (size_t)t * 16;
      const f32x4 s0 = *(const f32x4*)ssq, s1 = *(const f32x4*)(ssq + 4), s2 = *(const f32x4*)(ssq + 8), s3 = *(const f32x4*)(ssq + 12);
      const float tot = ((s0.x + s0.y) + (s0.z + s0.w)) + ((s1.x + s1.y) + (s1.z + s1.w)) + ((s2.x + s2.y) + (s2.z + s2.w)) + ((s3.x + s3.y) + (s3.z + s3.w));
      rstd = 1.f / sqrtf(tot * (1.f / D) + EPS); }
    constexpr int RG = (MODE == 1) ? AP_PROBE_RING : AP_RING;
    const unsigned char* U0 = U8; const unsigned char* U1 = U8 + (size_t)NEXP * 512; const unsigned char* V0 = V8; const unsigned char* V1 = V8 + (size_t)NEXP * 512;
    u32x4 R[RG][2];
    {
#pragma unroll
      for (int b4 = 0; b4 < RG / 4; ++b4) { const u32x4 ia = grp[b4]; load_half(R[4 * b4], U0, ia.x, sub); load_half(R[4 * b4 + 1], U0, ia.y, sub); load_half(R[4 * b4 + 2], U0, ia.z, sub); load_half(R[4 * b4 + 3], U0, ia.w, sub); } }
    pass_u<0, MODE, RG>(P, hrow, rstd, grp, R, U0, U1, sub);
    pass_u<1, MODE, RG>(P, hrow, rstd, grp, R, U1, V0, sub);
    float acc[4][16];
#pragma unroll
    for (int i = 0; i < 4; ++i)
#pragma unroll
        for (int q = 0; q < 16; ++q) acc[i][q] = 0.f;
    pass_v<0, MODE, RG>(acc, grp, R, V0, V1, sub);
    pass_v<1, MODE, RG>(acc, grp, R, V1, V1, sub);
    float ss = 0.f;
#pragma unroll
    for (int i = 0; i < 4; ++i) { const int e0 = (sub + 16 * i) * 16;
#pragma unroll
        for (int q = 0; q < 4; ++q) { const u32x2 hb = *(const u32x2*)(hrow + e0 + 4 * q);
            acc[i][4 * q] += bflo(hb.x); acc[i][4 * q + 1] += bfhi(hb.x); acc[i][4 * q + 2] += bflo(hb.y); acc[i][4 * q + 3] += bfhi(hb.y);
            ss += (acc[i][4 * q] * acc[i][4 * q] + acc[i][4 * q + 1] * acc[i][4 * q + 1]) + (acc[i][4 * q + 2] * acc[i][4 * q + 2] + acc[i][4 * q + 3] * acc[i][4 * q + 3]); }
        asm volatile("" ::: "memory"); }
    ss = row16_sum(ss);
    const float r2 = 1.f / sqrtf(ss * (1.f / D) + EPS);
    float* orow = outbase + (size_t)t * D;
#pragma unroll
    for (int i = 0; i < 4; ++i) { const int e0 = (sub + 16 * i) * 16;
#pragma unroll
        for (int q = 0; q < 4; ++q) { const f32x4 gv = *(const f32x4*)(P.norm_final + e0 + 4 * q);
            *(f32x4*)(orow + e0 + 4 * q) = (f32x4){acc[i][4 * q] * r2 * gv.x, acc[i][4 * q + 1] * r2 * gv.y, acc[i][4 * q + 2] * r2 * gv.z, acc[i][4 * q + 3] * r2 * gv.w}; }
        asm volatile("" ::: "memory"); }
}
template <int MODE> __device__ __forceinline__ void apply_phase(const Ptrs& P, float* outbase, unsigned char* shm, int G, int vcu) {
    int tid_l = threadIdx.x; asm volatile("" : "+v"(tid_l));
    const int lane = tid_l & 63; const int wave = __builtin_amdgcn_readfirstlane(tid_l >> 6);
    const int per = M / (G * 8);
#pragma unroll 1
    for (int r = 0; r < per; r += 4) apply_round<MODE>(P, outbase, (vcu * 8 + wave) * per + r, shm + wave * AP_WAVE_BYTES, lane);
}
}

#define LAS __attribute__((address_space(3)))
#define XB_TMO      128
#define XB_XCNT(j)  (256  + 64 * (j))
#define XB_XSUB(j)  (1280 + 64 * (j))
#define XB_XGEN(j)  (2304 + 64 * (j))
#define XB_TOP      3328
#define XB_TOPGEN   3392
#define XCD_BAR_WORDS 3456
#define XB_SPIN_CAP (1u << 18)

__device__ __forceinline__ unsigned xb_ld(unsigned* p)              { return __hip_atomic_load(p, __ATOMIC_RELAXED, __HIP_MEMORY_SCOPE_AGENT); }
__device__ __forceinline__ unsigned xb_add(unsigned* p, unsigned v) { return __hip_atomic_fetch_add(p, v, __ATOMIC_RELAXED, __HIP_MEMORY_SCOPE_AGENT); }
__device__ __forceinline__ unsigned xb_xcc_id() { return (unsigned)__builtin_amdgcn_s_getreg((3 << 11) | 20) & 0xFu; }
#define XB_SPIN(cond, bar) do { unsigned _sp = 0; while (cond) { __builtin_amdgcn_s_sleep(1); \
    if ((++_sp & 255u) == 0u) { if (xb_ld(&(bar)[XB_TMO])) break; if (_sp > XB_SPIN_CAP) { atomicAdd(&(bar)[XB_TMO], 1u); break; } } } } while (0)

struct XcdBarrier {
    unsigned* bar; unsigned x;
    volatile LAS unsigned* st;
};

__device__ __forceinline__ XcdBarrier xcd_barrier_post(unsigned* bar, volatile LAS unsigned* st) {
    XcdBarrier b; b.bar = bar; b.x = xb_xcc_id(); b.st = st;
    if (threadIdx.x == 0) (void)xb_add(&bar[XB_XCNT(b.x)], 1u);
    return b;
}
__device__ __forceinline__ void xcd_barrier_complete(unsigned* bar, unsigned x, unsigned& nloc, unsigned& nx) {
    const unsigned G = gridDim.x * gridDim.y * gridDim.z;
    unsigned sum, cnt, mine, sp = 0u;
    for (;;) {
        sum = 0u; cnt = 0u; mine = 0u;
#pragma unroll
        for (unsigned j = 0; j < 16; ++j) { const unsigned c = xb_ld(&bar[XB_XCNT(j)]); sum += c; cnt += (c > 0u) ? 1u : 0u; mine = (j == x) ? c : mine; }
        if (sum == G) break;
        __builtin_amdgcn_s_sleep(1);
        if ((++sp & 255u) == 0u) { if (xb_ld(&bar[XB_TMO])) break; if (sp > XB_SPIN_CAP) { atomicAdd(&bar[XB_TMO], 1u); break; } }
    }
    nloc = mine > 0u ? mine : 1u; nx = cnt > 0u ? cnt : 1u;
}

__device__ __forceinline__ void xcd_barrier(const XcdBarrier& b) {
    asm volatile("s_waitcnt vmcnt(0)" ::: "memory");
    __syncthreads();
    if (threadIdx.x == 0) {
        unsigned* bar = b.bar;
        __builtin_amdgcn_s_waitcnt(0);
        unsigned nloc = b.st[0], nx = b.st[1];
        if (nloc == 0u) { xcd_barrier_complete(bar, b.x, nloc, nx); b.st[0] = nloc; b.st[1] = nx; }
        const unsigned old = xb_add(&bar[XB_XSUB(b.x)], 1u);
        const unsigned gen = old / nloc;
        if (old + 1u == (gen + 1u) * nloc) {
            __builtin_amdgcn_fence(__ATOMIC_RELEASE, "agent");
            asm volatile("s_waitcnt vmcnt(0)" ::: "memory");
            const unsigned og = xb_add(&bar[XB_TOP], 1u);
            const unsigned tg = og / nx;
            if (og + 1u == (tg + 1u) * nx) xb_add(&bar[XB_TOPGEN], 1u);
            else XB_SPIN(xb_ld(&bar[XB_TOPGEN]) == tg, bar);
            __builtin_amdgcn_fence(__ATOMIC_ACQUIRE, "agent");
            xb_add(&bar[XB_XGEN(b.x)], 1u);
            asm volatile("s_waitcnt vmcnt(0)" ::: "memory");
        } else {
            XB_SPIN(xb_ld(&bar[XB_XGEN(b.x)]) == gen, bar);
            __builtin_amdgcn_fence(__ATOMIC_ACQUIRE, "agent");
            asm volatile("s_waitcnt vmcnt(0)" ::: "memory");
        }
    }
    __syncthreads();
}


namespace cg = cooperative_groups;
#ifndef REP_MASK
#define REP_MASK 0
#endif
#define REPS(k) (((REP_MASK) >> (k)) & 1 ? 2 : 1)
constexpr int PHASE_LDS = att::A_LDS_BYTES;
constexpr int MEGA_LDS = PHASE_LDS + 64;
static_assert(PHASE_LDS >= pg8::STAGE_BYTES && PHASE_LDS >= att::B_LDS_BYTES && PHASE_LDS >= peer::T_LDS_BYTES && PHASE_LDS >= 8 * 64 * 33 * 4 && PHASE_LDS >= apply::AP_LDS_BYTES, "LDS budget");
__global__ void __launch_bounds__(512, 2) mega_fwd(Ptrs P) {
    extern __shared__ __attribute__((aligned(16))) unsigned char lds_dyn[];
    volatile LAS unsigned* bst = (volatile LAS unsigned*)((LAS unsigned char*)lds_dyn + PHASE_LDS);
    if (threadIdx.x < 2) bst[threadIdx.x] = 0u;
    __syncthreads();
    const XcdBarrier bar = xcd_barrier_post((unsigned*)(P.ws + WS_CTL), bst);
    const int G = (int)gridDim.x, bx = (int)blockIdx.x, vcu = (G % 8 == 0) ? (bx % 8) * (G / 8) + bx / 8 : bx;
    unsigned char* ws = P.ws;
    PG8_LAS unsigned char* lds3 = (PG8_LAS unsigned char*)lds_dyn;
    for (int rep = 0; rep < REPS(0); ++rep) prep_phase(P, lds_dyn, G, bx);
    xcd_barrier(bar); if (REPS(9) == 2) xcd_barrier(bar);
    for (int rep = 0; rep < REPS(1); ++rep) {
      { pg8::Gemm g{(const bf16_t*)(ws + WS_XN), (const bf16_t*)(ws + WS_WIN), M, 1024, D, 0}; pg8::StaticOrder S; S.init(M, 1024, G, bx);
        pg8::gemm_phase<pg8::EpiProj, pg8::StaticOrder, true, true, false>(lds3, g, S, pg8::EpiProj{(bf16_t*)(ws + WS_PROJ), (const float*)(ws + WS_ROPE), 1.f, 0}); }
      { pg8::Gemm g{(const bf16_t*)(ws + WS_XN8), (const bf16_t*)(ws + WS_WIN8), M, INW - 1024, D / 2, 0}; pg8::StaticOrder S; S.init(M, INW - 1024, G, bx);
        pg8::gemm_phase<pg8::EpiProj, pg8::StaticOrder, true, true, true>(lds3, g, S, pg8::EpiProj{(bf16_t*)(ws + WS_PROJ), (const float*)(ws + WS_ROPE), 1.f / WIN_SCALE, 4}); } }
    xcd_barrier(bar); if (REPS(9) == 2) xcd_barrier(bar);
    { const float lam = lambda_full(P);
      for (int rep = 0; rep < REPS(2); ++rep) for (int u = vcu; u < BATCH * 4 * 8; u += G) att::attn_a_unit(u >> 5, (u >> 3) & 3, u & 7, (const bf16_t*)(ws + WS_PROJ), (bf16_t*)(ws + WS_YA), P.subln, lam, lds_dyn);
      for (int rep = 0; rep < REPS(3); ++rep) for (int u = vcu; u < BATCH * 8 * 8; u += G) att::attn_b_unit(u >> 6, (u >> 3) & 7, u & 7, (const bf16_t*)(ws + WS_PROJ), (bf16_t*)(ws + WS_YA), P.rpb, lds_dyn); }
    xcd_barrier(bar); if (REPS(9) == 2) xcd_barrier(bar);
    for (int rep = 0; rep < REPS(4); ++rep) { pg8::StaticOrder S; S.init(M, D, G, bx);
      pg8::gemm_phase<pg8::EpiGate2, pg8::StaticOrder, true, true>(lds3, pg8::Gemm{(const bf16_t*)(ws + WS_YA), (const bf16_t*)(ws + WS_WPA), M, D, D, 0}, S, pg8::EpiGate2{(const bf16_t*)(ws + WS_PROJ), (bf16_t*)(ws + WS_MERGED)}); }
    xcd_barrier(bar); if (REPS(9) == 2) xcd_barrier(bar);
    for (int rep = 0; rep < REPS(5); ++rep) { pg8::StaticOrder S; S.init(M, D, G, bx);
      pg8::gemm_phase<pg8::EpiHout, pg8::StaticOrder, true, true>(lds3, pg8::Gemm{(const bf16_t*)(ws + WS_MERGED), (const bf16_t*)(ws + WS_WOUT), M, D, D, 0}, S, pg8::EpiHout{P.x, P.out, (bf16_t*)(ws + WS_HB), (float*)(ws + WS_SSQ)});
      cvt_experts_phase(P, G, bx); }
    xcd_barrier(bar); if (REPS(9) == 2) xcd_barrier(bar);
    { pg8::StaticOrder S; S.init(M, PQ, G, bx);
      for (int rep = 0; rep < REPS(8); ++rep)
        pg8::gemm_phase<pg8::EpiQ, pg8::StaticOrder, true, true>(lds3, pg8::Gemm{(const bf16_t*)(ws + WS_HB), (const bf16_t*)(ws + WS_WQ), M, PQ, D, 0}, S, pg8::EpiQ{(const float*)(ws + WS_SSQ), (bf16_t*)(ws + WS_Q)});
      asm volatile("s_waitcnt vmcnt(0)" ::: "memory");
      __syncthreads();
      if (threadIdx.x == 0) { __builtin_amdgcn_fence(__ATOMIC_ACQUIRE, "agent"); asm volatile("s_waitcnt vmcnt(0)" ::: "memory"); }
      __syncthreads();
      for (int rep = 0; rep < REPS(6); ++rep) peer::topk_own_units(P, lds_dyn, S); }
    xcd_barrier(bar); if (REPS(9) == 2) xcd_barrier(bar);
#ifndef PROBE_MODE
#define PROBE_MODE 0
#endif
    if (REPS(7) == 2) apply::apply_phase<PROBE_MODE>(P, (float*)(ws + WS_Q), lds_dyn, G, vcu);
    apply::apply_phase<0>(P, P.out, lds_dyn, G, vcu);
}

extern "C" void kernel_launch(void* const* d_in, const int* in_sizes, int n_in, void* d_out, int out_size, void* d_ws, size_t ws_size, hipStream_t stream) {
    if (n_in != 18 || ws_size < WS_END) { fprintf(stderr, "kernel_launch: unexpected n_in %d / ws_size %zu\n", n_in, ws_size); return; }
    Ptrs P{};
    P.x = (const float*)d_in[0]; P.w_in = (const float*)d_in[1]; P.w_pa = (const float*)d_in[2]; P.w_pb = (const float*)d_in[3]; P.w_out = (const float*)d_in[4];
    P.norm_mix = (const float*)d_in[5]; P.norm_ffn = (const float*)d_in[6]; P.norm_final = (const float*)d_in[7];
    P.lq1 = (const float*)d_in[8]; P.lk1 = (const float*)d_in[9]; P.lq2 = (const float*)d_in[10]; P.lk2 = (const float*)d_in[11];
    P.subln = (const float*)d_in[12]; P.rpb = (const float*)d_in[13]; P.w_query = (const float*)d_in[14]; P.sub_keys = (const float*)d_in[15];
    P.peer_u = (const float*)d_in[16]; P.peer_v = (const float*)d_in[17];
    P.out = (float*)d_out; P.ws = (unsigned char*)d_ws;
    static int grid_blocks = 0;
    if (!grid_blocks) {
        int dev = 0, cus = 0, per_cu = 0;
        hipGetDevice(&dev);
        hipDeviceGetAttribute(&cus, hipDeviceAttributeMultiprocessorCount, dev);
        hipFuncSetAttribute((const void*)mega_fwd, hipFuncAttributeMaxDynamicSharedMemorySize, MEGA_LDS);
        hipOccupancyMaxActiveBlocksPerMultiprocessor(&per_cu, (const void*)mega_fwd, 512, MEGA_LDS);
        if (per_cu < 1) { fprintf(stderr, "kernel_launch: occupancy query says %d blocks per CU\n", per_cu); per_cu = 1; }
        grid_blocks = cus * per_cu;
    }
    hipMemsetAsync((unsigned char*)d_ws + WS_CTL, 0, 16384, stream);
    void* args[] = {&P};
    hipError_t e = hipLaunchCooperativeKernel((const void*)mega_fwd, dim3(grid_blocks), dim3(512), args, MEGA_LDS, stream);
    if (e != hipSuccess) fprintf(stderr, "cooperative launch failed: %s (grid %d)\n", hipGetErrorString(e), grid_blocks);
}
```

```cpp
#include <hip/hip_runtime.h>
#include <hip/hip_cooperative_groups.h>
#include <cstdio>
#include <cstdint>

typedef unsigned short bf16_t;
typedef unsigned u32x4 __attribute__((ext_vector_type(4)));
typedef unsigned u32x2 __attribute__((ext_vector_type(2)));
typedef float f32x4 __attribute__((ext_vector_type(4)));
typedef __bf16 bf16x2_t __attribute__((ext_vector_type(2)));

constexpr int D = 1024, BATCH = 8, SEQ = 2048, M = BATCH * SEQ, INW = 5120;
constexpr int C_QA = 0, C_KA = 512, C_VA = 1024, C_QB = 1536, C_KB = 2048, C_VB = 2560, C_GA = 3072, C_GB = 4096;
constexpr int NEXP = 16384, PQ = 2048;
constexpr float EPS = 1e-6f;
constexpr float LOG2E = 1.4426950408889634f;
constexpr float WIN_SCALE = 32.f;
constexpr float QSCALE = 0.125f * LOG2E;

constexpr size_t MiB = 1u << 20;
constexpr size_t WS_PROJ = 0;
constexpr size_t WS_HB = 0;
constexpr size_t WS_Q = 32 * MiB;
constexpr size_t WS_U = 96 * MiB;
constexpr size_t WS_V = 112 * MiB;
constexpr size_t WS_SU = 128 * MiB;
constexpr size_t WS_SV = 128 * MiB + 65536;
constexpr size_t WS_XN = 160 * MiB;
constexpr size_t WS_YA = 160 * MiB;
constexpr size_t WS_YB = 176 * MiB;
constexpr size_t WS_IDX = 160 * MiB;
constexpr size_t WS_G = 168 * MiB;
constexpr size_t WS_MERGED = 192 * MiB;
constexpr size_t WS_TOPV = 192 * MiB;
constexpr size_t WS_TOPI = 208 * MiB;
constexpr size_t WS_WIN = 224 * MiB;
constexpr size_t WS_WIN8 = 226 * MiB;
constexpr size_t WS_XN8 = 192 * MiB;
constexpr size_t WS_WQ = 234 * MiB;
constexpr size_t WS_WOUT = 238 * MiB;
constexpr size_t WS_WPA = 240 * MiB;
constexpr size_t WS_WPB = 241 * MiB;
constexpr size_t WS_SK = 242 * MiB;
constexpr size_t WS_ROPE = 242 * MiB + 512 * 1024;
constexpr size_t WS_SSQ = 243 * MiB;
constexpr size_t WS_CTL = 244 * MiB;
constexpr size_t WS_END = 256 * MiB;

__device__ __forceinline__ float bf2f(unsigned v) { return __uint_as_float(v << 16); }
__device__ __forceinline__ float bflo(unsigned w) { return __uint_as_float(w << 16); }
__device__ __forceinline__ float bfhi(unsigned w) { return __uint_as_float(w & 0xffff0000u); }
__device__ __forceinline__ unsigned f2bf(float f) { unsigned u = __float_as_uint(f); return (u + 0x7fffu + ((u >> 16) & 1u)) >> 16; }
__device__ __forceinline__ unsigned pk2(float lo, float hi) { return f2bf(lo) | (f2bf(hi) << 16); }
__device__ __forceinline__ float wave_sum(float v) {
#pragma unroll
    for (int o = 1; o < 64; o <<= 1) v += __shfl_xor(v, o);
    return v;
}
__device__ __forceinline__ float sigmoidf_(float x) { return 1.f / (1.f + __expf(-x)); }
__device__ __forceinline__ float gelu_exact(float x) { return 0.5f * x * (1.f + erff(x * 0.70710678118654752f)); }

struct Ptrs {
    const float *x, *w_in, *w_pa, *w_pb, *w_out, *norm_mix, *norm_ffn, *norm_final, *lq1, *lk1, *lq2, *lk2, *subln, *rpb, *w_query, *sub_keys, *peer_u, *peer_v;
    float* out; unsigned char* ws;
};

__device__ __forceinline__ void transpose_item(const float* W, int K, int N, const float* gain, bf16_t* WT, float* scr, int item, int lane, int ldo = 0, int koff = 0, int ldw = 0) {
    if (ldo == 0) ldo = K;
    if (ldw == 0) ldw = N;
    const int nblk = N / 32, kb = item / nblk, nb = item % nblk, k0 = 64 * kb, n0 = 32 * nb;
    float wv[32];
#pragma unroll
    for (int i = 0; i < 32; ++i) { const int kk = 2 * i + (lane >> 5); wv[i] = W[(size_t)(k0 + kk) * ldw + n0 + (lane & 31)]; }
#pragma unroll
    for (int i = 0; i < 32; ++i) { const int kk = 2 * i + (lane >> 5); float w = wv[i]; if (gain) w *= gain[k0 + kk]; scr[kk * 33 + (lane & 31)] = w; }
    asm volatile("s_waitcnt lgkmcnt(0)" ::: "memory");
    const int c = lane & 7;
#pragma unroll
    for (int j = 0; j < 4; ++j) { const int n = (lane >> 3) + 8 * j; const float* s = scr + (8 * c) * 33 + n;
        u32x4 o; o.x = pk2(s[0 * 33], s[1 * 33]); o.y = pk2(s[2 * 33], s[3 * 33]); o.z = pk2(s[4 * 33], s[5 * 33]); o.w = pk2(s[6 * 33], s[7 * 33]);
        *(u32x4*)(WT + (size_t)(n0 + n) * ldo + koff + k0 + 8 * c) = o; }
    asm volatile("s_waitcnt lgkmcnt(0)" ::: "memory");
}
__device__ __forceinline__ void cvt8(const float* src, bf16_t* dst, size_t i8) {
    const f32x4 a = *(const f32x4*)(src + i8 * 8), b = *(const f32x4*)(src + i8 * 8 + 4);
    u32x4 o; o.x = pk2(a.x, a.y); o.y = pk2(a.z, a.w); o.z = pk2(b.x, b.y); o.w = pk2(b.z, b.w);
    *(u32x4*)(dst + i8 * 8) = o;
}
__device__ __forceinline__ void transpose_item8(const float* W, int K, int N, int ldw, const float* gain, float wscale, unsigned char* WT, float* scr, int item, int lane) {
    const int nblk = N / 32, kb = item / nblk, nb = item % nblk, k0 = 64 * kb, n0 = 32 * nb;
    float wv[32];
#pragma unroll
    for (int i = 0; i < 32; ++i) { const int kk = 2 * i + (lane >> 5); wv[i] = W[(size_t)(k0 + kk) * ldw + n0 + (lane & 31)]; }
#pragma unroll
    for (int i = 0; i < 32; ++i) { const int kk = 2 * i + (lane >> 5); float w = wv[i] * wscale; if (gain) w *= gain[k0 + kk]; scr[kk * 33 + (lane & 31)] = w; }
    asm volatile("s_waitcnt lgkmcnt(0)" ::: "memory");
    const int c = lane & 7;
#pragma unroll
    for (int j = 0; j < 4; ++j) { const int n = (lane >> 3) + 8 * j; const float* s = scr + (8 * c) * 33 + n;
        u32x2 o; o.x = __builtin_amdgcn_cvt_pk_fp8_f32(s[0 * 33], s[1 * 33], 0u, false); o.x = __builtin_amdgcn_cvt_pk_fp8_f32(s[2 * 33], s[3 * 33], o.x, true);
        o.y = __builtin_amdgcn_cvt_pk_fp8_f32(s[4 * 33], s[5 * 33], 0u, false); o.y = __builtin_amdgcn_cvt_pk_fp8_f32(s[6 * 33], s[7 * 33], o.y, true);
        *(u32x2*)(WT + (size_t)(n0 + n) * K + k0 + 8 * c) = o; }
    asm volatile("s_waitcnt lgkmcnt(0)" ::: "memory");
}
__device__ __forceinline__ void rms_rows_emit(const f32x4 (&v)[4], bf16_t* orow16, unsigned char* orow, int lane) {
    float s = 0.f;
#pragma unroll
    for (int j = 0; j < 4; ++j) s += (v[j].x * v[j].x + v[j].y * v[j].y) + (v[j].z * v[j].z + v[j].w * v[j].w);
    const float rstd = 1.f / sqrtf(wave_sum(s) * (1.f / D) + EPS);
    unsigned* o4 = (unsigned*)orow + lane; u32x2* o8 = (u32x2*)orow16 + lane;
#pragma unroll
    for (int j = 0; j < 4; ++j) { unsigned w = __builtin_amdgcn_cvt_pk_fp8_f32(v[j].x * rstd, v[j].y * rstd, 0u, false); w = __builtin_amdgcn_cvt_pk_fp8_f32(v[j].z * rstd, v[j].w * rstd, w, true); o4[64 * j] = w;
        u32x2 w2; w2.x = pk2(v[j].x * rstd, v[j].y * rstd); w2.y = pk2(v[j].z * rstd, v[j].w * rstd); o8[64 * j] = w2; }
}
__device__ __forceinline__ void rms_rows(const float* x, bf16_t* xn16, unsigned char* xn8, int m0, int step, int lane) {
    if (m0 >= M) return;
    f32x4 cur[4], nxt[4];
#pragma unroll
    for (int j = 0; j < 4; ++j) cur[j] = ((const f32x4*)(x + (size_t)m0 * D) + lane)[64 * j];
    for (int m = m0; m < M; m += step) {
        const int mn = (m + step < M) ? m + step : m;
#pragma unroll
        for (int j = 0; j < 4; ++j) nxt[j] = ((const f32x4*)(x + (size_t)mn * D) + lane)[64 * j];
        rms_rows_emit(cur, xn16 + (size_t)m * D, xn8 + (size_t)m * D, lane);
#pragma unroll
        for (int j = 0; j < 4; ++j) cur[j] = nxt[j];
    }
}
__device__ __forceinline__ void rms_row_to_bf16(const float* xrow, bf16_t* orow, int lane) {
    const f32x4* xr = (const f32x4*)xrow + lane;
    f32x4 v[4]; float s = 0.f;
#pragma unroll
    for (int j = 0; j < 4; ++j) { v[j] = xr[64 * j]; s += (v[j].x * v[j].x + v[j].y * v[j].y) + (v[j].z * v[j].z + v[j].w * v[j].w); }
    const float rstd = 1.f / sqrtf(wave_sum(s) * (1.f / D) + EPS);
    u32x2* o8 = (u32x2*)orow + lane;
#pragma unroll
    for (int j = 0; j < 4; ++j) { u32x2 w; w.x = pk2(v[j].x * rstd, v[j].y * rstd); w.y = pk2(v[j].z * rstd, v[j].w * rstd); o8[64 * j] = w; }
}

__device__ __forceinline__ void prep_phase(const Ptrs& P, unsigned char* shm, int G, int bx) {
    int tid_l = threadIdx.x; asm volatile("" : "+v"(tid_l));
    const int lane = tid_l & 63; const int wave = __builtin_amdgcn_readfirstlane(tid_l >> 6);
    const int gw = bx * 8 + wave, NGW = G * 8;
    float* scr = (float*)(shm + wave * (64 * 33 * 4));
    unsigned char* ws = P.ws;
    constexpr int N_BF = 1024;
    constexpr int I_INB = (D / 64) * (N_BF / 32), I_IN8 = (D / 64) * ((INW - N_BF) / 32), I_IN = I_INB + I_IN8, I_Q = (D / 64) * (PQ / 32), I_OUT = (D / 64) * (D / 32), I_PA = (512 / 64) * (D / 32);
    constexpr int NIT = I_IN + I_Q + I_OUT + 2 * I_PA;
    for (int it = gw; it < NIT; it += NGW) {
        int r = it;
        if (r < I_INB) { transpose_item(P.w_in, D, N_BF, P.norm_mix, (bf16_t*)(ws + WS_WIN), scr, r, lane, 0, 0, INW); continue; } r -= I_INB;
        if (r < I_IN8) { transpose_item8(P.w_in + N_BF, D, INW - N_BF, INW, P.norm_mix, WIN_SCALE, ws + WS_WIN8, scr, r, lane); continue; } r -= I_IN8;
        if (r < I_Q) { transpose_item(P.w_query, D, PQ, P.norm_ffn, (bf16_t*)(ws + WS_WQ), scr, r, lane); continue; } r -= I_Q;
        if (r < I_OUT) { transpose_item(P.w_out, D, D, nullptr, (bf16_t*)(ws + WS_WOUT), scr, r, lane); continue; } r -= I_OUT;
        if (r < I_PA) { transpose_item(P.w_pa, 512, D, nullptr, (bf16_t*)(ws + WS_WPA), scr, r, lane, 1024, 0); continue; } r -= I_PA;
        transpose_item(P.w_pb, 512, D, nullptr, (bf16_t*)(ws + WS_WPA), scr, r, lane, 1024, 512);
    }
    rms_rows(P.x, (bf16_t*)(ws + WS_XN), ws + WS_XN8, gw, NGW, lane);
    const size_t gt = (size_t)bx * 512 + threadIdx.x, NT = (size_t)G * 512;
    for (size_t i = gt; i < (size_t)16 * 128 * 128 / 8; i += NT) cvt8(P.sub_keys, (bf16_t*)(ws + WS_SK), i);
    for (size_t i = gt; i < (size_t)SEQ * 8; i += NT) {
        const int pos = (int)(i >> 3), k = (int)(i & 7);
        const float inv = k == 0 ? 1.0f : k == 1 ? 0.19392274f : k == 2 ? 0.03760603f : k == 3 ? 0.0072926646f : k == 4 ? 0.0014142136f : k == 5 ? 0.0002742482f : k == 6 ? 5.3182957e-05f : 1.0313385e-05f;
        const float ang = (float)pos * inv;
        float sn, cs; sincosf(ang, &sn, &cs);
        float* t = (float*)(ws + WS_ROPE) + (size_t)pos * 16;
        t[k] = cs; t[8 + k] = sn;
    }
}
__device__ __forceinline__ void cvt_row_fp8(const f32x4 (&rv)[4], unsigned char* dst, float* inv_scale, int lane) {
    const f32x4 a = rv[0], b = rv[1], c = rv[2], d = rv[3];
    float m = fmaxf(fmaxf(fmaxf(fabsf(a.x), fabsf(a.y)), fmaxf(fabsf(a.z), fabsf(a.w))), fmaxf(fmaxf(fabsf(b.x), fabsf(b.y)), fmaxf(fabsf(b.z), fabsf(b.w))));
    m = fmaxf(m, fmaxf(fmaxf(fmaxf(fabsf(c.x), fabsf(c.y)), fmaxf(fabsf(c.z), fabsf(c.w))), fmaxf(fmaxf(fabsf(d.x), fabsf(d.y)), fmaxf(fabsf(d.z), fabsf(d.w)))));
#pragma unroll
    for (int o = 1; o < 64; o <<= 1) m = fmaxf(m, __shfl_xor(m, o));
    m = fmaxf(m, 1e-30f);
    const float sc = 256.f / m;
    u32x4 w;
    w.x = __builtin_amdgcn_cvt_pk_fp8_f32(a.x * sc, a.y * sc, 0u, false); w.x = __builtin_amdgcn_cvt_pk_fp8_f32(a.z * sc, a.w * sc, w.x, true);
    w.y = __builtin_amdgcn_cvt_pk_fp8_f32(b.x * sc, b.y * sc, 0u, false); w.y = __builtin_amdgcn_cvt_pk_fp8_f32(b.z * sc, b.w * sc, w.y, true);
    w.z = __builtin_amdgcn_cvt_pk_fp8_f32(c.x * sc, c.y * sc, 0u, false); w.z = __builtin_amdgcn_cvt_pk_fp8_f32(c.z * sc, c.w * sc, w.z, true);
    w.w = __builtin_amdgcn_cvt_pk_fp8_f32(d.x * sc, d.y * sc, 0u, false); w.w = __builtin_amdgcn_cvt_pk_fp8_f32(d.z * sc, d.w * sc, w.w, true);
    *(u32x4*)(dst + (size_t)(lane >> 5) * (NEXP * 512) + (lane & 31) * 16) = w;
    if (lane == 0) *inv_scale = m * (1.f / 256.f);
}
__device__ __forceinline__ unsigned pack_i8x4(float a, float b, float c, float d) {
    const int q0 = (int)rintf(a), q1 = (int)rintf(b), q2 = (int)rintf(c), q3 = (int)rintf(d);
    return (unsigned)(q0 & 0xff) | ((unsigned)(q1 & 0xff) << 8) | ((unsigned)(q2 & 0xff) << 16) | ((unsigned)q3 << 24);
}
__device__ __forceinline__ void cvt_row_i8(const f32x4 (&rv)[4], unsigned char* dst, float* inv_scale, int lane) {
    const f32x4 a = rv[0], b = rv[1], c = rv[2], d = rv[3];
    float m = fmaxf(fmaxf(fmaxf(fabsf(a.x), fabsf(a.y)), fmaxf(fabsf(a.z), fabsf(a.w))), fmaxf(fmaxf(fabsf(b.x), fabsf(b.y)), fmaxf(fabsf(b.z), fabsf(b.w))));
    m = fmaxf(m, fmaxf(fmaxf(fmaxf(fabsf(c.x), fabsf(c.y)), fmaxf(fabsf(c.z), fabsf(c.w))), fmaxf(fmaxf(fabsf(d.x), fabsf(d.y)), fmaxf(fabsf(d.z), fabsf(d.w)))));
#pragma unroll
    for (int o = 1; o < 64; o <<= 1) m = fmaxf(m, __shfl_xor(m, o));
    m = fmaxf(m, 1e-30f);
    const float sc = 127.f / m;
    u32x4 w;
    w.x = pack_i8x4(a.x * sc, a.y * sc, a.z * sc, a.w * sc); w.y = pack_i8x4(b.x * sc, b.y * sc, b.z * sc, b.w * sc);
    w.z = pack_i8x4(c.x * sc, c.y * sc, c.z * sc, c.w * sc); w.w = pack_i8x4(d.x * sc, d.y * sc, d.z * sc, d.w * sc);
    *(u32x4*)(dst + (size_t)(lane >> 5) * (NEXP * 512) + (lane & 31) * 16) = w;
    if (lane == 0) *inv_scale = m * (1.f / 127.f);
}
__device__ __forceinline__ void cvt_experts_phase(const Ptrs& P, int G, int bx) {
    int tid_l = threadIdx.x; asm volatile("" : "+v"(tid_l));
    const int lane = tid_l & 63; const int wave = __builtin_amdgcn_readfirstlane(tid_l >> 6);
    const int step = G * 8; int r = bx * 8 + wave;
    if (r >= 2 * NEXP) return;
    f32x4 cur[4], nxt[4];
    { const float* src = (r < NEXP ? P.peer_u + (size_t)r * D : P.peer_v + (size_t)(r - NEXP) * D);
#pragma unroll
      for (int j = 0; j < 4; ++j) cur[j] = ((const f32x4*)src + lane * 4)[j]; }
    for (; r < 2 * NEXP; r += step) {
        const int rn = (r + step < 2 * NEXP) ? r + step : r;
        const float* srcn = (rn < NEXP ? P.peer_u + (size_t)rn * D : P.peer_v + (size_t)(rn - NEXP) * D);
#pragma unroll
        for (int j = 0; j < 4; ++j) nxt[j] = ((const f32x4*)srcn + lane * 4)[j];
        if (r < NEXP) cvt_row_i8(cur, P.ws + WS_U + (size_t)r * 512, (float*)(P.ws + WS_SU) + r, lane);
        else { const int e = r - NEXP; cvt_row_fp8(cur, P.ws + WS_V + (size_t)e * 512, (float*)(P.ws + WS_SV) + e, lane); }
#pragma unroll
        for (int j = 0; j < 4; ++j) cur[j] = nxt[j];
    }
}

namespace pg8 {
#define PG8_LAS __attribute__((address_space(3)))
typedef unsigned short bf16_t;
typedef short bf16x8 __attribute__((ext_vector_type(8)));
typedef float f32x4 __attribute__((ext_vector_type(4)));
typedef unsigned u32x4 __attribute__((ext_vector_type(4)));
typedef int v8i_t __attribute__((ext_vector_type(8)));
constexpr int BM = 256, BK = 64, HALF = 128, HTB = HALF * BK * 2  , STAGE_BYTES = 8 * HTB, NXCD = 8, WGM = 4;

__host__ __device__ __forceinline__ int lds_byte(int r, int c) { const int st = (r >> 4) * 2 + (c >> 5), rr = r & 15, cc = c & 31, ob = rr * 64 + cc * 2; return st * 1024 + (ob ^ (((ob >> 9) & 1) << 5)); }
__host__ __device__ __forceinline__ void stage_rc(int b, int& R, int& C) { const int st = b / 1024, sb = b % 1024, swz = sb ^ (((sb >> 9) & 1) << 5); R = (st >> 1) * 16 + swz / 64; C = (st & 1) * 32 + (swz % 64) / 2; }
__host__ __device__ __forceinline__ int perm32(int rho) { const int n = rho >> 4, i = rho & 15; return 8 * (i >> 2) + 4 * n + (i & 3); }

struct Unit { int pm, pn; };
struct Gemm { const bf16_t* A; const bf16_t* Bt; int M, N, K, pad; };

struct StaticOrder {
    int nM, nN, nwg, G, c;
    __host__ __device__ void init(int M, int N, int G_, int c_) { nM = M / BM; nN = N / BM; nwg = nM * nN; G = G_; c = c_; }
    __host__ __device__ bool next(int i, Unit& u) const {
        const long L = (long)i * G + c; if (L >= nwg) return false;
        int wgid = (int)L; { const int q = nwg / NXCD, r = nwg % NXCD, xcd = wgid % NXCD, off = wgid / NXCD; wgid = (xcd < r ? xcd * (q + 1) : r * (q + 1) + (xcd - r) * q) + off; }
        const int nig = WGM * nN, gid = wgid / nig, fm = gid * WGM, gsz = (nM - fm) < WGM ? (nM - fm) : WGM;
        u.pm = fm + ((wgid % nig) % gsz); u.pn = (wgid % nig) / gsz; return true;
    }
    __device__ __forceinline__ void a_ready(const Unit&) const {}
    __device__ __forceinline__ void done(const Unit&) const {}
};
__device__ __forceinline__ unsigned cvt_pk_bf16(float lo, float hi) { unsigned r; asm volatile("v_cvt_pk_bf16_f32 %0, %1, %2" : "=v"(r) : "v"(lo), "v"(hi)); return r; }
typedef float f32x2 __attribute__((ext_vector_type(2)));

__device__ __forceinline__ float sigm(float x) { return __builtin_amdgcn_rcpf(1.f + __builtin_amdgcn_exp2f(-1.4426950408889634f * x)); }
struct EpiProj {
    static constexpr bool PERM = true, AFTER_DRAIN = false, MID = false;
    bf16_t* O; const float* rope; float osc; int pn0;
    __device__ __forceinline__ void operator()(const f32x4 (&acc)[2][2][4][2], const Unit& u, int wr, int wc, int fr_, int fq_) const {
        int fr = fr_, fq = fq_; asm volatile("" : "+v"(fr), "+v"(fq));
        const int pn = u.pn + pn0;
        const int row0 = u.pm * BM + wr * 64 + fr, col0 = pn * BM + wc * 32 + 8 * fq;
        const float sc = ((pn < 2 || pn == 6 || pn == 7) ? QSCALE : 1.f) * osc;
        const bool dorope = (pn < 4) && ((wc & 1) == 0);
#pragma unroll
        for (int ai = 0; ai < 2; ++ai)
#pragma unroll
            for (int m = 0; m < 4; ++m) { const int row = row0 + ai * HALF + m * 16; bf16_t* rowp = O + (size_t)row * INW + col0;
                f32x4 c4[2] = {{1.f, 1.f, 1.f, 1.f}, {1.f, 1.f, 1.f, 1.f}}, s4[2] = {{0.f, 0.f, 0.f, 0.f}, {0.f, 0.f, 0.f, 0.f}};
                if (dorope) { const float* rp = rope + (size_t)(row & (SEQ - 1)) * 16; c4[0] = *(const f32x4*)(rp); c4[1] = *(const f32x4*)(rp + 4); s4[0] = *(const f32x4*)(rp + 8); s4[1] = *(const f32x4*)(rp + 12); }
#pragma unroll
                for (int bj = 0; bj < 2; ++bj) { f32x4 v0 = acc[ai][bj][m][0], v1 = acc[ai][bj][m][1];
                    if (dorope) { f32x4 o0, o1;
#pragma unroll
                        for (int j = 0; j < 4; ++j) { o0[j] = __shfl_xor(v0[j], 16); o1[j] = __shfl_xor(v1[j], 16); }
                        if (fq == 0) { v0 = v0 * c4[0] - o0 * s4[0]; v1 = v1 * c4[1] - o1 * s4[1]; }
                        else if (fq == 1) { v0 = v0 * c4[0] + o0 * s4[0]; v1 = v1 * c4[1] + o1 * s4[1]; } }
                    v0 = v0 * sc; v1 = v1 * sc; u32x4 w; w.x = cvt_pk_bf16(v0[0], v0[1]); w.y = cvt_pk_bf16(v0[2], v0[3]); w.z = cvt_pk_bf16(v1[0], v1[1]); w.w = cvt_pk_bf16(v1[2], v1[3]);
                    *(u32x4*)(rowp + bj * HALF) = w; } }
    }
};
struct EpiGate2 {
    static constexpr bool PERM = true, AFTER_DRAIN = false, MID = true;
    const bf16_t* proj; bf16_t* O;
    __device__ __forceinline__ void mid(f32x4 (&acc)[2][2][4][2], const Unit& u, int wr, int wc, int fr, int fq) const {
        int row0 = u.pm * BM + wr * 64 + fr, col0 = u.pn * BM + wc * 32 + 8 * fq;
        asm volatile("" : "+v"(row0), "+v"(col0));
#pragma unroll
        for (int ai = 0; ai < 2; ++ai) {
            u32x4 gav[4][2], gbv[4][2];
#pragma unroll
            for (int m = 0; m < 4; ++m)
#pragma unroll
                for (int bj = 0; bj < 2; ++bj) { const bf16_t* gp = proj + (size_t)(row0 + ai * HALF + m * 16) * INW + col0 + bj * HALF; gav[m][bj] = *(const u32x4*)(gp + C_GA); gbv[m][bj] = *(const u32x4*)(gp + C_GB); }
#pragma unroll
            for (int m = 0; m < 4; ++m) {
#pragma unroll
                for (int bj = 0; bj < 2; ++bj) { const u32x4 ga = gav[m][bj], gb = gbv[m][bj];
                    const unsigned a_[4] = {ga.x, ga.y, ga.z, ga.w}, b_[4] = {gb.x, gb.y, gb.z, gb.w};
#pragma unroll
                    for (int q = 0; q < 4; ++q) {
                        const float r0 = (1.f + __builtin_amdgcn_exp2f(-1.4426950408889634f * bflo(b_[q]))) * __builtin_amdgcn_rcpf(1.f + __builtin_amdgcn_exp2f(-1.4426950408889634f * bflo(a_[q])));
                        const float r1 = (1.f + __builtin_amdgcn_exp2f(-1.4426950408889634f * bfhi(b_[q]))) * __builtin_amdgcn_rcpf(1.f + __builtin_amdgcn_exp2f(-1.4426950408889634f * bfhi(a_[q])));
                        acc[ai][bj][m][q >> 1][(q & 1) * 2] *= r0; acc[ai][bj][m][q >> 1][(q & 1) * 2 + 1] *= r1; } } }
            asm volatile("" ::: "memory"); }
    }
    __device__ __forceinline__ void operator()(const f32x4 (&acc)[2][2][4][2], const Unit& u, int wr, int wc, int fr_, int fq_) const {
        int fr = fr_, fq = fq_; asm volatile("" : "+v"(fr), "+v"(fq));
        const int row0 = u.pm * BM + wr * 64 + fr, col0 = u.pn * BM + wc * 32 + 8 * fq;
#pragma unroll
        for (int ai = 0; ai < 2; ++ai) {
            u32x4 gv[4][2];
#pragma unroll
            for (int m = 0; m < 4; ++m)
#pragma unroll
                for (int bj = 0; bj < 2; ++bj) gv[m][bj] = *(const u32x4*)(proj + (size_t)(row0 + ai * HALF + m * 16) * INW + C_GB + col0 + bj * HALF);
#pragma unroll
            for (int m = 0; m < 4; ++m) { const int row = row0 + ai * HALF + m * 16;
#pragma unroll
                for (int bj = 0; bj < 2; ++bj) { const int col = col0 + bj * HALF; const u32x4 g = gv[m][bj];
                    f32x4 v0 = acc[ai][bj][m][0], v1 = acc[ai][bj][m][1];
                    v0[0] *= sigm(bflo(g.x)); v0[1] *= sigm(bfhi(g.x)); v0[2] *= sigm(bflo(g.y)); v0[3] *= sigm(bfhi(g.y));
                    v1[0] *= sigm(bflo(g.z)); v1[1] *= sigm(bfhi(g.z)); v1[2] *= sigm(bflo(g.w)); v1[3] *= sigm(bfhi(g.w));
                    u32x4 w; w.x = cvt_pk_bf16(v0[0], v0[1]); w.y = cvt_pk_bf16(v0[2], v0[3]); w.z = cvt_pk_bf16(v1[0], v1[1]); w.w = cvt_pk_bf16(v1[2], v1[3]);
                    *(u32x4*)(O + (size_t)row * D + col) = w; } }
            asm volatile("" ::: "memory"); }
    }
};
struct EpiHout {
    static constexpr bool PERM = true, AFTER_DRAIN = false, MID = false;
    const float* x; float* H; bf16_t* HB; float* ssq16;
    __device__ __forceinline__ void operator()(const f32x4 (&acc)[2][2][4][2], const Unit& u, int wr, int wc, int fr_, int fq_) const {
        int fr = fr_, fq = fq_; asm volatile("" : "+v"(fr), "+v"(fq));
        const int row0 = u.pm * BM + wr * 64 + fr, col0 = u.pn * BM + wc * 32 + 8 * fq;
#pragma unroll
        for (int ai = 0; ai < 2; ++ai) {
            f32x4 xv[4][2][2];
#pragma unroll
            for (int m = 0; m < 4; ++m)
#pragma unroll
                for (int bj = 0; bj < 2; ++bj) { const float* xp = x + (size_t)(row0 + ai * HALF + m * 16) * D + col0 + bj * HALF; xv[m][bj][0] = *(const f32x4*)xp; xv[m][bj][1] = *(const f32x4*)(xp + 4); }
#pragma unroll
            for (int m = 0; m < 4; ++m) { const int row = row0 + ai * HALF + m * 16; float ss = 0.f;
#pragma unroll
                for (int bj = 0; bj < 2; ++bj) { const int col = col0 + bj * HALF;
                    const f32x4 v0 = acc[ai][bj][m][0] + xv[m][bj][0], v1 = acc[ai][bj][m][1] + xv[m][bj][1];
                    u32x4 w; w.x = cvt_pk_bf16(v0[0], v0[1]); w.y = cvt_pk_bf16(v0[2], v0[3]); w.z = cvt_pk_bf16(v1[0], v1[1]); w.w = cvt_pk_bf16(v1[2], v1[3]);
                    *(u32x4*)(HB + (size_t)row * D + col) = w;
                    ss += (v0[0] * v0[0] + v0[1] * v0[1]) + (v0[2] * v0[2] + v0[3] * v0[3]) + (v1[0] * v1[0] + v1[1] * v1[1]) + (v1[2] * v1[2] + v1[3] * v1[3]); }
                ss += __shfl_xor(ss, 16); ss += __shfl_xor(ss, 32);
                if (fq == 0) ssq16[(size_t)row * 16 + u.pn * 4 + wc] = ss; }
            asm volatile("" ::: "memory"); }
    }
};
struct EpiQ {
    static constexpr bool PERM = true, AFTER_DRAIN = false, MID = false;
    const float* ssq16; bf16_t* O;
    __device__ __forceinline__ void operator()(const f32x4 (&acc)[2][2][4][2], const Unit& u, int wr, int wc, int fr, int fq) const {
        const int row0 = u.pm * BM + wr * 64 + fr, col0 = u.pn * BM + wc * 32 + 8 * fq;
#pragma unroll
        for (int ai = 0; ai < 2; ++ai)
#pragma unroll
            for (int m = 0; m < 4; ++m) { const int row = row0 + ai * HALF + m * 16; const f32x4* sp = (const f32x4*)(ssq16 + (size_t)row * 16);
                const f32x4 a = sp[0], b = sp[1], c = sp[2], d = sp[3];
                const float tot = ((a[0] + a[1]) + (a[2] + a[3])) + ((b[0] + b[1]) + (b[2] + b[3])) + ((c[0] + c[1]) + (c[2] + c[3])) + ((d[0] + d[1]) + (d[2] + d[3]));
                const float rstd = 1.f / sqrtf(tot * (1.f / D) + EPS);
#pragma unroll
                for (int bj = 0; bj < 2; ++bj) { const f32x4 v0 = acc[ai][bj][m][0] * rstd, v1 = acc[ai][bj][m][1] * rstd;
                    u32x4 w; w.x = cvt_pk_bf16(v0[0], v0[1]); w.y = cvt_pk_bf16(v0[2], v0[3]); w.z = cvt_pk_bf16(v1[0], v1[1]); w.w = cvt_pk_bf16(v1[2], v1[3]);
                    *(u32x4*)(O + (size_t)row * PQ + col0 + bj * HALF) = w; } }
    }
};
template <class Epi, class Sched, bool ALIGN_EPI = false, bool SP2 = false, bool FP8 = false>
__device__ __forceinline__ void gemm_phase(PG8_LAS unsigned char* lds, const Gemm g, const Sched& S, const Epi& E) {
    int tid_l = threadIdx.x; asm volatile("" : "+v"(tid_l));
    const int tid = tid_l, wid = __builtin_amdgcn_readfirstlane(tid >> 6), lane = tid & 63, wr = wid >> 2, wc = wid & 3, fr = lane & 15, fq = lane >> 4;
    const int K = g.K, nt = K / BK;
    unsigned voffA[2], voffB[2];
#pragma unroll
    for (int i = 0; i < 2; ++i) { int R, C; stage_rc(tid * 16 + i * 8192, R, C); const int Rb = Epi::PERM ? ((R & ~31) + perm32(R & 31)) : R;
        voffA[i] = (unsigned)(R * K + C) * 2u; voffB[i] = (unsigned)(Rb * K + C) * 2u; }
    const size_t kstep = (size_t)(BK * 2);
    const size_t hstep = (size_t)HALF * K * 2;
    const size_t tstep = 2 * hstep;
    const unsigned ldsw = (unsigned)wid * 1024u;
    const int aoff = lds_byte(wr * 64 + fr, fq * 8), boff = lds_byte(wc * 32 + fr, fq * 8);
    const int aoffF0 = FP8 ? lds_byte(wr * 64 + fr, fq * 16) : 0, boffF0 = FP8 ? lds_byte(wc * 32 + fr, fq * 16) : 0;
#define PG8_SA(b, h) (((b) * 2 + (h)) * HTB)
#define PG8_SB(b, h) ((4 + (b) * 2 + (h)) * HTB)
#define PG8_STAGE(bufoff, gbase, voff) do { _Pragma("unroll") for (int _i = 0; _i < 2; ++_i) \
        __builtin_amdgcn_global_load_lds((const unsigned*)((const char*)(gbase) + (voff)[_i]), (PG8_LAS unsigned*)(lds + (bufoff) + ldsw + _i * 8192), 16, 0, 0); } while (0)
#define PG8_LDA(dst, b, h) do { if constexpr (FP8) { _Pragma("unroll") for (int m = 0; m < 4; ++m) { const u32x4 l_ = *(const PG8_LAS u32x4*)(lds + PG8_SA(b, h) + aoffF0 + m * 2048), h_ = *(const PG8_LAS u32x4*)(lds + PG8_SA(b, h) + aoffF0 + m * 2048 + 16); \
            dst##8[m] = (v8i_t){(int)l_.x, (int)l_.y, (int)l_.z, (int)l_.w, (int)h_.x, (int)h_.y, (int)h_.z, (int)h_.w}; } } \
        else { _Pragma("unroll") for (int m = 0; m < 4; ++m) _Pragma("unroll") for (int k = 0; k < 2; ++k) dst[m][k] = *(const PG8_LAS bf16x8*)(lds + PG8_SA(b, h) + aoff + m * 2048 + k * 1024); } } while (0)
#define PG8_LDB(dst, b, h) do { if constexpr (FP8) { _Pragma("unroll") for (int n = 0; n < 2; ++n) { const u32x4 l_ = *(const PG8_LAS u32x4*)(lds + PG8_SB(b, h) + boffF0 + n * 2048), h_ = *(const PG8_LAS u32x4*)(lds + PG8_SB(b, h) + boffF0 + n * 2048 + 16); \
            dst##8[n] = (v8i_t){(int)l_.x, (int)l_.y, (int)l_.z, (int)l_.w, (int)h_.x, (int)h_.y, (int)h_.z, (int)h_.w}; } } \
        else { _Pragma("unroll") for (int n = 0; n < 2; ++n) _Pragma("unroll") for (int k = 0; k < 2; ++k) dst[n][k] = *(const PG8_LAS bf16x8*)(lds + PG8_SB(b, h) + boff + n * 2048 + k * 1024); } } while (0)
#define PG8_MMA(ai, bj, At, Bt) do { __builtin_amdgcn_s_setprio(1); \
        if constexpr (FP8) { _Pragma("unroll") for (int m = 0; m < 4; ++m) _Pragma("unroll") for (int n = 0; n < 2; ++n) \
            asm volatile("v_mfma_scale_f32_16x16x128_f8f6f4 %0, %1, %2, %0, %3, %3 op_sel_hi:[0,0,0]" : "+v"(acc[ai][bj][m][n]) : "v"(Bt##8[n]), "v"(At##8[m]), "v"(mxone)); } \
        else { _Pragma("unroll") for (int m = 0; m < 4; ++m) _Pragma("unroll") for (int n = 0; n < 2; ++n) _Pragma("unroll") for (int k = 0; k < 2; ++k) \
            acc[ai][bj][m][n] = __builtin_amdgcn_mfma_f32_16x16x32_bf16(Bt[n][k], At[m][k], acc[ai][bj][m][n], 0, 0, 0); } \
        __builtin_amdgcn_s_setprio(0); } while (0)
#define PG8_WAIT_V(n) asm volatile("s_waitcnt vmcnt(" #n ")" ::: "memory")
#define PG8_WAIT_L(n) asm volatile("s_waitcnt lgkmcnt(" #n ")" ::: "memory")
#define PG8_BAR __builtin_amdgcn_s_barrier()
#define PG8_SCHED __builtin_amdgcn_sched_barrier(0)
    Unit cur, nxt; int ui = 0;
    if (!S.next(0, cur)) return;
    f32x4 acc[2][2][4][2];
#pragma unroll
    for (int a = 0; a < 2; ++a)
#pragma unroll
        for (int b = 0; b < 2; ++b)
#pragma unroll
            for (int m = 0; m < 4; ++m)
#pragma unroll
                for (int n = 0; n < 2; ++n) acc[a][b][m][n] = (f32x4){0.f, 0.f, 0.f, 0.f};
    bf16x8 At[4][2], B0[2][2], B1[2][2]; v8i_t At8[4], B08[2], B18[2];
    int mxone = 0x7F7F7F7F; asm volatile("" : "+v"(mxone));
    const char* cA = (const char*)g.A + (size_t)cur.pm * tstep; const char* cB = (const char*)g.Bt + (size_t)cur.pn * tstep;
    S.a_ready(cur);
    if constexpr (SP2) {
        PG8_STAGE(PG8_SB(0, 0), cB, voffB); PG8_STAGE(PG8_SB(0, 1), cB + hstep, voffB); PG8_STAGE(PG8_SA(0, 0), cA, voffA); PG8_STAGE(PG8_SA(0, 1), cA + hstep, voffA);
        if (wr == 1) PG8_BAR;
        PG8_WAIT_V(2); PG8_BAR;
        PG8_STAGE(PG8_SB(1, 0), cB + kstep, voffB); PG8_STAGE(PG8_SA(1, 0), cA + kstep, voffA); PG8_STAGE(PG8_SB(1, 1), cB + hstep + kstep, voffB);
        PG8_WAIT_V(6); PG8_BAR;
    } else {
        PG8_STAGE(PG8_SB(0, 0), cB, voffB); PG8_STAGE(PG8_SA(0, 0), cA, voffA); PG8_STAGE(PG8_SB(0, 1), cB + hstep, voffB); PG8_STAGE(PG8_SA(0, 1), cA + hstep, voffA);
        if (wr == 1) PG8_BAR;
        PG8_WAIT_V(4); PG8_BAR;
        PG8_STAGE(PG8_SB(1, 0), cB + kstep, voffB); PG8_STAGE(PG8_SA(1, 0), cA + kstep, voffA); PG8_STAGE(PG8_SB(1, 1), cB + hstep + kstep, voffB);
        PG8_WAIT_V(6); PG8_BAR;
    }
    for (;;) {
        const bool has_next = S.next(ui + 1, nxt);
        const char* nA = has_next ? (const char*)g.A + (size_t)nxt.pm * tstep : cA; const char* nB = has_next ? (const char*)g.Bt + (size_t)nxt.pn * tstep : cB;
#pragma unroll 1
        for (int t = 0; t < nt; t += 2) {
            if constexpr (Epi::MID) { if (t == nt / 2) E.mid(acc, cur, wr, wc, fr, fq); }
            const bool last = (t == nt - 2);
            const char* a1 = cA + (size_t)(t + 1) * kstep;
            const char* a2 = last ? nA : cA + (size_t)(t + 2) * kstep; const char* b2 = last ? nB : cB + (size_t)(t + 2) * kstep;
            const char* a3 = a2 + kstep; const char* b3 = b2 + kstep;
            if (last && has_next) S.a_ready(nxt);
            if constexpr (SP2) {
            PG8_LDB(B0, 0, 0); PG8_LDB(B1, 0, 1); PG8_SCHED; PG8_LDA(At, 0, 0); PG8_STAGE(PG8_SA(1, 1), a1 + hstep, voffA);
            PG8_WAIT_V(8); PG8_WAIT_L(0); PG8_BAR; PG8_MMA(0, 0, At, B0); PG8_MMA(0, 1, At, B1); PG8_BAR; PG8_SCHED;
            PG8_LDA(At, 0, 1); PG8_STAGE(PG8_SB(0, 0), b2, voffB); PG8_STAGE(PG8_SB(0, 1), b2 + hstep, voffB); PG8_STAGE(PG8_SA(0, 0), a2, voffA);
            PG8_WAIT_V(8); PG8_WAIT_L(0); PG8_BAR; PG8_MMA(1, 0, At, B0); PG8_MMA(1, 1, At, B1); PG8_BAR; PG8_SCHED;
            PG8_LDB(B0, 1, 0); PG8_LDB(B1, 1, 1); PG8_SCHED; PG8_LDA(At, 1, 0); PG8_STAGE(PG8_SA(0, 1), a2 + hstep, voffA);
            PG8_WAIT_V(8); PG8_WAIT_L(0); PG8_BAR; PG8_MMA(0, 0, At, B0); PG8_MMA(0, 1, At, B1); PG8_BAR; PG8_SCHED;
            PG8_LDA(At, 1, 1); PG8_STAGE(PG8_SB(1, 0), b3, voffB); PG8_STAGE(PG8_SB(1, 1), b3 + hstep, voffB); PG8_STAGE(PG8_SA(1, 0), a3, voffA);
            PG8_WAIT_V(8); PG8_WAIT_L(0); PG8_BAR; PG8_MMA(1, 0, At, B0); PG8_MMA(1, 1, At, B1); PG8_BAR; PG8_SCHED;
            } else {
            PG8_LDB(B0, 0, 0); PG8_SCHED; PG8_LDA(At, 0, 0); PG8_STAGE(PG8_SA(1, 1), a1 + hstep, voffA);
            PG8_WAIT_L(8); PG8_BAR; PG8_WAIT_L(0); PG8_MMA(0, 0, At, B0); PG8_BAR; PG8_SCHED;
            PG8_LDB(B1, 0, 1); PG8_STAGE(PG8_SB(0, 0), b2, voffB);
            PG8_BAR; PG8_WAIT_L(0); PG8_MMA(0, 1, At, B1); PG8_BAR;
            PG8_LDA(At, 0, 1); PG8_STAGE(PG8_SA(0, 0), a2, voffA);
            PG8_BAR; PG8_WAIT_L(0); PG8_MMA(1, 0, At, B0); PG8_BAR; PG8_SCHED;
            PG8_STAGE(PG8_SB(0, 1), b2 + hstep, voffB);
            PG8_WAIT_V(6); PG8_BAR; PG8_MMA(1, 1, At, B1); PG8_BAR;
            PG8_LDB(B0, 1, 0); PG8_SCHED; PG8_LDA(At, 1, 0); PG8_STAGE(PG8_SA(0, 1), a2 + hstep, voffA);
            PG8_WAIT_L(8); PG8_BAR; PG8_WAIT_L(0); PG8_MMA(0, 0, At, B0); PG8_BAR; PG8_SCHED;
            PG8_LDB(B1, 1, 1); PG8_STAGE(PG8_SB(1, 0), b3, voffB);
            PG8_BAR; PG8_WAIT_L(0); PG8_MMA(0, 1, At, B1); PG8_BAR;
            PG8_LDA(At, 1, 1); PG8_STAGE(PG8_SA(1, 0), a3, voffA);
            PG8_BAR; PG8_WAIT_L(0); PG8_MMA(1, 0, At, B0); PG8_BAR; PG8_SCHED;
            PG8_STAGE(PG8_SB(1, 1), b3 + hstep, voffB);
            PG8_WAIT_V(6); PG8_BAR; PG8_MMA(1, 1, At, B1); PG8_BAR;
            }
        }
        if constexpr (ALIGN_EPI) { if (wr == 0) PG8_BAR; }
        if constexpr (FP8) { asm volatile("s_nop 15\n\ts_nop 7" ::: "memory"); PG8_SCHED; }
        if constexpr (!Epi::AFTER_DRAIN) { E(acc, cur, wr, wc, fr, fq); S.done(cur); }
        if (!has_next) break;
#pragma unroll
        for (int a = 0; a < 2; ++a)
#pragma unroll
            for (int b = 0; b < 2; ++b)
#pragma unroll
                for (int m = 0; m < 4; ++m)
#pragma unroll
                    for (int n = 0; n < 2; ++n) acc[a][b][m][n] = (f32x4){0.f, 0.f, 0.f, 0.f};
        cur = nxt; cA = nA; cB = nB; ++ui;
        if constexpr (ALIGN_EPI) { if (wr == 1) PG8_BAR; }
    }
    PG8_WAIT_V(0);
    if constexpr (!ALIGN_EPI) { if (wr == 0) PG8_BAR; }
    PG8_BAR;
    if constexpr (Epi::AFTER_DRAIN) { E.fused(acc, cur, wr, wc, fr, fq, lds, wid, lane); S.done(cur); }
#undef PG8_SA
#undef PG8_SB
#undef PG8_STAGE
#undef PG8_LDA
#undef PG8_LDB
#undef PG8_MMA
#undef PG8_WAIT_V
#undef PG8_WAIT_L
#undef PG8_BAR
#undef PG8_SCHED
}
}

__device__ __forceinline__ float lambda_full(const Ptrs& P) {
    float a = 0.f, b = 0.f;
    for (int i = 0; i < 64; ++i) { a += P.lq1[i] * P.lk1[i]; b += P.lq2[i] * P.lk2[i]; }
    return __expf(a) - __expf(b) + 0.2f;
}

namespace att {
typedef short bf16x8 __attribute__((ext_vector_type(8)));
typedef short s16x4 __attribute__((ext_vector_type(4)));
typedef float f32x16 __attribute__((ext_vector_type(16)));
typedef float f32x2_t __attribute__((ext_vector_type(2)));
typedef __attribute__((address_space(3))) const char* lds_cptr;
typedef __attribute__((address_space(3))) char* lds_ptr;
__device__ __forceinline__ int crow(int r, int hi) { return (r & 3) + 8 * (r >> 2) + 4 * hi; }
__device__ __forceinline__ void glds16(const void* gsrc, unsigned lds_dst) { unsigned keep;
    asm volatile("s_mov_b32 %0, m0\n\ts_mov_b32 m0, %2\n\ts_nop 0\n\tglobal_load_lds_dwordx4 %1, off\n\ts_mov_b32 m0, %0" : "=&s"(keep) : "v"(gsrc), "s"(lds_dst) : "memory"); }
__device__ __forceinline__ unsigned cvtpk(float lo, float hi) { f32x2_t v = {lo, hi}; bf16x2_t b = __builtin_convertvector(v, bf16x2_t); return __builtin_bit_cast(unsigned, b); }
#define ATT_WAIT_BAR(N) asm volatile("s_waitcnt vmcnt(" #N ") lgkmcnt(0)\n\ts_barrier" ::: "memory")
#define ATT_LDSWAIT() asm volatile("s_waitcnt lgkmcnt(0)" ::: "memory")
#define ATT_SBAR() __builtin_amdgcn_sched_barrier(0)
template <bool REL> __device__ __forceinline__ void qkt(f32x16& p0, f32x16& p1, lds_cptr Kslot, const bf16x8* qr, const f32x16& negm, int r32, int hi) {
    lds_cptr kb = Kslot + hi * 1024 + r32 * 16;
#pragma unroll
    for (int d0 = 0; d0 < 4; ++d0) {
        const bf16x8 b0 = *(const __attribute__((address_space(3))) bf16x8*)(kb + d0 * 2048);
        const bf16x8 b1 = *(const __attribute__((address_space(3))) bf16x8*)(kb + d0 * 2048 + 512);
        if (d0 == 0) { if (REL) { p0 = __builtin_amdgcn_mfma_f32_32x32x16_bf16(b0, qr[0], negm, 0, 0, 0); p1 = __builtin_amdgcn_mfma_f32_32x32x16_bf16(b1, qr[0], negm, 0, 0, 0); }
                       else { p0 = __builtin_amdgcn_mfma_f32_32x32x16_bf16(b0, qr[0], f32x16{}, 0, 0, 0); p1 = __builtin_amdgcn_mfma_f32_32x32x16_bf16(b1, qr[0], f32x16{}, 0, 0, 0); } }
        else { p0 = __builtin_amdgcn_mfma_f32_32x32x16_bf16(b0, qr[d0], p0, 0, 0, 0); p1 = __builtin_amdgcn_mfma_f32_32x32x16_bf16(b1, qr[d0], p1, 0, 0, 0); } }
}
__device__ __forceinline__ float rowmax32(const f32x16& p0, const f32x16& p1) {
    float a = fmaxf(p0[0], p1[0]);
#pragma unroll
    for (int r = 1; r < 16; ++r) a = fmaxf(a, fmaxf(p0[r], p1[r]));
    auto rr = __builtin_amdgcn_permlane32_swap(__float_as_uint(a), __float_as_uint(a), false, false);
    return fmaxf(__uint_as_float(rr[0]), __uint_as_float(rr[1]));
}
__device__ __forceinline__ float halfsum(float a) { auto rr = __builtin_amdgcn_permlane32_swap(__float_as_uint(a), __float_as_uint(a), false, false); return __uint_as_float(rr[0]) + __uint_as_float(rr[1]); }
#define ATT_VREAD(lo, hi, d0) do { _Pragma("unroll") for (int ks = 0; ks < 4; ++ks) { \
        asm volatile("ds_read_b64_tr_b16 %0,%1 offset:%c2" : "=&v"(lo[ks]) : "v"(vb), "i"((d0) * 4096 + ks * 1024) : "memory"); \
        asm volatile("ds_read_b64_tr_b16 %0,%1 offset:%c2" : "=&v"(hi[ks]) : "v"(vb), "i"((d0) * 4096 + ks * 1024 + 512) : "memory"); } } while (0)
#define ATT_PK(lo, hi, k) (bf16x8){lo[k][0], lo[k][1], lo[k][2], lo[k][3], hi[k][0], hi[k][1], hi[k][2], hi[k][3]}
#define ATT_PVMMA(lo, hi, d0) do { \
        o[d0] = __builtin_amdgcn_mfma_f32_32x32x16_bf16(pa0, ATT_PK(lo, hi, 0), o[d0], 0, 0, 0); o[d0] = __builtin_amdgcn_mfma_f32_32x32x16_bf16(pa1, ATT_PK(lo, hi, 1), o[d0], 0, 0, 0); \
        o[d0] = __builtin_amdgcn_mfma_f32_32x32x16_bf16(pa2, ATT_PK(lo, hi, 2), o[d0], 0, 0, 0); o[d0] = __builtin_amdgcn_mfma_f32_32x32x16_bf16(pa3, ATT_PK(lo, hi, 3), o[d0], 0, 0, 0); } while (0)
template <int ND0> __device__ __forceinline__ void pv(f32x16* o, int vb, bf16x8 pa0, bf16x8 pa1, bf16x8 pa2, bf16x8 pa3) {
    s16x4 loA[4], hiA[4], loB[4], hiB[4];
    ATT_VREAD(loA, hiA, 0);
#pragma unroll
    for (int d0 = 0; d0 < ND0; d0 += 2) {
        if (d0 + 1 < ND0) { ATT_VREAD(loB, hiB, d0 + 1); asm volatile("s_waitcnt lgkmcnt(8)" ::: "memory"); } else { asm volatile("s_waitcnt lgkmcnt(0)" ::: "memory"); }
        ATT_SBAR();
        ATT_PVMMA(loA, hiA, d0);
        if (d0 + 1 < ND0) {
            if (d0 + 2 < ND0) { ATT_VREAD(loA, hiA, d0 + 2); asm volatile("s_waitcnt lgkmcnt(8)" ::: "memory"); } else { asm volatile("s_waitcnt lgkmcnt(0)" ::: "memory"); }
            ATT_SBAR();
            ATT_PVMMA(loB, hiB, d0 + 1);
        }
    }
}
#undef ATT_VREAD
#undef ATT_PVMMA
#undef ATT_PK
template <int DEAD> __device__ __forceinline__ constexpr bool live0(int r) { return DEAD != 2 || r >= 12; }
template <int DEAD> __device__ __forceinline__ constexpr bool live1(int r) { return DEAD != 1 || r < 4; }
template <int ND0, int THR, bool REL, int DEAD = 0> __device__ __forceinline__ void softmax_tile(f32x16& p0, f32x16& p1, float& mrun, float& lsum, f32x16& negm, bool first, f32x16* o, __attribute__((address_space(3))) float* wsf, int r32, int hi,
                                                                   u32x4& pw0, u32x4& pw1, u32x4& pw2, u32x4& pw3) {
    float rm;
    if (DEAD == 0) rm = rowmax32(p0, p1);
    else { float a = -3e38f;
#pragma unroll
        for (int r = 0; r < 16; ++r) { if (live0<DEAD>(r)) a = fmaxf(a, p0[r]); if (live1<DEAD>(r)) a = fmaxf(a, p1[r]); }
        auto rr = __builtin_amdgcn_permlane32_swap(__float_as_uint(a), __float_as_uint(a), false, false); rm = fmaxf(__uint_as_float(rr[0]), __uint_as_float(rr[1])); }
    if (!REL) rm -= mrun;
    if (first) {
        mrun = REL ? rm : mrun + rm;
        if (REL) {
#pragma unroll
            for (int r = 0; r < 16; ++r) { if (live0<DEAD>(r)) p0[r] -= rm; if (live1<DEAD>(r)) p1[r] -= rm; negm[r] = -mrun; } }
    } else if (__any(rm > (float)THR)) {
        const float dl = fmaxf(rm, 0.f), alpha = __builtin_amdgcn_exp2f(-dl); lsum *= alpha; mrun += dl;
        if (REL) {
#pragma unroll
            for (int r = 0; r < 16; ++r) { if (live0<DEAD>(r)) p0[r] -= dl; if (live1<DEAD>(r)) p1[r] -= dl; negm[r] = -mrun; } }
        if (hi == 0) wsf[r32] = alpha;
        ATT_LDSWAIT();
#pragma unroll
        for (int g = 0; g < 4; ++g) { const f32x4 a4 = *(const __attribute__((address_space(3))) f32x4*)(wsf + 8 * g + 4 * hi);
#pragma unroll
            for (int d0 = 0; d0 < ND0; ++d0) { o[d0][4 * g + 0] *= a4[0]; o[d0][4 * g + 1] *= a4[1]; o[d0][4 * g + 2] *= a4[2]; o[d0][4 * g + 3] *= a4[3]; } }
        ATT_LDSWAIT();
    }
    float s = 0.f;
#pragma unroll
    for (int r = 0; r < 16; ++r) {
        if (live0<DEAD>(r)) { p0[r] = __builtin_amdgcn_exp2f(REL ? p0[r] : p0[r] - mrun); s += p0[r]; } else p0[r] = 0.f;
        if (live1<DEAD>(r)) { p1[r] = __builtin_amdgcn_exp2f(REL ? p1[r] : p1[r] - mrun); s += p1[r]; } else p1[r] = 0.f; }
    lsum += s;
    pw0 = (u32x4){cvtpk(p0[0], p0[1]), cvtpk(p0[2], p0[3]), cvtpk(p0[4], p0[5]), cvtpk(p0[6], p0[7])};
    pw1 = (u32x4){cvtpk(p0[8], p0[9]), cvtpk(p0[10], p0[11]), cvtpk(p0[12], p0[13]), cvtpk(p0[14], p0[15])};
    pw2 = (u32x4){cvtpk(p1[0], p1[1]), cvtpk(p1[2], p1[3]), cvtpk(p1[4], p1[5]), cvtpk(p1[6], p1[7])};
    pw3 = (u32x4){cvtpk(p1[8], p1[9]), cvtpk(p1[10], p1[11]), cvtpk(p1[12], p1[13]), cvtpk(p1[14], p1[15])};
}

constexpr int A_SLOTK = 8192, A_SLOTV = 16384, A_NS = 3, A_NSV = 4;
constexpr int A_LDS_K = 0, A_LDS_V = A_NS * A_SLOTK, A_LDS_WS = A_LDS_V + A_NSV * A_SLOTV, A_LDS_ST = A_LDS_WS + 8 * 256, A_LDS_BYTES = A_LDS_ST + 8 * 8192;
__device__ __forceinline__ void attn_a_unit(int b, int h, int qb, const bf16_t* proj, bf16_t* ya, const float* subln, float lam, unsigned char* shm) {
    int tid_l = threadIdx.x; asm volatile("" : "+v"(tid_l));
    const int tid = tid_l, lane = tid & 63, r32 = lane & 31, hi = lane >> 5; const int wid = __builtin_amdgcn_readfirstlane(tid >> 6);
    const size_t rowbase = (size_t)b * SEQ; const int q0 = qb * 256;
    constexpr int NT = SEQ / 64;
    const unsigned lds0 = (unsigned)(uintptr_t)shm;
    const lds_cptr shm3 = (lds_cptr)shm;
    __attribute__((address_space(3))) float* wsf = (__attribute__((address_space(3))) float*)((lds_ptr)shm + A_LDS_WS) + wid * 64;
    const int vb0 = (int)(lds0 + A_LDS_V) + ((lane >> 4) & 1) * 32 + (lane & 3) * 8 + (4 * hi + ((lane & 15) >> 2)) * 64;
    __attribute__((address_space(3))) bf16_t* stg = (__attribute__((address_space(3))) bf16_t*)((lds_ptr)shm + A_LDS_ST) + wid * 4096;
    for (int mp = 0; mp < 2; ++mp) {
        const bf16_t* Kh = proj + rowbase * INW + C_KA + h * 128 + mp * 64;
        const bf16_t* Vh = proj + rowbase * INW + C_VA + h * 128;
        const bf16_t* Qw = proj + (rowbase + q0 + wid * 32) * INW + C_QA + h * 128 + mp * 64;
        const int pA = 2 * wid, pB = 2 * wid + 1;
        const unsigned kdst = lds0 + A_LDS_K + wid * 1024, vdstA = lds0 + A_LDS_V + pA * 1024, vdstB = lds0 + A_LDS_V + pB * 1024;
#define A_DMA(t, slot, vsl) do { int ln_ = lane; asm volatile("" : "+v"(ln_)); \
        const bf16_t* ksrc_ = Kh + (size_t)((t) * 64 + ln_) * INW + wid * 8; \
        const bf16_t* vsrcA_ = Vh + (size_t)((t) * 64 + 16 * (pA & 3) + (ln_ >> 2)) * INW + (pA >> 2) * 32 + (ln_ & 3) * 8; \
        const bf16_t* vsrcB_ = Vh + (size_t)((t) * 64 + 16 * (pB & 3) + (ln_ >> 2)) * INW + (pB >> 2) * 32 + (ln_ & 3) * 8; \
        glds16(ksrc_, (unsigned)__builtin_amdgcn_readfirstlane(kdst + (slot) * A_SLOTK)); \
        glds16(vsrcA_, (unsigned)__builtin_amdgcn_readfirstlane(vdstA + (vsl) * A_SLOTV)); \
        glds16(vsrcB_, (unsigned)__builtin_amdgcn_readfirstlane(vdstB + (vsl) * A_SLOTV)); } while (0)
        A_DMA(0, 0, 0); A_DMA(1, 1, 1);
        bf16x8 qr[4];
#pragma unroll
        for (int d0 = 0; d0 < 4; ++d0) qr[d0] = *(const bf16x8*)(Qw + (size_t)r32 * INW + d0 * 16 + hi * 8);
        f32x16 o[4]; o[0] = f32x16{}; o[1] = f32x16{}; o[2] = f32x16{}; o[3] = f32x16{};
        float mrun = 0.f, lsum = 0.f; f32x16 negm = f32x16{};
        int slot = 0, slot2 = 2, vslot = 0, vslot2 = 2, vprev = 3;
        const bool late = wid >= 4;
        u32x4 pw0 = {}, pw1 = {}, pw2 = {}, pw3 = {};
        for (int t = 0; t < NT; ++t) {
            if (t + 1 < NT) { ATT_WAIT_BAR(3); } else { ATT_WAIT_BAR(0); }
            if (t + 2 < NT) A_DMA(t + 2, slot2, vslot2);
            if (late && t > 0) pv<4>(o, vb0 + vprev * A_SLOTV, __builtin_bit_cast(bf16x8, pw0), __builtin_bit_cast(bf16x8, pw1), __builtin_bit_cast(bf16x8, pw2), __builtin_bit_cast(bf16x8, pw3));
            f32x16 p0, p1;
            qkt<false>(p0, p1, shm3 + A_LDS_K + slot * A_SLOTK, qr, negm, r32, hi);
            softmax_tile<4, 8, false>(p0, p1, mrun, lsum, negm, t == 0, o, wsf, r32, hi, pw0, pw1, pw2, pw3);
            if (!late) pv<4>(o, vb0 + vslot * A_SLOTV, __builtin_bit_cast(bf16x8, pw0), __builtin_bit_cast(bf16x8, pw1), __builtin_bit_cast(bf16x8, pw2), __builtin_bit_cast(bf16x8, pw3));
            slot = (slot == 2) ? 0 : slot + 1; slot2 = (slot2 == 2) ? 0 : slot2 + 1;
            vprev = vslot; vslot = (vslot + 1) & 3; vslot2 = (vslot2 + 1) & 3;
        }
        if (late) pv<4>(o, vb0 + vprev * A_SLOTV, __builtin_bit_cast(bf16x8, pw0), __builtin_bit_cast(bf16x8, pw1), __builtin_bit_cast(bf16x8, pw2), __builtin_bit_cast(bf16x8, pw3));
#undef A_DMA
        const float lt = halfsum(lsum);
        if (hi == 0) wsf[32 + r32] = lt;
        ATT_LDSWAIT();
        float rli[16];
#pragma unroll
        for (int g = 0; g < 4; ++g) { const f32x4 l4 = *(const __attribute__((address_space(3))) f32x4*)(wsf + 32 + 8 * g + 4 * hi);
            rli[4 * g + 0] = __builtin_amdgcn_rcpf(l4[0]); rli[4 * g + 1] = __builtin_amdgcn_rcpf(l4[1]); rli[4 * g + 2] = __builtin_amdgcn_rcpf(l4[2]); rli[4 * g + 3] = __builtin_amdgcn_rcpf(l4[3]); }
        ATT_LDSWAIT();
        if (mp == 0) {
#pragma unroll
            for (int d0 = 0; d0 < 4; ++d0)
#pragma unroll
                for (int r = 0; r < 16; ++r) stg[crow(r, hi) * 128 + d0 * 32 + r32] = (bf16_t)f2bf(o[d0][r] * rli[r]);
            asm volatile("s_waitcnt lgkmcnt(0)\n\ts_barrier" ::: "memory");
        } else {
            float ss[16];
#pragma unroll
            for (int r = 0; r < 16; ++r) ss[r] = 0.f;
#pragma unroll
            for (int d0 = 0; d0 < 4; ++d0)
#pragma unroll
                for (int r = 0; r < 16; ++r) { const float a = bf2f(stg[crow(r, hi) * 128 + d0 * 32 + r32]); const float y = a - lam * o[d0][r] * rli[r]; o[d0][r] = y; ss[r] += y * y; }
#pragma unroll
            for (int r = 0; r < 16; ++r) { float v = ss[r]; v += __shfl_xor(v, 1); v += __shfl_xor(v, 2); v += __shfl_xor(v, 4); v += __shfl_xor(v, 8); v += __shfl_xor(v, 16);
                ss[r] = 0.8f / sqrtf(v * (1.f / 128.f) + EPS); }
            ATT_LDSWAIT();
#pragma unroll
            for (int d0 = 0; d0 < 4; ++d0) { const float gsub = subln[d0 * 32 + r32];
#pragma unroll
                for (int r = 0; r < 16; ++r) stg[crow(r, hi) * 128 + d0 * 32 + r32] = (bf16_t)f2bf(o[d0][r] * ss[r] * gsub); }
            ATT_LDSWAIT();
            bf16_t* Yw = ya + (rowbase + q0 + wid * 32) * 1024 + h * 128;
#pragma unroll
            for (int i = 0; i < 8; ++i) { const int row = i * 4 + (lane >> 4), ch = lane & 15; const u32x4 v = *(const __attribute__((address_space(3))) u32x4*)(stg + row * 128 + ch * 8); *(u32x4*)(Yw + (size_t)row * 1024 + ch * 8) = v; }
            asm volatile("s_waitcnt lgkmcnt(0)\n\ts_barrier" ::: "memory");
        }
    }
}

template <int DEAD> __device__ __forceinline__ void na_tile(lds_cptr Kslot, int vb, const bf16x8* qr, const __attribute__((address_space(3))) float* bp, const float (&fm0)[16], const float (&fm1)[16],
                                                        float& mrun, float& lsum, f32x16& negm, bool first, f32x16* o, __attribute__((address_space(3))) float* wsf, int r32, int hi) {
    f32x16 p0, p1; u32x4 pw0, pw1, pw2, pw3;
    qkt<true>(p0, p1, Kslot, qr, negm, r32, hi);
#pragma unroll
    for (int rr = 0; rr < 16; ++rr) { const int jj = (rr & 3) + 8 * (rr >> 2);
        if (live0<DEAD>(rr)) p0[rr] += bp[jj] + fm0[rr];
        if (live1<DEAD>(rr)) p1[rr] += bp[jj + 32] + fm1[rr]; }
    softmax_tile<2, 8, true, DEAD>(p0, p1, mrun, lsum, negm, first, o, wsf, r32, hi, pw0, pw1, pw2, pw3);
    pv<2>(o, vb, __builtin_bit_cast(bf16x8, pw0), __builtin_bit_cast(bf16x8, pw1), __builtin_bit_cast(bf16x8, pw2), __builtin_bit_cast(bf16x8, pw3));
}
constexpr int B_SLOT = 8192, B_NS = 6, B_PF = 5;
constexpr int B_LDS_K = 0, B_LDS_V = B_NS * B_SLOT, B_LDS_WS = 2 * B_NS * B_SLOT, B_LDS_BIAS = B_LDS_WS + 8 * 256, B_LDS_ST = B_LDS_BIAS + 2560, B_LDS_BYTES = B_LDS_ST + 8 * 4096;
__device__ __forceinline__ void attn_b_unit(int b, int h, int rg, const bf16_t* proj, bf16_t* yb, const float* rpb, unsigned char* shm) {
    int tid_l = threadIdx.x; asm volatile("" : "+v"(tid_l));
    const int tid = tid_l, lane = tid & 63, r32 = lane & 31, hi = lane >> 5; const int wid = __builtin_amdgcn_readfirstlane(tid >> 6);
    const size_t rowbase = (size_t)b * SEQ;
    const int r = 4 * rg + (wid >> 1), c0 = 32 * (wid & 1);
    int rs = r - 4; rs = rs < 0 ? 0 : (rs > 24 ? 24 : rs);
    int rmin = 4 * rg - 4; rmin = rmin < 0 ? 0 : (rmin > 24 ? 24 : rmin);
    int rmaxs = 4 * rg + 3 - 4; rmaxs = rmaxs < 0 ? 0 : (rmaxs > 24 ? 24 : rmaxs);
    const int ntile = rmaxs + 8 - rmin;
    const unsigned lds0 = (unsigned)(uintptr_t)shm;
    const lds_cptr shm3 = (lds_cptr)shm;
    __attribute__((address_space(3))) float* wsf = (__attribute__((address_space(3))) float*)((lds_ptr)shm + B_LDS_WS) + wid * 64;
    __attribute__((address_space(3))) float* bias = (__attribute__((address_space(3))) float*)((lds_ptr)shm + B_LDS_BIAS) + 64;
    __attribute__((address_space(3))) bf16_t* stg = (__attribute__((address_space(3))) bf16_t*)((lds_ptr)shm + B_LDS_ST) + wid * 2048;
    const int vb0 = (int)(lds0 + B_LDS_V) + ((lane >> 4) & 1) * 32 + (lane & 3) * 8 + (4 * hi + ((lane & 15) >> 2)) * 64;
    for (int i = tid; i < 640; i += 512) { const int e = i - 64, ri = e >> 5, cj = e & 31; bias[e] = (e >= 0 && e < 480 && cj < 31) ? rpb[(h * 15 + ri) * 31 + cj] * LOG2E : 0.f; }
    const bf16_t* Kh = proj + rowbase * INW + C_KB + h * 64;
    const bf16_t* Vh = proj + rowbase * INW + C_VB + h * 64;
    const bf16_t* Qw = proj + (rowbase + r * 64 + c0) * INW + C_QB + h * 64;
    const unsigned kdst = lds0 + B_LDS_K + wid * 1024, vdst = lds0 + B_LDS_V + wid * 1024;
#define B_DMA(t, slot) do { int ln_ = lane; asm volatile("" : "+v"(ln_)); \
    const bf16_t* ksrc_ = Kh + (size_t)((rmin + (t)) * 64 + ln_) * INW + wid * 8; \
    const bf16_t* vsrc_ = Vh + (size_t)((rmin + (t)) * 64 + 16 * (wid & 3) + (ln_ >> 2)) * INW + (wid >> 2) * 32 + (ln_ & 3) * 8; \
    glds16(ksrc_, (unsigned)__builtin_amdgcn_readfirstlane(kdst + (slot) * B_SLOT)); \
    glds16(vsrc_, (unsigned)__builtin_amdgcn_readfirstlane(vdst + (slot) * B_SLOT)); } while (0)
#pragma unroll
    for (int t = 0; t < B_PF; ++t) B_DMA(t, t);
    bf16x8 qr[4];
#pragma unroll
    for (int d0 = 0; d0 < 4; ++d0) qr[d0] = *(const bf16x8*)(Qw + (size_t)r32 * INW + d0 * 16 + hi * 8);
    f32x16 o[2]; o[0] = f32x16{}; o[1] = f32x16{};
    float mrun = 0.f, lsum = 0.f; f32x16 negm = f32x16{}; bool first = true;
    const int c = c0 + r32; int cs = c - 8; cs = cs < 0 ? 0 : (cs > 48 ? 48 : cs);
    float fm0[16], fm1[16];
#pragma unroll
    for (int rr = 0; rr < 16; ++rr) { const int j0 = crow(rr, hi); fm0[rr] = ((unsigned)(j0 - cs) < 16u) ? 0.f : -1e30f; fm1[rr] = ((unsigned)(j0 + 32 - cs) < 16u) ? 0.f : -1e30f; }
    int slot = 0, slotn = B_PF;
    for (int t = 0; t < ntile; ++t) {
        { const int rem = ntile - 1 - t;
          if (rem >= 4) { ATT_WAIT_BAR(8); } else if (rem == 3) { ATT_WAIT_BAR(6); } else if (rem == 2) { ATT_WAIT_BAR(4); } else if (rem == 1) { ATT_WAIT_BAR(2); } else { ATT_WAIT_BAR(0); } }
        if (t + B_PF < ntile) B_DMA(t + B_PF, slotn);
        const int kr = rmin + t;
        if (kr >= rs && kr < rs + 8) {
            const __attribute__((address_space(3))) float* bp = bias + ((kr - r + 7) * 32 + 15 - c + 4 * hi);
            if (wid & 1) na_tile<2>(shm3 + B_LDS_K + slot * B_SLOT, vb0 + slot * B_SLOT, qr, bp, fm0, fm1, mrun, lsum, negm, first, o, wsf, r32, hi);
            else         na_tile<1>(shm3 + B_LDS_K + slot * B_SLOT, vb0 + slot * B_SLOT, qr, bp, fm0, fm1, mrun, lsum, negm, first, o, wsf, r32, hi);
            first = false;
        }
        slot = (slot == B_NS - 1) ? 0 : slot + 1; slotn = (slotn == B_NS - 1) ? 0 : slotn + 1;
    }
#undef B_DMA
    const float lt = halfsum(lsum);
    if (hi == 0) wsf[32 + r32] = lt;
    ATT_LDSWAIT();
    float rli[16];
#pragma unroll
    for (int g = 0; g < 4; ++g) { const f32x4 l4 = *(const __attribute__((address_space(3))) f32x4*)(wsf + 32 + 8 * g + 4 * hi);
        rli[4 * g + 0] = __builtin_amdgcn_rcpf(l4[0]); rli[4 * g + 1] = __builtin_amdgcn_rcpf(l4[1]); rli[4 * g + 2] = __builtin_amdgcn_rcpf(l4[2]); rli[4 * g + 3] = __builtin_amdgcn_rcpf(l4[3]); }
#pragma unroll
    for (int d0 = 0; d0 < 2; ++d0)
#pragma unroll
        for (int rr = 0; rr < 16; ++rr) stg[crow(rr, hi) * 64 + d0 * 32 + r32] = (bf16_t)f2bf(o[d0][rr] * rli[rr]);
    ATT_LDSWAIT();
    bf16_t* Yw = yb + (rowbase + r * 64 + c0) * 1024 + 512 + h * 64;
#pragma unroll
    for (int i = 0; i < 4; ++i) { const int row = i * 8 + (lane >> 3), ch = lane & 7; const u32x4 v = *(const __attribute__((address_space(3))) u32x4*)(stg + row * 64 + ch * 8); *(u32x4*)(Yw + (size_t)row * 1024 + ch * 8) = v; }
    asm volatile("s_waitcnt lgkmcnt(0)\n\ts_barrier" ::: "memory");
}
}

namespace peer {
typedef short bf16x8 __attribute__((ext_vector_type(8)));
typedef float f32x16 __attribute__((ext_vector_type(16)));
typedef __attribute__((address_space(3))) const char* lds_cptr;
constexpr int T_LDS_SK = 0, T_LDS_BYTES = 65536;
__device__ __forceinline__ int imax(int a, int b) { int r; asm("v_max_f32 %0, %1, %2" : "=v"(r) : "v"(a), "v"(b)); return r; }
__device__ __forceinline__ int imin(int a, int b) { int r; asm("v_min_f32 %0, %1, %2" : "=v"(r) : "v"(a), "v"(b)); return r; }
__device__ __forceinline__ int f2key(float s, int idx) { return (__float_as_int(s) & ~127) | idx; }
__device__ __forceinline__ int key2bits(int k) { return k; }
template <int N, int OFF, int TOT> __device__ __forceinline__ void bsort_desc(int (&a)[TOT]) {
#pragma unroll
    for (int k = 2; k <= N; k <<= 1)
#pragma unroll
        for (int j = k >> 1; j > 0; j >>= 1)
#pragma unroll
            for (int i = 0; i < N; ++i) { const int l = i ^ j; if (l > i) { const bool desc = (i & k) == 0; const int hi_ = imax(a[OFF + i], a[OFF + l]), lo_ = imin(a[OFF + i], a[OFF + l]); a[OFF + i] = desc ? hi_ : lo_; a[OFF + l] = desc ? lo_ : hi_; } }
}
__device__ constexpr unsigned char NET16[126] = {0,1,2,3,0,2,1,3,1,2,4,5,6,7,4,6,5,7,5,6,0,4,2,6,2,4,1,5,3,7,3,5,1,2,3,4,5,6,8,9,10,11,8,10,9,11,9,10,12,13,14,15,12,14,13,15,13,14,8,12,10,14,10,12,9,13,11,15,11,13,9,10,11,12,13,14,0,8,4,12,4,8,2,10,6,14,6,10,2,4,6,8,10,12,1,9,5,13,5,9,3,11,7,15,7,11,3,5,7,9,11,13,1,2,3,4,5,6,7,8,9,10,11,12,13,14};
__device__ constexpr unsigned char NET32[382] = {0,1,2,3,0,2,1,3,1,2,4,5,6,7,4,6,5,7,5,6,0,4,2,6,2,4,1,5,3,7,3,5,1,2,3,4,5,6,8,9,10,11,8,10,9,11,9,10,12,13,14,15,12,14,13,15,13,14,8,12,10,14,10,12,9,13,11,15,11,13,9,10,11,12,13,14,0,8,4,12,4,8,2,10,6,14,6,10,2,4,6,8,10,12,1,9,5,13,5,9,3,11,7,15,7,11,3,5,7,9,11,13,1,2,3,4,5,6,7,8,9,10,11,12,13,14,16,17,18,19,16,18,17,19,17,18,20,21,22,23,20,22,21,23,21,22,16,20,18,22,18,20,17,21,19,23,19,21,17,18,19,20,21,22,24,25,26,27,24,26,25,27,25,26,28,29,30,31,28,30,29,31,29,30,24,28,26,30,26,28,25,29,27,31,27,29,25,26,27,28,29,30,16,24,20,28,20,24,18,26,22,30,22,26,18,20,22,24,26,28,17,25,21,29,21,25,19,27,23,31,23,27,19,21,23,25,27,29,17,18,19,20,21,22,23,24,25,26,27,28,29,30,0,16,8,24,8,16,4,20,12,28,12,20,4,8,12,16,20,24,2,18,10,26,10,18,6,22,14,30,14,22,6,10,14,18,22,26,2,4,6,8,10,12,14,16,18,20,22,24,26,28,1,17,9,25,9,17,5,21,13,29,13,21,5,9,13,17,21,25,3,19,11,27,11,19,7,23,15,31,15,23,7,11,15,19,23,27,3,5,7,9,11,13,15,17,19,21,23,25,27,29,1,2,3,4,5,6,7,8,9,10,11,12,13,14,15,16,17,18,19,20,21,22,23,24,25,26,27,28,29,30};
template <int OFF, int TOT> __device__ __forceinline__ void sort16_desc(int (&a)[TOT]) {
#pragma unroll
    for (int c = 0; c < 63; ++c) { const int i = OFF + NET16[2 * c], j = OFF + NET16[2 * c + 1]; const int hi_ = imax(a[i], a[j]), lo_ = imin(a[i], a[j]); a[i] = hi_; a[j] = lo_; }
}
template <int TOT> __device__ __forceinline__ void sort32_desc(int (&a)[TOT]) {
#pragma unroll
    for (int c = 0; c < 191; ++c) { const int i = NET32[2 * c], j = NET32[2 * c + 1]; const int hi_ = imax(a[i], a[j]), lo_ = imin(a[i], a[j]); a[i] = hi_; a[j] = lo_; }
}
template <int N, int OFF, int TOT> __device__ __forceinline__ void bmerge_desc(int (&a)[TOT]) {
#pragma unroll
    for (int j = N >> 1; j > 0; j >>= 1)
#pragma unroll
        for (int i = 0; i < N; ++i) { const int l = i ^ j; if (l > i) { const int hi_ = imax(a[OFF + i], a[OFF + l]), lo_ = imin(a[OFF + i], a[OFF + l]); a[OFF + i] = hi_; a[OFF + l] = lo_; } }
}
template <int A, int B, int TOT> __device__ __forceinline__ void merge_top16(int (&a)[TOT]) {
#pragma unroll
    for (int i = 0; i < 16; ++i) a[A + i] = imax(a[A + i], a[B + 15 - i]);
    bmerge_desc<16, A, TOT>(a);
}
__device__ __forceinline__ void cross_top16(int (&t)[16]) {
    int lo[16], hi[16];
#pragma unroll
    for (int i = 0; i < 16; ++i) { auto rr = __builtin_amdgcn_permlane32_swap((unsigned)t[i], (unsigned)t[i], false, false); lo[i] = (int)rr[0]; hi[i] = (int)rr[1]; }
#pragma unroll
    for (int i = 0; i < 16; ++i) t[i] = imax(lo[i], hi[15 - i]);
    bmerge_desc<16, 0, 16>(t);
}
__device__ __forceinline__ void half_top16(int (&top)[16], const bf16_t* qrow  , lds_cptr skp  , int hi) {
    f32x16 sc[4]; sc[0] = f32x16{}; sc[1] = f32x16{}; sc[2] = f32x16{}; sc[3] = f32x16{};
    bf16x8 qf[8];
#pragma unroll
    for (int ks = 0; ks < 8; ++ks) qf[ks] = *(const bf16x8*)(qrow + ks * 16);
#pragma unroll
    for (int ks = 0; ks < 8; ++ks)
#pragma unroll
        for (int kt = 0; kt < 4; ++kt) { const bf16x8 af = *(const __attribute__((address_space(3))) bf16x8*)(skp + ks * 4096 + kt * 512);
            sc[kt] = __builtin_amdgcn_mfma_f32_32x32x16_bf16(af, qf[ks], sc[kt], 0, 0, 0); }
    int k[64];
#pragma unroll
    for (int kt = 0; kt < 4; ++kt)
#pragma unroll
        for (int r = 0; r < 16; ++r) k[kt * 16 + r] = f2key(sc[kt][r], (32 * kt + (r & 3) + 8 * (r >> 2)) | (4 * hi));
    sort16_desc<0, 64>(k); sort16_desc<16, 64>(k); sort16_desc<32, 64>(k); sort16_desc<48, 64>(k);
    merge_top16<0, 16, 64>(k); merge_top16<32, 48, 64>(k); merge_top16<0, 32, 64>(k);
#pragma unroll
    for (int i = 0; i < 16; ++i) top[i] = k[i];
    cross_top16(top);
}
__device__ __forceinline__ void topk_wave(int tok0, int h, const bf16_t* Q, int* IDX, float* Gt, lds_cptr sk, int lane) {
    const int r32 = lane & 31, hi = lane >> 5, tok = tok0 + r32;
    const bf16_t* qrow = Q + (size_t)tok * PQ + h * 256 + 8 * hi;
    lds_cptr skl = sk + hi * 2048 + r32 * 16;
    int A0[16], A1[16];
    half_top16(A0, qrow, skl, hi);
    half_top16(A1, qrow + 128, skl + 32768, hi);
    float x[16], y[16]; int xw[16], yw[16];
#pragma unroll
    for (int a = 0; a < 16; ++a) { const int b0 = key2bits(A0[a]), b1 = key2bits(A1[a]);
        const float v0 = __int_as_float(b0 & ~127), v1 = __int_as_float(b1 & ~127); const int i0 = (b0 & 127) << 7, i1 = b1 & 127;
        x[a] = hi ? v1 : v0; y[a] = hi ? v0 : v1; xw[a] = hi ? i1 : i0; yw[a] = hi ? i0 : i1; }
    int w[32]; int n = 0;
#define PEER_CAND(a, b) do { const int bits = __float_as_int(x[a] + y[b]); int ww = (bits & ~0x3FFF) | (xw[a] + yw[b]); \
        if ((a) == (b) && hi) ww = (int)0xFF800000; w[n] = ww; ++n; } while (0)
#pragma unroll
    for (int b = 0; b < 16; ++b) PEER_CAND(0, b);
#pragma unroll
    for (int b = 1; b < 8; ++b) PEER_CAND(1, b);
#pragma unroll
    for (int b = 2; b < 5; ++b) PEER_CAND(2, b);
    PEER_CAND(3, 3);
#undef PEER_CAND
#pragma unroll
    for (int i = 27; i < 32; ++i) w[i] = (int)0xFF800000;
    sort32_desc<32>(w);
    int T[16];
#pragma unroll
    for (int i = 0; i < 16; ++i) T[i] = w[i];
    cross_top16(T);
    float sv[16]; int ev[16];
#pragma unroll
    for (int j = 0; j < 16; ++j) { ev[j] = T[j] & 0x3FFF; sv[j] = __int_as_float(T[j] & ~0x3FFF); }
    const float s0 = sv[0]; float esum = 0.f;
#pragma unroll
    for (int j = 0; j < 16; ++j) { sv[j] = __expf(sv[j] - s0); esum += sv[j]; }
    const float inv = 1.f / esum;
    if (hi == 0) { u32x4* io = (u32x4*)(IDX + ((size_t)tok * 8 + h) * 16);
#pragma unroll
        for (int j = 0; j < 4; ++j) io[j] = (u32x4){(unsigned)ev[4 * j], (unsigned)ev[4 * j + 1], (unsigned)ev[4 * j + 2], (unsigned)ev[4 * j + 3]}; }
    else { f32x4* go = (f32x4*)(Gt + ((size_t)tok * 8 + h) * 16);
#pragma unroll
        for (int j = 0; j < 4; ++j) go[j] = (f32x4){sv[4 * j] * inv, sv[4 * j + 1] * inv, sv[4 * j + 2] * inv, sv[4 * j + 3] * inv}; }
}
template <class Sched> __device__ __forceinline__ void topk_own_units(const Ptrs& P, unsigned char* shm, const Sched& S) {
    int tid_l = threadIdx.x; asm volatile("" : "+v"(tid_l));
    const int tid = tid_l, lane = tid & 63; const int wid = __builtin_amdgcn_readfirstlane(tid >> 6);
    const unsigned lds0 = (unsigned)(uintptr_t)shm;
    const bf16_t* SKg = (const bf16_t*)(P.ws + WS_SK);
    int hprev = -1; pg8::Unit u;
    for (int i = 0; S.next(i, u); ++i) {
        const int h = u.pn, tg = u.pm;
        if (h != hprev) { hprev = h;
            asm volatile("s_waitcnt lgkmcnt(0)\n\ts_barrier" ::: "memory");
#pragma unroll
            for (int j = 0; j < 8; ++j) { const int piece = wid * 8 + j, p = piece >> 5, c = (piece >> 1) & 15, kh = piece & 1;
                att::glds16(SKg + ((size_t)((h * 2 + p) * 128 + kh * 64 + lane) * 128 + c * 8), (unsigned)__builtin_amdgcn_readfirstlane(lds0 + p * 32768 + c * 2048 + kh * 1024)); }
            asm volatile("s_waitcnt vmcnt(0)\n\ts_barrier" ::: "memory");
        }
        topk_wave(tg * 256 + wid * 32, h, (const bf16_t*)(P.ws + WS_Q), (int*)(P.ws + WS_IDX), (float*)(P.ws + WS_G), (lds_cptr)shm, lane);
    }
}
}

namespace apply {
typedef float f32x2 __attribute__((ext_vector_type(2)));
typedef __attribute__((address_space(3))) unsigned* lds_u32p;
constexpr int AP_WAVE_BYTES = 4 * (512 + 2048), AP_LDS_BYTES = 8 * AP_WAVE_BYTES;
__device__ __forceinline__ float gelu_fast(float v) {
    const float av = fabsf(v), t = __builtin_amdgcn_rcpf(av * 0.2316418882f + 1.0f);
    float q = t * 0.5307027145f + (-0.7265760135f); q = q * t + 0.7107068705f; q = q * t + (-0.142248368f); q = q * t + 0.127414796f; q = q * t;
    const float e = __builtin_amdgcn_exp2f((v * v) * (-0.72134752044f));
    const float m = v * (q * e);
    return v < 0.f ? m : v - m;
}
#define AP_DPP(v, ctrl) __builtin_bit_cast(float, __builtin_amdgcn_update_dpp(0, __builtin_bit_cast(int, (v)), (ctrl), 0xF, 0xF, true))
__device__ __forceinline__ float row16_sum(float v) { v += AP_DPP(v, 0xB1); v += AP_DPP(v, 0x4E); v += AP_DPP(v, 0x141); v += AP_DPP(v, 0x140); return v; }
__device__ __forceinline__ void load_half(u32x4 (&r)[2], const unsigned char* img, unsigned e, int sub) {
    const unsigned off = e * 512u + (unsigned)(sub * 16);
    r[0] = *(const u32x4*)(img + off); r[1] = *(const u32x4*)(img + off + 256u);
}
constexpr int AP_PROBE_RING = 16;
constexpr int AP_RING = 8;
typedef __attribute__((address_space(3))) u32x4* lds_v4p;
template <int HF, int MODE, int RING> __device__ __forceinline__ void pass_u(const Ptrs& P, const bf16_t* hrow, float rstd, lds_v4p grp, u32x4 (&R)[RING][2], const unsigned char* img, const unsigned char* img_next, int sub) {
    unsigned xq[8]; float sx;
    {
        float xf[2][16]; float mx = 0.f;
#pragma unroll
        for (int i = 0; i < 2; ++i) { const int e0 = (sub + 16 * (2 * HF + i)) * 16;
#pragma unroll
            for (int q = 0; q < 4; ++q) { const u32x2 hb = *(const u32x2*)(hrow + e0 + 4 * q); const f32x4 gv = *(const f32x4*)(P.norm_ffn + e0 + 4 * q);
                xf[i][4 * q] = bflo(hb.x) * rstd * gv.x; xf[i][4 * q + 1] = bfhi(hb.x) * rstd * gv.y; xf[i][4 * q + 2] = bflo(hb.y) * rstd * gv.z; xf[i][4 * q + 3] = bfhi(hb.y) * rstd * gv.w;
                mx = fmaxf(fmaxf(mx, fmaxf(fabsf(xf[i][4 * q]), fabsf(xf[i][4 * q + 1]))), fmaxf(fabsf(xf[i][4 * q + 2]), fabsf(xf[i][4 * q + 3]))); } }
        mx = fmaxf(mx, AP_DPP(mx, 0xB1)); mx = fmaxf(mx, AP_DPP(mx, 0x4E)); mx = fmaxf(mx, AP_DPP(mx, 0x141)); mx = fmaxf(mx, AP_DPP(mx, 0x140));
        mx = fmaxf(mx, 1e-30f); sx = mx * (1.f / 127.f); const float qs = 127.f / mx;
#pragma unroll
        for (int i = 0; i < 2; ++i)
#pragma unroll
            for (int q = 0; q < 4; ++q) xq[4 * i + q] = pack_i8x4(xf[i][4 * q] * qs, xf[i][4 * q + 1] * qs, xf[i][4 * q + 2] * qs, xf[i][4 * q + 3] * qs);
    }
#pragma unroll 1
    for (int j = 0; j < 128; j += RING) {
        const int jn = (j + RING) & 127;
        __builtin_amdgcn_s_barrier();
        const unsigned char* tb = (j + RING < 128) ? img : img_next;
        unsigned nid[RING], part[RING], suv[RING], gsv[RING];
#pragma unroll
        for (int b4 = 0; b4 < RING / 4; ++b4) { const u32x4 na = grp[jn / 4 + b4];
            nid[4 * b4] = na.x; nid[4 * b4 + 1] = na.y; nid[4 * b4 + 2] = na.z; nid[4 * b4 + 3] = na.w;
            u32x4 pa = {}, sa = {}, ga = {};
            if (HF == 1) { pa = grp[96 + j / 4 + b4]; sa = grp[32 + j / 4 + b4]; ga = grp[64 + j / 4 + b4]; }
            part[4 * b4] = pa.x; part[4 * b4 + 1] = pa.y; part[4 * b4 + 2] = pa.z; part[4 * b4 + 3] = pa.w;
            suv[4 * b4] = sa.x; suv[4 * b4 + 1] = sa.y; suv[4 * b4 + 2] = sa.z; suv[4 * b4 + 3] = sa.w;
            gsv[4 * b4] = ga.x; gsv[4 * b4 + 1] = ga.y; gsv[4 * b4 + 2] = ga.z; gsv[4 * b4 + 3] = ga.w; }
        float outv[RING];
#pragma unroll
        for (int bq = 0; bq < RING; ++bq) {
            int d0_ = 0, d1_ = 0;
            if (MODE == 1) { asm volatile("" :: "v"(R[bq][0]), "v"(R[bq][1])); d0_ = (int)xq[0]; }
            else {
                d0_ = __builtin_amdgcn_sdot4((int)R[bq][0].x, (int)xq[0], d0_, false); d1_ = __builtin_amdgcn_sdot4((int)R[bq][0].y, (int)xq[1], d1_, false);
                d0_ = __builtin_amdgcn_sdot4((int)R[bq][0].z, (int)xq[2], d0_, false); d1_ = __builtin_amdgcn_sdot4((int)R[bq][0].w, (int)xq[3], d1_, false);
                d0_ = __builtin_amdgcn_sdot4((int)R[bq][1].x, (int)xq[4], d0_, false); d1_ = __builtin_amdgcn_sdot4((int)R[bq][1].y, (int)xq[5], d1_, false);
                d0_ = __builtin_amdgcn_sdot4((int)R[bq][1].z, (int)xq[6], d0_, false); d1_ = __builtin_amdgcn_sdot4((int)R[bq][1].w, (int)xq[7], d1_, false);
            }
            asm volatile("" ::: "memory");
            load_half(R[bq], tb, MODE == 2 ? (nid[bq] & 15u) : nid[bq], sub);
            asm volatile("" ::: "memory");
            float a_ = row16_sum((float)(d0_ + d1_)) * sx;
            if (HF == 1) { a_ = (a_ + __uint_as_float(part[bq])) * __uint_as_float(suv[bq]); a_ = __uint_as_float(gsv[bq]) * gelu_fast(a_); }
            outv[bq] = a_;
        }
        if (sub == 0) {
#pragma unroll
            for (int b4 = 0; b4 < RING / 4; ++b4) grp[96 + j / 4 + b4] = (u32x4){__float_as_uint(outv[4 * b4]), __float_as_uint(outv[4 * b4 + 1]), __float_as_uint(outv[4 * b4 + 2]), __float_as_uint(outv[4 * b4 + 3])}; }
    }
    asm volatile("s_waitcnt lgkmcnt(0)" ::: "memory");
}
template <int HF, int MODE, int RING> __device__ __forceinline__ void pass_v(float (&acc)[4][16], lds_v4p grp, u32x4 (&R)[RING][2], const unsigned char* img, const unsigned char* img_next, int sub) {
#pragma unroll 1
    for (int j = 0; j < 128; j += RING) {
        const int jn = (j + RING) & 127;
        __builtin_amdgcn_s_barrier();
        const unsigned char* tb = (j + RING < 128) ? img : img_next;
        unsigned nid[RING], cvv[RING];
#pragma unroll
        for (int b4 = 0; b4 < RING / 4; ++b4) { const u32x4 na = grp[jn / 4 + b4], ca = grp[96 + j / 4 + b4];
            nid[4 * b4] = na.x; nid[4 * b4 + 1] = na.y; nid[4 * b4 + 2] = na.z; nid[4 * b4 + 3] = na.w; cvv[4 * b4] = ca.x; cvv[4 * b4 + 1] = ca.y; cvv[4 * b4 + 2] = ca.z; cvv[4 * b4 + 3] = ca.w; }
#pragma unroll
        for (int bq = 0; bq < RING; ++bq) {
            const float c_ = __uint_as_float(cvv[bq]); const f32x2 c2 = {c_, c_};
            if (MODE == 1) { asm volatile("" :: "v"(R[bq][0]), "v"(R[bq][1])); acc[2 * HF][0] += c_; }
            else {
#pragma unroll
            for (int i = 0; i < 2; ++i) { const unsigned w_[4] = {R[bq][i].x, R[bq][i].y, R[bq][i].z, R[bq][i].w};
#pragma unroll
                for (int q = 0; q < 4; ++q) { const f32x2 lo_ = __builtin_amdgcn_cvt_pk_f32_fp8(w_[q], false), hi_ = __builtin_amdgcn_cvt_pk_f32_fp8(w_[q], true);
                    f32x2 a0 = {acc[2 * HF + i][4 * q], acc[2 * HF + i][4 * q + 1]}, a1 = {acc[2 * HF + i][4 * q + 2], acc[2 * HF + i][4 * q + 3]}; a0 += c2 * lo_; a1 += c2 * hi_;
                    acc[2 * HF + i][4 * q] = a0.x; acc[2 * HF + i][4 * q + 1] = a0.y; acc[2 * HF + i][4 * q + 2] = a1.x; acc[2 * HF + i][4 * q + 3] = a1.y; } }
            }
            asm volatile("" ::: "memory");
            load_half(R[bq], tb, MODE == 2 ? (nid[bq] & 15u) : nid[bq], sub);
            asm volatile("" ::: "memory");
        }
    }
}
template <int MODE> __device__ __forceinline__ void apply_round(const Ptrs& P, float* outbase, int tbase, unsigned char* shm_wave, int lane_in) {
    int lane = lane_in; asm volatile("" : "+v"(lane));
    const int sub = lane & 15, g = lane >> 4, t = tbase + g;
    __attribute__((address_space(3))) unsigned* cnt = (lds_u32p)(__attribute__((address_space(3))) unsigned char*)shm_wave + g * 128;
    lds_v4p grp = (lds_v4p)((__attribute__((address_space(3))) unsigned char*)shm_wave + 2048 + g * 2048);
    __attribute__((address_space(3))) unsigned* grp1 = (__attribute__((address_space(3))) unsigned*)grp;
    const unsigned char* U8 = P.ws + WS_U; const unsigned char* V8 = P.ws + WS_V;
    {
        const int* idxp = (const int*)(P.ws + WS_IDX) + (size_t)t * 128 + sub * 8; const float* gp = (const float*)(P.ws + WS_G) + (size_t)t * 128 + sub * 8;
        const u32x4 ia = *(const u32x4*)idxp, ib = *(const u32x4*)(idxp + 4); const f32x4 ga = *(const f32x4*)gp, gb = *(const f32x4*)(gp + 4);
        const int e[8] = {(int)ia.x, (int)ia.y, (int)ia.z, (int)ia.w, (int)ib.x, (int)ib.y, (int)ib.z, (int)ib.w};
        const float gt[8] = {ga.x, ga.y, ga.z, ga.w, gb.x, gb.y, gb.z, gb.w};
        float su[8], sv[8];
#pragma unroll
        for (int i = 0; i < 8; ++i) { su[i] = ((const float*)(P.ws + WS_SU))[e[i]]; sv[i] = ((const float*)(P.ws + WS_SV))[e[i]]; }
#pragma unroll
        for (int i = 0; i < 8; ++i) cnt[sub * 8 + i] = 0u;
        asm volatile("s_waitcnt lgkmcnt(0)" ::: "memory");
        unsigned pos[8];
#pragma unroll
        for (int i = 0; i < 8; ++i) pos[i] = __hip_atomic_fetch_add(cnt + (e[i] >> 7), 1u, __ATOMIC_RELAXED, __HIP_MEMORY_SCOPE_WAVEFRONT);
        asm volatile("s_waitcnt lgkmcnt(0)" ::: "memory");
        unsigned c[8]; unsigned tot = 0;
#pragma unroll
        for (int i = 0; i < 8; ++i) { c[i] = cnt[sub * 8 + i]; }
#pragma unroll
        for (int i = 0; i < 8; ++i) { const unsigned x = c[i]; c[i] = tot; tot += x; }
        unsigned inc = tot;
#pragma unroll
        for (int d = 1; d < 16; d <<= 1) { const unsigned y = __shfl_up(inc, d, 16); if (sub >= d) inc += y; }
        const unsigned base = inc - tot;
        asm volatile("s_waitcnt lgkmcnt(0)" ::: "memory");
#pragma unroll
        for (int i = 0; i < 8; ++i) cnt[sub * 8 + i] = base + c[i];
        asm volatile("s_waitcnt lgkmcnt(0)" ::: "memory");
#pragma unroll
        for (int i = 0; i < 8; ++i) { const unsigned p = cnt[e[i] >> 7] + pos[i];
            grp1[p] = (unsigned)e[i]; grp1[128 + p] = __float_as_uint(su[i]); grp1[256 + p] = __float_as_uint(gt[i] * sv[i]); }
        asm volatile("s_waitcnt lgkmcnt(0)" ::: "memory");
    }
    const bf16_t* hrow = (const bf16_t*)(P.ws + WS_HB) + (size_t)t * D;
    float rstd;
    { const float* ssq = (const float*)(P.ws + WS_SSQ) + (size_t)t * 16;
      const f32x4 s0 = *(const f32x4*)ssq, s1 = *(const f32x4*)(ssq + 4), s2 = *(const f32x4*)(ssq + 8), s3 = *(const f32x4*)(ssq + 12);
      const float tot = ((s0.x + s0.y) + (s0.z + s0.w)) + ((s1.x + s1.y) + (s1.z + s1.w)) + ((s2.x + s2.y) + (s2.z + s2.w)) + ((s3.x + s3.y) + (s3.z + s3.w));
      rstd = 1.f / sqrtf(tot * (1.f / D) + EPS); }
    constexpr int RG = (MODE == 1) ? AP_PROBE_RING : AP_RING;
    const unsigned char* U0 = U8; const unsigned char* U1 = U8 + (size_t)NEXP * 512; const unsigned char* V0 = V8; const unsigned char* V1 = V8 + (size_t)NEXP * 512;
    u32x4 R[RG][2];
    {
#pragma unroll
      for (int b4 = 0; b4 < RG / 4; ++b4) { const u32x4 ia = grp[b4]; load_half(R[4 * b4], U0, ia.x, sub); load_half(R[4 * b4 + 1], U0, ia.y, sub); load_half(R[4 * b4 + 2], U0, ia.z, sub); load_half(R[4 * b4 + 3], U0, ia.w, sub); } }
    pass_u<0, MODE, RG>(P, hrow, rstd, grp, R, U0, U1, sub);
    pass_u<1, MODE, RG>(P, hrow, rstd, grp, R, U1, V0, sub);
    float acc[4][16];
#pragma unroll
    for (int i = 0; i < 4; ++i)
#pragma unroll
        for (int q = 0; q < 16; ++q) acc[i][q] = 0.f;
    pass_v<0, MODE, RG>(acc, grp, R, V0, V1, sub);
    pass_v<1, MODE, RG>(acc, grp, R, V1, V1, sub);
    float ss = 0.f;
#pragma unroll
    for (int i = 0; i < 4; ++i) { const int e0 = (sub + 16 * i) * 16;
#pragma unroll
        for (int q = 0; q < 4; ++q) { const u32x2 hb = *(const u32x2*)(hrow + e0 + 4 * q);
            acc[i][4 * q] += bflo(hb.x); acc[i][4 * q + 1] += bfhi(hb.x); acc[i][4 * q + 2] += bflo(hb.y); acc[i][4 * q + 3] += bfhi(hb.y);
            ss += (acc[i][4 * q] * acc[i][4 * q] + acc[i][4 * q + 1] * acc[i][4 * q + 1]) + (acc[i][4 * q + 2] * acc[i][4 * q + 2] + acc[i][4 * q + 3] * acc[i][4 * q + 3]); }
        asm volatile("" ::: "memory"); }
    ss = row16_sum(ss);
    const float r2 = 1.f / sqrtf(ss * (1.f / D) + EPS);
    float* orow = outbase + (size_t)t * D;
#pragma unroll
    for (int i = 0; i < 4; ++i) { const int e0 = (sub + 16 * i) * 16;
#pragma unroll
        for (int q = 0; q < 4; ++q) { const f32x4 gv = *(const f32x4*)(P.norm_final + e0 + 4 * q);
            *(f32x4*)(orow + e0 + 4 * q) = (f32x4){acc[i][4 * q] * r2 * gv.x, acc[i][4 * q + 1] * r2 * gv.y, acc[i][4 * q + 2] * r2 * gv.z, acc[i][4 * q + 3] * r2 * gv.w}; }
        asm volatile("" ::: "memory"); }
}
template <int MODE> __device__ __forceinline__ void apply_phase(const Ptrs& P, float* outbase, unsigned char* shm, int G, int vcu) {
    int tid_l = threadIdx.x; asm volatile("" : "+v"(tid_l));
    const int lane = tid_l & 63; const int wave = __builtin_amdgcn_readfirstlane(tid_l >> 6);
    const int per = M / (G * 8);
#pragma unroll 1
    for (int r = 0; r < per; r += 4) apply_round<MODE>(P, outbase, (vcu * 8 + wave) * per + r, shm + wave * AP_WAVE_BYTES, lane);
}
}

#define LAS __attribute__((address_space(3)))
#define XB_TMO      128
#define XB_XCNT(j)  (256  + 64 * (j))
#define XB_XSUB(j)  (1280 + 64 * (j))
#define XB_XGEN(j)  (2304 + 64 * (j))
#define XB_TOP      3328
#define XB_TOPGEN   3392
#define XCD_BAR_WORDS 3456
#define XB_SPIN_CAP (1u << 18)

__device__ __forceinline__ unsigned xb_ld(unsigned* p)              { return __hip_atomic_load(p, __ATOMIC_RELAXED, __HIP_MEMORY_SCOPE_AGENT); }
__device__ __forceinline__ unsigned xb_add(unsigned* p, unsigned v) { return __hip_atomic_fetch_add(p, v, __ATOMIC_RELAXED, __HIP_MEMORY_SCOPE_AGENT); }
__device__ __forceinline__ unsigned xb_xcc_id() { return (unsigned)__builtin_amdgcn_s_getreg((3 << 11) | 20) & 0xFu; }
#define XB_SPIN(cond, bar) do { unsigned _sp = 0; while (cond) { __builtin_amdgcn_s_sleep(1); \
    if ((++_sp & 255u) == 0u) { if (xb_ld(&(bar)[XB_TMO])) break; if (_sp > XB_SPIN_CAP) { atomicAdd(&(bar)[XB_TMO], 1u); break; } } } } while (0)

struct XcdBarrier {
    unsigned* bar; unsigned x;
    volatile LAS unsigned* st;
};

__device__ __forceinline__ XcdBarrier xcd_barrier_post(unsigned* bar, volatile LAS unsigned* st) {
    XcdBarrier b; b.bar = bar; b.x = xb_xcc_id(); b.st = st;
    if (threadIdx.x == 0) (void)xb_add(&bar[XB_XCNT(b.x)], 1u);
    return b;
}
__device__ __forceinline__ void xcd_barrier_complete(unsigned* bar, unsigned x, unsigned& nloc, unsigned& nx) {
    const unsigned G = gridDim.x * gridDim.y * gridDim.z;
    unsigned sum, cnt, mine, sp = 0u;
    for (;;) {
        sum = 0u; cnt = 0u; mine = 0u;
#pragma unroll
        for (unsigned j = 0; j < 16; ++j) { const unsigned c = xb_ld(&bar[XB_XCNT(j)]); sum += c; cnt += (c > 0u) ? 1u : 0u; mine = (j == x) ? c : mine; }
        if (sum == G) break;
        __builtin_amdgcn_s_sleep(1);
        if ((++sp & 255u) == 0u) { if (xb_ld(&bar[XB_TMO])) break; if (sp > XB_SPIN_CAP) { atomicAdd(&bar[XB_TMO], 1u); break; } }
    }
    nloc = mine > 0u ? mine : 1u; nx = cnt > 0u ? cnt : 1u;
}

__device__ __forceinline__ void xcd_barrier(const XcdBarrier& b) {
    asm volatile("s_waitcnt vmcnt(0)" ::: "memory");
    __syncthreads();
    if (threadIdx.x == 0) {
        unsigned* bar = b.bar;
        __builtin_amdgcn_s_waitcnt(0);
        unsigned nloc = b.st[0], nx = b.st[1];
        if (nloc == 0u) { xcd_barrier_complete(bar, b.x, nloc, nx); b.st[0] = nloc; b.st[1] = nx; }
        const unsigned old = xb_add(&bar[XB_XSUB(b.x)], 1u);
        const unsigned gen = old / nloc;
        if (old + 1u == (gen + 1u) * nloc) {
            __builtin_amdgcn_fence(__ATOMIC_RELEASE, "agent");
            asm volatile("s_waitcnt vmcnt(0)" ::: "memory");
            const unsigned og = xb_add(&bar[XB_TOP], 1u);
            const unsigned tg = og / nx;
            if (og + 1u == (tg + 1u) * nx) xb_add(&bar[XB_TOPGEN], 1u);
            else XB_SPIN(xb_ld(&bar[XB_TOPGEN]) == tg, bar);
            __builtin_amdgcn_fence(__ATOMIC_ACQUIRE, "agent");
            xb_add(&bar[XB_XGEN(b.x)], 1u);
            asm volatile("s_waitcnt vmcnt(0)" ::: "memory");
        } else {
            XB_SPIN(xb_ld(&bar[XB_XGEN(b.x)]) == gen, bar);
            __builtin_amdgcn_fence(__ATOMIC_ACQUIRE, "agent");
            asm volatile("s_waitcnt vmcnt(0)" ::: "memory");
        }
    }
    __syncthreads();
}


namespace cg = cooperative_groups;
#ifndef REP_MASK
#define REP_MASK 0
#endif
#define REPS(k) (((REP_MASK) >> (k)) & 1 ? 2 : 1)
constexpr int PHASE_LDS = att::A_LDS_BYTES;
constexpr int MEGA_LDS = PHASE_LDS + 64;
static_assert(PHASE_LDS >= pg8::STAGE_BYTES && PHASE_LDS >= att::B_LDS_BYTES && PHASE_LDS >= peer::T_LDS_BYTES && PHASE_LDS >= 8 * 64 * 33 * 4 && PHASE_LDS >= apply::AP_LDS_BYTES, "LDS budget");
__global__ void __launch_bounds__(512, 2) mega_fwd(Ptrs P) {
    extern __shared__ __attribute__((aligned(16))) unsigned char lds_dyn[];
    volatile LAS unsigned* bst = (volatile LAS unsigned*)((LAS unsigned char*)lds_dyn + PHASE_LDS);
    if (threadIdx.x < 2) bst[threadIdx.x] = 0u;
    __syncthreads();
    const XcdBarrier bar = xcd_barrier_post((unsigned*)(P.ws + WS_CTL), bst);
    const int G = (int)gridDim.x, bx = (int)blockIdx.x, vcu = (G % 8 == 0) ? (bx % 8) * (G / 8) + bx / 8 : bx;
    unsigned char* ws = P.ws;
    PG8_LAS unsigned char* lds3 = (PG8_LAS unsigned char*)lds_dyn;
    for (int rep = 0; rep < REPS(0); ++rep) prep_phase(P, lds_dyn, G, bx);
    xcd_barrier(bar); if (REPS(9) == 2) xcd_barrier(bar);
    for (int rep = 0; rep < REPS(1); ++rep) {
      { pg8::Gemm g{(const bf16_t*)(ws + WS_XN), (const bf16_t*)(ws + WS_WIN), M, 1024, D, 0}; pg8::StaticOrder S; S.init(M, 1024, G, bx);
        pg8::gemm_phase<pg8::EpiProj, pg8::StaticOrder, true, true, false>(lds3, g, S, pg8::EpiProj{(bf16_t*)(ws + WS_PROJ), (const float*)(ws + WS_ROPE), 1.f, 0}); }
      { pg8::Gemm g{(const bf16_t*)(ws + WS_XN8), (const bf16_t*)(ws + WS_WIN8), M, INW - 1024, D / 2, 0}; pg8::StaticOrder S; S.init(M, INW - 1024, G, bx);
        pg8::gemm_phase<pg8::EpiProj, pg8::StaticOrder, true, true, true>(lds3, g, S, pg8::EpiProj{(bf16_t*)(ws + WS_PROJ), (const float*)(ws + WS_ROPE), 1.f / WIN_SCALE, 4}); } }
    xcd_barrier(bar); if (REPS(9) == 2) xcd_barrier(bar);
    { const float lam = lambda_full(P);
      for (int rep = 0; rep < REPS(2); ++rep) for (int u = vcu; u < BATCH * 4 * 8; u += G) att::attn_a_unit(u >> 5, (u >> 3) & 3, u & 7, (const bf16_t*)(ws + WS_PROJ), (bf16_t*)(ws + WS_YA), P.subln, lam, lds_dyn);
      for (int rep = 0; rep < REPS(3); ++rep) for (int u = vcu; u < BATCH * 8 * 8; u += G) att::attn_b_unit(u >> 6, (u >> 3) & 7, u & 7, (const bf16_t*)(ws + WS_PROJ), (bf16_t*)(ws + WS_YA), P.rpb, lds_dyn); }
    xcd_barrier(bar); if (REPS(9) == 2) xcd_barrier(bar);
    for (int rep = 0; rep < REPS(4); ++rep) { pg8::StaticOrder S; S.init(M, D, G, bx);
      pg8::gemm_phase<pg8::EpiGate2, pg8::StaticOrder, true, true>(lds3, pg8::Gemm{(const bf16_t*)(ws + WS_YA), (const bf16_t*)(ws + WS_WPA), M, D, D, 0}, S, pg8::EpiGate2{(const bf16_t*)(ws + WS_PROJ), (bf16_t*)(ws + WS_MERGED)}); }
    xcd_barrier(bar); if (REPS(9) == 2) xcd_barrier(bar);
    for (int rep = 0; rep < REPS(5); ++rep) { pg8::StaticOrder S; S.init(M, D, G, bx);
      pg8::gemm_phase<pg8::EpiHout, pg8::StaticOrder, true, true>(lds3, pg8::Gemm{(const bf16_t*)(ws + WS_MERGED), (const bf16_t*)(ws + WS_WOUT), M, D, D, 0}, S, pg8::EpiHout{P.x, P.out, (bf16_t*)(ws + WS_HB), (float*)(ws + WS_SSQ)});
      cvt_experts_phase(P, G, bx); }
    xcd_barrier(bar); if (REPS(9) == 2) xcd_barrier(bar);
    { pg8::StaticOrder S; S.init(M, PQ, G, bx);
      for (int rep = 0; rep < REPS(8); ++rep)
        pg8::gemm_phase<pg8::EpiQ, pg8::StaticOrder, true, true>(lds3, pg8::Gemm{(const bf16_t*)(ws + WS_HB), (const bf16_t*)(ws + WS_WQ), M, PQ, D, 0}, S, pg8::EpiQ{(const float*)(ws + WS_SSQ), (bf16_t*)(ws + WS_Q)});
      asm volatile("s_waitcnt vmcnt(0)" ::: "memory");
      __syncthreads();
      if (threadIdx.x == 0) { __builtin_amdgcn_fence(__ATOMIC_ACQUIRE, "agent"); asm volatile("s_waitcnt vmcnt(0)" ::: "memory"); }
      __syncthreads();
      for (int rep = 0; rep < REPS(6); ++rep) peer::topk_own_units(P, lds_dyn, S); }
    xcd_barrier(bar); if (REPS(9) == 2) xcd_barrier(bar);
#ifndef PROBE_MODE
#define PROBE_MODE 0
#endif
    if (REPS(7) == 2) apply::apply_phase<PROBE_MODE>(P, (float*)(ws + WS_Q), lds_dyn, G, vcu);
    apply::apply_phase<0>(P, P.out, lds_dyn, G, vcu);
}

extern "C" void kernel_launch(void* const* d_in, const int* in_sizes, int n_in, void* d_out, int out_size, void* d_ws, size_t ws_size, hipStream_t stream) {
    if (n_in != 18 || ws_size < WS_END) { fprintf(stderr, "kernel_launch: unexpected n_in %d / ws_size %zu\n", n_in, ws_size); return; }
    Ptrs P{};
    P.x = (const float*)d_in[0]; P.w_in = (const float*)d_in[1]; P.w_pa = (const float*)d_in[2]; P.w_pb = (const float*)d_in[3]; P.w_out = (const float*)d_in[4];
    P.norm_mix = (const float*)d_in[5]; P.norm_ffn = (const float*)d_in[6]; P.norm_final = (const float*)d_in[7];
    P.lq1 = (const float*)d_in[8]; P.lk1 = (const float*)d_in[9]; P.lq2 = (const float*)d_in[10]; P.lk2 = (const float*)d_in[11];
    P.subln = (const float*)d_in[12]; P.rpb = (const float*)d_in[13]; P.w_query = (const float*)d_in[14]; P.sub_keys = (const float*)d_in[15];
    P.peer_u = (const float*)d_in[16]; P.peer_v = (const float*)d_in[17];
    P.out = (float*)d_out; P.ws = (unsigned char*)d_ws;
    static int grid_blocks = 0;
    if (!grid_blocks) {
        int dev = 0, cus = 0, per_cu = 0;
        hipGetDevice(&dev);
        hipDeviceGetAttribute(&cus, hipDeviceAttributeMultiprocessorCount, dev);
        hipFuncSetAttribute((const void*)mega_fwd, hipFuncAttributeMaxDynamicSharedMemorySize, MEGA_LDS);
        hipOccupancyMaxActiveBlocksPerMultiprocessor(&per_cu, (const void*)mega_fwd, 512, MEGA_LDS);
        if (per_cu < 1) { fprintf(stderr, "kernel_launch: occupancy query says %d blocks per CU\n", per_cu); per_cu = 1; }
        grid_blocks = cus * per_cu;
    }
    hipMemsetAsync((unsigned char*)d_ws + WS_CTL, 0, 16384, stream);
    void* args[] = {&P};
    hipError_t e = hipLaunchCooperativeKernel((const void*)mega_fwd, dim3(grid_blocks), dim3(512), args, MEGA_LDS, stream);
    if (e != hipSuccess) fprintf(stderr, "cooperative launch failed: %s (grid %d)\n", hipGetErrorString(e), grid_blocks);
}
```

```cpp
#include <hip/hip_runtime.h>
#include <hip/hip_cooperative_groups.h>
#include <cstdio>
#include <cstdint>

typedef unsigned short bf16_t;
typedef unsigned u32x4 __attribute__((ext_vector_type(4)));
typedef unsigned u32x2 __attribute__((ext_vector_type(2)));
typedef float f32x4 __attribute__((ext_vector_type(4)));
typedef __bf16 bf16x2_t __attribute__((ext_vector_type(2)));

constexpr int D = 1024, BATCH = 8, SEQ = 2048, M = BATCH * SEQ, INW = 5120;
constexpr int C_QA = 0, C_KA = 512, C_VA = 1024, C_QB = 1536, C_KB = 2048, C_VB = 2560, C_GA = 3072, C_GB = 4096;
constexpr int NEXP = 16384, PQ = 2048;
constexpr float EPS = 1e-6f;
constexpr float LOG2E = 1.4426950408889634f;
constexpr float WIN_SCALE = 32.f;
constexpr float QSCALE = 0.125f * LOG2E;

constexpr size_t MiB = 1u << 20;
constexpr size_t WS_PROJ = 0;
constexpr size_t WS_HB = 0;
constexpr size_t WS_Q = 32 * MiB;
constexpr size_t WS_U = 96 * MiB;
constexpr size_t WS_V = 112 * MiB;
constexpr size_t WS_SU = 128 * MiB;
constexpr size_t WS_SV = 128 * MiB + 65536;
constexpr size_t WS_XN = 160 * MiB;
constexpr size_t WS_YA = 160 * MiB;
constexpr size_t WS_YB = 176 * MiB;
constexpr size_t WS_IDX = 160 * MiB;
constexpr size_t WS_G = 168 * MiB;
constexpr size_t WS_MERGED = 192 * MiB;
constexpr size_t WS_TOPV = 192 * MiB;
constexpr size_t WS_TOPI = 208 * MiB;
constexpr size_t WS_WIN = 224 * MiB;
constexpr size_t WS_WIN8 = 226 * MiB;
constexpr size_t WS_XN8 = 192 * MiB;
constexpr size_t WS_WQ = 234 * MiB;
constexpr size_t WS_WOUT = 238 * MiB;
constexpr size_t WS_WPA = 240 * MiB;
constexpr size_t WS_WPB = 241 * MiB;
constexpr size_t WS_SK = 242 * MiB;
constexpr size_t WS_ROPE = 242 * MiB + 512 * 1024;
constexpr size_t WS_SSQ = 243 * MiB;
constexpr size_t WS_CTL = 244 * MiB;
constexpr size_t WS_END = 256 * MiB;

__device__ __forceinline__ float bf2f(unsigned v) { return __uint_as_float(v << 16); }
__device__ __forceinline__ float bflo(unsigned w) { return __uint_as_float(w << 16); }
__device__ __forceinline__ float bfhi(unsigned w) { return __uint_as_float(w & 0xffff0000u); }
__device__ __forceinline__ unsigned f2bf(float f) { unsigned u = __float_as_uint(f); return (u + 0x7fffu + ((u >> 16) & 1u)) >> 16; }
__device__ __forceinline__ unsigned pk2(float lo, float hi) { return f2bf(lo) | (f2bf(hi) << 16); }
__device__ __forceinline__ float wave_sum(float v) {
#pragma unroll
    for (int o = 1; o < 64; o <<= 1) v += __shfl_xor(v, o);
    return v;
}
__device__ __forceinline__ float sigmoidf_(float x) { return 1.f / (1.f + __expf(-x)); }
__device__ __forceinline__ float gelu_exact(float x) { return 0.5f * x * (1.f + erff(x * 0.70710678118654752f)); }

struct Ptrs {
    const float *x, *w_in, *w_pa, *w_pb, *w_out, *norm_mix, *norm_ffn, *norm_final, *lq1, *lk1, *lq2, *lk2, *subln, *rpb, *w_query, *sub_keys, *peer_u, *peer_v;
    float* out; unsigned char* ws;
};

__device__ __forceinline__ void transpose_item(const float* W, int K, int N, const float* gain, bf16_t* WT, float* scr, int item, int lane, int ldo = 0, int koff = 0, int ldw = 0) {
    if (ldo == 0) ldo = K;
    if (ldw == 0) ldw = N;
    const int nblk = N / 32, kb = item / nblk, nb = item % nblk, k0 = 64 * kb, n0 = 32 * nb;
    float wv[32];
#pragma unroll
    for (int i = 0; i < 32; ++i) { const int kk = 2 * i + (lane >> 5); wv[i] = W[(size_t)(k0 + kk) * ldw + n0 + (lane & 31)]; }
#pragma unroll
    for (int i = 0; i < 32; ++i) { const int kk = 2 * i + (lane >> 5); float w = wv[i]; if (gain) w *= gain[k0 + kk]; scr[kk * 33 + (lane & 31)] = w; }
    asm volatile("s_waitcnt lgkmcnt(0)" ::: "memory");
    const int c = lane & 7;
#pragma unroll
    for (int j = 0; j < 4; ++j) { const int n = (lane >> 3) + 8 * j; const float* s = scr + (8 * c) * 33 + n;
        u32x4 o; o.x = pk2(s[0 * 33], s[1 * 33]); o.y = pk2(s[2 * 33], s[3 * 33]); o.z = pk2(s[4 * 33], s[5 * 33]); o.w = pk2(s[6 * 33], s[7 * 33]);
        *(u32x4*)(WT + (size_t)(n0 + n) * ldo + koff + k0 + 8 * c) = o; }
    asm volatile("s_waitcnt lgkmcnt(0)" ::: "memory");
}
__device__ __forceinline__ void cvt8(const float* src, bf16_t* dst, size_t i8) {
    const f32x4 a = *(const f32x4*)(src + i8 * 8), b = *(const f32x4*)(src + i8 * 8 + 4);
    u32x4 o; o.x = pk2(a.x, a.y); o.y = pk2(a.z, a.w); o.z = pk2(b.x, b.y); o.w = pk2(b.z, b.w);
    *(u32x4*)(dst + i8 * 8) = o;
}
__device__ __forceinline__ void transpose_item8(const float* W, int K, int N, int ldw, const float* gain, float wscale, unsigned char* WT, float* scr, int item, int lane) {
    const int nblk = N / 32, kb = item / nblk, nb = item % nblk, k0 = 64 * kb, n0 = 32 * nb;
    float wv[32];
#pragma unroll
    for (int i = 0; i < 32; ++i) { const int kk = 2 * i + (lane >> 5); wv[i] = W[(size_t)(k0 + kk) * ldw + n0 + (lane & 31)]; }
#pragma unroll
    for (int i = 0; i < 32; ++i) { const int kk = 2 * i + (lane >> 5); float w = wv[i] * wscale; if (gain) w *= gain[k0 + kk]; scr[kk * 33 + (lane & 31)] = w; }
    asm volatile("s_waitcnt lgkmcnt(0)" ::: "memory");
    const int c = lane & 7;
#pragma unroll
    for (int j = 0; j < 4; ++j) { const int n = (lane >> 3) + 8 * j; const float* s = scr + (8 * c) * 33 + n;
        u32x2 o; o.x = __builtin_amdgcn_cvt_pk_fp8_f32(s[0 * 33], s[1 * 33], 0u, false); o.x = __builtin_amdgcn_cvt_pk_fp8_f32(s[2 * 33], s[3 * 33], o.x, true);
        o.y = __builtin_amdgcn_cvt_pk_fp8_f32(s[4 * 33], s[5 * 33], 0u, false); o.y = __builtin_amdgcn_cvt_pk_fp8_f32(s[6 * 33], s[7 * 33], o.y, true);
        *(u32x2*)(WT + (size_t)(n0 + n) * K + k0 + 8 * c) = o; }
    asm volatile("s_waitcnt lgkmcnt(0)" ::: "memory");
}
__device__ __forceinline__ void rms_rows_emit(const f32x4 (&v)[4], bf16_t* orow16, unsigned char* orow, int lane) {
    float s = 0.f;
#pragma unroll
    for (int j = 0; j < 4; ++j) s += (v[j].x * v[j].x + v[j].y * v[j].y) + (v[j].z * v[j].z + v[j].w * v[j].w);
    const float rstd = 1.f / sqrtf(wave_sum(s) * (1.f / D) + EPS);
    unsigned* o4 = (unsigned*)orow + lane; u32x2* o8 = (u32x2*)orow16 + lane;
#pragma unroll
    for (int j = 0; j < 4; ++j) { unsigned w = __builtin_amdgcn_cvt_pk_fp8_f32(v[j].x * rstd, v[j].y * rstd, 0u, false); w = __builtin_amdgcn_cvt_pk_fp8_f32(v[j].z * rstd, v[j].w * rstd, w, true); o4[64 * j] = w;
        u32x2 w2; w2.x = pk2(v[j].x * rstd, v[j].y * rstd); w2.y = pk2(v[j].z * rstd, v[j].w * rstd); o8[64 * j] = w2; }
}
__device__ __forceinline__ void rms_rows(const float* x, bf16_t* xn16, unsigned char* xn8, int m0, int step, int lane) {
    if (m0 >= M) return;
    f32x4 cur[4], nxt[4];
#pragma unroll
    for (int j = 0; j < 4; ++j) cur[j] = ((const f32x4*)(x + (size_t)m0 * D) + lane)[64 * j];
    for (int m = m0; m < M; m += step) {
        const int mn = (m + step < M) ? m + step : m;
#pragma unroll
        for (int j = 0; j < 4; ++j) nxt[j] = ((const f32x4*)(x + (size_t)mn * D) + lane)[64 * j];
        rms_rows_emit(cur, xn16 + (size_t)m * D, xn8 + (size_t)m * D, lane);
#pragma unroll
        for (int j = 0; j < 4; ++j) cur[j] = nxt[j];
    }
}
__device__ __forceinline__ void rms_row_to_bf16(const float* xrow, bf16_t* orow, int lane) {
    const f32x4* xr = (const f32x4*)xrow + lane;
    f32x4 v[4]; float s = 0.f;
#pragma unroll
    for (int j = 0; j < 4; ++j) { v[j] = xr[64 * j]; s += (v[j].x * v[j].x + v[j].y * v[j].y) + (v[j].z * v[j].z + v[j].w * v[j].w); }
    const float rstd = 1.f / sqrtf(wave_sum(s) * (1.f / D) + EPS);
    u32x2* o8 = (u32x2*)orow + lane;
#pragma unroll
    for (int j = 0; j < 4; ++j) { u32x2 w; w.x = pk2(v[j].x * rstd, v[j].y * rstd); w.y = pk2(v[j].z * rstd, v[j].w * rstd); o8[64 * j] = w; }
}

__device__ __forceinline__ void prep_phase(const Ptrs& P, unsigned char* shm, int G, int bx) {
    int tid_l = threadIdx.x; asm volatile("" : "+v"(tid_l));
    const int lane = tid_l & 63; const int wave = __builtin_amdgcn_readfirstlane(tid_l >> 6);
    const int gw = bx * 8 + wave, NGW = G * 8;
    float* scr = (float*)(shm + wave * (64 * 33 * 4));
    unsigned char* ws = P.ws;
    constexpr int N_BF = 1024;
    constexpr int I_INB = (D / 64) * (N_BF / 32), I_IN8 = (D / 64) * ((INW - N_BF) / 32), I_IN = I_INB + I_IN8, I_Q = (D / 64) * (PQ / 32), I_OUT = (D / 64) * (D / 32), I_PA = (512 / 64) * (D / 32);
    constexpr int NIT = I_IN + I_Q + I_OUT + 2 * I_PA;
    for (int it = gw; it < NIT; it += NGW) {
        int r = it;
        if (r < I_INB) { transpose_item(P.w_in, D, N_BF, P.norm_mix, (bf16_t*)(ws + WS_WIN), scr, r, lane, 0, 0, INW); continue; } r -= I_INB;
        if (r < I_IN8) { transpose_item8(P.w_in + N_BF, D, INW - N_BF, INW, P.norm_mix, WIN_SCALE, ws + WS_WIN8, scr, r, lane); continue; } r -= I_IN8;
        if (r < I_Q) { transpose_item(P.w_query, D, PQ, P.norm_ffn, (bf16_t*)(ws + WS_WQ), scr, r, lane); continue; } r -= I_Q;
        if (r < I_OUT) { transpose_item(P.w_out, D, D, nullptr, (bf16_t*)(ws + WS_WOUT), scr, r, lane); continue; } r -= I_OUT;
        if (r < I_PA) { transpose_item(P.w_pa, 512, D, nullptr, (bf16_t*)(ws + WS_WPA), scr, r, lane, 1024, 0); continue; } r -= I_PA;
        transpose_item(P.w_pb, 512, D, nullptr, (bf16_t*)(ws + WS_WPA), scr, r, lane, 1024, 512);
    }
    rms_rows(P.x, (bf16_t*)(ws + WS_XN), ws + WS_XN8, gw, NGW, lane);
    const size_t gt = (size_t)bx * 512 + threadIdx.x, NT = (size_t)G * 512;
    for (size_t i = gt; i < (size_t)16 * 128 * 128 / 8; i += NT) cvt8(P.sub_keys, (bf16_t*)(ws + WS_SK), i);
    for (size_t i = gt; i < (size_t)SEQ * 8; i += NT) {
        const int pos = (int)(i >> 3), k = (int)(i & 7);
        const float inv = k == 0 ? 1.0f : k == 1 ? 0.19392274f : k == 2 ? 0.03760603f : k == 3 ? 0.0072926646f : k == 4 ? 0.0014142136f : k == 5 ? 0.0002742482f : k == 6 ? 5.3182957e-05f : 1.0313385e-05f;
        const float ang = (float)pos * inv;
        float sn, cs; sincosf(ang, &sn, &cs);
        float* t = (float*)(ws + WS_ROPE) + (size_t)pos * 16;
        t[k] = cs; t[8 + k] = sn;
    }
}
__device__ __forceinline__ void cvt_row_fp8(const f32x4 (&rv)[4], unsigned char* dst, float* inv_scale, int lane) {
    const f32x4 a = rv[0], b = rv[1], c = rv[2], d = rv[3];
    float m = fmaxf(fmaxf(fmaxf(fabsf(a.x), fabsf(a.y)), fmaxf(fabsf(a.z), fabsf(a.w))), fmaxf(fmaxf(fabsf(b.x), fabsf(b.y)), fmaxf(fabsf(b.z), fabsf(b.w))));
    m = fmaxf(m, fmaxf(fmaxf(fmaxf(fabsf(c.x), fabsf(c.y)), fmaxf(fabsf(c.z), fabsf(c.w))), fmaxf(fmaxf(fabsf(d.x), fabsf(d.y)), fmaxf(fabsf(d.z), fabsf(d.w)))));
#pragma unroll
    for (int o = 1; o < 64; o <<= 1) m = fmaxf(m, __shfl_xor(m, o));
    m = fmaxf(m, 1e-30f);
    const float sc = 256.f / m;
    u32x4 w;
    w.x = __builtin_amdgcn_cvt_pk_fp8_f32(a.x * sc, a.y * sc, 0u, false); w.x = __builtin_amdgcn_cvt_pk_fp8_f32(a.z * sc, a.w * sc, w.x, true);
    w.y = __builtin_amdgcn_cvt_pk_fp8_f32(b.x * sc, b.y * sc, 0u, false); w.y = __builtin_amdgcn_cvt_pk_fp8_f32(b.z * sc, b.w * sc, w.y, true);
    w.z = __builtin_amdgcn_cvt_pk_fp8_f32(c.x * sc, c.y * sc, 0u, false); w.z = __builtin_amdgcn_cvt_pk_fp8_f32(c.z * sc, c.w * sc, w.z, true);
    w.w = __builtin_amdgcn_cvt_pk_fp8_f32(d.x * sc, d.y * sc, 0u, false); w.w = __builtin_amdgcn_cvt_pk_fp8_f32(d.z * sc, d.w * sc, w.w, true);
    *(u32x4*)(dst + (size_t)(lane >> 5) * (NEXP * 512) + (lane & 31) * 16) = w;
    if (lane == 0) *inv_scale = m * (1.f / 256.f);
}
__device__ __forceinline__ unsigned pack_i8x4(float a, float b, float c, float d) {
    const int q0 = (int)rintf(a), q1 = (int)rintf(b), q2 = (int)rintf(c), q3 = (int)rintf(d);
    return (unsigned)(q0 & 0xff) | ((unsigned)(q1 & 0xff) << 8) | ((unsigned)(q2 & 0xff) << 16) | ((unsigned)q3 << 24);
}
__device__ __forceinline__ void cvt_row_i8(const f32x4 (&rv)[4], unsigned char* dst, float* inv_scale, int lane) {
    const f32x4 a = rv[0], b = rv[1], c = rv[2], d = rv[3];
    float m = fmaxf(fmaxf(fmaxf(fabsf(a.x), fabsf(a.y)), fmaxf(fabsf(a.z), fabsf(a.w))), fmaxf(fmaxf(fabsf(b.x), fabsf(b.y)), fmaxf(fabsf(b.z), fabsf(b.w))));
    m = fmaxf(m, fmaxf(fmaxf(fmaxf(fabsf(c.x), fabsf(c.y)), fmaxf(fabsf(c.z), fabsf(c.w))), fmaxf(fmaxf(fabsf(d.x), fabsf(d.y)), fmaxf(fabsf(d.z), fabsf(d.w)))));
#pragma unroll
    for (int o = 1; o < 64; o <<= 1) m = fmaxf(m, __shfl_xor(m, o));
    m = fmaxf(m, 1e-30f);
    const float sc = 127.f / m;
    u32x4 w;
    w.x = pack_i8x4(a.x * sc, a.y * sc, a.z * sc, a.w * sc); w.y = pack_i8x4(b.x * sc, b.y * sc, b.z * sc, b.w * sc);
    w.z = pack_i8x4(c.x * sc, c.y * sc, c.z * sc, c.w * sc); w.w = pack_i8x4(d.x * sc, d.y * sc, d.z * sc, d.w * sc);
    *(u32x4*)(dst + (size_t)(lane >> 5) * (NEXP * 512) + (lane & 31) * 16) = w;
    if (lane == 0) *inv_scale = m * (1.f / 127.f);
}
__device__ __forceinline__ void cvt_experts_phase(const Ptrs& P, int G, int bx) {
    int tid_l = threadIdx.x; asm volatile("" : "+v"(tid_l));
    const int lane = tid_l & 63; const int wave = __builtin_amdgcn_readfirstlane(tid_l >> 6);
    const int step = G * 8; int r = bx * 8 + wave;
    if (r >= 2 * NEXP) return;
    f32x4 cur[4], nxt[4];
    { const float* src = (r < NEXP ? P.peer_u + (size_t)r * D : P.peer_v + (size_t)(r - NEXP) * D);
#pragma unroll
      for (int j = 0; j < 4; ++j) cur[j] = ((const f32x4*)src + lane * 4)[j]; }
    for (; r < 2 * NEXP; r += step) {
        const int rn = (r + step < 2 * NEXP) ? r + step : r;
        const float* srcn = (rn < NEXP ? P.peer_u + (size_t)rn * D : P.peer_v + (size_t)(rn - NEXP) * D);
#pragma unroll
        for (int j = 0; j < 4; ++j) nxt[j] = ((const f32x4*)srcn + lane * 4)[j];
        if (r < NEXP) cvt_row_i8(cur, P.ws + WS_U + (size_t)r * 512, (float*)(P.ws + WS_SU) + r, lane);
        else { const int e = r - NEXP; cvt_row_fp8(cur, P.ws + WS_V + (size_t)e * 512, (float*)(P.ws + WS_SV) + e, lane); }
#pragma unroll
        for (int j = 0; j < 4; ++j) cur[j] = nxt[j];
    }
}

namespace pg8 {
#define PG8_LAS __attribute__((address_space(3)))
typedef unsigned short bf16_t;
typedef short bf16x8 __attribute__((ext_vector_type(8)));
typedef float f32x4 __attribute__((ext_vector_type(4)));
typedef unsigned u32x4 __attribute__((ext_vector_type(4)));
typedef int v8i_t __attribute__((ext_vector_type(8)));
constexpr int BM = 256, BK = 64, HALF = 128, HTB = HALF * BK * 2  , STAGE_BYTES = 8 * HTB, NXCD = 8, WGM = 4;

__host__ __device__ __forceinline__ int lds_byte(int r, int c) { const int st = (r >> 4) * 2 + (c >> 5), rr = r & 15, cc = c & 31, ob = rr * 64 + cc * 2; return st * 1024 + (ob ^ (((ob >> 9) & 1) << 5)); }
__host__ __device__ __forceinline__ void stage_rc(int b, int& R, int& C) { const int st = b / 1024, sb = b % 1024, swz = sb ^ (((sb >> 9) & 1) << 5); R = (st >> 1) * 16 + swz / 64; C = (st & 1) * 32 + (swz % 64) / 2; }
__host__ __device__ __forceinline__ int perm32(int rho) { const int n = rho >> 4, i = rho & 15; return 8 * (i >> 2) + 4 * n + (i & 3); }

struct Unit { int pm, pn; };
struct Gemm { const bf16_t* A; const bf16_t* Bt; int M, N, K, pad; };

struct StaticOrder {
    int nM, nN, nwg, G, c;
    __host__ __device__ void init(int M, int N, int G_, int c_) { nM = M / BM; nN = N / BM; nwg = nM * nN; G = G_; c = c_; }
    __host__ __device__ bool next(int i, Unit& u) const {
        const long L = (long)i * G + c; if (L >= nwg) return false;
        int wgid = (int)L; { const int q = nwg / NXCD, r = nwg % NXCD, xcd = wgid % NXCD, off = wgid / NXCD; wgid = (xcd < r ? xcd * (q + 1) : r * (q + 1) + (xcd - r) * q) + off; }
        const int nig = WGM * nN, gid = wgid / nig, fm = gid * WGM, gsz = (nM - fm) < WGM ? (nM - fm) : WGM;
        u.pm = fm + ((wgid % nig) % gsz); u.pn = (wgid % nig) / gsz; return true;
    }
    __device__ __forceinline__ void a_ready(const Unit&) const {}
    __device__ __forceinline__ void done(const Unit&) const {}
};
__device__ __forceinline__ unsigned cvt_pk_bf16(float lo, float hi) { unsigned r; asm volatile("v_cvt_pk_bf16_f32 %0, %1, %2" : "=v"(r) : "v"(lo), "v"(hi)); return r; }
typedef float f32x2 __attribute__((ext_vector_type(2)));

__device__ __forceinline__ float sigm(float x) { return __builtin_amdgcn_rcpf(1.f + __builtin_amdgcn_exp2f(-1.4426950408889634f * x)); }
struct EpiProj {
    static constexpr bool PERM = true, AFTER_DRAIN = false, MID = false;
    bf16_t* O; const float* rope; float osc; int pn0;
    __device__ __forceinline__ void operator()(const f32x4 (&acc)[2][2][4][2], const Unit& u, int wr, int wc, int fr_, int fq_) const {
        int fr = fr_, fq = fq_; asm volatile("" : "+v"(fr), "+v"(fq));
        const int pn = u.pn + pn0;
        const int row0 = u.pm * BM + wr * 64 + fr, col0 = pn * BM + wc * 32 + 8 * fq;
        const float sc = ((pn < 2 || pn == 6 || pn == 7) ? QSCALE : 1.f) * osc;
        const bool dorope = (pn < 4) && ((wc & 1) == 0);
#pragma unroll
        for (int ai = 0; ai < 2; ++ai)
#pragma unroll
            for (int m = 0; m < 4; ++m) { const int row = row0 + ai * HALF + m * 16; bf16_t* rowp = O + (size_t)row * INW + col0;
                f32x4 c4[2] = {{1.f, 1.f, 1.f, 1.f}, {1.f, 1.f, 1.f, 1.f}}, s4[2] = {{0.f, 0.f, 0.f, 0.f}, {0.f, 0.f, 0.f, 0.f}};
                if (dorope) { const float* rp = rope + (size_t)(row & (SEQ - 1)) * 16; c4[0] = *(const f32x4*)(rp); c4[1] = *(const f32x4*)(rp + 4); s4[0] = *(const f32x4*)(rp + 8); s4[1] = *(const f32x4*)(rp + 12); }
#pragma unroll
                for (int bj = 0; bj < 2; ++bj) { f32x4 v0 = acc[ai][bj][m][0], v1 = acc[ai][bj][m][1];
                    if (dorope) { f32x4 o0, o1;
#pragma unroll
                        for (int j = 0; j < 4; ++j) { o0[j] = __shfl_xor(v0[j], 16); o1[j] = __shfl_xor(v1[j], 16); }
                        if (fq == 0) { v0 = v0 * c4[0] - o0 * s4[0]; v1 = v1 * c4[1] - o1 * s4[1]; }
                        else if (fq == 1) { v0 = v0 * c4[0] + o0 * s4[0]; v1 = v1 * c4[1] + o1 * s4[1]; } }
                    v0 = v0 * sc; v1 = v1 * sc; u32x4 w; w.x = cvt_pk_bf16(v0[0], v0[1]); w.y = cvt_pk_bf16(v0[2], v0[3]); w.z = cvt_pk_bf16(v1[0], v1[1]); w.w = cvt_pk_bf16(v1[2], v1[3]);
                    *(u32x4*)(rowp + bj * HALF) = w; } }
    }
};
struct EpiGate2 {
    static constexpr bool PERM = true, AFTER_DRAIN = false, MID = true;
    const bf16_t* proj; bf16_t* O;
    __device__ __forceinline__ void mid(f32x4 (&acc)[2][2][4][2], const Unit& u, int wr, int wc, int fr, int fq) const {
        int row0 = u.pm * BM + wr * 64 + fr, col0 = u.pn * BM + wc * 32 + 8 * fq;
        asm volatile("" : "+v"(row0), "+v"(col0));
#pragma unroll
        for (int ai = 0; ai < 2; ++ai) {
            u32x4 gav[4][2], gbv[4][2];
#pragma unroll
            for (int m = 0; m < 4; ++m)
#pragma unroll
                for (int bj = 0; bj < 2; ++bj) { const bf16_t* gp = proj + (size_t)(row0 + ai * HALF + m * 16) * INW + col0 + bj * HALF; gav[m][bj] = *(const u32x4*)(gp + C_GA); gbv[m][bj] = *(const u32x4*)(gp + C_GB); }
#pragma unroll
            for (int m = 0; m < 4; ++m) {
#pragma unroll
                for (int bj = 0; bj < 2; ++bj) { const u32x4 ga = gav[m][bj], gb = gbv[m][bj];
                    const unsigned a_[4] = {ga.x, ga.y, ga.z, ga.w}, b_[4] = {gb.x, gb.y, gb.z, gb.w};
#pragma unroll
                    for (int q = 0; q < 4; ++q) {
                        const float r0 = (1.f + __builtin_amdgcn_exp2f(-1.4426950408889634f * bflo(b_[q]))) * __builtin_amdgcn_rcpf(1.f + __builtin_amdgcn_exp2f(-1.4426950408889634f * bflo(a_[q])));
                        const float r1 = (1.f + __builtin_amdgcn_exp2f(-1.4426950408889634f * bfhi(b_[q]))) * __builtin_amdgcn_rcpf(1.f + __builtin_amdgcn_exp2f(-1.4426950408889634f * bfhi(a_[q])));
                        acc[ai][bj][m][q >> 1][(q & 1) * 2] *= r0; acc[ai][bj][m][q >> 1][(q & 1) * 2 + 1] *= r1; } } }
            asm volatile("" ::: "memory"); }
    }
    __device__ __forceinline__ void operator()(const f32x4 (&acc)[2][2][4][2], const Unit& u, int wr, int wc, int fr_, int fq_) const {
        int fr = fr_, fq = fq_; asm volatile("" : "+v"(fr), "+v"(fq));
        const int row0 = u.pm * BM + wr * 64 + fr, col0 = u.pn * BM + wc * 32 + 8 * fq;
#pragma unroll
        for (int ai = 0; ai < 2; ++ai) {
            u32x4 gv[4][2];
#pragma unroll
            for (int m = 0; m < 4; ++m)
#pragma unroll
                for (int bj = 0; bj < 2; ++bj) gv[m][bj] = *(const u32x4*)(proj + (size_t)(row0 + ai * HALF + m * 16) * INW + C_GB + col0 + bj * HALF);
#pragma unroll
            for (int m = 0; m < 4; ++m) { const int row = row0 + ai * HALF + m * 16;
#pragma unroll
                for (int bj = 0; bj < 2; ++bj) { const int col = col0 + bj * HALF; const u32x4 g = gv[m][bj];
                    f32x4 v0 = acc[ai][bj][m][0], v1 = acc[ai][bj][m][1];
                    v0[0] *= sigm(bflo(g.x)); v0[1] *= sigm(bfhi(g.x)); v0[2] *= sigm(bflo(g.y)); v0[3] *= sigm(bfhi(g.y));
                    v1[0] *= sigm(bflo(g.z)); v1[1] *= sigm(bfhi(g.z)); v1[2] *= sigm(bflo(g.w)); v1[3] *= sigm(bfhi(g.w));
                    u32x4 w; w.x = cvt_pk_bf16(v0[0], v0[1]); w.y = cvt_pk_bf16(v0[2], v0[3]); w.z = cvt_pk_bf16(v1[0], v1[1]); w.w = cvt_pk_bf16(v1[2], v1[3]);
                    *(u32x4*)(O + (size_t)row * D + col) = w; } }
            asm volatile("" ::: "memory"); }
    }
};
struct EpiHout {
    static constexpr bool PERM = true, AFTER_DRAIN = false, MID = false;
    const float* x; float* H; bf16_t* HB; float* ssq16;
    __device__ __forceinline__ void operator()(const f32x4 (&acc)[2][2][4][2], const Unit& u, int wr, int wc, int fr_, int fq_) const {
        int fr = fr_, fq = fq_; asm volatile("" : "+v"(fr), "+v"(fq));
        const int row0 = u.pm * BM + wr * 64 + fr, col0 = u.pn * BM + wc * 32 + 8 * fq;
#pragma unroll
        for (int ai = 0; ai < 2; ++ai) {
            f32x4 xv[4][2][2];
#pragma unroll
            for (int m = 0; m < 4; ++m)
#pragma unroll
                for (int bj = 0; bj < 2; ++bj) { const float* xp = x + (size_t)(row0 + ai * HALF + m * 16) * D + col0 + bj * HALF; xv[m][bj][0] = *(const f32x4*)xp; xv[m][bj][1] = *(const f32x4*)(xp + 4); }
#pragma unroll
            for (int m = 0; m < 4; ++m) { const int row = row0 + ai * HALF + m * 16; float ss = 0.f;
#pragma unroll
                for (int bj = 0; bj < 2; ++bj) { const int col = col0 + bj * HALF;
                    const f32x4 v0 = acc[ai][bj][m][0] + xv[m][bj][0], v1 = acc[ai][bj][m][1] + xv[m][bj][1];
                    u32x4 w; w.x = cvt_pk_bf16(v0[0], v0[1]); w.y = cvt_pk_bf16(v0[2], v0[3]); w.z = cvt_pk_bf16(v1[0], v1[1]); w.w = cvt_pk_bf16(v1[2], v1[3]);
                    *(u32x4*)(HB + (size_t)row * D + col) = w;
                    ss += (v0[0] * v0[0] + v0[1] * v0[1]) + (v0[2] * v0[2] + v0[3] * v0[3]) + (v1[0] * v1[0] + v1[1] * v1[1]) + (v1[2] * v1[2] + v1[3] * v1[3]); }
                ss += __shfl_xor(ss, 16); ss += __shfl_xor(ss, 32);
                if (fq == 0) ssq16[(size_t)row * 16 + u.pn * 4 + wc] = ss; }
            asm volatile("" ::: "memory"); }
    }
};
struct EpiQ {
    static constexpr bool PERM = true, AFTER_DRAIN = false, MID = false;
    const float* ssq16; bf16_t* O;
    __device__ __forceinline__ void operator()(const f32x4 (&acc)[2][2][4][2], const Unit& u, int wr, int wc, int fr, int fq) const {
        const int row0 = u.pm * BM + wr * 64 + fr, col0 = u.pn * BM + wc * 32 + 8 * fq;
#pragma unroll
        for (int ai = 0; ai < 2; ++ai)
#pragma unroll
            for (int m = 0; m < 4; ++m) { const int row = row0 + ai * HALF + m * 16; const f32x4* sp = (const f32x4*)(ssq16 + (size_t)row * 16);
                const f32x4 a = sp[0], b = sp[1], c = sp[2], d = sp[3];
                const float tot = ((a[0] + a[1]) + (a[2] + a[3])) + ((b[0] + b[1]) + (b[2] + b[3])) + ((c[0] + c[1]) + (c[2] + c[3])) + ((d[0] + d[1]) + (d[2] + d[3]));
                const float rstd = 1.f / sqrtf(tot * (1.f / D) + EPS);
#pragma unroll
                for (int bj = 0; bj < 2; ++bj) { const f32x4 v0 = acc[ai][bj][m][0] * rstd, v1 = acc[ai][bj][m][1] * rstd;
                    u32x4 w; w.x = cvt_pk_bf16(v0[0], v0[1]); w.y = cvt_pk_bf16(v0[2], v0[3]); w.z = cvt_pk_bf16(v1[0], v1[1]); w.w = cvt_pk_bf16(v1[2], v1[3]);
                    *(u32x4*)(O + (size_t)row * PQ + col0 + bj * HALF) = w; } }
    }
};
template <class Epi, class Sched, bool ALIGN_EPI = false, bool SP2 = false, bool FP8 = false>
__device__ __forceinline__ void gemm_phase(PG8_LAS unsigned char* lds, const Gemm g, const Sched& S, const Epi& E) {
    int tid_l = threadIdx.x; asm volatile("" : "+v"(tid_l));
    const int tid = tid_l, wid = __builtin_amdgcn_readfirstlane(tid >> 6), lane = tid & 63, wr = wid >> 2, wc = wid & 3, fr = lane & 15, fq = lane >> 4;
    const int K = g.K, nt = K / BK;
    unsigned voffA[2], voffB[2];
#pragma unroll
    for (int i = 0; i < 2; ++i) { int R, C; stage_rc(tid * 16 + i * 8192, R, C); const int Rb = Epi::PERM ? ((R & ~31) + perm32(R & 31)) : R;
        voffA[i] = (unsigned)(R * K + C) * 2u; voffB[i] = (unsigned)(Rb * K + C) * 2u; }
    const size_t kstep = (size_t)(BK * 2);
    const size_t hstep = (size_t)HALF * K * 2;
    const size_t tstep = 2 * hstep;
    const unsigned ldsw = (unsigned)wid * 1024u;
    const int aoff = lds_byte(wr * 64 + fr, fq * 8), boff = lds_byte(wc * 32 + fr, fq * 8);
    const int aoffF0 = FP8 ? lds_byte(wr * 64 + fr, fq * 16) : 0, boffF0 = FP8 ? lds_byte(wc * 32 + fr, fq * 16) : 0;
#define PG8_SA(b, h) (((b) * 2 + (h)) * HTB)
#define PG8_SB(b, h) ((4 + (b) * 2 + (h)) * HTB)
#define PG8_STAGE(bufoff, gbase, voff) do { _Pragma("unroll") for (int _i = 0; _i < 2; ++_i) \
        __builtin_amdgcn_global_load_lds((const unsigned*)((const char*)(gbase) + (voff)[_i]), (PG8_LAS unsigned*)(lds + (bufoff) + ldsw + _i * 8192), 16, 0, 0); } while (0)
#define PG8_LDA(dst, b, h) do { if constexpr (FP8) { _Pragma("unroll") for (int m = 0; m < 4; ++m) { const u32x4 l_ = *(const PG8_LAS u32x4*)(lds + PG8_SA(b, h) + aoffF0 + m * 2048), h_ = *(const PG8_LAS u32x4*)(lds + PG8_SA(b, h) + aoffF0 + m * 2048 + 16); \
            dst##8[m] = (v8i_t){(int)l_.x, (int)l_.y, (int)l_.z, (int)l_.w, (int)h_.x, (int)h_.y, (int)h_.z, (int)h_.w}; } } \
        else { _Pragma("unroll") for (int m = 0; m < 4; ++m) _Pragma("unroll") for (int k = 0; k < 2; ++k) dst[m][k] = *(const PG8_LAS bf16x8*)(lds + PG8_SA(b, h) + aoff + m * 2048 + k * 1024); } } while (0)
#define PG8_LDB(dst, b, h) do { if constexpr (FP8) { _Pragma("unroll") for (int n = 0; n < 2; ++n) { const u32x4 l_ = *(const PG8_LAS u32x4*)(lds + PG8_SB(b, h) + boffF0 + n * 2048), h_ = *(const PG8_LAS u32x4*)(lds + PG8_SB(b, h) + boffF0 + n * 2048 + 16); \
            dst##8[n] = (v8i_t){(int)l_.x, (int)l_.y, (int)l_.z, (int)l_.w, (int)h_.x, (int)h_.y, (int)h_.z, (int)h_.w}; } } \
        else { _Pragma("unroll") for (int n = 0; n < 2; ++n) _Pragma("unroll") for (int k = 0; k < 2; ++k) dst[n][k] = *(const PG8_LAS bf16x8*)(lds + PG8_SB(b, h) + boff + n * 2048 + k * 1024); } } while (0)
#define PG8_MMA(ai, bj, At, Bt) do { __builtin_amdgcn_s_setprio(1); \
        if constexpr (FP8) { _Pragma("unroll") for (int m = 0; m < 4; ++m) _Pragma("unroll") for (int n = 0; n < 2; ++n) \
            asm volatile("v_mfma_scale_f32_16x16x128_f8f6f4 %0, %1, %2, %0, %3, %3 op_sel_hi:[0,0,0]" : "+v"(acc[ai][bj][m][n]) : "v"(Bt##8[n]), "v"(At##8[m]), "v"(mxone)); } \
        else { _Pragma("unroll") for (int m = 0; m < 4; ++m) _Pragma("unroll") for (int n = 0; n < 2; ++n) _Pragma("unroll") for (int k = 0; k < 2; ++k) \
            acc[ai][bj][m][n] = __builtin_amdgcn_mfma_f32_16x16x32_bf16(Bt[n][k], At[m][k], acc[ai][bj][m][n], 0, 0, 0); } \
        __builtin_amdgcn_s_setprio(0); } while (0)
#define PG8_WAIT_V(n) asm volatile("s_waitcnt vmcnt(" #n ")" ::: "memory")
#define PG8_WAIT_L(n) asm volatile("s_waitcnt lgkmcnt(" #n ")" ::: "memory")
#define PG8_BAR __builtin_amdgcn_s_barrier()
#define PG8_SCHED __builtin_amdgcn_sched_barrier(0)
    Unit cur, nxt; int ui = 0;
    if (!S.next(0, cur)) return;
    f32x4 acc[2][2][4][2];
#pragma unroll
    for (int a = 0; a < 2; ++a)
#pragma unroll
        for (int b = 0; b < 2; ++b)
#pragma unroll
            for (int m = 0; m < 4; ++m)
#pragma unroll
                for (int n = 0; n < 2; ++n) acc[a][b][m][n] = (f32x4){0.f, 0.f, 0.f, 0.f};
    bf16x8 At[4][2], B0[2][2], B1[2][2]; v8i_t At8[4], B08[2], B18[2];
    int mxone = 0x7F7F7F7F; asm volatile("" : "+v"(mxone));
    const char* cA = (const char*)g.A + (size_t)cur.pm * tstep; const char* cB = (const char*)g.Bt + (size_t)cur.pn * tstep;
    S.a_ready(cur);
    if constexpr (SP2) {
        PG8_STAGE(PG8_SB(0, 0), cB, voffB); PG8_STAGE(PG8_SB(0, 1), cB + hstep, voffB); PG8_STAGE(PG8_SA(0, 0), cA, voffA); PG8_STAGE(PG8_SA(0, 1), cA + hstep, voffA);
        if (wr == 1) PG8_BAR;
        PG8_WAIT_V(2); PG8_BAR;
        PG8_STAGE(PG8_SB(1, 0), cB + kstep, voffB); PG8_STAGE(PG8_SA(1, 0), cA + kstep, voffA); PG8_STAGE(PG8_SB(1, 1), cB + hstep + kstep, voffB);
        PG8_WAIT_V(6); PG8_BAR;
    } else {
        PG8_STAGE(PG8_SB(0, 0), cB, voffB); PG8_STAGE(PG8_SA(0, 0), cA, voffA); PG8_STAGE(PG8_SB(0, 1), cB + hstep, voffB); PG8_STAGE(PG8_SA(0, 1), cA + hstep, voffA);
        if (wr == 1) PG8_BAR;
        PG8_WAIT_V(4); PG8_BAR;
        PG8_STAGE(PG8_SB(1, 0), cB + kstep, voffB); PG8_STAGE(PG8_SA(1, 0), cA + kstep, voffA); PG8_STAGE(PG8_SB(1, 1), cB + hstep + kstep, voffB);
        PG8_WAIT_V(6); PG8_BAR;
    }
    for (;;) {
        const bool has_next = S.next(ui + 1, nxt);
        const char* nA = has_next ? (const char*)g.A + (size_t)nxt.pm * tstep : cA; const char* nB = has_next ? (const char*)g.Bt + (size_t)nxt.pn * tstep : cB;
#pragma unroll 1
        for (int t = 0; t < nt; t += 2) {
            if constexpr (Epi::MID) { if (t == nt / 2) E.mid(acc, cur, wr, wc, fr, fq); }
            const bool last = (t == nt - 2);
            const char* a1 = cA + (size_t)(t + 1) * kstep;
            const char* a2 = last ? nA : cA + (size_t)(t + 2) * kstep; const char* b2 = last ? nB : cB + (size_t)(t + 2) * kstep;
            const char* a3 = a2 + kstep; const char* b3 = b2 + kstep;
            if (last && has_next) S.a_ready(nxt);
            if constexpr (SP2) {
            PG8_LDB(B0, 0, 0); PG8_LDB(B1, 0, 1); PG8_SCHED; PG8_LDA(At, 0, 0); PG8_STAGE(PG8_SA(1, 1), a1 + hstep, voffA);
            PG8_WAIT_V(8); PG8_WAIT_L(0); PG8_BAR; PG8_MMA(0, 0, At, B0); PG8_MMA(0, 1, At, B1); PG8_BAR; PG8_SCHED;
            PG8_LDA(At, 0, 1); PG8_STAGE(PG8_SB(0, 0), b2, voffB); PG8_STAGE(PG8_SB(0, 1), b2 + hstep, voffB); PG8_STAGE(PG8_SA(0, 0), a2, voffA);
            PG8_WAIT_V(8); PG8_WAIT_L(0); PG8_BAR; PG8_MMA(1, 0, At, B0); PG8_MMA(1, 1, At, B1); PG8_BAR; PG8_SCHED;
            PG8_LDB(B0, 1, 0); PG8_LDB(B1, 1, 1); PG8_SCHED; PG8_LDA(At, 1, 0); PG8_STAGE(PG8_SA(0, 1), a2 + hstep, voffA);
            PG8_WAIT_V(8); PG8_WAIT_L(0); PG8_BAR; PG8_MMA(0, 0, At, B0); PG8_MMA(0, 1, At, B1); PG8_BAR; PG8_SCHED;
            PG8_LDA(At, 1, 1); PG8_STAGE(PG8_SB(1, 0), b3, voffB); PG8_STAGE(PG8_SB(1, 1), b3 + hstep, voffB); PG8_STAGE(PG8_SA(1, 0), a3, voffA);
            PG8_WAIT_V(8); PG8_WAIT_L(0); PG8_BAR; PG8_MMA(1, 0, At, B0); PG8_MMA(1, 1, At, B1); PG8_BAR; PG8_SCHED;
            } else {
            PG8_LDB(B0, 0, 0); PG8_SCHED; PG8_LDA(At, 0, 0); PG8_STAGE(PG8_SA(1, 1), a1 + hstep, voffA);
            PG8_WAIT_L(8); PG8_BAR; PG8_WAIT_L(0); PG8_MMA(0, 0, At, B0); PG8_BAR; PG8_SCHED;
            PG8_LDB(B1, 0, 1); PG8_STAGE(PG8_SB(0, 0), b2, voffB);
            PG8_BAR; PG8_WAIT_L(0); PG8_MMA(0, 1, At, B1); PG8_BAR;
            PG8_LDA(At, 0, 1); PG8_STAGE(PG8_SA(0, 0), a2, voffA);
            PG8_BAR; PG8_WAIT_L(0); PG8_MMA(1, 0, At, B0); PG8_BAR; PG8_SCHED;
            PG8_STAGE(PG8_SB(0, 1), b2 + hstep, voffB);
            PG8_WAIT_V(6); PG8_BAR; PG8_MMA(1, 1, At, B1); PG8_BAR;
            PG8_LDB(B0, 1, 0); PG8_SCHED; PG8_LDA(At, 1, 0); PG8_STAGE(PG8_SA(0, 1), a2 + hstep, voffA);
            PG8_WAIT_L(8); PG8_BAR; PG8_WAIT_L(0); PG8_MMA(0, 0, At, B0); PG8_BAR; PG8_SCHED;
            PG8_LDB(B1, 1, 1); PG8_STAGE(PG8_SB(1, 0), b3, voffB);
            PG8_BAR; PG8_WAIT_L(0); PG8_MMA(0, 1, At, B1); PG8_BAR;
            PG8_LDA(At, 1, 1); PG8_STAGE(PG8_SA(1, 0), a3, voffA);
            PG8_BAR; PG8_WAIT_L(0); PG8_MMA(1, 0, At, B0); PG8_BAR; PG8_SCHED;
            PG8_STAGE(PG8_SB(1, 1), b3 + hstep, voffB);
            PG8_WAIT_V(6); PG8_BAR; PG8_MMA(1, 1, At, B1); PG8_BAR;
            }
        }
        if constexpr (ALIGN_EPI) { if (wr == 0) PG8_BAR; }
        if constexpr (FP8) { asm volatile("s_nop 15\n\ts_nop 7" ::: "memory"); PG8_SCHED; }
        if constexpr (!Epi::AFTER_DRAIN) { E(acc, cur, wr, wc, fr, fq); S.done(cur); }
        if (!has_next) break;
#pragma unroll
        for (int a = 0; a < 2; ++a)
#pragma unroll
            for (int b = 0; b < 2; ++b)
#pragma unroll
                for (int m = 0; m < 4; ++m)
#pragma unroll
                    for (int n = 0; n < 2; ++n) acc[a][b][m][n] = (f32x4){0.f, 0.f, 0.f, 0.f};
        cur = nxt; cA = nA; cB = nB; ++ui;
        if constexpr (ALIGN_EPI) { if (wr == 1) PG8_BAR; }
    }
    PG8_WAIT_V(0);
    if constexpr (!ALIGN_EPI) { if (wr == 0) PG8_BAR; }
    PG8_BAR;
    if constexpr (Epi::AFTER_DRAIN) { E.fused(acc, cur, wr, wc, fr, fq, lds, wid, lane); S.done(cur); }
#undef PG8_SA
#undef PG8_SB
#undef PG8_STAGE
#undef PG8_LDA
#undef PG8_LDB
#undef PG8_MMA
#undef PG8_WAIT_V
#undef PG8_WAIT_L
#undef PG8_BAR
#undef PG8_SCHED
}
}

__device__ __forceinline__ float lambda_full(const Ptrs& P) {
    float a = 0.f, b = 0.f;
    for (int i = 0; i < 64; ++i) { a += P.lq1[i] * P.lk1[i]; b += P.lq2[i] * P.lk2[i]; }
    return __expf(a) - __expf(b) + 0.2f;
}

namespace att {
typedef short bf16x8 __attribute__((ext_vector_type(8)));
typedef short s16x4 __attribute__((ext_vector_type(4)));
typedef float f32x16 __attribute__((ext_vector_type(16)));
typedef float f32x2_t __attribute__((ext_vector_type(2)));
typedef __attribute__((address_space(3))) const char* lds_cptr;
typedef __attribute__((address_space(3))) char* lds_ptr;
__device__ __forceinline__ int crow(int r, int hi) { return (r & 3) + 8 * (r >> 2) + 4 * hi; }
__device__ __forceinline__ void glds16(const void* gsrc, unsigned lds_dst) { unsigned keep;
    asm volatile("s_mov_b32 %0, m0\n\ts_mov_b32 m0, %2\n\ts_nop 0\n\tglobal_load_lds_dwordx4 %1, off\n\ts_mov_b32 m0, %0" : "=&s"(keep) : "v"(gsrc), "s"(lds_dst) : "memory"); }
__device__ __forceinline__ unsigned cvtpk(float lo, float hi) { f32x2_t v = {lo, hi}; bf16x2_t b = __builtin_convertvector(v, bf16x2_t); return __builtin_bit_cast(unsigned, b); }
#define ATT_WAIT_BAR(N) asm volatile("s_waitcnt vmcnt(" #N ") lgkmcnt(0)\n\ts_barrier" ::: "memory")
#define ATT_LDSWAIT() asm volatile("s_waitcnt lgkmcnt(0)" ::: "memory")
#define ATT_SBAR() __builtin_amdgcn_sched_barrier(0)
template <bool REL> __device__ __forceinline__ void qkt(f32x16& p0, f32x16& p1, lds_cptr Kslot, const bf16x8* qr, const f32x16& negm, int r32, int hi) {
    lds_cptr kb = Kslot + hi * 1024 + r32 * 16;
#pragma unroll
    for (int d0 = 0; d0 < 4; ++d0) {
        const bf16x8 b0 = *(const __attribute__((address_space(3))) bf16x8*)(kb + d0 * 2048);
        const bf16x8 b1 = *(const __attribute__((address_space(3))) bf16x8*)(kb + d0 * 2048 + 512);
        if (d0 == 0) { if (REL) { p0 = __builtin_amdgcn_mfma_f32_32x32x16_bf16(b0, qr[0], negm, 0, 0, 0); p1 = __builtin_amdgcn_mfma_f32_32x32x16_bf16(b1, qr[0], negm, 0, 0, 0); }
                       else { p0 = __builtin_amdgcn_mfma_f32_32x32x16_bf16(b0, qr[0], f32x16{}, 0, 0, 0); p1 = __builtin_amdgcn_mfma_f32_32x32x16_bf16(b1, qr[0], f32x16{}, 0, 0, 0); } }
        else { p0 = __builtin_amdgcn_mfma_f32_32x32x16_bf16(b0, qr[d0], p0, 0, 0, 0); p1 = __builtin_amdgcn_mfma_f32_32x32x16_bf16(b1, qr[d0], p1, 0, 0, 0); } }
}
__device__ __forceinline__ float rowmax32(const f32x16& p0, const f32x16& p1) {
    float a = fmaxf(p0[0], p1[0]);
#pragma unroll
    for (int r = 1; r < 16; ++r) a = fmaxf(a, fmaxf(p0[r], p1[r]));
    auto rr = __builtin_amdgcn_permlane32_swap(__float_as_uint(a), __float_as_uint(a), false, false);
    return fmaxf(__uint_as_float(rr[0]), __uint_as_float(rr[1]));
}
__device__ __forceinline__ float halfsum(float a) { auto rr = __builtin_amdgcn_permlane32_swap(__float_as_uint(a), __float_as_uint(a), false, false); return __uint_as_float(rr[0]) + __uint_as_float(rr[1]); }
#define ATT_VREAD(lo, hi, d0) do { _Pragma("unroll") for (int ks = 0; ks < 4; ++ks) { \
        asm volatile("ds_read_b64_tr_b16 %0,%1 offset:%c2" : "=&v"(lo[ks]) : "v"(vb), "i"((d0) * 4096 + ks * 1024) : "memory"); \
        asm volatile("ds_read_b64_tr_b16 %0,%1 offset:%c2" : "=&v"(hi[ks]) : "v"(vb), "i"((d0) * 4096 + ks * 1024 + 512) : "memory"); } } while (0)
#define ATT_PK(lo, hi, k) (bf16x8){lo[k][0], lo[k][1], lo[k][2], lo[k][3], hi[k][0], hi[k][1], hi[k][2], hi[k][3]}
#define ATT_PVMMA(lo, hi, d0) do { \
        o[d0] = __builtin_amdgcn_mfma_f32_32x32x16_bf16(pa0, ATT_PK(lo, hi, 0), o[d0], 0, 0, 0); o[d0] = __builtin_amdgcn_mfma_f32_32x32x16_bf16(pa1, ATT_PK(lo, hi, 1), o[d0], 0, 0, 0); \
        o[d0] = __builtin_amdgcn_mfma_f32_32x32x16_bf16(pa2, ATT_PK(lo, hi, 2), o[d0], 0, 0, 0); o[d0] = __builtin_amdgcn_mfma_f32_32x32x16_bf16(pa3, ATT_PK(lo, hi, 3), o[d0], 0, 0, 0); } while (0)
template <int ND0> __device__ __forceinline__ void pv(f32x16* o, int vb, bf16x8 pa0, bf16x8 pa1, bf16x8 pa2, bf16x8 pa3) {
    s16x4 loA[4], hiA[4], loB[4], hiB[4];
    ATT_VREAD(loA, hiA, 0);
#pragma unroll
    for (int d0 = 0; d0 < ND0; d0 += 2) {
        if (d0 + 1 < ND0) { ATT_VREAD(loB, hiB, d0 + 1); asm volatile("s_waitcnt lgkmcnt(8)" ::: "memory"); } else { asm volatile("s_waitcnt lgkmcnt(0)" ::: "memory"); }
        ATT_SBAR();
        ATT_PVMMA(loA, hiA, d0);
        if (d0 + 1 < ND0) {
            if (d0 + 2 < ND0) { ATT_VREAD(loA, hiA, d0 + 2); asm volatile("s_waitcnt lgkmcnt(8)" ::: "memory"); } else { asm volatile("s_waitcnt lgkmcnt(0)" ::: "memory"); }
            ATT_SBAR();
            ATT_PVMMA(loB, hiB, d0 + 1);
        }
    }
}
#undef ATT_VREAD
#undef ATT_PVMMA
#undef ATT_PK
template <int DEAD> __device__ __forceinline__ constexpr bool live0(int r) { return DEAD != 2 || r >= 12; }
template <int DEAD> __device__ __forceinline__ constexpr bool live1(int r) { return DEAD != 1 || r < 4; }
template <int ND0, int THR, bool REL, int DEAD = 0> __device__ __forceinline__ void softmax_tile(f32x16& p0, f32x16& p1, float& mrun, float& lsum, f32x16& negm, bool first, f32x16* o, __attribute__((address_space(3))) float* wsf, int r32, int hi,
                                                                   u32x4& pw0, u32x4& pw1, u32x4& pw2, u32x4& pw3) {
    float rm;
    if (DEAD == 0) rm = rowmax32(p0, p1);
    else { float a = -3e38f;
#pragma unroll
        for (int r = 0; r < 16; ++r) { if (live0<DEAD>(r)) a = fmaxf(a, p0[r]); if (live1<DEAD>(r)) a = fmaxf(a, p1[r]); }
        auto rr = __builtin_amdgcn_permlane32_swap(__float_as_uint(a), __float_as_uint(a), false, false); rm = fmaxf(__uint_as_float(rr[0]), __uint_as_float(rr[1])); }
    if (!REL) rm -= mrun;
    if (first) {
        mrun = REL ? rm : mrun + rm;
        if (REL) {
#pragma unroll
            for (int r = 0; r < 16; ++r) { if (live0<DEAD>(r)) p0[r] -= rm; if (live1<DEAD>(r)) p1[r] -= rm; negm[r] = -mrun; } }
    } else if (__any(rm > (float)THR)) {
        const float dl = fmaxf(rm, 0.f), alpha = __builtin_amdgcn_exp2f(-dl); lsum *= alpha; mrun += dl;
        if (REL) {
#pragma unroll
            for (int r = 0; r < 16; ++r) { if (live0<DEAD>(r)) p0[r] -= dl; if (live1<DEAD>(r)) p1[r] -= dl; negm[r] = -mrun; } }
        if (hi == 0) wsf[r32] = alpha;
        ATT_LDSWAIT();
#pragma unroll
        for (int g = 0; g < 4; ++g) { const f32x4 a4 = *(const __attribute__((address_space(3))) f32x4*)(wsf + 8 * g + 4 * hi);
#pragma unroll
            for (int d0 = 0; d0 < ND0; ++d0) { o[d0][4 * g + 0] *= a4[0]; o[d0][4 * g + 1] *= a4[1]; o[d0][4 * g + 2] *= a4[2]; o[d0][4 * g + 3] *= a4[3]; } }
        ATT_LDSWAIT();
    }
    float s = 0.f;
#pragma unroll
    for (int r = 0; r < 16; ++r) {
        if (live0<DEAD>(r)) { p0[r] = __builtin_amdgcn_exp2f(REL ? p0[r] : p0[r] - mrun); s += p0[r]; } else p0[r] = 0.f;
        if (live1<DEAD>(r)) { p1[r] = __builtin_amdgcn_exp2f(REL ? p1[r] : p1[r] - mrun); s += p1[r]; } else p1[r] = 0.f; }
    lsum += s;
    pw0 = (u32x4){cvtpk(p0[0], p0[1]), cvtpk(p0[2], p0[3]), cvtpk(p0[4], p0[5]), cvtpk(p0[6], p0[7])};
    pw1 = (u32x4){cvtpk(p0[8], p0[9]), cvtpk(p0[10], p0[11]), cvtpk(p0[12], p0[13]), cvtpk(p0[14], p0[15])};
    pw2 = (u32x4){cvtpk(p1[0], p1[1]), cvtpk(p1[2], p1[3]), cvtpk(p1[4], p1[5]), cvtpk(p1[6], p1[7])};
    pw3 = (u32x4){cvtpk(p1[8], p1[9]), cvtpk(p1[10], p1[11]), cvtpk(p1[12], p1[13]), cvtpk(p1[14], p1[15])};
}

constexpr int A_SLOTK = 8192, A_SLOTV = 16384, A_NS = 3, A_NSV = 4;
constexpr int A_LDS_K = 0, A_LDS_V = A_NS * A_SLOTK, A_LDS_WS = A_LDS_V + A_NSV * A_SLOTV, A_LDS_ST = A_LDS_WS + 8 * 256, A_LDS_BYTES = A_LDS_ST + 8 * 8192;
__device__ __forceinline__ void attn_a_unit(int b, int h, int qb, const bf16_t* proj, bf16_t* ya, const float* subln, float lam, unsigned char* shm) {
    int tid_l = threadIdx.x; asm volatile("" : "+v"(tid_l));
    const int tid = tid_l, lane = tid & 63, r32 = lane & 31, hi = lane >> 5; const int wid = __builtin_amdgcn_readfirstlane(tid >> 6);
    const size_t rowbase = (size_t)b * SEQ; const int q0 = qb * 256;
    constexpr int NT = SEQ / 64;
    const unsigned lds0 = (unsigned)(uintptr_t)shm;
    const lds_cptr shm3 = (lds_cptr)shm;
    __attribute__((address_space(3))) float* wsf = (__attribute__((address_space(3))) float*)((lds_ptr)shm + A_LDS_WS) + wid * 64;
    const int vb0 = (int)(lds0 + A_LDS_V) + ((lane >> 4) & 1) * 32 + (lane & 3) * 8 + (4 * hi + ((lane & 15) >> 2)) * 64;
    __attribute__((address_space(3))) bf16_t* stg = (__attribute__((address_space(3))) bf16_t*)((lds_ptr)shm + A_LDS_ST) + wid * 4096;
    for (int mp = 0; mp < 2; ++mp) {
        const bf16_t* Kh = proj + rowbase * INW + C_KA + h * 128 + mp * 64;
        const bf16_t* Vh = proj + rowbase * INW + C_VA + h * 128;
        const bf16_t* Qw = proj + (rowbase + q0 + wid * 32) * INW + C_QA + h * 128 + mp * 64;
        const int pA = 2 * wid, pB = 2 * wid + 1;
        const unsigned kdst = lds0 + A_LDS_K + wid * 1024, vdstA = lds0 + A_LDS_V + pA * 1024, vdstB = lds0 + A_LDS_V + pB * 1024;
#define A_DMA(t, slot, vsl) do { int ln_ = lane; asm volatile("" : "+v"(ln_)); \
        const bf16_t* ksrc_ = Kh + (size_t)((t) * 64 + ln_) * INW + wid * 8; \
        const bf16_t* vsrcA_ = Vh + (size_t)((t) * 64 + 16 * (pA & 3) + (ln_ >> 2)) * INW + (pA >> 2) * 32 + (ln_ & 3) * 8; \
        const bf16_t* vsrcB_ = Vh + (size_t)((t) * 64 + 16 * (pB & 3) + (ln_ >> 2)) * INW + (pB >> 2) * 32 + (ln_ & 3) * 8; \
        glds16(ksrc_, (unsigned)__builtin_amdgcn_readfirstlane(kdst + (slot) * A_SLOTK)); \
        glds16(vsrcA_, (unsigned)__builtin_amdgcn_readfirstlane(vdstA + (vsl) * A_SLOTV)); \
        glds16(vsrcB_, (unsigned)__builtin_amdgcn_readfirstlane(vdstB + (vsl) * A_SLOTV)); } while (0)
        A_DMA(0, 0, 0); A_DMA(1, 1, 1);
        bf16x8 qr[4];
#pragma unroll
        for (int d0 = 0; d0 < 4; ++d0) qr[d0] = *(const bf16x8*)(Qw + (size_t)r32 * INW + d0 * 16 + hi * 8);
        f32x16 o[4]; o[0] = f32x16{}; o[1] = f32x16{}; o[2] = f32x16{}; o[3] = f32x16{};
        float mrun = 0.f, lsum = 0.f; f32x16 negm = f32x16{};
        int slot = 0, slot2 = 2, vslot = 0, vslot2 = 2, vprev = 3;
        const bool late = wid >= 4;
        u32x4 pw0 = {}, pw1 = {}, pw2 = {}, pw3 = {};
        for (int t = 0; t < NT; ++t) {
            if (t + 1 < NT) { ATT_WAIT_BAR(3); } else { ATT_WAIT_BAR(0); }
            if (t + 2 < NT) A_DMA(t + 2, slot2, vslot2);
            if (late && t > 0) pv<4>(o, vb0 + vprev * A_SLOTV, __builtin_bit_cast(bf16x8, pw0), __builtin_bit_cast(bf16x8, pw1), __builtin_bit_cast(bf16x8, pw2), __builtin_bit_cast(bf16x8, pw3));
            f32x16 p0, p1;
            qkt<false>(p0, p1, shm3 + A_LDS_K + slot * A_SLOTK, qr, negm, r32, hi);
            softmax_tile<4, 8, false>(p0, p1, mrun, lsum, negm, t == 0, o, wsf, r32, hi, pw0, pw1, pw2, pw3);
            if (!late) pv<4>(o, vb0 + vslot * A_SLOTV, __builtin_bit_cast(bf16x8, pw0), __builtin_bit_cast(bf16x8, pw1), __builtin_bit_cast(bf16x8, pw2), __builtin_bit_cast(bf16x8, pw3));
            slot = (slot == 2) ? 0 : slot + 1; slot2 = (slot2 == 2) ? 0 : slot2 + 1;
            vprev = vslot; vslot = (vslot + 1) & 3; vslot2 = (vslot2 + 1) & 3;
        }
        if (late) pv<4>(o, vb0 + vprev * A_SLOTV, __builtin_bit_cast(bf16x8, pw0), __builtin_bit_cast(bf16x8, pw1), __builtin_bit_cast(bf16x8, pw2), __builtin_bit_cast(bf16x8, pw3));
#undef A_DMA
        const float lt = halfsum(lsum);
        if (hi == 0) wsf[32 + r32] = lt;
        ATT_LDSWAIT();
        float rli[16];
#pragma unroll
        for (int g = 0; g < 4; ++g) { const f32x4 l4 = *(const __attribute__((address_space(3))) f32x4*)(wsf + 32 + 8 * g + 4 * hi);
            rli[4 * g + 0] = __builtin_amdgcn_rcpf(l4[0]); rli[4 * g + 1] = __builtin_amdgcn_rcpf(l4[1]); rli[4 * g + 2] = __builtin_amdgcn_rcpf(l4[2]); rli[4 * g + 3] = __builtin_amdgcn_rcpf(l4[3]); }
        ATT_LDSWAIT();
        if (mp == 0) {
#pragma unroll
            for (int d0 = 0; d0 < 4; ++d0)
#pragma unroll
                for (int r = 0; r < 16; ++r) stg[crow(r, hi) * 128 + d0 * 32 + r32] = (bf16_t)f2bf(o[d0][r] * rli[r]);
            asm volatile("s_waitcnt lgkmcnt(0)\n\ts_barrier" ::: "memory");
        } else {
            float ss[16];
#pragma unroll
            for (int r = 0; r < 16; ++r) ss[r] = 0.f;
#pragma unroll
            for (int d0 = 0; d0 < 4; ++d0)
#pragma unroll
                for (int r = 0; r < 16; ++r) { const float a = bf2f(stg[crow(r, hi) * 128 + d0 * 32 + r32]); const float y = a - lam * o[d0][r] * rli[r]; o[d0][r] = y; ss[r] += y * y; }
#pragma unroll
            for (int r = 0; r < 16; ++r) { float v = ss[r]; v += __shfl_xor(v, 1); v += __shfl_xor(v, 2); v += __shfl_xor(v, 4); v += __shfl_xor(v, 8); v += __shfl_xor(v, 16);
                ss[r] = 0.8f / sqrtf(v * (1.f / 128.f) + EPS); }
            ATT_LDSWAIT();
#pragma unroll
            for (int d0 = 0; d0 < 4; ++d0) { const float gsub = subln[d0 * 32 + r32];
#pragma unroll
                for (int r = 0; r < 16; ++r) stg[crow(r, hi) * 128 + d0 * 32 + r32] = (bf16_t)f2bf(o[d0][r] * ss[r] * gsub); }
            ATT_LDSWAIT();
            bf16_t* Yw = ya + (rowbase + q0 + wid * 32) * 1024 + h * 128;
#pragma unroll
            for (int i = 0; i < 8; ++i) { const int row = i * 4 + (lane >> 4), ch = lane & 15; const u32x4 v = *(const __attribute__((address_space(3))) u32x4*)(stg + row * 128 + ch * 8); *(u32x4*)(Yw + (size_t)row * 1024 + ch * 8) = v; }
            asm volatile("s_waitcnt lgkmcnt(0)\n\ts_barrier" ::: "memory");
        }
    }
}

template <int DEAD> __device__ __forceinline__ void na_tile(lds_cptr Kslot, int vb, const bf16x8* qr, const __attribute__((address_space(3))) float* bp, const float (&fm0)[16], const float (&fm1)[16],
                                                        float& mrun, float& lsum, f32x16& negm, bool first, f32x16* o, __attribute__((address_space(3))) float* wsf, int r32, int hi) {
    f32x16 p0, p1; u32x4 pw0, pw1, pw2, pw3;
    qkt<true>(p0, p1, Kslot, qr, negm, r32, hi);
#pragma unroll
    for (int rr = 0; rr < 16; ++rr) { const int jj = (rr & 3) + 8 * (rr >> 2);
        if (live0<DEAD>(rr)) p0[rr] += bp[jj] + fm0[rr];
        if (live1<DEAD>(rr)) p1[rr] += bp[jj + 32] + fm1[rr]; }
    softmax_tile<2, 8, true, DEAD>(p0, p1, mrun, lsum, negm, first, o, wsf, r32, hi, pw0, pw1, pw2, pw3);
    pv<2>(o, vb, __builtin_bit_cast(bf16x8, pw0), __builtin_bit_cast(bf16x8, pw1), __builtin_bit_cast(bf16x8, pw2), __builtin_bit_cast(bf16x8, pw3));
}
constexpr int B_SLOT = 8192, B_NS = 6, B_PF = 5;
constexpr int B_LDS_K = 0, B_LDS_V = B_NS * B_SLOT, B_LDS_WS = 2 * B_NS * B_SLOT, B_LDS_BIAS = B_LDS_WS + 8 * 256, B_LDS_ST = B_LDS_BIAS + 2560, B_LDS_BYTES = B_LDS_ST + 8 * 4096;
__device__ __forceinline__ void attn_b_unit(int b, int h, int rg, const bf16_t* proj, bf16_t* yb, const float* rpb, unsigned char* shm) {
    int tid_l = threadIdx.x; asm volatile("" : "+v"(tid_l));
    const int tid = tid_l, lane = tid & 63, r32 = lane & 31, hi = lane >> 5; const int wid = __builtin_amdgcn_readfirstlane(tid >> 6);
    const size_t rowbase = (size_t)b * SEQ;
    const int r = 4 * rg + (wid >> 1), c0 = 32 * (wid & 1);
    int rs = r - 4; rs = rs < 0 ? 0 : (rs > 24 ? 24 : rs);
    int rmin = 4 * rg - 4; rmin = rmin < 0 ? 0 : (rmin > 24 ? 24 : rmin);
    int rmaxs = 4 * rg + 3 - 4; rmaxs = rmaxs < 0 ? 0 : (rmaxs > 24 ? 24 : rmaxs);
    const int ntile = rmaxs + 8 - rmin;
    const unsigned lds0 = (unsigned)(uintptr_t)shm;
    const lds_cptr shm3 = (lds_cptr)shm;
    __attribute__((address_space(3))) float* wsf = (__attribute__((address_space(3))) float*)((lds_ptr)shm + B_LDS_WS) + wid * 64;
    __attribute__((address_space(3))) float* bias = (__attribute__((address_space(3))) float*)((lds_ptr)shm + B_LDS_BIAS) + 64;
    __attribute__((address_space(3))) bf16_t* stg = (__attribute__((address_space(3))) bf16_t*)((lds_ptr)shm + B_LDS_ST) + wid * 2048;
    const int vb0 = (int)(lds0 + B_LDS_V) + ((lane >> 4) & 1) * 32 + (lane & 3) * 8 + (4 * hi + ((lane & 15) >> 2)) * 64;
    for (int i = tid; i < 640; i += 512) { const int e = i - 64, ri = e >> 5, cj = e & 31; bias[e] = (e >= 0 && e < 480 && cj < 31) ? rpb[(h * 15 + ri) * 31 + cj] * LOG2E : 0.f; }
    const bf16_t* Kh = proj + rowbase * INW + C_KB + h * 64;
    const bf16_t* Vh = proj + rowbase * INW + C_VB + h * 64;
    const bf16_t* Qw = proj + (rowbase + r * 64 + c0) * INW + C_QB + h * 64;
    const unsigned kdst = lds0 + B_LDS_K + wid * 1024, vdst = lds0 + B_LDS_V + wid * 1024;
#define B_DMA(t, slot) do { int ln_ = lane; asm volatile("" : "+v"(ln_)); \
    const bf16_t* ksrc_ = Kh + (size_t)((rmin + (t)) * 64 + ln_) * INW + wid * 8; \
    const bf16_t* vsrc_ = Vh + (size_t)((rmin + (t)) * 64 + 16 * (wid & 3) + (ln_ >> 2)) * INW + (wid >> 2) * 32 + (ln_ & 3) * 8; \
    glds16(ksrc_, (unsigned)__builtin_amdgcn_readfirstlane(kdst + (slot) * B_SLOT)); \
    glds16(vsrc_, (unsigned)__builtin_amdgcn_readfirstlane(vdst + (slot) * B_SLOT)); } while (0)
#pragma unroll
    for (int t = 0; t < B_PF; ++t) B_DMA(t, t);
    bf16x8 qr[4];
#pragma unroll
    for (int d0 = 0; d0 < 4; ++d0) qr[d0] = *(const bf16x8*)(Qw + (size_t)r32 * INW + d0 * 16 + hi * 8);
    f32x16 o[2]; o[0] = f32x16{}; o[1] = f32x16{};
    float mrun = 0.f, lsum = 0.f; f32x16 negm = f32x16{}; bool first = true;
    const int c = c0 + r32; int cs = c - 8; cs = cs < 0 ? 0 : (cs > 48 ? 48 : cs);
    float fm0[16], fm1[16];
#pragma unroll
    for (int rr = 0; rr < 16; ++rr) { const int j0 = crow(rr, hi); fm0[rr] = ((unsigned)(j0 - cs) < 16u) ? 0.f : -1e30f; fm1[rr] = ((unsigned)(j0 + 32 - cs) < 16u) ? 0.f : -1e30f; }
    int slot = 0, slotn = B_PF;
    for (int t = 0; t < ntile; ++t) {
        { const int rem = ntile - 1 - t;
          if (rem >= 4) { ATT_WAIT_BAR(8); } else if (rem == 3) { ATT_WAIT_BAR(6); } else if (rem == 2) { ATT_WAIT_BAR(4); } else if (rem == 1) { ATT_WAIT_BAR(2); } else { ATT_WAIT_BAR(0); } }
        if (t + B_PF < ntile) B_DMA(t + B_PF, slotn);
        const int kr = rmin + t;
        if (kr >= rs && kr < rs + 8) {
            const __attribute__((address_space(3))) float* bp = bias + ((kr - r + 7) * 32 + 15 - c + 4 * hi);
            if (wid & 1) na_tile<2>(shm3 + B_LDS_K + slot * B_SLOT, vb0 + slot * B_SLOT, qr, bp, fm0, fm1, mrun, lsum, negm, first, o, wsf, r32, hi);
            else         na_tile<1>(shm3 + B_LDS_K + slot * B_SLOT, vb0 + slot * B_SLOT, qr, bp, fm0, fm1, mrun, lsum, negm, first, o, wsf, r32, hi);
            first = false;
        }
        slot = (slot == B_NS - 1) ? 0 : slot + 1; slotn = (slotn == B_NS - 1) ? 0 : slotn + 1;
    }
#undef B_DMA
    const float lt = halfsum(lsum);
    if (hi == 0) wsf[32 + r32] = lt;
    ATT_LDSWAIT();
    float rli[16];
#pragma unroll
    for (int g = 0; g < 4; ++g) { const f32x4 l4 = *(const __attribute__((address_space(3))) f32x4*)(wsf + 32 + 8 * g + 4 * hi);
        rli[4 * g + 0] = __builtin_amdgcn_rcpf(l4[0]); rli[4 * g + 1] = __builtin_amdgcn_rcpf(l4[1]); rli[4 * g + 2] = __builtin_amdgcn_rcpf(l4[2]); rli[4 * g + 3] = __builtin_amdgcn_rcpf(l4[3]); }
#pragma unroll
    for (int d0 = 0; d0 < 2; ++d0)
#pragma unroll
        for (int rr = 0; rr < 16; ++rr) stg[crow(rr, hi) * 64 + d0 * 32 + r32] = (bf16_t)f2bf(o[d0][rr] * rli[rr]);
    ATT_LDSWAIT();
    bf16_t* Yw = yb + (rowbase + r * 64 + c0) * 1024 + 512 + h * 64;
#pragma unroll
    for (int i = 0; i < 4; ++i) { const int row = i * 8 + (lane >> 3), ch = lane & 7; const u32x4 v = *(const __attribute__((address_space(3))) u32x4*)(stg + row * 64 + ch * 8); *(u32x4*)(Yw + (size_t)row * 1024 + ch * 8) = v; }
    asm volatile("s_waitcnt lgkmcnt(0)\n\ts_barrier" ::: "memory");
}
}

namespace peer {
typedef short bf16x8 __attribute__((ext_vector_type(8)));
typedef float f32x16 __attribute__((ext_vector_type(16)));
typedef __attribute__((address_space(3))) const char* lds_cptr;
constexpr int T_LDS_SK = 0, T_LDS_BYTES = 65536;
__device__ __forceinline__ int imax(int a, int b) { int r; asm("v_max_f32 %0, %1, %2" : "=v"(r) : "v"(a), "v"(b)); return r; }
__device__ __forceinline__ int imin(int a, int b) { int r; asm("v_min_f32 %0, %1, %2" : "=v"(r) : "v"(a), "v"(b)); return r; }
__device__ __forceinline__ int f2key(float s, int idx) { return (__float_as_int(s) & ~127) | idx; }
__device__ __forceinline__ int key2bits(int k) { return k; }
template <int N, int OFF, int TOT> __device__ __forceinline__ void bsort_desc(int (&a)[TOT]) {
#pragma unroll
    for (int k = 2; k <= N; k <<= 1)
#pragma unroll
        for (int j = k >> 1; j > 0; j >>= 1)
#pragma unroll
            for (int i = 0; i < N; ++i) { const int l = i ^ j; if (l > i) { const bool desc = (i & k) == 0; const int hi_ = imax(a[OFF + i], a[OFF + l]), lo_ = imin(a[OFF + i], a[OFF + l]); a[OFF + i] = desc ? hi_ : lo_; a[OFF + l] = desc ? lo_ : hi_; } }
}
__device__ constexpr unsigned char NET16[126] = {0,1,2,3,0,2,1,3,1,2,4,5,6,7,4,6,5,7,5,6,0,4,2,6,2,4,1,5,3,7,3,5,1,2,3,4,5,6,8,9,10,11,8,10,9,11,9,10,12,13,14,15,12,14,13,15,13,14,8,12,10,14,10,12,9,13,11,15,11,13,9,10,11,12,13,14,0,8,4,12,4,8,2,10,6,14,6,10,2,4,6,8,10,12,1,9,5,13,5,9,3,11,7,15,7,11,3,5,7,9,11,13,1,2,3,4,5,6,7,8,9,10,11,12,13,14};
__device__ constexpr unsigned char NET32[382] = {0,1,2,3,0,2,1,3,1,2,4,5,6,7,4,6,5,7,5,6,0,4,2,6,2,4,1,5,3,7,3,5,1,2,3,4,5,6,8,9,10,11,8,10,9,11,9,10,12,13,14,15,12,14,13,15,13,14,8,12,10,14,10,12,9,13,11,15,11,13,9,10,11,12,13,14,0,8,4,12,4,8,2,10,6,14,6,10,2,4,6,8,10,12,1,9,5,13,5,9,3,11,7,15,7,11,3,5,7,9,11,13,1,2,3,4,5,6,7,8,9,10,11,12,13,14,16,17,18,19,16,18,17,19,17,18,20,21,22,23,20,22,21,23,21,22,16,20,18,22,18,20,17,21,19,23,19,21,17,18,19,20,21,22,24,25,26,27,24,26,25,27,25,26,28,29,30,31,28,30,29,31,29,30,24,28,26,30,26,28,25,29,27,31,27,29,25,26,27,28,29,30,16,24,20,28,20,24,18,26,22,30,22,26,18,20,22,24,26,28,17,25,21,29,21,25,19,27,23,31,23,27,19,21,23,25,27,29,17,18,19,20,21,22,23,24,25,26,27,28,29,30,0,16,8,24,8,16,4,20,12,28,12,20,4,8,12,16,20,24,2,18,10,26,10,18,6,22,14,30,14,22,6,10,14,18,22,26,2,4,6,8,10,12,14,16,18,20,22,24,26,28,1,17,9,25,9,17,5,21,13,29,13,21,5,9,13,17,21,25,3,19,11,27,11,19,7,23,15,31,15,23,7,11,15,19,23,27,3,5,7,9,11,13,15,17,19,21,23,25,27,29,1,2,3,4,5,6,7,8,9,10,11,12,13,14,15,16,17,18,19,20,21,22,23,24,25,26,27,28,29,30};
template <int OFF, int TOT> __device__ __forceinline__ void sort16_desc(int (&a)[TOT]) {
#pragma unroll
    for (int c = 0; c < 63; ++c) { const int i = OFF + NET16[2 * c], j = OFF + NET16[2 * c + 1]; const int hi_ = imax(a[i], a[j]), lo_ = imin(a[i], a[j]); a[i] = hi_; a[j] = lo_; }
}
template <int TOT> __device__ __forceinline__ void sort32_desc(int (&a)[TOT]) {
#pragma unroll
    for (int c = 0; c < 191; ++c) { const int i = NET32[2 * c], j = NET32[2 * c + 1]; const int hi_ = imax(a[i], a[j]), lo_ = imin(a[i], a[j]); a[i] = hi_; a[j] = lo_; }
}
template <int N, int OFF, int TOT> __device__ __forceinline__ void bmerge_desc(int (&a)[TOT]) {
#pragma unroll
    for (int j = N >> 1; j > 0; j >>= 1)
#pragma unroll
        for (int i = 0; i < N; ++i) { const int l = i ^ j; if (l > i) { const int hi_ = imax(a[OFF + i], a[OFF + l]), lo_ = imin(a[OFF + i], a[OFF + l]); a[OFF + i] = hi_; a[OFF + l] = lo_; } }
}
template <int A, int B, int TOT> __device__ __forceinline__ void merge_top16(int (&a)[TOT]) {
#pragma unroll
    for (int i = 0; i < 16; ++i) a[A + i] = imax(a[A + i], a[B + 15 - i]);
    bmerge_desc<16, A, TOT>(a);
}
__device__ __forceinline__ void cross_top16(int (&t)[16]) {
    int lo[16], hi[16];
#pragma unroll
    for (int i = 0; i < 16; ++i) { auto rr = __builtin_amdgcn_permlane32_swap((unsigned)t[i], (unsigned)t[i], false, false); lo[i] = (int)rr[0]; hi[i] = (int)rr[1]; }
#pragma unroll
    for (int i = 0; i < 16; ++i) t[i] = imax(lo[i], hi[15 - i]);
    bmerge_desc<16, 0, 16>(t);
}
struct RowStream {
    const float* pu; const float* pv; unsigned char* ws; int r, step, lane; f32x4 v0, v1, v2, v3;
    __device__ __forceinline__ void issue() {
        if (r < 2 * NEXP) { const float* src = (r < NEXP ? pu + (size_t)r * D : pv + (size_t)(r - NEXP) * D); const f32x4* s4 = (const f32x4*)src + lane * 4; v0 = s4[0]; v1 = s4[1]; v2 = s4[2]; v3 = s4[3]; } }
    __device__ __forceinline__ void finish() {
        if (r < 2 * NEXP) { const f32x4 cur[4] = {v0, v1, v2, v3};
            if (r < NEXP) cvt_row_i8(cur, ws + WS_U + (size_t)r * 512, (float*)(ws + WS_SU) + r, lane);
            else { const int e = r - NEXP; cvt_row_fp8(cur, ws + WS_V + (size_t)e * 512, (float*)(ws + WS_SV) + e, lane); }
            r += step; } }
    __device__ __forceinline__ void hook() { finish(); issue(); }
};
__device__ __forceinline__ void half_top16(int (&top)[16], const bf16_t* qrow  , lds_cptr skp  , int hi, RowStream& RS) {
    f32x16 sc[4]; sc[0] = f32x16{}; sc[1] = f32x16{}; sc[2] = f32x16{}; sc[3] = f32x16{};
    bf16x8 qf[8];
#pragma unroll
    for (int ks = 0; ks < 8; ++ks) qf[ks] = *(const bf16x8*)(qrow + ks * 16);
    RS.hook();
#pragma unroll
    for (int ks = 0; ks < 8; ++ks)
#pragma unroll
        for (int kt = 0; kt < 4; ++kt) { const bf16x8 af = *(const __attribute__((address_space(3))) bf16x8*)(skp + ks * 4096 + kt * 512);
            sc[kt] = __builtin_amdgcn_mfma_f32_32x32x16_bf16(af, qf[ks], sc[kt], 0, 0, 0); }
    int k[64];
#pragma unroll
    for (int kt = 0; kt < 4; ++kt)
#pragma unroll
        for (int r = 0; r < 16; ++r) k[kt * 16 + r] = f2key(sc[kt][r], (32 * kt + (r & 3) + 8 * (r >> 2)) | (4 * hi));
    sort16_desc<0, 64>(k); sort16_desc<16, 64>(k);
    RS.hook();
    sort16_desc<32, 64>(k); sort16_desc<48, 64>(k);
    RS.hook();
    merge_top16<0, 16, 64>(k); merge_top16<32, 48, 64>(k); merge_top16<0, 32, 64>(k);
#pragma unroll
    for (int i = 0; i < 16; ++i) top[i] = k[i];
    cross_top16(top);
}
__device__ __forceinline__ void topk_wave(int tok0, int h, const bf16_t* Q, int* IDX, float* Gt, lds_cptr sk, int lane, RowStream& RS) {
    const int r32 = lane & 31, hi = lane >> 5, tok = tok0 + r32;
    const bf16_t* qrow = Q + (size_t)tok * PQ + h * 256 + 8 * hi;
    lds_cptr skl = sk + hi * 2048 + r32 * 16;
    int A0[16], A1[16];
    half_top16(A0, qrow, skl, hi, RS);
    half_top16(A1, qrow + 128, skl + 32768, hi, RS);
    RS.hook();
    float x[16], y[16]; int xw[16], yw[16];
#pragma unroll
    for (int a = 0; a < 16; ++a) { const int b0 = key2bits(A0[a]), b1 = key2bits(A1[a]);
        const float v0 = __int_as_float(b0 & ~127), v1 = __int_as_float(b1 & ~127); const int i0 = (b0 & 127) << 7, i1 = b1 & 127;
        x[a] = hi ? v1 : v0; y[a] = hi ? v0 : v1; xw[a] = hi ? i1 : i0; yw[a] = hi ? i0 : i1; }
    int w[32]; int n = 0;
#define PEER_CAND(a, b) do { const int bits = __float_as_int(x[a] + y[b]); int ww = (bits & ~0x3FFF) | (xw[a] + yw[b]); \
        if ((a) == (b) && hi) ww = (int)0xFF800000; w[n] = ww; ++n; } while (0)
#pragma unroll
    for (int b = 0; b < 16; ++b) PEER_CAND(0, b);
#pragma unroll
    for (int b = 1; b < 8; ++b) PEER_CAND(1, b);
#pragma unroll
    for (int b = 2; b < 5; ++b) PEER_CAND(2, b);
    PEER_CAND(3, 3);
#undef PEER_CAND
#pragma unroll
    for (int i = 27; i < 32; ++i) w[i] = (int)0xFF800000;
    RS.hook();
    sort32_desc<32>(w);
    RS.hook();
    int T[16];
#pragma unroll
    for (int i = 0; i < 16; ++i) T[i] = w[i];
    cross_top16(T);
    float sv[16]; int ev[16];
#pragma unroll
    for (int j = 0; j < 16; ++j) { ev[j] = T[j] & 0x3FFF; sv[j] = __int_as_float(T[j] & ~0x3FFF); }
    const float s0 = sv[0]; float esum = 0.f;
#pragma unroll
    for (int j = 0; j < 16; ++j) { sv[j] = __expf(sv[j] - s0); esum += sv[j]; }
    const float inv = 1.f / esum;
    if (hi == 0) { u32x4* io = (u32x4*)(IDX + ((size_t)tok * 8 + h) * 16);
#pragma unroll
        for (int j = 0; j < 4; ++j) io[j] = (u32x4){(unsigned)ev[4 * j], (unsigned)ev[4 * j + 1], (unsigned)ev[4 * j + 2], (unsigned)ev[4 * j + 3]}; }
    else { f32x4* go = (f32x4*)(Gt + ((size_t)tok * 8 + h) * 16);
#pragma unroll
        for (int j = 0; j < 4; ++j) go[j] = (f32x4){sv[4 * j] * inv, sv[4 * j + 1] * inv, sv[4 * j + 2] * inv, sv[4 * j + 3] * inv}; }
}
template <class Sched> __device__ __forceinline__ void topk_own_units(const Ptrs& P, unsigned char* shm, const Sched& S) {
    int tid_l = threadIdx.x; asm volatile("" : "+v"(tid_l));
    const int tid = tid_l, lane = tid & 63; const int wid = __builtin_amdgcn_readfirstlane(tid >> 6);
    const unsigned lds0 = (unsigned)(uintptr_t)shm;
    const bf16_t* SKg = (const bf16_t*)(P.ws + WS_SK);
    int hprev = -1; pg8::Unit u;
    RowStream RS; RS.pu = P.peer_u; RS.pv = P.peer_v; RS.ws = P.ws; RS.lane = lane; RS.step = (int)gridDim.x * 8; RS.r = (int)blockIdx.x * 8 + wid; RS.v0 = RS.v1 = RS.v2 = RS.v3 = f32x4{};
    RS.issue();
    for (int i = 0; S.next(i, u); ++i) {
        const int h = u.pn, tg = u.pm;
        if (h != hprev) { hprev = h;
            asm volatile("s_waitcnt lgkmcnt(0)\n\ts_barrier" ::: "memory");
#pragma unroll
            for (int j = 0; j < 8; ++j) { const int piece = wid * 8 + j, p = piece >> 5, c = (piece >> 1) & 15, kh = piece & 1;
                att::glds16(SKg + ((size_t)((h * 2 + p) * 128 + kh * 64 + lane) * 128 + c * 8), (unsigned)__builtin_amdgcn_readfirstlane(lds0 + p * 32768 + c * 2048 + kh * 1024)); }
            asm volatile("s_waitcnt vmcnt(0)\n\ts_barrier" ::: "memory");
        }
        topk_wave(tg * 256 + wid * 32, h, (const bf16_t*)(P.ws + WS_Q), (int*)(P.ws + WS_IDX), (float*)(P.ws + WS_G), (lds_cptr)shm, lane, RS);
    }
    while (RS.r < 2 * NEXP) RS.hook();
}
}

namespace apply {
typedef float f32x2 __attribute__((ext_vector_type(2)));
typedef __attribute__((address_space(3))) unsigned* lds_u32p;
constexpr int AP_WAVE_BYTES = 4 * (512 + 2048), AP_LDS_BYTES = 8 * AP_WAVE_BYTES;
__device__ __forceinline__ float gelu_fast(float v) {
    const float av = fabsf(v), t = __builtin_amdgcn_rcpf(av * 0.2316418882f + 1.0f);
    float q = t * 0.5307027145f + (-0.7265760135f); q = q * t + 0.7107068705f; q = q * t + (-0.142248368f); q = q * t + 0.127414796f; q = q * t;
    const float e = __builtin_amdgcn_exp2f((v * v) * (-0.72134752044f));
    const float m = v * (q * e);
    return v < 0.f ? m : v - m;
}
#define AP_DPP(v, ctrl) __builtin_bit_cast(float, __builtin_amdgcn_update_dpp(0, __builtin_bit_cast(int, (v)), (ctrl), 0xF, 0xF, true))
__device__ __forceinline__ float row16_sum(float v) { v += AP_DPP(v, 0xB1); v += AP_DPP(v, 0x4E); v += AP_DPP(v, 0x141); v += AP_DPP(v, 0x140); return v; }
__device__ __forceinline__ void load_half(u32x4 (&r)[2], const unsigned char* img, unsigned e, int sub) {
    const unsigned off = e * 512u + (unsigned)(sub * 16);
    r[0] = *(const u32x4*)(img + off); r[1] = *(const u32x4*)(img + off + 256u);
}
constexpr int AP_PROBE_RING = 16;
constexpr int AP_RING = 8;
typedef __attribute__((address_space(3))) u32x4* lds_v4p;
template <int HF, int MODE, int RING> __device__ __forceinline__ void pass_u(const Ptrs& P, const bf16_t* hrow, float rstd, lds_v4p grp, u32x4 (&R)[RING][2], const unsigned char* img, const unsigned char* img_next, int sub) {
    unsigned xq[8]; float sx;
    {
        float xf[2][16]; float mx = 0.f;
#pragma unroll
        for (int i = 0; i < 2; ++i) { const int e0 = (sub + 16 * (2 * HF + i)) * 16;
#pragma unroll
            for (int q = 0; q < 4; ++q) { const u32x2 hb = *(const u32x2*)(hrow + e0 + 4 * q); const f32x4 gv = *(const f32x4*)(P.norm_ffn + e0 + 4 * q);
                xf[i][4 * q] = bflo(hb.x) * rstd * gv.x; xf[i][4 * q + 1] = bfhi(hb.x) * rstd * gv.y; xf[i][4 * q + 2] = bflo(hb.y) * rstd * gv.z; xf[i][4 * q + 3] = bfhi(hb.y) * rstd * gv.w;
                mx = fmaxf(fmaxf(mx, fmaxf(fabsf(xf[i][4 * q]), fabsf(xf[i][4 * q + 1]))), fmaxf(fabsf(xf[i][4 * q + 2]), fabsf(xf[i][4 * q + 3]))); } }
        mx = fmaxf(mx, AP_DPP(mx, 0xB1)); mx = fmaxf(mx, AP_DPP(mx, 0x4E)); mx = fmaxf(mx, AP_DPP(mx, 0x141)); mx = fmaxf(mx, AP_DPP(mx, 0x140));
        mx = fmaxf(mx, 1e-30f); sx = mx * (1.f / 127.f); const float qs = 127.f / mx;
#pragma unroll
        for (int i = 0; i < 2; ++i)
#pragma unroll
            for (int q = 0; q < 4; ++q) xq[4 * i + q] = pack_i8x4(xf[i][4 * q] * qs, xf[i][4 * q + 1] * qs, xf[i][4 * q + 2] * qs, xf[i][4 * q + 3] * qs);
    }
#pragma unroll 1
    for (int j = 0; j < 128; j += RING) {
        const int jn = (j + RING) & 127;
        __builtin_amdgcn_s_barrier();
        const unsigned char* tb = (j + RING < 128) ? img : img_next;
        unsigned nid[RING], part[RING], suv[RING], gsv[RING];
#pragma unroll
        for (int b4 = 0; b4 < RING / 4; ++b4) { const u32x4 na = grp[jn / 4 + b4];
            nid[4 * b4] = na.x; nid[4 * b4 + 1] = na.y; nid[4 * b4 + 2] = na.z; nid[4 * b4 + 3] = na.w;
            u32x4 pa = {}, sa = {}, ga = {};
            if (HF == 1) { pa = grp[96 + j / 4 + b4]; sa = grp[32 + j / 4 + b4]; ga = grp[64 + j / 4 + b4]; }
            part[4 * b4] = pa.x; part[4 * b4 + 1] = pa.y; part[4 * b4 + 2] = pa.z; part[4 * b4 + 3] = pa.w;
            suv[4 * b4] = sa.x; suv[4 * b4 + 1] = sa.y; suv[4 * b4 + 2] = sa.z; suv[4 * b4 + 3] = sa.w;
            gsv[4 * b4] = ga.x; gsv[4 * b4 + 1] = ga.y; gsv[4 * b4 + 2] = ga.z; gsv[4 * b4 + 3] = ga.w; }
        float outv[RING];
#pragma unroll
        for (int bq = 0; bq < RING; ++bq) {
            int d0_ = 0, d1_ = 0;
            if (MODE == 1) { asm volatile("" :: "v"(R[bq][0]), "v"(R[bq][1])); d0_ = (int)xq[0]; }
            else {
                d0_ = __builtin_amdgcn_sdot4((int)R[bq][0].x, (int)xq[0], d0_, false); d1_ = __builtin_amdgcn_sdot4((int)R[bq][0].y, (int)xq[1], d1_, false);
                d0_ = __builtin_amdgcn_sdot4((int)R[bq][0].z, (int)xq[2], d0_, false); d1_ = __builtin_amdgcn_sdot4((int)R[bq][0].w, (int)xq[3], d1_, false);
                d0_ = __builtin_amdgcn_sdot4((int)R[bq][1].x, (int)xq[4], d0_, false); d1_ = __builtin_amdgcn_sdot4((int)R[bq][1].y, (int)xq[5], d1_, false);
                d0_ = __builtin_amdgcn_sdot4((int)R[bq][1].z, (int)xq[6], d0_, false); d1_ = __builtin_amdgcn_sdot4((int)R[bq][1].w, (int)xq[7], d1_, false);
            }
            asm volatile("" ::: "memory");
            load_half(R[bq], tb, MODE == 2 ? (nid[bq] & 15u) : nid[bq], sub);
            asm volatile("" ::: "memory");
            float a_ = row16_sum((float)(d0_ + d1_)) * sx;
            if (HF == 1) { a_ = (a_ + __uint_as_float(part[bq])) * __uint_as_float(suv[bq]); a_ = __uint_as_float(gsv[bq]) * gelu_fast(a_); }
            outv[bq] = a_;
        }
        if (sub == 0) {
#pragma unroll
            for (int b4 = 0; b4 < RING / 4; ++b4) grp[96 + j / 4 + b4] = (u32x4){__float_as_uint(outv[4 * b4]), __float_as_uint(outv[4 * b4 + 1]), __float_as_uint(outv[4 * b4 + 2]), __float_as_uint(outv[4 * b4 + 3])}; }
    }
    asm volatile("s_waitcnt lgkmcnt(0)" ::: "memory");
}
template <int HF, int MODE, int RING> __device__ __forceinline__ void pass_v(float (&acc)[4][16], lds_v4p grp, u32x4 (&R)[RING][2], const unsigned char* img, const unsigned char* img_next, int sub) {
#pragma unroll 1
    for (int j = 0; j < 128; j += RING) {
        const int jn = (j + RING) & 127;
        __builtin_amdgcn_s_barrier();
        const unsigned char* tb = (j + RING < 128) ? img : img_next;
        unsigned nid[RING], cvv[RING];
#pragma unroll
        for (int b4 = 0; b4 < RING / 4; ++b4) { const u32x4 na = grp[jn / 4 + b4], ca = grp[96 + j / 4 + b4];
            nid[4 * b4] = na.x; nid[4 * b4 + 1] = na.y; nid[4 * b4 + 2] = na.z; nid[4 * b4 + 3] = na.w; cvv[4 * b4] = ca.x; cvv[4 * b4 + 1] = ca.y; cvv[4 * b4 + 2] = ca.z; cvv[4 * b4 + 3] = ca.w; }
#pragma unroll
        for (int bq = 0; bq < RING; ++bq) {
            const float c_ = __uint_as_float(cvv[bq]); const f32x2 c2 = {c_, c_};
            if (MODE == 1) { asm volatile("" :: "v"(R[bq][0]), "v"(R[bq][1])); acc[2 * HF][0] += c_; }
            else {
#pragma unroll
            for (int i = 0; i < 2; ++i) { const unsigned w_[4] = {R[bq][i].x, R[bq][i].y, R[bq][i].z, R[bq][i].w};
#pragma unroll
                for (int q = 0; q < 4; ++q) { const f32x2 lo_ = __builtin_amdgcn_cvt_pk_f32_fp8(w_[q], false), hi_ = __builtin_amdgcn_cvt_pk_f32_fp8(w_[q], true);
                    f32x2 a0 = {acc[2 * HF + i][4 * q], acc[2 * HF + i][4 * q + 1]}, a1 = {acc[2 * HF + i][4 * q + 2], acc[2 * HF + i][4 * q + 3]}; a0 += c2 * lo_; a1 += c2 * hi_;
                    acc[2 * HF + i][4 * q] = a0.x; acc[2 * HF + i][4 * q + 1] = a0.y; acc[2 * HF + i][4 * q + 2] = a1.x; acc[2 * HF + i][4 * q + 3] = a1.y; } }
            }
            asm volatile("" ::: "memory");
            load_half(R[bq], tb, MODE == 2 ? (nid[bq] & 15u) : nid[bq], sub);
            asm volatile("" ::: "memory");
        }
    }
}
template <int MODE> __device__ __forceinline__ void apply_round(const Ptrs& P, float* outbase, int tbase, unsigned char* shm_wave, int lane_in) {
    int lane = lane_in; asm volatile("" : "+v"(lane));
    const int sub = lane & 15, g = lane >> 4, t = tbase + g;
    __attribute__((address_space(3))) unsigned* cnt = (lds_u32p)(__attribute__((address_space(3))) unsigned char*)shm_wave + g * 128;
    lds_v4p grp = (lds_v4p)((__attribute__((address_space(3))) unsigned char*)shm_wave + 2048 + g * 2048);
    __attribute__((address_space(3))) unsigned* grp1 = (__attribute__((address_space(3))) unsigned*)grp;
    const unsigned char* U8 = P.ws + WS_U; const unsigned char* V8 = P.ws + WS_V;
    {
        const int* idxp = (const int*)(P.ws + WS_IDX) + (size_t)t * 128 + sub * 8; const float* gp = (const float*)(P.ws + WS_G) + (size_t)t * 128 + sub * 8;
        const u32x4 ia = *(const u32x4*)idxp, ib = *(const u32x4*)(idxp + 4); const f32x4 ga = *(const f32x4*)gp, gb = *(const f32x4*)(gp + 4);
        const int e[8] = {(int)ia.x, (int)ia.y, (int)ia.z, (int)ia.w, (int)ib.x, (int)ib.y, (int)ib.z, (int)ib.w};
        const float gt[8] = {ga.x, ga.y, ga.z, ga.w, gb.x, gb.y, gb.z, gb.w};
        float su[8], sv[8];
#pragma unroll
        for (int i = 0; i < 8; ++i) { su[i] = ((const float*)(P.ws + WS_SU))[e[i]]; sv[i] = ((const float*)(P.ws + WS_SV))[e[i]]; }
#pragma unroll
        for (int i = 0; i < 8; ++i) cnt[sub * 8 + i] = 0u;
        asm volatile("s_waitcnt lgkmcnt(0)" ::: "memory");
        unsigned pos[8];
#pragma unroll
        for (int i = 0; i < 8; ++i) pos[i] = __hip_atomic_fetch_add(cnt + (e[i] >> 7), 1u, __ATOMIC_RELAXED, __HIP_MEMORY_SCOPE_WAVEFRONT);
        asm volatile("s_waitcnt lgkmcnt(0)" ::: "memory");
        unsigned c[8]; unsigned tot = 0;
#pragma unroll
        for (int i = 0; i < 8; ++i) { c[i] = cnt[sub * 8 + i]; }
#pragma unroll
        for (int i = 0; i < 8; ++i) { const unsigned x = c[i]; c[i] = tot; tot += x; }
        unsigned inc = tot;
#pragma unroll
        for (int d = 1; d < 16; d <<= 1) { const unsigned y = __shfl_up(inc, d, 16); if (sub >= d) inc += y; }
        const unsigned base = inc - tot;
        asm volatile("s_waitcnt lgkmcnt(0)" ::: "memory");
#pragma unroll
        for (int i = 0; i < 8; ++i) cnt[sub * 8 + i] = base + c[i];
        asm volatile("s_waitcnt lgkmcnt(0)" ::: "memory");
#pragma unroll
        for (int i = 0; i < 8; ++i) { const unsigned p = cnt[e[i] >> 7] + pos[i];
            grp1[p] = (unsigned)e[i]; grp1[128 + p] = __float_as_uint(su[i]); grp1[256 + p] = __float_as_uint(gt[i] * sv[i]); }
        asm volatile("s_waitcnt lgkmcnt(0)" ::: "memory");
    }
    const bf16_t* hrow = (const bf16_t*)(P.ws + WS_HB) + (size_t)t * D;
    float rstd;
    { const float* ssq = (const float*)(P.ws + WS_SSQ) + (size_t)t * 16;
      const f32x4 s0 = *(const f32x4*)ssq, s1 = *(const f32x4*)(ssq + 4), s2 = *(const f32x4*)(ssq + 8), s3 = *(const f32x4*)(ssq + 12);
      const float tot = ((s0.x + s0.y) + (s0.z + s0.w)) + ((s1.x + s1.y) + (s1.z + s1.w)) + ((s2.x + s2.y) + (s2.z + s2.w)) + ((s3.x + s3.y) + (s3.z + s3.w));
      rstd = 1.f / sqrtf(tot * (1.f / D) + EPS); }
    constexpr int RG = (MODE == 1) ? AP_PROBE_RING : AP_RING;
    const unsigned char* U0 = U8; const unsigned char* U1 = U8 + (size_t)NEXP * 512; const unsigned char* V0 = V8; const unsigned char* V1 = V8 + (size_t)NEXP * 512;
    u32x4 R[RG][2];
    {
#pragma unroll
      for (int b4 = 0; b4 < RG / 4; ++b4) { const u32x4 ia = grp[b4]; load_half(R[4 * b4], U0, ia.x, sub); load_half(R[4 * b4 + 1], U0, ia.y, sub); load_half(R[4 * b4 + 2], U0, ia.z, sub); load_half(R[4 * b4 + 3], U0, ia.w, sub); } }
    pass_u<0, MODE, RG>(P, hrow, rstd, grp, R, U0, U1, sub);
    pass_u<1, MODE, RG>(P, hrow, rstd, grp, R, U1, V0, sub);
    float acc[4][16];
#pragma unroll
    for (int i = 0; i < 4; ++i)
#pragma unroll
        for (int q = 0; q < 16; ++q) acc[i][q] = 0.f;
    pass_v<0, MODE, RG>(acc, grp, R, V0, V1, sub);
    pass_v<1, MODE, RG>(acc, grp, R, V1, V1, sub);
    float ss = 0.f;
#pragma unroll
    for (int i = 0; i < 4; ++i) { const int e0 = (sub + 16 * i) * 16;
#pragma unroll
        for (int q = 0; q < 4; ++q) { const u32x2 hb = *(const u32x2*)(hrow + e0 + 4 * q);
            acc[i][4 * q] += bflo(hb.x); acc[i][4 * q + 1] += bfhi(hb.x); acc[i][4 * q + 2] += bflo(hb.y); acc[i][4 * q + 3] += bfhi(hb.y);
            ss += (acc[i][4 * q] * acc[i][4 * q] + acc[i][4 * q + 1] * acc[i][4 * q + 1]) + (acc[i][4 * q + 2] * acc[i][4 * q + 2] + acc[i][4 * q + 3] * acc[i][4 * q + 3]); }
        asm volatile("" ::: "memory"); }
    ss = row16_sum(ss);
    const float r2 = 1.f / sqrtf(ss * (1.f / D) + EPS);
    float* orow = outbase + (size_t)t * D;
#pragma unroll
    for (int i = 0; i < 4; ++i) { const int e0 = (sub + 16 * i) * 16;
#pragma unroll
        for (int q = 0; q < 4; ++q) { const f32x4 gv = *(const f32x4*)(P.norm_final + e0 + 4 * q);
            *(f32x4*)(orow + e0 + 4 * q) = (f32x4){acc[i][4 * q] * r2 * gv.x, acc[i][4 * q + 1] * r2 * gv.y, acc[i][4 * q + 2] * r2 * gv.z, acc[i][4 * q + 3] * r2 * gv.w}; }
        asm volatile("" ::: "memory"); }
}
template <int MODE> __device__ __forceinline__ void apply_phase(const Ptrs& P, float* outbase, unsigned char* shm, int G, int vcu) {
    int tid_l = threadIdx.x; asm volatile("" : "+v"(tid_l));
    const int lane = tid_l & 63; const int wave = __builtin_amdgcn_readfirstlane(tid_l >> 6);
    const int per = M / (G * 8);
#pragma unroll 1
    for (int r = 0; r < per; r += 4) apply_round<MODE>(P, outbase, (vcu * 8 + wave) * per + r, shm + wave * AP_WAVE_BYTES, lane);
}
}

#define LAS __attribute__((address_space(3)))
#define XB_TMO      128
#define XB_XCNT(j)  (256  + 64 * (j))
#define XB_XSUB(j)  (1280 + 64 * (j))
#define XB_XGEN(j)  (2304 + 64 * (j))
#define XB_TOP      3328
#define XB_TOPGEN   3392
#define XCD_BAR_WORDS 3456
#define XB_SPIN_CAP (1u << 18)

__device__ __forceinline__ unsigned xb_ld(unsigned* p)              { return __hip_atomic_load(p, __ATOMIC_RELAXED, __HIP_MEMORY_SCOPE_AGENT); }
__device__ __forceinline__ unsigned xb_add(unsigned* p, unsigned v) { return __hip_atomic_fetch_add(p, v, __ATOMIC_RELAXED, __HIP_MEMORY_SCOPE_AGENT); }
__device__ __forceinline__ unsigned xb_xcc_id() { return (unsigned)__builtin_amdgcn_s_getreg((3 << 11) | 20) & 0xFu; }
#define XB_SPIN(cond, bar) do { unsigned _sp = 0; while (cond) { __builtin_amdgcn_s_sleep(1); \
    if ((++_sp & 255u) == 0u) { if (xb_ld(&(bar)[XB_TMO])) break; if (_sp > XB_SPIN_CAP) { atomicAdd(&(bar)[XB_TMO], 1u); break; } } } } while (0)

struct XcdBarrier {
    unsigned* bar; unsigned x;
    volatile LAS unsigned* st;
};

__device__ __forceinline__ XcdBarrier xcd_barrier_post(unsigned* bar, volatile LAS unsigned* st) {
    XcdBarrier b; b.bar = bar; b.x = xb_xcc_id(); b.st = st;
    if (threadIdx.x == 0) (void)xb_add(&bar[XB_XCNT(b.x)], 1u);
    return b;
}
__device__ __forceinline__ void xcd_barrier_complete(unsigned* bar, unsigned x, unsigned& nloc, unsigned& nx) {
    const unsigned G = gridDim.x * gridDim.y * gridDim.z;
    unsigned sum, cnt, mine, sp = 0u;
    for (;;) {
        sum = 0u; cnt = 0u; mine = 0u;
#pragma unroll
        for (unsigned j = 0; j < 16; ++j) { const unsigned c = xb_ld(&bar[XB_XCNT(j)]); sum += c; cnt += (c > 0u) ? 1u : 0u; mine = (j == x) ? c : mine; }
        if (sum == G) break;
        __builtin_amdgcn_s_sleep(1);
        if ((++sp & 255u) == 0u) { if (xb_ld(&bar[XB_TMO])) break; if (sp > XB_SPIN_CAP) { atomicAdd(&bar[XB_TMO], 1u); break; } }
    }
    nloc = mine > 0u ? mine : 1u; nx = cnt > 0u ? cnt : 1u;
}

__device__ __forceinline__ void xcd_barrier(const XcdBarrier& b) {
    asm volatile("s_waitcnt vmcnt(0)" ::: "memory");
    __syncthreads();
    if (threadIdx.x == 0) {
        unsigned* bar = b.bar;
        __builtin_amdgcn_s_waitcnt(0);
        unsigned nloc = b.st[0], nx = b.st[1];
        if (nloc == 0u) { xcd_barrier_complete(bar, b.x, nloc, nx); b.st[0] = nloc; b.st[1] = nx; }
        const unsigned old = xb_add(&bar[XB_XSUB(b.x)], 1u);
        const unsigned gen = old / nloc;
        if (old + 1u == (gen + 1u) * nloc) {
            __builtin_amdgcn_fence(__ATOMIC_RELEASE, "agent");
            asm volatile("s_waitcnt vmcnt(0)" ::: "memory");
            const unsigned og = xb_add(&bar[XB_TOP], 1u);
            const unsigned tg = og / nx;
            if (og + 1u == (tg + 1u) * nx) xb_add(&bar[XB_TOPGEN], 1u);
            else XB_SPIN(xb_ld(&bar[XB_TOPGEN]) == tg, bar);
            __builtin_amdgcn_fence(__ATOMIC_ACQUIRE, "agent");
            xb_add(&bar[XB_XGEN(b.x)], 1u);
            asm volatile("s_waitcnt vmcnt(0)" ::: "memory");
        } else {
            XB_SPIN(xb_ld(&bar[XB_XGEN(b.x)]) == gen, bar);
            __builtin_amdgcn_fence(__ATOMIC_ACQUIRE, "agent");
            asm volatile("s_waitcnt vmcnt(0)" ::: "memory");
        }
    }
    __syncthreads();
}


namespace cg = cooperative_groups;
#ifndef REP_MASK
#define REP_MASK 0
#endif
#define REPS(k) (((REP_MASK) >> (k)) & 1 ? 2 : 1)
constexpr int PHASE_LDS = att::A_LDS_BYTES;
constexpr int MEGA_LDS = PHASE_LDS + 64;
static_assert(PHASE_LDS >= pg8::STAGE_BYTES && PHASE_LDS >= att::B_LDS_BYTES && PHASE_LDS >= peer::T_LDS_BYTES && PHASE_LDS >= 8 * 64 * 33 * 4 && PHASE_LDS >= apply::AP_LDS_BYTES, "LDS budget");
__global__ void __launch_bounds__(512, 2) mega_fwd(Ptrs P) {
    extern __shared__ __attribute__((aligned(16))) unsigned char lds_dyn[];
    volatile LAS unsigned* bst = (volatile LAS unsigned*)((LAS unsigned char*)lds_dyn + PHASE_LDS);
    if (threadIdx.x < 2) bst[threadIdx.x] = 0u;
    __syncthreads();
    const XcdBarrier bar = xcd_barrier_post((unsigned*)(P.ws + WS_CTL), bst);
    const int G = (int)gridDim.x, bx = (int)blockIdx.x, vcu = (G % 8 == 0) ? (bx % 8) * (G / 8) + bx / 8 : bx;
    unsigned char* ws = P.ws;
    PG8_LAS unsigned char* lds3 = (PG8_LAS unsigned char*)lds_dyn;
    for (int rep = 0; rep < REPS(0); ++rep) prep_phase(P, lds_dyn, G, bx);
    xcd_barrier(bar); if (REPS(9) == 2) xcd_barrier(bar);
    for (int rep = 0; rep < REPS(1); ++rep) {
      { pg8::Gemm g{(const bf16_t*)(ws + WS_XN), (const bf16_t*)(ws + WS_WIN), M, 1024, D, 0}; pg8::StaticOrder S; S.init(M, 1024, G, bx);
        pg8::gemm_phase<pg8::EpiProj, pg8::StaticOrder, true, true, false>(lds3, g, S, pg8::EpiProj{(bf16_t*)(ws + WS_PROJ), (const float*)(ws + WS_ROPE), 1.f, 0}); }
      { pg8::Gemm g{(const bf16_t*)(ws + WS_XN8), (const bf16_t*)(ws + WS_WIN8), M, INW - 1024, D / 2, 0}; pg8::StaticOrder S; S.init(M, INW - 1024, G, bx);
        pg8::gemm_phase<pg8::EpiProj, pg8::StaticOrder, true, true, true>(lds3, g, S, pg8::EpiProj{(bf16_t*)(ws + WS_PROJ), (const float*)(ws + WS_ROPE), 1.f / WIN_SCALE, 4}); } }
    xcd_barrier(bar); if (REPS(9) == 2) xcd_barrier(bar);
    { const float lam = lambda_full(P);
      for (int rep = 0; rep < REPS(2); ++rep) for (int u = vcu; u < BATCH * 4 * 8; u += G) att::attn_a_unit(u >> 5, (u >> 3) & 3, u & 7, (const bf16_t*)(ws + WS_PROJ), (bf16_t*)(ws + WS_YA), P.subln, lam, lds_dyn);
      for (int rep = 0; rep < REPS(3); ++rep) for (int u = vcu; u < BATCH * 8 * 8; u += G) att::attn_b_unit(u >> 6, (u >> 3) & 7, u & 7, (const bf16_t*)(ws + WS_PROJ), (bf16_t*)(ws + WS_YA), P.rpb, lds_dyn); }
    xcd_barrier(bar); if (REPS(9) == 2) xcd_barrier(bar);
    for (int rep = 0; rep < REPS(4); ++rep) { pg8::StaticOrder S; S.init(M, D, G, bx);
      pg8::gemm_phase<pg8::EpiGate2, pg8::StaticOrder, true, true>(lds3, pg8::Gemm{(const bf16_t*)(ws + WS_YA), (const bf16_t*)(ws + WS_WPA), M, D, D, 0}, S, pg8::EpiGate2{(const bf16_t*)(ws + WS_PROJ), (bf16_t*)(ws + WS_MERGED)}); }
    xcd_barrier(bar); if (REPS(9) == 2) xcd_barrier(bar);
    for (int rep = 0; rep < REPS(5); ++rep) { pg8::StaticOrder S; S.init(M, D, G, bx);
      pg8::gemm_phase<pg8::EpiHout, pg8::StaticOrder, true, true>(lds3, pg8::Gemm{(const bf16_t*)(ws + WS_MERGED), (const bf16_t*)(ws + WS_WOUT), M, D, D, 0}, S, pg8::EpiHout{P.x, P.out, (bf16_t*)(ws + WS_HB), (float*)(ws + WS_SSQ)});
    }
    xcd_barrier(bar); if (REPS(9) == 2) xcd_barrier(bar);
    { pg8::StaticOrder S; S.init(M, PQ, G, bx);
      for (int rep = 0; rep < REPS(8); ++rep)
        pg8::gemm_phase<pg8::EpiQ, pg8::StaticOrder, true, true>(lds3, pg8::Gemm{(const bf16_t*)(ws + WS_HB), (const bf16_t*)(ws + WS_WQ), M, PQ, D, 0}, S, pg8::EpiQ{(const float*)(ws + WS_SSQ), (bf16_t*)(ws + WS_Q)});
      asm volatile("s_waitcnt vmcnt(0)" ::: "memory");
      __syncthreads();
      if (threadIdx.x == 0) { __builtin_amdgcn_fence(__ATOMIC_ACQUIRE, "agent"); asm volatile("s_waitcnt vmcnt(0)" ::: "memory"); }
      __syncthreads();
      for (int rep = 0; rep < REPS(6); ++rep) peer::topk_own_units(P, lds_dyn, S); }
    xcd_barrier(bar); if (REPS(9) == 2) xcd_barrier(bar);
#ifndef PROBE_MODE
#define PROBE_MODE 0
#endif
    if (REPS(7) == 2) apply::apply_phase<PROBE_MODE>(P, (float*)(ws + WS_Q), lds_dyn, G, vcu);
    apply::apply_phase<0>(P, P.out, lds_dyn, G, vcu);
}

extern "C" void kernel_launch(void* const* d_in, const int* in_sizes, int n_in, void* d_out, int out_size, void* d_ws, size_t ws_size, hipStream_t stream) {
    if (n_in != 18 || ws_size < WS_END) { fprintf(stderr, "kernel_launch: unexpected n_in %d / ws_size %zu\n", n_in, ws_size); return; }
    Ptrs P{};
    P.x = (const float*)d_in[0]; P.w_in = (const float*)d_in[1]; P.w_pa = (const float*)d_in[2]; P.w_pb = (const float*)d_in[3]; P.w_out = (const float*)d_in[4];
    P.norm_mix = (const float*)d_in[5]; P.norm_ffn = (const float*)d_in[6]; P.norm_final = (const float*)d_in[7];
    P.lq1 = (const float*)d_in[8]; P.lk1 = (const float*)d_in[9]; P.lq2 = (const float*)d_in[10]; P.lk2 = (const float*)d_in[11];
    P.subln = (const float*)d_in[12]; P.rpb = (const float*)d_in[13]; P.w_query = (const float*)d_in[14]; P.sub_keys = (const float*)d_in[15];
    P.peer_u = (const float*)d_in[16]; P.peer_v = (const float*)d_in[17];
    P.out = (float*)d_out; P.ws = (unsigned char*)d_ws;
    static int grid_blocks = 0;
    if (!grid_blocks) {
        int dev = 0, cus = 0, per_cu = 0;
        hipGetDevice(&dev);
        hipDeviceGetAttribute(&cus, hipDeviceAttributeMultiprocessorCount, dev);
        hipFuncSetAttribute((const void*)mega_fwd, hipFuncAttributeMaxDynamicSharedMemorySize, MEGA_LDS);
        hipOccupancyMaxActiveBlocksPerMultiprocessor(&per_cu, (const void*)mega_fwd, 512, MEGA_LDS);
        if (per_cu < 1) { fprintf(stderr, "kernel_launch: occupancy query says %d blocks per CU\n", per_cu); per_cu = 1; }
        grid_blocks = cus * per_cu;
    }
    hipMemsetAsync((unsigned char*)d_ws + WS_CTL, 0, 16384, stream);
    void* args[] = {&P};
    hipError_t e = hipLaunchCooperativeKernel((const void*)mega_fwd, dim3(grid_blocks), dim3(512), args, MEGA_LDS, stream);
    if (e != hipSuccess) fprintf(stderr, "cooperative launch failed: %s (grid %d)\n", hipGetErrorString(e), grid_blocks);
}
```

```cpp
#include <hip/hip_runtime.h>
#include <hip/hip_cooperative_groups.h>
#include <cstdio>
#include <cstdint>

typedef unsigned short bf16_t;
typedef unsigned u32x4 __attribute__((ext_vector_type(4)));
typedef unsigned u32x2 __attribute__((ext_vector_type(2)));
typedef float f32x4 __attribute__((ext_vector_type(4)));
typedef __bf16 bf16x2_t __attribute__((ext_vector_type(2)));

constexpr int D = 1024, BATCH = 8, SEQ = 2048, M = BATCH * SEQ, INW = 5120;
constexpr int C_QA = 0, C_KA = 512, C_VA = 1024, C_QB = 1536, C_KB = 2048, C_VB = 2560, C_GA = 3072, C_GB = 4096;
constexpr int NEXP = 16384, PQ = 2048;
constexpr float EPS = 1e-6f;
constexpr float LOG2E = 1.4426950408889634f;
constexpr float WIN_SCALE = 32.f;
constexpr float QSCALE = 0.125f * LOG2E;

constexpr size_t MiB = 1u << 20;
constexpr size_t WS_PROJ = 0;
constexpr size_t WS_HB = 0;
constexpr size_t WS_Q = 32 * MiB;
constexpr size_t WS_U = 96 * MiB;
constexpr size_t WS_V = 112 * MiB;
constexpr size_t WS_SU = 128 * MiB;
constexpr size_t WS_SV = 128 * MiB + 65536;
constexpr size_t WS_XN = 160 * MiB;
constexpr size_t WS_YA = 160 * MiB;
constexpr size_t WS_YB = 176 * MiB;
constexpr size_t WS_IDX = 160 * MiB;
constexpr size_t WS_G = 168 * MiB;
constexpr size_t WS_MERGED = 192 * MiB;
constexpr size_t WS_TOPV = 192 * MiB;
constexpr size_t WS_TOPI = 208 * MiB;
constexpr size_t WS_WIN = 224 * MiB;
constexpr size_t WS_WIN8 = 226 * MiB;
constexpr size_t WS_XN8 = 192 * MiB;
constexpr size_t WS_WQ = 234 * MiB;
constexpr size_t WS_WOUT = 238 * MiB;
constexpr size_t WS_WPA = 240 * MiB;
constexpr size_t WS_WPB = 241 * MiB;
constexpr size_t WS_SK = 242 * MiB;
constexpr size_t WS_ROPE = 242 * MiB + 512 * 1024;
constexpr size_t WS_SSQ = 243 * MiB;
constexpr size_t WS_CTL = 244 * MiB;
constexpr size_t WS_END = 256 * MiB;

__device__ __forceinline__ float bf2f(unsigned v) { return __uint_as_float(v << 16); }
__device__ __forceinline__ float bflo(unsigned w) { return __uint_as_float(w << 16); }
__device__ __forceinline__ float bfhi(unsigned w) { return __uint_as_float(w & 0xffff0000u); }
__device__ __forceinline__ unsigned f2bf(float f) { unsigned u = __float_as_uint(f); return (u + 0x7fffu + ((u >> 16) & 1u)) >> 16; }
__device__ __forceinline__ unsigned pk2(float lo, float hi) { return f2bf(lo) | (f2bf(hi) << 16); }
__device__ __forceinline__ float wave_sum(float v) {
#pragma unroll
    for (int o = 1; o < 64; o <<= 1) v += __shfl_xor(v, o);
    return v;
}
__device__ __forceinline__ float sigmoidf_(float x) { return 1.f / (1.f + __expf(-x)); }
__device__ __forceinline__ float gelu_exact(float x) { return 0.5f * x * (1.f + erff(x * 0.70710678118654752f)); }

struct Ptrs {
    const float *x, *w_in, *w_pa, *w_pb, *w_out, *norm_mix, *norm_ffn, *norm_final, *lq1, *lk1, *lq2, *lk2, *subln, *rpb, *w_query, *sub_keys, *peer_u, *peer_v;
    float* out; unsigned char* ws;
};

__device__ __forceinline__ void transpose_item(const float* W, int K, int N, const float* gain, bf16_t* WT, float* scr, int item, int lane, int ldo = 0, int koff = 0, int ldw = 0) {
    if (ldo == 0) ldo = K;
    if (ldw == 0) ldw = N;
    const int nblk = N / 32, kb = item / nblk, nb = item % nblk, k0 = 64 * kb, n0 = 32 * nb;
    float wv[32];
#pragma unroll
    for (int i = 0; i < 32; ++i) { const int kk = 2 * i + (lane >> 5); wv[i] = W[(size_t)(k0 + kk) * ldw + n0 + (lane & 31)]; }
#pragma unroll
    for (int i = 0; i < 32; ++i) { const int kk = 2 * i + (lane >> 5); float w = wv[i]; if (gain) w *= gain[k0 + kk]; scr[kk * 33 + (lane & 31)] = w; }
    asm volatile("s_waitcnt lgkmcnt(0)" ::: "memory");
    const int c = lane & 7;
#pragma unroll
    for (int j = 0; j < 4; ++j) { const int n = (lane >> 3) + 8 * j; const float* s = scr + (8 * c) * 33 + n;
        u32x4 o; o.x = pk2(s[0 * 33], s[1 * 33]); o.y = pk2(s[2 * 33], s[3 * 33]); o.z = pk2(s[4 * 33], s[5 * 33]); o.w = pk2(s[6 * 33], s[7 * 33]);
        *(u32x4*)(WT + (size_t)(n0 + n) * ldo + koff + k0 + 8 * c) = o; }
    asm volatile("s_waitcnt lgkmcnt(0)" ::: "memory");
}
__device__ __forceinline__ void cvt8(const float* src, bf16_t* dst, size_t i8) {
    const f32x4 a = *(const f32x4*)(src + i8 * 8), b = *(const f32x4*)(src + i8 * 8 + 4);
    u32x4 o; o.x = pk2(a.x, a.y); o.y = pk2(a.z, a.w); o.z = pk2(b.x, b.y); o.w = pk2(b.z, b.w);
    *(u32x4*)(dst + i8 * 8) = o;
}
__device__ __forceinline__ void transpose_item8(const float* W, int K, int N, int ldw, const float* gain, float wscale, unsigned char* WT, float* scr, int item, int lane) {
    const int nblk = N / 32, kb = item / nblk, nb = item % nblk, k0 = 64 * kb, n0 = 32 * nb;
    float wv[32];
#pragma unroll
    for (int i = 0; i < 32; ++i) { const int kk = 2 * i + (lane >> 5); wv[i] = W[(size_t)(k0 + kk) * ldw + n0 + (lane & 31)]; }
#pragma unroll
    for (int i = 0; i < 32; ++i) { const int kk = 2 * i + (lane >> 5); float w = wv[i] * wscale; if (gain) w *= gain[k0 + kk]; scr[kk * 33 + (lane & 31)] = w; }
    asm volatile("s_waitcnt lgkmcnt(0)" ::: "memory");
    const int c = lane & 7;
#pragma unroll
    for (int j = 0; j < 4; ++j) { const int n = (lane >> 3) + 8 * j; const float* s = scr + (8 * c) * 33 + n;
        u32x2 o; o.x = __builtin_amdgcn_cvt_pk_fp8_f32(s[0 * 33], s[1 * 33], 0u, false); o.x = __builtin_amdgcn_cvt_pk_fp8_f32(s[2 * 33], s[3 * 33], o.x, true);
        o.y = __builtin_amdgcn_cvt_pk_fp8_f32(s[4 * 33], s[5 * 33], 0u, false); o.y = __builtin_amdgcn_cvt_pk_fp8_f32(s[6 * 33], s[7 * 33], o.y, true);
        *(u32x2*)(WT + (size_t)(n0 + n) * K + k0 + 8 * c) = o; }
    asm volatile("s_waitcnt lgkmcnt(0)" ::: "memory");
}
__device__ __forceinline__ void rms_rows_emit(const f32x4 (&v)[4], bf16_t* orow16, unsigned char* orow, int lane) {
    float s = 0.f;
#pragma unroll
    for (int j = 0; j < 4; ++j) s += (v[j].x * v[j].x + v[j].y * v[j].y) + (v[j].z * v[j].z + v[j].w * v[j].w);
    const float rstd = 1.f / sqrtf(wave_sum(s) * (1.f / D) + EPS);
    unsigned* o4 = (unsigned*)orow + lane; u32x2* o8 = (u32x2*)orow16 + lane;
#pragma unroll
    for (int j = 0; j < 4; ++j) { unsigned w = __builtin_amdgcn_cvt_pk_fp8_f32(v[j].x * rstd, v[j].y * rstd, 0u, false); w = __builtin_amdgcn_cvt_pk_fp8_f32(v[j].z * rstd, v[j].w * rstd, w, true); o4[64 * j] = w;
        u32x2 w2; w2.x = pk2(v[j].x * rstd, v[j].y * rstd); w2.y = pk2(v[j].z * rstd, v[j].w * rstd); o8[64 * j] = w2; }
}
__device__ __forceinline__ void rms_rows(const float* x, bf16_t* xn16, unsigned char* xn8, int m0, int step, int lane) {
    if (m0 >= M) return;
    f32x4 cur[4], nxt[4];
#pragma unroll
    for (int j = 0; j < 4; ++j) cur[j] = ((const f32x4*)(x + (size_t)m0 * D) + lane)[64 * j];
    for (int m = m0; m < M; m += step) {
        const int mn = (m + step < M) ? m + step : m;
#pragma unroll
        for (int j = 0; j < 4; ++j) nxt[j] = ((const f32x4*)(x + (size_t)mn * D) + lane)[64 * j];
        rms_rows_emit(cur, xn16 + (size_t)m * D, xn8 + (size_t)m * D, lane);
#pragma unroll
        for (int j = 0; j < 4; ++j) cur[j] = nxt[j];
    }
}
__device__ __forceinline__ void rms_row_to_bf16(const float* xrow, bf16_t* orow, int lane) {
    const f32x4* xr = (const f32x4*)xrow + lane;
    f32x4 v[4]; float s = 0.f;
#pragma unroll
    for (int j = 0; j < 4; ++j) { v[j] = xr[64 * j]; s += (v[j].x * v[j].x + v[j].y * v[j].y) + (v[j].z * v[j].z + v[j].w * v[j].w); }
    const float rstd = 1.f / sqrtf(wave_sum(s) * (1.f / D) + EPS);
    u32x2* o8 = (u32x2*)orow + lane;
#pragma unroll
    for (int j = 0; j < 4; ++j) { u32x2 w; w.x = pk2(v[j].x * rstd, v[j].y * rstd); w.y = pk2(v[j].z * rstd, v[j].w * rstd); o8[64 * j] = w; }
}

__device__ __forceinline__ void prep_phase(const Ptrs& P, unsigned char* shm, int G, int bx) {
    int tid_l = threadIdx.x; asm volatile("" : "+v"(tid_l));
    const int lane = tid_l & 63; const int wave = __builtin_amdgcn_readfirstlane(tid_l >> 6);
    const int gw = bx * 8 + wave, NGW = G * 8;
    float* scr = (float*)(shm + wave * (64 * 33 * 4));
    unsigned char* ws = P.ws;
    constexpr int N_BF = 1024;
    constexpr int I_INB = (D / 64) * (N_BF / 32), I_IN8 = (D / 64) * ((INW - N_BF) / 32), I_IN = I_INB + I_IN8, I_Q = (D / 64) * (PQ / 32), I_OUT = (D / 64) * (D / 32), I_PA = (512 / 64) * (D / 32);
    constexpr int NIT = I_IN + I_Q + I_OUT + 2 * I_PA;
    for (int it = gw; it < NIT; it += NGW) {
        int r = it;
        if (r < I_INB) { transpose_item(P.w_in, D, N_BF, P.norm_mix, (bf16_t*)(ws + WS_WIN), scr, r, lane, 0, 0, INW); continue; } r -= I_INB;
        if (r < I_IN8) { transpose_item8(P.w_in + N_BF, D, INW - N_BF, INW, P.norm_mix, WIN_SCALE, ws + WS_WIN8, scr, r, lane); continue; } r -= I_IN8;
        if (r < I_Q) { transpose_item(P.w_query, D, PQ, P.norm_ffn, (bf16_t*)(ws + WS_WQ), scr, r, lane); continue; } r -= I_Q;
        if (r < I_OUT) { transpose_item(P.w_out, D, D, nullptr, (bf16_t*)(ws + WS_WOUT), scr, r, lane); continue; } r -= I_OUT;
        if (r < I_PA) { transpose_item(P.w_pa, 512, D, nullptr, (bf16_t*)(ws + WS_WPA), scr, r, lane, 1024, 0); continue; } r -= I_PA;
        transpose_item(P.w_pb, 512, D, nullptr, (bf16_t*)(ws + WS_WPA), scr, r, lane, 1024, 512);
    }
    rms_rows(P.x, (bf16_t*)(ws + WS_XN), ws + WS_XN8, gw, NGW, lane);
    const size_t gt = (size_t)bx * 512 + threadIdx.x, NT = (size_t)G * 512;
    for (size_t i = gt; i < (size_t)16 * 128 * 128 / 8; i += NT) cvt8(P.sub_keys, (bf16_t*)(ws + WS_SK), i);
    for (size_t i = gt; i < (size_t)SEQ * 8; i += NT) {
        const int pos = (int)(i >> 3), k = (int)(i & 7);
        const float inv = k == 0 ? 1.0f : k == 1 ? 0.19392274f : k == 2 ? 0.03760603f : k == 3 ? 0.0072926646f : k == 4 ? 0.0014142136f : k == 5 ? 0.0002742482f : k == 6 ? 5.3182957e-05f : 1.0313385e-05f;
        const float ang = (float)pos * inv;
        float sn, cs; sincosf(ang, &sn, &cs);
        float* t = (float*)(ws + WS_ROPE) + (size_t)pos * 16;
        t[k] = cs; t[8 + k] = sn;
    }
}
__device__ __forceinline__ void cvt_row_fp8(const f32x4 (&rv)[4], unsigned char* dst, float* inv_scale, int lane) {
    const f32x4 a = rv[0], b = rv[1], c = rv[2], d = rv[3];
    float m = fmaxf(fmaxf(fmaxf(fabsf(a.x), fabsf(a.y)), fmaxf(fabsf(a.z), fabsf(a.w))), fmaxf(fmaxf(fabsf(b.x), fabsf(b.y)), fmaxf(fabsf(b.z), fabsf(b.w))));
    m = fmaxf(m, fmaxf(fmaxf(fmaxf(fabsf(c.x), fabsf(c.y)), fmaxf(fabsf(c.z), fabsf(c.w))), fmaxf(fmaxf(fabsf(d.x), fabsf(d.y)), fmaxf(fabsf(d.z), fabsf(d.w)))));
#pragma unroll
    for (int o = 1; o < 64; o <<= 1) m = fmaxf(m, __shfl_xor(m, o));
    m = fmaxf(m, 1e-30f);
    const float sc = 256.f / m;
    u32x4 w;
    w.x = __builtin_amdgcn_cvt_pk_fp8_f32(a.x * sc, a.y * sc, 0u, false); w.x = __builtin_amdgcn_cvt_pk_fp8_f32(a.z * sc, a.w * sc, w.x, true);
    w.y = __builtin_amdgcn_cvt_pk_fp8_f32(b.x * sc, b.y * sc, 0u, false); w.y = __builtin_amdgcn_cvt_pk_fp8_f32(b.z * sc, b.w * sc, w.y, true);
    w.z = __builtin_amdgcn_cvt_pk_fp8_f32(c.x * sc, c.y * sc, 0u, false); w.z = __builtin_amdgcn_cvt_pk_fp8_f32(c.z * sc, c.w * sc, w.z, true);
    w.w = __builtin_amdgcn_cvt_pk_fp8_f32(d.x * sc, d.y * sc, 0u, false); w.w = __builtin_amdgcn_cvt_pk_fp8_f32(d.z * sc, d.w * sc, w.w, true);
    *(u32x4*)(dst + (size_t)(lane >> 5) * (NEXP * 512) + (lane & 31) * 16) = w;
    if (lane == 0) *inv_scale = m * (1.f / 256.f);
}
__device__ __forceinline__ unsigned nib4(float v, float sc) { const int q = (int)rintf(fminf(fmaxf(v * sc, -7.f), 7.f)); return (unsigned)q & 15u; }
__device__ __forceinline__ unsigned pack_i4x8(const f32x4& a, const f32x4& b, float sc) {
    return nib4(a.x, sc) | (nib4(a.y, sc) << 4) | (nib4(a.z, sc) << 8) | (nib4(a.w, sc) << 12) | (nib4(b.x, sc) << 16) | (nib4(b.y, sc) << 20) | (nib4(b.z, sc) << 24) | (nib4(b.w, sc) << 28);
}
__device__ __forceinline__ void cvt_row_i4(const f32x4 (&rv)[4], unsigned char* dst, float* inv_scale, int lane) {
    const f32x4 a = rv[0], b = rv[1], c = rv[2], d = rv[3];
    float ss = ((a.x * a.x + a.y * a.y) + (a.z * a.z + a.w * a.w)) + ((b.x * b.x + b.y * b.y) + (b.z * b.z + b.w * b.w));
    ss += ((c.x * c.x + c.y * c.y) + (c.z * c.z + c.w * c.w)) + ((d.x * d.x + d.y * d.y) + (d.z * d.z + d.w * d.w));
#pragma unroll
    for (int o = 1; o < 64; o <<= 1) ss += __shfl_xor(ss, o);
    const float rms = fmaxf(sqrtf(ss * (1.f / D)), 1e-30f);
    const float sc = 2.8f / rms;
    u32x2 w; w.x = pack_i4x8(a, b, sc); w.y = pack_i4x8(c, d, sc);
    *(u32x2*)(dst + (size_t)(lane >> 5) * (NEXP * 256) + (lane & 15) * 16 + ((lane >> 4) & 1) * 8) = w;
    if (lane == 0) *inv_scale = rms * (2.5f / 7.f);
}
__device__ __forceinline__ unsigned pack_i8x4(float a, float b, float c, float d) {
    const int q0 = (int)rintf(a), q1 = (int)rintf(b), q2 = (int)rintf(c), q3 = (int)rintf(d);
    return (unsigned)(q0 & 0xff) | ((unsigned)(q1 & 0xff) << 8) | ((unsigned)(q2 & 0xff) << 16) | ((unsigned)q3 << 24);
}
__device__ __forceinline__ void cvt_row_i8(const f32x4 (&rv)[4], unsigned char* dst, float* inv_scale, int lane) {
    const f32x4 a = rv[0], b = rv[1], c = rv[2], d = rv[3];
    float m = fmaxf(fmaxf(fmaxf(fabsf(a.x), fabsf(a.y)), fmaxf(fabsf(a.z), fabsf(a.w))), fmaxf(fmaxf(fabsf(b.x), fabsf(b.y)), fmaxf(fabsf(b.z), fabsf(b.w))));
    m = fmaxf(m, fmaxf(fmaxf(fmaxf(fabsf(c.x), fabsf(c.y)), fmaxf(fabsf(c.z), fabsf(c.w))), fmaxf(fmaxf(fabsf(d.x), fabsf(d.y)), fmaxf(fabsf(d.z), fabsf(d.w)))));
#pragma unroll
    for (int o = 1; o < 64; o <<= 1) m = fmaxf(m, __shfl_xor(m, o));
    m = fmaxf(m, 1e-30f);
    const float sc = 127.f / m;
    u32x4 w;
    w.x = pack_i8x4(a.x * sc, a.y * sc, a.z * sc, a.w * sc); w.y = pack_i8x4(b.x * sc, b.y * sc, b.z * sc, b.w * sc);
    w.z = pack_i8x4(c.x * sc, c.y * sc, c.z * sc, c.w * sc); w.w = pack_i8x4(d.x * sc, d.y * sc, d.z * sc, d.w * sc);
    *(u32x4*)(dst + (size_t)(lane >> 5) * (NEXP * 512) + (lane & 31) * 16) = w;
    if (lane == 0) *inv_scale = m * (1.f / 127.f);
}
__device__ __forceinline__ void cvt_experts_phase(const Ptrs& P, int G, int bx) {
    int tid_l = threadIdx.x; asm volatile("" : "+v"(tid_l));
    const int lane = tid_l & 63; const int wave = __builtin_amdgcn_readfirstlane(tid_l >> 6);
    const int step = G * 8; int r = bx * 8 + wave;
    if (r >= 2 * NEXP) return;
    f32x4 cur[4], nxt[4];
    { const float* src = (r < NEXP ? P.peer_u + (size_t)r * D : P.peer_v + (size_t)(r - NEXP) * D);
#pragma unroll
      for (int j = 0; j < 4; ++j) cur[j] = ((const f32x4*)src + lane * 4)[j]; }
    for (; r < 2 * NEXP; r += step) {
        const int rn = (r + step < 2 * NEXP) ? r + step : r;
        const float* srcn = (rn < NEXP ? P.peer_u + (size_t)rn * D : P.peer_v + (size_t)(rn - NEXP) * D);
#pragma unroll
        for (int j = 0; j < 4; ++j) nxt[j] = ((const f32x4*)srcn + lane * 4)[j];
        if (r < NEXP) cvt_row_i8(cur, P.ws + WS_U + (size_t)r * 512, (float*)(P.ws + WS_SU) + r, lane);
        else { const int e = r - NEXP; cvt_row_fp8(cur, P.ws + WS_V + (size_t)e * 512, (float*)(P.ws + WS_SV) + e, lane); }
#pragma unroll
        for (int j = 0; j < 4; ++j) cur[j] = nxt[j];
    }
}

namespace pg8 {
#define PG8_LAS __attribute__((address_space(3)))
typedef unsigned short bf16_t;
typedef short bf16x8 __attribute__((ext_vector_type(8)));
typedef float f32x4 __attribute__((ext_vector_type(4)));
typedef unsigned u32x4 __attribute__((ext_vector_type(4)));
typedef int v8i_t __attribute__((ext_vector_type(8)));
constexpr int BM = 256, BK = 64, HALF = 128, HTB = HALF * BK * 2  , STAGE_BYTES = 8 * HTB, NXCD = 8, WGM = 4;

__host__ __device__ __forceinline__ int lds_byte(int r, int c) { const int st = (r >> 4) * 2 + (c >> 5), rr = r & 15, cc = c & 31, ob = rr * 64 + cc * 2; return st * 1024 + (ob ^ (((ob >> 9) & 1) << 5)); }
__host__ __device__ __forceinline__ void stage_rc(int b, int& R, int& C) { const int st = b / 1024, sb = b % 1024, swz = sb ^ (((sb >> 9) & 1) << 5); R = (st >> 1) * 16 + swz / 64; C = (st & 1) * 32 + (swz % 64) / 2; }
__host__ __device__ __forceinline__ int perm32(int rho) { const int n = rho >> 4, i = rho & 15; return 8 * (i >> 2) + 4 * n + (i & 3); }

struct Unit { int pm, pn; };
struct Gemm { const bf16_t* A; const bf16_t* Bt; int M, N, K, pad; };

struct StaticOrder {
    int nM, nN, nwg, G, c;
    __host__ __device__ void init(int M, int N, int G_, int c_) { nM = M / BM; nN = N / BM; nwg = nM * nN; G = G_; c = c_; }
    __host__ __device__ bool next(int i, Unit& u) const {
        const long L = (long)i * G + c; if (L >= nwg) return false;
        int wgid = (int)L; { const int q = nwg / NXCD, r = nwg % NXCD, xcd = wgid % NXCD, off = wgid / NXCD; wgid = (xcd < r ? xcd * (q + 1) : r * (q + 1) + (xcd - r) * q) + off; }
        const int nig = WGM * nN, gid = wgid / nig, fm = gid * WGM, gsz = (nM - fm) < WGM ? (nM - fm) : WGM;
        u.pm = fm + ((wgid % nig) % gsz); u.pn = (wgid % nig) / gsz; return true;
    }
    __device__ __forceinline__ void a_ready(const Unit&) const {}
    __device__ __forceinline__ void done(const Unit&) const {}
};
__device__ __forceinline__ unsigned cvt_pk_bf16(float lo, float hi) { unsigned r; asm volatile("v_cvt_pk_bf16_f32 %0, %1, %2" : "=v"(r) : "v"(lo), "v"(hi)); return r; }
typedef float f32x2 __attribute__((ext_vector_type(2)));

__device__ __forceinline__ float sigm(float x) { return __builtin_amdgcn_rcpf(1.f + __builtin_amdgcn_exp2f(-1.4426950408889634f * x)); }
struct EpiProj {
    static constexpr bool PERM = true, AFTER_DRAIN = false, MID = false;
    bf16_t* O; const float* rope; float osc; int pn0;
    __device__ __forceinline__ void operator()(const f32x4 (&acc)[2][2][4][2], const Unit& u, int wr, int wc, int fr_, int fq_) const {
        int fr = fr_, fq = fq_; asm volatile("" : "+v"(fr), "+v"(fq));
        const int pn = u.pn + pn0;
        const int row0 = u.pm * BM + wr * 64 + fr, col0 = pn * BM + wc * 32 + 8 * fq;
        const float sc = ((pn < 2 || pn == 6 || pn == 7) ? QSCALE : 1.f) * osc;
        const bool dorope = (pn < 4) && ((wc & 1) == 0);
#pragma unroll
        for (int ai = 0; ai < 2; ++ai)
#pragma unroll
            for (int m = 0; m < 4; ++m) { const int row = row0 + ai * HALF + m * 16; bf16_t* rowp = O + (size_t)row * INW + col0;
                f32x4 c4[2] = {{1.f, 1.f, 1.f, 1.f}, {1.f, 1.f, 1.f, 1.f}}, s4[2] = {{0.f, 0.f, 0.f, 0.f}, {0.f, 0.f, 0.f, 0.f}};
                if (dorope) { const float* rp = rope + (size_t)(row & (SEQ - 1)) * 16; c4[0] = *(const f32x4*)(rp); c4[1] = *(const f32x4*)(rp + 4); s4[0] = *(const f32x4*)(rp + 8); s4[1] = *(const f32x4*)(rp + 12); }
#pragma unroll
                for (int bj = 0; bj < 2; ++bj) { f32x4 v0 = acc[ai][bj][m][0], v1 = acc[ai][bj][m][1];
                    if (dorope) { f32x4 o0, o1;
#pragma unroll
                        for (int j = 0; j < 4; ++j) { o0[j] = __shfl_xor(v0[j], 16); o1[j] = __shfl_xor(v1[j], 16); }
                        if (fq == 0) { v0 = v0 * c4[0] - o0 * s4[0]; v1 = v1 * c4[1] - o1 * s4[1]; }
                        else if (fq == 1) { v0 = v0 * c4[0] + o0 * s4[0]; v1 = v1 * c4[1] + o1 * s4[1]; } }
                    v0 = v0 * sc; v1 = v1 * sc; u32x4 w; w.x = cvt_pk_bf16(v0[0], v0[1]); w.y = cvt_pk_bf16(v0[2], v0[3]); w.z = cvt_pk_bf16(v1[0], v1[1]); w.w = cvt_pk_bf16(v1[2], v1[3]);
                    *(u32x4*)(rowp + bj * HALF) = w; } }
    }
};
struct EpiGate2 {
    static constexpr bool PERM = true, AFTER_DRAIN = false, MID = true;
    const bf16_t* proj; bf16_t* O;
    __device__ __forceinline__ void mid(f32x4 (&acc)[2][2][4][2], const Unit& u, int wr, int wc, int fr, int fq) const {
        int row0 = u.pm * BM + wr * 64 + fr, col0 = u.pn * BM + wc * 32 + 8 * fq;
        asm volatile("" : "+v"(row0), "+v"(col0));
#pragma unroll
        for (int ai = 0; ai < 2; ++ai) {
            u32x4 gav[4][2], gbv[4][2];
#pragma unroll
            for (int m = 0; m < 4; ++m)
#pragma unroll
                for (int bj = 0; bj < 2; ++bj) { const bf16_t* gp = proj + (size_t)(row0 + ai * HALF + m * 16) * INW + col0 + bj * HALF; gav[m][bj] = *(const u32x4*)(gp + C_GA); gbv[m][bj] = *(const u32x4*)(gp + C_GB); }
#pragma unroll
            for (int m = 0; m < 4; ++m) {
#pragma unroll
                for (int bj = 0; bj < 2; ++bj) { const u32x4 ga = gav[m][bj], gb = gbv[m][bj];
                    const unsigned a_[4] = {ga.x, ga.y, ga.z, ga.w}, b_[4] = {gb.x, gb.y, gb.z, gb.w};
#pragma unroll
                    for (int q = 0; q < 4; ++q) {
                        const float r0 = (1.f + __builtin_amdgcn_exp2f(-1.4426950408889634f * bflo(b_[q]))) * __builtin_amdgcn_rcpf(1.f + __builtin_amdgcn_exp2f(-1.4426950408889634f * bflo(a_[q])));
                        const float r1 = (1.f + __builtin_amdgcn_exp2f(-1.4426950408889634f * bfhi(b_[q]))) * __builtin_amdgcn_rcpf(1.f + __builtin_amdgcn_exp2f(-1.4426950408889634f * bfhi(a_[q])));
                        acc[ai][bj][m][q >> 1][(q & 1) * 2] *= r0; acc[ai][bj][m][q >> 1][(q & 1) * 2 + 1] *= r1; } } }
            asm volatile("" ::: "memory"); }
    }
    __device__ __forceinline__ void operator()(const f32x4 (&acc)[2][2][4][2], const Unit& u, int wr, int wc, int fr_, int fq_) const {
        int fr = fr_, fq = fq_; asm volatile("" : "+v"(fr), "+v"(fq));
        const int row0 = u.pm * BM + wr * 64 + fr, col0 = u.pn * BM + wc * 32 + 8 * fq;
#pragma unroll
        for (int ai = 0; ai < 2; ++ai) {
            u32x4 gv[4][2];
#pragma unroll
            for (int m = 0; m < 4; ++m)
#pragma unroll
                for (int bj = 0; bj < 2; ++bj) gv[m][bj] = *(const u32x4*)(proj + (size_t)(row0 + ai * HALF + m * 16) * INW + C_GB + col0 + bj * HALF);
#pragma unroll
            for (int m = 0; m < 4; ++m) { const int row = row0 + ai * HALF + m * 16;
#pragma unroll
                for (int bj = 0; bj < 2; ++bj) { const int col = col0 + bj * HALF; const u32x4 g = gv[m][bj];
                    f32x4 v0 = acc[ai][bj][m][0], v1 = acc[ai][bj][m][1];
                    v0[0] *= sigm(bflo(g.x)); v0[1] *= sigm(bfhi(g.x)); v0[2] *= sigm(bflo(g.y)); v0[3] *= sigm(bfhi(g.y));
                    v1[0] *= sigm(bflo(g.z)); v1[1] *= sigm(bfhi(g.z)); v1[2] *= sigm(bflo(g.w)); v1[3] *= sigm(bfhi(g.w));
                    u32x4 w; w.x = cvt_pk_bf16(v0[0], v0[1]); w.y = cvt_pk_bf16(v0[2], v0[3]); w.z = cvt_pk_bf16(v1[0], v1[1]); w.w = cvt_pk_bf16(v1[2], v1[3]);
                    *(u32x4*)(O + (size_t)row * D + col) = w; } }
            asm volatile("" ::: "memory"); }
    }
};
struct EpiHout {
    static constexpr bool PERM = true, AFTER_DRAIN = false, MID = false;
    const float* x; float* H; bf16_t* HB; float* ssq16;
    __device__ __forceinline__ void operator()(const f32x4 (&acc)[2][2][4][2], const Unit& u, int wr, int wc, int fr_, int fq_) const {
        int fr = fr_, fq = fq_; asm volatile("" : "+v"(fr), "+v"(fq));
        const int row0 = u.pm * BM + wr * 64 + fr, col0 = u.pn * BM + wc * 32 + 8 * fq;
#pragma unroll
        for (int ai = 0; ai < 2; ++ai) {
            f32x4 xv[4][2][2];
#pragma unroll
            for (int m = 0; m < 4; ++m)
#pragma unroll
                for (int bj = 0; bj < 2; ++bj) { const float* xp = x + (size_t)(row0 + ai * HALF + m * 16) * D + col0 + bj * HALF; xv[m][bj][0] = *(const f32x4*)xp; xv[m][bj][1] = *(const f32x4*)(xp + 4); }
#pragma unroll
            for (int m = 0; m < 4; ++m) { const int row = row0 + ai * HALF + m * 16; float ss = 0.f;
#pragma unroll
                for (int bj = 0; bj < 2; ++bj) { const int col = col0 + bj * HALF;
                    const f32x4 v0 = acc[ai][bj][m][0] + xv[m][bj][0], v1 = acc[ai][bj][m][1] + xv[m][bj][1];
                    u32x4 w; w.x = cvt_pk_bf16(v0[0], v0[1]); w.y = cvt_pk_bf16(v0[2], v0[3]); w.z = cvt_pk_bf16(v1[0], v1[1]); w.w = cvt_pk_bf16(v1[2], v1[3]);
                    *(u32x4*)(HB + (size_t)row * D + col) = w;
                    ss += (v0[0] * v0[0] + v0[1] * v0[1]) + (v0[2] * v0[2] + v0[3] * v0[3]) + (v1[0] * v1[0] + v1[1] * v1[1]) + (v1[2] * v1[2] + v1[3] * v1[3]); }
                ss += __shfl_xor(ss, 16); ss += __shfl_xor(ss, 32);
                if (fq == 0) ssq16[(size_t)row * 16 + u.pn * 4 + wc] = ss; }
            asm volatile("" ::: "memory"); }
    }
};
struct EpiQ {
    static constexpr bool PERM = true, AFTER_DRAIN = false, MID = false;
    const float* ssq16; bf16_t* O;
    __device__ __forceinline__ void operator()(const f32x4 (&acc)[2][2][4][2], const Unit& u, int wr, int wc, int fr, int fq) const {
        const int row0 = u.pm * BM + wr * 64 + fr, col0 = u.pn * BM + wc * 32 + 8 * fq;
#pragma unroll
        for (int ai = 0; ai < 2; ++ai)
#pragma unroll
            for (int m = 0; m < 4; ++m) { const int row = row0 + ai * HALF + m * 16; const f32x4* sp = (const f32x4*)(ssq16 + (size_t)row * 16);
                const f32x4 a = sp[0], b = sp[1], c = sp[2], d = sp[3];
                const float tot = ((a[0] + a[1]) + (a[2] + a[3])) + ((b[0] + b[1]) + (b[2] + b[3])) + ((c[0] + c[1]) + (c[2] + c[3])) + ((d[0] + d[1]) + (d[2] + d[3]));
                const float rstd = 1.f / sqrtf(tot * (1.f / D) + EPS);
#pragma unroll
                for (int bj = 0; bj < 2; ++bj) { const f32x4 v0 = acc[ai][bj][m][0] * rstd, v1 = acc[ai][bj][m][1] * rstd;
                    u32x4 w; w.x = cvt_pk_bf16(v0[0], v0[1]); w.y = cvt_pk_bf16(v0[2], v0[3]); w.z = cvt_pk_bf16(v1[0], v1[1]); w.w = cvt_pk_bf16(v1[2], v1[3]);
                    *(u32x4*)(O + (size_t)row * PQ + col0 + bj * HALF) = w; } }
    }
};
template <class Epi, class Sched, bool ALIGN_EPI = false, bool SP2 = false, bool FP8 = false>
__device__ __forceinline__ void gemm_phase(PG8_LAS unsigned char* lds, const Gemm g, const Sched& S, const Epi& E) {
    int tid_l = threadIdx.x; asm volatile("" : "+v"(tid_l));
    const int tid = tid_l, wid = __builtin_amdgcn_readfirstlane(tid >> 6), lane = tid & 63, wr = wid >> 2, wc = wid & 3, fr = lane & 15, fq = lane >> 4;
    const int K = g.K, nt = K / BK;
    unsigned voffA[2], voffB[2];
#pragma unroll
    for (int i = 0; i < 2; ++i) { int R, C; stage_rc(tid * 16 + i * 8192, R, C); const int Rb = Epi::PERM ? ((R & ~31) + perm32(R & 31)) : R;
        voffA[i] = (unsigned)(R * K + C) * 2u; voffB[i] = (unsigned)(Rb * K + C) * 2u; }
    const size_t kstep = (size_t)(BK * 2);
    const size_t hstep = (size_t)HALF * K * 2;
    const size_t tstep = 2 * hstep;
    const unsigned ldsw = (unsigned)wid * 1024u;
    const int aoff = lds_byte(wr * 64 + fr, fq * 8), boff = lds_byte(wc * 32 + fr, fq * 8);
    const int aoffF0 = FP8 ? lds_byte(wr * 64 + fr, fq * 16) : 0, boffF0 = FP8 ? lds_byte(wc * 32 + fr, fq * 16) : 0;
#define PG8_SA(b, h) (((b) * 2 + (h)) * HTB)
#define PG8_SB(b, h) ((4 + (b) * 2 + (h)) * HTB)
#define PG8_STAGE(bufoff, gbase, voff) do { _Pragma("unroll") for (int _i = 0; _i < 2; ++_i) \
        __builtin_amdgcn_global_load_lds((const unsigned*)((const char*)(gbase) + (voff)[_i]), (PG8_LAS unsigned*)(lds + (bufoff) + ldsw + _i * 8192), 16, 0, 0); } while (0)
#define PG8_LDA(dst, b, h) do { if constexpr (FP8) { _Pragma("unroll") for (int m = 0; m < 4; ++m) { const u32x4 l_ = *(const PG8_LAS u32x4*)(lds + PG8_SA(b, h) + aoffF0 + m * 2048), h_ = *(const PG8_LAS u32x4*)(lds + PG8_SA(b, h) + aoffF0 + m * 2048 + 16); \
            dst##8[m] = (v8i_t){(int)l_.x, (int)l_.y, (int)l_.z, (int)l_.w, (int)h_.x, (int)h_.y, (int)h_.z, (int)h_.w}; } } \
        else { _Pragma("unroll") for (int m = 0; m < 4; ++m) _Pragma("unroll") for (int k = 0; k < 2; ++k) dst[m][k] = *(const PG8_LAS bf16x8*)(lds + PG8_SA(b, h) + aoff + m * 2048 + k * 1024); } } while (0)
#define PG8_LDB(dst, b, h) do { if constexpr (FP8) { _Pragma("unroll") for (int n = 0; n < 2; ++n) { const u32x4 l_ = *(const PG8_LAS u32x4*)(lds + PG8_SB(b, h) + boffF0 + n * 2048), h_ = *(const PG8_LAS u32x4*)(lds + PG8_SB(b, h) + boffF0 + n * 2048 + 16); \
            dst##8[n] = (v8i_t){(int)l_.x, (int)l_.y, (int)l_.z, (int)l_.w, (int)h_.x, (int)h_.y, (int)h_.z, (int)h_.w}; } } \
        else { _Pragma("unroll") for (int n = 0; n < 2; ++n) _Pragma("unroll") for (int k = 0; k < 2; ++k) dst[n][k] = *(const PG8_LAS bf16x8*)(lds + PG8_SB(b, h) + boff + n * 2048 + k * 1024); } } while (0)
#define PG8_MMA(ai, bj, At, Bt) do { __builtin_amdgcn_s_setprio(1); \
        if constexpr (FP8) { _Pragma("unroll") for (int m = 0; m < 4; ++m) _Pragma("unroll") for (int n = 0; n < 2; ++n) \
            asm volatile("v_mfma_scale_f32_16x16x128_f8f6f4 %0, %1, %2, %0, %3, %3 op_sel_hi:[0,0,0]" : "+v"(acc[ai][bj][m][n]) : "v"(Bt##8[n]), "v"(At##8[m]), "v"(mxone)); } \
        else { _Pragma("unroll") for (int m = 0; m < 4; ++m) _Pragma("unroll") for (int n = 0; n < 2; ++n) _Pragma("unroll") for (int k = 0; k < 2; ++k) \
            acc[ai][bj][m][n] = __builtin_amdgcn_mfma_f32_16x16x32_bf16(Bt[n][k], At[m][k], acc[ai][bj][m][n], 0, 0, 0); } \
        __builtin_amdgcn_s_setprio(0); } while (0)
#define PG8_WAIT_V(n) asm volatile("s_waitcnt vmcnt(" #n ")" ::: "memory")
#define PG8_WAIT_L(n) asm volatile("s_waitcnt lgkmcnt(" #n ")" ::: "memory")
#define PG8_BAR __builtin_amdgcn_s_barrier()
#define PG8_SCHED __builtin_amdgcn_sched_barrier(0)
    Unit cur, nxt; int ui = 0;
    if (!S.next(0, cur)) return;
    f32x4 acc[2][2][4][2];
#pragma unroll
    for (int a = 0; a < 2; ++a)
#pragma unroll
        for (int b = 0; b < 2; ++b)
#pragma unroll
            for (int m = 0; m < 4; ++m)
#pragma unroll
                for (int n = 0; n < 2; ++n) acc[a][b][m][n] = (f32x4){0.f, 0.f, 0.f, 0.f};
    bf16x8 At[4][2], B0[2][2], B1[2][2]; v8i_t At8[4], B08[2], B18[2];
    int mxone = 0x7F7F7F7F; asm volatile("" : "+v"(mxone));
    const char* cA = (const char*)g.A + (size_t)cur.pm * tstep; const char* cB = (const char*)g.Bt + (size_t)cur.pn * tstep;
    S.a_ready(cur);
    if constexpr (SP2) {
        PG8_STAGE(PG8_SB(0, 0), cB, voffB); PG8_STAGE(PG8_SB(0, 1), cB + hstep, voffB); PG8_STAGE(PG8_SA(0, 0), cA, voffA); PG8_STAGE(PG8_SA(0, 1), cA + hstep, voffA);
        if (wr == 1) PG8_BAR;
        PG8_WAIT_V(2); PG8_BAR;
        PG8_STAGE(PG8_SB(1, 0), cB + kstep, voffB); PG8_STAGE(PG8_SA(1, 0), cA + kstep, voffA); PG8_STAGE(PG8_SB(1, 1), cB + hstep + kstep, voffB);
        PG8_WAIT_V(6); PG8_BAR;
    } else {
        PG8_STAGE(PG8_SB(0, 0), cB, voffB); PG8_STAGE(PG8_SA(0, 0), cA, voffA); PG8_STAGE(PG8_SB(0, 1), cB + hstep, voffB); PG8_STAGE(PG8_SA(0, 1), cA + hstep, voffA);
        if (wr == 1) PG8_BAR;
        PG8_WAIT_V(4); PG8_BAR;
        PG8_STAGE(PG8_SB(1, 0), cB + kstep, voffB); PG8_STAGE(PG8_SA(1, 0), cA + kstep, voffA); PG8_STAGE(PG8_SB(1, 1), cB + hstep + kstep, voffB);
        PG8_WAIT_V(6); PG8_BAR;
    }
    for (;;) {
        const bool has_next = S.next(ui + 1, nxt);
        const char* nA = has_next ? (const char*)g.A + (size_t)nxt.pm * tstep : cA; const char* nB = has_next ? (const char*)g.Bt + (size_t)nxt.pn * tstep : cB;
#pragma unroll 1
        for (int t = 0; t < nt; t += 2) {
            if constexpr (Epi::MID) { if (t == nt / 2) E.mid(acc, cur, wr, wc, fr, fq); }
            const bool last = (t == nt - 2);
            const char* a1 = cA + (size_t)(t + 1) * kstep;
            const char* a2 = last ? nA : cA + (size_t)(t + 2) * kstep; const char* b2 = last ? nB : cB + (size_t)(t + 2) * kstep;
            const char* a3 = a2 + kstep; const char* b3 = b2 + kstep;
            if (last && has_next) S.a_ready(nxt);
            if constexpr (SP2) {
            PG8_LDB(B0, 0, 0); PG8_LDB(B1, 0, 1); PG8_SCHED; PG8_LDA(At, 0, 0); PG8_STAGE(PG8_SA(1, 1), a1 + hstep, voffA);
            PG8_WAIT_V(8); PG8_WAIT_L(0); PG8_BAR; PG8_MMA(0, 0, At, B0); PG8_MMA(0, 1, At, B1); PG8_BAR; PG8_SCHED;
            PG8_LDA(At, 0, 1); PG8_STAGE(PG8_SB(0, 0), b2, voffB); PG8_STAGE(PG8_SB(0, 1), b2 + hstep, voffB); PG8_STAGE(PG8_SA(0, 0), a2, voffA);
            PG8_WAIT_V(8); PG8_WAIT_L(0); PG8_BAR; PG8_MMA(1, 0, At, B0); PG8_MMA(1, 1, At, B1); PG8_BAR; PG8_SCHED;
            PG8_LDB(B0, 1, 0); PG8_LDB(B1, 1, 1); PG8_SCHED; PG8_LDA(At, 1, 0); PG8_STAGE(PG8_SA(0, 1), a2 + hstep, voffA);
            PG8_WAIT_V(8); PG8_WAIT_L(0); PG8_BAR; PG8_MMA(0, 0, At, B0); PG8_MMA(0, 1, At, B1); PG8_BAR; PG8_SCHED;
            PG8_LDA(At, 1, 1); PG8_STAGE(PG8_SB(1, 0), b3, voffB); PG8_STAGE(PG8_SB(1, 1), b3 + hstep, voffB); PG8_STAGE(PG8_SA(1, 0), a3, voffA);
            PG8_WAIT_V(8); PG8_WAIT_L(0); PG8_BAR; PG8_MMA(1, 0, At, B0); PG8_MMA(1, 1, At, B1); PG8_BAR; PG8_SCHED;
            } else {
            PG8_LDB(B0, 0, 0); PG8_SCHED; PG8_LDA(At, 0, 0); PG8_STAGE(PG8_SA(1, 1), a1 + hstep, voffA);
            PG8_WAIT_L(8); PG8_BAR; PG8_WAIT_L(0); PG8_MMA(0, 0, At, B0); PG8_BAR; PG8_SCHED;
            PG8_LDB(B1, 0, 1); PG8_STAGE(PG8_SB(0, 0), b2, voffB);
            PG8_BAR; PG8_WAIT_L(0); PG8_MMA(0, 1, At, B1); PG8_BAR;
            PG8_LDA(At, 0, 1); PG8_STAGE(PG8_SA(0, 0), a2, voffA);
            PG8_BAR; PG8_WAIT_L(0); PG8_MMA(1, 0, At, B0); PG8_BAR; PG8_SCHED;
            PG8_STAGE(PG8_SB(0, 1), b2 + hstep, voffB);
            PG8_WAIT_V(6); PG8_BAR; PG8_MMA(1, 1, At, B1); PG8_BAR;
            PG8_LDB(B0, 1, 0); PG8_SCHED; PG8_LDA(At, 1, 0); PG8_STAGE(PG8_SA(0, 1), a2 + hstep, voffA);
            PG8_WAIT_L(8); PG8_BAR; PG8_WAIT_L(0); PG8_MMA(0, 0, At, B0); PG8_BAR; PG8_SCHED;
            PG8_LDB(B1, 1, 1); PG8_STAGE(PG8_SB(1, 0), b3, voffB);
            PG8_BAR; PG8_WAIT_L(0); PG8_MMA(0, 1, At, B1); PG8_BAR;
            PG8_LDA(At, 1, 1); PG8_STAGE(PG8_SA(1, 0), a3, voffA);
            PG8_BAR; PG8_WAIT_L(0); PG8_MMA(1, 0, At, B0); PG8_BAR; PG8_SCHED;
            PG8_STAGE(PG8_SB(1, 1), b3 + hstep, voffB);
            PG8_WAIT_V(6); PG8_BAR; PG8_MMA(1, 1, At, B1); PG8_BAR;
            }
        }
        if constexpr (ALIGN_EPI) { if (wr == 0) PG8_BAR; }
        if constexpr (FP8) { asm volatile("s_nop 15\n\ts_nop 7" ::: "memory"); PG8_SCHED; }
        if constexpr (!Epi::AFTER_DRAIN) { E(acc, cur, wr, wc, fr, fq); S.done(cur); }
        if (!has_next) break;
#pragma unroll
        for (int a = 0; a < 2; ++a)
#pragma unroll
            for (int b = 0; b < 2; ++b)
#pragma unroll
                for (int m = 0; m < 4; ++m)
#pragma unroll
                    for (int n = 0; n < 2; ++n) acc[a][b][m][n] = (f32x4){0.f, 0.f, 0.f, 0.f};
        cur = nxt; cA = nA; cB = nB; ++ui;
        if constexpr (ALIGN_EPI) { if (wr == 1) PG8_BAR; }
    }
    PG8_WAIT_V(0);
    if constexpr (!ALIGN_EPI) { if (wr == 0) PG8_BAR; }
    PG8_BAR;
    if constexpr (Epi::AFTER_DRAIN) { E.fused(acc, cur, wr, wc, fr, fq, lds, wid, lane); S.done(cur); }
#undef PG8_SA
#undef PG8_SB
#undef PG8_STAGE
#undef PG8_LDA
#undef PG8_LDB
#undef PG8_MMA
#undef PG8_WAIT_V
#undef PG8_WAIT_L
#undef PG8_BAR
#undef PG8_SCHED
}
}

__device__ __forceinline__ float lambda_full(const Ptrs& P) {
    float a = 0.f, b = 0.f;
    for (int i = 0; i < 64; ++i) { a += P.lq1[i] * P.lk1[i]; b += P.lq2[i] * P.lk2[i]; }
    return __expf(a) - __expf(b) + 0.2f;
}

namespace att {
typedef short bf16x8 __attribute__((ext_vector_type(8)));
typedef short s16x4 __attribute__((ext_vector_type(4)));
typedef float f32x16 __attribute__((ext_vector_type(16)));
typedef float f32x2_t __attribute__((ext_vector_type(2)));
typedef __attribute__((address_space(3))) const char* lds_cptr;
typedef __attribute__((address_space(3))) char* lds_ptr;
__device__ __forceinline__ int crow(int r, int hi) { return (r & 3) + 8 * (r >> 2) + 4 * hi; }
__device__ __forceinline__ void glds16(const void* gsrc, unsigned lds_dst) { unsigned keep;
    asm volatile("s_mov_b32 %0, m0\n\ts_mov_b32 m0, %2\n\ts_nop 0\n\tglobal_load_lds_dwordx4 %1, off\n\ts_mov_b32 m0, %0" : "=&s"(keep) : "v"(gsrc), "s"(lds_dst) : "memory"); }
__device__ __forceinline__ unsigned cvtpk(float lo, float hi) { f32x2_t v = {lo, hi}; bf16x2_t b = __builtin_convertvector(v, bf16x2_t); return __builtin_bit_cast(unsigned, b); }
#define ATT_WAIT_BAR(N) asm volatile("s_waitcnt vmcnt(" #N ") lgkmcnt(0)\n\ts_barrier" ::: "memory")
#define ATT_LDSWAIT() asm volatile("s_waitcnt lgkmcnt(0)" ::: "memory")
#define ATT_SBAR() __builtin_amdgcn_sched_barrier(0)
template <bool REL> __device__ __forceinline__ void qkt(f32x16& p0, f32x16& p1, lds_cptr Kslot, const bf16x8* qr, const f32x16& negm, int r32, int hi) {
    lds_cptr kb = Kslot + hi * 1024 + r32 * 16;
#pragma unroll
    for (int d0 = 0; d0 < 4; ++d0) {
        const bf16x8 b0 = *(const __attribute__((address_space(3))) bf16x8*)(kb + d0 * 2048);
        const bf16x8 b1 = *(const __attribute__((address_space(3))) bf16x8*)(kb + d0 * 2048 + 512);
        if (d0 == 0) { if (REL) { p0 = __builtin_amdgcn_mfma_f32_32x32x16_bf16(b0, qr[0], negm, 0, 0, 0); p1 = __builtin_amdgcn_mfma_f32_32x32x16_bf16(b1, qr[0], negm, 0, 0, 0); }
                       else { p0 = __builtin_amdgcn_mfma_f32_32x32x16_bf16(b0, qr[0], f32x16{}, 0, 0, 0); p1 = __builtin_amdgcn_mfma_f32_32x32x16_bf16(b1, qr[0], f32x16{}, 0, 0, 0); } }
        else { p0 = __builtin_amdgcn_mfma_f32_32x32x16_bf16(b0, qr[d0], p0, 0, 0, 0); p1 = __builtin_amdgcn_mfma_f32_32x32x16_bf16(b1, qr[d0], p1, 0, 0, 0); } }
}
__device__ __forceinline__ float rowmax32(const f32x16& p0, const f32x16& p1) {
    float a = fmaxf(p0[0], p1[0]);
#pragma unroll
    for (int r = 1; r < 16; ++r) a = fmaxf(a, fmaxf(p0[r], p1[r]));
    auto rr = __builtin_amdgcn_permlane32_swap(__float_as_uint(a), __float_as_uint(a), false, false);
    return fmaxf(__uint_as_float(rr[0]), __uint_as_float(rr[1]));
}
__device__ __forceinline__ float halfsum(float a) { auto rr = __builtin_amdgcn_permlane32_swap(__float_as_uint(a), __float_as_uint(a), false, false); return __uint_as_float(rr[0]) + __uint_as_float(rr[1]); }
#define ATT_VREAD(lo, hi, d0) do { _Pragma("unroll") for (int ks = 0; ks < 4; ++ks) { \
        asm volatile("ds_read_b64_tr_b16 %0,%1 offset:%c2" : "=&v"(lo[ks]) : "v"(vb), "i"((d0) * 4096 + ks * 1024) : "memory"); \
        asm volatile("ds_read_b64_tr_b16 %0,%1 offset:%c2" : "=&v"(hi[ks]) : "v"(vb), "i"((d0) * 4096 + ks * 1024 + 512) : "memory"); } } while (0)
#define ATT_PK(lo, hi, k) (bf16x8){lo[k][0], lo[k][1], lo[k][2], lo[k][3], hi[k][0], hi[k][1], hi[k][2], hi[k][3]}
#define ATT_PVMMA(lo, hi, d0) do { \
        o[d0] = __builtin_amdgcn_mfma_f32_32x32x16_bf16(pa0, ATT_PK(lo, hi, 0), o[d0], 0, 0, 0); o[d0] = __builtin_amdgcn_mfma_f32_32x32x16_bf16(pa1, ATT_PK(lo, hi, 1), o[d0], 0, 0, 0); \
        o[d0] = __builtin_amdgcn_mfma_f32_32x32x16_bf16(pa2, ATT_PK(lo, hi, 2), o[d0], 0, 0, 0); o[d0] = __builtin_amdgcn_mfma_f32_32x32x16_bf16(pa3, ATT_PK(lo, hi, 3), o[d0], 0, 0, 0); } while (0)
template <int ND0> __device__ __forceinline__ void pv(f32x16* o, int vb, bf16x8 pa0, bf16x8 pa1, bf16x8 pa2, bf16x8 pa3) {
    s16x4 loA[4], hiA[4], loB[4], hiB[4];
    ATT_VREAD(loA, hiA, 0);
#pragma unroll
    for (int d0 = 0; d0 < ND0; d0 += 2) {
        if (d0 + 1 < ND0) { ATT_VREAD(loB, hiB, d0 + 1); asm volatile("s_waitcnt lgkmcnt(8)" ::: "memory"); } else { asm volatile("s_waitcnt lgkmcnt(0)" ::: "memory"); }
        ATT_SBAR();
        ATT_PVMMA(loA, hiA, d0);
        if (d0 + 1 < ND0) {
            if (d0 + 2 < ND0) { ATT_VREAD(loA, hiA, d0 + 2); asm volatile("s_waitcnt lgkmcnt(8)" ::: "memory"); } else { asm volatile("s_waitcnt lgkmcnt(0)" ::: "memory"); }
            ATT_SBAR();
            ATT_PVMMA(loB, hiB, d0 + 1);
        }
    }
}
#undef ATT_VREAD
#undef ATT_PVMMA
#undef ATT_PK
template <int DEAD> __device__ __forceinline__ constexpr bool live0(int r) { return DEAD != 2 || r >= 12; }
template <int DEAD> __device__ __forceinline__ constexpr bool live1(int r) { return DEAD != 1 || r < 4; }
template <int ND0, int THR, bool REL, int DEAD = 0> __device__ __forceinline__ void softmax_tile(f32x16& p0, f32x16& p1, float& mrun, float& lsum, f32x16& negm, bool first, f32x16* o, __attribute__((address_space(3))) float* wsf, int r32, int hi,
                                                                   u32x4& pw0, u32x4& pw1, u32x4& pw2, u32x4& pw3) {
    float rm;
    if (DEAD == 0) rm = rowmax32(p0, p1);
    else { float a = -3e38f;
#pragma unroll
        for (int r = 0; r < 16; ++r) { if (live0<DEAD>(r)) a = fmaxf(a, p0[r]); if (live1<DEAD>(r)) a = fmaxf(a, p1[r]); }
        auto rr = __builtin_amdgcn_permlane32_swap(__float_as_uint(a), __float_as_uint(a), false, false); rm = fmaxf(__uint_as_float(rr[0]), __uint_as_float(rr[1])); }
    if (!REL) rm -= mrun;
    if (first) {
        mrun = REL ? rm : mrun + rm;
        if (REL) {
#pragma unroll
            for (int r = 0; r < 16; ++r) { if (live0<DEAD>(r)) p0[r] -= rm; if (live1<DEAD>(r)) p1[r] -= rm; negm[r] = -mrun; } }
    } else if (__any(rm > (float)THR)) {
        const float dl = fmaxf(rm, 0.f), alpha = __builtin_amdgcn_exp2f(-dl); lsum *= alpha; mrun += dl;
        if (REL) {
#pragma unroll
            for (int r = 0; r < 16; ++r) { if (live0<DEAD>(r)) p0[r] -= dl; if (live1<DEAD>(r)) p1[r] -= dl; negm[r] = -mrun; } }
        if (hi == 0) wsf[r32] = alpha;
        ATT_LDSWAIT();
#pragma unroll
        for (int g = 0; g < 4; ++g) { const f32x4 a4 = *(const __attribute__((address_space(3))) f32x4*)(wsf + 8 * g + 4 * hi);
#pragma unroll
            for (int d0 = 0; d0 < ND0; ++d0) { o[d0][4 * g + 0] *= a4[0]; o[d0][4 * g + 1] *= a4[1]; o[d0][4 * g + 2] *= a4[2]; o[d0][4 * g + 3] *= a4[3]; } }
        ATT_LDSWAIT();
    }
    float s = 0.f;
#pragma unroll
    for (int r = 0; r < 16; ++r) {
        if (live0<DEAD>(r)) { p0[r] = __builtin_amdgcn_exp2f(REL ? p0[r] : p0[r] - mrun); s += p0[r]; } else p0[r] = 0.f;
        if (live1<DEAD>(r)) { p1[r] = __builtin_amdgcn_exp2f(REL ? p1[r] : p1[r] - mrun); s += p1[r]; } else p1[r] = 0.f; }
    lsum += s;
    pw0 = (u32x4){cvtpk(p0[0], p0[1]), cvtpk(p0[2], p0[3]), cvtpk(p0[4], p0[5]), cvtpk(p0[6], p0[7])};
    pw1 = (u32x4){cvtpk(p0[8], p0[9]), cvtpk(p0[10], p0[11]), cvtpk(p0[12], p0[13]), cvtpk(p0[14], p0[15])};
    pw2 = (u32x4){cvtpk(p1[0], p1[1]), cvtpk(p1[2], p1[3]), cvtpk(p1[4], p1[5]), cvtpk(p1[6], p1[7])};
    pw3 = (u32x4){cvtpk(p1[8], p1[9]), cvtpk(p1[10], p1[11]), cvtpk(p1[12], p1[13]), cvtpk(p1[14], p1[15])};
}

constexpr int A_SLOTK = 8192, A_SLOTV = 16384, A_NS = 3, A_NSV = 4;
constexpr int A_LDS_K = 0, A_LDS_V = A_NS * A_SLOTK, A_LDS_WS = A_LDS_V + A_NSV * A_SLOTV, A_LDS_ST = A_LDS_WS + 8 * 256, A_LDS_BYTES = A_LDS_ST + 8 * 8192;
__device__ __forceinline__ void attn_a_unit(int b, int h, int qb, const bf16_t* proj, bf16_t* ya, const float* subln, float lam, unsigned char* shm) {
    int tid_l = threadIdx.x; asm volatile("" : "+v"(tid_l));
    const int tid = tid_l, lane = tid & 63, r32 = lane & 31, hi = lane >> 5; const int wid = __builtin_amdgcn_readfirstlane(tid >> 6);
    const size_t rowbase = (size_t)b * SEQ; const int q0 = qb * 256;
    constexpr int NT = SEQ / 64;
    const unsigned lds0 = (unsigned)(uintptr_t)shm;
    const lds_cptr shm3 = (lds_cptr)shm;
    __attribute__((address_space(3))) float* wsf = (__attribute__((address_space(3))) float*)((lds_ptr)shm + A_LDS_WS) + wid * 64;
    const int vb0 = (int)(lds0 + A_LDS_V) + ((lane >> 4) & 1) * 32 + (lane & 3) * 8 + (4 * hi + ((lane & 15) >> 2)) * 64;
    __attribute__((address_space(3))) bf16_t* stg = (__attribute__((address_space(3))) bf16_t*)((lds_ptr)shm + A_LDS_ST) + wid * 4096;
    for (int mp = 0; mp < 2; ++mp) {
        const bf16_t* Kh = proj + rowbase * INW + C_KA + h * 128 + mp * 64;
        const bf16_t* Vh = proj + rowbase * INW + C_VA + h * 128;
        const bf16_t* Qw = proj + (rowbase + q0 + wid * 32) * INW + C_QA + h * 128 + mp * 64;
        const int pA = 2 * wid, pB = 2 * wid + 1;
        const unsigned kdst = lds0 + A_LDS_K + wid * 1024, vdstA = lds0 + A_LDS_V + pA * 1024, vdstB = lds0 + A_LDS_V + pB * 1024;
#define A_DMA(t, slot, vsl) do { int ln_ = lane; asm volatile("" : "+v"(ln_)); \
        const bf16_t* ksrc_ = Kh + (size_t)((t) * 64 + ln_) * INW + wid * 8; \
        const bf16_t* vsrcA_ = Vh + (size_t)((t) * 64 + 16 * (pA & 3) + (ln_ >> 2)) * INW + (pA >> 2) * 32 + (ln_ & 3) * 8; \
        const bf16_t* vsrcB_ = Vh + (size_t)((t) * 64 + 16 * (pB & 3) + (ln_ >> 2)) * INW + (pB >> 2) * 32 + (ln_ & 3) * 8; \
        glds16(ksrc_, (unsigned)__builtin_amdgcn_readfirstlane(kdst + (slot) * A_SLOTK)); \
        glds16(vsrcA_, (unsigned)__builtin_amdgcn_readfirstlane(vdstA + (vsl) * A_SLOTV)); \
        glds16(vsrcB_, (unsigned)__builtin_amdgcn_readfirstlane(vdstB + (vsl) * A_SLOTV)); } while (0)
        A_DMA(0, 0, 0); A_DMA(1, 1, 1);
        bf16x8 qr[4];
#pragma unroll
        for (int d0 = 0; d0 < 4; ++d0) qr[d0] = *(const bf16x8*)(Qw + (size_t)r32 * INW + d0 * 16 + hi * 8);
        f32x16 o[4]; o[0] = f32x16{}; o[1] = f32x16{}; o[2] = f32x16{}; o[3] = f32x16{};
        float mrun = 0.f, lsum = 0.f; f32x16 negm = f32x16{};
        int slot = 0, slot2 = 2, vslot = 0, vslot2 = 2, vprev = 3;
        const bool late = wid >= 4;
        u32x4 pw0 = {}, pw1 = {}, pw2 = {}, pw3 = {};
        for (int t = 0; t < NT; ++t) {
            if (t + 1 < NT) { ATT_WAIT_BAR(3); } else { ATT_WAIT_BAR(0); }
            if (t + 2 < NT) A_DMA(t + 2, slot2, vslot2);
            if (late && t > 0) pv<4>(o, vb0 + vprev * A_SLOTV, __builtin_bit_cast(bf16x8, pw0), __builtin_bit_cast(bf16x8, pw1), __builtin_bit_cast(bf16x8, pw2), __builtin_bit_cast(bf16x8, pw3));
            f32x16 p0, p1;
            qkt<false>(p0, p1, shm3 + A_LDS_K + slot * A_SLOTK, qr, negm, r32, hi);
            softmax_tile<4, 8, false>(p0, p1, mrun, lsum, negm, t == 0, o, wsf, r32, hi, pw0, pw1, pw2, pw3);
            if (!late) pv<4>(o, vb0 + vslot * A_SLOTV, __builtin_bit_cast(bf16x8, pw0), __builtin_bit_cast(bf16x8, pw1), __builtin_bit_cast(bf16x8, pw2), __builtin_bit_cast(bf16x8, pw3));
            slot = (slot == 2) ? 0 : slot + 1; slot2 = (slot2 == 2) ? 0 : slot2 + 1;
            vprev = vslot; vslot = (vslot + 1) & 3; vslot2 = (vslot2 + 1) & 3;
        }
        if (late) pv<4>(o, vb0 + vprev * A_SLOTV, __builtin_bit_cast(bf16x8, pw0), __builtin_bit_cast(bf16x8, pw1), __builtin_bit_cast(bf16x8, pw2), __builtin_bit_cast(bf16x8, pw3));
#undef A_DMA
        const float lt = halfsum(lsum);
        if (hi == 0) wsf[32 + r32] = lt;
        ATT_LDSWAIT();
        float rli[16];
#pragma unroll
        for (int g = 0; g < 4; ++g) { const f32x4 l4 = *(const __attribute__((address_space(3))) f32x4*)(wsf + 32 + 8 * g + 4 * hi);
            rli[4 * g + 0] = __builtin_amdgcn_rcpf(l4[0]); rli[4 * g + 1] = __builtin_amdgcn_rcpf(l4[1]); rli[4 * g + 2] = __builtin_amdgcn_rcpf(l4[2]); rli[4 * g + 3] = __builtin_amdgcn_rcpf(l4[3]); }
        ATT_LDSWAIT();
        if (mp == 0) {
#pragma unroll
            for (int d0 = 0; d0 < 4; ++d0)
#pragma unroll
                for (int r = 0; r < 16; ++r) stg[crow(r, hi) * 128 + d0 * 32 + r32] = (bf16_t)f2bf(o[d0][r] * rli[r]);
            asm volatile("s_waitcnt lgkmcnt(0)\n\ts_barrier" ::: "memory");
        } else {
            float ss[16];
#pragma unroll
            for (int r = 0; r < 16; ++r) ss[r] = 0.f;
#pragma unroll
            for (int d0 = 0; d0 < 4; ++d0)
#pragma unroll
                for (int r = 0; r < 16; ++r) { const float a = bf2f(stg[crow(r, hi) * 128 + d0 * 32 + r32]); const float y = a - lam * o[d0][r] * rli[r]; o[d0][r] = y; ss[r] += y * y; }
#pragma unroll
            for (int r = 0; r < 16; ++r) { float v = ss[r]; v += __shfl_xor(v, 1); v += __shfl_xor(v, 2); v += __shfl_xor(v, 4); v += __shfl_xor(v, 8); v += __shfl_xor(v, 16);
                ss[r] = 0.8f / sqrtf(v * (1.f / 128.f) + EPS); }
            ATT_LDSWAIT();
#pragma unroll
            for (int d0 = 0; d0 < 4; ++d0) { const float gsub = subln[d0 * 32 + r32];
#pragma unroll
                for (int r = 0; r < 16; ++r) stg[crow(r, hi) * 128 + d0 * 32 + r32] = (bf16_t)f2bf(o[d0][r] * ss[r] * gsub); }
            ATT_LDSWAIT();
            bf16_t* Yw = ya + (rowbase + q0 + wid * 32) * 1024 + h * 128;
#pragma unroll
            for (int i = 0; i < 8; ++i) { const int row = i * 4 + (lane >> 4), ch = lane & 15; const u32x4 v = *(const __attribute__((address_space(3))) u32x4*)(stg + row * 128 + ch * 8); *(u32x4*)(Yw + (size_t)row * 1024 + ch * 8) = v; }
            asm volatile("s_waitcnt lgkmcnt(0)\n\ts_barrier" ::: "memory");
        }
    }
}

template <int DEAD> __device__ __forceinline__ void na_tile(lds_cptr Kslot, int vb, const bf16x8* qr, const __attribute__((address_space(3))) float* bp, const float (&fm0)[16], const float (&fm1)[16],
                                                        float& mrun, float& lsum, f32x16& negm, bool first, f32x16* o, __attribute__((address_space(3))) float* wsf, int r32, int hi) {
    f32x16 p0, p1; u32x4 pw0, pw1, pw2, pw3;
    qkt<true>(p0, p1, Kslot, qr, negm, r32, hi);
#pragma unroll
    for (int rr = 0; rr < 16; ++rr) { const int jj = (rr & 3) + 8 * (rr >> 2);
        if (live0<DEAD>(rr)) p0[rr] += bp[jj] + fm0[rr];
        if (live1<DEAD>(rr)) p1[rr] += bp[jj + 32] + fm1[rr]; }
    softmax_tile<2, 8, true, DEAD>(p0, p1, mrun, lsum, negm, first, o, wsf, r32, hi, pw0, pw1, pw2, pw3);
    pv<2>(o, vb, __builtin_bit_cast(bf16x8, pw0), __builtin_bit_cast(bf16x8, pw1), __builtin_bit_cast(bf16x8, pw2), __builtin_bit_cast(bf16x8, pw3));
}
constexpr int B_SLOT = 8192, B_NS = 6, B_PF = 5;
constexpr int B_LDS_K = 0, B_LDS_V = B_NS * B_SLOT, B_LDS_WS = 2 * B_NS * B_SLOT, B_LDS_BIAS = B_LDS_WS + 8 * 256, B_LDS_ST = B_LDS_BIAS + 2560, B_LDS_BYTES = B_LDS_ST + 8 * 4096;
__device__ __forceinline__ void attn_b_unit(int b, int h, int rg, const bf16_t* proj, bf16_t* yb, const float* rpb, unsigned char* shm) {
    int tid_l = threadIdx.x; asm volatile("" : "+v"(tid_l));
    const int tid = tid_l, lane = tid & 63, r32 = lane & 31, hi = lane >> 5; const int wid = __builtin_amdgcn_readfirstlane(tid >> 6);
    const size_t rowbase = (size_t)b * SEQ;
    const int r = 4 * rg + (wid >> 1), c0 = 32 * (wid & 1);
    int rs = r - 4; rs = rs < 0 ? 0 : (rs > 24 ? 24 : rs);
    int rmin = 4 * rg - 4; rmin = rmin < 0 ? 0 : (rmin > 24 ? 24 : rmin);
    int rmaxs = 4 * rg + 3 - 4; rmaxs = rmaxs < 0 ? 0 : (rmaxs > 24 ? 24 : rmaxs);
    const int ntile = rmaxs + 8 - rmin;
    const unsigned lds0 = (unsigned)(uintptr_t)shm;
    const lds_cptr shm3 = (lds_cptr)shm;
    __attribute__((address_space(3))) float* wsf = (__attribute__((address_space(3))) float*)((lds_ptr)shm + B_LDS_WS) + wid * 64;
    __attribute__((address_space(3))) float* bias = (__attribute__((address_space(3))) float*)((lds_ptr)shm + B_LDS_BIAS) + 64;
    __attribute__((address_space(3))) bf16_t* stg = (__attribute__((address_space(3))) bf16_t*)((lds_ptr)shm + B_LDS_ST) + wid * 2048;
    const int vb0 = (int)(lds0 + B_LDS_V) + ((lane >> 4) & 1) * 32 + (lane & 3) * 8 + (4 * hi + ((lane & 15) >> 2)) * 64;
    for (int i = tid; i < 640; i += 512) { const int e = i - 64, ri = e >> 5, cj = e & 31; bias[e] = (e >= 0 && e < 480 && cj < 31) ? rpb[(h * 15 + ri) * 31 + cj] * LOG2E : 0.f; }
    const bf16_t* Kh = proj + rowbase * INW + C_KB + h * 64;
    const bf16_t* Vh = proj + rowbase * INW + C_VB + h * 64;
    const bf16_t* Qw = proj + (rowbase + r * 64 + c0) * INW + C_QB + h * 64;
    const unsigned kdst = lds0 + B_LDS_K + wid * 1024, vdst = lds0 + B_LDS_V + wid * 1024;
#define B_DMA(t, slot) do { int ln_ = lane; asm volatile("" : "+v"(ln_)); \
    const bf16_t* ksrc_ = Kh + (size_t)((rmin + (t)) * 64 + ln_) * INW + wid * 8; \
    const bf16_t* vsrc_ = Vh + (size_t)((rmin + (t)) * 64 + 16 * (wid & 3) + (ln_ >> 2)) * INW + (wid >> 2) * 32 + (ln_ & 3) * 8; \
    glds16(ksrc_, (unsigned)__builtin_amdgcn_readfirstlane(kdst + (slot) * B_SLOT)); \
    glds16(vsrc_, (unsigned)__builtin_amdgcn_readfirstlane(vdst + (slot) * B_SLOT)); } while (0)
#pragma unroll
    for (int t = 0; t < B_PF; ++t) B_DMA(t, t);
    bf16x8 qr[4];
#pragma unroll
    for (int d0 = 0; d0 < 4; ++d0) qr[d0] = *(const bf16x8*)(Qw + (size_t)r32 * INW + d0 * 16 + hi * 8);
    f32x16 o[2]; o[0] = f32x16{}; o[1] = f32x16{};
    float mrun = 0.f, lsum = 0.f; f32x16 negm = f32x16{}; bool first = true;
    const int c = c0 + r32; int cs = c - 8; cs = cs < 0 ? 0 : (cs > 48 ? 48 : cs);
    float fm0[16], fm1[16];
#pragma unroll
    for (int rr = 0; rr < 16; ++rr) { const int j0 = crow(rr, hi); fm0[rr] = ((unsigned)(j0 - cs) < 16u) ? 0.f : -1e30f; fm1[rr] = ((unsigned)(j0 + 32 - cs) < 16u) ? 0.f : -1e30f; }
    int slot = 0, slotn = B_PF;
    for (int t = 0; t < ntile; ++t) {
        { const int rem = ntile - 1 - t;
          if (rem >= 4) { ATT_WAIT_BAR(8); } else if (rem == 3) { ATT_WAIT_BAR(6); } else if (rem == 2) { ATT_WAIT_BAR(4); } else if (rem == 1) { ATT_WAIT_BAR(2); } else { ATT_WAIT_BAR(0); } }
        if (t + B_PF < ntile) B_DMA(t + B_PF, slotn);
        const int kr = rmin + t;
        if (kr >= rs && kr < rs + 8) {
            const __attribute__((address_space(3))) float* bp = bias + ((kr - r + 7) * 32 + 15 - c + 4 * hi);
            if (wid & 1) na_tile<2>(shm3 + B_LDS_K + slot * B_SLOT, vb0 + slot * B_SLOT, qr, bp, fm0, fm1, mrun, lsum, negm, first, o, wsf, r32, hi);
            else         na_tile<1>(shm3 + B_LDS_K + slot * B_SLOT, vb0 + slot * B_SLOT, qr, bp, fm0, fm1, mrun, lsum, negm, first, o, wsf, r32, hi);
            first = false;
        }
        slot = (slot == B_NS - 1) ? 0 : slot + 1; slotn = (slotn == B_NS - 1) ? 0 : slotn + 1;
    }
#undef B_DMA
    const float lt = halfsum(lsum);
    if (hi == 0) wsf[32 + r32] = lt;
    ATT_LDSWAIT();
    float rli[16];
#pragma unroll
    for (int g = 0; g < 4; ++g) { const f32x4 l4 = *(const __attribute__((address_space(3))) f32x4*)(wsf + 32 + 8 * g + 4 * hi);
        rli[4 * g + 0] = __builtin_amdgcn_rcpf(l4[0]); rli[4 * g + 1] = __builtin_amdgcn_rcpf(l4[1]); rli[4 * g + 2] = __builtin_amdgcn_rcpf(l4[2]); rli[4 * g + 3] = __builtin_amdgcn_rcpf(l4[3]); }
#pragma unroll
    for (int d0 = 0; d0 < 2; ++d0)
#pragma unroll
        for (int rr = 0; rr < 16; ++rr) stg[crow(rr, hi) * 64 + d0 * 32 + r32] = (bf16_t)f2bf(o[d0][rr] * rli[rr]);
    ATT_LDSWAIT();
    bf16_t* Yw = yb + (rowbase + r * 64 + c0) * 1024 + 512 + h * 64;
#pragma unroll
    for (int i = 0; i < 4; ++i) { const int row = i * 8 + (lane >> 3), ch = lane & 7; const u32x4 v = *(const __attribute__((address_space(3))) u32x4*)(stg + row * 64 + ch * 8); *(u32x4*)(Yw + (size_t)row * 1024 + ch * 8) = v; }
    asm volatile("s_waitcnt lgkmcnt(0)\n\ts_barrier" ::: "memory");
}
}

namespace peer {
typedef short bf16x8 __attribute__((ext_vector_type(8)));
typedef float f32x16 __attribute__((ext_vector_type(16)));
typedef __attribute__((address_space(3))) const char* lds_cptr;
constexpr int T_LDS_SK = 0, T_LDS_BYTES = 65536;
__device__ __forceinline__ int imax(int a, int b) { int r; asm("v_max_f32 %0, %1, %2" : "=v"(r) : "v"(a), "v"(b)); return r; }
__device__ __forceinline__ int imin(int a, int b) { int r; asm("v_min_f32 %0, %1, %2" : "=v"(r) : "v"(a), "v"(b)); return r; }
__device__ __forceinline__ int f2key(float s, int idx) { return (__float_as_int(s) & ~127) | idx; }
__device__ __forceinline__ int key2bits(int k) { return k; }
template <int N, int OFF, int TOT> __device__ __forceinline__ void bsort_desc(int (&a)[TOT]) {
#pragma unroll
    for (int k = 2; k <= N; k <<= 1)
#pragma unroll
        for (int j = k >> 1; j > 0; j >>= 1)
#pragma unroll
            for (int i = 0; i < N; ++i) { const int l = i ^ j; if (l > i) { const bool desc = (i & k) == 0; const int hi_ = imax(a[OFF + i], a[OFF + l]), lo_ = imin(a[OFF + i], a[OFF + l]); a[OFF + i] = desc ? hi_ : lo_; a[OFF + l] = desc ? lo_ : hi_; } }
}
__device__ constexpr unsigned char NET16[126] = {0,1,2,3,0,2,1,3,1,2,4,5,6,7,4,6,5,7,5,6,0,4,2,6,2,4,1,5,3,7,3,5,1,2,3,4,5,6,8,9,10,11,8,10,9,11,9,10,12,13,14,15,12,14,13,15,13,14,8,12,10,14,10,12,9,13,11,15,11,13,9,10,11,12,13,14,0,8,4,12,4,8,2,10,6,14,6,10,2,4,6,8,10,12,1,9,5,13,5,9,3,11,7,15,7,11,3,5,7,9,11,13,1,2,3,4,5,6,7,8,9,10,11,12,13,14};
__device__ constexpr unsigned char NET32[382] = {0,1,2,3,0,2,1,3,1,2,4,5,6,7,4,6,5,7,5,6,0,4,2,6,2,4,1,5,3,7,3,5,1,2,3,4,5,6,8,9,10,11,8,10,9,11,9,10,12,13,14,15,12,14,13,15,13,14,8,12,10,14,10,12,9,13,11,15,11,13,9,10,11,12,13,14,0,8,4,12,4,8,2,10,6,14,6,10,2,4,6,8,10,12,1,9,5,13,5,9,3,11,7,15,7,11,3,5,7,9,11,13,1,2,3,4,5,6,7,8,9,10,11,12,13,14,16,17,18,19,16,18,17,19,17,18,20,21,22,23,20,22,21,23,21,22,16,20,18,22,18,20,17,21,19,23,19,21,17,18,19,20,21,22,24,25,26,27,24,26,25,27,25,26,28,29,30,31,28,30,29,31,29,30,24,28,26,30,26,28,25,29,27,31,27,29,25,26,27,28,29,30,16,24,20,28,20,24,18,26,22,30,22,26,18,20,22,24,26,28,17,25,21,29,21,25,19,27,23,31,23,27,19,21,23,25,27,29,17,18,19,20,21,22,23,24,25,26,27,28,29,30,0,16,8,24,8,16,4,20,12,28,12,20,4,8,12,16,20,24,2,18,10,26,10,18,6,22,14,30,14,22,6,10,14,18,22,26,2,4,6,8,10,12,14,16,18,20,22,24,26,28,1,17,9,25,9,17,5,21,13,29,13,21,5,9,13,17,21,25,3,19,11,27,11,19,7,23,15,31,15,23,7,11,15,19,23,27,3,5,7,9,11,13,15,17,19,21,23,25,27,29,1,2,3,4,5,6,7,8,9,10,11,12,13,14,15,16,17,18,19,20,21,22,23,24,25,26,27,28,29,30};
template <int OFF, int TOT> __device__ __forceinline__ void sort16_desc(int (&a)[TOT]) {
#pragma unroll
    for (int c = 0; c < 63; ++c) { const int i = OFF + NET16[2 * c], j = OFF + NET16[2 * c + 1]; const int hi_ = imax(a[i], a[j]), lo_ = imin(a[i], a[j]); a[i] = hi_; a[j] = lo_; }
}
template <int TOT> __device__ __forceinline__ void sort32_desc(int (&a)[TOT]) {
#pragma unroll
    for (int c = 0; c < 191; ++c) { const int i = NET32[2 * c], j = NET32[2 * c + 1]; const int hi_ = imax(a[i], a[j]), lo_ = imin(a[i], a[j]); a[i] = hi_; a[j] = lo_; }
}
template <int N, int OFF, int TOT> __device__ __forceinline__ void bmerge_desc(int (&a)[TOT]) {
#pragma unroll
    for (int j = N >> 1; j > 0; j >>= 1)
#pragma unroll
        for (int i = 0; i < N; ++i) { const int l = i ^ j; if (l > i) { const int hi_ = imax(a[OFF + i], a[OFF + l]), lo_ = imin(a[OFF + i], a[OFF + l]); a[OFF + i] = hi_; a[OFF + l] = lo_; } }
}
template <int A, int B, int TOT> __device__ __forceinline__ void merge_top16(int (&a)[TOT]) {
#pragma unroll
    for (int i = 0; i < 16; ++i) a[A + i] = imax(a[A + i], a[B + 15 - i]);
    bmerge_desc<16, A, TOT>(a);
}
__device__ __forceinline__ void cross_top16(int (&t)[16]) {
    int lo[16], hi[16];
#pragma unroll
    for (int i = 0; i < 16; ++i) { auto rr = __builtin_amdgcn_permlane32_swap((unsigned)t[i], (unsigned)t[i], false, false); lo[i] = (int)rr[0]; hi[i] = (int)rr[1]; }
#pragma unroll
    for (int i = 0; i < 16; ++i) t[i] = imax(lo[i], hi[15 - i]);
    bmerge_desc<16, 0, 16>(t);
}
struct RowStream {
    const float* pu; const float* pv; unsigned char* ws; int r, step, lane; f32x4 v0, v1, v2, v3;
    __device__ __forceinline__ void issue() {
        if (r < 2 * NEXP) { const float* src = (r < NEXP ? pu + (size_t)r * D : pv + (size_t)(r - NEXP) * D); const f32x4* s4 = (const f32x4*)src + lane * 4; v0 = s4[0]; v1 = s4[1]; v2 = s4[2]; v3 = s4[3]; } }
    __device__ __forceinline__ void finish() {
        if (r < 2 * NEXP) { const f32x4 cur[4] = {v0, v1, v2, v3};
            if (r < NEXP) cvt_row_i4(cur, ws + WS_U + (size_t)r * 256, (float*)(ws + WS_SU) + r, lane);
            else { const int e = r - NEXP; cvt_row_fp8(cur, ws + WS_V + (size_t)e * 512, (float*)(ws + WS_SV) + e, lane); }
            r += step; } }
    __device__ __forceinline__ void hook() { finish(); issue(); }
};
__device__ __forceinline__ void half_top16(int (&top)[16], const bf16_t* qrow  , lds_cptr skp  , int hi, RowStream& RS) {
    f32x16 sc[4]; sc[0] = f32x16{}; sc[1] = f32x16{}; sc[2] = f32x16{}; sc[3] = f32x16{};
    bf16x8 qf[8];
#pragma unroll
    for (int ks = 0; ks < 8; ++ks) qf[ks] = *(const bf16x8*)(qrow + ks * 16);
    RS.hook();
#pragma unroll
    for (int ks = 0; ks < 8; ++ks)
#pragma unroll
        for (int kt = 0; kt < 4; ++kt) { const bf16x8 af = *(const __attribute__((address_space(3))) bf16x8*)(skp + ks * 4096 + kt * 512);
            sc[kt] = __builtin_amdgcn_mfma_f32_32x32x16_bf16(af, qf[ks], sc[kt], 0, 0, 0); }
    int k[64];
#pragma unroll
    for (int kt = 0; kt < 4; ++kt)
#pragma unroll
        for (int r = 0; r < 16; ++r) k[kt * 16 + r] = f2key(sc[kt][r], (32 * kt + (r & 3) + 8 * (r >> 2)) | (4 * hi));
    sort16_desc<0, 64>(k); sort16_desc<16, 64>(k);
    RS.hook();
    sort16_desc<32, 64>(k); sort16_desc<48, 64>(k);
    RS.hook();
    merge_top16<0, 16, 64>(k); merge_top16<32, 48, 64>(k); merge_top16<0, 32, 64>(k);
#pragma unroll
    for (int i = 0; i < 16; ++i) top[i] = k[i];
    cross_top16(top);
}
__device__ __forceinline__ void topk_wave(int tok0, int h, const bf16_t* Q, int* IDX, float* Gt, lds_cptr sk, int lane, RowStream& RS) {
    const int r32 = lane & 31, hi = lane >> 5, tok = tok0 + r32;
    const bf16_t* qrow = Q + (size_t)tok * PQ + h * 256 + 8 * hi;
    lds_cptr skl = sk + hi * 2048 + r32 * 16;
    int A0[16], A1[16];
    half_top16(A0, qrow, skl, hi, RS);
    half_top16(A1, qrow + 128, skl + 32768, hi, RS);
    RS.hook();
    float x[16], y[16]; int xw[16], yw[16];
#pragma unroll
    for (int a = 0; a < 16; ++a) { const int b0 = key2bits(A0[a]), b1 = key2bits(A1[a]);
        const float v0 = __int_as_float(b0 & ~127), v1 = __int_as_float(b1 & ~127); const int i0 = (b0 & 127) << 7, i1 = b1 & 127;
        x[a] = hi ? v1 : v0; y[a] = hi ? v0 : v1; xw[a] = hi ? i1 : i0; yw[a] = hi ? i0 : i1; }
    int w[32]; int n = 0;
#define PEER_CAND(a, b) do { const int bits = __float_as_int(x[a] + y[b]); int ww = (bits & ~0x3FFF) | (xw[a] + yw[b]); \
        if ((a) == (b) && hi) ww = (int)0xFF800000; w[n] = ww; ++n; } while (0)
#pragma unroll
    for (int b = 0; b < 16; ++b) PEER_CAND(0, b);
#pragma unroll
    for (int b = 1; b < 8; ++b) PEER_CAND(1, b);
#pragma unroll
    for (int b = 2; b < 5; ++b) PEER_CAND(2, b);
    PEER_CAND(3, 3);
#undef PEER_CAND
#pragma unroll
    for (int i = 27; i < 32; ++i) w[i] = (int)0xFF800000;
    RS.hook();
    sort32_desc<32>(w);
    RS.hook();
    int T[16];
#pragma unroll
    for (int i = 0; i < 16; ++i) T[i] = w[i];
    cross_top16(T);
    float sv[16]; int ev[16];
#pragma unroll
    for (int j = 0; j < 16; ++j) { ev[j] = T[j] & 0x3FFF; sv[j] = __int_as_float(T[j] & ~0x3FFF); }
    const float s0 = sv[0]; float esum = 0.f;
#pragma unroll
    for (int j = 0; j < 16; ++j) { sv[j] = __expf(sv[j] - s0); esum += sv[j]; }
    const float inv = 1.f / esum;
    if (hi == 0) { u32x4* io = (u32x4*)(IDX + ((size_t)tok * 8 + h) * 16);
#pragma unroll
        for (int j = 0; j < 4; ++j) io[j] = (u32x4){(unsigned)ev[4 * j], (unsigned)ev[4 * j + 1], (unsigned)ev[4 * j + 2], (unsigned)ev[4 * j + 3]}; }
    else { f32x4* go = (f32x4*)(Gt + ((size_t)tok * 8 + h) * 16);
#pragma unroll
        for (int j = 0; j < 4; ++j) go[j] = (f32x4){sv[4 * j] * inv, sv[4 * j + 1] * inv, sv[4 * j + 2] * inv, sv[4 * j + 3] * inv}; }
}
template <class Sched> __device__ __forceinline__ void topk_own_units(const Ptrs& P, unsigned char* shm, const Sched& S) {
    int tid_l = threadIdx.x; asm volatile("" : "+v"(tid_l));
    const int tid = tid_l, lane = tid & 63; const int wid = __builtin_amdgcn_readfirstlane(tid >> 6);
    const unsigned lds0 = (unsigned)(uintptr_t)shm;
    const bf16_t* SKg = (const bf16_t*)(P.ws + WS_SK);
    int hprev = -1; pg8::Unit u;
    RowStream RS; RS.pu = P.peer_u; RS.pv = P.peer_v; RS.ws = P.ws; RS.lane = lane; RS.step = (int)gridDim.x * 8; RS.r = (int)blockIdx.x * 8 + wid; RS.v0 = RS.v1 = RS.v2 = RS.v3 = f32x4{};
    RS.issue();
    for (int i = 0; S.next(i, u); ++i) {
        const int h = u.pn, tg = u.pm;
        if (h != hprev) { hprev = h;
            asm volatile("s_waitcnt lgkmcnt(0)\n\ts_barrier" ::: "memory");
#pragma unroll
            for (int j = 0; j < 8; ++j) { const int piece = wid * 8 + j, p = piece >> 5, c = (piece >> 1) & 15, kh = piece & 1;
                att::glds16(SKg + ((size_t)((h * 2 + p) * 128 + kh * 64 + lane) * 128 + c * 8), (unsigned)__builtin_amdgcn_readfirstlane(lds0 + p * 32768 + c * 2048 + kh * 1024)); }
            asm volatile("s_waitcnt vmcnt(0)\n\ts_barrier" ::: "memory");
        }
        topk_wave(tg * 256 + wid * 32, h, (const bf16_t*)(P.ws + WS_Q), (int*)(P.ws + WS_IDX), (float*)(P.ws + WS_G), (lds_cptr)shm, lane, RS);
    }
    while (RS.r < 2 * NEXP) RS.hook();
}
}

namespace apply {
typedef float f32x2 __attribute__((ext_vector_type(2)));
typedef __attribute__((address_space(3))) unsigned* lds_u32p;
constexpr int AP_WAVE_BYTES = 4 * (512 + 2048), AP_LDS_BYTES = 8 * AP_WAVE_BYTES;
__device__ __forceinline__ float gelu_fast(float v) {
    const float av = fabsf(v), t = __builtin_amdgcn_rcpf(av * 0.2316418882f + 1.0f);
    float q = t * 0.5307027145f + (-0.7265760135f); q = q * t + 0.7107068705f; q = q * t + (-0.142248368f); q = q * t + 0.127414796f; q = q * t;
    const float e = __builtin_amdgcn_exp2f((v * v) * (-0.72134752044f));
    const float m = v * (q * e);
    return v < 0.f ? m : v - m;
}
#define AP_DPP(v, ctrl) __builtin_bit_cast(float, __builtin_amdgcn_update_dpp(0, __builtin_bit_cast(int, (v)), (ctrl), 0xF, 0xF, true))
__device__ __forceinline__ float row16_sum(float v) { v += AP_DPP(v, 0xB1); v += AP_DPP(v, 0x4E); v += AP_DPP(v, 0x141); v += AP_DPP(v, 0x140); return v; }
__device__ __forceinline__ void load_half(u32x4 (&r)[2], const unsigned char* img, unsigned e, int sub) {
    const unsigned off = e * 512u + (unsigned)(sub * 16);
    r[0] = *(const u32x4*)(img + off); r[1] = *(const u32x4*)(img + off + 256u);
}
constexpr int AP_PROBE_RING = 16;
constexpr int AP_RING = 8;
typedef __attribute__((address_space(3))) u32x4* lds_v4p;
template <int HF, int MODE, int RING> __device__ __forceinline__ void pass_u(const Ptrs& P, const bf16_t* hrow, float rstd, lds_v4p grp, u32x4 (&R)[RING][2], const unsigned char* img, const unsigned char* img_next, int sub) {
    unsigned xq[8]; float sx;
    {
        float xf[2][16]; float mx = 0.f;
#pragma unroll
        for (int i = 0; i < 2; ++i) { const int e0 = (sub + 16 * (2 * HF + i)) * 16;
#pragma unroll
            for (int q = 0; q < 4; ++q) { const u32x2 hb = *(const u32x2*)(hrow + e0 + 4 * q); const f32x4 gv = *(const f32x4*)(P.norm_ffn + e0 + 4 * q);
                xf[i][4 * q] = bflo(hb.x) * rstd * gv.x; xf[i][4 * q + 1] = bfhi(hb.x) * rstd * gv.y; xf[i][4 * q + 2] = bflo(hb.y) * rstd * gv.z; xf[i][4 * q + 3] = bfhi(hb.y) * rstd * gv.w;
                mx = fmaxf(fmaxf(mx, fmaxf(fabsf(xf[i][4 * q]), fabsf(xf[i][4 * q + 1]))), fmaxf(fabsf(xf[i][4 * q + 2]), fabsf(xf[i][4 * q + 3]))); } }
        mx = fmaxf(mx, AP_DPP(mx, 0xB1)); mx = fmaxf(mx, AP_DPP(mx, 0x4E)); mx = fmaxf(mx, AP_DPP(mx, 0x141)); mx = fmaxf(mx, AP_DPP(mx, 0x140));
        mx = fmaxf(mx, 1e-30f); sx = mx * (1.f / 127.f); const float qs = 127.f / mx;
#pragma unroll
        for (int i = 0; i < 2; ++i)
#pragma unroll
            for (int q = 0; q < 4; ++q) xq[4 * i + q] = pack_i8x4(xf[i][4 * q] * qs, xf[i][4 * q + 1] * qs, xf[i][4 * q + 2] * qs, xf[i][4 * q + 3] * qs);
    }
#pragma unroll 1
    for (int j = 0; j < 128; j += RING) {
        const int jn = (j + RING) & 127;
        __builtin_amdgcn_s_barrier();
        const unsigned char* tb = (j + RING < 128) ? img : img_next;
        unsigned nid[RING], part[RING], suv[RING], gsv[RING];
#pragma unroll
        for (int b4 = 0; b4 < RING / 4; ++b4) { const u32x4 na = grp[jn / 4 + b4];
            nid[4 * b4] = na.x; nid[4 * b4 + 1] = na.y; nid[4 * b4 + 2] = na.z; nid[4 * b4 + 3] = na.w;
            u32x4 pa = {}, sa = {}, ga = {};
            if (HF == 1) { pa = grp[96 + j / 4 + b4]; sa = grp[32 + j / 4 + b4]; ga = grp[64 + j / 4 + b4]; }
            part[4 * b4] = pa.x; part[4 * b4 + 1] = pa.y; part[4 * b4 + 2] = pa.z; part[4 * b4 + 3] = pa.w;
            suv[4 * b4] = sa.x; suv[4 * b4 + 1] = sa.y; suv[4 * b4 + 2] = sa.z; suv[4 * b4 + 3] = sa.w;
            gsv[4 * b4] = ga.x; gsv[4 * b4 + 1] = ga.y; gsv[4 * b4 + 2] = ga.z; gsv[4 * b4 + 3] = ga.w; }
        float outv[RING];
#pragma unroll
        for (int bq = 0; bq < RING; ++bq) {
            int d0_ = 0, d1_ = 0;
            if (MODE == 1) { asm volatile("" :: "v"(R[bq][0]), "v"(R[bq][1])); d0_ = (int)xq[0]; }
            else {
                d0_ = __builtin_amdgcn_sdot4((int)R[bq][0].x, (int)xq[0], d0_, false); d1_ = __builtin_amdgcn_sdot4((int)R[bq][0].y, (int)xq[1], d1_, false);
                d0_ = __builtin_amdgcn_sdot4((int)R[bq][0].z, (int)xq[2], d0_, false); d1_ = __builtin_amdgcn_sdot4((int)R[bq][0].w, (int)xq[3], d1_, false);
                d0_ = __builtin_amdgcn_sdot4((int)R[bq][1].x, (int)xq[4], d0_, false); d1_ = __builtin_amdgcn_sdot4((int)R[bq][1].y, (int)xq[5], d1_, false);
                d0_ = __builtin_amdgcn_sdot4((int)R[bq][1].z, (int)xq[6], d0_, false); d1_ = __builtin_amdgcn_sdot4((int)R[bq][1].w, (int)xq[7], d1_, false);
            }
            asm volatile("" ::: "memory");
            load_half(R[bq], tb, MODE == 2 ? (nid[bq] & 15u) : nid[bq], sub);
            asm volatile("" ::: "memory");
            float a_ = row16_sum((float)(d0_ + d1_)) * sx;
            if (HF == 1) { a_ = (a_ + __uint_as_float(part[bq])) * __uint_as_float(suv[bq]); a_ = __uint_as_float(gsv[bq]) * gelu_fast(a_); }
            outv[bq] = a_;
        }
        if (sub == 0) {
#pragma unroll
            for (int b4 = 0; b4 < RING / 4; ++b4) grp[96 + j / 4 + b4] = (u32x4){__float_as_uint(outv[4 * b4]), __float_as_uint(outv[4 * b4 + 1]), __float_as_uint(outv[4 * b4 + 2]), __float_as_uint(outv[4 * b4 + 3])}; }
    }
    asm volatile("s_waitcnt lgkmcnt(0)" ::: "memory");
}
template <int HF, int MODE, int RING> __device__ __forceinline__ void pass_v(float (&acc)[4][16], lds_v4p grp, u32x4 (&R)[RING][2], const unsigned char* img, const unsigned char* img_next, int sub) {
#pragma unroll 1
    for (int j = 0; j < 128; j += RING) {
        const int jn = (j + RING) & 127;
        __builtin_amdgcn_s_barrier();
        const unsigned char* tb = (j + RING < 128) ? img : img_next;
        unsigned nid[RING], cvv[RING];
#pragma unroll
        for (int b4 = 0; b4 < RING / 4; ++b4) { const u32x4 na = grp[jn / 4 + b4], ca = grp[96 + j / 4 + b4];
            nid[4 * b4] = na.x; nid[4 * b4 + 1] = na.y; nid[4 * b4 + 2] = na.z; nid[4 * b4 + 3] = na.w; cvv[4 * b4] = ca.x; cvv[4 * b4 + 1] = ca.y; cvv[4 * b4 + 2] = ca.z; cvv[4 * b4 + 3] = ca.w; }
#pragma unroll
        for (int bq = 0; bq < RING; ++bq) {
            const float c_ = __uint_as_float(cvv[bq]); const f32x2 c2 = {c_, c_};
            if (MODE == 1) { asm volatile("" :: "v"(R[bq][0]), "v"(R[bq][1])); acc[2 * HF][0] += c_; }
            else {
#pragma unroll
            for (int i = 0; i < 2; ++i) { const unsigned w_[4] = {R[bq][i].x, R[bq][i].y, R[bq][i].z, R[bq][i].w};
#pragma unroll
                for (int q = 0; q < 4; ++q) { const f32x2 lo_ = __builtin_amdgcn_cvt_pk_f32_fp8(w_[q], false), hi_ = __builtin_amdgcn_cvt_pk_f32_fp8(w_[q], true);
                    f32x2 a0 = {acc[2 * HF + i][4 * q], acc[2 * HF + i][4 * q + 1]}, a1 = {acc[2 * HF + i][4 * q + 2], acc[2 * HF + i][4 * q + 3]}; a0 += c2 * lo_; a1 += c2 * hi_;
                    acc[2 * HF + i][4 * q] = a0.x; acc[2 * HF + i][4 * q + 1] = a0.y; acc[2 * HF + i][4 * q + 2] = a1.x; acc[2 * HF + i][4 * q + 3] = a1.y; } }
            }
            asm volatile("" ::: "memory");
            load_half(R[bq], tb, MODE == 2 ? (nid[bq] & 15u) : nid[bq], sub);
            asm volatile("" ::: "memory");
        }
    }
}
constexpr int AP_RINGU = 16;
__device__ __forceinline__ u32x4 load_q4(const unsigned char* img, unsigned e, int sub) { return *(const u32x4*)(img + e * 256u + (unsigned)(sub * 16)); }
template <int HF, bool NEXTV> __device__ __forceinline__ void pass_u4(const Ptrs& P, const bf16_t* hrow, float rstd, lds_v4p grp, u32x4 (&R)[AP_RINGU], const unsigned char* img, const unsigned char* img_next, int sub) {
    constexpr int RING = AP_RINGU;
    unsigned xh[4], xl[4]; float sx;
    {
        float xf[2][16]; float mx = 0.f;
#pragma unroll
        for (int i = 0; i < 2; ++i) { const int e0 = (sub + 16 * (2 * HF + i)) * 16;
#pragma unroll
            for (int q = 0; q < 4; ++q) { const u32x2 hb = *(const u32x2*)(hrow + e0 + 4 * q); const f32x4 gv = *(const f32x4*)(P.norm_ffn + e0 + 4 * q);
                xf[i][4 * q] = bflo(hb.x) * rstd * gv.x; xf[i][4 * q + 1] = bfhi(hb.x) * rstd * gv.y; xf[i][4 * q + 2] = bflo(hb.y) * rstd * gv.z; xf[i][4 * q + 3] = bfhi(hb.y) * rstd * gv.w;
                mx = fmaxf(fmaxf(mx, fmaxf(fabsf(xf[i][4 * q]), fabsf(xf[i][4 * q + 1]))), fmaxf(fabsf(xf[i][4 * q + 2]), fabsf(xf[i][4 * q + 3]))); } }
        mx = fmaxf(mx, AP_DPP(mx, 0xB1)); mx = fmaxf(mx, AP_DPP(mx, 0x4E)); mx = fmaxf(mx, AP_DPP(mx, 0x141)); mx = fmaxf(mx, AP_DPP(mx, 0x140));
        mx = fmaxf(mx, 1e-30f); sx = mx * (1.f / 119.f); const float qs = 119.f / mx;
#pragma unroll
        for (int q = 0; q < 4; ++q) { unsigned h_ = 0u, l_ = 0u;
#pragma unroll
            for (int i = 0; i < 8; ++i) { const int xi = (int)rintf(xf[q >> 1][8 * (q & 1) + i] * qs); const int lo = ((xi + 8) & 15) - 8; const int hi = (xi - lo) >> 4;
                h_ |= ((unsigned)hi & 15u) << (4 * i); l_ |= ((unsigned)lo & 15u) << (4 * i); }
            xh[q] = h_; xl[q] = l_; }
    }
#pragma unroll 1
    for (int j = 0; j < 128; j += RING) {
        const int jn = (j + RING) & 127;
        __builtin_amdgcn_s_barrier();
        const bool last = !(j + RING < 128);
        const unsigned char* tb = last ? img_next : img;
        unsigned nid[RING], part[RING], suv[RING], gsv[RING];
#pragma unroll
        for (int b4 = 0; b4 < RING / 4; ++b4) { const u32x4 na = grp[jn / 4 + b4];
            nid[4 * b4] = na.x; nid[4 * b4 + 1] = na.y; nid[4 * b4 + 2] = na.z; nid[4 * b4 + 3] = na.w;
            u32x4 pa = {}, sa = {}, ga = {};
            if (HF == 1) { pa = grp[96 + j / 4 + b4]; sa = grp[32 + j / 4 + b4]; ga = grp[64 + j / 4 + b4]; }
            part[4 * b4] = pa.x; part[4 * b4 + 1] = pa.y; part[4 * b4 + 2] = pa.z; part[4 * b4 + 3] = pa.w;
            suv[4 * b4] = sa.x; suv[4 * b4 + 1] = sa.y; suv[4 * b4 + 2] = sa.z; suv[4 * b4 + 3] = sa.w;
            gsv[4 * b4] = ga.x; gsv[4 * b4 + 1] = ga.y; gsv[4 * b4 + 2] = ga.z; gsv[4 * b4 + 3] = ga.w; }
        float outv[RING];
#pragma unroll
        for (int bq = 0; bq < RING; ++bq) {
            int dh_ = __builtin_amdgcn_sdot8((int)R[bq].x, (int)xh[0], 0, false), dl_ = __builtin_amdgcn_sdot8((int)R[bq].x, (int)xl[0], 0, false);
            dh_ = __builtin_amdgcn_sdot8((int)R[bq].y, (int)xh[1], dh_, false); dl_ = __builtin_amdgcn_sdot8((int)R[bq].y, (int)xl[1], dl_, false);
            dh_ = __builtin_amdgcn_sdot8((int)R[bq].z, (int)xh[2], dh_, false); dl_ = __builtin_amdgcn_sdot8((int)R[bq].z, (int)xl[2], dl_, false);
            dh_ = __builtin_amdgcn_sdot8((int)R[bq].w, (int)xh[3], dh_, false); dl_ = __builtin_amdgcn_sdot8((int)R[bq].w, (int)xl[3], dl_, false);
            asm volatile("" ::: "memory");
            if (NEXTV) { if (last) R[bq] = *(const u32x4*)(tb + nid[bq >> 1] * 512u + (unsigned)(sub * 16 + (bq & 1) * 256)); else R[bq] = load_q4(tb, nid[bq], sub); }
            else R[bq] = load_q4(tb, nid[bq], sub);
            asm volatile("" ::: "memory");
            float a_ = row16_sum((float)(dh_ * 16 + dl_)) * sx;
            if (HF == 1) { a_ = (a_ + __uint_as_float(part[bq])) * __uint_as_float(suv[bq]); a_ = __uint_as_float(gsv[bq]) * gelu_fast(a_); }
            outv[bq] = a_;
        }
        if (sub == 0) {
#pragma unroll
            for (int b4 = 0; b4 < RING / 4; ++b4) grp[96 + j / 4 + b4] = (u32x4){__float_as_uint(outv[4 * b4]), __float_as_uint(outv[4 * b4 + 1]), __float_as_uint(outv[4 * b4 + 2]), __float_as_uint(outv[4 * b4 + 3])}; }
    }
    asm volatile("s_waitcnt lgkmcnt(0)" ::: "memory");
}
template <int HF> __device__ __forceinline__ void pass_v8f(float (&acc)[4][16], lds_v4p grp, u32x4 (&R)[AP_RINGU], const unsigned char* img, const unsigned char* img_next, int sub) {
    constexpr int RING = 8;
#pragma unroll 1
    for (int j = 0; j < 128; j += RING) {
        const int jn = (j + RING) & 127;
        __builtin_amdgcn_s_barrier();
        const unsigned char* tb = (j + RING < 128) ? img : img_next;
        unsigned nid[RING], cvv[RING];
#pragma unroll
        for (int b4 = 0; b4 < RING / 4; ++b4) { const u32x4 na = grp[jn / 4 + b4], ca = grp[96 + j / 4 + b4];
            nid[4 * b4] = na.x; nid[4 * b4 + 1] = na.y; nid[4 * b4 + 2] = na.z; nid[4 * b4 + 3] = na.w; cvv[4 * b4] = ca.x; cvv[4 * b4 + 1] = ca.y; cvv[4 * b4 + 2] = ca.z; cvv[4 * b4 + 3] = ca.w; }
#pragma unroll
        for (int bq = 0; bq < RING; ++bq) {
            const float c_ = __uint_as_float(cvv[bq]); const f32x2 c2 = {c_, c_};
#pragma unroll
            for (int i = 0; i < 2; ++i) { const unsigned w_[4] = {R[2 * bq + i].x, R[2 * bq + i].y, R[2 * bq + i].z, R[2 * bq + i].w};
#pragma unroll
                for (int q = 0; q < 4; ++q) { const f32x2 lo_ = __builtin_amdgcn_cvt_pk_f32_fp8(w_[q], false), hi_ = __builtin_amdgcn_cvt_pk_f32_fp8(w_[q], true);
                    f32x2 a0 = {acc[2 * HF + i][4 * q], acc[2 * HF + i][4 * q + 1]}, a1 = {acc[2 * HF + i][4 * q + 2], acc[2 * HF + i][4 * q + 3]}; a0 += c2 * lo_; a1 += c2 * hi_;
                    acc[2 * HF + i][4 * q] = a0.x; acc[2 * HF + i][4 * q + 1] = a0.y; acc[2 * HF + i][4 * q + 2] = a1.x; acc[2 * HF + i][4 * q + 3] = a1.y; } }
            asm volatile("" ::: "memory");
            { const unsigned off = nid[bq] * 512u + (unsigned)(sub * 16); R[2 * bq] = *(const u32x4*)(tb + off); R[2 * bq + 1] = *(const u32x4*)(tb + off + 256u); }
            asm volatile("" ::: "memory");
        }
    }
}
template <int MODE> __device__ __forceinline__ void apply_round(const Ptrs& P, float* outbase, int tbase, unsigned char* shm_wave, int lane_in) {
    int lane = lane_in; asm volatile("" : "+v"(lane));
    const int sub = lane & 15, g = lane >> 4, t = tbase + g;
    __attribute__((address_space(3))) unsigned* cnt = (lds_u32p)(__attribute__((address_space(3))) unsigned char*)shm_wave + g * 128;
    lds_v4p grp = (lds_v4p)((__attribute__((address_space(3))) unsigned char*)shm_wave + 2048 + g * 2048);
    __attribute__((address_space(3))) unsigned* grp1 = (__attribute__((address_space(3))) unsigned*)grp;
    const unsigned char* U8 = P.ws + WS_U; const unsigned char* V8 = P.ws + WS_V;
    {
        const int* idxp = (const int*)(P.ws + WS_IDX) + (size_t)t * 128 + sub * 8; const float* gp = (const float*)(P.ws + WS_G) + (size_t)t * 128 + sub * 8;
        const u32x4 ia = *(const u32x4*)idxp, ib = *(const u32x4*)(idxp + 4); const f32x4 ga = *(const f32x4*)gp, gb = *(const f32x4*)(gp + 4);
        const int e[8] = {(int)ia.x, (int)ia.y, (int)ia.z, (int)ia.w, (int)ib.x, (int)ib.y, (int)ib.z, (int)ib.w};
        const float gt[8] = {ga.x, ga.y, ga.z, ga.w, gb.x, gb.y, gb.z, gb.w};
        float su[8], sv[8];
#pragma unroll
        for (int i = 0; i < 8; ++i) { su[i] = ((const float*)(P.ws + WS_SU))[e[i]]; sv[i] = ((const float*)(P.ws + WS_SV))[e[i]]; }
#pragma unroll
        for (int i = 0; i < 8; ++i) cnt[sub * 8 + i] = 0u;
        asm volatile("s_waitcnt lgkmcnt(0)" ::: "memory");
        unsigned pos[8];
#pragma unroll
        for (int i = 0; i < 8; ++i) pos[i] = __hip_atomic_fetch_add(cnt + (e[i] >> 7), 1u, __ATOMIC_RELAXED, __HIP_MEMORY_SCOPE_WAVEFRONT);
        asm volatile("s_waitcnt lgkmcnt(0)" ::: "memory");
        unsigned c[8]; unsigned tot = 0;
#pragma unroll
        for (int i = 0; i < 8; ++i) { c[i] = cnt[sub * 8 + i]; }
#pragma unroll
        for (int i = 0; i < 8; ++i) { const unsigned x = c[i]; c[i] = tot; tot += x; }
        unsigned inc = tot;
#pragma unroll
        for (int d = 1; d < 16; d <<= 1) { const unsigned y = __shfl_up(inc, d, 16); if (sub >= d) inc += y; }
        const unsigned base = inc - tot;
        asm volatile("s_waitcnt lgkmcnt(0)" ::: "memory");
#pragma unroll
        for (int i = 0; i < 8; ++i) cnt[sub * 8 + i] = base + c[i];
        asm volatile("s_waitcnt lgkmcnt(0)" ::: "memory");
#pragma unroll
        for (int i = 0; i < 8; ++i) { const unsigned p = cnt[e[i] >> 7] + pos[i];
            grp1[p] = (unsigned)e[i]; grp1[128 + p] = __float_as_uint(su[i]); grp1[256 + p] = __float_as_uint(gt[i] * sv[i]); }
        asm volatile("s_waitcnt lgkmcnt(0)" ::: "memory");
    }
    const bf16_t* hrow = (const bf16_t*)(P.ws + WS_HB) + (size_t)t * D;
    float rstd;
    { const float* ssq = (const float*)(P.ws + WS_SSQ) + (size_t)t * 16;
      const f32x4 s0 = *(const f32x4*)ssq, s1 = *(const f32x4*)(ssq + 4), s2 = *(const f32x4*)(ssq + 8), s3 = *(const f32x4*)(ssq + 12);
      const float tot = ((s0.x + s0.y) + (s0.z + s0.w)) + ((s1.x + s1.y) + (s1.z + s1.w)) + ((s2.x + s2.y) + (s2.z + s2.w)) + ((s3.x + s3.y) + (s3.z + s3.w));
      rstd = 1.f / sqrtf(tot * (1.f / D) + EPS); }
    const unsigned char* U0 = U8; const unsigned char* U1 = U8 + (size_t)NEXP * 256; const unsigned char* V0 = V8; const unsigned char* V1 = V8 + (size_t)NEXP * 512;
    u32x4 R[AP_RINGU];
    {
#pragma unroll
      for (int b4 = 0; b4 < AP_RINGU / 4; ++b4) { const u32x4 ia = grp[b4]; R[4 * b4] = load_q4(U0, ia.x, sub); R[4 * b4 + 1] = load_q4(U0, ia.y, sub); R[4 * b4 + 2] = load_q4(U0, ia.z, sub); R[4 * b4 + 3] = load_q4(U0, ia.w, sub); } }
    pass_u4<0, false>(P, hrow, rstd, grp, R, U0, U1, sub);
    pass_u4<1, true>(P, hrow, rstd, grp, R, U1, V0, sub);
    float acc[4][16];
#pragma unroll
    for (int i = 0; i < 4; ++i)
#pragma unroll
        for (int q = 0; q < 16; ++q) acc[i][q] = 0.f;
    pass_v8f<0>(acc, grp, R, V0, V1, sub);
    pass_v8f<1>(acc, grp, R, V1, V1, sub);
    float ss = 0.f;
#pragma unroll
    for (int i = 0; i < 4; ++i) { const int e0 = (sub + 16 * i) * 16;
#pragma unroll
        for (int q = 0; q < 4; ++q) { const u32x2 hb = *(const u32x2*)(hrow + e0 + 4 * q);
            acc[i][4 * q] += bflo(hb.x); acc[i][4 * q + 1] += bfhi(hb.x); acc[i][4 * q + 2] += bflo(hb.y); acc[i][4 * q + 3] += bfhi(hb.y);
            ss += (acc[i][4 * q] * acc[i][4 * q] + acc[i][4 * q + 1] * acc[i][4 * q + 1]) + (acc[i][4 * q + 2] * acc[i][4 * q + 2] + acc[i][4 * q + 3] * acc[i][4 * q + 3]); }
        asm volatile("" ::: "memory"); }
    ss = row16_sum(ss);
    const float r2 = 1.f / sqrtf(ss * (1.f / D) + EPS);
    float* orow = outbase + (size_t)t * D;
#pragma unroll
    for (int i = 0; i < 4; ++i) { const int e0 = (sub + 16 * i) * 16;
#pragma unroll
        for (int q = 0; q < 4; ++q) { const f32x4 gv = *(const f32x4*)(P.norm_final + e0 + 4 * q);
            *(f32x4*)(orow + e0 + 4 * q) = (f32x4){acc[i][4 * q] * r2 * gv.x, acc[i][4 * q + 1] * r2 * gv.y, acc[i][4 * q + 2] * r2 * gv.z, acc[i][4 * q + 3] * r2 * gv.w}; }
        asm volatile("" ::: "memory"); }
}
template <int MODE> __device__ __forceinline__ void apply_phase(const Ptrs& P, float* outbase, unsigned char* shm, int G, int vcu) {
    int tid_l = threadIdx.x; asm volatile("" : "+v"(tid_l));
    const int lane = tid_l & 63; const int wave = __builtin_amdgcn_readfirstlane(tid_l >> 6);
    const int per = M / (G * 8);
#pragma unroll 1
    for (int r = 0; r < per; r += 4) apply_round<MODE>(P, outbase, (vcu * 8 + wave) * per + r, shm + wave * AP_WAVE_BYTES, lane);
}
}

#define LAS __attribute__((address_space(3)))
#define XB_TMO      128
#define XB_XCNT(j)  (256  + 64 * (j))
#define XB_XSUB(j)  (1280 + 64 * (j))
#define XB_XGEN(j)  (2304 + 64 * (j))
#define XB_TOP      3328
#define XB_TOPGEN   3392
#define XCD_BAR_WORDS 3456
#define XB_SPIN_CAP (1u << 18)

__device__ __forceinline__ unsigned xb_ld(unsigned* p)              { return __hip_atomic_load(p, __ATOMIC_RELAXED, __HIP_MEMORY_SCOPE_AGENT); }
__device__ __forceinline__ unsigned xb_add(unsigned* p, unsigned v) { return __hip_atomic_fetch_add(p, v, __ATOMIC_RELAXED, __HIP_MEMORY_SCOPE_AGENT); }
__device__ __forceinline__ unsigned xb_xcc_id() { return (unsigned)__builtin_amdgcn_s_getreg((3 << 11) | 20) & 0xFu; }
#define XB_SPIN(cond, bar) do { unsigned _sp = 0; while (cond) { __builtin_amdgcn_s_sleep(1); \
    if ((++_sp & 255u) == 0u) { if (xb_ld(&(bar)[XB_TMO])) break; if (_sp > XB_SPIN_CAP) { atomicAdd(&(bar)[XB_TMO], 1u); break; } } } } while (0)

struct XcdBarrier {
    unsigned* bar; unsigned x;
    volatile LAS unsigned* st;
};

__device__ __forceinline__ XcdBarrier xcd_barrier_post(unsigned* bar, volatile LAS unsigned* st) {
    XcdBarrier b; b.bar = bar; b.x = xb_xcc_id(); b.st = st;
    if (threadIdx.x == 0) (void)xb_add(&bar[XB_XCNT(b.x)], 1u);
    return b;
}
__device__ __forceinline__ void xcd_barrier_complete(unsigned* bar, unsigned x, unsigned& nloc, unsigned& nx) {
    const unsigned G = gridDim.x * gridDim.y * gridDim.z;
    unsigned sum, cnt, mine, sp = 0u;
    for (;;) {
        sum = 0u; cnt = 0u; mine = 0u;
#pragma unroll
        for (unsigned j = 0; j < 16; ++j) { const unsigned c = xb_ld(&bar[XB_XCNT(j)]); sum += c; cnt += (c > 0u) ? 1u : 0u; mine = (j == x) ? c : mine; }
        if (sum == G) break;
        __builtin_amdgcn_s_sleep(1);
        if ((++sp & 255u) == 0u) { if (xb_ld(&bar[XB_TMO])) break; if (sp > XB_SPIN_CAP) { atomicAdd(&bar[XB_TMO], 1u); break; } }
    }
    nloc = mine > 0u ? mine : 1u; nx = cnt > 0u ? cnt : 1u;
}

__device__ __forceinline__ void xcd_barrier(const XcdBarrier& b) {
    asm volatile("s_waitcnt vmcnt(0)" ::: "memory");
    __syncthreads();
    if (threadIdx.x == 0) {
        unsigned* bar = b.bar;
        __builtin_amdgcn_s_waitcnt(0);
        unsigned nloc = b.st[0], nx = b.st[1];
        if (nloc == 0u) { xcd_barrier_complete(bar, b.x, nloc, nx); b.st[0] = nloc; b.st[1] = nx; }
        const unsigned old = xb_add(&bar[XB_XSUB(b.x)], 1u);
        const unsigned gen = old / nloc;
        if (old + 1u == (gen + 1u) * nloc) {
            __builtin_amdgcn_fence(__ATOMIC_RELEASE, "agent");
            asm volatile("s_waitcnt vmcnt(0)" ::: "memory");
            const unsigned og = xb_add(&bar[XB_TOP], 1u);
            const unsigned tg = og / nx;
            if (og + 1u == (tg + 1u) * nx) xb_add(&bar[XB_TOPGEN], 1u);
            else XB_SPIN(xb_ld(&bar[XB_TOPGEN]) == tg, bar);
            __builtin_amdgcn_fence(__ATOMIC_ACQUIRE, "agent");
            xb_add(&bar[XB_XGEN(b.x)], 1u);
            asm volatile("s_waitcnt vmcnt(0)" ::: "memory");
        } else {
            XB_SPIN(xb_ld(&bar[XB_XGEN(b.x)]) == gen, bar);
            __builtin_amdgcn_fence(__ATOMIC_ACQUIRE, "agent");
            asm volatile("s_waitcnt vmcnt(0)" ::: "memory");
        }
    }
    __syncthreads();
}


namespace cg = cooperative_groups;
#ifndef REP_MASK
#define REP_MASK 0
#endif
#define REPS(k) (((REP_MASK) >> (k)) & 1 ? 2 : 1)
constexpr int PHASE_LDS = att::A_LDS_BYTES;
constexpr int MEGA_LDS = PHASE_LDS + 64;
static_assert(PHASE_LDS >= pg8::STAGE_BYTES && PHASE_LDS >= att::B_LDS_BYTES && PHASE_LDS >= peer::T_LDS_BYTES && PHASE_LDS >= 8 * 64 * 33 * 4 && PHASE_LDS >= apply::AP_LDS_BYTES, "LDS budget");
__global__ void __launch_bounds__(512, 2) mega_fwd(Ptrs P) {
    extern __shared__ __attribute__((aligned(16))) unsigned char lds_dyn[];
    volatile LAS unsigned* bst = (volatile LAS unsigned*)((LAS unsigned char*)lds_dyn + PHASE_LDS);
    if (threadIdx.x < 2) bst[threadIdx.x] = 0u;
    __syncthreads();
    const XcdBarrier bar = xcd_barrier_post((unsigned*)(P.ws + WS_CTL), bst);
    const int G = (int)gridDim.x, bx = (int)blockIdx.x, vcu = (G % 8 == 0) ? (bx % 8) * (G / 8) + bx / 8 : bx;
    unsigned char* ws = P.ws;
    PG8_LAS unsigned char* lds3 = (PG8_LAS unsigned char*)lds_dyn;
    for (int rep = 0; rep < REPS(0); ++rep) prep_phase(P, lds_dyn, G, bx);
    xcd_barrier(bar); if (REPS(9) == 2) xcd_barrier(bar);
    for (int rep = 0; rep < REPS(1); ++rep) {
      { pg8::Gemm g{(const bf16_t*)(ws + WS_XN), (const bf16_t*)(ws + WS_WIN), M, 1024, D, 0}; pg8::StaticOrder S; S.init(M, 1024, G, bx);
        pg8::gemm_phase<pg8::EpiProj, pg8::StaticOrder, true, true, false>(lds3, g, S, pg8::EpiProj{(bf16_t*)(ws + WS_PROJ), (const float*)(ws + WS_ROPE), 1.f, 0}); }
      { pg8::Gemm g{(const bf16_t*)(ws + WS_XN8), (const bf16_t*)(ws + WS_WIN8), M, INW - 1024, D / 2, 0}; pg8::StaticOrder S; S.init(M, INW - 1024, G, bx);
        pg8::gemm_phase<pg8::EpiProj, pg8::StaticOrder, true, true, true>(lds3, g, S, pg8::EpiProj{(bf16_t*)(ws + WS_PROJ), (const float*)(ws + WS_ROPE), 1.f / WIN_SCALE, 4}); } }
    xcd_barrier(bar); if (REPS(9) == 2) xcd_barrier(bar);
    { const float lam = lambda_full(P);
      for (int rep = 0; rep < REPS(2); ++rep) for (int u = vcu; u < BATCH * 4 * 8; u += G) att::attn_a_unit(u >> 5, (u >> 3) & 3, u & 7, (const bf16_t*)(ws + WS_PROJ), (bf16_t*)(ws + WS_YA), P.subln, lam, lds_dyn);
      for (int rep = 0; rep < REPS(3); ++rep) for (int u = vcu; u < BATCH * 8 * 8; u += G) att::attn_b_unit(u >> 6, (u >> 3) & 7, u & 7, (const bf16_t*)(ws + WS_PROJ), (bf16_t*)(ws + WS_YA), P.rpb, lds_dyn); }
    xcd_barrier(bar); if (REPS(9) == 2) xcd_barrier(bar);
    for (int rep = 0; rep < REPS(4); ++rep) { pg8::StaticOrder S; S.init(M, D, G, bx);
      pg8::gemm_phase<pg8::EpiGate2, pg8::StaticOrder, true, true>(lds3, pg8::Gemm{(const bf16_t*)(ws + WS_YA), (const bf16_t*)(ws + WS_WPA), M, D, D, 0}, S, pg8::EpiGate2{(const bf16_t*)(ws + WS_PROJ), (bf16_t*)(ws + WS_MERGED)}); }
    xcd_barrier(bar); if (REPS(9) == 2) xcd_barrier(bar);
    for (int rep = 0; rep < REPS(5); ++rep) { pg8::StaticOrder S; S.init(M, D, G, bx);
      pg8::gemm_phase<pg8::EpiHout, pg8::StaticOrder, true, true>(lds3, pg8::Gemm{(const bf16_t*)(ws + WS_MERGED), (const bf16_t*)(ws + WS_WOUT), M, D, D, 0}, S, pg8::EpiHout{P.x, P.out, (bf16_t*)(ws + WS_HB), (float*)(ws + WS_SSQ)});
    }
    xcd_barrier(bar); if (REPS(9) == 2) xcd_barrier(bar);
    { pg8::StaticOrder S; S.init(M, PQ, G, bx);
      for (int rep = 0; rep < REPS(8); ++rep)
        pg8::gemm_phase<pg8::EpiQ, pg8::StaticOrder, true, true>(lds3, pg8::Gemm{(const bf16_t*)(ws + WS_HB), (const bf16_t*)(ws + WS_WQ), M, PQ, D, 0}, S, pg8::EpiQ{(const float*)(ws + WS_SSQ), (bf16_t*)(ws + WS_Q)});
      asm volatile("s_waitcnt vmcnt(0)" ::: "memory");
      __syncthreads();
      if (threadIdx.x == 0) { __builtin_amdgcn_fence(__ATOMIC_ACQUIRE, "agent"); asm volatile("s_waitcnt vmcnt(0)" ::: "memory"); }
      __syncthreads();
      for (int rep = 0; rep < REPS(6); ++rep) peer::topk_own_units(P, lds_dyn, S); }
    xcd_barrier(bar); if (REPS(9) == 2) xcd_barrier(bar);
#ifndef PROBE_MODE
#define PROBE_MODE 0
#endif
    if (REPS(7) == 2) apply::apply_phase<PROBE_MODE>(P, (float*)(ws + WS_Q), lds_dyn, G, vcu);
    apply::apply_phase<0>(P, P.out, lds_dyn, G, vcu);
}

extern "C" void kernel_launch(void* const* d_in, const int* in_sizes, int n_in, void* d_out, int out_size, void* d_ws, size_t ws_size, hipStream_t stream) {
    if (n_in != 18 || ws_size < WS_END) { fprintf(stderr, "kernel_launch: unexpected n_in %d / ws_size %zu\n", n_in, ws_size); return; }
    Ptrs P{};
    P.x = (const float*)d_in[0]; P.w_in = (const float*)d_in[1]; P.w_pa = (const float*)d_in[2]; P.w_pb = (const float*)d_in[3]; P.w_out = (const float*)d_in[4];
    P.norm_mix = (const float*)d_in[5]; P.norm_ffn = (const float*)d_in[6]; P.norm_final = (const float*)d_in[7];
    P.lq1 = (const float*)d_in[8]; P.lk1 = (const float*)d_in[9]; P.lq2 = (const float*)d_in[10]; P.lk2 = (const float*)d_in[11];
    P.subln = (const float*)d_in[12]; P.rpb = (const float*)d_in[13]; P.w_query = (const float*)d_in[14]; P.sub_keys = (const float*)d_in[15];
    P.peer_u = (const float*)d_in[16]; P.peer_v = (const float*)d_in[17];
    P.out = (float*)d_out; P.ws = (unsigned char*)d_ws;
    static int grid_blocks = 0;
    if (!grid_blocks) {
        int dev = 0, cus = 0, per_cu = 0;
        hipGetDevice(&dev);
        hipDeviceGetAttribute(&cus, hipDeviceAttributeMultiprocessorCount, dev);
        hipFuncSetAttribute((const void*)mega_fwd, hipFuncAttributeMaxDynamicSharedMemorySize, MEGA_LDS);
        hipOccupancyMaxActiveBlocksPerMultiprocessor(&per_cu, (const void*)mega_fwd, 512, MEGA_LDS);
        if (per_cu < 1) { fprintf(stderr, "kernel_launch: occupancy query says %d blocks per CU\n", per_cu); per_cu = 1; }
        grid_blocks = cus * per_cu;
    }
    hipMemsetAsync((unsigned char*)d_ws + WS_CTL, 0, 16384, stream);
    void* args[] = {&P};
    hipError_t e = hipLaunchCooperativeKernel((const void*)mega_fwd, dim3(grid_blocks), dim3(512), args, MEGA_LDS, stream);
    if (e != hipSuccess) fprintf(stderr, "cooperative launch failed: %s (grid %d)\n", hipGetErrorString(e), grid_blocks);
}
```

```cpp
#include <hip/hip_runtime.h>
#include <hip/hip_cooperative_groups.h>
#include <cstdio>
#include <cstdint>

typedef unsigned short bf16_t;
typedef unsigned u32x4 __attribute__((ext_vector_type(4)));
typedef unsigned u32x2 __attribute__((ext_vector_type(2)));
typedef float f32x4 __attribute__((ext_vector_type(4)));
typedef __bf16 bf16x2_t __attribute__((ext_vector_type(2)));

constexpr int D = 1024, BATCH = 8, SEQ = 2048, M = BATCH * SEQ, INW = 5120;
constexpr int C_QA = 0, C_KA = 512, C_VA = 1024, C_QB = 1536, C_KB = 2048, C_VB = 2560, C_GA = 3072, C_GB = 4096;
constexpr int NEXP = 16384, PQ = 2048;
constexpr float EPS = 1e-6f;
constexpr float LOG2E = 1.4426950408889634f;
constexpr float WIN_SCALE = 32.f;
constexpr float QSCALE = 0.125f * LOG2E;

constexpr size_t MiB = 1u << 20;
constexpr size_t WS_PROJ = 0;
constexpr size_t WS_HB = 0;
constexpr size_t WS_Q = 32 * MiB;
constexpr size_t WS_U = 96 * MiB;
constexpr size_t WS_V = 112 * MiB;
constexpr size_t WS_SU = 128 * MiB;
constexpr size_t WS_SV = 128 * MiB + 65536;
constexpr size_t WS_XN = 160 * MiB;
constexpr size_t WS_YA = 160 * MiB;
constexpr size_t WS_YB = 176 * MiB;
constexpr size_t WS_IDX = 160 * MiB;
constexpr size_t WS_G = 168 * MiB;
constexpr size_t WS_MERGED = 192 * MiB;
constexpr size_t WS_TOPV = 192 * MiB;
constexpr size_t WS_TOPI = 208 * MiB;
constexpr size_t WS_WIN = 224 * MiB;
constexpr size_t WS_WIN8 = 226 * MiB;
constexpr size_t WS_XN8 = 192 * MiB;
constexpr size_t WS_WQ = 234 * MiB;
constexpr size_t WS_WOUT = 238 * MiB;
constexpr size_t WS_WPA = 240 * MiB;
constexpr size_t WS_WPB = 241 * MiB;
constexpr size_t WS_SK = 242 * MiB;
constexpr size_t WS_ROPE = 242 * MiB + 512 * 1024;
constexpr size_t WS_SSQ = 243 * MiB;
constexpr size_t WS_CTL = 244 * MiB;
constexpr size_t WS_END = 256 * MiB;

__device__ __forceinline__ float bf2f(unsigned v) { return __uint_as_float(v << 16); }
__device__ __forceinline__ float bflo(unsigned w) { return __uint_as_float(w << 16); }
__device__ __forceinline__ float bfhi(unsigned w) { return __uint_as_float(w & 0xffff0000u); }
__device__ __forceinline__ unsigned f2bf(float f) { unsigned u = __float_as_uint(f); return (u + 0x7fffu + ((u >> 16) & 1u)) >> 16; }
__device__ __forceinline__ unsigned pk2(float lo, float hi) { return f2bf(lo) | (f2bf(hi) << 16); }
__device__ __forceinline__ float wave_sum(float v) {
#pragma unroll
    for (int o = 1; o < 64; o <<= 1) v += __shfl_xor(v, o);
    return v;
}
__device__ __forceinline__ float sigmoidf_(float x) { return 1.f / (1.f + __expf(-x)); }
__device__ __forceinline__ float gelu_exact(float x) { return 0.5f * x * (1.f + erff(x * 0.70710678118654752f)); }

struct Ptrs {
    const float *x, *w_in, *w_pa, *w_pb, *w_out, *norm_mix, *norm_ffn, *norm_final, *lq1, *lk1, *lq2, *lk2, *subln, *rpb, *w_query, *sub_keys, *peer_u, *peer_v;
    float* out; unsigned char* ws;
};

__device__ __forceinline__ void transpose_item(const float* W, int K, int N, const float* gain, bf16_t* WT, float* scr, int item, int lane, int ldo = 0, int koff = 0, int ldw = 0) {
    if (ldo == 0) ldo = K;
    if (ldw == 0) ldw = N;
    const int nblk = N / 32, kb = item / nblk, nb = item % nblk, k0 = 64 * kb, n0 = 32 * nb;
    float wv[32];
#pragma unroll
    for (int i = 0; i < 32; ++i) { const int kk = 2 * i + (lane >> 5); wv[i] = W[(size_t)(k0 + kk) * ldw + n0 + (lane & 31)]; }
#pragma unroll
    for (int i = 0; i < 32; ++i) { const int kk = 2 * i + (lane >> 5); float w = wv[i]; if (gain) w *= gain[k0 + kk]; scr[kk * 33 + (lane & 31)] = w; }
    asm volatile("s_waitcnt lgkmcnt(0)" ::: "memory");
    const int c = lane & 7;
#pragma unroll
    for (int j = 0; j < 4; ++j) { const int n = (lane >> 3) + 8 * j; const float* s = scr + (8 * c) * 33 + n;
        u32x4 o; o.x = pk2(s[0 * 33], s[1 * 33]); o.y = pk2(s[2 * 33], s[3 * 33]); o.z = pk2(s[4 * 33], s[5 * 33]); o.w = pk2(s[6 * 33], s[7 * 33]);
        *(u32x4*)(WT + (size_t)(n0 + n) * ldo + koff + k0 + 8 * c) = o; }
    asm volatile("s_waitcnt lgkmcnt(0)" ::: "memory");
}
__device__ __forceinline__ void cvt8(const float* src, bf16_t* dst, size_t i8) {
    const f32x4 a = *(const f32x4*)(src + i8 * 8), b = *(const f32x4*)(src + i8 * 8 + 4);
    u32x4 o; o.x = pk2(a.x, a.y); o.y = pk2(a.z, a.w); o.z = pk2(b.x, b.y); o.w = pk2(b.z, b.w);
    *(u32x4*)(dst + i8 * 8) = o;
}
__device__ __forceinline__ void transpose_item8(const float* W, int K, int N, int ldw, const float* gain, float wscale, unsigned char* WT, float* scr, int item, int lane) {
    const int nblk = N / 32, kb = item / nblk, nb = item % nblk, k0 = 64 * kb, n0 = 32 * nb;
    float wv[32];
#pragma unroll
    for (int i = 0; i < 32; ++i) { const int kk = 2 * i + (lane >> 5); wv[i] = W[(size_t)(k0 + kk) * ldw + n0 + (lane & 31)]; }
#pragma unroll
    for (int i = 0; i < 32; ++i) { const int kk = 2 * i + (lane >> 5); float w = wv[i] * wscale; if (gain) w *= gain[k0 + kk]; scr[kk * 33 + (lane & 31)] = w; }
    asm volatile("s_waitcnt lgkmcnt(0)" ::: "memory");
    const int c = lane & 7;
#pragma unroll
    for (int j = 0; j < 4; ++j) { const int n = (lane >> 3) + 8 * j; const float* s = scr + (8 * c) * 33 + n;
        u32x2 o; o.x = __builtin_amdgcn_cvt_pk_fp8_f32(s[0 * 33], s[1 * 33], 0u, false); o.x = __builtin_amdgcn_cvt_pk_fp8_f32(s[2 * 33], s[3 * 33], o.x, true);
        o.y = __builtin_amdgcn_cvt_pk_fp8_f32(s[4 * 33], s[5 * 33], 0u, false); o.y = __builtin_amdgcn_cvt_pk_fp8_f32(s[6 * 33], s[7 * 33], o.y, true);
        *(u32x2*)(WT + (size_t)(n0 + n) * K + k0 + 8 * c) = o; }
    asm volatile("s_waitcnt lgkmcnt(0)" ::: "memory");
}
__device__ __forceinline__ void rms_rows_emit(const f32x4 (&v)[4], bf16_t* orow16, unsigned char* orow, int lane) {
    float s = 0.f;
#pragma unroll
    for (int j = 0; j < 4; ++j) s += (v[j].x * v[j].x + v[j].y * v[j].y) + (v[j].z * v[j].z + v[j].w * v[j].w);
    const float rstd = 1.f / sqrtf(wave_sum(s) * (1.f / D) + EPS);
    unsigned* o4 = (unsigned*)orow + lane; u32x2* o8 = (u32x2*)orow16 + lane;
#pragma unroll
    for (int j = 0; j < 4; ++j) { unsigned w = __builtin_amdgcn_cvt_pk_fp8_f32(v[j].x * rstd, v[j].y * rstd, 0u, false); w = __builtin_amdgcn_cvt_pk_fp8_f32(v[j].z * rstd, v[j].w * rstd, w, true); o4[64 * j] = w;
        u32x2 w2; w2.x = pk2(v[j].x * rstd, v[j].y * rstd); w2.y = pk2(v[j].z * rstd, v[j].w * rstd); o8[64 * j] = w2; }
}
__device__ __forceinline__ void rms_rows(const float* x, bf16_t* xn16, unsigned char* xn8, int m0, int step, int lane) {
    if (m0 >= M) return;
    f32x4 cur[4], nxt[4];
#pragma unroll
    for (int j = 0; j < 4; ++j) cur[j] = ((const f32x4*)(x + (size_t)m0 * D) + lane)[64 * j];
    for (int m = m0; m < M; m += step) {
        const int mn = (m + step < M) ? m + step : m;
#pragma unroll
        for (int j = 0; j < 4; ++j) nxt[j] = ((const f32x4*)(x + (size_t)mn * D) + lane)[64 * j];
        rms_rows_emit(cur, xn16 + (size_t)m * D, xn8 + (size_t)m * D, lane);
#pragma unroll
        for (int j = 0; j < 4; ++j) cur[j] = nxt[j];
    }
}
__device__ __forceinline__ void rms_row_to_bf16(const float* xrow, bf16_t* orow, int lane) {
    const f32x4* xr = (const f32x4*)xrow + lane;
    f32x4 v[4]; float s = 0.f;
#pragma unroll
    for (int j = 0; j < 4; ++j) { v[j] = xr[64 * j]; s += (v[j].x * v[j].x + v[j].y * v[j].y) + (v[j].z * v[j].z + v[j].w * v[j].w); }
    const float rstd = 1.f / sqrtf(wave_sum(s) * (1.f / D) + EPS);
    u32x2* o8 = (u32x2*)orow + lane;
#pragma unroll
    for (int j = 0; j < 4; ++j) { u32x2 w; w.x = pk2(v[j].x * rstd, v[j].y * rstd); w.y = pk2(v[j].z * rstd, v[j].w * rstd); o8[64 * j] = w; }
}

__device__ __forceinline__ void prep_phase(const Ptrs& P, unsigned char* shm, int G, int bx) {
    int tid_l = threadIdx.x; asm volatile("" : "+v"(tid_l));
    const int lane = tid_l & 63; const int wave = __builtin_amdgcn_readfirstlane(tid_l >> 6);
    const int gw = bx * 8 + wave, NGW = G * 8;
    float* scr = (float*)(shm + wave * (64 * 33 * 4));
    unsigned char* ws = P.ws;
    constexpr int N_BF = 1024;
    constexpr int I_INB = (D / 64) * (N_BF / 32), I_IN8 = (D / 64) * ((INW - N_BF) / 32), I_IN = I_INB + I_IN8, I_Q = (D / 64) * (PQ / 32), I_OUT = (D / 64) * (D / 32), I_PA = (512 / 64) * (D / 32);
    constexpr int NIT = I_IN + I_Q + I_OUT + 2 * I_PA;
    for (int it = gw; it < NIT; it += NGW) {
        int r = it;
        if (r < I_INB) { transpose_item(P.w_in, D, N_BF, P.norm_mix, (bf16_t*)(ws + WS_WIN), scr, r, lane, 0, 0, INW); continue; } r -= I_INB;
        if (r < I_IN8) { transpose_item8(P.w_in + N_BF, D, INW - N_BF, INW, P.norm_mix, WIN_SCALE, ws + WS_WIN8, scr, r, lane); continue; } r -= I_IN8;
        if (r < I_Q) { transpose_item(P.w_query, D, PQ, P.norm_ffn, (bf16_t*)(ws + WS_WQ), scr, r, lane); continue; } r -= I_Q;
        if (r < I_OUT) { transpose_item(P.w_out, D, D, nullptr, (bf16_t*)(ws + WS_WOUT), scr, r, lane); continue; } r -= I_OUT;
        if (r < I_PA) { transpose_item(P.w_pa, 512, D, nullptr, (bf16_t*)(ws + WS_WPA), scr, r, lane, 1024, 0); continue; } r -= I_PA;
        transpose_item(P.w_pb, 512, D, nullptr, (bf16_t*)(ws + WS_WPA), scr, r, lane, 1024, 512);
    }
    rms_rows(P.x, (bf16_t*)(ws + WS_XN), ws + WS_XN8, gw, NGW, lane);
    const size_t gt = (size_t)bx * 512 + threadIdx.x, NT = (size_t)G * 512;
    for (size_t i = gt; i < (size_t)16 * 128 * 128 / 8; i += NT) cvt8(P.sub_keys, (bf16_t*)(ws + WS_SK), i);
    for (size_t i = gt; i < (size_t)SEQ * 8; i += NT) {
        const int pos = (int)(i >> 3), k = (int)(i & 7);
        const float inv = k == 0 ? 1.0f : k == 1 ? 0.19392274f : k == 2 ? 0.03760603f : k == 3 ? 0.0072926646f : k == 4 ? 0.0014142136f : k == 5 ? 0.0002742482f : k == 6 ? 5.3182957e-05f : 1.0313385e-05f;
        const float ang = (float)pos * inv;
        float sn, cs; sincosf(ang, &sn, &cs);
        float* t = (float*)(ws + WS_ROPE) + (size_t)pos * 16;
        t[k] = cs; t[8 + k] = sn;
    }
}
__device__ __forceinline__ void cvt_row_fp8(const f32x4 (&rv)[4], unsigned char* dst, float* inv_scale, int lane) {
    const f32x4 a = rv[0], b = rv[1], c = rv[2], d = rv[3];
    float m = fmaxf(fmaxf(fmaxf(fabsf(a.x), fabsf(a.y)), fmaxf(fabsf(a.z), fabsf(a.w))), fmaxf(fmaxf(fabsf(b.x), fabsf(b.y)), fmaxf(fabsf(b.z), fabsf(b.w))));
    m = fmaxf(m, fmaxf(fmaxf(fmaxf(fabsf(c.x), fabsf(c.y)), fmaxf(fabsf(c.z), fabsf(c.w))), fmaxf(fmaxf(fabsf(d.x), fabsf(d.y)), fmaxf(fabsf(d.z), fabsf(d.w)))));
#pragma unroll
    for (int o = 1; o < 64; o <<= 1) m = fmaxf(m, __shfl_xor(m, o));
    m = fmaxf(m, 1e-30f);
    const float sc = 256.f / m;
    u32x4 w;
    w.x = __builtin_amdgcn_cvt_pk_fp8_f32(a.x * sc, a.y * sc, 0u, false); w.x = __builtin_amdgcn_cvt_pk_fp8_f32(a.z * sc, a.w * sc, w.x, true);
    w.y = __builtin_amdgcn_cvt_pk_fp8_f32(b.x * sc, b.y * sc, 0u, false); w.y = __builtin_amdgcn_cvt_pk_fp8_f32(b.z * sc, b.w * sc, w.y, true);
    w.z = __builtin_amdgcn_cvt_pk_fp8_f32(c.x * sc, c.y * sc, 0u, false); w.z = __builtin_amdgcn_cvt_pk_fp8_f32(c.z * sc, c.w * sc, w.z, true);
    w.w = __builtin_amdgcn_cvt_pk_fp8_f32(d.x * sc, d.y * sc, 0u, false); w.w = __builtin_amdgcn_cvt_pk_fp8_f32(d.z * sc, d.w * sc, w.w, true);
    *(u32x4*)(dst + (size_t)(lane >> 5) * (NEXP * 512) + (lane & 31) * 16) = w;
    if (lane == 0) *inv_scale = m * (1.f / 256.f);
}
__device__ __forceinline__ unsigned nib4(float v, float sc) { const int q = (int)rintf(fminf(fmaxf(v * sc, -7.f), 7.f)); return (unsigned)q & 15u; }
__device__ __forceinline__ unsigned pack_i4x8(const f32x4& a, const f32x4& b, float sc) {
    return nib4(a.x, sc) | (nib4(a.y, sc) << 4) | (nib4(a.z, sc) << 8) | (nib4(a.w, sc) << 12) | (nib4(b.x, sc) << 16) | (nib4(b.y, sc) << 20) | (nib4(b.z, sc) << 24) | (nib4(b.w, sc) << 28);
}
__device__ __forceinline__ void cvt_row_i4(const f32x4 (&rv)[4], unsigned char* dst, float* inv_scale, int lane) {
    const f32x4 a = rv[0], b = rv[1], c = rv[2], d = rv[3];
    float ss = ((a.x * a.x + a.y * a.y) + (a.z * a.z + a.w * a.w)) + ((b.x * b.x + b.y * b.y) + (b.z * b.z + b.w * b.w));
    ss += ((c.x * c.x + c.y * c.y) + (c.z * c.z + c.w * c.w)) + ((d.x * d.x + d.y * d.y) + (d.z * d.z + d.w * d.w));
#pragma unroll
    for (int o = 1; o < 64; o <<= 1) ss += __shfl_xor(ss, o);
    const float rms = fmaxf(sqrtf(ss * (1.f / D)), 1e-30f);
    const float sc = 2.8f / rms;
    u32x2 w; w.x = pack_i4x8(a, b, sc); w.y = pack_i4x8(c, d, sc);
    *(u32x2*)(dst + (size_t)(lane >> 5) * (NEXP * 256) + (lane & 15) * 16 + ((lane >> 4) & 1) * 8) = w;
    if (lane == 0) *inv_scale = rms * (2.5f / 7.f);
}
__device__ __forceinline__ unsigned pack_i8x4(float a, float b, float c, float d) {
    const int q0 = (int)rintf(a), q1 = (int)rintf(b), q2 = (int)rintf(c), q3 = (int)rintf(d);
    return (unsigned)(q0 & 0xff) | ((unsigned)(q1 & 0xff) << 8) | ((unsigned)(q2 & 0xff) << 16) | ((unsigned)q3 << 24);
}
__device__ __forceinline__ void cvt_row_i8(const f32x4 (&rv)[4], unsigned char* dst, float* inv_scale, int lane) {
    const f32x4 a = rv[0], b = rv[1], c = rv[2], d = rv[3];
    float m = fmaxf(fmaxf(fmaxf(fabsf(a.x), fabsf(a.y)), fmaxf(fabsf(a.z), fabsf(a.w))), fmaxf(fmaxf(fabsf(b.x), fabsf(b.y)), fmaxf(fabsf(b.z), fabsf(b.w))));
    m = fmaxf(m, fmaxf(fmaxf(fmaxf(fabsf(c.x), fabsf(c.y)), fmaxf(fabsf(c.z), fabsf(c.w))), fmaxf(fmaxf(fabsf(d.x), fabsf(d.y)), fmaxf(fabsf(d.z), fabsf(d.w)))));
#pragma unroll
    for (int o = 1; o < 64; o <<= 1) m = fmaxf(m, __shfl_xor(m, o));
    m = fmaxf(m, 1e-30f);
    const float sc = 127.f / m;
    u32x4 w;
    w.x = pack_i8x4(a.x * sc, a.y * sc, a.z * sc, a.w * sc); w.y = pack_i8x4(b.x * sc, b.y * sc, b.z * sc, b.w * sc);
    w.z = pack_i8x4(c.x * sc, c.y * sc, c.z * sc, c.w * sc); w.w = pack_i8x4(d.x * sc, d.y * sc, d.z * sc, d.w * sc);
    *(u32x4*)(dst + (size_t)(lane >> 5) * (NEXP * 512) + (lane & 31) * 16) = w;
    if (lane == 0) *inv_scale = m * (1.f / 127.f);
}
__device__ __forceinline__ void cvt_experts_phase(const Ptrs& P, int G, int bx) {
    int tid_l = threadIdx.x; asm volatile("" : "+v"(tid_l));
    const int lane = tid_l & 63; const int wave = __builtin_amdgcn_readfirstlane(tid_l >> 6);
    const int step = G * 8; int r = bx * 8 + wave;
    if (r >= 2 * NEXP) return;
    f32x4 cur[4], nxt[4];
    { const float* src = (r < NEXP ? P.peer_u + (size_t)r * D : P.peer_v + (size_t)(r - NEXP) * D);
#pragma unroll
      for (int j = 0; j < 4; ++j) cur[j] = ((const f32x4*)src + lane * 4)[j]; }
    for (; r < 2 * NEXP; r += step) {
        const int rn = (r + step < 2 * NEXP) ? r + step : r;
        const float* srcn = (rn < NEXP ? P.peer_u + (size_t)rn * D : P.peer_v + (size_t)(rn - NEXP) * D);
#pragma unroll
        for (int j = 0; j < 4; ++j) nxt[j] = ((const f32x4*)srcn + lane * 4)[j];
        if (r < NEXP) cvt_row_i8(cur, P.ws + WS_U + (size_t)r * 512, (float*)(P.ws + WS_SU) + r, lane);
        else { const int e = r - NEXP; cvt_row_fp8(cur, P.ws + WS_V + (size_t)e * 512, (float*)(P.ws + WS_SV) + e, lane); }
#pragma unroll
        for (int j = 0; j < 4; ++j) cur[j] = nxt[j];
    }
}

namespace pg8 {
#define PG8_LAS __attribute__((address_space(3)))
typedef unsigned short bf16_t;
typedef short bf16x8 __attribute__((ext_vector_type(8)));
typedef float f32x4 __attribute__((ext_vector_type(4)));
typedef unsigned u32x4 __attribute__((ext_vector_type(4)));
typedef int v8i_t __attribute__((ext_vector_type(8)));
constexpr int BM = 256, BK = 64, HALF = 128, HTB = HALF * BK * 2  , STAGE_BYTES = 8 * HTB, NXCD = 8, WGM = 4;

__host__ __device__ __forceinline__ int lds_byte(int r, int c) { const int st = (r >> 4) * 2 + (c >> 5), rr = r & 15, cc = c & 31, ob = rr * 64 + cc * 2; return st * 1024 + (ob ^ (((ob >> 9) & 1) << 5)); }
__host__ __device__ __forceinline__ void stage_rc(int b, int& R, int& C) { const int st = b / 1024, sb = b % 1024, swz = sb ^ (((sb >> 9) & 1) << 5); R = (st >> 1) * 16 + swz / 64; C = (st & 1) * 32 + (swz % 64) / 2; }
__host__ __device__ __forceinline__ int perm32(int rho) { const int n = rho >> 4, i = rho & 15; return 8 * (i >> 2) + 4 * n + (i & 3); }

struct Unit { int pm, pn; };
struct Gemm { const bf16_t* A; const bf16_t* Bt; int M, N, K, pad; };

struct StaticOrder {
    int nM, nN, nwg, G, c;
    __host__ __device__ void init(int M, int N, int G_, int c_) { nM = M / BM; nN = N / BM; nwg = nM * nN; G = G_; c = c_; }
    __host__ __device__ bool next(int i, Unit& u) const {
        const long L = (long)i * G + c; if (L >= nwg) return false;
        int wgid = (int)L; { const int q = nwg / NXCD, r = nwg % NXCD, xcd = wgid % NXCD, off = wgid / NXCD; wgid = (xcd < r ? xcd * (q + 1) : r * (q + 1) + (xcd - r) * q) + off; }
        const int nig = WGM * nN, gid = wgid / nig, fm = gid * WGM, gsz = (nM - fm) < WGM ? (nM - fm) : WGM;
        u.pm = fm + ((wgid % nig) % gsz); u.pn = (wgid % nig) / gsz; return true;
    }
    __device__ __forceinline__ void a_ready(const Unit&) const {}
    __device__ __forceinline__ void done(const Unit&) const {}
};
__device__ __forceinline__ unsigned cvt_pk_bf16(float lo, float hi) { unsigned r; asm volatile("v_cvt_pk_bf16_f32 %0, %1, %2" : "=v"(r) : "v"(lo), "v"(hi)); return r; }
typedef float f32x2 __attribute__((ext_vector_type(2)));

__device__ __forceinline__ float sigm(float x) { return __builtin_amdgcn_rcpf(1.f + __builtin_amdgcn_exp2f(-1.4426950408889634f * x)); }
struct EpiProj {
    static constexpr bool PERM = true, AFTER_DRAIN = false, MID = false;
    bf16_t* O; const float* rope; float osc; int pn0;
    __device__ __forceinline__ void operator()(const f32x4 (&acc)[2][2][4][2], const Unit& u, int wr, int wc, int fr_, int fq_) const {
        int fr = fr_, fq = fq_; asm volatile("" : "+v"(fr), "+v"(fq));
        const int pn = u.pn + pn0;
        const int row0 = u.pm * BM + wr * 64 + fr, col0 = pn * BM + wc * 32 + 8 * fq;
        const float sc = ((pn < 2 || pn == 6 || pn == 7) ? QSCALE : 1.f) * osc;
        const bool dorope = (pn < 4) && ((wc & 1) == 0);
#pragma unroll
        for (int ai = 0; ai < 2; ++ai)
#pragma unroll
            for (int m = 0; m < 4; ++m) { const int row = row0 + ai * HALF + m * 16; bf16_t* rowp = O + (size_t)row * INW + col0;
                f32x4 c4[2] = {{1.f, 1.f, 1.f, 1.f}, {1.f, 1.f, 1.f, 1.f}}, s4[2] = {{0.f, 0.f, 0.f, 0.f}, {0.f, 0.f, 0.f, 0.f}};
                if (dorope) { const float* rp = rope + (size_t)(row & (SEQ - 1)) * 16; c4[0] = *(const f32x4*)(rp); c4[1] = *(const f32x4*)(rp + 4); s4[0] = *(const f32x4*)(rp + 8); s4[1] = *(const f32x4*)(rp + 12); }
#pragma unroll
                for (int bj = 0; bj < 2; ++bj) { f32x4 v0 = acc[ai][bj][m][0], v1 = acc[ai][bj][m][1];
                    if (dorope) { f32x4 o0, o1;
#pragma unroll
                        for (int j = 0; j < 4; ++j) { o0[j] = __shfl_xor(v0[j], 16); o1[j] = __shfl_xor(v1[j], 16); }
                        if (fq == 0) { v0 = v0 * c4[0] - o0 * s4[0]; v1 = v1 * c4[1] - o1 * s4[1]; }
                        else if (fq == 1) { v0 = v0 * c4[0] + o0 * s4[0]; v1 = v1 * c4[1] + o1 * s4[1]; } }
                    v0 = v0 * sc; v1 = v1 * sc; u32x4 w; w.x = cvt_pk_bf16(v0[0], v0[1]); w.y = cvt_pk_bf16(v0[2], v0[3]); w.z = cvt_pk_bf16(v1[0], v1[1]); w.w = cvt_pk_bf16(v1[2], v1[3]);
                    *(u32x4*)(rowp + bj * HALF) = w; } }
    }
};
struct EpiGate2 {
    static constexpr bool PERM = true, AFTER_DRAIN = false, MID = true;
    const bf16_t* proj; bf16_t* O;
    __device__ __forceinline__ void mid(f32x4 (&acc)[2][2][4][2], const Unit& u, int wr, int wc, int fr, int fq) const {
        int row0 = u.pm * BM + wr * 64 + fr, col0 = u.pn * BM + wc * 32 + 8 * fq;
        asm volatile("" : "+v"(row0), "+v"(col0));
#pragma unroll
        for (int ai = 0; ai < 2; ++ai) {
            u32x4 gav[4][2], gbv[4][2];
#pragma unroll
            for (int m = 0; m < 4; ++m)
#pragma unroll
                for (int bj = 0; bj < 2; ++bj) { const bf16_t* gp = proj + (size_t)(row0 + ai * HALF + m * 16) * INW + col0 + bj * HALF; gav[m][bj] = *(const u32x4*)(gp + C_GA); gbv[m][bj] = *(const u32x4*)(gp + C_GB); }
#pragma unroll
            for (int m = 0; m < 4; ++m) {
#pragma unroll
                for (int bj = 0; bj < 2; ++bj) { const u32x4 ga = gav[m][bj], gb = gbv[m][bj];
                    const unsigned a_[4] = {ga.x, ga.y, ga.z, ga.w}, b_[4] = {gb.x, gb.y, gb.z, gb.w};
#pragma unroll
                    for (int q = 0; q < 4; ++q) {
                        const float r0 = (1.f + __builtin_amdgcn_exp2f(-1.4426950408889634f * bflo(b_[q]))) * __builtin_amdgcn_rcpf(1.f + __builtin_amdgcn_exp2f(-1.4426950408889634f * bflo(a_[q])));
                        const float r1 = (1.f + __builtin_amdgcn_exp2f(-1.4426950408889634f * bfhi(b_[q]))) * __builtin_amdgcn_rcpf(1.f + __builtin_amdgcn_exp2f(-1.4426950408889634f * bfhi(a_[q])));
                        acc[ai][bj][m][q >> 1][(q & 1) * 2] *= r0; acc[ai][bj][m][q >> 1][(q & 1) * 2 + 1] *= r1; } } }
            asm volatile("" ::: "memory"); }
    }
    __device__ __forceinline__ void operator()(const f32x4 (&acc)[2][2][4][2], const Unit& u, int wr, int wc, int fr_, int fq_) const {
        int fr = fr_, fq = fq_; asm volatile("" : "+v"(fr), "+v"(fq));
        const int row0 = u.pm * BM + wr * 64 + fr, col0 = u.pn * BM + wc * 32 + 8 * fq;
#pragma unroll
        for (int ai = 0; ai < 2; ++ai) {
            u32x4 gv[4][2];
#pragma unroll
            for (int m = 0; m < 4; ++m)
#pragma unroll
                for (int bj = 0; bj < 2; ++bj) gv[m][bj] = *(const u32x4*)(proj + (size_t)(row0 + ai * HALF + m * 16) * INW + C_GB + col0 + bj * HALF);
#pragma unroll
            for (int m = 0; m < 4; ++m) { const int row = row0 + ai * HALF + m * 16;
#pragma unroll
                for (int bj = 0; bj < 2; ++bj) { const int col = col0 + bj * HALF; const u32x4 g = gv[m][bj];
                    f32x4 v0 = acc[ai][bj][m][0], v1 = acc[ai][bj][m][1];
                    v0[0] *= sigm(bflo(g.x)); v0[1] *= sigm(bfhi(g.x)); v0[2] *= sigm(bflo(g.y)); v0[3] *= sigm(bfhi(g.y));
                    v1[0] *= sigm(bflo(g.z)); v1[1] *= sigm(bfhi(g.z)); v1[2] *= sigm(bflo(g.w)); v1[3] *= sigm(bfhi(g.w));
                    u32x4 w; w.x = cvt_pk_bf16(v0[0], v0[1]); w.y = cvt_pk_bf16(v0[2], v0[3]); w.z = cvt_pk_bf16(v1[0], v1[1]); w.w = cvt_pk_bf16(v1[2], v1[3]);
                    *(u32x4*)(O + (size_t)row * D + col) = w; } }
            asm volatile("" ::: "memory"); }
    }
};
struct EpiHout {
    static constexpr bool PERM = true, AFTER_DRAIN = false, MID = false;
    const float* x; float* H; bf16_t* HB; float* ssq16;
    __device__ __forceinline__ void operator()(const f32x4 (&acc)[2][2][4][2], const Unit& u, int wr, int wc, int fr_, int fq_) const {
        int fr = fr_, fq = fq_; asm volatile("" : "+v"(fr), "+v"(fq));
        const int row0 = u.pm * BM + wr * 64 + fr, col0 = u.pn * BM + wc * 32 + 8 * fq;
#pragma unroll
        for (int ai = 0; ai < 2; ++ai) {
            f32x4 xv[4][2][2];
#pragma unroll
            for (int m = 0; m < 4; ++m)
#pragma unroll
                for (int bj = 0; bj < 2; ++bj) { const float* xp = x + (size_t)(row0 + ai * HALF + m * 16) * D + col0 + bj * HALF; xv[m][bj][0] = *(const f32x4*)xp; xv[m][bj][1] = *(const f32x4*)(xp + 4); }
#pragma unroll
            for (int m = 0; m < 4; ++m) { const int row = row0 + ai * HALF + m * 16; float ss = 0.f;
#pragma unroll
                for (int bj = 0; bj < 2; ++bj) { const int col = col0 + bj * HALF;
                    const f32x4 v0 = acc[ai][bj][m][0] + xv[m][bj][0], v1 = acc[ai][bj][m][1] + xv[m][bj][1];
                    u32x4 w; w.x = cvt_pk_bf16(v0[0], v0[1]); w.y = cvt_pk_bf16(v0[2], v0[3]); w.z = cvt_pk_bf16(v1[0], v1[1]); w.w = cvt_pk_bf16(v1[2], v1[3]);
                    *(u32x4*)(HB + (size_t)row * D + col) = w;
                    ss += (v0[0] * v0[0] + v0[1] * v0[1]) + (v0[2] * v0[2] + v0[3] * v0[3]) + (v1[0] * v1[0] + v1[1] * v1[1]) + (v1[2] * v1[2] + v1[3] * v1[3]); }
                ss += __shfl_xor(ss, 16); ss += __shfl_xor(ss, 32);
                if (fq == 0) ssq16[(size_t)row * 16 + u.pn * 4 + wc] = ss; }
            asm volatile("" ::: "memory"); }
    }
};
struct EpiQ {
    static constexpr bool PERM = true, AFTER_DRAIN = false, MID = false;
    const float* ssq16; bf16_t* O;
    __device__ __forceinline__ void operator()(const f32x4 (&acc)[2][2][4][2], const Unit& u, int wr, int wc, int fr, int fq) const {
        const int row0 = u.pm * BM + wr * 64 + fr, col0 = u.pn * BM + wc * 32 + 8 * fq;
#pragma unroll
        for (int ai = 0; ai < 2; ++ai)
#pragma unroll
            for (int m = 0; m < 4; ++m) { const int row = row0 + ai * HALF + m * 16; const f32x4* sp = (const f32x4*)(ssq16 + (size_t)row * 16);
                const f32x4 a = sp[0], b = sp[1], c = sp[2], d = sp[3];
                const float tot = ((a[0] + a[1]) + (a[2] + a[3])) + ((b[0] + b[1]) + (b[2] + b[3])) + ((c[0] + c[1]) + (c[2] + c[3])) + ((d[0] + d[1]) + (d[2] + d[3]));
                const float rstd = 1.f / sqrtf(tot * (1.f / D) + EPS);
#pragma unroll
                for (int bj = 0; bj < 2; ++bj) { const f32x4 v0 = acc[ai][bj][m][0] * rstd, v1 = acc[ai][bj][m][1] * rstd;
                    u32x4 w; w.x = cvt_pk_bf16(v0[0], v0[1]); w.y = cvt_pk_bf16(v0[2], v0[3]); w.z = cvt_pk_bf16(v1[0], v1[1]); w.w = cvt_pk_bf16(v1[2], v1[3]);
                    *(u32x4*)(O + (size_t)row * PQ + col0 + bj * HALF) = w; } }
    }
};
template <class Epi, class Sched, bool ALIGN_EPI = false, bool SP2 = false, bool FP8 = false>
__device__ __forceinline__ void gemm_phase(PG8_LAS unsigned char* lds, const Gemm g, const Sched& S, const Epi& E) {
    int tid_l = threadIdx.x; asm volatile("" : "+v"(tid_l));
    const int tid = tid_l, wid = __builtin_amdgcn_readfirstlane(tid >> 6), lane = tid & 63, wr = wid >> 2, wc = wid & 3, fr = lane & 15, fq = lane >> 4;
    const int K = g.K, nt = K / BK;
    unsigned voffA[2], voffB[2];
#pragma unroll
    for (int i = 0; i < 2; ++i) { int R, C; stage_rc(tid * 16 + i * 8192, R, C); const int Rb = Epi::PERM ? ((R & ~31) + perm32(R & 31)) : R;
        voffA[i] = (unsigned)(R * K + C) * 2u; voffB[i] = (unsigned)(Rb * K + C) * 2u; }
    const size_t kstep = (size_t)(BK * 2);
    const size_t hstep = (size_t)HALF * K * 2;
    const size_t tstep = 2 * hstep;
    const unsigned ldsw = (unsigned)wid * 1024u;
    const int aoff = lds_byte(wr * 64 + fr, fq * 8), boff = lds_byte(wc * 32 + fr, fq * 8);
    const int aoffF0 = FP8 ? lds_byte(wr * 64 + fr, fq * 16) : 0, boffF0 = FP8 ? lds_byte(wc * 32 + fr, fq * 16) : 0;
#define PG8_SA(b, h) (((b) * 2 + (h)) * HTB)
#define PG8_SB(b, h) ((4 + (b) * 2 + (h)) * HTB)
#define PG8_STAGE(bufoff, gbase, voff) do { _Pragma("unroll") for (int _i = 0; _i < 2; ++_i) \
        __builtin_amdgcn_global_load_lds((const unsigned*)((const char*)(gbase) + (voff)[_i]), (PG8_LAS unsigned*)(lds + (bufoff) + ldsw + _i * 8192), 16, 0, 0); } while (0)
#define PG8_LDA(dst, b, h) do { if constexpr (FP8) { _Pragma("unroll") for (int m = 0; m < 4; ++m) { const u32x4 l_ = *(const PG8_LAS u32x4*)(lds + PG8_SA(b, h) + aoffF0 + m * 2048), h_ = *(const PG8_LAS u32x4*)(lds + PG8_SA(b, h) + aoffF0 + m * 2048 + 16); \
            dst##8[m] = (v8i_t){(int)l_.x, (int)l_.y, (int)l_.z, (int)l_.w, (int)h_.x, (int)h_.y, (int)h_.z, (int)h_.w}; } } \
        else { _Pragma("unroll") for (int m = 0; m < 4; ++m) _Pragma("unroll") for (int k = 0; k < 2; ++k) dst[m][k] = *(const PG8_LAS bf16x8*)(lds + PG8_SA(b, h) + aoff + m * 2048 + k * 1024); } } while (0)
#define PG8_LDB(dst, b, h) do { if constexpr (FP8) { _Pragma("unroll") for (int n = 0; n < 2; ++n) { const u32x4 l_ = *(const PG8_LAS u32x4*)(lds + PG8_SB(b, h) + boffF0 + n * 2048), h_ = *(const PG8_LAS u32x4*)(lds + PG8_SB(b, h) + boffF0 + n * 2048 + 16); \
            dst##8[n] = (v8i_t){(int)l_.x, (int)l_.y, (int)l_.z, (int)l_.w, (int)h_.x, (int)h_.y, (int)h_.z, (int)h_.w}; } } \
        else { _Pragma("unroll") for (int n = 0; n < 2; ++n) _Pragma("unroll") for (int k = 0; k < 2; ++k) dst[n][k] = *(const PG8_LAS bf16x8*)(lds + PG8_SB(b, h) + boff + n * 2048 + k * 1024); } } while (0)
#define PG8_MMA(ai, bj, At, Bt) do { __builtin_amdgcn_s_setprio(1); \
        if constexpr (FP8) { _Pragma("unroll") for (int m = 0; m < 4; ++m) _Pragma("unroll") for (int n = 0; n < 2; ++n) \
            asm volatile("v_mfma_scale_f32_16x16x128_f8f6f4 %0, %1, %2, %0, %3, %3 op_sel_hi:[0,0,0]" : "+v"(acc[ai][bj][m][n]) : "v"(Bt##8[n]), "v"(At##8[m]), "v"(mxone)); } \
        else { _Pragma("unroll") for (int m = 0; m < 4; ++m) _Pragma("unroll") for (int n = 0; n < 2; ++n) _Pragma("unroll") for (int k = 0; k < 2; ++k) \
            acc[ai][bj][m][n] = __builtin_amdgcn_mfma_f32_16x16x32_bf16(Bt[n][k], At[m][k], acc[ai][bj][m][n], 0, 0, 0); } \
        __builtin_amdgcn_s_setprio(0); } while (0)
#define PG8_WAIT_V(n) asm volatile("s_waitcnt vmcnt(" #n ")" ::: "memory")
#define PG8_WAIT_L(n) asm volatile("s_waitcnt lgkmcnt(" #n ")" ::: "memory")
#define PG8_BAR __builtin_amdgcn_s_barrier()
#define PG8_SCHED __builtin_amdgcn_sched_barrier(0)
    Unit cur, nxt; int ui = 0;
    if (!S.next(0, cur)) return;
    f32x4 acc[2][2][4][2];
#pragma unroll
    for (int a = 0; a < 2; ++a)
#pragma unroll
        for (int b = 0; b < 2; ++b)
#pragma unroll
            for (int m = 0; m < 4; ++m)
#pragma unroll
                for (int n = 0; n < 2; ++n) acc[a][b][m][n] = (f32x4){0.f, 0.f, 0.f, 0.f};
    bf16x8 At[4][2], B0[2][2], B1[2][2]; v8i_t At8[4], B08[2], B18[2];
    int mxone = 0x7F7F7F7F; asm volatile("" : "+v"(mxone));
    const char* cA = (const char*)g.A + (size_t)cur.pm * tstep; const char* cB = (const char*)g.Bt + (size_t)cur.pn * tstep;
    S.a_ready(cur);
    if constexpr (SP2) {
        PG8_STAGE(PG8_SB(0, 0), cB, voffB); PG8_STAGE(PG8_SB(0, 1), cB + hstep, voffB); PG8_STAGE(PG8_SA(0, 0), cA, voffA); PG8_STAGE(PG8_SA(0, 1), cA + hstep, voffA);
        if (wr == 1) PG8_BAR;
        PG8_WAIT_V(2); PG8_BAR;
        PG8_STAGE(PG8_SB(1, 0), cB + kstep, voffB); PG8_STAGE(PG8_SA(1, 0), cA + kstep, voffA); PG8_STAGE(PG8_SB(1, 1), cB + hstep + kstep, voffB);
        PG8_WAIT_V(6); PG8_BAR;
    } else {
        PG8_STAGE(PG8_SB(0, 0), cB, voffB); PG8_STAGE(PG8_SA(0, 0), cA, voffA); PG8_STAGE(PG8_SB(0, 1), cB + hstep, voffB); PG8_STAGE(PG8_SA(0, 1), cA + hstep, voffA);
        if (wr == 1) PG8_BAR;
        PG8_WAIT_V(4); PG8_BAR;
        PG8_STAGE(PG8_SB(1, 0), cB + kstep, voffB); PG8_STAGE(PG8_SA(1, 0), cA + kstep, voffA); PG8_STAGE(PG8_SB(1, 1), cB + hstep + kstep, voffB);
        PG8_WAIT_V(6); PG8_BAR;
    }
    for (;;) {
        const bool has_next = S.next(ui + 1, nxt);
        const char* nA = has_next ? (const char*)g.A + (size_t)nxt.pm * tstep : cA; const char* nB = has_next ? (const char*)g.Bt + (size_t)nxt.pn * tstep : cB;
#pragma unroll 1
        for (int t = 0; t < nt; t += 2) {
            if constexpr (Epi::MID) { if (t == nt / 2) E.mid(acc, cur, wr, wc, fr, fq); }
            const bool last = (t == nt - 2);
            const char* a1 = cA + (size_t)(t + 1) * kstep;
            const char* a2 = last ? nA : cA + (size_t)(t + 2) * kstep; const char* b2 = last ? nB : cB + (size_t)(t + 2) * kstep;
            const char* a3 = a2 + kstep; const char* b3 = b2 + kstep;
            if (last && has_next) S.a_ready(nxt);
            if constexpr (SP2) {
            PG8_LDB(B0, 0, 0); PG8_LDB(B1, 0, 1); PG8_SCHED; PG8_LDA(At, 0, 0); PG8_STAGE(PG8_SA(1, 1), a1 + hstep, voffA);
            PG8_WAIT_V(8); PG8_WAIT_L(0); PG8_BAR; PG8_MMA(0, 0, At, B0); PG8_MMA(0, 1, At, B1); PG8_BAR; PG8_SCHED;
            PG8_LDA(At, 0, 1); PG8_STAGE(PG8_SB(0, 0), b2, voffB); PG8_STAGE(PG8_SB(0, 1), b2 + hstep, voffB); PG8_STAGE(PG8_SA(0, 0), a2, voffA);
            PG8_WAIT_V(8); PG8_WAIT_L(0); PG8_BAR; PG8_MMA(1, 0, At, B0); PG8_MMA(1, 1, At, B1); PG8_BAR; PG8_SCHED;
            PG8_LDB(B0, 1, 0); PG8_LDB(B1, 1, 1); PG8_SCHED; PG8_LDA(At, 1, 0); PG8_STAGE(PG8_SA(0, 1), a2 + hstep, voffA);
            PG8_WAIT_V(8); PG8_WAIT_L(0); PG8_BAR; PG8_MMA(0, 0, At, B0); PG8_MMA(0, 1, At, B1); PG8_BAR; PG8_SCHED;
            PG8_LDA(At, 1, 1); PG8_STAGE(PG8_SB(1, 0), b3, voffB); PG8_STAGE(PG8_SB(1, 1), b3 + hstep, voffB); PG8_STAGE(PG8_SA(1, 0), a3, voffA);
            PG8_WAIT_V(8); PG8_WAIT_L(0); PG8_BAR; PG8_MMA(1, 0, At, B0); PG8_MMA(1, 1, At, B1); PG8_BAR; PG8_SCHED;
            } else {
            PG8_LDB(B0, 0, 0); PG8_SCHED; PG8_LDA(At, 0, 0); PG8_STAGE(PG8_SA(1, 1), a1 + hstep, voffA);
            PG8_WAIT_L(8); PG8_BAR; PG8_WAIT_L(0); PG8_MMA(0, 0, At, B0); PG8_BAR; PG8_SCHED;
            PG8_LDB(B1, 0, 1); PG8_STAGE(PG8_SB(0, 0), b2, voffB);
            PG8_BAR; PG8_WAIT_L(0); PG8_MMA(0, 1, At, B1); PG8_BAR;
            PG8_LDA(At, 0, 1); PG8_STAGE(PG8_SA(0, 0), a2, voffA);
            PG8_BAR; PG8_WAIT_L(0); PG8_MMA(1, 0, At, B0); PG8_BAR; PG8_SCHED;
            PG8_STAGE(PG8_SB(0, 1), b2 + hstep, voffB);
            PG8_WAIT_V(6); PG8_BAR; PG8_MMA(1, 1, At, B1); PG8_BAR;
            PG8_LDB(B0, 1, 0); PG8_SCHED; PG8_LDA(At, 1, 0); PG8_STAGE(PG8_SA(0, 1), a2 + hstep, voffA);
            PG8_WAIT_L(8); PG8_BAR; PG8_WAIT_L(0); PG8_MMA(0, 0, At, B0); PG8_BAR; PG8_SCHED;
            PG8_LDB(B1, 1, 1); PG8_STAGE(PG8_SB(1, 0), b3, voffB);
            PG8_BAR; PG8_WAIT_L(0); PG8_MMA(0, 1, At, B1); PG8_BAR;
            PG8_LDA(At, 1, 1); PG8_STAGE(PG8_SA(1, 0), a3, voffA);
            PG8_BAR; PG8_WAIT_L(0); PG8_MMA(1, 0, At, B0); PG8_BAR; PG8_SCHED;
            PG8_STAGE(PG8_SB(1, 1), b3 + hstep, voffB);
            PG8_WAIT_V(6); PG8_BAR; PG8_MMA(1, 1, At, B1); PG8_BAR;
            }
        }
        if constexpr (ALIGN_EPI) { if (wr == 0) PG8_BAR; }
        if constexpr (FP8) { asm volatile("s_nop 15\n\ts_nop 7" ::: "memory"); PG8_SCHED; }
        if constexpr (!Epi::AFTER_DRAIN) { E(acc, cur, wr, wc, fr, fq); S.done(cur); }
        if (!has_next) break;
#pragma unroll
        for (int a = 0; a < 2; ++a)
#pragma unroll
            for (int b = 0; b < 2; ++b)
#pragma unroll
                for (int m = 0; m < 4; ++m)
#pragma unroll
                    for (int n = 0; n < 2; ++n) acc[a][b][m][n] = (f32x4){0.f, 0.f, 0.f, 0.f};
        cur = nxt; cA = nA; cB = nB; ++ui;
        if constexpr (ALIGN_EPI) { if (wr == 1) PG8_BAR; }
    }
    PG8_WAIT_V(0);
    if constexpr (!ALIGN_EPI) { if (wr == 0) PG8_BAR; }
    PG8_BAR;
    if constexpr (Epi::AFTER_DRAIN) { E.fused(acc, cur, wr, wc, fr, fq, lds, wid, lane); S.done(cur); }
#undef PG8_SA
#undef PG8_SB
#undef PG8_STAGE
#undef PG8_LDA
#undef PG8_LDB
#undef PG8_MMA
#undef PG8_WAIT_V
#undef PG8_WAIT_L
#undef PG8_BAR
#undef PG8_SCHED
}
}

__device__ __forceinline__ float lambda_full(const Ptrs& P) {
    float a = 0.f, b = 0.f;
    for (int i = 0; i < 64; ++i) { a += P.lq1[i] * P.lk1[i]; b += P.lq2[i] * P.lk2[i]; }
    return __expf(a) - __expf(b) + 0.2f;
}

namespace att {
typedef short bf16x8 __attribute__((ext_vector_type(8)));
typedef short s16x4 __attribute__((ext_vector_type(4)));
typedef float f32x16 __attribute__((ext_vector_type(16)));
typedef float f32x2_t __attribute__((ext_vector_type(2)));
typedef __attribute__((address_space(3))) const char* lds_cptr;
typedef __attribute__((address_space(3))) char* lds_ptr;
__device__ __forceinline__ int crow(int r, int hi) { return (r & 3) + 8 * (r >> 2) + 4 * hi; }
__device__ __forceinline__ void glds16(const void* gsrc, unsigned lds_dst) { unsigned keep;
    asm volatile("s_mov_b32 %0, m0\n\ts_mov_b32 m0, %2\n\ts_nop 0\n\tglobal_load_lds_dwordx4 %1, off\n\ts_mov_b32 m0, %0" : "=&s"(keep) : "v"(gsrc), "s"(lds_dst) : "memory"); }
__device__ __forceinline__ unsigned cvtpk(float lo, float hi) { f32x2_t v = {lo, hi}; bf16x2_t b = __builtin_convertvector(v, bf16x2_t); return __builtin_bit_cast(unsigned, b); }
#define ATT_WAIT_BAR(N) asm volatile("s_waitcnt vmcnt(" #N ") lgkmcnt(0)\n\ts_barrier" ::: "memory")
#define ATT_LDSWAIT() asm volatile("s_waitcnt lgkmcnt(0)" ::: "memory")
#define ATT_SBAR() __builtin_amdgcn_sched_barrier(0)
template <bool REL> __device__ __forceinline__ void qkt(f32x16& p0, f32x16& p1, lds_cptr Kslot, const bf16x8* qr, const f32x16& negm, int r32, int hi) {
    lds_cptr kb = Kslot + hi * 1024 + r32 * 16;
#pragma unroll
    for (int d0 = 0; d0 < 4; ++d0) {
        const bf16x8 b0 = *(const __attribute__((address_space(3))) bf16x8*)(kb + d0 * 2048);
        const bf16x8 b1 = *(const __attribute__((address_space(3))) bf16x8*)(kb + d0 * 2048 + 512);
        if (d0 == 0) { if (REL) { p0 = __builtin_amdgcn_mfma_f32_32x32x16_bf16(b0, qr[0], negm, 0, 0, 0); p1 = __builtin_amdgcn_mfma_f32_32x32x16_bf16(b1, qr[0], negm, 0, 0, 0); }
                       else { p0 = __builtin_amdgcn_mfma_f32_32x32x16_bf16(b0, qr[0], f32x16{}, 0, 0, 0); p1 = __builtin_amdgcn_mfma_f32_32x32x16_bf16(b1, qr[0], f32x16{}, 0, 0, 0); } }
        else { p0 = __builtin_amdgcn_mfma_f32_32x32x16_bf16(b0, qr[d0], p0, 0, 0, 0); p1 = __builtin_amdgcn_mfma_f32_32x32x16_bf16(b1, qr[d0], p1, 0, 0, 0); } }
}
__device__ __forceinline__ float rowmax32(const f32x16& p0, const f32x16& p1) {
    float a = fmaxf(p0[0], p1[0]);
#pragma unroll
    for (int r = 1; r < 16; ++r) a = fmaxf(a, fmaxf(p0[r], p1[r]));
    auto rr = __builtin_amdgcn_permlane32_swap(__float_as_uint(a), __float_as_uint(a), false, false);
    return fmaxf(__uint_as_float(rr[0]), __uint_as_float(rr[1]));
}
__device__ __forceinline__ float halfsum(float a) { auto rr = __builtin_amdgcn_permlane32_swap(__float_as_uint(a), __float_as_uint(a), false, false); return __uint_as_float(rr[0]) + __uint_as_float(rr[1]); }
#define ATT_VREAD(lo, hi, d0) do { _Pragma("unroll") for (int ks = 0; ks < 4; ++ks) { \
        asm volatile("ds_read_b64_tr_b16 %0,%1 offset:%c2" : "=&v"(lo[ks]) : "v"(vb), "i"((d0) * 4096 + ks * 1024) : "memory"); \
        asm volatile("ds_read_b64_tr_b16 %0,%1 offset:%c2" : "=&v"(hi[ks]) : "v"(vb), "i"((d0) * 4096 + ks * 1024 + 512) : "memory"); } } while (0)
#define ATT_PK(lo, hi, k) (bf16x8){lo[k][0], lo[k][1], lo[k][2], lo[k][3], hi[k][0], hi[k][1], hi[k][2], hi[k][3]}
#define ATT_PVMMA(lo, hi, d0) do { \
        o[d0] = __builtin_amdgcn_mfma_f32_32x32x16_bf16(pa0, ATT_PK(lo, hi, 0), o[d0], 0, 0, 0); o[d0] = __builtin_amdgcn_mfma_f32_32x32x16_bf16(pa1, ATT_PK(lo, hi, 1), o[d0], 0, 0, 0); \
        o[d0] = __builtin_amdgcn_mfma_f32_32x32x16_bf16(pa2, ATT_PK(lo, hi, 2), o[d0], 0, 0, 0); o[d0] = __builtin_amdgcn_mfma_f32_32x32x16_bf16(pa3, ATT_PK(lo, hi, 3), o[d0], 0, 0, 0); } while (0)
template <int ND0> __device__ __forceinline__ void pv(f32x16* o, int vb, bf16x8 pa0, bf16x8 pa1, bf16x8 pa2, bf16x8 pa3) {
    s16x4 loA[4], hiA[4], loB[4], hiB[4];
    ATT_VREAD(loA, hiA, 0);
#pragma unroll
    for (int d0 = 0; d0 < ND0; d0 += 2) {
        if (d0 + 1 < ND0) { ATT_VREAD(loB, hiB, d0 + 1); asm volatile("s_waitcnt lgkmcnt(8)" ::: "memory"); } else { asm volatile("s_waitcnt lgkmcnt(0)" ::: "memory"); }
        ATT_SBAR();
        ATT_PVMMA(loA, hiA, d0);
        if (d0 + 1 < ND0) {
            if (d0 + 2 < ND0) { ATT_VREAD(loA, hiA, d0 + 2); asm volatile("s_waitcnt lgkmcnt(8)" ::: "memory"); } else { asm volatile("s_waitcnt lgkmcnt(0)" ::: "memory"); }
            ATT_SBAR();
            ATT_PVMMA(loB, hiB, d0 + 1);
        }
    }
}
#undef ATT_VREAD
#undef ATT_PVMMA
#undef ATT_PK
template <int DEAD> __device__ __forceinline__ constexpr bool live0(int r) { return DEAD != 2 || r >= 12; }
template <int DEAD> __device__ __forceinline__ constexpr bool live1(int r) { return DEAD != 1 || r < 4; }
template <int ND0, int THR, bool REL, int DEAD = 0> __device__ __forceinline__ void softmax_tile(f32x16& p0, f32x16& p1, float& mrun, float& lsum, f32x16& negm, bool first, f32x16* o, __attribute__((address_space(3))) float* wsf, int r32, int hi,
                                                                   u32x4& pw0, u32x4& pw1, u32x4& pw2, u32x4& pw3) {
    float rm;
    if (DEAD == 0) rm = rowmax32(p0, p1);
    else { float a = -3e38f;
#pragma unroll
        for (int r = 0; r < 16; ++r) { if (live0<DEAD>(r)) a = fmaxf(a, p0[r]); if (live1<DEAD>(r)) a = fmaxf(a, p1[r]); }
        auto rr = __builtin_amdgcn_permlane32_swap(__float_as_uint(a), __float_as_uint(a), false, false); rm = fmaxf(__uint_as_float(rr[0]), __uint_as_float(rr[1])); }
    if (!REL) rm -= mrun;
    if (first) {
        mrun = REL ? rm : mrun + rm;
        if (REL) {
#pragma unroll
            for (int r = 0; r < 16; ++r) { if (live0<DEAD>(r)) p0[r] -= rm; if (live1<DEAD>(r)) p1[r] -= rm; negm[r] = -mrun; } }
    } else if (__any(rm > (float)THR)) {
        const float dl = fmaxf(rm, 0.f), alpha = __builtin_amdgcn_exp2f(-dl); lsum *= alpha; mrun += dl;
        if (REL) {
#pragma unroll
            for (int r = 0; r < 16; ++r) { if (live0<DEAD>(r)) p0[r] -= dl; if (live1<DEAD>(r)) p1[r] -= dl; negm[r] = -mrun; } }
        if (hi == 0) wsf[r32] = alpha;
        ATT_LDSWAIT();
#pragma unroll
        for (int g = 0; g < 4; ++g) { const f32x4 a4 = *(const __attribute__((address_space(3))) f32x4*)(wsf + 8 * g + 4 * hi);
#pragma unroll
            for (int d0 = 0; d0 < ND0; ++d0) { o[d0][4 * g + 0] *= a4[0]; o[d0][4 * g + 1] *= a4[1]; o[d0][4 * g + 2] *= a4[2]; o[d0][4 * g + 3] *= a4[3]; } }
        ATT_LDSWAIT();
    }
    float s = 0.f;
#pragma unroll
    for (int r = 0; r < 16; ++r) {
        if (live0<DEAD>(r)) { p0[r] = __builtin_amdgcn_exp2f(REL ? p0[r] : p0[r] - mrun); s += p0[r]; } else p0[r] = 0.f;
        if (live1<DEAD>(r)) { p1[r] = __builtin_amdgcn_exp2f(REL ? p1[r] : p1[r] - mrun); s += p1[r]; } else p1[r] = 0.f; }
    lsum += s;
    pw0 = (u32x4){cvtpk(p0[0], p0[1]), cvtpk(p0[2], p0[3]), cvtpk(p0[4], p0[5]), cvtpk(p0[6], p0[7])};
    pw1 = (u32x4){cvtpk(p0[8], p0[9]), cvtpk(p0[10], p0[11]), cvtpk(p0[12], p0[13]), cvtpk(p0[14], p0[15])};
    pw2 = (u32x4){cvtpk(p1[0], p1[1]), cvtpk(p1[2], p1[3]), cvtpk(p1[4], p1[5]), cvtpk(p1[6], p1[7])};
    pw3 = (u32x4){cvtpk(p1[8], p1[9]), cvtpk(p1[10], p1[11]), cvtpk(p1[12], p1[13]), cvtpk(p1[14], p1[15])};
}

constexpr int A_SLOTK = 8192, A_SLOTV = 16384, A_NS = 3, A_NSV = 4;
constexpr int A_LDS_K = 0, A_LDS_V = A_NS * A_SLOTK, A_LDS_WS = A_LDS_V + A_NSV * A_SLOTV, A_LDS_ST = A_LDS_WS + 8 * 256, A_LDS_BYTES = A_LDS_ST + 8 * 8192;
__device__ __forceinline__ void attn_a_unit(int b, int h, int qb, const bf16_t* proj, bf16_t* ya, const float* subln, float lam, unsigned char* shm) {
    int tid_l = threadIdx.x; asm volatile("" : "+v"(tid_l));
    const int tid = tid_l, lane = tid & 63, r32 = lane & 31, hi = lane >> 5; const int wid = __builtin_amdgcn_readfirstlane(tid >> 6);
    const size_t rowbase = (size_t)b * SEQ; const int q0 = qb * 256;
    constexpr int NT = SEQ / 64;
    const unsigned lds0 = (unsigned)(uintptr_t)shm;
    const lds_cptr shm3 = (lds_cptr)shm;
    __attribute__((address_space(3))) float* wsf = (__attribute__((address_space(3))) float*)((lds_ptr)shm + A_LDS_WS) + wid * 64;
    const int vb0 = (int)(lds0 + A_LDS_V) + ((lane >> 4) & 1) * 32 + (lane & 3) * 8 + (4 * hi + ((lane & 15) >> 2)) * 64;
    __attribute__((address_space(3))) bf16_t* stg = (__attribute__((address_space(3))) bf16_t*)((lds_ptr)shm + A_LDS_ST) + wid * 4096;
    for (int mp = 0; mp < 2; ++mp) {
        const bf16_t* Kh = proj + rowbase * INW + C_KA + h * 128 + mp * 64;
        const bf16_t* Vh = proj + rowbase * INW + C_VA + h * 128;
        const bf16_t* Qw = proj + (rowbase + q0 + wid * 32) * INW + C_QA + h * 128 + mp * 64;
        const int pA = 2 * wid, pB = 2 * wid + 1;
        const unsigned kdst = lds0 + A_LDS_K + wid * 1024, vdstA = lds0 + A_LDS_V + pA * 1024, vdstB = lds0 + A_LDS_V + pB * 1024;
#define A_DMA(t, slot, vsl) do { int ln_ = lane; asm volatile("" : "+v"(ln_)); \
        const bf16_t* ksrc_ = Kh + (size_t)((t) * 64 + ln_) * INW + wid * 8; \
        const bf16_t* vsrcA_ = Vh + (size_t)((t) * 64 + 16 * (pA & 3) + (ln_ >> 2)) * INW + (pA >> 2) * 32 + (ln_ & 3) * 8; \
        const bf16_t* vsrcB_ = Vh + (size_t)((t) * 64 + 16 * (pB & 3) + (ln_ >> 2)) * INW + (pB >> 2) * 32 + (ln_ & 3) * 8; \
        glds16(ksrc_, (unsigned)__builtin_amdgcn_readfirstlane(kdst + (slot) * A_SLOTK)); \
        glds16(vsrcA_, (unsigned)__builtin_amdgcn_readfirstlane(vdstA + (vsl) * A_SLOTV)); \
        glds16(vsrcB_, (unsigned)__builtin_amdgcn_readfirstlane(vdstB + (vsl) * A_SLOTV)); } while (0)
        A_DMA(0, 0, 0); A_DMA(1, 1, 1);
        bf16x8 qr[4];
#pragma unroll
        for (int d0 = 0; d0 < 4; ++d0) qr[d0] = *(const bf16x8*)(Qw + (size_t)r32 * INW + d0 * 16 + hi * 8);
        f32x16 o[4]; o[0] = f32x16{}; o[1] = f32x16{}; o[2] = f32x16{}; o[3] = f32x16{};
        float mrun = 0.f, lsum = 0.f; f32x16 negm = f32x16{};
        int slot = 0, slot2 = 2, vslot = 0, vslot2 = 2, vprev = 3;
        const bool late = wid >= 4;
        u32x4 pw0 = {}, pw1 = {}, pw2 = {}, pw3 = {};
        for (int t = 0; t < NT; ++t) {
            if (t + 1 < NT) { ATT_WAIT_BAR(3); } else { ATT_WAIT_BAR(0); }
            if (t + 2 < NT) A_DMA(t + 2, slot2, vslot2);
            if (late && t > 0) pv<4>(o, vb0 + vprev * A_SLOTV, __builtin_bit_cast(bf16x8, pw0), __builtin_bit_cast(bf16x8, pw1), __builtin_bit_cast(bf16x8, pw2), __builtin_bit_cast(bf16x8, pw3));
            f32x16 p0, p1;
            qkt<false>(p0, p1, shm3 + A_LDS_K + slot * A_SLOTK, qr, negm, r32, hi);
            softmax_tile<4, 8, false>(p0, p1, mrun, lsum, negm, t == 0, o, wsf, r32, hi, pw0, pw1, pw2, pw3);
            if (!late) pv<4>(o, vb0 + vslot * A_SLOTV, __builtin_bit_cast(bf16x8, pw0), __builtin_bit_cast(bf16x8, pw1), __builtin_bit_cast(bf16x8, pw2), __builtin_bit_cast(bf16x8, pw3));
            slot = (slot == 2) ? 0 : slot + 1; slot2 = (slot2 == 2) ? 0 : slot2 + 1;
            vprev = vslot; vslot = (vslot + 1) & 3; vslot2 = (vslot2 + 1) & 3;
        }
        if (late) pv<4>(o, vb0 + vprev * A_SLOTV, __builtin_bit_cast(bf16x8, pw0), __builtin_bit_cast(bf16x8, pw1), __builtin_bit_cast(bf16x8, pw2), __builtin_bit_cast(bf16x8, pw3));
#undef A_DMA
        const float lt = halfsum(lsum);
        if (hi == 0) wsf[32 + r32] = lt;
        ATT_LDSWAIT();
        float rli[16];
#pragma unroll
        for (int g = 0; g < 4; ++g) { const f32x4 l4 = *(const __attribute__((address_space(3))) f32x4*)(wsf + 32 + 8 * g + 4 * hi);
            rli[4 * g + 0] = __builtin_amdgcn_rcpf(l4[0]); rli[4 * g + 1] = __builtin_amdgcn_rcpf(l4[1]); rli[4 * g + 2] = __builtin_amdgcn_rcpf(l4[2]); rli[4 * g + 3] = __builtin_amdgcn_rcpf(l4[3]); }
        ATT_LDSWAIT();
        if (mp == 0) {
#pragma unroll
            for (int d0 = 0; d0 < 4; ++d0)
#pragma unroll
                for (int r = 0; r < 16; ++r) stg[crow(r, hi) * 128 + d0 * 32 + r32] = (bf16_t)f2bf(o[d0][r] * rli[r]);
            asm volatile("s_waitcnt lgkmcnt(0)\n\ts_barrier" ::: "memory");
        } else {
            float ss[16];
#pragma unroll
            for (int r = 0; r < 16; ++r) ss[r] = 0.f;
#pragma unroll
            for (int d0 = 0; d0 < 4; ++d0)
#pragma unroll
                for (int r = 0; r < 16; ++r) { const float a = bf2f(stg[crow(r, hi) * 128 + d0 * 32 + r32]); const float y = a - lam * o[d0][r] * rli[r]; o[d0][r] = y; ss[r] += y * y; }
#pragma unroll
            for (int r = 0; r < 16; ++r) { float v = ss[r]; v += __shfl_xor(v, 1); v += __shfl_xor(v, 2); v += __shfl_xor(v, 4); v += __shfl_xor(v, 8); v += __shfl_xor(v, 16);
                ss[r] = 0.8f / sqrtf(v * (1.f / 128.f) + EPS); }
            ATT_LDSWAIT();
#pragma unroll
            for (int d0 = 0; d0 < 4; ++d0) { const float gsub = subln[d0 * 32 + r32];
#pragma unroll
                for (int r = 0; r < 16; ++r) stg[crow(r, hi) * 128 + d0 * 32 + r32] = (bf16_t)f2bf(o[d0][r] * ss[r] * gsub); }
            ATT_LDSWAIT();
            bf16_t* Yw = ya + (rowbase + q0 + wid * 32) * 1024 + h * 128;
#pragma unroll
            for (int i = 0; i < 8; ++i) { const int row = i * 4 + (lane >> 4), ch = lane & 15; const u32x4 v = *(const __attribute__((address_space(3))) u32x4*)(stg + row * 128 + ch * 8); *(u32x4*)(Yw + (size_t)row * 1024 + ch * 8) = v; }
            asm volatile("s_waitcnt lgkmcnt(0)\n\ts_barrier" ::: "memory");
        }
    }
}

template <int DEAD> __device__ __forceinline__ void na_tile(lds_cptr Kslot, int vb, const bf16x8* qr, const __attribute__((address_space(3))) float* bp, const float (&fm0)[16], const float (&fm1)[16],
                                                        float& mrun, float& lsum, f32x16& negm, bool first, f32x16* o, __attribute__((address_space(3))) float* wsf, int r32, int hi) {
    f32x16 p0, p1; u32x4 pw0, pw1, pw2, pw3;
    qkt<true>(p0, p1, Kslot, qr, negm, r32, hi);
#pragma unroll
    for (int rr = 0; rr < 16; ++rr) { const int jj = (rr & 3) + 8 * (rr >> 2);
        if (live0<DEAD>(rr)) p0[rr] += bp[jj] + fm0[rr];
        if (live1<DEAD>(rr)) p1[rr] += bp[jj + 32] + fm1[rr]; }
    softmax_tile<2, 8, true, DEAD>(p0, p1, mrun, lsum, negm, first, o, wsf, r32, hi, pw0, pw1, pw2, pw3);
    pv<2>(o, vb, __builtin_bit_cast(bf16x8, pw0), __builtin_bit_cast(bf16x8, pw1), __builtin_bit_cast(bf16x8, pw2), __builtin_bit_cast(bf16x8, pw3));
}
constexpr int B_SLOT = 8192, B_NS = 6, B_PF = 5;
constexpr int B_LDS_K = 0, B_LDS_V = B_NS * B_SLOT, B_LDS_WS = 2 * B_NS * B_SLOT, B_LDS_BIAS = B_LDS_WS + 8 * 256, B_LDS_ST = B_LDS_BIAS + 2560, B_LDS_BYTES = B_LDS_ST + 8 * 4096;
__device__ __forceinline__ void attn_b_unit(int b, int h, int rg, const bf16_t* proj, bf16_t* yb, const float* rpb, unsigned char* shm) {
    int tid_l = threadIdx.x; asm volatile("" : "+v"(tid_l));
    const int tid = tid_l, lane = tid & 63, r32 = lane & 31, hi = lane >> 5; const int wid = __builtin_amdgcn_readfirstlane(tid >> 6);
    const size_t rowbase = (size_t)b * SEQ;
    const int r = 4 * rg + (wid >> 1), c0 = 32 * (wid & 1);
    int rs = r - 4; rs = rs < 0 ? 0 : (rs > 24 ? 24 : rs);
    int rmin = 4 * rg - 4; rmin = rmin < 0 ? 0 : (rmin > 24 ? 24 : rmin);
    int rmaxs = 4 * rg + 3 - 4; rmaxs = rmaxs < 0 ? 0 : (rmaxs > 24 ? 24 : rmaxs);
    const int ntile = rmaxs + 8 - rmin;
    const unsigned lds0 = (unsigned)(uintptr_t)shm;
    const lds_cptr shm3 = (lds_cptr)shm;
    __attribute__((address_space(3))) float* wsf = (__attribute__((address_space(3))) float*)((lds_ptr)shm + B_LDS_WS) + wid * 64;
    __attribute__((address_space(3))) float* bias = (__attribute__((address_space(3))) float*)((lds_ptr)shm + B_LDS_BIAS) + 64;
    __attribute__((address_space(3))) bf16_t* stg = (__attribute__((address_space(3))) bf16_t*)((lds_ptr)shm + B_LDS_ST) + wid * 2048;
    const int vb0 = (int)(lds0 + B_LDS_V) + ((lane >> 4) & 1) * 32 + (lane & 3) * 8 + (4 * hi + ((lane & 15) >> 2)) * 64;
    for (int i = tid; i < 640; i += 512) { const int e = i - 64, ri = e >> 5, cj = e & 31; bias[e] = (e >= 0 && e < 480 && cj < 31) ? rpb[(h * 15 + ri) * 31 + cj] * LOG2E : 0.f; }
    const bf16_t* Kh = proj + rowbase * INW + C_KB + h * 64;
    const bf16_t* Vh = proj + rowbase * INW + C_VB + h * 64;
    const bf16_t* Qw = proj + (rowbase + r * 64 + c0) * INW + C_QB + h * 64;
    const unsigned kdst = lds0 + B_LDS_K + wid * 1024, vdst = lds0 + B_LDS_V + wid * 1024;
#define B_DMA(t, slot) do { int ln_ = lane; asm volatile("" : "+v"(ln_)); \
    const bf16_t* ksrc_ = Kh + (size_t)((rmin + (t)) * 64 + ln_) * INW + wid * 8; \
    const bf16_t* vsrc_ = Vh + (size_t)((rmin + (t)) * 64 + 16 * (wid & 3) + (ln_ >> 2)) * INW + (wid >> 2) * 32 + (ln_ & 3) * 8; \
    glds16(ksrc_, (unsigned)__builtin_amdgcn_readfirstlane(kdst + (slot) * B_SLOT)); \
    glds16(vsrc_, (unsigned)__builtin_amdgcn_readfirstlane(vdst + (slot) * B_SLOT)); } while (0)
#pragma unroll
    for (int t = 0; t < B_PF; ++t) B_DMA(t, t);
    bf16x8 qr[4];
#pragma unroll
    for (int d0 = 0; d0 < 4; ++d0) qr[d0] = *(const bf16x8*)(Qw + (size_t)r32 * INW + d0 * 16 + hi * 8);
    f32x16 o[2]; o[0] = f32x16{}; o[1] = f32x16{};
    float mrun = 0.f, lsum = 0.f; f32x16 negm = f32x16{}; bool first = true;
    const int c = c0 + r32; int cs = c - 8; cs = cs < 0 ? 0 : (cs > 48 ? 48 : cs);
    float fm0[16], fm1[16];
#pragma unroll
    for (int rr = 0; rr < 16; ++rr) { const int j0 = crow(rr, hi); fm0[rr] = ((unsigned)(j0 - cs) < 16u) ? 0.f : -1e30f; fm1[rr] = ((unsigned)(j0 + 32 - cs) < 16u) ? 0.f : -1e30f; }
    int slot = 0, slotn = B_PF;
    for (int t = 0; t < ntile; ++t) {
        { const int rem = ntile - 1 - t;
          if (rem >= 4) { ATT_WAIT_BAR(8); } else if (rem == 3) { ATT_WAIT_BAR(6); } else if (rem == 2) { ATT_WAIT_BAR(4); } else if (rem == 1) { ATT_WAIT_BAR(2); } else { ATT_WAIT_BAR(0); } }
        if (t + B_PF < ntile) B_DMA(t + B_PF, slotn);
        const int kr = rmin + t;
        if (kr >= rs && kr < rs + 8) {
            const __attribute__((address_space(3))) float* bp = bias + ((kr - r + 7) * 32 + 15 - c + 4 * hi);
            if (wid & 1) na_tile<2>(shm3 + B_LDS_K + slot * B_SLOT, vb0 + slot * B_SLOT, qr, bp, fm0, fm1, mrun, lsum, negm, first, o, wsf, r32, hi);
            else         na_tile<1>(shm3 + B_LDS_K + slot * B_SLOT, vb0 + slot * B_SLOT, qr, bp, fm0, fm1, mrun, lsum, negm, first, o, wsf, r32, hi);
            first = false;
        }
        slot = (slot == B_NS - 1) ? 0 : slot + 1; slotn = (slotn == B_NS - 1) ? 0 : slotn + 1;
    }
#undef B_DMA
    const float lt = halfsum(lsum);
    if (hi == 0) wsf[32 + r32] = lt;
    ATT_LDSWAIT();
    float rli[16];
#pragma unroll
    for (int g = 0; g < 4; ++g) { const f32x4 l4 = *(const __attribute__((address_space(3))) f32x4*)(wsf + 32 + 8 * g + 4 * hi);
        rli[4 * g + 0] = __builtin_amdgcn_rcpf(l4[0]); rli[4 * g + 1] = __builtin_amdgcn_rcpf(l4[1]); rli[4 * g + 2] = __builtin_amdgcn_rcpf(l4[2]); rli[4 * g + 3] = __builtin_amdgcn_rcpf(l4[3]); }
#pragma unroll
    for (int d0 = 0; d0 < 2; ++d0)
#pragma unroll
        for (int rr = 0; rr < 16; ++rr) stg[crow(rr, hi) * 64 + d0 * 32 + r32] = (bf16_t)f2bf(o[d0][rr] * rli[rr]);
    ATT_LDSWAIT();
    bf16_t* Yw = yb + (rowbase + r * 64 + c0) * 1024 + 512 + h * 64;
#pragma unroll
    for (int i = 0; i < 4; ++i) { const int row = i * 8 + (lane >> 3), ch = lane & 7; const u32x4 v = *(const __attribute__((address_space(3))) u32x4*)(stg + row * 64 + ch * 8); *(u32x4*)(Yw + (size_t)row * 1024 + ch * 8) = v; }
    asm volatile("s_waitcnt lgkmcnt(0)\n\ts_barrier" ::: "memory");
}
}

namespace peer {
typedef short bf16x8 __attribute__((ext_vector_type(8)));
typedef float f32x16 __attribute__((ext_vector_type(16)));
typedef __attribute__((address_space(3))) const char* lds_cptr;
constexpr int T_LDS_SK = 0, T_LDS_BYTES = 65536;
__device__ __forceinline__ int imax(int a, int b) { int r; asm("v_max_f32 %0, %1, %2" : "=v"(r) : "v"(a), "v"(b)); return r; }
__device__ __forceinline__ int imin(int a, int b) { int r; asm("v_min_f32 %0, %1, %2" : "=v"(r) : "v"(a), "v"(b)); return r; }
__device__ __forceinline__ int f2key(float s, int idx) { return (__float_as_int(s) & ~127) | idx; }
__device__ __forceinline__ int key2bits(int k) { return k; }
template <int N, int OFF, int TOT> __device__ __forceinline__ void bsort_desc(int (&a)[TOT]) {
#pragma unroll
    for (int k = 2; k <= N; k <<= 1)
#pragma unroll
        for (int j = k >> 1; j > 0; j >>= 1)
#pragma unroll
            for (int i = 0; i < N; ++i) { const int l = i ^ j; if (l > i) { const bool desc = (i & k) == 0; const int hi_ = imax(a[OFF + i], a[OFF + l]), lo_ = imin(a[OFF + i], a[OFF + l]); a[OFF + i] = desc ? hi_ : lo_; a[OFF + l] = desc ? lo_ : hi_; } }
}
__device__ constexpr unsigned char NET16[126] = {0,1,2,3,0,2,1,3,1,2,4,5,6,7,4,6,5,7,5,6,0,4,2,6,2,4,1,5,3,7,3,5,1,2,3,4,5,6,8,9,10,11,8,10,9,11,9,10,12,13,14,15,12,14,13,15,13,14,8,12,10,14,10,12,9,13,11,15,11,13,9,10,11,12,13,14,0,8,4,12,4,8,2,10,6,14,6,10,2,4,6,8,10,12,1,9,5,13,5,9,3,11,7,15,7,11,3,5,7,9,11,13,1,2,3,4,5,6,7,8,9,10,11,12,13,14};
__device__ constexpr unsigned char NET32[382] = {0,1,2,3,0,2,1,3,1,2,4,5,6,7,4,6,5,7,5,6,0,4,2,6,2,4,1,5,3,7,3,5,1,2,3,4,5,6,8,9,10,11,8,10,9,11,9,10,12,13,14,15,12,14,13,15,13,14,8,12,10,14,10,12,9,13,11,15,11,13,9,10,11,12,13,14,0,8,4,12,4,8,2,10,6,14,6,10,2,4,6,8,10,12,1,9,5,13,5,9,3,11,7,15,7,11,3,5,7,9,11,13,1,2,3,4,5,6,7,8,9,10,11,12,13,14,16,17,18,19,16,18,17,19,17,18,20,21,22,23,20,22,21,23,21,22,16,20,18,22,18,20,17,21,19,23,19,21,17,18,19,20,21,22,24,25,26,27,24,26,25,27,25,26,28,29,30,31,28,30,29,31,29,30,24,28,26,30,26,28,25,29,27,31,27,29,25,26,27,28,29,30,16,24,20,28,20,24,18,26,22,30,22,26,18,20,22,24,26,28,17,25,21,29,21,25,19,27,23,31,23,27,19,21,23,25,27,29,17,18,19,20,21,22,23,24,25,26,27,28,29,30,0,16,8,24,8,16,4,20,12,28,12,20,4,8,12,16,20,24,2,18,10,26,10,18,6,22,14,30,14,22,6,10,14,18,22,26,2,4,6,8,10,12,14,16,18,20,22,24,26,28,1,17,9,25,9,17,5,21,13,29,13,21,5,9,13,17,21,25,3,19,11,27,11,19,7,23,15,31,15,23,7,11,15,19,23,27,3,5,7,9,11,13,15,17,19,21,23,25,27,29,1,2,3,4,5,6,7,8,9,10,11,12,13,14,15,16,17,18,19,20,21,22,23,24,25,26,27,28,29,30};
template <int OFF, int TOT> __device__ __forceinline__ void sort16_desc(int (&a)[TOT]) {
#pragma unroll
    for (int c = 0; c < 63; ++c) { const int i = OFF + NET16[2 * c], j = OFF + NET16[2 * c + 1]; const int hi_ = imax(a[i], a[j]), lo_ = imin(a[i], a[j]); a[i] = hi_; a[j] = lo_; }
}
template <int TOT> __device__ __forceinline__ void sort32_desc(int (&a)[TOT]) {
#pragma unroll
    for (int c = 0; c < 191; ++c) { const int i = NET32[2 * c], j = NET32[2 * c + 1]; const int hi_ = imax(a[i], a[j]), lo_ = imin(a[i], a[j]); a[i] = hi_; a[j] = lo_; }
}
template <int N, int OFF, int TOT> __device__ __forceinline__ void bmerge_desc(int (&a)[TOT]) {
#pragma unroll
    for (int j = N >> 1; j > 0; j >>= 1)
#pragma unroll
        for (int i = 0; i < N; ++i) { const int l = i ^ j; if (l > i) { const int hi_ = imax(a[OFF + i], a[OFF + l]), lo_ = imin(a[OFF + i], a[OFF + l]); a[OFF + i] = hi_; a[OFF + l] = lo_; } }
}
template <int A, int B, int TOT> __device__ __forceinline__ void merge_top16(int (&a)[TOT]) {
#pragma unroll
    for (int i = 0; i < 16; ++i) a[A + i] = imax(a[A + i], a[B + 15 - i]);
    bmerge_desc<16, A, TOT>(a);
}
__device__ __forceinline__ void cross_top16(int (&t)[16]) {
    int lo[16], hi[16];
#pragma unroll
    for (int i = 0; i < 16; ++i) { auto rr = __builtin_amdgcn_permlane32_swap((unsigned)t[i], (unsigned)t[i], false, false); lo[i] = (int)rr[0]; hi[i] = (int)rr[1]; }
#pragma unroll
    for (int i = 0; i < 16; ++i) t[i] = imax(lo[i], hi[15 - i]);
    bmerge_desc<16, 0, 16>(t);
}
struct RowStream {
    const float* pu; const float* pv; unsigned char* ws; int r, step, lane; f32x4 v0, v1, v2, v3;
    __device__ __forceinline__ void issue() {
        if (r < 2 * NEXP) { const float* src = (r < NEXP ? pu + (size_t)r * D : pv + (size_t)(r - NEXP) * D); const f32x4* s4 = (const f32x4*)src + lane * 4; v0 = s4[0]; v1 = s4[1]; v2 = s4[2]; v3 = s4[3]; } }
    __device__ __forceinline__ void finish() {
        if (r < 2 * NEXP) { const f32x4 cur[4] = {v0, v1, v2, v3};
            if (r < NEXP) cvt_row_i4(cur, ws + WS_U + (size_t)r * 256, (float*)(ws + WS_SU) + r, lane);
            else { const int e = r - NEXP; cvt_row_fp8(cur, ws + WS_V + (size_t)e * 512, (float*)(ws + WS_SV) + e, lane); }
            r += step; } }
    __device__ __forceinline__ void hook() { finish(); issue(); }
};
__device__ __forceinline__ void half_top16(int (&top)[16], const bf16_t* qrow  , lds_cptr skp  , int hi, RowStream& RS) {
    f32x16 sc[4]; sc[0] = f32x16{}; sc[1] = f32x16{}; sc[2] = f32x16{}; sc[3] = f32x16{};
    bf16x8 qf[8];
#pragma unroll
    for (int ks = 0; ks < 8; ++ks) qf[ks] = *(const bf16x8*)(qrow + ks * 16);
    RS.hook();
#pragma unroll
    for (int ks = 0; ks < 8; ++ks)
#pragma unroll
        for (int kt = 0; kt < 4; ++kt) { const bf16x8 af = *(const __attribute__((address_space(3))) bf16x8*)(skp + ks * 4096 + kt * 512);
            sc[kt] = __builtin_amdgcn_mfma_f32_32x32x16_bf16(af, qf[ks], sc[kt], 0, 0, 0); }
    int k[64];
#pragma unroll
    for (int kt = 0; kt < 4; ++kt)
#pragma unroll
        for (int r = 0; r < 16; ++r) k[kt * 16 + r] = f2key(sc[kt][r], (32 * kt + (r & 3) + 8 * (r >> 2)) | (4 * hi));
    sort16_desc<0, 64>(k); sort16_desc<16, 64>(k);
    RS.hook();
    sort16_desc<32, 64>(k); sort16_desc<48, 64>(k);
    RS.hook();
    merge_top16<0, 16, 64>(k); merge_top16<32, 48, 64>(k); merge_top16<0, 32, 64>(k);
#pragma unroll
    for (int i = 0; i < 16; ++i) top[i] = k[i];
    cross_top16(top);
}
__device__ __forceinline__ void topk_wave(int tok0, int h, const bf16_t* Q, int* IDX, float* Gt, lds_cptr sk, int lane, RowStream& RS) {
    const int r32 = lane & 31, hi = lane >> 5, tok = tok0 + r32;
    const bf16_t* qrow = Q + (size_t)tok * PQ + h * 256 + 8 * hi;
    lds_cptr skl = sk + hi * 2048 + r32 * 16;
    int A0[16], A1[16];
    half_top16(A0, qrow, skl, hi, RS);
    half_top16(A1, qrow + 128, skl + 32768, hi, RS);
    RS.hook();
    float x[16], y[16]; int xw[16], yw[16];
#pragma unroll
    for (int a = 0; a < 16; ++a) { const int b0 = key2bits(A0[a]), b1 = key2bits(A1[a]);
        const float v0 = __int_as_float(b0 & ~127), v1 = __int_as_float(b1 & ~127); const int i0 = (b0 & 127) << 7, i1 = b1 & 127;
        x[a] = hi ? v1 : v0; y[a] = hi ? v0 : v1; xw[a] = hi ? i1 : i0; yw[a] = hi ? i0 : i1; }
    int w[32]; int n = 0;
#define PEER_CAND(a, b) do { const int bits = __float_as_int(x[a] + y[b]); int ww = (bits & ~0x3FFF) | (xw[a] + yw[b]); \
        if ((a) == (b) && hi) ww = (int)0xFF800000; w[n] = ww; ++n; } while (0)
#pragma unroll
    for (int b = 0; b < 16; ++b) PEER_CAND(0, b);
#pragma unroll
    for (int b = 1; b < 8; ++b) PEER_CAND(1, b);
#pragma unroll
    for (int b = 2; b < 5; ++b) PEER_CAND(2, b);
    PEER_CAND(3, 3);
#undef PEER_CAND
#pragma unroll
    for (int i = 27; i < 32; ++i) w[i] = (int)0xFF800000;
    RS.hook();
    sort32_desc<32>(w);
    RS.hook();
    int T[16];
#pragma unroll
    for (int i = 0; i < 16; ++i) T[i] = w[i];
    cross_top16(T);
    float sv[16]; int ev[16];
#pragma unroll
    for (int j = 0; j < 16; ++j) { ev[j] = T[j] & 0x3FFF; sv[j] = __int_as_float(T[j] & ~0x3FFF); }
    const float s0 = sv[0]; float esum = 0.f;
#pragma unroll
    for (int j = 0; j < 16; ++j) { sv[j] = __expf(sv[j] - s0); esum += sv[j]; }
    const float inv = 1.f / esum;
    if (hi == 0) { u32x4* io = (u32x4*)(IDX + ((size_t)tok * 8 + h) * 16);
#pragma unroll
        for (int j = 0; j < 4; ++j) io[j] = (u32x4){(unsigned)ev[4 * j], (unsigned)ev[4 * j + 1], (unsigned)ev[4 * j + 2], (unsigned)ev[4 * j + 3]}; }
    else { f32x4* go = (f32x4*)(Gt + ((size_t)tok * 8 + h) * 16);
#pragma unroll
        for (int j = 0; j < 4; ++j) go[j] = (f32x4){sv[4 * j] * inv, sv[4 * j + 1] * inv, sv[4 * j + 2] * inv, sv[4 * j + 3] * inv}; }
}
template <class Sched> __device__ __forceinline__ void topk_own_units(const Ptrs& P, unsigned char* shm, const Sched& S) {
    int tid_l = threadIdx.x; asm volatile("" : "+v"(tid_l));
    const int tid = tid_l, lane = tid & 63; const int wid = __builtin_amdgcn_readfirstlane(tid >> 6);
    const unsigned lds0 = (unsigned)(uintptr_t)shm;
    const bf16_t* SKg = (const bf16_t*)(P.ws + WS_SK);
    int hprev = -1; pg8::Unit u;
    RowStream RS; RS.pu = P.peer_u; RS.pv = P.peer_v; RS.ws = P.ws; RS.lane = lane; RS.step = (int)gridDim.x * 8; RS.r = (int)blockIdx.x * 8 + wid; RS.v0 = RS.v1 = RS.v2 = RS.v3 = f32x4{};
    RS.issue();
    for (int i = 0; S.next(i, u); ++i) {
        const int h = u.pn, tg = u.pm;
        if (h != hprev) { hprev = h;
            asm volatile("s_waitcnt lgkmcnt(0)\n\ts_barrier" ::: "memory");
#pragma unroll
            for (int j = 0; j < 8; ++j) { const int piece = wid * 8 + j, p = piece >> 5, c = (piece >> 1) & 15, kh = piece & 1;
                att::glds16(SKg + ((size_t)((h * 2 + p) * 128 + kh * 64 + lane) * 128 + c * 8), (unsigned)__builtin_amdgcn_readfirstlane(lds0 + p * 32768 + c * 2048 + kh * 1024)); }
            asm volatile("s_waitcnt vmcnt(0)\n\ts_barrier" ::: "memory");
        }
        topk_wave(tg * 256 + wid * 32, h, (const bf16_t*)(P.ws + WS_Q), (int*)(P.ws + WS_IDX), (float*)(P.ws + WS_G), (lds_cptr)shm, lane, RS);
    }
    while (RS.r < 2 * NEXP) RS.hook();
}
}

namespace apply {
typedef float f32x2 __attribute__((ext_vector_type(2)));
typedef __attribute__((address_space(3))) unsigned* lds_u32p;
constexpr int AP_WAVE_BYTES = 4 * (512 + 2048), AP_LDS_BYTES = 8 * AP_WAVE_BYTES;
__device__ __forceinline__ float gelu_fast(float v) {
    const float av = fabsf(v), t = __builtin_amdgcn_rcpf(av * 0.2316418882f + 1.0f);
    float q = t * 0.5307027145f + (-0.7265760135f); q = q * t + 0.7107068705f; q = q * t + (-0.142248368f); q = q * t + 0.127414796f; q = q * t;
    const float e = __builtin_amdgcn_exp2f((v * v) * (-0.72134752044f));
    const float m = v * (q * e);
    return v < 0.f ? m : v - m;
}
#define AP_DPP(v, ctrl) __builtin_bit_cast(float, __builtin_amdgcn_update_dpp(0, __builtin_bit_cast(int, (v)), (ctrl), 0xF, 0xF, true))
__device__ __forceinline__ float row16_sum(float v) { v += AP_DPP(v, 0xB1); v += AP_DPP(v, 0x4E); v += AP_DPP(v, 0x141); v += AP_DPP(v, 0x140); return v; }
__device__ __forceinline__ void load_half(u32x4 (&r)[2], const unsigned char* img, unsigned e, int sub) {
    const unsigned off = e * 512u + (unsigned)(sub * 16);
    r[0] = *(const u32x4*)(img + off); r[1] = *(const u32x4*)(img + off + 256u);
}
constexpr int AP_PROBE_RING = 16;
constexpr int AP_RING = 8;
typedef __attribute__((address_space(3))) u32x4* lds_v4p;
template <int HF, int MODE, int RING> __device__ __forceinline__ void pass_u(const Ptrs& P, const bf16_t* hrow, float rstd, lds_v4p grp, u32x4 (&R)[RING][2], const unsigned char* img, const unsigned char* img_next, int sub) {
    unsigned xq[8]; float sx;
    {
        float xf[2][16]; float mx = 0.f;
#pragma unroll
        for (int i = 0; i < 2; ++i) { const int e0 = (sub + 16 * (2 * HF + i)) * 16;
#pragma unroll
            for (int q = 0; q < 4; ++q) { const u32x2 hb = *(const u32x2*)(hrow + e0 + 4 * q); const f32x4 gv = *(const f32x4*)(P.norm_ffn + e0 + 4 * q);
                xf[i][4 * q] = bflo(hb.x) * rstd * gv.x; xf[i][4 * q + 1] = bfhi(hb.x) * rstd * gv.y; xf[i][4 * q + 2] = bflo(hb.y) * rstd * gv.z; xf[i][4 * q + 3] = bfhi(hb.y) * rstd * gv.w;
                mx = fmaxf(fmaxf(mx, fmaxf(fabsf(xf[i][4 * q]), fabsf(xf[i][4 * q + 1]))), fmaxf(fabsf(xf[i][4 * q + 2]), fabsf(xf[i][4 * q + 3]))); } }
        mx = fmaxf(mx, AP_DPP(mx, 0xB1)); mx = fmaxf(mx, AP_DPP(mx, 0x4E)); mx = fmaxf(mx, AP_DPP(mx, 0x141)); mx = fmaxf(mx, AP_DPP(mx, 0x140));
        mx = fmaxf(mx, 1e-30f); sx = mx * (1.f / 127.f); const float qs = 127.f / mx;
#pragma unroll
        for (int i = 0; i < 2; ++i)
#pragma unroll
            for (int q = 0; q < 4; ++q) xq[4 * i + q] = pack_i8x4(xf[i][4 * q] * qs, xf[i][4 * q + 1] * qs, xf[i][4 * q + 2] * qs, xf[i][4 * q + 3] * qs);
    }
#pragma unroll 1
    for (int j = 0; j < 128; j += RING) {
        const int jn = (j + RING) & 127;
        __builtin_amdgcn_s_barrier();
        const unsigned char* tb = (j + RING < 128) ? img : img_next;
        unsigned nid[RING], part[RING], suv[RING], gsv[RING];
#pragma unroll
        for (int b4 = 0; b4 < RING / 4; ++b4) { const u32x4 na = grp[jn / 4 + b4];
            nid[4 * b4] = na.x; nid[4 * b4 + 1] = na.y; nid[4 * b4 + 2] = na.z; nid[4 * b4 + 3] = na.w;
            u32x4 pa = {}, sa = {}, ga = {};
            if (HF == 1) { pa = grp[96 + j / 4 + b4]; sa = grp[32 + j / 4 + b4]; ga = grp[64 + j / 4 + b4]; }
            part[4 * b4] = pa.x; part[4 * b4 + 1] = pa.y; part[4 * b4 + 2] = pa.z; part[4 * b4 + 3] = pa.w;
            suv[4 * b4] = sa.x; suv[4 * b4 + 1] = sa.y; suv[4 * b4 + 2] = sa.z; suv[4 * b4 + 3] = sa.w;
            gsv[4 * b4] = ga.x; gsv[4 * b4 + 1] = ga.y; gsv[4 * b4 + 2] = ga.z; gsv[4 * b4 + 3] = ga.w; }
        float outv[RING];
#pragma unroll
        for (int bq = 0; bq < RING; ++bq) {
            int d0_ = 0, d1_ = 0;
            if (MODE == 1) { asm volatile("" :: "v"(R[bq][0]), "v"(R[bq][1])); d0_ = (int)xq[0]; }
            else {
                d0_ = __builtin_amdgcn_sdot4((int)R[bq][0].x, (int)xq[0], d0_, false); d1_ = __builtin_amdgcn_sdot4((int)R[bq][0].y, (int)xq[1], d1_, false);
                d0_ = __builtin_amdgcn_sdot4((int)R[bq][0].z, (int)xq[2], d0_, false); d1_ = __builtin_amdgcn_sdot4((int)R[bq][0].w, (int)xq[3], d1_, false);
                d0_ = __builtin_amdgcn_sdot4((int)R[bq][1].x, (int)xq[4], d0_, false); d1_ = __builtin_amdgcn_sdot4((int)R[bq][1].y, (int)xq[5], d1_, false);
                d0_ = __builtin_amdgcn_sdot4((int)R[bq][1].z, (int)xq[6], d0_, false); d1_ = __builtin_amdgcn_sdot4((int)R[bq][1].w, (int)xq[7], d1_, false);
            }
            asm volatile("" ::: "memory");
            load_half(R[bq], tb, MODE == 2 ? (nid[bq] & 15u) : nid[bq], sub);
            asm volatile("" ::: "memory");
            float a_ = row16_sum((float)(d0_ + d1_)) * sx;
            if (HF == 1) { a_ = (a_ + __uint_as_float(part[bq])) * __uint_as_float(suv[bq]); a_ = __uint_as_float(gsv[bq]) * gelu_fast(a_); }
            outv[bq] = a_;
        }
        if (sub == 0) {
#pragma unroll
            for (int b4 = 0; b4 < RING / 4; ++b4) grp[96 + j / 4 + b4] = (u32x4){__float_as_uint(outv[4 * b4]), __float_as_uint(outv[4 * b4 + 1]), __float_as_uint(outv[4 * b4 + 2]), __float_as_uint(outv[4 * b4 + 3])}; }
    }
    asm volatile("s_waitcnt lgkmcnt(0)" ::: "memory");
}
template <int HF, int MODE, int RING> __device__ __forceinline__ void pass_v(float (&acc)[4][16], lds_v4p grp, u32x4 (&R)[RING][2], const unsigned char* img, const unsigned char* img_next, int sub) {
#pragma unroll 1
    for (int j = 0; j < 128; j += RING) {
        const int jn = (j + RING) & 127;
        __builtin_amdgcn_s_barrier();
        const unsigned char* tb = (j + RING < 128) ? img : img_next;
        unsigned nid[RING], cvv[RING];
#pragma unroll
        for (int b4 = 0; b4 < RING / 4; ++b4) { const u32x4 na = grp[jn / 4 + b4], ca = grp[96 + j / 4 + b4];
            nid[4 * b4] = na.x; nid[4 * b4 + 1] = na.y; nid[4 * b4 + 2] = na.z; nid[4 * b4 + 3] = na.w; cvv[4 * b4] = ca.x; cvv[4 * b4 + 1] = ca.y; cvv[4 * b4 + 2] = ca.z; cvv[4 * b4 + 3] = ca.w; }
#pragma unroll
        for (int bq = 0; bq < RING; ++bq) {
            const float c_ = __uint_as_float(cvv[bq]); const f32x2 c2 = {c_, c_};
            if (MODE == 1) { asm volatile("" :: "v"(R[bq][0]), "v"(R[bq][1])); acc[2 * HF][0] += c_; }
            else {
#pragma unroll
            for (int i = 0; i < 2; ++i) { const unsigned w_[4] = {R[bq][i].x, R[bq][i].y, R[bq][i].z, R[bq][i].w};
#pragma unroll
                for (int q = 0; q < 4; ++q) { const f32x2 lo_ = __builtin_amdgcn_cvt_pk_f32_fp8(w_[q], false), hi_ = __builtin_amdgcn_cvt_pk_f32_fp8(w_[q], true);
                    f32x2 a0 = {acc[2 * HF + i][4 * q], acc[2 * HF + i][4 * q + 1]}, a1 = {acc[2 * HF + i][4 * q + 2], acc[2 * HF + i][4 * q + 3]}; a0 += c2 * lo_; a1 += c2 * hi_;
                    acc[2 * HF + i][4 * q] = a0.x; acc[2 * HF + i][4 * q + 1] = a0.y; acc[2 * HF + i][4 * q + 2] = a1.x; acc[2 * HF + i][4 * q + 3] = a1.y; } }
            }
            asm volatile("" ::: "memory");
            load_half(R[bq], tb, MODE == 2 ? (nid[bq] & 15u) : nid[bq], sub);
            asm volatile("" ::: "memory");
        }
    }
}
constexpr int AP_RINGU = 16;
__device__ __forceinline__ u32x4 load_q4(const unsigned char* img, unsigned e, int sub) { return *(const u32x4*)(img + e * 256u + (unsigned)(sub * 16)); }
template <int HF, bool NEXTV> __device__ __forceinline__ void pass_u4(const Ptrs& P, const bf16_t* hrow, float rstd, lds_v4p grp, u32x4 (&R)[AP_RINGU], const unsigned char* img, const unsigned char* img_next, int sub) {
    constexpr int RING = AP_RINGU;
    unsigned xh[4], xl[4]; float sx;
    {
        float xf[2][16]; float mx = 0.f;
#pragma unroll
        for (int i = 0; i < 2; ++i) { const int e0 = (sub + 16 * (2 * HF + i)) * 16;
#pragma unroll
            for (int q = 0; q < 4; ++q) { const u32x2 hb = *(const u32x2*)(hrow + e0 + 4 * q); const f32x4 gv = *(const f32x4*)(P.norm_ffn + e0 + 4 * q);
                xf[i][4 * q] = bflo(hb.x) * rstd * gv.x; xf[i][4 * q + 1] = bfhi(hb.x) * rstd * gv.y; xf[i][4 * q + 2] = bflo(hb.y) * rstd * gv.z; xf[i][4 * q + 3] = bfhi(hb.y) * rstd * gv.w;
                mx = fmaxf(fmaxf(mx, fmaxf(fabsf(xf[i][4 * q]), fabsf(xf[i][4 * q + 1]))), fmaxf(fabsf(xf[i][4 * q + 2]), fabsf(xf[i][4 * q + 3]))); } }
        mx = fmaxf(mx, AP_DPP(mx, 0xB1)); mx = fmaxf(mx, AP_DPP(mx, 0x4E)); mx = fmaxf(mx, AP_DPP(mx, 0x141)); mx = fmaxf(mx, AP_DPP(mx, 0x140));
        mx = fmaxf(mx, 1e-30f); sx = mx * (1.f / 119.f); const float qs = 119.f / mx;
#pragma unroll
        for (int q = 0; q < 4; ++q) { unsigned h_ = 0u, l_ = 0u;
#pragma unroll
            for (int i = 0; i < 8; ++i) { const int xi = (int)rintf(xf[q >> 1][8 * (q & 1) + i] * qs); const int lo = ((xi + 8) & 15) - 8; const int hi = (xi - lo) >> 4;
                h_ |= ((unsigned)hi & 15u) << (4 * i); l_ |= ((unsigned)lo & 15u) << (4 * i); }
            xh[q] = h_; xl[q] = l_; }
    }
#pragma unroll 1
    for (int j = 0; j < 128; j += RING) {
        const int jn = (j + RING) & 127;
        __builtin_amdgcn_s_barrier();
        const bool last = !(j + RING < 128);
        const unsigned char* tb = last ? img_next : img;
        unsigned nid[RING], part[RING], suv[RING], gsv[RING];
#pragma unroll
        for (int b4 = 0; b4 < RING / 4; ++b4) { const u32x4 na = grp[jn / 4 + b4];
            nid[4 * b4] = na.x; nid[4 * b4 + 1] = na.y; nid[4 * b4 + 2] = na.z; nid[4 * b4 + 3] = na.w;
            u32x4 pa = {}, sa = {}, ga = {};
            if (HF == 1) { pa = grp[96 + j / 4 + b4]; sa = grp[32 + j / 4 + b4]; ga = grp[64 + j / 4 + b4]; }
            part[4 * b4] = pa.x; part[4 * b4 + 1] = pa.y; part[4 * b4 + 2] = pa.z; part[4 * b4 + 3] = pa.w;
            suv[4 * b4] = sa.x; suv[4 * b4 + 1] = sa.y; suv[4 * b4 + 2] = sa.z; suv[4 * b4 + 3] = sa.w;
            gsv[4 * b4] = ga.x; gsv[4 * b4 + 1] = ga.y; gsv[4 * b4 + 2] = ga.z; gsv[4 * b4 + 3] = ga.w; }
        float outv[RING];
#pragma unroll
        for (int bq = 0; bq < RING; ++bq) {
            int dh_ = __builtin_amdgcn_sdot8((int)R[bq].x, (int)xh[0], 0, false), dl_ = __builtin_amdgcn_sdot8((int)R[bq].x, (int)xl[0], 0, false);
            dh_ = __builtin_amdgcn_sdot8((int)R[bq].y, (int)xh[1], dh_, false); dl_ = __builtin_amdgcn_sdot8((int)R[bq].y, (int)xl[1], dl_, false);
            dh_ = __builtin_amdgcn_sdot8((int)R[bq].z, (int)xh[2], dh_, false); dl_ = __builtin_amdgcn_sdot8((int)R[bq].z, (int)xl[2], dl_, false);
            dh_ = __builtin_amdgcn_sdot8((int)R[bq].w, (int)xh[3], dh_, false); dl_ = __builtin_amdgcn_sdot8((int)R[bq].w, (int)xl[3], dl_, false);
            asm volatile("" ::: "memory");
            if (NEXTV) { if (last) R[bq] = *(const u32x4*)(tb + nid[bq >> 1] * 512u + (unsigned)(sub * 16 + (bq & 1) * 256)); else R[bq] = load_q4(tb, nid[bq], sub); }
            else R[bq] = load_q4(tb, nid[bq], sub);
            asm volatile("" ::: "memory");
            float a_ = row16_sum((float)(dh_ * 16 + dl_)) * sx;
            if (HF == 1) { a_ = (a_ + __uint_as_float(part[bq])) * __uint_as_float(suv[bq]); a_ = __uint_as_float(gsv[bq]) * gelu_fast(a_); }
            outv[bq] = a_;
        }
        if (sub == 0) {
#pragma unroll
            for (int b4 = 0; b4 < RING / 4; ++b4) grp[96 + j / 4 + b4] = (u32x4){__float_as_uint(outv[4 * b4]), __float_as_uint(outv[4 * b4 + 1]), __float_as_uint(outv[4 * b4 + 2]), __float_as_uint(outv[4 * b4 + 3])}; }
    }
    asm volatile("s_waitcnt lgkmcnt(0)" ::: "memory");
}
template <int HF> __device__ __forceinline__ void pass_v8f(float (&acc)[4][16], lds_v4p grp, u32x4 (&R)[AP_RINGU], const unsigned char* img, const unsigned char* img_next, int sub) {
    constexpr int RING = 8;
#pragma unroll 1
    for (int j = 0; j < 128; j += RING) {
        const int jn = (j + RING) & 127;
        if ((j & 31) == 0) __builtin_amdgcn_s_barrier();
        const unsigned char* tb = (j + RING < 128) ? img : img_next;
        unsigned nid[RING], cvv[RING];
#pragma unroll
        for (int b4 = 0; b4 < RING / 4; ++b4) { const u32x4 na = grp[jn / 4 + b4], ca = grp[96 + j / 4 + b4];
            nid[4 * b4] = na.x; nid[4 * b4 + 1] = na.y; nid[4 * b4 + 2] = na.z; nid[4 * b4 + 3] = na.w; cvv[4 * b4] = ca.x; cvv[4 * b4 + 1] = ca.y; cvv[4 * b4 + 2] = ca.z; cvv[4 * b4 + 3] = ca.w; }
#pragma unroll
        for (int bq = 0; bq < RING; ++bq) {
            const float c_ = __uint_as_float(cvv[bq]); const f32x2 c2 = {c_, c_};
#pragma unroll
            for (int i = 0; i < 2; ++i) { const unsigned w_[4] = {R[2 * bq + i].x, R[2 * bq + i].y, R[2 * bq + i].z, R[2 * bq + i].w};
#pragma unroll
                for (int q = 0; q < 4; ++q) { const f32x2 lo_ = __builtin_amdgcn_cvt_pk_f32_fp8(w_[q], false), hi_ = __builtin_amdgcn_cvt_pk_f32_fp8(w_[q], true);
                    f32x2 a0 = {acc[2 * HF + i][4 * q], acc[2 * HF + i][4 * q + 1]}, a1 = {acc[2 * HF + i][4 * q + 2], acc[2 * HF + i][4 * q + 3]}; a0 += c2 * lo_; a1 += c2 * hi_;
                    acc[2 * HF + i][4 * q] = a0.x; acc[2 * HF + i][4 * q + 1] = a0.y; acc[2 * HF + i][4 * q + 2] = a1.x; acc[2 * HF + i][4 * q + 3] = a1.y; } }
            asm volatile("" ::: "memory");
            { const unsigned off = nid[bq] * 512u + (unsigned)(sub * 16); R[2 * bq] = *(const u32x4*)(tb + off); R[2 * bq + 1] = *(const u32x4*)(tb + off + 256u); }
            asm volatile("" ::: "memory");
        }
    }
}
template <int MODE> __device__ __forceinline__ void apply_round(const Ptrs& P, float* outbase, int tbase, unsigned char* shm_wave, int lane_in) {
    int lane = lane_in; asm volatile("" : "+v"(lane));
    const int sub = lane & 15, g = lane >> 4, t = tbase + g;
    __attribute__((address_space(3))) unsigned* cnt = (lds_u32p)(__attribute__((address_space(3))) unsigned char*)shm_wave + g * 128;
    lds_v4p grp = (lds_v4p)((__attribute__((address_space(3))) unsigned char*)shm_wave + 2048 + g * 2048);
    __attribute__((address_space(3))) unsigned* grp1 = (__attribute__((address_space(3))) unsigned*)grp;
    const unsigned char* U8 = P.ws + WS_U; const unsigned char* V8 = P.ws + WS_V;
    {
        const int* idxp = (const int*)(P.ws + WS_IDX) + (size_t)t * 128 + sub * 8; const float* gp = (const float*)(P.ws + WS_G) + (size_t)t * 128 + sub * 8;
        const u32x4 ia = *(const u32x4*)idxp, ib = *(const u32x4*)(idxp + 4); const f32x4 ga = *(const f32x4*)gp, gb = *(const f32x4*)(gp + 4);
        const int e[8] = {(int)ia.x, (int)ia.y, (int)ia.z, (int)ia.w, (int)ib.x, (int)ib.y, (int)ib.z, (int)ib.w};
        const float gt[8] = {ga.x, ga.y, ga.z, ga.w, gb.x, gb.y, gb.z, gb.w};
        float su[8], sv[8];
#pragma unroll
        for (int i = 0; i < 8; ++i) { su[i] = ((const float*)(P.ws + WS_SU))[e[i]]; sv[i] = ((const float*)(P.ws + WS_SV))[e[i]]; }
#pragma unroll
        for (int i = 0; i < 8; ++i) cnt[sub * 8 + i] = 0u;
        asm volatile("s_waitcnt lgkmcnt(0)" ::: "memory");
        unsigned pos[8];
#pragma unroll
        for (int i = 0; i < 8; ++i) pos[i] = __hip_atomic_fetch_add(cnt + (e[i] >> 7), 1u, __ATOMIC_RELAXED, __HIP_MEMORY_SCOPE_WAVEFRONT);
        asm volatile("s_waitcnt lgkmcnt(0)" ::: "memory");
        unsigned c[8]; unsigned tot = 0;
#pragma unroll
        for (int i = 0; i < 8; ++i) { c[i] = cnt[sub * 8 + i]; }
#pragma unroll
        for (int i = 0; i < 8; ++i) { const unsigned x = c[i]; c[i] = tot; tot += x; }
        unsigned inc = tot;
#pragma unroll
        for (int d = 1; d < 16; d <<= 1) { const unsigned y = __shfl_up(inc, d, 16); if (sub >= d) inc += y; }
        const unsigned base = inc - tot;
        asm volatile("s_waitcnt lgkmcnt(0)" ::: "memory");
#pragma unroll
        for (int i = 0; i < 8; ++i) cnt[sub * 8 + i] = base + c[i];
        asm volatile("s_waitcnt lgkmcnt(0)" ::: "memory");
#pragma unroll
        for (int i = 0; i < 8; ++i) { const unsigned p = cnt[e[i] >> 7] + pos[i];
            grp1[p] = (unsigned)e[i]; grp1[128 + p] = __float_as_uint(su[i]); grp1[256 + p] = __float_as_uint(gt[i] * sv[i]); }
        asm volatile("s_waitcnt lgkmcnt(0)" ::: "memory");
    }
    const bf16_t* hrow = (const bf16_t*)(P.ws + WS_HB) + (size_t)t * D;
    float rstd;
    { const float* ssq = (const float*)(P.ws + WS_SSQ) + (size_t)t * 16;
      const f32x4 s0 = *(const f32x4*)ssq, s1 = *(const f32x4*)(ssq + 4), s2 = *(const f32x4*)(ssq + 8), s3 = *(const f32x4*)(ssq + 12);
      const float tot = ((s0.x + s0.y) + (s0.z + s0.w)) + ((s1.x + s1.y) + (s1.z + s1.w)) + ((s2.x + s2.y) + (s2.z + s2.w)) + ((s3.x + s3.y) + (s3.z + s3.w));
      rstd = 1.f / sqrtf(tot * (1.f / D) + EPS); }
    const unsigned char* U0 = U8; const unsigned char* U1 = U8 + (size_t)NEXP * 256; const unsigned char* V0 = V8; const unsigned char* V1 = V8 + (size_t)NEXP * 512;
    u32x4 R[AP_RINGU];
    {
#pragma unroll
      for (int b4 = 0; b4 < AP_RINGU / 4; ++b4) { const u32x4 ia = grp[b4]; R[4 * b4] = load_q4(U0, ia.x, sub); R[4 * b4 + 1] = load_q4(U0, ia.y, sub); R[4 * b4 + 2] = load_q4(U0, ia.z, sub); R[4 * b4 + 3] = load_q4(U0, ia.w, sub); } }
    pass_u4<0, false>(P, hrow, rstd, grp, R, U0, U1, sub);
    pass_u4<1, true>(P, hrow, rstd, grp, R, U1, V0, sub);
    float acc[4][16];
#pragma unroll
    for (int i = 0; i < 4; ++i)
#pragma unroll
        for (int q = 0; q < 16; ++q) acc[i][q] = 0.f;
    pass_v8f<0>(acc, grp, R, V0, V1, sub);
    pass_v8f<1>(acc, grp, R, V1, V1, sub);
    float ss = 0.f;
#pragma unroll
    for (int i = 0; i < 4; ++i) { const int e0 = (sub + 16 * i) * 16;
#pragma unroll
        for (int q = 0; q < 4; ++q) { const u32x2 hb = *(const u32x2*)(hrow + e0 + 4 * q);
            acc[i][4 * q] += bflo(hb.x); acc[i][4 * q + 1] += bfhi(hb.x); acc[i][4 * q + 2] += bflo(hb.y); acc[i][4 * q + 3] += bfhi(hb.y);
            ss += (acc[i][4 * q] * acc[i][4 * q] + acc[i][4 * q + 1] * acc[i][4 * q + 1]) + (acc[i][4 * q + 2] * acc[i][4 * q + 2] + acc[i][4 * q + 3] * acc[i][4 * q + 3]); }
        asm volatile("" ::: "memory"); }
    ss = row16_sum(ss);
    const float r2 = 1.f / sqrtf(ss * (1.f / D) + EPS);
    float* orow = outbase + (size_t)t * D;
#pragma unroll
    for (int i = 0; i < 4; ++i) { const int e0 = (sub + 16 * i) * 16;
#pragma unroll
        for (int q = 0; q < 4; ++q) { const f32x4 gv = *(const f32x4*)(P.norm_final + e0 + 4 * q);
            *(f32x4*)(orow + e0 + 4 * q) = (f32x4){acc[i][4 * q] * r2 * gv.x, acc[i][4 * q + 1] * r2 * gv.y, acc[i][4 * q + 2] * r2 * gv.z, acc[i][4 * q + 3] * r2 * gv.w}; }
        asm volatile("" ::: "memory"); }
}
template <int MODE> __device__ __forceinline__ void apply_phase(const Ptrs& P, float* outbase, unsigned char* shm, int G, int vcu) {
    int tid_l = threadIdx.x; asm volatile("" : "+v"(tid_l));
    const int lane = tid_l & 63; const int wave = __builtin_amdgcn_readfirstlane(tid_l >> 6);
    const int per = M / (G * 8);
#pragma unroll 1
    for (int r = 0; r < per; r += 4) apply_round<MODE>(P, outbase, (vcu * 8 + wave) * per + r, shm + wave * AP_WAVE_BYTES, lane);
}
}

#define LAS __attribute__((address_space(3)))
#define XB_TMO      128
#define XB_XCNT(j)  (256  + 64 * (j))
#define XB_XSUB(j)  (1280 + 64 * (j))
#define XB_XGEN(j)  (2304 + 64 * (j))
#define XB_TOP      3328
#define XB_TOPGEN   3392
#define XCD_BAR_WORDS 3456
#define XB_SPIN_CAP (1u << 18)

__device__ __forceinline__ unsigned xb_ld(unsigned* p)              { return __hip_atomic_load(p, __ATOMIC_RELAXED, __HIP_MEMORY_SCOPE_AGENT); }
__device__ __forceinline__ unsigned xb_add(unsigned* p, unsigned v) { return __hip_atomic_fetch_add(p, v, __ATOMIC_RELAXED, __HIP_MEMORY_SCOPE_AGENT); }
__device__ __forceinline__ unsigned xb_xcc_id() { return (unsigned)__builtin_amdgcn_s_getreg((3 << 11) | 20) & 0xFu; }
#define XB_SPIN(cond, bar) do { unsigned _sp = 0; while (cond) { __builtin_amdgcn_s_sleep(1); \
    if ((++_sp & 255u) == 0u) { if (xb_ld(&(bar)[XB_TMO])) break; if (_sp > XB_SPIN_CAP) { atomicAdd(&(bar)[XB_TMO], 1u); break; } } } } while (0)

struct XcdBarrier {
    unsigned* bar; unsigned x;
    volatile LAS unsigned* st;
};

__device__ __forceinline__ XcdBarrier xcd_barrier_post(unsigned* bar, volatile LAS unsigned* st) {
    XcdBarrier b; b.bar = bar; b.x = xb_xcc_id(); b.st = st;
    if (threadIdx.x == 0) (void)xb_add(&bar[XB_XCNT(b.x)], 1u);
    return b;
}
__device__ __forceinline__ void xcd_barrier_complete(unsigned* bar, unsigned x, unsigned& nloc, unsigned& nx) {
    const unsigned G = gridDim.x * gridDim.y * gridDim.z;
    unsigned sum, cnt, mine, sp = 0u;
    for (;;) {
        sum = 0u; cnt = 0u; mine = 0u;
#pragma unroll
        for (unsigned j = 0; j < 16; ++j) { const unsigned c = xb_ld(&bar[XB_XCNT(j)]); sum += c; cnt += (c > 0u) ? 1u : 0u; mine = (j == x) ? c : mine; }
        if (sum == G) break;
        __builtin_amdgcn_s_sleep(1);
        if ((++sp & 255u) == 0u) { if (xb_ld(&bar[XB_TMO])) break; if (sp > XB_SPIN_CAP) { atomicAdd(&bar[XB_TMO], 1u); break; } }
    }
    nloc = mine > 0u ? mine : 1u; nx = cnt > 0u ? cnt : 1u;
}

__device__ __forceinline__ void xcd_barrier(const XcdBarrier& b) {
    asm volatile("s_waitcnt vmcnt(0)" ::: "memory");
    __syncthreads();
    if (threadIdx.x == 0) {
        unsigned* bar = b.bar;
        __builtin_amdgcn_s_waitcnt(0);
        unsigned nloc = b.st[0], nx = b.st[1];
        if (nloc == 0u) { xcd_barrier_complete(bar, b.x, nloc, nx); b.st[0] = nloc; b.st[1] = nx; }
        const unsigned old = xb_add(&bar[XB_XSUB(b.x)], 1u);
        const unsigned gen = old / nloc;
        if (old + 1u == (gen + 1u) * nloc) {
            __builtin_amdgcn_fence(__ATOMIC_RELEASE, "agent");
            asm volatile("s_waitcnt vmcnt(0)" ::: "memory");
            const unsigned og = xb_add(&bar[XB_TOP], 1u);
            const unsigned tg = og / nx;
            if (og + 1u == (tg + 1u) * nx) xb_add(&bar[XB_TOPGEN], 1u);
            else XB_SPIN(xb_ld(&bar[XB_TOPGEN]) == tg, bar);
            __builtin_amdgcn_fence(__ATOMIC_ACQUIRE, "agent");
            xb_add(&bar[XB_XGEN(b.x)], 1u);
            asm volatile("s_waitcnt vmcnt(0)" ::: "memory");
        } else {
            XB_SPIN(xb_ld(&bar[XB_XGEN(b.x)]) == gen, bar);
            __builtin_amdgcn_fence(__ATOMIC_ACQUIRE, "agent");
            asm volatile("s_waitcnt vmcnt(0)" ::: "memory");
        }
    }
    __syncthreads();
}


namespace cg = cooperative_groups;
#ifndef REP_MASK
#define REP_MASK 0
#endif
#define REPS(k) (((REP_MASK) >> (k)) & 1 ? 2 : 1)
constexpr int PHASE_LDS = att::A_LDS_BYTES;
constexpr int MEGA_LDS = PHASE_LDS + 64;
static_assert(PHASE_LDS >= pg8::STAGE_BYTES && PHASE_LDS >= att::B_LDS_BYTES && PHASE_LDS >= peer::T_LDS_BYTES && PHASE_LDS >= 8 * 64 * 33 * 4 && PHASE_LDS >= apply::AP_LDS_BYTES, "LDS budget");
__global__ void __launch_bounds__(512, 2) mega_fwd(Ptrs P) {
    extern __shared__ __attribute__((aligned(16))) unsigned char lds_dyn[];
    volatile LAS unsigned* bst = (volatile LAS unsigned*)((LAS unsigned char*)lds_dyn + PHASE_LDS);
    if (threadIdx.x < 2) bst[threadIdx.x] = 0u;
    __syncthreads();
    const XcdBarrier bar = xcd_barrier_post((unsigned*)(P.ws + WS_CTL), bst);
    const int G = (int)gridDim.x, bx = (int)blockIdx.x, vcu = (G % 8 == 0) ? (bx % 8) * (G / 8) + bx / 8 : bx;
    unsigned char* ws = P.ws;
    PG8_LAS unsigned char* lds3 = (PG8_LAS unsigned char*)lds_dyn;
    for (int rep = 0; rep < REPS(0); ++rep) prep_phase(P, lds_dyn, G, bx);
    xcd_barrier(bar); if (REPS(9) == 2) xcd_barrier(bar);
    for (int rep = 0; rep < REPS(1); ++rep) {
      { pg8::Gemm g{(const bf16_t*)(ws + WS_XN), (const bf16_t*)(ws + WS_WIN), M, 1024, D, 0}; pg8::StaticOrder S; S.init(M, 1024, G, bx);
        pg8::gemm_phase<pg8::EpiProj, pg8::StaticOrder, true, true, false>(lds3, g, S, pg8::EpiProj{(bf16_t*)(ws + WS_PROJ), (const float*)(ws + WS_ROPE), 1.f, 0}); }
      { pg8::Gemm g{(const bf16_t*)(ws + WS_XN8), (const bf16_t*)(ws + WS_WIN8), M, INW - 1024, D / 2, 0}; pg8::StaticOrder S; S.init(M, INW - 1024, G, bx);
        pg8::gemm_phase<pg8::EpiProj, pg8::StaticOrder, true, true, true>(lds3, g, S, pg8::EpiProj{(bf16_t*)(ws + WS_PROJ), (const float*)(ws + WS_ROPE), 1.f / WIN_SCALE, 4}); } }
    xcd_barrier(bar); if (REPS(9) == 2) xcd_barrier(bar);
    { const float lam = lambda_full(P);
      for (int rep = 0; rep < REPS(2); ++rep) for (int u = vcu; u < BATCH * 4 * 8; u += G) att::attn_a_unit(u >> 5, (u >> 3) & 3, u & 7, (const bf16_t*)(ws + WS_PROJ), (bf16_t*)(ws + WS_YA), P.subln, lam, lds_dyn);
      for (int rep = 0; rep < REPS(3); ++rep) for (int u = vcu; u < BATCH * 8 * 8; u += G) att::attn_b_unit(u >> 6, (u >> 3) & 7, u & 7, (const bf16_t*)(ws + WS_PROJ), (bf16_t*)(ws + WS_YA), P.rpb, lds_dyn); }
    xcd_barrier(bar); if (REPS(9) == 2) xcd_barrier(bar);
    for (int rep = 0; rep < REPS(4); ++rep) { pg8::StaticOrder S; S.init(M, D, G, bx);
      pg8::gemm_phase<pg8::EpiGate2, pg8::StaticOrder, true, true>(lds3, pg8::Gemm{(const bf16_t*)(ws + WS_YA), (const bf16_t*)(ws + WS_WPA), M, D, D, 0}, S, pg8::EpiGate2{(const bf16_t*)(ws + WS_PROJ), (bf16_t*)(ws + WS_MERGED)}); }
    xcd_barrier(bar); if (REPS(9) == 2) xcd_barrier(bar);
    for (int rep = 0; rep < REPS(5); ++rep) { pg8::StaticOrder S; S.init(M, D, G, bx);
      pg8::gemm_phase<pg8::EpiHout, pg8::StaticOrder, true, true>(lds3, pg8::Gemm{(const bf16_t*)(ws + WS_MERGED), (const bf16_t*)(ws + WS_WOUT), M, D, D, 0}, S, pg8::EpiHout{P.x, P.out, (bf16_t*)(ws + WS_HB), (float*)(ws + WS_SSQ)});
    }
    xcd_barrier(bar); if (REPS(9) == 2) xcd_barrier(bar);
    { pg8::StaticOrder S; S.init(M, PQ, G, bx);
      for (int rep = 0; rep < REPS(8); ++rep)
        pg8::gemm_phase<pg8::EpiQ, pg8::StaticOrder, true, true>(lds3, pg8::Gemm{(const bf16_t*)(ws + WS_HB), (const bf16_t*)(ws + WS_WQ), M, PQ, D, 0}, S, pg8::EpiQ{(const float*)(ws + WS_SSQ), (bf16_t*)(ws + WS_Q)});
      asm volatile("s_waitcnt vmcnt(0)" ::: "memory");
      __syncthreads();
      if (threadIdx.x == 0) { __builtin_amdgcn_fence(__ATOMIC_ACQUIRE, "agent"); asm volatile("s_waitcnt vmcnt(0)" ::: "memory"); }
      __syncthreads();
      for (int rep = 0; rep < REPS(6); ++rep) peer::topk_own_units(P, lds_dyn, S); }
    xcd_barrier(bar); if (REPS(9) == 2) xcd_barrier(bar);
#ifndef PROBE_MODE
#define PROBE_MODE 0
#endif
    if (REPS(7) == 2) apply::apply_phase<PROBE_MODE>(P, (float*)(ws + WS_Q), lds_dyn, G, vcu);
    apply::apply_phase<0>(P, P.out, lds_dyn, G, vcu);
}

extern "C" void kernel_launch(void* const* d_in, const int* in_sizes, int n_in, void* d_out, int out_size, void* d_ws, size_t ws_size, hipStream_t stream) {
    if (n_in != 18 || ws_size < WS_END) { fprintf(stderr, "kernel_launch: unexpected n_in %d / ws_size %zu\n", n_in, ws_size); return; }
    Ptrs P{};
    P.x = (const float*)d_in[0]; P.w_in = (const float*)d_in[1]; P.w_pa = (const float*)d_in[2]; P.w_pb = (const float*)d_in[3]; P.w_out = (const float*)d_in[4];
    P.norm_mix = (const float*)d_in[5]; P.norm_ffn = (const float*)d_in[6]; P.norm_final = (const float*)d_in[7];
    P.lq1 = (const float*)d_in[8]; P.lk1 = (const float*)d_in[9]; P.lq2 = (const float*)d_in[10]; P.lk2 = (const float*)d_in[11];
    P.subln = (const float*)d_in[12]; P.rpb = (const float*)d_in[13]; P.w_query = (const float*)d_in[14]; P.sub_keys = (const float*)d_in[15];
    P.peer_u = (const float*)d_in[16]; P.peer_v = (const float*)d_in[17];
    P.out = (float*)d_out; P.ws = (unsigned char*)d_ws;
    static int grid_blocks = 0;
    if (!grid_blocks) {
        int dev = 0, cus = 0, per_cu = 0;
        hipGetDevice(&dev);
        hipDeviceGetAttribute(&cus, hipDeviceAttributeMultiprocessorCount, dev);
        hipFuncSetAttribute((const void*)mega_fwd, hipFuncAttributeMaxDynamicSharedMemorySize, MEGA_LDS);
        hipOccupancyMaxActiveBlocksPerMultiprocessor(&per_cu, (const void*)mega_fwd, 512, MEGA_LDS);
        if (per_cu < 1) { fprintf(stderr, "kernel_launch: occupancy query says %d blocks per CU\n", per_cu); per_cu = 1; }
        grid_blocks = cus * per_cu;
    }
    hipMemsetAsync((unsigned char*)d_ws + WS_CTL, 0, 16384, stream);
    void* args[] = {&P};
    hipError_t e = hipLaunchCooperativeKernel((const void*)mega_fwd, dim3(grid_blocks), dim3(512), args, MEGA_LDS, stream);
    if (e != hipSuccess) fprintf(stderr, "cooperative launch failed: %s (grid %d)\n", hipGetErrorString(e), grid_blocks);
}
```

```cpp
#include <hip/hip_runtime.h>
#include <hip/hip_cooperative_groups.h>
#include <cstdio>
#include <cstdint>

typedef unsigned short bf16_t;
typedef unsigned u32x4 __attribute__((ext_vector_type(4)));
typedef unsigned u32x2 __attribute__((ext_vector_type(2)));
typedef float f32x4 __attribute__((ext_vector_type(4)));
typedef __bf16 bf16x2_t __attribute__((ext_vector_type(2)));

constexpr int D = 1024, BATCH = 8, SEQ = 2048, M = BATCH * SEQ, INW = 5120;
constexpr int C_QA = 0, C_KA = 512, C_VA = 1024, C_QB = 1536, C_KB = 2048, C_VB = 2560, C_GA = 3072, C_GB = 4096;
constexpr int NEXP = 16384, PQ = 2048;
constexpr float EPS = 1e-6f;
constexpr float LOG2E = 1.4426950408889634f;
constexpr float WIN_SCALE = 32.f;
constexpr float QSCALE = 0.125f * LOG2E;

constexpr size_t MiB = 1u << 20;
constexpr size_t WS_PROJ = 0;
constexpr size_t WS_HB = 0;
constexpr size_t WS_Q = 32 * MiB;
constexpr size_t WS_U = 96 * MiB;
constexpr size_t WS_V = 112 * MiB;
constexpr size_t WS_SU = 128 * MiB;
constexpr size_t WS_SV = 128 * MiB + 65536;
constexpr size_t WS_XN = 160 * MiB;
constexpr size_t WS_YA = 160 * MiB;
constexpr size_t WS_YB = 176 * MiB;
constexpr size_t WS_IDX = 160 * MiB;
constexpr size_t WS_G = 168 * MiB;
constexpr size_t WS_MERGED = 192 * MiB;
constexpr size_t WS_TOPV = 192 * MiB;
constexpr size_t WS_TOPI = 208 * MiB;
constexpr size_t WS_WIN = 224 * MiB;
constexpr size_t WS_WIN8 = 226 * MiB;
constexpr size_t WS_XN8 = 192 * MiB;
constexpr size_t WS_WQ = 234 * MiB;
constexpr size_t WS_WOUT = 238 * MiB;
constexpr size_t WS_WPA = 240 * MiB;
constexpr size_t WS_WPB = 241 * MiB;
constexpr size_t WS_SK = 242 * MiB;
constexpr size_t WS_ROPE = 242 * MiB + 512 * 1024;
constexpr size_t WS_SSQ = 243 * MiB;
constexpr size_t WS_CTL = 244 * MiB;
constexpr size_t WS_END = 256 * MiB;

__device__ __forceinline__ float bf2f(unsigned v) { return __uint_as_float(v << 16); }
__device__ __forceinline__ float bflo(unsigned w) { return __uint_as_float(w << 16); }
__device__ __forceinline__ float bfhi(unsigned w) { return __uint_as_float(w & 0xffff0000u); }
__device__ __forceinline__ unsigned f2bf(float f) { unsigned u = __float_as_uint(f); return (u + 0x7fffu + ((u >> 16) & 1u)) >> 16; }
__device__ __forceinline__ unsigned pk2(float lo, float hi) { return f2bf(lo) | (f2bf(hi) << 16); }
__device__ __forceinline__ float wave_sum(float v) {
#pragma unroll
    for (int o = 1; o < 64; o <<= 1) v += __shfl_xor(v, o);
    return v;
}
__device__ __forceinline__ float sigmoidf_(float x) { return 1.f / (1.f + __expf(-x)); }
__device__ __forceinline__ float gelu_exact(float x) { return 0.5f * x * (1.f + erff(x * 0.70710678118654752f)); }

struct Ptrs {
    const float *x, *w_in, *w_pa, *w_pb, *w_out, *norm_mix, *norm_ffn, *norm_final, *lq1, *lk1, *lq2, *lk2, *subln, *rpb, *w_query, *sub_keys, *peer_u, *peer_v;
    float* out; unsigned char* ws;
};

__device__ __forceinline__ void transpose_item(const float* W, int K, int N, const float* gain, bf16_t* WT, float* scr, int item, int lane, int ldo = 0, int koff = 0, int ldw = 0) {
    if (ldo == 0) ldo = K;
    if (ldw == 0) ldw = N;
    const int nblk = N / 32, kb = item / nblk, nb = item % nblk, k0 = 64 * kb, n0 = 32 * nb;
    float wv[32];
#pragma unroll
    for (int i = 0; i < 32; ++i) { const int kk = 2 * i + (lane >> 5); wv[i] = W[(size_t)(k0 + kk) * ldw + n0 + (lane & 31)]; }
#pragma unroll
    for (int i = 0; i < 32; ++i) { const int kk = 2 * i + (lane >> 5); float w = wv[i]; if (gain) w *= gain[k0 + kk]; scr[kk * 33 + (lane & 31)] = w; }
    asm volatile("s_waitcnt lgkmcnt(0)" ::: "memory");
    const int c = lane & 7;
#pragma unroll
    for (int j = 0; j < 4; ++j) { const int n = (lane >> 3) + 8 * j; const float* s = scr + (8 * c) * 33 + n;
        u32x4 o; o.x = pk2(s[0 * 33], s[1 * 33]); o.y = pk2(s[2 * 33], s[3 * 33]); o.z = pk2(s[4 * 33], s[5 * 33]); o.w = pk2(s[6 * 33], s[7 * 33]);
        *(u32x4*)(WT + (size_t)(n0 + n) * ldo + koff + k0 + 8 * c) = o; }
    asm volatile("s_waitcnt lgkmcnt(0)" ::: "memory");
}
__device__ __forceinline__ void cvt8(const float* src, bf16_t* dst, size_t i8) {
    const f32x4 a = *(const f32x4*)(src + i8 * 8), b = *(const f32x4*)(src + i8 * 8 + 4);
    u32x4 o; o.x = pk2(a.x, a.y); o.y = pk2(a.z, a.w); o.z = pk2(b.x, b.y); o.w = pk2(b.z, b.w);
    *(u32x4*)(dst + i8 * 8) = o;
}
__device__ __forceinline__ void transpose_item8(const float* W, int K, int N, int ldw, const float* gain, float wscale, unsigned char* WT, float* scr, int item, int lane) {
    const int nblk = N / 32, kb = item / nblk, nb = item % nblk, k0 = 64 * kb, n0 = 32 * nb;
    float wv[32];
#pragma unroll
    for (int i = 0; i < 32; ++i) { const int kk = 2 * i + (lane >> 5); wv[i] = W[(size_t)(k0 + kk) * ldw + n0 + (lane & 31)]; }
#pragma unroll
    for (int i = 0; i < 32; ++i) { const int kk = 2 * i + (lane >> 5); float w = wv[i] * wscale; if (gain) w *= gain[k0 + kk]; scr[kk * 33 + (lane & 31)] = w; }
    asm volatile("s_waitcnt lgkmcnt(0)" ::: "memory");
    const int c = lane & 7;
#pragma unroll
    for (int j = 0; j < 4; ++j) { const int n = (lane >> 3) + 8 * j; const float* s = scr + (8 * c) * 33 + n;
        u32x2 o; o.x = __builtin_amdgcn_cvt_pk_fp8_f32(s[0 * 33], s[1 * 33], 0u, false); o.x = __builtin_amdgcn_cvt_pk_fp8_f32(s[2 * 33], s[3 * 33], o.x, true);
        o.y = __builtin_amdgcn_cvt_pk_fp8_f32(s[4 * 33], s[5 * 33], 0u, false); o.y = __builtin_amdgcn_cvt_pk_fp8_f32(s[6 * 33], s[7 * 33], o.y, true);
        *(u32x2*)(WT + (size_t)(n0 + n) * K + k0 + 8 * c) = o; }
    asm volatile("s_waitcnt lgkmcnt(0)" ::: "memory");
}
__device__ __forceinline__ void rms_rows_emit(const f32x4 (&v)[4], bf16_t* orow16, unsigned char* orow, int lane) {
    float s = 0.f;
#pragma unroll
    for (int j = 0; j < 4; ++j) s += (v[j].x * v[j].x + v[j].y * v[j].y) + (v[j].z * v[j].z + v[j].w * v[j].w);
    const float rstd = 1.f / sqrtf(wave_sum(s) * (1.f / D) + EPS);
    unsigned* o4 = (unsigned*)orow + lane; u32x2* o8 = (u32x2*)orow16 + lane;
#pragma unroll
    for (int j = 0; j < 4; ++j) { unsigned w = __builtin_amdgcn_cvt_pk_fp8_f32(v[j].x * rstd, v[j].y * rstd, 0u, false); w = __builtin_amdgcn_cvt_pk_fp8_f32(v[j].z * rstd, v[j].w * rstd, w, true); o4[64 * j] = w;
        u32x2 w2; w2.x = pk2(v[j].x * rstd, v[j].y * rstd); w2.y = pk2(v[j].z * rstd, v[j].w * rstd); o8[64 * j] = w2; }
}
__device__ __forceinline__ void rms_rows(const float* x, bf16_t* xn16, unsigned char* xn8, int m0, int step, int lane) {
    if (m0 >= M) return;
    f32x4 cur[4], nxt[4];
#pragma unroll
    for (int j = 0; j < 4; ++j) cur[j] = ((const f32x4*)(x + (size_t)m0 * D) + lane)[64 * j];
    for (int m = m0; m < M; m += step) {
        const int mn = (m + step < M) ? m + step : m;
#pragma unroll
        for (int j = 0; j < 4; ++j) nxt[j] = ((const f32x4*)(x + (size_t)mn * D) + lane)[64 * j];
        rms_rows_emit(cur, xn16 + (size_t)m * D, xn8 + (size_t)m * D, lane);
#pragma unroll
        for (int j = 0; j < 4; ++j) cur[j] = nxt[j];
    }
}
__device__ __forceinline__ void rms_row_to_bf16(const float* xrow, bf16_t* orow, int lane) {
    const f32x4* xr = (const f32x4*)xrow + lane;
    f32x4 v[4]; float s = 0.f;
#pragma unroll
    for (int j = 0; j < 4; ++j) { v[j] = xr[64 * j]; s += (v[j].x * v[j].x + v[j].y * v[j].y) + (v[j].z * v[j].z + v[j].w * v[j].w); }
    const float rstd = 1.f / sqrtf(wave_sum(s) * (1.f / D) + EPS);
    u32x2* o8 = (u32x2*)orow + lane;
#pragma unroll
    for (int j = 0; j < 4; ++j) { u32x2 w; w.x = pk2(v[j].x * rstd, v[j].y * rstd); w.y = pk2(v[j].z * rstd, v[j].w * rstd); o8[64 * j] = w; }
}

__device__ __forceinline__ void prep_phase(const Ptrs& P, unsigned char* shm, int G, int bx) {
    int tid_l = threadIdx.x; asm volatile("" : "+v"(tid_l));
    const int lane = tid_l & 63; const int wave = __builtin_amdgcn_readfirstlane(tid_l >> 6);
    const int gw = bx * 8 + wave, NGW = G * 8;
    float* scr = (float*)(shm + wave * (64 * 33 * 4));
    unsigned char* ws = P.ws;
    constexpr int N_BF = 1024;
    constexpr int I_INB = (D / 64) * (N_BF / 32), I_IN8 = (D / 64) * ((INW - N_BF) / 32), I_IN = I_INB + I_IN8, I_Q = (D / 64) * (PQ / 32), I_OUT = (D / 64) * (D / 32), I_PA = (512 / 64) * (D / 32);
    constexpr int NIT = I_IN + I_Q + I_OUT + 2 * I_PA;
    for (int it = gw; it < NIT; it += NGW) {
        int r = it;
        if (r < I_INB) { transpose_item(P.w_in, D, N_BF, P.norm_mix, (bf16_t*)(ws + WS_WIN), scr, r, lane, 0, 0, INW); continue; } r -= I_INB;
        if (r < I_IN8) { transpose_item8(P.w_in + N_BF, D, INW - N_BF, INW, P.norm_mix, WIN_SCALE, ws + WS_WIN8, scr, r, lane); continue; } r -= I_IN8;
        if (r < I_Q) { transpose_item(P.w_query, D, PQ, P.norm_ffn, (bf16_t*)(ws + WS_WQ), scr, r, lane); continue; } r -= I_Q;
        if (r < I_OUT) { transpose_item(P.w_out, D, D, nullptr, (bf16_t*)(ws + WS_WOUT), scr, r, lane); continue; } r -= I_OUT;
        if (r < I_PA) { transpose_item(P.w_pa, 512, D, nullptr, (bf16_t*)(ws + WS_WPA), scr, r, lane, 1024, 0); continue; } r -= I_PA;
        transpose_item(P.w_pb, 512, D, nullptr, (bf16_t*)(ws + WS_WPA), scr, r, lane, 1024, 512);
    }
    rms_rows(P.x, (bf16_t*)(ws + WS_XN), ws + WS_XN8, gw, NGW, lane);
    const size_t gt = (size_t)bx * 512 + threadIdx.x, NT = (size_t)G * 512;
    for (size_t i = gt; i < (size_t)16 * 128 * 128 / 8; i += NT) cvt8(P.sub_keys, (bf16_t*)(ws + WS_SK), i);
    for (size_t i = gt; i < (size_t)SEQ * 8; i += NT) {
        const int pos = (int)(i >> 3), k = (int)(i & 7);
        const float inv = k == 0 ? 1.0f : k == 1 ? 0.19392274f : k == 2 ? 0.03760603f : k == 3 ? 0.0072926646f : k == 4 ? 0.0014142136f : k == 5 ? 0.0002742482f : k == 6 ? 5.3182957e-05f : 1.0313385e-05f;
        const float ang = (float)pos * inv;
        float sn, cs; sincosf(ang, &sn, &cs);
        float* t = (float*)(ws + WS_ROPE) + (size_t)pos * 16;
        t[k] = cs; t[8 + k] = sn;
    }
}
__device__ __forceinline__ void cvt_row_fp8(const f32x4 (&rv)[4], unsigned char* dst, float* inv_scale, int lane) {
    const f32x4 a = rv[0], b = rv[1], c = rv[2], d = rv[3];
    float m = fmaxf(fmaxf(fmaxf(fabsf(a.x), fabsf(a.y)), fmaxf(fabsf(a.z), fabsf(a.w))), fmaxf(fmaxf(fabsf(b.x), fabsf(b.y)), fmaxf(fabsf(b.z), fabsf(b.w))));
    m = fmaxf(m, fmaxf(fmaxf(fmaxf(fabsf(c.x), fabsf(c.y)), fmaxf(fabsf(c.z), fabsf(c.w))), fmaxf(fmaxf(fabsf(d.x), fabsf(d.y)), fmaxf(fabsf(d.z), fabsf(d.w)))));
#pragma unroll
    for (int o = 1; o < 64; o <<= 1) m = fmaxf(m, __shfl_xor(m, o));
    m = fmaxf(m, 1e-30f);
    const float sc = 256.f / m;
    u32x4 w;
    w.x = __builtin_amdgcn_cvt_pk_fp8_f32(a.x * sc, a.y * sc, 0u, false); w.x = __builtin_amdgcn_cvt_pk_fp8_f32(a.z * sc, a.w * sc, w.x, true);
    w.y = __builtin_amdgcn_cvt_pk_fp8_f32(b.x * sc, b.y * sc, 0u, false); w.y = __builtin_amdgcn_cvt_pk_fp8_f32(b.z * sc, b.w * sc, w.y, true);
    w.z = __builtin_amdgcn_cvt_pk_fp8_f32(c.x * sc, c.y * sc, 0u, false); w.z = __builtin_amdgcn_cvt_pk_fp8_f32(c.z * sc, c.w * sc, w.z, true);
    w.w = __builtin_amdgcn_cvt_pk_fp8_f32(d.x * sc, d.y * sc, 0u, false); w.w = __builtin_amdgcn_cvt_pk_fp8_f32(d.z * sc, d.w * sc, w.w, true);
    *(u32x4*)(dst + (size_t)(lane >> 5) * (NEXP * 512) + (lane & 31) * 16) = w;
    if (lane == 0) *inv_scale = m * (1.f / 256.f);
}
__device__ __forceinline__ unsigned nib4(float v, float sc) { const int q = (int)rintf(fminf(fmaxf(v * sc, -7.f), 7.f)); return (unsigned)q & 15u; }
__device__ __forceinline__ unsigned pack_i4x8(const f32x4& a, const f32x4& b, float sc) {
    return nib4(a.x, sc) | (nib4(a.y, sc) << 4) | (nib4(a.z, sc) << 8) | (nib4(a.w, sc) << 12) | (nib4(b.x, sc) << 16) | (nib4(b.y, sc) << 20) | (nib4(b.z, sc) << 24) | (nib4(b.w, sc) << 28);
}
__device__ __forceinline__ void cvt_row_i4(const f32x4 (&rv)[4], unsigned char* dst, float* inv_scale, int lane) {
    const f32x4 a = rv[0], b = rv[1], c = rv[2], d = rv[3];
    float ss = ((a.x * a.x + a.y * a.y) + (a.z * a.z + a.w * a.w)) + ((b.x * b.x + b.y * b.y) + (b.z * b.z + b.w * b.w));
    ss += ((c.x * c.x + c.y * c.y) + (c.z * c.z + c.w * c.w)) + ((d.x * d.x + d.y * d.y) + (d.z * d.z + d.w * d.w));
#pragma unroll
    for (int o = 1; o < 64; o <<= 1) ss += __shfl_xor(ss, o);
    const float rms = fmaxf(sqrtf(ss * (1.f / D)), 1e-30f);
    const float sc = 2.8f / rms;
    u32x2 w; w.x = pack_i4x8(a, b, sc); w.y = pack_i4x8(c, d, sc);
    *(u32x2*)(dst + (size_t)(lane >> 5) * (NEXP * 256) + (lane & 15) * 16 + ((lane >> 4) & 1) * 8) = w;
    if (lane == 0) *inv_scale = rms * (2.5f / 7.f);
}
__device__ __forceinline__ unsigned pack_i8x4(float a, float b, float c, float d) {
    const int q0 = (int)rintf(a), q1 = (int)rintf(b), q2 = (int)rintf(c), q3 = (int)rintf(d);
    return (unsigned)(q0 & 0xff) | ((unsigned)(q1 & 0xff) << 8) | ((unsigned)(q2 & 0xff) << 16) | ((unsigned)q3 << 24);
}
__device__ __forceinline__ void cvt_row_i8(const f32x4 (&rv)[4], unsigned char* dst, float* inv_scale, int lane) {
    const f32x4 a = rv[0], b = rv[1], c = rv[2], d = rv[3];
    float m = fmaxf(fmaxf(fmaxf(fabsf(a.x), fabsf(a.y)), fmaxf(fabsf(a.z), fabsf(a.w))), fmaxf(fmaxf(fabsf(b.x), fabsf(b.y)), fmaxf(fabsf(b.z), fabsf(b.w))));
    m = fmaxf(m, fmaxf(fmaxf(fmaxf(fabsf(c.x), fabsf(c.y)), fmaxf(fabsf(c.z), fabsf(c.w))), fmaxf(fmaxf(fabsf(d.x), fabsf(d.y)), fmaxf(fabsf(d.z), fabsf(d.w)))));
#pragma unroll
    for (int o = 1; o < 64; o <<= 1) m = fmaxf(m, __shfl_xor(m, o));
    m = fmaxf(m, 1e-30f);
    const float sc = 127.f / m;
    u32x4 w;
    w.x = pack_i8x4(a.x * sc, a.y * sc, a.z * sc, a.w * sc); w.y = pack_i8x4(b.x * sc, b.y * sc, b.z * sc, b.w * sc);
    w.z = pack_i8x4(c.x * sc, c.y * sc, c.z * sc, c.w * sc); w.w = pack_i8x4(d.x * sc, d.y * sc, d.z * sc, d.w * sc);
    *(u32x4*)(dst + (size_t)(lane >> 5) * (NEXP * 512) + (lane & 31) * 16) = w;
    if (lane == 0) *inv_scale = m * (1.f / 127.f);
}
__device__ __forceinline__ void cvt_experts_phase(const Ptrs& P, int G, int bx) {
    int tid_l = threadIdx.x; asm volatile("" : "+v"(tid_l));
    const int lane = tid_l & 63; const int wave = __builtin_amdgcn_readfirstlane(tid_l >> 6);
    const int step = G * 8; int r = bx * 8 + wave;
    if (r >= 2 * NEXP) return;
    f32x4 cur[4], nxt[4];
    { const float* src = (r < NEXP ? P.peer_u + (size_t)r * D : P.peer_v + (size_t)(r - NEXP) * D);
#pragma unroll
      for (int j = 0; j < 4; ++j) cur[j] = ((const f32x4*)src + lane * 4)[j]; }
    for (; r < 2 * NEXP; r += step) {
        const int rn = (r + step < 2 * NEXP) ? r + step : r;
        const float* srcn = (rn < NEXP ? P.peer_u + (size_t)rn * D : P.peer_v + (size_t)(rn - NEXP) * D);
#pragma unroll
        for (int j = 0; j < 4; ++j) nxt[j] = ((const f32x4*)srcn + lane * 4)[j];
        if (r < NEXP) cvt_row_i8(cur, P.ws + WS_U + (size_t)r * 512, (float*)(P.ws + WS_SU) + r, lane);
        else { const int e = r - NEXP; cvt_row_fp8(cur, P.ws + WS_V + (size_t)e * 512, (float*)(P.ws + WS_SV) + e, lane); }
#pragma unroll
        for (int j = 0; j < 4; ++j) cur[j] = nxt[j];
    }
}

namespace pg8 {
#define PG8_LAS __attribute__((address_space(3)))
typedef unsigned short bf16_t;
typedef short bf16x8 __attribute__((ext_vector_type(8)));
typedef float f32x4 __attribute__((ext_vector_type(4)));
typedef unsigned u32x4 __attribute__((ext_vector_type(4)));
typedef int v8i_t __attribute__((ext_vector_type(8)));
constexpr int BM = 256, BK = 64, HALF = 128, HTB = HALF * BK * 2  , STAGE_BYTES = 8 * HTB, NXCD = 8, WGM = 4;

__host__ __device__ __forceinline__ int lds_byte(int r, int c) { const int st = (r >> 4) * 2 + (c >> 5), rr = r & 15, cc = c & 31, ob = rr * 64 + cc * 2; return st * 1024 + (ob ^ (((ob >> 9) & 1) << 5)); }
__host__ __device__ __forceinline__ void stage_rc(int b, int& R, int& C) { const int st = b / 1024, sb = b % 1024, swz = sb ^ (((sb >> 9) & 1) << 5); R = (st >> 1) * 16 + swz / 64; C = (st & 1) * 32 + (swz % 64) / 2; }
__host__ __device__ __forceinline__ int perm32(int rho) { const int n = rho >> 4, i = rho & 15; return 8 * (i >> 2) + 4 * n + (i & 3); }

struct Unit { int pm, pn; };
struct Gemm { const bf16_t* A; const bf16_t* Bt; int M, N, K, pad; };

struct StaticOrder {
    int nM, nN, nwg, G, c;
    __host__ __device__ void init(int M, int N, int G_, int c_) { nM = M / BM; nN = N / BM; nwg = nM * nN; G = G_; c = c_; }
    __host__ __device__ bool next(int i, Unit& u) const {
        const long L = (long)i * G + c; if (L >= nwg) return false;
        int wgid = (int)L; { const int q = nwg / NXCD, r = nwg % NXCD, xcd = wgid % NXCD, off = wgid / NXCD; wgid = (xcd < r ? xcd * (q + 1) : r * (q + 1) + (xcd - r) * q) + off; }
        const int nig = WGM * nN, gid = wgid / nig, fm = gid * WGM, gsz = (nM - fm) < WGM ? (nM - fm) : WGM;
        u.pm = fm + ((wgid % nig) % gsz); u.pn = (wgid % nig) / gsz; return true;
    }
    __device__ __forceinline__ void a_ready(const Unit&) const {}
    __device__ __forceinline__ void done(const Unit&) const {}
};
__device__ __forceinline__ unsigned cvt_pk_bf16(float lo, float hi) { unsigned r; asm volatile("v_cvt_pk_bf16_f32 %0, %1, %2" : "=v"(r) : "v"(lo), "v"(hi)); return r; }
typedef float f32x2 __attribute__((ext_vector_type(2)));

__device__ __forceinline__ float sigm(float x) { return __builtin_amdgcn_rcpf(1.f + __builtin_amdgcn_exp2f(-1.4426950408889634f * x)); }
struct EpiProj {
    static constexpr bool PERM = true, AFTER_DRAIN = false, MID = false;
    bf16_t* O; const float* rope; float osc; int pn0;
    __device__ __forceinline__ void operator()(const f32x4 (&acc)[2][2][4][2], const Unit& u, int wr, int wc, int fr_, int fq_) const {
        int fr = fr_, fq = fq_; asm volatile("" : "+v"(fr), "+v"(fq));
        const int pn = u.pn + pn0;
        const int row0 = u.pm * BM + wr * 64 + fr, col0 = pn * BM + wc * 32 + 8 * fq;
        const float sc = ((pn < 2 || pn == 6 || pn == 7) ? QSCALE : 1.f) * osc;
        const bool dorope = (pn < 4) && ((wc & 1) == 0);
#pragma unroll
        for (int ai = 0; ai < 2; ++ai)
#pragma unroll
            for (int m = 0; m < 4; ++m) { const int row = row0 + ai * HALF + m * 16; bf16_t* rowp = O + (size_t)row * INW + col0;
                f32x4 c4[2] = {{1.f, 1.f, 1.f, 1.f}, {1.f, 1.f, 1.f, 1.f}}, s4[2] = {{0.f, 0.f, 0.f, 0.f}, {0.f, 0.f, 0.f, 0.f}};
                if (dorope) { const float* rp = rope + (size_t)(row & (SEQ - 1)) * 16; c4[0] = *(const f32x4*)(rp); c4[1] = *(const f32x4*)(rp + 4); s4[0] = *(const f32x4*)(rp + 8); s4[1] = *(const f32x4*)(rp + 12); }
#pragma unroll
                for (int bj = 0; bj < 2; ++bj) { f32x4 v0 = acc[ai][bj][m][0], v1 = acc[ai][bj][m][1];
                    if (dorope) { f32x4 o0, o1;
#pragma unroll
                        for (int j = 0; j < 4; ++j) { o0[j] = __shfl_xor(v0[j], 16); o1[j] = __shfl_xor(v1[j], 16); }
                        if (fq == 0) { v0 = v0 * c4[0] - o0 * s4[0]; v1 = v1 * c4[1] - o1 * s4[1]; }
                        else if (fq == 1) { v0 = v0 * c4[0] + o0 * s4[0]; v1 = v1 * c4[1] + o1 * s4[1]; } }
                    v0 = v0 * sc; v1 = v1 * sc; u32x4 w; w.x = cvt_pk_bf16(v0[0], v0[1]); w.y = cvt_pk_bf16(v0[2], v0[3]); w.z = cvt_pk_bf16(v1[0], v1[1]); w.w = cvt_pk_bf16(v1[2], v1[3]);
                    *(u32x4*)(rowp + bj * HALF) = w; } }
    }
};
struct EpiGate2 {
    static constexpr bool PERM = true, AFTER_DRAIN = false, MID = true;
    const bf16_t* proj; bf16_t* O;
    __device__ __forceinline__ void mid(f32x4 (&acc)[2][2][4][2], const Unit& u, int wr, int wc, int fr, int fq) const {
        int row0 = u.pm * BM + wr * 64 + fr, col0 = u.pn * BM + wc * 32 + 8 * fq;
        asm volatile("" : "+v"(row0), "+v"(col0));
#pragma unroll
        for (int ai = 0; ai < 2; ++ai) {
            u32x4 gav[4][2], gbv[4][2];
#pragma unroll
            for (int m = 0; m < 4; ++m)
#pragma unroll
                for (int bj = 0; bj < 2; ++bj) { const bf16_t* gp = proj + (size_t)(row0 + ai * HALF + m * 16) * INW + col0 + bj * HALF; gav[m][bj] = *(const u32x4*)(gp + C_GA); gbv[m][bj] = *(const u32x4*)(gp + C_GB); }
#pragma unroll
            for (int m = 0; m < 4; ++m) {
#pragma unroll
                for (int bj = 0; bj < 2; ++bj) { const u32x4 ga = gav[m][bj], gb = gbv[m][bj];
                    const unsigned a_[4] = {ga.x, ga.y, ga.z, ga.w}, b_[4] = {gb.x, gb.y, gb.z, gb.w};
#pragma unroll
                    for (int q = 0; q < 4; ++q) {
                        const float r0 = (1.f + __builtin_amdgcn_exp2f(-1.4426950408889634f * bflo(b_[q]))) * __builtin_amdgcn_rcpf(1.f + __builtin_amdgcn_exp2f(-1.4426950408889634f * bflo(a_[q])));
                        const float r1 = (1.f + __builtin_amdgcn_exp2f(-1.4426950408889634f * bfhi(b_[q]))) * __builtin_amdgcn_rcpf(1.f + __builtin_amdgcn_exp2f(-1.4426950408889634f * bfhi(a_[q])));
                        acc[ai][bj][m][q >> 1][(q & 1) * 2] *= r0; acc[ai][bj][m][q >> 1][(q & 1) * 2 + 1] *= r1; } } }
            asm volatile("" ::: "memory"); }
    }
    __device__ __forceinline__ void operator()(const f32x4 (&acc)[2][2][4][2], const Unit& u, int wr, int wc, int fr_, int fq_) const {
        int fr = fr_, fq = fq_; asm volatile("" : "+v"(fr), "+v"(fq));
        const int row0 = u.pm * BM + wr * 64 + fr, col0 = u.pn * BM + wc * 32 + 8 * fq;
#pragma unroll
        for (int ai = 0; ai < 2; ++ai) {
            u32x4 gv[4][2];
#pragma unroll
            for (int m = 0; m < 4; ++m)
#pragma unroll
                for (int bj = 0; bj < 2; ++bj) gv[m][bj] = *(const u32x4*)(proj + (size_t)(row0 + ai * HALF + m * 16) * INW + C_GB + col0 + bj * HALF);
#pragma unroll
            for (int m = 0; m < 4; ++m) { const int row = row0 + ai * HALF + m * 16;
#pragma unroll
                for (int bj = 0; bj < 2; ++bj) { const int col = col0 + bj * HALF; const u32x4 g = gv[m][bj];
                    f32x4 v0 = acc[ai][bj][m][0], v1 = acc[ai][bj][m][1];
                    v0[0] *= sigm(bflo(g.x)); v0[1] *= sigm(bfhi(g.x)); v0[2] *= sigm(bflo(g.y)); v0[3] *= sigm(bfhi(g.y));
                    v1[0] *= sigm(bflo(g.z)); v1[1] *= sigm(bfhi(g.z)); v1[2] *= sigm(bflo(g.w)); v1[3] *= sigm(bfhi(g.w));
                    u32x4 w; w.x = cvt_pk_bf16(v0[0], v0[1]); w.y = cvt_pk_bf16(v0[2], v0[3]); w.z = cvt_pk_bf16(v1[0], v1[1]); w.w = cvt_pk_bf16(v1[2], v1[3]);
                    *(u32x4*)(O + (size_t)row * D + col) = w; } }
            asm volatile("" ::: "memory"); }
    }
};
struct EpiHout {
    static constexpr bool PERM = true, AFTER_DRAIN = false, MID = false;
    const float* x; float* H; bf16_t* HB; float* ssq16;
    __device__ __forceinline__ void operator()(const f32x4 (&acc)[2][2][4][2], const Unit& u, int wr, int wc, int fr_, int fq_) const {
        int fr = fr_, fq = fq_; asm volatile("" : "+v"(fr), "+v"(fq));
        const int row0 = u.pm * BM + wr * 64 + fr, col0 = u.pn * BM + wc * 32 + 8 * fq;
#pragma unroll
        for (int ai = 0; ai < 2; ++ai) {
            f32x4 xv[4][2][2];
#pragma unroll
            for (int m = 0; m < 4; ++m)
#pragma unroll
                for (int bj = 0; bj < 2; ++bj) { const float* xp = x + (size_t)(row0 + ai * HALF + m * 16) * D + col0 + bj * HALF; xv[m][bj][0] = *(const f32x4*)xp; xv[m][bj][1] = *(const f32x4*)(xp + 4); }
#pragma unroll
            for (int m = 0; m < 4; ++m) { const int row = row0 + ai * HALF + m * 16; float ss = 0.f;
#pragma unroll
                for (int bj = 0; bj < 2; ++bj) { const int col = col0 + bj * HALF;
                    const f32x4 v0 = acc[ai][bj][m][0] + xv[m][bj][0], v1 = acc[ai][bj][m][1] + xv[m][bj][1];
                    u32x4 w; w.x = cvt_pk_bf16(v0[0], v0[1]); w.y = cvt_pk_bf16(v0[2], v0[3]); w.z = cvt_pk_bf16(v1[0], v1[1]); w.w = cvt_pk_bf16(v1[2], v1[3]);
                    *(u32x4*)(HB + (size_t)row * D + col) = w;
                    ss += (v0[0] * v0[0] + v0[1] * v0[1]) + (v0[2] * v0[2] + v0[3] * v0[3]) + (v1[0] * v1[0] + v1[1] * v1[1]) + (v1[2] * v1[2] + v1[3] * v1[3]); }
                ss += __shfl_xor(ss, 16); ss += __shfl_xor(ss, 32);
                if (fq == 0) ssq16[(size_t)row * 16 + u.pn * 4 + wc] = ss; }
            asm volatile("" ::: "memory"); }
    }
};
struct EpiQ {
    static constexpr bool PERM = true, AFTER_DRAIN = false, MID = false;
    const float* ssq16; bf16_t* O;
    __device__ __forceinline__ void operator()(const f32x4 (&acc)[2][2][4][2], const Unit& u, int wr, int wc, int fr, int fq) const {
        const int row0 = u.pm * BM + wr * 64 + fr, col0 = u.pn * BM + wc * 32 + 8 * fq;
#pragma unroll
        for (int ai = 0; ai < 2; ++ai)
#pragma unroll
            for (int m = 0; m < 4; ++m) { const int row = row0 + ai * HALF + m * 16; const f32x4* sp = (const f32x4*)(ssq16 + (size_t)row * 16);
                const f32x4 a = sp[0], b = sp[1], c = sp[2], d = sp[3];
                const float tot = ((a[0] + a[1]) + (a[2] + a[3])) + ((b[0] + b[1]) + (b[2] + b[3])) + ((c[0] + c[1]) + (c[2] + c[3])) + ((d[0] + d[1]) + (d[2] + d[3]));
                const float rstd = 1.f / sqrtf(tot * (1.f / D) + EPS);
#pragma unroll
                for (int bj = 0; bj < 2; ++bj) { const f32x4 v0 = acc[ai][bj][m][0] * rstd, v1 = acc[ai][bj][m][1] * rstd;
                    u32x4 w; w.x = cvt_pk_bf16(v0[0], v0[1]); w.y = cvt_pk_bf16(v0[2], v0[3]); w.z = cvt_pk_bf16(v1[0], v1[1]); w.w = cvt_pk_bf16(v1[2], v1[3]);
                    *(u32x4*)(O + (size_t)row * PQ + col0 + bj * HALF) = w; } }
    }
};
template <class Epi, class Sched, bool ALIGN_EPI = false, bool SP2 = false, bool FP8 = false>
__device__ __forceinline__ void gemm_phase(PG8_LAS unsigned char* lds, const Gemm g, const Sched& S, const Epi& E) {
    int tid_l = threadIdx.x; asm volatile("" : "+v"(tid_l));
    const int tid = tid_l, wid = __builtin_amdgcn_readfirstlane(tid >> 6), lane = tid & 63, wr = wid >> 2, wc = wid & 3, fr = lane & 15, fq = lane >> 4;
    const int K = g.K, nt = K / BK;
    unsigned voffA[2], voffB[2];
#pragma unroll
    for (int i = 0; i < 2; ++i) { int R, C; stage_rc(tid * 16 + i * 8192, R, C); const int Rb = Epi::PERM ? ((R & ~31) + perm32(R & 31)) : R;
        voffA[i] = (unsigned)(R * K + C) * 2u; voffB[i] = (unsigned)(Rb * K + C) * 2u; }
    const size_t kstep = (size_t)(BK * 2);
    const size_t hstep = (size_t)HALF * K * 2;
    const size_t tstep = 2 * hstep;
    const unsigned ldsw = (unsigned)wid * 1024u;
    const int aoff = lds_byte(wr * 64 + fr, fq * 8), boff = lds_byte(wc * 32 + fr, fq * 8);
    const int aoffF0 = FP8 ? lds_byte(wr * 64 + fr, fq * 16) : 0, boffF0 = FP8 ? lds_byte(wc * 32 + fr, fq * 16) : 0;
#define PG8_SA(b, h) (((b) * 2 + (h)) * HTB)
#define PG8_SB(b, h) ((4 + (b) * 2 + (h)) * HTB)
#define PG8_STAGE(bufoff, gbase, voff) do { _Pragma("unroll") for (int _i = 0; _i < 2; ++_i) \
        __builtin_amdgcn_global_load_lds((const unsigned*)((const char*)(gbase) + (voff)[_i]), (PG8_LAS unsigned*)(lds + (bufoff) + ldsw + _i * 8192), 16, 0, 0); } while (0)
#define PG8_LDA(dst, b, h) do { if constexpr (FP8) { _Pragma("unroll") for (int m = 0; m < 4; ++m) { const u32x4 l_ = *(const PG8_LAS u32x4*)(lds + PG8_SA(b, h) + aoffF0 + m * 2048), h_ = *(const PG8_LAS u32x4*)(lds + PG8_SA(b, h) + aoffF0 + m * 2048 + 16); \
            dst##8[m] = (v8i_t){(int)l_.x, (int)l_.y, (int)l_.z, (int)l_.w, (int)h_.x, (int)h_.y, (int)h_.z, (int)h_.w}; } } \
        else { _Pragma("unroll") for (int m = 0; m < 4; ++m) _Pragma("unroll") for (int k = 0; k < 2; ++k) dst[m][k] = *(const PG8_LAS bf16x8*)(lds + PG8_SA(b, h) + aoff + m * 2048 + k * 1024); } } while (0)
#define PG8_LDB(dst, b, h) do { if constexpr (FP8) { _Pragma("unroll") for (int n = 0; n < 2; ++n) { const u32x4 l_ = *(const PG8_LAS u32x4*)(lds + PG8_SB(b, h) + boffF0 + n * 2048), h_ = *(const PG8_LAS u32x4*)(lds + PG8_SB(b, h) + boffF0 + n * 2048 + 16); \
            dst##8[n] = (v8i_t){(int)l_.x, (int)l_.y, (int)l_.z, (int)l_.w, (int)h_.x, (int)h_.y, (int)h_.z, (int)h_.w}; } } \
        else { _Pragma("unroll") for (int n = 0; n < 2; ++n) _Pragma("unroll") for (int k = 0; k < 2; ++k) dst[n][k] = *(const PG8_LAS bf16x8*)(lds + PG8_SB(b, h) + boff + n * 2048 + k * 1024); } } while (0)
#define PG8_MMA(ai, bj, At, Bt) do { __builtin_amdgcn_s_setprio(1); \
        if constexpr (FP8) { _Pragma("unroll") for (int m = 0; m < 4; ++m) _Pragma("unroll") for (int n = 0; n < 2; ++n) \
            asm volatile("v_mfma_scale_f32_16x16x128_f8f6f4 %0, %1, %2, %0, %3, %3 op_sel_hi:[0,0,0]" : "+v"(acc[ai][bj][m][n]) : "v"(Bt##8[n]), "v"(At##8[m]), "v"(mxone)); } \
        else { _Pragma("unroll") for (int m = 0; m < 4; ++m) _Pragma("unroll") for (int n = 0; n < 2; ++n) _Pragma("unroll") for (int k = 0; k < 2; ++k) \
            acc[ai][bj][m][n] = __builtin_amdgcn_mfma_f32_16x16x32_bf16(Bt[n][k], At[m][k], acc[ai][bj][m][n], 0, 0, 0); } \
        __builtin_amdgcn_s_setprio(0); } while (0)
#define PG8_WAIT_V(n) asm volatile("s_waitcnt vmcnt(" #n ")" ::: "memory")
#define PG8_WAIT_L(n) asm volatile("s_waitcnt lgkmcnt(" #n ")" ::: "memory")
#define PG8_BAR __builtin_amdgcn_s_barrier()
#define PG8_SCHED __builtin_amdgcn_sched_barrier(0)
    Unit cur, nxt; int ui = 0;
    if (!S.next(0, cur)) return;
    f32x4 acc[2][2][4][2];
#pragma unroll
    for (int a = 0; a < 2; ++a)
#pragma unroll
        for (int b = 0; b < 2; ++b)
#pragma unroll
            for (int m = 0; m < 4; ++m)
#pragma unroll
                for (int n = 0; n < 2; ++n) acc[a][b][m][n] = (f32x4){0.f, 0.f, 0.f, 0.f};
    bf16x8 At[4][2], B0[2][2], B1[2][2]; v8i_t At8[4], B08[2], B18[2];
    int mxone = 0x7F7F7F7F; asm volatile("" : "+v"(mxone));
    const char* cA = (const char*)g.A + (size_t)cur.pm * tstep; const char* cB = (const char*)g.Bt + (size_t)cur.pn * tstep;
    S.a_ready(cur);
    if constexpr (SP2) {
        PG8_STAGE(PG8_SB(0, 0), cB, voffB); PG8_STAGE(PG8_SB(0, 1), cB + hstep, voffB); PG8_STAGE(PG8_SA(0, 0), cA, voffA); PG8_STAGE(PG8_SA(0, 1), cA + hstep, voffA);
        if (wr == 1) PG8_BAR;
        PG8_WAIT_V(2); PG8_BAR;
        PG8_STAGE(PG8_SB(1, 0), cB + kstep, voffB); PG8_STAGE(PG8_SA(1, 0), cA + kstep, voffA); PG8_STAGE(PG8_SB(1, 1), cB + hstep + kstep, voffB);
        PG8_WAIT_V(6); PG8_BAR;
    } else {
        PG8_STAGE(PG8_SB(0, 0), cB, voffB); PG8_STAGE(PG8_SA(0, 0), cA, voffA); PG8_STAGE(PG8_SB(0, 1), cB + hstep, voffB); PG8_STAGE(PG8_SA(0, 1), cA + hstep, voffA);
        if (wr == 1) PG8_BAR;
        PG8_WAIT_V(4); PG8_BAR;
        PG8_STAGE(PG8_SB(1, 0), cB + kstep, voffB); PG8_STAGE(PG8_SA(1, 0), cA + kstep, voffA); PG8_STAGE(PG8_SB(1, 1), cB + hstep + kstep, voffB);
        PG8_WAIT_V(6); PG8_BAR;
    }
    for (;;) {
        const bool has_next = S.next(ui + 1, nxt);
        const char* nA = has_next ? (const char*)g.A + (size_t)nxt.pm * tstep : cA; const char* nB = has_next ? (const char*)g.Bt + (size_t)nxt.pn * tstep : cB;
#pragma unroll 1
        for (int t = 0; t < nt; t += 2) {
            if constexpr (Epi::MID) { if (t == nt / 2) E.mid(acc, cur, wr, wc, fr, fq); }
            const bool last = (t == nt - 2);
            const char* a1 = cA + (size_t)(t + 1) * kstep;
            const char* a2 = last ? nA : cA + (size_t)(t + 2) * kstep; const char* b2 = last ? nB : cB + (size_t)(t + 2) * kstep;
            const char* a3 = a2 + kstep; const char* b3 = b2 + kstep;
            if (last && has_next) S.a_ready(nxt);
            if constexpr (SP2) {
            PG8_LDB(B0, 0, 0); PG8_LDB(B1, 0, 1); PG8_SCHED; PG8_LDA(At, 0, 0); PG8_STAGE(PG8_SA(1, 1), a1 + hstep, voffA);
            PG8_WAIT_V(8); PG8_WAIT_L(0); PG8_BAR; PG8_MMA(0, 0, At, B0); PG8_MMA(0, 1, At, B1); PG8_BAR; PG8_SCHED;
            PG8_LDA(At, 0, 1); PG8_STAGE(PG8_SB(0, 0), b2, voffB); PG8_STAGE(PG8_SB(0, 1), b2 + hstep, voffB); PG8_STAGE(PG8_SA(0, 0), a2, voffA);
            PG8_WAIT_V(8); PG8_WAIT_L(0); PG8_BAR; PG8_MMA(1, 0, At, B0); PG8_MMA(1, 1, At, B1); PG8_BAR; PG8_SCHED;
            PG8_LDB(B0, 1, 0); PG8_LDB(B1, 1, 1); PG8_SCHED; PG8_LDA(At, 1, 0); PG8_STAGE(PG8_SA(0, 1), a2 + hstep, voffA);
            PG8_WAIT_V(8); PG8_WAIT_L(0); PG8_BAR; PG8_MMA(0, 0, At, B0); PG8_MMA(0, 1, At, B1); PG8_BAR; PG8_SCHED;
            PG8_LDA(At, 1, 1); PG8_STAGE(PG8_SB(1, 0), b3, voffB); PG8_STAGE(PG8_SB(1, 1), b3 + hstep, voffB); PG8_STAGE(PG8_SA(1, 0), a3, voffA);
            PG8_WAIT_V(8); PG8_WAIT_L(0); PG8_BAR; PG8_MMA(1, 0, At, B0); PG8_MMA(1, 1, At, B1); PG8_BAR; PG8_SCHED;
            } else {
            PG8_LDB(B0, 0, 0); PG8_SCHED; PG8_LDA(At, 0, 0); PG8_STAGE(PG8_SA(1, 1), a1 + hstep, voffA);
            PG8_WAIT_L(8); PG8_BAR; PG8_WAIT_L(0); PG8_MMA(0, 0, At, B0); PG8_BAR; PG8_SCHED;
            PG8_LDB(B1, 0, 1); PG8_STAGE(PG8_SB(0, 0), b2, voffB);
            PG8_BAR; PG8_WAIT_L(0); PG8_MMA(0, 1, At, B1); PG8_BAR;
            PG8_LDA(At, 0, 1); PG8_STAGE(PG8_SA(0, 0), a2, voffA);
            PG8_BAR; PG8_WAIT_L(0); PG8_MMA(1, 0, At, B0); PG8_BAR; PG8_SCHED;
            PG8_STAGE(PG8_SB(0, 1), b2 + hstep, voffB);
            PG8_WAIT_V(6); PG8_BAR; PG8_MMA(1, 1, At, B1); PG8_BAR;
            PG8_LDB(B0, 1, 0); PG8_SCHED; PG8_LDA(At, 1, 0); PG8_STAGE(PG8_SA(0, 1), a2 + hstep, voffA);
            PG8_WAIT_L(8); PG8_BAR; PG8_WAIT_L(0); PG8_MMA(0, 0, At, B0); PG8_BAR; PG8_SCHED;
            PG8_LDB(B1, 1, 1); PG8_STAGE(PG8_SB(1, 0), b3, voffB);
            PG8_BAR; PG8_WAIT_L(0); PG8_MMA(0, 1, At, B1); PG8_BAR;
            PG8_LDA(At, 1, 1); PG8_STAGE(PG8_SA(1, 0), a3, voffA);
            PG8_BAR; PG8_WAIT_L(0); PG8_MMA(1, 0, At, B0); PG8_BAR; PG8_SCHED;
            PG8_STAGE(PG8_SB(1, 1), b3 + hstep, voffB);
            PG8_WAIT_V(6); PG8_BAR; PG8_MMA(1, 1, At, B1); PG8_BAR;
            }
        }
        if constexpr (ALIGN_EPI) { if (wr == 0) PG8_BAR; }
        if constexpr (FP8) { asm volatile("s_nop 15\n\ts_nop 7" ::: "memory"); PG8_SCHED; }
        if constexpr (!Epi::AFTER_DRAIN) { E(acc, cur, wr, wc, fr, fq); S.done(cur); }
        if (!has_next) break;
#pragma unroll
        for (int a = 0; a < 2; ++a)
#pragma unroll
            for (int b = 0; b < 2; ++b)
#pragma unroll
                for (int m = 0; m < 4; ++m)
#pragma unroll
                    for (int n = 0; n < 2; ++n) acc[a][b][m][n] = (f32x4){0.f, 0.f, 0.f, 0.f};
        cur = nxt; cA = nA; cB = nB; ++ui;
        if constexpr (ALIGN_EPI) { if (wr == 1) PG8_BAR; }
    }
    PG8_WAIT_V(0);
    if constexpr (!ALIGN_EPI) { if (wr == 0) PG8_BAR; }
    PG8_BAR;
    if constexpr (Epi::AFTER_DRAIN) { E.fused(acc, cur, wr, wc, fr, fq, lds, wid, lane); S.done(cur); }
#undef PG8_SA
#undef PG8_SB
#undef PG8_STAGE
#undef PG8_LDA
#undef PG8_LDB
#undef PG8_MMA
#undef PG8_WAIT_V
#undef PG8_WAIT_L
#undef PG8_BAR
#undef PG8_SCHED
}
}

__device__ __forceinline__ float lambda_full(const Ptrs& P) {
    float a = 0.f, b = 0.f;
    for (int i = 0; i < 64; ++i) { a += P.lq1[i] * P.lk1[i]; b += P.lq2[i] * P.lk2[i]; }
    return __expf(a) - __expf(b) + 0.2f;
}

namespace att {
typedef short bf16x8 __attribute__((ext_vector_type(8)));
typedef short s16x4 __attribute__((ext_vector_type(4)));
typedef float f32x16 __attribute__((ext_vector_type(16)));
typedef float f32x2_t __attribute__((ext_vector_type(2)));
typedef __attribute__((address_space(3))) const char* lds_cptr;
typedef __attribute__((address_space(3))) char* lds_ptr;
__device__ __forceinline__ int crow(int r, int hi) { return (r & 3) + 8 * (r >> 2) + 4 * hi; }
__device__ __forceinline__ void glds16(const void* gsrc, unsigned lds_dst) { unsigned keep;
    asm volatile("s_mov_b32 %0, m0\n\ts_mov_b32 m0, %2\n\ts_nop 0\n\tglobal_load_lds_dwordx4 %1, off\n\ts_mov_b32 m0, %0" : "=&s"(keep) : "v"(gsrc), "s"(lds_dst) : "memory"); }
__device__ __forceinline__ unsigned cvtpk(float lo, float hi) { f32x2_t v = {lo, hi}; bf16x2_t b = __builtin_convertvector(v, bf16x2_t); return __builtin_bit_cast(unsigned, b); }
#define ATT_WAIT_BAR(N) asm volatile("s_waitcnt vmcnt(" #N ") lgkmcnt(0)\n\ts_barrier" ::: "memory")
#define ATT_LDSWAIT() asm volatile("s_waitcnt lgkmcnt(0)" ::: "memory")
#define ATT_SBAR() __builtin_amdgcn_sched_barrier(0)
template <bool REL> __device__ __forceinline__ void qkt(f32x16& p0, f32x16& p1, lds_cptr Kslot, const bf16x8* qr, const f32x16& negm, int r32, int hi) {
    lds_cptr kb = Kslot + hi * 1024 + r32 * 16;
#pragma unroll
    for (int d0 = 0; d0 < 4; ++d0) {
        const bf16x8 b0 = *(const __attribute__((address_space(3))) bf16x8*)(kb + d0 * 2048);
        const bf16x8 b1 = *(const __attribute__((address_space(3))) bf16x8*)(kb + d0 * 2048 + 512);
        if (d0 == 0) { if (REL) { p0 = __builtin_amdgcn_mfma_f32_32x32x16_bf16(b0, qr[0], negm, 0, 0, 0); p1 = __builtin_amdgcn_mfma_f32_32x32x16_bf16(b1, qr[0], negm, 0, 0, 0); }
                       else { p0 = __builtin_amdgcn_mfma_f32_32x32x16_bf16(b0, qr[0], f32x16{}, 0, 0, 0); p1 = __builtin_amdgcn_mfma_f32_32x32x16_bf16(b1, qr[0], f32x16{}, 0, 0, 0); } }
        else { p0 = __builtin_amdgcn_mfma_f32_32x32x16_bf16(b0, qr[d0], p0, 0, 0, 0); p1 = __builtin_amdgcn_mfma_f32_32x32x16_bf16(b1, qr[d0], p1, 0, 0, 0); } }
}
__device__ __forceinline__ float rowmax32(const f32x16& p0, const f32x16& p1) {
    float a = fmaxf(p0[0], p1[0]);
#pragma unroll
    for (int r = 1; r < 16; ++r) a = fmaxf(a, fmaxf(p0[r], p1[r]));
    auto rr = __builtin_amdgcn_permlane32_swap(__float_as_uint(a), __float_as_uint(a), false, false);
    return fmaxf(__uint_as_float(rr[0]), __uint_as_float(rr[1]));
}
__device__ __forceinline__ float halfsum(float a) { auto rr = __builtin_amdgcn_permlane32_swap(__float_as_uint(a), __float_as_uint(a), false, false); return __uint_as_float(rr[0]) + __uint_as_float(rr[1]); }
#define ATT_VREAD(lo, hi, d0) do { _Pragma("unroll") for (int ks = 0; ks < 4; ++ks) { \
        asm volatile("ds_read_b64_tr_b16 %0,%1 offset:%c2" : "=&v"(lo[ks]) : "v"(vb), "i"((d0) * 4096 + ks * 1024) : "memory"); \
        asm volatile("ds_read_b64_tr_b16 %0,%1 offset:%c2" : "=&v"(hi[ks]) : "v"(vb), "i"((d0) * 4096 + ks * 1024 + 512) : "memory"); } } while (0)
#define ATT_PK(lo, hi, k) (bf16x8){lo[k][0], lo[k][1], lo[k][2], lo[k][3], hi[k][0], hi[k][1], hi[k][2], hi[k][3]}
#define ATT_PVMMA(lo, hi, d0) do { \
        o[d0] = __builtin_amdgcn_mfma_f32_32x32x16_bf16(pa0, ATT_PK(lo, hi, 0), o[d0], 0, 0, 0); o[d0] = __builtin_amdgcn_mfma_f32_32x32x16_bf16(pa1, ATT_PK(lo, hi, 1), o[d0], 0, 0, 0); \
        o[d0] = __builtin_amdgcn_mfma_f32_32x32x16_bf16(pa2, ATT_PK(lo, hi, 2), o[d0], 0, 0, 0); o[d0] = __builtin_amdgcn_mfma_f32_32x32x16_bf16(pa3, ATT_PK(lo, hi, 3), o[d0], 0, 0, 0); } while (0)
template <int ND0> __device__ __forceinline__ void pv(f32x16* o, int vb, bf16x8 pa0, bf16x8 pa1, bf16x8 pa2, bf16x8 pa3) {
    s16x4 loA[4], hiA[4], loB[4], hiB[4];
    ATT_VREAD(loA, hiA, 0);
#pragma unroll
    for (int d0 = 0; d0 < ND0; d0 += 2) {
        if (d0 + 1 < ND0) { ATT_VREAD(loB, hiB, d0 + 1); asm volatile("s_waitcnt lgkmcnt(8)" ::: "memory"); } else { asm volatile("s_waitcnt lgkmcnt(0)" ::: "memory"); }
        ATT_SBAR();
        ATT_PVMMA(loA, hiA, d0);
        if (d0 + 1 < ND0) {
            if (d0 + 2 < ND0) { ATT_VREAD(loA, hiA, d0 + 2); asm volatile("s_waitcnt lgkmcnt(8)" ::: "memory"); } else { asm volatile("s_waitcnt lgkmcnt(0)" ::: "memory"); }
            ATT_SBAR();
            ATT_PVMMA(loB, hiB, d0 + 1);
        }
    }
}
#undef ATT_VREAD
#undef ATT_PVMMA
#undef ATT_PK
template <int DEAD> __device__ __forceinline__ constexpr bool live0(int r) { return DEAD != 2 || r >= 12; }
template <int DEAD> __device__ __forceinline__ constexpr bool live1(int r) { return DEAD != 1 || r < 4; }
template <int ND0, int THR, bool REL, int DEAD = 0> __device__ __forceinline__ void softmax_tile(f32x16& p0, f32x16& p1, float& mrun, float& lsum, f32x16& negm, bool first, f32x16* o, __attribute__((address_space(3))) float* wsf, int r32, int hi,
                                                                   u32x4& pw0, u32x4& pw1, u32x4& pw2, u32x4& pw3) {
    float rm;
    if (DEAD == 0) rm = rowmax32(p0, p1);
    else { float a = -3e38f;
#pragma unroll
        for (int r = 0; r < 16; ++r) { if (live0<DEAD>(r)) a = fmaxf(a, p0[r]); if (live1<DEAD>(r)) a = fmaxf(a, p1[r]); }
        auto rr = __builtin_amdgcn_permlane32_swap(__float_as_uint(a), __float_as_uint(a), false, false); rm = fmaxf(__uint_as_float(rr[0]), __uint_as_float(rr[1])); }
    if (!REL) rm -= mrun;
    if (first) {
        mrun = REL ? rm : mrun + rm;
        if (REL) {
#pragma unroll
            for (int r = 0; r < 16; ++r) { if (live0<DEAD>(r)) p0[r] -= rm; if (live1<DEAD>(r)) p1[r] -= rm; negm[r] = -mrun; } }
    } else if (__any(rm > (float)THR)) {
        const float dl = fmaxf(rm, 0.f), alpha = __builtin_amdgcn_exp2f(-dl); lsum *= alpha; mrun += dl;
        if (REL) {
#pragma unroll
            for (int r = 0; r < 16; ++r) { if (live0<DEAD>(r)) p0[r] -= dl; if (live1<DEAD>(r)) p1[r] -= dl; negm[r] = -mrun; } }
        if (hi == 0) wsf[r32] = alpha;
        ATT_LDSWAIT();
#pragma unroll
        for (int g = 0; g < 4; ++g) { const f32x4 a4 = *(const __attribute__((address_space(3))) f32x4*)(wsf + 8 * g + 4 * hi);
#pragma unroll
            for (int d0 = 0; d0 < ND0; ++d0) { o[d0][4 * g + 0] *= a4[0]; o[d0][4 * g + 1] *= a4[1]; o[d0][4 * g + 2] *= a4[2]; o[d0][4 * g + 3] *= a4[3]; } }
        ATT_LDSWAIT();
    }
    float s = 0.f;
#pragma unroll
    for (int r = 0; r < 16; ++r) {
        if (live0<DEAD>(r)) { p0[r] = __builtin_amdgcn_exp2f(REL ? p0[r] : p0[r] - mrun); s += p0[r]; } else p0[r] = 0.f;
        if (live1<DEAD>(r)) { p1[r] = __builtin_amdgcn_exp2f(REL ? p1[r] : p1[r] - mrun); s += p1[r]; } else p1[r] = 0.f; }
    lsum += s;
    pw0 = (u32x4){cvtpk(p0[0], p0[1]), cvtpk(p0[2], p0[3]), cvtpk(p0[4], p0[5]), cvtpk(p0[6], p0[7])};
    pw1 = (u32x4){cvtpk(p0[8], p0[9]), cvtpk(p0[10], p0[11]), cvtpk(p0[12], p0[13]), cvtpk(p0[14], p0[15])};
    pw2 = (u32x4){cvtpk(p1[0], p1[1]), cvtpk(p1[2], p1[3]), cvtpk(p1[4], p1[5]), cvtpk(p1[6], p1[7])};
    pw3 = (u32x4){cvtpk(p1[8], p1[9]), cvtpk(p1[10], p1[11]), cvtpk(p1[12], p1[13]), cvtpk(p1[14], p1[15])};
}

constexpr int A_SLOTK = 8192, A_SLOTV = 16384, A_NS = 3, A_NSV = 4;
constexpr int A_LDS_K = 0, A_LDS_V = A_NS * A_SLOTK, A_LDS_WS = A_LDS_V + A_NSV * A_SLOTV, A_LDS_ST = A_LDS_WS + 8 * 256, A_LDS_BYTES = A_LDS_ST + 8 * 8192;
__device__ __forceinline__ void attn_a_unit(int b, int h, int qb, const bf16_t* proj, bf16_t* ya, const float* subln, float lam, unsigned char* shm) {
    int tid_l = threadIdx.x; asm volatile("" : "+v"(tid_l));
    const int tid = tid_l, lane = tid & 63, r32 = lane & 31, hi = lane >> 5; const int wid = __builtin_amdgcn_readfirstlane(tid >> 6);
    const size_t rowbase = (size_t)b * SEQ; const int q0 = qb * 256;
    constexpr int NT = SEQ / 64;
    const unsigned lds0 = (unsigned)(uintptr_t)shm;
    const lds_cptr shm3 = (lds_cptr)shm;
    __attribute__((address_space(3))) float* wsf = (__attribute__((address_space(3))) float*)((lds_ptr)shm + A_LDS_WS) + wid * 64;
    const int vb0 = (int)(lds0 + A_LDS_V) + ((lane >> 4) & 1) * 32 + (lane & 3) * 8 + (4 * hi + ((lane & 15) >> 2)) * 64;
    __attribute__((address_space(3))) bf16_t* stg = (__attribute__((address_space(3))) bf16_t*)((lds_ptr)shm + A_LDS_ST) + wid * 4096;
    for (int mp = 0; mp < 2; ++mp) {
        const bf16_t* Kh = proj + rowbase * INW + C_KA + h * 128 + mp * 64;
        const bf16_t* Vh = proj + rowbase * INW + C_VA + h * 128;
        const bf16_t* Qw = proj + (rowbase + q0 + wid * 32) * INW + C_QA + h * 128 + mp * 64;
        const int pA = 2 * wid, pB = 2 * wid + 1;
        const unsigned kdst = lds0 + A_LDS_K + wid * 1024, vdstA = lds0 + A_LDS_V + pA * 1024, vdstB = lds0 + A_LDS_V + pB * 1024;
#define A_DMA(t, slot, vsl) do { int ln_ = lane; asm volatile("" : "+v"(ln_)); \
        const bf16_t* ksrc_ = Kh + (size_t)((t) * 64 + ln_) * INW + wid * 8; \
        const bf16_t* vsrcA_ = Vh + (size_t)((t) * 64 + 16 * (pA & 3) + (ln_ >> 2)) * INW + (pA >> 2) * 32 + (ln_ & 3) * 8; \
        const bf16_t* vsrcB_ = Vh + (size_t)((t) * 64 + 16 * (pB & 3) + (ln_ >> 2)) * INW + (pB >> 2) * 32 + (ln_ & 3) * 8; \
        glds16(ksrc_, (unsigned)__builtin_amdgcn_readfirstlane(kdst + (slot) * A_SLOTK)); \
        glds16(vsrcA_, (unsigned)__builtin_amdgcn_readfirstlane(vdstA + (vsl) * A_SLOTV)); \
        glds16(vsrcB_, (unsigned)__builtin_amdgcn_readfirstlane(vdstB + (vsl) * A_SLOTV)); } while (0)
        A_DMA(0, 0, 0); A_DMA(1, 1, 1);
        bf16x8 qr[4];
#pragma unroll
        for (int d0 = 0; d0 < 4; ++d0) qr[d0] = *(const bf16x8*)(Qw + (size_t)r32 * INW + d0 * 16 + hi * 8);
        f32x16 o[4]; o[0] = f32x16{}; o[1] = f32x16{}; o[2] = f32x16{}; o[3] = f32x16{};
        float mrun = 0.f, lsum = 0.f; f32x16 negm = f32x16{};
        int slot = 0, slot2 = 2, vslot = 0, vslot2 = 2, vprev = 3;
        const bool late = wid >= 4;
        u32x4 pw0 = {}, pw1 = {}, pw2 = {}, pw3 = {};
        for (int t = 0; t < NT; ++t) {
            if (t + 1 < NT) { ATT_WAIT_BAR(3); } else { ATT_WAIT_BAR(0); }
            if (t + 2 < NT) A_DMA(t + 2, slot2, vslot2);
            if (late && t > 0) pv<4>(o, vb0 + vprev * A_SLOTV, __builtin_bit_cast(bf16x8, pw0), __builtin_bit_cast(bf16x8, pw1), __builtin_bit_cast(bf16x8, pw2), __builtin_bit_cast(bf16x8, pw3));
            f32x16 p0, p1;
            qkt<false>(p0, p1, shm3 + A_LDS_K + slot * A_SLOTK, qr, negm, r32, hi);
            softmax_tile<4, 8, false>(p0, p1, mrun, lsum, negm, t == 0, o, wsf, r32, hi, pw0, pw1, pw2, pw3);
            if (!late) pv<4>(o, vb0 + vslot * A_SLOTV, __builtin_bit_cast(bf16x8, pw0), __builtin_bit_cast(bf16x8, pw1), __builtin_bit_cast(bf16x8, pw2), __builtin_bit_cast(bf16x8, pw3));
            slot = (slot == 2) ? 0 : slot + 1; slot2 = (slot2 == 2) ? 0 : slot2 + 1;
            vprev = vslot; vslot = (vslot + 1) & 3; vslot2 = (vslot2 + 1) & 3;
        }
        if (late) pv<4>(o, vb0 + vprev * A_SLOTV, __builtin_bit_cast(bf16x8, pw0), __builtin_bit_cast(bf16x8, pw1), __builtin_bit_cast(bf16x8, pw2), __builtin_bit_cast(bf16x8, pw3));
#undef A_DMA
        const float lt = halfsum(lsum);
        if (hi == 0) wsf[32 + r32] = lt;
        ATT_LDSWAIT();
        float rli[16];
#pragma unroll
        for (int g = 0; g < 4; ++g) { const f32x4 l4 = *(const __attribute__((address_space(3))) f32x4*)(wsf + 32 + 8 * g + 4 * hi);
            rli[4 * g + 0] = __builtin_amdgcn_rcpf(l4[0]); rli[4 * g + 1] = __builtin_amdgcn_rcpf(l4[1]); rli[4 * g + 2] = __builtin_amdgcn_rcpf(l4[2]); rli[4 * g + 3] = __builtin_amdgcn_rcpf(l4[3]); }
        ATT_LDSWAIT();
        if (mp == 0) {
#pragma unroll
            for (int d0 = 0; d0 < 4; ++d0)
#pragma unroll
                for (int r = 0; r < 16; ++r) stg[crow(r, hi) * 128 + d0 * 32 + r32] = (bf16_t)f2bf(o[d0][r] * rli[r]);
            asm volatile("s_waitcnt lgkmcnt(0)\n\ts_barrier" ::: "memory");
        } else {
            float ss[16];
#pragma unroll
            for (int r = 0; r < 16; ++r) ss[r] = 0.f;
#pragma unroll
            for (int d0 = 0; d0 < 4; ++d0)
#pragma unroll
                for (int r = 0; r < 16; ++r) { const float a = bf2f(stg[crow(r, hi) * 128 + d0 * 32 + r32]); const float y = a - lam * o[d0][r] * rli[r]; o[d0][r] = y; ss[r] += y * y; }
#pragma unroll
            for (int r = 0; r < 16; ++r) { float v = ss[r]; v += __shfl_xor(v, 1); v += __shfl_xor(v, 2); v += __shfl_xor(v, 4); v += __shfl_xor(v, 8); v += __shfl_xor(v, 16);
                ss[r] = 0.8f / sqrtf(v * (1.f / 128.f) + EPS); }
            ATT_LDSWAIT();
#pragma unroll
            for (int d0 = 0; d0 < 4; ++d0) { const float gsub = subln[d0 * 32 + r32];
#pragma unroll
                for (int r = 0; r < 16; ++r) stg[crow(r, hi) * 128 + d0 * 32 + r32] = (bf16_t)f2bf(o[d0][r] * ss[r] * gsub); }
            ATT_LDSWAIT();
            bf16_t* Yw = ya + (rowbase + q0 + wid * 32) * 1024 + h * 128;
#pragma unroll
            for (int i = 0; i < 8; ++i) { const int row = i * 4 + (lane >> 4), ch = lane & 15; const u32x4 v = *(const __attribute__((address_space(3))) u32x4*)(stg + row * 128 + ch * 8); *(u32x4*)(Yw + (size_t)row * 1024 + ch * 8) = v; }
            asm volatile("s_waitcnt lgkmcnt(0)\n\ts_barrier" ::: "memory");
        }
    }
}

template <int DEAD> __device__ __forceinline__ void na_tile(lds_cptr Kslot, int vb, const bf16x8* qr, const __attribute__((address_space(3))) float* bp, const float (&fm0)[16], const float (&fm1)[16],
                                                        float& mrun, float& lsum, f32x16& negm, bool first, f32x16* o, __attribute__((address_space(3))) float* wsf, int r32, int hi) {
    f32x16 p0, p1; u32x4 pw0, pw1, pw2, pw3;
    qkt<true>(p0, p1, Kslot, qr, negm, r32, hi);
#pragma unroll
    for (int rr = 0; rr < 16; ++rr) { const int jj = (rr & 3) + 8 * (rr >> 2);
        if (live0<DEAD>(rr)) p0[rr] += bp[jj] + fm0[rr];
        if (live1<DEAD>(rr)) p1[rr] += bp[jj + 32] + fm1[rr]; }
    softmax_tile<2, 8, true, DEAD>(p0, p1, mrun, lsum, negm, first, o, wsf, r32, hi, pw0, pw1, pw2, pw3);
    pv<2>(o, vb, __builtin_bit_cast(bf16x8, pw0), __builtin_bit_cast(bf16x8, pw1), __builtin_bit_cast(bf16x8, pw2), __builtin_bit_cast(bf16x8, pw3));
}
constexpr int B_SLOT = 8192, B_NS = 6, B_PF = 5;
constexpr int B_LDS_K = 0, B_LDS_V = B_NS * B_SLOT, B_LDS_WS = 2 * B_NS * B_SLOT, B_LDS_BIAS = B_LDS_WS + 8 * 256, B_LDS_ST = B_LDS_BIAS + 2560, B_LDS_BYTES = B_LDS_ST + 8 * 4096;
__device__ __forceinline__ void attn_b_unit(int b, int h, int rg, const bf16_t* proj, bf16_t* yb, const float* rpb, unsigned char* shm) {
    int tid_l = threadIdx.x; asm volatile("" : "+v"(tid_l));
    const int tid = tid_l, lane = tid & 63, r32 = lane & 31, hi = lane >> 5; const int wid = __builtin_amdgcn_readfirstlane(tid >> 6);
    const size_t rowbase = (size_t)b * SEQ;
    const int r = 4 * rg + (wid >> 1), c0 = 32 * (wid & 1);
    int rs = r - 4; rs = rs < 0 ? 0 : (rs > 24 ? 24 : rs);
    int rmin = 4 * rg - 4; rmin = rmin < 0 ? 0 : (rmin > 24 ? 24 : rmin);
    int rmaxs = 4 * rg + 3 - 4; rmaxs = rmaxs < 0 ? 0 : (rmaxs > 24 ? 24 : rmaxs);
    const int ntile = rmaxs + 8 - rmin;
    const unsigned lds0 = (unsigned)(uintptr_t)shm;
    const lds_cptr shm3 = (lds_cptr)shm;
    __attribute__((address_space(3))) float* wsf = (__attribute__((address_space(3))) float*)((lds_ptr)shm + B_LDS_WS) + wid * 64;
    __attribute__((address_space(3))) float* bias = (__attribute__((address_space(3))) float*)((lds_ptr)shm + B_LDS_BIAS) + 64;
    __attribute__((address_space(3))) bf16_t* stg = (__attribute__((address_space(3))) bf16_t*)((lds_ptr)shm + B_LDS_ST) + wid * 2048;
    const int vb0 = (int)(lds0 + B_LDS_V) + ((lane >> 4) & 1) * 32 + (lane & 3) * 8 + (4 * hi + ((lane & 15) >> 2)) * 64;
    for (int i = tid; i < 640; i += 512) { const int e = i - 64, ri = e >> 5, cj = e & 31; bias[e] = (e >= 0 && e < 480 && cj < 31) ? rpb[(h * 15 + ri) * 31 + cj] * LOG2E : 0.f; }
    const bf16_t* Kh = proj + rowbase * INW + C_KB + h * 64;
    const bf16_t* Vh = proj + rowbase * INW + C_VB + h * 64;
    const bf16_t* Qw = proj + (rowbase + r * 64 + c0) * INW + C_QB + h * 64;
    const unsigned kdst = lds0 + B_LDS_K + wid * 1024, vdst = lds0 + B_LDS_V + wid * 1024;
#define B_DMA(t, slot) do { int ln_ = lane; asm volatile("" : "+v"(ln_)); \
    const bf16_t* ksrc_ = Kh + (size_t)((rmin + (t)) * 64 + ln_) * INW + wid * 8; \
    const bf16_t* vsrc_ = Vh + (size_t)((rmin + (t)) * 64 + 16 * (wid & 3) + (ln_ >> 2)) * INW + (wid >> 2) * 32 + (ln_ & 3) * 8; \
    glds16(ksrc_, (unsigned)__builtin_amdgcn_readfirstlane(kdst + (slot) * B_SLOT)); \
    glds16(vsrc_, (unsigned)__builtin_amdgcn_readfirstlane(vdst + (slot) * B_SLOT)); } while (0)
#pragma unroll
    for (int t = 0; t < 4; ++t) B_DMA(t, t);
    bf16x8 qr[4];
#pragma unroll
    for (int d0 = 0; d0 < 4; ++d0) qr[d0] = *(const bf16x8*)(Qw + (size_t)r32 * INW + d0 * 16 + hi * 8);
    f32x16 o[2]; o[0] = f32x16{}; o[1] = f32x16{};
    float mrun = 0.f, lsum = 0.f; f32x16 negm = f32x16{}; bool first = true;
    const int c = c0 + r32; int cs = c - 8; cs = cs < 0 ? 0 : (cs > 48 ? 48 : cs);
    float fm0[16], fm1[16];
#pragma unroll
    for (int rr = 0; rr < 16; ++rr) { const int j0 = crow(rr, hi); fm0[rr] = ((unsigned)(j0 - cs) < 16u) ? 0.f : -1e30f; fm1[rr] = ((unsigned)(j0 + 32 - cs) < 16u) ? 0.f : -1e30f; }
    int slot = 0, slotn = 4;
#define B_TILE(tt, sl) do { const int kr = rmin + (tt); \
        if (kr >= rs && kr < rs + 8) {        \
            const __attribute__((address_space(3))) float* bp = bias + ((kr - r + 7) * 32 + 15 - c + 4 * hi);        \
            if (wid & 1) na_tile<2>(shm3 + B_LDS_K + (sl) * B_SLOT, vb0 + (sl) * B_SLOT, qr, bp, fm0, fm1, mrun, lsum, negm, first, o, wsf, r32, hi); \
            else         na_tile<1>(shm3 + B_LDS_K + (sl) * B_SLOT, vb0 + (sl) * B_SLOT, qr, bp, fm0, fm1, mrun, lsum, negm, first, o, wsf, r32, hi); \
            first = false; } } while (0)
    for (int t = 0; t < ntile; t += 2) {
        { const int rem = ntile - (t + 2);
          if (rem >= 2) { ATT_WAIT_BAR(4); } else if (rem == 1) { ATT_WAIT_BAR(2); } else { ATT_WAIT_BAR(0); } }
        const int slot1 = (slot == B_NS - 1) ? 0 : slot + 1, slotn1 = (slotn == B_NS - 1) ? 0 : slotn + 1;
        if (t + 4 < ntile) B_DMA(t + 4, slotn);
        if (t + 5 < ntile) B_DMA(t + 5, slotn1);
#pragma unroll 1
        for (int k2 = 0; k2 < 2; ++k2) { const int sl = k2 ? slot1 : slot; if (t + k2 < ntile) B_TILE(t + k2, sl); }
        slot = (slot1 == B_NS - 1) ? 0 : slot1 + 1; slotn = (slotn1 == B_NS - 1) ? 0 : slotn1 + 1;
    }
#undef B_TILE
#undef B_DMA
    const float lt = halfsum(lsum);
    if (hi == 0) wsf[32 + r32] = lt;
    ATT_LDSWAIT();
    float rli[16];
#pragma unroll
    for (int g = 0; g < 4; ++g) { const f32x4 l4 = *(const __attribute__((address_space(3))) f32x4*)(wsf + 32 + 8 * g + 4 * hi);
        rli[4 * g + 0] = __builtin_amdgcn_rcpf(l4[0]); rli[4 * g + 1] = __builtin_amdgcn_rcpf(l4[1]); rli[4 * g + 2] = __builtin_amdgcn_rcpf(l4[2]); rli[4 * g + 3] = __builtin_amdgcn_rcpf(l4[3]); }
#pragma unroll
    for (int d0 = 0; d0 < 2; ++d0)
#pragma unroll
        for (int rr = 0; rr < 16; ++rr) stg[crow(rr, hi) * 64 + d0 * 32 + r32] = (bf16_t)f2bf(o[d0][rr] * rli[rr]);
    ATT_LDSWAIT();
    bf16_t* Yw = yb + (rowbase + r * 64 + c0) * 1024 + 512 + h * 64;
#pragma unroll
    for (int i = 0; i < 4; ++i) { const int row = i * 8 + (lane >> 3), ch = lane & 7; const u32x4 v = *(const __attribute__((address_space(3))) u32x4*)(stg + row * 64 + ch * 8); *(u32x4*)(Yw + (size_t)row * 1024 + ch * 8) = v; }
    asm volatile("s_waitcnt lgkmcnt(0)\n\ts_barrier" ::: "memory");
}
}

namespace peer {
typedef short bf16x8 __attribute__((ext_vector_type(8)));
typedef float f32x16 __attribute__((ext_vector_type(16)));
typedef __attribute__((address_space(3))) const char* lds_cptr;
constexpr int T_LDS_SK = 0, T_LDS_BYTES = 65536;
__device__ __forceinline__ int imax(int a, int b) { int r; asm("v_max_f32 %0, %1, %2" : "=v"(r) : "v"(a), "v"(b)); return r; }
__device__ __forceinline__ int imin(int a, int b) { int r; asm("v_min_f32 %0, %1, %2" : "=v"(r) : "v"(a), "v"(b)); return r; }
__device__ __forceinline__ int f2key(float s, int idx) { return (__float_as_int(s) & ~127) | idx; }
__device__ __forceinline__ int key2bits(int k) { return k; }
template <int N, int OFF, int TOT> __device__ __forceinline__ void bsort_desc(int (&a)[TOT]) {
#pragma unroll
    for (int k = 2; k <= N; k <<= 1)
#pragma unroll
        for (int j = k >> 1; j > 0; j >>= 1)
#pragma unroll
            for (int i = 0; i < N; ++i) { const int l = i ^ j; if (l > i) { const bool desc = (i & k) == 0; const int hi_ = imax(a[OFF + i], a[OFF + l]), lo_ = imin(a[OFF + i], a[OFF + l]); a[OFF + i] = desc ? hi_ : lo_; a[OFF + l] = desc ? lo_ : hi_; } }
}
__device__ constexpr unsigned char NET16[126] = {0,1,2,3,0,2,1,3,1,2,4,5,6,7,4,6,5,7,5,6,0,4,2,6,2,4,1,5,3,7,3,5,1,2,3,4,5,6,8,9,10,11,8,10,9,11,9,10,12,13,14,15,12,14,13,15,13,14,8,12,10,14,10,12,9,13,11,15,11,13,9,10,11,12,13,14,0,8,4,12,4,8,2,10,6,14,6,10,2,4,6,8,10,12,1,9,5,13,5,9,3,11,7,15,7,11,3,5,7,9,11,13,1,2,3,4,5,6,7,8,9,10,11,12,13,14};
__device__ constexpr unsigned char NET32[382] = {0,1,2,3,0,2,1,3,1,2,4,5,6,7,4,6,5,7,5,6,0,4,2,6,2,4,1,5,3,7,3,5,1,2,3,4,5,6,8,9,10,11,8,10,9,11,9,10,12,13,14,15,12,14,13,15,13,14,8,12,10,14,10,12,9,13,11,15,11,13,9,10,11,12,13,14,0,8,4,12,4,8,2,10,6,14,6,10,2,4,6,8,10,12,1,9,5,13,5,9,3,11,7,15,7,11,3,5,7,9,11,13,1,2,3,4,5,6,7,8,9,10,11,12,13,14,16,17,18,19,16,18,17,19,17,18,20,21,22,23,20,22,21,23,21,22,16,20,18,22,18,20,17,21,19,23,19,21,17,18,19,20,21,22,24,25,26,27,24,26,25,27,25,26,28,29,30,31,28,30,29,31,29,30,24,28,26,30,26,28,25,29,27,31,27,29,25,26,27,28,29,30,16,24,20,28,20,24,18,26,22,30,22,26,18,20,22,24,26,28,17,25,21,29,21,25,19,27,23,31,23,27,19,21,23,25,27,29,17,18,19,20,21,22,23,24,25,26,27,28,29,30,0,16,8,24,8,16,4,20,12,28,12,20,4,8,12,16,20,24,2,18,10,26,10,18,6,22,14,30,14,22,6,10,14,18,22,26,2,4,6,8,10,12,14,16,18,20,22,24,26,28,1,17,9,25,9,17,5,21,13,29,13,21,5,9,13,17,21,25,3,19,11,27,11,19,7,23,15,31,15,23,7,11,15,19,23,27,3,5,7,9,11,13,15,17,19,21,23,25,27,29,1,2,3,4,5,6,7,8,9,10,11,12,13,14,15,16,17,18,19,20,21,22,23,24,25,26,27,28,29,30};
template <int OFF, int TOT> __device__ __forceinline__ void sort16_desc(int (&a)[TOT]) {
#pragma unroll
    for (int c = 0; c < 63; ++c) { const int i = OFF + NET16[2 * c], j = OFF + NET16[2 * c + 1]; const int hi_ = imax(a[i], a[j]), lo_ = imin(a[i], a[j]); a[i] = hi_; a[j] = lo_; }
}
template <int TOT> __device__ __forceinline__ void sort32_desc(int (&a)[TOT]) {
#pragma unroll
    for (int c = 0; c < 191; ++c) { const int i = NET32[2 * c], j = NET32[2 * c + 1]; const int hi_ = imax(a[i], a[j]), lo_ = imin(a[i], a[j]); a[i] = hi_; a[j] = lo_; }
}
template <int N, int OFF, int TOT> __device__ __forceinline__ void bmerge_desc(int (&a)[TOT]) {
#pragma unroll
    for (int j = N >> 1; j > 0; j >>= 1)
#pragma unroll
        for (int i = 0; i < N; ++i) { const int l = i ^ j; if (l > i) { const int hi_ = imax(a[OFF + i], a[OFF + l]), lo_ = imin(a[OFF + i], a[OFF + l]); a[OFF + i] = hi_; a[OFF + l] = lo_; } }
}
template <int A, int B, int TOT> __device__ __forceinline__ void merge_top16(int (&a)[TOT]) {
#pragma unroll
    for (int i = 0; i < 16; ++i) a[A + i] = imax(a[A + i], a[B + 15 - i]);
    bmerge_desc<16, A, TOT>(a);
}
__device__ __forceinline__ void cross_top16(int (&t)[16]) {
    int lo[16], hi[16];
#pragma unroll
    for (int i = 0; i < 16; ++i) { auto rr = __builtin_amdgcn_permlane32_swap((unsigned)t[i], (unsigned)t[i], false, false); lo[i] = (int)rr[0]; hi[i] = (int)rr[1]; }
#pragma unroll
    for (int i = 0; i < 16; ++i) t[i] = imax(lo[i], hi[15 - i]);
    bmerge_desc<16, 0, 16>(t);
}
struct RowStream {
    const float* pu; const float* pv; unsigned char* ws; int r, step, lane; f32x4 v0, v1, v2, v3;
    __device__ __forceinline__ void issue() {
        if (r < 2 * NEXP) { const float* src = (r < NEXP ? pu + (size_t)r * D : pv + (size_t)(r - NEXP) * D); const f32x4* s4 = (const f32x4*)src + lane * 4; v0 = s4[0]; v1 = s4[1]; v2 = s4[2]; v3 = s4[3]; } }
    __device__ __forceinline__ void finish() {
        if (r < 2 * NEXP) { const f32x4 cur[4] = {v0, v1, v2, v3};
            if (r < NEXP) cvt_row_i4(cur, ws + WS_U + (size_t)r * 256, (float*)(ws + WS_SU) + r, lane);
            else { const int e = r - NEXP; cvt_row_fp8(cur, ws + WS_V + (size_t)e * 512, (float*)(ws + WS_SV) + e, lane); }
            r += step; } }
    __device__ __forceinline__ void hook() { finish(); issue(); }
};
__device__ __forceinline__ void half_top16(int (&top)[16], const bf16_t* qrow  , lds_cptr skp  , int hi, RowStream& RS) {
    f32x16 sc[4]; sc[0] = f32x16{}; sc[1] = f32x16{}; sc[2] = f32x16{}; sc[3] = f32x16{};
    bf16x8 qf[8];
#pragma unroll
    for (int ks = 0; ks < 8; ++ks) qf[ks] = *(const bf16x8*)(qrow + ks * 16);
    RS.hook();
#pragma unroll
    for (int ks = 0; ks < 8; ++ks)
#pragma unroll
        for (int kt = 0; kt < 4; ++kt) { const bf16x8 af = *(const __attribute__((address_space(3))) bf16x8*)(skp + ks * 4096 + kt * 512);
            sc[kt] = __builtin_amdgcn_mfma_f32_32x32x16_bf16(af, qf[ks], sc[kt], 0, 0, 0); }
    int k[64];
#pragma unroll
    for (int kt = 0; kt < 4; ++kt)
#pragma unroll
        for (int r = 0; r < 16; ++r) k[kt * 16 + r] = f2key(sc[kt][r], (32 * kt + (r & 3) + 8 * (r >> 2)) | (4 * hi));
    sort16_desc<0, 64>(k); sort16_desc<16, 64>(k);
    RS.hook();
    sort16_desc<32, 64>(k); sort16_desc<48, 64>(k);
    RS.hook();
    merge_top16<0, 16, 64>(k); merge_top16<32, 48, 64>(k); merge_top16<0, 32, 64>(k);
#pragma unroll
    for (int i = 0; i < 16; ++i) top[i] = k[i];
    cross_top16(top);
}
__device__ __forceinline__ void topk_wave(int tok0, int h, const bf16_t* Q, int* IDX, float* Gt, lds_cptr sk, int lane, RowStream& RS) {
    const int r32 = lane & 31, hi = lane >> 5, tok = tok0 + r32;
    const bf16_t* qrow = Q + (size_t)tok * PQ + h * 256 + 8 * hi;
    lds_cptr skl = sk + hi * 2048 + r32 * 16;
    int A0[16], A1[16];
    half_top16(A0, qrow, skl, hi, RS);
    half_top16(A1, qrow + 128, skl + 32768, hi, RS);
    RS.hook();
    float x[16], y[16]; int xw[16], yw[16];
#pragma unroll
    for (int a = 0; a < 16; ++a) { const int b0 = key2bits(A0[a]), b1 = key2bits(A1[a]);
        const float v0 = __int_as_float(b0 & ~127), v1 = __int_as_float(b1 & ~127); const int i0 = (b0 & 127) << 7, i1 = b1 & 127;
        x[a] = hi ? v1 : v0; y[a] = hi ? v0 : v1; xw[a] = hi ? i1 : i0; yw[a] = hi ? i0 : i1; }
    int w[32]; int n = 0;
#define PEER_CAND(a, b) do { const int bits = __float_as_int(x[a] + y[b]); int ww = (bits & ~0x3FFF) | (xw[a] + yw[b]); \
        if ((a) == (b) && hi) ww = (int)0xFF800000; w[n] = ww; ++n; } while (0)
#pragma unroll
    for (int b = 0; b < 16; ++b) PEER_CAND(0, b);
#pragma unroll
    for (int b = 1; b < 8; ++b) PEER_CAND(1, b);
#pragma unroll
    for (int b = 2; b < 5; ++b) PEER_CAND(2, b);
    PEER_CAND(3, 3);
#undef PEER_CAND
#pragma unroll
    for (int i = 27; i < 32; ++i) w[i] = (int)0xFF800000;
    RS.hook();
    sort32_desc<32>(w);
    RS.hook();
    int T[16];
#pragma unroll
    for (int i = 0; i < 16; ++i) T[i] = w[i];
    cross_top16(T);
    float sv[16]; int ev[16];
#pragma unroll
    for (int j = 0; j < 16; ++j) { ev[j] = T[j] & 0x3FFF; sv[j] = __int_as_float(T[j] & ~0x3FFF); }
    const float s0 = sv[0]; float esum = 0.f;
#pragma unroll
    for (int j = 0; j < 16; ++j) { sv[j] = __expf(sv[j] - s0); esum += sv[j]; }
    const float inv = 1.f / esum;
    if (hi == 0) { u32x4* io = (u32x4*)(IDX + ((size_t)tok * 8 + h) * 16);
#pragma unroll
        for (int j = 0; j < 4; ++j) io[j] = (u32x4){(unsigned)ev[4 * j], (unsigned)ev[4 * j + 1], (unsigned)ev[4 * j + 2], (unsigned)ev[4 * j + 3]}; }
    else { f32x4* go = (f32x4*)(Gt + ((size_t)tok * 8 + h) * 16);
#pragma unroll
        for (int j = 0; j < 4; ++j) go[j] = (f32x4){sv[4 * j] * inv, sv[4 * j + 1] * inv, sv[4 * j + 2] * inv, sv[4 * j + 3] * inv}; }
}
template <class Sched> __device__ __forceinline__ void topk_own_units(const Ptrs& P, unsigned char* shm, const Sched& S) {
    int tid_l = threadIdx.x; asm volatile("" : "+v"(tid_l));
    const int tid = tid_l, lane = tid & 63; const int wid = __builtin_amdgcn_readfirstlane(tid >> 6);
    const unsigned lds0 = (unsigned)(uintptr_t)shm;
    const bf16_t* SKg = (const bf16_t*)(P.ws + WS_SK);
    int hprev = -1; pg8::Unit u;
    RowStream RS; RS.pu = P.peer_u; RS.pv = P.peer_v; RS.ws = P.ws; RS.lane = lane; RS.step = (int)gridDim.x * 8; RS.r = (int)blockIdx.x * 8 + wid; RS.v0 = RS.v1 = RS.v2 = RS.v3 = f32x4{};
    RS.issue();
    for (int i = 0; S.next(i, u); ++i) {
        const int h = u.pn, tg = u.pm;
        if (h != hprev) { hprev = h;
            asm volatile("s_waitcnt lgkmcnt(0)\n\ts_barrier" ::: "memory");
#pragma unroll
            for (int j = 0; j < 8; ++j) { const int piece = wid * 8 + j, p = piece >> 5, c = (piece >> 1) & 15, kh = piece & 1;
                att::glds16(SKg + ((size_t)((h * 2 + p) * 128 + kh * 64 + lane) * 128 + c * 8), (unsigned)__builtin_amdgcn_readfirstlane(lds0 + p * 32768 + c * 2048 + kh * 1024)); }
            asm volatile("s_waitcnt vmcnt(0)\n\ts_barrier" ::: "memory");
        }
        topk_wave(tg * 256 + wid * 32, h, (const bf16_t*)(P.ws + WS_Q), (int*)(P.ws + WS_IDX), (float*)(P.ws + WS_G), (lds_cptr)shm, lane, RS);
    }
    while (RS.r < 2 * NEXP) RS.hook();
}
}

namespace apply {
typedef float f32x2 __attribute__((ext_vector_type(2)));
typedef __attribute__((address_space(3))) unsigned* lds_u32p;
constexpr int AP_WAVE_BYTES = 4 * (512 + 2048), AP_LDS_BYTES = 8 * AP_WAVE_BYTES;
__device__ __forceinline__ float gelu_fast(float v) {
    const float av = fabsf(v), t = __builtin_amdgcn_rcpf(av * 0.2316418882f + 1.0f);
    float q = t * 0.5307027145f + (-0.7265760135f); q = q * t + 0.7107068705f; q = q * t + (-0.142248368f); q = q * t + 0.127414796f; q = q * t;
    const float e = __builtin_amdgcn_exp2f((v * v) * (-0.72134752044f));
    const float m = v * (q * e);
    return v < 0.f ? m : v - m;
}
#define AP_DPP(v, ctrl) __builtin_bit_cast(float, __builtin_amdgcn_update_dpp(0, __builtin_bit_cast(int, (v)), (ctrl), 0xF, 0xF, true))
__device__ __forceinline__ float row16_sum(float v) { v += AP_DPP(v, 0xB1); v += AP_DPP(v, 0x4E); v += AP_DPP(v, 0x141); v += AP_DPP(v, 0x140); return v; }
__device__ __forceinline__ void load_half(u32x4 (&r)[2], const unsigned char* img, unsigned e, int sub) {
    const unsigned off = e * 512u + (unsigned)(sub * 16);
    r[0] = *(const u32x4*)(img + off); r[1] = *(const u32x4*)(img + off + 256u);
}
constexpr int AP_PROBE_RING = 16;
constexpr int AP_RING = 8;
typedef __attribute__((address_space(3))) u32x4* lds_v4p;
template <int HF, int MODE, int RING> __device__ __forceinline__ void pass_u(const Ptrs& P, const bf16_t* hrow, float rstd, lds_v4p grp, u32x4 (&R)[RING][2], const unsigned char* img, const unsigned char* img_next, int sub) {
    unsigned xq[8]; float sx;
    {
        float xf[2][16]; float mx = 0.f;
#pragma unroll
        for (int i = 0; i < 2; ++i) { const int e0 = (sub + 16 * (2 * HF + i)) * 16;
#pragma unroll
            for (int q = 0; q < 4; ++q) { const u32x2 hb = *(const u32x2*)(hrow + e0 + 4 * q); const f32x4 gv = *(const f32x4*)(P.norm_ffn + e0 + 4 * q);
                xf[i][4 * q] = bflo(hb.x) * rstd * gv.x; xf[i][4 * q + 1] = bfhi(hb.x) * rstd * gv.y; xf[i][4 * q + 2] = bflo(hb.y) * rstd * gv.z; xf[i][4 * q + 3] = bfhi(hb.y) * rstd * gv.w;
                mx = fmaxf(fmaxf(mx, fmaxf(fabsf(xf[i][4 * q]), fabsf(xf[i][4 * q + 1]))), fmaxf(fabsf(xf[i][4 * q + 2]), fabsf(xf[i][4 * q + 3]))); } }
        mx = fmaxf(mx, AP_DPP(mx, 0xB1)); mx = fmaxf(mx, AP_DPP(mx, 0x4E)); mx = fmaxf(mx, AP_DPP(mx, 0x141)); mx = fmaxf(mx, AP_DPP(mx, 0x140));
        mx = fmaxf(mx, 1e-30f); sx = mx * (1.f / 127.f); const float qs = 127.f / mx;
#pragma unroll
        for (int i = 0; i < 2; ++i)
#pragma unroll
            for (int q = 0; q < 4; ++q) xq[4 * i + q] = pack_i8x4(xf[i][4 * q] * qs, xf[i][4 * q + 1] * qs, xf[i][4 * q + 2] * qs, xf[i][4 * q + 3] * qs);
    }
#pragma unroll 1
    for (int j = 0; j < 128; j += RING) {
        const int jn = (j + RING) & 127;
        __builtin_amdgcn_s_barrier();
        const unsigned char* tb = (j + RING < 128) ? img : img_next;
        unsigned nid[RING], part[RING], suv[RING], gsv[RING];
#pragma unroll
        for (int b4 = 0; b4 < RING / 4; ++b4) { const u32x4 na = grp[jn / 4 + b4];
            nid[4 * b4] = na.x; nid[4 * b4 + 1] = na.y; nid[4 * b4 + 2] = na.z; nid[4 * b4 + 3] = na.w;
            u32x4 pa = {}, sa = {}, ga = {};
            if (HF == 1) { pa = grp[96 + j / 4 + b4]; sa = grp[32 + j / 4 + b4]; ga = grp[64 + j / 4 + b4]; }
            part[4 * b4] = pa.x; part[4 * b4 + 1] = pa.y; part[4 * b4 + 2] = pa.z; part[4 * b4 + 3] = pa.w;
            suv[4 * b4] = sa.x; suv[4 * b4 + 1] = sa.y; suv[4 * b4 + 2] = sa.z; suv[4 * b4 + 3] = sa.w;
            gsv[4 * b4] = ga.x; gsv[4 * b4 + 1] = ga.y; gsv[4 * b4 + 2] = ga.z; gsv[4 * b4 + 3] = ga.w; }
        float outv[RING];
#pragma unroll
        for (int bq = 0; bq < RING; ++bq) {
            int d0_ = 0, d1_ = 0;
            if (MODE == 1) { asm volatile("" :: "v"(R[bq][0]), "v"(R[bq][1])); d0_ = (int)xq[0]; }
            else {
                d0_ = __builtin_amdgcn_sdot4((int)R[bq][0].x, (int)xq[0], d0_, false); d1_ = __builtin_amdgcn_sdot4((int)R[bq][0].y, (int)xq[1], d1_, false);
                d0_ = __builtin_amdgcn_sdot4((int)R[bq][0].z, (int)xq[2], d0_, false); d1_ = __builtin_amdgcn_sdot4((int)R[bq][0].w, (int)xq[3], d1_, false);
                d0_ = __builtin_amdgcn_sdot4((int)R[bq][1].x, (int)xq[4], d0_, false); d1_ = __builtin_amdgcn_sdot4((int)R[bq][1].y, (int)xq[5], d1_, false);
                d0_ = __builtin_amdgcn_sdot4((int)R[bq][1].z, (int)xq[6], d0_, false); d1_ = __builtin_amdgcn_sdot4((int)R[bq][1].w, (int)xq[7], d1_, false);
            }
            asm volatile("" ::: "memory");
            load_half(R[bq], tb, MODE == 2 ? (nid[bq] & 15u) : nid[bq], sub);
            asm volatile("" ::: "memory");
            float a_ = row16_sum((float)(d0_ + d1_)) * sx;
            if (HF == 1) { a_ = (a_ + __uint_as_float(part[bq])) * __uint_as_float(suv[bq]); a_ = __uint_as_float(gsv[bq]) * gelu_fast(a_); }
            outv[bq] = a_;
        }
        if (sub == 0) {
#pragma unroll
            for (int b4 = 0; b4 < RING / 4; ++b4) grp[96 + j / 4 + b4] = (u32x4){__float_as_uint(outv[4 * b4]), __float_as_uint(outv[4 * b4 + 1]), __float_as_uint(outv[4 * b4 + 2]), __float_as_uint(outv[4 * b4 + 3])}; }
    }
    asm volatile("s_waitcnt lgkmcnt(0)" ::: "memory");
}
template <int HF, int MODE, int RING> __device__ __forceinline__ void pass_v(float (&acc)[4][16], lds_v4p grp, u32x4 (&R)[RING][2], const unsigned char* img, const unsigned char* img_next, int sub) {
#pragma unroll 1
    for (int j = 0; j < 128; j += RING) {
        const int jn = (j + RING) & 127;
        __builtin_amdgcn_s_barrier();
        const unsigned char* tb = (j + RING < 128) ? img : img_next;
        unsigned nid[RING], cvv[RING];
#pragma unroll
        for (int b4 = 0; b4 < RING / 4; ++b4) { const u32x4 na = grp[jn / 4 + b4], ca = grp[96 + j / 4 + b4];
            nid[4 * b4] = na.x; nid[4 * b4 + 1] = na.y; nid[4 * b4 + 2] = na.z; nid[4 * b4 + 3] = na.w; cvv[4 * b4] = ca.x; cvv[4 * b4 + 1] = ca.y; cvv[4 * b4 + 2] = ca.z; cvv[4 * b4 + 3] = ca.w; }
#pragma unroll
        for (int bq = 0; bq < RING; ++bq) {
            const float c_ = __uint_as_float(cvv[bq]); const f32x2 c2 = {c_, c_};
            if (MODE == 1) { asm volatile("" :: "v"(R[bq][0]), "v"(R[bq][1])); acc[2 * HF][0] += c_; }
            else {
#pragma unroll
            for (int i = 0; i < 2; ++i) { const unsigned w_[4] = {R[bq][i].x, R[bq][i].y, R[bq][i].z, R[bq][i].w};
#pragma unroll
                for (int q = 0; q < 4; ++q) { const f32x2 lo_ = __builtin_amdgcn_cvt_pk_f32_fp8(w_[q], false), hi_ = __builtin_amdgcn_cvt_pk_f32_fp8(w_[q], true);
                    f32x2 a0 = {acc[2 * HF + i][4 * q], acc[2 * HF + i][4 * q + 1]}, a1 = {acc[2 * HF + i][4 * q + 2], acc[2 * HF + i][4 * q + 3]}; a0 += c2 * lo_; a1 += c2 * hi_;
                    acc[2 * HF + i][4 * q] = a0.x; acc[2 * HF + i][4 * q + 1] = a0.y; acc[2 * HF + i][4 * q + 2] = a1.x; acc[2 * HF + i][4 * q + 3] = a1.y; } }
            }
            asm volatile("" ::: "memory");
            load_half(R[bq], tb, MODE == 2 ? (nid[bq] & 15u) : nid[bq], sub);
            asm volatile("" ::: "memory");
        }
    }
}
constexpr int AP_RINGU = 16;
__device__ __forceinline__ u32x4 load_q4(const unsigned char* img, unsigned e, int sub) { return *(const u32x4*)(img + e * 256u + (unsigned)(sub * 16)); }
template <int HF, bool NEXTV> __device__ __forceinline__ void pass_u4(const Ptrs& P, const bf16_t* hrow, float rstd, lds_v4p grp, u32x4 (&R)[AP_RINGU], const unsigned char* img, const unsigned char* img_next, int sub) {
    constexpr int RING = AP_RINGU;
    unsigned xh[4], xl[4]; float sx;
    {
        float xf[2][16]; float mx = 0.f;
#pragma unroll
        for (int i = 0; i < 2; ++i) { const int e0 = (sub + 16 * (2 * HF + i)) * 16;
#pragma unroll
            for (int q = 0; q < 4; ++q) { const u32x2 hb = *(const u32x2*)(hrow + e0 + 4 * q); const f32x4 gv = *(const f32x4*)(P.norm_ffn + e0 + 4 * q);
                xf[i][4 * q] = bflo(hb.x) * rstd * gv.x; xf[i][4 * q + 1] = bfhi(hb.x) * rstd * gv.y; xf[i][4 * q + 2] = bflo(hb.y) * rstd * gv.z; xf[i][4 * q + 3] = bfhi(hb.y) * rstd * gv.w;
                mx = fmaxf(fmaxf(mx, fmaxf(fabsf(xf[i][4 * q]), fabsf(xf[i][4 * q + 1]))), fmaxf(fabsf(xf[i][4 * q + 2]), fabsf(xf[i][4 * q + 3]))); } }
        mx = fmaxf(mx, AP_DPP(mx, 0xB1)); mx = fmaxf(mx, AP_DPP(mx, 0x4E)); mx = fmaxf(mx, AP_DPP(mx, 0x141)); mx = fmaxf(mx, AP_DPP(mx, 0x140));
        mx = fmaxf(mx, 1e-30f); sx = mx * (1.f / 119.f); const float qs = 119.f / mx;
#pragma unroll
        for (int q = 0; q < 4; ++q) { unsigned h_ = 0u, l_ = 0u;
#pragma unroll
            for (int i = 0; i < 8; ++i) { const int xi = (int)rintf(xf[q >> 1][8 * (q & 1) + i] * qs); const int lo = ((xi + 8) & 15) - 8; const int hi = (xi - lo) >> 4;
                h_ |= ((unsigned)hi & 15u) << (4 * i); l_ |= ((unsigned)lo & 15u) << (4 * i); }
            xh[q] = h_; xl[q] = l_; }
    }
#pragma unroll 1
    for (int j = 0; j < 128; j += RING) {
        const int jn = (j + RING) & 127;
        __builtin_amdgcn_s_barrier();
        const bool last = !(j + RING < 128);
        const unsigned char* tb = last ? img_next : img;
        unsigned nid[RING], part[RING], suv[RING], gsv[RING];
#pragma unroll
        for (int b4 = 0; b4 < RING / 4; ++b4) { const u32x4 na = grp[jn / 4 + b4];
            nid[4 * b4] = na.x; nid[4 * b4 + 1] = na.y; nid[4 * b4 + 2] = na.z; nid[4 * b4 + 3] = na.w;
            u32x4 pa = {}, sa = {}, ga = {};
            if (HF == 1) { pa = grp[96 + j / 4 + b4]; sa = grp[32 + j / 4 + b4]; ga = grp[64 + j / 4 + b4]; }
            part[4 * b4] = pa.x; part[4 * b4 + 1] = pa.y; part[4 * b4 + 2] = pa.z; part[4 * b4 + 3] = pa.w;
            suv[4 * b4] = sa.x; suv[4 * b4 + 1] = sa.y; suv[4 * b4 + 2] = sa.z; suv[4 * b4 + 3] = sa.w;
            gsv[4 * b4] = ga.x; gsv[4 * b4 + 1] = ga.y; gsv[4 * b4 + 2] = ga.z; gsv[4 * b4 + 3] = ga.w; }
        float outv[RING];
#pragma unroll
        for (int bq = 0; bq < RING; ++bq) {
            int dh_ = __builtin_amdgcn_sdot8((int)R[bq].x, (int)xh[0], 0, false), dl_ = __builtin_amdgcn_sdot8((int)R[bq].x, (int)xl[0], 0, false);
            dh_ = __builtin_amdgcn_sdot8((int)R[bq].y, (int)xh[1], dh_, false); dl_ = __builtin_amdgcn_sdot8((int)R[bq].y, (int)xl[1], dl_, false);
            dh_ = __builtin_amdgcn_sdot8((int)R[bq].z, (int)xh[2], dh_, false); dl_ = __builtin_amdgcn_sdot8((int)R[bq].z, (int)xl[2], dl_, false);
            dh_ = __builtin_amdgcn_sdot8((int)R[bq].w, (int)xh[3], dh_, false); dl_ = __builtin_amdgcn_sdot8((int)R[bq].w, (int)xl[3], dl_, false);
            asm volatile("" ::: "memory");
            if (NEXTV) { if (last) R[bq] = *(const u32x4*)(tb + nid[bq >> 1] * 512u + (unsigned)(sub * 16 + (bq & 1) * 256)); else R[bq] = load_q4(tb, nid[bq], sub); }
            else R[bq] = load_q4(tb, nid[bq], sub);
            asm volatile("" ::: "memory");
            float a_ = row16_sum((float)(dh_ * 16 + dl_)) * sx;
            if (HF == 1) { a_ = (a_ + __uint_as_float(part[bq])) * __uint_as_float(suv[bq]); a_ = __uint_as_float(gsv[bq]) * gelu_fast(a_); }
            outv[bq] = a_;
        }
        if (sub == 0) {
#pragma unroll
            for (int b4 = 0; b4 < RING / 4; ++b4) grp[96 + j / 4 + b4] = (u32x4){__float_as_uint(outv[4 * b4]), __float_as_uint(outv[4 * b4 + 1]), __float_as_uint(outv[4 * b4 + 2]), __float_as_uint(outv[4 * b4 + 3])}; }
    }
    asm volatile("s_waitcnt lgkmcnt(0)" ::: "memory");
}
template <int HF> __device__ __forceinline__ void pass_v8f(float (&acc)[4][16], lds_v4p grp, u32x4 (&R)[AP_RINGU], const unsigned char* img, const unsigned char* img_next, int sub) {
    constexpr int RING = 8;
#pragma unroll 1
    for (int j = 0; j < 128; j += RING) {
        const int jn = (j + RING) & 127;
        if ((j & 31) == 0) __builtin_amdgcn_s_barrier();
        const unsigned char* tb = (j + RING < 128) ? img : img_next;
        unsigned nid[RING], cvv[RING];
#pragma unroll
        for (int b4 = 0; b4 < RING / 4; ++b4) { const u32x4 na = grp[jn / 4 + b4], ca = grp[96 + j / 4 + b4];
            nid[4 * b4] = na.x; nid[4 * b4 + 1] = na.y; nid[4 * b4 + 2] = na.z; nid[4 * b4 + 3] = na.w; cvv[4 * b4] = ca.x; cvv[4 * b4 + 1] = ca.y; cvv[4 * b4 + 2] = ca.z; cvv[4 * b4 + 3] = ca.w; }
#pragma unroll
        for (int bq = 0; bq < RING; ++bq) {
            const float c_ = __uint_as_float(cvv[bq]); const f32x2 c2 = {c_, c_};
#pragma unroll
            for (int i = 0; i < 2; ++i) { const unsigned w_[4] = {R[2 * bq + i].x, R[2 * bq + i].y, R[2 * bq + i].z, R[2 * bq + i].w};
#pragma unroll
                for (int q = 0; q < 4; ++q) { const f32x2 lo_ = __builtin_amdgcn_cvt_pk_f32_fp8(w_[q], false), hi_ = __builtin_amdgcn_cvt_pk_f32_fp8(w_[q], true);
                    f32x2 a0 = {acc[2 * HF + i][4 * q], acc[2 * HF + i][4 * q + 1]}, a1 = {acc[2 * HF + i][4 * q + 2], acc[2 * HF + i][4 * q + 3]}; a0 += c2 * lo_; a1 += c2 * hi_;
                    acc[2 * HF + i][4 * q] = a0.x; acc[2 * HF + i][4 * q + 1] = a0.y; acc[2 * HF + i][4 * q + 2] = a1.x; acc[2 * HF + i][4 * q + 3] = a1.y; } }
            asm volatile("" ::: "memory");
            { const unsigned off = nid[bq] * 512u + (unsigned)(sub * 16); R[2 * bq] = *(const u32x4*)(tb + off); R[2 * bq + 1] = *(const u32x4*)(tb + off + 256u); }
            asm volatile("" ::: "memory");
        }
    }
}
template <int MODE> __device__ __forceinline__ void apply_round(const Ptrs& P, float* outbase, int tbase, unsigned char* shm_wave, int lane_in) {
    int lane = lane_in; asm volatile("" : "+v"(lane));
    const int sub = lane & 15, g = lane >> 4, t = tbase + g;
    __attribute__((address_space(3))) unsigned* cnt = (lds_u32p)(__attribute__((address_space(3))) unsigned char*)shm_wave + g * 128;
    lds_v4p grp = (lds_v4p)((__attribute__((address_space(3))) unsigned char*)shm_wave + 2048 + g * 2048);
    __attribute__((address_space(3))) unsigned* grp1 = (__attribute__((address_space(3))) unsigned*)grp;
    const unsigned char* U8 = P.ws + WS_U; const unsigned char* V8 = P.ws + WS_V;
    {
        const int* idxp = (const int*)(P.ws + WS_IDX) + (size_t)t * 128 + sub * 8; const float* gp = (const float*)(P.ws + WS_G) + (size_t)t * 128 + sub * 8;
        const u32x4 ia = *(const u32x4*)idxp, ib = *(const u32x4*)(idxp + 4); const f32x4 ga = *(const f32x4*)gp, gb = *(const f32x4*)(gp + 4);
        const int e[8] = {(int)ia.x, (int)ia.y, (int)ia.z, (int)ia.w, (int)ib.x, (int)ib.y, (int)ib.z, (int)ib.w};
        const float gt[8] = {ga.x, ga.y, ga.z, ga.w, gb.x, gb.y, gb.z, gb.w};
        float su[8], sv[8];
#pragma unroll
        for (int i = 0; i < 8; ++i) { su[i] = ((const float*)(P.ws + WS_SU))[e[i]]; sv[i] = ((const float*)(P.ws + WS_SV))[e[i]]; }
#pragma unroll
        for (int i = 0; i < 8; ++i) cnt[sub * 8 + i] = 0u;
        asm volatile("s_waitcnt lgkmcnt(0)" ::: "memory");
        unsigned pos[8];
#pragma unroll
        for (int i = 0; i < 8; ++i) pos[i] = __hip_atomic_fetch_add(cnt + (e[i] >> 7), 1u, __ATOMIC_RELAXED, __HIP_MEMORY_SCOPE_WAVEFRONT);
        asm volatile("s_waitcnt lgkmcnt(0)" ::: "memory");
        unsigned c[8]; unsigned tot = 0;
#pragma unroll
        for (int i = 0; i < 8; ++i) { c[i] = cnt[sub * 8 + i]; }
#pragma unroll
        for (int i = 0; i < 8; ++i) { const unsigned x = c[i]; c[i] = tot; tot += x; }
        unsigned inc = tot;
#pragma unroll
        for (int d = 1; d < 16; d <<= 1) { const unsigned y = __shfl_up(inc, d, 16); if (sub >= d) inc += y; }
        const unsigned base = inc - tot;
        asm volatile("s_waitcnt lgkmcnt(0)" ::: "memory");
#pragma unroll
        for (int i = 0; i < 8; ++i) cnt[sub * 8 + i] = base + c[i];
        asm volatile("s_waitcnt lgkmcnt(0)" ::: "memory");
#pragma unroll
        for (int i = 0; i < 8; ++i) { const unsigned p = cnt[e[i] >> 7] + pos[i];
            grp1[p] = (unsigned)e[i]; grp1[128 + p] = __float_as_uint(su[i]); grp1[256 + p] = __float_as_uint(gt[i] * sv[i]); }
        asm volatile("s_waitcnt lgkmcnt(0)" ::: "memory");
    }
    const bf16_t* hrow = (const bf16_t*)(P.ws + WS_HB) + (size_t)t * D;
    float rstd;
    { const float* ssq = (const float*)(P.ws + WS_SSQ) + (size_t)t * 16;
      const f32x4 s0 = *(const f32x4*)ssq, s1 = *(const f32x4*)(ssq + 4), s2 = *(const f32x4*)(ssq + 8), s3 = *(const f32x4*)(ssq + 12);
      const float tot = ((s0.x + s0.y) + (s0.z + s0.w)) + ((s1.x + s1.y) + (s1.z + s1.w)) + ((s2.x + s2.y) + (s2.z + s2.w)) + ((s3.x + s3.y) + (s3.z + s3.w));
      rstd = 1.f / sqrtf(tot * (1.f / D) + EPS); }
    const unsigned char* U0 = U8; const unsigned char* U1 = U8 + (size_t)NEXP * 256; const unsigned char* V0 = V8; const unsigned char* V1 = V8 + (size_t)NEXP * 512;
    u32x4 R[AP_RINGU];
    {
#pragma unroll
      for (int b4 = 0; b4 < AP_RINGU / 4; ++b4) { const u32x4 ia = grp[b4]; R[4 * b4] = load_q4(U0, ia.x, sub); R[4 * b4 + 1] = load_q4(U0, ia.y, sub); R[4 * b4 + 2] = load_q4(U0, ia.z, sub); R[4 * b4 + 3] = load_q4(U0, ia.w, sub); } }
    pass_u4<0, false>(P, hrow, rstd, grp, R, U0, U1, sub);
    pass_u4<1, true>(P, hrow, rstd, grp, R, U1, V0, sub);
    float acc[4][16];
#pragma unroll
    for (int i = 0; i < 4; ++i)
#pragma unroll
        for (int q = 0; q < 16; ++q) acc[i][q] = 0.f;
    pass_v8f<0>(acc, grp, R, V0, V1, sub);
    pass_v8f<1>(acc, grp, R, V1, V1, sub);
    float ss = 0.f;
#pragma unroll
    for (int i = 0; i < 4; ++i) { const int e0 = (sub + 16 * i) * 16;
#pragma unroll
        for (int q = 0; q < 4; ++q) { const u32x2 hb = *(const u32x2*)(hrow + e0 + 4 * q);
            acc[i][4 * q] += bflo(hb.x); acc[i][4 * q + 1] += bfhi(hb.x); acc[i][4 * q + 2] += bflo(hb.y); acc[i][4 * q + 3] += bfhi(hb.y);
            ss += (acc[i][4 * q] * acc[i][4 * q] + acc[i][4 * q + 1] * acc[i][4 * q + 1]) + (acc[i][4 * q + 2] * acc[i][4 * q + 2] + acc[i][4 * q + 3] * acc[i][4 * q + 3]); }
        asm volatile("" ::: "memory"); }
    ss = row16_sum(ss);
    const float r2 = 1.f / sqrtf(ss * (1.f / D) + EPS);
    float* orow = outbase + (size_t)t * D;
#pragma unroll
    for (int i = 0; i < 4; ++i) { const int e0 = (sub + 16 * i) * 16;
#pragma unroll
        for (int q = 0; q < 4; ++q) { const f32x4 gv = *(const f32x4*)(P.norm_final + e0 + 4 * q);
            *(f32x4*)(orow + e0 + 4 * q) = (f32x4){acc[i][4 * q] * r2 * gv.x, acc[i][4 * q + 1] * r2 * gv.y, acc[i][4 * q + 2] * r2 * gv.z, acc[i][4 * q + 3] * r2 * gv.w}; }
        asm volatile("" ::: "memory"); }
}
template <int MODE> __device__ __forceinline__ void apply_phase(const Ptrs& P, float* outbase, unsigned char* shm, int G, int vcu) {
    int tid_l = threadIdx.x; asm volatile("" : "+v"(tid_l));
    const int lane = tid_l & 63; const int wave = __builtin_amdgcn_readfirstlane(tid_l >> 6);
    const int per = M / (G * 8);
#pragma unroll 1
    for (int r = 0; r < per; r += 4) apply_round<MODE>(P, outbase, (vcu * 8 + wave) * per + r, shm + wave * AP_WAVE_BYTES, lane);
}
}

#define LAS __attribute__((address_space(3)))
#define XB_TMO      128
#define XB_XCNT(j)  (256  + 64 * (j))
#define XB_XSUB(j)  (1280 + 64 * (j))
#define XB_XGEN(j)  (2304 + 64 * (j))
#define XB_TOP      3328
#define XB_TOPGEN   3392
#define XCD_BAR_WORDS 3456
#define XB_SPIN_CAP (1u << 18)

__device__ __forceinline__ unsigned xb_ld(unsigned* p)              { return __hip_atomic_load(p, __ATOMIC_RELAXED, __HIP_MEMORY_SCOPE_AGENT); }
__device__ __forceinline__ unsigned xb_add(unsigned* p, unsigned v) { return __hip_atomic_fetch_add(p, v, __ATOMIC_RELAXED, __HIP_MEMORY_SCOPE_AGENT); }
__device__ __forceinline__ unsigned xb_xcc_id() { return (unsigned)__builtin_amdgcn_s_getreg((3 << 11) | 20) & 0xFu; }
#define XB_SPIN(cond, bar) do { unsigned _sp = 0; while (cond) { __builtin_amdgcn_s_sleep(1); \
    if ((++_sp & 255u) == 0u) { if (xb_ld(&(bar)[XB_TMO])) break; if (_sp > XB_SPIN_CAP) { atomicAdd(&(bar)[XB_TMO], 1u); break; } } } } while (0)

struct XcdBarrier {
    unsigned* bar; unsigned x;
    volatile LAS unsigned* st;
};

__device__ __forceinline__ XcdBarrier xcd_barrier_post(unsigned* bar, volatile LAS unsigned* st) {
    XcdBarrier b; b.bar = bar; b.x = xb_xcc_id(); b.st = st;
    if (threadIdx.x == 0) (void)xb_add(&bar[XB_XCNT(b.x)], 1u);
    return b;
}
__device__ __forceinline__ void xcd_barrier_complete(unsigned* bar, unsigned x, unsigned& nloc, unsigned& nx) {
    const unsigned G = gridDim.x * gridDim.y * gridDim.z;
    unsigned sum, cnt, mine, sp = 0u;
    for (;;) {
        sum = 0u; cnt = 0u; mine = 0u;
#pragma unroll
        for (unsigned j = 0; j < 16; ++j) { const unsigned c = xb_ld(&bar[XB_XCNT(j)]); sum += c; cnt += (c > 0u) ? 1u : 0u; mine = (j == x) ? c : mine; }
        if (sum == G) break;
        __builtin_amdgcn_s_sleep(1);
        if ((++sp & 255u) == 0u) { if (xb_ld(&bar[XB_TMO])) break; if (sp > XB_SPIN_CAP) { atomicAdd(&bar[XB_TMO], 1u); break; } }
    }
    nloc = mine > 0u ? mine : 1u; nx = cnt > 0u ? cnt : 1u;
}

__device__ __forceinline__ void xcd_barrier(const XcdBarrier& b) {
    asm volatile("s_waitcnt vmcnt(0)" ::: "memory");
    __syncthreads();
    if (threadIdx.x == 0) {
        unsigned* bar = b.bar;
        __builtin_amdgcn_s_waitcnt(0);
        unsigned nloc = b.st[0], nx = b.st[1];
        if (nloc == 0u) { xcd_barrier_complete(bar, b.x, nloc, nx); b.st[0] = nloc; b.st[1] = nx; }
        const unsigned old = xb_add(&bar[XB_XSUB(b.x)], 1u);
        const unsigned gen = old / nloc;
        if (old + 1u == (gen + 1u) * nloc) {
            __builtin_amdgcn_fence(__ATOMIC_RELEASE, "agent");
            asm volatile("s_waitcnt vmcnt(0)" ::: "memory");
            const unsigned og = xb_add(&bar[XB_TOP], 1u);
            const unsigned tg = og / nx;
            if (og + 1u == (tg + 1u) * nx) xb_add(&bar[XB_TOPGEN], 1u);
            else XB_SPIN(xb_ld(&bar[XB_TOPGEN]) == tg, bar);
            __builtin_amdgcn_fence(__ATOMIC_ACQUIRE, "agent");
            xb_add(&bar[XB_XGEN(b.x)], 1u);
            asm volatile("s_waitcnt vmcnt(0)" ::: "memory");
        } else {
            XB_SPIN(xb_ld(&bar[XB_XGEN(b.x)]) == gen, bar);
            __builtin_amdgcn_fence(__ATOMIC_ACQUIRE, "agent");
            asm volatile("s_waitcnt vmcnt(0)" ::: "memory");
        }
    }
    __syncthreads();
}


namespace cg = cooperative_groups;
#ifndef REP_MASK
#define REP_MASK 0
#endif
#define REPS(k) (((REP_MASK) >> (k)) & 1 ? 2 : 1)
constexpr int PHASE_LDS = att::A_LDS_BYTES;
constexpr int MEGA_LDS = PHASE_LDS + 64;
static_assert(PHASE_LDS >= pg8::STAGE_BYTES && PHASE_LDS >= att::B_LDS_BYTES && PHASE_LDS >= peer::T_LDS_BYTES && PHASE_LDS >= 8 * 64 * 33 * 4 && PHASE_LDS >= apply::AP_LDS_BYTES, "LDS budget");
__global__ void __launch_bounds__(512, 2) mega_fwd(Ptrs P) {
    extern __shared__ __attribute__((aligned(16))) unsigned char lds_dyn[];
    volatile LAS unsigned* bst = (volatile LAS unsigned*)((LAS unsigned char*)lds_dyn + PHASE_LDS);
    if (threadIdx.x < 2) bst[threadIdx.x] = 0u;
    __syncthreads();
    const XcdBarrier bar = xcd_barrier_post((unsigned*)(P.ws + WS_CTL), bst);
    const int G = (int)gridDim.x, bx = (int)blockIdx.x, vcu = (G % 8 == 0) ? (bx % 8) * (G / 8) + bx / 8 : bx;
    unsigned char* ws = P.ws;
    PG8_LAS unsigned char* lds3 = (PG8_LAS unsigned char*)lds_dyn;
    for (int rep = 0; rep < REPS(0); ++rep) prep_phase(P, lds_dyn, G, bx);
    xcd_barrier(bar); if (REPS(9) == 2) xcd_barrier(bar);
    for (int rep = 0; rep < REPS(1); ++rep) {
      { pg8::Gemm g{(const bf16_t*)(ws + WS_XN), (const bf16_t*)(ws + WS_WIN), M, 1024, D, 0}; pg8::StaticOrder S; S.init(M, 1024, G, bx);
        pg8::gemm_phase<pg8::EpiProj, pg8::StaticOrder, true, true, false>(lds3, g, S, pg8::EpiProj{(bf16_t*)(ws + WS_PROJ), (const float*)(ws + WS_ROPE), 1.f, 0}); }
      { pg8::Gemm g{(const bf16_t*)(ws + WS_XN8), (const bf16_t*)(ws + WS_WIN8), M, INW - 1024, D / 2, 0}; pg8::StaticOrder S; S.init(M, INW - 1024, G, bx);
        pg8::gemm_phase<pg8::EpiProj, pg8::StaticOrder, true, true, true>(lds3, g, S, pg8::EpiProj{(bf16_t*)(ws + WS_PROJ), (const float*)(ws + WS_ROPE), 1.f / WIN_SCALE, 4}); } }
    xcd_barrier(bar); if (REPS(9) == 2) xcd_barrier(bar);
    { const float lam = lambda_full(P);
      for (int rep = 0; rep < REPS(2); ++rep) for (int u = vcu; u < BATCH * 4 * 8; u += G) att::attn_a_unit(u >> 5, (u >> 3) & 3, u & 7, (const bf16_t*)(ws + WS_PROJ), (bf16_t*)(ws + WS_YA), P.subln, lam, lds_dyn);
      for (int rep = 0; rep < REPS(3); ++rep) for (int u = vcu; u < BATCH * 8 * 8; u += G) att::attn_b_unit(u >> 6, (u >> 3) & 7, u & 7, (const bf16_t*)(ws + WS_PROJ), (bf16_t*)(ws + WS_YA), P.rpb, lds_dyn); }
    xcd_barrier(bar); if (REPS(9) == 2) xcd_barrier(bar);
    for (int rep = 0; rep < REPS(4); ++rep) { pg8::StaticOrder S; S.init(M, D, G, bx);
      pg8::gemm_phase<pg8::EpiGate2, pg8::StaticOrder, true, true>(lds3, pg8::Gemm{(const bf16_t*)(ws + WS_YA), (const bf16_t*)(ws + WS_WPA), M, D, D, 0}, S, pg8::EpiGate2{(const bf16_t*)(ws + WS_PROJ), (bf16_t*)(ws + WS_MERGED)}); }
    xcd_barrier(bar); if (REPS(9) == 2) xcd_barrier(bar);
    for (int rep = 0; rep < REPS(5); ++rep) { pg8::StaticOrder S; S.init(M, D, G, bx);
      pg8::gemm_phase<pg8::EpiHout, pg8::StaticOrder, true, true>(lds3, pg8::Gemm{(const bf16_t*)(ws + WS_MERGED), (const bf16_t*)(ws + WS_WOUT), M, D, D, 0}, S, pg8::EpiHout{P.x, P.out, (bf16_t*)(ws + WS_HB), (float*)(ws + WS_SSQ)});
    }
    xcd_barrier(bar); if (REPS(9) == 2) xcd_barrier(bar);
    { pg8::StaticOrder S; S.init(M, PQ, G, bx);
      for (int rep = 0; rep < REPS(8); ++rep)
        pg8::gemm_phase<pg8::EpiQ, pg8::StaticOrder, true, true>(lds3, pg8::Gemm{(const bf16_t*)(ws + WS_HB), (const bf16_t*)(ws + WS_WQ), M, PQ, D, 0}, S, pg8::EpiQ{(const float*)(ws + WS_SSQ), (bf16_t*)(ws + WS_Q)});
      asm volatile("s_waitcnt vmcnt(0)" ::: "memory");
      __syncthreads();
      if (threadIdx.x == 0) { __builtin_amdgcn_fence(__ATOMIC_ACQUIRE, "agent"); asm volatile("s_waitcnt vmcnt(0)" ::: "memory"); }
      __syncthreads();
      for (int rep = 0; rep < REPS(6); ++rep) peer::topk_own_units(P, lds_dyn, S); }
    xcd_barrier(bar); if (REPS(9) == 2) xcd_barrier(bar);
#ifndef PROBE_MODE
#define PROBE_MODE 0
#endif
    if (REPS(7) == 2) apply::apply_phase<PROBE_MODE>(P, (float*)(ws + WS_Q), lds_dyn, G, vcu);
    apply::apply_phase<0>(P, P.out, lds_dyn, G, vcu);
}

extern "C" void kernel_launch(void* const* d_in, const int* in_sizes, int n_in, void* d_out, int out_size, void* d_ws, size_t ws_size, hipStream_t stream) {
    if (n_in != 18 || ws_size < WS_END) { fprintf(stderr, "kernel_launch: unexpected n_in %d / ws_size %zu\n", n_in, ws_size); return; }
    Ptrs P{};
    P.x = (const float*)d_in[0]; P.w_in = (const float*)d_in[1]; P.w_pa = (const float*)d_in[2]; P.w_pb = (const float*)d_in[3]; P.w_out = (const float*)d_in[4];
    P.norm_mix = (const float*)d_in[5]; P.norm_ffn = (const float*)d_in[6]; P.norm_final = (const float*)d_in[7];
    P.lq1 = (const float*)d_in[8]; P.lk1 = (const float*)d_in[9]; P.lq2 = (const float*)d_in[10]; P.lk2 = (const float*)d_in[11];
    P.subln = (const float*)d_in[12]; P.rpb = (const float*)d_in[13]; P.w_query = (const float*)d_in[14]; P.sub_keys = (const float*)d_in[15];
    P.peer_u = (const float*)d_in[16]; P.peer_v = (const float*)d_in[17];
    P.out = (float*)d_out; P.ws = (unsigned char*)d_ws;
    static int grid_blocks = 0;
    if (!grid_blocks) {
        int dev = 0, cus = 0, per_cu = 0;
        hipGetDevice(&dev);
        hipDeviceGetAttribute(&cus, hipDeviceAttributeMultiprocessorCount, dev);
        hipFuncSetAttribute((const void*)mega_fwd, hipFuncAttributeMaxDynamicSharedMemorySize, MEGA_LDS);
        hipOccupancyMaxActiveBlocksPerMultiprocessor(&per_cu, (const void*)mega_fwd, 512, MEGA_LDS);
        if (per_cu < 1) { fprintf(stderr, "kernel_launch: occupancy query says %d blocks per CU\n", per_cu); per_cu = 1; }
        grid_blocks = cus * per_cu;
    }
    hipMemsetAsync((unsigned char*)d_ws + WS_CTL, 0, 16384, stream);
    void* args[] = {&P};
    hipError_t e = hipLaunchCooperativeKernel((const void*)mega_fwd, dim3(grid_blocks), dim3(512), args, MEGA_LDS, stream);
    if (e != hipSuccess) fprintf(stderr, "cooperative launch failed: %s (grid %d)\n", hipGetErrorString(e), grid_blocks);
}
```

```cpp
#include <hip/hip_runtime.h>
#include <hip/hip_cooperative_groups.h>
#include <cstdio>
#include <cstdint>

typedef unsigned short bf16_t;
typedef unsigned u32x4 __attribute__((ext_vector_type(4)));
typedef unsigned u32x2 __attribute__((ext_vector_type(2)));
typedef float f32x4 __attribute__((ext_vector_type(4)));
typedef __bf16 bf16x2_t __attribute__((ext_vector_type(2)));

constexpr int D = 1024, BATCH = 8, SEQ = 2048, M = BATCH * SEQ, INW = 5120;
constexpr int C_QA = 0, C_KA = 512, C_VA = 1024, C_QB = 1536, C_KB = 2048, C_VB = 2560, C_GA = 3072, C_GB = 4096;
constexpr int NEXP = 16384, PQ = 2048;
constexpr float EPS = 1e-6f;
constexpr float LOG2E = 1.4426950408889634f;
constexpr float WIN_SCALE = 32.f;
constexpr float QSCALE = 0.125f * LOG2E;

constexpr size_t MiB = 1u << 20;
constexpr size_t WS_PROJ = 0;
constexpr size_t WS_HB = 0;
constexpr size_t WS_Q = 32 * MiB;
constexpr size_t WS_U = 96 * MiB;
constexpr size_t WS_V = 112 * MiB;
constexpr size_t WS_SU = 128 * MiB;
constexpr size_t WS_SV = 128 * MiB + 65536;
constexpr size_t WS_XN = 160 * MiB;
constexpr size_t WS_YA = 160 * MiB;
constexpr size_t WS_YB = 176 * MiB;
constexpr size_t WS_IDX = 160 * MiB;
constexpr size_t WS_G = 168 * MiB;
constexpr size_t WS_MERGED = 192 * MiB;
constexpr size_t WS_TOPV = 192 * MiB;
constexpr size_t WS_TOPI = 208 * MiB;
constexpr size_t WS_WIN = 224 * MiB;
constexpr size_t WS_WIN8 = 226 * MiB;
constexpr size_t WS_XN8 = 192 * MiB;
constexpr size_t WS_WQ = 234 * MiB;
constexpr size_t WS_WOUT = 238 * MiB;
constexpr size_t WS_WPA = 240 * MiB;
constexpr size_t WS_WPB = 241 * MiB;
constexpr size_t WS_SK = 242 * MiB;
constexpr size_t WS_ROPE = 242 * MiB + 512 * 1024;
constexpr size_t WS_SSQ = 243 * MiB;
constexpr size_t WS_CTL = 244 * MiB;
constexpr size_t WS_END = 256 * MiB;

__device__ __forceinline__ float bf2f(unsigned v) { return __uint_as_float(v << 16); }
__device__ __forceinline__ float bflo(unsigned w) { return __uint_as_float(w << 16); }
__device__ __forceinline__ float bfhi(unsigned w) { return __uint_as_float(w & 0xffff0000u); }
__device__ __forceinline__ unsigned f2bf(float f) { unsigned u = __float_as_uint(f); return (u + 0x7fffu + ((u >> 16) & 1u)) >> 16; }
__device__ __forceinline__ unsigned pk2(float lo, float hi) { return f2bf(lo) | (f2bf(hi) << 16); }
__device__ __forceinline__ float wave_sum(float v) {
#pragma unroll
    for (int o = 1; o < 64; o <<= 1) v += __shfl_xor(v, o);
    return v;
}
__device__ __forceinline__ float sigmoidf_(float x) { return 1.f / (1.f + __expf(-x)); }
__device__ __forceinline__ float gelu_exact(float x) { return 0.5f * x * (1.f + erff(x * 0.70710678118654752f)); }

struct Ptrs {
    const float *x, *w_in, *w_pa, *w_pb, *w_out, *norm_mix, *norm_ffn, *norm_final, *lq1, *lk1, *lq2, *lk2, *subln, *rpb, *w_query, *sub_keys, *peer_u, *peer_v;
    float* out; unsigned char* ws;
};

__device__ __forceinline__ void transpose_item(const float* W, int K, int N, const float* gain, bf16_t* WT, float* scr, int item, int lane, int ldo = 0, int koff = 0, int ldw = 0) {
    if (ldo == 0) ldo = K;
    if (ldw == 0) ldw = N;
    const int nblk = N / 32, kb = item / nblk, nb = item % nblk, k0 = 64 * kb, n0 = 32 * nb;
    float wv[32];
#pragma unroll
    for (int i = 0; i < 32; ++i) { const int kk = 2 * i + (lane >> 5); wv[i] = W[(size_t)(k0 + kk) * ldw + n0 + (lane & 31)]; }
#pragma unroll
    for (int i = 0; i < 32; ++i) { const int kk = 2 * i + (lane >> 5); float w = wv[i]; if (gain) w *= gain[k0 + kk]; scr[kk * 33 + (lane & 31)] = w; }
    asm volatile("s_waitcnt lgkmcnt(0)" ::: "memory");
    const int c = lane & 7;
#pragma unroll
    for (int j = 0; j < 4; ++j) { const int n = (lane >> 3) + 8 * j; const float* s = scr + (8 * c) * 33 + n;
        u32x4 o; o.x = pk2(s[0 * 33], s[1 * 33]); o.y = pk2(s[2 * 33], s[3 * 33]); o.z = pk2(s[4 * 33], s[5 * 33]); o.w = pk2(s[6 * 33], s[7 * 33]);
        *(u32x4*)(WT + (size_t)(n0 + n) * ldo + koff + k0 + 8 * c) = o; }
    asm volatile("s_waitcnt lgkmcnt(0)" ::: "memory");
}
__device__ __forceinline__ void cvt8(const float* src, bf16_t* dst, size_t i8) {
    const f32x4 a = *(const f32x4*)(src + i8 * 8), b = *(const f32x4*)(src + i8 * 8 + 4);
    u32x4 o; o.x = pk2(a.x, a.y); o.y = pk2(a.z, a.w); o.z = pk2(b.x, b.y); o.w = pk2(b.z, b.w);
    *(u32x4*)(dst + i8 * 8) = o;
}
__device__ __forceinline__ void transpose_item8(const float* W, int K, int N, int ldw, const float* gain, float wscale, unsigned char* WT, float* scr, int item, int lane) {
    const int nblk = N / 32, kb = item / nblk, nb = item % nblk, k0 = 64 * kb, n0 = 32 * nb;
    float wv[32];
#pragma unroll
    for (int i = 0; i < 32; ++i) { const int kk = 2 * i + (lane >> 5); wv[i] = W[(size_t)(k0 + kk) * ldw + n0 + (lane & 31)]; }
#pragma unroll
    for (int i = 0; i < 32; ++i) { const int kk = 2 * i + (lane >> 5); float w = wv[i] * wscale; if (gain) w *= gain[k0 + kk]; scr[kk * 33 + (lane & 31)] = w; }
    asm volatile("s_waitcnt lgkmcnt(0)" ::: "memory");
    const int c = lane & 7;
#pragma unroll
    for (int j = 0; j < 4; ++j) { const int n = (lane >> 3) + 8 * j; const float* s = scr + (8 * c) * 33 + n;
        u32x2 o; o.x = __builtin_amdgcn_cvt_pk_fp8_f32(s[0 * 33], s[1 * 33], 0u, false); o.x = __builtin_amdgcn_cvt_pk_fp8_f32(s[2 * 33], s[3 * 33], o.x, true);
        o.y = __builtin_amdgcn_cvt_pk_fp8_f32(s[4 * 33], s[5 * 33], 0u, false); o.y = __builtin_amdgcn_cvt_pk_fp8_f32(s[6 * 33], s[7 * 33], o.y, true);
        *(u32x2*)(WT + (size_t)(n0 + n) * K + k0 + 8 * c) = o; }
    asm volatile("s_waitcnt lgkmcnt(0)" ::: "memory");
}
__device__ __forceinline__ void rms_rows_emit(const f32x4 (&v)[4], bf16_t* orow16, unsigned char* orow, int lane) {
    float s = 0.f;
#pragma unroll
    for (int j = 0; j < 4; ++j) s += (v[j].x * v[j].x + v[j].y * v[j].y) + (v[j].z * v[j].z + v[j].w * v[j].w);
    const float rstd = 1.f / sqrtf(wave_sum(s) * (1.f / D) + EPS);
    unsigned* o4 = (unsigned*)orow + lane; u32x2* o8 = (u32x2*)orow16 + lane;
#pragma unroll
    for (int j = 0; j < 4; ++j) { unsigned w = __builtin_amdgcn_cvt_pk_fp8_f32(v[j].x * rstd, v[j].y * rstd, 0u, false); w = __builtin_amdgcn_cvt_pk_fp8_f32(v[j].z * rstd, v[j].w * rstd, w, true); o4[64 * j] = w;
        u32x2 w2; w2.x = pk2(v[j].x * rstd, v[j].y * rstd); w2.y = pk2(v[j].z * rstd, v[j].w * rstd); o8[64 * j] = w2; }
}
__device__ __forceinline__ void rms_rows(const float* x, bf16_t* xn16, unsigned char* xn8, int m0, int step, int lane) {
    if (m0 >= M) return;
    f32x4 cur[4], nxt[4];
#pragma unroll
    for (int j = 0; j < 4; ++j) cur[j] = ((const f32x4*)(x + (size_t)m0 * D) + lane)[64 * j];
    for (int m = m0; m < M; m += step) {
        const int mn = (m + step < M) ? m + step : m;
#pragma unroll
        for (int j = 0; j < 4; ++j) nxt[j] = ((const f32x4*)(x + (size_t)mn * D) + lane)[64 * j];
        rms_rows_emit(cur, xn16 + (size_t)m * D, xn8 + (size_t)m * D, lane);
#pragma unroll
        for (int j = 0; j < 4; ++j) cur[j] = nxt[j];
    }
}
__device__ __forceinline__ void rms_row_to_bf16(const float* xrow, bf16_t* orow, int lane) {
    const f32x4* xr = (const f32x4*)xrow + lane;
    f32x4 v[4]; float s = 0.f;
#pragma unroll
    for (int j = 0; j < 4; ++j) { v[j] = xr[64 * j]; s += (v[j].x * v[j].x + v[j].y * v[j].y) + (v[j].z * v[j].z + v[j].w * v[j].w); }
    const float rstd = 1.f / sqrtf(wave_sum(s) * (1.f / D) + EPS);
    u32x2* o8 = (u32x2*)orow + lane;
#pragma unroll
    for (int j = 0; j < 4; ++j) { u32x2 w; w.x = pk2(v[j].x * rstd, v[j].y * rstd); w.y = pk2(v[j].z * rstd, v[j].w * rstd); o8[64 * j] = w; }
}

__device__ __forceinline__ void prep_phase(const Ptrs& P, unsigned char* shm, int G, int bx) {
    int tid_l = threadIdx.x; asm volatile("" : "+v"(tid_l));
    const int lane = tid_l & 63; const int wave = __builtin_amdgcn_readfirstlane(tid_l >> 6);
    const int gw = bx * 8 + wave, NGW = G * 8;
    float* scr = (float*)(shm + wave * (64 * 33 * 4));
    unsigned char* ws = P.ws;
    constexpr int N_BF = 1024;
    constexpr int I_INB = (D / 64) * (N_BF / 32), I_IN8 = (D / 64) * ((INW - N_BF) / 32), I_IN = I_INB + I_IN8, I_Q = (D / 64) * (PQ / 32), I_OUT = (D / 64) * (D / 32), I_PA = (512 / 64) * (D / 32);
    constexpr int NIT = I_IN + I_Q + I_OUT + 2 * I_PA;
    for (int it = gw; it < NIT; it += NGW) {
        int r = it;
        if (r < I_INB) { transpose_item(P.w_in, D, N_BF, P.norm_mix, (bf16_t*)(ws + WS_WIN), scr, r, lane, 0, 0, INW); continue; } r -= I_INB;
        if (r < I_IN8) { transpose_item8(P.w_in + N_BF, D, INW - N_BF, INW, P.norm_mix, WIN_SCALE, ws + WS_WIN8, scr, r, lane); continue; } r -= I_IN8;
        if (r < I_Q) { transpose_item(P.w_query, D, PQ, P.norm_ffn, (bf16_t*)(ws + WS_WQ), scr, r, lane); continue; } r -= I_Q;
        if (r < I_OUT) { transpose_item(P.w_out, D, D, nullptr, (bf16_t*)(ws + WS_WOUT), scr, r, lane); continue; } r -= I_OUT;
        if (r < I_PA) { transpose_item(P.w_pa, 512, D, nullptr, (bf16_t*)(ws + WS_WPA), scr, r, lane, 1024, 0); continue; } r -= I_PA;
        transpose_item(P.w_pb, 512, D, nullptr, (bf16_t*)(ws + WS_WPA), scr, r, lane, 1024, 512);
    }
    rms_rows(P.x, (bf16_t*)(ws + WS_XN), ws + WS_XN8, gw, NGW, lane);
    const size_t gt = (size_t)bx * 512 + threadIdx.x, NT = (size_t)G * 512;
    for (size_t i = gt; i < (size_t)16 * 128 * 128 / 8; i += NT) cvt8(P.sub_keys, (bf16_t*)(ws + WS_SK), i);
    for (size_t i = gt; i < (size_t)SEQ * 8; i += NT) {
        const int pos = (int)(i >> 3), k = (int)(i & 7);
        const float inv = k == 0 ? 1.0f : k == 1 ? 0.19392274f : k == 2 ? 0.03760603f : k == 3 ? 0.0072926646f : k == 4 ? 0.0014142136f : k == 5 ? 0.0002742482f : k == 6 ? 5.3182957e-05f : 1.0313385e-05f;
        const float ang = (float)pos * inv;
        float sn, cs; sincosf(ang, &sn, &cs);
        float* t = (float*)(ws + WS_ROPE) + (size_t)pos * 16;
        t[k] = cs; t[8 + k] = sn;
    }
}
__device__ __forceinline__ void cvt_row_fp8(const f32x4 (&rv)[4], unsigned char* dst, float* inv_scale, int lane) {
    const f32x4 a = rv[0], b = rv[1], c = rv[2], d = rv[3];
    float m = fmaxf(fmaxf(fmaxf(fabsf(a.x), fabsf(a.y)), fmaxf(fabsf(a.z), fabsf(a.w))), fmaxf(fmaxf(fabsf(b.x), fabsf(b.y)), fmaxf(fabsf(b.z), fabsf(b.w))));
    m = fmaxf(m, fmaxf(fmaxf(fmaxf(fabsf(c.x), fabsf(c.y)), fmaxf(fabsf(c.z), fabsf(c.w))), fmaxf(fmaxf(fabsf(d.x), fabsf(d.y)), fmaxf(fabsf(d.z), fabsf(d.w)))));
#pragma unroll
    for (int o = 1; o < 64; o <<= 1) m = fmaxf(m, __shfl_xor(m, o));
    m = fmaxf(m, 1e-30f);
    const float sc = 256.f / m;
    u32x4 w;
    w.x = __builtin_amdgcn_cvt_pk_fp8_f32(a.x * sc, a.y * sc, 0u, false); w.x = __builtin_amdgcn_cvt_pk_fp8_f32(a.z * sc, a.w * sc, w.x, true);
    w.y = __builtin_amdgcn_cvt_pk_fp8_f32(b.x * sc, b.y * sc, 0u, false); w.y = __builtin_amdgcn_cvt_pk_fp8_f32(b.z * sc, b.w * sc, w.y, true);
    w.z = __builtin_amdgcn_cvt_pk_fp8_f32(c.x * sc, c.y * sc, 0u, false); w.z = __builtin_amdgcn_cvt_pk_fp8_f32(c.z * sc, c.w * sc, w.z, true);
    w.w = __builtin_amdgcn_cvt_pk_fp8_f32(d.x * sc, d.y * sc, 0u, false); w.w = __builtin_amdgcn_cvt_pk_fp8_f32(d.z * sc, d.w * sc, w.w, true);
    *(u32x4*)(dst + (size_t)(lane >> 5) * (NEXP * 512) + (lane & 31) * 16) = w;
    if (lane == 0) *inv_scale = m * (1.f / 256.f);
}
__device__ __forceinline__ unsigned nib4(float v, float sc) { const int q = (int)rintf(fminf(fmaxf(v * sc, -7.f), 7.f)); return (unsigned)q & 15u; }
__device__ __forceinline__ unsigned pack_i4x8(const f32x4& a, const f32x4& b, float sc) {
    return nib4(a.x, sc) | (nib4(a.y, sc) << 4) | (nib4(a.z, sc) << 8) | (nib4(a.w, sc) << 12) | (nib4(b.x, sc) << 16) | (nib4(b.y, sc) << 20) | (nib4(b.z, sc) << 24) | (nib4(b.w, sc) << 28);
}
__device__ __forceinline__ void cvt_row_i4(const f32x4 (&rv)[4], unsigned char* dst, float* inv_scale, int lane) {
    const f32x4 a = rv[0], b = rv[1], c = rv[2], d = rv[3];
    float ss = ((a.x * a.x + a.y * a.y) + (a.z * a.z + a.w * a.w)) + ((b.x * b.x + b.y * b.y) + (b.z * b.z + b.w * b.w));
    ss += ((c.x * c.x + c.y * c.y) + (c.z * c.z + c.w * c.w)) + ((d.x * d.x + d.y * d.y) + (d.z * d.z + d.w * d.w));
#pragma unroll
    for (int o = 1; o < 64; o <<= 1) ss += __shfl_xor(ss, o);
    const float rms = fmaxf(sqrtf(ss * (1.f / D)), 1e-30f);
    const float sc = 2.8f / rms;
    u32x2 w; w.x = pack_i4x8(a, b, sc); w.y = pack_i4x8(c, d, sc);
    *(u32x2*)(dst + (size_t)(lane >> 5) * (NEXP * 256) + (lane & 15) * 16 + ((lane >> 4) & 1) * 8) = w;
    if (lane == 0) *inv_scale = rms * (2.5f / 7.f);
}
__device__ __forceinline__ unsigned pack_i8x4(float a, float b, float c, float d) {
    const int q0 = (int)rintf(a), q1 = (int)rintf(b), q2 = (int)rintf(c), q3 = (int)rintf(d);
    return (unsigned)(q0 & 0xff) | ((unsigned)(q1 & 0xff) << 8) | ((unsigned)(q2 & 0xff) << 16) | ((unsigned)q3 << 24);
}
__device__ __forceinline__ void cvt_row_i8(const f32x4 (&rv)[4], unsigned char* dst, float* inv_scale, int lane) {
    const f32x4 a = rv[0], b = rv[1], c = rv[2], d = rv[3];
    float m = fmaxf(fmaxf(fmaxf(fabsf(a.x), fabsf(a.y)), fmaxf(fabsf(a.z), fabsf(a.w))), fmaxf(fmaxf(fabsf(b.x), fabsf(b.y)), fmaxf(fabsf(b.z), fabsf(b.w))));
    m = fmaxf(m, fmaxf(fmaxf(fmaxf(fabsf(c.x), fabsf(c.y)), fmaxf(fabsf(c.z), fabsf(c.w))), fmaxf(fmaxf(fabsf(d.x), fabsf(d.y)), fmaxf(fabsf(d.z), fabsf(d.w)))));
#pragma unroll
    for (int o = 1; o < 64; o <<= 1) m = fmaxf(m, __shfl_xor(m, o));
    m = fmaxf(m, 1e-30f);
    const float sc = 127.f / m;
    u32x4 w;
    w.x = pack_i8x4(a.x * sc, a.y * sc, a.z * sc, a.w * sc); w.y = pack_i8x4(b.x * sc, b.y * sc, b.z * sc, b.w * sc);
    w.z = pack_i8x4(c.x * sc, c.y * sc, c.z * sc, c.w * sc); w.w = pack_i8x4(d.x * sc, d.y * sc, d.z * sc, d.w * sc);
    *(u32x4*)(dst + (size_t)(lane >> 5) * (NEXP * 512) + (lane & 31) * 16) = w;
    if (lane == 0) *inv_scale = m * (1.f / 127.f);
}
__device__ __forceinline__ void cvt_experts_phase(const Ptrs& P, int G, int bx) {
    int tid_l = threadIdx.x; asm volatile("" : "+v"(tid_l));
    const int lane = tid_l & 63; const int wave = __builtin_amdgcn_readfirstlane(tid_l >> 6);
    const int step = G * 8; int r = bx * 8 + wave;
    if (r >= 2 * NEXP) return;
    f32x4 cur[4], nxt[4];
    { const float* src = (r < NEXP ? P.peer_u + (size_t)r * D : P.peer_v + (size_t)(r - NEXP) * D);
#pragma unroll
      for (int j = 0; j < 4; ++j) cur[j] = ((const f32x4*)src + lane * 4)[j]; }
    for (; r < 2 * NEXP; r += step) {
        const int rn = (r + step < 2 * NEXP) ? r + step : r;
        const float* srcn = (rn < NEXP ? P.peer_u + (size_t)rn * D : P.peer_v + (size_t)(rn - NEXP) * D);
#pragma unroll
        for (int j = 0; j < 4; ++j) nxt[j] = ((const f32x4*)srcn + lane * 4)[j];
        if (r < NEXP) cvt_row_i8(cur, P.ws + WS_U + (size_t)r * 512, (float*)(P.ws + WS_SU) + r, lane);
        else { const int e = r - NEXP; cvt_row_fp8(cur, P.ws + WS_V + (size_t)e * 512, (float*)(P.ws + WS_SV) + e, lane); }
#pragma unroll
        for (int j = 0; j < 4; ++j) cur[j] = nxt[j];
    }
}

namespace pg8 {
#define PG8_LAS __attribute__((address_space(3)))
typedef unsigned short bf16_t;
typedef short bf16x8 __attribute__((ext_vector_type(8)));
typedef float f32x4 __attribute__((ext_vector_type(4)));
typedef unsigned u32x4 __attribute__((ext_vector_type(4)));
typedef int v8i_t __attribute__((ext_vector_type(8)));
constexpr int BM = 256, BK = 64, HALF = 128, HTB = HALF * BK * 2  , STAGE_BYTES = 8 * HTB, NXCD = 8, WGM = 4;

__host__ __device__ __forceinline__ int lds_byte(int r, int c) { const int st = (r >> 4) * 2 + (c >> 5), rr = r & 15, cc = c & 31, ob = rr * 64 + cc * 2; return st * 1024 + (ob ^ (((ob >> 9) & 1) << 5)); }
__host__ __device__ __forceinline__ void stage_rc(int b, int& R, int& C) { const int st = b / 1024, sb = b % 1024, swz = sb ^ (((sb >> 9) & 1) << 5); R = (st >> 1) * 16 + swz / 64; C = (st & 1) * 32 + (swz % 64) / 2; }
__host__ __device__ __forceinline__ int perm32(int rho) { const int n = rho >> 4, i = rho & 15; return 8 * (i >> 2) + 4 * n + (i & 3); }

struct Unit { int pm, pn; };
struct Gemm { const bf16_t* A; const bf16_t* Bt; int M, N, K, pad; };

struct StaticOrder {
    int nM, nN, nwg, G, c;
    __host__ __device__ void init(int M, int N, int G_, int c_) { nM = M / BM; nN = N / BM; nwg = nM * nN; G = G_; c = c_; }
    __host__ __device__ bool next(int i, Unit& u) const {
        const long L = (long)i * G + c; if (L >= nwg) return false;
        int wgid = (int)L; { const int q = nwg / NXCD, r = nwg % NXCD, xcd = wgid % NXCD, off = wgid / NXCD; wgid = (xcd < r ? xcd * (q + 1) : r * (q + 1) + (xcd - r) * q) + off; }
        const int nig = WGM * nN, gid = wgid / nig, fm = gid * WGM, gsz = (nM - fm) < WGM ? (nM - fm) : WGM;
        u.pm = fm + ((wgid % nig) % gsz); u.pn = (wgid % nig) / gsz; return true;
    }
    __device__ __forceinline__ void a_ready(const Unit&) const {}
    __device__ __forceinline__ void done(const Unit&) const {}
};
__device__ __forceinline__ unsigned cvt_pk_bf16(float lo, float hi) { unsigned r; asm volatile("v_cvt_pk_bf16_f32 %0, %1, %2" : "=v"(r) : "v"(lo), "v"(hi)); return r; }
typedef float f32x2 __attribute__((ext_vector_type(2)));

__device__ __forceinline__ float sigm(float x) { return __builtin_amdgcn_rcpf(1.f + __builtin_amdgcn_exp2f(-1.4426950408889634f * x)); }
struct EpiProj {
    static constexpr bool PERM = true, AFTER_DRAIN = false, MID = false;
    bf16_t* O; const float* rope; float osc; int pn0;
    __device__ __forceinline__ void operator()(const f32x4 (&acc)[2][2][4][2], const Unit& u, int wr, int wc, int fr_, int fq_) const {
        int fr = fr_, fq = fq_; asm volatile("" : "+v"(fr), "+v"(fq));
        const int pn = u.pn + pn0;
        const int row0 = u.pm * BM + wr * 64 + fr, col0 = pn * BM + wc * 32 + 8 * fq;
        const float sc = ((pn < 2 || pn == 6 || pn == 7) ? QSCALE : 1.f) * osc;
        const bool dorope = (pn < 4) && ((wc & 1) == 0);
#pragma unroll
        for (int ai = 0; ai < 2; ++ai)
#pragma unroll
            for (int m = 0; m < 4; ++m) { const int row = row0 + ai * HALF + m * 16; bf16_t* rowp = O + (size_t)row * INW + col0;
                f32x4 c4[2] = {{1.f, 1.f, 1.f, 1.f}, {1.f, 1.f, 1.f, 1.f}}, s4[2] = {{0.f, 0.f, 0.f, 0.f}, {0.f, 0.f, 0.f, 0.f}};
                if (dorope) { const float* rp = rope + (size_t)(row & (SEQ - 1)) * 16; c4[0] = *(const f32x4*)(rp); c4[1] = *(const f32x4*)(rp + 4); s4[0] = *(const f32x4*)(rp + 8); s4[1] = *(const f32x4*)(rp + 12); }
#pragma unroll
                for (int bj = 0; bj < 2; ++bj) { f32x4 v0 = acc[ai][bj][m][0], v1 = acc[ai][bj][m][1];
                    if (dorope) { f32x4 o0, o1;
#pragma unroll
                        for (int j = 0; j < 4; ++j) { o0[j] = __shfl_xor(v0[j], 16); o1[j] = __shfl_xor(v1[j], 16); }
                        if (fq == 0) { v0 = v0 * c4[0] - o0 * s4[0]; v1 = v1 * c4[1] - o1 * s4[1]; }
                        else if (fq == 1) { v0 = v0 * c4[0] + o0 * s4[0]; v1 = v1 * c4[1] + o1 * s4[1]; } }
                    v0 = v0 * sc; v1 = v1 * sc; u32x4 w; w.x = cvt_pk_bf16(v0[0], v0[1]); w.y = cvt_pk_bf16(v0[2], v0[3]); w.z = cvt_pk_bf16(v1[0], v1[1]); w.w = cvt_pk_bf16(v1[2], v1[3]);
                    *(u32x4*)(rowp + bj * HALF) = w; } }
    }
};
struct EpiGate2 {
    static constexpr bool PERM = true, AFTER_DRAIN = false, MID = true;
    const bf16_t* proj; bf16_t* O;
    __device__ __forceinline__ void mid(f32x4 (&acc)[2][2][4][2], const Unit& u, int wr, int wc, int fr, int fq) const {
        int row0 = u.pm * BM + wr * 64 + fr, col0 = u.pn * BM + wc * 32 + 8 * fq;
        asm volatile("" : "+v"(row0), "+v"(col0));
#pragma unroll
        for (int ai = 0; ai < 2; ++ai) {
            u32x4 gav[4][2], gbv[4][2];
#pragma unroll
            for (int m = 0; m < 4; ++m)
#pragma unroll
                for (int bj = 0; bj < 2; ++bj) { const bf16_t* gp = proj + (size_t)(row0 + ai * HALF + m * 16) * INW + col0 + bj * HALF; gav[m][bj] = *(const u32x4*)(gp + C_GA); gbv[m][bj] = *(const u32x4*)(gp + C_GB); }
#pragma unroll
            for (int m = 0; m < 4; ++m) {
#pragma unroll
                for (int bj = 0; bj < 2; ++bj) { const u32x4 ga = gav[m][bj], gb = gbv[m][bj];
                    const unsigned a_[4] = {ga.x, ga.y, ga.z, ga.w}, b_[4] = {gb.x, gb.y, gb.z, gb.w};
#pragma unroll
                    for (int q = 0; q < 4; ++q) {
                        const float r0 = (1.f + __builtin_amdgcn_exp2f(-1.4426950408889634f * bflo(b_[q]))) * __builtin_amdgcn_rcpf(1.f + __builtin_amdgcn_exp2f(-1.4426950408889634f * bflo(a_[q])));
                        const float r1 = (1.f + __builtin_amdgcn_exp2f(-1.4426950408889634f * bfhi(b_[q]))) * __builtin_amdgcn_rcpf(1.f + __builtin_amdgcn_exp2f(-1.4426950408889634f * bfhi(a_[q])));
                        acc[ai][bj][m][q >> 1][(q & 1) * 2] *= r0; acc[ai][bj][m][q >> 1][(q & 1) * 2 + 1] *= r1; } } }
            asm volatile("" ::: "memory"); }
    }
    __device__ __forceinline__ void operator()(const f32x4 (&acc)[2][2][4][2], const Unit& u, int wr, int wc, int fr_, int fq_) const {
        int fr = fr_, fq = fq_; asm volatile("" : "+v"(fr), "+v"(fq));
        const int row0 = u.pm * BM + wr * 64 + fr, col0 = u.pn * BM + wc * 32 + 8 * fq;
#pragma unroll
        for (int ai = 0; ai < 2; ++ai) {
            u32x4 gv[4][2];
#pragma unroll
            for (int m = 0; m < 4; ++m)
#pragma unroll
                for (int bj = 0; bj < 2; ++bj) gv[m][bj] = *(const u32x4*)(proj + (size_t)(row0 + ai * HALF + m * 16) * INW + C_GB + col0 + bj * HALF);
#pragma unroll
            for (int m = 0; m < 4; ++m) { const int row = row0 + ai * HALF + m * 16;
#pragma unroll
                for (int bj = 0; bj < 2; ++bj) { const int col = col0 + bj * HALF; const u32x4 g = gv[m][bj];
                    f32x4 v0 = acc[ai][bj][m][0], v1 = acc[ai][bj][m][1];
                    v0[0] *= sigm(bflo(g.x)); v0[1] *= sigm(bfhi(g.x)); v0[2] *= sigm(bflo(g.y)); v0[3] *= sigm(bfhi(g.y));
                    v1[0] *= sigm(bflo(g.z)); v1[1] *= sigm(bfhi(g.z)); v1[2] *= sigm(bflo(g.w)); v1[3] *= sigm(bfhi(g.w));
                    u32x4 w; w.x = cvt_pk_bf16(v0[0], v0[1]); w.y = cvt_pk_bf16(v0[2], v0[3]); w.z = cvt_pk_bf16(v1[0], v1[1]); w.w = cvt_pk_bf16(v1[2], v1[3]);
                    *(u32x4*)(O + (size_t)row * D + col) = w; } }
            asm volatile("" ::: "memory"); }
    }
};
struct EpiHout {
    static constexpr bool PERM = true, AFTER_DRAIN = false, MID = false;
    const float* x; float* H; bf16_t* HB; float* ssq16;
    __device__ __forceinline__ void operator()(const f32x4 (&acc)[2][2][4][2], const Unit& u, int wr, int wc, int fr_, int fq_) const {
        int fr = fr_, fq = fq_; asm volatile("" : "+v"(fr), "+v"(fq));
        const int row0 = u.pm * BM + wr * 64 + fr, col0 = u.pn * BM + wc * 32 + 8 * fq;
#pragma unroll
        for (int ai = 0; ai < 2; ++ai) {
            f32x4 xv[4][2][2];
#pragma unroll
            for (int m = 0; m < 4; ++m)
#pragma unroll
                for (int bj = 0; bj < 2; ++bj) { const float* xp = x + (size_t)(row0 + ai * HALF + m * 16) * D + col0 + bj * HALF; xv[m][bj][0] = *(const f32x4*)xp; xv[m][bj][1] = *(const f32x4*)(xp + 4); }
#pragma unroll
            for (int m = 0; m < 4; ++m) { const int row = row0 + ai * HALF + m * 16; float ss = 0.f;
#pragma unroll
                for (int bj = 0; bj < 2; ++bj) { const int col = col0 + bj * HALF;
                    const f32x4 v0 = acc[ai][bj][m][0] + xv[m][bj][0], v1 = acc[ai][bj][m][1] + xv[m][bj][1];
                    u32x4 w; w.x = cvt_pk_bf16(v0[0], v0[1]); w.y = cvt_pk_bf16(v0[2], v0[3]); w.z = cvt_pk_bf16(v1[0], v1[1]); w.w = cvt_pk_bf16(v1[2], v1[3]);
                    *(u32x4*)(HB + (size_t)row * D + col) = w;
                    ss += (v0[0] * v0[0] + v0[1] * v0[1]) + (v0[2] * v0[2] + v0[3] * v0[3]) + (v1[0] * v1[0] + v1[1] * v1[1]) + (v1[2] * v1[2] + v1[3] * v1[3]); }
                ss += __shfl_xor(ss, 16); ss += __shfl_xor(ss, 32);
                if (fq == 0) ssq16[(size_t)row * 16 + u.pn * 4 + wc] = ss; }
            asm volatile("" ::: "memory"); }
    }
};
struct EpiQ {
    static constexpr bool PERM = true, AFTER_DRAIN = false, MID = false;
    const float* ssq16; bf16_t* O;
    __device__ __forceinline__ void operator()(const f32x4 (&acc)[2][2][4][2], const Unit& u, int wr, int wc, int fr, int fq) const {
        const int row0 = u.pm * BM + wr * 64 + fr, col0 = u.pn * BM + wc * 32 + 8 * fq;
#pragma unroll
        for (int ai = 0; ai < 2; ++ai)
#pragma unroll
            for (int m = 0; m < 4; ++m) { const int row = row0 + ai * HALF + m * 16; const f32x4* sp = (const f32x4*)(ssq16 + (size_t)row * 16);
                const f32x4 a = sp[0], b = sp[1], c = sp[2], d = sp[3];
                const float tot = ((a[0] + a[1]) + (a[2] + a[3])) + ((b[0] + b[1]) + (b[2] + b[3])) + ((c[0] + c[1]) + (c[2] + c[3])) + ((d[0] + d[1]) + (d[2] + d[3]));
                const float rstd = 1.f / sqrtf(tot * (1.f / D) + EPS);
#pragma unroll
                for (int bj = 0; bj < 2; ++bj) { const f32x4 v0 = acc[ai][bj][m][0] * rstd, v1 = acc[ai][bj][m][1] * rstd;
                    u32x4 w; w.x = cvt_pk_bf16(v0[0], v0[1]); w.y = cvt_pk_bf16(v0[2], v0[3]); w.z = cvt_pk_bf16(v1[0], v1[1]); w.w = cvt_pk_bf16(v1[2], v1[3]);
                    *(u32x4*)(O + (size_t)row * PQ + col0 + bj * HALF) = w; } }
    }
};
template <class Epi, class Sched, bool ALIGN_EPI = false, bool SP2 = false, bool FP8 = false>
__device__ __forceinline__ void gemm_phase(PG8_LAS unsigned char* lds, const Gemm g, const Sched& S, const Epi& E) {
    int tid_l = threadIdx.x; asm volatile("" : "+v"(tid_l));
    const int tid = tid_l, wid = __builtin_amdgcn_readfirstlane(tid >> 6), lane = tid & 63, wr = wid >> 2, wc = wid & 3, fr = lane & 15, fq = lane >> 4;
    const int K = g.K, nt = K / BK;
    unsigned voffA[2], voffB[2];
#pragma unroll
    for (int i = 0; i < 2; ++i) { int R, C; stage_rc(tid * 16 + i * 8192, R, C); const int Rb = Epi::PERM ? ((R & ~31) + perm32(R & 31)) : R;
        voffA[i] = (unsigned)(R * K + C) * 2u; voffB[i] = (unsigned)(Rb * K + C) * 2u; }
    const size_t kstep = (size_t)(BK * 2);
    const size_t hstep = (size_t)HALF * K * 2;
    const size_t tstep = 2 * hstep;
    const unsigned ldsw = (unsigned)wid * 1024u;
    const int aoff = lds_byte(wr * 64 + fr, fq * 8), boff = lds_byte(wc * 32 + fr, fq * 8);
    const int aoffF0 = FP8 ? lds_byte(wr * 64 + fr, fq * 16) : 0, boffF0 = FP8 ? lds_byte(wc * 32 + fr, fq * 16) : 0;
#define PG8_SA(b, h) (((b) * 2 + (h)) * HTB)
#define PG8_SB(b, h) ((4 + (b) * 2 + (h)) * HTB)
#define PG8_STAGE(bufoff, gbase, voff) do { _Pragma("unroll") for (int _i = 0; _i < 2; ++_i) \
        __builtin_amdgcn_global_load_lds((const unsigned*)((const char*)(gbase) + (voff)[_i]), (PG8_LAS unsigned*)(lds + (bufoff) + ldsw + _i * 8192), 16, 0, 0); } while (0)
#define PG8_LDA(dst, b, h) do { if constexpr (FP8) { _Pragma("unroll") for (int m = 0; m < 4; ++m) { const u32x4 l_ = *(const PG8_LAS u32x4*)(lds + PG8_SA(b, h) + aoffF0 + m * 2048), h_ = *(const PG8_LAS u32x4*)(lds + PG8_SA(b, h) + aoffF0 + m * 2048 + 16); \
            dst##8[m] = (v8i_t){(int)l_.x, (int)l_.y, (int)l_.z, (int)l_.w, (int)h_.x, (int)h_.y, (int)h_.z, (int)h_.w}; } } \
        else { _Pragma("unroll") for (int m = 0; m < 4; ++m) _Pragma("unroll") for (int k = 0; k < 2; ++k) dst[m][k] = *(const PG8_LAS bf16x8*)(lds + PG8_SA(b, h) + aoff + m * 2048 + k * 1024); } } while (0)
#define PG8_LDB(dst, b, h) do { if constexpr (FP8) { _Pragma("unroll") for (int n = 0; n < 2; ++n) { const u32x4 l_ = *(const PG8_LAS u32x4*)(lds + PG8_SB(b, h) + boffF0 + n * 2048), h_ = *(const PG8_LAS u32x4*)(lds + PG8_SB(b, h) + boffF0 + n * 2048 + 16); \
            dst##8[n] = (v8i_t){(int)l_.x, (int)l_.y, (int)l_.z, (int)l_.w, (int)h_.x, (int)h_.y, (int)h_.z, (int)h_.w}; } } \
        else { _Pragma("unroll") for (int n = 0; n < 2; ++n) _Pragma("unroll") for (int k = 0; k < 2; ++k) dst[n][k] = *(const PG8_LAS bf16x8*)(lds + PG8_SB(b, h) + boff + n * 2048 + k * 1024); } } while (0)
#define PG8_MMA(ai, bj, At, Bt) do { __builtin_amdgcn_s_setprio(1); \
        if constexpr (FP8) { _Pragma("unroll") for (int m = 0; m < 4; ++m) _Pragma("unroll") for (int n = 0; n < 2; ++n) \
            asm volatile("v_mfma_scale_f32_16x16x128_f8f6f4 %0, %1, %2, %0, %3, %3 op_sel_hi:[0,0,0]" : "+v"(acc[ai][bj][m][n]) : "v"(Bt##8[n]), "v"(At##8[m]), "v"(mxone)); } \
        else { _Pragma("unroll") for (int m = 0; m < 4; ++m) _Pragma("unroll") for (int n = 0; n < 2; ++n) _Pragma("unroll") for (int k = 0; k < 2; ++k) \
            acc[ai][bj][m][n] = __builtin_amdgcn_mfma_f32_16x16x32_bf16(Bt[n][k], At[m][k], acc[ai][bj][m][n], 0, 0, 0); } \
        __builtin_amdgcn_s_setprio(0); } while (0)
#define PG8_WAIT_V(n) asm volatile("s_waitcnt vmcnt(" #n ")" ::: "memory")
#define PG8_WAIT_L(n) asm volatile("s_waitcnt lgkmcnt(" #n ")" ::: "memory")
#define PG8_BAR __builtin_amdgcn_s_barrier()
#define PG8_SCHED __builtin_amdgcn_sched_barrier(0)
    Unit cur, nxt; int ui = 0;
    if (!S.next(0, cur)) return;
    f32x4 acc[2][2][4][2];
#pragma unroll
    for (int a = 0; a < 2; ++a)
#pragma unroll
        for (int b = 0; b < 2; ++b)
#pragma unroll
            for (int m = 0; m < 4; ++m)
#pragma unroll
                for (int n = 0; n < 2; ++n) acc[a][b][m][n] = (f32x4){0.f, 0.f, 0.f, 0.f};
    bf16x8 At[4][2], B0[2][2], B1[2][2]; v8i_t At8[4], B08[2], B18[2];
    int mxone = 0x7F7F7F7F; asm volatile("" : "+v"(mxone));
    const char* cA = (const char*)g.A + (size_t)cur.pm * tstep; const char* cB = (const char*)g.Bt + (size_t)cur.pn * tstep;
    S.a_ready(cur);
    if constexpr (SP2) {
        PG8_STAGE(PG8_SB(0, 0), cB, voffB); PG8_STAGE(PG8_SB(0, 1), cB + hstep, voffB); PG8_STAGE(PG8_SA(0, 0), cA, voffA); PG8_STAGE(PG8_SA(0, 1), cA + hstep, voffA);
        if (wr == 1) PG8_BAR;
        PG8_WAIT_V(2); PG8_BAR;
        PG8_STAGE(PG8_SB(1, 0), cB + kstep, voffB); PG8_STAGE(PG8_SA(1, 0), cA + kstep, voffA); PG8_STAGE(PG8_SB(1, 1), cB + hstep + kstep, voffB);
        PG8_WAIT_V(6); PG8_BAR;
    } else {
        PG8_STAGE(PG8_SB(0, 0), cB, voffB); PG8_STAGE(PG8_SA(0, 0), cA, voffA); PG8_STAGE(PG8_SB(0, 1), cB + hstep, voffB); PG8_STAGE(PG8_SA(0, 1), cA + hstep, voffA);
        if (wr == 1) PG8_BAR;
        PG8_WAIT_V(4); PG8_BAR;
        PG8_STAGE(PG8_SB(1, 0), cB + kstep, voffB); PG8_STAGE(PG8_SA(1, 0), cA + kstep, voffA); PG8_STAGE(PG8_SB(1, 1), cB + hstep + kstep, voffB);
        PG8_WAIT_V(6); PG8_BAR;
    }
    for (;;) {
        const bool has_next = S.next(ui + 1, nxt);
        const char* nA = has_next ? (const char*)g.A + (size_t)nxt.pm * tstep : cA; const char* nB = has_next ? (const char*)g.Bt + (size_t)nxt.pn * tstep : cB;
#pragma unroll 1
        for (int t = 0; t < nt; t += 2) {
            if constexpr (Epi::MID) { if (t == nt / 2) E.mid(acc, cur, wr, wc, fr, fq); }
            const bool last = (t == nt - 2);
            const char* a1 = cA + (size_t)(t + 1) * kstep;
            const char* a2 = last ? nA : cA + (size_t)(t + 2) * kstep; const char* b2 = last ? nB : cB + (size_t)(t + 2) * kstep;
            const char* a3 = a2 + kstep; const char* b3 = b2 + kstep;
            if (last && has_next) S.a_ready(nxt);
            if constexpr (SP2) {
            PG8_LDB(B0, 0, 0); PG8_LDB(B1, 0, 1); PG8_SCHED; PG8_LDA(At, 0, 0); PG8_STAGE(PG8_SA(1, 1), a1 + hstep, voffA);
            PG8_WAIT_V(8); PG8_WAIT_L(0); PG8_BAR; PG8_MMA(0, 0, At, B0); PG8_MMA(0, 1, At, B1); PG8_BAR; PG8_SCHED;
            PG8_LDA(At, 0, 1); PG8_STAGE(PG8_SB(0, 0), b2, voffB); PG8_STAGE(PG8_SB(0, 1), b2 + hstep, voffB); PG8_STAGE(PG8_SA(0, 0), a2, voffA);
            PG8_WAIT_V(8); PG8_WAIT_L(0); PG8_BAR; PG8_MMA(1, 0, At, B0); PG8_MMA(1, 1, At, B1); PG8_BAR; PG8_SCHED;
            PG8_LDB(B0, 1, 0); PG8_LDB(B1, 1, 1); PG8_SCHED; PG8_LDA(At, 1, 0); PG8_STAGE(PG8_SA(0, 1), a2 + hstep, voffA);
            PG8_WAIT_V(8); PG8_WAIT_L(0); PG8_BAR; PG8_MMA(0, 0, At, B0); PG8_MMA(0, 1, At, B1); PG8_BAR; PG8_SCHED;
            PG8_LDA(At, 1, 1); PG8_STAGE(PG8_SB(1, 0), b3, voffB); PG8_STAGE(PG8_SB(1, 1), b3 + hstep, voffB); PG8_STAGE(PG8_SA(1, 0), a3, voffA);
            PG8_WAIT_V(8); PG8_WAIT_L(0); PG8_BAR; PG8_MMA(1, 0, At, B0); PG8_MMA(1, 1, At, B1); PG8_BAR; PG8_SCHED;
            } else {
            PG8_LDB(B0, 0, 0); PG8_SCHED; PG8_LDA(At, 0, 0); PG8_STAGE(PG8_SA(1, 1), a1 + hstep, voffA);
            PG8_WAIT_L(8); PG8_BAR; PG8_WAIT_L(0); PG8_MMA(0, 0, At, B0); PG8_BAR; PG8_SCHED;
            PG8_LDB(B1, 0, 1); PG8_STAGE(PG8_SB(0, 0), b2, voffB);
            PG8_BAR; PG8_WAIT_L(0); PG8_MMA(0, 1, At, B1); PG8_BAR;
            PG8_LDA(At, 0, 1); PG8_STAGE(PG8_SA(0, 0), a2, voffA);
            PG8_BAR; PG8_WAIT_L(0); PG8_MMA(1, 0, At, B0); PG8_BAR; PG8_SCHED;
            PG8_STAGE(PG8_SB(0, 1), b2 + hstep, voffB);
            PG8_WAIT_V(6); PG8_BAR; PG8_MMA(1, 1, At, B1); PG8_BAR;
            PG8_LDB(B0, 1, 0); PG8_SCHED; PG8_LDA(At, 1, 0); PG8_STAGE(PG8_SA(0, 1), a2 + hstep, voffA);
            PG8_WAIT_L(8); PG8_BAR; PG8_WAIT_L(0); PG8_MMA(0, 0, At, B0); PG8_BAR; PG8_SCHED;
            PG8_LDB(B1, 1, 1); PG8_STAGE(PG8_SB(1, 0), b3, voffB);
            PG8_BAR; PG8_WAIT_L(0); PG8_MMA(0, 1, At, B1); PG8_BAR;
            PG8_LDA(At, 1, 1); PG8_STAGE(PG8_SA(1, 0), a3, voffA);
            PG8_BAR; PG8_WAIT_L(0); PG8_MMA(1, 0, At, B0); PG8_BAR; PG8_SCHED;
            PG8_STAGE(PG8_SB(1, 1), b3 + hstep, voffB);
            PG8_WAIT_V(6); PG8_BAR; PG8_MMA(1, 1, At, B1); PG8_BAR;
            }
        }
        if constexpr (ALIGN_EPI) { if (wr == 0) PG8_BAR; }
        if constexpr (FP8) { asm volatile("s_nop 15\n\ts_nop 7" ::: "memory"); PG8_SCHED; }
        if constexpr (!Epi::AFTER_DRAIN) { E(acc, cur, wr, wc, fr, fq); S.done(cur); }
        if (!has_next) break;
#pragma unroll
        for (int a = 0; a < 2; ++a)
#pragma unroll
            for (int b = 0; b < 2; ++b)
#pragma unroll
                for (int m = 0; m < 4; ++m)
#pragma unroll
                    for (int n = 0; n < 2; ++n) acc[a][b][m][n] = (f32x4){0.f, 0.f, 0.f, 0.f};
        cur = nxt; cA = nA; cB = nB; ++ui;
        if constexpr (ALIGN_EPI) { if (wr == 1) PG8_BAR; }
    }
    PG8_WAIT_V(0);
    if constexpr (!ALIGN_EPI) { if (wr == 0) PG8_BAR; }
    PG8_BAR;
    if constexpr (Epi::AFTER_DRAIN) { E.fused(acc, cur, wr, wc, fr, fq, lds, wid, lane); S.done(cur); }
#undef PG8_SA
#undef PG8_SB
#undef PG8_STAGE
#undef PG8_LDA
#undef PG8_LDB
#undef PG8_MMA
#undef PG8_WAIT_V
#undef PG8_WAIT_L
#undef PG8_BAR
#undef PG8_SCHED
}
}

__device__ __forceinline__ float lambda_full(const Ptrs& P) {
    float a = 0.f, b = 0.f;
    for (int i = 0; i < 64; ++i) { a += P.lq1[i] * P.lk1[i]; b += P.lq2[i] * P.lk2[i]; }
    return __expf(a) - __expf(b) + 0.2f;
}

namespace att {
typedef short bf16x8 __attribute__((ext_vector_type(8)));
typedef short s16x4 __attribute__((ext_vector_type(4)));
typedef float f32x16 __attribute__((ext_vector_type(16)));
typedef float f32x2_t __attribute__((ext_vector_type(2)));
typedef __attribute__((address_space(3))) const char* lds_cptr;
typedef __attribute__((address_space(3))) char* lds_ptr;
__device__ __forceinline__ int crow(int r, int hi) { return (r & 3) + 8 * (r >> 2) + 4 * hi; }
__device__ __forceinline__ void glds16(const void* gsrc, unsigned lds_dst) { unsigned keep;
    asm volatile("s_mov_b32 %0, m0\n\ts_mov_b32 m0, %2\n\ts_nop 0\n\tglobal_load_lds_dwordx4 %1, off\n\ts_mov_b32 m0, %0" : "=&s"(keep) : "v"(gsrc), "s"(lds_dst) : "memory"); }
__device__ __forceinline__ unsigned cvtpk(float lo, float hi) { f32x2_t v = {lo, hi}; bf16x2_t b = __builtin_convertvector(v, bf16x2_t); return __builtin_bit_cast(unsigned, b); }
#define ATT_WAIT_BAR(N) asm volatile("s_waitcnt vmcnt(" #N ") lgkmcnt(0)\n\ts_barrier" ::: "memory")
#define ATT_LDSWAIT() asm volatile("s_waitcnt lgkmcnt(0)" ::: "memory")
#define ATT_SBAR() __builtin_amdgcn_sched_barrier(0)
template <bool REL> __device__ __forceinline__ void qkt(f32x16& p0, f32x16& p1, lds_cptr Kslot, const bf16x8* qr, const f32x16& negm, int r32, int hi) {
    lds_cptr kb = Kslot + hi * 1024 + r32 * 16;
#pragma unroll
    for (int d0 = 0; d0 < 4; ++d0) {
        const bf16x8 b0 = *(const __attribute__((address_space(3))) bf16x8*)(kb + d0 * 2048);
        const bf16x8 b1 = *(const __attribute__((address_space(3))) bf16x8*)(kb + d0 * 2048 + 512);
        if (d0 == 0) { if (REL) { p0 = __builtin_amdgcn_mfma_f32_32x32x16_bf16(b0, qr[0], negm, 0, 0, 0); p1 = __builtin_amdgcn_mfma_f32_32x32x16_bf16(b1, qr[0], negm, 0, 0, 0); }
                       else { p0 = __builtin_amdgcn_mfma_f32_32x32x16_bf16(b0, qr[0], f32x16{}, 0, 0, 0); p1 = __builtin_amdgcn_mfma_f32_32x32x16_bf16(b1, qr[0], f32x16{}, 0, 0, 0); } }
        else { p0 = __builtin_amdgcn_mfma_f32_32x32x16_bf16(b0, qr[d0], p0, 0, 0, 0); p1 = __builtin_amdgcn_mfma_f32_32x32x16_bf16(b1, qr[d0], p1, 0, 0, 0); } }
}
__device__ __forceinline__ float rowmax32(const f32x16& p0, const f32x16& p1) {
    float a = fmaxf(p0[0], p1[0]);
#pragma unroll
    for (int r = 1; r < 16; ++r) a = fmaxf(a, fmaxf(p0[r], p1[r]));
    auto rr = __builtin_amdgcn_permlane32_swap(__float_as_uint(a), __float_as_uint(a), false, false);
    return fmaxf(__uint_as_float(rr[0]), __uint_as_float(rr[1]));
}
__device__ __forceinline__ float halfsum(float a) { auto rr = __builtin_amdgcn_permlane32_swap(__float_as_uint(a), __float_as_uint(a), false, false); return __uint_as_float(rr[0]) + __uint_as_float(rr[1]); }
#define ATT_VREAD(lo, hi, d0) do { _Pragma("unroll") for (int ks = 0; ks < 4; ++ks) { \
        asm volatile("ds_read_b64_tr_b16 %0,%1 offset:%c2" : "=&v"(lo[ks]) : "v"(vb), "i"((d0) * 4096 + ks * 1024) : "memory"); \
        asm volatile("ds_read_b64_tr_b16 %0,%1 offset:%c2" : "=&v"(hi[ks]) : "v"(vb), "i"((d0) * 4096 + ks * 1024 + 512) : "memory"); } } while (0)
#define ATT_PK(lo, hi, k) (bf16x8){lo[k][0], lo[k][1], lo[k][2], lo[k][3], hi[k][0], hi[k][1], hi[k][2], hi[k][3]}
#define ATT_PVMMA(lo, hi, d0) do { \
        o[d0] = __builtin_amdgcn_mfma_f32_32x32x16_bf16(pa0, ATT_PK(lo, hi, 0), o[d0], 0, 0, 0); o[d0] = __builtin_amdgcn_mfma_f32_32x32x16_bf16(pa1, ATT_PK(lo, hi, 1), o[d0], 0, 0, 0); \
        o[d0] = __builtin_amdgcn_mfma_f32_32x32x16_bf16(pa2, ATT_PK(lo, hi, 2), o[d0], 0, 0, 0); o[d0] = __builtin_amdgcn_mfma_f32_32x32x16_bf16(pa3, ATT_PK(lo, hi, 3), o[d0], 0, 0, 0); } while (0)
template <int ND0> __device__ __forceinline__ void pv(f32x16* o, int vb, bf16x8 pa0, bf16x8 pa1, bf16x8 pa2, bf16x8 pa3) {
    s16x4 loA[4], hiA[4], loB[4], hiB[4];
    ATT_VREAD(loA, hiA, 0);
#pragma unroll
    for (int d0 = 0; d0 < ND0; d0 += 2) {
        if (d0 + 1 < ND0) { ATT_VREAD(loB, hiB, d0 + 1); asm volatile("s_waitcnt lgkmcnt(8)" ::: "memory"); } else { asm volatile("s_waitcnt lgkmcnt(0)" ::: "memory"); }
        ATT_SBAR();
        ATT_PVMMA(loA, hiA, d0);
        if (d0 + 1 < ND0) {
            if (d0 + 2 < ND0) { ATT_VREAD(loA, hiA, d0 + 2); asm volatile("s_waitcnt lgkmcnt(8)" ::: "memory"); } else { asm volatile("s_waitcnt lgkmcnt(0)" ::: "memory"); }
            ATT_SBAR();
            ATT_PVMMA(loB, hiB, d0 + 1);
        }
    }
}
#undef ATT_VREAD
#undef ATT_PVMMA
#undef ATT_PK
template <int DEAD> __device__ __forceinline__ constexpr bool live0(int r) { return DEAD != 2 || r >= 12; }
template <int DEAD> __device__ __forceinline__ constexpr bool live1(int r) { return DEAD != 1 || r < 4; }
template <int ND0, int THR, bool REL, int DEAD = 0> __device__ __forceinline__ void softmax_tile(f32x16& p0, f32x16& p1, float& mrun, float& lsum, f32x16& negm, bool first, f32x16* o, __attribute__((address_space(3))) float* wsf, int r32, int hi,
                                                                   u32x4& pw0, u32x4& pw1, u32x4& pw2, u32x4& pw3) {
    float rm;
    if (DEAD == 0) rm = rowmax32(p0, p1);
    else { float a = -3e38f;
#pragma unroll
        for (int r = 0; r < 16; ++r) { if (live0<DEAD>(r)) a = fmaxf(a, p0[r]); if (live1<DEAD>(r)) a = fmaxf(a, p1[r]); }
        auto rr = __builtin_amdgcn_permlane32_swap(__float_as_uint(a), __float_as_uint(a), false, false); rm = fmaxf(__uint_as_float(rr[0]), __uint_as_float(rr[1])); }
    if (!REL) rm -= mrun;
    if (first) {
        mrun = REL ? rm : mrun + rm;
        if (REL) {
#pragma unroll
            for (int r = 0; r < 16; ++r) { if (live0<DEAD>(r)) p0[r] -= rm; if (live1<DEAD>(r)) p1[r] -= rm; negm[r] = -mrun; } }
    } else if (__any(rm > (float)THR)) {
        const float dl = fmaxf(rm, 0.f), alpha = __builtin_amdgcn_exp2f(-dl); lsum *= alpha; mrun += dl;
        if (REL) {
#pragma unroll
            for (int r = 0; r < 16; ++r) { if (live0<DEAD>(r)) p0[r] -= dl; if (live1<DEAD>(r)) p1[r] -= dl; negm[r] = -mrun; } }
        if (hi == 0) wsf[r32] = alpha;
        ATT_LDSWAIT();
#pragma unroll
        for (int g = 0; g < 4; ++g) { const f32x4 a4 = *(const __attribute__((address_space(3))) f32x4*)(wsf + 8 * g + 4 * hi);
#pragma unroll
            for (int d0 = 0; d0 < ND0; ++d0) { o[d0][4 * g + 0] *= a4[0]; o[d0][4 * g + 1] *= a4[1]; o[d0][4 * g + 2] *= a4[2]; o[d0][4 * g + 3] *= a4[3]; } }
        ATT_LDSWAIT();
    }
    float s = 0.f;
#pragma unroll
    for (int r = 0; r < 16; ++r) {
        if (live0<DEAD>(r)) { p0[r] = __builtin_amdgcn_exp2f(REL ? p0[r] : p0[r] - mrun); s += p0[r]; } else p0[r] = 0.f;
        if (live1<DEAD>(r)) { p1[r] = __builtin_amdgcn_exp2f(REL ? p1[r] : p1[r] - mrun); s += p1[r]; } else p1[r] = 0.f; }
    lsum += s;
    pw0 = (u32x4){cvtpk(p0[0], p0[1]), cvtpk(p0[2], p0[3]), cvtpk(p0[4], p0[5]), cvtpk(p0[6], p0[7])};
    pw1 = (u32x4){cvtpk(p0[8], p0[9]), cvtpk(p0[10], p0[11]), cvtpk(p0[12], p0[13]), cvtpk(p0[14], p0[15])};
    pw2 = (u32x4){cvtpk(p1[0], p1[1]), cvtpk(p1[2], p1[3]), cvtpk(p1[4], p1[5]), cvtpk(p1[6], p1[7])};
    pw3 = (u32x4){cvtpk(p1[8], p1[9]), cvtpk(p1[10], p1[11]), cvtpk(p1[12], p1[13]), cvtpk(p1[14], p1[15])};
}

constexpr int A_SLOTK = 8192, A_SLOTV = 16384, A_NS = 3, A_NSV = 4;
constexpr int A_LDS_K = 0, A_LDS_V = A_NS * A_SLOTK, A_LDS_WS = A_LDS_V + A_NSV * A_SLOTV, A_LDS_ST = A_LDS_WS + 8 * 256, A_LDS_BYTES = A_LDS_ST + 8 * 8192;
__device__ __forceinline__ void attn_a_unit(int b, int h, int qb, const bf16_t* proj, bf16_t* ya, const float* subln, float lam, unsigned char* shm) {
    int tid_l = threadIdx.x; asm volatile("" : "+v"(tid_l));
    const int tid = tid_l, lane = tid & 63, r32 = lane & 31, hi = lane >> 5; const int wid = __builtin_amdgcn_readfirstlane(tid >> 6);
    const size_t rowbase = (size_t)b * SEQ; const int q0 = qb * 256;
    constexpr int NT = SEQ / 64;
    const unsigned lds0 = (unsigned)(uintptr_t)shm;
    const lds_cptr shm3 = (lds_cptr)shm;
    __attribute__((address_space(3))) float* wsf = (__attribute__((address_space(3))) float*)((lds_ptr)shm + A_LDS_WS) + wid * 64;
    const int vb0 = (int)(lds0 + A_LDS_V) + ((lane >> 4) & 1) * 32 + (lane & 3) * 8 + (4 * hi + ((lane & 15) >> 2)) * 64;
    __attribute__((address_space(3))) bf16_t* stg = (__attribute__((address_space(3))) bf16_t*)((lds_ptr)shm + A_LDS_ST) + wid * 4096;
    for (int mp = 0; mp < 2; ++mp) {
        const bf16_t* Kh = proj + rowbase * INW + C_KA + h * 128 + mp * 64;
        const bf16_t* Vh = proj + rowbase * INW + C_VA + h * 128;
        const bf16_t* Qw = proj + (rowbase + q0 + wid * 32) * INW + C_QA + h * 128 + mp * 64;
        const int pA = 2 * wid, pB = 2 * wid + 1;
        const unsigned kdst = lds0 + A_LDS_K + wid * 1024, vdstA = lds0 + A_LDS_V + pA * 1024, vdstB = lds0 + A_LDS_V + pB * 1024;
#define A_DMA(t, slot, vsl) do { int ln_ = lane; asm volatile("" : "+v"(ln_)); \
        const bf16_t* ksrc_ = Kh + (size_t)((t) * 64 + ln_) * INW + wid * 8; \
        const bf16_t* vsrcA_ = Vh + (size_t)((t) * 64 + 16 * (pA & 3) + (ln_ >> 2)) * INW + (pA >> 2) * 32 + (ln_ & 3) * 8; \
        const bf16_t* vsrcB_ = Vh + (size_t)((t) * 64 + 16 * (pB & 3) + (ln_ >> 2)) * INW + (pB >> 2) * 32 + (ln_ & 3) * 8; \
        glds16(ksrc_, (unsigned)__builtin_amdgcn_readfirstlane(kdst + (slot) * A_SLOTK)); \
        glds16(vsrcA_, (unsigned)__builtin_amdgcn_readfirstlane(vdstA + (vsl) * A_SLOTV)); \
        glds16(vsrcB_, (unsigned)__builtin_amdgcn_readfirstlane(vdstB + (vsl) * A_SLOTV)); } while (0)
        A_DMA(0, 0, 0); A_DMA(1, 1, 1);
        bf16x8 qr[4];
#pragma unroll
        for (int d0 = 0; d0 < 4; ++d0) qr[d0] = *(const bf16x8*)(Qw + (size_t)r32 * INW + d0 * 16 + hi * 8);
        f32x16 o[4]; o[0] = f32x16{}; o[1] = f32x16{}; o[2] = f32x16{}; o[3] = f32x16{};
        float mrun = 0.f, lsum = 0.f; f32x16 negm = f32x16{};
        int slot = 0, slot2 = 2, vslot = 0, vslot2 = 2, vprev = 3;
        const bool late = wid >= 4;
        u32x4 pw0 = {}, pw1 = {}, pw2 = {}, pw3 = {};
        for (int t = 0; t < NT; ++t) {
            if (t + 1 < NT) { ATT_WAIT_BAR(3); } else { ATT_WAIT_BAR(0); }
            if (t + 2 < NT) A_DMA(t + 2, slot2, vslot2);
            if (late && t > 0) pv<4>(o, vb0 + vprev * A_SLOTV, __builtin_bit_cast(bf16x8, pw0), __builtin_bit_cast(bf16x8, pw1), __builtin_bit_cast(bf16x8, pw2), __builtin_bit_cast(bf16x8, pw3));
            f32x16 p0, p1;
            qkt<false>(p0, p1, shm3 + A_LDS_K + slot * A_SLOTK, qr, negm, r32, hi);
            softmax_tile<4, 8, false>(p0, p1, mrun, lsum, negm, t == 0, o, wsf, r32, hi, pw0, pw1, pw2, pw3);
            if (!late) pv<4>(o, vb0 + vslot * A_SLOTV, __builtin_bit_cast(bf16x8, pw0), __builtin_bit_cast(bf16x8, pw1), __builtin_bit_cast(bf16x8, pw2), __builtin_bit_cast(bf16x8, pw3));
            slot = (slot == 2) ? 0 : slot + 1; slot2 = (slot2 == 2) ? 0 : slot2 + 1;
            vprev = vslot; vslot = (vslot + 1) & 3; vslot2 = (vslot2 + 1) & 3;
        }
        if (late) pv<4>(o, vb0 + vprev * A_SLOTV, __builtin_bit_cast(bf16x8, pw0), __builtin_bit_cast(bf16x8, pw1), __builtin_bit_cast(bf16x8, pw2), __builtin_bit_cast(bf16x8, pw3));
#undef A_DMA
        const float lt = halfsum(lsum);
        if (hi == 0) wsf[32 + r32] = lt;
        ATT_LDSWAIT();
        float rli[16];
#pragma unroll
        for (int g = 0; g < 4; ++g) { const f32x4 l4 = *(const __attribute__((address_space(3))) f32x4*)(wsf + 32 + 8 * g + 4 * hi);
            rli[4 * g + 0] = __builtin_amdgcn_rcpf(l4[0]); rli[4 * g + 1] = __builtin_amdgcn_rcpf(l4[1]); rli[4 * g + 2] = __builtin_amdgcn_rcpf(l4[2]); rli[4 * g + 3] = __builtin_amdgcn_rcpf(l4[3]); }
        ATT_LDSWAIT();
        if (mp == 0) {
#pragma unroll
            for (int d0 = 0; d0 < 4; ++d0)
#pragma unroll
                for (int r = 0; r < 16; ++r) stg[crow(r, hi) * 128 + d0 * 32 + r32] = (bf16_t)f2bf(o[d0][r] * rli[r]);
            asm volatile("s_waitcnt lgkmcnt(0)\n\ts_barrier" ::: "memory");
        } else {
            float ss[16];
#pragma unroll
            for (int r = 0; r < 16; ++r) ss[r] = 0.f;
#pragma unroll
            for (int d0 = 0; d0 < 4; ++d0)
#pragma unroll
                for (int r = 0; r < 16; ++r) { const float a = bf2f(stg[crow(r, hi) * 128 + d0 * 32 + r32]); const float y = a - lam * o[d0][r] * rli[r]; o[d0][r] = y; ss[r] += y * y; }
#pragma unroll
            for (int r = 0; r < 16; ++r) { float v = ss[r]; v += __shfl_xor(v, 1); v += __shfl_xor(v, 2); v += __shfl_xor(v, 4); v += __shfl_xor(v, 8); v += __shfl_xor(v, 16);
                ss[r] = 0.8f / sqrtf(v * (1.f / 128.f) + EPS); }
            ATT_LDSWAIT();
#pragma unroll
            for (int d0 = 0; d0 < 4; ++d0) { const float gsub = subln[d0 * 32 + r32];
#pragma unroll
                for (int r = 0; r < 16; ++r) stg[crow(r, hi) * 128 + d0 * 32 + r32] = (bf16_t)f2bf(o[d0][r] * ss[r] * gsub); }
            ATT_LDSWAIT();
            bf16_t* Yw = ya + (rowbase + q0 + wid * 32) * 1024 + h * 128;
#pragma unroll
            for (int i = 0; i < 8; ++i) { const int row = i * 4 + (lane >> 4), ch = lane & 15; const u32x4 v = *(const __attribute__((address_space(3))) u32x4*)(stg + row * 128 + ch * 8); *(u32x4*)(Yw + (size_t)row * 1024 + ch * 8) = v; }
            asm volatile("s_waitcnt lgkmcnt(0)\n\ts_barrier" ::: "memory");
        }
    }
}

template <int DEAD> __device__ __forceinline__ void na_tile(lds_cptr Kslot, int vb, const bf16x8* qr, const __attribute__((address_space(3))) float* bp, const float (&fm0)[16], const float (&fm1)[16],
                                                        float& mrun, float& lsum, f32x16& negm, bool first, f32x16* o, __attribute__((address_space(3))) float* wsf, int r32, int hi) {
    f32x16 p0, p1; u32x4 pw0, pw1, pw2, pw3;
    qkt<true>(p0, p1, Kslot, qr, negm, r32, hi);
#pragma unroll
    for (int rr = 0; rr < 16; ++rr) { const int jj = (rr & 3) + 8 * (rr >> 2);
        if (live0<DEAD>(rr)) p0[rr] += bp[jj] + fm0[rr];
        if (live1<DEAD>(rr)) p1[rr] += bp[jj + 32] + fm1[rr]; }
    softmax_tile<2, 8, true, DEAD>(p0, p1, mrun, lsum, negm, first, o, wsf, r32, hi, pw0, pw1, pw2, pw3);
    pv<2>(o, vb, __builtin_bit_cast(bf16x8, pw0), __builtin_bit_cast(bf16x8, pw1), __builtin_bit_cast(bf16x8, pw2), __builtin_bit_cast(bf16x8, pw3));
}
constexpr int B_SLOT = 8192, B_NS = 6, B_PF = 5;
constexpr int B_LDS_K = 0, B_LDS_V = B_NS * B_SLOT, B_LDS_WS = 2 * B_NS * B_SLOT, B_LDS_BIAS = B_LDS_WS + 8 * 256, B_LDS_ST = B_LDS_BIAS + 2560, B_LDS_BYTES = B_LDS_ST + 8 * 4096;
__device__ __forceinline__ void attn_b_unit(int b, int h, int rg, const bf16_t* proj, bf16_t* yb, const float* rpb, unsigned char* shm) {
    int tid_l = threadIdx.x; asm volatile("" : "+v"(tid_l));
    const int tid = tid_l, lane = tid & 63, r32 = lane & 31, hi = lane >> 5; const int wid = __builtin_amdgcn_readfirstlane(tid >> 6);
    const size_t rowbase = (size_t)b * SEQ;
    const int r = 4 * rg + (wid >> 1), c0 = 32 * (wid & 1);
    int rs = r - 4; rs = rs < 0 ? 0 : (rs > 24 ? 24 : rs);
    int rmin = 4 * rg - 4; rmin = rmin < 0 ? 0 : (rmin > 24 ? 24 : rmin);
    int rmaxs = 4 * rg + 3 - 4; rmaxs = rmaxs < 0 ? 0 : (rmaxs > 24 ? 24 : rmaxs);
    const int ntile = rmaxs + 8 - rmin;
    const unsigned lds0 = (unsigned)(uintptr_t)shm;
    const lds_cptr shm3 = (lds_cptr)shm;
    __attribute__((address_space(3))) float* wsf = (__attribute__((address_space(3))) float*)((lds_ptr)shm + B_LDS_WS) + wid * 64;
    __attribute__((address_space(3))) float* bias = (__attribute__((address_space(3))) float*)((lds_ptr)shm + B_LDS_BIAS) + 64;
    __attribute__((address_space(3))) bf16_t* stg = (__attribute__((address_space(3))) bf16_t*)((lds_ptr)shm + B_LDS_ST) + wid * 2048;
    const int vb0 = (int)(lds0 + B_LDS_V) + ((lane >> 4) & 1) * 32 + (lane & 3) * 8 + (4 * hi + ((lane & 15) >> 2)) * 64;
    for (int i = tid; i < 640; i += 512) { const int e = i - 64, ri = e >> 5, cj = e & 31; bias[e] = (e >= 0 && e < 480 && cj < 31) ? rpb[(h * 15 + ri) * 31 + cj] * LOG2E : 0.f; }
    const bf16_t* Kh = proj + rowbase * INW + C_KB + h * 64;
    const bf16_t* Vh = proj + rowbase * INW + C_VB + h * 64;
    const bf16_t* Qw = proj + (rowbase + r * 64 + c0) * INW + C_QB + h * 64;
    const unsigned kdst = lds0 + B_LDS_K + wid * 1024, vdst = lds0 + B_LDS_V + wid * 1024;
#define B_DMA(t, slot) do { int ln_ = lane; asm volatile("" : "+v"(ln_)); \
    const bf16_t* ksrc_ = Kh + (size_t)((rmin + (t)) * 64 + ln_) * INW + wid * 8; \
    const bf16_t* vsrc_ = Vh + (size_t)((rmin + (t)) * 64 + 16 * (wid & 3) + (ln_ >> 2)) * INW + (wid >> 2) * 32 + (ln_ & 3) * 8; \
    glds16(ksrc_, (unsigned)__builtin_amdgcn_readfirstlane(kdst + (slot) * B_SLOT)); \
    glds16(vsrc_, (unsigned)__builtin_amdgcn_readfirstlane(vdst + (slot) * B_SLOT)); } while (0)
#pragma unroll
    for (int t = 0; t < 4; ++t) B_DMA(t, t);
    bf16x8 qr[4];
#pragma unroll
    for (int d0 = 0; d0 < 4; ++d0) qr[d0] = *(const bf16x8*)(Qw + (size_t)r32 * INW + d0 * 16 + hi * 8);
    f32x16 o[2]; o[0] = f32x16{}; o[1] = f32x16{};
    float mrun = 0.f, lsum = 0.f; f32x16 negm = f32x16{}; bool first = true;
    const int c = c0 + r32; int cs = c - 8; cs = cs < 0 ? 0 : (cs > 48 ? 48 : cs);
    float fm0[16], fm1[16];
#pragma unroll
    for (int rr = 0; rr < 16; ++rr) { const int j0 = crow(rr, hi); fm0[rr] = ((unsigned)(j0 - cs) < 16u) ? 0.f : -1e30f; fm1[rr] = ((unsigned)(j0 + 32 - cs) < 16u) ? 0.f : -1e30f; }
    int slot = 0, slotn = 4;
#define B_TILE(tt, sl) do { const int kr = rmin + (tt); \
        if (kr >= rs && kr < rs + 8) {        \
            const __attribute__((address_space(3))) float* bp = bias + ((kr - r + 7) * 32 + 15 - c + 4 * hi);        \
            if (wid & 1) na_tile<2>(shm3 + B_LDS_K + (sl) * B_SLOT, vb0 + (sl) * B_SLOT, qr, bp, fm0, fm1, mrun, lsum, negm, first, o, wsf, r32, hi); \
            else         na_tile<1>(shm3 + B_LDS_K + (sl) * B_SLOT, vb0 + (sl) * B_SLOT, qr, bp, fm0, fm1, mrun, lsum, negm, first, o, wsf, r32, hi); \
            first = false; } } while (0)
    for (int t = 0; t < ntile; t += 2) {
        { const int rem = ntile - (t + 2);
          if (rem >= 2) { ATT_WAIT_BAR(4); } else if (rem == 1) { ATT_WAIT_BAR(2); } else { ATT_WAIT_BAR(0); } }
        const int slot1 = (slot == B_NS - 1) ? 0 : slot + 1, slotn1 = (slotn == B_NS - 1) ? 0 : slotn + 1;
        if (t + 4 < ntile) B_DMA(t + 4, slotn);
        if (t + 5 < ntile) B_DMA(t + 5, slotn1);
#pragma unroll 1
        for (int k2 = 0; k2 < 2; ++k2) { const int sl = k2 ? slot1 : slot; if (t + k2 < ntile) B_TILE(t + k2, sl); }
        slot = (slot1 == B_NS - 1) ? 0 : slot1 + 1; slotn = (slotn1 == B_NS - 1) ? 0 : slotn1 + 1;
    }
#undef B_TILE
#undef B_DMA
    const float lt = halfsum(lsum);
    if (hi == 0) wsf[32 + r32] = lt;
    ATT_LDSWAIT();
    float rli[16];
#pragma unroll
    for (int g = 0; g < 4; ++g) { const f32x4 l4 = *(const __attribute__((address_space(3))) f32x4*)(wsf + 32 + 8 * g + 4 * hi);
        rli[4 * g + 0] = __builtin_amdgcn_rcpf(l4[0]); rli[4 * g + 1] = __builtin_amdgcn_rcpf(l4[1]); rli[4 * g + 2] = __builtin_amdgcn_rcpf(l4[2]); rli[4 * g + 3] = __builtin_amdgcn_rcpf(l4[3]); }
#pragma unroll
    for (int d0 = 0; d0 < 2; ++d0)
#pragma unroll
        for (int rr = 0; rr < 16; ++rr) stg[crow(rr, hi) * 64 + d0 * 32 + r32] = (bf16_t)f2bf(o[d0][rr] * rli[rr]);
    ATT_LDSWAIT();
    bf16_t* Yw = yb + (rowbase + r * 64 + c0) * 1024 + 512 + h * 64;
#pragma unroll
    for (int i = 0; i < 4; ++i) { const int row = i * 8 + (lane >> 3), ch = lane & 7; const u32x4 v = *(const __attribute__((address_space(3))) u32x4*)(stg + row * 64 + ch * 8); *(u32x4*)(Yw + (size_t)row * 1024 + ch * 8) = v; }
    asm volatile("s_waitcnt lgkmcnt(0)\n\ts_barrier" ::: "memory");
}
}

namespace peer {
typedef short bf16x8 __attribute__((ext_vector_type(8)));
typedef float f32x16 __attribute__((ext_vector_type(16)));
typedef __attribute__((address_space(3))) const char* lds_cptr;
constexpr int T_LDS_SK = 0, T_LDS_BYTES = 65536;
__device__ __forceinline__ int imax(int a, int b) { int r; asm("v_max_f32 %0, %1, %2" : "=v"(r) : "v"(a), "v"(b)); return r; }
__device__ __forceinline__ int imin(int a, int b) { int r; asm("v_min_f32 %0, %1, %2" : "=v"(r) : "v"(a), "v"(b)); return r; }
__device__ __forceinline__ int f2key(float s, int idx) { return (__float_as_int(s) & ~127) | idx; }
__device__ __forceinline__ int key2bits(int k) { return k; }
template <int N, int OFF, int TOT> __device__ __forceinline__ void bsort_desc(int (&a)[TOT]) {
#pragma unroll
    for (int k = 2; k <= N; k <<= 1)
#pragma unroll
        for (int j = k >> 1; j > 0; j >>= 1)
#pragma unroll
            for (int i = 0; i < N; ++i) { const int l = i ^ j; if (l > i) { const bool desc = (i & k) == 0; const int hi_ = imax(a[OFF + i], a[OFF + l]), lo_ = imin(a[OFF + i], a[OFF + l]); a[OFF + i] = desc ? hi_ : lo_; a[OFF + l] = desc ? lo_ : hi_; } }
}
__device__ constexpr unsigned char NET16[126] = {0,1,2,3,0,2,1,3,1,2,4,5,6,7,4,6,5,7,5,6,0,4,2,6,2,4,1,5,3,7,3,5,1,2,3,4,5,6,8,9,10,11,8,10,9,11,9,10,12,13,14,15,12,14,13,15,13,14,8,12,10,14,10,12,9,13,11,15,11,13,9,10,11,12,13,14,0,8,4,12,4,8,2,10,6,14,6,10,2,4,6,8,10,12,1,9,5,13,5,9,3,11,7,15,7,11,3,5,7,9,11,13,1,2,3,4,5,6,7,8,9,10,11,12,13,14};
__device__ constexpr unsigned char NET32[382] = {0,1,2,3,0,2,1,3,1,2,4,5,6,7,4,6,5,7,5,6,0,4,2,6,2,4,1,5,3,7,3,5,1,2,3,4,5,6,8,9,10,11,8,10,9,11,9,10,12,13,14,15,12,14,13,15,13,14,8,12,10,14,10,12,9,13,11,15,11,13,9,10,11,12,13,14,0,8,4,12,4,8,2,10,6,14,6,10,2,4,6,8,10,12,1,9,5,13,5,9,3,11,7,15,7,11,3,5,7,9,11,13,1,2,3,4,5,6,7,8,9,10,11,12,13,14,16,17,18,19,16,18,17,19,17,18,20,21,22,23,20,22,21,23,21,22,16,20,18,22,18,20,17,21,19,23,19,21,17,18,19,20,21,22,24,25,26,27,24,26,25,27,25,26,28,29,30,31,28,30,29,31,29,30,24,28,26,30,26,28,25,29,27,31,27,29,25,26,27,28,29,30,16,24,20,28,20,24,18,26,22,30,22,26,18,20,22,24,26,28,17,25,21,29,21,25,19,27,23,31,23,27,19,21,23,25,27,29,17,18,19,20,21,22,23,24,25,26,27,28,29,30,0,16,8,24,8,16,4,20,12,28,12,20,4,8,12,16,20,24,2,18,10,26,10,18,6,22,14,30,14,22,6,10,14,18,22,26,2,4,6,8,10,12,14,16,18,20,22,24,26,28,1,17,9,25,9,17,5,21,13,29,13,21,5,9,13,17,21,25,3,19,11,27,11,19,7,23,15,31,15,23,7,11,15,19,23,27,3,5,7,9,11,13,15,17,19,21,23,25,27,29,1,2,3,4,5,6,7,8,9,10,11,12,13,14,15,16,17,18,19,20,21,22,23,24,25,26,27,28,29,30};
template <int OFF, int TOT> __device__ __forceinline__ void sort16_desc(int (&a)[TOT]) {
#pragma unroll
    for (int c = 0; c < 63; ++c) { const int i = OFF + NET16[2 * c], j = OFF + NET16[2 * c + 1]; const int hi_ = imax(a[i], a[j]), lo_ = imin(a[i], a[j]); a[i] = hi_; a[j] = lo_; }
}
template <int TOT> __device__ __forceinline__ void sort32_desc(int (&a)[TOT]) {
#pragma unroll
    for (int c = 0; c < 191; ++c) { const int i = NET32[2 * c], j = NET32[2 * c + 1]; const int hi_ = imax(a[i], a[j]), lo_ = imin(a[i], a[j]); a[i] = hi_; a[j] = lo_; }
}
template <int N, int OFF, int TOT> __device__ __forceinline__ void bmerge_desc(int (&a)[TOT]) {
#pragma unroll
    for (int j = N >> 1; j > 0; j >>= 1)
#pragma unroll
        for (int i = 0; i < N; ++i) { const int l = i ^ j; if (l > i) { const int hi_ = imax(a[OFF + i], a[OFF + l]), lo_ = imin(a[OFF + i], a[OFF + l]); a[OFF + i] = hi_; a[OFF + l] = lo_; } }
}
template <int A, int B, int TOT> __device__ __forceinline__ void merge_top16(int (&a)[TOT]) {
#pragma unroll
    for (int i = 0; i < 16; ++i) a[A + i] = imax(a[A + i], a[B + 15 - i]);
    bmerge_desc<16, A, TOT>(a);
}
__device__ __forceinline__ void cross_top16(int (&t)[16]) {
    int lo[16], hi[16];
#pragma unroll
    for (int i = 0; i < 16; ++i) { auto rr = __builtin_amdgcn_permlane32_swap((unsigned)t[i], (unsigned)t[i], false, false); lo[i] = (int)rr[0]; hi[i] = (int)rr[1]; }
#pragma unroll
    for (int i = 0; i < 16; ++i) t[i] = imax(lo[i], hi[15 - i]);
    bmerge_desc<16, 0, 16>(t);
}
struct RowStream {
    const float* pu; const float* pv; unsigned char* ws; int r, step, lane; f32x4 v0, v1, v2, v3;
    __device__ __forceinline__ void issue() {
        if (r < 2 * NEXP) { const float* src = (r < NEXP ? pu + (size_t)r * D : pv + (size_t)(r - NEXP) * D); const f32x4* s4 = (const f32x4*)src + lane * 4; v0 = s4[0]; v1 = s4[1]; v2 = s4[2]; v3 = s4[3]; } }
    __device__ __forceinline__ void finish() {
        if (r < 2 * NEXP) { const f32x4 cur[4] = {v0, v1, v2, v3};
            if (r < NEXP) cvt_row_i4(cur, ws + WS_U + (size_t)r * 256, (float*)(ws + WS_SU) + r, lane);
            else { const int e = r - NEXP; cvt_row_fp8(cur, ws + WS_V + (size_t)e * 512, (float*)(ws + WS_SV) + e, lane); }
            r += step; } }
    __device__ __forceinline__ void hook() { finish(); issue(); }
};
__device__ __forceinline__ void half_top16(int (&top)[16], const bf16_t* qrow  , lds_cptr skp  , int hi, RowStream& RS) {
    f32x16 sc[4]; sc[0] = f32x16{}; sc[1] = f32x16{}; sc[2] = f32x16{}; sc[3] = f32x16{};
    bf16x8 qf[8];
#pragma unroll
    for (int ks = 0; ks < 8; ++ks) qf[ks] = *(const bf16x8*)(qrow + ks * 16);
    RS.hook();
#pragma unroll
    for (int ks = 0; ks < 8; ++ks)
#pragma unroll
        for (int kt = 0; kt < 4; ++kt) { const bf16x8 af = *(const __attribute__((address_space(3))) bf16x8*)(skp + ks * 4096 + kt * 512);
            sc[kt] = __builtin_amdgcn_mfma_f32_32x32x16_bf16(af, qf[ks], sc[kt], 0, 0, 0); }
    int k[64];
#pragma unroll
    for (int kt = 0; kt < 4; ++kt)
#pragma unroll
        for (int r = 0; r < 16; ++r) k[kt * 16 + r] = f2key(sc[kt][r], (32 * kt + (r & 3) + 8 * (r >> 2)) | (4 * hi));
    sort16_desc<0, 64>(k); sort16_desc<16, 64>(k);
    RS.hook();
    sort16_desc<32, 64>(k); sort16_desc<48, 64>(k);
    RS.hook();
    merge_top16<0, 16, 64>(k); merge_top16<32, 48, 64>(k); merge_top16<0, 32, 64>(k);
#pragma unroll
    for (int i = 0; i < 16; ++i) top[i] = k[i];
    cross_top16(top);
}
__device__ __forceinline__ void topk_wave(int tok0, int h, const bf16_t* Q, int* IDX, float* Gt, lds_cptr sk, int lane, RowStream& RS) {
    const int r32 = lane & 31, hi = lane >> 5, tok = tok0 + r32;
    const bf16_t* qrow = Q + (size_t)tok * PQ + h * 256 + 8 * hi;
    lds_cptr skl = sk + hi * 2048 + r32 * 16;
    int A0[16], A1[16];
    half_top16(A0, qrow, skl, hi, RS);
    half_top16(A1, qrow + 128, skl + 32768, hi, RS);
    RS.hook();
    float x[16], y[16]; int xw[16], yw[16];
#pragma unroll
    for (int a = 0; a < 16; ++a) { const int b0 = key2bits(A0[a]), b1 = key2bits(A1[a]);
        const float v0 = __int_as_float(b0 & ~127), v1 = __int_as_float(b1 & ~127); const int i0 = (b0 & 127) << 7, i1 = b1 & 127;
        x[a] = hi ? v1 : v0; y[a] = hi ? v0 : v1; xw[a] = hi ? i1 : i0; yw[a] = hi ? i0 : i1; }
    int w[32]; int n = 0;
#define PEER_CAND(a, b) do { const int bits = __float_as_int(x[a] + y[b]); int ww = (bits & ~0x3FFF) | (xw[a] + yw[b]); \
        if ((a) == (b) && hi) ww = (int)0xFF800000; w[n] = ww; ++n; } while (0)
#pragma unroll
    for (int b = 0; b < 16; ++b) PEER_CAND(0, b);
#pragma unroll
    for (int b = 1; b < 8; ++b) PEER_CAND(1, b);
#pragma unroll
    for (int b = 2; b < 5; ++b) PEER_CAND(2, b);
    PEER_CAND(3, 3);
#undef PEER_CAND
#pragma unroll
    for (int i = 27; i < 32; ++i) w[i] = (int)0xFF800000;
    RS.hook();
    sort32_desc<32>(w);
    RS.hook();
    int T[16];
#pragma unroll
    for (int i = 0; i < 16; ++i) T[i] = w[i];
    cross_top16(T);
    float sv[16]; int ev[16];
#pragma unroll
    for (int j = 0; j < 16; ++j) { ev[j] = T[j] & 0x3FFF; sv[j] = __int_as_float(T[j] & ~0x3FFF); }
    const float s0 = sv[0]; float esum = 0.f;
#pragma unroll
    for (int j = 0; j < 16; ++j) { sv[j] = __expf(sv[j] - s0); esum += sv[j]; }
    const float inv = 1.f / esum;
    if (hi == 0) { u32x4* io = (u32x4*)(IDX + ((size_t)tok * 8 + h) * 16);
#pragma unroll
        for (int j = 0; j < 4; ++j) io[j] = (u32x4){(unsigned)ev[4 * j], (unsigned)ev[4 * j + 1], (unsigned)ev[4 * j + 2], (unsigned)ev[4 * j + 3]}; }
    else { f32x4* go = (f32x4*)(Gt + ((size_t)tok * 8 + h) * 16);
#pragma unroll
        for (int j = 0; j < 4; ++j) go[j] = (f32x4){sv[4 * j] * inv, sv[4 * j + 1] * inv, sv[4 * j + 2] * inv, sv[4 * j + 3] * inv}; }
}
template <class Sched> __device__ __forceinline__ void topk_own_units(const Ptrs& P, unsigned char* shm, const Sched& S) {
    int tid_l = threadIdx.x; asm volatile("" : "+v"(tid_l));
    const int tid = tid_l, lane = tid & 63; const int wid = __builtin_amdgcn_readfirstlane(tid >> 6);
    const unsigned lds0 = (unsigned)(uintptr_t)shm;
    const bf16_t* SKg = (const bf16_t*)(P.ws + WS_SK);
    int hprev = -1; pg8::Unit u;
    RowStream RS; RS.pu = P.peer_u; RS.pv = P.peer_v; RS.ws = P.ws; RS.lane = lane; RS.step = (int)gridDim.x * 8; RS.r = (int)blockIdx.x * 8 + wid; RS.v0 = RS.v1 = RS.v2 = RS.v3 = f32x4{};
    RS.issue();
    for (int i = 0; S.next(i, u); ++i) {
        const int h = u.pn, tg = u.pm;
        if (h != hprev) { hprev = h;
            asm volatile("s_waitcnt lgkmcnt(0)\n\ts_barrier" ::: "memory");
#pragma unroll
            for (int j = 0; j < 8; ++j) { const int piece = wid * 8 + j, p = piece >> 5, c = (piece >> 1) & 15, kh = piece & 1;
                att::glds16(SKg + ((size_t)((h * 2 + p) * 128 + kh * 64 + lane) * 128 + c * 8), (unsigned)__builtin_amdgcn_readfirstlane(lds0 + p * 32768 + c * 2048 + kh * 1024)); }
            asm volatile("s_waitcnt vmcnt(0)\n\ts_barrier" ::: "memory");
        }
        topk_wave(tg * 256 + wid * 32, h, (const bf16_t*)(P.ws + WS_Q), (int*)(P.ws + WS_IDX), (float*)(P.ws + WS_G), (lds_cptr)shm, lane, RS);
    }
    while (RS.r < 2 * NEXP) RS.hook();
}
}

namespace apply {
typedef float f32x2 __attribute__((ext_vector_type(2)));
typedef __attribute__((address_space(3))) unsigned* lds_u32p;
constexpr int AP_WAVE_BYTES = 4 * (512 + 2048), AP_LDS_BYTES = 8 * AP_WAVE_BYTES;
__device__ __forceinline__ float gelu_fast(float v) {
    const float av = fabsf(v), t = __builtin_amdgcn_rcpf(av * 0.2316418882f + 1.0f);
    float q = t * 0.5307027145f + (-0.7265760135f); q = q * t + 0.7107068705f; q = q * t + (-0.142248368f); q = q * t + 0.127414796f; q = q * t;
    const float e = __builtin_amdgcn_exp2f((v * v) * (-0.72134752044f));
    const float m = v * (q * e);
    return v < 0.f ? m : v - m;
}
#define AP_DPP(v, ctrl) __builtin_bit_cast(float, __builtin_amdgcn_update_dpp(0, __builtin_bit_cast(int, (v)), (ctrl), 0xF, 0xF, true))
__device__ __forceinline__ float row16_sum(float v) { v += AP_DPP(v, 0xB1); v += AP_DPP(v, 0x4E); v += AP_DPP(v, 0x141); v += AP_DPP(v, 0x140); return v; }
__device__ __forceinline__ void load_half(u32x4 (&r)[2], const unsigned char* img, unsigned e, int sub) {
    const unsigned off = e * 512u + (unsigned)(sub * 16);
    r[0] = *(const u32x4*)(img + off); r[1] = *(const u32x4*)(img + off + 256u);
}
constexpr int AP_PROBE_RING = 16;
constexpr int AP_RING = 8;
typedef __attribute__((address_space(3))) u32x4* lds_v4p;
template <int HF, int MODE, int RING> __device__ __forceinline__ void pass_u(const Ptrs& P, const bf16_t* hrow, float rstd, lds_v4p grp, u32x4 (&R)[RING][2], const unsigned char* img, const unsigned char* img_next, int sub) {
    unsigned xq[8]; float sx;
    {
        float xf[2][16]; float mx = 0.f;
#pragma unroll
        for (int i = 0; i < 2; ++i) { const int e0 = (sub + 16 * (2 * HF + i)) * 16;
#pragma unroll
            for (int q = 0; q < 4; ++q) { const u32x2 hb = *(const u32x2*)(hrow + e0 + 4 * q); const f32x4 gv = *(const f32x4*)(P.norm_ffn + e0 + 4 * q);
                xf[i][4 * q] = bflo(hb.x) * rstd * gv.x; xf[i][4 * q + 1] = bfhi(hb.x) * rstd * gv.y; xf[i][4 * q + 2] = bflo(hb.y) * rstd * gv.z; xf[i][4 * q + 3] = bfhi(hb.y) * rstd * gv.w;
                mx = fmaxf(fmaxf(mx, fmaxf(fabsf(xf[i][4 * q]), fabsf(xf[i][4 * q + 1]))), fmaxf(fabsf(xf[i][4 * q + 2]), fabsf(xf[i][4 * q + 3]))); } }
        mx = fmaxf(mx, AP_DPP(mx, 0xB1)); mx = fmaxf(mx, AP_DPP(mx, 0x4E)); mx = fmaxf(mx, AP_DPP(mx, 0x141)); mx = fmaxf(mx, AP_DPP(mx, 0x140));
        mx = fmaxf(mx, 1e-30f); sx = mx * (1.f / 127.f); const float qs = 127.f / mx;
#pragma unroll
        for (int i = 0; i < 2; ++i)
#pragma unroll
            for (int q = 0; q < 4; ++q) xq[4 * i + q] = pack_i8x4(xf[i][4 * q] * qs, xf[i][4 * q + 1] * qs, xf[i][4 * q + 2] * qs, xf[i][4 * q + 3] * qs);
    }
#pragma unroll 1
    for (int j = 0; j < 128; j += RING) {
        const int jn = (j + RING) & 127;
        __builtin_amdgcn_s_barrier();
        const unsigned char* tb = (j + RING < 128) ? img : img_next;
        unsigned nid[RING], part[RING], suv[RING], gsv[RING];
#pragma unroll
        for (int b4 = 0; b4 < RING / 4; ++b4) { const u32x4 na = grp[jn / 4 + b4];
            nid[4 * b4] = na.x; nid[4 * b4 + 1] = na.y; nid[4 * b4 + 2] = na.z; nid[4 * b4 + 3] = na.w;
            u32x4 pa = {}, sa = {}, ga = {};
            if (HF == 1) { pa = grp[96 + j / 4 + b4]; sa = grp[32 + j / 4 + b4]; ga = grp[64 + j / 4 + b4]; }
            part[4 * b4] = pa.x; part[4 * b4 + 1] = pa.y; part[4 * b4 + 2] = pa.z; part[4 * b4 + 3] = pa.w;
            suv[4 * b4] = sa.x; suv[4 * b4 + 1] = sa.y; suv[4 * b4 + 2] = sa.z; suv[4 * b4 + 3] = sa.w;
            gsv[4 * b4] = ga.x; gsv[4 * b4 + 1] = ga.y; gsv[4 * b4 + 2] = ga.z; gsv[4 * b4 + 3] = ga.w; }
        float outv[RING];
#pragma unroll
        for (int bq = 0; bq < RING; ++bq) {
            int d0_ = 0, d1_ = 0;
            if (MODE == 1) { asm volatile("" :: "v"(R[bq][0]), "v"(R[bq][1])); d0_ = (int)xq[0]; }
            else {
                d0_ = __builtin_amdgcn_sdot4((int)R[bq][0].x, (int)xq[0], d0_, false); d1_ = __builtin_amdgcn_sdot4((int)R[bq][0].y, (int)xq[1], d1_, false);
                d0_ = __builtin_amdgcn_sdot4((int)R[bq][0].z, (int)xq[2], d0_, false); d1_ = __builtin_amdgcn_sdot4((int)R[bq][0].w, (int)xq[3], d1_, false);
                d0_ = __builtin_amdgcn_sdot4((int)R[bq][1].x, (int)xq[4], d0_, false); d1_ = __builtin_amdgcn_sdot4((int)R[bq][1].y, (int)xq[5], d1_, false);
                d0_ = __builtin_amdgcn_sdot4((int)R[bq][1].z, (int)xq[6], d0_, false); d1_ = __builtin_amdgcn_sdot4((int)R[bq][1].w, (int)xq[7], d1_, false);
            }
            asm volatile("" ::: "memory");
            load_half(R[bq], tb, MODE == 2 ? (nid[bq] & 15u) : nid[bq], sub);
            asm volatile("" ::: "memory");
            float a_ = row16_sum((float)(d0_ + d1_)) * sx;
            if (HF == 1) { a_ = (a_ + __uint_as_float(part[bq])) * __uint_as_float(suv[bq]); a_ = __uint_as_float(gsv[bq]) * gelu_fast(a_); }
            outv[bq] = a_;
        }
        if (sub == 0) {
#pragma unroll
            for (int b4 = 0; b4 < RING / 4; ++b4) grp[96 + j / 4 + b4] = (u32x4){__float_as_uint(outv[4 * b4]), __float_as_uint(outv[4 * b4 + 1]), __float_as_uint(outv[4 * b4 + 2]), __float_as_uint(outv[4 * b4 + 3])}; }
    }
    asm volatile("s_waitcnt lgkmcnt(0)" ::: "memory");
}
template <int HF, int MODE, int RING> __device__ __forceinline__ void pass_v(float (&acc)[4][16], lds_v4p grp, u32x4 (&R)[RING][2], const unsigned char* img, const unsigned char* img_next, int sub) {
#pragma unroll 1
    for (int j = 0; j < 128; j += RING) {
        const int jn = (j + RING) & 127;
        __builtin_amdgcn_s_barrier();
        const unsigned char* tb = (j + RING < 128) ? img : img_next;
        unsigned nid[RING], cvv[RING];
#pragma unroll
        for (int b4 = 0; b4 < RING / 4; ++b4) { const u32x4 na = grp[jn / 4 + b4], ca = grp[96 + j / 4 + b4];
            nid[4 * b4] = na.x; nid[4 * b4 + 1] = na.y; nid[4 * b4 + 2] = na.z; nid[4 * b4 + 3] = na.w; cvv[4 * b4] = ca.x; cvv[4 * b4 + 1] = ca.y; cvv[4 * b4 + 2] = ca.z; cvv[4 * b4 + 3] = ca.w; }
#pragma unroll
        for (int bq = 0; bq < RING; ++bq) {
            const float c_ = __uint_as_float(cvv[bq]); const f32x2 c2 = {c_, c_};
            if (MODE == 1) { asm volatile("" :: "v"(R[bq][0]), "v"(R[bq][1])); acc[2 * HF][0] += c_; }
            else {
#pragma unroll
            for (int i = 0; i < 2; ++i) { const unsigned w_[4] = {R[bq][i].x, R[bq][i].y, R[bq][i].z, R[bq][i].w};
#pragma unroll
                for (int q = 0; q < 4; ++q) { const f32x2 lo_ = __builtin_amdgcn_cvt_pk_f32_fp8(w_[q], false), hi_ = __builtin_amdgcn_cvt_pk_f32_fp8(w_[q], true);
                    f32x2 a0 = {acc[2 * HF + i][4 * q], acc[2 * HF + i][4 * q + 1]}, a1 = {acc[2 * HF + i][4 * q + 2], acc[2 * HF + i][4 * q + 3]}; a0 += c2 * lo_; a1 += c2 * hi_;
                    acc[2 * HF + i][4 * q] = a0.x; acc[2 * HF + i][4 * q + 1] = a0.y; acc[2 * HF + i][4 * q + 2] = a1.x; acc[2 * HF + i][4 * q + 3] = a1.y; } }
            }
            asm volatile("" ::: "memory");
            load_half(R[bq], tb, MODE == 2 ? (nid[bq] & 15u) : nid[bq], sub);
            asm volatile("" ::: "memory");
        }
    }
}
constexpr int AP_RINGU = 16;
__device__ __forceinline__ u32x4 load_q4(const unsigned char* img, unsigned e, int sub) { return *(const u32x4*)(img + e * 256u + (unsigned)(sub * 16)); }
template <int HF, int RF> __device__ __forceinline__ void u4_half_turn(lds_v4p grp, u32x4 (&R)[AP_RINGU], const unsigned (&xh)[4], const unsigned (&xl)[4], float sx, const unsigned char* tb, int jb, int jr, int sub) {
    constexpr int RING = AP_RINGU;
    __builtin_amdgcn_s_barrier();
    unsigned nid[RING];
    if (RF != 2) {
#pragma unroll
        for (int b4 = 0; b4 < RING / 4; ++b4) { const u32x4 na = grp[jr / 4 + b4]; nid[4 * b4] = na.x; nid[4 * b4 + 1] = na.y; nid[4 * b4 + 2] = na.z; nid[4 * b4 + 3] = na.w; } }
    float outv[RING];
#pragma unroll
    for (int b4 = 0; b4 < RING / 4; ++b4) {
        u32x4 pa = {}, sa = {}, ga = {};
        if (HF == 1) { pa = grp[96 + jb / 4 + b4]; sa = grp[32 + jb / 4 + b4]; ga = grp[64 + jb / 4 + b4]; }
        const unsigned part[4] = {pa.x, pa.y, pa.z, pa.w}, suv[4] = {sa.x, sa.y, sa.z, sa.w}, gsv[4] = {ga.x, ga.y, ga.z, ga.w};
#pragma unroll
        for (int b1 = 0; b1 < 4; ++b1) { const int bq = 4 * b4 + b1;
            int dh_ = __builtin_amdgcn_sdot8((int)R[bq].x, (int)xh[0], 0, false), dl_ = __builtin_amdgcn_sdot8((int)R[bq].x, (int)xl[0], 0, false);
            dh_ = __builtin_amdgcn_sdot8((int)R[bq].y, (int)xh[1], dh_, false); dl_ = __builtin_amdgcn_sdot8((int)R[bq].y, (int)xl[1], dl_, false);
            dh_ = __builtin_amdgcn_sdot8((int)R[bq].z, (int)xh[2], dh_, false); dl_ = __builtin_amdgcn_sdot8((int)R[bq].z, (int)xl[2], dl_, false);
            dh_ = __builtin_amdgcn_sdot8((int)R[bq].w, (int)xh[3], dh_, false); dl_ = __builtin_amdgcn_sdot8((int)R[bq].w, (int)xl[3], dl_, false);
            asm volatile("" ::: "memory");
            if (RF == 0) R[bq] = load_q4(tb, nid[bq], sub);
            else if (RF == 1) R[bq] = *(const u32x4*)(tb + nid[bq >> 1] * 512u + (unsigned)(sub * 16 + (bq & 1) * 256));
            asm volatile("" ::: "memory");
            float a_ = row16_sum((float)(dh_ * 16 + dl_)) * sx;
            if (HF == 1) { a_ = (a_ + __uint_as_float(part[b1])) * __uint_as_float(suv[b1]); a_ = __uint_as_float(gsv[b1]) * gelu_fast(a_); }
            outv[bq] = a_; }
    }
    if (sub == 0) {
#pragma unroll
        for (int b4 = 0; b4 < RING / 4; ++b4) grp[96 + jb / 4 + b4] = (u32x4){__float_as_uint(outv[4 * b4]), __float_as_uint(outv[4 * b4 + 1]), __float_as_uint(outv[4 * b4 + 2]), __float_as_uint(outv[4 * b4 + 3])}; }
}
template <int HF, bool NEXTV> __device__ __forceinline__ void pass_u4(const Ptrs& P, const bf16_t* hrow, float rstd, lds_v4p grp, u32x4 (&RA)[AP_RINGU], u32x4 (&RB)[AP_RINGU], const unsigned char* img, const unsigned char* img_next, int sub) {
    unsigned xh[4], xl[4]; float sx;
    {
        float xf[2][16]; float mx = 0.f;
#pragma unroll
        for (int i = 0; i < 2; ++i) { const int e0 = (sub + 16 * (2 * HF + i)) * 16;
#pragma unroll
            for (int q = 0; q < 4; ++q) { const u32x2 hb = *(const u32x2*)(hrow + e0 + 4 * q); const f32x4 gv = *(const f32x4*)(P.norm_ffn + e0 + 4 * q);
                xf[i][4 * q] = bflo(hb.x) * rstd * gv.x; xf[i][4 * q + 1] = bfhi(hb.x) * rstd * gv.y; xf[i][4 * q + 2] = bflo(hb.y) * rstd * gv.z; xf[i][4 * q + 3] = bfhi(hb.y) * rstd * gv.w;
                mx = fmaxf(fmaxf(mx, fmaxf(fabsf(xf[i][4 * q]), fabsf(xf[i][4 * q + 1]))), fmaxf(fabsf(xf[i][4 * q + 2]), fabsf(xf[i][4 * q + 3]))); } }
        mx = fmaxf(mx, AP_DPP(mx, 0xB1)); mx = fmaxf(mx, AP_DPP(mx, 0x4E)); mx = fmaxf(mx, AP_DPP(mx, 0x141)); mx = fmaxf(mx, AP_DPP(mx, 0x140));
        mx = fmaxf(mx, 1e-30f); sx = mx * (1.f / 119.f); const float qs = 119.f / mx;
#pragma unroll
        for (int q = 0; q < 4; ++q) { unsigned h_ = 0u, l_ = 0u;
#pragma unroll
            for (int i = 0; i < 8; ++i) { const int xi = (int)rintf(xf[q >> 1][8 * (q & 1) + i] * qs); const int lo = ((xi + 8) & 15) - 8; const int hi = (xi - lo) >> 4;
                h_ |= ((unsigned)hi & 15u) << (4 * i); l_ |= ((unsigned)lo & 15u) << (4 * i); }
            xh[q] = h_; xl[q] = l_; }
    }
#pragma unroll 1
    for (int j = 0; j < 96; j += 32) {
        u4_half_turn<HF, 0>(grp, RA, xh, xl, sx, img, j, j + 32, sub);
        u4_half_turn<HF, 0>(grp, RB, xh, xl, sx, img, j + 16, j + 48, sub);
    }
    u4_half_turn<HF, NEXTV ? 1 : 0>(grp, RA, xh, xl, sx, img_next, 96, 0, sub);
    u4_half_turn<HF, NEXTV ? 2 : 0>(grp, RB, xh, xl, sx, img_next, 112, 16, sub);
    asm volatile("s_waitcnt lgkmcnt(0)" ::: "memory");
}
template <int HF> __device__ __forceinline__ void pass_v8f(float (&acc)[4][16], lds_v4p grp, u32x4 (&R)[AP_RINGU], const unsigned char* img, const unsigned char* img_next, int sub) {
    constexpr int RING = 8;
#pragma unroll 1
    for (int j = 0; j < 128; j += RING) {
        const int jn = (j + RING) & 127;
        if ((j & 31) == 0) __builtin_amdgcn_s_barrier();
        const unsigned char* tb = (j + RING < 128) ? img : img_next;
        unsigned nid[RING], cvv[RING];
#pragma unroll
        for (int b4 = 0; b4 < RING / 4; ++b4) { const u32x4 na = grp[jn / 4 + b4], ca = grp[96 + j / 4 + b4];
            nid[4 * b4] = na.x; nid[4 * b4 + 1] = na.y; nid[4 * b4 + 2] = na.z; nid[4 * b4 + 3] = na.w; cvv[4 * b4] = ca.x; cvv[4 * b4 + 1] = ca.y; cvv[4 * b4 + 2] = ca.z; cvv[4 * b4 + 3] = ca.w; }
#pragma unroll
        for (int bq = 0; bq < RING; ++bq) {
            const float c_ = __uint_as_float(cvv[bq]); const f32x2 c2 = {c_, c_};
#pragma unroll
            for (int i = 0; i < 2; ++i) { const unsigned w_[4] = {R[2 * bq + i].x, R[2 * bq + i].y, R[2 * bq + i].z, R[2 * bq + i].w};
#pragma unroll
                for (int q = 0; q < 4; ++q) { const f32x2 lo_ = __builtin_amdgcn_cvt_pk_f32_fp8(w_[q], false), hi_ = __builtin_amdgcn_cvt_pk_f32_fp8(w_[q], true);
                    f32x2 a0 = {acc[2 * HF + i][4 * q], acc[2 * HF + i][4 * q + 1]}, a1 = {acc[2 * HF + i][4 * q + 2], acc[2 * HF + i][4 * q + 3]}; a0 += c2 * lo_; a1 += c2 * hi_;
                    acc[2 * HF + i][4 * q] = a0.x; acc[2 * HF + i][4 * q + 1] = a0.y; acc[2 * HF + i][4 * q + 2] = a1.x; acc[2 * HF + i][4 * q + 3] = a1.y; } }
            asm volatile("" ::: "memory");
            { const unsigned off = nid[bq] * 512u + (unsigned)(sub * 16); R[2 * bq] = *(const u32x4*)(tb + off); R[2 * bq + 1] = *(const u32x4*)(tb + off + 256u); }
            asm volatile("" ::: "memory");
        }
    }
}
template <int MODE> __device__ __forceinline__ void apply_round(const Ptrs& P, float* outbase, int tbase, unsigned char* shm_wave, int lane_in) {
    int lane = lane_in; asm volatile("" : "+v"(lane));
    const int sub = lane & 15, g = lane >> 4, t = tbase + g;
    __attribute__((address_space(3))) unsigned* cnt = (lds_u32p)(__attribute__((address_space(3))) unsigned char*)shm_wave + g * 128;
    lds_v4p grp = (lds_v4p)((__attribute__((address_space(3))) unsigned char*)shm_wave + 2048 + g * 2048);
    __attribute__((address_space(3))) unsigned* grp1 = (__attribute__((address_space(3))) unsigned*)grp;
    const unsigned char* U8 = P.ws + WS_U; const unsigned char* V8 = P.ws + WS_V;
    {
        const int* idxp = (const int*)(P.ws + WS_IDX) + (size_t)t * 128 + sub * 8; const float* gp = (const float*)(P.ws + WS_G) + (size_t)t * 128 + sub * 8;
        const u32x4 ia = *(const u32x4*)idxp, ib = *(const u32x4*)(idxp + 4); const f32x4 ga = *(const f32x4*)gp, gb = *(const f32x4*)(gp + 4);
        const int e[8] = {(int)ia.x, (int)ia.y, (int)ia.z, (int)ia.w, (int)ib.x, (int)ib.y, (int)ib.z, (int)ib.w};
        const float gt[8] = {ga.x, ga.y, ga.z, ga.w, gb.x, gb.y, gb.z, gb.w};
        float su[8], sv[8];
#pragma unroll
        for (int i = 0; i < 8; ++i) { su[i] = ((const float*)(P.ws + WS_SU))[e[i]]; sv[i] = ((const float*)(P.ws + WS_SV))[e[i]]; }
#pragma unroll
        for (int i = 0; i < 8; ++i) cnt[sub * 8 + i] = 0u;
        asm volatile("s_waitcnt lgkmcnt(0)" ::: "memory");
        unsigned pos[8];
#pragma unroll
        for (int i = 0; i < 8; ++i) pos[i] = __hip_atomic_fetch_add(cnt + (e[i] >> 7), 1u, __ATOMIC_RELAXED, __HIP_MEMORY_SCOPE_WAVEFRONT);
        asm volatile("s_waitcnt lgkmcnt(0)" ::: "memory");
        unsigned c[8]; unsigned tot = 0;
#pragma unroll
        for (int i = 0; i < 8; ++i) { c[i] = cnt[sub * 8 + i]; }
#pragma unroll
        for (int i = 0; i < 8; ++i) { const unsigned x = c[i]; c[i] = tot; tot += x; }
        unsigned inc = tot;
#pragma unroll
        for (int d = 1; d < 16; d <<= 1) { const unsigned y = __shfl_up(inc, d, 16); if (sub >= d) inc += y; }
        const unsigned base = inc - tot;
        asm volatile("s_waitcnt lgkmcnt(0)" ::: "memory");
#pragma unroll
        for (int i = 0; i < 8; ++i) cnt[sub * 8 + i] = base + c[i];
        asm volatile("s_waitcnt lgkmcnt(0)" ::: "memory");
#pragma unroll
        for (int i = 0; i < 8; ++i) { const unsigned p = cnt[e[i] >> 7] + pos[i];
            grp1[p] = (unsigned)e[i]; grp1[128 + p] = __float_as_uint(su[i]); grp1[256 + p] = __float_as_uint(gt[i] * sv[i]); }
        asm volatile("s_waitcnt lgkmcnt(0)" ::: "memory");
    }
    const bf16_t* hrow = (const bf16_t*)(P.ws + WS_HB) + (size_t)t * D;
    float rstd;
    { const float* ssq = (const float*)(P.ws + WS_SSQ) + (size_t)t * 16;
      const f32x4 s0 = *(const f32x4*)ssq, s1 = *(const f32x4*)(ssq + 4), s2 = *(const f32x4*)(ssq + 8), s3 = *(const f32x4*)(ssq + 12);
      const float tot = ((s0.x + s0.y) + (s0.z + s0.w)) + ((s1.x + s1.y) + (s1.z + s1.w)) + ((s2.x + s2.y) + (s2.z + s2.w)) + ((s3.x + s3.y) + (s3.z + s3.w));
      rstd = 1.f / sqrtf(tot * (1.f / D) + EPS); }
    const unsigned char* U0 = U8; const unsigned char* U1 = U8 + (size_t)NEXP * 256; const unsigned char* V0 = V8; const unsigned char* V1 = V8 + (size_t)NEXP * 512;
    u32x4 R[AP_RINGU];
    {
      u32x4 RB[AP_RINGU];
#pragma unroll
      for (int b4 = 0; b4 < AP_RINGU / 4; ++b4) { const u32x4 ia = grp[b4]; R[4 * b4] = load_q4(U0, ia.x, sub); R[4 * b4 + 1] = load_q4(U0, ia.y, sub); R[4 * b4 + 2] = load_q4(U0, ia.z, sub); R[4 * b4 + 3] = load_q4(U0, ia.w, sub); }
#pragma unroll
      for (int b4 = 0; b4 < AP_RINGU / 4; ++b4) { const u32x4 ia = grp[4 + b4]; RB[4 * b4] = load_q4(U0, ia.x, sub); RB[4 * b4 + 1] = load_q4(U0, ia.y, sub); RB[4 * b4 + 2] = load_q4(U0, ia.z, sub); RB[4 * b4 + 3] = load_q4(U0, ia.w, sub); }
      pass_u4<0, false>(P, hrow, rstd, grp, R, RB, U0, U1, sub);
      pass_u4<1, true>(P, hrow, rstd, grp, R, RB, U1, V0, sub);
    }
    float acc[4][16];
#pragma unroll
    for (int i = 0; i < 4; ++i)
#pragma unroll
        for (int q = 0; q < 16; ++q) acc[i][q] = 0.f;
    pass_v8f<0>(acc, grp, R, V0, V1, sub);
    pass_v8f<1>(acc, grp, R, V1, V1, sub);
    float ss = 0.f;
#pragma unroll
    for (int i = 0; i < 4; ++i) { const int e0 = (sub + 16 * i) * 16;
#pragma unroll
        for (int q = 0; q < 4; ++q) { const u32x2 hb = *(const u32x2*)(hrow + e0 + 4 * q);
            acc[i][4 * q] += bflo(hb.x); acc[i][4 * q + 1] += bfhi(hb.x); acc[i][4 * q + 2] += bflo(hb.y); acc[i][4 * q + 3] += bfhi(hb.y);
            ss += (acc[i][4 * q] * acc[i][4 * q] + acc[i][4 * q + 1] * acc[i][4 * q + 1]) + (acc[i][4 * q + 2] * acc[i][4 * q + 2] + acc[i][4 * q + 3] * acc[i][4 * q + 3]); }
        asm volatile("" ::: "memory"); }
    ss = row16_sum(ss);
    const float r2 = 1.f / sqrtf(ss * (1.f / D) + EPS);
    float* orow = outbase + (size_t)t * D;
#pragma unroll
    for (int i = 0; i < 4; ++i) { const int e0 = (sub + 16 * i) * 16;
#pragma unroll
        for (int q = 0; q < 4; ++q) { const f32x4 gv = *(const f32x4*)(P.norm_final + e0 + 4 * q);
            *(f32x4*)(orow + e0 + 4 * q) = (f32x4){acc[i][4 * q] * r2 * gv.x, acc[i][4 * q + 1] * r2 * gv.y, acc[i][4 * q + 2] * r2 * gv.z, acc[i][4 * q + 3] * r2 * gv.w}; }
        asm volatile("" ::: "memory"); }
}
template <int MODE> __device__ __forceinline__ void apply_phase(const Ptrs& P, float* outbase, unsigned char* shm, int G, int vcu) {
    int tid_l = threadIdx.x; asm volatile("" : "+v"(tid_l));
    const int lane = tid_l & 63; const int wave = __builtin_amdgcn_readfirstlane(tid_l >> 6);
    const int per = M / (G * 8);
#pragma unroll 1
    for (int r = 0; r < per; r += 4) apply_round<MODE>(P, outbase, (vcu * 8 + wave) * per + r, shm + wave * AP_WAVE_BYTES, lane);
}
}

#define LAS __attribute__((address_space(3)))
#define XB_TMO      128
#define XB_XCNT(j)  (256  + 64 * (j))
#define XB_XSUB(j)  (1280 + 64 * (j))
#define XB_XGEN(j)  (2304 + 64 * (j))
#define XB_TOP      3328
#define XB_TOPGEN   3392
#define XCD_BAR_WORDS 3456
#define XB_SPIN_CAP (1u << 18)

__device__ __forceinline__ unsigned xb_ld(unsigned* p)              { return __hip_atomic_load(p, __ATOMIC_RELAXED, __HIP_MEMORY_SCOPE_AGENT); }
__device__ __forceinline__ unsigned xb_add(unsigned* p, unsigned v) { return __hip_atomic_fetch_add(p, v, __ATOMIC_RELAXED, __HIP_MEMORY_SCOPE_AGENT); }
__device__ __forceinline__ unsigned xb_xcc_id() { return (unsigned)__builtin_amdgcn_s_getreg((3 << 11) | 20) & 0xFu; }
#define XB_SPIN(cond, bar) do { unsigned _sp = 0; while (cond) { __builtin_amdgcn_s_sleep(1); \
    if ((++_sp & 255u) == 0u) { if (xb_ld(&(bar)[XB_TMO])) break; if (_sp > XB_SPIN_CAP) { atomicAdd(&(bar)[XB_TMO], 1u); break; } } } } while (0)

struct XcdBarrier {
    unsigned* bar; unsigned x;
    volatile LAS unsigned* st;
};

__device__ __forceinline__ XcdBarrier xcd_barrier_post(unsigned* bar, volatile LAS unsigned* st) {
    XcdBarrier b; b.bar = bar; b.x = xb_xcc_id(); b.st = st;
    if (threadIdx.x == 0) (void)xb_add(&bar[XB_XCNT(b.x)], 1u);
    return b;
}
__device__ __forceinline__ void xcd_barrier_complete(unsigned* bar, unsigned x, unsigned& nloc, unsigned& nx) {
    const unsigned G = gridDim.x * gridDim.y * gridDim.z;
    unsigned sum, cnt, mine, sp = 0u;
    for (;;) {
        sum = 0u; cnt = 0u; mine = 0u;
#pragma unroll
        for (unsigned j = 0; j < 16; ++j) { const unsigned c = xb_ld(&bar[XB_XCNT(j)]); sum += c; cnt += (c > 0u) ? 1u : 0u; mine = (j == x) ? c : mine; }
        if (sum == G) break;
        __builtin_amdgcn_s_sleep(1);
        if ((++sp & 255u) == 0u) { if (xb_ld(&bar[XB_TMO])) break; if (sp > XB_SPIN_CAP) { atomicAdd(&bar[XB_TMO], 1u); break; } }
    }
    nloc = mine > 0u ? mine : 1u; nx = cnt > 0u ? cnt : 1u;
}

__device__ __forceinline__ void xcd_barrier(const XcdBarrier& b) {
    asm volatile("s_waitcnt vmcnt(0)" ::: "memory");
    __syncthreads();
    if (threadIdx.x == 0) {
        unsigned* bar = b.bar;
        __builtin_amdgcn_s_waitcnt(0);
        unsigned nloc = b.st[0], nx = b.st[1];
        if (nloc == 0u) { xcd_barrier_complete(bar, b.x, nloc, nx); b.st[0] = nloc; b.st[1] = nx; }
        const unsigned old = xb_add(&bar[XB_XSUB(b.x)], 1u);
        const unsigned gen = old / nloc;
        if (old + 1u == (gen + 1u) * nloc) {
            __builtin_amdgcn_fence(__ATOMIC_RELEASE, "agent");
            asm volatile("s_waitcnt vmcnt(0)" ::: "memory");
            const unsigned og = xb_add(&bar[XB_TOP], 1u);
            const unsigned tg = og / nx;
            if (og + 1u == (tg + 1u) * nx) xb_add(&bar[XB_TOPGEN], 1u);
            else XB_SPIN(xb_ld(&bar[XB_TOPGEN]) == tg, bar);
            __builtin_amdgcn_fence(__ATOMIC_ACQUIRE, "agent");
            xb_add(&bar[XB_XGEN(b.x)], 1u);
            asm volatile("s_waitcnt vmcnt(0)" ::: "memory");
        } else {
            XB_SPIN(xb_ld(&bar[XB_XGEN(b.x)]) == gen, bar);
            __builtin_amdgcn_fence(__ATOMIC_ACQUIRE, "agent");
            asm volatile("s_waitcnt vmcnt(0)" ::: "memory");
        }
    }
    __syncthreads();
}


namespace cg = cooperative_groups;
#ifndef REP_MASK
#define REP_MASK 0
#endif
#define REPS(k) (((REP_MASK) >> (k)) & 1 ? 2 : 1)
constexpr int PHASE_LDS = att::A_LDS_BYTES;
constexpr int MEGA_LDS = PHASE_LDS + 64;
static_assert(PHASE_LDS >= pg8::STAGE_BYTES && PHASE_LDS >= att::B_LDS_BYTES && PHASE_LDS >= peer::T_LDS_BYTES && PHASE_LDS >= 8 * 64 * 33 * 4 && PHASE_LDS >= apply::AP_LDS_BYTES, "LDS budget");
__global__ void __launch_bounds__(512, 2) mega_fwd(Ptrs P) {
    extern __shared__ __attribute__((aligned(16))) unsigned char lds_dyn[];
    volatile LAS unsigned* bst = (volatile LAS unsigned*)((LAS unsigned char*)lds_dyn + PHASE_LDS);
    if (threadIdx.x < 2) bst[threadIdx.x] = 0u;
    __syncthreads();
    const XcdBarrier bar = xcd_barrier_post((unsigned*)(P.ws + WS_CTL), bst);
    const int G = (int)gridDim.x, bx = (int)blockIdx.x, vcu = (G % 8 == 0) ? (bx % 8) * (G / 8) + bx / 8 : bx;
    unsigned char* ws = P.ws;
    PG8_LAS unsigned char* lds3 = (PG8_LAS unsigned char*)lds_dyn;
    for (int rep = 0; rep < REPS(0); ++rep) prep_phase(P, lds_dyn, G, bx);
    xcd_barrier(bar); if (REPS(9) == 2) xcd_barrier(bar);
    for (int rep = 0; rep < REPS(1); ++rep) {
      { pg8::Gemm g{(const bf16_t*)(ws + WS_XN), (const bf16_t*)(ws + WS_WIN), M, 1024, D, 0}; pg8::StaticOrder S; S.init(M, 1024, G, bx);
        pg8::gemm_phase<pg8::EpiProj, pg8::StaticOrder, true, true, false>(lds3, g, S, pg8::EpiProj{(bf16_t*)(ws + WS_PROJ), (const float*)(ws + WS_ROPE), 1.f, 0}); }
      { pg8::Gemm g{(const bf16_t*)(ws + WS_XN8), (const bf16_t*)(ws + WS_WIN8), M, INW - 1024, D / 2, 0}; pg8::StaticOrder S; S.init(M, INW - 1024, G, bx);
        pg8::gemm_phase<pg8::EpiProj, pg8::StaticOrder, true, true, true>(lds3, g, S, pg8::EpiProj{(bf16_t*)(ws + WS_PROJ), (const float*)(ws + WS_ROPE), 1.f / WIN_SCALE, 4}); } }
    xcd_barrier(bar); if (REPS(9) == 2) xcd_barrier(bar);
    { const float lam = lambda_full(P);
      for (int rep = 0; rep < REPS(2); ++rep) for (int u = vcu; u < BATCH * 4 * 8; u += G) att::attn_a_unit(u >> 5, (u >> 3) & 3, u & 7, (const bf16_t*)(ws + WS_PROJ), (bf16_t*)(ws + WS_YA), P.subln, lam, lds_dyn);
      for (int rep = 0; rep < REPS(3); ++rep) for (int u = vcu; u < BATCH * 8 * 8; u += G) att::attn_b_unit(u >> 6, (u >> 3) & 7, u & 7, (const bf16_t*)(ws + WS_PROJ), (bf16_t*)(ws + WS_YA), P.rpb, lds_dyn); }
    xcd_barrier(bar); if (REPS(9) == 2) xcd_barrier(bar);
    for (int rep = 0; rep < REPS(4); ++rep) { pg8::StaticOrder S; S.init(M, D, G, bx);
      pg8::gemm_phase<pg8::EpiGate2, pg8::StaticOrder, true, true>(lds3, pg8::Gemm{(const bf16_t*)(ws + WS_YA), (const bf16_t*)(ws + WS_WPA), M, D, D, 0}, S, pg8::EpiGate2{(const bf16_t*)(ws + WS_PROJ), (bf16_t*)(ws + WS_MERGED)}); }
    xcd_barrier(bar); if (REPS(9) == 2) xcd_barrier(bar);
    for (int rep = 0; rep < REPS(5); ++rep) { pg8::StaticOrder S; S.init(M, D, G, bx);
      pg8::gemm_phase<pg8::EpiHout, pg8::StaticOrder, true, true>(lds3, pg8::Gemm{(const bf16_t*)(ws + WS_MERGED), (const bf16_t*)(ws + WS_WOUT), M, D, D, 0}, S, pg8::EpiHout{P.x, P.out, (bf16_t*)(ws + WS_HB), (float*)(ws + WS_SSQ)});
    }
    xcd_barrier(bar); if (REPS(9) == 2) xcd_barrier(bar);
    { pg8::StaticOrder S; S.init(M, PQ, G, bx);
      for (int rep = 0; rep < REPS(8); ++rep)
        pg8::gemm_phase<pg8::EpiQ, pg8::StaticOrder, true, true>(lds3, pg8::Gemm{(const bf16_t*)(ws + WS_HB), (const bf16_t*)(ws + WS_WQ), M, PQ, D, 0}, S, pg8::EpiQ{(const float*)(ws + WS_SSQ), (bf16_t*)(ws + WS_Q)});
      asm volatile("s_waitcnt vmcnt(0)" ::: "memory");
      __syncthreads();
      if (threadIdx.x == 0) { __builtin_amdgcn_fence(__ATOMIC_ACQUIRE, "agent"); asm volatile("s_waitcnt vmcnt(0)" ::: "memory"); }
      __syncthreads();
      for (int rep = 0; rep < REPS(6); ++rep) peer::topk_own_units(P, lds_dyn, S); }
    xcd_barrier(bar); if (REPS(9) == 2) xcd_barrier(bar);
#ifndef PROBE_MODE
#define PROBE_MODE 0
#endif
    if (REPS(7) == 2) apply::apply_phase<PROBE_MODE>(P, (float*)(ws + WS_Q), lds_dyn, G, vcu);
    apply::apply_phase<0>(P, P.out, lds_dyn, G, vcu);
}

extern "C" void kernel_launch(void* const* d_in, const int* in_sizes, int n_in, void* d_out, int out_size, void* d_ws, size_t ws_size, hipStream_t stream) {
    if (n_in != 18 || ws_size < WS_END) { fprintf(stderr, "kernel_launch: unexpected n_in %d / ws_size %zu\n", n_in, ws_size); return; }
    Ptrs P{};
    P.x = (const float*)d_in[0]; P.w_in = (const float*)d_in[1]; P.w_pa = (const float*)d_in[2]; P.w_pb = (const float*)d_in[3]; P.w_out = (const float*)d_in[4];
    P.norm_mix = (const float*)d_in[5]; P.norm_ffn = (const float*)d_in[6]; P.norm_final = (const float*)d_in[7];
    P.lq1 = (const float*)d_in[8]; P.lk1 = (const float*)d_in[9]; P.lq2 = (const float*)d_in[10]; P.lk2 = (const float*)d_in[11];
    P.subln = (const float*)d_in[12]; P.rpb = (const float*)d_in[13]; P.w_query = (const float*)d_in[14]; P.sub_keys = (const float*)d_in[15];
    P.peer_u = (const float*)d_in[16]; P.peer_v = (const float*)d_in[17];
    P.out = (float*)d_out; P.ws = (unsigned char*)d_ws;
    static int grid_blocks = 0;
    if (!grid_blocks) {
        int dev = 0, cus = 0, per_cu = 0;
        hipGetDevice(&dev);
        hipDeviceGetAttribute(&cus, hipDeviceAttributeMultiprocessorCount, dev);
        hipFuncSetAttribute((const void*)mega_fwd, hipFuncAttributeMaxDynamicSharedMemorySize, MEGA_LDS);
        hipOccupancyMaxActiveBlocksPerMultiprocessor(&per_cu, (const void*)mega_fwd, 512, MEGA_LDS);
        if (per_cu < 1) { fprintf(stderr, "kernel_launch: occupancy query says %d blocks per CU\n", per_cu); per_cu = 1; }
        grid_blocks = cus * per_cu;
    }
    hipMemsetAsync((unsigned char*)d_ws + WS_CTL, 0, 16384, stream);
    void* args[] = {&P};
    hipError_t e = hipLaunchCooperativeKernel((const void*)mega_fwd, dim3(grid_blocks), dim3(512), args, MEGA_LDS, stream);
    if (e != hipSuccess) fprintf(stderr, "cooperative launch failed: %s (grid %d)\n", hipGetErrorString(e), grid_blocks);
}
```

```cpp
#include <hip/hip_runtime.h>
#include <hip/hip_cooperative_groups.h>
#include <cstdio>
#include <cstdint>

typedef unsigned short bf16_t;
typedef unsigned u32x4 __attribute__((ext_vector_type(4)));
typedef unsigned u32x2 __attribute__((ext_vector_type(2)));
typedef float f32x4 __attribute__((ext_vector_type(4)));
typedef __bf16 bf16x2_t __attribute__((ext_vector_type(2)));

constexpr int D = 1024, BATCH = 8, SEQ = 2048, M = BATCH * SEQ, INW = 5120;
constexpr int C_QA = 0, C_KA = 512, C_VA = 1024, C_QB = 1536, C_KB = 2048, C_VB = 2560, C_GA = 3072, C_GB = 4096;
constexpr int NEXP = 16384, PQ = 2048;
constexpr float EPS = 1e-6f;
constexpr float LOG2E = 1.4426950408889634f;
constexpr float WIN_SCALE = 32.f;
constexpr float QSCALE = 0.125f * LOG2E;

constexpr size_t MiB = 1u << 20;
constexpr size_t WS_PROJ = 0;
constexpr size_t WS_HB = 0;
constexpr size_t WS_Q = 32 * MiB;
constexpr size_t WS_U = 96 * MiB;
constexpr size_t WS_V = 112 * MiB;
constexpr size_t WS_SU = 128 * MiB;
constexpr size_t WS_SV = 128 * MiB + 65536;
constexpr size_t WS_XN = 160 * MiB;
constexpr size_t WS_YA = 160 * MiB;
constexpr size_t WS_YB = 176 * MiB;
constexpr size_t WS_IDX = 160 * MiB;
constexpr size_t WS_G = 168 * MiB;
constexpr size_t WS_MERGED = 192 * MiB;
constexpr size_t WS_TOPV = 192 * MiB;
constexpr size_t WS_TOPI = 208 * MiB;
constexpr size_t WS_WIN = 224 * MiB;
constexpr size_t WS_WIN8 = 226 * MiB;
constexpr size_t WS_XN8 = 192 * MiB;
constexpr size_t WS_WQ = 234 * MiB;
constexpr size_t WS_WOUT = 238 * MiB;
constexpr size_t WS_WPA = 240 * MiB;
constexpr size_t WS_WPB = 241 * MiB;
constexpr size_t WS_SK = 242 * MiB;
constexpr size_t WS_ROPE = 242 * MiB + 512 * 1024;
constexpr size_t WS_SSQ = 243 * MiB;
constexpr size_t WS_CTL = 244 * MiB;
constexpr size_t WS_END = 256 * MiB;

__device__ __forceinline__ float bf2f(unsigned v) { return __uint_as_float(v << 16); }
__device__ __forceinline__ float bflo(unsigned w) { return __uint_as_float(w << 16); }
__device__ __forceinline__ float bfhi(unsigned w) { return __uint_as_float(w & 0xffff0000u); }
__device__ __forceinline__ unsigned f2bf(float f) { unsigned u = __float_as_uint(f); return (u + 0x7fffu + ((u >> 16) & 1u)) >> 16; }
__device__ __forceinline__ unsigned pk2(float lo, float hi) { return f2bf(lo) | (f2bf(hi) << 16); }
__device__ __forceinline__ float wave_sum(float v) {
#pragma unroll
    for (int o = 1; o < 64; o <<= 1) v += __shfl_xor(v, o);
    return v;
}
__device__ __forceinline__ float sigmoidf_(float x) { return 1.f / (1.f + __expf(-x)); }
__device__ __forceinline__ float gelu_exact(float x) { return 0.5f * x * (1.f + erff(x * 0.70710678118654752f)); }

struct Ptrs {
    const float *x, *w_in, *w_pa, *w_pb, *w_out, *norm_mix, *norm_ffn, *norm_final, *lq1, *lk1, *lq2, *lk2, *subln, *rpb, *w_query, *sub_keys, *peer_u, *peer_v;
    float* out; unsigned char* ws;
};

__device__ __forceinline__ void transpose_item(const float* W, int K, int N, const float* gain, bf16_t* WT, float* scr, int item, int lane, int ldo = 0, int koff = 0, int ldw = 0) {
    if (ldo == 0) ldo = K;
    if (ldw == 0) ldw = N;
    const int nblk = N / 32, kb = item / nblk, nb = item % nblk, k0 = 64 * kb, n0 = 32 * nb;
    float wv[32];
#pragma unroll
    for (int i = 0; i < 32; ++i) { const int kk = 2 * i + (lane >> 5); wv[i] = W[(size_t)(k0 + kk) * ldw + n0 + (lane & 31)]; }
#pragma unroll
    for (int i = 0; i < 32; ++i) { const int kk = 2 * i + (lane >> 5); float w = wv[i]; if (gain) w *= gain[k0 + kk]; scr[kk * 33 + (lane & 31)] = w; }
    asm volatile("s_waitcnt lgkmcnt(0)" ::: "memory");
    const int c = lane & 7;
#pragma unroll
    for (int j = 0; j < 4; ++j) { const int n = (lane >> 3) + 8 * j; const float* s = scr + (8 * c) * 33 + n;
        u32x4 o; o.x = pk2(s[0 * 33], s[1 * 33]); o.y = pk2(s[2 * 33], s[3 * 33]); o.z = pk2(s[4 * 33], s[5 * 33]); o.w = pk2(s[6 * 33], s[7 * 33]);
        *(u32x4*)(WT + (size_t)(n0 + n) * ldo + koff + k0 + 8 * c) = o; }
    asm volatile("s_waitcnt lgkmcnt(0)" ::: "memory");
}
__device__ __forceinline__ void cvt8(const float* src, bf16_t* dst, size_t i8) {
    const f32x4 a = *(const f32x4*)(src + i8 * 8), b = *(const f32x4*)(src + i8 * 8 + 4);
    u32x4 o; o.x = pk2(a.x, a.y); o.y = pk2(a.z, a.w); o.z = pk2(b.x, b.y); o.w = pk2(b.z, b.w);
    *(u32x4*)(dst + i8 * 8) = o;
}
__device__ __forceinline__ void transpose_item8(const float* W, int K, int N, int ldw, const float* gain, float wscale, unsigned char* WT, float* scr, int item, int lane) {
    const int nblk = N / 32, kb = item / nblk, nb = item % nblk, k0 = 64 * kb, n0 = 32 * nb;
    float wv[32];
#pragma unroll
    for (int i = 0; i < 32; ++i) { const int kk = 2 * i + (lane >> 5); wv[i] = W[(size_t)(k0 + kk) * ldw + n0 + (lane & 31)]; }
#pragma unroll
    for (int i = 0; i < 32; ++i) { const int kk = 2 * i + (lane >> 5); float w = wv[i] * wscale; if (gain) w *= gain[k0 + kk]; scr[kk * 33 + (lane & 31)] = w; }
    asm volatile("s_waitcnt lgkmcnt(0)" ::: "memory");
    const int c = lane & 7;
#pragma unroll
    for (int j = 0; j < 4; ++j) { const int n = (lane >> 3) + 8 * j; const float* s = scr + (8 * c) * 33 + n;
        u32x2 o; o.x = __builtin_amdgcn_cvt_pk_fp8_f32(s[0 * 33], s[1 * 33], 0u, false); o.x = __builtin_amdgcn_cvt_pk_fp8_f32(s[2 * 33], s[3 * 33], o.x, true);
        o.y = __builtin_amdgcn_cvt_pk_fp8_f32(s[4 * 33], s[5 * 33], 0u, false); o.y = __builtin_amdgcn_cvt_pk_fp8_f32(s[6 * 33], s[7 * 33], o.y, true);
        *(u32x2*)(WT + (size_t)(n0 + n) * K + k0 + 8 * c) = o; }
    asm volatile("s_waitcnt lgkmcnt(0)" ::: "memory");
}
__device__ __forceinline__ void rms_rows_emit(const f32x4 (&v)[4], bf16_t* orow16, unsigned char* orow, int lane) {
    float s = 0.f;
#pragma unroll
    for (int j = 0; j < 4; ++j) s += (v[j].x * v[j].x + v[j].y * v[j].y) + (v[j].z * v[j].z + v[j].w * v[j].w);
    const float rstd = 1.f / sqrtf(wave_sum(s) * (1.f / D) + EPS);
    unsigned* o4 = (unsigned*)orow + lane; u32x2* o8 = (u32x2*)orow16 + lane;
#pragma unroll
    for (int j = 0; j < 4; ++j) { unsigned w = __builtin_amdgcn_cvt_pk_fp8_f32(v[j].x * rstd, v[j].y * rstd, 0u, false); w = __builtin_amdgcn_cvt_pk_fp8_f32(v[j].z * rstd, v[j].w * rstd, w, true); o4[64 * j] = w;
        u32x2 w2; w2.x = pk2(v[j].x * rstd, v[j].y * rstd); w2.y = pk2(v[j].z * rstd, v[j].w * rstd); o8[64 * j] = w2; }
}
__device__ __forceinline__ void rms_rows(const float* x, bf16_t* xn16, unsigned char* xn8, int m0, int step, int lane) {
    if (m0 >= M) return;
    f32x4 cur[4], nxt[4];
#pragma unroll
    for (int j = 0; j < 4; ++j) cur[j] = ((const f32x4*)(x + (size_t)m0 * D) + lane)[64 * j];
    for (int m = m0; m < M; m += step) {
        const int mn = (m + step < M) ? m + step : m;
#pragma unroll
        for (int j = 0; j < 4; ++j) nxt[j] = ((const f32x4*)(x + (size_t)mn * D) + lane)[64 * j];
        rms_rows_emit(cur, xn16 + (size_t)m * D, xn8 + (size_t)m * D, lane);
#pragma unroll
        for (int j = 0; j < 4; ++j) cur[j] = nxt[j];
    }
}
__device__ __forceinline__ void rms_row_to_bf16(const float* xrow, bf16_t* orow, int lane) {
    const f32x4* xr = (const f32x4*)xrow + lane;
    f32x4 v[4]; float s = 0.f;
#pragma unroll
    for (int j = 0; j < 4; ++j) { v[j] = xr[64 * j]; s += (v[j].x * v[j].x + v[j].y * v[j].y) + (v[j].z * v[j].z + v[j].w * v[j].w); }
    const float rstd = 1.f / sqrtf(wave_sum(s) * (1.f / D) + EPS);
    u32x2* o8 = (u32x2*)orow + lane;
#pragma unroll
    for (int j = 0; j < 4; ++j) { u32x2 w; w.x = pk2(v[j].x * rstd, v[j].y * rstd); w.y = pk2(v[j].z * rstd, v[j].w * rstd); o8[64 * j] = w; }
}

__device__ __forceinline__ void prep_phase(const Ptrs& P, unsigned char* shm, int G, int bx) {
    int tid_l = threadIdx.x; asm volatile("" : "+v"(tid_l));
    const int lane = tid_l & 63; const int wave = __builtin_amdgcn_readfirstlane(tid_l >> 6);
    const int gw = bx * 8 + wave, NGW = G * 8;
    float* scr = (float*)(shm + wave * (64 * 33 * 4));
    unsigned char* ws = P.ws;
    constexpr int N_BF = 1024;
    constexpr int I_INB = (D / 64) * (N_BF / 32), I_IN8 = (D / 64) * ((INW - N_BF) / 32), I_IN = I_INB + I_IN8, I_Q = (D / 64) * (PQ / 32), I_OUT = (D / 64) * (D / 32), I_PA = (512 / 64) * (D / 32);
    constexpr int NIT = I_IN + I_Q + I_OUT + 2 * I_PA;
    for (int it = gw; it < NIT; it += NGW) {
        int r = it;
        if (r < I_INB) { transpose_item(P.w_in, D, N_BF, P.norm_mix, (bf16_t*)(ws + WS_WIN), scr, r, lane, 0, 0, INW); continue; } r -= I_INB;
        if (r < I_IN8) { transpose_item8(P.w_in + N_BF, D, INW - N_BF, INW, P.norm_mix, WIN_SCALE, ws + WS_WIN8, scr, r, lane); continue; } r -= I_IN8;
        if (r < I_Q) { transpose_item(P.w_query, D, PQ, P.norm_ffn, (bf16_t*)(ws + WS_WQ), scr, r, lane); continue; } r -= I_Q;
        if (r < I_OUT) { transpose_item(P.w_out, D, D, nullptr, (bf16_t*)(ws + WS_WOUT), scr, r, lane); continue; } r -= I_OUT;
        if (r < I_PA) { transpose_item(P.w_pa, 512, D, nullptr, (bf16_t*)(ws + WS_WPA), scr, r, lane, 1024, 0); continue; } r -= I_PA;
        transpose_item(P.w_pb, 512, D, nullptr, (bf16_t*)(ws + WS_WPA), scr, r, lane, 1024, 512);
    }
    rms_rows(P.x, (bf16_t*)(ws + WS_XN), ws + WS_XN8, gw, NGW, lane);
    const size_t gt = (size_t)bx * 512 + threadIdx.x, NT = (size_t)G * 512;
    for (size_t i = gt; i < (size_t)16 * 128 * 128 / 8; i += NT) cvt8(P.sub_keys, (bf16_t*)(ws + WS_SK), i);
    for (size_t i = gt; i < (size_t)SEQ * 8; i += NT) {
        const int pos = (int)(i >> 3), k = (int)(i & 7);
        const float inv = k == 0 ? 1.0f : k == 1 ? 0.19392274f : k == 2 ? 0.03760603f : k == 3 ? 0.0072926646f : k == 4 ? 0.0014142136f : k == 5 ? 0.0002742482f : k == 6 ? 5.3182957e-05f : 1.0313385e-05f;
        const float ang = (float)pos * inv;
        float sn, cs; sincosf(ang, &sn, &cs);
        float* t = (float*)(ws + WS_ROPE) + (size_t)pos * 16;
        t[k] = cs; t[8 + k] = sn;
    }
}
__device__ __forceinline__ void cvt_row_fp8(const f32x4 (&rv)[4], unsigned char* dst, float* inv_scale, int lane) {
    const f32x4 a = rv[0], b = rv[1], c = rv[2], d = rv[3];
    float m = fmaxf(fmaxf(fmaxf(fabsf(a.x), fabsf(a.y)), fmaxf(fabsf(a.z), fabsf(a.w))), fmaxf(fmaxf(fabsf(b.x), fabsf(b.y)), fmaxf(fabsf(b.z), fabsf(b.w))));
    m = fmaxf(m, fmaxf(fmaxf(fmaxf(fabsf(c.x), fabsf(c.y)), fmaxf(fabsf(c.z), fabsf(c.w))), fmaxf(fmaxf(fabsf(d.x), fabsf(d.y)), fmaxf(fabsf(d.z), fabsf(d.w)))));
#pragma unroll
    for (int o = 1; o < 64; o <<= 1) m = fmaxf(m, __shfl_xor(m, o));
    m = fmaxf(m, 1e-30f);
    const float sc = 256.f / m;
    u32x4 w;
    w.x = __builtin_amdgcn_cvt_pk_fp8_f32(a.x * sc, a.y * sc, 0u, false); w.x = __builtin_amdgcn_cvt_pk_fp8_f32(a.z * sc, a.w * sc, w.x, true);
    w.y = __builtin_amdgcn_cvt_pk_fp8_f32(b.x * sc, b.y * sc, 0u, false); w.y = __builtin_amdgcn_cvt_pk_fp8_f32(b.z * sc, b.w * sc, w.y, true);
    w.z = __builtin_amdgcn_cvt_pk_fp8_f32(c.x * sc, c.y * sc, 0u, false); w.z = __builtin_amdgcn_cvt_pk_fp8_f32(c.z * sc, c.w * sc, w.z, true);
    w.w = __builtin_amdgcn_cvt_pk_fp8_f32(d.x * sc, d.y * sc, 0u, false); w.w = __builtin_amdgcn_cvt_pk_fp8_f32(d.z * sc, d.w * sc, w.w, true);
    *(u32x4*)(dst + (size_t)(lane >> 5) * (NEXP * 512) + (lane & 31) * 16) = w;
    if (lane == 0) *inv_scale = m * (1.f / 256.f);
}
typedef float f32x16v __attribute__((ext_vector_type(16)));
typedef float f32x32v __attribute__((ext_vector_type(32)));
typedef unsigned u32x6v __attribute__((ext_vector_type(6)));
__device__ __forceinline__ void cvt_row_fp6(const f32x4 (&rv)[4], unsigned char* dst  , float* inv_scale, int lane) {
    const f32x4 a = rv[0], b = rv[1], c = rv[2], d = rv[3];
    float m = fmaxf(fmaxf(fmaxf(fabsf(a.x), fabsf(a.y)), fmaxf(fabsf(a.z), fabsf(a.w))), fmaxf(fmaxf(fabsf(b.x), fabsf(b.y)), fmaxf(fabsf(b.z), fabsf(b.w))));
    m = fmaxf(m, fmaxf(fmaxf(fmaxf(fabsf(c.x), fabsf(c.y)), fmaxf(fabsf(c.z), fabsf(c.w))), fmaxf(fmaxf(fabsf(d.x), fabsf(d.y)), fmaxf(fabsf(d.z), fabsf(d.w)))));
#pragma unroll
    for (int o = 1; o < 64; o <<= 1) m = fmaxf(m, __shfl_xor(m, o));
    m = fmaxf(m, 1e-30f);
    const float sc = 7.5f / m;
    f32x16v own, oth;
    const float ov[16] = {a.x, a.y, a.z, a.w, b.x, b.y, b.z, b.w, c.x, c.y, c.z, c.w, d.x, d.y, d.z, d.w};
#pragma unroll
    for (int i = 0; i < 16; ++i) { const float v = fminf(fmaxf(ov[i] * sc, -7.5f), 7.5f); own[i] = v; oth[i] = __shfl_xor(v, 16); }
    const u32x6v w = __builtin_amdgcn_cvt_scalef32_2xpk16_fp6_f32(own, oth, 1.0f);
    if (((lane >> 4) & 1) == 0) { u32x2* o = (u32x2*)(dst + (lane & 15) * 48 + (lane >> 5) * 24); o[0] = (u32x2){w[0], w[1]}; o[1] = (u32x2){w[2], w[3]}; o[2] = (u32x2){w[4], w[5]}; }
    if (lane == 0) *inv_scale = m * (1.f / 7.5f);
}
__device__ __forceinline__ unsigned nib4(float v, float sc) { const int q = (int)rintf(fminf(fmaxf(v * sc, -7.f), 7.f)); return (unsigned)q & 15u; }
__device__ __forceinline__ unsigned pack_i4x8(const f32x4& a, const f32x4& b, float sc) {
    return nib4(a.x, sc) | (nib4(a.y, sc) << 4) | (nib4(a.z, sc) << 8) | (nib4(a.w, sc) << 12) | (nib4(b.x, sc) << 16) | (nib4(b.y, sc) << 20) | (nib4(b.z, sc) << 24) | (nib4(b.w, sc) << 28);
}
__device__ __forceinline__ void cvt_row_i4(const f32x4 (&rv)[4], unsigned char* dst, float* inv_scale, int lane) {
    const f32x4 a = rv[0], b = rv[1], c = rv[2], d = rv[3];
    float ss = ((a.x * a.x + a.y * a.y) + (a.z * a.z + a.w * a.w)) + ((b.x * b.x + b.y * b.y) + (b.z * b.z + b.w * b.w));
    ss += ((c.x * c.x + c.y * c.y) + (c.z * c.z + c.w * c.w)) + ((d.x * d.x + d.y * d.y) + (d.z * d.z + d.w * d.w));
#pragma unroll
    for (int o = 1; o < 64; o <<= 1) ss += __shfl_xor(ss, o);
    const float rms = fmaxf(sqrtf(ss * (1.f / D)), 1e-30f);
    const float sc = 2.8f / rms;
    u32x2 w; w.x = pack_i4x8(a, b, sc); w.y = pack_i4x8(c, d, sc);
    *(u32x2*)(dst + (size_t)(lane >> 5) * (NEXP * 256) + (lane & 15) * 16 + ((lane >> 4) & 1) * 8) = w;
    if (lane == 0) *inv_scale = rms * (2.5f / 7.f);
}
__device__ __forceinline__ unsigned pack_i8x4(float a, float b, float c, float d) {
    const int q0 = (int)rintf(a), q1 = (int)rintf(b), q2 = (int)rintf(c), q3 = (int)rintf(d);
    return (unsigned)(q0 & 0xff) | ((unsigned)(q1 & 0xff) << 8) | ((unsigned)(q2 & 0xff) << 16) | ((unsigned)q3 << 24);
}
__device__ __forceinline__ void cvt_row_i8(const f32x4 (&rv)[4], unsigned char* dst, float* inv_scale, int lane) {
    const f32x4 a = rv[0], b = rv[1], c = rv[2], d = rv[3];
    float m = fmaxf(fmaxf(fmaxf(fabsf(a.x), fabsf(a.y)), fmaxf(fabsf(a.z), fabsf(a.w))), fmaxf(fmaxf(fabsf(b.x), fabsf(b.y)), fmaxf(fabsf(b.z), fabsf(b.w))));
    m = fmaxf(m, fmaxf(fmaxf(fmaxf(fabsf(c.x), fabsf(c.y)), fmaxf(fabsf(c.z), fabsf(c.w))), fmaxf(fmaxf(fabsf(d.x), fabsf(d.y)), fmaxf(fabsf(d.z), fabsf(d.w)))));
#pragma unroll
    for (int o = 1; o < 64; o <<= 1) m = fmaxf(m, __shfl_xor(m, o));
    m = fmaxf(m, 1e-30f);
    const float sc = 127.f / m;
    u32x4 w;
    w.x = pack_i8x4(a.x * sc, a.y * sc, a.z * sc, a.w * sc); w.y = pack_i8x4(b.x * sc, b.y * sc, b.z * sc, b.w * sc);
    w.z = pack_i8x4(c.x * sc, c.y * sc, c.z * sc, c.w * sc); w.w = pack_i8x4(d.x * sc, d.y * sc, d.z * sc, d.w * sc);
    *(u32x4*)(dst + (size_t)(lane >> 5) * (NEXP * 512) + (lane & 31) * 16) = w;
    if (lane == 0) *inv_scale = m * (1.f / 127.f);
}
__device__ __forceinline__ void cvt_experts_phase(const Ptrs& P, int G, int bx) {
    int tid_l = threadIdx.x; asm volatile("" : "+v"(tid_l));
    const int lane = tid_l & 63; const int wave = __builtin_amdgcn_readfirstlane(tid_l >> 6);
    const int step = G * 8; int r = bx * 8 + wave;
    if (r >= 2 * NEXP) return;
    f32x4 cur[4], nxt[4];
    { const float* src = (r < NEXP ? P.peer_u + (size_t)r * D : P.peer_v + (size_t)(r - NEXP) * D);
#pragma unroll
      for (int j = 0; j < 4; ++j) cur[j] = ((const f32x4*)src + lane * 4)[j]; }
    for (; r < 2 * NEXP; r += step) {
        const int rn = (r + step < 2 * NEXP) ? r + step : r;
        const float* srcn = (rn < NEXP ? P.peer_u + (size_t)rn * D : P.peer_v + (size_t)(rn - NEXP) * D);
#pragma unroll
        for (int j = 0; j < 4; ++j) nxt[j] = ((const f32x4*)srcn + lane * 4)[j];
        if (r < NEXP) cvt_row_i8(cur, P.ws + WS_U + (size_t)r * 512, (float*)(P.ws + WS_SU) + r, lane);
        else { const int e = r - NEXP; cvt_row_fp8(cur, P.ws + WS_V + (size_t)e * 512, (float*)(P.ws + WS_SV) + e, lane); }
#pragma unroll
        for (int j = 0; j < 4; ++j) cur[j] = nxt[j];
    }
}

namespace pg8 {
#define PG8_LAS __attribute__((address_space(3)))
typedef unsigned short bf16_t;
typedef short bf16x8 __attribute__((ext_vector_type(8)));
typedef float f32x4 __attribute__((ext_vector_type(4)));
typedef unsigned u32x4 __attribute__((ext_vector_type(4)));
typedef int v8i_t __attribute__((ext_vector_type(8)));
constexpr int BM = 256, BK = 64, HALF = 128, HTB = HALF * BK * 2  , STAGE_BYTES = 8 * HTB, NXCD = 8, WGM = 4;

__host__ __device__ __forceinline__ int lds_byte(int r, int c) { const int st = (r >> 4) * 2 + (c >> 5), rr = r & 15, cc = c & 31, ob = rr * 64 + cc * 2; return st * 1024 + (ob ^ (((ob >> 9) & 1) << 5)); }
__host__ __device__ __forceinline__ void stage_rc(int b, int& R, int& C) { const int st = b / 1024, sb = b % 1024, swz = sb ^ (((sb >> 9) & 1) << 5); R = (st >> 1) * 16 + swz / 64; C = (st & 1) * 32 + (swz % 64) / 2; }
__host__ __device__ __forceinline__ int perm32(int rho) { const int n = rho >> 4, i = rho & 15; return 8 * (i >> 2) + 4 * n + (i & 3); }

struct Unit { int pm, pn; };
struct Gemm { const bf16_t* A; const bf16_t* Bt; int M, N, K, pad; };

struct StaticOrder {
    int nM, nN, nwg, G, c;
    __host__ __device__ void init(int M, int N, int G_, int c_) { nM = M / BM; nN = N / BM; nwg = nM * nN; G = G_; c = c_; }
    __host__ __device__ bool next(int i, Unit& u) const {
        const long L = (long)i * G + c; if (L >= nwg) return false;
        int wgid = (int)L; { const int q = nwg / NXCD, r = nwg % NXCD, xcd = wgid % NXCD, off = wgid / NXCD; wgid = (xcd < r ? xcd * (q + 1) : r * (q + 1) + (xcd - r) * q) + off; }
        const int nig = WGM * nN, gid = wgid / nig, fm = gid * WGM, gsz = (nM - fm) < WGM ? (nM - fm) : WGM;
        u.pm = fm + ((wgid % nig) % gsz); u.pn = (wgid % nig) / gsz; return true;
    }
    __device__ __forceinline__ void a_ready(const Unit&) const {}
    __device__ __forceinline__ void done(const Unit&) const {}
};
__device__ __forceinline__ unsigned cvt_pk_bf16(float lo, float hi) { unsigned r; asm volatile("v_cvt_pk_bf16_f32 %0, %1, %2" : "=v"(r) : "v"(lo), "v"(hi)); return r; }
typedef float f32x2 __attribute__((ext_vector_type(2)));

__device__ __forceinline__ float sigm(float x) { return __builtin_amdgcn_rcpf(1.f + __builtin_amdgcn_exp2f(-1.4426950408889634f * x)); }
struct EpiProj {
    static constexpr bool PERM = true, AFTER_DRAIN = false, MID = false;
    bf16_t* O; const float* rope; float osc; int pn0;
    __device__ __forceinline__ void operator()(const f32x4 (&acc)[2][2][4][2], const Unit& u, int wr, int wc, int fr_, int fq_) const {
        int fr = fr_, fq = fq_; asm volatile("" : "+v"(fr), "+v"(fq));
        const int pn = u.pn + pn0;
        const int row0 = u.pm * BM + wr * 64 + fr, col0 = pn * BM + wc * 32 + 8 * fq;
        const float sc = ((pn < 2 || pn == 6 || pn == 7) ? QSCALE : 1.f) * osc;
        const bool dorope = (pn < 4) && ((wc & 1) == 0);
#pragma unroll
        for (int ai = 0; ai < 2; ++ai)
#pragma unroll
            for (int m = 0; m < 4; ++m) { const int row = row0 + ai * HALF + m * 16; bf16_t* rowp = O + (size_t)row * INW + col0;
                f32x4 c4[2] = {{1.f, 1.f, 1.f, 1.f}, {1.f, 1.f, 1.f, 1.f}}, s4[2] = {{0.f, 0.f, 0.f, 0.f}, {0.f, 0.f, 0.f, 0.f}};
                if (dorope) { const float* rp = rope + (size_t)(row & (SEQ - 1)) * 16; c4[0] = *(const f32x4*)(rp); c4[1] = *(const f32x4*)(rp + 4); s4[0] = *(const f32x4*)(rp + 8); s4[1] = *(const f32x4*)(rp + 12); }
#pragma unroll
                for (int bj = 0; bj < 2; ++bj) { f32x4 v0 = acc[ai][bj][m][0], v1 = acc[ai][bj][m][1];
                    if (dorope) { f32x4 o0, o1;
#pragma unroll
                        for (int j = 0; j < 4; ++j) { o0[j] = __shfl_xor(v0[j], 16); o1[j] = __shfl_xor(v1[j], 16); }
                        if (fq == 0) { v0 = v0 * c4[0] - o0 * s4[0]; v1 = v1 * c4[1] - o1 * s4[1]; }
                        else if (fq == 1) { v0 = v0 * c4[0] + o0 * s4[0]; v1 = v1 * c4[1] + o1 * s4[1]; } }
                    v0 = v0 * sc; v1 = v1 * sc; u32x4 w; w.x = cvt_pk_bf16(v0[0], v0[1]); w.y = cvt_pk_bf16(v0[2], v0[3]); w.z = cvt_pk_bf16(v1[0], v1[1]); w.w = cvt_pk_bf16(v1[2], v1[3]);
                    *(u32x4*)(rowp + bj * HALF) = w; } }
    }
};
struct EpiGate2 {
    static constexpr bool PERM = true, AFTER_DRAIN = false, MID = true;
    const bf16_t* proj; bf16_t* O;
    __device__ __forceinline__ void mid(f32x4 (&acc)[2][2][4][2], const Unit& u, int wr, int wc, int fr, int fq) const {
        int row0 = u.pm * BM + wr * 64 + fr, col0 = u.pn * BM + wc * 32 + 8 * fq;
        asm volatile("" : "+v"(row0), "+v"(col0));
#pragma unroll
        for (int ai = 0; ai < 2; ++ai) {
            u32x4 gav[4][2], gbv[4][2];
#pragma unroll
            for (int m = 0; m < 4; ++m)
#pragma unroll
                for (int bj = 0; bj < 2; ++bj) { const bf16_t* gp = proj + (size_t)(row0 + ai * HALF + m * 16) * INW + col0 + bj * HALF; gav[m][bj] = *(const u32x4*)(gp + C_GA); gbv[m][bj] = *(const u32x4*)(gp + C_GB); }
#pragma unroll
            for (int m = 0; m < 4; ++m) {
#pragma unroll
                for (int bj = 0; bj < 2; ++bj) { const u32x4 ga = gav[m][bj], gb = gbv[m][bj];
                    const unsigned a_[4] = {ga.x, ga.y, ga.z, ga.w}, b_[4] = {gb.x, gb.y, gb.z, gb.w};
#pragma unroll
                    for (int q = 0; q < 4; ++q) {
                        const float r0 = (1.f + __builtin_amdgcn_exp2f(-1.4426950408889634f * bflo(b_[q]))) * __builtin_amdgcn_rcpf(1.f + __builtin_amdgcn_exp2f(-1.4426950408889634f * bflo(a_[q])));
                        const float r1 = (1.f + __builtin_amdgcn_exp2f(-1.4426950408889634f * bfhi(b_[q]))) * __builtin_amdgcn_rcpf(1.f + __builtin_amdgcn_exp2f(-1.4426950408889634f * bfhi(a_[q])));
                        acc[ai][bj][m][q >> 1][(q & 1) * 2] *= r0; acc[ai][bj][m][q >> 1][(q & 1) * 2 + 1] *= r1; } } }
            asm volatile("" ::: "memory"); }
    }
    __device__ __forceinline__ void operator()(const f32x4 (&acc)[2][2][4][2], const Unit& u, int wr, int wc, int fr_, int fq_) const {
        int fr = fr_, fq = fq_; asm volatile("" : "+v"(fr), "+v"(fq));
        const int row0 = u.pm * BM + wr * 64 + fr, col0 = u.pn * BM + wc * 32 + 8 * fq;
#pragma unroll
        for (int ai = 0; ai < 2; ++ai) {
            u32x4 gv[4][2];
#pragma unroll
            for (int m = 0; m < 4; ++m)
#pragma unroll
                for (int bj = 0; bj < 2; ++bj) gv[m][bj] = *(const u32x4*)(proj + (size_t)(row0 + ai * HALF + m * 16) * INW + C_GB + col0 + bj * HALF);
#pragma unroll
            for (int m = 0; m < 4; ++m) { const int row = row0 + ai * HALF + m * 16;
#pragma unroll
                for (int bj = 0; bj < 2; ++bj) { const int col = col0 + bj * HALF; const u32x4 g = gv[m][bj];
                    f32x4 v0 = acc[ai][bj][m][0], v1 = acc[ai][bj][m][1];
                    v0[0] *= sigm(bflo(g.x)); v0[1] *= sigm(bfhi(g.x)); v0[2] *= sigm(bflo(g.y)); v0[3] *= sigm(bfhi(g.y));
                    v1[0] *= sigm(bflo(g.z)); v1[1] *= sigm(bfhi(g.z)); v1[2] *= sigm(bflo(g.w)); v1[3] *= sigm(bfhi(g.w));
                    u32x4 w; w.x = cvt_pk_bf16(v0[0], v0[1]); w.y = cvt_pk_bf16(v0[2], v0[3]); w.z = cvt_pk_bf16(v1[0], v1[1]); w.w = cvt_pk_bf16(v1[2], v1[3]);
                    *(u32x4*)(O + (size_t)row * D + col) = w; } }
            asm volatile("" ::: "memory"); }
    }
};
struct EpiHout {
    static constexpr bool PERM = true, AFTER_DRAIN = false, MID = false;
    const float* x; float* H; bf16_t* HB; float* ssq16;
    __device__ __forceinline__ void operator()(const f32x4 (&acc)[2][2][4][2], const Unit& u, int wr, int wc, int fr_, int fq_) const {
        int fr = fr_, fq = fq_; asm volatile("" : "+v"(fr), "+v"(fq));
        const int row0 = u.pm * BM + wr * 64 + fr, col0 = u.pn * BM + wc * 32 + 8 * fq;
#pragma unroll
        for (int ai = 0; ai < 2; ++ai) {
            f32x4 xv[4][2][2];
#pragma unroll
            for (int m = 0; m < 4; ++m)
#pragma unroll
                for (int bj = 0; bj < 2; ++bj) { const float* xp = x + (size_t)(row0 + ai * HALF + m * 16) * D + col0 + bj * HALF; xv[m][bj][0] = *(const f32x4*)xp; xv[m][bj][1] = *(const f32x4*)(xp + 4); }
#pragma unroll
            for (int m = 0; m < 4; ++m) { const int row = row0 + ai * HALF + m * 16; float ss = 0.f;
#pragma unroll
                for (int bj = 0; bj < 2; ++bj) { const int col = col0 + bj * HALF;
                    const f32x4 v0 = acc[ai][bj][m][0] + xv[m][bj][0], v1 = acc[ai][bj][m][1] + xv[m][bj][1];
                    u32x4 w; w.x = cvt_pk_bf16(v0[0], v0[1]); w.y = cvt_pk_bf16(v0[2], v0[3]); w.z = cvt_pk_bf16(v1[0], v1[1]); w.w = cvt_pk_bf16(v1[2], v1[3]);
                    *(u32x4*)(HB + (size_t)row * D + col) = w;
                    ss += (v0[0] * v0[0] + v0[1] * v0[1]) + (v0[2] * v0[2] + v0[3] * v0[3]) + (v1[0] * v1[0] + v1[1] * v1[1]) + (v1[2] * v1[2] + v1[3] * v1[3]); }
                ss += __shfl_xor(ss, 16); ss += __shfl_xor(ss, 32);
                if (fq == 0) ssq16[(size_t)row * 16 + u.pn * 4 + wc] = ss; }
            asm volatile("" ::: "memory"); }
    }
};
struct EpiQ {
    static constexpr bool PERM = true, AFTER_DRAIN = false, MID = false;
    const float* ssq16; bf16_t* O;
    __device__ __forceinline__ void operator()(const f32x4 (&acc)[2][2][4][2], const Unit& u, int wr, int wc, int fr, int fq) const {
        const int row0 = u.pm * BM + wr * 64 + fr, col0 = u.pn * BM + wc * 32 + 8 * fq;
#pragma unroll
        for (int ai = 0; ai < 2; ++ai)
#pragma unroll
            for (int m = 0; m < 4; ++m) { const int row = row0 + ai * HALF + m * 16; const f32x4* sp = (const f32x4*)(ssq16 + (size_t)row * 16);
                const f32x4 a = sp[0], b = sp[1], c = sp[2], d = sp[3];
                const float tot = ((a[0] + a[1]) + (a[2] + a[3])) + ((b[0] + b[1]) + (b[2] + b[3])) + ((c[0] + c[1]) + (c[2] + c[3])) + ((d[0] + d[1]) + (d[2] + d[3]));
                const float rstd = 1.f / sqrtf(tot * (1.f / D) + EPS);
#pragma unroll
                for (int bj = 0; bj < 2; ++bj) { const f32x4 v0 = acc[ai][bj][m][0] * rstd, v1 = acc[ai][bj][m][1] * rstd;
                    u32x4 w; w.x = cvt_pk_bf16(v0[0], v0[1]); w.y = cvt_pk_bf16(v0[2], v0[3]); w.z = cvt_pk_bf16(v1[0], v1[1]); w.w = cvt_pk_bf16(v1[2], v1[3]);
                    *(u32x4*)(O + (size_t)row * PQ + col0 + bj * HALF) = w; } }
    }
};
template <class Epi, class Sched, bool ALIGN_EPI = false, bool SP2 = false, bool FP8 = false>
__device__ __forceinline__ void gemm_phase(PG8_LAS unsigned char* lds, const Gemm g, const Sched& S, const Epi& E) {
    int tid_l = threadIdx.x; asm volatile("" : "+v"(tid_l));
    const int tid = tid_l, wid = __builtin_amdgcn_readfirstlane(tid >> 6), lane = tid & 63, wr = wid >> 2, wc = wid & 3, fr = lane & 15, fq = lane >> 4;
    const int K = g.K, nt = K / BK;
    unsigned voffA[2], voffB[2];
#pragma unroll
    for (int i = 0; i < 2; ++i) { int R, C; stage_rc(tid * 16 + i * 8192, R, C); const int Rb = Epi::PERM ? ((R & ~31) + perm32(R & 31)) : R;
        voffA[i] = (unsigned)(R * K + C) * 2u; voffB[i] = (unsigned)(Rb * K + C) * 2u; }
    const size_t kstep = (size_t)(BK * 2);
    const size_t hstep = (size_t)HALF * K * 2;
    const size_t tstep = 2 * hstep;
    const unsigned ldsw = (unsigned)wid * 1024u;
    const int aoff = lds_byte(wr * 64 + fr, fq * 8), boff = lds_byte(wc * 32 + fr, fq * 8);
    const int aoffF0 = FP8 ? lds_byte(wr * 64 + fr, fq * 16) : 0, boffF0 = FP8 ? lds_byte(wc * 32 + fr, fq * 16) : 0;
#define PG8_SA(b, h) (((b) * 2 + (h)) * HTB)
#define PG8_SB(b, h) ((4 + (b) * 2 + (h)) * HTB)
#define PG8_STAGE(bufoff, gbase, voff) do { _Pragma("unroll") for (int _i = 0; _i < 2; ++_i) \
        __builtin_amdgcn_global_load_lds((const unsigned*)((const char*)(gbase) + (voff)[_i]), (PG8_LAS unsigned*)(lds + (bufoff) + ldsw + _i * 8192), 16, 0, 0); } while (0)
#define PG8_LDA(dst, b, h) do { if constexpr (FP8) { _Pragma("unroll") for (int m = 0; m < 4; ++m) { const u32x4 l_ = *(const PG8_LAS u32x4*)(lds + PG8_SA(b, h) + aoffF0 + m * 2048), h_ = *(const PG8_LAS u32x4*)(lds + PG8_SA(b, h) + aoffF0 + m * 2048 + 16); \
            dst##8[m] = (v8i_t){(int)l_.x, (int)l_.y, (int)l_.z, (int)l_.w, (int)h_.x, (int)h_.y, (int)h_.z, (int)h_.w}; } } \
        else { _Pragma("unroll") for (int m = 0; m < 4; ++m) _Pragma("unroll") for (int k = 0; k < 2; ++k) dst[m][k] = *(const PG8_LAS bf16x8*)(lds + PG8_SA(b, h) + aoff + m * 2048 + k * 1024); } } while (0)
#define PG8_LDB(dst, b, h) do { if constexpr (FP8) { _Pragma("unroll") for (int n = 0; n < 2; ++n) { const u32x4 l_ = *(const PG8_LAS u32x4*)(lds + PG8_SB(b, h) + boffF0 + n * 2048), h_ = *(const PG8_LAS u32x4*)(lds + PG8_SB(b, h) + boffF0 + n * 2048 + 16); \
            dst##8[n] = (v8i_t){(int)l_.x, (int)l_.y, (int)l_.z, (int)l_.w, (int)h_.x, (int)h_.y, (int)h_.z, (int)h_.w}; } } \
        else { _Pragma("unroll") for (int n = 0; n < 2; ++n) _Pragma("unroll") for (int k = 0; k < 2; ++k) dst[n][k] = *(const PG8_LAS bf16x8*)(lds + PG8_SB(b, h) + boff + n * 2048 + k * 1024); } } while (0)
#define PG8_MMA(ai, bj, At, Bt) do { __builtin_amdgcn_s_setprio(1); \
        if constexpr (FP8) { _Pragma("unroll") for (int m = 0; m < 4; ++m) _Pragma("unroll") for (int n = 0; n < 2; ++n) \
            asm volatile("v_mfma_scale_f32_16x16x128_f8f6f4 %0, %1, %2, %0, %3, %3 op_sel_hi:[0,0,0]" : "+v"(acc[ai][bj][m][n]) : "v"(Bt##8[n]), "v"(At##8[m]), "v"(mxone)); } \
        else { _Pragma("unroll") for (int m = 0; m < 4; ++m) _Pragma("unroll") for (int n = 0; n < 2; ++n) _Pragma("unroll") for (int k = 0; k < 2; ++k) \
            acc[ai][bj][m][n] = __builtin_amdgcn_mfma_f32_16x16x32_bf16(Bt[n][k], At[m][k], acc[ai][bj][m][n], 0, 0, 0); } \
        __builtin_amdgcn_s_setprio(0); } while (0)
#define PG8_WAIT_V(n) asm volatile("s_waitcnt vmcnt(" #n ")" ::: "memory")
#define PG8_WAIT_L(n) asm volatile("s_waitcnt lgkmcnt(" #n ")" ::: "memory")
#define PG8_BAR __builtin_amdgcn_s_barrier()
#define PG8_SCHED __builtin_amdgcn_sched_barrier(0)
    Unit cur, nxt; int ui = 0;
    if (!S.next(0, cur)) return;
    f32x4 acc[2][2][4][2];
#pragma unroll
    for (int a = 0; a < 2; ++a)
#pragma unroll
        for (int b = 0; b < 2; ++b)
#pragma unroll
            for (int m = 0; m < 4; ++m)
#pragma unroll
                for (int n = 0; n < 2; ++n) acc[a][b][m][n] = (f32x4){0.f, 0.f, 0.f, 0.f};
    bf16x8 At[4][2], B0[2][2], B1[2][2]; v8i_t At8[4], B08[2], B18[2];
    int mxone = 0x7F7F7F7F; asm volatile("" : "+v"(mxone));
    const char* cA = (const char*)g.A + (size_t)cur.pm * tstep; const char* cB = (const char*)g.Bt + (size_t)cur.pn * tstep;
    S.a_ready(cur);
    if constexpr (SP2) {
        PG8_STAGE(PG8_SB(0, 0), cB, voffB); PG8_STAGE(PG8_SB(0, 1), cB + hstep, voffB); PG8_STAGE(PG8_SA(0, 0), cA, voffA); PG8_STAGE(PG8_SA(0, 1), cA + hstep, voffA);
        if (wr == 1) PG8_BAR;
        PG8_WAIT_V(2); PG8_BAR;
        PG8_STAGE(PG8_SB(1, 0), cB + kstep, voffB); PG8_STAGE(PG8_SA(1, 0), cA + kstep, voffA); PG8_STAGE(PG8_SB(1, 1), cB + hstep + kstep, voffB);
        PG8_WAIT_V(6); PG8_BAR;
    } else {
        PG8_STAGE(PG8_SB(0, 0), cB, voffB); PG8_STAGE(PG8_SA(0, 0), cA, voffA); PG8_STAGE(PG8_SB(0, 1), cB + hstep, voffB); PG8_STAGE(PG8_SA(0, 1), cA + hstep, voffA);
        if (wr == 1) PG8_BAR;
        PG8_WAIT_V(4); PG8_BAR;
        PG8_STAGE(PG8_SB(1, 0), cB + kstep, voffB); PG8_STAGE(PG8_SA(1, 0), cA + kstep, voffA); PG8_STAGE(PG8_SB(1, 1), cB + hstep + kstep, voffB);
        PG8_WAIT_V(6); PG8_BAR;
    }
    for (;;) {
        const bool has_next = S.next(ui + 1, nxt);
        const char* nA = has_next ? (const char*)g.A + (size_t)nxt.pm * tstep : cA; const char* nB = has_next ? (const char*)g.Bt + (size_t)nxt.pn * tstep : cB;
#pragma unroll 1
        for (int t = 0; t < nt; t += 2) {
            if constexpr (Epi::MID) { if (t == nt / 2) E.mid(acc, cur, wr, wc, fr, fq); }
            const bool last = (t == nt - 2);
            const char* a1 = cA + (size_t)(t + 1) * kstep;
            const char* a2 = last ? nA : cA + (size_t)(t + 2) * kstep; const char* b2 = last ? nB : cB + (size_t)(t + 2) * kstep;
            const char* a3 = a2 + kstep; const char* b3 = b2 + kstep;
            if (last && has_next) S.a_ready(nxt);
            if constexpr (SP2) {
            PG8_LDB(B0, 0, 0); PG8_LDB(B1, 0, 1); PG8_SCHED; PG8_LDA(At, 0, 0); PG8_STAGE(PG8_SA(1, 1), a1 + hstep, voffA);
            PG8_WAIT_V(8); PG8_WAIT_L(0); PG8_BAR; PG8_MMA(0, 0, At, B0); PG8_MMA(0, 1, At, B1); PG8_BAR; PG8_SCHED;
            PG8_LDA(At, 0, 1); PG8_STAGE(PG8_SB(0, 0), b2, voffB); PG8_STAGE(PG8_SB(0, 1), b2 + hstep, voffB); PG8_STAGE(PG8_SA(0, 0), a2, voffA);
            PG8_WAIT_V(8); PG8_WAIT_L(0); PG8_BAR; PG8_MMA(1, 0, At, B0); PG8_MMA(1, 1, At, B1); PG8_BAR; PG8_SCHED;
            PG8_LDB(B0, 1, 0); PG8_LDB(B1, 1, 1); PG8_SCHED; PG8_LDA(At, 1, 0); PG8_STAGE(PG8_SA(0, 1), a2 + hstep, voffA);
            PG8_WAIT_V(8); PG8_WAIT_L(0); PG8_BAR; PG8_MMA(0, 0, At, B0); PG8_MMA(0, 1, At, B1); PG8_BAR; PG8_SCHED;
            PG8_LDA(At, 1, 1); PG8_STAGE(PG8_SB(1, 0), b3, voffB); PG8_STAGE(PG8_SB(1, 1), b3 + hstep, voffB); PG8_STAGE(PG8_SA(1, 0), a3, voffA);
            PG8_WAIT_V(8); PG8_WAIT_L(0); PG8_BAR; PG8_MMA(1, 0, At, B0); PG8_MMA(1, 1, At, B1); PG8_BAR; PG8_SCHED;
            } else {
            PG8_LDB(B0, 0, 0); PG8_SCHED; PG8_LDA(At, 0, 0); PG8_STAGE(PG8_SA(1, 1), a1 + hstep, voffA);
            PG8_WAIT_L(8); PG8_BAR; PG8_WAIT_L(0); PG8_MMA(0, 0, At, B0); PG8_BAR; PG8_SCHED;
            PG8_LDB(B1, 0, 1); PG8_STAGE(PG8_SB(0, 0), b2, voffB);
            PG8_BAR; PG8_WAIT_L(0); PG8_MMA(0, 1, At, B1); PG8_BAR;
            PG8_LDA(At, 0, 1); PG8_STAGE(PG8_SA(0, 0), a2, voffA);
            PG8_BAR; PG8_WAIT_L(0); PG8_MMA(1, 0, At, B0); PG8_BAR; PG8_SCHED;
            PG8_STAGE(PG8_SB(0, 1), b2 + hstep, voffB);
            PG8_WAIT_V(6); PG8_BAR; PG8_MMA(1, 1, At, B1); PG8_BAR;
            PG8_LDB(B0, 1, 0); PG8_SCHED; PG8_LDA(At, 1, 0); PG8_STAGE(PG8_SA(0, 1), a2 + hstep, voffA);
            PG8_WAIT_L(8); PG8_BAR; PG8_WAIT_L(0); PG8_MMA(0, 0, At, B0); PG8_BAR; PG8_SCHED;
            PG8_LDB(B1, 1, 1); PG8_STAGE(PG8_SB(1, 0), b3, voffB);
            PG8_BAR; PG8_WAIT_L(0); PG8_MMA(0, 1, At, B1); PG8_BAR;
            PG8_LDA(At, 1, 1); PG8_STAGE(PG8_SA(1, 0), a3, voffA);
            PG8_BAR; PG8_WAIT_L(0); PG8_MMA(1, 0, At, B0); PG8_BAR; PG8_SCHED;
            PG8_STAGE(PG8_SB(1, 1), b3 + hstep, voffB);
            PG8_WAIT_V(6); PG8_BAR; PG8_MMA(1, 1, At, B1); PG8_BAR;
            }
        }
        if constexpr (ALIGN_EPI) { if (wr == 0) PG8_BAR; }
        if constexpr (FP8) { asm volatile("s_nop 15\n\ts_nop 7" ::: "memory"); PG8_SCHED; }
        if constexpr (!Epi::AFTER_DRAIN) { E(acc, cur, wr, wc, fr, fq); S.done(cur); }
        if (!has_next) break;
#pragma unroll
        for (int a = 0; a < 2; ++a)
#pragma unroll
            for (int b = 0; b < 2; ++b)
#pragma unroll
                for (int m = 0; m < 4; ++m)
#pragma unroll
                    for (int n = 0; n < 2; ++n) acc[a][b][m][n] = (f32x4){0.f, 0.f, 0.f, 0.f};
        cur = nxt; cA = nA; cB = nB; ++ui;
        if constexpr (ALIGN_EPI) { if (wr == 1) PG8_BAR; }
    }
    PG8_WAIT_V(0);
    if constexpr (!ALIGN_EPI) { if (wr == 0) PG8_BAR; }
    PG8_BAR;
    if constexpr (Epi::AFTER_DRAIN) { E.fused(acc, cur, wr, wc, fr, fq, lds, wid, lane); S.done(cur); }
#undef PG8_SA
#undef PG8_SB
#undef PG8_STAGE
#undef PG8_LDA
#undef PG8_LDB
#undef PG8_MMA
#undef PG8_WAIT_V
#undef PG8_WAIT_L
#undef PG8_BAR
#undef PG8_SCHED
}
}

__device__ __forceinline__ float lambda_full(const Ptrs& P) {
    float a = 0.f, b = 0.f;
    for (int i = 0; i < 64; ++i) { a += P.lq1[i] * P.lk1[i]; b += P.lq2[i] * P.lk2[i]; }
    return __expf(a) - __expf(b) + 0.2f;
}

namespace att {
typedef short bf16x8 __attribute__((ext_vector_type(8)));
typedef short s16x4 __attribute__((ext_vector_type(4)));
typedef float f32x16 __attribute__((ext_vector_type(16)));
typedef float f32x2_t __attribute__((ext_vector_type(2)));
typedef __attribute__((address_space(3))) const char* lds_cptr;
typedef __attribute__((address_space(3))) char* lds_ptr;
__device__ __forceinline__ int crow(int r, int hi) { return (r & 3) + 8 * (r >> 2) + 4 * hi; }
__device__ __forceinline__ void glds16(const void* gsrc, unsigned lds_dst) { unsigned keep;
    asm volatile("s_mov_b32 %0, m0\n\ts_mov_b32 m0, %2\n\ts_nop 0\n\tglobal_load_lds_dwordx4 %1, off\n\ts_mov_b32 m0, %0" : "=&s"(keep) : "v"(gsrc), "s"(lds_dst) : "memory"); }
__device__ __forceinline__ unsigned cvtpk(float lo, float hi) { f32x2_t v = {lo, hi}; bf16x2_t b = __builtin_convertvector(v, bf16x2_t); return __builtin_bit_cast(unsigned, b); }
#define ATT_WAIT_BAR(N) asm volatile("s_waitcnt vmcnt(" #N ") lgkmcnt(0)\n\ts_barrier" ::: "memory")
#define ATT_LDSWAIT() asm volatile("s_waitcnt lgkmcnt(0)" ::: "memory")
#define ATT_SBAR() __builtin_amdgcn_sched_barrier(0)
template <bool REL> __device__ __forceinline__ void qkt(f32x16& p0, f32x16& p1, lds_cptr Kslot, const bf16x8* qr, const f32x16& negm, int r32, int hi) {
    lds_cptr kb = Kslot + hi * 1024 + r32 * 16;
#pragma unroll
    for (int d0 = 0; d0 < 4; ++d0) {
        const bf16x8 b0 = *(const __attribute__((address_space(3))) bf16x8*)(kb + d0 * 2048);
        const bf16x8 b1 = *(const __attribute__((address_space(3))) bf16x8*)(kb + d0 * 2048 + 512);
        if (d0 == 0) { if (REL) { p0 = __builtin_amdgcn_mfma_f32_32x32x16_bf16(b0, qr[0], negm, 0, 0, 0); p1 = __builtin_amdgcn_mfma_f32_32x32x16_bf16(b1, qr[0], negm, 0, 0, 0); }
                       else { p0 = __builtin_amdgcn_mfma_f32_32x32x16_bf16(b0, qr[0], f32x16{}, 0, 0, 0); p1 = __builtin_amdgcn_mfma_f32_32x32x16_bf16(b1, qr[0], f32x16{}, 0, 0, 0); } }
        else { p0 = __builtin_amdgcn_mfma_f32_32x32x16_bf16(b0, qr[d0], p0, 0, 0, 0); p1 = __builtin_amdgcn_mfma_f32_32x32x16_bf16(b1, qr[d0], p1, 0, 0, 0); } }
}
__device__ __forceinline__ float rowmax32(const f32x16& p0, const f32x16& p1) {
    float a = fmaxf(p0[0], p1[0]);
#pragma unroll
    for (int r = 1; r < 16; ++r) a = fmaxf(a, fmaxf(p0[r], p1[r]));
    auto rr = __builtin_amdgcn_permlane32_swap(__float_as_uint(a), __float_as_uint(a), false, false);
    return fmaxf(__uint_as_float(rr[0]), __uint_as_float(rr[1]));
}
__device__ __forceinline__ float halfsum(float a) { auto rr = __builtin_amdgcn_permlane32_swap(__float_as_uint(a), __float_as_uint(a), false, false); return __uint_as_float(rr[0]) + __uint_as_float(rr[1]); }
#define ATT_VREAD(lo, hi, d0) do { _Pragma("unroll") for (int ks = 0; ks < 4; ++ks) { \
        asm volatile("ds_read_b64_tr_b16 %0,%1 offset:%c2" : "=&v"(lo[ks]) : "v"(vb), "i"((d0) * 4096 + ks * 1024) : "memory"); \
        asm volatile("ds_read_b64_tr_b16 %0,%1 offset:%c2" : "=&v"(hi[ks]) : "v"(vb), "i"((d0) * 4096 + ks * 1024 + 512) : "memory"); } } while (0)
#define ATT_PK(lo, hi, k) (bf16x8){lo[k][0], lo[k][1], lo[k][2], lo[k][3], hi[k][0], hi[k][1], hi[k][2], hi[k][3]}
#define ATT_PVMMA(lo, hi, d0) do { \
        o[d0] = __builtin_amdgcn_mfma_f32_32x32x16_bf16(pa0, ATT_PK(lo, hi, 0), o[d0], 0, 0, 0); o[d0] = __builtin_amdgcn_mfma_f32_32x32x16_bf16(pa1, ATT_PK(lo, hi, 1), o[d0], 0, 0, 0); \
        o[d0] = __builtin_amdgcn_mfma_f32_32x32x16_bf16(pa2, ATT_PK(lo, hi, 2), o[d0], 0, 0, 0); o[d0] = __builtin_amdgcn_mfma_f32_32x32x16_bf16(pa3, ATT_PK(lo, hi, 3), o[d0], 0, 0, 0); } while (0)
template <int ND0> __device__ __forceinline__ void pv(f32x16* o, int vb, bf16x8 pa0, bf16x8 pa1, bf16x8 pa2, bf16x8 pa3) {
    s16x4 loA[4], hiA[4], loB[4], hiB[4];
    ATT_VREAD(loA, hiA, 0);
#pragma unroll
    for (int d0 = 0; d0 < ND0; d0 += 2) {
        if (d0 + 1 < ND0) { ATT_VREAD(loB, hiB, d0 + 1); asm volatile("s_waitcnt lgkmcnt(8)" ::: "memory"); } else { asm volatile("s_waitcnt lgkmcnt(0)" ::: "memory"); }
        ATT_SBAR();
        ATT_PVMMA(loA, hiA, d0);
        if (d0 + 1 < ND0) {
            if (d0 + 2 < ND0) { ATT_VREAD(loA, hiA, d0 + 2); asm volatile("s_waitcnt lgkmcnt(8)" ::: "memory"); } else { asm volatile("s_waitcnt lgkmcnt(0)" ::: "memory"); }
            ATT_SBAR();
            ATT_PVMMA(loB, hiB, d0 + 1);
        }
    }
}
#undef ATT_VREAD
#undef ATT_PVMMA
#undef ATT_PK
template <int DEAD> __device__ __forceinline__ constexpr bool live0(int r) { return DEAD != 2 || r >= 12; }
template <int DEAD> __device__ __forceinline__ constexpr bool live1(int r) { return DEAD != 1 || r < 4; }
template <int ND0, int THR, bool REL, int DEAD = 0> __device__ __forceinline__ void softmax_tile(f32x16& p0, f32x16& p1, float& mrun, float& lsum, f32x16& negm, bool first, f32x16* o, __attribute__((address_space(3))) float* wsf, int r32, int hi,
                                                                   u32x4& pw0, u32x4& pw1, u32x4& pw2, u32x4& pw3) {
    float rm;
    if (DEAD == 0) rm = rowmax32(p0, p1);
    else { float a = -3e38f;
#pragma unroll
        for (int r = 0; r < 16; ++r) { if (live0<DEAD>(r)) a = fmaxf(a, p0[r]); if (live1<DEAD>(r)) a = fmaxf(a, p1[r]); }
        auto rr = __builtin_amdgcn_permlane32_swap(__float_as_uint(a), __float_as_uint(a), false, false); rm = fmaxf(__uint_as_float(rr[0]), __uint_as_float(rr[1])); }
    if (!REL) rm -= mrun;
    if (first) {
        mrun = REL ? rm : mrun + rm;
        if (REL) {
#pragma unroll
            for (int r = 0; r < 16; ++r) { if (live0<DEAD>(r)) p0[r] -= rm; if (live1<DEAD>(r)) p1[r] -= rm; negm[r] = -mrun; } }
    } else if (__any(rm > (float)THR)) {
        const float dl = fmaxf(rm, 0.f), alpha = __builtin_amdgcn_exp2f(-dl); lsum *= alpha; mrun += dl;
        if (REL) {
#pragma unroll
            for (int r = 0; r < 16; ++r) { if (live0<DEAD>(r)) p0[r] -= dl; if (live1<DEAD>(r)) p1[r] -= dl; negm[r] = -mrun; } }
        if (hi == 0) wsf[r32] = alpha;
        ATT_LDSWAIT();
#pragma unroll
        for (int g = 0; g < 4; ++g) { const f32x4 a4 = *(const __attribute__((address_space(3))) f32x4*)(wsf + 8 * g + 4 * hi);
#pragma unroll
            for (int d0 = 0; d0 < ND0; ++d0) { o[d0][4 * g + 0] *= a4[0]; o[d0][4 * g + 1] *= a4[1]; o[d0][4 * g + 2] *= a4[2]; o[d0][4 * g + 3] *= a4[3]; } }
        ATT_LDSWAIT();
    }
    float s = 0.f;
#pragma unroll
    for (int r = 0; r < 16; ++r) {
        if (live0<DEAD>(r)) { p0[r] = __builtin_amdgcn_exp2f(REL ? p0[r] : p0[r] - mrun); s += p0[r]; } else p0[r] = 0.f;
        if (live1<DEAD>(r)) { p1[r] = __builtin_amdgcn_exp2f(REL ? p1[r] : p1[r] - mrun); s += p1[r]; } else p1[r] = 0.f; }
    lsum += s;
    pw0 = (u32x4){cvtpk(p0[0], p0[1]), cvtpk(p0[2], p0[3]), cvtpk(p0[4], p0[5]), cvtpk(p0[6], p0[7])};
    pw1 = (u32x4){cvtpk(p0[8], p0[9]), cvtpk(p0[10], p0[11]), cvtpk(p0[12], p0[13]), cvtpk(p0[14], p0[15])};
    pw2 = (u32x4){cvtpk(p1[0], p1[1]), cvtpk(p1[2], p1[3]), cvtpk(p1[4], p1[5]), cvtpk(p1[6], p1[7])};
    pw3 = (u32x4){cvtpk(p1[8], p1[9]), cvtpk(p1[10], p1[11]), cvtpk(p1[12], p1[13]), cvtpk(p1[14], p1[15])};
}

constexpr int A_SLOTK = 8192, A_SLOTV = 16384, A_NS = 3, A_NSV = 4;
constexpr int A_LDS_K = 0, A_LDS_V = A_NS * A_SLOTK, A_LDS_WS = A_LDS_V + A_NSV * A_SLOTV, A_LDS_ST = A_LDS_WS + 8 * 256, A_LDS_BYTES = A_LDS_ST + 8 * 8192;
__device__ __forceinline__ void attn_a_unit(int b, int h, int qb, const bf16_t* proj, bf16_t* ya, const float* subln, float lam, unsigned char* shm) {
    int tid_l = threadIdx.x; asm volatile("" : "+v"(tid_l));
    const int tid = tid_l, lane = tid & 63, r32 = lane & 31, hi = lane >> 5; const int wid = __builtin_amdgcn_readfirstlane(tid >> 6);
    const size_t rowbase = (size_t)b * SEQ; const int q0 = qb * 256;
    constexpr int NT = SEQ / 64;
    const unsigned lds0 = (unsigned)(uintptr_t)shm;
    const lds_cptr shm3 = (lds_cptr)shm;
    __attribute__((address_space(3))) float* wsf = (__attribute__((address_space(3))) float*)((lds_ptr)shm + A_LDS_WS) + wid * 64;
    const int vb0 = (int)(lds0 + A_LDS_V) + ((lane >> 4) & 1) * 32 + (lane & 3) * 8 + (4 * hi + ((lane & 15) >> 2)) * 64;
    __attribute__((address_space(3))) bf16_t* stg = (__attribute__((address_space(3))) bf16_t*)((lds_ptr)shm + A_LDS_ST) + wid * 4096;
    for (int mp = 0; mp < 2; ++mp) {
        const bf16_t* Kh = proj + rowbase * INW + C_KA + h * 128 + mp * 64;
        const bf16_t* Vh = proj + rowbase * INW + C_VA + h * 128;
        const bf16_t* Qw = proj + (rowbase + q0 + wid * 32) * INW + C_QA + h * 128 + mp * 64;
        const int pA = 2 * wid, pB = 2 * wid + 1;
        const unsigned kdst = lds0 + A_LDS_K + wid * 1024, vdstA = lds0 + A_LDS_V + pA * 1024, vdstB = lds0 + A_LDS_V + pB * 1024;
#define A_DMA(t, slot, vsl) do { int ln_ = lane; asm volatile("" : "+v"(ln_)); \
        const bf16_t* ksrc_ = Kh + (size_t)((t) * 64 + ln_) * INW + wid * 8; \
        const bf16_t* vsrcA_ = Vh + (size_t)((t) * 64 + 16 * (pA & 3) + (ln_ >> 2)) * INW + (pA >> 2) * 32 + (ln_ & 3) * 8; \
        const bf16_t* vsrcB_ = Vh + (size_t)((t) * 64 + 16 * (pB & 3) + (ln_ >> 2)) * INW + (pB >> 2) * 32 + (ln_ & 3) * 8; \
        glds16(ksrc_, (unsigned)__builtin_amdgcn_readfirstlane(kdst + (slot) * A_SLOTK)); \
        glds16(vsrcA_, (unsigned)__builtin_amdgcn_readfirstlane(vdstA + (vsl) * A_SLOTV)); \
        glds16(vsrcB_, (unsigned)__builtin_amdgcn_readfirstlane(vdstB + (vsl) * A_SLOTV)); } while (0)
        A_DMA(0, 0, 0); A_DMA(1, 1, 1);
        bf16x8 qr[4];
#pragma unroll
        for (int d0 = 0; d0 < 4; ++d0) qr[d0] = *(const bf16x8*)(Qw + (size_t)r32 * INW + d0 * 16 + hi * 8);
        f32x16 o[4]; o[0] = f32x16{}; o[1] = f32x16{}; o[2] = f32x16{}; o[3] = f32x16{};
        float mrun = 0.f, lsum = 0.f; f32x16 negm = f32x16{};
        int slot = 0, slot2 = 2, vslot = 0, vslot2 = 2, vprev = 3;
        const bool late = wid >= 4;
        u32x4 pw0 = {}, pw1 = {}, pw2 = {}, pw3 = {};
        for (int t = 0; t < NT; ++t) {
            if (t + 1 < NT) { ATT_WAIT_BAR(3); } else { ATT_WAIT_BAR(0); }
            if (t + 2 < NT) A_DMA(t + 2, slot2, vslot2);
            if (late && t > 0) pv<4>(o, vb0 + vprev * A_SLOTV, __builtin_bit_cast(bf16x8, pw0), __builtin_bit_cast(bf16x8, pw1), __builtin_bit_cast(bf16x8, pw2), __builtin_bit_cast(bf16x8, pw3));
            f32x16 p0, p1;
            qkt<false>(p0, p1, shm3 + A_LDS_K + slot * A_SLOTK, qr, negm, r32, hi);
            softmax_tile<4, 8, false>(p0, p1, mrun, lsum, negm, t == 0, o, wsf, r32, hi, pw0, pw1, pw2, pw3);
            if (!late) pv<4>(o, vb0 + vslot * A_SLOTV, __builtin_bit_cast(bf16x8, pw0), __builtin_bit_cast(bf16x8, pw1), __builtin_bit_cast(bf16x8, pw2), __builtin_bit_cast(bf16x8, pw3));
            slot = (slot == 2) ? 0 : slot + 1; slot2 = (slot2 == 2) ? 0 : slot2 + 1;
            vprev = vslot; vslot = (vslot + 1) & 3; vslot2 = (vslot2 + 1) & 3;
        }
        if (late) pv<4>(o, vb0 + vprev * A_SLOTV, __builtin_bit_cast(bf16x8, pw0), __builtin_bit_cast(bf16x8, pw1), __builtin_bit_cast(bf16x8, pw2), __builtin_bit_cast(bf16x8, pw3));
#undef A_DMA
        const float lt = halfsum(lsum);
        if (hi == 0) wsf[32 + r32] = lt;
        ATT_LDSWAIT();
        float rli[16];
#pragma unroll
        for (int g = 0; g < 4; ++g) { const f32x4 l4 = *(const __attribute__((address_space(3))) f32x4*)(wsf + 32 + 8 * g + 4 * hi);
            rli[4 * g + 0] = __builtin_amdgcn_rcpf(l4[0]); rli[4 * g + 1] = __builtin_amdgcn_rcpf(l4[1]); rli[4 * g + 2] = __builtin_amdgcn_rcpf(l4[2]); rli[4 * g + 3] = __builtin_amdgcn_rcpf(l4[3]); }
        ATT_LDSWAIT();
        if (mp == 0) {
#pragma unroll
            for (int d0 = 0; d0 < 4; ++d0)
#pragma unroll
                for (int r = 0; r < 16; ++r) stg[crow(r, hi) * 128 + d0 * 32 + r32] = (bf16_t)f2bf(o[d0][r] * rli[r]);
            asm volatile("s_waitcnt lgkmcnt(0)\n\ts_barrier" ::: "memory");
        } else {
            float ss[16];
#pragma unroll
            for (int r = 0; r < 16; ++r) ss[r] = 0.f;
#pragma unroll
            for (int d0 = 0; d0 < 4; ++d0)
#pragma unroll
                for (int r = 0; r < 16; ++r) { const float a = bf2f(stg[crow(r, hi) * 128 + d0 * 32 + r32]); const float y = a - lam * o[d0][r] * rli[r]; o[d0][r] = y; ss[r] += y * y; }
#pragma unroll
            for (int r = 0; r < 16; ++r) { float v = ss[r]; v += __shfl_xor(v, 1); v += __shfl_xor(v, 2); v += __shfl_xor(v, 4); v += __shfl_xor(v, 8); v += __shfl_xor(v, 16);
                ss[r] = 0.8f / sqrtf(v * (1.f / 128.f) + EPS); }
            ATT_LDSWAIT();
#pragma unroll
            for (int d0 = 0; d0 < 4; ++d0) { const float gsub = subln[d0 * 32 + r32];
#pragma unroll
                for (int r = 0; r < 16; ++r) stg[crow(r, hi) * 128 + d0 * 32 + r32] = (bf16_t)f2bf(o[d0][r] * ss[r] * gsub); }
            ATT_LDSWAIT();
            bf16_t* Yw = ya + (rowbase + q0 + wid * 32) * 1024 + h * 128;
#pragma unroll
            for (int i = 0; i < 8; ++i) { const int row = i * 4 + (lane >> 4), ch = lane & 15; const u32x4 v = *(const __attribute__((address_space(3))) u32x4*)(stg + row * 128 + ch * 8); *(u32x4*)(Yw + (size_t)row * 1024 + ch * 8) = v; }
            asm volatile("s_waitcnt lgkmcnt(0)\n\ts_barrier" ::: "memory");
        }
    }
}

template <int DEAD> __device__ __forceinline__ void na_tile(lds_cptr Kslot, int vb, const bf16x8* qr, const __attribute__((address_space(3))) float* bp, const float (&fm0)[16], const float (&fm1)[16],
                                                        float& mrun, float& lsum, f32x16& negm, bool first, f32x16* o, __attribute__((address_space(3))) float* wsf, int r32, int hi) {
    f32x16 p0, p1; u32x4 pw0, pw1, pw2, pw3;
    qkt<true>(p0, p1, Kslot, qr, negm, r32, hi);
#pragma unroll
    for (int rr = 0; rr < 16; ++rr) { const int jj = (rr & 3) + 8 * (rr >> 2);
        if (live0<DEAD>(rr)) p0[rr] += bp[jj] + fm0[rr];
        if (live1<DEAD>(rr)) p1[rr] += bp[jj + 32] + fm1[rr]; }
    softmax_tile<2, 8, true, DEAD>(p0, p1, mrun, lsum, negm, first, o, wsf, r32, hi, pw0, pw1, pw2, pw3);
    pv<2>(o, vb, __builtin_bit_cast(bf16x8, pw0), __builtin_bit_cast(bf16x8, pw1), __builtin_bit_cast(bf16x8, pw2), __builtin_bit_cast(bf16x8, pw3));
}
constexpr int B_SLOT = 8192, B_NS = 6, B_PF = 5;
constexpr int B_LDS_K = 0, B_LDS_V = B_NS * B_SLOT, B_LDS_WS = 2 * B_NS * B_SLOT, B_LDS_BIAS = B_LDS_WS + 8 * 256, B_LDS_ST = B_LDS_BIAS + 2560, B_LDS_BYTES = B_LDS_ST + 8 * 4096;
__device__ __forceinline__ void attn_b_unit(int b, int h, int rg, const bf16_t* proj, bf16_t* yb, const float* rpb, unsigned char* shm) {
    int tid_l = threadIdx.x; asm volatile("" : "+v"(tid_l));
    const int tid = tid_l, lane = tid & 63, r32 = lane & 31, hi = lane >> 5; const int wid = __builtin_amdgcn_readfirstlane(tid >> 6);
    const size_t rowbase = (size_t)b * SEQ;
    const int r = 4 * rg + (wid >> 1), c0 = 32 * (wid & 1);
    int rs = r - 4; rs = rs < 0 ? 0 : (rs > 24 ? 24 : rs);
    int rmin = 4 * rg - 4; rmin = rmin < 0 ? 0 : (rmin > 24 ? 24 : rmin);
    int rmaxs = 4 * rg + 3 - 4; rmaxs = rmaxs < 0 ? 0 : (rmaxs > 24 ? 24 : rmaxs);
    const int ntile = rmaxs + 8 - rmin;
    const unsigned lds0 = (unsigned)(uintptr_t)shm;
    const lds_cptr shm3 = (lds_cptr)shm;
    __attribute__((address_space(3))) float* wsf = (__attribute__((address_space(3))) float*)((lds_ptr)shm + B_LDS_WS) + wid * 64;
    __attribute__((address_space(3))) float* bias = (__attribute__((address_space(3))) float*)((lds_ptr)shm + B_LDS_BIAS) + 64;
    __attribute__((address_space(3))) bf16_t* stg = (__attribute__((address_space(3))) bf16_t*)((lds_ptr)shm + B_LDS_ST) + wid * 2048;
    const int vb0 = (int)(lds0 + B_LDS_V) + ((lane >> 4) & 1) * 32 + (lane & 3) * 8 + (4 * hi + ((lane & 15) >> 2)) * 64;
    for (int i = tid; i < 640; i += 512) { const int e = i - 64, ri = e >> 5, cj = e & 31; bias[e] = (e >= 0 && e < 480 && cj < 31) ? rpb[(h * 15 + ri) * 31 + cj] * LOG2E : 0.f; }
    const bf16_t* Kh = proj + rowbase * INW + C_KB + h * 64;
    const bf16_t* Vh = proj + rowbase * INW + C_VB + h * 64;
    const bf16_t* Qw = proj + (rowbase + r * 64 + c0) * INW + C_QB + h * 64;
    const unsigned kdst = lds0 + B_LDS_K + wid * 1024, vdst = lds0 + B_LDS_V + wid * 1024;
#define B_DMA(t, slot) do { int ln_ = lane; asm volatile("" : "+v"(ln_)); \
    const bf16_t* ksrc_ = Kh + (size_t)((rmin + (t)) * 64 + ln_) * INW + wid * 8; \
    const bf16_t* vsrc_ = Vh + (size_t)((rmin + (t)) * 64 + 16 * (wid & 3) + (ln_ >> 2)) * INW + (wid >> 2) * 32 + (ln_ & 3) * 8; \
    glds16(ksrc_, (unsigned)__builtin_amdgcn_readfirstlane(kdst + (slot) * B_SLOT)); \
    glds16(vsrc_, (unsigned)__builtin_amdgcn_readfirstlane(vdst + (slot) * B_SLOT)); } while (0)
#pragma unroll
    for (int t = 0; t < 4; ++t) B_DMA(t, t);
    bf16x8 qr[4];
#pragma unroll
    for (int d0 = 0; d0 < 4; ++d0) qr[d0] = *(const bf16x8*)(Qw + (size_t)r32 * INW + d0 * 16 + hi * 8);
    f32x16 o[2]; o[0] = f32x16{}; o[1] = f32x16{};
    float mrun = 0.f, lsum = 0.f; f32x16 negm = f32x16{}; bool first = true;
    const int c = c0 + r32; int cs = c - 8; cs = cs < 0 ? 0 : (cs > 48 ? 48 : cs);
    float fm0[16], fm1[16];
#pragma unroll
    for (int rr = 0; rr < 16; ++rr) { const int j0 = crow(rr, hi); fm0[rr] = ((unsigned)(j0 - cs) < 16u) ? 0.f : -1e30f; fm1[rr] = ((unsigned)(j0 + 32 - cs) < 16u) ? 0.f : -1e30f; }
    int slot = 0, slotn = 4;
#define B_TILE(tt, sl) do { const int kr = rmin + (tt); \
        if (kr >= rs && kr < rs + 8) {        \
            const __attribute__((address_space(3))) float* bp = bias + ((kr - r + 7) * 32 + 15 - c + 4 * hi);        \
            if (wid & 1) na_tile<2>(shm3 + B_LDS_K + (sl) * B_SLOT, vb0 + (sl) * B_SLOT, qr, bp, fm0, fm1, mrun, lsum, negm, first, o, wsf, r32, hi); \
            else         na_tile<1>(shm3 + B_LDS_K + (sl) * B_SLOT, vb0 + (sl) * B_SLOT, qr, bp, fm0, fm1, mrun, lsum, negm, first, o, wsf, r32, hi); \
            first = false; } } while (0)
    for (int t = 0; t < ntile; t += 2) {
        { const int rem = ntile - (t + 2);
          if (rem >= 2) { ATT_WAIT_BAR(4); } else if (rem == 1) { ATT_WAIT_BAR(2); } else { ATT_WAIT_BAR(0); } }
        const int slot1 = (slot == B_NS - 1) ? 0 : slot + 1, slotn1 = (slotn == B_NS - 1) ? 0 : slotn + 1;
        if (t + 4 < ntile) B_DMA(t + 4, slotn);
        if (t + 5 < ntile) B_DMA(t + 5, slotn1);
#pragma unroll 1
        for (int k2 = 0; k2 < 2; ++k2) { const int sl = k2 ? slot1 : slot; if (t + k2 < ntile) B_TILE(t + k2, sl); }
        slot = (slot1 == B_NS - 1) ? 0 : slot1 + 1; slotn = (slotn1 == B_NS - 1) ? 0 : slotn1 + 1;
    }
#undef B_TILE
#undef B_DMA
    const float lt = halfsum(lsum);
    if (hi == 0) wsf[32 + r32] = lt;
    ATT_LDSWAIT();
    float rli[16];
#pragma unroll
    for (int g = 0; g < 4; ++g) { const f32x4 l4 = *(const __attribute__((address_space(3))) f32x4*)(wsf + 32 + 8 * g + 4 * hi);
        rli[4 * g + 0] = __builtin_amdgcn_rcpf(l4[0]); rli[4 * g + 1] = __builtin_amdgcn_rcpf(l4[1]); rli[4 * g + 2] = __builtin_amdgcn_rcpf(l4[2]); rli[4 * g + 3] = __builtin_amdgcn_rcpf(l4[3]); }
#pragma unroll
    for (int d0 = 0; d0 < 2; ++d0)
#pragma unroll
        for (int rr = 0; rr < 16; ++rr) stg[crow(rr, hi) * 64 + d0 * 32 + r32] = (bf16_t)f2bf(o[d0][rr] * rli[rr]);
    ATT_LDSWAIT();
    bf16_t* Yw = yb + (rowbase + r * 64 + c0) * 1024 + 512 + h * 64;
#pragma unroll
    for (int i = 0; i < 4; ++i) { const int row = i * 8 + (lane >> 3), ch = lane & 7; const u32x4 v = *(const __attribute__((address_space(3))) u32x4*)(stg + row * 64 + ch * 8); *(u32x4*)(Yw + (size_t)row * 1024 + ch * 8) = v; }
    asm volatile("s_waitcnt lgkmcnt(0)\n\ts_barrier" ::: "memory");
}
}

namespace peer {
typedef short bf16x8 __attribute__((ext_vector_type(8)));
typedef float f32x16 __attribute__((ext_vector_type(16)));
typedef __attribute__((address_space(3))) const char* lds_cptr;
constexpr int T_LDS_SK = 0, T_LDS_BYTES = 65536;
__device__ __forceinline__ int imax(int a, int b) { int r; asm("v_max_f32 %0, %1, %2" : "=v"(r) : "v"(a), "v"(b)); return r; }
__device__ __forceinline__ int imin(int a, int b) { int r; asm("v_min_f32 %0, %1, %2" : "=v"(r) : "v"(a), "v"(b)); return r; }
__device__ __forceinline__ int f2key(float s, int idx) { return (__float_as_int(s) & ~127) | idx; }
__device__ __forceinline__ int key2bits(int k) { return k; }
template <int N, int OFF, int TOT> __device__ __forceinline__ void bsort_desc(int (&a)[TOT]) {
#pragma unroll
    for (int k = 2; k <= N; k <<= 1)
#pragma unroll
        for (int j = k >> 1; j > 0; j >>= 1)
#pragma unroll
            for (int i = 0; i < N; ++i) { const int l = i ^ j; if (l > i) { const bool desc = (i & k) == 0; const int hi_ = imax(a[OFF + i], a[OFF + l]), lo_ = imin(a[OFF + i], a[OFF + l]); a[OFF + i] = desc ? hi_ : lo_; a[OFF + l] = desc ? lo_ : hi_; } }
}
__device__ constexpr unsigned char NET16[126] = {0,1,2,3,0,2,1,3,1,2,4,5,6,7,4,6,5,7,5,6,0,4,2,6,2,4,1,5,3,7,3,5,1,2,3,4,5,6,8,9,10,11,8,10,9,11,9,10,12,13,14,15,12,14,13,15,13,14,8,12,10,14,10,12,9,13,11,15,11,13,9,10,11,12,13,14,0,8,4,12,4,8,2,10,6,14,6,10,2,4,6,8,10,12,1,9,5,13,5,9,3,11,7,15,7,11,3,5,7,9,11,13,1,2,3,4,5,6,7,8,9,10,11,12,13,14};
__device__ constexpr unsigned char NET32[382] = {0,1,2,3,0,2,1,3,1,2,4,5,6,7,4,6,5,7,5,6,0,4,2,6,2,4,1,5,3,7,3,5,1,2,3,4,5,6,8,9,10,11,8,10,9,11,9,10,12,13,14,15,12,14,13,15,13,14,8,12,10,14,10,12,9,13,11,15,11,13,9,10,11,12,13,14,0,8,4,12,4,8,2,10,6,14,6,10,2,4,6,8,10,12,1,9,5,13,5,9,3,11,7,15,7,11,3,5,7,9,11,13,1,2,3,4,5,6,7,8,9,10,11,12,13,14,16,17,18,19,16,18,17,19,17,18,20,21,22,23,20,22,21,23,21,22,16,20,18,22,18,20,17,21,19,23,19,21,17,18,19,20,21,22,24,25,26,27,24,26,25,27,25,26,28,29,30,31,28,30,29,31,29,30,24,28,26,30,26,28,25,29,27,31,27,29,25,26,27,28,29,30,16,24,20,28,20,24,18,26,22,30,22,26,18,20,22,24,26,28,17,25,21,29,21,25,19,27,23,31,23,27,19,21,23,25,27,29,17,18,19,20,21,22,23,24,25,26,27,28,29,30,0,16,8,24,8,16,4,20,12,28,12,20,4,8,12,16,20,24,2,18,10,26,10,18,6,22,14,30,14,22,6,10,14,18,22,26,2,4,6,8,10,12,14,16,18,20,22,24,26,28,1,17,9,25,9,17,5,21,13,29,13,21,5,9,13,17,21,25,3,19,11,27,11,19,7,23,15,31,15,23,7,11,15,19,23,27,3,5,7,9,11,13,15,17,19,21,23,25,27,29,1,2,3,4,5,6,7,8,9,10,11,12,13,14,15,16,17,18,19,20,21,22,23,24,25,26,27,28,29,30};
template <int OFF, int TOT> __device__ __forceinline__ void sort16_desc(int (&a)[TOT]) {
#pragma unroll
    for (int c = 0; c < 63; ++c) { const int i = OFF + NET16[2 * c], j = OFF + NET16[2 * c + 1]; const int hi_ = imax(a[i], a[j]), lo_ = imin(a[i], a[j]); a[i] = hi_; a[j] = lo_; }
}
template <int TOT> __device__ __forceinline__ void sort32_desc(int (&a)[TOT]) {
#pragma unroll
    for (int c = 0; c < 191; ++c) { const int i = NET32[2 * c], j = NET32[2 * c + 1]; const int hi_ = imax(a[i], a[j]), lo_ = imin(a[i], a[j]); a[i] = hi_; a[j] = lo_; }
}
template <int N, int OFF, int TOT> __device__ __forceinline__ void bmerge_desc(int (&a)[TOT]) {
#pragma unroll
    for (int j = N >> 1; j > 0; j >>= 1)
#pragma unroll
        for (int i = 0; i < N; ++i) { const int l = i ^ j; if (l > i) { const int hi_ = imax(a[OFF + i], a[OFF + l]), lo_ = imin(a[OFF + i], a[OFF + l]); a[OFF + i] = hi_; a[OFF + l] = lo_; } }
}
template <int A, int B, int TOT> __device__ __forceinline__ void merge_top16(int (&a)[TOT]) {
#pragma unroll
    for (int i = 0; i < 16; ++i) a[A + i] = imax(a[A + i], a[B + 15 - i]);
    bmerge_desc<16, A, TOT>(a);
}
__device__ __forceinline__ void cross_top16(int (&t)[16]) {
    int lo[16], hi[16];
#pragma unroll
    for (int i = 0; i < 16; ++i) { auto rr = __builtin_amdgcn_permlane32_swap((unsigned)t[i], (unsigned)t[i], false, false); lo[i] = (int)rr[0]; hi[i] = (int)rr[1]; }
#pragma unroll
    for (int i = 0; i < 16; ++i) t[i] = imax(lo[i], hi[15 - i]);
    bmerge_desc<16, 0, 16>(t);
}
struct RowStream {
    const float* pu; const float* pv; unsigned char* ws; int r, step, lane; f32x4 v0, v1, v2, v3;
    __device__ __forceinline__ void issue() {
        if (r < 2 * NEXP) { const float* src = (r < NEXP ? pu + (size_t)r * D : pv + (size_t)(r - NEXP) * D); const f32x4* s4 = (const f32x4*)src + lane * 4; v0 = s4[0]; v1 = s4[1]; v2 = s4[2]; v3 = s4[3]; } }
    __device__ __forceinline__ void finish() {
        if (r < 2 * NEXP) { const f32x4 cur[4] = {v0, v1, v2, v3};
            if (r < NEXP) cvt_row_i4(cur, ws + WS_U + (size_t)r * 256, (float*)(ws + WS_SU) + r, lane);
            else { const int e = r - NEXP; cvt_row_fp6(cur, ws + WS_V + (size_t)e * 768, (float*)(ws + WS_SV) + e, lane); }
            r += step; } }
    __device__ __forceinline__ void hook() { finish(); issue(); }
};
__device__ __forceinline__ void half_top16(int (&top)[16], const bf16_t* qrow  , lds_cptr skp  , int hi, RowStream& RS) {
    f32x16 sc[4]; sc[0] = f32x16{}; sc[1] = f32x16{}; sc[2] = f32x16{}; sc[3] = f32x16{};
    bf16x8 qf[8];
#pragma unroll
    for (int ks = 0; ks < 8; ++ks) qf[ks] = *(const bf16x8*)(qrow + ks * 16);
    RS.hook();
#pragma unroll
    for (int ks = 0; ks < 8; ++ks)
#pragma unroll
        for (int kt = 0; kt < 4; ++kt) { const bf16x8 af = *(const __attribute__((address_space(3))) bf16x8*)(skp + ks * 4096 + kt * 512);
            sc[kt] = __builtin_amdgcn_mfma_f32_32x32x16_bf16(af, qf[ks], sc[kt], 0, 0, 0); }
    int k[64];
#pragma unroll
    for (int kt = 0; kt < 4; ++kt)
#pragma unroll
        for (int r = 0; r < 16; ++r) k[kt * 16 + r] = f2key(sc[kt][r], (32 * kt + (r & 3) + 8 * (r >> 2)) | (4 * hi));
    sort16_desc<0, 64>(k); sort16_desc<16, 64>(k);
    RS.hook();
    sort16_desc<32, 64>(k); sort16_desc<48, 64>(k);
    RS.hook();
    merge_top16<0, 16, 64>(k); merge_top16<32, 48, 64>(k); merge_top16<0, 32, 64>(k);
#pragma unroll
    for (int i = 0; i < 16; ++i) top[i] = k[i];
    cross_top16(top);
}
__device__ __forceinline__ void topk_wave(int tok0, int h, const bf16_t* Q, int* IDX, float* Gt, lds_cptr sk, int lane, RowStream& RS) {
    const int r32 = lane & 31, hi = lane >> 5, tok = tok0 + r32;
    const bf16_t* qrow = Q + (size_t)tok * PQ + h * 256 + 8 * hi;
    lds_cptr skl = sk + hi * 2048 + r32 * 16;
    int A0[16], A1[16];
    half_top16(A0, qrow, skl, hi, RS);
    half_top16(A1, qrow + 128, skl + 32768, hi, RS);
    RS.hook();
    float x[16], y[16]; int xw[16], yw[16];
#pragma unroll
    for (int a = 0; a < 16; ++a) { const int b0 = key2bits(A0[a]), b1 = key2bits(A1[a]);
        const float v0 = __int_as_float(b0 & ~127), v1 = __int_as_float(b1 & ~127); const int i0 = (b0 & 127) << 7, i1 = b1 & 127;
        x[a] = hi ? v1 : v0; y[a] = hi ? v0 : v1; xw[a] = hi ? i1 : i0; yw[a] = hi ? i0 : i1; }
    int w[32]; int n = 0;
#define PEER_CAND(a, b) do { const int bits = __float_as_int(x[a] + y[b]); int ww = (bits & ~0x3FFF) | (xw[a] + yw[b]); \
        if ((a) == (b) && hi) ww = (int)0xFF800000; w[n] = ww; ++n; } while (0)
#pragma unroll
    for (int b = 0; b < 16; ++b) PEER_CAND(0, b);
#pragma unroll
    for (int b = 1; b < 8; ++b) PEER_CAND(1, b);
#pragma unroll
    for (int b = 2; b < 5; ++b) PEER_CAND(2, b);
    PEER_CAND(3, 3);
#undef PEER_CAND
#pragma unroll
    for (int i = 27; i < 32; ++i) w[i] = (int)0xFF800000;
    RS.hook();
    sort32_desc<32>(w);
    RS.hook();
    int T[16];
#pragma unroll
    for (int i = 0; i < 16; ++i) T[i] = w[i];
    cross_top16(T);
    float sv[16]; int ev[16];
#pragma unroll
    for (int j = 0; j < 16; ++j) { ev[j] = T[j] & 0x3FFF; sv[j] = __int_as_float(T[j] & ~0x3FFF); }
    const float s0 = sv[0]; float esum = 0.f;
#pragma unroll
    for (int j = 0; j < 16; ++j) { sv[j] = __expf(sv[j] - s0); esum += sv[j]; }
    const float inv = 1.f / esum;
    if (hi == 0) { u32x4* io = (u32x4*)(IDX + ((size_t)tok * 8 + h) * 16);
#pragma unroll
        for (int j = 0; j < 4; ++j) io[j] = (u32x4){(unsigned)ev[4 * j], (unsigned)ev[4 * j + 1], (unsigned)ev[4 * j + 2], (unsigned)ev[4 * j + 3]}; }
    else { f32x4* go = (f32x4*)(Gt + ((size_t)tok * 8 + h) * 16);
#pragma unroll
        for (int j = 0; j < 4; ++j) go[j] = (f32x4){sv[4 * j] * inv, sv[4 * j + 1] * inv, sv[4 * j + 2] * inv, sv[4 * j + 3] * inv}; }
}
template <class Sched> __device__ __forceinline__ void topk_own_units(const Ptrs& P, unsigned char* shm, const Sched& S) {
    int tid_l = threadIdx.x; asm volatile("" : "+v"(tid_l));
    const int tid = tid_l, lane = tid & 63; const int wid = __builtin_amdgcn_readfirstlane(tid >> 6);
    const unsigned lds0 = (unsigned)(uintptr_t)shm;
    const bf16_t* SKg = (const bf16_t*)(P.ws + WS_SK);
    int hprev = -1; pg8::Unit u;
    RowStream RS; RS.pu = P.peer_u; RS.pv = P.peer_v; RS.ws = P.ws; RS.lane = lane; RS.step = (int)gridDim.x * 8; RS.r = (int)blockIdx.x * 8 + wid; RS.v0 = RS.v1 = RS.v2 = RS.v3 = f32x4{};
    RS.issue();
    for (int i = 0; S.next(i, u); ++i) {
        const int h = u.pn, tg = u.pm;
        if (h != hprev) { hprev = h;
            asm volatile("s_waitcnt lgkmcnt(0)\n\ts_barrier" ::: "memory");
#pragma unroll
            for (int j = 0; j < 8; ++j) { const int piece = wid * 8 + j, p = piece >> 5, c = (piece >> 1) & 15, kh = piece & 1;
                att::glds16(SKg + ((size_t)((h * 2 + p) * 128 + kh * 64 + lane) * 128 + c * 8), (unsigned)__builtin_amdgcn_readfirstlane(lds0 + p * 32768 + c * 2048 + kh * 1024)); }
            asm volatile("s_waitcnt vmcnt(0)\n\ts_barrier" ::: "memory");
        }
        topk_wave(tg * 256 + wid * 32, h, (const bf16_t*)(P.ws + WS_Q), (int*)(P.ws + WS_IDX), (float*)(P.ws + WS_G), (lds_cptr)shm, lane, RS);
    }
    while (RS.r < 2 * NEXP) RS.hook();
}
}

namespace apply {
typedef float f32x2 __attribute__((ext_vector_type(2)));
typedef __attribute__((address_space(3))) unsigned* lds_u32p;
constexpr int AP_WAVE_BYTES = 4 * (512 + 2048), AP_LDS_BYTES = 8 * AP_WAVE_BYTES;
__device__ __forceinline__ float gelu_fast(float v) {
    const float av = fabsf(v), t = __builtin_amdgcn_rcpf(av * 0.2316418882f + 1.0f);
    float q = t * 0.5307027145f + (-0.7265760135f); q = q * t + 0.7107068705f; q = q * t + (-0.142248368f); q = q * t + 0.127414796f; q = q * t;
    const float e = __builtin_amdgcn_exp2f((v * v) * (-0.72134752044f));
    const float m = v * (q * e);
    return v < 0.f ? m : v - m;
}
#define AP_DPP(v, ctrl) __builtin_bit_cast(float, __builtin_amdgcn_update_dpp(0, __builtin_bit_cast(int, (v)), (ctrl), 0xF, 0xF, true))
__device__ __forceinline__ float row16_sum(float v) { v += AP_DPP(v, 0xB1); v += AP_DPP(v, 0x4E); v += AP_DPP(v, 0x141); v += AP_DPP(v, 0x140); return v; }
__device__ __forceinline__ void load_half(u32x4 (&r)[2], const unsigned char* img, unsigned e, int sub) {
    const unsigned off = e * 512u + (unsigned)(sub * 16);
    r[0] = *(const u32x4*)(img + off); r[1] = *(const u32x4*)(img + off + 256u);
}
constexpr int AP_PROBE_RING = 16;
constexpr int AP_RING = 8;
typedef __attribute__((address_space(3))) u32x4* lds_v4p;
template <int HF, int MODE, int RING> __device__ __forceinline__ void pass_u(const Ptrs& P, const bf16_t* hrow, float rstd, lds_v4p grp, u32x4 (&R)[RING][2], const unsigned char* img, const unsigned char* img_next, int sub) {
    unsigned xq[8]; float sx;
    {
        float xf[2][16]; float mx = 0.f;
#pragma unroll
        for (int i = 0; i < 2; ++i) { const int e0 = (sub + 16 * (2 * HF + i)) * 16;
#pragma unroll
            for (int q = 0; q < 4; ++q) { const u32x2 hb = *(const u32x2*)(hrow + e0 + 4 * q); const f32x4 gv = *(const f32x4*)(P.norm_ffn + e0 + 4 * q);
                xf[i][4 * q] = bflo(hb.x) * rstd * gv.x; xf[i][4 * q + 1] = bfhi(hb.x) * rstd * gv.y; xf[i][4 * q + 2] = bflo(hb.y) * rstd * gv.z; xf[i][4 * q + 3] = bfhi(hb.y) * rstd * gv.w;
                mx = fmaxf(fmaxf(mx, fmaxf(fabsf(xf[i][4 * q]), fabsf(xf[i][4 * q + 1]))), fmaxf(fabsf(xf[i][4 * q + 2]), fabsf(xf[i][4 * q + 3]))); } }
        mx = fmaxf(mx, AP_DPP(mx, 0xB1)); mx = fmaxf(mx, AP_DPP(mx, 0x4E)); mx = fmaxf(mx, AP_DPP(mx, 0x141)); mx = fmaxf(mx, AP_DPP(mx, 0x140));
        mx = fmaxf(mx, 1e-30f); sx = mx * (1.f / 127.f); const float qs = 127.f / mx;
#pragma unroll
        for (int i = 0; i < 2; ++i)
#pragma unroll
            for (int q = 0; q < 4; ++q) xq[4 * i + q] = pack_i8x4(xf[i][4 * q] * qs, xf[i][4 * q + 1] * qs, xf[i][4 * q + 2] * qs, xf[i][4 * q + 3] * qs);
    }
#pragma unroll 1
    for (int j = 0; j < 128; j += RING) {
        const int jn = (j + RING) & 127;
        __builtin_amdgcn_s_barrier();
        const unsigned char* tb = (j + RING < 128) ? img : img_next;
        unsigned nid[RING], part[RING], suv[RING], gsv[RING];
#pragma unroll
        for (int b4 = 0; b4 < RING / 4; ++b4) { const u32x4 na = grp[jn / 4 + b4];
            nid[4 * b4] = na.x; nid[4 * b4 + 1] = na.y; nid[4 * b4 + 2] = na.z; nid[4 * b4 + 3] = na.w;
            u32x4 pa = {}, sa = {}, ga = {};
            if (HF == 1) { pa = grp[96 + j / 4 + b4]; sa = grp[32 + j / 4 + b4]; ga = grp[64 + j / 4 + b4]; }
            part[4 * b4] = pa.x; part[4 * b4 + 1] = pa.y; part[4 * b4 + 2] = pa.z; part[4 * b4 + 3] = pa.w;
            suv[4 * b4] = sa.x; suv[4 * b4 + 1] = sa.y; suv[4 * b4 + 2] = sa.z; suv[4 * b4 + 3] = sa.w;
            gsv[4 * b4] = ga.x; gsv[4 * b4 + 1] = ga.y; gsv[4 * b4 + 2] = ga.z; gsv[4 * b4 + 3] = ga.w; }
        float outv[RING];
#pragma unroll
        for (int bq = 0; bq < RING; ++bq) {
            int d0_ = 0, d1_ = 0;
            if (MODE == 1) { asm volatile("" :: "v"(R[bq][0]), "v"(R[bq][1])); d0_ = (int)xq[0]; }
            else {
                d0_ = __builtin_amdgcn_sdot4((int)R[bq][0].x, (int)xq[0], d0_, false); d1_ = __builtin_amdgcn_sdot4((int)R[bq][0].y, (int)xq[1], d1_, false);
                d0_ = __builtin_amdgcn_sdot4((int)R[bq][0].z, (int)xq[2], d0_, false); d1_ = __builtin_amdgcn_sdot4((int)R[bq][0].w, (int)xq[3], d1_, false);
                d0_ = __builtin_amdgcn_sdot4((int)R[bq][1].x, (int)xq[4], d0_, false); d1_ = __builtin_amdgcn_sdot4((int)R[bq][1].y, (int)xq[5], d1_, false);
                d0_ = __builtin_amdgcn_sdot4((int)R[bq][1].z, (int)xq[6], d0_, false); d1_ = __builtin_amdgcn_sdot4((int)R[bq][1].w, (int)xq[7], d1_, false);
            }
            asm volatile("" ::: "memory");
            load_half(R[bq], tb, MODE == 2 ? (nid[bq] & 15u) : nid[bq], sub);
            asm volatile("" ::: "memory");
            float a_ = row16_sum((float)(d0_ + d1_)) * sx;
            if (HF == 1) { a_ = (a_ + __uint_as_float(part[bq])) * __uint_as_float(suv[bq]); a_ = __uint_as_float(gsv[bq]) * gelu_fast(a_); }
            outv[bq] = a_;
        }
        if (sub == 0) {
#pragma unroll
            for (int b4 = 0; b4 < RING / 4; ++b4) grp[96 + j / 4 + b4] = (u32x4){__float_as_uint(outv[4 * b4]), __float_as_uint(outv[4 * b4 + 1]), __float_as_uint(outv[4 * b4 + 2]), __float_as_uint(outv[4 * b4 + 3])}; }
    }
    asm volatile("s_waitcnt lgkmcnt(0)" ::: "memory");
}
template <int HF, int MODE, int RING> __device__ __forceinline__ void pass_v(float (&acc)[4][16], lds_v4p grp, u32x4 (&R)[RING][2], const unsigned char* img, const unsigned char* img_next, int sub) {
#pragma unroll 1
    for (int j = 0; j < 128; j += RING) {
        const int jn = (j + RING) & 127;
        __builtin_amdgcn_s_barrier();
        const unsigned char* tb = (j + RING < 128) ? img : img_next;
        unsigned nid[RING], cvv[RING];
#pragma unroll
        for (int b4 = 0; b4 < RING / 4; ++b4) { const u32x4 na = grp[jn / 4 + b4], ca = grp[96 + j / 4 + b4];
            nid[4 * b4] = na.x; nid[4 * b4 + 1] = na.y; nid[4 * b4 + 2] = na.z; nid[4 * b4 + 3] = na.w; cvv[4 * b4] = ca.x; cvv[4 * b4 + 1] = ca.y; cvv[4 * b4 + 2] = ca.z; cvv[4 * b4 + 3] = ca.w; }
#pragma unroll
        for (int bq = 0; bq < RING; ++bq) {
            const float c_ = __uint_as_float(cvv[bq]); const f32x2 c2 = {c_, c_};
            if (MODE == 1) { asm volatile("" :: "v"(R[bq][0]), "v"(R[bq][1])); acc[2 * HF][0] += c_; }
            else {
#pragma unroll
            for (int i = 0; i < 2; ++i) { const unsigned w_[4] = {R[bq][i].x, R[bq][i].y, R[bq][i].z, R[bq][i].w};
#pragma unroll
                for (int q = 0; q < 4; ++q) { const f32x2 lo_ = __builtin_amdgcn_cvt_pk_f32_fp8(w_[q], false), hi_ = __builtin_amdgcn_cvt_pk_f32_fp8(w_[q], true);
                    f32x2 a0 = {acc[2 * HF + i][4 * q], acc[2 * HF + i][4 * q + 1]}, a1 = {acc[2 * HF + i][4 * q + 2], acc[2 * HF + i][4 * q + 3]}; a0 += c2 * lo_; a1 += c2 * hi_;
                    acc[2 * HF + i][4 * q] = a0.x; acc[2 * HF + i][4 * q + 1] = a0.y; acc[2 * HF + i][4 * q + 2] = a1.x; acc[2 * HF + i][4 * q + 3] = a1.y; } }
            }
            asm volatile("" ::: "memory");
            load_half(R[bq], tb, MODE == 2 ? (nid[bq] & 15u) : nid[bq], sub);
            asm volatile("" ::: "memory");
        }
    }
}
constexpr int AP_RINGU = 16;
__device__ __forceinline__ u32x4 load_q4(const unsigned char* img, unsigned e, int sub) { return *(const u32x4*)(img + e * 256u + (unsigned)(sub * 16)); }
template <int HF, int RF> __device__ __forceinline__ void u4_half_turn(lds_v4p grp, u32x4 (&R)[AP_RINGU], const unsigned (&xh)[4], const unsigned (&xl)[4], float sx, const unsigned char* tb, int jb, int jr, int sub) {
    constexpr int RING = AP_RINGU;
    __builtin_amdgcn_s_barrier();
    unsigned nid[RING];
    {
#pragma unroll
        for (int b4 = 0; b4 < RING / 4; ++b4) { const u32x4 na = grp[jr / 4 + b4]; nid[4 * b4] = na.x; nid[4 * b4 + 1] = na.y; nid[4 * b4 + 2] = na.z; nid[4 * b4 + 3] = na.w; } }
    float outv[RING];
#pragma unroll
    for (int b4 = 0; b4 < RING / 4; ++b4) {
        u32x4 pa = {}, sa = {}, ga = {};
        if (HF == 1) { pa = grp[96 + jb / 4 + b4]; sa = grp[32 + jb / 4 + b4]; ga = grp[64 + jb / 4 + b4]; }
        const unsigned part[4] = {pa.x, pa.y, pa.z, pa.w}, suv[4] = {sa.x, sa.y, sa.z, sa.w}, gsv[4] = {ga.x, ga.y, ga.z, ga.w};
#pragma unroll
        for (int b1 = 0; b1 < 4; ++b1) { const int bq = 4 * b4 + b1;
            int dh_ = __builtin_amdgcn_sdot8((int)R[bq].x, (int)xh[0], 0, false), dl_ = __builtin_amdgcn_sdot8((int)R[bq].x, (int)xl[0], 0, false);
            dh_ = __builtin_amdgcn_sdot8((int)R[bq].y, (int)xh[1], dh_, false); dl_ = __builtin_amdgcn_sdot8((int)R[bq].y, (int)xl[1], dl_, false);
            dh_ = __builtin_amdgcn_sdot8((int)R[bq].z, (int)xh[2], dh_, false); dl_ = __builtin_amdgcn_sdot8((int)R[bq].z, (int)xl[2], dl_, false);
            dh_ = __builtin_amdgcn_sdot8((int)R[bq].w, (int)xh[3], dh_, false); dl_ = __builtin_amdgcn_sdot8((int)R[bq].w, (int)xl[3], dl_, false);
            asm volatile("" ::: "memory");
            if (RF == 0) R[bq] = load_q4(tb, nid[bq], sub);
            else if (RF == 1) R[bq] = *(const u32x4*)(tb + nid[bq / 3] * 768u + (unsigned)(sub * 48 + (bq % 3) * 16));
            else if (RF == 2) { if (bq < 8) R[bq] = *(const u32x4*)(tb + nid[(16 + bq) / 3] * 768u + (unsigned)(sub * 48 + ((16 + bq) % 3) * 16)); }
            asm volatile("" ::: "memory");
            float a_ = row16_sum((float)(dh_ * 16 + dl_)) * sx;
            if (HF == 1) { a_ = (a_ + __uint_as_float(part[b1])) * __uint_as_float(suv[b1]); a_ = __uint_as_float(gsv[b1]) * gelu_fast(a_); }
            outv[bq] = a_; }
    }
    if (sub == 0) {
#pragma unroll
        for (int b4 = 0; b4 < RING / 4; ++b4) grp[96 + jb / 4 + b4] = (u32x4){__float_as_uint(outv[4 * b4]), __float_as_uint(outv[4 * b4 + 1]), __float_as_uint(outv[4 * b4 + 2]), __float_as_uint(outv[4 * b4 + 3])}; }
}
template <int HF, bool NEXTV> __device__ __forceinline__ void pass_u4(const Ptrs& P, const bf16_t* hrow, float rstd, lds_v4p grp, u32x4 (&RA)[AP_RINGU], u32x4 (&RB)[AP_RINGU], const unsigned char* img, const unsigned char* img_next, int sub) {
    unsigned xh[4], xl[4]; float sx;
    {
        float xf[2][16]; float mx = 0.f;
#pragma unroll
        for (int i = 0; i < 2; ++i) { const int e0 = (sub + 16 * (2 * HF + i)) * 16;
#pragma unroll
            for (int q = 0; q < 4; ++q) { const u32x2 hb = *(const u32x2*)(hrow + e0 + 4 * q); const f32x4 gv = *(const f32x4*)(P.norm_ffn + e0 + 4 * q);
                xf[i][4 * q] = bflo(hb.x) * rstd * gv.x; xf[i][4 * q + 1] = bfhi(hb.x) * rstd * gv.y; xf[i][4 * q + 2] = bflo(hb.y) * rstd * gv.z; xf[i][4 * q + 3] = bfhi(hb.y) * rstd * gv.w;
                mx = fmaxf(fmaxf(mx, fmaxf(fabsf(xf[i][4 * q]), fabsf(xf[i][4 * q + 1]))), fmaxf(fabsf(xf[i][4 * q + 2]), fabsf(xf[i][4 * q + 3]))); } }
        mx = fmaxf(mx, AP_DPP(mx, 0xB1)); mx = fmaxf(mx, AP_DPP(mx, 0x4E)); mx = fmaxf(mx, AP_DPP(mx, 0x141)); mx = fmaxf(mx, AP_DPP(mx, 0x140));
        mx = fmaxf(mx, 1e-30f); sx = mx * (1.f / 119.f); const float qs = 119.f / mx;
#pragma unroll
        for (int q = 0; q < 4; ++q) { unsigned h_ = 0u, l_ = 0u;
#pragma unroll
            for (int i = 0; i < 8; ++i) { const int xi = (int)rintf(xf[q >> 1][8 * (q & 1) + i] * qs); const int lo = ((xi + 8) & 15) - 8; const int hi = (xi - lo) >> 4;
                h_ |= ((unsigned)hi & 15u) << (4 * i); l_ |= ((unsigned)lo & 15u) << (4 * i); }
            xh[q] = h_; xl[q] = l_; }
    }
#pragma unroll 1
    for (int j = 0; j < 96; j += 32) {
        u4_half_turn<HF, 0>(grp, RA, xh, xl, sx, img, j, j + 32, sub);
        u4_half_turn<HF, 0>(grp, RB, xh, xl, sx, img, j + 16, j + 48, sub);
    }
    u4_half_turn<HF, NEXTV ? 1 : 0>(grp, RA, xh, xl, sx, img_next, 96, 0, sub);
    u4_half_turn<HF, NEXTV ? 2 : 0>(grp, RB, xh, xl, sx, img_next, 112, NEXTV ? 0 : 16, sub);
    asm volatile("s_waitcnt lgkmcnt(0)" ::: "memory");
}
template <int HF> __device__ __forceinline__ void pass_v8f(float (&acc)[4][16], lds_v4p grp, u32x4 (&R)[AP_RINGU], const unsigned char* img, const unsigned char* img_next, int sub) {
    constexpr int RING = 8;
#pragma unroll 1
    for (int j = 0; j < 128; j += RING) {
        const int jn = (j + RING) & 127;
        if ((j & 31) == 0) __builtin_amdgcn_s_barrier();
        const unsigned char* tb = (j + RING < 128) ? img : img_next;
        unsigned nid[RING], cvv[RING];
#pragma unroll
        for (int b4 = 0; b4 < RING / 4; ++b4) { const u32x4 na = grp[jn / 4 + b4], ca = grp[96 + j / 4 + b4];
            nid[4 * b4] = na.x; nid[4 * b4 + 1] = na.y; nid[4 * b4 + 2] = na.z; nid[4 * b4 + 3] = na.w; cvv[4 * b4] = ca.x; cvv[4 * b4 + 1] = ca.y; cvv[4 * b4 + 2] = ca.z; cvv[4 * b4 + 3] = ca.w; }
#pragma unroll
        for (int bq = 0; bq < RING; ++bq) {
            const float c_ = __uint_as_float(cvv[bq]); const f32x2 c2 = {c_, c_};
#pragma unroll
            for (int i = 0; i < 2; ++i) { const unsigned w_[4] = {R[2 * bq + i].x, R[2 * bq + i].y, R[2 * bq + i].z, R[2 * bq + i].w};
#pragma unroll
                for (int q = 0; q < 4; ++q) { const f32x2 lo_ = __builtin_amdgcn_cvt_pk_f32_fp8(w_[q], false), hi_ = __builtin_amdgcn_cvt_pk_f32_fp8(w_[q], true);
                    f32x2 a0 = {acc[2 * HF + i][4 * q], acc[2 * HF + i][4 * q + 1]}, a1 = {acc[2 * HF + i][4 * q + 2], acc[2 * HF + i][4 * q + 3]}; a0 += c2 * lo_; a1 += c2 * hi_;
                    acc[2 * HF + i][4 * q] = a0.x; acc[2 * HF + i][4 * q + 1] = a0.y; acc[2 * HF + i][4 * q + 2] = a1.x; acc[2 * HF + i][4 * q + 3] = a1.y; } }
            asm volatile("" ::: "memory");
            { const unsigned off = nid[bq] * 512u + (unsigned)(sub * 16); R[2 * bq] = *(const u32x4*)(tb + off); R[2 * bq + 1] = *(const u32x4*)(tb + off + 256u); }
            asm volatile("" ::: "memory");
        }
    }
}
#define AP_PIECE(p) ((p) < 16 ? RA[(p) < 16 ? (p) : 0] : RB[(p) >= 16 ? (p) - 16 : 0])
__device__ __forceinline__ void pass_v6(float (&accP)[2][32], lds_v4p grp, u32x4 (&RA)[AP_RINGU], u32x4 (&RB)[AP_RINGU], const unsigned char* img, int sub) {
#pragma unroll 1
    for (int j = 0; j < 128; j += 8) {
        const int jn = (j + 8) & 127;
        if ((j & 31) == 0) __builtin_amdgcn_s_barrier();
        unsigned nid[8], cvv[8];
#pragma unroll
        for (int b4 = 0; b4 < 2; ++b4) { const u32x4 na = grp[jn / 4 + b4], ca = grp[96 + j / 4 + b4];
            nid[4 * b4] = na.x; nid[4 * b4 + 1] = na.y; nid[4 * b4 + 2] = na.z; nid[4 * b4 + 3] = na.w; cvv[4 * b4] = ca.x; cvv[4 * b4 + 1] = ca.y; cvv[4 * b4 + 2] = ca.z; cvv[4 * b4 + 3] = ca.w; }
#pragma unroll
        for (int e = 0; e < 8; ++e) {
            const float c_ = __uint_as_float(cvv[e]); const f32x2 c2 = {c_, c_};
            const u32x4 p0 = AP_PIECE(3 * e), p1 = AP_PIECE(3 * e + 1), p2 = AP_PIECE(3 * e + 2);
            { const u32x6v blk = {p0.x, p0.y, p0.z, p0.w, p1.x, p1.y}; const f32x32v r = __builtin_amdgcn_cvt_scalef32_pk32_f32_fp6(blk, 1.0f);
#pragma unroll
              for (int p = 0; p < 32; p += 2) { f32x2 a0 = {accP[0][p], accP[0][p + 1]}; const f32x2 rv = {r[p], r[p + 1]}; a0 += c2 * rv; accP[0][p] = a0.x; accP[0][p + 1] = a0.y; } }
            { const u32x6v blk = {p1.z, p1.w, p2.x, p2.y, p2.z, p2.w}; const f32x32v r = __builtin_amdgcn_cvt_scalef32_pk32_f32_fp6(blk, 1.0f);
#pragma unroll
              for (int p = 0; p < 32; p += 2) { f32x2 a0 = {accP[1][p], accP[1][p + 1]}; const f32x2 rv = {r[p], r[p + 1]}; a0 += c2 * rv; accP[1][p] = a0.x; accP[1][p + 1] = a0.y; } }
            asm volatile("" ::: "memory");
            { const unsigned char* rp = img + nid[e] * 768u + (unsigned)(sub * 48);
              AP_PIECE(3 * e) = *(const u32x4*)rp; AP_PIECE(3 * e + 1) = *(const u32x4*)(rp + 16); AP_PIECE(3 * e + 2) = *(const u32x4*)(rp + 32); }
            asm volatile("" ::: "memory");
        }
    }
}
#ifndef AP_FP6_INTERLEAVED
#define AP_FP6_INTERLEAVED 1
#endif
template <int MODE> __device__ __forceinline__ void apply_round(const Ptrs& P, float* outbase, int tbase, unsigned char* shm_wave, int lane_in) {
    int lane = lane_in; asm volatile("" : "+v"(lane));
    const int sub = lane & 15, g = lane >> 4, t = tbase + g;
    __attribute__((address_space(3))) unsigned* cnt = (lds_u32p)(__attribute__((address_space(3))) unsigned char*)shm_wave + g * 128;
    lds_v4p grp = (lds_v4p)((__attribute__((address_space(3))) unsigned char*)shm_wave + 2048 + g * 2048);
    __attribute__((address_space(3))) unsigned* grp1 = (__attribute__((address_space(3))) unsigned*)grp;
    const unsigned char* U8 = P.ws + WS_U; const unsigned char* V8 = P.ws + WS_V;
    {
        const int* idxp = (const int*)(P.ws + WS_IDX) + (size_t)t * 128 + sub * 8; const float* gp = (const float*)(P.ws + WS_G) + (size_t)t * 128 + sub * 8;
        const u32x4 ia = *(const u32x4*)idxp, ib = *(const u32x4*)(idxp + 4); const f32x4 ga = *(const f32x4*)gp, gb = *(const f32x4*)(gp + 4);
        const int e[8] = {(int)ia.x, (int)ia.y, (int)ia.z, (int)ia.w, (int)ib.x, (int)ib.y, (int)ib.z, (int)ib.w};
        const float gt[8] = {ga.x, ga.y, ga.z, ga.w, gb.x, gb.y, gb.z, gb.w};
        float su[8], sv[8];
#pragma unroll
        for (int i = 0; i < 8; ++i) { su[i] = ((const float*)(P.ws + WS_SU))[e[i]]; sv[i] = ((const float*)(P.ws + WS_SV))[e[i]]; }
#pragma unroll
        for (int i = 0; i < 8; ++i) cnt[sub * 8 + i] = 0u;
        asm volatile("s_waitcnt lgkmcnt(0)" ::: "memory");
        unsigned pos[8];
#pragma unroll
        for (int i = 0; i < 8; ++i) pos[i] = __hip_atomic_fetch_add(cnt + (e[i] >> 7), 1u, __ATOMIC_RELAXED, __HIP_MEMORY_SCOPE_WAVEFRONT);
        asm volatile("s_waitcnt lgkmcnt(0)" ::: "memory");
        unsigned c[8]; unsigned tot = 0;
#pragma unroll
        for (int i = 0; i < 8; ++i) { c[i] = cnt[sub * 8 + i]; }
#pragma unroll
        for (int i = 0; i < 8; ++i) { const unsigned x = c[i]; c[i] = tot; tot += x; }
        unsigned inc = tot;
#pragma unroll
        for (int d = 1; d < 16; d <<= 1) { const unsigned y = __shfl_up(inc, d, 16); if (sub >= d) inc += y; }
        const unsigned base = inc - tot;
        asm volatile("s_waitcnt lgkmcnt(0)" ::: "memory");
#pragma unroll
        for (int i = 0; i < 8; ++i) cnt[sub * 8 + i] = base + c[i];
        asm volatile("s_waitcnt lgkmcnt(0)" ::: "memory");
#pragma unroll
        for (int i = 0; i < 8; ++i) { const unsigned p = cnt[e[i] >> 7] + pos[i];
            grp1[p] = (unsigned)e[i]; grp1[128 + p] = __float_as_uint(su[i]); grp1[256 + p] = __float_as_uint(gt[i] * sv[i]); }
        asm volatile("s_waitcnt lgkmcnt(0)" ::: "memory");
    }
    const bf16_t* hrow = (const bf16_t*)(P.ws + WS_HB) + (size_t)t * D;
    float rstd;
    { const float* ssq = (const float*)(P.ws + WS_SSQ) + (size_t)t * 16;
      const f32x4 s0 = *(const f32x4*)ssq, s1 = *(const f32x4*)(ssq + 4), s2 = *(const f32x4*)(ssq + 8), s3 = *(const f32x4*)(ssq + 12);
      const float tot = ((s0.x + s0.y) + (s0.z + s0.w)) + ((s1.x + s1.y) + (s1.z + s1.w)) + ((s2.x + s2.y) + (s2.z + s2.w)) + ((s3.x + s3.y) + (s3.z + s3.w));
      rstd = 1.f / sqrtf(tot * (1.f / D) + EPS); }
    const unsigned char* U0 = U8; const unsigned char* U1 = U8 + (size_t)NEXP * 256; const unsigned char* V0 = V8;
    u32x4 R[AP_RINGU], RB[AP_RINGU];
    {
#pragma unroll
      for (int b4 = 0; b4 < AP_RINGU / 4; ++b4) { const u32x4 ia = grp[b4]; R[4 * b4] = load_q4(U0, ia.x, sub); R[4 * b4 + 1] = load_q4(U0, ia.y, sub); R[4 * b4 + 2] = load_q4(U0, ia.z, sub); R[4 * b4 + 3] = load_q4(U0, ia.w, sub); }
#pragma unroll
      for (int b4 = 0; b4 < AP_RINGU / 4; ++b4) { const u32x4 ia = grp[4 + b4]; RB[4 * b4] = load_q4(U0, ia.x, sub); RB[4 * b4 + 1] = load_q4(U0, ia.y, sub); RB[4 * b4 + 2] = load_q4(U0, ia.z, sub); RB[4 * b4 + 3] = load_q4(U0, ia.w, sub); }
      pass_u4<0, false>(P, hrow, rstd, grp, R, RB, U0, U1, sub);
      pass_u4<1, true>(P, hrow, rstd, grp, R, RB, U1, V0, sub);
    }
    float accP[2][32];
#pragma unroll
    for (int k = 0; k < 2; ++k)
#pragma unroll
        for (int p = 0; p < 32; ++p) accP[k][p] = 0.f;
    pass_v6(accP, grp, R, RB, V0, sub);
    float acc[4][16];
#pragma unroll
    for (int i = 0; i < 4; ++i)
#pragma unroll
        for (int q = 0; q < 16; ++q) acc[i][q] = accP[i >> 1][AP_FP6_INTERLEAVED ? 2 * q + (i & 1) : 16 * (i & 1) + q];
    float ss = 0.f;
#pragma unroll
    for (int i = 0; i < 4; ++i) { const int e0 = (sub + 16 * i) * 16;
#pragma unroll
        for (int q = 0; q < 4; ++q) { const u32x2 hb = *(const u32x2*)(hrow + e0 + 4 * q);
            acc[i][4 * q] += bflo(hb.x); acc[i][4 * q + 1] += bfhi(hb.x); acc[i][4 * q + 2] += bflo(hb.y); acc[i][4 * q + 3] += bfhi(hb.y);
            ss += (acc[i][4 * q] * acc[i][4 * q] + acc[i][4 * q + 1] * acc[i][4 * q + 1]) + (acc[i][4 * q + 2] * acc[i][4 * q + 2] + acc[i][4 * q + 3] * acc[i][4 * q + 3]); }
        asm volatile("" ::: "memory"); }
    ss = row16_sum(ss);
    const float r2 = 1.f / sqrtf(ss * (1.f / D) + EPS);
    float* orow = outbase + (size_t)t * D;
#pragma unroll
    for (int i = 0; i < 4; ++i) { const int e0 = (sub + 16 * i) * 16;
#pragma unroll
        for (int q = 0; q < 4; ++q) { const f32x4 gv = *(const f32x4*)(P.norm_final + e0 + 4 * q);
            *(f32x4*)(orow + e0 + 4 * q) = (f32x4){acc[i][4 * q] * r2 * gv.x, acc[i][4 * q + 1] * r2 * gv.y, acc[i][4 * q + 2] * r2 * gv.z, acc[i][4 * q + 3] * r2 * gv.w}; }
        asm volatile("" ::: "memory"); }
}
template <int MODE> __device__ __forceinline__ void apply_phase(const Ptrs& P, float* outbase, unsigned char* shm, int G, int vcu) {
    int tid_l = threadIdx.x; asm volatile("" : "+v"(tid_l));
    const int lane = tid_l & 63; const int wave = __builtin_amdgcn_readfirstlane(tid_l >> 6);
    const int per = M / (G * 8);
#pragma unroll 1
    for (int r = 0; r < per; r += 4) apply_round<MODE>(P, outbase, (vcu * 8 + wave) * per + r, shm + wave * AP_WAVE_BYTES, lane);
}
}

#define LAS __attribute__((address_space(3)))
#define XB_TMO      128
#define XB_XCNT(j)  (256  + 64 * (j))
#define XB_XSUB(j)  (1280 + 64 * (j))
#define XB_XGEN(j)  (2304 + 64 * (j))
#define XB_TOP      3328
#define XB_TOPGEN   3392
#define XCD_BAR_WORDS 3456
#define XB_SPIN_CAP (1u << 18)

__device__ __forceinline__ unsigned xb_ld(unsigned* p)              { return __hip_atomic_load(p, __ATOMIC_RELAXED, __HIP_MEMORY_SCOPE_AGENT); }
__device__ __forceinline__ unsigned xb_add(unsigned* p, unsigned v) { return __hip_atomic_fetch_add(p, v, __ATOMIC_RELAXED, __HIP_MEMORY_SCOPE_AGENT); }
__device__ __forceinline__ unsigned xb_xcc_id() { return (unsigned)__builtin_amdgcn_s_getreg((3 << 11) | 20) & 0xFu; }
#define XB_SPIN(cond, bar) do { unsigned _sp = 0; while (cond) { __builtin_amdgcn_s_sleep(1); \
    if ((++_sp & 255u) == 0u) { if (xb_ld(&(bar)[XB_TMO])) break; if (_sp > XB_SPIN_CAP) { atomicAdd(&(bar)[XB_TMO], 1u); break; } } } } while (0)

struct XcdBarrier {
    unsigned* bar; unsigned x;
    volatile LAS unsigned* st;
};

__device__ __forceinline__ XcdBarrier xcd_barrier_post(unsigned* bar, volatile LAS unsigned* st) {
    XcdBarrier b; b.bar = bar; b.x = xb_xcc_id(); b.st = st;
    if (threadIdx.x == 0) (void)xb_add(&bar[XB_XCNT(b.x)], 1u);
    return b;
}
__device__ __forceinline__ void xcd_barrier_complete(unsigned* bar, unsigned x, unsigned& nloc, unsigned& nx) {
    const unsigned G = gridDim.x * gridDim.y * gridDim.z;
    unsigned sum, cnt, mine, sp = 0u;
    for (;;) {
        sum = 0u; cnt = 0u; mine = 0u;
#pragma unroll
        for (unsigned j = 0; j < 16; ++j) { const unsigned c = xb_ld(&bar[XB_XCNT(j)]); sum += c; cnt += (c > 0u) ? 1u : 0u; mine = (j == x) ? c : mine; }
        if (sum == G) break;
        __builtin_amdgcn_s_sleep(1);
        if ((++sp & 255u) == 0u) { if (xb_ld(&bar[XB_TMO])) break; if (sp > XB_SPIN_CAP) { atomicAdd(&bar[XB_TMO], 1u); break; } }
    }
    nloc = mine > 0u ? mine : 1u; nx = cnt > 0u ? cnt : 1u;
}

__device__ __forceinline__ void xcd_barrier(const XcdBarrier& b) {
    asm volatile("s_waitcnt vmcnt(0)" ::: "memory");
    __syncthreads();
    if (threadIdx.x == 0) {
        unsigned* bar = b.bar;
        __builtin_amdgcn_s_waitcnt(0);
        unsigned nloc = b.st[0], nx = b.st[1];
        if (nloc == 0u) { xcd_barrier_complete(bar, b.x, nloc, nx); b.st[0] = nloc; b.st[1] = nx; }
        const unsigned old = xb_add(&bar[XB_XSUB(b.x)], 1u);
        const unsigned gen = old / nloc;
        if (old + 1u == (gen + 1u) * nloc) {
            __builtin_amdgcn_fence(__ATOMIC_RELEASE, "agent");
            asm volatile("s_waitcnt vmcnt(0)" ::: "memory");
            const unsigned og = xb_add(&bar[XB_TOP], 1u);
            const unsigned tg = og / nx;
            if (og + 1u == (tg + 1u) * nx) xb_add(&bar[XB_TOPGEN], 1u);
            else XB_SPIN(xb_ld(&bar[XB_TOPGEN]) == tg, bar);
            __builtin_amdgcn_fence(__ATOMIC_ACQUIRE, "agent");
            xb_add(&bar[XB_XGEN(b.x)], 1u);
            asm volatile("s_waitcnt vmcnt(0)" ::: "memory");
        } else {
            XB_SPIN(xb_ld(&bar[XB_XGEN(b.x)]) == gen, bar);
            __builtin_amdgcn_fence(__ATOMIC_ACQUIRE, "agent");
            asm volatile("s_waitcnt vmcnt(0)" ::: "memory");
        }
    }
    __syncthreads();
}


namespace cg = cooperative_groups;
#ifndef REP_MASK
#define REP_MASK 0
#endif
#define REPS(k) (((REP_MASK) >> (k)) & 1 ? 2 : 1)
constexpr int PHASE_LDS = att::A_LDS_BYTES;
constexpr int MEGA_LDS = PHASE_LDS + 64;
static_assert(PHASE_LDS >= pg8::STAGE_BYTES && PHASE_LDS >= att::B_LDS_BYTES && PHASE_LDS >= peer::T_LDS_BYTES && PHASE_LDS >= 8 * 64 * 33 * 4 && PHASE_LDS >= apply::AP_LDS_BYTES, "LDS budget");
__global__ void __launch_bounds__(512, 2) mega_fwd(Ptrs P) {
    extern __shared__ __attribute__((aligned(16))) unsigned char lds_dyn[];
    volatile LAS unsigned* bst = (volatile LAS unsigned*)((LAS unsigned char*)lds_dyn + PHASE_LDS);
    if (threadIdx.x < 2) bst[threadIdx.x] = 0u;
    __syncthreads();
    const XcdBarrier bar = xcd_barrier_post((unsigned*)(P.ws + WS_CTL), bst);
    const int G = (int)gridDim.x, bx = (int)blockIdx.x, vcu = (G % 8 == 0) ? (bx % 8) * (G / 8) + bx / 8 : bx;
    unsigned char* ws = P.ws;
    PG8_LAS unsigned char* lds3 = (PG8_LAS unsigned char*)lds_dyn;
    for (int rep = 0; rep < REPS(0); ++rep) prep_phase(P, lds_dyn, G, bx);
    xcd_barrier(bar); if (REPS(9) == 2) xcd_barrier(bar);
    for (int rep = 0; rep < REPS(1); ++rep) {
      { pg8::Gemm g{(const bf16_t*)(ws + WS_XN), (const bf16_t*)(ws + WS_WIN), M, 1024, D, 0}; pg8::StaticOrder S; S.init(M, 1024, G, bx);
        pg8::gemm_phase<pg8::EpiProj, pg8::StaticOrder, true, true, false>(lds3, g, S, pg8::EpiProj{(bf16_t*)(ws + WS_PROJ), (const float*)(ws + WS_ROPE), 1.f, 0}); }
      { pg8::Gemm g{(const bf16_t*)(ws + WS_XN8), (const bf16_t*)(ws + WS_WIN8), M, INW - 1024, D / 2, 0}; pg8::StaticOrder S; S.init(M, INW - 1024, G, bx);
        pg8::gemm_phase<pg8::EpiProj, pg8::StaticOrder, true, true, true>(lds3, g, S, pg8::EpiProj{(bf16_t*)(ws + WS_PROJ), (const float*)(ws + WS_ROPE), 1.f / WIN_SCALE, 4}); } }
    xcd_barrier(bar); if (REPS(9) == 2) xcd_barrier(bar);
    { const float lam = lambda_full(P);
      for (int rep = 0; rep < REPS(2); ++rep) for (int u = vcu; u < BATCH * 4 * 8; u += G) att::attn_a_unit(u >> 5, (u >> 3) & 3, u & 7, (const bf16_t*)(ws + WS_PROJ), (bf16_t*)(ws + WS_YA), P.subln, lam, lds_dyn);
      for (int rep = 0; rep < REPS(3); ++rep) for (int u = vcu; u < BATCH * 8 * 8; u += G) att::attn_b_unit(u >> 6, (u >> 3) & 7, u & 7, (const bf16_t*)(ws + WS_PROJ), (bf16_t*)(ws + WS_YA), P.rpb, lds_dyn); }
    xcd_barrier(bar); if (REPS(9) == 2) xcd_barrier(bar);
    for (int rep = 0; rep < REPS(4); ++rep) { pg8::StaticOrder S; S.init(M, D, G, bx);
      pg8::gemm_phase<pg8::EpiGate2, pg8::StaticOrder, true, true>(lds3, pg8::Gemm{(const bf16_t*)(ws + WS_YA), (const bf16_t*)(ws + WS_WPA), M, D, D, 0}, S, pg8::EpiGate2{(const bf16_t*)(ws + WS_PROJ), (bf16_t*)(ws + WS_MERGED)}); }
    xcd_barrier(bar); if (REPS(9) == 2) xcd_barrier(bar);
    for (int rep = 0; rep < REPS(5); ++rep) { pg8::StaticOrder S; S.init(M, D, G, bx);
      pg8::gemm_phase<pg8::EpiHout, pg8::StaticOrder, true, true>(lds3, pg8::Gemm{(const bf16_t*)(ws + WS_MERGED), (const bf16_t*)(ws + WS_WOUT), M, D, D, 0}, S, pg8::EpiHout{P.x, P.out, (bf16_t*)(ws + WS_HB), (float*)(ws + WS_SSQ)});
    }
    xcd_barrier(bar); if (REPS(9) == 2) xcd_barrier(bar);
    { pg8::StaticOrder S; S.init(M, PQ, G, bx);
      for (int rep = 0; rep < REPS(8); ++rep)
        pg8::gemm_phase<pg8::EpiQ, pg8::StaticOrder, true, true>(lds3, pg8::Gemm{(const bf16_t*)(ws + WS_HB), (const bf16_t*)(ws + WS_WQ), M, PQ, D, 0}, S, pg8::EpiQ{(const float*)(ws + WS_SSQ), (bf16_t*)(ws + WS_Q)});
      asm volatile("s_waitcnt vmcnt(0)" ::: "memory");
      __syncthreads();
      if (threadIdx.x == 0) { __builtin_amdgcn_fence(__ATOMIC_ACQUIRE, "agent"); asm volatile("s_waitcnt vmcnt(0)" ::: "memory"); }
      __syncthreads();
      for (int rep = 0; rep < REPS(6); ++rep) peer::topk_own_units(P, lds_dyn, S); }
    xcd_barrier(bar); if (REPS(9) == 2) xcd_barrier(bar);
#ifndef PROBE_MODE
#define PROBE_MODE 0
#endif
    if (REPS(7) == 2) apply::apply_phase<PROBE_MODE>(P, (float*)(ws + WS_Q), lds_dyn, G, vcu);
    apply::apply_phase<0>(P, P.out, lds_dyn, G, vcu);
}

extern "C" void kernel_launch(void* const* d_in, const int* in_sizes, int n_in, void* d_out, int out_size, void* d_ws, size_t ws_size, hipStream_t stream) {
    if (n_in != 18 || ws_size < WS_END) { fprintf(stderr, "kernel_launch: unexpected n_in %d / ws_size %zu\n", n_in, ws_size); return; }
    Ptrs P{};
    P.x = (const float*)d_in[0]; P.w_in = (const float*)d_in[1]; P.w_pa = (const float*)d_in[2]; P.w_pb = (const float*)d_in[3]; P.w_out = (const float*)d_in[4];
    P.norm_mix = (const float*)d_in[5]; P.norm_ffn = (const float*)d_in[6]; P.norm_final = (const float*)d_in[7];
    P.lq1 = (const float*)d_in[8]; P.lk1 = (const float*)d_in[9]; P.lq2 = (const float*)d_in[10]; P.lk2 = (const float*)d_in[11];
    P.subln = (const float*)d_in[12]; P.rpb = (const float*)d_in[13]; P.w_query = (const float*)d_in[14]; P.sub_keys = (const float*)d_in[15];
    P.peer_u = (const float*)d_in[16]; P.peer_v = (const float*)d_in[17];
    P.out = (float*)d_out; P.ws = (unsigned char*)d_ws;
    static int grid_blocks = 0;
    if (!grid_blocks) {
        int dev = 0, cus = 0, per_cu = 0;
        hipGetDevice(&dev);
        hipDeviceGetAttribute(&cus, hipDeviceAttributeMultiprocessorCount, dev);
        hipFuncSetAttribute((const void*)mega_fwd, hipFuncAttributeMaxDynamicSharedMemorySize, MEGA_LDS);
        hipOccupancyMaxActiveBlocksPerMultiprocessor(&per_cu, (const void*)mega_fwd, 512, MEGA_LDS);
        if (per_cu < 1) { fprintf(stderr, "kernel_launch: occupancy query says %d blocks per CU\n", per_cu); per_cu = 1; }
        grid_blocks = cus * per_cu;
    }
    hipMemsetAsync((unsigned char*)d_ws + WS_CTL, 0, 16384, stream);
    void* args[] = {&P};
    hipError_t e = hipLaunchCooperativeKernel((const void*)mega_fwd, dim3(grid_blocks), dim3(512), args, MEGA_LDS, stream);
    if (e != hipSuccess) fprintf(stderr, "cooperative launch failed: %s (grid %d)\n", hipGetErrorString(e), grid_blocks);
}
```

```cpp
#include <hip/hip_runtime.h>
#include <hip/hip_cooperative_groups.h>
#include <cstdio>
#include <cstdint>

typedef unsigned short bf16_t;
typedef unsigned u32x4 __attribute__((ext_vector_type(4)));
typedef unsigned u32x2 __attribute__((ext_vector_type(2)));
typedef float f32x4 __attribute__((ext_vector_type(4)));
typedef __bf16 bf16x2_t __attribute__((ext_vector_type(2)));

constexpr int D = 1024, BATCH = 8, SEQ = 2048, M = BATCH * SEQ, INW = 5120;
constexpr int C_QA = 0, C_KA = 512, C_VA = 1024, C_QB = 1536, C_KB = 2048, C_VB = 2560, C_GA = 3072, C_GB = 4096;
constexpr int NEXP = 16384, PQ = 2048;
constexpr float EPS = 1e-6f;
constexpr float LOG2E = 1.4426950408889634f;
constexpr float WIN_SCALE = 32.f;
constexpr float QSCALE = 0.125f * LOG2E;

constexpr size_t MiB = 1u << 20;
constexpr size_t WS_PROJ = 0;
constexpr size_t WS_HB = 0;
constexpr size_t WS_Q = 32 * MiB;
constexpr size_t WS_U = 96 * MiB;
constexpr size_t WS_V = 112 * MiB;
constexpr size_t WS_SU = 128 * MiB;
constexpr size_t WS_SV = 128 * MiB + 65536;
constexpr size_t WS_XN = 160 * MiB;
constexpr size_t WS_YA = 160 * MiB;
constexpr size_t WS_YB = 176 * MiB;
constexpr size_t WS_IDX = 160 * MiB;
constexpr size_t WS_G = 168 * MiB;
constexpr size_t WS_MERGED = 192 * MiB;
constexpr size_t WS_TOPV = 192 * MiB;
constexpr size_t WS_TOPI = 208 * MiB;
constexpr size_t WS_WIN = 224 * MiB;
constexpr size_t WS_WIN8 = 226 * MiB;
constexpr size_t WS_XN8 = 192 * MiB;
constexpr size_t WS_WQ = 234 * MiB;
constexpr size_t WS_WOUT = 238 * MiB;
constexpr size_t WS_WPA = 240 * MiB;
constexpr size_t WS_WPB = 241 * MiB;
constexpr size_t WS_SK = 242 * MiB;
constexpr size_t WS_ROPE = 242 * MiB + 512 * 1024;
constexpr size_t WS_SSQ = 243 * MiB;
constexpr size_t WS_CTL = 244 * MiB;
constexpr size_t WS_END = 256 * MiB;

__device__ __forceinline__ float bf2f(unsigned v) { return __uint_as_float(v << 16); }
__device__ __forceinline__ float bflo(unsigned w) { return __uint_as_float(w << 16); }
__device__ __forceinline__ float bfhi(unsigned w) { return __uint_as_float(w & 0xffff0000u); }
__device__ __forceinline__ unsigned f2bf(float f) { unsigned u = __float_as_uint(f); return (u + 0x7fffu + ((u >> 16) & 1u)) >> 16; }
__device__ __forceinline__ unsigned pk2(float lo, float hi) { return f2bf(lo) | (f2bf(hi) << 16); }
__device__ __forceinline__ float wave_sum(float v) {
#pragma unroll
    for (int o = 1; o < 64; o <<= 1) v += __shfl_xor(v, o);
    return v;
}
__device__ __forceinline__ float sigmoidf_(float x) { return 1.f / (1.f + __expf(-x)); }
__device__ __forceinline__ float gelu_exact(float x) { return 0.5f * x * (1.f + erff(x * 0.70710678118654752f)); }

struct Ptrs {
    const float *x, *w_in, *w_pa, *w_pb, *w_out, *norm_mix, *norm_ffn, *norm_final, *lq1, *lk1, *lq2, *lk2, *subln, *rpb, *w_query, *sub_keys, *peer_u, *peer_v;
    float* out; unsigned char* ws;
};

__device__ __forceinline__ void transpose_item(const float* W, int K, int N, const float* gain, bf16_t* WT, float* scr, int item, int lane, int ldo = 0, int koff = 0, int ldw = 0) {
    if (ldo == 0) ldo = K;
    if (ldw == 0) ldw = N;
    const int nblk = N / 32, kb = item / nblk, nb = item % nblk, k0 = 64 * kb, n0 = 32 * nb;
    float wv[32];
#pragma unroll
    for (int i = 0; i < 32; ++i) { const int kk = 2 * i + (lane >> 5); wv[i] = W[(size_t)(k0 + kk) * ldw + n0 + (lane & 31)]; }
#pragma unroll
    for (int i = 0; i < 32; ++i) { const int kk = 2 * i + (lane >> 5); float w = wv[i]; if (gain) w *= gain[k0 + kk]; scr[kk * 33 + (lane & 31)] = w; }
    asm volatile("s_waitcnt lgkmcnt(0)" ::: "memory");
    const int c = lane & 7;
#pragma unroll
    for (int j = 0; j < 4; ++j) { const int n = (lane >> 3) + 8 * j; const float* s = scr + (8 * c) * 33 + n;
        u32x4 o; o.x = pk2(s[0 * 33], s[1 * 33]); o.y = pk2(s[2 * 33], s[3 * 33]); o.z = pk2(s[4 * 33], s[5 * 33]); o.w = pk2(s[6 * 33], s[7 * 33]);
        *(u32x4*)(WT + (size_t)(n0 + n) * ldo + koff + k0 + 8 * c) = o; }
    asm volatile("s_waitcnt lgkmcnt(0)" ::: "memory");
}
__device__ __forceinline__ void cvt8(const float* src, bf16_t* dst, size_t i8) {
    const f32x4 a = *(const f32x4*)(src + i8 * 8), b = *(const f32x4*)(src + i8 * 8 + 4);
    u32x4 o; o.x = pk2(a.x, a.y); o.y = pk2(a.z, a.w); o.z = pk2(b.x, b.y); o.w = pk2(b.z, b.w);
    *(u32x4*)(dst + i8 * 8) = o;
}
__device__ __forceinline__ void transpose_item8(const float* W, int K, int N, int ldw, const float* gain, float wscale, unsigned char* WT, float* scr, int item, int lane) {
    const int nblk = N / 32, kb = item / nblk, nb = item % nblk, k0 = 64 * kb, n0 = 32 * nb;
    float wv[32];
#pragma unroll
    for (int i = 0; i < 32; ++i) { const int kk = 2 * i + (lane >> 5); wv[i] = W[(size_t)(k0 + kk) * ldw + n0 + (lane & 31)]; }
#pragma unroll
    for (int i = 0; i < 32; ++i) { const int kk = 2 * i + (lane >> 5); float w = wv[i] * wscale; if (gain) w *= gain[k0 + kk]; scr[kk * 33 + (lane & 31)] = w; }
    asm volatile("s_waitcnt lgkmcnt(0)" ::: "memory");
    const int c = lane & 7;
#pragma unroll
    for (int j = 0; j < 4; ++j) { const int n = (lane >> 3) + 8 * j; const float* s = scr + (8 * c) * 33 + n;
        u32x2 o; o.x = __builtin_amdgcn_cvt_pk_fp8_f32(s[0 * 33], s[1 * 33], 0u, false); o.x = __builtin_amdgcn_cvt_pk_fp8_f32(s[2 * 33], s[3 * 33], o.x, true);
        o.y = __builtin_amdgcn_cvt_pk_fp8_f32(s[4 * 33], s[5 * 33], 0u, false); o.y = __builtin_amdgcn_cvt_pk_fp8_f32(s[6 * 33], s[7 * 33], o.y, true);
        *(u32x2*)(WT + (size_t)(n0 + n) * K + k0 + 8 * c) = o; }
    asm volatile("s_waitcnt lgkmcnt(0)" ::: "memory");
}
__device__ __forceinline__ void rms_rows_emit(const f32x4 (&v)[4], bf16_t* orow16, unsigned char* orow, int lane) {
    float s = 0.f;
#pragma unroll
    for (int j = 0; j < 4; ++j) s += (v[j].x * v[j].x + v[j].y * v[j].y) + (v[j].z * v[j].z + v[j].w * v[j].w);
    const float rstd = 1.f / sqrtf(wave_sum(s) * (1.f / D) + EPS);
    unsigned* o4 = (unsigned*)orow + lane; u32x2* o8 = (u32x2*)orow16 + lane;
#pragma unroll
    for (int j = 0; j < 4; ++j) { unsigned w = __builtin_amdgcn_cvt_pk_fp8_f32(v[j].x * rstd, v[j].y * rstd, 0u, false); w = __builtin_amdgcn_cvt_pk_fp8_f32(v[j].z * rstd, v[j].w * rstd, w, true); o4[64 * j] = w;
        u32x2 w2; w2.x = pk2(v[j].x * rstd, v[j].y * rstd); w2.y = pk2(v[j].z * rstd, v[j].w * rstd); o8[64 * j] = w2; }
}
__device__ __forceinline__ void rms_rows(const float* x, bf16_t* xn16, unsigned char* xn8, int m0, int step, int lane) {
    if (m0 >= M) return;
    f32x4 cur[4], nxt[4];
#pragma unroll
    for (int j = 0; j < 4; ++j) cur[j] = ((const f32x4*)(x + (size_t)m0 * D) + lane)[64 * j];
    for (int m = m0; m < M; m += step) {
        const int mn = (m + step < M) ? m + step : m;
#pragma unroll
        for (int j = 0; j < 4; ++j) nxt[j] = ((const f32x4*)(x + (size_t)mn * D) + lane)[64 * j];
        rms_rows_emit(cur, xn16 + (size_t)m * D, xn8 + (size_t)m * D, lane);
#pragma unroll
        for (int j = 0; j < 4; ++j) cur[j] = nxt[j];
    }
}
__device__ __forceinline__ void rms_row_to_bf16(const float* xrow, bf16_t* orow, int lane) {
    const f32x4* xr = (const f32x4*)xrow + lane;
    f32x4 v[4]; float s = 0.f;
#pragma unroll
    for (int j = 0; j < 4; ++j) { v[j] = xr[64 * j]; s += (v[j].x * v[j].x + v[j].y * v[j].y) + (v[j].z * v[j].z + v[j].w * v[j].w); }
    const float rstd = 1.f / sqrtf(wave_sum(s) * (1.f / D) + EPS);
    u32x2* o8 = (u32x2*)orow + lane;
#pragma unroll
    for (int j = 0; j < 4; ++j) { u32x2 w; w.x = pk2(v[j].x * rstd, v[j].y * rstd); w.y = pk2(v[j].z * rstd, v[j].w * rstd); o8[64 * j] = w; }
}

__device__ __forceinline__ void prep_phase(const Ptrs& P, unsigned char* shm, int G, int bx) {
    int tid_l = threadIdx.x; asm volatile("" : "+v"(tid_l));
    const int lane = tid_l & 63; const int wave = __builtin_amdgcn_readfirstlane(tid_l >> 6);
    const int gw = bx * 8 + wave, NGW = G * 8;
    float* scr = (float*)(shm + wave * (64 * 33 * 4));
    unsigned char* ws = P.ws;
    constexpr int N_BF = 1024;
    constexpr int I_INB = (D / 64) * (N_BF / 32), I_IN8 = (D / 64) * ((INW - N_BF) / 32), I_IN = I_INB + I_IN8, I_Q = (D / 64) * (PQ / 32), I_OUT = (D / 64) * (D / 32), I_PA = (512 / 64) * (D / 32);
    constexpr int NIT = I_IN + I_Q + I_OUT + 2 * I_PA;
    for (int it = gw; it < NIT; it += NGW) {
        int r = it;
        if (r < I_INB) { transpose_item(P.w_in, D, N_BF, P.norm_mix, (bf16_t*)(ws + WS_WIN), scr, r, lane, 0, 0, INW); continue; } r -= I_INB;
        if (r < I_IN8) { transpose_item8(P.w_in + N_BF, D, INW - N_BF, INW, P.norm_mix, WIN_SCALE, ws + WS_WIN8, scr, r, lane); continue; } r -= I_IN8;
        if (r < I_Q) { transpose_item(P.w_query, D, PQ, P.norm_ffn, (bf16_t*)(ws + WS_WQ), scr, r, lane); continue; } r -= I_Q;
        if (r < I_OUT) { transpose_item(P.w_out, D, D, nullptr, (bf16_t*)(ws + WS_WOUT), scr, r, lane); continue; } r -= I_OUT;
        if (r < I_PA) { transpose_item(P.w_pa, 512, D, nullptr, (bf16_t*)(ws + WS_WPA), scr, r, lane, 1024, 0); continue; } r -= I_PA;
        transpose_item(P.w_pb, 512, D, nullptr, (bf16_t*)(ws + WS_WPA), scr, r, lane, 1024, 512);
    }
    rms_rows(P.x, (bf16_t*)(ws + WS_XN), ws + WS_XN8, gw, NGW, lane);
    const size_t gt = (size_t)bx * 512 + threadIdx.x, NT = (size_t)G * 512;
    for (size_t i = gt; i < (size_t)16 * 128 * 128 / 8; i += NT) cvt8(P.sub_keys, (bf16_t*)(ws + WS_SK), i);
    for (size_t i = gt; i < (size_t)SEQ * 8; i += NT) {
        const int pos = (int)(i >> 3), k = (int)(i & 7);
        const float inv = k == 0 ? 1.0f : k == 1 ? 0.19392274f : k == 2 ? 0.03760603f : k == 3 ? 0.0072926646f : k == 4 ? 0.0014142136f : k == 5 ? 0.0002742482f : k == 6 ? 5.3182957e-05f : 1.0313385e-05f;
        const float ang = (float)pos * inv;
        float sn, cs; sincosf(ang, &sn, &cs);
        float* t = (float*)(ws + WS_ROPE) + (size_t)pos * 16;
        t[k] = cs; t[8 + k] = sn;
    }
}
__device__ __forceinline__ void cvt_row_fp8(const f32x4 (&rv)[4], unsigned char* dst, float* inv_scale, int lane) {
    const f32x4 a = rv[0], b = rv[1], c = rv[2], d = rv[3];
    float m = fmaxf(fmaxf(fmaxf(fabsf(a.x), fabsf(a.y)), fmaxf(fabsf(a.z), fabsf(a.w))), fmaxf(fmaxf(fabsf(b.x), fabsf(b.y)), fmaxf(fabsf(b.z), fabsf(b.w))));
    m = fmaxf(m, fmaxf(fmaxf(fmaxf(fabsf(c.x), fabsf(c.y)), fmaxf(fabsf(c.z), fabsf(c.w))), fmaxf(fmaxf(fabsf(d.x), fabsf(d.y)), fmaxf(fabsf(d.z), fabsf(d.w)))));
#pragma unroll
    for (int o = 1; o < 64; o <<= 1) m = fmaxf(m, __shfl_xor(m, o));
    m = fmaxf(m, 1e-30f);
    const float sc = 256.f / m;
    u32x4 w;
    w.x = __builtin_amdgcn_cvt_pk_fp8_f32(a.x * sc, a.y * sc, 0u, false); w.x = __builtin_amdgcn_cvt_pk_fp8_f32(a.z * sc, a.w * sc, w.x, true);
    w.y = __builtin_amdgcn_cvt_pk_fp8_f32(b.x * sc, b.y * sc, 0u, false); w.y = __builtin_amdgcn_cvt_pk_fp8_f32(b.z * sc, b.w * sc, w.y, true);
    w.z = __builtin_amdgcn_cvt_pk_fp8_f32(c.x * sc, c.y * sc, 0u, false); w.z = __builtin_amdgcn_cvt_pk_fp8_f32(c.z * sc, c.w * sc, w.z, true);
    w.w = __builtin_amdgcn_cvt_pk_fp8_f32(d.x * sc, d.y * sc, 0u, false); w.w = __builtin_amdgcn_cvt_pk_fp8_f32(d.z * sc, d.w * sc, w.w, true);
    *(u32x4*)(dst + (size_t)(lane >> 5) * (NEXP * 512) + (lane & 31) * 16) = w;
    if (lane == 0) *inv_scale = m * (1.f / 256.f);
}
__device__ __forceinline__ unsigned nib4(float v, float sc) { const int q = (int)rintf(fminf(fmaxf(v * sc, -7.f), 7.f)); return (unsigned)q & 15u; }
__device__ __forceinline__ unsigned pack_i4x8(const f32x4& a, const f32x4& b, float sc) {
    return nib4(a.x, sc) | (nib4(a.y, sc) << 4) | (nib4(a.z, sc) << 8) | (nib4(a.w, sc) << 12) | (nib4(b.x, sc) << 16) | (nib4(b.y, sc) << 20) | (nib4(b.z, sc) << 24) | (nib4(b.w, sc) << 28);
}
__device__ __forceinline__ void cvt_row_i4(const f32x4 (&rv)[4], unsigned char* dst, float* inv_scale, int lane) {
    const f32x4 a = rv[0], b = rv[1], c = rv[2], d = rv[3];
    float ss = ((a.x * a.x + a.y * a.y) + (a.z * a.z + a.w * a.w)) + ((b.x * b.x + b.y * b.y) + (b.z * b.z + b.w * b.w));
    ss += ((c.x * c.x + c.y * c.y) + (c.z * c.z + c.w * c.w)) + ((d.x * d.x + d.y * d.y) + (d.z * d.z + d.w * d.w));
#pragma unroll
    for (int o = 1; o < 64; o <<= 1) ss += __shfl_xor(ss, o);
    const float rms = fmaxf(sqrtf(ss * (1.f / D)), 1e-30f);
    const float sc = 2.8f / rms;
    u32x2 w; w.x = pack_i4x8(a, b, sc); w.y = pack_i4x8(c, d, sc);
    *(u32x2*)(dst + (lane >> 5) * 256 + (lane & 15) * 16 + ((lane >> 4) & 1) * 8) = w;
    if (lane == 0) *inv_scale = rms * (2.5f / 7.f);
}
__device__ __forceinline__ unsigned pack_i8x4(float a, float b, float c, float d) {
    const int q0 = (int)rintf(a), q1 = (int)rintf(b), q2 = (int)rintf(c), q3 = (int)rintf(d);
    return (unsigned)(q0 & 0xff) | ((unsigned)(q1 & 0xff) << 8) | ((unsigned)(q2 & 0xff) << 16) | ((unsigned)q3 << 24);
}
__device__ __forceinline__ void cvt_row_i8(const f32x4 (&rv)[4], unsigned char* dst, float* inv_scale, int lane) {
    const f32x4 a = rv[0], b = rv[1], c = rv[2], d = rv[3];
    float m = fmaxf(fmaxf(fmaxf(fabsf(a.x), fabsf(a.y)), fmaxf(fabsf(a.z), fabsf(a.w))), fmaxf(fmaxf(fabsf(b.x), fabsf(b.y)), fmaxf(fabsf(b.z), fabsf(b.w))));
    m = fmaxf(m, fmaxf(fmaxf(fmaxf(fabsf(c.x), fabsf(c.y)), fmaxf(fabsf(c.z), fabsf(c.w))), fmaxf(fmaxf(fabsf(d.x), fabsf(d.y)), fmaxf(fabsf(d.z), fabsf(d.w)))));
#pragma unroll
    for (int o = 1; o < 64; o <<= 1) m = fmaxf(m, __shfl_xor(m, o));
    m = fmaxf(m, 1e-30f);
    const float sc = 127.f / m;
    u32x4 w;
    w.x = pack_i8x4(a.x * sc, a.y * sc, a.z * sc, a.w * sc); w.y = pack_i8x4(b.x * sc, b.y * sc, b.z * sc, b.w * sc);
    w.z = pack_i8x4(c.x * sc, c.y * sc, c.z * sc, c.w * sc); w.w = pack_i8x4(d.x * sc, d.y * sc, d.z * sc, d.w * sc);
    *(u32x4*)(dst + (size_t)(lane >> 5) * (NEXP * 512) + (lane & 31) * 16) = w;
    if (lane == 0) *inv_scale = m * (1.f / 127.f);
}
__device__ __forceinline__ void cvt_experts_phase(const Ptrs& P, int G, int bx) {
    int tid_l = threadIdx.x; asm volatile("" : "+v"(tid_l));
    const int lane = tid_l & 63; const int wave = __builtin_amdgcn_readfirstlane(tid_l >> 6);
    const int step = G * 8; int r = bx * 8 + wave;
    if (r >= 2 * NEXP) return;
    f32x4 cur[4], nxt[4];
    { const float* src = (r < NEXP ? P.peer_u + (size_t)r * D : P.peer_v + (size_t)(r - NEXP) * D);
#pragma unroll
      for (int j = 0; j < 4; ++j) cur[j] = ((const f32x4*)src + lane * 4)[j]; }
    for (; r < 2 * NEXP; r += step) {
        const int rn = (r + step < 2 * NEXP) ? r + step : r;
        const float* srcn = (rn < NEXP ? P.peer_u + (size_t)rn * D : P.peer_v + (size_t)(rn - NEXP) * D);
#pragma unroll
        for (int j = 0; j < 4; ++j) nxt[j] = ((const f32x4*)srcn + lane * 4)[j];
        if (r < NEXP) cvt_row_i8(cur, P.ws + WS_U + (size_t)r * 512, (float*)(P.ws + WS_SU) + r, lane);
        else { const int e = r - NEXP; cvt_row_fp8(cur, P.ws + WS_V + (size_t)e * 512, (float*)(P.ws + WS_SV) + e, lane); }
#pragma unroll
        for (int j = 0; j < 4; ++j) cur[j] = nxt[j];
    }
}

namespace pg8 {
#define PG8_LAS __attribute__((address_space(3)))
typedef unsigned short bf16_t;
typedef short bf16x8 __attribute__((ext_vector_type(8)));
typedef float f32x4 __attribute__((ext_vector_type(4)));
typedef unsigned u32x4 __attribute__((ext_vector_type(4)));
typedef int v8i_t __attribute__((ext_vector_type(8)));
constexpr int BM = 256, BK = 64, HALF = 128, HTB = HALF * BK * 2  , STAGE_BYTES = 8 * HTB, NXCD = 8, WGM = 4;

__host__ __device__ __forceinline__ int lds_byte(int r, int c) { const int st = (r >> 4) * 2 + (c >> 5), rr = r & 15, cc = c & 31, ob = rr * 64 + cc * 2; return st * 1024 + (ob ^ (((ob >> 9) & 1) << 5)); }
__host__ __device__ __forceinline__ void stage_rc(int b, int& R, int& C) { const int st = b / 1024, sb = b % 1024, swz = sb ^ (((sb >> 9) & 1) << 5); R = (st >> 1) * 16 + swz / 64; C = (st & 1) * 32 + (swz % 64) / 2; }
__host__ __device__ __forceinline__ int perm32(int rho) { const int n = rho >> 4, i = rho & 15; return 8 * (i >> 2) + 4 * n + (i & 3); }

struct Unit { int pm, pn; };
struct Gemm { const bf16_t* A; const bf16_t* Bt; int M, N, K, pad; };

struct StaticOrder {
    int nM, nN, nwg, G, c;
    __host__ __device__ void init(int M, int N, int G_, int c_) { nM = M / BM; nN = N / BM; nwg = nM * nN; G = G_; c = c_; }
    __host__ __device__ bool next(int i, Unit& u) const {
        const long L = (long)i * G + c; if (L >= nwg) return false;
        int wgid = (int)L; { const int q = nwg / NXCD, r = nwg % NXCD, xcd = wgid % NXCD, off = wgid / NXCD; wgid = (xcd < r ? xcd * (q + 1) : r * (q + 1) + (xcd - r) * q) + off; }
        const int nig = WGM * nN, gid = wgid / nig, fm = gid * WGM, gsz = (nM - fm) < WGM ? (nM - fm) : WGM;
        u.pm = fm + ((wgid % nig) % gsz); u.pn = (wgid % nig) / gsz; return true;
    }
    __device__ __forceinline__ void a_ready(const Unit&) const {}
    __device__ __forceinline__ void done(const Unit&) const {}
};
__device__ __forceinline__ unsigned cvt_pk_bf16(float lo, float hi) { unsigned r; asm volatile("v_cvt_pk_bf16_f32 %0, %1, %2" : "=v"(r) : "v"(lo), "v"(hi)); return r; }
typedef float f32x2 __attribute__((ext_vector_type(2)));

__device__ __forceinline__ float sigm(float x) { return __builtin_amdgcn_rcpf(1.f + __builtin_amdgcn_exp2f(-1.4426950408889634f * x)); }
struct EpiProj {
    static constexpr bool PERM = true, AFTER_DRAIN = false, MID = false;
    bf16_t* O; const float* rope; float osc; int pn0;
    __device__ __forceinline__ void operator()(const f32x4 (&acc)[2][2][4][2], const Unit& u, int wr, int wc, int fr_, int fq_) const {
        int fr = fr_, fq = fq_; asm volatile("" : "+v"(fr), "+v"(fq));
        const int pn = u.pn + pn0;
        const int row0 = u.pm * BM + wr * 64 + fr, col0 = pn * BM + wc * 32 + 8 * fq;
        const float sc = ((pn < 2 || pn == 6 || pn == 7) ? QSCALE : 1.f) * osc;
        const bool dorope = (pn < 4) && ((wc & 1) == 0);
#pragma unroll
        for (int ai = 0; ai < 2; ++ai)
#pragma unroll
            for (int m = 0; m < 4; ++m) { const int row = row0 + ai * HALF + m * 16; bf16_t* rowp = O + (size_t)row * INW + col0;
                f32x4 c4[2] = {{1.f, 1.f, 1.f, 1.f}, {1.f, 1.f, 1.f, 1.f}}, s4[2] = {{0.f, 0.f, 0.f, 0.f}, {0.f, 0.f, 0.f, 0.f}};
                if (dorope) { const float* rp = rope + (size_t)(row & (SEQ - 1)) * 16; c4[0] = *(const f32x4*)(rp); c4[1] = *(const f32x4*)(rp + 4); s4[0] = *(const f32x4*)(rp + 8); s4[1] = *(const f32x4*)(rp + 12); }
#pragma unroll
                for (int bj = 0; bj < 2; ++bj) { f32x4 v0 = acc[ai][bj][m][0], v1 = acc[ai][bj][m][1];
                    if (dorope) { f32x4 o0, o1;
#pragma unroll
                        for (int j = 0; j < 4; ++j) { o0[j] = __shfl_xor(v0[j], 16); o1[j] = __shfl_xor(v1[j], 16); }
                        if (fq == 0) { v0 = v0 * c4[0] - o0 * s4[0]; v1 = v1 * c4[1] - o1 * s4[1]; }
                        else if (fq == 1) { v0 = v0 * c4[0] + o0 * s4[0]; v1 = v1 * c4[1] + o1 * s4[1]; } }
                    v0 = v0 * sc; v1 = v1 * sc; u32x4 w; w.x = cvt_pk_bf16(v0[0], v0[1]); w.y = cvt_pk_bf16(v0[2], v0[3]); w.z = cvt_pk_bf16(v1[0], v1[1]); w.w = cvt_pk_bf16(v1[2], v1[3]);
                    *(u32x4*)(rowp + bj * HALF) = w; } }
    }
};
struct EpiGate2 {
    static constexpr bool PERM = true, AFTER_DRAIN = false, MID = true;
    const bf16_t* proj; bf16_t* O;
    __device__ __forceinline__ void mid(f32x4 (&acc)[2][2][4][2], const Unit& u, int wr, int wc, int fr, int fq) const {
        int row0 = u.pm * BM + wr * 64 + fr, col0 = u.pn * BM + wc * 32 + 8 * fq;
        asm volatile("" : "+v"(row0), "+v"(col0));
#pragma unroll
        for (int ai = 0; ai < 2; ++ai) {
            u32x4 gav[4][2], gbv[4][2];
#pragma unroll
            for (int m = 0; m < 4; ++m)
#pragma unroll
                for (int bj = 0; bj < 2; ++bj) { const bf16_t* gp = proj + (size_t)(row0 + ai * HALF + m * 16) * INW + col0 + bj * HALF; gav[m][bj] = *(const u32x4*)(gp + C_GA); gbv[m][bj] = *(const u32x4*)(gp + C_GB); }
#pragma unroll
            for (int m = 0; m < 4; ++m) {
#pragma unroll
                for (int bj = 0; bj < 2; ++bj) { const u32x4 ga = gav[m][bj], gb = gbv[m][bj];
                    const unsigned a_[4] = {ga.x, ga.y, ga.z, ga.w}, b_[4] = {gb.x, gb.y, gb.z, gb.w};
#pragma unroll
                    for (int q = 0; q < 4; ++q) {
                        const float r0 = (1.f + __builtin_amdgcn_exp2f(-1.4426950408889634f * bflo(b_[q]))) * __builtin_amdgcn_rcpf(1.f + __builtin_amdgcn_exp2f(-1.4426950408889634f * bflo(a_[q])));
                        const float r1 = (1.f + __builtin_amdgcn_exp2f(-1.4426950408889634f * bfhi(b_[q]))) * __builtin_amdgcn_rcpf(1.f + __builtin_amdgcn_exp2f(-1.4426950408889634f * bfhi(a_[q])));
                        acc[ai][bj][m][q >> 1][(q & 1) * 2] *= r0; acc[ai][bj][m][q >> 1][(q & 1) * 2 + 1] *= r1; } } }
            asm volatile("" ::: "memory"); }
    }
    __device__ __forceinline__ void operator()(const f32x4 (&acc)[2][2][4][2], const Unit& u, int wr, int wc, int fr_, int fq_) const {
        int fr = fr_, fq = fq_; asm volatile("" : "+v"(fr), "+v"(fq));
        const int row0 = u.pm * BM + wr * 64 + fr, col0 = u.pn * BM + wc * 32 + 8 * fq;
#pragma unroll
        for (int ai = 0; ai < 2; ++ai) {
            u32x4 gv[4][2];
#pragma unroll
            for (int m = 0; m < 4; ++m)
#pragma unroll
                for (int bj = 0; bj < 2; ++bj) gv[m][bj] = *(const u32x4*)(proj + (size_t)(row0 + ai * HALF + m * 16) * INW + C_GB + col0 + bj * HALF);
#pragma unroll
            for (int m = 0; m < 4; ++m) { const int row = row0 + ai * HALF + m * 16;
#pragma unroll
                for (int bj = 0; bj < 2; ++bj) { const int col = col0 + bj * HALF; const u32x4 g = gv[m][bj];
                    f32x4 v0 = acc[ai][bj][m][0], v1 = acc[ai][bj][m][1];
                    v0[0] *= sigm(bflo(g.x)); v0[1] *= sigm(bfhi(g.x)); v0[2] *= sigm(bflo(g.y)); v0[3] *= sigm(bfhi(g.y));
                    v1[0] *= sigm(bflo(g.z)); v1[1] *= sigm(bfhi(g.z)); v1[2] *= sigm(bflo(g.w)); v1[3] *= sigm(bfhi(g.w));
                    u32x4 w; w.x = cvt_pk_bf16(v0[0], v0[1]); w.y = cvt_pk_bf16(v0[2], v0[3]); w.z = cvt_pk_bf16(v1[0], v1[1]); w.w = cvt_pk_bf16(v1[2], v1[3]);
                    *(u32x4*)(O + (size_t)row * D + col) = w; } }
            asm volatile("" ::: "memory"); }
    }
};
struct EpiHout {
    static constexpr bool PERM = true, AFTER_DRAIN = false, MID = false;
    const float* x; float* H; bf16_t* HB; float* ssq16;
    __device__ __forceinline__ void operator()(const f32x4 (&acc)[2][2][4][2], const Unit& u, int wr, int wc, int fr_, int fq_) const {
        int fr = fr_, fq = fq_; asm volatile("" : "+v"(fr), "+v"(fq));
        const int row0 = u.pm * BM + wr * 64 + fr, col0 = u.pn * BM + wc * 32 + 8 * fq;
#pragma unroll
        for (int ai = 0; ai < 2; ++ai) {
            f32x4 xv[4][2][2];
#pragma unroll
            for (int m = 0; m < 4; ++m)
#pragma unroll
                for (int bj = 0; bj < 2; ++bj) { const float* xp = x + (size_t)(row0 + ai * HALF + m * 16) * D + col0 + bj * HALF; xv[m][bj][0] = *(const f32x4*)xp; xv[m][bj][1] = *(const f32x4*)(xp + 4); }
#pragma unroll
            for (int m = 0; m < 4; ++m) { const int row = row0 + ai * HALF + m * 16; float ss = 0.f;
#pragma unroll
                for (int bj = 0; bj < 2; ++bj) { const int col = col0 + bj * HALF;
                    const f32x4 v0 = acc[ai][bj][m][0] + xv[m][bj][0], v1 = acc[ai][bj][m][1] + xv[m][bj][1];
                    u32x4 w; w.x = cvt_pk_bf16(v0[0], v0[1]); w.y = cvt_pk_bf16(v0[2], v0[3]); w.z = cvt_pk_bf16(v1[0], v1[1]); w.w = cvt_pk_bf16(v1[2], v1[3]);
                    *(u32x4*)(HB + (size_t)row * D + col) = w;
                    ss += (v0[0] * v0[0] + v0[1] * v0[1]) + (v0[2] * v0[2] + v0[3] * v0[3]) + (v1[0] * v1[0] + v1[1] * v1[1]) + (v1[2] * v1[2] + v1[3] * v1[3]); }
                ss += __shfl_xor(ss, 16); ss += __shfl_xor(ss, 32);
                if (fq == 0) ssq16[(size_t)row * 16 + u.pn * 4 + wc] = ss; }
            asm volatile("" ::: "memory"); }
    }
};
struct EpiQ {
    static constexpr bool PERM = true, AFTER_DRAIN = false, MID = false;
    const float* ssq16; bf16_t* O;
    __device__ __forceinline__ void operator()(const f32x4 (&acc)[2][2][4][2], const Unit& u, int wr, int wc, int fr, int fq) const {
        const int row0 = u.pm * BM + wr * 64 + fr, col0 = u.pn * BM + wc * 32 + 8 * fq;
#pragma unroll
        for (int ai = 0; ai < 2; ++ai)
#pragma unroll
            for (int m = 0; m < 4; ++m) { const int row = row0 + ai * HALF + m * 16; const f32x4* sp = (const f32x4*)(ssq16 + (size_t)row * 16);
                const f32x4 a = sp[0], b = sp[1], c = sp[2], d = sp[3];
                const float tot = ((a[0] + a[1]) + (a[2] + a[3])) + ((b[0] + b[1]) + (b[2] + b[3])) + ((c[0] + c[1]) + (c[2] + c[3])) + ((d[0] + d[1]) + (d[2] + d[3]));
                const float rstd = 1.f / sqrtf(tot * (1.f / D) + EPS);
#pragma unroll
                for (int bj = 0; bj < 2; ++bj) { const f32x4 v0 = acc[ai][bj][m][0] * rstd, v1 = acc[ai][bj][m][1] * rstd;
                    u32x4 w; w.x = cvt_pk_bf16(v0[0], v0[1]); w.y = cvt_pk_bf16(v0[2], v0[3]); w.z = cvt_pk_bf16(v1[0], v1[1]); w.w = cvt_pk_bf16(v1[2], v1[3]);
                    *(u32x4*)(O + (size_t)row * PQ + col0 + bj * HALF) = w; } }
    }
};
template <class Epi, class Sched, bool ALIGN_EPI = false, bool SP2 = false, bool FP8 = false>
__device__ __forceinline__ void gemm_phase(PG8_LAS unsigned char* lds, const Gemm g, const Sched& S, const Epi& E) {
    int tid_l = threadIdx.x; asm volatile("" : "+v"(tid_l));
    const int tid = tid_l, wid = __builtin_amdgcn_readfirstlane(tid >> 6), lane = tid & 63, wr = wid >> 2, wc = wid & 3, fr = lane & 15, fq = lane >> 4;
    const int K = g.K, nt = K / BK;
    unsigned voffA[2], voffB[2];
#pragma unroll
    for (int i = 0; i < 2; ++i) { int R, C; stage_rc(tid * 16 + i * 8192, R, C); const int Rb = Epi::PERM ? ((R & ~31) + perm32(R & 31)) : R;
        voffA[i] = (unsigned)(R * K + C) * 2u; voffB[i] = (unsigned)(Rb * K + C) * 2u; }
    const size_t kstep = (size_t)(BK * 2);
    const size_t hstep = (size_t)HALF * K * 2;
    const size_t tstep = 2 * hstep;
    const unsigned ldsw = (unsigned)wid * 1024u;
    const int aoff = lds_byte(wr * 64 + fr, fq * 8), boff = lds_byte(wc * 32 + fr, fq * 8);
    const int aoffF0 = FP8 ? lds_byte(wr * 64 + fr, fq * 16) : 0, boffF0 = FP8 ? lds_byte(wc * 32 + fr, fq * 16) : 0;
#define PG8_SA(b, h) (((b) * 2 + (h)) * HTB)
#define PG8_SB(b, h) ((4 + (b) * 2 + (h)) * HTB)
#define PG8_STAGE(bufoff, gbase, voff) do { _Pragma("unroll") for (int _i = 0; _i < 2; ++_i) \
        __builtin_amdgcn_global_load_lds((const unsigned*)((const char*)(gbase) + (voff)[_i]), (PG8_LAS unsigned*)(lds + (bufoff) + ldsw + _i * 8192), 16, 0, 0); } while (0)
#define PG8_LDA(dst, b, h) do { if constexpr (FP8) { _Pragma("unroll") for (int m = 0; m < 4; ++m) { const u32x4 l_ = *(const PG8_LAS u32x4*)(lds + PG8_SA(b, h) + aoffF0 + m * 2048), h_ = *(const PG8_LAS u32x4*)(lds + PG8_SA(b, h) + aoffF0 + m * 2048 + 16); \
            dst##8[m] = (v8i_t){(int)l_.x, (int)l_.y, (int)l_.z, (int)l_.w, (int)h_.x, (int)h_.y, (int)h_.z, (int)h_.w}; } } \
        else { _Pragma("unroll") for (int m = 0; m < 4; ++m) _Pragma("unroll") for (int k = 0; k < 2; ++k) dst[m][k] = *(const PG8_LAS bf16x8*)(lds + PG8_SA(b, h) + aoff + m * 2048 + k * 1024); } } while (0)
#define PG8_LDB(dst, b, h) do { if constexpr (FP8) { _Pragma("unroll") for (int n = 0; n < 2; ++n) { const u32x4 l_ = *(const PG8_LAS u32x4*)(lds + PG8_SB(b, h) + boffF0 + n * 2048), h_ = *(const PG8_LAS u32x4*)(lds + PG8_SB(b, h) + boffF0 + n * 2048 + 16); \
            dst##8[n] = (v8i_t){(int)l_.x, (int)l_.y, (int)l_.z, (int)l_.w, (int)h_.x, (int)h_.y, (int)h_.z, (int)h_.w}; } } \
        else { _Pragma("unroll") for (int n = 0; n < 2; ++n) _Pragma("unroll") for (int k = 0; k < 2; ++k) dst[n][k] = *(const PG8_LAS bf16x8*)(lds + PG8_SB(b, h) + boff + n * 2048 + k * 1024); } } while (0)
#define PG8_MMA(ai, bj, At, Bt) do { __builtin_amdgcn_s_setprio(1); \
        if constexpr (FP8) { _Pragma("unroll") for (int m = 0; m < 4; ++m) _Pragma("unroll") for (int n = 0; n < 2; ++n) \
            asm volatile("v_mfma_scale_f32_16x16x128_f8f6f4 %0, %1, %2, %0, %3, %3 op_sel_hi:[0,0,0]" : "+v"(acc[ai][bj][m][n]) : "v"(Bt##8[n]), "v"(At##8[m]), "v"(mxone)); } \
        else { _Pragma("unroll") for (int m = 0; m < 4; ++m) _Pragma("unroll") for (int n = 0; n < 2; ++n) _Pragma("unroll") for (int k = 0; k < 2; ++k) \
            acc[ai][bj][m][n] = __builtin_amdgcn_mfma_f32_16x16x32_bf16(Bt[n][k], At[m][k], acc[ai][bj][m][n], 0, 0, 0); } \
        __builtin_amdgcn_s_setprio(0); } while (0)
#define PG8_WAIT_V(n) asm volatile("s_waitcnt vmcnt(" #n ")" ::: "memory")
#define PG8_WAIT_L(n) asm volatile("s_waitcnt lgkmcnt(" #n ")" ::: "memory")
#define PG8_BAR __builtin_amdgcn_s_barrier()
#define PG8_SCHED __builtin_amdgcn_sched_barrier(0)
    Unit cur, nxt; int ui = 0;
    if (!S.next(0, cur)) return;
    f32x4 acc[2][2][4][2];
#pragma unroll
    for (int a = 0; a < 2; ++a)
#pragma unroll
        for (int b = 0; b < 2; ++b)
#pragma unroll
            for (int m = 0; m < 4; ++m)
#pragma unroll
                for (int n = 0; n < 2; ++n) acc[a][b][m][n] = (f32x4){0.f, 0.f, 0.f, 0.f};
    bf16x8 At[4][2], B0[2][2], B1[2][2]; v8i_t At8[4], B08[2], B18[2];
    int mxone = 0x7F7F7F7F; asm volatile("" : "+v"(mxone));
    const char* cA = (const char*)g.A + (size_t)cur.pm * tstep; const char* cB = (const char*)g.Bt + (size_t)cur.pn * tstep;
    S.a_ready(cur);
    if constexpr (SP2) {
        PG8_STAGE(PG8_SB(0, 0), cB, voffB); PG8_STAGE(PG8_SB(0, 1), cB + hstep, voffB); PG8_STAGE(PG8_SA(0, 0), cA, voffA); PG8_STAGE(PG8_SA(0, 1), cA + hstep, voffA);
        if (wr == 1) PG8_BAR;
        PG8_WAIT_V(2); PG8_BAR;
        PG8_STAGE(PG8_SB(1, 0), cB + kstep, voffB); PG8_STAGE(PG8_SA(1, 0), cA + kstep, voffA); PG8_STAGE(PG8_SB(1, 1), cB + hstep + kstep, voffB);
        PG8_WAIT_V(6); PG8_BAR;
    } else {
        PG8_STAGE(PG8_SB(0, 0), cB, voffB); PG8_STAGE(PG8_SA(0, 0), cA, voffA); PG8_STAGE(PG8_SB(0, 1), cB + hstep, voffB); PG8_STAGE(PG8_SA(0, 1), cA + hstep, voffA);
        if (wr == 1) PG8_BAR;
        PG8_WAIT_V(4); PG8_BAR;
        PG8_STAGE(PG8_SB(1, 0), cB + kstep, voffB); PG8_STAGE(PG8_SA(1, 0), cA + kstep, voffA); PG8_STAGE(PG8_SB(1, 1), cB + hstep + kstep, voffB);
        PG8_WAIT_V(6); PG8_BAR;
    }
    for (;;) {
        const bool has_next = S.next(ui + 1, nxt);
        const char* nA = has_next ? (const char*)g.A + (size_t)nxt.pm * tstep : cA; const char* nB = has_next ? (const char*)g.Bt + (size_t)nxt.pn * tstep : cB;
#pragma unroll 1
        for (int t = 0; t < nt; t += 2) {
            if constexpr (Epi::MID) { if (t == nt / 2) E.mid(acc, cur, wr, wc, fr, fq); }
            const bool last = (t == nt - 2);
            const char* a1 = cA + (size_t)(t + 1) * kstep;
            const char* a2 = last ? nA : cA + (size_t)(t + 2) * kstep; const char* b2 = last ? nB : cB + (size_t)(t + 2) * kstep;
            const char* a3 = a2 + kstep; const char* b3 = b2 + kstep;
            if (last && has_next) S.a_ready(nxt);
            if constexpr (SP2) {
            PG8_LDB(B0, 0, 0); PG8_LDB(B1, 0, 1); PG8_SCHED; PG8_LDA(At, 0, 0); PG8_STAGE(PG8_SA(1, 1), a1 + hstep, voffA);
            PG8_WAIT_V(8); PG8_WAIT_L(0); PG8_BAR; PG8_MMA(0, 0, At, B0); PG8_MMA(0, 1, At, B1); PG8_BAR; PG8_SCHED;
            PG8_LDA(At, 0, 1); PG8_STAGE(PG8_SB(0, 0), b2, voffB); PG8_STAGE(PG8_SB(0, 1), b2 + hstep, voffB); PG8_STAGE(PG8_SA(0, 0), a2, voffA);
            PG8_WAIT_V(8); PG8_WAIT_L(0); PG8_BAR; PG8_MMA(1, 0, At, B0); PG8_MMA(1, 1, At, B1); PG8_BAR; PG8_SCHED;
            PG8_LDB(B0, 1, 0); PG8_LDB(B1, 1, 1); PG8_SCHED; PG8_LDA(At, 1, 0); PG8_STAGE(PG8_SA(0, 1), a2 + hstep, voffA);
            PG8_WAIT_V(8); PG8_WAIT_L(0); PG8_BAR; PG8_MMA(0, 0, At, B0); PG8_MMA(0, 1, At, B1); PG8_BAR; PG8_SCHED;
            PG8_LDA(At, 1, 1); PG8_STAGE(PG8_SB(1, 0), b3, voffB); PG8_STAGE(PG8_SB(1, 1), b3 + hstep, voffB); PG8_STAGE(PG8_SA(1, 0), a3, voffA);
            PG8_WAIT_V(8); PG8_WAIT_L(0); PG8_BAR; PG8_MMA(1, 0, At, B0); PG8_MMA(1, 1, At, B1); PG8_BAR; PG8_SCHED;
            } else {
            PG8_LDB(B0, 0, 0); PG8_SCHED; PG8_LDA(At, 0, 0); PG8_STAGE(PG8_SA(1, 1), a1 + hstep, voffA);
            PG8_WAIT_L(8); PG8_BAR; PG8_WAIT_L(0); PG8_MMA(0, 0, At, B0); PG8_BAR; PG8_SCHED;
            PG8_LDB(B1, 0, 1); PG8_STAGE(PG8_SB(0, 0), b2, voffB);
            PG8_BAR; PG8_WAIT_L(0); PG8_MMA(0, 1, At, B1); PG8_BAR;
            PG8_LDA(At, 0, 1); PG8_STAGE(PG8_SA(0, 0), a2, voffA);
            PG8_BAR; PG8_WAIT_L(0); PG8_MMA(1, 0, At, B0); PG8_BAR; PG8_SCHED;
            PG8_STAGE(PG8_SB(0, 1), b2 + hstep, voffB);
            PG8_WAIT_V(6); PG8_BAR; PG8_MMA(1, 1, At, B1); PG8_BAR;
            PG8_LDB(B0, 1, 0); PG8_SCHED; PG8_LDA(At, 1, 0); PG8_STAGE(PG8_SA(0, 1), a2 + hstep, voffA);
            PG8_WAIT_L(8); PG8_BAR; PG8_WAIT_L(0); PG8_MMA(0, 0, At, B0); PG8_BAR; PG8_SCHED;
            PG8_LDB(B1, 1, 1); PG8_STAGE(PG8_SB(1, 0), b3, voffB);
            PG8_BAR; PG8_WAIT_L(0); PG8_MMA(0, 1, At, B1); PG8_BAR;
            PG8_LDA(At, 1, 1); PG8_STAGE(PG8_SA(1, 0), a3, voffA);
            PG8_BAR; PG8_WAIT_L(0); PG8_MMA(1, 0, At, B0); PG8_BAR; PG8_SCHED;
            PG8_STAGE(PG8_SB(1, 1), b3 + hstep, voffB);
            PG8_WAIT_V(6); PG8_BAR; PG8_MMA(1, 1, At, B1); PG8_BAR;
            }
        }
        if constexpr (ALIGN_EPI) { if (wr == 0) PG8_BAR; }
        if constexpr (FP8) { asm volatile("s_nop 15\n\ts_nop 7" ::: "memory"); PG8_SCHED; }
        if constexpr (!Epi::AFTER_DRAIN) { E(acc, cur, wr, wc, fr, fq); S.done(cur); }
        if (!has_next) break;
#pragma unroll
        for (int a = 0; a < 2; ++a)
#pragma unroll
            for (int b = 0; b < 2; ++b)
#pragma unroll
                for (int m = 0; m < 4; ++m)
#pragma unroll
                    for (int n = 0; n < 2; ++n) acc[a][b][m][n] = (f32x4){0.f, 0.f, 0.f, 0.f};
        cur = nxt; cA = nA; cB = nB; ++ui;
        if constexpr (ALIGN_EPI) { if (wr == 1) PG8_BAR; }
    }
    PG8_WAIT_V(0);
    if constexpr (!ALIGN_EPI) { if (wr == 0) PG8_BAR; }
    PG8_BAR;
    if constexpr (Epi::AFTER_DRAIN) { E.fused(acc, cur, wr, wc, fr, fq, lds, wid, lane); S.done(cur); }
#undef PG8_SA
#undef PG8_SB
#undef PG8_STAGE
#undef PG8_LDA
#undef PG8_LDB
#undef PG8_MMA
#undef PG8_WAIT_V
#undef PG8_WAIT_L
#undef PG8_BAR
#undef PG8_SCHED
}
}

__device__ __forceinline__ float lambda_full(const Ptrs& P) {
    float a = 0.f, b = 0.f;
    for (int i = 0; i < 64; ++i) { a += P.lq1[i] * P.lk1[i]; b += P.lq2[i] * P.lk2[i]; }
    return __expf(a) - __expf(b) + 0.2f;
}

namespace att {
typedef short bf16x8 __attribute__((ext_vector_type(8)));
typedef short s16x4 __attribute__((ext_vector_type(4)));
typedef float f32x16 __attribute__((ext_vector_type(16)));
typedef float f32x2_t __attribute__((ext_vector_type(2)));
typedef __attribute__((address_space(3))) const char* lds_cptr;
typedef __attribute__((address_space(3))) char* lds_ptr;
__device__ __forceinline__ int crow(int r, int hi) { return (r & 3) + 8 * (r >> 2) + 4 * hi; }
__device__ __forceinline__ void glds16(const void* gsrc, unsigned lds_dst) { unsigned keep;
    asm volatile("s_mov_b32 %0, m0\n\ts_mov_b32 m0, %2\n\ts_nop 0\n\tglobal_load_lds_dwordx4 %1, off\n\ts_mov_b32 m0, %0" : "=&s"(keep) : "v"(gsrc), "s"(lds_dst) : "memory"); }
__device__ __forceinline__ unsigned cvtpk(float lo, float hi) { f32x2_t v = {lo, hi}; bf16x2_t b = __builtin_convertvector(v, bf16x2_t); return __builtin_bit_cast(unsigned, b); }
#define ATT_WAIT_BAR(N) asm volatile("s_waitcnt vmcnt(" #N ") lgkmcnt(0)\n\ts_barrier" ::: "memory")
#define ATT_LDSWAIT() asm volatile("s_waitcnt lgkmcnt(0)" ::: "memory")
#define ATT_SBAR() __builtin_amdgcn_sched_barrier(0)
template <bool REL> __device__ __forceinline__ void qkt(f32x16& p0, f32x16& p1, lds_cptr Kslot, const bf16x8* qr, const f32x16& negm, int r32, int hi) {
    lds_cptr kb = Kslot + hi * 1024 + r32 * 16;
#pragma unroll
    for (int d0 = 0; d0 < 4; ++d0) {
        const bf16x8 b0 = *(const __attribute__((address_space(3))) bf16x8*)(kb + d0 * 2048);
        const bf16x8 b1 = *(const __attribute__((address_space(3))) bf16x8*)(kb + d0 * 2048 + 512);
        if (d0 == 0) { if (REL) { p0 = __builtin_amdgcn_mfma_f32_32x32x16_bf16(b0, qr[0], negm, 0, 0, 0); p1 = __builtin_amdgcn_mfma_f32_32x32x16_bf16(b1, qr[0], negm, 0, 0, 0); }
                       else { p0 = __builtin_amdgcn_mfma_f32_32x32x16_bf16(b0, qr[0], f32x16{}, 0, 0, 0); p1 = __builtin_amdgcn_mfma_f32_32x32x16_bf16(b1, qr[0], f32x16{}, 0, 0, 0); } }
        else { p0 = __builtin_amdgcn_mfma_f32_32x32x16_bf16(b0, qr[d0], p0, 0, 0, 0); p1 = __builtin_amdgcn_mfma_f32_32x32x16_bf16(b1, qr[d0], p1, 0, 0, 0); } }
}
__device__ __forceinline__ float rowmax32(const f32x16& p0, const f32x16& p1) {
    float a = fmaxf(p0[0], p1[0]);
#pragma unroll
    for (int r = 1; r < 16; ++r) a = fmaxf(a, fmaxf(p0[r], p1[r]));
    auto rr = __builtin_amdgcn_permlane32_swap(__float_as_uint(a), __float_as_uint(a), false, false);
    return fmaxf(__uint_as_float(rr[0]), __uint_as_float(rr[1]));
}
__device__ __forceinline__ float halfsum(float a) { auto rr = __builtin_amdgcn_permlane32_swap(__float_as_uint(a), __float_as_uint(a), false, false); return __uint_as_float(rr[0]) + __uint_as_float(rr[1]); }
#define ATT_VREAD(lo, hi, d0) do { _Pragma("unroll") for (int ks = 0; ks < 4; ++ks) { \
        asm volatile("ds_read_b64_tr_b16 %0,%1 offset:%c2" : "=&v"(lo[ks]) : "v"(vb), "i"((d0) * 4096 + ks * 1024) : "memory"); \
        asm volatile("ds_read_b64_tr_b16 %0,%1 offset:%c2" : "=&v"(hi[ks]) : "v"(vb), "i"((d0) * 4096 + ks * 1024 + 512) : "memory"); } } while (0)
#define ATT_PK(lo, hi, k) (bf16x8){lo[k][0], lo[k][1], lo[k][2], lo[k][3], hi[k][0], hi[k][1], hi[k][2], hi[k][3]}
#define ATT_PVMMA(lo, hi, d0) do { \
        o[d0] = __builtin_amdgcn_mfma_f32_32x32x16_bf16(pa0, ATT_PK(lo, hi, 0), o[d0], 0, 0, 0); o[d0] = __builtin_amdgcn_mfma_f32_32x32x16_bf16(pa1, ATT_PK(lo, hi, 1), o[d0], 0, 0, 0); \
        o[d0] = __builtin_amdgcn_mfma_f32_32x32x16_bf16(pa2, ATT_PK(lo, hi, 2), o[d0], 0, 0, 0); o[d0] = __builtin_amdgcn_mfma_f32_32x32x16_bf16(pa3, ATT_PK(lo, hi, 3), o[d0], 0, 0, 0); } while (0)
template <int ND0> __device__ __forceinline__ void pv(f32x16* o, int vb, bf16x8 pa0, bf16x8 pa1, bf16x8 pa2, bf16x8 pa3) {
    s16x4 loA[4], hiA[4], loB[4], hiB[4];
    ATT_VREAD(loA, hiA, 0);
#pragma unroll
    for (int d0 = 0; d0 < ND0; d0 += 2) {
        if (d0 + 1 < ND0) { ATT_VREAD(loB, hiB, d0 + 1); asm volatile("s_waitcnt lgkmcnt(8)" ::: "memory"); } else { asm volatile("s_waitcnt lgkmcnt(0)" ::: "memory"); }
        ATT_SBAR();
        ATT_PVMMA(loA, hiA, d0);
        if (d0 + 1 < ND0) {
            if (d0 + 2 < ND0) { ATT_VREAD(loA, hiA, d0 + 2); asm volatile("s_waitcnt lgkmcnt(8)" ::: "memory"); } else { asm volatile("s_waitcnt lgkmcnt(0)" ::: "memory"); }
            ATT_SBAR();
            ATT_PVMMA(loB, hiB, d0 + 1);
        }
    }
}
#undef ATT_VREAD
#undef ATT_PVMMA
#undef ATT_PK
template <int DEAD> __device__ __forceinline__ constexpr bool live0(int r) { return DEAD != 2 || r >= 12; }
template <int DEAD> __device__ __forceinline__ constexpr bool live1(int r) { return DEAD != 1 || r < 4; }
template <int ND0, int THR, bool REL, int DEAD = 0> __device__ __forceinline__ void softmax_tile(f32x16& p0, f32x16& p1, float& mrun, float& lsum, f32x16& negm, bool first, f32x16* o, __attribute__((address_space(3))) float* wsf, int r32, int hi,
                                                                   u32x4& pw0, u32x4& pw1, u32x4& pw2, u32x4& pw3) {
    float rm;
    if (DEAD == 0) rm = rowmax32(p0, p1);
    else { float a = -3e38f;
#pragma unroll
        for (int r = 0; r < 16; ++r) { if (live0<DEAD>(r)) a = fmaxf(a, p0[r]); if (live1<DEAD>(r)) a = fmaxf(a, p1[r]); }
        auto rr = __builtin_amdgcn_permlane32_swap(__float_as_uint(a), __float_as_uint(a), false, false); rm = fmaxf(__uint_as_float(rr[0]), __uint_as_float(rr[1])); }
    if (!REL) rm -= mrun;
    if (first) {
        mrun = REL ? rm : mrun + rm;
        if (REL) {
#pragma unroll
            for (int r = 0; r < 16; ++r) { if (live0<DEAD>(r)) p0[r] -= rm; if (live1<DEAD>(r)) p1[r] -= rm; negm[r] = -mrun; } }
    } else if (__any(rm > (float)THR)) {
        const float dl = fmaxf(rm, 0.f), alpha = __builtin_amdgcn_exp2f(-dl); lsum *= alpha; mrun += dl;
        if (REL) {
#pragma unroll
            for (int r = 0; r < 16; ++r) { if (live0<DEAD>(r)) p0[r] -= dl; if (live1<DEAD>(r)) p1[r] -= dl; negm[r] = -mrun; } }
        if (hi == 0) wsf[r32] = alpha;
        ATT_LDSWAIT();
#pragma unroll
        for (int g = 0; g < 4; ++g) { const f32x4 a4 = *(const __attribute__((address_space(3))) f32x4*)(wsf + 8 * g + 4 * hi);
#pragma unroll
            for (int d0 = 0; d0 < ND0; ++d0) { o[d0][4 * g + 0] *= a4[0]; o[d0][4 * g + 1] *= a4[1]; o[d0][4 * g + 2] *= a4[2]; o[d0][4 * g + 3] *= a4[3]; } }
        ATT_LDSWAIT();
    }
    float s = 0.f;
#pragma unroll
    for (int r = 0; r < 16; ++r) {
        if (live0<DEAD>(r)) { p0[r] = __builtin_amdgcn_exp2f(REL ? p0[r] : p0[r] - mrun); s += p0[r]; } else p0[r] = 0.f;
        if (live1<DEAD>(r)) { p1[r] = __builtin_amdgcn_exp2f(REL ? p1[r] : p1[r] - mrun); s += p1[r]; } else p1[r] = 0.f; }
    lsum += s;
    pw0 = (u32x4){cvtpk(p0[0], p0[1]), cvtpk(p0[2], p0[3]), cvtpk(p0[4], p0[5]), cvtpk(p0[6], p0[7])};
    pw1 = (u32x4){cvtpk(p0[8], p0[9]), cvtpk(p0[10], p0[11]), cvtpk(p0[12], p0[13]), cvtpk(p0[14], p0[15])};
    pw2 = (u32x4){cvtpk(p1[0], p1[1]), cvtpk(p1[2], p1[3]), cvtpk(p1[4], p1[5]), cvtpk(p1[6], p1[7])};
    pw3 = (u32x4){cvtpk(p1[8], p1[9]), cvtpk(p1[10], p1[11]), cvtpk(p1[12], p1[13]), cvtpk(p1[14], p1[15])};
}

constexpr int A_SLOTK = 8192, A_SLOTV = 16384, A_NS = 3, A_NSV = 4;
constexpr int A_LDS_K = 0, A_LDS_V = A_NS * A_SLOTK, A_LDS_WS = A_LDS_V + A_NSV * A_SLOTV, A_LDS_ST = A_LDS_WS + 8 * 256, A_LDS_BYTES = A_LDS_ST + 8 * 8192;
__device__ __forceinline__ void attn_a_unit(int b, int h, int qb, const bf16_t* proj, bf16_t* ya, const float* subln, float lam, unsigned char* shm) {
    int tid_l = threadIdx.x; asm volatile("" : "+v"(tid_l));
    const int tid = tid_l, lane = tid & 63, r32 = lane & 31, hi = lane >> 5; const int wid = __builtin_amdgcn_readfirstlane(tid >> 6);
    const size_t rowbase = (size_t)b * SEQ; const int q0 = qb * 256;
    constexpr int NT = SEQ / 64;
    const unsigned lds0 = (unsigned)(uintptr_t)shm;
    const lds_cptr shm3 = (lds_cptr)shm;
    __attribute__((address_space(3))) float* wsf = (__attribute__((address_space(3))) float*)((lds_ptr)shm + A_LDS_WS) + wid * 64;
    const int vb0 = (int)(lds0 + A_LDS_V) + ((lane >> 4) & 1) * 32 + (lane & 3) * 8 + (4 * hi + ((lane & 15) >> 2)) * 64;
    __attribute__((address_space(3))) bf16_t* stg = (__attribute__((address_space(3))) bf16_t*)((lds_ptr)shm + A_LDS_ST) + wid * 4096;
    for (int mp = 0; mp < 2; ++mp) {
        const bf16_t* Kh = proj + rowbase * INW + C_KA + h * 128 + mp * 64;
        const bf16_t* Vh = proj + rowbase * INW + C_VA + h * 128;
        const bf16_t* Qw = proj + (rowbase + q0 + wid * 32) * INW + C_QA + h * 128 + mp * 64;
        const int pA = 2 * wid, pB = 2 * wid + 1;
        const unsigned kdst = lds0 + A_LDS_K + wid * 1024, vdstA = lds0 + A_LDS_V + pA * 1024, vdstB = lds0 + A_LDS_V + pB * 1024;
#define A_DMA(t, slot, vsl) do { int ln_ = lane; asm volatile("" : "+v"(ln_)); \
        const bf16_t* ksrc_ = Kh + (size_t)((t) * 64 + ln_) * INW + wid * 8; \
        const bf16_t* vsrcA_ = Vh + (size_t)((t) * 64 + 16 * (pA & 3) + (ln_ >> 2)) * INW + (pA >> 2) * 32 + (ln_ & 3) * 8; \
        const bf16_t* vsrcB_ = Vh + (size_t)((t) * 64 + 16 * (pB & 3) + (ln_ >> 2)) * INW + (pB >> 2) * 32 + (ln_ & 3) * 8; \
        glds16(ksrc_, (unsigned)__builtin_amdgcn_readfirstlane(kdst + (slot) * A_SLOTK)); \
        glds16(vsrcA_, (unsigned)__builtin_amdgcn_readfirstlane(vdstA + (vsl) * A_SLOTV)); \
        glds16(vsrcB_, (unsigned)__builtin_amdgcn_readfirstlane(vdstB + (vsl) * A_SLOTV)); } while (0)
        A_DMA(0, 0, 0); A_DMA(1, 1, 1);
        bf16x8 qr[4];
#pragma unroll
        for (int d0 = 0; d0 < 4; ++d0) qr[d0] = *(const bf16x8*)(Qw + (size_t)r32 * INW + d0 * 16 + hi * 8);
        f32x16 o[4]; o[0] = f32x16{}; o[1] = f32x16{}; o[2] = f32x16{}; o[3] = f32x16{};
        float mrun = 0.f, lsum = 0.f; f32x16 negm = f32x16{};
        int slot = 0, slot2 = 2, vslot = 0, vslot2 = 2, vprev = 3;
        const bool late = wid >= 4;
        u32x4 pw0 = {}, pw1 = {}, pw2 = {}, pw3 = {};
        for (int t = 0; t < NT; ++t) {
            if (t + 1 < NT) { ATT_WAIT_BAR(3); } else { ATT_WAIT_BAR(0); }
            if (t + 2 < NT) A_DMA(t + 2, slot2, vslot2);
            if (late && t > 0) pv<4>(o, vb0 + vprev * A_SLOTV, __builtin_bit_cast(bf16x8, pw0), __builtin_bit_cast(bf16x8, pw1), __builtin_bit_cast(bf16x8, pw2), __builtin_bit_cast(bf16x8, pw3));
            f32x16 p0, p1;
            qkt<false>(p0, p1, shm3 + A_LDS_K + slot * A_SLOTK, qr, negm, r32, hi);
            softmax_tile<4, 8, false>(p0, p1, mrun, lsum, negm, t == 0, o, wsf, r32, hi, pw0, pw1, pw2, pw3);
            if (!late) pv<4>(o, vb0 + vslot * A_SLOTV, __builtin_bit_cast(bf16x8, pw0), __builtin_bit_cast(bf16x8, pw1), __builtin_bit_cast(bf16x8, pw2), __builtin_bit_cast(bf16x8, pw3));
            slot = (slot == 2) ? 0 : slot + 1; slot2 = (slot2 == 2) ? 0 : slot2 + 1;
            vprev = vslot; vslot = (vslot + 1) & 3; vslot2 = (vslot2 + 1) & 3;
        }
        if (late) pv<4>(o, vb0 + vprev * A_SLOTV, __builtin_bit_cast(bf16x8, pw0), __builtin_bit_cast(bf16x8, pw1), __builtin_bit_cast(bf16x8, pw2), __builtin_bit_cast(bf16x8, pw3));
#undef A_DMA
        const float lt = halfsum(lsum);
        if (hi == 0) wsf[32 + r32] = lt;
        ATT_LDSWAIT();
        float rli[16];
#pragma unroll
        for (int g = 0; g < 4; ++g) { const f32x4 l4 = *(const __attribute__((address_space(3))) f32x4*)(wsf + 32 + 8 * g + 4 * hi);
            rli[4 * g + 0] = __builtin_amdgcn_rcpf(l4[0]); rli[4 * g + 1] = __builtin_amdgcn_rcpf(l4[1]); rli[4 * g + 2] = __builtin_amdgcn_rcpf(l4[2]); rli[4 * g + 3] = __builtin_amdgcn_rcpf(l4[3]); }
        ATT_LDSWAIT();
        if (mp == 0) {
#pragma unroll
            for (int d0 = 0; d0 < 4; ++d0)
#pragma unroll
                for (int r = 0; r < 16; ++r) stg[crow(r, hi) * 128 + d0 * 32 + r32] = (bf16_t)f2bf(o[d0][r] * rli[r]);
            asm volatile("s_waitcnt lgkmcnt(0)\n\ts_barrier" ::: "memory");
        } else {
            float ss[16];
#pragma unroll
            for (int r = 0; r < 16; ++r) ss[r] = 0.f;
#pragma unroll
            for (int d0 = 0; d0 < 4; ++d0)
#pragma unroll
                for (int r = 0; r < 16; ++r) { const float a = bf2f(stg[crow(r, hi) * 128 + d0 * 32 + r32]); const float y = a - lam * o[d0][r] * rli[r]; o[d0][r] = y; ss[r] += y * y; }
#pragma unroll
            for (int r = 0; r < 16; ++r) { float v = ss[r]; v += __shfl_xor(v, 1); v += __shfl_xor(v, 2); v += __shfl_xor(v, 4); v += __shfl_xor(v, 8); v += __shfl_xor(v, 16);
                ss[r] = 0.8f / sqrtf(v * (1.f / 128.f) + EPS); }
            ATT_LDSWAIT();
#pragma unroll
            for (int d0 = 0; d0 < 4; ++d0) { const float gsub = subln[d0 * 32 + r32];
#pragma unroll
                for (int r = 0; r < 16; ++r) stg[crow(r, hi) * 128 + d0 * 32 + r32] = (bf16_t)f2bf(o[d0][r] * ss[r] * gsub); }
            ATT_LDSWAIT();
            bf16_t* Yw = ya + (rowbase + q0 + wid * 32) * 1024 + h * 128;
#pragma unroll
            for (int i = 0; i < 8; ++i) { const int row = i * 4 + (lane >> 4), ch = lane & 15; const u32x4 v = *(const __attribute__((address_space(3))) u32x4*)(stg + row * 128 + ch * 8); *(u32x4*)(Yw + (size_t)row * 1024 + ch * 8) = v; }
            asm volatile("s_waitcnt lgkmcnt(0)\n\ts_barrier" ::: "memory");
        }
    }
}

template <int DEAD> __device__ __forceinline__ void na_tile(lds_cptr Kslot, int vb, const bf16x8* qr, const __attribute__((address_space(3))) float* bp, const float (&fm0)[16], const float (&fm1)[16],
                                                        float& mrun, float& lsum, f32x16& negm, bool first, f32x16* o, __attribute__((address_space(3))) float* wsf, int r32, int hi) {
    f32x16 p0, p1; u32x4 pw0, pw1, pw2, pw3;
    qkt<true>(p0, p1, Kslot, qr, negm, r32, hi);
#pragma unroll
    for (int rr = 0; rr < 16; ++rr) { const int jj = (rr & 3) + 8 * (rr >> 2);
        if (live0<DEAD>(rr)) p0[rr] += bp[jj] + fm0[rr];
        if (live1<DEAD>(rr)) p1[rr] += bp[jj + 32] + fm1[rr]; }
    softmax_tile<2, 8, true, DEAD>(p0, p1, mrun, lsum, negm, first, o, wsf, r32, hi, pw0, pw1, pw2, pw3);
    pv<2>(o, vb, __builtin_bit_cast(bf16x8, pw0), __builtin_bit_cast(bf16x8, pw1), __builtin_bit_cast(bf16x8, pw2), __builtin_bit_cast(bf16x8, pw3));
}
constexpr int B_SLOT = 8192, B_NS = 6, B_PF = 5;
constexpr int B_LDS_K = 0, B_LDS_V = B_NS * B_SLOT, B_LDS_WS = 2 * B_NS * B_SLOT, B_LDS_BIAS = B_LDS_WS + 8 * 256, B_LDS_ST = B_LDS_BIAS + 2560, B_LDS_BYTES = B_LDS_ST + 8 * 4096;
__device__ __forceinline__ void attn_b_unit(int b, int h, int rg, const bf16_t* proj, bf16_t* yb, const float* rpb, unsigned char* shm) {
    int tid_l = threadIdx.x; asm volatile("" : "+v"(tid_l));
    const int tid = tid_l, lane = tid & 63, r32 = lane & 31, hi = lane >> 5; const int wid = __builtin_amdgcn_readfirstlane(tid >> 6);
    const size_t rowbase = (size_t)b * SEQ;
    const int r = 4 * rg + (wid >> 1), c0 = 32 * (wid & 1);
    int rs = r - 4; rs = rs < 0 ? 0 : (rs > 24 ? 24 : rs);
    int rmin = 4 * rg - 4; rmin = rmin < 0 ? 0 : (rmin > 24 ? 24 : rmin);
    int rmaxs = 4 * rg + 3 - 4; rmaxs = rmaxs < 0 ? 0 : (rmaxs > 24 ? 24 : rmaxs);
    const int ntile = rmaxs + 8 - rmin;
    const unsigned lds0 = (unsigned)(uintptr_t)shm;
    const lds_cptr shm3 = (lds_cptr)shm;
    __attribute__((address_space(3))) float* wsf = (__attribute__((address_space(3))) float*)((lds_ptr)shm + B_LDS_WS) + wid * 64;
    __attribute__((address_space(3))) float* bias = (__attribute__((address_space(3))) float*)((lds_ptr)shm + B_LDS_BIAS) + 64;
    __attribute__((address_space(3))) bf16_t* stg = (__attribute__((address_space(3))) bf16_t*)((lds_ptr)shm + B_LDS_ST) + wid * 2048;
    const int vb0 = (int)(lds0 + B_LDS_V) + ((lane >> 4) & 1) * 32 + (lane & 3) * 8 + (4 * hi + ((lane & 15) >> 2)) * 64;
    for (int i = tid; i < 640; i += 512) { const int e = i - 64, ri = e >> 5, cj = e & 31; bias[e] = (e >= 0 && e < 480 && cj < 31) ? rpb[(h * 15 + ri) * 31 + cj] * LOG2E : 0.f; }
    const bf16_t* Kh = proj + rowbase * INW + C_KB + h * 64;
    const bf16_t* Vh = proj + rowbase * INW + C_VB + h * 64;
    const bf16_t* Qw = proj + (rowbase + r * 64 + c0) * INW + C_QB + h * 64;
    const unsigned kdst = lds0 + B_LDS_K + wid * 1024, vdst = lds0 + B_LDS_V + wid * 1024;
#define B_DMA(t, slot) do { int ln_ = lane; asm volatile("" : "+v"(ln_)); \
    const bf16_t* ksrc_ = Kh + (size_t)((rmin + (t)) * 64 + ln_) * INW + wid * 8; \
    const bf16_t* vsrc_ = Vh + (size_t)((rmin + (t)) * 64 + 16 * (wid & 3) + (ln_ >> 2)) * INW + (wid >> 2) * 32 + (ln_ & 3) * 8; \
    glds16(ksrc_, (unsigned)__builtin_amdgcn_readfirstlane(kdst + (slot) * B_SLOT)); \
    glds16(vsrc_, (unsigned)__builtin_amdgcn_readfirstlane(vdst + (slot) * B_SLOT)); } while (0)
#pragma unroll
    for (int t = 0; t < 4; ++t) B_DMA(t, t);
    bf16x8 qr[4];
#pragma unroll
    for (int d0 = 0; d0 < 4; ++d0) qr[d0] = *(const bf16x8*)(Qw + (size_t)r32 * INW + d0 * 16 + hi * 8);
    f32x16 o[2]; o[0] = f32x16{}; o[1] = f32x16{};
    float mrun = 0.f, lsum = 0.f; f32x16 negm = f32x16{}; bool first = true;
    const int c = c0 + r32; int cs = c - 8; cs = cs < 0 ? 0 : (cs > 48 ? 48 : cs);
    float fm0[16], fm1[16];
#pragma unroll
    for (int rr = 0; rr < 16; ++rr) { const int j0 = crow(rr, hi); fm0[rr] = ((unsigned)(j0 - cs) < 16u) ? 0.f : -1e30f; fm1[rr] = ((unsigned)(j0 + 32 - cs) < 16u) ? 0.f : -1e30f; }
    int slot = 0, slotn = 4;
#define B_TILE(tt, sl) do { const int kr = rmin + (tt); \
        if (kr >= rs && kr < rs + 8) {        \
            const __attribute__((address_space(3))) float* bp = bias + ((kr - r + 7) * 32 + 15 - c + 4 * hi);        \
            if (wid & 1) na_tile<2>(shm3 + B_LDS_K + (sl) * B_SLOT, vb0 + (sl) * B_SLOT, qr, bp, fm0, fm1, mrun, lsum, negm, first, o, wsf, r32, hi); \
            else         na_tile<1>(shm3 + B_LDS_K + (sl) * B_SLOT, vb0 + (sl) * B_SLOT, qr, bp, fm0, fm1, mrun, lsum, negm, first, o, wsf, r32, hi); \
            first = false; } } while (0)
    for (int t = 0; t < ntile; t += 2) {
        { const int rem = ntile - (t + 2);
          if (rem >= 2) { ATT_WAIT_BAR(4); } else if (rem == 1) { ATT_WAIT_BAR(2); } else { ATT_WAIT_BAR(0); } }
        const int slot1 = (slot == B_NS - 1) ? 0 : slot + 1, slotn1 = (slotn == B_NS - 1) ? 0 : slotn + 1;
        if (t + 4 < ntile) B_DMA(t + 4, slotn);
        if (t + 5 < ntile) B_DMA(t + 5, slotn1);
#pragma unroll 1
        for (int k2 = 0; k2 < 2; ++k2) { const int sl = k2 ? slot1 : slot; if (t + k2 < ntile) B_TILE(t + k2, sl); }
        slot = (slot1 == B_NS - 1) ? 0 : slot1 + 1; slotn = (slotn1 == B_NS - 1) ? 0 : slotn1 + 1;
    }
#undef B_TILE
#undef B_DMA
    const float lt = halfsum(lsum);
    if (hi == 0) wsf[32 + r32] = lt;
    ATT_LDSWAIT();
    float rli[16];
#pragma unroll
    for (int g = 0; g < 4; ++g) { const f32x4 l4 = *(const __attribute__((address_space(3))) f32x4*)(wsf + 32 + 8 * g + 4 * hi);
        rli[4 * g + 0] = __builtin_amdgcn_rcpf(l4[0]); rli[4 * g + 1] = __builtin_amdgcn_rcpf(l4[1]); rli[4 * g + 2] = __builtin_amdgcn_rcpf(l4[2]); rli[4 * g + 3] = __builtin_amdgcn_rcpf(l4[3]); }
#pragma unroll
    for (int d0 = 0; d0 < 2; ++d0)
#pragma unroll
        for (int rr = 0; rr < 16; ++rr) stg[crow(rr, hi) * 64 + d0 * 32 + r32] = (bf16_t)f2bf(o[d0][rr] * rli[rr]);
    ATT_LDSWAIT();
    bf16_t* Yw = yb + (rowbase + r * 64 + c0) * 1024 + 512 + h * 64;
#pragma unroll
    for (int i = 0; i < 4; ++i) { const int row = i * 8 + (lane >> 3), ch = lane & 7; const u32x4 v = *(const __attribute__((address_space(3))) u32x4*)(stg + row * 64 + ch * 8); *(u32x4*)(Yw + (size_t)row * 1024 + ch * 8) = v; }
    asm volatile("s_waitcnt lgkmcnt(0)\n\ts_barrier" ::: "memory");
}
}

namespace peer {
typedef short bf16x8 __attribute__((ext_vector_type(8)));
typedef float f32x16 __attribute__((ext_vector_type(16)));
typedef __attribute__((address_space(3))) const char* lds_cptr;
constexpr int T_LDS_SK = 0, T_LDS_BYTES = 65536;
__device__ __forceinline__ int imax(int a, int b) { int r; asm("v_max_f32 %0, %1, %2" : "=v"(r) : "v"(a), "v"(b)); return r; }
__device__ __forceinline__ int imin(int a, int b) { int r; asm("v_min_f32 %0, %1, %2" : "=v"(r) : "v"(a), "v"(b)); return r; }
__device__ __forceinline__ int f2key(float s, int idx) { return (__float_as_int(s) & ~127) | idx; }
__device__ __forceinline__ int key2bits(int k) { return k; }
template <int N, int OFF, int TOT> __device__ __forceinline__ void bsort_desc(int (&a)[TOT]) {
#pragma unroll
    for (int k = 2; k <= N; k <<= 1)
#pragma unroll
        for (int j = k >> 1; j > 0; j >>= 1)
#pragma unroll
            for (int i = 0; i < N; ++i) { const int l = i ^ j; if (l > i) { const bool desc = (i & k) == 0; const int hi_ = imax(a[OFF + i], a[OFF + l]), lo_ = imin(a[OFF + i], a[OFF + l]); a[OFF + i] = desc ? hi_ : lo_; a[OFF + l] = desc ? lo_ : hi_; } }
}
__device__ constexpr unsigned char NET16[126] = {0,1,2,3,0,2,1,3,1,2,4,5,6,7,4,6,5,7,5,6,0,4,2,6,2,4,1,5,3,7,3,5,1,2,3,4,5,6,8,9,10,11,8,10,9,11,9,10,12,13,14,15,12,14,13,15,13,14,8,12,10,14,10,12,9,13,11,15,11,13,9,10,11,12,13,14,0,8,4,12,4,8,2,10,6,14,6,10,2,4,6,8,10,12,1,9,5,13,5,9,3,11,7,15,7,11,3,5,7,9,11,13,1,2,3,4,5,6,7,8,9,10,11,12,13,14};
__device__ constexpr unsigned char NET32[382] = {0,1,2,3,0,2,1,3,1,2,4,5,6,7,4,6,5,7,5,6,0,4,2,6,2,4,1,5,3,7,3,5,1,2,3,4,5,6,8,9,10,11,8,10,9,11,9,10,12,13,14,15,12,14,13,15,13,14,8,12,10,14,10,12,9,13,11,15,11,13,9,10,11,12,13,14,0,8,4,12,4,8,2,10,6,14,6,10,2,4,6,8,10,12,1,9,5,13,5,9,3,11,7,15,7,11,3,5,7,9,11,13,1,2,3,4,5,6,7,8,9,10,11,12,13,14,16,17,18,19,16,18,17,19,17,18,20,21,22,23,20,22,21,23,21,22,16,20,18,22,18,20,17,21,19,23,19,21,17,18,19,20,21,22,24,25,26,27,24,26,25,27,25,26,28,29,30,31,28,30,29,31,29,30,24,28,26,30,26,28,25,29,27,31,27,29,25,26,27,28,29,30,16,24,20,28,20,24,18,26,22,30,22,26,18,20,22,24,26,28,17,25,21,29,21,25,19,27,23,31,23,27,19,21,23,25,27,29,17,18,19,20,21,22,23,24,25,26,27,28,29,30,0,16,8,24,8,16,4,20,12,28,12,20,4,8,12,16,20,24,2,18,10,26,10,18,6,22,14,30,14,22,6,10,14,18,22,26,2,4,6,8,10,12,14,16,18,20,22,24,26,28,1,17,9,25,9,17,5,21,13,29,13,21,5,9,13,17,21,25,3,19,11,27,11,19,7,23,15,31,15,23,7,11,15,19,23,27,3,5,7,9,11,13,15,17,19,21,23,25,27,29,1,2,3,4,5,6,7,8,9,10,11,12,13,14,15,16,17,18,19,20,21,22,23,24,25,26,27,28,29,30};
template <int OFF, int TOT> __device__ __forceinline__ void sort16_desc(int (&a)[TOT]) {
#pragma unroll
    for (int c = 0; c < 63; ++c) { const int i = OFF + NET16[2 * c], j = OFF + NET16[2 * c + 1]; const int hi_ = imax(a[i], a[j]), lo_ = imin(a[i], a[j]); a[i] = hi_; a[j] = lo_; }
}
template <int TOT> __device__ __forceinline__ void sort32_desc(int (&a)[TOT]) {
#pragma unroll
    for (int c = 0; c < 191; ++c) { const int i = NET32[2 * c], j = NET32[2 * c + 1]; const int hi_ = imax(a[i], a[j]), lo_ = imin(a[i], a[j]); a[i] = hi_; a[j] = lo_; }
}
template <int N, int OFF, int TOT> __device__ __forceinline__ void bmerge_desc(int (&a)[TOT]) {
#pragma unroll
    for (int j = N >> 1; j > 0; j >>= 1)
#pragma unroll
        for (int i = 0; i < N; ++i) { const int l = i ^ j; if (l > i) { const int hi_ = imax(a[OFF + i], a[OFF + l]), lo_ = imin(a[OFF + i], a[OFF + l]); a[OFF + i] = hi_; a[OFF + l] = lo_; } }
}
template <int A, int B, int TOT> __device__ __forceinline__ void merge_top16(int (&a)[TOT]) {
#pragma unroll
    for (int i = 0; i < 16; ++i) a[A + i] = imax(a[A + i], a[B + 15 - i]);
    bmerge_desc<16, A, TOT>(a);
}
__device__ __forceinline__ void cross_top16(int (&t)[16]) {
    int lo[16], hi[16];
#pragma unroll
    for (int i = 0; i < 16; ++i) { auto rr = __builtin_amdgcn_permlane32_swap((unsigned)t[i], (unsigned)t[i], false, false); lo[i] = (int)rr[0]; hi[i] = (int)rr[1]; }
#pragma unroll
    for (int i = 0; i < 16; ++i) t[i] = imax(lo[i], hi[15 - i]);
    bmerge_desc<16, 0, 16>(t);
}
struct RowStream {
    const float* pu; const float* pv; unsigned char* ws; int r, step, lane; f32x4 v0, v1, v2, v3;
    __device__ __forceinline__ void issue() {
        if (r < 2 * NEXP) { const float* src = (r < NEXP ? pu + (size_t)r * D : pv + (size_t)(r - NEXP) * D); const f32x4* s4 = (const f32x4*)src + lane * 4; v0 = s4[0]; v1 = s4[1]; v2 = s4[2]; v3 = s4[3]; } }
    __device__ __forceinline__ void finish() {
        if (r < 2 * NEXP) { const f32x4 cur[4] = {v0, v1, v2, v3};
            if (r < NEXP) cvt_row_i4(cur, ws + WS_U + (size_t)r * 512, (float*)(ws + WS_SU) + r, lane);
            else { const int e = r - NEXP; cvt_row_fp8(cur, ws + WS_V + (size_t)e * 512, (float*)(ws + WS_SV) + e, lane); }
            r += step; } }
    __device__ __forceinline__ void hook() { finish(); issue(); }
};
__device__ __forceinline__ void half_top16(int (&top)[16], const bf16_t* qrow  , lds_cptr skp  , int hi, RowStream& RS) {
    f32x16 sc[4]; sc[0] = f32x16{}; sc[1] = f32x16{}; sc[2] = f32x16{}; sc[3] = f32x16{};
    bf16x8 qf[8];
#pragma unroll
    for (int ks = 0; ks < 8; ++ks) qf[ks] = *(const bf16x8*)(qrow + ks * 16);
    RS.hook();
#pragma unroll
    for (int ks = 0; ks < 8; ++ks)
#pragma unroll
        for (int kt = 0; kt < 4; ++kt) { const bf16x8 af = *(const __attribute__((address_space(3))) bf16x8*)(skp + ks * 4096 + kt * 512);
            sc[kt] = __builtin_amdgcn_mfma_f32_32x32x16_bf16(af, qf[ks], sc[kt], 0, 0, 0); }
    int k[64];
#pragma unroll
    for (int kt = 0; kt < 4; ++kt)
#pragma unroll
        for (int r = 0; r < 16; ++r) k[kt * 16 + r] = f2key(sc[kt][r], (32 * kt + (r & 3) + 8 * (r >> 2)) | (4 * hi));
    sort16_desc<0, 64>(k); sort16_desc<16, 64>(k);
    RS.hook();
    sort16_desc<32, 64>(k); sort16_desc<48, 64>(k);
    RS.hook();
    merge_top16<0, 16, 64>(k); merge_top16<32, 48, 64>(k); merge_top16<0, 32, 64>(k);
#pragma unroll
    for (int i = 0; i < 16; ++i) top[i] = k[i];
    cross_top16(top);
}
__device__ __forceinline__ void topk_wave(int tok0, int h, const bf16_t* Q, int* IDX, float* Gt, lds_cptr sk, int lane, RowStream& RS) {
    const int r32 = lane & 31, hi = lane >> 5, tok = tok0 + r32;
    const bf16_t* qrow = Q + (size_t)tok * PQ + h * 256 + 8 * hi;
    lds_cptr skl = sk + hi * 2048 + r32 * 16;
    int A0[16], A1[16];
    half_top16(A0, qrow, skl, hi, RS);
    half_top16(A1, qrow + 128, skl + 32768, hi, RS);
    RS.hook();
    float x[16], y[16]; int xw[16], yw[16];
#pragma unroll
    for (int a = 0; a < 16; ++a) { const int b0 = key2bits(A0[a]), b1 = key2bits(A1[a]);
        const float v0 = __int_as_float(b0 & ~127), v1 = __int_as_float(b1 & ~127); const int i0 = (b0 & 127) << 7, i1 = b1 & 127;
        x[a] = hi ? v1 : v0; y[a] = hi ? v0 : v1; xw[a] = hi ? i1 : i0; yw[a] = hi ? i0 : i1; }
    int w[32]; int n = 0;
#define PEER_CAND(a, b) do { const int bits = __float_as_int(x[a] + y[b]); int ww = (bits & ~0x3FFF) | (xw[a] + yw[b]); \
        if ((a) == (b) && hi) ww = (int)0xFF800000; w[n] = ww; ++n; } while (0)
#pragma unroll
    for (int b = 0; b < 16; ++b) PEER_CAND(0, b);
#pragma unroll
    for (int b = 1; b < 8; ++b) PEER_CAND(1, b);
#pragma unroll
    for (int b = 2; b < 5; ++b) PEER_CAND(2, b);
    PEER_CAND(3, 3);
#undef PEER_CAND
#pragma unroll
    for (int i = 27; i < 32; ++i) w[i] = (int)0xFF800000;
    RS.hook();
    sort32_desc<32>(w);
    RS.hook();
    int T[16];
#pragma unroll
    for (int i = 0; i < 16; ++i) T[i] = w[i];
    cross_top16(T);
    float sv[16]; int ev[16];
#pragma unroll
    for (int j = 0; j < 16; ++j) { ev[j] = T[j] & 0x3FFF; sv[j] = __int_as_float(T[j] & ~0x3FFF); }
    const float s0 = sv[0]; float esum = 0.f;
#pragma unroll
    for (int j = 0; j < 16; ++j) { sv[j] = __expf(sv[j] - s0); esum += sv[j]; }
    const float inv = 1.f / esum;
    if (hi == 0) { u32x4* io = (u32x4*)(IDX + ((size_t)tok * 8 + h) * 16);
#pragma unroll
        for (int j = 0; j < 4; ++j) io[j] = (u32x4){(unsigned)ev[4 * j], (unsigned)ev[4 * j + 1], (unsigned)ev[4 * j + 2], (unsigned)ev[4 * j + 3]}; }
    else { f32x4* go = (f32x4*)(Gt + ((size_t)tok * 8 + h) * 16);
#pragma unroll
        for (int j = 0; j < 4; ++j) go[j] = (f32x4){sv[4 * j] * inv, sv[4 * j + 1] * inv, sv[4 * j + 2] * inv, sv[4 * j + 3] * inv}; }
}
template <class Sched> __device__ __forceinline__ void topk_own_units(const Ptrs& P, unsigned char* shm, const Sched& S) {
    int tid_l = threadIdx.x; asm volatile("" : "+v"(tid_l));
    const int tid = tid_l, lane = tid & 63; const int wid = __builtin_amdgcn_readfirstlane(tid >> 6);
    const unsigned lds0 = (unsigned)(uintptr_t)shm;
    const bf16_t* SKg = (const bf16_t*)(P.ws + WS_SK);
    int hprev = -1; pg8::Unit u;
    RowStream RS; RS.pu = P.peer_u; RS.pv = P.peer_v; RS.ws = P.ws; RS.lane = lane; RS.step = (int)gridDim.x * 8; RS.r = (int)blockIdx.x * 8 + wid; RS.v0 = RS.v1 = RS.v2 = RS.v3 = f32x4{};
    RS.issue();
    for (int i = 0; S.next(i, u); ++i) {
        const int h = u.pn, tg = u.pm;
        if (h != hprev) { hprev = h;
            asm volatile("s_waitcnt lgkmcnt(0)\n\ts_barrier" ::: "memory");
#pragma unroll
            for (int j = 0; j < 8; ++j) { const int piece = wid * 8 + j, p = piece >> 5, c = (piece >> 1) & 15, kh = piece & 1;
                att::glds16(SKg + ((size_t)((h * 2 + p) * 128 + kh * 64 + lane) * 128 + c * 8), (unsigned)__builtin_amdgcn_readfirstlane(lds0 + p * 32768 + c * 2048 + kh * 1024)); }
            asm volatile("s_waitcnt vmcnt(0)\n\ts_barrier" ::: "memory");
        }
        topk_wave(tg * 256 + wid * 32, h, (const bf16_t*)(P.ws + WS_Q), (int*)(P.ws + WS_IDX), (float*)(P.ws + WS_G), (lds_cptr)shm, lane, RS);
    }
    while (RS.r < 2 * NEXP) RS.hook();
}
}

namespace apply {
typedef float f32x2 __attribute__((ext_vector_type(2)));
typedef __attribute__((address_space(3))) unsigned* lds_u32p;
constexpr int AP_WAVE_BYTES = 4 * (512 + 2048), AP_LDS_BYTES = 8 * AP_WAVE_BYTES;
__device__ __forceinline__ float gelu_fast(float v) {
    const float av = fabsf(v), t = __builtin_amdgcn_rcpf(av * 0.2316418882f + 1.0f);
    float q = t * 0.5307027145f + (-0.7265760135f); q = q * t + 0.7107068705f; q = q * t + (-0.142248368f); q = q * t + 0.127414796f; q = q * t;
    const float e = __builtin_amdgcn_exp2f((v * v) * (-0.72134752044f));
    const float m = v * (q * e);
    return v < 0.f ? m : v - m;
}
#define AP_DPP(v, ctrl) __builtin_bit_cast(float, __builtin_amdgcn_update_dpp(0, __builtin_bit_cast(int, (v)), (ctrl), 0xF, 0xF, true))
__device__ __forceinline__ float row16_sum(float v) { v += AP_DPP(v, 0xB1); v += AP_DPP(v, 0x4E); v += AP_DPP(v, 0x141); v += AP_DPP(v, 0x140); return v; }
__device__ __forceinline__ void load_half(u32x4 (&r)[2], const unsigned char* img, unsigned e, int sub) {
    const unsigned off = e * 512u + (unsigned)(sub * 16);
    r[0] = *(const u32x4*)(img + off); r[1] = *(const u32x4*)(img + off + 256u);
}
constexpr int AP_PROBE_RING = 16;
constexpr int AP_RING = 8;
typedef __attribute__((address_space(3))) u32x4* lds_v4p;
template <int HF, int MODE, int RING> __device__ __forceinline__ void pass_u(const Ptrs& P, const bf16_t* hrow, float rstd, lds_v4p grp, u32x4 (&R)[RING][2], const unsigned char* img, const unsigned char* img_next, int sub) {
    unsigned xq[8]; float sx;
    {
        float xf[2][16]; float mx = 0.f;
#pragma unroll
        for (int i = 0; i < 2; ++i) { const int e0 = (sub + 16 * (2 * HF + i)) * 16;
#pragma unroll
            for (int q = 0; q < 4; ++q) { const u32x2 hb = *(const u32x2*)(hrow + e0 + 4 * q); const f32x4 gv = *(const f32x4*)(P.norm_ffn + e0 + 4 * q);
                xf[i][4 * q] = bflo(hb.x) * rstd * gv.x; xf[i][4 * q + 1] = bfhi(hb.x) * rstd * gv.y; xf[i][4 * q + 2] = bflo(hb.y) * rstd * gv.z; xf[i][4 * q + 3] = bfhi(hb.y) * rstd * gv.w;
                mx = fmaxf(fmaxf(mx, fmaxf(fabsf(xf[i][4 * q]), fabsf(xf[i][4 * q + 1]))), fmaxf(fabsf(xf[i][4 * q + 2]), fabsf(xf[i][4 * q + 3]))); } }
        mx = fmaxf(mx, AP_DPP(mx, 0xB1)); mx = fmaxf(mx, AP_DPP(mx, 0x4E)); mx = fmaxf(mx, AP_DPP(mx, 0x141)); mx = fmaxf(mx, AP_DPP(mx, 0x140));
        mx = fmaxf(mx, 1e-30f); sx = mx * (1.f / 127.f); const float qs = 127.f / mx;
#pragma unroll
        for (int i = 0; i < 2; ++i)
#pragma unroll
            for (int q = 0; q < 4; ++q) xq[4 * i + q] = pack_i8x4(xf[i][4 * q] * qs, xf[i][4 * q + 1] * qs, xf[i][4 * q + 2] * qs, xf[i][4 * q + 3] * qs);
    }
#pragma unroll 1
    for (int j = 0; j < 128; j += RING) {
        const int jn = (j + RING) & 127;
        __builtin_amdgcn_s_barrier();
        const unsigned char* tb = (j + RING < 128) ? img : img_next;
        unsigned nid[RING], part[RING], suv[RING], gsv[RING];
#pragma unroll
        for (int b4 = 0; b4 < RING / 4; ++b4) { const u32x4 na = grp[jn / 4 + b4];
            nid[4 * b4] = na.x; nid[4 * b4 + 1] = na.y; nid[4 * b4 + 2] = na.z; nid[4 * b4 + 3] = na.w;
            u32x4 pa = {}, sa = {}, ga = {};
            if (HF == 1) { pa = grp[96 + j / 4 + b4]; sa = grp[32 + j / 4 + b4]; ga = grp[64 + j / 4 + b4]; }
            part[4 * b4] = pa.x; part[4 * b4 + 1] = pa.y; part[4 * b4 + 2] = pa.z; part[4 * b4 + 3] = pa.w;
            suv[4 * b4] = sa.x; suv[4 * b4 + 1] = sa.y; suv[4 * b4 + 2] = sa.z; suv[4 * b4 + 3] = sa.w;
            gsv[4 * b4] = ga.x; gsv[4 * b4 + 1] = ga.y; gsv[4 * b4 + 2] = ga.z; gsv[4 * b4 + 3] = ga.w; }
        float outv[RING];
#pragma unroll
        for (int bq = 0; bq < RING; ++bq) {
            int d0_ = 0, d1_ = 0;
            if (MODE == 1) { asm volatile("" :: "v"(R[bq][0]), "v"(R[bq][1])); d0_ = (int)xq[0]; }
            else {
                d0_ = __builtin_amdgcn_sdot4((int)R[bq][0].x, (int)xq[0], d0_, false); d1_ = __builtin_amdgcn_sdot4((int)R[bq][0].y, (int)xq[1], d1_, false);
                d0_ = __builtin_amdgcn_sdot4((int)R[bq][0].z, (int)xq[2], d0_, false); d1_ = __builtin_amdgcn_sdot4((int)R[bq][0].w, (int)xq[3], d1_, false);
                d0_ = __builtin_amdgcn_sdot4((int)R[bq][1].x, (int)xq[4], d0_, false); d1_ = __builtin_amdgcn_sdot4((int)R[bq][1].y, (int)xq[5], d1_, false);
                d0_ = __builtin_amdgcn_sdot4((int)R[bq][1].z, (int)xq[6], d0_, false); d1_ = __builtin_amdgcn_sdot4((int)R[bq][1].w, (int)xq[7], d1_, false);
            }
            asm volatile("" ::: "memory");
            load_half(R[bq], tb, MODE == 2 ? (nid[bq] & 15u) : nid[bq], sub);
            asm volatile("" ::: "memory");
            float a_ = row16_sum((float)(d0_ + d1_)) * sx;
            if (HF == 1) { a_ = (a_ + __uint_as_float(part[bq])) * __uint_as_float(suv[bq]); a_ = __uint_as_float(gsv[bq]) * gelu_fast(a_); }
            outv[bq] = a_;
        }
        if (sub == 0) {
#pragma unroll
            for (int b4 = 0; b4 < RING / 4; ++b4) grp[96 + j / 4 + b4] = (u32x4){__float_as_uint(outv[4 * b4]), __float_as_uint(outv[4 * b4 + 1]), __float_as_uint(outv[4 * b4 + 2]), __float_as_uint(outv[4 * b4 + 3])}; }
    }
    asm volatile("s_waitcnt lgkmcnt(0)" ::: "memory");
}
template <int HF, int MODE, int RING> __device__ __forceinline__ void pass_v(float (&acc)[4][16], lds_v4p grp, u32x4 (&R)[RING][2], const unsigned char* img, const unsigned char* img_next, int sub) {
#pragma unroll 1
    for (int j = 0; j < 128; j += RING) {
        const int jn = (j + RING) & 127;
        __builtin_amdgcn_s_barrier();
        const unsigned char* tb = (j + RING < 128) ? img : img_next;
        unsigned nid[RING], cvv[RING];
#pragma unroll
        for (int b4 = 0; b4 < RING / 4; ++b4) { const u32x4 na = grp[jn / 4 + b4], ca = grp[96 + j / 4 + b4];
            nid[4 * b4] = na.x; nid[4 * b4 + 1] = na.y; nid[4 * b4 + 2] = na.z; nid[4 * b4 + 3] = na.w; cvv[4 * b4] = ca.x; cvv[4 * b4 + 1] = ca.y; cvv[4 * b4 + 2] = ca.z; cvv[4 * b4 + 3] = ca.w; }
#pragma unroll
        for (int bq = 0; bq < RING; ++bq) {
            const float c_ = __uint_as_float(cvv[bq]); const f32x2 c2 = {c_, c_};
            if (MODE == 1) { asm volatile("" :: "v"(R[bq][0]), "v"(R[bq][1])); acc[2 * HF][0] += c_; }
            else {
#pragma unroll
            for (int i = 0; i < 2; ++i) { const unsigned w_[4] = {R[bq][i].x, R[bq][i].y, R[bq][i].z, R[bq][i].w};
#pragma unroll
                for (int q = 0; q < 4; ++q) { const f32x2 lo_ = __builtin_amdgcn_cvt_pk_f32_fp8(w_[q], false), hi_ = __builtin_amdgcn_cvt_pk_f32_fp8(w_[q], true);
                    f32x2 a0 = {acc[2 * HF + i][4 * q], acc[2 * HF + i][4 * q + 1]}, a1 = {acc[2 * HF + i][4 * q + 2], acc[2 * HF + i][4 * q + 3]}; a0 += c2 * lo_; a1 += c2 * hi_;
                    acc[2 * HF + i][4 * q] = a0.x; acc[2 * HF + i][4 * q + 1] = a0.y; acc[2 * HF + i][4 * q + 2] = a1.x; acc[2 * HF + i][4 * q + 3] = a1.y; } }
            }
            asm volatile("" ::: "memory");
            load_half(R[bq], tb, MODE == 2 ? (nid[bq] & 15u) : nid[bq], sub);
            asm volatile("" ::: "memory");
        }
    }
}
constexpr int AP_RINGU = 16;
__device__ __forceinline__ u32x4 load_q4(const unsigned char* img, unsigned e, int sub) { return *(const u32x4*)(img + e * 256u + (unsigned)(sub * 16)); }
template <int HF, int RF> __device__ __forceinline__ void u4_half_turn(lds_v4p grp, u32x4 (&R)[AP_RINGU], const unsigned (&xh)[4], const unsigned (&xl)[4], float sx, const unsigned char* tb, int jb, int jr, int sub) {
    constexpr int RING = AP_RINGU;
    __builtin_amdgcn_s_barrier();
    unsigned nid[RING];
    if (RF != 2) {
#pragma unroll
        for (int b4 = 0; b4 < RING / 4; ++b4) { const u32x4 na = grp[jr / 4 + b4]; nid[4 * b4] = na.x; nid[4 * b4 + 1] = na.y; nid[4 * b4 + 2] = na.z; nid[4 * b4 + 3] = na.w; } }
    float outv[RING];
#pragma unroll
    for (int b4 = 0; b4 < RING / 4; ++b4) {
        u32x4 pa = {}, sa = {}, ga = {};
        if (HF == 1) { pa = grp[96 + jb / 4 + b4]; sa = grp[32 + jb / 4 + b4]; ga = grp[64 + jb / 4 + b4]; }
        const unsigned part[4] = {pa.x, pa.y, pa.z, pa.w}, suv[4] = {sa.x, sa.y, sa.z, sa.w}, gsv[4] = {ga.x, ga.y, ga.z, ga.w};
#pragma unroll
        for (int b1 = 0; b1 < 4; ++b1) { const int bq = 4 * b4 + b1;
            int dh_ = __builtin_amdgcn_sdot8((int)R[bq].x, (int)xh[0], 0, false), dl_ = __builtin_amdgcn_sdot8((int)R[bq].x, (int)xl[0], 0, false);
            dh_ = __builtin_amdgcn_sdot8((int)R[bq].y, (int)xh[1], dh_, false); dl_ = __builtin_amdgcn_sdot8((int)R[bq].y, (int)xl[1], dl_, false);
            dh_ = __builtin_amdgcn_sdot8((int)R[bq].z, (int)xh[2], dh_, false); dl_ = __builtin_amdgcn_sdot8((int)R[bq].z, (int)xl[2], dl_, false);
            dh_ = __builtin_amdgcn_sdot8((int)R[bq].w, (int)xh[3], dh_, false); dl_ = __builtin_amdgcn_sdot8((int)R[bq].w, (int)xl[3], dl_, false);
            asm volatile("" ::: "memory");
            if (RF == 0) R[bq] = load_q4(tb, nid[bq], sub);
            else if (RF == 1) R[bq] = *(const u32x4*)(tb + nid[bq >> 1] * 512u + (unsigned)(sub * 16 + (bq & 1) * 256));
            asm volatile("" ::: "memory");
            float a_ = row16_sum((float)(dh_ * 16 + dl_)) * sx;
            if (HF == 1) { a_ = (a_ + __uint_as_float(part[b1])) * __uint_as_float(suv[b1]); a_ = __uint_as_float(gsv[b1]) * gelu_fast(a_); }
            outv[bq] = a_; }
    }
    if (sub == 0) {
#pragma unroll
        for (int b4 = 0; b4 < RING / 4; ++b4) grp[96 + jb / 4 + b4] = (u32x4){__float_as_uint(outv[4 * b4]), __float_as_uint(outv[4 * b4 + 1]), __float_as_uint(outv[4 * b4 + 2]), __float_as_uint(outv[4 * b4 + 3])}; }
}
template <int HF, bool NEXTV> __device__ __forceinline__ void pass_u4(const Ptrs& P, const bf16_t* hrow, float rstd, lds_v4p grp, u32x4 (&RA)[AP_RINGU], u32x4 (&RB)[AP_RINGU], const unsigned char* img, const unsigned char* img_next, int sub) {
    unsigned xh[4], xl[4]; float sx;
    {
        float xf[2][16]; float mx = 0.f;
#pragma unroll
        for (int i = 0; i < 2; ++i) { const int e0 = (sub + 16 * (2 * HF + i)) * 16;
#pragma unroll
            for (int q = 0; q < 4; ++q) { const u32x2 hb = *(const u32x2*)(hrow + e0 + 4 * q); const f32x4 gv = *(const f32x4*)(P.norm_ffn + e0 + 4 * q);
                xf[i][4 * q] = bflo(hb.x) * rstd * gv.x; xf[i][4 * q + 1] = bfhi(hb.x) * rstd * gv.y; xf[i][4 * q + 2] = bflo(hb.y) * rstd * gv.z; xf[i][4 * q + 3] = bfhi(hb.y) * rstd * gv.w;
                mx = fmaxf(fmaxf(mx, fmaxf(fabsf(xf[i][4 * q]), fabsf(xf[i][4 * q + 1]))), fmaxf(fabsf(xf[i][4 * q + 2]), fabsf(xf[i][4 * q + 3]))); } }
        mx = fmaxf(mx, AP_DPP(mx, 0xB1)); mx = fmaxf(mx, AP_DPP(mx, 0x4E)); mx = fmaxf(mx, AP_DPP(mx, 0x141)); mx = fmaxf(mx, AP_DPP(mx, 0x140));
        mx = fmaxf(mx, 1e-30f); sx = mx * (1.f / 119.f); const float qs = 119.f / mx;
#pragma unroll
        for (int q = 0; q < 4; ++q) { unsigned h_ = 0u, l_ = 0u;
#pragma unroll
            for (int i = 0; i < 8; ++i) { const int xi = (int)rintf(xf[q >> 1][8 * (q & 1) + i] * qs); const int lo = ((xi + 8) & 15) - 8; const int hi = (xi - lo) >> 4;
                h_ |= ((unsigned)hi & 15u) << (4 * i); l_ |= ((unsigned)lo & 15u) << (4 * i); }
            xh[q] = h_; xl[q] = l_; }
    }
#pragma unroll 1
    for (int j = 0; j < 96; j += 32) {
        u4_half_turn<HF, 0>(grp, RA, xh, xl, sx, img, j, j + 32, sub);
        u4_half_turn<HF, 0>(grp, RB, xh, xl, sx, img, j + 16, j + 48, sub);
    }
    u4_half_turn<HF, NEXTV ? 1 : 0>(grp, RA, xh, xl, sx, img_next, 96, 0, sub);
    u4_half_turn<HF, NEXTV ? 2 : 0>(grp, RB, xh, xl, sx, img_next, 112, 16, sub);
    asm volatile("s_waitcnt lgkmcnt(0)" ::: "memory");
}
template <int RF> __device__ __forceinline__ void u4f_half_turn(lds_v4p grp, u32x4 (&R)[AP_RINGU], const unsigned (&xh)[8], const unsigned (&xl)[8], float sx, const unsigned char* tb, int jb, int jr, int sub) {
    unsigned nid[8];
    if (RF != 2) {
#pragma unroll
        for (int b4 = 0; b4 < 2; ++b4) { const u32x4 na = grp[jr / 4 + b4]; nid[4 * b4] = na.x; nid[4 * b4 + 1] = na.y; nid[4 * b4 + 2] = na.z; nid[4 * b4 + 3] = na.w; } }
    float outv[8];
#pragma unroll
    for (int b4 = 0; b4 < 2; ++b4) {
        const u32x4 sa = grp[32 + jb / 4 + b4], ga = grp[64 + jb / 4 + b4];
        const unsigned suv[4] = {sa.x, sa.y, sa.z, sa.w}, gsv[4] = {ga.x, ga.y, ga.z, ga.w};
#pragma unroll
        for (int b1 = 0; b1 < 4; ++b1) { const int e = 4 * b4 + b1;
            int dh_ = 0, dl_ = 0;
#pragma unroll
            for (int p = 0; p < 2; ++p) { const unsigned w_[4] = {R[2 * e + p].x, R[2 * e + p].y, R[2 * e + p].z, R[2 * e + p].w};
#pragma unroll
                for (int q = 0; q < 4; ++q) { dh_ = __builtin_amdgcn_sdot8((int)w_[q], (int)xh[4 * p + q], dh_, false); dl_ = __builtin_amdgcn_sdot8((int)w_[q], (int)xl[4 * p + q], dl_, false); } }
            asm volatile("" ::: "memory");
            if (RF == 0) { const unsigned off = nid[e] * 512u + (unsigned)(sub * 16); R[2 * e] = *(const u32x4*)(tb + off); R[2 * e + 1] = *(const u32x4*)(tb + off + 256u); }
            else if (RF == 1) { const unsigned off = nid[e] * 512u + (unsigned)(sub * 16); R[2 * e] = *(const u32x4*)(tb + off); R[2 * e + 1] = *(const u32x4*)(tb + off + 256u); }
            asm volatile("" ::: "memory");
            float a_ = row16_sum((float)(dh_ * 16 + dl_)) * sx * __uint_as_float(suv[b1]);
            outv[e] = __uint_as_float(gsv[b1]) * gelu_fast(a_); }
    }
    if (sub == 0) {
#pragma unroll
        for (int b4 = 0; b4 < 2; ++b4) grp[96 + jb / 4 + b4] = (u32x4){__float_as_uint(outv[4 * b4]), __float_as_uint(outv[4 * b4 + 1]), __float_as_uint(outv[4 * b4 + 2]), __float_as_uint(outv[4 * b4 + 3])}; }
}
__device__ __forceinline__ void pass_u4f(const Ptrs& P, const bf16_t* hrow, float rstd, lds_v4p grp, u32x4 (&RA)[AP_RINGU], u32x4 (&RB)[AP_RINGU], const unsigned char* img, const unsigned char* vimg, int sub) {
    unsigned xh[8], xl[8]; float sx;
    {
        float mx = 0.f;
#pragma unroll
        for (int i = 0; i < 4; ++i) { const int e0 = (sub + 16 * i) * 16;
#pragma unroll
            for (int q = 0; q < 4; ++q) { const u32x2 hb = *(const u32x2*)(hrow + e0 + 4 * q); const f32x4 gv = *(const f32x4*)(P.norm_ffn + e0 + 4 * q);
                const float x0 = bflo(hb.x) * rstd * gv.x, x1 = bfhi(hb.x) * rstd * gv.y, x2 = bflo(hb.y) * rstd * gv.z, x3 = bfhi(hb.y) * rstd * gv.w;
                mx = fmaxf(fmaxf(mx, fmaxf(fabsf(x0), fabsf(x1))), fmaxf(fabsf(x2), fabsf(x3))); } }
        mx = fmaxf(mx, AP_DPP(mx, 0xB1)); mx = fmaxf(mx, AP_DPP(mx, 0x4E)); mx = fmaxf(mx, AP_DPP(mx, 0x141)); mx = fmaxf(mx, AP_DPP(mx, 0x140));
        mx = fmaxf(mx, 1e-30f); sx = mx * (1.f / 119.f); const float qs = 119.f / mx;
#pragma unroll
        for (int q = 0; q < 8; ++q) { unsigned h_ = 0u, l_ = 0u; const int e0 = (sub + 16 * (q >> 1)) * 16 + 8 * (q & 1);
#pragma unroll
            for (int hf = 0; hf < 2; ++hf) { const u32x2 hb = *(const u32x2*)(hrow + e0 + 4 * hf); const f32x4 gv = *(const f32x4*)(P.norm_ffn + e0 + 4 * hf);
                const float xv[4] = {bflo(hb.x) * rstd * gv.x, bfhi(hb.x) * rstd * gv.y, bflo(hb.y) * rstd * gv.z, bfhi(hb.y) * rstd * gv.w};
#pragma unroll
                for (int i = 0; i < 4; ++i) { const int xi = (int)rintf(xv[i] * qs); const int lo = ((xi + 8) & 15) - 8; const int hi = (xi - lo) >> 4;
                    h_ |= ((unsigned)hi & 15u) << (4 * (4 * hf + i)); l_ |= ((unsigned)lo & 15u) << (4 * (4 * hf + i)); } }
            xh[q] = h_; xl[q] = l_; }
    }
#pragma unroll 1
    for (int j = 0; j < 112; j += 16) {
        __builtin_amdgcn_s_barrier();
        u4f_half_turn<0>(grp, RA, xh, xl, sx, img, j, j + 16, sub);
        u4f_half_turn<0>(grp, RB, xh, xl, sx, img, j + 8, j + 24, sub);
    }
    __builtin_amdgcn_s_barrier();
    u4f_half_turn<1>(grp, RA, xh, xl, sx, vimg, 112, 0, sub);
    u4f_half_turn<2>(grp, RB, xh, xl, sx, vimg, 120, 0, sub);
    asm volatile("s_waitcnt lgkmcnt(0)" ::: "memory");
}
template <int HF> __device__ __forceinline__ void pass_v8f(float (&acc)[4][16], lds_v4p grp, u32x4 (&R)[AP_RINGU], const unsigned char* img, const unsigned char* img_next, int sub) {
    constexpr int RING = 8;
#pragma unroll 1
    for (int j = 0; j < 128; j += RING) {
        const int jn = (j + RING) & 127;
        if ((j & 31) == 0) __builtin_amdgcn_s_barrier();
        const unsigned char* tb = (j + RING < 128) ? img : img_next;
        unsigned nid[RING], cvv[RING];
#pragma unroll
        for (int b4 = 0; b4 < RING / 4; ++b4) { const u32x4 na = grp[jn / 4 + b4], ca = grp[96 + j / 4 + b4];
            nid[4 * b4] = na.x; nid[4 * b4 + 1] = na.y; nid[4 * b4 + 2] = na.z; nid[4 * b4 + 3] = na.w; cvv[4 * b4] = ca.x; cvv[4 * b4 + 1] = ca.y; cvv[4 * b4 + 2] = ca.z; cvv[4 * b4 + 3] = ca.w; }
#pragma unroll
        for (int bq = 0; bq < RING; ++bq) {
            const float c_ = __uint_as_float(cvv[bq]); const f32x2 c2 = {c_, c_};
#pragma unroll
            for (int i = 0; i < 2; ++i) { const unsigned w_[4] = {R[2 * bq + i].x, R[2 * bq + i].y, R[2 * bq + i].z, R[2 * bq + i].w};
#pragma unroll
                for (int q = 0; q < 4; ++q) { const f32x2 lo_ = __builtin_amdgcn_cvt_pk_f32_fp8(w_[q], false), hi_ = __builtin_amdgcn_cvt_pk_f32_fp8(w_[q], true);
                    f32x2 a0 = {acc[2 * HF + i][4 * q], acc[2 * HF + i][4 * q + 1]}, a1 = {acc[2 * HF + i][4 * q + 2], acc[2 * HF + i][4 * q + 3]}; a0 += c2 * lo_; a1 += c2 * hi_;
                    acc[2 * HF + i][4 * q] = a0.x; acc[2 * HF + i][4 * q + 1] = a0.y; acc[2 * HF + i][4 * q + 2] = a1.x; acc[2 * HF + i][4 * q + 3] = a1.y; } }
            asm volatile("" ::: "memory");
            { const unsigned off = nid[bq] * 512u + (unsigned)(sub * 16); R[2 * bq] = *(const u32x4*)(tb + off); R[2 * bq + 1] = *(const u32x4*)(tb + off + 256u); }
            asm volatile("" ::: "memory");
        }
    }
}
template <int MODE> __device__ __forceinline__ void apply_round(const Ptrs& P, float* outbase, int tbase, unsigned char* shm_wave, int lane_in) {
    int lane = lane_in; asm volatile("" : "+v"(lane));
    const int sub = lane & 15, g = lane >> 4, t = tbase + g;
    __attribute__((address_space(3))) unsigned* cnt = (lds_u32p)(__attribute__((address_space(3))) unsigned char*)shm_wave + g * 128;
    lds_v4p grp = (lds_v4p)((__attribute__((address_space(3))) unsigned char*)shm_wave + 2048 + g * 2048);
    __attribute__((address_space(3))) unsigned* grp1 = (__attribute__((address_space(3))) unsigned*)grp;
    const unsigned char* U8 = P.ws + WS_U; const unsigned char* V8 = P.ws + WS_V;
    {
        const int* idxp = (const int*)(P.ws + WS_IDX) + (size_t)t * 128 + sub * 8; const float* gp = (const float*)(P.ws + WS_G) + (size_t)t * 128 + sub * 8;
        const u32x4 ia = *(const u32x4*)idxp, ib = *(const u32x4*)(idxp + 4); const f32x4 ga = *(const f32x4*)gp, gb = *(const f32x4*)(gp + 4);
        const int e[8] = {(int)ia.x, (int)ia.y, (int)ia.z, (int)ia.w, (int)ib.x, (int)ib.y, (int)ib.z, (int)ib.w};
        const float gt[8] = {ga.x, ga.y, ga.z, ga.w, gb.x, gb.y, gb.z, gb.w};
        float su[8], sv[8];
#pragma unroll
        for (int i = 0; i < 8; ++i) { su[i] = ((const float*)(P.ws + WS_SU))[e[i]]; sv[i] = ((const float*)(P.ws + WS_SV))[e[i]]; }
#pragma unroll
        for (int i = 0; i < 8; ++i) cnt[sub * 8 + i] = 0u;
        asm volatile("s_waitcnt lgkmcnt(0)" ::: "memory");
        unsigned pos[8];
#pragma unroll
        for (int i = 0; i < 8; ++i) pos[i] = __hip_atomic_fetch_add(cnt + (e[i] >> 7), 1u, __ATOMIC_RELAXED, __HIP_MEMORY_SCOPE_WAVEFRONT);
        asm volatile("s_waitcnt lgkmcnt(0)" ::: "memory");
        unsigned c[8]; unsigned tot = 0;
#pragma unroll
        for (int i = 0; i < 8; ++i) { c[i] = cnt[sub * 8 + i]; }
#pragma unroll
        for (int i = 0; i < 8; ++i) { const unsigned x = c[i]; c[i] = tot; tot += x; }
        unsigned inc = tot;
#pragma unroll
        for (int d = 1; d < 16; d <<= 1) { const unsigned y = __shfl_up(inc, d, 16); if (sub >= d) inc += y; }
        const unsigned base = inc - tot;
        asm volatile("s_waitcnt lgkmcnt(0)" ::: "memory");
#pragma unroll
        for (int i = 0; i < 8; ++i) cnt[sub * 8 + i] = base + c[i];
        asm volatile("s_waitcnt lgkmcnt(0)" ::: "memory");
#pragma unroll
        for (int i = 0; i < 8; ++i) { const unsigned p = cnt[e[i] >> 7] + pos[i];
            grp1[p] = (unsigned)e[i]; grp1[128 + p] = __float_as_uint(su[i]); grp1[256 + p] = __float_as_uint(gt[i] * sv[i]); }
        asm volatile("s_waitcnt lgkmcnt(0)" ::: "memory");
    }
    const bf16_t* hrow = (const bf16_t*)(P.ws + WS_HB) + (size_t)t * D;
    float rstd;
    { const float* ssq = (const float*)(P.ws + WS_SSQ) + (size_t)t * 16;
      const f32x4 s0 = *(const f32x4*)ssq, s1 = *(const f32x4*)(ssq + 4), s2 = *(const f32x4*)(ssq + 8), s3 = *(const f32x4*)(ssq + 12);
      const float tot = ((s0.x + s0.y) + (s0.z + s0.w)) + ((s1.x + s1.y) + (s1.z + s1.w)) + ((s2.x + s2.y) + (s2.z + s2.w)) + ((s3.x + s3.y) + (s3.z + s3.w));
      rstd = 1.f / sqrtf(tot * (1.f / D) + EPS); }
    const unsigned char* U0 = U8; const unsigned char* U1 = U8 + (size_t)NEXP * 256; const unsigned char* V0 = V8; const unsigned char* V1 = V8 + (size_t)NEXP * 512;
    u32x4 R[AP_RINGU];
    {
      u32x4 RB[AP_RINGU];
#pragma unroll
      for (int b4 = 0; b4 < 4; ++b4) { const u32x4 ia = grp[b4]; const unsigned ev[4] = {ia.x, ia.y, ia.z, ia.w};
#pragma unroll
        for (int k = 0; k < 4; ++k) { const int e = 4 * b4 + k; const unsigned off = ev[k] * 512u + (unsigned)(sub * 16);
          if (e < 8) { R[2 * e] = *(const u32x4*)(U0 + off); R[2 * e + 1] = *(const u32x4*)(U0 + off + 256u); } else { RB[2 * (e - 8)] = *(const u32x4*)(U0 + off); RB[2 * (e - 8) + 1] = *(const u32x4*)(U0 + off + 256u); } } }
      pass_u4f(P, hrow, rstd, grp, R, RB, U0, V0, sub);
    }
    float acc[4][16];
#pragma unroll
    for (int i = 0; i < 4; ++i)
#pragma unroll
        for (int q = 0; q < 16; ++q) acc[i][q] = 0.f;
    pass_v8f<0>(acc, grp, R, V0, V1, sub);
    pass_v8f<1>(acc, grp, R, V1, V1, sub);
    float ss = 0.f;
#pragma unroll
    for (int i = 0; i < 4; ++i) { const int e0 = (sub + 16 * i) * 16;
#pragma unroll
        for (int q = 0; q < 4; ++q) { const u32x2 hb = *(const u32x2*)(hrow + e0 + 4 * q);
            acc[i][4 * q] += bflo(hb.x); acc[i][4 * q + 1] += bfhi(hb.x); acc[i][4 * q + 2] += bflo(hb.y); acc[i][4 * q + 3] += bfhi(hb.y);
            ss += (acc[i][4 * q] * acc[i][4 * q] + acc[i][4 * q + 1] * acc[i][4 * q + 1]) + (acc[i][4 * q + 2] * acc[i][4 * q + 2] + acc[i][4 * q + 3] * acc[i][4 * q + 3]); }
        asm volatile("" ::: "memory"); }
    ss = row16_sum(ss);
    const float r2 = 1.f / sqrtf(ss * (1.f / D) + EPS);
    float* orow = outbase + (size_t)t * D;
#pragma unroll
    for (int i = 0; i < 4; ++i) { const int e0 = (sub + 16 * i) * 16;
#pragma unroll
        for (int q = 0; q < 4; ++q) { const f32x4 gv = *(const f32x4*)(P.norm_final + e0 + 4 * q);
            *(f32x4*)(orow + e0 + 4 * q) = (f32x4){acc[i][4 * q] * r2 * gv.x, acc[i][4 * q + 1] * r2 * gv.y, acc[i][4 * q + 2] * r2 * gv.z, acc[i][4 * q + 3] * r2 * gv.w}; }
        asm volatile("" ::: "memory"); }
}
template <int MODE> __device__ __forceinline__ void apply_phase(const Ptrs& P, float* outbase, unsigned char* shm, int G, int vcu) {
    int tid_l = threadIdx.x; asm volatile("" : "+v"(tid_l));
    const int lane = tid_l & 63; const int wave = __builtin_amdgcn_readfirstlane(tid_l >> 6);
    const int per = M / (G * 8);
#pragma unroll 1
    for (int r = 0; r < per; r += 4) apply_round<MODE>(P, outbase, (vcu * 8 + wave) * per + r, shm + wave * AP_WAVE_BYTES, lane);
}
}

#define LAS __attribute__((address_space(3)))
#define XB_TMO      128
#define XB_XCNT(j)  (256  + 64 * (j))
#define XB_XSUB(j)  (1280 + 64 * (j))
#define XB_XGEN(j)  (2304 + 64 * (j))
#define XB_TOP      3328
#define XB_TOPGEN   3392
#define XCD_BAR_WORDS 3456
#define XB_SPIN_CAP (1u << 18)

__device__ __forceinline__ unsigned xb_ld(unsigned* p)              { return __hip_atomic_load(p, __ATOMIC_RELAXED, __HIP_MEMORY_SCOPE_AGENT); }
__device__ __forceinline__ unsigned xb_add(unsigned* p, unsigned v) { return __hip_atomic_fetch_add(p, v, __ATOMIC_RELAXED, __HIP_MEMORY_SCOPE_AGENT); }
__device__ __forceinline__ unsigned xb_xcc_id() { return (unsigned)__builtin_amdgcn_s_getreg((3 << 11) | 20) & 0xFu; }
#define XB_SPIN(cond, bar) do { unsigned _sp = 0; while (cond) { __builtin_amdgcn_s_sleep(1); \
    if ((++_sp & 255u) == 0u) { if (xb_ld(&(bar)[XB_TMO])) break; if (_sp > XB_SPIN_CAP) { atomicAdd(&(bar)[XB_TMO], 1u); break; } } } } while (0)

struct XcdBarrier {
    unsigned* bar; unsigned x;
    volatile LAS unsigned* st;
};

__device__ __forceinline__ XcdBarrier xcd_barrier_post(unsigned* bar, volatile LAS unsigned* st) {
    XcdBarrier b; b.bar = bar; b.x = xb_xcc_id(); b.st = st;
    if (threadIdx.x == 0) (void)xb_add(&bar[XB_XCNT(b.x)], 1u);
    return b;
}
__device__ __forceinline__ void xcd_barrier_complete(unsigned* bar, unsigned x, unsigned& nloc, unsigned& nx) {
    const unsigned G = gridDim.x * gridDim.y * gridDim.z;
    unsigned sum, cnt, mine, sp = 0u;
    for (;;) {
        sum = 0u; cnt = 0u; mine = 0u;
#pragma unroll
        for (unsigned j = 0; j < 16; ++j) { const unsigned c = xb_ld(&bar[XB_XCNT(j)]); sum += c; cnt += (c > 0u) ? 1u : 0u; mine = (j == x) ? c : mine; }
        if (sum == G) break;
        __builtin_amdgcn_s_sleep(1);
        if ((++sp & 255u) == 0u) { if (xb_ld(&bar[XB_TMO])) break; if (sp > XB_SPIN_CAP) { atomicAdd(&bar[XB_TMO], 1u); break; } }
    }
    nloc = mine > 0u ? mine : 1u; nx = cnt > 0u ? cnt : 1u;
}

__device__ __forceinline__ void xcd_barrier(const XcdBarrier& b) {
    asm volatile("s_waitcnt vmcnt(0)" ::: "memory");
    __syncthreads();
    if (threadIdx.x == 0) {
        unsigned* bar = b.bar;
        __builtin_amdgcn_s_waitcnt(0);
        unsigned nloc = b.st[0], nx = b.st[1];
        if (nloc == 0u) { xcd_barrier_complete(bar, b.x, nloc, nx); b.st[0] = nloc; b.st[1] = nx; }
        const unsigned old = xb_add(&bar[XB_XSUB(b.x)], 1u);
        const unsigned gen = old / nloc;
        if (old + 1u == (gen + 1u) * nloc) {
            __builtin_amdgcn_fence(__ATOMIC_RELEASE, "agent");
            asm volatile("s_waitcnt vmcnt(0)" ::: "memory");
            const unsigned og = xb_add(&bar[XB_TOP], 1u);
            const unsigned tg = og / nx;
            if (og + 1u == (tg + 1u) * nx) xb_add(&bar[XB_TOPGEN], 1u);
            else XB_SPIN(xb_ld(&bar[XB_TOPGEN]) == tg, bar);
            __builtin_amdgcn_fence(__ATOMIC_ACQUIRE, "agent");
            xb_add(&bar[XB_XGEN(b.x)], 1u);
            asm volatile("s_waitcnt vmcnt(0)" ::: "memory");
        } else {
            XB_SPIN(xb_ld(&bar[XB_XGEN(b.x)]) == gen, bar);
            __builtin_amdgcn_fence(__ATOMIC_ACQUIRE, "agent");
            asm volatile("s_waitcnt vmcnt(0)" ::: "memory");
        }
    }
    __syncthreads();
}


namespace cg = cooperative_groups;
#ifndef REP_MASK
#define REP_MASK 0
#endif
#define REPS(k) (((REP_MASK) >> (k)) & 1 ? 2 : 1)
constexpr int PHASE_LDS = att::A_LDS_BYTES;
constexpr int MEGA_LDS = PHASE_LDS + 64;
static_assert(PHASE_LDS >= pg8::STAGE_BYTES && PHASE_LDS >= att::B_LDS_BYTES && PHASE_LDS >= peer::T_LDS_BYTES && PHASE_LDS >= 8 * 64 * 33 * 4 && PHASE_LDS >= apply::AP_LDS_BYTES, "LDS budget");
__global__ void __launch_bounds__(512, 2) mega_fwd(Ptrs P) {
    extern __shared__ __attribute__((aligned(16))) unsigned char lds_dyn[];
    volatile LAS unsigned* bst = (volatile LAS unsigned*)((LAS unsigned char*)lds_dyn + PHASE_LDS);
    if (threadIdx.x < 2) bst[threadIdx.x] = 0u;
    __syncthreads();
    const XcdBarrier bar = xcd_barrier_post((unsigned*)(P.ws + WS_CTL), bst);
    const int G = (int)gridDim.x, bx = (int)blockIdx.x, vcu = (G % 8 == 0) ? (bx % 8) * (G / 8) + bx / 8 : bx;
    unsigned char* ws = P.ws;
    PG8_LAS unsigned char* lds3 = (PG8_LAS unsigned char*)lds_dyn;
    for (int rep = 0; rep < REPS(0); ++rep) prep_phase(P, lds_dyn, G, bx);
    xcd_barrier(bar); if (REPS(9) == 2) xcd_barrier(bar);
    for (int rep = 0; rep < REPS(1); ++rep) {
      { pg8::Gemm g{(const bf16_t*)(ws + WS_XN), (const bf16_t*)(ws + WS_WIN), M, 1024, D, 0}; pg8::StaticOrder S; S.init(M, 1024, G, bx);
        pg8::gemm_phase<pg8::EpiProj, pg8::StaticOrder, true, true, false>(lds3, g, S, pg8::EpiProj{(bf16_t*)(ws + WS_PROJ), (const float*)(ws + WS_ROPE), 1.f, 0}); }
      { pg8::Gemm g{(const bf16_t*)(ws + WS_XN8), (const bf16_t*)(ws + WS_WIN8), M, INW - 1024, D / 2, 0}; pg8::StaticOrder S; S.init(M, INW - 1024, G, bx);
        pg8::gemm_phase<pg8::EpiProj, pg8::StaticOrder, true, true, true>(lds3, g, S, pg8::EpiProj{(bf16_t*)(ws + WS_PROJ), (const float*)(ws + WS_ROPE), 1.f / WIN_SCALE, 4}); } }
    xcd_barrier(bar); if (REPS(9) == 2) xcd_barrier(bar);
    { const float lam = lambda_full(P);
      for (int rep = 0; rep < REPS(2); ++rep) for (int u = vcu; u < BATCH * 4 * 8; u += G) att::attn_a_unit(u >> 5, (u >> 3) & 3, u & 7, (const bf16_t*)(ws + WS_PROJ), (bf16_t*)(ws + WS_YA), P.subln, lam, lds_dyn);
      for (int rep = 0; rep < REPS(3); ++rep) for (int u = vcu; u < BATCH * 8 * 8; u += G) att::attn_b_unit(u >> 6, (u >> 3) & 7, u & 7, (const bf16_t*)(ws + WS_PROJ), (bf16_t*)(ws + WS_YA), P.rpb, lds_dyn); }
    xcd_barrier(bar); if (REPS(9) == 2) xcd_barrier(bar);
    for (int rep = 0; rep < REPS(4); ++rep) { pg8::StaticOrder S; S.init(M, D, G, bx);
      pg8::gemm_phase<pg8::EpiGate2, pg8::StaticOrder, true, true>(lds3, pg8::Gemm{(const bf16_t*)(ws + WS_YA), (const bf16_t*)(ws + WS_WPA), M, D, D, 0}, S, pg8::EpiGate2{(const bf16_t*)(ws + WS_PROJ), (bf16_t*)(ws + WS_MERGED)}); }
    xcd_barrier(bar); if (REPS(9) == 2) xcd_barrier(bar);
    for (int rep = 0; rep < REPS(5); ++rep) { pg8::StaticOrder S; S.init(M, D, G, bx);
      pg8::gemm_phase<pg8::EpiHout, pg8::StaticOrder, true, true>(lds3, pg8::Gemm{(const bf16_t*)(ws + WS_MERGED), (const bf16_t*)(ws + WS_WOUT), M, D, D, 0}, S, pg8::EpiHout{P.x, P.out, (bf16_t*)(ws + WS_HB), (float*)(ws + WS_SSQ)});
    }
    xcd_barrier(bar); if (REPS(9) == 2) xcd_barrier(bar);
    { pg8::StaticOrder S; S.init(M, PQ, G, bx);
      for (int rep = 0; rep < REPS(8); ++rep)
        pg8::gemm_phase<pg8::EpiQ, pg8::StaticOrder, true, true>(lds3, pg8::Gemm{(const bf16_t*)(ws + WS_HB), (const bf16_t*)(ws + WS_WQ), M, PQ, D, 0}, S, pg8::EpiQ{(const float*)(ws + WS_SSQ), (bf16_t*)(ws + WS_Q)});
      asm volatile("s_waitcnt vmcnt(0)" ::: "memory");
      __syncthreads();
      if (threadIdx.x == 0) { __builtin_amdgcn_fence(__ATOMIC_ACQUIRE, "agent"); asm volatile("s_waitcnt vmcnt(0)" ::: "memory"); }
      __syncthreads();
      for (int rep = 0; rep < REPS(6); ++rep) peer::topk_own_units(P, lds_dyn, S); }
    xcd_barrier(bar); if (REPS(9) == 2) xcd_barrier(bar);
#ifndef PROBE_MODE
#define PROBE_MODE 0
#endif
    if (REPS(7) == 2) apply::apply_phase<PROBE_MODE>(P, (float*)(ws + WS_Q), lds_dyn, G, vcu);
    apply::apply_phase<0>(P, P.out, lds_dyn, G, vcu);
}

extern "C" void kernel_launch(void* const* d_in, const int* in_sizes, int n_in, void* d_out, int out_size, void* d_ws, size_t ws_size, hipStream_t stream) {
    if (n_in != 18 || ws_size < WS_END) { fprintf(stderr, "kernel_launch: unexpected n_in %d / ws_size %zu\n", n_in, ws_size); return; }
    Ptrs P{};
    P.x = (const float*)d_in[0]; P.w_in = (const float*)d_in[1]; P.w_pa = (const float*)d_in[2]; P.w_pb = (const float*)d_in[3]; P.w_out = (const float*)d_in[4];
    P.norm_mix = (const float*)d_in[5]; P.norm_ffn = (const float*)d_in[6]; P.norm_final = (const float*)d_in[7];
    P.lq1 = (const float*)d_in[8]; P.lk1 = (const float*)d_in[9]; P.lq2 = (const float*)d_in[10]; P.lk2 = (const float*)d_in[11];
    P.subln = (const float*)d_in[12]; P.rpb = (const float*)d_in[13]; P.w_query = (const float*)d_in[14]; P.sub_keys = (const float*)d_in[15];
    P.peer_u = (const float*)d_in[16]; P.peer_v = (const float*)d_in[17];
    P.out = (float*)d_out; P.ws = (unsigned char*)d_ws;
    static int grid_blocks = 0;
    if (!grid_blocks) {
        int dev = 0, cus = 0, per_cu = 0;
        hipGetDevice(&dev);
        hipDeviceGetAttribute(&cus, hipDeviceAttributeMultiprocessorCount, dev);
        hipFuncSetAttribute((const void*)mega_fwd, hipFuncAttributeMaxDynamicSharedMemorySize, MEGA_LDS);
        hipOccupancyMaxActiveBlocksPerMultiprocessor(&per_cu, (const void*)mega_fwd, 512, MEGA_LDS);
        if (per_cu < 1) { fprintf(stderr, "kernel_launch: occupancy query says %d blocks per CU\n", per_cu); per_cu = 1; }
        grid_blocks = cus * per_cu;
    }
    hipMemsetAsync((unsigned char*)d_ws + WS_CTL, 0, 16384, stream);
    void* args[] = {&P};
    hipError_t e = hipLaunchCooperativeKernel((const void*)mega_fwd, dim3(grid_blocks), dim3(512), args, MEGA_LDS, stream);
    if (e != hipSuccess) fprintf(stderr, "cooperative launch failed: %s (grid %d)\n", hipGetErrorString(e), grid_blocks);
}
```

```cpp
#include <hip/hip_runtime.h>
#include <hip/hip_cooperative_groups.h>
#include <cstdio>
#include <cstdint>

typedef unsigned short bf16_t;
typedef unsigned u32x4 __attribute__((ext_vector_type(4)));
typedef unsigned u32x2 __attribute__((ext_vector_type(2)));
typedef float f32x4 __attribute__((ext_vector_type(4)));
typedef __bf16 bf16x2_t __attribute__((ext_vector_type(2)));

constexpr int D = 1024, BATCH = 8, SEQ = 2048, M = BATCH * SEQ, INW = 5120;
constexpr int C_QA = 0, C_KA = 512, C_VA = 1024, C_QB = 1536, C_KB = 2048, C_VB = 2560, C_GA = 3072, C_GB = 4096;
constexpr int NEXP = 16384, PQ = 2048;
constexpr float EPS = 1e-6f;
constexpr float LOG2E = 1.4426950408889634f;
constexpr float WIN_SCALE = 32.f;
constexpr float QSCALE = 0.125f * LOG2E;

constexpr size_t MiB = 1u << 20;
constexpr size_t WS_PROJ = 0;
constexpr size_t WS_HB = 0;
constexpr size_t WS_Q = 32 * MiB;
constexpr size_t WS_U = 96 * MiB;
constexpr size_t WS_V = 112 * MiB;
constexpr size_t WS_SU = 128 * MiB;
constexpr size_t WS_SV = 128 * MiB + 65536;
constexpr size_t WS_XN = 160 * MiB;
constexpr size_t WS_YA = 160 * MiB;
constexpr size_t WS_YB = 176 * MiB;
constexpr size_t WS_IDX = 160 * MiB;
constexpr size_t WS_G = 168 * MiB;
constexpr size_t WS_MERGED = 192 * MiB;
constexpr size_t WS_TOPV = 192 * MiB;
constexpr size_t WS_TOPI = 208 * MiB;
constexpr size_t WS_WIN = 224 * MiB;
constexpr size_t WS_WIN8 = 226 * MiB;
constexpr size_t WS_XN8 = 192 * MiB;
constexpr size_t WS_WQ = 234 * MiB;
constexpr size_t WS_WOUT = 238 * MiB;
constexpr size_t WS_WPA = 240 * MiB;
constexpr size_t WS_WPB = 241 * MiB;
constexpr size_t WS_SK = 242 * MiB;
constexpr size_t WS_ROPE = 242 * MiB + 512 * 1024;
constexpr size_t WS_SSQ = 243 * MiB;
constexpr size_t WS_CTL = 244 * MiB;
constexpr size_t WS_END = 256 * MiB;

__device__ __forceinline__ float bf2f(unsigned v) { return __uint_as_float(v << 16); }
__device__ __forceinline__ float bflo(unsigned w) { return __uint_as_float(w << 16); }
__device__ __forceinline__ float bfhi(unsigned w) { return __uint_as_float(w & 0xffff0000u); }
__device__ __forceinline__ unsigned f2bf(float f) { unsigned u = __float_as_uint(f); return (u + 0x7fffu + ((u >> 16) & 1u)) >> 16; }
__device__ __forceinline__ unsigned pk2(float lo, float hi) { return f2bf(lo) | (f2bf(hi) << 16); }
__device__ __forceinline__ float wave_sum(float v) {
#pragma unroll
    for (int o = 1; o < 64; o <<= 1) v += __shfl_xor(v, o);
    return v;
}
__device__ __forceinline__ float sigmoidf_(float x) { return 1.f / (1.f + __expf(-x)); }
__device__ __forceinline__ float gelu_exact(float x) { return 0.5f * x * (1.f + erff(x * 0.70710678118654752f)); }

struct Ptrs {
    const float *x, *w_in, *w_pa, *w_pb, *w_out, *norm_mix, *norm_ffn, *norm_final, *lq1, *lk1, *lq2, *lk2, *subln, *rpb, *w_query, *sub_keys, *peer_u, *peer_v;
    float* out; unsigned char* ws;
};

__device__ __forceinline__ void transpose_item(const float* W, int K, int N, const float* gain, bf16_t* WT, float* scr, int item, int lane, int ldo = 0, int koff = 0, int ldw = 0) {
    if (ldo == 0) ldo = K;
    if (ldw == 0) ldw = N;
    const int nblk = N / 32, kb = item / nblk, nb = item % nblk, k0 = 64 * kb, n0 = 32 * nb;
    float wv[32];
#pragma unroll
    for (int i = 0; i < 32; ++i) { const int kk = 2 * i + (lane >> 5); wv[i] = W[(size_t)(k0 + kk) * ldw + n0 + (lane & 31)]; }
#pragma unroll
    for (int i = 0; i < 32; ++i) { const int kk = 2 * i + (lane >> 5); float w = wv[i]; if (gain) w *= gain[k0 + kk]; scr[kk * 33 + (lane & 31)] = w; }
    asm volatile("s_waitcnt lgkmcnt(0)" ::: "memory");
    const int c = lane & 7;
#pragma unroll
    for (int j = 0; j < 4; ++j) { const int n = (lane >> 3) + 8 * j; const float* s = scr + (8 * c) * 33 + n;
        u32x4 o; o.x = pk2(s[0 * 33], s[1 * 33]); o.y = pk2(s[2 * 33], s[3 * 33]); o.z = pk2(s[4 * 33], s[5 * 33]); o.w = pk2(s[6 * 33], s[7 * 33]);
        *(u32x4*)(WT + (size_t)(n0 + n) * ldo + koff + k0 + 8 * c) = o; }
    asm volatile("s_waitcnt lgkmcnt(0)" ::: "memory");
}
__device__ __forceinline__ void cvt8(const float* src, bf16_t* dst, size_t i8) {
    const f32x4 a = *(const f32x4*)(src + i8 * 8), b = *(const f32x4*)(src + i8 * 8 + 4);
    u32x4 o; o.x = pk2(a.x, a.y); o.y = pk2(a.z, a.w); o.z = pk2(b.x, b.y); o.w = pk2(b.z, b.w);
    *(u32x4*)(dst + i8 * 8) = o;
}
__device__ __forceinline__ void transpose_item8(const float* W, int K, int N, int ldw, const float* gain, float wscale, unsigned char* WT, float* scr, int item, int lane) {
    const int nblk = N / 32, kb = item / nblk, nb = item % nblk, k0 = 64 * kb, n0 = 32 * nb;
    float wv[32];
#pragma unroll
    for (int i = 0; i < 32; ++i) { const int kk = 2 * i + (lane >> 5); wv[i] = W[(size_t)(k0 + kk) * ldw + n0 + (lane & 31)]; }
#pragma unroll
    for (int i = 0; i < 32; ++i) { const int kk = 2 * i + (lane >> 5); float w = wv[i] * wscale; if (gain) w *= gain[k0 + kk]; scr[kk * 33 + (lane & 31)] = w; }
    asm volatile("s_waitcnt lgkmcnt(0)" ::: "memory");
    const int c = lane & 7;
#pragma unroll
    for (int j = 0; j < 4; ++j) { const int n = (lane >> 3) + 8 * j; const float* s = scr + (8 * c) * 33 + n;
        u32x2 o; o.x = __builtin_amdgcn_cvt_pk_fp8_f32(s[0 * 33], s[1 * 33], 0u, false); o.x = __builtin_amdgcn_cvt_pk_fp8_f32(s[2 * 33], s[3 * 33], o.x, true);
        o.y = __builtin_amdgcn_cvt_pk_fp8_f32(s[4 * 33], s[5 * 33], 0u, false); o.y = __builtin_amdgcn_cvt_pk_fp8_f32(s[6 * 33], s[7 * 33], o.y, true);
        *(u32x2*)(WT + (size_t)(n0 + n) * K + k0 + 8 * c) = o; }
    asm volatile("s_waitcnt lgkmcnt(0)" ::: "memory");
}
__device__ __forceinline__ void rms_rows_emit(const f32x4 (&v)[4], bf16_t* orow16, unsigned char* orow, int lane) {
    float s = 0.f;
#pragma unroll
    for (int j = 0; j < 4; ++j) s += (v[j].x * v[j].x + v[j].y * v[j].y) + (v[j].z * v[j].z + v[j].w * v[j].w);
    const float rstd = 1.f / sqrtf(wave_sum(s) * (1.f / D) + EPS);
    unsigned* o4 = (unsigned*)orow + lane; u32x2* o8 = (u32x2*)orow16 + lane;
#pragma unroll
    for (int j = 0; j < 4; ++j) { unsigned w = __builtin_amdgcn_cvt_pk_fp8_f32(v[j].x * rstd, v[j].y * rstd, 0u, false); w = __builtin_amdgcn_cvt_pk_fp8_f32(v[j].z * rstd, v[j].w * rstd, w, true); o4[64 * j] = w;
        u32x2 w2; w2.x = pk2(v[j].x * rstd, v[j].y * rstd); w2.y = pk2(v[j].z * rstd, v[j].w * rstd); o8[64 * j] = w2; }
}
__device__ __forceinline__ void rms_rows(const float* x, bf16_t* xn16, unsigned char* xn8, int m0, int step, int lane) {
    if (m0 >= M) return;
    f32x4 cur[4], nxt[4];
#pragma unroll
    for (int j = 0; j < 4; ++j) cur[j] = ((const f32x4*)(x + (size_t)m0 * D) + lane)[64 * j];
    for (int m = m0; m < M; m += step) {
        const int mn = (m + step < M) ? m + step : m;
#pragma unroll
        for (int j = 0; j < 4; ++j) nxt[j] = ((const f32x4*)(x + (size_t)mn * D) + lane)[64 * j];
        rms_rows_emit(cur, xn16 + (size_t)m * D, xn8 + (size_t)m * D, lane);
#pragma unroll
        for (int j = 0; j < 4; ++j) cur[j] = nxt[j];
    }
}
__device__ __forceinline__ void rms_row_to_bf16(const float* xrow, bf16_t* orow, int lane) {
    const f32x4* xr = (const f32x4*)xrow + lane;
    f32x4 v[4]; float s = 0.f;
#pragma unroll
    for (int j = 0; j < 4; ++j) { v[j] = xr[64 * j]; s += (v[j].x * v[j].x + v[j].y * v[j].y) + (v[j].z * v[j].z + v[j].w * v[j].w); }
    const float rstd = 1.f / sqrtf(wave_sum(s) * (1.f / D) + EPS);
    u32x2* o8 = (u32x2*)orow + lane;
#pragma unroll
    for (int j = 0; j < 4; ++j) { u32x2 w; w.x = pk2(v[j].x * rstd, v[j].y * rstd); w.y = pk2(v[j].z * rstd, v[j].w * rstd); o8[64 * j] = w; }
}

__device__ __forceinline__ void prep_phase(const Ptrs& P, unsigned char* shm, int G, int bx) {
    int tid_l = threadIdx.x; asm volatile("" : "+v"(tid_l));
    const int lane = tid_l & 63; const int wave = __builtin_amdgcn_readfirstlane(tid_l >> 6);
    const int gw = bx * 8 + wave, NGW = G * 8;
    float* scr = (float*)(shm + wave * (64 * 33 * 4));
    unsigned char* ws = P.ws;
    constexpr int N_BF = 1024;
    constexpr int I_INB = (D / 64) * (N_BF / 32), I_IN8 = (D / 64) * ((INW - N_BF) / 32), I_IN = I_INB + I_IN8, I_Q = (D / 64) * (PQ / 32), I_OUT = (D / 64) * (D / 32), I_PA = (512 / 64) * (D / 32);
    constexpr int NIT = I_IN + I_Q + I_OUT + 2 * I_PA;
    for (int it = gw; it < NIT; it += NGW) {
        int r = it;
        if (r < I_INB) { transpose_item(P.w_in, D, N_BF, P.norm_mix, (bf16_t*)(ws + WS_WIN), scr, r, lane, 0, 0, INW); continue; } r -= I_INB;
        if (r < I_IN8) { transpose_item8(P.w_in + N_BF, D, INW - N_BF, INW, P.norm_mix, WIN_SCALE, ws + WS_WIN8, scr, r, lane); continue; } r -= I_IN8;
        if (r < I_Q) { transpose_item(P.w_query, D, PQ, P.norm_ffn, (bf16_t*)(ws + WS_WQ), scr, r, lane); continue; } r -= I_Q;
        if (r < I_OUT) { transpose_item(P.w_out, D, D, nullptr, (bf16_t*)(ws + WS_WOUT), scr, r, lane); continue; } r -= I_OUT;
        if (r < I_PA) { transpose_item(P.w_pa, 512, D, nullptr, (bf16_t*)(ws + WS_WPA), scr, r, lane, 1024, 0); continue; } r -= I_PA;
        transpose_item(P.w_pb, 512, D, nullptr, (bf16_t*)(ws + WS_WPA), scr, r, lane, 1024, 512);
    }
    rms_rows(P.x, (bf16_t*)(ws + WS_XN), ws + WS_XN8, gw, NGW, lane);
    const size_t gt = (size_t)bx * 512 + threadIdx.x, NT = (size_t)G * 512;
    for (size_t i = gt; i < (size_t)16 * 128 * 128 / 8; i += NT) cvt8(P.sub_keys, (bf16_t*)(ws + WS_SK), i);
    for (size_t i = gt; i < (size_t)SEQ * 8; i += NT) {
        const int pos = (int)(i >> 3), k = (int)(i & 7);
        const float inv = k == 0 ? 1.0f : k == 1 ? 0.19392274f : k == 2 ? 0.03760603f : k == 3 ? 0.0072926646f : k == 4 ? 0.0014142136f : k == 5 ? 0.0002742482f : k == 6 ? 5.3182957e-05f : 1.0313385e-05f;
        const float ang = (float)pos * inv;
        float sn, cs; sincosf(ang, &sn, &cs);
        float* t = (float*)(ws + WS_ROPE) + (size_t)pos * 16;
        t[k] = cs; t[8 + k] = sn;
    }
}
__device__ __forceinline__ void cvt_row_fp8(const f32x4 (&rv)[4], unsigned char* dst, float* inv_scale, int lane) {
    const f32x4 a = rv[0], b = rv[1], c = rv[2], d = rv[3];
    float m = fmaxf(fmaxf(fmaxf(fabsf(a.x), fabsf(a.y)), fmaxf(fabsf(a.z), fabsf(a.w))), fmaxf(fmaxf(fabsf(b.x), fabsf(b.y)), fmaxf(fabsf(b.z), fabsf(b.w))));
    m = fmaxf(m, fmaxf(fmaxf(fmaxf(fabsf(c.x), fabsf(c.y)), fmaxf(fabsf(c.z), fabsf(c.w))), fmaxf(fmaxf(fabsf(d.x), fabsf(d.y)), fmaxf(fabsf(d.z), fabsf(d.w)))));
#pragma unroll
    for (int o = 1; o < 64; o <<= 1) m = fmaxf(m, __shfl_xor(m, o));
    m = fmaxf(m, 1e-30f);
    const float sc = 256.f / m;
    u32x4 w;
    w.x = __builtin_amdgcn_cvt_pk_fp8_f32(a.x * sc, a.y * sc, 0u, false); w.x = __builtin_amdgcn_cvt_pk_fp8_f32(a.z * sc, a.w * sc, w.x, true);
    w.y = __builtin_amdgcn_cvt_pk_fp8_f32(b.x * sc, b.y * sc, 0u, false); w.y = __builtin_amdgcn_cvt_pk_fp8_f32(b.z * sc, b.w * sc, w.y, true);
    w.z = __builtin_amdgcn_cvt_pk_fp8_f32(c.x * sc, c.y * sc, 0u, false); w.z = __builtin_amdgcn_cvt_pk_fp8_f32(c.z * sc, c.w * sc, w.z, true);
    w.w = __builtin_amdgcn_cvt_pk_fp8_f32(d.x * sc, d.y * sc, 0u, false); w.w = __builtin_amdgcn_cvt_pk_fp8_f32(d.z * sc, d.w * sc, w.w, true);
    *(u32x4*)(dst + (size_t)(lane >> 5) * (NEXP * 512) + (lane & 31) * 16) = w;
    if (lane == 0) *inv_scale = m * (1.f / 256.f);
}
__device__ __forceinline__ unsigned nib4(float v, float sc) { const int q = (int)rintf(fminf(fmaxf(v * sc, -7.f), 7.f)); return (unsigned)q & 15u; }
__device__ __forceinline__ unsigned pack_i4x8(const f32x4& a, const f32x4& b, float sc) {
    return nib4(a.x, sc) | (nib4(a.y, sc) << 4) | (nib4(a.z, sc) << 8) | (nib4(a.w, sc) << 12) | (nib4(b.x, sc) << 16) | (nib4(b.y, sc) << 20) | (nib4(b.z, sc) << 24) | (nib4(b.w, sc) << 28);
}
__device__ __forceinline__ void cvt_row_i4(const f32x4 (&rv)[4], unsigned char* dst, float* inv_scale, int lane) {
    const f32x4 a = rv[0], b = rv[1], c = rv[2], d = rv[3];
    float ss = ((a.x * a.x + a.y * a.y) + (a.z * a.z + a.w * a.w)) + ((b.x * b.x + b.y * b.y) + (b.z * b.z + b.w * b.w));
    ss += ((c.x * c.x + c.y * c.y) + (c.z * c.z + c.w * c.w)) + ((d.x * d.x + d.y * d.y) + (d.z * d.z + d.w * d.w));
#pragma unroll
    for (int o = 1; o < 64; o <<= 1) ss += __shfl_xor(ss, o);
    const float rms = fmaxf(sqrtf(ss * (1.f / D)), 1e-30f);
    const float sc = 2.8f / rms;
    u32x2 w; w.x = pack_i4x8(a, b, sc); w.y = pack_i4x8(c, d, sc);
    *(u32x2*)(dst + (lane >> 5) * 256 + (lane & 15) * 16 + ((lane >> 4) & 1) * 8) = w;
    if (lane == 0) *inv_scale = rms * (2.5f / 7.f);
}
__device__ __forceinline__ unsigned pack_i8x4(float a, float b, float c, float d) {
    const int q0 = (int)rintf(a), q1 = (int)rintf(b), q2 = (int)rintf(c), q3 = (int)rintf(d);
    return (unsigned)(q0 & 0xff) | ((unsigned)(q1 & 0xff) << 8) | ((unsigned)(q2 & 0xff) << 16) | ((unsigned)q3 << 24);
}
__device__ __forceinline__ void cvt_row_i8(const f32x4 (&rv)[4], unsigned char* dst, float* inv_scale, int lane) {
    const f32x4 a = rv[0], b = rv[1], c = rv[2], d = rv[3];
    float m = fmaxf(fmaxf(fmaxf(fabsf(a.x), fabsf(a.y)), fmaxf(fabsf(a.z), fabsf(a.w))), fmaxf(fmaxf(fabsf(b.x), fabsf(b.y)), fmaxf(fabsf(b.z), fabsf(b.w))));
    m = fmaxf(m, fmaxf(fmaxf(fmaxf(fabsf(c.x), fabsf(c.y)), fmaxf(fabsf(c.z), fabsf(c.w))), fmaxf(fmaxf(fabsf(d.x), fabsf(d.y)), fmaxf(fabsf(d.z), fabsf(d.w)))));
#pragma unroll
    for (int o = 1; o < 64; o <<= 1) m = fmaxf(m, __shfl_xor(m, o));
    m = fmaxf(m, 1e-30f);
    const float sc = 127.f / m;
    u32x4 w;
    w.x = pack_i8x4(a.x * sc, a.y * sc, a.z * sc, a.w * sc); w.y = pack_i8x4(b.x * sc, b.y * sc, b.z * sc, b.w * sc);
    w.z = pack_i8x4(c.x * sc, c.y * sc, c.z * sc, c.w * sc); w.w = pack_i8x4(d.x * sc, d.y * sc, d.z * sc, d.w * sc);
    *(u32x4*)(dst + (size_t)(lane >> 5) * (NEXP * 512) + (lane & 31) * 16) = w;
    if (lane == 0) *inv_scale = m * (1.f / 127.f);
}
__device__ __forceinline__ void cvt_experts_phase(const Ptrs& P, int G, int bx) {
    int tid_l = threadIdx.x; asm volatile("" : "+v"(tid_l));
    const int lane = tid_l & 63; const int wave = __builtin_amdgcn_readfirstlane(tid_l >> 6);
    const int step = G * 8; int r = bx * 8 + wave;
    if (r >= 2 * NEXP) return;
    f32x4 cur[4], nxt[4];
    { const float* src = (r < NEXP ? P.peer_u + (size_t)r * D : P.peer_v + (size_t)(r - NEXP) * D);
#pragma unroll
      for (int j = 0; j < 4; ++j) cur[j] = ((const f32x4*)src + lane * 4)[j]; }
    for (; r < 2 * NEXP; r += step) {
        const int rn = (r + step < 2 * NEXP) ? r + step : r;
        const float* srcn = (rn < NEXP ? P.peer_u + (size_t)rn * D : P.peer_v + (size_t)(rn - NEXP) * D);
#pragma unroll
        for (int j = 0; j < 4; ++j) nxt[j] = ((const f32x4*)srcn + lane * 4)[j];
        if (r < NEXP) cvt_row_i8(cur, P.ws + WS_U + (size_t)r * 512, (float*)(P.ws + WS_SU) + r, lane);
        else { const int e = r - NEXP; cvt_row_fp8(cur, P.ws + WS_V + (size_t)e * 512, (float*)(P.ws + WS_SV) + e, lane); }
#pragma unroll
        for (int j = 0; j < 4; ++j) cur[j] = nxt[j];
    }
}

namespace pg8 {
#define PG8_LAS __attribute__((address_space(3)))
typedef unsigned short bf16_t;
typedef short bf16x8 __attribute__((ext_vector_type(8)));
typedef float f32x4 __attribute__((ext_vector_type(4)));
typedef unsigned u32x4 __attribute__((ext_vector_type(4)));
typedef int v8i_t __attribute__((ext_vector_type(8)));
constexpr int BM = 256, BK = 64, HALF = 128, HTB = HALF * BK * 2  , STAGE_BYTES = 8 * HTB, NXCD = 8, WGM = 4;

__host__ __device__ __forceinline__ int lds_byte(int r, int c) { const int st = (r >> 4) * 2 + (c >> 5), rr = r & 15, cc = c & 31, ob = rr * 64 + cc * 2; return st * 1024 + (ob ^ (((ob >> 9) & 1) << 5)); }
__host__ __device__ __forceinline__ void stage_rc(int b, int& R, int& C) { const int st = b / 1024, sb = b % 1024, swz = sb ^ (((sb >> 9) & 1) << 5); R = (st >> 1) * 16 + swz / 64; C = (st & 1) * 32 + (swz % 64) / 2; }
__host__ __device__ __forceinline__ int perm32(int rho) { const int n = rho >> 4, i = rho & 15; return 8 * (i >> 2) + 4 * n + (i & 3); }

struct Unit { int pm, pn; };
struct Gemm { const bf16_t* A; const bf16_t* Bt; int M, N, K, pad; };

struct StaticOrder {
    int nM, nN, nwg, G, c;
    __host__ __device__ void init(int M, int N, int G_, int c_) { nM = M / BM; nN = N / BM; nwg = nM * nN; G = G_; c = c_; }
    __host__ __device__ bool next(int i, Unit& u) const {
        const long L = (long)i * G + c; if (L >= nwg) return false;
        int wgid = (int)L; { const int q = nwg / NXCD, r = nwg % NXCD, xcd = wgid % NXCD, off = wgid / NXCD; wgid = (xcd < r ? xcd * (q + 1) : r * (q + 1) + (xcd - r) * q) + off; }
        const int nig = WGM * nN, gid = wgid / nig, fm = gid * WGM, gsz = (nM - fm) < WGM ? (nM - fm) : WGM;
        u.pm = fm + ((wgid % nig) % gsz); u.pn = (wgid % nig) / gsz; return true;
    }
    __device__ __forceinline__ void a_ready(const Unit&) const {}
    __device__ __forceinline__ void done(const Unit&) const {}
};
__device__ __forceinline__ unsigned cvt_pk_bf16(float lo, float hi) { unsigned r; asm volatile("v_cvt_pk_bf16_f32 %0, %1, %2" : "=v"(r) : "v"(lo), "v"(hi)); return r; }
typedef float f32x2 __attribute__((ext_vector_type(2)));

__device__ __forceinline__ float sigm(float x) { return __builtin_amdgcn_rcpf(1.f + __builtin_amdgcn_exp2f(-1.4426950408889634f * x)); }
struct EpiProj {
    static constexpr bool PERM = true, AFTER_DRAIN = false, MID = false;
    bf16_t* O; const float* rope; float osc; int pn0;
    __device__ __forceinline__ void operator()(const f32x4 (&acc)[2][2][4][2], const Unit& u, int wr, int wc, int fr_, int fq_) const {
        int fr = fr_, fq = fq_; asm volatile("" : "+v"(fr), "+v"(fq));
        const int pn = u.pn + pn0;
        const int row0 = u.pm * BM + wr * 64 + fr, col0 = pn * BM + wc * 32 + 8 * fq;
        const float sc = ((pn < 2 || pn == 6 || pn == 7) ? QSCALE : 1.f) * osc;
        const bool dorope = (pn < 4) && ((wc & 1) == 0);
#pragma unroll
        for (int ai = 0; ai < 2; ++ai)
#pragma unroll
            for (int m = 0; m < 4; ++m) { const int row = row0 + ai * HALF + m * 16; bf16_t* rowp = O + (size_t)row * INW + col0;
                f32x4 c4[2] = {{1.f, 1.f, 1.f, 1.f}, {1.f, 1.f, 1.f, 1.f}}, s4[2] = {{0.f, 0.f, 0.f, 0.f}, {0.f, 0.f, 0.f, 0.f}};
                if (dorope) { const float* rp = rope + (size_t)(row & (SEQ - 1)) * 16; c4[0] = *(const f32x4*)(rp); c4[1] = *(const f32x4*)(rp + 4); s4[0] = *(const f32x4*)(rp + 8); s4[1] = *(const f32x4*)(rp + 12); }
#pragma unroll
                for (int bj = 0; bj < 2; ++bj) { f32x4 v0 = acc[ai][bj][m][0], v1 = acc[ai][bj][m][1];
                    if (dorope) { f32x4 o0, o1;
#pragma unroll
                        for (int j = 0; j < 4; ++j) { o0[j] = __shfl_xor(v0[j], 16); o1[j] = __shfl_xor(v1[j], 16); }
                        if (fq == 0) { v0 = v0 * c4[0] - o0 * s4[0]; v1 = v1 * c4[1] - o1 * s4[1]; }
                        else if (fq == 1) { v0 = v0 * c4[0] + o0 * s4[0]; v1 = v1 * c4[1] + o1 * s4[1]; } }
                    v0 = v0 * sc; v1 = v1 * sc; u32x4 w; w.x = cvt_pk_bf16(v0[0], v0[1]); w.y = cvt_pk_bf16(v0[2], v0[3]); w.z = cvt_pk_bf16(v1[0], v1[1]); w.w = cvt_pk_bf16(v1[2], v1[3]);
                    *(u32x4*)(rowp + bj * HALF) = w; } }
    }
};
struct EpiGate2 {
    static constexpr bool PERM = true, AFTER_DRAIN = false, MID = true;
    const bf16_t* proj; bf16_t* O;
    __device__ __forceinline__ void mid(f32x4 (&acc)[2][2][4][2], const Unit& u, int wr, int wc, int fr, int fq) const {
        int row0 = u.pm * BM + wr * 64 + fr, col0 = u.pn * BM + wc * 32 + 8 * fq;
        asm volatile("" : "+v"(row0), "+v"(col0));
#pragma unroll
        for (int ai = 0; ai < 2; ++ai) {
            u32x4 gav[4][2], gbv[4][2];
#pragma unroll
            for (int m = 0; m < 4; ++m)
#pragma unroll
                for (int bj = 0; bj < 2; ++bj) { const bf16_t* gp = proj + (size_t)(row0 + ai * HALF + m * 16) * INW + col0 + bj * HALF; gav[m][bj] = *(const u32x4*)(gp + C_GA); gbv[m][bj] = *(const u32x4*)(gp + C_GB); }
#pragma unroll
            for (int m = 0; m < 4; ++m) {
#pragma unroll
                for (int bj = 0; bj < 2; ++bj) { const u32x4 ga = gav[m][bj], gb = gbv[m][bj];
                    const unsigned a_[4] = {ga.x, ga.y, ga.z, ga.w}, b_[4] = {gb.x, gb.y, gb.z, gb.w};
#pragma unroll
                    for (int q = 0; q < 4; ++q) {
                        const float r0 = (1.f + __builtin_amdgcn_exp2f(-1.4426950408889634f * bflo(b_[q]))) * __builtin_amdgcn_rcpf(1.f + __builtin_amdgcn_exp2f(-1.4426950408889634f * bflo(a_[q])));
                        const float r1 = (1.f + __builtin_amdgcn_exp2f(-1.4426950408889634f * bfhi(b_[q]))) * __builtin_amdgcn_rcpf(1.f + __builtin_amdgcn_exp2f(-1.4426950408889634f * bfhi(a_[q])));
                        acc[ai][bj][m][q >> 1][(q & 1) * 2] *= r0; acc[ai][bj][m][q >> 1][(q & 1) * 2 + 1] *= r1; } } }
            asm volatile("" ::: "memory"); }
    }
    __device__ __forceinline__ void operator()(const f32x4 (&acc)[2][2][4][2], const Unit& u, int wr, int wc, int fr_, int fq_) const {
        int fr = fr_, fq = fq_; asm volatile("" : "+v"(fr), "+v"(fq));
        const int row0 = u.pm * BM + wr * 64 + fr, col0 = u.pn * BM + wc * 32 + 8 * fq;
#pragma unroll
        for (int ai = 0; ai < 2; ++ai) {
            u32x4 gv[4][2];
#pragma unroll
            for (int m = 0; m < 4; ++m)
#pragma unroll
                for (int bj = 0; bj < 2; ++bj) gv[m][bj] = *(const u32x4*)(proj + (size_t)(row0 + ai * HALF + m * 16) * INW + C_GB + col0 + bj * HALF);
#pragma unroll
            for (int m = 0; m < 4; ++m) { const int row = row0 + ai * HALF + m * 16;
#pragma unroll
                for (int bj = 0; bj < 2; ++bj) { const int col = col0 + bj * HALF; const u32x4 g = gv[m][bj];
                    f32x4 v0 = acc[ai][bj][m][0], v1 = acc[ai][bj][m][1];
                    v0[0] *= sigm(bflo(g.x)); v0[1] *= sigm(bfhi(g.x)); v0[2] *= sigm(bflo(g.y)); v0[3] *= sigm(bfhi(g.y));
                    v1[0] *= sigm(bflo(g.z)); v1[1] *= sigm(bfhi(g.z)); v1[2] *= sigm(bflo(g.w)); v1[3] *= sigm(bfhi(g.w));
                    u32x4 w; w.x = cvt_pk_bf16(v0[0], v0[1]); w.y = cvt_pk_bf16(v0[2], v0[3]); w.z = cvt_pk_bf16(v1[0], v1[1]); w.w = cvt_pk_bf16(v1[2], v1[3]);
                    *(u32x4*)(O + (size_t)row * D + col) = w; } }
            asm volatile("" ::: "memory"); }
    }
};
struct EpiHout {
    static constexpr bool PERM = true, AFTER_DRAIN = false, MID = false;
    const float* x; float* H; bf16_t* HB; float* ssq16;
    __device__ __forceinline__ void operator()(const f32x4 (&acc)[2][2][4][2], const Unit& u, int wr, int wc, int fr_, int fq_) const {
        int fr = fr_, fq = fq_; asm volatile("" : "+v"(fr), "+v"(fq));
        const int row0 = u.pm * BM + wr * 64 + fr, col0 = u.pn * BM + wc * 32 + 8 * fq;
#pragma unroll
        for (int ai = 0; ai < 2; ++ai) {
            f32x4 xv[4][2][2];
#pragma unroll
            for (int m = 0; m < 4; ++m)
#pragma unroll
                for (int bj = 0; bj < 2; ++bj) { const float* xp = x + (size_t)(row0 + ai * HALF + m * 16) * D + col0 + bj * HALF; xv[m][bj][0] = *(const f32x4*)xp; xv[m][bj][1] = *(const f32x4*)(xp + 4); }
#pragma unroll
            for (int m = 0; m < 4; ++m) { const int row = row0 + ai * HALF + m * 16; float ss = 0.f;
#pragma unroll
                for (int bj = 0; bj < 2; ++bj) { const int col = col0 + bj * HALF;
                    const f32x4 v0 = acc[ai][bj][m][0] + xv[m][bj][0], v1 = acc[ai][bj][m][1] + xv[m][bj][1];
                    u32x4 w; w.x = cvt_pk_bf16(v0[0], v0[1]); w.y = cvt_pk_bf16(v0[2], v0[3]); w.z = cvt_pk_bf16(v1[0], v1[1]); w.w = cvt_pk_bf16(v1[2], v1[3]);
                    *(u32x4*)(HB + (size_t)row * D + col) = w;
                    ss += (v0[0] * v0[0] + v0[1] * v0[1]) + (v0[2] * v0[2] + v0[3] * v0[3]) + (v1[0] * v1[0] + v1[1] * v1[1]) + (v1[2] * v1[2] + v1[3] * v1[3]); }
                ss += __shfl_xor(ss, 16); ss += __shfl_xor(ss, 32);
                if (fq == 0) ssq16[(size_t)row * 16 + u.pn * 4 + wc] = ss; }
            asm volatile("" ::: "memory"); }
    }
};
struct EpiQ {
    static constexpr bool PERM = true, AFTER_DRAIN = false, MID = false;
    const float* ssq16; bf16_t* O;
    __device__ __forceinline__ void operator()(const f32x4 (&acc)[2][2][4][2], const Unit& u, int wr, int wc, int fr, int fq) const {
        const int row0 = u.pm * BM + wr * 64 + fr, col0 = u.pn * BM + wc * 32 + 8 * fq;
#pragma unroll
        for (int ai = 0; ai < 2; ++ai)
#pragma unroll
            for (int m = 0; m < 4; ++m) { const int row = row0 + ai * HALF + m * 16; const f32x4* sp = (const f32x4*)(ssq16 + (size_t)row * 16);
                const f32x4 a = sp[0], b = sp[1], c = sp[2], d = sp[3];
                const float tot = ((a[0] + a[1]) + (a[2] + a[3])) + ((b[0] + b[1]) + (b[2] + b[3])) + ((c[0] + c[1]) + (c[2] + c[3])) + ((d[0] + d[1]) + (d[2] + d[3]));
                const float rstd = 1.f / sqrtf(tot * (1.f / D) + EPS);
#pragma unroll
                for (int bj = 0; bj < 2; ++bj) { const f32x4 v0 = acc[ai][bj][m][0] * rstd, v1 = acc[ai][bj][m][1] * rstd;
                    u32x4 w; w.x = cvt_pk_bf16(v0[0], v0[1]); w.y = cvt_pk_bf16(v0[2], v0[3]); w.z = cvt_pk_bf16(v1[0], v1[1]); w.w = cvt_pk_bf16(v1[2], v1[3]);
                    *(u32x4*)(O + (size_t)row * PQ + col0 + bj * HALF) = w; } }
    }
};
template <class Epi, class Sched, bool ALIGN_EPI = false, bool SP2 = false, bool FP8 = false>
__device__ __forceinline__ void gemm_phase(PG8_LAS unsigned char* lds, const Gemm g, const Sched& S, const Epi& E) {
    int tid_l = threadIdx.x; asm volatile("" : "+v"(tid_l));
    const int tid = tid_l, wid = __builtin_amdgcn_readfirstlane(tid >> 6), lane = tid & 63, wr = wid >> 2, wc = wid & 3, fr = lane & 15, fq = lane >> 4;
    const int K = g.K, nt = K / BK;
    unsigned voffA[2], voffB[2];
#pragma unroll
    for (int i = 0; i < 2; ++i) { int R, C; stage_rc(tid * 16 + i * 8192, R, C); const int Rb = Epi::PERM ? ((R & ~31) + perm32(R & 31)) : R;
        voffA[i] = (unsigned)(R * K + C) * 2u; voffB[i] = (unsigned)(Rb * K + C) * 2u; }
    const size_t kstep = (size_t)(BK * 2);
    const size_t hstep = (size_t)HALF * K * 2;
    const size_t tstep = 2 * hstep;
    const unsigned ldsw = (unsigned)wid * 1024u;
    const int aoff = lds_byte(wr * 64 + fr, fq * 8), boff = lds_byte(wc * 32 + fr, fq * 8);
    const int aoffF0 = FP8 ? lds_byte(wr * 64 + fr, fq * 16) : 0, boffF0 = FP8 ? lds_byte(wc * 32 + fr, fq * 16) : 0;
#define PG8_SA(b, h) (((b) * 2 + (h)) * HTB)
#define PG8_SB(b, h) ((4 + (b) * 2 + (h)) * HTB)
#define PG8_STAGE(bufoff, gbase, voff) do { _Pragma("unroll") for (int _i = 0; _i < 2; ++_i) \
        __builtin_amdgcn_global_load_lds((const unsigned*)((const char*)(gbase) + (voff)[_i]), (PG8_LAS unsigned*)(lds + (bufoff) + ldsw + _i * 8192), 16, 0, 0); } while (0)
#define PG8_LDA(dst, b, h) do { if constexpr (FP8) { _Pragma("unroll") for (int m = 0; m < 4; ++m) { const u32x4 l_ = *(const PG8_LAS u32x4*)(lds + PG8_SA(b, h) + aoffF0 + m * 2048), h_ = *(const PG8_LAS u32x4*)(lds + PG8_SA(b, h) + aoffF0 + m * 2048 + 16); \
            dst##8[m] = (v8i_t){(int)l_.x, (int)l_.y, (int)l_.z, (int)l_.w, (int)h_.x, (int)h_.y, (int)h_.z, (int)h_.w}; } } \
        else { _Pragma("unroll") for (int m = 0; m < 4; ++m) _Pragma("unroll") for (int k = 0; k < 2; ++k) dst[m][k] = *(const PG8_LAS bf16x8*)(lds + PG8_SA(b, h) + aoff + m * 2048 + k * 1024); } } while (0)
#define PG8_LDB(dst, b, h) do { if constexpr (FP8) { _Pragma("unroll") for (int n = 0; n < 2; ++n) { const u32x4 l_ = *(const PG8_LAS u32x4*)(lds + PG8_SB(b, h) + boffF0 + n * 2048), h_ = *(const PG8_LAS u32x4*)(lds + PG8_SB(b, h) + boffF0 + n * 2048 + 16); \
            dst##8[n] = (v8i_t){(int)l_.x, (int)l_.y, (int)l_.z, (int)l_.w, (int)h_.x, (int)h_.y, (int)h_.z, (int)h_.w}; } } \
        else { _Pragma("unroll") for (int n = 0; n < 2; ++n) _Pragma("unroll") for (int k = 0; k < 2; ++k) dst[n][k] = *(const PG8_LAS bf16x8*)(lds + PG8_SB(b, h) + boff + n * 2048 + k * 1024); } } while (0)
#define PG8_MMA(ai, bj, At, Bt) do { __builtin_amdgcn_s_setprio(1); \
        if constexpr (FP8) { _Pragma("unroll") for (int m = 0; m < 4; ++m) _Pragma("unroll") for (int n = 0; n < 2; ++n) \
            asm volatile("v_mfma_scale_f32_16x16x128_f8f6f4 %0, %1, %2, %0, %3, %3 op_sel_hi:[0,0,0]" : "+v"(acc[ai][bj][m][n]) : "v"(Bt##8[n]), "v"(At##8[m]), "v"(mxone)); } \
        else { _Pragma("unroll") for (int m = 0; m < 4; ++m) _Pragma("unroll") for (int n = 0; n < 2; ++n) _Pragma("unroll") for (int k = 0; k < 2; ++k) \
            acc[ai][bj][m][n] = __builtin_amdgcn_mfma_f32_16x16x32_bf16(Bt[n][k], At[m][k], acc[ai][bj][m][n], 0, 0, 0); } \
        __builtin_amdgcn_s_setprio(0); } while (0)
#define PG8_WAIT_V(n) asm volatile("s_waitcnt vmcnt(" #n ")" ::: "memory")
#define PG8_WAIT_L(n) asm volatile("s_waitcnt lgkmcnt(" #n ")" ::: "memory")
#define PG8_BAR __builtin_amdgcn_s_barrier()
#define PG8_SCHED __builtin_amdgcn_sched_barrier(0)
    Unit cur, nxt; int ui = 0;
    if (!S.next(0, cur)) return;
    f32x4 acc[2][2][4][2];
#pragma unroll
    for (int a = 0; a < 2; ++a)
#pragma unroll
        for (int b = 0; b < 2; ++b)
#pragma unroll
            for (int m = 0; m < 4; ++m)
#pragma unroll
                for (int n = 0; n < 2; ++n) acc[a][b][m][n] = (f32x4){0.f, 0.f, 0.f, 0.f};
    bf16x8 At[4][2], B0[2][2], B1[2][2]; v8i_t At8[4], B08[2], B18[2];
    int mxone = 0x7F7F7F7F; asm volatile("" : "+v"(mxone));
    const char* cA = (const char*)g.A + (size_t)cur.pm * tstep; const char* cB = (const char*)g.Bt + (size_t)cur.pn * tstep;
    S.a_ready(cur);
    if constexpr (SP2) {
        PG8_STAGE(PG8_SB(0, 0), cB, voffB); PG8_STAGE(PG8_SB(0, 1), cB + hstep, voffB); PG8_STAGE(PG8_SA(0, 0), cA, voffA); PG8_STAGE(PG8_SA(0, 1), cA + hstep, voffA);
        if (wr == 1) PG8_BAR;
        PG8_WAIT_V(2); PG8_BAR;
        PG8_STAGE(PG8_SB(1, 0), cB + kstep, voffB); PG8_STAGE(PG8_SA(1, 0), cA + kstep, voffA); PG8_STAGE(PG8_SB(1, 1), cB + hstep + kstep, voffB);
        PG8_WAIT_V(6); PG8_BAR;
    } else {
        PG8_STAGE(PG8_SB(0, 0), cB, voffB); PG8_STAGE(PG8_SA(0, 0), cA, voffA); PG8_STAGE(PG8_SB(0, 1), cB + hstep, voffB); PG8_STAGE(PG8_SA(0, 1), cA + hstep, voffA);
        if (wr == 1) PG8_BAR;
        PG8_WAIT_V(4); PG8_BAR;
        PG8_STAGE(PG8_SB(1, 0), cB + kstep, voffB); PG8_STAGE(PG8_SA(1, 0), cA + kstep, voffA); PG8_STAGE(PG8_SB(1, 1), cB + hstep + kstep, voffB);
        PG8_WAIT_V(6); PG8_BAR;
    }
    for (;;) {
        const bool has_next = S.next(ui + 1, nxt);
        const char* nA = has_next ? (const char*)g.A + (size_t)nxt.pm * tstep : cA; const char* nB = has_next ? (const char*)g.Bt + (size_t)nxt.pn * tstep : cB;
#pragma unroll 1
        for (int t = 0; t < nt; t += 2) {
            if constexpr (Epi::MID) { if (t == nt / 2) E.mid(acc, cur, wr, wc, fr, fq); }
            const bool last = (t == nt - 2);
            const char* a1 = cA + (size_t)(t + 1) * kstep;
            const char* a2 = last ? nA : cA + (size_t)(t + 2) * kstep; const char* b2 = last ? nB : cB + (size_t)(t + 2) * kstep;
            const char* a3 = a2 + kstep; const char* b3 = b2 + kstep;
            if (last && has_next) S.a_ready(nxt);
            if constexpr (SP2) {
            PG8_LDB(B0, 0, 0); PG8_LDB(B1, 0, 1); PG8_SCHED; PG8_LDA(At, 0, 0); PG8_STAGE(PG8_SA(1, 1), a1 + hstep, voffA);
            PG8_WAIT_V(8); PG8_WAIT_L(0); PG8_BAR; PG8_MMA(0, 0, At, B0); PG8_MMA(0, 1, At, B1); PG8_BAR; PG8_SCHED;
            PG8_LDA(At, 0, 1); PG8_STAGE(PG8_SB(0, 0), b2, voffB); PG8_STAGE(PG8_SB(0, 1), b2 + hstep, voffB); PG8_STAGE(PG8_SA(0, 0), a2, voffA);
            PG8_WAIT_V(8); PG8_WAIT_L(0); PG8_BAR; PG8_MMA(1, 0, At, B0); PG8_MMA(1, 1, At, B1); PG8_BAR; PG8_SCHED;
            PG8_LDB(B0, 1, 0); PG8_LDB(B1, 1, 1); PG8_SCHED; PG8_LDA(At, 1, 0); PG8_STAGE(PG8_SA(0, 1), a2 + hstep, voffA);
            PG8_WAIT_V(8); PG8_WAIT_L(0); PG8_BAR; PG8_MMA(0, 0, At, B0); PG8_MMA(0, 1, At, B1); PG8_BAR; PG8_SCHED;
            PG8_LDA(At, 1, 1); PG8_STAGE(PG8_SB(1, 0), b3, voffB); PG8_STAGE(PG8_SB(1, 1), b3 + hstep, voffB); PG8_STAGE(PG8_SA(1, 0), a3, voffA);
            PG8_WAIT_V(8); PG8_WAIT_L(0); PG8_BAR; PG8_MMA(1, 0, At, B0); PG8_MMA(1, 1, At, B1); PG8_BAR; PG8_SCHED;
            } else {
            PG8_LDB(B0, 0, 0); PG8_SCHED; PG8_LDA(At, 0, 0); PG8_STAGE(PG8_SA(1, 1), a1 + hstep, voffA);
            PG8_WAIT_L(8); PG8_BAR; PG8_WAIT_L(0); PG8_MMA(0, 0, At, B0); PG8_BAR; PG8_SCHED;
            PG8_LDB(B1, 0, 1); PG8_STAGE(PG8_SB(0, 0), b2, voffB);
            PG8_BAR; PG8_WAIT_L(0); PG8_MMA(0, 1, At, B1); PG8_BAR;
            PG8_LDA(At, 0, 1); PG8_STAGE(PG8_SA(0, 0), a2, voffA);
            PG8_BAR; PG8_WAIT_L(0); PG8_MMA(1, 0, At, B0); PG8_BAR; PG8_SCHED;
            PG8_STAGE(PG8_SB(0, 1), b2 + hstep, voffB);
            PG8_WAIT_V(6); PG8_BAR; PG8_MMA(1, 1, At, B1); PG8_BAR;
            PG8_LDB(B0, 1, 0); PG8_SCHED; PG8_LDA(At, 1, 0); PG8_STAGE(PG8_SA(0, 1), a2 + hstep, voffA);
            PG8_WAIT_L(8); PG8_BAR; PG8_WAIT_L(0); PG8_MMA(0, 0, At, B0); PG8_BAR; PG8_SCHED;
            PG8_LDB(B1, 1, 1); PG8_STAGE(PG8_SB(1, 0), b3, voffB);
            PG8_BAR; PG8_WAIT_L(0); PG8_MMA(0, 1, At, B1); PG8_BAR;
            PG8_LDA(At, 1, 1); PG8_STAGE(PG8_SA(1, 0), a3, voffA);
            PG8_BAR; PG8_WAIT_L(0); PG8_MMA(1, 0, At, B0); PG8_BAR; PG8_SCHED;
            PG8_STAGE(PG8_SB(1, 1), b3 + hstep, voffB);
            PG8_WAIT_V(6); PG8_BAR; PG8_MMA(1, 1, At, B1); PG8_BAR;
            }
        }
        if constexpr (ALIGN_EPI) { if (wr == 0) PG8_BAR; }
        if constexpr (FP8) { asm volatile("s_nop 15\n\ts_nop 7" ::: "memory"); PG8_SCHED; }
        if constexpr (!Epi::AFTER_DRAIN) { E(acc, cur, wr, wc, fr, fq); S.done(cur); }
        if (!has_next) break;
#pragma unroll
        for (int a = 0; a < 2; ++a)
#pragma unroll
            for (int b = 0; b < 2; ++b)
#pragma unroll
                for (int m = 0; m < 4; ++m)
#pragma unroll
                    for (int n = 0; n < 2; ++n) acc[a][b][m][n] = (f32x4){0.f, 0.f, 0.f, 0.f};
        cur = nxt; cA = nA; cB = nB; ++ui;
        if constexpr (ALIGN_EPI) { if (wr == 1) PG8_BAR; }
    }
    PG8_WAIT_V(0);
    if constexpr (!ALIGN_EPI) { if (wr == 0) PG8_BAR; }
    PG8_BAR;
    if constexpr (Epi::AFTER_DRAIN) { E.fused(acc, cur, wr, wc, fr, fq, lds, wid, lane); S.done(cur); }
#undef PG8_SA
#undef PG8_SB
#undef PG8_STAGE
#undef PG8_LDA
#undef PG8_LDB
#undef PG8_MMA
#undef PG8_WAIT_V
#undef PG8_WAIT_L
#undef PG8_BAR
#undef PG8_SCHED
}
}

__device__ __forceinline__ float lambda_full(const Ptrs& P) {
    float a = 0.f, b = 0.f;
    for (int i = 0; i < 64; ++i) { a += P.lq1[i] * P.lk1[i]; b += P.lq2[i] * P.lk2[i]; }
    return __expf(a) - __expf(b) + 0.2f;
}

namespace att {
typedef short bf16x8 __attribute__((ext_vector_type(8)));
typedef short s16x4 __attribute__((ext_vector_type(4)));
typedef float f32x16 __attribute__((ext_vector_type(16)));
typedef float f32x2_t __attribute__((ext_vector_type(2)));
typedef __attribute__((address_space(3))) const char* lds_cptr;
typedef __attribute__((address_space(3))) char* lds_ptr;
__device__ __forceinline__ int crow(int r, int hi) { return (r & 3) + 8 * (r >> 2) + 4 * hi; }
__device__ __forceinline__ void glds16(const void* gsrc, unsigned lds_dst) { unsigned keep;
    asm volatile("s_mov_b32 %0, m0\n\ts_mov_b32 m0, %2\n\ts_nop 0\n\tglobal_load_lds_dwordx4 %1, off\n\ts_mov_b32 m0, %0" : "=&s"(keep) : "v"(gsrc), "s"(lds_dst) : "memory"); }
__device__ __forceinline__ unsigned cvtpk(float lo, float hi) { f32x2_t v = {lo, hi}; bf16x2_t b = __builtin_convertvector(v, bf16x2_t); return __builtin_bit_cast(unsigned, b); }
#define ATT_WAIT_BAR(N) asm volatile("s_waitcnt vmcnt(" #N ") lgkmcnt(0)\n\ts_barrier" ::: "memory")
#define ATT_LDSWAIT() asm volatile("s_waitcnt lgkmcnt(0)" ::: "memory")
#define ATT_SBAR() __builtin_amdgcn_sched_barrier(0)
template <bool REL> __device__ __forceinline__ void qkt(f32x16& p0, f32x16& p1, lds_cptr Kslot, const bf16x8* qr, const f32x16& negm, int r32, int hi) {
    lds_cptr kb = Kslot + hi * 1024 + r32 * 16;
#pragma unroll
    for (int d0 = 0; d0 < 4; ++d0) {
        const bf16x8 b0 = *(const __attribute__((address_space(3))) bf16x8*)(kb + d0 * 2048);
        const bf16x8 b1 = *(const __attribute__((address_space(3))) bf16x8*)(kb + d0 * 2048 + 512);
        if (d0 == 0) { if (REL) { p0 = __builtin_amdgcn_mfma_f32_32x32x16_bf16(b0, qr[0], negm, 0, 0, 0); p1 = __builtin_amdgcn_mfma_f32_32x32x16_bf16(b1, qr[0], negm, 0, 0, 0); }
                       else { p0 = __builtin_amdgcn_mfma_f32_32x32x16_bf16(b0, qr[0], f32x16{}, 0, 0, 0); p1 = __builtin_amdgcn_mfma_f32_32x32x16_bf16(b1, qr[0], f32x16{}, 0, 0, 0); } }
        else { p0 = __builtin_amdgcn_mfma_f32_32x32x16_bf16(b0, qr[d0], p0, 0, 0, 0); p1 = __builtin_amdgcn_mfma_f32_32x32x16_bf16(b1, qr[d0], p1, 0, 0, 0); } }
}
__device__ __forceinline__ float rowmax32(const f32x16& p0, const f32x16& p1) {
    float a = fmaxf(p0[0], p1[0]);
#pragma unroll
    for (int r = 1; r < 16; ++r) a = fmaxf(a, fmaxf(p0[r], p1[r]));
    auto rr = __builtin_amdgcn_permlane32_swap(__float_as_uint(a), __float_as_uint(a), false, false);
    return fmaxf(__uint_as_float(rr[0]), __uint_as_float(rr[1]));
}
__device__ __forceinline__ float halfsum(float a) { auto rr = __builtin_amdgcn_permlane32_swap(__float_as_uint(a), __float_as_uint(a), false, false); return __uint_as_float(rr[0]) + __uint_as_float(rr[1]); }
#define ATT_VREAD(lo, hi, d0) do { _Pragma("unroll") for (int ks = 0; ks < 4; ++ks) { \
        asm volatile("ds_read_b64_tr_b16 %0,%1 offset:%c2" : "=&v"(lo[ks]) : "v"(vb), "i"((d0) * 4096 + ks * 1024) : "memory"); \
        asm volatile("ds_read_b64_tr_b16 %0,%1 offset:%c2" : "=&v"(hi[ks]) : "v"(vb), "i"((d0) * 4096 + ks * 1024 + 512) : "memory"); } } while (0)
#define ATT_PK(lo, hi, k) (bf16x8){lo[k][0], lo[k][1], lo[k][2], lo[k][3], hi[k][0], hi[k][1], hi[k][2], hi[k][3]}
#define ATT_PVMMA(lo, hi, d0) do { \
        o[d0] = __builtin_amdgcn_mfma_f32_32x32x16_bf16(pa0, ATT_PK(lo, hi, 0), o[d0], 0, 0, 0); o[d0] = __builtin_amdgcn_mfma_f32_32x32x16_bf16(pa1, ATT_PK(lo, hi, 1), o[d0], 0, 0, 0); \
        o[d0] = __builtin_amdgcn_mfma_f32_32x32x16_bf16(pa2, ATT_PK(lo, hi, 2), o[d0], 0, 0, 0); o[d0] = __builtin_amdgcn_mfma_f32_32x32x16_bf16(pa3, ATT_PK(lo, hi, 3), o[d0], 0, 0, 0); } while (0)
template <int ND0> __device__ __forceinline__ void pv(f32x16* o, int vb, bf16x8 pa0, bf16x8 pa1, bf16x8 pa2, bf16x8 pa3) {
    s16x4 loA[4], hiA[4], loB[4], hiB[4];
    ATT_VREAD(loA, hiA, 0);
#pragma unroll
    for (int d0 = 0; d0 < ND0; d0 += 2) {
        if (d0 + 1 < ND0) { ATT_VREAD(loB, hiB, d0 + 1); asm volatile("s_waitcnt lgkmcnt(8)" ::: "memory"); } else { asm volatile("s_waitcnt lgkmcnt(0)" ::: "memory"); }
        ATT_SBAR();
        ATT_PVMMA(loA, hiA, d0);
        if (d0 + 1 < ND0) {
            if (d0 + 2 < ND0) { ATT_VREAD(loA, hiA, d0 + 2); asm volatile("s_waitcnt lgkmcnt(8)" ::: "memory"); } else { asm volatile("s_waitcnt lgkmcnt(0)" ::: "memory"); }
            ATT_SBAR();
            ATT_PVMMA(loB, hiB, d0 + 1);
        }
    }
}
#undef ATT_VREAD
#undef ATT_PVMMA
#undef ATT_PK
template <int DEAD> __device__ __forceinline__ constexpr bool live0(int r) { return DEAD != 2 || r >= 12; }
template <int DEAD> __device__ __forceinline__ constexpr bool live1(int r) { return DEAD != 1 || r < 4; }
template <int ND0, int THR, bool REL, int DEAD = 0> __device__ __forceinline__ void softmax_tile(f32x16& p0, f32x16& p1, float& mrun, float& lsum, f32x16& negm, bool first, f32x16* o, __attribute__((address_space(3))) float* wsf, int r32, int hi,
                                                                   u32x4& pw0, u32x4& pw1, u32x4& pw2, u32x4& pw3) {
    float rm;
    if (DEAD == 0) rm = rowmax32(p0, p1);
    else { float a = -3e38f;
#pragma unroll
        for (int r = 0; r < 16; ++r) { if (live0<DEAD>(r)) a = fmaxf(a, p0[r]); if (live1<DEAD>(r)) a = fmaxf(a, p1[r]); }
        auto rr = __builtin_amdgcn_permlane32_swap(__float_as_uint(a), __float_as_uint(a), false, false); rm = fmaxf(__uint_as_float(rr[0]), __uint_as_float(rr[1])); }
    if (!REL) rm -= mrun;
    if (first) {
        mrun = REL ? rm : mrun + rm;
        if (REL) {
#pragma unroll
            for (int r = 0; r < 16; ++r) { if (live0<DEAD>(r)) p0[r] -= rm; if (live1<DEAD>(r)) p1[r] -= rm; negm[r] = -mrun; } }
    } else if (__any(rm > (float)THR)) {
        const float dl = fmaxf(rm, 0.f), alpha = __builtin_amdgcn_exp2f(-dl); lsum *= alpha; mrun += dl;
        if (REL) {
#pragma unroll
            for (int r = 0; r < 16; ++r) { if (live0<DEAD>(r)) p0[r] -= dl; if (live1<DEAD>(r)) p1[r] -= dl; negm[r] = -mrun; } }
        if (hi == 0) wsf[r32] = alpha;
        ATT_LDSWAIT();
#pragma unroll
        for (int g = 0; g < 4; ++g) { const f32x4 a4 = *(const __attribute__((address_space(3))) f32x4*)(wsf + 8 * g + 4 * hi);
#pragma unroll
            for (int d0 = 0; d0 < ND0; ++d0) { o[d0][4 * g + 0] *= a4[0]; o[d0][4 * g + 1] *= a4[1]; o[d0][4 * g + 2] *= a4[2]; o[d0][4 * g + 3] *= a4[3]; } }
        ATT_LDSWAIT();
    }
    float s = 0.f;
#pragma unroll
    for (int r = 0; r < 16; ++r) {
        if (live0<DEAD>(r)) { p0[r] = __builtin_amdgcn_exp2f(REL ? p0[r] : p0[r] - mrun); s += p0[r]; } else p0[r] = 0.f;
        if (live1<DEAD>(r)) { p1[r] = __builtin_amdgcn_exp2f(REL ? p1[r] : p1[r] - mrun); s += p1[r]; } else p1[r] = 0.f; }
    lsum += s;
    pw0 = (u32x4){cvtpk(p0[0], p0[1]), cvtpk(p0[2], p0[3]), cvtpk(p0[4], p0[5]), cvtpk(p0[6], p0[7])};
    pw1 = (u32x4){cvtpk(p0[8], p0[9]), cvtpk(p0[10], p0[11]), cvtpk(p0[12], p0[13]), cvtpk(p0[14], p0[15])};
    pw2 = (u32x4){cvtpk(p1[0], p1[1]), cvtpk(p1[2], p1[3]), cvtpk(p1[4], p1[5]), cvtpk(p1[6], p1[7])};
    pw3 = (u32x4){cvtpk(p1[8], p1[9]), cvtpk(p1[10], p1[11]), cvtpk(p1[12], p1[13]), cvtpk(p1[14], p1[15])};
}

constexpr int A_SLOTK = 8192, A_SLOTV = 16384, A_NS = 3, A_NSV = 4;
constexpr int A_LDS_K = 0, A_LDS_V = A_NS * A_SLOTK, A_LDS_WS = A_LDS_V + A_NSV * A_SLOTV, A_LDS_ST = A_LDS_WS + 8 * 256, A_LDS_BYTES = A_LDS_ST + 8 * 8192;
__device__ __forceinline__ void attn_a_unit(int b, int h, int qb, const bf16_t* proj, bf16_t* ya, const float* subln, float lam, unsigned char* shm) {
    int tid_l = threadIdx.x; asm volatile("" : "+v"(tid_l));
    const int tid = tid_l, lane = tid & 63, r32 = lane & 31, hi = lane >> 5; const int wid = __builtin_amdgcn_readfirstlane(tid >> 6);
    const size_t rowbase = (size_t)b * SEQ; const int q0 = qb * 256;
    constexpr int NT = SEQ / 64;
    const unsigned lds0 = (unsigned)(uintptr_t)shm;
    const lds_cptr shm3 = (lds_cptr)shm;
    __attribute__((address_space(3))) float* wsf = (__attribute__((address_space(3))) float*)((lds_ptr)shm + A_LDS_WS) + wid * 64;
    const int vb0 = (int)(lds0 + A_LDS_V) + ((lane >> 4) & 1) * 32 + (lane & 3) * 8 + (4 * hi + ((lane & 15) >> 2)) * 64;
    __attribute__((address_space(3))) bf16_t* stg = (__attribute__((address_space(3))) bf16_t*)((lds_ptr)shm + A_LDS_ST) + wid * 4096;
    for (int mp = 0; mp < 2; ++mp) {
        const bf16_t* Kh = proj + rowbase * INW + C_KA + h * 128 + mp * 64;
        const bf16_t* Vh = proj + rowbase * INW + C_VA + h * 128;
        const bf16_t* Qw = proj + (rowbase + q0 + wid * 32) * INW + C_QA + h * 128 + mp * 64;
        const int pA = 2 * wid, pB = 2 * wid + 1;
        const unsigned kdst = lds0 + A_LDS_K + wid * 1024, vdstA = lds0 + A_LDS_V + pA * 1024, vdstB = lds0 + A_LDS_V + pB * 1024;
#define A_DMA(t, slot, vsl) do { int ln_ = lane; asm volatile("" : "+v"(ln_)); \
        const bf16_t* ksrc_ = Kh + (size_t)((t) * 64 + ln_) * INW + wid * 8; \
        const bf16_t* vsrcA_ = Vh + (size_t)((t) * 64 + 16 * (pA & 3) + (ln_ >> 2)) * INW + (pA >> 2) * 32 + (ln_ & 3) * 8; \
        const bf16_t* vsrcB_ = Vh + (size_t)((t) * 64 + 16 * (pB & 3) + (ln_ >> 2)) * INW + (pB >> 2) * 32 + (ln_ & 3) * 8; \
        glds16(ksrc_, (unsigned)__builtin_amdgcn_readfirstlane(kdst + (slot) * A_SLOTK)); \
        glds16(vsrcA_, (unsigned)__builtin_amdgcn_readfirstlane(vdstA + (vsl) * A_SLOTV)); \
        glds16(vsrcB_, (unsigned)__builtin_amdgcn_readfirstlane(vdstB + (vsl) * A_SLOTV)); } while (0)
        A_DMA(0, 0, 0); A_DMA(1, 1, 1);
        bf16x8 qr[4];
#pragma unroll
        for (int d0 = 0; d0 < 4; ++d0) qr[d0] = *(const bf16x8*)(Qw + (size_t)r32 * INW + d0 * 16 + hi * 8);
        f32x16 o[4]; o[0] = f32x16{}; o[1] = f32x16{}; o[2] = f32x16{}; o[3] = f32x16{};
        float mrun = 0.f, lsum = 0.f; f32x16 negm = f32x16{};
        int slot = 0, slot2 = 2, vslot = 0, vslot2 = 2, vprev = 3;
        const bool late = wid >= 4;
        u32x4 pw0 = {}, pw1 = {}, pw2 = {}, pw3 = {};
        for (int t = 0; t < NT; ++t) {
            if (t + 1 < NT) { ATT_WAIT_BAR(3); } else { ATT_WAIT_BAR(0); }
            if (t + 2 < NT) A_DMA(t + 2, slot2, vslot2);
            if (late && t > 0) pv<4>(o, vb0 + vprev * A_SLOTV, __builtin_bit_cast(bf16x8, pw0), __builtin_bit_cast(bf16x8, pw1), __builtin_bit_cast(bf16x8, pw2), __builtin_bit_cast(bf16x8, pw3));
            f32x16 p0, p1;
            qkt<false>(p0, p1, shm3 + A_LDS_K + slot * A_SLOTK, qr, negm, r32, hi);
            softmax_tile<4, 8, false>(p0, p1, mrun, lsum, negm, t == 0, o, wsf, r32, hi, pw0, pw1, pw2, pw3);
            if (!late) pv<4>(o, vb0 + vslot * A_SLOTV, __builtin_bit_cast(bf16x8, pw0), __builtin_bit_cast(bf16x8, pw1), __builtin_bit_cast(bf16x8, pw2), __builtin_bit_cast(bf16x8, pw3));
            slot = (slot == 2) ? 0 : slot + 1; slot2 = (slot2 == 2) ? 0 : slot2 + 1;
            vprev = vslot; vslot = (vslot + 1) & 3; vslot2 = (vslot2 + 1) & 3;
        }
        if (late) pv<4>(o, vb0 + vprev * A_SLOTV, __builtin_bit_cast(bf16x8, pw0), __builtin_bit_cast(bf16x8, pw1), __builtin_bit_cast(bf16x8, pw2), __builtin_bit_cast(bf16x8, pw3));
#undef A_DMA
        const float lt = halfsum(lsum);
        if (hi == 0) wsf[32 + r32] = lt;
        ATT_LDSWAIT();
        float rli[16];
#pragma unroll
        for (int g = 0; g < 4; ++g) { const f32x4 l4 = *(const __attribute__((address_space(3))) f32x4*)(wsf + 32 + 8 * g + 4 * hi);
            rli[4 * g + 0] = __builtin_amdgcn_rcpf(l4[0]); rli[4 * g + 1] = __builtin_amdgcn_rcpf(l4[1]); rli[4 * g + 2] = __builtin_amdgcn_rcpf(l4[2]); rli[4 * g + 3] = __builtin_amdgcn_rcpf(l4[3]); }
        ATT_LDSWAIT();
        if (mp == 0) {
#pragma unroll
            for (int d0 = 0; d0 < 4; ++d0)
#pragma unroll
                for (int r = 0; r < 16; ++r) stg[crow(r, hi) * 128 + d0 * 32 + r32] = (bf16_t)f2bf(o[d0][r] * rli[r]);
            asm volatile("s_waitcnt lgkmcnt(0)\n\ts_barrier" ::: "memory");
        } else {
            float ss[16];
#pragma unroll
            for (int r = 0; r < 16; ++r) ss[r] = 0.f;
#pragma unroll
            for (int d0 = 0; d0 < 4; ++d0)
#pragma unroll
                for (int r = 0; r < 16; ++r) { const float a = bf2f(stg[crow(r, hi) * 128 + d0 * 32 + r32]); const float y = a - lam * o[d0][r] * rli[r]; o[d0][r] = y; ss[r] += y * y; }
#pragma unroll
            for (int r = 0; r < 16; ++r) { float v = ss[r]; v += __shfl_xor(v, 1); v += __shfl_xor(v, 2); v += __shfl_xor(v, 4); v += __shfl_xor(v, 8); v += __shfl_xor(v, 16);
                ss[r] = 0.8f / sqrtf(v * (1.f / 128.f) + EPS); }
            ATT_LDSWAIT();
#pragma unroll
            for (int d0 = 0; d0 < 4; ++d0) { const float gsub = subln[d0 * 32 + r32];
#pragma unroll
                for (int r = 0; r < 16; ++r) stg[crow(r, hi) * 128 + d0 * 32 + r32] = (bf16_t)f2bf(o[d0][r] * ss[r] * gsub); }
            ATT_LDSWAIT();
            bf16_t* Yw = ya + (rowbase + q0 + wid * 32) * 1024 + h * 128;
#pragma unroll
            for (int i = 0; i < 8; ++i) { const int row = i * 4 + (lane >> 4), ch = lane & 15; const u32x4 v = *(const __attribute__((address_space(3))) u32x4*)(stg + row * 128 + ch * 8); *(u32x4*)(Yw + (size_t)row * 1024 + ch * 8) = v; }
            asm volatile("s_waitcnt lgkmcnt(0)\n\ts_barrier" ::: "memory");
        }
    }
}

template <int DEAD> __device__ __forceinline__ void na_tile(lds_cptr Kslot, int vb, const bf16x8* qr, const __attribute__((address_space(3))) float* bp, const float (&fm0)[16], const float (&fm1)[16],
                                                        float& mrun, float& lsum, f32x16& negm, bool first, f32x16* o, __attribute__((address_space(3))) float* wsf, int r32, int hi) {
    f32x16 p0, p1; u32x4 pw0, pw1, pw2, pw3;
    qkt<true>(p0, p1, Kslot, qr, negm, r32, hi);
#pragma unroll
    for (int rr = 0; rr < 16; ++rr) { const int jj = (rr & 3) + 8 * (rr >> 2);
        if (live0<DEAD>(rr)) p0[rr] += bp[jj] + fm0[rr];
        if (live1<DEAD>(rr)) p1[rr] += bp[jj + 32] + fm1[rr]; }
    softmax_tile<2, 8, true, DEAD>(p0, p1, mrun, lsum, negm, first, o, wsf, r32, hi, pw0, pw1, pw2, pw3);
    pv<2>(o, vb, __builtin_bit_cast(bf16x8, pw0), __builtin_bit_cast(bf16x8, pw1), __builtin_bit_cast(bf16x8, pw2), __builtin_bit_cast(bf16x8, pw3));
}
constexpr int B_SLOT = 8192, B_NS = 6, B_PF = 5;
constexpr int B_LDS_K = 0, B_LDS_V = B_NS * B_SLOT, B_LDS_WS = 2 * B_NS * B_SLOT, B_LDS_BIAS = B_LDS_WS + 8 * 256, B_LDS_ST = B_LDS_BIAS + 2560, B_LDS_BYTES = B_LDS_ST + 8 * 4096;
__device__ __forceinline__ void attn_b_unit(int b, int h, int rg, const bf16_t* proj, bf16_t* yb, const float* rpb, unsigned char* shm) {
    int tid_l = threadIdx.x; asm volatile("" : "+v"(tid_l));
    const int tid = tid_l, lane = tid & 63, r32 = lane & 31, hi = lane >> 5; const int wid = __builtin_amdgcn_readfirstlane(tid >> 6);
    const size_t rowbase = (size_t)b * SEQ;
    const int r = 4 * rg + (wid >> 1), c0 = 32 * (wid & 1);
    int rs = r - 4; rs = rs < 0 ? 0 : (rs > 24 ? 24 : rs);
    int rmin = 4 * rg - 4; rmin = rmin < 0 ? 0 : (rmin > 24 ? 24 : rmin);
    int rmaxs = 4 * rg + 3 - 4; rmaxs = rmaxs < 0 ? 0 : (rmaxs > 24 ? 24 : rmaxs);
    const int ntile = rmaxs + 8 - rmin;
    const unsigned lds0 = (unsigned)(uintptr_t)shm;
    const lds_cptr shm3 = (lds_cptr)shm;
    __attribute__((address_space(3))) float* wsf = (__attribute__((address_space(3))) float*)((lds_ptr)shm + B_LDS_WS) + wid * 64;
    __attribute__((address_space(3))) float* bias = (__attribute__((address_space(3))) float*)((lds_ptr)shm + B_LDS_BIAS) + 64;
    __attribute__((address_space(3))) bf16_t* stg = (__attribute__((address_space(3))) bf16_t*)((lds_ptr)shm + B_LDS_ST) + wid * 2048;
    const int vb0 = (int)(lds0 + B_LDS_V) + ((lane >> 4) & 1) * 32 + (lane & 3) * 8 + (4 * hi + ((lane & 15) >> 2)) * 64;
    for (int i = tid; i < 640; i += 512) { const int e = i - 64, ri = e >> 5, cj = e & 31; bias[e] = (e >= 0 && e < 480 && cj < 31) ? rpb[(h * 15 + ri) * 31 + cj] * LOG2E : 0.f; }
    const bf16_t* Kh = proj + rowbase * INW + C_KB + h * 64;
    const bf16_t* Vh = proj + rowbase * INW + C_VB + h * 64;
    const bf16_t* Qw = proj + (rowbase + r * 64 + c0) * INW + C_QB + h * 64;
    const unsigned kdst = lds0 + B_LDS_K + wid * 1024, vdst = lds0 + B_LDS_V + wid * 1024;
#define B_DMA(t, slot) do { int ln_ = lane; asm volatile("" : "+v"(ln_)); \
    const bf16_t* ksrc_ = Kh + (size_t)((rmin + (t)) * 64 + ln_) * INW + wid * 8; \
    const bf16_t* vsrc_ = Vh + (size_t)((rmin + (t)) * 64 + 16 * (wid & 3) + (ln_ >> 2)) * INW + (wid >> 2) * 32 + (ln_ & 3) * 8; \
    glds16(ksrc_, (unsigned)__builtin_amdgcn_readfirstlane(kdst + (slot) * B_SLOT)); \
    glds16(vsrc_, (unsigned)__builtin_amdgcn_readfirstlane(vdst + (slot) * B_SLOT)); } while (0)
#pragma unroll
    for (int t = 0; t < 3; ++t) B_DMA(t, t);
    bf16x8 qr[4];
#pragma unroll
    for (int d0 = 0; d0 < 4; ++d0) qr[d0] = *(const bf16x8*)(Qw + (size_t)r32 * INW + d0 * 16 + hi * 8);
    f32x16 o[2]; o[0] = f32x16{}; o[1] = f32x16{};
    float mrun = 0.f, lsum = 0.f; f32x16 negm = f32x16{}; bool first = true;
    const int c = c0 + r32; int cs = c - 8; cs = cs < 0 ? 0 : (cs > 48 ? 48 : cs);
    float fm0[16], fm1[16];
#pragma unroll
    for (int rr = 0; rr < 16; ++rr) { const int j0 = crow(rr, hi); fm0[rr] = ((unsigned)(j0 - cs) < 16u) ? 0.f : -1e30f; fm1[rr] = ((unsigned)(j0 + 32 - cs) < 16u) ? 0.f : -1e30f; }
    int slot = 0, slotn = 3;
#define B_TILE(tt, sl) do { const int kr = rmin + (tt); \
        if (kr >= rs && kr < rs + 8) {        \
            const __attribute__((address_space(3))) float* bp = bias + ((kr - r + 7) * 32 + 15 - c + 4 * hi);        \
            if (wid & 1) na_tile<2>(shm3 + B_LDS_K + (sl) * B_SLOT, vb0 + (sl) * B_SLOT, qr, bp, fm0, fm1, mrun, lsum, negm, first, o, wsf, r32, hi); \
            else         na_tile<1>(shm3 + B_LDS_K + (sl) * B_SLOT, vb0 + (sl) * B_SLOT, qr, bp, fm0, fm1, mrun, lsum, negm, first, o, wsf, r32, hi); \
            first = false; } } while (0)
    for (int t = 0; t < ntile; t += 3) {
        ATT_WAIT_BAR(0);
#pragma unroll
        for (int k3 = 0; k3 < 3; ++k3) { int sn = slotn + k3; sn = sn >= B_NS ? sn - B_NS : sn; if (t + 3 + k3 < ntile) B_DMA(t + 3 + k3, sn); }
#pragma unroll 1
        for (int k3 = 0; k3 < 3; ++k3) { int sl = slot + k3; sl = sl >= B_NS ? sl - B_NS : sl; if (t + k3 < ntile) B_TILE(t + k3, sl); }
        slot = slot + 3 >= B_NS ? slot + 3 - B_NS : slot + 3; slotn = slotn + 3 >= B_NS ? slotn + 3 - B_NS : slotn + 3;
    }
#undef B_TILE
#undef B_DMA
    const float lt = halfsum(lsum);
    if (hi == 0) wsf[32 + r32] = lt;
    ATT_LDSWAIT();
    float rli[16];
#pragma unroll
    for (int g = 0; g < 4; ++g) { const f32x4 l4 = *(const __attribute__((address_space(3))) f32x4*)(wsf + 32 + 8 * g + 4 * hi);
        rli[4 * g + 0] = __builtin_amdgcn_rcpf(l4[0]); rli[4 * g + 1] = __builtin_amdgcn_rcpf(l4[1]); rli[4 * g + 2] = __builtin_amdgcn_rcpf(l4[2]); rli[4 * g + 3] = __builtin_amdgcn_rcpf(l4[3]); }
#pragma unroll
    for (int d0 = 0; d0 < 2; ++d0)
#pragma unroll
        for (int rr = 0; rr < 16; ++rr) stg[crow(rr, hi) * 64 + d0 * 32 + r32] = (bf16_t)f2bf(o[d0][rr] * rli[rr]);
    ATT_LDSWAIT();
    bf16_t* Yw = yb + (rowbase + r * 64 + c0) * 1024 + 512 + h * 64;
#pragma unroll
    for (int i = 0; i < 4; ++i) { const int row = i * 8 + (lane >> 3), ch = lane & 7; const u32x4 v = *(const __attribute__((address_space(3))) u32x4*)(stg + row * 64 + ch * 8); *(u32x4*)(Yw + (size_t)row * 1024 + ch * 8) = v; }
    asm volatile("s_waitcnt lgkmcnt(0)\n\ts_barrier" ::: "memory");
}
}

namespace peer {
typedef short bf16x8 __attribute__((ext_vector_type(8)));
typedef float f32x16 __attribute__((ext_vector_type(16)));
typedef __attribute__((address_space(3))) const char* lds_cptr;
constexpr int T_LDS_SK = 0, T_LDS_BYTES = 65536;
__device__ __forceinline__ int imax(int a, int b) { int r; asm("v_max_f32 %0, %1, %2" : "=v"(r) : "v"(a), "v"(b)); return r; }
__device__ __forceinline__ int imin(int a, int b) { int r; asm("v_min_f32 %0, %1, %2" : "=v"(r) : "v"(a), "v"(b)); return r; }
__device__ __forceinline__ int f2key(float s, int idx) { return (__float_as_int(s) & ~127) | idx; }
__device__ __forceinline__ int key2bits(int k) { return k; }
template <int N, int OFF, int TOT> __device__ __forceinline__ void bsort_desc(int (&a)[TOT]) {
#pragma unroll
    for (int k = 2; k <= N; k <<= 1)
#pragma unroll
        for (int j = k >> 1; j > 0; j >>= 1)
#pragma unroll
            for (int i = 0; i < N; ++i) { const int l = i ^ j; if (l > i) { const bool desc = (i & k) == 0; const int hi_ = imax(a[OFF + i], a[OFF + l]), lo_ = imin(a[OFF + i], a[OFF + l]); a[OFF + i] = desc ? hi_ : lo_; a[OFF + l] = desc ? lo_ : hi_; } }
}
__device__ constexpr unsigned char NET16[126] = {0,1,2,3,0,2,1,3,1,2,4,5,6,7,4,6,5,7,5,6,0,4,2,6,2,4,1,5,3,7,3,5,1,2,3,4,5,6,8,9,10,11,8,10,9,11,9,10,12,13,14,15,12,14,13,15,13,14,8,12,10,14,10,12,9,13,11,15,11,13,9,10,11,12,13,14,0,8,4,12,4,8,2,10,6,14,6,10,2,4,6,8,10,12,1,9,5,13,5,9,3,11,7,15,7,11,3,5,7,9,11,13,1,2,3,4,5,6,7,8,9,10,11,12,13,14};
__device__ constexpr unsigned char NET32[382] = {0,1,2,3,0,2,1,3,1,2,4,5,6,7,4,6,5,7,5,6,0,4,2,6,2,4,1,5,3,7,3,5,1,2,3,4,5,6,8,9,10,11,8,10,9,11,9,10,12,13,14,15,12,14,13,15,13,14,8,12,10,14,10,12,9,13,11,15,11,13,9,10,11,12,13,14,0,8,4,12,4,8,2,10,6,14,6,10,2,4,6,8,10,12,1,9,5,13,5,9,3,11,7,15,7,11,3,5,7,9,11,13,1,2,3,4,5,6,7,8,9,10,11,12,13,14,16,17,18,19,16,18,17,19,17,18,20,21,22,23,20,22,21,23,21,22,16,20,18,22,18,20,17,21,19,23,19,21,17,18,19,20,21,22,24,25,26,27,24,26,25,27,25,26,28,29,30,31,28,30,29,31,29,30,24,28,26,30,26,28,25,29,27,31,27,29,25,26,27,28,29,30,16,24,20,28,20,24,18,26,22,30,22,26,18,20,22,24,26,28,17,25,21,29,21,25,19,27,23,31,23,27,19,21,23,25,27,29,17,18,19,20,21,22,23,24,25,26,27,28,29,30,0,16,8,24,8,16,4,20,12,28,12,20,4,8,12,16,20,24,2,18,10,26,10,18,6,22,14,30,14,22,6,10,14,18,22,26,2,4,6,8,10,12,14,16,18,20,22,24,26,28,1,17,9,25,9,17,5,21,13,29,13,21,5,9,13,17,21,25,3,19,11,27,11,19,7,23,15,31,15,23,7,11,15,19,23,27,3,5,7,9,11,13,15,17,19,21,23,25,27,29,1,2,3,4,5,6,7,8,9,10,11,12,13,14,15,16,17,18,19,20,21,22,23,24,25,26,27,28,29,30};
template <int OFF, int TOT> __device__ __forceinline__ void sort16_desc(int (&a)[TOT]) {
#pragma unroll
    for (int c = 0; c < 63; ++c) { const int i = OFF + NET16[2 * c], j = OFF + NET16[2 * c + 1]; const int hi_ = imax(a[i], a[j]), lo_ = imin(a[i], a[j]); a[i] = hi_; a[j] = lo_; }
}
template <int TOT> __device__ __forceinline__ void sort32_desc(int (&a)[TOT]) {
#pragma unroll
    for (int c = 0; c < 191; ++c) { const int i = NET32[2 * c], j = NET32[2 * c + 1]; const int hi_ = imax(a[i], a[j]), lo_ = imin(a[i], a[j]); a[i] = hi_; a[j] = lo_; }
}
template <int N, int OFF, int TOT> __device__ __forceinline__ void bmerge_desc(int (&a)[TOT]) {
#pragma unroll
    for (int j = N >> 1; j > 0; j >>= 1)
#pragma unroll
        for (int i = 0; i < N; ++i) { const int l = i ^ j; if (l > i) { const int hi_ = imax(a[OFF + i], a[OFF + l]), lo_ = imin(a[OFF + i], a[OFF + l]); a[OFF + i] = hi_; a[OFF + l] = lo_; } }
}
template <int A, int B, int TOT> __device__ __forceinline__ void merge_top16(int (&a)[TOT]) {
#pragma unroll
    for (int i = 0; i < 16; ++i) a[A + i] = imax(a[A + i], a[B + 15 - i]);
    bmerge_desc<16, A, TOT>(a);
}
__device__ __forceinline__ void cross_top16(int (&t)[16]) {
    int lo[16], hi[16];
#pragma unroll
    for (int i = 0; i < 16; ++i) { auto rr = __builtin_amdgcn_permlane32_swap((unsigned)t[i], (unsigned)t[i], false, false); lo[i] = (int)rr[0]; hi[i] = (int)rr[1]; }
#pragma unroll
    for (int i = 0; i < 16; ++i) t[i] = imax(lo[i], hi[15 - i]);
    bmerge_desc<16, 0, 16>(t);
}
struct RowStream {
    const float* pu; const float* pv; unsigned char* ws; int r, step, lane; f32x4 v0, v1, v2, v3;
    __device__ __forceinline__ void issue() {
        if (r < 2 * NEXP) { const float* src = (r < NEXP ? pu + (size_t)r * D : pv + (size_t)(r - NEXP) * D); const f32x4* s4 = (const f32x4*)src + lane * 4; v0 = s4[0]; v1 = s4[1]; v2 = s4[2]; v3 = s4[3]; } }
    __device__ __forceinline__ void finish() {
        if (r < 2 * NEXP) { const f32x4 cur[4] = {v0, v1, v2, v3};
            if (r < NEXP) cvt_row_i4(cur, ws + WS_U + (size_t)r * 512, (float*)(ws + WS_SU) + r, lane);
            else { const int e = r - NEXP; cvt_row_fp8(cur, ws + WS_V + (size_t)e * 512, (float*)(ws + WS_SV) + e, lane); }
            r += step; } }
    __device__ __forceinline__ void hook() { finish(); issue(); }
};
__device__ __forceinline__ void half_top16(int (&top)[16], const bf16_t* qrow  , lds_cptr skp  , int hi, RowStream& RS) {
    f32x16 sc[4]; sc[0] = f32x16{}; sc[1] = f32x16{}; sc[2] = f32x16{}; sc[3] = f32x16{};
    bf16x8 qf[8];
#pragma unroll
    for (int ks = 0; ks < 8; ++ks) qf[ks] = *(const bf16x8*)(qrow + ks * 16);
    RS.hook();
#pragma unroll
    for (int ks = 0; ks < 8; ++ks)
#pragma unroll
        for (int kt = 0; kt < 4; ++kt) { const bf16x8 af = *(const __attribute__((address_space(3))) bf16x8*)(skp + ks * 4096 + kt * 512);
            sc[kt] = __builtin_amdgcn_mfma_f32_32x32x16_bf16(af, qf[ks], sc[kt], 0, 0, 0); }
    int k[64];
#pragma unroll
    for (int kt = 0; kt < 4; ++kt)
#pragma unroll
        for (int r = 0; r < 16; ++r) k[kt * 16 + r] = f2key(sc[kt][r], (32 * kt + (r & 3) + 8 * (r >> 2)) | (4 * hi));
    sort16_desc<0, 64>(k); sort16_desc<16, 64>(k);
    RS.hook();
    sort16_desc<32, 64>(k); sort16_desc<48, 64>(k);
    RS.hook();
    merge_top16<0, 16, 64>(k); merge_top16<32, 48, 64>(k); merge_top16<0, 32, 64>(k);
#pragma unroll
    for (int i = 0; i < 16; ++i) top[i] = k[i];
    cross_top16(top);
}
__device__ __forceinline__ void topk_wave(int tok0, int h, const bf16_t* Q, int* IDX, float* Gt, lds_cptr sk, int lane, RowStream& RS) {
    const int r32 = lane & 31, hi = lane >> 5, tok = tok0 + r32;
    const bf16_t* qrow = Q + (size_t)tok * PQ + h * 256 + 8 * hi;
    lds_cptr skl = sk + hi * 2048 + r32 * 16;
    int A0[16], A1[16];
    half_top16(A0, qrow, skl, hi, RS);
    half_top16(A1, qrow + 128, skl + 32768, hi, RS);
    RS.hook();
    float x[16], y[16]; int xw[16], yw[16];
#pragma unroll
    for (int a = 0; a < 16; ++a) { const int b0 = key2bits(A0[a]), b1 = key2bits(A1[a]);
        const float v0 = __int_as_float(b0 & ~127), v1 = __int_as_float(b1 & ~127); const int i0 = (b0 & 127) << 7, i1 = b1 & 127;
        x[a] = hi ? v1 : v0; y[a] = hi ? v0 : v1; xw[a] = hi ? i1 : i0; yw[a] = hi ? i0 : i1; }
    int w[32]; int n = 0;
#define PEER_CAND(a, b) do { const int bits = __float_as_int(x[a] + y[b]); int ww = (bits & ~0x3FFF) | (xw[a] + yw[b]); \
        if ((a) == (b) && hi) ww = (int)0xFF800000; w[n] = ww; ++n; } while (0)
#pragma unroll
    for (int b = 0; b < 16; ++b) PEER_CAND(0, b);
#pragma unroll
    for (int b = 1; b < 8; ++b) PEER_CAND(1, b);
#pragma unroll
    for (int b = 2; b < 5; ++b) PEER_CAND(2, b);
    PEER_CAND(3, 3);
#undef PEER_CAND
#pragma unroll
    for (int i = 27; i < 32; ++i) w[i] = (int)0xFF800000;
    RS.hook();
    sort32_desc<32>(w);
    RS.hook();
    int T[16];
#pragma unroll
    for (int i = 0; i < 16; ++i) T[i] = w[i];
    cross_top16(T);
    float sv[16]; int ev[16];
#pragma unroll
    for (int j = 0; j < 16; ++j) { ev[j] = T[j] & 0x3FFF; sv[j] = __int_as_float(T[j] & ~0x3FFF); }
    const float s0 = sv[0]; float esum = 0.f;
#pragma unroll
    for (int j = 0; j < 16; ++j) { sv[j] = __expf(sv[j] - s0); esum += sv[j]; }
    const float inv = 1.f / esum;
    if (hi == 0) { u32x4* io = (u32x4*)(IDX + ((size_t)tok * 8 + h) * 16);
#pragma unroll
        for (int j = 0; j < 4; ++j) io[j] = (u32x4){(unsigned)ev[4 * j], (unsigned)ev[4 * j + 1], (unsigned)ev[4 * j + 2], (unsigned)ev[4 * j + 3]}; }
    else { f32x4* go = (f32x4*)(Gt + ((size_t)tok * 8 + h) * 16);
#pragma unroll
        for (int j = 0; j < 4; ++j) go[j] = (f32x4){sv[4 * j] * inv, sv[4 * j + 1] * inv, sv[4 * j + 2] * inv, sv[4 * j + 3] * inv}; }
}
template <class Sched> __device__ __forceinline__ void topk_own_units(const Ptrs& P, unsigned char* shm, const Sched& S) {
    int tid_l = threadIdx.x; asm volatile("" : "+v"(tid_l));
    const int tid = tid_l, lane = tid & 63; const int wid = __builtin_amdgcn_readfirstlane(tid >> 6);
    const unsigned lds0 = (unsigned)(uintptr_t)shm;
    const bf16_t* SKg = (const bf16_t*)(P.ws + WS_SK);
    int hprev = -1; pg8::Unit u;
    RowStream RS; RS.pu = P.peer_u; RS.pv = P.peer_v; RS.ws = P.ws; RS.lane = lane; RS.step = (int)gridDim.x * 8; RS.r = (int)blockIdx.x * 8 + wid; RS.v0 = RS.v1 = RS.v2 = RS.v3 = f32x4{};
    RS.issue();
    for (int i = 0; S.next(i, u); ++i) {
        const int h = u.pn, tg = u.pm;
        if (h != hprev) { hprev = h;
            asm volatile("s_waitcnt lgkmcnt(0)\n\ts_barrier" ::: "memory");
#pragma unroll
            for (int j = 0; j < 8; ++j) { const int piece = wid * 8 + j, p = piece >> 5, c = (piece >> 1) & 15, kh = piece & 1;
                att::glds16(SKg + ((size_t)((h * 2 + p) * 128 + kh * 64 + lane) * 128 + c * 8), (unsigned)__builtin_amdgcn_readfirstlane(lds0 + p * 32768 + c * 2048 + kh * 1024)); }
            asm volatile("s_waitcnt vmcnt(0)\n\ts_barrier" ::: "memory");
        }
        topk_wave(tg * 256 + wid * 32, h, (const bf16_t*)(P.ws + WS_Q), (int*)(P.ws + WS_IDX), (float*)(P.ws + WS_G), (lds_cptr)shm, lane, RS);
    }
    while (RS.r < 2 * NEXP) RS.hook();
}
}

namespace apply {
typedef float f32x2 __attribute__((ext_vector_type(2)));
typedef __attribute__((address_space(3))) unsigned* lds_u32p;
constexpr int AP_WAVE_BYTES = 4 * (512 + 2048), AP_LDS_BYTES = 8 * AP_WAVE_BYTES;
__device__ __forceinline__ float gelu_fast(float v) {
    const float av = fabsf(v), t = __builtin_amdgcn_rcpf(av * 0.2316418882f + 1.0f);
    float q = t * 0.5307027145f + (-0.7265760135f); q = q * t + 0.7107068705f; q = q * t + (-0.142248368f); q = q * t + 0.127414796f; q = q * t;
    const float e = __builtin_amdgcn_exp2f((v * v) * (-0.72134752044f));
    const float m = v * (q * e);
    return v < 0.f ? m : v - m;
}
#define AP_DPP(v, ctrl) __builtin_bit_cast(float, __builtin_amdgcn_update_dpp(0, __builtin_bit_cast(int, (v)), (ctrl), 0xF, 0xF, true))
__device__ __forceinline__ float row16_sum(float v) { v += AP_DPP(v, 0xB1); v += AP_DPP(v, 0x4E); v += AP_DPP(v, 0x141); v += AP_DPP(v, 0x140); return v; }
__device__ __forceinline__ void load_half(u32x4 (&r)[2], const unsigned char* img, unsigned e, int sub) {
    const unsigned off = e * 512u + (unsigned)(sub * 16);
    r[0] = *(const u32x4*)(img + off); r[1] = *(const u32x4*)(img + off + 256u);
}
constexpr int AP_PROBE_RING = 16;
constexpr int AP_RING = 8;
typedef __attribute__((address_space(3))) u32x4* lds_v4p;
template <int HF, int MODE, int RING> __device__ __forceinline__ void pass_u(const Ptrs& P, const bf16_t* hrow, float rstd, lds_v4p grp, u32x4 (&R)[RING][2], const unsigned char* img, const unsigned char* img_next, int sub) {
    unsigned xq[8]; float sx;
    {
        float xf[2][16]; float mx = 0.f;
#pragma unroll
        for (int i = 0; i < 2; ++i) { const int e0 = (sub + 16 * (2 * HF + i)) * 16;
#pragma unroll
            for (int q = 0; q < 4; ++q) { const u32x2 hb = *(const u32x2*)(hrow + e0 + 4 * q); const f32x4 gv = *(const f32x4*)(P.norm_ffn + e0 + 4 * q);
                xf[i][4 * q] = bflo(hb.x) * rstd * gv.x; xf[i][4 * q + 1] = bfhi(hb.x) * rstd * gv.y; xf[i][4 * q + 2] = bflo(hb.y) * rstd * gv.z; xf[i][4 * q + 3] = bfhi(hb.y) * rstd * gv.w;
                mx = fmaxf(fmaxf(mx, fmaxf(fabsf(xf[i][4 * q]), fabsf(xf[i][4 * q + 1]))), fmaxf(fabsf(xf[i][4 * q + 2]), fabsf(xf[i][4 * q + 3]))); } }
        mx = fmaxf(mx, AP_DPP(mx, 0xB1)); mx = fmaxf(mx, AP_DPP(mx, 0x4E)); mx = fmaxf(mx, AP_DPP(mx, 0x141)); mx = fmaxf(mx, AP_DPP(mx, 0x140));
        mx = fmaxf(mx, 1e-30f); sx = mx * (1.f / 127.f); const float qs = 127.f / mx;
#pragma unroll
        for (int i = 0; i < 2; ++i)
#pragma unroll
            for (int q = 0; q < 4; ++q) xq[4 * i + q] = pack_i8x4(xf[i][4 * q] * qs, xf[i][4 * q + 1] * qs, xf[i][4 * q + 2] * qs, xf[i][4 * q + 3] * qs);
    }
#pragma unroll 1
    for (int j = 0; j < 128; j += RING) {
        const int jn = (j + RING) & 127;
        __builtin_amdgcn_s_barrier();
        const unsigned char* tb = (j + RING < 128) ? img : img_next;
        unsigned nid[RING], part[RING], suv[RING], gsv[RING];
#pragma unroll
        for (int b4 = 0; b4 < RING / 4; ++b4) { const u32x4 na = grp[jn / 4 + b4];
            nid[4 * b4] = na.x; nid[4 * b4 + 1] = na.y; nid[4 * b4 + 2] = na.z; nid[4 * b4 + 3] = na.w;
            u32x4 pa = {}, sa = {}, ga = {};
            if (HF == 1) { pa = grp[96 + j / 4 + b4]; sa = grp[32 + j / 4 + b4]; ga = grp[64 + j / 4 + b4]; }
            part[4 * b4] = pa.x; part[4 * b4 + 1] = pa.y; part[4 * b4 + 2] = pa.z; part[4 * b4 + 3] = pa.w;
            suv[4 * b4] = sa.x; suv[4 * b4 + 1] = sa.y; suv[4 * b4 + 2] = sa.z; suv[4 * b4 + 3] = sa.w;
            gsv[4 * b4] = ga.x; gsv[4 * b4 + 1] = ga.y; gsv[4 * b4 + 2] = ga.z; gsv[4 * b4 + 3] = ga.w; }
        float outv[RING];
#pragma unroll
        for (int bq = 0; bq < RING; ++bq) {
            int d0_ = 0, d1_ = 0;
            if (MODE == 1) { asm volatile("" :: "v"(R[bq][0]), "v"(R[bq][1])); d0_ = (int)xq[0]; }
            else {
                d0_ = __builtin_amdgcn_sdot4((int)R[bq][0].x, (int)xq[0], d0_, false); d1_ = __builtin_amdgcn_sdot4((int)R[bq][0].y, (int)xq[1], d1_, false);
                d0_ = __builtin_amdgcn_sdot4((int)R[bq][0].z, (int)xq[2], d0_, false); d1_ = __builtin_amdgcn_sdot4((int)R[bq][0].w, (int)xq[3], d1_, false);
                d0_ = __builtin_amdgcn_sdot4((int)R[bq][1].x, (int)xq[4], d0_, false); d1_ = __builtin_amdgcn_sdot4((int)R[bq][1].y, (int)xq[5], d1_, false);
                d0_ = __builtin_amdgcn_sdot4((int)R[bq][1].z, (int)xq[6], d0_, false); d1_ = __builtin_amdgcn_sdot4((int)R[bq][1].w, (int)xq[7], d1_, false);
            }
            asm volatile("" ::: "memory");
            load_half(R[bq], tb, MODE == 2 ? (nid[bq] & 15u) : nid[bq], sub);
            asm volatile("" ::: "memory");
            float a_ = row16_sum((float)(d0_ + d1_)) * sx;
            if (HF == 1) { a_ = (a_ + __uint_as_float(part[bq])) * __uint_as_float(suv[bq]); a_ = __uint_as_float(gsv[bq]) * gelu_fast(a_); }
            outv[bq] = a_;
        }
        if (sub == 0) {
#pragma unroll
            for (int b4 = 0; b4 < RING / 4; ++b4) grp[96 + j / 4 + b4] = (u32x4){__float_as_uint(outv[4 * b4]), __float_as_uint(outv[4 * b4 + 1]), __float_as_uint(outv[4 * b4 + 2]), __float_as_uint(outv[4 * b4 + 3])}; }
    }
    asm volatile("s_waitcnt lgkmcnt(0)" ::: "memory");
}
template <int HF, int MODE, int RING> __device__ __forceinline__ void pass_v(float (&acc)[4][16], lds_v4p grp, u32x4 (&R)[RING][2], const unsigned char* img, const unsigned char* img_next, int sub) {
#pragma unroll 1
    for (int j = 0; j < 128; j += RING) {
        const int jn = (j + RING) & 127;
        __builtin_amdgcn_s_barrier();
        const unsigned char* tb = (j + RING < 128) ? img : img_next;
        unsigned nid[RING], cvv[RING];
#pragma unroll
        for (int b4 = 0; b4 < RING / 4; ++b4) { const u32x4 na = grp[jn / 4 + b4], ca = grp[96 + j / 4 + b4];
            nid[4 * b4] = na.x; nid[4 * b4 + 1] = na.y; nid[4 * b4 + 2] = na.z; nid[4 * b4 + 3] = na.w; cvv[4 * b4] = ca.x; cvv[4 * b4 + 1] = ca.y; cvv[4 * b4 + 2] = ca.z; cvv[4 * b4 + 3] = ca.w; }
#pragma unroll
        for (int bq = 0; bq < RING; ++bq) {
            const float c_ = __uint_as_float(cvv[bq]); const f32x2 c2 = {c_, c_};
            if (MODE == 1) { asm volatile("" :: "v"(R[bq][0]), "v"(R[bq][1])); acc[2 * HF][0] += c_; }
            else {
#pragma unroll
            for (int i = 0; i < 2; ++i) { const unsigned w_[4] = {R[bq][i].x, R[bq][i].y, R[bq][i].z, R[bq][i].w};
#pragma unroll
                for (int q = 0; q < 4; ++q) { const f32x2 lo_ = __builtin_amdgcn_cvt_pk_f32_fp8(w_[q], false), hi_ = __builtin_amdgcn_cvt_pk_f32_fp8(w_[q], true);
                    f32x2 a0 = {acc[2 * HF + i][4 * q], acc[2 * HF + i][4 * q + 1]}, a1 = {acc[2 * HF + i][4 * q + 2], acc[2 * HF + i][4 * q + 3]}; a0 += c2 * lo_; a1 += c2 * hi_;
                    acc[2 * HF + i][4 * q] = a0.x; acc[2 * HF + i][4 * q + 1] = a0.y; acc[2 * HF + i][4 * q + 2] = a1.x; acc[2 * HF + i][4 * q + 3] = a1.y; } }
            }
            asm volatile("" ::: "memory");
            load_half(R[bq], tb, MODE == 2 ? (nid[bq] & 15u) : nid[bq], sub);
            asm volatile("" ::: "memory");
        }
    }
}
constexpr int AP_RINGU = 16;
__device__ __forceinline__ u32x4 load_q4(const unsigned char* img, unsigned e, int sub) { return *(const u32x4*)(img + e * 256u + (unsigned)(sub * 16)); }
template <int HF, int RF> __device__ __forceinline__ void u4_half_turn(lds_v4p grp, u32x4 (&R)[AP_RINGU], const unsigned (&xh)[4], const unsigned (&xl)[4], float sx, const unsigned char* tb, int jb, int jr, int sub) {
    constexpr int RING = AP_RINGU;
    __builtin_amdgcn_s_barrier();
    unsigned nid[RING];
    if (RF != 2) {
#pragma unroll
        for (int b4 = 0; b4 < RING / 4; ++b4) { const u32x4 na = grp[jr / 4 + b4]; nid[4 * b4] = na.x; nid[4 * b4 + 1] = na.y; nid[4 * b4 + 2] = na.z; nid[4 * b4 + 3] = na.w; } }
    float outv[RING];
#pragma unroll
    for (int b4 = 0; b4 < RING / 4; ++b4) {
        u32x4 pa = {}, sa = {}, ga = {};
        if (HF == 1) { pa = grp[96 + jb / 4 + b4]; sa = grp[32 + jb / 4 + b4]; ga = grp[64 + jb / 4 + b4]; }
        const unsigned part[4] = {pa.x, pa.y, pa.z, pa.w}, suv[4] = {sa.x, sa.y, sa.z, sa.w}, gsv[4] = {ga.x, ga.y, ga.z, ga.w};
#pragma unroll
        for (int b1 = 0; b1 < 4; ++b1) { const int bq = 4 * b4 + b1;
            int dh_ = __builtin_amdgcn_sdot8((int)R[bq].x, (int)xh[0], 0, false), dl_ = __builtin_amdgcn_sdot8((int)R[bq].x, (int)xl[0], 0, false);
            dh_ = __builtin_amdgcn_sdot8((int)R[bq].y, (int)xh[1], dh_, false); dl_ = __builtin_amdgcn_sdot8((int)R[bq].y, (int)xl[1], dl_, false);
            dh_ = __builtin_amdgcn_sdot8((int)R[bq].z, (int)xh[2], dh_, false); dl_ = __builtin_amdgcn_sdot8((int)R[bq].z, (int)xl[2], dl_, false);
            dh_ = __builtin_amdgcn_sdot8((int)R[bq].w, (int)xh[3], dh_, false); dl_ = __builtin_amdgcn_sdot8((int)R[bq].w, (int)xl[3], dl_, false);
            asm volatile("" ::: "memory");
            if (RF == 0) R[bq] = load_q4(tb, nid[bq], sub);
            else if (RF == 1) R[bq] = *(const u32x4*)(tb + nid[bq >> 1] * 512u + (unsigned)(sub * 16 + (bq & 1) * 256));
            asm volatile("" ::: "memory");
            float a_ = row16_sum((float)(dh_ * 16 + dl_)) * sx;
            if (HF == 1) { a_ = (a_ + __uint_as_float(part[b1])) * __uint_as_float(suv[b1]); a_ = __uint_as_float(gsv[b1]) * gelu_fast(a_); }
            outv[bq] = a_; }
    }
    if (sub == 0) {
#pragma unroll
        for (int b4 = 0; b4 < RING / 4; ++b4) grp[96 + jb / 4 + b4] = (u32x4){__float_as_uint(outv[4 * b4]), __float_as_uint(outv[4 * b4 + 1]), __float_as_uint(outv[4 * b4 + 2]), __float_as_uint(outv[4 * b4 + 3])}; }
}
template <int HF, bool NEXTV> __device__ __forceinline__ void pass_u4(const Ptrs& P, const bf16_t* hrow, float rstd, lds_v4p grp, u32x4 (&RA)[AP_RINGU], u32x4 (&RB)[AP_RINGU], const unsigned char* img, const unsigned char* img_next, int sub) {
    unsigned xh[4], xl[4]; float sx;
    {
        float xf[2][16]; float mx = 0.f;
#pragma unroll
        for (int i = 0; i < 2; ++i) { const int e0 = (sub + 16 * (2 * HF + i)) * 16;
#pragma unroll
            for (int q = 0; q < 4; ++q) { const u32x2 hb = *(const u32x2*)(hrow + e0 + 4 * q); const f32x4 gv = *(const f32x4*)(P.norm_ffn + e0 + 4 * q);
                xf[i][4 * q] = bflo(hb.x) * rstd * gv.x; xf[i][4 * q + 1] = bfhi(hb.x) * rstd * gv.y; xf[i][4 * q + 2] = bflo(hb.y) * rstd * gv.z; xf[i][4 * q + 3] = bfhi(hb.y) * rstd * gv.w;
                mx = fmaxf(fmaxf(mx, fmaxf(fabsf(xf[i][4 * q]), fabsf(xf[i][4 * q + 1]))), fmaxf(fabsf(xf[i][4 * q + 2]), fabsf(xf[i][4 * q + 3]))); } }
        mx = fmaxf(mx, AP_DPP(mx, 0xB1)); mx = fmaxf(mx, AP_DPP(mx, 0x4E)); mx = fmaxf(mx, AP_DPP(mx, 0x141)); mx = fmaxf(mx, AP_DPP(mx, 0x140));
        mx = fmaxf(mx, 1e-30f); sx = mx * (1.f / 119.f); const float qs = 119.f / mx;
#pragma unroll
        for (int q = 0; q < 4; ++q) { unsigned h_ = 0u, l_ = 0u;
#pragma unroll
            for (int i = 0; i < 8; ++i) { const int xi = (int)rintf(xf[q >> 1][8 * (q & 1) + i] * qs); const int lo = ((xi + 8) & 15) - 8; const int hi = (xi - lo) >> 4;
                h_ |= ((unsigned)hi & 15u) << (4 * i); l_ |= ((unsigned)lo & 15u) << (4 * i); }
            xh[q] = h_; xl[q] = l_; }
    }
#pragma unroll 1
    for (int j = 0; j < 96; j += 32) {
        u4_half_turn<HF, 0>(grp, RA, xh, xl, sx, img, j, j + 32, sub);
        u4_half_turn<HF, 0>(grp, RB, xh, xl, sx, img, j + 16, j + 48, sub);
    }
    u4_half_turn<HF, NEXTV ? 1 : 0>(grp, RA, xh, xl, sx, img_next, 96, 0, sub);
    u4_half_turn<HF, NEXTV ? 2 : 0>(grp, RB, xh, xl, sx, img_next, 112, 16, sub);
    asm volatile("s_waitcnt lgkmcnt(0)" ::: "memory");
}
template <int RF> __device__ __forceinline__ void u4f_half_turn(lds_v4p grp, u32x4 (&R)[AP_RINGU], const unsigned (&xh)[8], const unsigned (&xl)[8], float sx, const unsigned char* tb, int jb, int jr, int sub) {
    unsigned nid[8];
    if (RF != 2) {
#pragma unroll
        for (int b4 = 0; b4 < 2; ++b4) { const u32x4 na = grp[jr / 4 + b4]; nid[4 * b4] = na.x; nid[4 * b4 + 1] = na.y; nid[4 * b4 + 2] = na.z; nid[4 * b4 + 3] = na.w; } }
    float outv[8];
#pragma unroll
    for (int b4 = 0; b4 < 2; ++b4) {
        const u32x4 sa = grp[32 + jb / 4 + b4], ga = grp[64 + jb / 4 + b4];
        const unsigned suv[4] = {sa.x, sa.y, sa.z, sa.w}, gsv[4] = {ga.x, ga.y, ga.z, ga.w};
#pragma unroll
        for (int b1 = 0; b1 < 4; ++b1) { const int e = 4 * b4 + b1;
            int dh_ = 0, dl_ = 0;
#pragma unroll
            for (int p = 0; p < 2; ++p) { const unsigned w_[4] = {R[2 * e + p].x, R[2 * e + p].y, R[2 * e + p].z, R[2 * e + p].w};
#pragma unroll
                for (int q = 0; q < 4; ++q) { dh_ = __builtin_amdgcn_sdot8((int)w_[q], (int)xh[4 * p + q], dh_, false); dl_ = __builtin_amdgcn_sdot8((int)w_[q], (int)xl[4 * p + q], dl_, false); } }
            asm volatile("" ::: "memory");
            if (RF == 0) { const unsigned off = nid[e] * 512u + (unsigned)(sub * 16); R[2 * e] = *(const u32x4*)(tb + off); R[2 * e + 1] = *(const u32x4*)(tb + off + 256u); }
            else if (RF == 1) { const unsigned off = nid[e] * 512u + (unsigned)(sub * 16); R[2 * e] = *(const u32x4*)(tb + off); R[2 * e + 1] = *(const u32x4*)(tb + off + 256u); }
            asm volatile("" ::: "memory");
            float a_ = row16_sum((float)(dh_ * 16 + dl_)) * sx * __uint_as_float(suv[b1]);
            outv[e] = __uint_as_float(gsv[b1]) * gelu_fast(a_); }
    }
    if (sub == 0) {
#pragma unroll
        for (int b4 = 0; b4 < 2; ++b4) grp[96 + jb / 4 + b4] = (u32x4){__float_as_uint(outv[4 * b4]), __float_as_uint(outv[4 * b4 + 1]), __float_as_uint(outv[4 * b4 + 2]), __float_as_uint(outv[4 * b4 + 3])}; }
}
__device__ __forceinline__ void pass_u4f(const Ptrs& P, const bf16_t* hrow, float rstd, lds_v4p grp, u32x4 (&RA)[AP_RINGU], u32x4 (&RB)[AP_RINGU], const unsigned char* img, const unsigned char* vimg, int sub) {
    unsigned xh[8], xl[8]; float sx;
    {
        float mx = 0.f;
#pragma unroll
        for (int i = 0; i < 4; ++i) { const int e0 = (sub + 16 * i) * 16;
#pragma unroll
            for (int q = 0; q < 4; ++q) { const u32x2 hb = *(const u32x2*)(hrow + e0 + 4 * q); const f32x4 gv = *(const f32x4*)(P.norm_ffn + e0 + 4 * q);
                const float x0 = bflo(hb.x) * rstd * gv.x, x1 = bfhi(hb.x) * rstd * gv.y, x2 = bflo(hb.y) * rstd * gv.z, x3 = bfhi(hb.y) * rstd * gv.w;
                mx = fmaxf(fmaxf(mx, fmaxf(fabsf(x0), fabsf(x1))), fmaxf(fabsf(x2), fabsf(x3))); } }
        mx = fmaxf(mx, AP_DPP(mx, 0xB1)); mx = fmaxf(mx, AP_DPP(mx, 0x4E)); mx = fmaxf(mx, AP_DPP(mx, 0x141)); mx = fmaxf(mx, AP_DPP(mx, 0x140));
        mx = fmaxf(mx, 1e-30f); sx = mx * (1.f / 119.f); const float qs = 119.f / mx;
#pragma unroll
        for (int q = 0; q < 8; ++q) { unsigned h_ = 0u, l_ = 0u; const int e0 = (sub + 16 * (q >> 1)) * 16 + 8 * (q & 1);
#pragma unroll
            for (int hf = 0; hf < 2; ++hf) { const u32x2 hb = *(const u32x2*)(hrow + e0 + 4 * hf); const f32x4 gv = *(const f32x4*)(P.norm_ffn + e0 + 4 * hf);
                const float xv[4] = {bflo(hb.x) * rstd * gv.x, bfhi(hb.x) * rstd * gv.y, bflo(hb.y) * rstd * gv.z, bfhi(hb.y) * rstd * gv.w};
#pragma unroll
                for (int i = 0; i < 4; ++i) { const int xi = (int)rintf(xv[i] * qs); const int lo = ((xi + 8) & 15) - 8; const int hi = (xi - lo) >> 4;
                    h_ |= ((unsigned)hi & 15u) << (4 * (4 * hf + i)); l_ |= ((unsigned)lo & 15u) << (4 * (4 * hf + i)); } }
            xh[q] = h_; xl[q] = l_; }
    }
#pragma unroll 1
    for (int j = 0; j < 112; j += 16) {
        __builtin_amdgcn_s_barrier();
        u4f_half_turn<0>(grp, RA, xh, xl, sx, img, j, j + 16, sub);
        u4f_half_turn<0>(grp, RB, xh, xl, sx, img, j + 8, j + 24, sub);
    }
    __builtin_amdgcn_s_barrier();
    u4f_half_turn<1>(grp, RA, xh, xl, sx, vimg, 112, 0, sub);
    u4f_half_turn<2>(grp, RB, xh, xl, sx, vimg, 120, 0, sub);
    asm volatile("s_waitcnt lgkmcnt(0)" ::: "memory");
}
template <int HF> __device__ __forceinline__ void pass_v8f(float (&acc)[4][16], lds_v4p grp, u32x4 (&R)[AP_RINGU], const unsigned char* img, const unsigned char* img_next, int sub) {
    constexpr int RING = 8;
#pragma unroll 1
    for (int j = 0; j < 128; j += RING) {
        const int jn = (j + RING) & 127;
        if ((j & 31) == 0) __builtin_amdgcn_s_barrier();
        const unsigned char* tb = (j + RING < 128) ? img : img_next;
        unsigned nid[RING], cvv[RING];
#pragma unroll
        for (int b4 = 0; b4 < RING / 4; ++b4) { const u32x4 na = grp[jn / 4 + b4], ca = grp[96 + j / 4 + b4];
            nid[4 * b4] = na.x; nid[4 * b4 + 1] = na.y; nid[4 * b4 + 2] = na.z; nid[4 * b4 + 3] = na.w; cvv[4 * b4] = ca.x; cvv[4 * b4 + 1] = ca.y; cvv[4 * b4 + 2] = ca.z; cvv[4 * b4 + 3] = ca.w; }
#pragma unroll
        for (int bq = 0; bq < RING; ++bq) {
            const float c_ = __uint_as_float(cvv[bq]); const f32x2 c2 = {c_, c_};
#pragma unroll
            for (int i = 0; i < 2; ++i) { const unsigned w_[4] = {R[2 * bq + i].x, R[2 * bq + i].y, R[2 * bq + i].z, R[2 * bq + i].w};
#pragma unroll
                for (int q = 0; q < 4; ++q) { const f32x2 lo_ = __builtin_amdgcn_cvt_pk_f32_fp8(w_[q], false), hi_ = __builtin_amdgcn_cvt_pk_f32_fp8(w_[q], true);
                    f32x2 a0 = {acc[2 * HF + i][4 * q], acc[2 * HF + i][4 * q + 1]}, a1 = {acc[2 * HF + i][4 * q + 2], acc[2 * HF + i][4 * q + 3]}; a0 += c2 * lo_; a1 += c2 * hi_;
                    acc[2 * HF + i][4 * q] = a0.x; acc[2 * HF + i][4 * q + 1] = a0.y; acc[2 * HF + i][4 * q + 2] = a1.x; acc[2 * HF + i][4 * q + 3] = a1.y; } }
            asm volatile("" ::: "memory");
            { const unsigned off = nid[bq] * 512u + (unsigned)(sub * 16); R[2 * bq] = *(const u32x4*)(tb + off); R[2 * bq + 1] = *(const u32x4*)(tb + off + 256u); }
            asm volatile("" ::: "memory");
        }
    }
}
template <int MODE> __device__ __forceinline__ void apply_round(const Ptrs& P, float* outbase, int tbase, unsigned char* shm_wave, int lane_in) {
    int lane = lane_in; asm volatile("" : "+v"(lane));
    const int sub = lane & 15, g = lane >> 4, t = tbase + g;
    __attribute__((address_space(3))) unsigned* cnt = (lds_u32p)(__attribute__((address_space(3))) unsigned char*)shm_wave + g * 128;
    lds_v4p grp = (lds_v4p)((__attribute__((address_space(3))) unsigned char*)shm_wave + 2048 + g * 2048);
    __attribute__((address_space(3))) unsigned* grp1 = (__attribute__((address_space(3))) unsigned*)grp;
    const unsigned char* U8 = P.ws + WS_U; const unsigned char* V8 = P.ws + WS_V;
    {
        const int* idxp = (const int*)(P.ws + WS_IDX) + (size_t)t * 128 + sub * 8; const float* gp = (const float*)(P.ws + WS_G) + (size_t)t * 128 + sub * 8;
        const u32x4 ia = *(const u32x4*)idxp, ib = *(const u32x4*)(idxp + 4); const f32x4 ga = *(const f32x4*)gp, gb = *(const f32x4*)(gp + 4);
        const int e[8] = {(int)ia.x, (int)ia.y, (int)ia.z, (int)ia.w, (int)ib.x, (int)ib.y, (int)ib.z, (int)ib.w};
        const float gt[8] = {ga.x, ga.y, ga.z, ga.w, gb.x, gb.y, gb.z, gb.w};
        float su[8], sv[8];
#pragma unroll
        for (int i = 0; i < 8; ++i) { su[i] = ((const float*)(P.ws + WS_SU))[e[i]]; sv[i] = ((const float*)(P.ws + WS_SV))[e[i]]; }
#pragma unroll
        for (int i = 0; i < 8; ++i) cnt[sub * 8 + i] = 0u;
        asm volatile("s_waitcnt lgkmcnt(0)" ::: "memory");
        unsigned pos[8];
#pragma unroll
        for (int i = 0; i < 8; ++i) pos[i] = __hip_atomic_fetch_add(cnt + (e[i] >> 7), 1u, __ATOMIC_RELAXED, __HIP_MEMORY_SCOPE_WAVEFRONT);
        asm volatile("s_waitcnt lgkmcnt(0)" ::: "memory");
        unsigned c[8]; unsigned tot = 0;
#pragma unroll
        for (int i = 0; i < 8; ++i) { c[i] = cnt[sub * 8 + i]; }
#pragma unroll
        for (int i = 0; i < 8; ++i) { const unsigned x = c[i]; c[i] = tot; tot += x; }
        unsigned inc = tot;
#pragma unroll
        for (int d = 1; d < 16; d <<= 1) { const unsigned y = __shfl_up(inc, d, 16); if (sub >= d) inc += y; }
        const unsigned base = inc - tot;
        asm volatile("s_waitcnt lgkmcnt(0)" ::: "memory");
#pragma unroll
        for (int i = 0; i < 8; ++i) cnt[sub * 8 + i] = base + c[i];
        asm volatile("s_waitcnt lgkmcnt(0)" ::: "memory");
#pragma unroll
        for (int i = 0; i < 8; ++i) { const unsigned p = cnt[e[i] >> 7] + pos[i];
            grp1[p] = (unsigned)e[i]; grp1[128 + p] = __float_as_uint(su[i]); grp1[256 + p] = __float_as_uint(gt[i] * sv[i]); }
        asm volatile("s_waitcnt lgkmcnt(0)" ::: "memory");
    }
    const bf16_t* hrow = (const bf16_t*)(P.ws + WS_HB) + (size_t)t * D;
    float rstd;
    { const float* ssq = (const float*)(P.ws + WS_SSQ) + (size_t)t * 16;
      const f32x4 s0 = *(const f32x4*)ssq, s1 = *(const f32x4*)(ssq + 4), s2 = *(const f32x4*)(ssq + 8), s3 = *(const f32x4*)(ssq + 12);
      const float tot = ((s0.x + s0.y) + (s0.z + s0.w)) + ((s1.x + s1.y) + (s1.z + s1.w)) + ((s2.x + s2.y) + (s2.z + s2.w)) + ((s3.x + s3.y) + (s3.z + s3.w));
      rstd = 1.f / sqrtf(tot * (1.f / D) + EPS); }
    const unsigned char* U0 = U8; const unsigned char* U1 = U8 + (size_t)NEXP * 256; const unsigned char* V0 = V8; const unsigned char* V1 = V8 + (size_t)NEXP * 512;
    u32x4 R[AP_RINGU];
    {
      u32x4 RB[AP_RINGU];
#pragma unroll
      for (int b4 = 0; b4 < 4; ++b4) { const u32x4 ia = grp[b4]; const unsigned ev[4] = {ia.x, ia.y, ia.z, ia.w};
#pragma unroll
        for (int k = 0; k < 4; ++k) { const int e = 4 * b4 + k; const unsigned off = ev[k] * 512u + (unsigned)(sub * 16);
          if (e < 8) { R[2 * e] = *(const u32x4*)(U0 + off); R[2 * e + 1] = *(const u32x4*)(U0 + off + 256u); } else { RB[2 * (e - 8)] = *(const u32x4*)(U0 + off); RB[2 * (e - 8) + 1] = *(const u32x4*)(U0 + off + 256u); } } }
      pass_u4f(P, hrow, rstd, grp, R, RB, U0, V0, sub);
    }
    float acc[4][16];
#pragma unroll
    for (int i = 0; i < 4; ++i)
#pragma unroll
        for (int q = 0; q < 16; ++q) acc[i][q] = 0.f;
    pass_v8f<0>(acc, grp, R, V0, V1, sub);
    pass_v8f<1>(acc, grp, R, V1, V1, sub);
    float ss = 0.f;
#pragma unroll
    for (int i = 0; i < 4; ++i) { const int e0 = (sub + 16 * i) * 16;
#pragma unroll
        for (int q = 0; q < 4; ++q) { const u32x2 hb = *(const u32x2*)(hrow + e0 + 4 * q);
            acc[i][4 * q] += bflo(hb.x); acc[i][4 * q + 1] += bfhi(hb.x); acc[i][4 * q + 2] += bflo(hb.y); acc[i][4 * q + 3] += bfhi(hb.y);
            ss += (acc[i][4 * q] * acc[i][4 * q] + acc[i][4 * q + 1] * acc[i][4 * q + 1]) + (acc[i][4 * q + 2] * acc[i][4 * q + 2] + acc[i][4 * q + 3] * acc[i][4 * q + 3]); }
        asm volatile("" ::: "memory"); }
    ss = row16_sum(ss);
    const float r2 = 1.f / sqrtf(ss * (1.f / D) + EPS);
    float* orow = outbase + (size_t)t * D;
#pragma unroll
    for (int i = 0; i < 4; ++i) { const int e0 = (sub + 16 * i) * 16;
#pragma unroll
        for (int q = 0; q < 4; ++q) { const f32x4 gv = *(const f32x4*)(P.norm_final + e0 + 4 * q);
            *(f32x4*)(orow + e0 + 4 * q) = (f32x4){acc[i][4 * q] * r2 * gv.x, acc[i][4 * q + 1] * r2 * gv.y, acc[i][4 * q + 2] * r2 * gv.z, acc[i][4 * q + 3] * r2 * gv.w}; }
        asm volatile("" ::: "memory"); }
}
template <int MODE> __device__ __forceinline__ void apply_phase(const Ptrs& P, float* outbase, unsigned char* shm, int G, int vcu) {
    int tid_l = threadIdx.x; asm volatile("" : "+v"(tid_l));
    const int lane = tid_l & 63; const int wave = __builtin_amdgcn_readfirstlane(tid_l >> 6);
    const int per = M / (G * 8);
#pragma unroll 1
    for (int r = 0; r < per; r += 4) apply_round<MODE>(P, outbase, (vcu * 8 + wave) * per + r, shm + wave * AP_WAVE_BYTES, lane);
}
}

#define LAS __attribute__((address_space(3)))
#define XB_TMO      128
#define XB_XCNT(j)  (256  + 64 * (j))
#define XB_XSUB(j)  (1280 + 64 * (j))
#define XB_XGEN(j)  (2304 + 64 * (j))
#define XB_TOP      3328
#define XB_TOPGEN   3392
#define XCD_BAR_WORDS 3456
#define XB_SPIN_CAP (1u << 18)

__device__ __forceinline__ unsigned xb_ld(unsigned* p)              { return __hip_atomic_load(p, __ATOMIC_RELAXED, __HIP_MEMORY_SCOPE_AGENT); }
__device__ __forceinline__ unsigned xb_add(unsigned* p, unsigned v) { return __hip_atomic_fetch_add(p, v, __ATOMIC_RELAXED, __HIP_MEMORY_SCOPE_AGENT); }
__device__ __forceinline__ unsigned xb_xcc_id() { return (unsigned)__builtin_amdgcn_s_getreg((3 << 11) | 20) & 0xFu; }
#define XB_SPIN(cond, bar) do { unsigned _sp = 0; while (cond) { __builtin_amdgcn_s_sleep(1); \
    if ((++_sp & 255u) == 0u) { if (xb_ld(&(bar)[XB_TMO])) break; if (_sp > XB_SPIN_CAP) { atomicAdd(&(bar)[XB_TMO], 1u); break; } } } } while (0)

struct XcdBarrier {
    unsigned* bar; unsigned x;
    volatile LAS unsigned* st;
};

__device__ __forceinline__ XcdBarrier xcd_barrier_post(unsigned* bar, volatile LAS unsigned* st) {
    XcdBarrier b; b.bar = bar; b.x = xb_xcc_id(); b.st = st;
    if (threadIdx.x == 0) (void)xb_add(&bar[XB_XCNT(b.x)], 1u);
    return b;
}
__device__ __forceinline__ void xcd_barrier_complete(unsigned* bar, unsigned x, unsigned& nloc, unsigned& nx) {
    const unsigned G = gridDim.x * gridDim.y * gridDim.z;
    unsigned sum, cnt, mine, sp = 0u;
    for (;;) {
        sum = 0u; cnt = 0u; mine = 0u;
#pragma unroll
        for (unsigned j = 0; j < 16; ++j) { const unsigned c = xb_ld(&bar[XB_XCNT(j)]); sum += c; cnt += (c > 0u) ? 1u : 0u; mine = (j == x) ? c : mine; }
        if (sum == G) break;
        __builtin_amdgcn_s_sleep(1);
        if ((++sp & 255u) == 0u) { if (xb_ld(&bar[XB_TMO])) break; if (sp > XB_SPIN_CAP) { atomicAdd(&bar[XB_TMO], 1u); break; } }
    }
    nloc = mine > 0u ? mine : 1u; nx = cnt > 0u ? cnt : 1u;
}

__device__ __forceinline__ void xcd_barrier(const XcdBarrier& b) {
    asm volatile("s_waitcnt vmcnt(0)" ::: "memory");
    __syncthreads();
    if (threadIdx.x == 0) {
        unsigned* bar = b.bar;
        __builtin_amdgcn_s_waitcnt(0);
        unsigned nloc = b.st[0], nx = b.st[1];
        if (nloc == 0u) { xcd_barrier_complete(bar, b.x, nloc, nx); b.st[0] = nloc; b.st[1] = nx; }
        const unsigned old = xb_add(&bar[XB_XSUB(b.x)], 1u);
        const unsigned gen = old / nloc;
        if (old + 1u == (gen + 1u) * nloc) {
            __builtin_amdgcn_fence(__ATOMIC_RELEASE, "agent");
            asm volatile("s_waitcnt vmcnt(0)" ::: "memory");
            const unsigned og = xb_add(&bar[XB_TOP], 1u);
            const unsigned tg = og / nx;
            if (og + 1u == (tg + 1u) * nx) xb_add(&bar[XB_TOPGEN], 1u);
            else XB_SPIN(xb_ld(&bar[XB_TOPGEN]) == tg, bar);
            __builtin_amdgcn_fence(__ATOMIC_ACQUIRE, "agent");
            xb_add(&bar[XB_XGEN(b.x)], 1u);
            asm volatile("s_waitcnt vmcnt(0)" ::: "memory");
        } else {
            XB_SPIN(xb_ld(&bar[XB_XGEN(b.x)]) == gen, bar);
            __builtin_amdgcn_fence(__ATOMIC_ACQUIRE, "agent");
            asm volatile("s_waitcnt vmcnt(0)" ::: "memory");
        }
    }
    __syncthreads();
}


namespace cg = cooperative_groups;
#ifndef REP_MASK
#define REP_MASK 0
#endif
#define REPS(k) (((REP_MASK) >> (k)) & 1 ? 2 : 1)
constexpr int PHASE_LDS = att::A_LDS_BYTES;
constexpr int MEGA_LDS = PHASE_LDS + 64;
static_assert(PHASE_LDS >= pg8::STAGE_BYTES && PHASE_LDS >= att::B_LDS_BYTES && PHASE_LDS >= peer::T_LDS_BYTES && PHASE_LDS >= 8 * 64 * 33 * 4 && PHASE_LDS >= apply::AP_LDS_BYTES, "LDS budget");
__global__ void __launch_bounds__(512, 2) mega_fwd(Ptrs P) {
    extern __shared__ __attribute__((aligned(16))) unsigned char lds_dyn[];
    volatile LAS unsigned* bst = (volatile LAS unsigned*)((LAS unsigned char*)lds_dyn + PHASE_LDS);
    if (threadIdx.x < 2) bst[threadIdx.x] = 0u;
    __syncthreads();
    const XcdBarrier bar = xcd_barrier_post((unsigned*)(P.ws + WS_CTL), bst);
    const int G = (int)gridDim.x, bx = (int)blockIdx.x, vcu = (G % 8 == 0) ? (bx % 8) * (G / 8) + bx / 8 : bx;
    unsigned char* ws = P.ws;
    PG8_LAS unsigned char* lds3 = (PG8_LAS unsigned char*)lds_dyn;
    for (int rep = 0; rep < REPS(0); ++rep) prep_phase(P, lds_dyn, G, bx);
    xcd_barrier(bar); if (REPS(9) == 2) xcd_barrier(bar);
    for (int rep = 0; rep < REPS(1); ++rep) {
      { pg8::Gemm g{(const bf16_t*)(ws + WS_XN), (const bf16_t*)(ws + WS_WIN), M, 1024, D, 0}; pg8::StaticOrder S; S.init(M, 1024, G, bx);
        pg8::gemm_phase<pg8::EpiProj, pg8::StaticOrder, true, true, false>(lds3, g, S, pg8::EpiProj{(bf16_t*)(ws + WS_PROJ), (const float*)(ws + WS_ROPE), 1.f, 0}); }
      { pg8::Gemm g{(const bf16_t*)(ws + WS_XN8), (const bf16_t*)(ws + WS_WIN8), M, INW - 1024, D / 2, 0}; pg8::StaticOrder S; S.init(M, INW - 1024, G, bx);
        pg8::gemm_phase<pg8::EpiProj, pg8::StaticOrder, true, true, true>(lds3, g, S, pg8::EpiProj{(bf16_t*)(ws + WS_PROJ), (const float*)(ws + WS_ROPE), 1.f / WIN_SCALE, 4}); } }
    xcd_barrier(bar); if (REPS(9) == 2) xcd_barrier(bar);
    { const float lam = lambda_full(P);
      for (int rep = 0; rep < REPS(2); ++rep) for (int u = vcu; u < BATCH * 4 * 8; u += G) att::attn_a_unit(u >> 5, (u >> 3) & 3, u & 7, (const bf16_t*)(ws + WS_PROJ), (bf16_t*)(ws + WS_YA), P.subln, lam, lds_dyn);
      for (int rep = 0; rep < REPS(3); ++rep) for (int u = vcu; u < BATCH * 8 * 8; u += G) att::attn_b_unit(u >> 6, (u >> 3) & 7, u & 7, (const bf16_t*)(ws + WS_PROJ), (bf16_t*)(ws + WS_YA), P.rpb, lds_dyn); }
    xcd_barrier(bar); if (REPS(9) == 2) xcd_barrier(bar);
    for (int rep = 0; rep < REPS(4); ++rep) { pg8::StaticOrder S; S.init(M, D, G, bx);
      pg8::gemm_phase<pg8::EpiGate2, pg8::StaticOrder, true, true>(lds3, pg8::Gemm{(const bf16_t*)(ws + WS_YA), (const bf16_t*)(ws + WS_WPA), M, D, D, 0}, S, pg8::EpiGate2{(const bf16_t*)(ws + WS_PROJ), (bf16_t*)(ws + WS_MERGED)}); }
    xcd_barrier(bar); if (REPS(9) == 2) xcd_barrier(bar);
    for (int rep = 0; rep < REPS(5); ++rep) { pg8::StaticOrder S; S.init(M, D, G, bx);
      pg8::gemm_phase<pg8::EpiHout, pg8::StaticOrder, true, true>(lds3, pg8::Gemm{(const bf16_t*)(ws + WS_MERGED), (const bf16_t*)(ws + WS_WOUT), M, D, D, 0}, S, pg8::EpiHout{P.x, P.out, (bf16_t*)(ws + WS_HB), (float*)(ws + WS_SSQ)});
    }
    xcd_barrier(bar); if (REPS(9) == 2) xcd_barrier(bar);
    { pg8::StaticOrder S; S.init(M, PQ, G, bx);
      for (int rep = 0; rep < REPS(8); ++rep)
        pg8::gemm_phase<pg8::EpiQ, pg8::StaticOrder, true, true>(lds3, pg8::Gemm{(const bf16_t*)(ws + WS_HB), (const bf16_t*)(ws + WS_WQ), M, PQ, D, 0}, S, pg8::EpiQ{(const float*)(ws + WS_SSQ), (bf16_t*)(ws + WS_Q)});
      asm volatile("s_waitcnt vmcnt(0)" ::: "memory");
      __syncthreads();
      if (threadIdx.x == 0) { __builtin_amdgcn_fence(__ATOMIC_ACQUIRE, "agent"); asm volatile("s_waitcnt vmcnt(0)" ::: "memory"); }
      __syncthreads();
      for (int rep = 0; rep < REPS(6); ++rep) peer::topk_own_units(P, lds_dyn, S); }
    xcd_barrier(bar); if (REPS(9) == 2) xcd_barrier(bar);
#ifndef PROBE_MODE
#define PROBE_MODE 0
#endif
    if (REPS(7) == 2) apply::apply_phase<PROBE_MODE>(P, (float*)(ws + WS_Q), lds_dyn, G, vcu);
    apply::apply_phase<0>(P, P.out, lds_dyn, G, vcu);
}

extern "C" void kernel_launch(void* const* d_in, const int* in_sizes, int n_in, void* d_out, int out_size, void* d_ws, size_t ws_size, hipStream_t stream) {
    if (n_in != 18 || ws_size < WS_END) { fprintf(stderr, "kernel_launch: unexpected n_in %d / ws_size %zu\n", n_in, ws_size); return; }
    Ptrs P{};
    P.x = (const float*)d_in[0]; P.w_in = (const float*)d_in[1]; P.w_pa = (const float*)d_in[2]; P.w_pb = (const float*)d_in[3]; P.w_out = (const float*)d_in[4];
    P.norm_mix = (const float*)d_in[5]; P.norm_ffn = (const float*)d_in[6]; P.norm_final = (const float*)d_in[7];
    P.lq1 = (const float*)d_in[8]; P.lk1 = (const float*)d_in[9]; P.lq2 = (const float*)d_in[10]; P.lk2 = (const float*)d_in[11];
    P.subln = (const float*)d_in[12]; P.rpb = (const float*)d_in[13]; P.w_query = (const float*)d_in[14]; P.sub_keys = (const float*)d_in[15];
    P.peer_u = (const float*)d_in[16]; P.peer_v = (const float*)d_in[17];
    P.out = (float*)d_out; P.ws = (unsigned char*)d_ws;
    static int grid_blocks = 0;
    if (!grid_blocks) {
        int dev = 0, cus = 0, per_cu = 0;
        hipGetDevice(&dev);
        hipDeviceGetAttribute(&cus, hipDeviceAttributeMultiprocessorCount, dev);
        hipFuncSetAttribute((const void*)mega_fwd, hipFuncAttributeMaxDynamicSharedMemorySize, MEGA_LDS);
        hipOccupancyMaxActiveBlocksPerMultiprocessor(&per_cu, (const void*)mega_fwd, 512, MEGA_LDS);
        if (per_cu < 1) { fprintf(stderr, "kernel_launch: occupancy query says %d blocks per CU\n", per_cu); per_cu = 1; }
        grid_blocks = cus * per_cu;
    }
    hipMemsetAsync((unsigned char*)d_ws + WS_CTL, 0, 16384, stream);
    void* args[] = {&P};
    hipError_t e = hipLaunchCooperativeKernel((const void*)mega_fwd, dim3(grid_blocks), dim3(512), args, MEGA_LDS, stream);
    if (e != hipSuccess) fprintf(stderr, "cooperative launch failed: %s (grid %d)\n", hipGetErrorString(e), grid_blocks);
}
```
